# Optimizing an MI355X kernel written in HIP

```python
import math
import jax, jax.numpy as jnp
from jax import lax
import numpy as np

D_MODEL = 1024
BATCH = 8
SEQ = 2048
DEPTH = 2

DIFF_HEADS = 4
DIFF_QK_DIM = D_MODEL // 16
DIFF_V_DIM = 2 * DIFF_QK_DIM
DIFF_WIDTH = DIFF_HEADS * DIFF_V_DIM
DIFF_QK_COLS = DIFF_HEADS * 2 * DIFF_QK_DIM
Q_BLOCK = 128
ROPE_THETA = 10000.0
FOURIER_GROUPS = 4
FOURIER_GROUP_DIM = D_MODEL // 16
FOURIER_WIDTH = FOURIER_GROUPS * FOURIER_GROUP_DIM
GLA_HEADS = 4
GLA_V_DIM = D_MODEL // 16
GLA_K_DIM = GLA_V_DIM // 2
GLA_WIDTH = GLA_HEADS * GLA_V_DIM
GLA_K_COLS = GLA_HEADS * GLA_K_DIM
GLA_GATE_RANK = 16
GLA_GATE_TAU = 16.0
GLA_CHUNK = 64
IN_WIDTH = 3 * DIFF_QK_COLS + FOURIER_WIDTH + 2 * GLA_K_COLS + 2 * GLA_WIDTH + 2 * GLA_GATE_RANK
MIX_WIDTH = DIFF_WIDTH + FOURIER_WIDTH + GLA_WIDTH
FFN_HIDDEN = ((math.ceil(8 * D_MODEL / 3) + 255) // 256) * 256
DEEPNORM_ALPHA = (2 * DEPTH) ** 0.25
DEEPNORM_BETA = (8 * DEPTH) ** -0.25
LN_EPS = 1e-5

kernel_name = "hybrid_diffattn_fnet_gla_deepnorm_encoder"


def layer_norm(x, g, b):
    xf = x.astype(jnp.float32)
    mu = jnp.mean(xf, axis=-1, keepdims=True)
    var = jnp.mean(jnp.square(xf - mu), axis=-1, keepdims=True)
    y = (xf - mu) * lax.rsqrt(var + LN_EPS)
    return (y * g.astype(jnp.float32) + b.astype(jnp.float32)).astype(x.dtype)


def rms_norm(x, g):
    xf = x.astype(jnp.float32)
    y = xf * lax.rsqrt(jnp.mean(jnp.square(xf), axis=-1, keepdims=True) + LN_EPS)
    return (y * g.astype(jnp.float32)).astype(x.dtype)


def rope_tables(seq_len, dim):
    pos = jnp.arange(seq_len, dtype=jnp.float32)
    inv_freq = ROPE_THETA ** (-jnp.arange(0, dim, 2, dtype=jnp.float32) / dim)
    ang = pos[:, None] * inv_freq[None, :]
    return jnp.cos(ang), jnp.sin(ang)


def apply_rope(t, cos, sin):
    tf = t.astype(jnp.float32)
    half = tf.shape[-1] // 2
    t1, t2 = tf[..., :half], tf[..., half:]
    c = cos[None, :, None, None, :]
    s = sin[None, :, None, None, :]
    return jnp.concatenate([t1 * c - t2 * s, t2 * c + t1 * s], axis=-1).astype(t.dtype)


def split_in_proj(h):
    sizes = (DIFF_QK_COLS, DIFF_QK_COLS, DIFF_WIDTH, FOURIER_WIDTH,
             GLA_K_COLS, GLA_K_COLS, GLA_WIDTH, GLA_WIDTH, 2 * GLA_GATE_RANK)
    idx = np.cumsum(sizes)[:-1].tolist()
    return jnp.split(h, idx, axis=-1)


def diff_attention(q, k, v, lam_params, lam_init, g, cos, sin):
    B, S, _ = q.shape
    qh = apply_rope(q.reshape(B, S, DIFF_HEADS, 2, DIFF_QK_DIM), cos, sin)
    kh = apply_rope(k.reshape(B, S, DIFF_HEADS, 2, DIFF_QK_DIM), cos, sin)
    vh = v.reshape(B, S, DIFF_HEADS, DIFF_V_DIM)
    lp = lam_params.astype(jnp.float32)
    lam = jnp.exp(jnp.sum(lp[0] * lp[1])) - jnp.exp(jnp.sum(lp[2] * lp[3])) + lam_init
    scale = DIFF_QK_DIM ** -0.5
    nb = S // Q_BLOCK
    qb = jnp.moveaxis(qh.reshape(B, nb, Q_BLOCK, DIFF_HEADS, 2, DIFF_QK_DIM), 1, 0)

    def block(qi):
        s = jnp.einsum('bqhmd,bkhmd->bhmqk', qi, kh,
                       preferred_element_type=jnp.float32) * scale
        p = jax.nn.softmax(s, axis=-1)
        a = p[:, :, 0] - lam * p[:, :, 1]
        return jnp.einsum('bhqk,bkhe->bqhe', a.astype(vh.dtype), vh)

    o = lax.map(block, qb)
    o = jnp.moveaxis(o, 0, 1).reshape(B, S, DIFF_HEADS, DIFF_V_DIM)
    o = rms_norm(o, g) * (1.0 - lam_init)
    return o.reshape(B, S, DIFF_WIDTH)


def fourier_mix(u, w):
    B, S, _ = u.shape
    uf = u.astype(jnp.float32).reshape(B, S, FOURIER_GROUPS, FOURIER_GROUP_DIM)
    z = jnp.fft.fft2(uf, axes=(1, 3), norm='ortho').real
    y = jnp.einsum('bsgc,gce->bsge', z.astype(u.dtype), w)
    return y.reshape(B, S, FOURIER_WIDTH)


def gla_causal_chunked(q, k, v, g):
    B, H, S, dk = q.shape
    dv = v.shape[-1]
    C = GLA_CHUNK
    N = S // C
    q = q.reshape(B, H, N, C, dk)
    k = k.reshape(B, H, N, C, dk)
    v = v.reshape(B, H, N, C, dv)
    b = lax.cumsum(g.reshape(B, H, N, C, dk), axis=3)
    q_t = q * jnp.exp(b)
    k_t = k * jnp.exp(-b)
    mask = jnp.tril(jnp.ones((C, C), jnp.float32))
    a = jnp.einsum('bhncd,bhned->bhnce', q_t, k_t) * mask
    o_intra = jnp.einsum('bhnce,bhnev->bhncv', a, v)
    b_last = b[:, :, :, -1:, :]
    chunk_kv = jnp.einsum('bhncd,bhncv->bhndv', k * jnp.exp(b_last - b), v)
    chunk_decay = jnp.exp(b_last[:, :, :, 0, :])

    def step(state, inp):
        dec, kv = inp
        return dec[..., None] * state + kv, state

    init = jnp.zeros((B, H, dk, dv), jnp.float32)
    _, s_prev = lax.scan(step, init, (jnp.moveaxis(chunk_decay, 2, 0),
                                      jnp.moveaxis(chunk_kv, 2, 0)))
    s_prev = jnp.moveaxis(s_prev, 0, 2)
    o_inter = jnp.einsum('bhncd,bhndv->bhncv', q_t, s_prev)
    return (o_intra + o_inter).reshape(B, H, S, dv)


def gla_bidirectional(q, k, v, r, z, w2, b2, g):
    B, S, _ = q.shape

    def heads(t, d):
        return t.astype(jnp.float32).reshape(B, S, GLA_HEADS, d).transpose(0, 2, 1, 3)

    qh = heads(q, GLA_K_DIM) * GLA_K_DIM ** -0.5
    kh = heads(k, GLA_K_DIM)
    vh = heads(v, GLA_V_DIM)
    zz = z.astype(jnp.float32).reshape(B, S, 2, GLA_GATE_RANK)
    logit = jnp.einsum('bsdr,drk->dbsk', zz, w2.astype(jnp.float32)) \
        + b2.astype(jnp.float32)[:, None, None, :]
    log_a = jax.nn.log_sigmoid(logit) / GLA_GATE_TAU
    ga_f = heads(log_a[0], GLA_K_DIM)
    ga_b = heads(log_a[1], GLA_K_DIM)
    flip = lambda t: jnp.flip(t, axis=2)
    o_f = gla_causal_chunked(qh, kh, vh, ga_f)
    o_b = flip(gla_causal_chunked(flip(qh), flip(kh), flip(vh), flip(ga_b)))
    o = (o_f + o_b).transpose(0, 2, 1, 3)
    gate = jax.nn.silu(r.astype(jnp.float32)).reshape(B, S, GLA_HEADS, GLA_V_DIM)
    o = rms_norm(o, g) * gate
    return o.reshape(B, S, GLA_WIDTH).astype(q.dtype)


def hybrid_mixer(x, w_in, lam_params, lam_init, diff_g, fourier_w, gla_w2, gla_b2,
                 gla_g, w_out, cos, sin):
    h = jnp.einsum('bsd,de->bse', x, w_in)
    dq, dk, dv, fu, gq, gk, gv, gr, gz = split_in_proj(h)
    o_diff = diff_attention(dq, dk, dv, lam_params, lam_init, diff_g, cos, sin)
    o_four = fourier_mix(fu, fourier_w)
    o_gla = gla_bidirectional(gq, gk, gv, gr, gz, gla_w2, gla_b2, gla_g)
    o = jnp.concatenate([o_diff, o_four.astype(o_diff.dtype), o_gla.astype(o_diff.dtype)], axis=-1)
    return jnp.einsum('bse,ed->bsd', o, w_out)


def swiglu_ffn(x, w_gate, w_up, w_down):
    hg = jnp.einsum('bsd,df->bsf', x, w_gate)
    hu = jnp.einsum('bsd,df->bsf', x, w_up)
    return jnp.einsum('bsf,fd->bsd', jax.nn.silu(hg) * hu, w_down)


def setup_inputs(seed: int = 0) -> dict:
    key = jax.random.key(seed)
    ks = jax.random.split(key, 16)
    f32 = jnp.float32
    nrm = lambda k, shape: jax.random.normal(k, shape, f32)
    x = nrm(ks[0], (BATCH, SEQ, D_MODEL))
    col_scale = jnp.concatenate([
        jnp.ones((2 * DIFF_QK_COLS,), f32),
        jnp.full((DIFF_WIDTH,), DEEPNORM_BETA, f32),
        jnp.ones((FOURIER_WIDTH + 2 * GLA_K_COLS,), f32),
        jnp.full((GLA_WIDTH,), DEEPNORM_BETA, f32),
        jnp.ones((GLA_WIDTH + 2 * GLA_GATE_RANK,), f32)])
    w_in = nrm(ks[1], (DEPTH, D_MODEL, IN_WIDTH)) * (D_MODEL ** -0.5) * col_scale
    diff_lambda = nrm(ks[2], (DEPTH, 4, DIFF_QK_DIM)) * 0.1
    diff_norm_g = 1.0 + 0.02 * nrm(ks[3], (DEPTH, DIFF_V_DIM))
    fourier_w = nrm(ks[4], (DEPTH, FOURIER_GROUPS, FOURIER_GROUP_DIM, FOURIER_GROUP_DIM)) \
        * (FOURIER_GROUP_DIM ** -0.5)
    gla_gate_w2 = nrm(ks[5], (DEPTH, 2, GLA_GATE_RANK, GLA_K_COLS)) * (GLA_GATE_RANK ** -0.5)
    gla_gate_b2 = 0.1 * nrm(ks[6], (DEPTH, 2, GLA_K_COLS))
    gla_norm_g = 1.0 + 0.02 * nrm(ks[7], (DEPTH, GLA_V_DIM))
    w_out = nrm(ks[8], (DEPTH, MIX_WIDTH, D_MODEL)) * (MIX_WIDTH ** -0.5) * DEEPNORM_BETA
    ln1_g = 1.0 + 0.02 * nrm(ks[9], (DEPTH, D_MODEL))
    ln1_b = 0.02 * nrm(ks[10], (DEPTH, D_MODEL))
    ffn_w_gate = nrm(ks[11], (DEPTH, D_MODEL, FFN_HIDDEN)) * (D_MODEL ** -0.5)
    ffn_w_up = nrm(ks[12], (DEPTH, D_MODEL, FFN_HIDDEN)) * (D_MODEL ** -0.5)
    ffn_w_down = nrm(ks[13], (DEPTH, FFN_HIDDEN, D_MODEL)) * (FFN_HIDDEN ** -0.5) * DEEPNORM_BETA
    ln2_g = 1.0 + 0.02 * nrm(ks[14], (DEPTH, D_MODEL))
    ln2_b = 0.02 * nrm(ks[15], (DEPTH, D_MODEL))
    return {"x": x, "w_in": w_in, "diff_lambda": diff_lambda, "diff_norm_g": diff_norm_g,
            "fourier_w": fourier_w, "gla_gate_w2": gla_gate_w2, "gla_gate_b2": gla_gate_b2,
            "gla_norm_g": gla_norm_g, "w_out": w_out, "ln1_g": ln1_g, "ln1_b": ln1_b,
            "ffn_w_gate": ffn_w_gate, "ffn_w_up": ffn_w_up, "ffn_w_down": ffn_w_down,
            "ln2_g": ln2_g, "ln2_b": ln2_b}


def reference(x, w_in, diff_lambda, diff_norm_g, fourier_w, gla_gate_w2, gla_gate_b2,
              gla_norm_g, w_out, ln1_g, ln1_b, ffn_w_gate, ffn_w_up, ffn_w_down,
              ln2_g, ln2_b):
    cos, sin = rope_tables(x.shape[1], DIFF_QK_DIM)
    for l in range(DEPTH):
        lam_init = 0.8 - 0.6 * math.exp(-0.3 * l)
        m = hybrid_mixer(x, w_in[l], diff_lambda[l], lam_init, diff_norm_g[l], fourier_w[l],
                         gla_gate_w2[l], gla_gate_b2[l], gla_norm_g[l], w_out[l], cos, sin)
        x = layer_norm(DEEPNORM_ALPHA * x + m.astype(x.dtype), ln1_g[l], ln1_b[l])
        f = swiglu_ffn(x, ffn_w_gate[l], ffn_w_up[l], ffn_w_down[l])
        x = layer_norm(DEEPNORM_ALPHA * x + f.astype(x.dtype), ln2_g[l], ln2_b[l])
    return x
```

```cpp
#include <hip/hip_runtime.h>
#include <cstdint>
#include <cstdio>
#include <cmath>

typedef unsigned short bf16_t;
namespace cfg {
constexpr int B = 8, S = 2048, D = 1024, T = B * S, L = 2;
constexpr int INW = 2592, NIN = 3072, FF = 2816, NGU = 2 * FF;
constexpr float ALPHA = 1.41421356237309515f;
constexpr float EPS = 1e-5f;
constexpr float QSCALE = 0.125f * 1.4426950408889634f;
constexpr float GQSCALE = 0.17677669529663687f;
constexpr size_t MiB = 1u << 20;
constexpr size_t WS_CTL = 0;
constexpr size_t WS_VEC = 1 * MiB;
constexpr size_t V_ROPEC = WS_VEC, V_ROPES = WS_VEC + 256 * 1024, V_MF = WS_VEC + 512 * 1024;
constexpr size_t V_C1IN = WS_VEC + 768 * 1024, V_C2IN = V_C1IN + 24 * 1024, V_C1GU = V_C2IN + 24 * 1024, V_C2GU = V_C1GU + 44 * 1024;
constexpr size_t WS_WIN = 2 * MiB, WS_WOUT = 14 * MiB, WS_WGU = 18 * MiB, WS_WDN = 40 * MiB, WS_TAB = 51 * MiB;
constexpr size_t SZ_WIN = 6 * MiB, SZ_WOUT = 2 * MiB, SZ_WGU = 11 * MiB, SZ_WDN = 5632 * 1024;
constexpr size_t WS_XB = 67 * MiB;
constexpr size_t WS_Y1 = 99 * MiB, WS_Q = 99 * MiB, WS_K = 115 * MiB, WS_V = 131 * MiB, WS_XT = 147 * MiB;
constexpr size_t WS_ACT = 163 * MiB, WS_GQK = 163 * MiB, WS_GV = 171 * MiB, WS_GR = 179 * MiB, WS_GL = 187 * MiB, WS_OC = 203 * MiB, WS_OF = 235 * MiB;
constexpr size_t WS_ST1 = 251 * MiB, WS_ST2 = 253 * MiB, WS_DEC = 255 * MiB, WS_END = 256 * MiB;
}
using namespace cfg;

__device__ __forceinline__ float bf2f(bf16_t v) { return __uint_as_float((unsigned)v << 16); }
__device__ __forceinline__ bf16_t f2bf(float f) { unsigned u = __float_as_uint(f); return (bf16_t)((u + 0x7fffu + ((u >> 16) & 1u)) >> 16); }


template <int M> __device__ __forceinline__ float xadd(float v) {
    if constexpr (M == 32) { auto r = __builtin_amdgcn_permlane32_swap(__float_as_uint(v), __float_as_uint(v), false, false); return __uint_as_float(r[0]) + __uint_as_float(r[1]); }
    else return v + __int_as_float(__builtin_amdgcn_ds_swizzle(__float_as_int(v), (M << 10) | 0x1f));
}
struct RowStat { float mu, rstd; };
__device__ __forceinline__ RowStat row_stat(const float* ST, int row) {
    float s = 0.f, ss = 0.f;
    for (int i = 0; i < 8; ++i) { const float4 a = *(const float4*)(ST + (size_t)row * 32 + 4 * i); s += a.x + a.z; ss += a.y + a.w; }
    const float mu = s * (1.f / 1024.f); const float var = ss * (1.f / 1024.f) - mu * mu;
    RowStat r; r.mu = mu; r.rstd = rsqrtf(fmaxf(var, 0.f) + EPS); return r;
}
namespace pg8 {
#define PG8_LAS __attribute__((address_space(3)))
typedef unsigned short bf16_t;
typedef short bf16x8 __attribute__((ext_vector_type(8)));
typedef float f32x4 __attribute__((ext_vector_type(4)));
typedef unsigned u32x4 __attribute__((ext_vector_type(4)));
constexpr int BM = 256, BK = 64, HALF = 128, HTB = HALF * BK * 2  , STAGE_BYTES = 8 * HTB, NXCD = 8, WGM = 8;

__host__ __device__ __forceinline__ int lds_byte(int r, int c) { const int st = (r >> 4) * 2 + (c >> 5), rr = r & 15, cc = c & 31, ob = rr * 64 + cc * 2; return st * 1024 + (ob ^ (((ob >> 9) & 1) << 5)); }
__host__ __device__ __forceinline__ void stage_rc(int b, int& R, int& C) { const int st = b / 1024, sb = b % 1024, swz = sb ^ (((sb >> 9) & 1) << 5); R = (st >> 1) * 16 + swz / 64; C = (st & 1) * 32 + (swz % 64) / 2; }
__host__ __device__ __forceinline__ int perm32(int rho) { const int n = rho >> 4, i = rho & 15; return 8 * (i >> 2) + 4 * n + (i & 3); }

struct Unit { int pm, pn; };
struct Gemm { const bf16_t* A; const bf16_t* Bt; int M, N, K; };

struct StaticOrder {
    int nM, nN, nwg, G, c;
    __host__ __device__ void init(int M, int N, int G_, int c_) { nM = M / BM; nN = N / BM; nwg = nM * nN; G = G_; c = c_; }
    __host__ __device__ bool next(int i, Unit& u) const {
        const long L = (long)i * G + c; if (L >= nwg) return false;
        int wgid = (int)L; { const int q = nwg / NXCD, r = nwg % NXCD, xcd = wgid % NXCD, off = wgid / NXCD; wgid = (xcd < r ? xcd * (q + 1) : r * (q + 1) + (xcd - r) * q) + off; }
        const int nig = WGM * nN, gid = wgid / nig, fm = gid * WGM, gsz = (nM - fm) < WGM ? (nM - fm) : WGM;
        u.pm = fm + ((wgid % nig) % gsz); u.pn = (wgid % nig) / gsz; return true;
    }
    __device__ __forceinline__ void a_ready(const Unit&) const {}
    __device__ __forceinline__ void done(const Unit&) const {}
};
template <class Epi, class Sched, bool ALIGN_EPI = false, bool SP2 = false>
__device__ __forceinline__ void gemm_phase(PG8_LAS unsigned char* lds, const Gemm g, const Sched& S, const Epi& E) {
    int tid_o = threadIdx.x; asm volatile("" : "+v"(tid_o));
    const int tid = tid_o, wid = __builtin_amdgcn_readfirstlane(tid >> 6), lane = tid & 63, wr = wid >> 2, wc = wid & 3, fr = lane & 15, fq = lane >> 4;
    const int K = g.K, nt = K / BK;
    unsigned voffA[2], voffB[2];
#pragma unroll
    for (int i = 0; i < 2; ++i) { int R, C; stage_rc(tid * 16 + i * 8192, R, C); const int Rb = Epi::PERM ? ((R & ~31) + perm32(R & 31)) : R;
        voffA[i] = (unsigned)(R * K + C) * 2u; voffB[i] = (unsigned)(Rb * K + C) * 2u; }
    const size_t kstep = (size_t)(BK * 2);
    const size_t hstep = (size_t)HALF * K * 2;
    const size_t tstep = 2 * hstep;
    const unsigned ldsw = (unsigned)wid * 1024u;
    const int aoff = lds_byte(wr * 64 + fr, fq * 8), boff = lds_byte(wc * 32 + fr, fq * 8);
#define PG8_SA(b, h) (((b) * 2 + (h)) * HTB)
#define PG8_SB(b, h) ((4 + (b) * 2 + (h)) * HTB)
#define PG8_STAGE(bufoff, gbase, voff) do { _Pragma("unroll") for (int _i = 0; _i < 2; ++_i) \
        __builtin_amdgcn_global_load_lds((const unsigned*)((const char*)(gbase) + (voff)[_i]), (PG8_LAS unsigned*)(lds + (bufoff) + ldsw + _i * 8192), 16, 0, 0); } while (0)
#define PG8_LDA(dst, b, h) do { _Pragma("unroll") for (int m = 0; m < 4; ++m) _Pragma("unroll") for (int k = 0; k < 2; ++k) dst[m][k] = *(const PG8_LAS bf16x8*)(lds + PG8_SA(b, h) + aoff + m * 2048 + k * 1024); } while (0)
#define PG8_LDB(dst, b, h) do { _Pragma("unroll") for (int n = 0; n < 2; ++n) _Pragma("unroll") for (int k = 0; k < 2; ++k) dst[n][k] = *(const PG8_LAS bf16x8*)(lds + PG8_SB(b, h) + boff + n * 2048 + k * 1024); } while (0)
#define PG8_MMA(ai, bj, At, Bt) do { __builtin_amdgcn_s_setprio(1); _Pragma("unroll") for (int m = 0; m < 4; ++m) _Pragma("unroll") for (int n = 0; n < 2; ++n) _Pragma("unroll") for (int k = 0; k < 2; ++k) \
        acc[ai][bj][m][n] = __builtin_amdgcn_mfma_f32_16x16x32_bf16(Bt[n][k], At[m][k], acc[ai][bj][m][n], 0, 0, 0); __builtin_amdgcn_s_setprio(0); } while (0)
#define PG8_WAIT_V(n) asm volatile("s_waitcnt vmcnt(" #n ")" ::: "memory")
#define PG8_WAIT_L(n) asm volatile("s_waitcnt lgkmcnt(" #n ")" ::: "memory")
#define PG8_BAR __builtin_amdgcn_s_barrier()
#define PG8_SCHED __builtin_amdgcn_sched_barrier(0)
    Unit cur, nxt; int ui = 0;
    if (!S.next(0, cur)) return;
    f32x4 acc[2][2][4][2];
#pragma unroll
    for (int a = 0; a < 2; ++a)
#pragma unroll
        for (int b = 0; b < 2; ++b)
#pragma unroll
            for (int m = 0; m < 4; ++m)
#pragma unroll
                for (int n = 0; n < 2; ++n) acc[a][b][m][n] = (f32x4){0.f, 0.f, 0.f, 0.f};
    bf16x8 At[4][2], B0[2][2], B1[2][2];
    const char* cA = (const char*)g.A + (size_t)cur.pm * tstep; const char* cB = (const char*)g.Bt + (size_t)cur.pn * tstep;
    S.a_ready(cur);
    if constexpr (SP2) {
        PG8_STAGE(PG8_SB(0, 0), cB, voffB); PG8_STAGE(PG8_SB(0, 1), cB + hstep, voffB); PG8_STAGE(PG8_SA(0, 0), cA, voffA); PG8_STAGE(PG8_SA(0, 1), cA + hstep, voffA);
        if (wr == 1) PG8_BAR;
        PG8_WAIT_V(2); PG8_BAR;
        PG8_STAGE(PG8_SB(1, 0), cB + kstep, voffB); PG8_STAGE(PG8_SA(1, 0), cA + kstep, voffA); PG8_STAGE(PG8_SB(1, 1), cB + hstep + kstep, voffB);
        PG8_WAIT_V(6); PG8_BAR;
    } else {
        PG8_STAGE(PG8_SB(0, 0), cB, voffB); PG8_STAGE(PG8_SA(0, 0), cA, voffA); PG8_STAGE(PG8_SB(0, 1), cB + hstep, voffB); PG8_STAGE(PG8_SA(0, 1), cA + hstep, voffA);
        if (wr == 1) PG8_BAR;
        PG8_WAIT_V(4); PG8_BAR;
        PG8_STAGE(PG8_SB(1, 0), cB + kstep, voffB); PG8_STAGE(PG8_SA(1, 0), cA + kstep, voffA); PG8_STAGE(PG8_SB(1, 1), cB + hstep + kstep, voffB);
        PG8_WAIT_V(6); PG8_BAR;
    }
    for (;;) {
        const bool has_next = S.next(ui + 1, nxt);
        const char* nA = has_next ? (const char*)g.A + (size_t)nxt.pm * tstep : cA; const char* nB = has_next ? (const char*)g.Bt + (size_t)nxt.pn * tstep : cB;
        for (int t = 0; t < nt; t += 2) {
            const bool last = (t == nt - 2);
            const char* a1 = cA + (size_t)(t + 1) * kstep;
            const char* a2 = last ? nA : cA + (size_t)(t + 2) * kstep; const char* b2 = last ? nB : cB + (size_t)(t + 2) * kstep;
            const char* a3 = a2 + kstep; const char* b3 = b2 + kstep;
            if (last && has_next) S.a_ready(nxt);
            if constexpr (SP2) {
            PG8_LDB(B0, 0, 0); PG8_LDB(B1, 0, 1); PG8_SCHED; PG8_LDA(At, 0, 0); PG8_STAGE(PG8_SA(1, 1), a1 + hstep, voffA);
            PG8_WAIT_V(8); PG8_WAIT_L(0); PG8_BAR; PG8_MMA(0, 0, At, B0); PG8_MMA(0, 1, At, B1); PG8_BAR; PG8_SCHED;
            PG8_LDA(At, 0, 1); PG8_STAGE(PG8_SB(0, 0), b2, voffB); PG8_STAGE(PG8_SB(0, 1), b2 + hstep, voffB); PG8_STAGE(PG8_SA(0, 0), a2, voffA);
            PG8_WAIT_V(8); PG8_WAIT_L(0); PG8_BAR; PG8_MMA(1, 0, At, B0); PG8_MMA(1, 1, At, B1); PG8_BAR; PG8_SCHED;
            PG8_LDB(B0, 1, 0); PG8_LDB(B1, 1, 1); PG8_SCHED; PG8_LDA(At, 1, 0); PG8_STAGE(PG8_SA(0, 1), a2 + hstep, voffA);
            PG8_WAIT_V(8); PG8_WAIT_L(0); PG8_BAR; PG8_MMA(0, 0, At, B0); PG8_MMA(0, 1, At, B1); PG8_BAR; PG8_SCHED;
            PG8_LDA(At, 1, 1); PG8_STAGE(PG8_SB(1, 0), b3, voffB); PG8_STAGE(PG8_SB(1, 1), b3 + hstep, voffB); PG8_STAGE(PG8_SA(1, 0), a3, voffA);
            PG8_WAIT_V(8); PG8_WAIT_L(0); PG8_BAR; PG8_MMA(1, 0, At, B0); PG8_MMA(1, 1, At, B1); PG8_BAR; PG8_SCHED;
            } else {
            PG8_LDB(B0, 0, 0); PG8_SCHED; PG8_LDA(At, 0, 0); PG8_STAGE(PG8_SA(1, 1), a1 + hstep, voffA);
            PG8_WAIT_L(8); PG8_BAR; PG8_WAIT_L(0); PG8_MMA(0, 0, At, B0); PG8_BAR; PG8_SCHED;
            PG8_LDB(B1, 0, 1); PG8_STAGE(PG8_SB(0, 0), b2, voffB);
            PG8_BAR; PG8_WAIT_L(0); PG8_MMA(0, 1, At, B1); PG8_BAR;
            PG8_LDA(At, 0, 1); PG8_STAGE(PG8_SA(0, 0), a2, voffA);
            PG8_BAR; PG8_WAIT_L(0); PG8_MMA(1, 0, At, B0); PG8_BAR; PG8_SCHED;
            PG8_STAGE(PG8_SB(0, 1), b2 + hstep, voffB);
            PG8_WAIT_V(6); PG8_BAR; PG8_MMA(1, 1, At, B1); PG8_BAR;
            PG8_LDB(B0, 1, 0); PG8_SCHED; PG8_LDA(At, 1, 0); PG8_STAGE(PG8_SA(0, 1), a2 + hstep, voffA);
            PG8_WAIT_L(8); PG8_BAR; PG8_WAIT_L(0); PG8_MMA(0, 0, At, B0); PG8_BAR; PG8_SCHED;
            PG8_LDB(B1, 1, 1); PG8_STAGE(PG8_SB(1, 0), b3, voffB);
            PG8_BAR; PG8_WAIT_L(0); PG8_MMA(0, 1, At, B1); PG8_BAR;
            PG8_LDA(At, 1, 1); PG8_STAGE(PG8_SA(1, 0), a3, voffA);
            PG8_BAR; PG8_WAIT_L(0); PG8_MMA(1, 0, At, B0); PG8_BAR; PG8_SCHED;
            PG8_STAGE(PG8_SB(1, 1), b3 + hstep, voffB);
            PG8_WAIT_V(6); PG8_BAR; PG8_MMA(1, 1, At, B1); PG8_BAR;
            }
        }
        if constexpr (ALIGN_EPI) { if (wr == 0) PG8_BAR; }
        if constexpr (!Epi::AFTER_DRAIN) { E(acc, cur, wr, wc, fr, fq); S.done(cur); }
        if (!has_next) break;
#pragma unroll
        for (int a = 0; a < 2; ++a)
#pragma unroll
            for (int b = 0; b < 2; ++b)
#pragma unroll
                for (int m = 0; m < 4; ++m)
#pragma unroll
                    for (int n = 0; n < 2; ++n) acc[a][b][m][n] = (f32x4){0.f, 0.f, 0.f, 0.f};
        cur = nxt; cA = nA; cB = nB; ++ui;
        if constexpr (ALIGN_EPI) { if (wr == 1) PG8_BAR; }
    }
    PG8_WAIT_V(0);
    if constexpr (!ALIGN_EPI) { if (wr == 0) PG8_BAR; }
    PG8_BAR;
    if constexpr (Epi::AFTER_DRAIN) { E.fused(acc, cur, wr, wc, fr, fq, lds, wid, lane); S.done(cur); }
#undef PG8_SA
#undef PG8_SB
#undef PG8_STAGE
#undef PG8_LDA
#undef PG8_LDB
#undef PG8_MMA
#undef PG8_WAIT_V
#undef PG8_WAIT_L
#undef PG8_BAR
#undef PG8_SCHED
}
}
namespace pg8 {
__device__ __forceinline__ unsigned cvt_pk_bf16(float lo, float hi) { unsigned r; asm volatile("v_cvt_pk_bf16_f32 %0, %1, %2" : "=v"(r) : "v"(lo), "v"(hi)); return r; }
__device__ __forceinline__ void st8(bf16_t* p, const f32x4 a, const f32x4 b) { u32x4 w; w.x = cvt_pk_bf16(a[0], a[1]); w.y = cvt_pk_bf16(a[2], a[3]); w.z = cvt_pk_bf16(b[0], b[1]); w.w = cvt_pk_bf16(b[2], b[3]); *(u32x4*)p = w; }
__device__ __forceinline__ void st8nt(bf16_t* p, const f32x4 a, const f32x4 b) { u32x4 w; w.x = cvt_pk_bf16(a[0], a[1]); w.y = cvt_pk_bf16(a[2], a[3]); w.z = cvt_pk_bf16(b[0], b[1]); w.w = cvt_pk_bf16(b[2], b[3]); __builtin_nontemporal_store(w, (u32x4*)p); }
struct RS { float a, b; };
struct StatLd { f32x4 x, y; };
__device__ __forceinline__ StatLd stat_load(const float* ST, int row, int fq) { const f32x4* p = (const f32x4*)(ST + (size_t)row * 32 + fq * 8); StatLd r; r.x = p[0]; r.y = p[1]; return r; }
__device__ __forceinline__ RS stat_fin(const StatLd& t) {
    float s = (t.x[0] + t.x[2]) + (t.y[0] + t.y[2]), ss = (t.x[1] + t.x[3]) + (t.y[1] + t.y[3]);
    s = xadd<16>(s); ss = xadd<16>(ss); s = xadd<32>(s); ss = xadd<32>(ss);
    const float mu = s * (1.f / 1024.f), var = ss * (1.f / 1024.f) - mu * mu, rstd = rsqrtf(fmaxf(var, 0.f) + cfg::EPS);
    RS r; r.a = rstd; r.b = -rstd * mu; return r;
}
__device__ __forceinline__ RS row_stat16(const float* ST, int row, int fq) { return stat_fin(stat_load(ST, row, fq)); }
__device__ __forceinline__ float fsilu(float x) { return x * __builtin_amdgcn_rcpf(1.f + __expf(-x)); }
__device__ __forceinline__ float flogsig16(float x) { return (fminf(x, 0.f) - __logf(1.f + __expf(-fabsf(x)))) * (1.f / 16.f); }

struct FEpiIn {
    static constexpr bool PERM = true, AFTER_DRAIN = false;
    unsigned char* ws; const float* b2; int l;
    struct RowLd { StatLd t; f32x4 rc[2], rsn[2]; };
    template <int KIND> __device__ __forceinline__ RowLd load_row(const float* st, int row, int fq) const {
        RowLd r; if constexpr (KIND != 0) { if (st) r.t = stat_load(st, row, fq); }
        if constexpr (KIND == 0) { const int pos = row & 2047; const float* cp = (const float*)(ws + cfg::V_ROPEC) + pos * 32 + 8 * fq; const float* sp = (const float*)(ws + cfg::V_ROPES) + pos * 32 + 8 * fq;
            r.rc[0] = *(const f32x4*)cp; r.rc[1] = *(const f32x4*)(cp + 4); r.rsn[0] = *(const f32x4*)sp; r.rsn[1] = *(const f32x4*)(sp + 4); }
        return r;
    }
    template <int KIND> __device__ __forceinline__ void rows(const f32x4 (&acc)[2][2][4][2], const Unit& u, int wr, int wc, int fr, int fq) const {
        const int pn = u.pn, cw = 32 * wc + 8 * fq, row0 = u.pm * BM + 64 * wr + fr;
        const float* st = l ? (const float*)(ws + cfg::WS_ST2) : (const float*)nullptr;
        f32x4 k1[2][2], k2[2][2], bias[2][2];
        const float qs = __uint_as_float(__builtin_amdgcn_readfirstlane(__float_as_uint(pn < 2 ? cfg::QSCALE : 1.f)));
        RS rsa[8];
        if constexpr (KIND == 0) { if (st) { StatLd t[8];
#pragma unroll
            for (int i = 0; i < 8; ++i) t[i] = stat_load(st, row0 + 128 * (i >> 2) + 16 * (i & 3), fq);
#pragma unroll
            for (int i = 0; i < 8; ++i) rsa[i] = stat_fin(t[i]); } }
        RowLd cur = load_row<KIND>(st, row0, fq), nxt;
        if (st) {
#pragma unroll
            for (int bj = 0; bj < 2; ++bj)
#pragma unroll
                for (int n = 0; n < 2; ++n) {
                    if constexpr (KIND == 2) {
                        const float* fp = (const float*)(ws + cfg::V_MF) + (size_t)(l * 8) * 512 + (pn - 6) * 256 + cw + 128 * bj + 4 * n;
                        k1[bj][n] = (*(const f32x4*)fp + *(const f32x4*)(fp + 1024)) + (*(const f32x4*)(fp + 2048) + *(const f32x4*)(fp + 3072));
                        k2[bj][n] = (*(const f32x4*)(fp + 512) + *(const f32x4*)(fp + 1536)) + (*(const f32x4*)(fp + 2560) + *(const f32x4*)(fp + 3584));
                    } else { const float* c1 = (const float*)(ws + cfg::V_C1IN) + l * cfg::NIN + pn * 256 + cw; const float* c2 = (const float*)(ws + cfg::V_C2IN) + l * cfg::NIN + pn * 256 + cw;
                        k1[bj][n] = *(const f32x4*)(c1 + 128 * bj + 4 * n); k2[bj][n] = *(const f32x4*)(c2 + 128 * bj + 4 * n); } } }
        if constexpr (KIND == 6) {
#pragma unroll
            for (int bj = 0; bj < 2; ++bj)
#pragma unroll
                for (int n = 0; n < 2; ++n) bias[bj][n] = *(const f32x4*)(b2 + 128 * bj + cw + 4 * n); }
#pragma unroll
        for (int i = 0; i < 8; ++i) {
            const int ai = i >> 2, m = i & 3, row = row0 + 128 * ai + 16 * m, pos = row & 2047;
            if (i < 7) nxt = load_row<KIND>(st, row0 + 128 * ((i + 1) >> 2) + 16 * ((i + 1) & 3), fq);
            f32x4 v[2][2];
            if (st) { RS rs; if constexpr (KIND == 0) rs = rsa[i]; else rs = stat_fin(cur.t);
#pragma unroll
                for (int bj = 0; bj < 2; ++bj)
#pragma unroll
                    for (int n = 0; n < 2; ++n) v[bj][n] = rs.a * acc[ai][bj][m][n] + (rs.b * k1[bj][n] + k2[bj][n]);
            } else {
#pragma unroll
                for (int bj = 0; bj < 2; ++bj)
#pragma unroll
                    for (int n = 0; n < 2; ++n) v[bj][n] = acc[ai][bj][m][n]; }
            if constexpr (KIND == 0) {
                f32x4 a0 = v[0][0] * cur.rc[0] - v[1][0] * cur.rsn[0], a1 = v[0][1] * cur.rc[1] - v[1][1] * cur.rsn[1];
                f32x4 b0 = v[1][0] * cur.rc[0] + v[0][0] * cur.rsn[0], b1 = v[1][1] * cur.rc[1] + v[0][1] * cur.rsn[1];
                a0 = a0 * qs; a1 = a1 * qs; b0 = b0 * qs; b1 = b1 * qs;
                bf16_t* dst = (bf16_t*)(ws + (pn < 2 ? cfg::WS_Q : cfg::WS_K)) + (size_t)row * 512 + (4 * (pn & 1) + wc) * 64 + 8 * fq;
                st8(dst, a0, a1); st8(dst + 32, b0, b1);
            } else if constexpr (KIND == 1) {
                bf16_t* dst = (bf16_t*)(ws + cfg::WS_V) + (size_t)row * 512 + (pn - 4) * 256 + cw; st8(dst, v[0][0], v[0][1]); st8(dst + 128, v[1][0], v[1][1]);
            } else if constexpr (KIND == 2) {
                bf16_t* dst = (bf16_t*)(ws + cfg::WS_TAB) + (size_t)row * 512 + (pn - 6) * 256 + cw; st8(dst, v[0][0], v[0][1]); st8(dst + 128, v[1][0], v[1][1]);
            } else if constexpr (KIND == 3) {
                bf16_t* dst = (bf16_t*)(ws + cfg::WS_GQK) + (size_t)row * 256 + cw; st8(dst, v[0][0] * cfg::GQSCALE, v[0][1] * cfg::GQSCALE); st8(dst + 128, v[1][0], v[1][1]);
            } else if constexpr (KIND == 4) {
                bf16_t* dst = (bf16_t*)(ws + cfg::WS_GV) + (size_t)row * 256 + cw; st8(dst, v[0][0], v[0][1]); st8(dst + 128, v[1][0], v[1][1]);
            } else if constexpr (KIND == 5) {
                bf16_t* dst = (bf16_t*)(ws + cfg::WS_GR) + (size_t)row * 256 + cw;
#pragma unroll
                for (int bj = 0; bj < 2; ++bj) { f32x4 x0 = v[bj][0], x1 = v[bj][1];
#pragma unroll
                    for (int e = 0; e < 4; ++e) { x0[e] = fsilu(x0[e]); x1[e] = fsilu(x1[e]); } st8(dst + 128 * bj, x0, x1); }
            } else {
                float* dst = (float*)(ws + cfg::WS_GL) + (size_t)row * 256 + cw;
#pragma unroll
                for (int bj = 0; bj < 2; ++bj)
#pragma unroll
                    for (int n = 0; n < 2; ++n) { f32x4 x = v[bj][n] + bias[bj][n];
#pragma unroll
                        for (int e = 0; e < 4; ++e) x[e] = flogsig16(x[e]); *(f32x4*)(dst + 128 * bj + 4 * n) = x; }
            }
            if (i < 7) cur = nxt;
        }
    }
    __device__ __forceinline__ void operator()(const f32x4 (&acc)[2][2][4][2], const Unit& u, int wr, int wc, int fr, int fq) const {
        asm volatile("" : "+v"(fr), "+v"(fq));
        unsigned zo = 0u; asm volatile("" : "+s"(zo)); FEpiIn me = *this; me.ws = ws + zo;
        const int pn = u.pn;
        if (pn < 4) me.rows<0>(acc, u, wr, wc, fr, fq); else if (pn < 6) me.rows<1>(acc, u, wr, wc, fr, fq); else if (pn < 8) me.rows<2>(acc, u, wr, wc, fr, fq);
        else if (pn == 8) me.rows<3>(acc, u, wr, wc, fr, fq); else if (pn == 9) me.rows<4>(acc, u, wr, wc, fr, fq); else if (pn == 10) me.rows<5>(acc, u, wr, wc, fr, fq); else me.rows<6>(acc, u, wr, wc, fr, fq);
    }
};
struct FEpiRes {
    static constexpr bool PERM = true, AFTER_DRAIN = false;
    const float* stprev; const float* g; const float* bb; bf16_t* XB; float* ST;
    struct RowLd { u32x4 xb[2]; StatLd t; };
    __device__ __forceinline__ RowLd load_row(int row, int col0, int fq) const {
        RowLd r; const size_t off = (size_t)row * 1024 + col0;
        r.xb[0] = *(const u32x4*)(XB + off); r.xb[1] = *(const u32x4*)(XB + off + 128); if (stprev) r.t = stat_load(stprev, row, fq);
        return r;
    }
    __device__ __forceinline__ void operator()(const f32x4 (&acc)[2][2][4][2], const Unit& u, int wr, int wc, int fr, int fq) const {
        asm volatile("" : "+v"(fr), "+v"(fq));
        const int col0 = u.pn * BM + 32 * wc + 8 * fq, row0 = u.pm * BM + 64 * wr + fr;
        f32x4 gv[2][2], bv[2][2];
        RowLd cur = load_row(row0, col0, fq), nxt;
        if (stprev) {
#pragma unroll
            for (int bj = 0; bj < 2; ++bj)
#pragma unroll
                for (int n = 0; n < 2; ++n) { gv[bj][n] = *(const f32x4*)(g + col0 + 128 * bj + 4 * n); bv[bj][n] = *(const f32x4*)(bb + col0 + 128 * bj + 4 * n); } }
#pragma unroll
        for (int i = 0; i < 8; ++i) { const int ai = i >> 2, m = i & 3, row = row0 + 128 * ai + 16 * m; const size_t off = (size_t)row * 1024 + col0;
            if (i < 7) nxt = load_row(row0 + 128 * ((i + 1) >> 2) + 16 * ((i + 1) & 3), col0, fq);
            RS rs; rs.a = 1.f; rs.b = 0.f; if (stprev) rs = stat_fin(cur.t);
            float s = 0.f, ss = 0.f;
#pragma unroll
            for (int bj = 0; bj < 2; ++bj) { f32x4 y[2];
#pragma unroll
                for (int n = 0; n < 2; ++n) { const unsigned w0 = cur.xb[bj][2 * n], w1 = cur.xb[bj][2 * n + 1];
                    f32x4 x = (f32x4){__uint_as_float(w0 << 16), __uint_as_float(w0 & 0xffff0000u), __uint_as_float(w1 << 16), __uint_as_float(w1 & 0xffff0000u)};
                    if (stprev) x = (rs.a * x + rs.b) * gv[bj][n] + bv[bj][n];
                    y[n] = cfg::ALPHA * x + acc[ai][bj][m][n];
                    s += (y[n][0] + y[n][1]) + (y[n][2] + y[n][3]); ss += (y[n][0] * y[n][0] + y[n][1] * y[n][1]) + (y[n][2] * y[n][2] + y[n][3] * y[n][3]); }
                st8(XB + off + 128 * bj, y[0], y[1]); }
            s = xadd<16>(s); ss = xadd<16>(ss); s = xadd<32>(s); ss = xadd<32>(ss);
            if (fq == 0) { typedef float f32x2 __attribute__((ext_vector_type(2))); *(f32x2*)(ST + (size_t)row * 32 + (u.pn * 4 + wc) * 2) = (f32x2){s, ss}; }
            if (i < 7) cur = nxt; }
    }
};
struct FEpiGU {
    static constexpr bool PERM = true, AFTER_DRAIN = false;
    const float* st; const float* c1; const float* c2; bf16_t* ACT;
    __device__ __forceinline__ void operator()(const f32x4 (&acc)[2][2][4][2], const Unit& u, int wr, int wc, int fr, int fq) const {
        asm volatile("" : "+v"(fr), "+v"(fq));
        const int cw = 32 * wc + 8 * fq, row0 = u.pm * BM + 64 * wr + fr; const float* c1p = c1 + u.pn * 256 + cw; const float* c2p = c2 + u.pn * 256 + cw;
        f32x4 k1[2][2], k2[2][2];
#pragma unroll
        for (int hb = 0; hb < 2; ++hb) {
            asm volatile("" ::: "memory");
            StatLd t[4]; RS rs[4];
#pragma unroll
            for (int i = 0; i < 4; ++i) t[i] = stat_load(st, row0 + 128 * hb + 16 * i, fq);
            if (hb == 0) {
#pragma unroll
                for (int bj = 0; bj < 2; ++bj)
#pragma unroll
                    for (int n = 0; n < 2; ++n) { k1[bj][n] = *(const f32x4*)(c1p + 128 * bj + 4 * n); k2[bj][n] = *(const f32x4*)(c2p + 128 * bj + 4 * n); } }
#pragma unroll
            for (int i = 0; i < 4; ++i) rs[i] = stat_fin(t[i]);
#pragma unroll
            for (int m = 0; m < 4; ++m) { const int ai = hb; f32x4 a[2];
#pragma unroll
                for (int n = 0; n < 2; ++n) { const f32x4 hg = rs[m].a * acc[ai][0][m][n] + (rs[m].b * k1[0][n] + k2[0][n]), hu = rs[m].a * acc[ai][1][m][n] + (rs[m].b * k1[1][n] + k2[1][n]);
#pragma unroll
                    for (int e = 0; e < 4; ++e) a[n][e] = fsilu(hg[e]) * hu[e]; }
                st8nt(ACT + (size_t)(row0 + 128 * ai + 16 * m) * cfg::FF + 128 * u.pn + cw, a[0], a[1]); } }
    }
};
struct FEpiFour {
    static constexpr bool PERM = true, AFTER_DRAIN = false;
    bf16_t* OC;
    __device__ __forceinline__ void operator()(const f32x4 (&acc)[2][2][4][2], const Unit& u, int wr, int wc, int fr, int fq) const {
        asm volatile("" : "+v"(fr), "+v"(fq));
        const int cw = 32 * wc + 8 * fq;
#pragma unroll
        for (int ai = 0; ai < 2; ++ai)
#pragma unroll
            for (int m = 0; m < 4; ++m) { const int row = u.pm * BM + 128 * ai + 64 * wr + 16 * m + fr; bf16_t* dst = OC + (size_t)(u.pn * 2048 + row) * 1024 + 512 + cw;
                st8(dst, acc[ai][0][m][0], acc[ai][0][m][1]); st8(dst + 128, acc[ai][1][m][0], acc[ai][1][m][1]); }
    }
};
}
namespace att {
using bf16x8 = __attribute__((ext_vector_type(8))) short;
using s16x4  = __attribute__((ext_vector_type(4))) short;
using f32x16 = __attribute__((ext_vector_type(16))) float;
using u32x4  = __attribute__((ext_vector_type(4))) unsigned;
constexpr int NW = 8, QBLK = 32, KVBLK = 64, LD = 512, NT = cfg::S / KVBLK;
constexpr int SHM_V = KVBLK * 128 * 2, SHM_K = KVBLK * 128 * 2, SHM_X = 2 * SHM_V + 2 * SHM_K, SHM_ATTN = SHM_X + NW * 64 * 4;
constexpr float THRL = 6.0f;
#define ATT_KSWZ(row, colB) ((row) * 256 + ((colB) ^ (((row) & 7) << 4)))
#define ATT_SBAR() __builtin_amdgcn_sched_barrier(0)
__device__ __forceinline__ int crow(int r, int hi) { return (r & 3) + 8 * (r >> 2) + 4 * hi; }
__device__ __forceinline__ unsigned cvtpk(float lo, float hi) { unsigned r; asm volatile("v_cvt_pk_bf16_f32 %0, %1, %2" : "=v"(r) : "v"(lo), "v"(hi)); return r; }
__device__ __forceinline__ void partialSM(f32x16& p0, f32x16& p1, float& m_reg, float& alpha) {
  float pmax = p0[0];
#pragma unroll
  for (int r = 1; r < 16; ++r) pmax = fmaxf(pmax, p0[r]);
#pragma unroll
  for (int r = 0; r < 16; ++r) pmax = fmaxf(pmax, p1[r]);
  { auto rr = __builtin_amdgcn_permlane32_swap(__float_as_uint(pmax), __float_as_uint(pmax), false, false); pmax = fmaxf(__uint_as_float(rr[0]), __uint_as_float(rr[1])); }
  float mn;
  if (__builtin_expect(__all(pmax - m_reg <= THRL), 1)) { mn = m_reg; alpha = 1.f; }
  else { mn = fmaxf(m_reg, pmax); alpha = __builtin_amdgcn_exp2f(m_reg - mn); m_reg = mn; }
#pragma unroll
  for (int r = 0; r < 16; ++r) p0[r] = p0[r] - mn;
#pragma unroll
  for (int r = 0; r < 16; ++r) p1[r] = p1[r] - mn;
#pragma unroll
  for (int r = 0; r < 16; ++r) p0[r] = __builtin_amdgcn_exp2f(p0[r]);
}
__device__ __forceinline__ void finishSM(f32x16& p0, f32x16& p1, float alpha, float& l_reg, bf16x8& pa0, bf16x8& pa1, bf16x8& pa2, bf16x8& pa3) {
#pragma unroll
  for (int r = 0; r < 16; ++r) p1[r] = __builtin_amdgcn_exp2f(p1[r]);
  float ps = 0;
#pragma unroll
  for (int r = 0; r < 16; ++r) ps += p0[r];
#pragma unroll
  for (int r = 0; r < 16; ++r) ps += p1[r];
  { auto rr = __builtin_amdgcn_permlane32_swap(__float_as_uint(ps), __float_as_uint(ps), false, false); ps = __uint_as_float(rr[0]) + __uint_as_float(rr[1]); }
  l_reg = l_reg * alpha + ps;
#define ATT_PK4(P, BASE, OUT) do { unsigned a0 = cvtpk(P[BASE + 0], P[BASE + 1]), a1 = cvtpk(P[BASE + 2], P[BASE + 3]);   \
    unsigned b0 = cvtpk(P[BASE + 4], P[BASE + 5]), b1 = cvtpk(P[BASE + 6], P[BASE + 7]);                              \
    auto r0 = __builtin_amdgcn_permlane32_swap(a0, b0, false, false); auto r1 = __builtin_amdgcn_permlane32_swap(a1, b1, false, false); \
    u32x4 w = {r0[0], r1[0], r0[1], r1[1]}; OUT = *reinterpret_cast<bf16x8*>(&w); } while (0)
  ATT_PK4(p0, 0, pa0); ATT_PK4(p0, 8, pa1); ATT_PK4(p1, 0, pa2); ATT_PK4(p1, 8, pa3);
#undef ATT_PK4
}
__device__ __forceinline__ void qkt(f32x16& p0, f32x16& p1, const char* Ks, const bf16x8* qr, int r32, int hi, int mofs) {
  p0 = f32x16{}; p1 = f32x16{};
#pragma unroll
  for (int d0 = 0; d0 < 4; ++d0) { const int cb = (mofs + d0 * 16 + hi * 8) * 2;
    const bf16x8 b0 = *reinterpret_cast<const bf16x8*>(Ks + ATT_KSWZ(r32, cb));
    const bf16x8 b1 = *reinterpret_cast<const bf16x8*>(Ks + ATT_KSWZ(32 + r32, cb));
    p0 = __builtin_amdgcn_mfma_f32_32x32x16_bf16(b0, qr[d0], p0, 0, 0, 0);
    p1 = __builtin_amdgcn_mfma_f32_32x32x16_bf16(b1, qr[d0], p1, 0, 0, 0); }
}
__device__ __forceinline__ int v_st(int k, int c) { const int kk = (k & ~0xC) | ((k & 4) << 1) | ((k & 8) >> 1); return ((kk >> 3) * 4 + (c >> 5)) * 512 + ((kk & 7) * 32 + (c & 31)) * 2; }
__device__ __forceinline__ int v_rd_base(int lane) { return ((lane & 3) << 3) | (((lane >> 2) & 3) << 6) | (((lane >> 4) & 1) << 5) | (((lane >> 5) & 1) << 8); }
constexpr int v_rd_off(int d0, int ks, int half) { return d0 * 512 + ks * 4096 + half * 2048; }
template <int OFF> __device__ __forceinline__ s16x4 tr_read(int vb) { s16x4 r; asm volatile("ds_read_b64_tr_b16 %0, %1 offset:%2" : "=&v"(r) : "v"(vb), "i"(OFF) : "memory"); return r; }
template <int D0> __device__ __forceinline__ void pv_one(f32x16& od, int vb, bf16x8 pa0, bf16x8 pa1, bf16x8 pa2, bf16x8 pa3) {
  const s16x4 l0 = tr_read<v_rd_off(D0, 0, 0)>(vb), h0 = tr_read<v_rd_off(D0, 0, 1)>(vb), l1 = tr_read<v_rd_off(D0, 1, 0)>(vb), h1 = tr_read<v_rd_off(D0, 1, 1)>(vb);
  const s16x4 l2 = tr_read<v_rd_off(D0, 2, 0)>(vb), h2 = tr_read<v_rd_off(D0, 2, 1)>(vb), l3 = tr_read<v_rd_off(D0, 3, 0)>(vb), h3 = tr_read<v_rd_off(D0, 3, 1)>(vb);
  asm volatile("s_waitcnt lgkmcnt(0)" ::: "memory"); ATT_SBAR();
#define ATT_PK(L, H) (bf16x8){L[0], L[1], L[2], L[3], H[0], H[1], H[2], H[3]}
  od = __builtin_amdgcn_mfma_f32_32x32x16_bf16(pa0, ATT_PK(l0, h0), od, 0, 0, 0);
  od = __builtin_amdgcn_mfma_f32_32x32x16_bf16(pa1, ATT_PK(l1, h1), od, 0, 0, 0);
  od = __builtin_amdgcn_mfma_f32_32x32x16_bf16(pa2, ATT_PK(l2, h2), od, 0, 0, 0);
  od = __builtin_amdgcn_mfma_f32_32x32x16_bf16(pa3, ATT_PK(l3, h3), od, 0, 0, 0);
#undef ATT_PK
}
__device__ __forceinline__ void pv_d0(f32x16* o, int vb, bf16x8 pa0, bf16x8 pa1, bf16x8 pa2, bf16x8 pa3) {
  pv_one<0>(o[0], vb, pa0, pa1, pa2, pa3); pv_one<1>(o[1], vb, pa0, pa1, pa2, pa3); pv_one<2>(o[2], vb, pa0, pa1, pa2, pa3); pv_one<3>(o[3], vb, pa0, pa1, pa2, pa3);
}

__device__ __forceinline__ void attn_unit(int b, int h, int qb, const bf16_t* __restrict__ Qg, const bf16_t* __restrict__ Kg, const bf16_t* __restrict__ Vg, bf16_t* __restrict__ OC,
                                          const float* __restrict__ lamp, const float* __restrict__ dgv, int layer, char* lds) {
  int tid_o = threadIdx.x; asm volatile("" : "+v"(tid_o));
  const int tid = tid_o, wid = __builtin_amdgcn_readfirstlane(tid >> 6), lane = tid & 63, r32 = lane & 31, hi = lane >> 5, mp = wid >> 2, wl = wid & 3, mofs = mp * 64;
  char* V_lds = lds; char* K_lds = lds + 2 * SHM_V;
  float* ws = (float*)(lds + SHM_X) + wid * 64; float* li_l = ws; float* al_l = ws + 32;
  float m_reg = -1e30f, l_reg = 0; f32x16 o[4] = {}; bf16x8 qr[4];
  const int q0 = qb * 128 + wl * QBLK;
  const bf16_t* Qw = Qg + (size_t)(b * cfg::S + q0 + r32) * LD + h * 128 + mofs + hi * 8;
#pragma unroll
  for (int d0 = 0; d0 < 4; ++d0) qr[d0] = *reinterpret_cast<const bf16x8*>(Qw + d0 * 16);
  const bf16_t* Kh = Kg + (size_t)b * cfg::S * LD + h * 128; const bf16_t* Vh = Vg + (size_t)b * cfg::S * LD + h * 128;
  const int sr = tid >> 4, sc = (tid & 15) * 8, vst0 = v_st(sr, sc), vst1 = v_st(32 + sr, sc);
  const int vb0 = (int)(uintptr_t)V_lds + v_rd_base(lane);
  struct { bf16x8 vs0, vs1, ks0, ks1; } sr_[2];
#define ATT_SLOAD(i, k0) do { sr_[i].vs0 = *reinterpret_cast<const bf16x8*>(&Vh[(size_t)((k0) + sr) * LD + sc]); sr_[i].vs1 = *reinterpret_cast<const bf16x8*>(&Vh[(size_t)((k0) + 32 + sr) * LD + sc]); \
    sr_[i].ks0 = *reinterpret_cast<const bf16x8*>(&Kh[(size_t)((k0) + sr) * LD + sc]); sr_[i].ks1 = *reinterpret_cast<const bf16x8*>(&Kh[(size_t)((k0) + 32 + sr) * LD + sc]); } while (0)
#define ATT_SWRITE(bf, i) do { *(bf16x8*)(V_lds + (bf) * SHM_V + vst0) = sr_[i].vs0; *(bf16x8*)(V_lds + (bf) * SHM_V + vst1) = sr_[i].vs1; const int kc = sc * 2; \
    *(bf16x8*)(K_lds + (bf) * SHM_K + ATT_KSWZ(sr, kc)) = sr_[i].ks0; *(bf16x8*)(K_lds + (bf) * SHM_K + ATT_KSWZ(32 + sr, kc)) = sr_[i].ks1; } while (0)
#define ATT_SWAIT() asm volatile("s_waitcnt vmcnt(4)" ::: "memory")
#define ATT_RESC(a) do { if (__any((a) < 1.f)) { if (hi == 0) al_l[r32] = (a); asm volatile("s_waitcnt lgkmcnt(0)" ::: "memory"); \
    _Pragma("unroll") for (int d = 0; d < 4; ++d) _Pragma("unroll") for (int r = 0; r < 16; ++r) o[d][r] *= al_l[crow(r, hi)]; } } while (0)
  f32x16 pA0, pA1, pB0, pB1; float alA, alB; bf16x8 pa0, pa1, pa2, pa3;
  ATT_SLOAD(0, 0); asm volatile("s_waitcnt vmcnt(0)" ::: "memory"); ATT_SWRITE(0, 0); __syncthreads();
  qkt(pA0, pA1, K_lds, qr, r32, hi, mofs); partialSM(pA0, pA1, m_reg, alA);
  ATT_SLOAD(1, KVBLK); ATT_SLOAD(0, 2 * KVBLK);
  ATT_SWAIT(); ATT_SWRITE(1, 1); __syncthreads();
  for (int j = 1; j + 1 < NT; j += 2) {
    ATT_SBAR(); qkt(pB0, pB1, K_lds + SHM_K, qr, r32, hi, mofs);
    finishSM(pA0, pA1, alA, l_reg, pa0, pa1, pa2, pa3); ATT_SBAR();
    ATT_SLOAD(1, (j + 2) * KVBLK); ATT_SBAR();
    pv_d0(o, vb0, pa0, pa1, pa2, pa3); partialSM(pB0, pB1, m_reg, alB);
    __syncthreads(); ATT_SWAIT(); ATT_SWRITE(0, 0);
    ATT_RESC(alB); __syncthreads();
    ATT_SBAR(); qkt(pA0, pA1, K_lds, qr, r32, hi, mofs);
    finishSM(pB0, pB1, alB, l_reg, pa0, pa1, pa2, pa3); ATT_SBAR();
    if (j + 3 < NT) ATT_SLOAD(0, (j + 3) * KVBLK); ATT_SBAR();
    pv_d0(o, vb0 + SHM_V, pa0, pa1, pa2, pa3); partialSM(pA0, pA1, m_reg, alA);
    __syncthreads(); ATT_SWAIT(); ATT_SWRITE(1, 1);
    ATT_RESC(alA); __syncthreads();
  }
  ATT_SBAR(); qkt(pB0, pB1, K_lds + SHM_K, qr, r32, hi, mofs);
  finishSM(pA0, pA1, alA, l_reg, pa0, pa1, pa2, pa3); ATT_SBAR();
  pv_d0(o, vb0, pa0, pa1, pa2, pa3); partialSM(pB0, pB1, m_reg, alB);
  __syncthreads(); ATT_RESC(alB);
  finishSM(pB0, pB1, alB, l_reg, pa0, pa1, pa2, pa3); ATT_SBAR();
  pv_d0(o, vb0 + SHM_V, pa0, pa1, pa2, pa3);
  if (hi == 0) li_l[r32] = l_reg; asm volatile("s_waitcnt lgkmcnt(0)" ::: "memory");
  float rli[16];
#pragma unroll
  for (int r = 0; r < 16; ++r) rli[r] = __builtin_amdgcn_rcpf(li_l[crow(r, hi)]);
#pragma unroll
  for (int d0 = 0; d0 < 4; ++d0)
#pragma unroll
    for (int r = 0; r < 16; ++r) o[d0][r] *= rli[r];
  __syncthreads();
  float* X = (float*)lds;
  if (mp == 1) {
#pragma unroll
    for (int r = 0; r < 16; ++r)
#pragma unroll
      for (int d0 = 0; d0 < 4; ++d0) X[(wl * 32 + crow(r, hi)) * 128 + d0 * 32 + r32] = o[d0][r];
  }
  __syncthreads();
  if (mp == 0) {
    int layer_o = __builtin_amdgcn_readfirstlane(layer); asm volatile("" : "+s"(layer_o)); const float lam_init = layer_o == 0 ? 0.2f : 0.35550906759f;
    float lam; { float s1 = lamp[lane] * lamp[64 + lane], s2 = lamp[128 + lane] * lamp[192 + lane];
      s1 = xadd<1>(s1); s2 = xadd<1>(s2); s1 = xadd<2>(s1); s2 = xadd<2>(s2); s1 = xadd<4>(s1); s2 = xadd<4>(s2); s1 = xadd<8>(s1); s2 = xadd<8>(s2); s1 = xadd<16>(s1); s2 = xadd<16>(s2); s1 = xadd<32>(s1); s2 = xadd<32>(s2);
      lam = __expf(s1) - __expf(s2) + lam_init; }
    float gq[4];
#pragma unroll
    for (int d0 = 0; d0 < 4; ++d0) gq[d0] = dgv[d0 * 32 + r32] * (1.f - lam_init);
#pragma unroll
    for (int r = 0; r < 16; ++r) {
      float ssq = 0.f;
#pragma unroll
      for (int d0 = 0; d0 < 4; ++d0) { const float df = o[d0][r] - lam * X[(wl * 32 + crow(r, hi)) * 128 + d0 * 32 + r32]; o[d0][r] = df; ssq += df * df; }
      ssq = xadd<1>(ssq); ssq = xadd<2>(ssq); ssq = xadd<4>(ssq); ssq = xadd<8>(ssq); ssq = xadd<16>(ssq);
      const float rn = rsqrtf(ssq * (1.f / 128.f) + cfg::EPS);
      bf16_t* dst = OC + (size_t)(b * cfg::S + q0 + crow(r, hi)) * 1024 + h * 128 + r32;
#pragma unroll
      for (int d0 = 0; d0 < 4; ++d0) dst[d0 * 32] = (bf16_t)(cvtpk(o[d0][r] * rn * gq[d0], 0.f) & 0xffffu);
    }
  }
  __syncthreads();
#undef ATT_SLOAD
#undef ATT_SWRITE
#undef ATT_SWAIT
#undef ATT_RESC
}
#undef ATT_KSWZ
#undef ATT_SBAR
}
namespace gla {
using att::bf16x8; using att::s16x4; using att::f32x16; using att::u32x4; using att::crow; using att::cvtpk; using att::tr_read;
typedef float f32x4 __attribute__((ext_vector_type(4)));
typedef unsigned u32x2 __attribute__((ext_vector_type(2)));
#define GLAS __attribute__((address_space(3)))
constexpr int KT_STRIDE = 144;
constexpr int A_KT = 0, A_V = 36864, A_BEND = A_V + 32768;
constexpr int B_QT = 0, B_KT = 32768, B_V = 65536, B_SC = 98304;
__device__ __forceinline__ int v_st64(int k, int c) { const int kk = (k & ~0xC) | ((k & 4) << 1) | ((k & 8) >> 1); return ((kk >> 3) * 2 + (c >> 5)) * 512 + ((kk & 7) * 32 + (c & 31)) * 2; }
constexpr int v_off64(int d0, int ks, int half) { return d0 * 512 + ks * 2048 + half * 1024; }
__device__ __forceinline__ float bf2f_(unsigned short v) { return __uint_as_float((unsigned)v << 16); }
__device__ __forceinline__ void load_v_tile(const bf16_t* __restrict__ src, GLAS unsigned char* dst, int lane) {
    u32x4 tv[8];
#pragma unroll
    for (int i = 0; i < 8; ++i) { const int row = (lane >> 3) + 8 * i, ch = lane & 7; tv[i] = *(const u32x4*)(src + (size_t)row * 256 + ch * 8); }
#pragma unroll
    for (int i = 0; i < 8; ++i) { const int row = (lane >> 3) + 8 * i, ch = lane & 7; *(GLAS u32x4*)(dst + v_st64(row, ch * 8)) = tv[i]; }
}
#define GLA_PK(L, H) (bf16x8){L[0], L[1], L[2], L[3], H[0], H[1], H[2], H[3]}
#define GLA_MM4(o0, o1, vb, AF) do { \
    const s16x4 l00 = tr_read<v_off64(0, 0, 0)>(vb), h00 = tr_read<v_off64(0, 0, 1)>(vb), l01 = tr_read<v_off64(0, 1, 0)>(vb), h01 = tr_read<v_off64(0, 1, 1)>(vb); \
    const s16x4 l02 = tr_read<v_off64(0, 2, 0)>(vb), h02 = tr_read<v_off64(0, 2, 1)>(vb), l03 = tr_read<v_off64(0, 3, 0)>(vb), h03 = tr_read<v_off64(0, 3, 1)>(vb); \
    const s16x4 l10 = tr_read<v_off64(1, 0, 0)>(vb), h10 = tr_read<v_off64(1, 0, 1)>(vb), l11 = tr_read<v_off64(1, 1, 0)>(vb), h11 = tr_read<v_off64(1, 1, 1)>(vb); \
    const s16x4 l12 = tr_read<v_off64(1, 2, 0)>(vb), h12 = tr_read<v_off64(1, 2, 1)>(vb), l13 = tr_read<v_off64(1, 3, 0)>(vb), h13 = tr_read<v_off64(1, 3, 1)>(vb); \
    asm volatile("s_waitcnt lgkmcnt(0)" ::: "memory"); __builtin_amdgcn_sched_barrier(0); \
    o0 = __builtin_amdgcn_mfma_f32_32x32x16_bf16(AF(0), GLA_PK(l00, h00), o0, 0, 0, 0); o1 = __builtin_amdgcn_mfma_f32_32x32x16_bf16(AF(0), GLA_PK(l10, h10), o1, 0, 0, 0); \
    o0 = __builtin_amdgcn_mfma_f32_32x32x16_bf16(AF(1), GLA_PK(l01, h01), o0, 0, 0, 0); o1 = __builtin_amdgcn_mfma_f32_32x32x16_bf16(AF(1), GLA_PK(l11, h11), o1, 0, 0, 0); \
    o0 = __builtin_amdgcn_mfma_f32_32x32x16_bf16(AF(2), GLA_PK(l02, h02), o0, 0, 0, 0); o1 = __builtin_amdgcn_mfma_f32_32x32x16_bf16(AF(2), GLA_PK(l12, h12), o1, 0, 0, 0); \
    o0 = __builtin_amdgcn_mfma_f32_32x32x16_bf16(AF(3), GLA_PK(l03, h03), o0, 0, 0, 0); o1 = __builtin_amdgcn_mfma_f32_32x32x16_bf16(AF(3), GLA_PK(l13, h13), o1, 0, 0, 0); } while (0)
__device__ __forceinline__ bf16x8 afrag_tr(const GLAS unsigned char* row, int ks, int hi) { return *(const GLAS bf16x8*)(row + (16 * ks + 8 * hi) * 2); }

__device__ __forceinline__ void gla_a_item(int b, int h, int g, unsigned char* ws, GLAS unsigned char* lds) {
    int tid_o = threadIdx.x; asm volatile("" : "+v"(tid_o));
    const int tid = tid_o, wave = __builtin_amdgcn_readfirstlane(tid >> 6), lane = tid & 63, r32 = lane & 31, hi = lane >> 5;
    const float* GL = (const float*)(ws + cfg::WS_GL); const bf16_t* GQK = (const bf16_t*)(ws + cfg::WS_GQK); const bf16_t* GV = (const bf16_t*)(ws + cfg::WS_GV);
    float* KVC = (float*)(ws + cfg::WS_OF); float* DEC = (float*)(ws + cfg::WS_DEC);
    const size_t tok0 = (size_t)b * 2048 + g * 256;
    GLAS float* bend_s = (GLAS float*)(lds + A_BEND);
    if (wave < 4) {
        const int c = wave, dir = lane >> 5, d = lane & 31;
        const float* gl = GL + (tok0 + c * 64) * 256 + dir * 128 + h * 32 + d; const bf16_t* kp = GQK + (tok0 + c * 64) * 256 + 128 + h * 32 + d;
        GLAS unsigned char* row = lds + A_KT + ((c * 2 + dir) * 32 + d) * KT_STRIDE; float bsum = 0.f; float gA[8], gB[8]; unsigned short kA[8], kB[8];
#define GLA_LOAD(G, K, blk) do { const int t0_ = dir ? 56 - 8 * (blk) : 8 * (blk); _Pragma("unroll") for (int i = 0; i < 8; ++i) { G[i] = gl[(size_t)(t0_ + i) * 256]; K[i] = kp[(size_t)(t0_ + i) * 256]; } } while (0)
#define GLA_PROC(G, K, blk) do { const int t0_ = dir ? 56 - 8 * (blk) : 8 * (blk); float kt[8]; \
            if (dir == 0) { _Pragma("unroll") for (int i = 0; i < 8; ++i) { bsum += G[i]; kt[i] = bf2f_(K[i]) * __expf(-bsum); } } \
            else { _Pragma("unroll") for (int i = 7; i >= 0; --i) { bsum += G[i]; kt[i] = bf2f_(K[i]) * __expf(-bsum); } } \
            u32x4 w; w.x = cvtpk(kt[0], kt[1]); w.y = cvtpk(kt[2], kt[3]); w.z = cvtpk(kt[4], kt[5]); w.w = cvtpk(kt[6], kt[7]); *(GLAS u32x4*)(row + t0_ * 2) = w; } while (0)
        GLA_LOAD(gA, kA, 0);
#pragma unroll
        for (int bp = 0; bp < 4; ++bp) { GLA_LOAD(gB, kB, 2 * bp + 1); GLA_PROC(gA, kA, 2 * bp); if (bp < 3) GLA_LOAD(gA, kA, 2 * bp + 2); GLA_PROC(gB, kB, 2 * bp + 1); }
#undef GLA_LOAD
#undef GLA_PROC
        bend_s[(c * 2 + dir) * 32 + d] = bsum;
        DEC[((size_t)((b * 4 + h) * 32 + g * 4 + c) * 2 + dir) * 32 + d] = __expf(bsum);
    } else { const int c = wave - 4; load_v_tile(GV + (tok0 + c * 64) * 256 + h * 64, lds + A_V + c * 8192, lane); }
    __syncthreads();
    {
        const int c = wave >> 1, dir = wave & 1; f32x16 o0 = {}, o1 = {};
        const int vb = (int)(unsigned)(uintptr_t)(lds + A_V + c * 8192) + att::v_rd_base(lane);
        const GLAS unsigned char* arow = lds + A_KT + ((c * 2 + dir) * 32 + r32) * KT_STRIDE;
#define GLA_AF(ks) afrag_tr(arow, ks, hi)
        GLA_MM4(o0, o1, vb, GLA_AF);
#undef GLA_AF
        float* dst = KVC + ((size_t)((b * 4 + h) * 32 + g * 4 + c) * 2 + dir) * 2048 + r32;
#pragma unroll
        for (int r = 0; r < 16; ++r) { const int d = crow(r, hi); const float sc = __expf(bend_s[(c * 2 + dir) * 32 + d]); dst[d * 64] = o0[r] * sc; dst[d * 64 + 32] = o1[r] * sc; }
    }
    __syncthreads();
}

__device__ __forceinline__ void gla_b_item(int b, int h, int g, unsigned char* ws, const float* __restrict__ gng, bf16_t* __restrict__ OC, GLAS unsigned char* lds) {
    int tid_o = threadIdx.x; asm volatile("" : "+v"(tid_o));
    const int tid = tid_o, wave = __builtin_amdgcn_readfirstlane(tid >> 6), lane = tid & 63, r32 = lane & 31, hi = lane >> 5;
    const float* GL = (const float*)(ws + cfg::WS_GL); const bf16_t* GQK = (const bf16_t*)(ws + cfg::WS_GQK); const bf16_t* GV = (const bf16_t*)(ws + cfg::WS_GV); const bf16_t* GR = (const bf16_t*)(ws + cfg::WS_GR);
    const float* KVC = (const float*)(ws + cfg::WS_OF) + (size_t)((b * 4 + h) * 32) * 2 * 2048; const float* DEC = (const float*)(ws + cfg::WS_DEC) + (size_t)((b * 4 + h) * 32) * 2 * 32;
    const size_t tok0 = (size_t)b * 2048 + g * 256;
    if (wave < 4) {
        const int c = wave, dir = lane >> 5, d = lane & 31;
        const float* gl = GL + (tok0 + c * 64) * 256 + dir * 128 + h * 32 + d; const bf16_t* qp = GQK + (tok0 + c * 64) * 256 + h * 32 + d;
        GLAS unsigned short* qt = (GLAS unsigned short*)(lds + B_QT + c * 8192) + dir * 32 + d;
        GLAS unsigned short* kt = (GLAS unsigned short*)(lds + B_KT + c * 8192 + dir * 4096) + d;
        float bsum = 0.f; float gA[8], gB[8]; unsigned short qA[8], kA[8], qB[8], kB[8];
#define GLB_LOAD(G, Q, K, blk) do { const int t0_ = dir ? 56 - 8 * (blk) : 8 * (blk); _Pragma("unroll") for (int i = 0; i < 8; ++i) { G[i] = gl[(size_t)(t0_ + i) * 256]; Q[i] = qp[(size_t)(t0_ + i) * 256]; K[i] = qp[(size_t)(t0_ + i) * 256 + 128]; } } while (0)
#define GLB_PROC(G, Q, K, blk) do { const int t0_ = dir ? 56 - 8 * (blk) : 8 * (blk); _Pragma("unroll") for (int ii = 0; ii < 8; ++ii) { \
            const float gi = dir ? G[7 - ii] : G[ii], qi = bf2f_(dir ? Q[7 - ii] : Q[ii]), ki = bf2f_(dir ? K[7 - ii] : K[ii]); const int tt = t0_ + (dir ? 7 - ii : ii); \
            bsum += gi; const float e = __expf(bsum), ei = __expf(-bsum); \
            qt[tt * 64] = (unsigned short)(cvtpk(qi * e, 0.f) & 0xffffu); kt[tt * 32] = (unsigned short)(cvtpk(ki * ei, 0.f) & 0xffffu); } } while (0)
        GLB_LOAD(gA, qA, kA, 0);
#pragma unroll
        for (int bp = 0; bp < 4; ++bp) { GLB_LOAD(gB, qB, kB, 2 * bp + 1); GLB_PROC(gA, qA, kA, 2 * bp); if (bp < 3) GLB_LOAD(gA, qA, kA, 2 * bp + 2); GLB_PROC(gB, qB, kB, 2 * bp + 1); }
#undef GLB_LOAD
#undef GLB_PROC
    } else {
        const int c = wave - 4; load_v_tile(GV + (tok0 + c * 64) * 256 + h * 64, lds + B_V + c * 8192, lane);
        const int t2 = tid - 256, d = t2 >> 3, v8 = (t2 & 7) * 8;
        const float* kvp = KVC + d * 64 + v8; const float* dcp = DEC + d;
        f32x4 own[4][2][2]; float dow[4][2];
#pragma unroll
        for (int c4 = 0; c4 < 4; ++c4)
#pragma unroll
            for (int dr = 0; dr < 2; ++dr) { const int n = 4 * g + c4; own[c4][dr][0] = *(const f32x4*)(kvp + (size_t)(n * 2 + dr) * 2048); own[c4][dr][1] = *(const f32x4*)(kvp + (size_t)(n * 2 + dr) * 2048 + 4); dow[c4][dr] = dcp[(n * 2 + dr) * 32]; }
        f32x4 Sf0 = {0.f, 0.f, 0.f, 0.f}, Sf1 = Sf0, Sb0 = Sf0, Sb1 = Sf0;
#pragma unroll 8
        for (int n = 0; n < 4 * g; ++n) { const float dc = dcp[(n * 2) * 32]; Sf0 = dc * Sf0 + *(const f32x4*)(kvp + (size_t)(n * 2) * 2048); Sf1 = dc * Sf1 + *(const f32x4*)(kvp + (size_t)(n * 2) * 2048 + 4); }
#pragma unroll 8
        for (int n = 31; n >= 4 * g + 4; --n) { const float dc = dcp[(n * 2 + 1) * 32]; Sb0 = dc * Sb0 + *(const f32x4*)(kvp + (size_t)(n * 2 + 1) * 2048); Sb1 = dc * Sb1 + *(const f32x4*)(kvp + (size_t)(n * 2 + 1) * 2048 + 4); }
#pragma unroll
        for (int c4 = 0; c4 < 4; ++c4) { u32x4 w; w.x = cvtpk(Sf0[0], Sf0[1]); w.y = cvtpk(Sf0[2], Sf0[3]); w.z = cvtpk(Sf1[0], Sf1[1]); w.w = cvtpk(Sf1[2], Sf1[3]);
            *(GLAS u32x4*)(lds + B_SC + c4 * 8192 + v_st64(d, v8)) = w; Sf0 = dow[c4][0] * Sf0 + own[c4][0][0]; Sf1 = dow[c4][0] * Sf1 + own[c4][0][1]; }
#pragma unroll
        for (int c4 = 3; c4 >= 0; --c4) { u32x4 w; w.x = cvtpk(Sb0[0], Sb0[1]); w.y = cvtpk(Sb0[2], Sb0[3]); w.z = cvtpk(Sb1[0], Sb1[1]); w.w = cvtpk(Sb1[2], Sb1[3]);
            *(GLAS u32x4*)(lds + B_SC + c4 * 8192 + v_st64(32 + d, v8)) = w; Sb0 = dow[c4][1] * Sb0 + own[c4][1][0]; Sb1 = dow[c4][1] * Sb1 + own[c4][1][1]; }
    }
    __syncthreads();
    {
        const int c = wave >> 1, th = wave & 1, t = 32 * th + r32;
        const GLAS unsigned char* qrow = lds + B_QT + c * 8192 + t * 128;
        f32x16 pf0 = {}, pf1 = {}, pb0 = {}, pb1 = {};
#pragma unroll
        for (int ks = 0; ks < 2; ++ks) {
            const bf16x8 qf = *(const GLAS bf16x8*)(qrow + (16 * ks + 8 * hi) * 2), qb = *(const GLAS bf16x8*)(qrow + (32 + 16 * ks + 8 * hi) * 2);
            const GLAS unsigned char* kf = lds + B_KT + c * 8192 + r32 * 64 + (16 * ks + 8 * hi) * 2; const GLAS unsigned char* kb = kf + 4096;
            pf0 = __builtin_amdgcn_mfma_f32_32x32x16_bf16(*(const GLAS bf16x8*)kf, qf, pf0, 0, 0, 0); pf1 = __builtin_amdgcn_mfma_f32_32x32x16_bf16(*(const GLAS bf16x8*)(kf + 2048), qf, pf1, 0, 0, 0);
            pb0 = __builtin_amdgcn_mfma_f32_32x32x16_bf16(*(const GLAS bf16x8*)kb, qb, pb0, 0, 0, 0); pb1 = __builtin_amdgcn_mfma_f32_32x32x16_bf16(*(const GLAS bf16x8*)(kb + 2048), qb, pb1, 0, 0, 0);
        }
#pragma unroll
        for (int r = 0; r < 16; ++r) { const int j0 = crow(r, hi), j1 = 32 + j0;
            pf0[r] = (j0 <= t ? pf0[r] : 0.f) + (j0 >= t ? pb0[r] : 0.f); pf1[r] = (j1 <= t ? pf1[r] : 0.f) + (j1 >= t ? pb1[r] : 0.f); }
        bf16x8 pa0, pa1, pa2, pa3;
#define GLA_PK4(P, BASE, OUT) do { unsigned a0 = cvtpk(P[BASE + 0], P[BASE + 1]), a1 = cvtpk(P[BASE + 2], P[BASE + 3]); unsigned b0 = cvtpk(P[BASE + 4], P[BASE + 5]), b1 = cvtpk(P[BASE + 6], P[BASE + 7]); \
    auto r0 = __builtin_amdgcn_permlane32_swap(a0, b0, false, false); auto r1 = __builtin_amdgcn_permlane32_swap(a1, b1, false, false); \
    u32x4 w = {r0[0], r1[0], r0[1], r1[1]}; OUT = *reinterpret_cast<bf16x8*>(&w); } while (0)
        GLA_PK4(pf0, 0, pa0); GLA_PK4(pf0, 8, pa1); GLA_PK4(pf1, 0, pa2); GLA_PK4(pf1, 8, pa3);
#undef GLA_PK4
        f32x16 o0 = {}, o1 = {};
        { const int vb = (int)(unsigned)(uintptr_t)(lds + B_V + c * 8192) + att::v_rd_base(lane);
#define GLA_AF(ks) ((ks) == 0 ? pa0 : (ks) == 1 ? pa1 : (ks) == 2 ? pa2 : pa3)
          GLA_MM4(o0, o1, vb, GLA_AF);
#undef GLA_AF
        }
        { const int vb = (int)(unsigned)(uintptr_t)(lds + B_SC + c * 8192) + att::v_rd_base(lane);
#define GLA_AF(ks) afrag_tr(qrow, ks, hi)
          GLA_MM4(o0, o1, vb, GLA_AF);
#undef GLA_AF
        }
        const float g0 = gng[r32], g1 = gng[32 + r32];
#pragma unroll
        for (int r = 0; r < 16; ++r) {
            float ssq = o0[r] * o0[r] + o1[r] * o1[r];
            ssq = xadd<1>(ssq); ssq = xadd<2>(ssq); ssq = xadd<4>(ssq); ssq = xadd<8>(ssq); ssq = xadd<16>(ssq);
            const float rn = rsqrtf(ssq * (1.f / 64.f) + cfg::EPS);
            const size_t tok = tok0 + c * 64 + 32 * th + crow(r, hi);
            const bf16_t* gr = GR + tok * 256 + h * 64 + r32; bf16_t* dst = OC + tok * 1024 + 768 + h * 64 + r32;
            dst[0] = (bf16_t)(cvtpk(o0[r] * rn * g0 * bf2f_(gr[0]), 0.f) & 0xffffu); dst[32] = (bf16_t)(cvtpk(o1[r] * rn * g1 * bf2f_(gr[32]), 0.f) & 0xffffu);
        }
    }
    __syncthreads();
}
#undef GLA_MM4
#undef GLA_PK
#undef GLAS
}
namespace fft {
using att::bf16x8; using att::s16x4; using att::f32x16; using att::u32x4; using att::crow; using att::cvtpk; using att::tr_read;
#define FLAS __attribute__((address_space(3)))
__device__ __forceinline__ int img_off(int k, int c) { const int kk = (k & ~0xC) | ((k & 4) << 1) | ((k & 8) >> 1); return ((kk >> 3) * 8 + (c >> 5)) * 512 + ((kk & 7) * 32 + (c & 31)) * 2; }
constexpr int rd_off(int ks, int half) { return ks * 8192 + half * 4096; }
#define FFT_PK(L, H) (bf16x8){L[0], L[1], L[2], L[3], H[0], H[1], H[2], H[3]}
typedef float f32x2_t __attribute__((ext_vector_type(2))); typedef __bf16 bf16x2_t __attribute__((ext_vector_type(2)));
__device__ __forceinline__ unsigned pk2f(float a, float b) { f32x2_t v = {a, b}; bf16x2_t r = __builtin_convertvector(v, bf16x2_t); return __builtin_bit_cast(unsigned, r); }

__device__ __forceinline__ void stage1_item(int b, int s2, const bf16_t* __restrict__ FX, bf16_t* __restrict__ I1, FLAS unsigned char* lds) {
    int tid_o = threadIdx.x; asm volatile("" : "+v"(tid_o));
    const int tid = tid_o, wave = __builtin_amdgcn_readfirstlane(tid >> 6), lane = tid & 63, r32 = lane & 31, hi = lane >> 5;
    bf16x8 F1[2][4];
#pragma unroll
    for (int ks = 0; ks < 4; ++ks) { float cr[8], ci[8];
#pragma unroll
        for (int j = 0; j < 8; ++j) { const int k = 16 * ks + 8 * hi + j, s1 = k & 31; const float rev = (float)((r32 * s1) & 31) * (1.f / 32.f); const float c = __builtin_amdgcn_cosf(rev), sn = __builtin_amdgcn_sinf(rev);
            const bool p1 = (k >> 5) != 0; cr[j] = p1 ? -sn : c; ci[j] = p1 ? -c : -sn; }
        u32x4 wr = {pk2f(cr[0], cr[1]), pk2f(cr[2], cr[3]), pk2f(cr[4], cr[5]), pk2f(cr[6], cr[7])}, wi = {pk2f(ci[0], ci[1]), pk2f(ci[2], ci[3]), pk2f(ci[4], ci[5]), pk2f(ci[6], ci[7])};
        F1[0][ks] = *reinterpret_cast<bf16x8*>(&wr); F1[1][ks] = *reinterpret_cast<bf16x8*>(&wi); }
    { u32x4 tv[4];
#pragma unroll
      for (int i = 0; i < 4; ++i) { const int p = tid + 512 * i, k = p >> 5, c8 = (p & 31) * 8; tv[i] = *(const u32x4*)(FX + (size_t)(b * 2048 + 64 * (k & 31) + s2) * 512 + (k >> 5) * 256 + c8); }
#pragma unroll
      for (int i = 0; i < 4; ++i) { const int p = tid + 512 * i, k = p >> 5, c8 = (p & 31) * 8; *(FLAS u32x4*)(lds + img_off(k, c8)) = tv[i]; } }
    __syncthreads();
    f32x16 re = {}, im = {};
    { const int vb = (int)(unsigned)(uintptr_t)lds + att::v_rd_base(lane) + wave * 512;
      const s16x4 l0 = tr_read<rd_off(0, 0)>(vb), h0 = tr_read<rd_off(0, 1)>(vb), l1 = tr_read<rd_off(1, 0)>(vb), h1 = tr_read<rd_off(1, 1)>(vb);
      const s16x4 l2 = tr_read<rd_off(2, 0)>(vb), h2 = tr_read<rd_off(2, 1)>(vb), l3 = tr_read<rd_off(3, 0)>(vb), h3 = tr_read<rd_off(3, 1)>(vb);
      asm volatile("s_waitcnt lgkmcnt(0)" ::: "memory"); __builtin_amdgcn_sched_barrier(0);
      re = __builtin_amdgcn_mfma_f32_32x32x16_bf16(F1[0][0], FFT_PK(l0, h0), re, 0, 0, 0); im = __builtin_amdgcn_mfma_f32_32x32x16_bf16(F1[1][0], FFT_PK(l0, h0), im, 0, 0, 0);
      re = __builtin_amdgcn_mfma_f32_32x32x16_bf16(F1[0][1], FFT_PK(l1, h1), re, 0, 0, 0); im = __builtin_amdgcn_mfma_f32_32x32x16_bf16(F1[1][1], FFT_PK(l1, h1), im, 0, 0, 0);
      re = __builtin_amdgcn_mfma_f32_32x32x16_bf16(F1[0][2], FFT_PK(l2, h2), re, 0, 0, 0); im = __builtin_amdgcn_mfma_f32_32x32x16_bf16(F1[1][2], FFT_PK(l2, h2), im, 0, 0, 0);
      re = __builtin_amdgcn_mfma_f32_32x32x16_bf16(F1[0][3], FFT_PK(l3, h3), re, 0, 0, 0); im = __builtin_amdgcn_mfma_f32_32x32x16_bf16(F1[1][3], FFT_PK(l3, h3), im, 0, 0, 0); }
    bf16_t* dst = I1 + (size_t)(b * 32) * 128 * 256 + (size_t)s2 * 256 + 32 * wave + r32;
#pragma unroll
    for (int r = 0; r < 16; ++r) { const int k1 = crow(r, hi); const float rev = (float)((k1 * s2) & 2047) * (1.f / 2048.f); const float ct = __builtin_amdgcn_cosf(rev), st = __builtin_amdgcn_sinf(rev);
        const float ar = re[r] * ct + im[r] * st, ai = im[r] * ct - re[r] * st; const unsigned w = pk2f(ar, ai);
        dst[(size_t)k1 * 128 * 256] = (bf16_t)(w & 0xffffu); dst[(size_t)k1 * 128 * 256 + 64 * 256] = (bf16_t)(w >> 16); }
    __syncthreads();
}

__device__ __forceinline__ void stage2_item(int b, int k1, const bf16_t* __restrict__ I1, bf16_t* __restrict__ OC, FLAS unsigned char* lds) {
    int tid_o = threadIdx.x; asm volatile("" : "+v"(tid_o));
    const int tid = tid_o, wave = __builtin_amdgcn_readfirstlane(tid >> 6), lane = tid & 63, r32 = lane & 31, hi = lane >> 5;
    const bf16_t* src = I1 + (size_t)(b * 32 + k1) * 128 * 256;
    { u32x4 tv[8];
#pragma unroll
      for (int i = 0; i < 8; ++i) { const int p = tid + 512 * i, k = p >> 5, c8 = (p & 31) * 8; tv[i] = *(const u32x4*)(src + (size_t)k * 256 + c8); }
#pragma unroll
      for (int i = 0; i < 8; ++i) { const int p = tid + 512 * i, k = p >> 5, c8 = (p & 31) * 8; *(FLAS u32x4*)(lds + img_off(k, c8)) = tv[i]; } }
    f32x16 y0 = {}, y1 = {};
    __syncthreads();
    const int vb = (int)(unsigned)(uintptr_t)lds + att::v_rd_base(lane) + wave * 512, vb2 = vb + 32768;
    bf16x8 F2[2][8];
#pragma unroll
    for (int ks = 0; ks < 8; ++ks) { float c0[8], c1[8];
#pragma unroll
        for (int j = 0; j < 8; ++j) { const int k = 16 * ks + 8 * hi + j, s2 = k & 63; const float r0 = (float)((r32 * s2) & 63) * (1.f / 64.f), r1 = (float)(((32 + r32) * s2) & 63) * (1.f / 64.f);
            c0[j] = (k >> 6) ? __builtin_amdgcn_sinf(r0) : __builtin_amdgcn_cosf(r0); c1[j] = (k >> 6) ? __builtin_amdgcn_sinf(r1) : __builtin_amdgcn_cosf(r1); }
        u32x4 w0 = {pk2f(c0[0], c0[1]), pk2f(c0[2], c0[3]), pk2f(c0[4], c0[5]), pk2f(c0[6], c0[7])}, w1 = {pk2f(c1[0], c1[1]), pk2f(c1[2], c1[3]), pk2f(c1[4], c1[5]), pk2f(c1[6], c1[7])};
        F2[0][ks] = *reinterpret_cast<bf16x8*>(&w0); F2[1][ks] = *reinterpret_cast<bf16x8*>(&w1); }
#define FFT_STEP(ks) do { \
      const s16x4 lo_ = tr_read<rd_off((ks) & 3, 0)>((ks) < 4 ? vb : vb2), hi_ = tr_read<rd_off((ks) & 3, 1)>((ks) < 4 ? vb : vb2); asm volatile("s_waitcnt lgkmcnt(0)" ::: "memory"); __builtin_amdgcn_sched_barrier(0); \
      y0 = __builtin_amdgcn_mfma_f32_32x32x16_bf16(F2[0][ks], FFT_PK(lo_, hi_), y0, 0, 0, 0); y1 = __builtin_amdgcn_mfma_f32_32x32x16_bf16(F2[1][ks], FFT_PK(lo_, hi_), y1, 0, 0, 0); } while (0)
    FFT_STEP(0); FFT_STEP(1); FFT_STEP(2); FFT_STEP(3); FFT_STEP(4); FFT_STEP(5); FFT_STEP(6); FFT_STEP(7);
#undef FFT_STEP
    bf16_t* dst = OC + (size_t)(b * 2048 + k1) * 1024 + 512 + 32 * wave + r32;
#pragma unroll
    for (int r = 0; r < 16; ++r) { const int k2 = crow(r, hi); const unsigned w = pk2f(y0[r], y1[r]);
        dst[(size_t)(32 * k2) * 1024] = (bf16_t)(w & 0xffffu); dst[(size_t)(32 * (32 + k2)) * 1024] = (bf16_t)(w >> 16); }
    __syncthreads();
}
#undef FFT_PK
#undef FLAS
}
namespace pro {
#define PLAS __attribute__((address_space(3)))
typedef float f32x4 __attribute__((ext_vector_type(4)));
typedef unsigned u32x4 __attribute__((ext_vector_type(4)));
__device__ __forceinline__ unsigned pk2(float lo, float hi) { unsigned r; asm volatile("v_cvt_pk_bf16_f32 %0, %1, %2" : "=v"(r) : "v"(lo), "v"(hi)); return r; }
__device__ __forceinline__ float lo_f(unsigned w) { return __uint_as_float(w << 16); }
__device__ __forceinline__ float hi_f(unsigned w) { return __uint_as_float(w & 0xffff0000u); }
template <bool SUMS, int STRIDE> __device__ __forceinline__ void tile_emit(int K, bf16_t* WT, const float* gain, const float* lnb, float (&a1)[4], float (&a2)[4], const PLAS float* scr, int lane) {
    const int c = lane & 7; float gk[8], bk[8];
#pragma unroll
    for (int q = 0; q < 8; ++q) { gk[q] = gain ? gain[8 * c + q] : 1.f; bk[q] = lnb ? lnb[8 * c + q] : 0.f; }
#pragma unroll
    for (int j = 0; j < 4; ++j) { const int n = (lane >> 3) + 8 * j; const PLAS float* s = scr + (8 * c) * STRIDE + n; float v[8];
#pragma unroll
        for (int q = 0; q < 8; ++q) v[q] = s[q * STRIDE];
        u32x4 o; o.x = pk2(v[0] * gk[0], v[1] * gk[1]); o.y = pk2(v[2] * gk[2], v[3] * gk[3]); o.z = pk2(v[4] * gk[4], v[5] * gk[5]); o.w = pk2(v[6] * gk[6], v[7] * gk[7]);
        *(u32x4*)(WT + (size_t)n * K + 8 * c) = o;
        if (SUMS) { float p1 = (lo_f(o.x) + hi_f(o.x)) + (lo_f(o.y) + hi_f(o.y)) + (lo_f(o.z) + hi_f(o.z)) + (lo_f(o.w) + hi_f(o.w)); float p2 = 0.f;
#pragma unroll
            for (int q = 0; q < 8; ++q) p2 += bk[q] * v[q];
            p1 = xadd<1>(p1); p2 = xadd<1>(p2); p1 = xadd<2>(p1); p2 = xadd<2>(p2); p1 = xadd<4>(p1); p2 = xadd<4>(p2);
            a1[j] += p1; a2[j] += p2; }
    }
    asm volatile("s_waitcnt lgkmcnt(0)" ::: "memory");
}
__device__ __forceinline__ void tile_dma(const float* W, int N, PLAS float* scr, int lane) {
    const float* src = W + (size_t)(lane >> 3) * N + (lane & 7) * 4;
#pragma unroll
    for (int i = 0; i < 8; ++i) __builtin_amdgcn_global_load_lds((const unsigned*)(src + (size_t)(8 * i) * N), (PLAS unsigned*)(scr + i * 256), 16, 0, 0);
}
template <bool SUMS, class Val> __device__ __forceinline__ void tile_item(const Val& val, int K, bf16_t* WT, const float* gain, const float* lnb, float (&a1)[4], float (&a2)[4], PLAS float* scr, int lane) {
#pragma unroll 2
    for (int i = 0; i < 32; ++i) { const int kk = 2 * i + (lane >> 5); scr[kk * 33 + (lane & 31)] = val(kk, lane & 31); }
    asm volatile("s_waitcnt lgkmcnt(0)" ::: "memory");
    tile_emit<SUMS, 33>(K, WT, gain, lnb, a1, a2, scr, lane);
}
struct ValPlain { static constexpr int BATCH = 32; const float* W; int N; __device__ __forceinline__ float operator()(int kk, int j) const { return W[(size_t)kk * N + j]; } };
struct ValGate { static constexpr int BATCH = 2; const float* W; const float* w2; __device__ __forceinline__ float operator()(int kk, int j) const {
    const float* wr = W + (size_t)kk * cfg::INW; float a = 0.f;
#pragma unroll
    for (int r = 0; r < 16; ++r) a += wr[r] * w2[r * 128 + j]; return a; } };

__device__ __forceinline__ void fold_item(int item, unsigned char* ws, const float* w_in, const float* fw, const float* lng, const float* lnb, PLAS unsigned char* lds, int tid) {
    const int l = item >> 5, g = (item >> 3) & 3, part = (item >> 2) & 1, kq = item & 3;
    PLAS float* M = (PLAS float*)lds;
    { const int c = tid >> 3, e0 = (tid & 7) * 8; float acc[8];
#pragma unroll
      for (int q = 0; q < 8; ++q) acc[q] = 0.f;
      const float* w = fw + (size_t)((l * 4 + g) * 64) * 64 + e0;
      for (int k2 = 0; k2 < 64; ++k2) { float rev = (float)((k2 * c) & 63) * (1.f / 64.f); asm volatile("" : "+v"(rev)); const float tr = part ? __builtin_amdgcn_sinf(rev) : __builtin_amdgcn_cosf(rev);
          const f32x4 w0 = *(const f32x4*)(w + k2 * 64), w1 = *(const f32x4*)(w + k2 * 64 + 4);
#pragma unroll
          for (int q = 0; q < 4; ++q) { acc[q] += tr * w0[q]; acc[4 + q] += tr * w1[q]; } }
      const float sc = 0.00276213586400995f;
#pragma unroll
      for (int q = 0; q < 8; ++q) M[c * 64 + e0 + q] = acc[q] * sc; }
    __syncthreads();
    PLAS float* Wl = (PLAS float*)(lds + 16384);
    { const float* wsrc = w_in + ((size_t)l * 1024 + kq * 256) * cfg::INW + 1536 + 64 * g; f32x4 tv[8];
#pragma unroll
      for (int i = 0; i < 8; ++i) tv[i] = *(const f32x4*)(wsrc + (size_t)((tid >> 4) + 32 * i) * cfg::INW + (tid & 15) * 4);
#pragma unroll
      for (int i = 0; i < 8; ++i) *(PLAS f32x4*)(Wl + ((tid >> 4) + 32 * i) * 64 + (tid & 15) * 4) = tv[i]; }
    __syncthreads();
    { const int e = tid & 63, kg = tid >> 6, k0 = kq * 256 + kg * 32, np = 1536 + part * 256 + g * 64 + e; float mc[64];
#pragma unroll
      for (int c = 0; c < 64; ++c) mc[c] = M[c * 64 + e];
      bf16_t* dst = (bf16_t*)(ws + cfg::WS_WIN + l * cfg::SZ_WIN) + (size_t)np * 1024 + k0; float s1 = 0.f, s2 = 0.f;
      for (int kb = 0; kb < 4; ++kb) { float o[8];
#pragma unroll
          for (int q = 0; q < 8; ++q) { const int k = k0 + kb * 8 + q; const PLAS f32x4* wr = (const PLAS f32x4*)(Wl + (kg * 32 + kb * 8 + q) * 64); float a = 0.f;
#pragma unroll
              for (int c4 = 0; c4 < 16; ++c4) { const f32x4 w4 = wr[c4]; a += w4[0] * mc[4 * c4] + w4[1] * mc[4 * c4 + 1] + w4[2] * mc[4 * c4 + 2] + w4[3] * mc[4 * c4 + 3]; }
              o[q] = a * (lng ? lng[k] : 1.f); s2 += lnb ? lnb[k] * a : 0.f; }
          u32x4 w; w.x = pk2(o[0], o[1]); w.y = pk2(o[2], o[3]); w.z = pk2(o[4], o[5]); w.w = pk2(o[6], o[7]); *(u32x4*)(dst + kb * 8) = w;
          s1 += (lo_f(w.x) + hi_f(w.x)) + (lo_f(w.y) + hi_f(w.y)) + (lo_f(w.z) + hi_f(w.z)) + (lo_f(w.w) + hi_f(w.w)); }
      __syncthreads();
      PLAS float* red = (PLAS float*)lds; red[(kg * 64 + e) * 2] = s1; red[(kg * 64 + e) * 2 + 1] = s2;
      __syncthreads();
      if (kg == 0) { float t1 = 0.f, t2 = 0.f;
#pragma unroll
          for (int w = 0; w < 8; ++w) { t1 += red[(w * 64 + e) * 2]; t2 += red[(w * 64 + e) * 2 + 1]; }
          float* fp = (float*)(ws + cfg::V_MF) + (size_t)((l * 4 + kq) * 2) * 512 + part * 256 + g * 64 + e; fp[0] = t1; fp[512] = t2; } }
    __syncthreads();
}

struct Inputs { const float *x, *w_in, *fw, *gw2, *w_out, *ln1g, *ln1b, *wg, *wu, *wd, *ln2g, *ln2b; };
__device__ __forceinline__ void prologue(unsigned char* ws, const Inputs& in, PLAS unsigned char* lds, int vcu, int G) {
    int tid_o = threadIdx.x; asm volatile("" : "+v"(tid_o));
    const int tid = tid_o, wave = __builtin_amdgcn_readfirstlane(tid >> 6), lane = tid & 63;
    const float* x = in.x; const float* w_in = in.w_in; const float* fw = in.fw; const float* gw2 = in.gw2; const float* w_out = in.w_out; const float* ln1g = in.ln1g; const float* ln1b = in.ln1b;
    const float* wg = in.wg; const float* wu = in.wu; const float* wd = in.wd; const float* ln2g = in.ln2g; const float* ln2b = in.ln2b;
    if (vcu < 64) { const int l = vcu >> 5; fold_item(vcu, ws, w_in, fw, l ? ln2g : (const float*)nullptr, l ? ln2b : (const float*)nullptr, lds, tid); }
    PLAS float* scr = (PLAS float*)(lds + wave * 16384); PLAS float* scr1 = scr + 2048; PLAS float* redw = (PLAS float*)(lds + 131072 + 1024 + wave * 256);
    const int gw = vcu * 8 + wave, NGW = G * 8;
    for (int it = vcu; it < 512; it += G) {
        const int l = it >> 8, r = it & 255; float a1[4] = {0.f, 0.f, 0.f, 0.f}, a2[4] = {0.f, 0.f, 0.f, 0.f}; float* c1o; float* c2o;
        const int k0 = wave * 64, k1 = k0 + 512;
        if (r < 80) { const int nb = r; const float* lngb = l ? ln2g : (const float*)nullptr; const float* lnbb = l ? ln2b : (const float*)nullptr;
            bf16_t* Wt = (bf16_t*)(ws + cfg::WS_WIN + l * cfg::SZ_WIN);
            if (nb < 72) { int np0, src;
                if (nb < 32) { const int pn = nb >> 3, p = (nb & 7) * 32, wc = (p >> 5) & 3, bj = p >> 7; np0 = pn * 256 + p; src = (pn >> 1) * 512 + (pn & 1) * 256 + 64 * wc + 32 * bj; }
                else if (nb < 48) { np0 = 1024 + (nb - 32) * 32; src = np0; }
                else { np0 = 2048 + (nb - 48) * 32; src = 1792 + (nb - 48) * 32; }
                tile_dma(w_in + ((size_t)l * 1024 + k0) * cfg::INW + src, cfg::INW, scr, lane); tile_dma(w_in + ((size_t)l * 1024 + k1) * cfg::INW + src, cfg::INW, scr1, lane);
                asm volatile("s_waitcnt vmcnt(0)" ::: "memory");
                tile_emit<true, 32>(1024, Wt + (size_t)np0 * 1024 + k0, lngb ? lngb + k0 : lngb, lnbb ? lnbb + k0 : lnbb, a1, a2, scr, lane);
                tile_emit<true, 32>(1024, Wt + (size_t)np0 * 1024 + k1, lngb ? lngb + k1 : lngb, lnbb ? lnbb + k1 : lnbb, a1, a2, scr1, lane);
                c1o = (float*)(ws + cfg::V_C1IN) + l * cfg::NIN + np0; c2o = (float*)(ws + cfg::V_C2IN) + l * cfg::NIN + np0;
            } else { const int p0 = (nb - 72) * 32, dir = p0 >> 7, kk0 = p0 & 127, np0 = 2816 + p0;
                for (int kb = wave; kb < 16; kb += 8) { const int kq = kb * 64; ValGate v{w_in + ((size_t)l * 1024 + kq) * cfg::INW + 2560 + 16 * dir, gw2 + (size_t)((l * 2 + dir) * 16) * 128 + kk0};
                    tile_item<true>(v, 1024, Wt + (size_t)np0 * 1024 + kq, lngb ? lngb + kq : lngb, lnbb ? lnbb + kq : lnbb, a1, a2, scr, lane); }
                c1o = (float*)(ws + cfg::V_C1IN) + l * cfg::NIN + np0; c2o = (float*)(ws + cfg::V_C2IN) + l * cfg::NIN + np0; }
        } else { const int nb = r - 80, np0 = nb * 32, pn = np0 >> 8, p = np0 & 255, bj = p >> 7, f0 = 128 * pn + (p & 127);
            const float* W = (bj ? wu : wg) + (size_t)l * 1024 * cfg::FF + f0; bf16_t* Wt = (bf16_t*)(ws + cfg::WS_WGU + l * cfg::SZ_WGU) + (size_t)np0 * 1024;
            tile_dma(W + (size_t)k0 * cfg::FF, cfg::FF, scr, lane); tile_dma(W + (size_t)k1 * cfg::FF, cfg::FF, scr1, lane);
            asm volatile("s_waitcnt vmcnt(0)" ::: "memory");
            tile_emit<true, 32>(1024, Wt + k0, ln1g + l * 1024 + k0, ln1b + l * 1024 + k0, a1, a2, scr, lane);
            tile_emit<true, 32>(1024, Wt + k1, ln1g + l * 1024 + k1, ln1b + l * 1024 + k1, a1, a2, scr1, lane);
            c1o = (float*)(ws + cfg::V_C1GU) + l * cfg::NGU + np0; c2o = (float*)(ws + cfg::V_C2GU) + l * cfg::NGU + np0; }
        if ((lane & 7) == 0) {
#pragma unroll
            for (int j = 0; j < 4; ++j) { const int n = (lane >> 3) + 8 * j; redw[n * 2] = a1[j]; redw[n * 2 + 1] = a2[j]; } }
        __syncthreads();
        if (wave == 0 && lane < 32) { float t1 = 0.f, t2 = 0.f;
#pragma unroll
            for (int w = 0; w < 8; ++w) { const PLAS float* rw = (const PLAS float*)(lds + 131072 + 1024 + w * 256); t1 += rw[lane * 2]; t2 += rw[lane * 2 + 1]; }
            c1o[lane] = t1; c2o[lane] = t2; }
        __syncthreads();
    }
    constexpr int I_OUT = 32 * 16, I_DN = 32 * 44, I_L = I_OUT + I_DN;
    for (int it = gw; it < 2 * I_L; it += 2 * NGW) {
        const float* Ws[2]; int Ns[2], Ks[2]; bf16_t* Wd[2]; float d1[4], d2[4];
#pragma unroll
        for (int q = 0; q < 2; ++q) { const int itq = it + q * NGW; const int ic = itq < 2 * I_L ? itq : it; const int l = ic / I_L; int r = ic - l * I_L;
            if (r < I_OUT) { const int nb = r >> 4, kb = r & 15, k0 = kb * 64, n0 = nb * 32; Ws[q] = w_out + ((size_t)l * 1024 + k0) * 1024 + n0; Ns[q] = 1024; Ks[q] = 1024;
                Wd[q] = (bf16_t*)(ws + cfg::WS_WOUT + l * cfg::SZ_WOUT) + (size_t)n0 * 1024 + k0; }
            else { r -= I_OUT; const int nb = r / 44, kb = r - nb * 44, k0 = kb * 64, n0 = nb * 32; Ws[q] = wd + ((size_t)l * cfg::FF + k0) * 1024 + n0; Ns[q] = 1024; Ks[q] = cfg::FF;
                Wd[q] = (bf16_t*)(ws + cfg::WS_WDN + l * cfg::SZ_WDN) + (size_t)n0 * cfg::FF + k0; } }
        tile_dma(Ws[0], Ns[0], scr, lane); tile_dma(Ws[1], Ns[1], scr1, lane);
        asm volatile("s_waitcnt vmcnt(0)" ::: "memory");
        tile_emit<false, 32>(Ks[0], Wd[0], (const float*)nullptr, (const float*)nullptr, d1, d2, scr, lane);
        if (it + NGW < 2 * I_L) tile_emit<false, 32>(Ks[1], Wd[1], (const float*)nullptr, (const float*)nullptr, d1, d2, scr1, lane);
    }
    const int xw = (vcu - 64) * 8 + wave, NXW = (G - 64) * 8;
    if (vcu >= 64 && G > 64)
    for (int m = xw; m < cfg::T; m += 4 * NXW) {
        f32x4 v[4][4];
#pragma unroll
        for (int q = 0; q < 4; ++q) { const int mr = (m + q * NXW) < cfg::T ? (m + q * NXW) : m; const f32x4* xr = (const f32x4*)(x + (size_t)mr * 1024) + lane;
#pragma unroll
            for (int j = 0; j < 4; ++j) v[q][j] = xr[64 * j]; }
#pragma unroll
        for (int q = 0; q < 4; ++q) { const int mr = (m + q * NXW) < cfg::T ? (m + q * NXW) : m; unsigned long long* o8 = (unsigned long long*)((bf16_t*)(ws + cfg::WS_XB) + (size_t)mr * 1024) + lane;
#pragma unroll
            for (int j = 0; j < 4; ++j) o8[64 * j] = (unsigned long long)pk2(v[q][j][0], v[q][j][1]) | ((unsigned long long)pk2(v[q][j][2], v[q][j][3]) << 32); } }
    for (int i = gw * 64 + lane; i < 2048 * 32; i += NGW * 64) { const int pos = i >> 5, f = i & 31; const float inv = exp2f(-(float)f * (13.287712379549449f / 32.f)); const float ang = (float)pos * inv;
        double rv = (double)ang * 0.15915494309189535; rv -= floor(rv); const float rev = (float)rv;
        ((float*)(ws + cfg::V_ROPEC))[i] = __builtin_amdgcn_cosf(rev); ((float*)(ws + cfg::V_ROPES))[i] = __builtin_amdgcn_sinf(rev); }
}
#undef PLAS
}
constexpr int NWAVES = 8;
constexpr int RING_OFF = 0, RING_BYTES = 131072;
constexpr int LDSCTL_OFF = RING_BYTES, MISC_OFF = LDSCTL_OFF + 320;
constexpr int LDS_BYTES = 147456;
constexpr int CW_BAR = 4096;
constexpr size_t CTL_ZERO_BYTES = 64 * 1024;
#define GAS __attribute__((address_space(1)))
#define LAS __attribute__((address_space(3)))
typedef GAS unsigned gu32;
#define RLX_AGENT __ATOMIC_RELAXED, __HIP_MEMORY_SCOPE_AGENT
#define XB_TMO      128
#define XB_XCNT(j)  (256  + 64 * (j))
#define XB_XSUB(j)  (1280 + 64 * (j))
#define XB_XGEN(j)  (2304 + 64 * (j))
#define XB_TOP      3328
#define XB_TOPGEN   3392
#define XCD_BAR_WORDS 3456
#define XB_SPIN_CAP (1u << 18)

__device__ __forceinline__ unsigned xb_ld(unsigned* p)              { return __hip_atomic_load(p, __ATOMIC_RELAXED, __HIP_MEMORY_SCOPE_AGENT); }
__device__ __forceinline__ unsigned xb_add(unsigned* p, unsigned v) { return __hip_atomic_fetch_add(p, v, __ATOMIC_RELAXED, __HIP_MEMORY_SCOPE_AGENT); }
__device__ __forceinline__ unsigned xb_xcc_id() { return (unsigned)__builtin_amdgcn_s_getreg((3 << 11) | 20) & 0xFu; }
#define XB_SPIN(cond, bar) do { unsigned _sp = 0; while (cond) { __builtin_amdgcn_s_sleep(1); \
    if ((++_sp & 255u) == 0u) { if (xb_ld(&(bar)[XB_TMO])) break; if (_sp > XB_SPIN_CAP) { atomicAdd(&(bar)[XB_TMO], 1u); break; } } } } while (0)

struct XcdBarrier {
    unsigned* bar; unsigned x;
    volatile LAS unsigned* st;
};

__device__ __forceinline__ XcdBarrier xcd_barrier_post(unsigned* bar, volatile LAS unsigned* st) {
    XcdBarrier b; b.bar = bar; b.x = xb_xcc_id(); b.st = st;
    if (threadIdx.x == 0) (void)xb_add(&bar[XB_XCNT(b.x)], 1u);
    return b;
}
__device__ __forceinline__ void xcd_barrier_complete(unsigned* bar, unsigned x, unsigned& nloc, unsigned& nx) {
    const unsigned G = gridDim.x * gridDim.y * gridDim.z;
    unsigned sum, cnt, mine, sp = 0u;
    for (;;) {
        sum = 0u; cnt = 0u; mine = 0u;
#pragma unroll
        for (unsigned j = 0; j < 16; ++j) { const unsigned c = xb_ld(&bar[XB_XCNT(j)]); sum += c; cnt += (c > 0u) ? 1u : 0u; mine = (j == x) ? c : mine; }
        if (sum == G) break;
        __builtin_amdgcn_s_sleep(1);
        if ((++sp & 255u) == 0u) { if (xb_ld(&bar[XB_TMO])) break; if (sp > XB_SPIN_CAP) { atomicAdd(&bar[XB_TMO], 1u); break; } }
    }
    nloc = mine > 0u ? mine : 1u; nx = cnt > 0u ? cnt : 1u;
}

__device__ __forceinline__ void xcd_barrier(const XcdBarrier& b) {
    asm volatile("s_waitcnt vmcnt(0)" ::: "memory");
    __syncthreads();
    if (threadIdx.x == 0) {
        unsigned* bar = b.bar;
        __builtin_amdgcn_s_waitcnt(0);
        unsigned nloc = b.st[0], nx = b.st[1];
        if (nloc == 0u) { xcd_barrier_complete(bar, b.x, nloc, nx); b.st[0] = nloc; b.st[1] = nx; }
        const unsigned old = xb_add(&bar[XB_XSUB(b.x)], 1u);
        const unsigned gen = old / nloc;
        if (old + 1u == (gen + 1u) * nloc) {
            __builtin_amdgcn_fence(__ATOMIC_RELEASE, "agent");
            asm volatile("s_waitcnt vmcnt(0)" ::: "memory");
            const unsigned og = xb_add(&bar[XB_TOP], 1u);
            const unsigned tg = og / nx;
            if (og + 1u == (tg + 1u) * nx) xb_add(&bar[XB_TOPGEN], 1u);
            else XB_SPIN(xb_ld(&bar[XB_TOPGEN]) == tg, bar);
            __builtin_amdgcn_fence(__ATOMIC_ACQUIRE, "agent");
            xb_add(&bar[XB_XGEN(b.x)], 1u);
            asm volatile("s_waitcnt vmcnt(0)" ::: "memory");
        } else {
            XB_SPIN(xb_ld(&bar[XB_XGEN(b.x)]) == gen, bar);
            __builtin_amdgcn_fence(__ATOMIC_ACQUIRE, "agent");
            asm volatile("s_waitcnt vmcnt(0)" ::: "memory");
        }
    }
    __syncthreads();
}


enum { PH_PRO = 0, PH_IN = 1, PH_ATT = 2, PH_MIXB = 3, PH_OUT = 4, PH_GU = 5, PH_DN = 6, PH_FIN = 13, N_PHASES = 14 };
struct MArgs { const float* in[16]; float* out; unsigned char* ws; int ph_lo, ph_hi, li, pad; };

__global__ void __launch_bounds__(NWAVES * 64, 2) mk_fwd(MArgs a) {
    extern __shared__ __attribute__((aligned(16))) unsigned char lds[];
    LAS unsigned char* ldsl = (LAS unsigned char*)lds;
    volatile LAS unsigned* MISC = (volatile LAS unsigned*)(ldsl + MISC_OFF);
    const int tid = threadIdx.x;
    const int G = gridDim.x, bx = blockIdx.x, vcu = (G % 8 == 0) ? (bx % 8) * (G / 8) + bx / 8 : bx;
    unsigned char* ws = a.ws;
    for (int u = tid; u < (LDS_BYTES - LDSCTL_OFF) / 4; u += NWAVES * 64) ((LAS unsigned*)(ldsl + LDSCTL_OFF))[u] = 0u;
    __syncthreads();
    XcdBarrier bar; bar.bar = (unsigned*)(ws + WS_CTL) + CW_BAR + a.li * XCD_BAR_WORDS; bar.x = 0; bar.st = nullptr;
    if (a.ph_hi - a.ph_lo > 1) bar = xcd_barrier_post((unsigned*)(ws + WS_CTL) + CW_BAR + a.li * XCD_BAR_WORDS, MISC + 8);
    const int G0 = G, bx0 = bx, vcu0 = vcu; unsigned char* const ws0 = ws;
    for (int ph = a.ph_lo; ph < a.ph_hi; ++ph) {
        int G = G0, bx = bx0, vcu = vcu0; unsigned zo = 0u; asm volatile("" : "+s"(G), "+s"(bx), "+s"(vcu), "+s"(zo)); unsigned char* ws = ws0 + zo;
        const int l = (ph >= 1 && ph <= 12) ? (ph - 1) / 6 : 0;
        const int kind = (ph == 0) ? PH_PRO : (ph == PH_FIN ? PH_FIN : 1 + (ph - 1) % 6);
        if (kind == PH_PRO) {
            { pro::Inputs pin{a.in[0], a.in[1], a.in[4], a.in[5], a.in[8], a.in[9], a.in[10], a.in[11], a.in[12], a.in[13], a.in[14], a.in[15]}; pro::prologue(ws, pin, ldsl + RING_OFF, vcu, G); }
        } else if (kind == PH_IN) {
            pg8::Gemm g{(const bf16_t*)(ws + WS_XB), (const bf16_t*)(ws + WS_WIN + l * SZ_WIN), T, NIN, D}; pg8::StaticOrder S; S.init(T, NIN, G, bx);
            pg8::FEpiIn E{ws, a.in[6] + l * 256, l};
            pg8::gemm_phase<pg8::FEpiIn, pg8::StaticOrder, true, true>(ldsl + RING_OFF, g, S, E);
        } else if (kind == PH_ATT) {
            for (int i = 0; i < 2; ++i) { const int idx = vcu * 2 + i; if (idx >= 512) break; const int bh = idx >> 4, qb = idx & 15;
                att::attn_unit(bh >> 2, bh & 3, qb, (const bf16_t*)(ws + WS_Q), (const bf16_t*)(ws + WS_K), (const bf16_t*)(ws + WS_V), (bf16_t*)(ws + WS_OC), a.in[2] + l * 256, a.in[3] + l * 128, l, (char*)lds + RING_OFF); }
            for (int i = 0; i < 2; ++i) { const int it = vcu * 2 + i; if (it >= 512) break;
                                fft::stage1_item(it >> 6, it & 63, (const bf16_t*)(ws + WS_TAB), (bf16_t*)(ws + WS_XT), ldsl + RING_OFF); }

            if (vcu < 256) gla::gla_a_item(vcu >> 5, (vcu >> 3) & 3, vcu & 7, ws, ldsl + RING_OFF);
        } else if (kind == PH_MIXB) {
            if (vcu < 256) fft::stage2_item(vcu >> 5, vcu & 31, (const bf16_t*)(ws + WS_XT), (bf16_t*)(ws + WS_OC), ldsl + RING_OFF);
            if (vcu < 256) gla::gla_b_item(vcu >> 5, (vcu >> 3) & 3, vcu & 7, ws, a.in[7] + l * 64, (bf16_t*)(ws + WS_OC), ldsl + RING_OFF);
        } else if (kind == PH_OUT) {
            pg8::Gemm g{(const bf16_t*)(ws + WS_OC), (const bf16_t*)(ws + WS_WOUT + l * SZ_WOUT), T, D, D}; pg8::StaticOrder S; S.init(T, D, G, bx);
            pg8::FEpiRes E{l ? (const float*)(ws + WS_ST2) : (const float*)nullptr, a.in[14] + (l ? l - 1 : 0) * 1024, a.in[15] + (l ? l - 1 : 0) * 1024, (bf16_t*)(ws + WS_XB), (float*)(ws + WS_ST1)};
            pg8::gemm_phase<pg8::FEpiRes, pg8::StaticOrder, true, true>(ldsl + RING_OFF, g, S, E);
        } else if (kind == PH_GU) {
            pg8::Gemm g{(const bf16_t*)(ws + WS_XB), (const bf16_t*)(ws + WS_WGU + l * SZ_WGU), T, NGU, D}; pg8::StaticOrder S; S.init(T, NGU, G, bx);
            pg8::FEpiGU E{(const float*)(ws + WS_ST1), (const float*)(ws + V_C1GU) + l * NGU, (const float*)(ws + V_C2GU) + l * NGU, (bf16_t*)(ws + WS_ACT)};
            pg8::gemm_phase<pg8::FEpiGU, pg8::StaticOrder, true, true>(ldsl + RING_OFF, g, S, E);
        } else if (kind == PH_DN) {
            pg8::Gemm g{(const bf16_t*)(ws + WS_ACT), (const bf16_t*)(ws + WS_WDN + l * SZ_WDN), T, D, FF}; pg8::StaticOrder S; S.init(T, D, G, bx);
            pg8::FEpiRes E{(const float*)(ws + WS_ST1), a.in[9] + l * 1024, a.in[10] + l * 1024, (bf16_t*)(ws + WS_XB), (float*)(ws + WS_ST2)};
            pg8::gemm_phase<pg8::FEpiRes, pg8::StaticOrder, true, true>(ldsl + RING_OFF, g, S, E);
        } else if (kind == PH_FIN) {
            const float* g2 = a.in[14] + 1024; const float* b2v = a.in[15] + 1024; const float* ST2 = (const float*)(ws + WS_ST2); const bf16_t* XB = (const bf16_t*)(ws + WS_XB); float* Y2 = a.out;
            int tid_f = threadIdx.x; asm volatile("" : "+v"(tid_f)); const int lane = tid_f & 63, wave = __builtin_amdgcn_readfirstlane(tid_f >> 6);
            typedef float f32x4 __attribute__((ext_vector_type(4))); typedef unsigned u32x2 __attribute__((ext_vector_type(2)));
            f32x4 gg[4], bq[4];
#pragma unroll
            for (int j = 0; j < 4; ++j) { gg[j] = *((const f32x4*)g2 + lane + 64 * j); bq[j] = *((const f32x4*)b2v + lane + 64 * j); }
            for (int row = vcu * NWAVES + wave; row < T; row += G * NWAVES) { const RowStat rs = row_stat(ST2, row);
                const u32x2* xr = (const u32x2*)(XB + (size_t)row * 1024) + lane; f32x4* yr = (f32x4*)(Y2 + (size_t)row * 1024) + lane;
#pragma unroll
                for (int j = 0; j < 4; ++j) { const u32x2 w = xr[64 * j]; const f32x4 v = {__uint_as_float(w.x << 16), __uint_as_float(w.x & 0xffff0000u), __uint_as_float(w.y << 16), __uint_as_float(w.y & 0xffff0000u)};
                    yr[64 * j] = (v - rs.mu) * rs.rstd * gg[j] + bq[j]; } }
        }
        if (ph + 1 < a.ph_hi) xcd_barrier(bar);
    }
}

static void launch_frame(const MArgs& base, int lo, int hi, int grid, hipStream_t stream, int li = 0) {
    MArgs a = base; a.ph_lo = lo; a.ph_hi = hi; a.li = li;
    hipLaunchKernelGGL(mk_fwd, dim3(grid), dim3(NWAVES * 64), LDS_BYTES, stream, a);
}
extern "C" void kernel_launch(void* const* d_in, const int* in_sizes, int n_in, void* d_out, int out_size, void* d_ws, size_t ws_size, hipStream_t stream) {
    static int grid = 0;
    if (grid == 0) {
        if (n_in != 16 || in_sizes[0] != T * D || out_size != T * D || ws_size < WS_END) { fprintf(stderr, "kernel_launch: unexpected shapes (n_in %d, in0 %d, out %d, ws %zu)\n", n_in, n_in > 0 ? in_sizes[0] : -1, out_size, ws_size); grid = -1; return; }
        int dev = 0, cus = 0, per_cu = 0;
        if (hipGetDevice(&dev) != hipSuccess || hipDeviceGetAttribute(&cus, hipDeviceAttributeMultiprocessorCount, dev) != hipSuccess) { grid = -1; return; }
        if (hipFuncSetAttribute((const void*)mk_fwd, hipFuncAttributeMaxDynamicSharedMemorySize, LDS_BYTES) != hipSuccess) { fprintf(stderr, "kernel_launch: hipFuncSetAttribute failed\n"); grid = -1; return; }
        if (hipOccupancyMaxActiveBlocksPerMultiprocessor(&per_cu, (const void*)mk_fwd, NWAVES * 64, LDS_BYTES) != hipSuccess || per_cu < 1) { fprintf(stderr, "kernel_launch: occupancy query says %d workgroups per CU\n", per_cu); per_cu = 1; }
        (void)hipGetLastError();
        grid = cus;
        if (grid != 256) { fprintf(stderr, "kernel_launch: this kernel's work split is built for the 256 CUs of an MI355X, found %d; nothing launched\n", cus); grid = -1; return; }
    }
    if (grid < 0) return;
    const float* x = (const float*)d_in[0]; const float* w_in = (const float*)d_in[1]; const float* dlam = (const float*)d_in[2]; const float* dng = (const float*)d_in[3];
    const float* fw = (const float*)d_in[4]; const float* gw2 = (const float*)d_in[5]; const float* gb2 = (const float*)d_in[6]; const float* gng = (const float*)d_in[7];
    const float* w_out = (const float*)d_in[8]; const float* ln1g = (const float*)d_in[9]; const float* ln1b = (const float*)d_in[10];
    const float* wg = (const float*)d_in[11]; const float* wu = (const float*)d_in[12]; const float* wd = (const float*)d_in[13]; const float* ln2g = (const float*)d_in[14]; const float* ln2b = (const float*)d_in[15];
    char* ws = (char*)d_ws;
    float* ropec = (float*)(ws + V_ROPEC); float* ropes = (float*)(ws + V_ROPES); float* MF = (float*)(ws + V_MF);
    float* c1in = (float*)(ws + V_C1IN); float* c2in = (float*)(ws + V_C2IN); float* c1gu = (float*)(ws + V_C1GU); float* c2gu = (float*)(ws + V_C2GU);
    bf16_t* TAB = (bf16_t*)(ws + WS_TAB); bf16_t* XB = (bf16_t*)(ws + WS_XB);
    bf16_t* Q = (bf16_t*)(ws + WS_Q); bf16_t* K = (bf16_t*)(ws + WS_K); bf16_t* V = (bf16_t*)(ws + WS_V);
    bf16_t* GQK = (bf16_t*)(ws + WS_GQK); bf16_t* GV = (bf16_t*)(ws + WS_GV); bf16_t* GR = (bf16_t*)(ws + WS_GR); float* GL = (float*)(ws + WS_GL);
    bf16_t* OC = (bf16_t*)(ws + WS_OC); float* OF = (float*)(ws + WS_OF);
    (void)hipMemsetAsync(ws + WS_CTL, 0, CTL_ZERO_BYTES, stream);
    MArgs base{}; for (int i = 0; i < 16; ++i) base.in[i] = (const float*)d_in[i]; base.out = (float*)d_out; base.ws = (unsigned char*)d_ws;
    launch_frame(base, 0, N_PHASES, grid, stream, 0);
}
```

```cpp
#include <hip/hip_runtime.h>
#include <cstdint>
#include <cstdio>
#include <cmath>

typedef unsigned short bf16_t;
namespace cfg {
constexpr int B = 8, S = 2048, D = 1024, T = B * S, L = 2;
constexpr int INW = 2592, NIN = 3072, FF = 2816, NGU = 2 * FF;
constexpr float ALPHA = 1.41421356237309515f;
constexpr float EPS = 1e-5f;
constexpr float QSCALE = 0.125f * 1.4426950408889634f;
constexpr float GQSCALE = 0.17677669529663687f;
constexpr size_t MiB = 1u << 20;
constexpr size_t WS_CTL = 0;
constexpr size_t WS_VEC = 1 * MiB;
constexpr size_t V_ROPEC = WS_VEC, V_ROPES = WS_VEC + 256 * 1024, V_MF = WS_VEC + 512 * 1024;
constexpr size_t V_C1IN = WS_VEC + 768 * 1024, V_C2IN = V_C1IN + 24 * 1024, V_C1GU = V_C2IN + 24 * 1024, V_C2GU = V_C1GU + 44 * 1024;
constexpr size_t WS_WIN = 2 * MiB, WS_WOUT = 14 * MiB, WS_WGU = 18 * MiB, WS_WDN = 40 * MiB, WS_TAB = 51 * MiB;
constexpr size_t SZ_WIN = 6 * MiB, SZ_WOUT = 2 * MiB, SZ_WGU = 11 * MiB, SZ_WDN = 5632 * 1024;
constexpr size_t WS_XB = 67 * MiB;
constexpr size_t WS_Y1 = 99 * MiB, WS_Q = 99 * MiB, WS_K = 115 * MiB, WS_V = 131 * MiB, WS_XT = 147 * MiB;
constexpr size_t WS_ACT = 163 * MiB, WS_GQK = 163 * MiB, WS_GV = 171 * MiB, WS_GR = 179 * MiB, WS_GL = 187 * MiB, WS_OC = 203 * MiB, WS_OF = 235 * MiB;
constexpr size_t WS_ST1 = 251 * MiB, WS_ST2 = 253 * MiB, WS_DEC = 255 * MiB, WS_END = 256 * MiB;
}
using namespace cfg;

__device__ __forceinline__ float bf2f(bf16_t v) { return __uint_as_float((unsigned)v << 16); }
__device__ __forceinline__ bf16_t f2bf(float f) { unsigned u = __float_as_uint(f); return (bf16_t)((u + 0x7fffu + ((u >> 16) & 1u)) >> 16); }


template <int M> __device__ __forceinline__ float xadd(float v) {
    if constexpr (M == 32) { auto r = __builtin_amdgcn_permlane32_swap(__float_as_uint(v), __float_as_uint(v), false, false); return __uint_as_float(r[0]) + __uint_as_float(r[1]); }
    else return v + __int_as_float(__builtin_amdgcn_ds_swizzle(__float_as_int(v), (M << 10) | 0x1f));
}
struct RowStat { float mu, rstd; };
__device__ __forceinline__ RowStat row_stat(const float* ST, int row) {
    float s = 0.f, ss = 0.f;
    for (int i = 0; i < 8; ++i) { const float4 a = *(const float4*)(ST + (size_t)row * 32 + 4 * i); s += a.x + a.z; ss += a.y + a.w; }
    const float mu = s * (1.f / 1024.f); const float var = ss * (1.f / 1024.f) - mu * mu;
    RowStat r; r.mu = mu; r.rstd = rsqrtf(fmaxf(var, 0.f) + EPS); return r;
}
namespace pg8 {
#define PG8_LAS __attribute__((address_space(3)))
typedef unsigned short bf16_t;
typedef short bf16x8 __attribute__((ext_vector_type(8)));
typedef float f32x4 __attribute__((ext_vector_type(4)));
typedef unsigned u32x4 __attribute__((ext_vector_type(4)));
constexpr int BM = 256, BK = 64, HALF = 128, HTB = HALF * BK * 2  , STAGE_BYTES = 8 * HTB, NXCD = 8, WGM = 8;

__host__ __device__ __forceinline__ int lds_byte(int r, int c) { const int st = (r >> 4) * 2 + (c >> 5), rr = r & 15, cc = c & 31, ob = rr * 64 + cc * 2; return st * 1024 + (ob ^ (((ob >> 9) & 1) << 5)); }
__host__ __device__ __forceinline__ void stage_rc(int b, int& R, int& C) { const int st = b / 1024, sb = b % 1024, swz = sb ^ (((sb >> 9) & 1) << 5); R = (st >> 1) * 16 + swz / 64; C = (st & 1) * 32 + (swz % 64) / 2; }
__host__ __device__ __forceinline__ int perm32(int rho) { const int n = rho >> 4, i = rho & 15; return 8 * (i >> 2) + 4 * n + (i & 3); }

struct Unit { int pm, pn; };
struct Gemm { const bf16_t* A; const bf16_t* Bt; int M, N, K; };

struct StaticOrder {
    int nM, nN, nwg, G, c;
    __host__ __device__ void init(int M, int N, int G_, int c_) { nM = M / BM; nN = N / BM; nwg = nM * nN; G = G_; c = c_; }
    __host__ __device__ bool next(int i, Unit& u) const {
        const long L = (long)i * G + c; if (L >= nwg) return false;
        int wgid = (int)L; { const int q = nwg / NXCD, r = nwg % NXCD, xcd = wgid % NXCD, off = wgid / NXCD; wgid = (xcd < r ? xcd * (q + 1) : r * (q + 1) + (xcd - r) * q) + off; }
        const int nig = WGM * nN, gid = wgid / nig, fm = gid * WGM, gsz = (nM - fm) < WGM ? (nM - fm) : WGM;
        u.pm = fm + ((wgid % nig) % gsz); u.pn = (wgid % nig) / gsz; return true;
    }
    __device__ __forceinline__ void a_ready(const Unit&) const {}
    __device__ __forceinline__ void done(const Unit&) const {}
};
template <class Epi, class Sched, bool ALIGN_EPI = false, bool SP2 = false>
__device__ __forceinline__ void gemm_phase(PG8_LAS unsigned char* lds, const Gemm g, const Sched& S, const Epi& E) {
    int tid_o = threadIdx.x; asm volatile("" : "+v"(tid_o));
    const int tid = tid_o, wid = __builtin_amdgcn_readfirstlane(tid >> 6), lane = tid & 63, wr = wid >> 2, wc = wid & 3, fr = lane & 15, fq = lane >> 4;
    const int K = g.K, nt = K / BK;
    unsigned voffA[2], voffB[2];
#pragma unroll
    for (int i = 0; i < 2; ++i) { int R, C; stage_rc(tid * 16 + i * 8192, R, C); const int Rb = Epi::PERM ? ((R & ~31) + perm32(R & 31)) : R;
        voffA[i] = (unsigned)(R * K + C) * 2u; voffB[i] = (unsigned)(Rb * K + C) * 2u; }
    const size_t kstep = (size_t)(BK * 2);
    const size_t hstep = (size_t)HALF * K * 2;
    const size_t tstep = 2 * hstep;
    const unsigned ldsw = (unsigned)wid * 1024u;
    const int aoff = lds_byte(wr * 64 + fr, fq * 8), boff = lds_byte(wc * 32 + fr, fq * 8);
#define PG8_SA(b, h) (((b) * 2 + (h)) * HTB)
#define PG8_SB(b, h) ((4 + (b) * 2 + (h)) * HTB)
#define PG8_STAGE(bufoff, gbase, voff) do { _Pragma("unroll") for (int _i = 0; _i < 2; ++_i) \
        __builtin_amdgcn_global_load_lds((const unsigned*)((const char*)(gbase) + (voff)[_i]), (PG8_LAS unsigned*)(lds + (bufoff) + ldsw + _i * 8192), 16, 0, 0); } while (0)
#define PG8_LDA(dst, b, h) do { _Pragma("unroll") for (int m = 0; m < 4; ++m) _Pragma("unroll") for (int k = 0; k < 2; ++k) dst[m][k] = *(const PG8_LAS bf16x8*)(lds + PG8_SA(b, h) + aoff + m * 2048 + k * 1024); } while (0)
#define PG8_LDB(dst, b, h) do { _Pragma("unroll") for (int n = 0; n < 2; ++n) _Pragma("unroll") for (int k = 0; k < 2; ++k) dst[n][k] = *(const PG8_LAS bf16x8*)(lds + PG8_SB(b, h) + boff + n * 2048 + k * 1024); } while (0)
#define PG8_MMA(ai, bj, At, Bt) do { __builtin_amdgcn_s_setprio(1); _Pragma("unroll") for (int m = 0; m < 4; ++m) _Pragma("unroll") for (int n = 0; n < 2; ++n) _Pragma("unroll") for (int k = 0; k < 2; ++k) \
        acc[ai][bj][m][n] = __builtin_amdgcn_mfma_f32_16x16x32_bf16(Bt[n][k], At[m][k], acc[ai][bj][m][n], 0, 0, 0); __builtin_amdgcn_s_setprio(0); } while (0)
#define PG8_WAIT_V(n) asm volatile("s_waitcnt vmcnt(" #n ")" ::: "memory")
#define PG8_WAIT_L(n) asm volatile("s_waitcnt lgkmcnt(" #n ")" ::: "memory")
#define PG8_BAR __builtin_amdgcn_s_barrier()
#define PG8_SCHED __builtin_amdgcn_sched_barrier(0)
    Unit cur, nxt; int ui = 0;
    if (!S.next(0, cur)) return;
    f32x4 acc[2][2][4][2];
#pragma unroll
    for (int a = 0; a < 2; ++a)
#pragma unroll
        for (int b = 0; b < 2; ++b)
#pragma unroll
            for (int m = 0; m < 4; ++m)
#pragma unroll
                for (int n = 0; n < 2; ++n) acc[a][b][m][n] = (f32x4){0.f, 0.f, 0.f, 0.f};
    bf16x8 At[4][2], B0[2][2], B1[2][2];
    const char* cA = (const char*)g.A + (size_t)cur.pm * tstep; const char* cB = (const char*)g.Bt + (size_t)cur.pn * tstep;
    S.a_ready(cur);
    if constexpr (SP2) {
        PG8_STAGE(PG8_SB(0, 0), cB, voffB); PG8_STAGE(PG8_SB(0, 1), cB + hstep, voffB); PG8_STAGE(PG8_SA(0, 0), cA, voffA); PG8_STAGE(PG8_SA(0, 1), cA + hstep, voffA);
        if (wr == 1) PG8_BAR;
        PG8_WAIT_V(2); PG8_BAR;
        PG8_STAGE(PG8_SB(1, 0), cB + kstep, voffB); PG8_STAGE(PG8_SA(1, 0), cA + kstep, voffA); PG8_STAGE(PG8_SB(1, 1), cB + hstep + kstep, voffB);
        PG8_WAIT_V(6); PG8_BAR;
    } else {
        PG8_STAGE(PG8_SB(0, 0), cB, voffB); PG8_STAGE(PG8_SA(0, 0), cA, voffA); PG8_STAGE(PG8_SB(0, 1), cB + hstep, voffB); PG8_STAGE(PG8_SA(0, 1), cA + hstep, voffA);
        if (wr == 1) PG8_BAR;
        PG8_WAIT_V(4); PG8_BAR;
        PG8_STAGE(PG8_SB(1, 0), cB + kstep, voffB); PG8_STAGE(PG8_SA(1, 0), cA + kstep, voffA); PG8_STAGE(PG8_SB(1, 1), cB + hstep + kstep, voffB);
        PG8_WAIT_V(6); PG8_BAR;
    }
    for (;;) {
        const bool has_next = S.next(ui + 1, nxt);
        const char* nA = has_next ? (const char*)g.A + (size_t)nxt.pm * tstep : cA; const char* nB = has_next ? (const char*)g.Bt + (size_t)nxt.pn * tstep : cB;
        for (int t = 0; t < nt; t += 2) {
            const bool last = (t == nt - 2);
            const char* a1 = cA + (size_t)(t + 1) * kstep;
            const char* a2 = last ? nA : cA + (size_t)(t + 2) * kstep; const char* b2 = last ? nB : cB + (size_t)(t + 2) * kstep;
            const char* a3 = a2 + kstep; const char* b3 = b2 + kstep;
            if (last && has_next) S.a_ready(nxt);
            if constexpr (SP2) {
            PG8_LDB(B0, 0, 0); PG8_LDB(B1, 0, 1); PG8_SCHED; PG8_LDA(At, 0, 0); PG8_STAGE(PG8_SA(1, 1), a1 + hstep, voffA);
            PG8_WAIT_V(8); PG8_WAIT_L(0); PG8_BAR; PG8_MMA(0, 0, At, B0); PG8_MMA(0, 1, At, B1); PG8_BAR; PG8_SCHED;
            PG8_LDA(At, 0, 1); PG8_STAGE(PG8_SB(0, 0), b2, voffB); PG8_STAGE(PG8_SB(0, 1), b2 + hstep, voffB); PG8_STAGE(PG8_SA(0, 0), a2, voffA);
            PG8_WAIT_V(8); PG8_WAIT_L(0); PG8_BAR; PG8_MMA(1, 0, At, B0); PG8_MMA(1, 1, At, B1); PG8_BAR; PG8_SCHED;
            PG8_LDB(B0, 1, 0); PG8_LDB(B1, 1, 1); PG8_SCHED; PG8_LDA(At, 1, 0); PG8_STAGE(PG8_SA(0, 1), a2 + hstep, voffA);
            PG8_WAIT_V(8); PG8_WAIT_L(0); PG8_BAR; PG8_MMA(0, 0, At, B0); PG8_MMA(0, 1, At, B1); PG8_BAR; PG8_SCHED;
            PG8_LDA(At, 1, 1); PG8_STAGE(PG8_SB(1, 0), b3, voffB); PG8_STAGE(PG8_SB(1, 1), b3 + hstep, voffB); PG8_STAGE(PG8_SA(1, 0), a3, voffA);
            PG8_WAIT_V(8); PG8_WAIT_L(0); PG8_BAR; PG8_MMA(1, 0, At, B0); PG8_MMA(1, 1, At, B1); PG8_BAR; PG8_SCHED;
            } else {
            PG8_LDB(B0, 0, 0); PG8_SCHED; PG8_LDA(At, 0, 0); PG8_STAGE(PG8_SA(1, 1), a1 + hstep, voffA);
            PG8_WAIT_L(8); PG8_BAR; PG8_WAIT_L(0); PG8_MMA(0, 0, At, B0); PG8_BAR; PG8_SCHED;
            PG8_LDB(B1, 0, 1); PG8_STAGE(PG8_SB(0, 0), b2, voffB);
            PG8_BAR; PG8_WAIT_L(0); PG8_MMA(0, 1, At, B1); PG8_BAR;
            PG8_LDA(At, 0, 1); PG8_STAGE(PG8_SA(0, 0), a2, voffA);
            PG8_BAR; PG8_WAIT_L(0); PG8_MMA(1, 0, At, B0); PG8_BAR; PG8_SCHED;
            PG8_STAGE(PG8_SB(0, 1), b2 + hstep, voffB);
            PG8_WAIT_V(6); PG8_BAR; PG8_MMA(1, 1, At, B1); PG8_BAR;
            PG8_LDB(B0, 1, 0); PG8_SCHED; PG8_LDA(At, 1, 0); PG8_STAGE(PG8_SA(0, 1), a2 + hstep, voffA);
            PG8_WAIT_L(8); PG8_BAR; PG8_WAIT_L(0); PG8_MMA(0, 0, At, B0); PG8_BAR; PG8_SCHED;
            PG8_LDB(B1, 1, 1); PG8_STAGE(PG8_SB(1, 0), b3, voffB);
            PG8_BAR; PG8_WAIT_L(0); PG8_MMA(0, 1, At, B1); PG8_BAR;
            PG8_LDA(At, 1, 1); PG8_STAGE(PG8_SA(1, 0), a3, voffA);
            PG8_BAR; PG8_WAIT_L(0); PG8_MMA(1, 0, At, B0); PG8_BAR; PG8_SCHED;
            PG8_STAGE(PG8_SB(1, 1), b3 + hstep, voffB);
            PG8_WAIT_V(6); PG8_BAR; PG8_MMA(1, 1, At, B1); PG8_BAR;
            }
        }
        if constexpr (ALIGN_EPI) { if (wr == 0) PG8_BAR; }
        if constexpr (!Epi::AFTER_DRAIN) { E(acc, cur, wr, wc, fr, fq); S.done(cur); }
        if (!has_next) break;
#pragma unroll
        for (int a = 0; a < 2; ++a)
#pragma unroll
            for (int b = 0; b < 2; ++b)
#pragma unroll
                for (int m = 0; m < 4; ++m)
#pragma unroll
                    for (int n = 0; n < 2; ++n) acc[a][b][m][n] = (f32x4){0.f, 0.f, 0.f, 0.f};
        cur = nxt; cA = nA; cB = nB; ++ui;
        if constexpr (ALIGN_EPI) { if (wr == 1) PG8_BAR; }
    }
    PG8_WAIT_V(0);
    if constexpr (!ALIGN_EPI) { if (wr == 0) PG8_BAR; }
    PG8_BAR;
    if constexpr (Epi::AFTER_DRAIN) { E.fused(acc, cur, wr, wc, fr, fq, lds, wid, lane); S.done(cur); }
#undef PG8_SA
#undef PG8_SB
#undef PG8_STAGE
#undef PG8_LDA
#undef PG8_LDB
#undef PG8_MMA
#undef PG8_WAIT_V
#undef PG8_WAIT_L
#undef PG8_BAR
#undef PG8_SCHED
}
}
namespace pg8 {
__device__ __forceinline__ unsigned cvt_pk_bf16(float lo, float hi) { unsigned r; asm volatile("v_cvt_pk_bf16_f32 %0, %1, %2" : "=v"(r) : "v"(lo), "v"(hi)); return r; }
__device__ __forceinline__ void st8(bf16_t* p, const f32x4 a, const f32x4 b) { u32x4 w; w.x = cvt_pk_bf16(a[0], a[1]); w.y = cvt_pk_bf16(a[2], a[3]); w.z = cvt_pk_bf16(b[0], b[1]); w.w = cvt_pk_bf16(b[2], b[3]); *(u32x4*)p = w; }
__device__ __forceinline__ void st8nt(bf16_t* p, const f32x4 a, const f32x4 b) { u32x4 w; w.x = cvt_pk_bf16(a[0], a[1]); w.y = cvt_pk_bf16(a[2], a[3]); w.z = cvt_pk_bf16(b[0], b[1]); w.w = cvt_pk_bf16(b[2], b[3]); __builtin_nontemporal_store(w, (u32x4*)p); }
struct RS { float a, b; };
struct StatLd { f32x4 x, y; };
__device__ __forceinline__ StatLd stat_load(const float* ST, int row, int fq) { const f32x4* p = (const f32x4*)(ST + (size_t)row * 32 + fq * 8); StatLd r; r.x = p[0]; r.y = p[1]; return r; }
__device__ __forceinline__ RS stat_fin(const StatLd& t) {
    float s = (t.x[0] + t.x[2]) + (t.y[0] + t.y[2]), ss = (t.x[1] + t.x[3]) + (t.y[1] + t.y[3]);
    s = xadd<16>(s); ss = xadd<16>(ss); s = xadd<32>(s); ss = xadd<32>(ss);
    const float mu = s * (1.f / 1024.f), var = ss * (1.f / 1024.f) - mu * mu, rstd = rsqrtf(fmaxf(var, 0.f) + cfg::EPS);
    RS r; r.a = rstd; r.b = -rstd * mu; return r;
}
__device__ __forceinline__ RS row_stat16(const float* ST, int row, int fq) { return stat_fin(stat_load(ST, row, fq)); }
__device__ __forceinline__ float fsilu(float x) { return x * __builtin_amdgcn_rcpf(1.f + __expf(-x)); }
__device__ __forceinline__ float flogsig16(float x) { return (fminf(x, 0.f) - __logf(1.f + __expf(-fabsf(x)))) * (1.f / 16.f); }

struct FEpiIn {
    static constexpr bool PERM = true, AFTER_DRAIN = false;
    unsigned char* ws; const float* b2; int l;
    struct RowLd { StatLd t; f32x4 rc[2], rsn[2]; };
    template <int KIND> __device__ __forceinline__ RowLd load_row(const float* st, int row, int fq) const {
        RowLd r; if constexpr (KIND != 0) { if (st) r.t = stat_load(st, row, fq); }
        if constexpr (KIND == 0) { const int pos = row & 2047; const float* cp = (const float*)(ws + cfg::V_ROPEC) + pos * 32 + 8 * fq; const float* sp = (const float*)(ws + cfg::V_ROPES) + pos * 32 + 8 * fq;
            r.rc[0] = *(const f32x4*)cp; r.rc[1] = *(const f32x4*)(cp + 4); r.rsn[0] = *(const f32x4*)sp; r.rsn[1] = *(const f32x4*)(sp + 4); }
        return r;
    }
    template <int KIND> __device__ __forceinline__ void rows(const f32x4 (&acc)[2][2][4][2], const Unit& u, int wr, int wc, int fr, int fq) const {
        const int pn = u.pn, cw = 32 * wc + 8 * fq, row0 = u.pm * BM + 64 * wr + fr;
        const float* st = l ? (const float*)(ws + cfg::WS_ST2) : (const float*)nullptr;
        f32x4 k1[2][2], k2[2][2], bias[2][2];
        const float qs = __uint_as_float(__builtin_amdgcn_readfirstlane(__float_as_uint(pn < 2 ? cfg::QSCALE : 1.f)));
        RS rsa[8];
        if constexpr (KIND == 0) { if (st) { StatLd t[8];
#pragma unroll
            for (int i = 0; i < 8; ++i) t[i] = stat_load(st, row0 + 128 * (i >> 2) + 16 * (i & 3), fq);
#pragma unroll
            for (int i = 0; i < 8; ++i) rsa[i] = stat_fin(t[i]); } }
        RowLd cur = load_row<KIND>(st, row0, fq), nxt;
        if (st) {
#pragma unroll
            for (int bj = 0; bj < 2; ++bj)
#pragma unroll
                for (int n = 0; n < 2; ++n) {
                    if constexpr (KIND == 2) {
                        const float* fp = (const float*)(ws + cfg::V_MF) + (size_t)(l * 8) * 512 + (pn - 6) * 256 + cw + 128 * bj + 4 * n;
                        k1[bj][n] = (*(const f32x4*)fp + *(const f32x4*)(fp + 1024)) + (*(const f32x4*)(fp + 2048) + *(const f32x4*)(fp + 3072));
                        k2[bj][n] = (*(const f32x4*)(fp + 512) + *(const f32x4*)(fp + 1536)) + (*(const f32x4*)(fp + 2560) + *(const f32x4*)(fp + 3584));
                    } else { const float* c1 = (const float*)(ws + cfg::V_C1IN) + l * cfg::NIN + pn * 256 + cw; const float* c2 = (const float*)(ws + cfg::V_C2IN) + l * cfg::NIN + pn * 256 + cw;
                        k1[bj][n] = *(const f32x4*)(c1 + 128 * bj + 4 * n); k2[bj][n] = *(const f32x4*)(c2 + 128 * bj + 4 * n); } } }
        if constexpr (KIND == 6) {
#pragma unroll
            for (int bj = 0; bj < 2; ++bj)
#pragma unroll
                for (int n = 0; n < 2; ++n) bias[bj][n] = *(const f32x4*)(b2 + 128 * bj + cw + 4 * n); }
#pragma unroll
        for (int i = 0; i < 8; ++i) {
            const int ai = i >> 2, m = i & 3, row = row0 + 128 * ai + 16 * m, pos = row & 2047;
            if (i < 7) nxt = load_row<KIND>(st, row0 + 128 * ((i + 1) >> 2) + 16 * ((i + 1) & 3), fq);
            f32x4 v[2][2];
            if (st) { RS rs; if constexpr (KIND == 0) rs = rsa[i]; else rs = stat_fin(cur.t);
#pragma unroll
                for (int bj = 0; bj < 2; ++bj)
#pragma unroll
                    for (int n = 0; n < 2; ++n) v[bj][n] = rs.a * acc[ai][bj][m][n] + (rs.b * k1[bj][n] + k2[bj][n]);
            } else {
#pragma unroll
                for (int bj = 0; bj < 2; ++bj)
#pragma unroll
                    for (int n = 0; n < 2; ++n) v[bj][n] = acc[ai][bj][m][n]; }
            if constexpr (KIND == 0) {
                f32x4 a0 = v[0][0] * cur.rc[0] - v[1][0] * cur.rsn[0], a1 = v[0][1] * cur.rc[1] - v[1][1] * cur.rsn[1];
                f32x4 b0 = v[1][0] * cur.rc[0] + v[0][0] * cur.rsn[0], b1 = v[1][1] * cur.rc[1] + v[0][1] * cur.rsn[1];
                a0 = a0 * qs; a1 = a1 * qs; b0 = b0 * qs; b1 = b1 * qs;
                bf16_t* dst = (bf16_t*)(ws + (pn < 2 ? cfg::WS_Q : cfg::WS_K)) + (size_t)row * 512 + (4 * (pn & 1) + wc) * 64 + 8 * fq;
                st8(dst, a0, a1); st8(dst + 32, b0, b1);
            } else if constexpr (KIND == 1) {
                bf16_t* dst = (bf16_t*)(ws + cfg::WS_V) + (size_t)row * 512 + (pn - 4) * 256 + cw; st8(dst, v[0][0], v[0][1]); st8(dst + 128, v[1][0], v[1][1]);
            } else if constexpr (KIND == 2) {
                bf16_t* dst = (bf16_t*)(ws + cfg::WS_TAB) + (size_t)row * 512 + (pn - 6) * 256 + cw; st8(dst, v[0][0], v[0][1]); st8(dst + 128, v[1][0], v[1][1]);
            } else if constexpr (KIND == 3) {
                bf16_t* dst = (bf16_t*)(ws + cfg::WS_GQK) + (size_t)row * 256 + cw; st8(dst, v[0][0] * cfg::GQSCALE, v[0][1] * cfg::GQSCALE); st8(dst + 128, v[1][0], v[1][1]);
            } else if constexpr (KIND == 4) {
                bf16_t* dst = (bf16_t*)(ws + cfg::WS_GV) + (size_t)row * 256 + cw; st8(dst, v[0][0], v[0][1]); st8(dst + 128, v[1][0], v[1][1]);
            } else if constexpr (KIND == 5) {
                bf16_t* dst = (bf16_t*)(ws + cfg::WS_GR) + (size_t)row * 256 + cw;
#pragma unroll
                for (int bj = 0; bj < 2; ++bj) { f32x4 x0 = v[bj][0], x1 = v[bj][1];
#pragma unroll
                    for (int e = 0; e < 4; ++e) { x0[e] = fsilu(x0[e]); x1[e] = fsilu(x1[e]); } st8(dst + 128 * bj, x0, x1); }
            } else {
                float* dst = (float*)(ws + cfg::WS_GL) + (size_t)row * 256 + cw;
#pragma unroll
                for (int bj = 0; bj < 2; ++bj)
#pragma unroll
                    for (int n = 0; n < 2; ++n) { f32x4 x = v[bj][n] + bias[bj][n];
#pragma unroll
                        for (int e = 0; e < 4; ++e) x[e] = flogsig16(x[e]); *(f32x4*)(dst + 128 * bj + 4 * n) = x; }
            }
            if (i < 7) cur = nxt;
        }
    }
    __device__ __forceinline__ void operator()(const f32x4 (&acc)[2][2][4][2], const Unit& u, int wr, int wc, int fr, int fq) const {
        asm volatile("" : "+v"(fr), "+v"(fq));
        unsigned zo = 0u; asm volatile("" : "+s"(zo)); FEpiIn me = *this; me.ws = ws + zo;
        const int pn = u.pn;
        if (pn < 4) me.rows<0>(acc, u, wr, wc, fr, fq); else if (pn < 6) me.rows<1>(acc, u, wr, wc, fr, fq); else if (pn < 8) me.rows<2>(acc, u, wr, wc, fr, fq);
        else if (pn == 8) me.rows<3>(acc, u, wr, wc, fr, fq); else if (pn == 9) me.rows<4>(acc, u, wr, wc, fr, fq); else if (pn == 10) me.rows<5>(acc, u, wr, wc, fr, fq); else me.rows<6>(acc, u, wr, wc, fr, fq);
    }
};
struct FEpiRes {
    static constexpr bool PERM = true, AFTER_DRAIN = false;
    const float* stprev; const float* g; const float* bb; bf16_t* XB; float* ST;
    struct RowLd { u32x4 xb[2]; StatLd t; };
    __device__ __forceinline__ RowLd load_row(int row, int col0, int fq) const {
        RowLd r; const size_t off = (size_t)row * 1024 + col0;
        r.xb[0] = *(const u32x4*)(XB + off); r.xb[1] = *(const u32x4*)(XB + off + 128); if (stprev) r.t = stat_load(stprev, row, fq);
        return r;
    }
    __device__ __forceinline__ void operator()(const f32x4 (&acc)[2][2][4][2], const Unit& u, int wr, int wc, int fr, int fq) const {
        asm volatile("" : "+v"(fr), "+v"(fq));
        const int col0 = u.pn * BM + 32 * wc + 8 * fq, row0 = u.pm * BM + 64 * wr + fr;
        f32x4 gv[2][2], bv[2][2];
        RowLd cur = load_row(row0, col0, fq), nxt;
        if (stprev) {
#pragma unroll
            for (int bj = 0; bj < 2; ++bj)
#pragma unroll
                for (int n = 0; n < 2; ++n) { gv[bj][n] = *(const f32x4*)(g + col0 + 128 * bj + 4 * n); bv[bj][n] = *(const f32x4*)(bb + col0 + 128 * bj + 4 * n); } }
#pragma unroll
        for (int i = 0; i < 8; ++i) { const int ai = i >> 2, m = i & 3, row = row0 + 128 * ai + 16 * m; const size_t off = (size_t)row * 1024 + col0;
            if (i < 7) nxt = load_row(row0 + 128 * ((i + 1) >> 2) + 16 * ((i + 1) & 3), col0, fq);
            RS rs; rs.a = 1.f; rs.b = 0.f; if (stprev) rs = stat_fin(cur.t);
            float s = 0.f, ss = 0.f;
#pragma unroll
            for (int bj = 0; bj < 2; ++bj) { f32x4 y[2];
#pragma unroll
                for (int n = 0; n < 2; ++n) { const unsigned w0 = cur.xb[bj][2 * n], w1 = cur.xb[bj][2 * n + 1];
                    f32x4 x = (f32x4){__uint_as_float(w0 << 16), __uint_as_float(w0 & 0xffff0000u), __uint_as_float(w1 << 16), __uint_as_float(w1 & 0xffff0000u)};
                    if (stprev) x = (rs.a * x + rs.b) * gv[bj][n] + bv[bj][n];
                    y[n] = cfg::ALPHA * x + acc[ai][bj][m][n];
                    s += (y[n][0] + y[n][1]) + (y[n][2] + y[n][3]); ss += (y[n][0] * y[n][0] + y[n][1] * y[n][1]) + (y[n][2] * y[n][2] + y[n][3] * y[n][3]); }
                st8nt(XB + off + 128 * bj, y[0], y[1]); }
            s = xadd<16>(s); ss = xadd<16>(ss); s = xadd<32>(s); ss = xadd<32>(ss);
            if (fq == 0) { typedef float f32x2 __attribute__((ext_vector_type(2))); *(f32x2*)(ST + (size_t)row * 32 + (u.pn * 4 + wc) * 2) = (f32x2){s, ss}; }
            if (i < 7) cur = nxt; }
    }
};
struct FEpiGU {
    static constexpr bool PERM = true, AFTER_DRAIN = false;
    const float* st; const float* c1; const float* c2; bf16_t* ACT;
    __device__ __forceinline__ void operator()(const f32x4 (&acc)[2][2][4][2], const Unit& u, int wr, int wc, int fr, int fq) const {
        asm volatile("" : "+v"(fr), "+v"(fq));
        const int cw = 32 * wc + 8 * fq, row0 = u.pm * BM + 64 * wr + fr; const float* c1p = c1 + u.pn * 256 + cw; const float* c2p = c2 + u.pn * 256 + cw;
        f32x4 k1[2][2], k2[2][2];
#pragma unroll
        for (int hb = 0; hb < 2; ++hb) {
            asm volatile("" ::: "memory");
            StatLd t[4]; RS rs[4];
#pragma unroll
            for (int i = 0; i < 4; ++i) t[i] = stat_load(st, row0 + 128 * hb + 16 * i, fq);
            if (hb == 0) {
#pragma unroll
                for (int bj = 0; bj < 2; ++bj)
#pragma unroll
                    for (int n = 0; n < 2; ++n) { k1[bj][n] = *(const f32x4*)(c1p + 128 * bj + 4 * n); k2[bj][n] = *(const f32x4*)(c2p + 128 * bj + 4 * n); } }
#pragma unroll
            for (int i = 0; i < 4; ++i) rs[i] = stat_fin(t[i]);
#pragma unroll
            for (int m = 0; m < 4; ++m) { const int ai = hb; f32x4 a[2];
#pragma unroll
                for (int n = 0; n < 2; ++n) { const f32x4 hg = rs[m].a * acc[ai][0][m][n] + (rs[m].b * k1[0][n] + k2[0][n]), hu = rs[m].a * acc[ai][1][m][n] + (rs[m].b * k1[1][n] + k2[1][n]);
#pragma unroll
                    for (int e = 0; e < 4; ++e) a[n][e] = fsilu(hg[e]) * hu[e]; }
                st8nt(ACT + (size_t)(row0 + 128 * ai + 16 * m) * cfg::FF + 128 * u.pn + cw, a[0], a[1]); } }
    }
};
struct FEpiFour {
    static constexpr bool PERM = true, AFTER_DRAIN = false;
    bf16_t* OC;
    __device__ __forceinline__ void operator()(const f32x4 (&acc)[2][2][4][2], const Unit& u, int wr, int wc, int fr, int fq) const {
        asm volatile("" : "+v"(fr), "+v"(fq));
        const int cw = 32 * wc + 8 * fq;
#pragma unroll
        for (int ai = 0; ai < 2; ++ai)
#pragma unroll
            for (int m = 0; m < 4; ++m) { const int row = u.pm * BM + 128 * ai + 64 * wr + 16 * m + fr; bf16_t* dst = OC + (size_t)(u.pn * 2048 + row) * 1024 + 512 + cw;
                st8(dst, acc[ai][0][m][0], acc[ai][0][m][1]); st8(dst + 128, acc[ai][1][m][0], acc[ai][1][m][1]); }
    }
};
}
namespace att {
using bf16x8 = __attribute__((ext_vector_type(8))) short;
using s16x4  = __attribute__((ext_vector_type(4))) short;
using f32x16 = __attribute__((ext_vector_type(16))) float;
using u32x4  = __attribute__((ext_vector_type(4))) unsigned;
constexpr int NW = 8, QBLK = 32, KVBLK = 64, LD = 512, NT = cfg::S / KVBLK;
constexpr int SHM_V = KVBLK * 128 * 2, SHM_K = KVBLK * 128 * 2, SHM_X = 2 * SHM_V + 2 * SHM_K, SHM_ATTN = SHM_X + NW * 64 * 4;
constexpr float THRL = 6.0f;
#define ATT_KSWZ(row, colB) ((row) * 256 + ((colB) ^ (((row) & 7) << 4)))
#define ATT_SBAR() __builtin_amdgcn_sched_barrier(0)
__device__ __forceinline__ int crow(int r, int hi) { return (r & 3) + 8 * (r >> 2) + 4 * hi; }
__device__ __forceinline__ unsigned cvtpk(float lo, float hi) { unsigned r; asm volatile("v_cvt_pk_bf16_f32 %0, %1, %2" : "=v"(r) : "v"(lo), "v"(hi)); return r; }
__device__ __forceinline__ void partialSM(f32x16& p0, f32x16& p1, float& m_reg, float& alpha) {
  float pmax = p0[0];
#pragma unroll
  for (int r = 1; r < 16; ++r) pmax = fmaxf(pmax, p0[r]);
#pragma unroll
  for (int r = 0; r < 16; ++r) pmax = fmaxf(pmax, p1[r]);
  { auto rr = __builtin_amdgcn_permlane32_swap(__float_as_uint(pmax), __float_as_uint(pmax), false, false); pmax = fmaxf(__uint_as_float(rr[0]), __uint_as_float(rr[1])); }
  float mn;
  if (__builtin_expect(__all(pmax - m_reg <= THRL), 1)) { mn = m_reg; alpha = 1.f; }
  else { mn = fmaxf(m_reg, pmax); alpha = __builtin_amdgcn_exp2f(m_reg - mn); m_reg = mn; }
#pragma unroll
  for (int r = 0; r < 16; ++r) p0[r] = p0[r] - mn;
#pragma unroll
  for (int r = 0; r < 16; ++r) p1[r] = p1[r] - mn;
#pragma unroll
  for (int r = 0; r < 16; ++r) p0[r] = __builtin_amdgcn_exp2f(p0[r]);
}
__device__ __forceinline__ void finishSM(f32x16& p0, f32x16& p1, float alpha, float& l_reg, bf16x8& pa0, bf16x8& pa1, bf16x8& pa2, bf16x8& pa3) {
#pragma unroll
  for (int r = 0; r < 16; ++r) p1[r] = __builtin_amdgcn_exp2f(p1[r]);
  float ps = 0;
#pragma unroll
  for (int r = 0; r < 16; ++r) ps += p0[r];
#pragma unroll
  for (int r = 0; r < 16; ++r) ps += p1[r];
  { auto rr = __builtin_amdgcn_permlane32_swap(__float_as_uint(ps), __float_as_uint(ps), false, false); ps = __uint_as_float(rr[0]) + __uint_as_float(rr[1]); }
  l_reg = l_reg * alpha + ps;
#define ATT_PK4(P, BASE, OUT) do { unsigned a0 = cvtpk(P[BASE + 0], P[BASE + 1]), a1 = cvtpk(P[BASE + 2], P[BASE + 3]);   \
    unsigned b0 = cvtpk(P[BASE + 4], P[BASE + 5]), b1 = cvtpk(P[BASE + 6], P[BASE + 7]);                              \
    auto r0 = __builtin_amdgcn_permlane32_swap(a0, b0, false, false); auto r1 = __builtin_amdgcn_permlane32_swap(a1, b1, false, false); \
    u32x4 w = {r0[0], r1[0], r0[1], r1[1]}; OUT = *reinterpret_cast<bf16x8*>(&w); } while (0)
  ATT_PK4(p0, 0, pa0); ATT_PK4(p0, 8, pa1); ATT_PK4(p1, 0, pa2); ATT_PK4(p1, 8, pa3);
#undef ATT_PK4
}
__device__ __forceinline__ void qkt(f32x16& p0, f32x16& p1, const char* Ks, const bf16x8* qr, int r32, int hi, int mofs) {
  p0 = f32x16{}; p1 = f32x16{};
#pragma unroll
  for (int d0 = 0; d0 < 4; ++d0) { const int cb = (mofs + d0 * 16 + hi * 8) * 2;
    const bf16x8 b0 = *reinterpret_cast<const bf16x8*>(Ks + ATT_KSWZ(r32, cb));
    const bf16x8 b1 = *reinterpret_cast<const bf16x8*>(Ks + ATT_KSWZ(32 + r32, cb));
    p0 = __builtin_amdgcn_mfma_f32_32x32x16_bf16(b0, qr[d0], p0, 0, 0, 0);
    p1 = __builtin_amdgcn_mfma_f32_32x32x16_bf16(b1, qr[d0], p1, 0, 0, 0); }
}
__device__ __forceinline__ int v_st(int k, int c) { const int kk = (k & ~0xC) | ((k & 4) << 1) | ((k & 8) >> 1); return ((kk >> 3) * 4 + (c >> 5)) * 512 + ((kk & 7) * 32 + (c & 31)) * 2; }
__device__ __forceinline__ int v_rd_base(int lane) { return ((lane & 3) << 3) | (((lane >> 2) & 3) << 6) | (((lane >> 4) & 1) << 5) | (((lane >> 5) & 1) << 8); }
constexpr int v_rd_off(int d0, int ks, int half) { return d0 * 512 + ks * 4096 + half * 2048; }
template <int OFF> __device__ __forceinline__ s16x4 tr_read(int vb) { s16x4 r; asm volatile("ds_read_b64_tr_b16 %0, %1 offset:%2" : "=&v"(r) : "v"(vb), "i"(OFF) : "memory"); return r; }
template <int D0> __device__ __forceinline__ void pv_one(f32x16& od, int vb, bf16x8 pa0, bf16x8 pa1, bf16x8 pa2, bf16x8 pa3) {
  const s16x4 l0 = tr_read<v_rd_off(D0, 0, 0)>(vb), h0 = tr_read<v_rd_off(D0, 0, 1)>(vb), l1 = tr_read<v_rd_off(D0, 1, 0)>(vb), h1 = tr_read<v_rd_off(D0, 1, 1)>(vb);
  const s16x4 l2 = tr_read<v_rd_off(D0, 2, 0)>(vb), h2 = tr_read<v_rd_off(D0, 2, 1)>(vb), l3 = tr_read<v_rd_off(D0, 3, 0)>(vb), h3 = tr_read<v_rd_off(D0, 3, 1)>(vb);
  asm volatile("s_waitcnt lgkmcnt(0)" ::: "memory"); ATT_SBAR();
#define ATT_PK(L, H) (bf16x8){L[0], L[1], L[2], L[3], H[0], H[1], H[2], H[3]}
  od = __builtin_amdgcn_mfma_f32_32x32x16_bf16(pa0, ATT_PK(l0, h0), od, 0, 0, 0);
  od = __builtin_amdgcn_mfma_f32_32x32x16_bf16(pa1, ATT_PK(l1, h1), od, 0, 0, 0);
  od = __builtin_amdgcn_mfma_f32_32x32x16_bf16(pa2, ATT_PK(l2, h2), od, 0, 0, 0);
  od = __builtin_amdgcn_mfma_f32_32x32x16_bf16(pa3, ATT_PK(l3, h3), od, 0, 0, 0);
#undef ATT_PK
}
__device__ __forceinline__ void pv_d0(f32x16* o, int vb, bf16x8 pa0, bf16x8 pa1, bf16x8 pa2, bf16x8 pa3) {
  pv_one<0>(o[0], vb, pa0, pa1, pa2, pa3); pv_one<1>(o[1], vb, pa0, pa1, pa2, pa3); pv_one<2>(o[2], vb, pa0, pa1, pa2, pa3); pv_one<3>(o[3], vb, pa0, pa1, pa2, pa3);
}

__device__ __forceinline__ void attn_unit(int b, int h, int qb, const bf16_t* __restrict__ Qg, const bf16_t* __restrict__ Kg, const bf16_t* __restrict__ Vg, bf16_t* __restrict__ OC,
                                          const float* __restrict__ lamp, const float* __restrict__ dgv, int layer, char* lds) {
  int tid_o = threadIdx.x; asm volatile("" : "+v"(tid_o));
  const int tid = tid_o, wid = __builtin_amdgcn_readfirstlane(tid >> 6), lane = tid & 63, r32 = lane & 31, hi = lane >> 5, mp = wid >> 2, wl = wid & 3, mofs = mp * 64;
  char* V_lds = lds; char* K_lds = lds + 2 * SHM_V;
  float* ws = (float*)(lds + SHM_X) + wid * 64; float* li_l = ws; float* al_l = ws + 32;
  float m_reg = -1e30f, l_reg = 0; f32x16 o[4] = {}; bf16x8 qr[4];
  const int q0 = qb * 128 + wl * QBLK;
  const bf16_t* Qw = Qg + (size_t)(b * cfg::S + q0 + r32) * LD + h * 128 + mofs + hi * 8;
#pragma unroll
  for (int d0 = 0; d0 < 4; ++d0) qr[d0] = *reinterpret_cast<const bf16x8*>(Qw + d0 * 16);
  const bf16_t* Kh = Kg + (size_t)b * cfg::S * LD + h * 128; const bf16_t* Vh = Vg + (size_t)b * cfg::S * LD + h * 128;
  const int sr = tid >> 4, sc = (tid & 15) * 8, vst0 = v_st(sr, sc), vst1 = v_st(32 + sr, sc);
  const int vb0 = (int)(uintptr_t)V_lds + v_rd_base(lane);
  struct { bf16x8 vs0, vs1, ks0, ks1; } sr_[2];
#define ATT_SLOAD(i, k0) do { sr_[i].vs0 = *reinterpret_cast<const bf16x8*>(&Vh[(size_t)((k0) + sr) * LD + sc]); sr_[i].vs1 = *reinterpret_cast<const bf16x8*>(&Vh[(size_t)((k0) + 32 + sr) * LD + sc]); \
    sr_[i].ks0 = *reinterpret_cast<const bf16x8*>(&Kh[(size_t)((k0) + sr) * LD + sc]); sr_[i].ks1 = *reinterpret_cast<const bf16x8*>(&Kh[(size_t)((k0) + 32 + sr) * LD + sc]); } while (0)
#define ATT_SWRITE(bf, i) do { *(bf16x8*)(V_lds + (bf) * SHM_V + vst0) = sr_[i].vs0; *(bf16x8*)(V_lds + (bf) * SHM_V + vst1) = sr_[i].vs1; const int kc = sc * 2; \
    *(bf16x8*)(K_lds + (bf) * SHM_K + ATT_KSWZ(sr, kc)) = sr_[i].ks0; *(bf16x8*)(K_lds + (bf) * SHM_K + ATT_KSWZ(32 + sr, kc)) = sr_[i].ks1; } while (0)
#define ATT_SWAIT() asm volatile("s_waitcnt vmcnt(4)" ::: "memory")
#define ATT_RESC(a) do { if (__any((a) < 1.f)) { if (hi == 0) al_l[r32] = (a); asm volatile("s_waitcnt lgkmcnt(0)" ::: "memory"); \
    _Pragma("unroll") for (int d = 0; d < 4; ++d) _Pragma("unroll") for (int r = 0; r < 16; ++r) o[d][r] *= al_l[crow(r, hi)]; } } while (0)
  f32x16 pA0, pA1, pB0, pB1; float alA, alB; bf16x8 pa0, pa1, pa2, pa3;
  ATT_SLOAD(0, 0); asm volatile("s_waitcnt vmcnt(0)" ::: "memory"); ATT_SWRITE(0, 0); __syncthreads();
  qkt(pA0, pA1, K_lds, qr, r32, hi, mofs); partialSM(pA0, pA1, m_reg, alA);
  ATT_SLOAD(1, KVBLK); ATT_SLOAD(0, 2 * KVBLK);
  ATT_SWAIT(); ATT_SWRITE(1, 1); __syncthreads();
  for (int j = 1; j + 1 < NT; j += 2) {
    ATT_SBAR(); qkt(pB0, pB1, K_lds + SHM_K, qr, r32, hi, mofs);
    finishSM(pA0, pA1, alA, l_reg, pa0, pa1, pa2, pa3); ATT_SBAR();
    ATT_SLOAD(1, (j + 2) * KVBLK); ATT_SBAR();
    pv_d0(o, vb0, pa0, pa1, pa2, pa3); partialSM(pB0, pB1, m_reg, alB);
    __syncthreads(); ATT_SWAIT(); ATT_SWRITE(0, 0);
    ATT_RESC(alB); __syncthreads();
    ATT_SBAR(); qkt(pA0, pA1, K_lds, qr, r32, hi, mofs);
    finishSM(pB0, pB1, alB, l_reg, pa0, pa1, pa2, pa3); ATT_SBAR();
    if (j + 3 < NT) ATT_SLOAD(0, (j + 3) * KVBLK); ATT_SBAR();
    pv_d0(o, vb0 + SHM_V, pa0, pa1, pa2, pa3); partialSM(pA0, pA1, m_reg, alA);
    __syncthreads(); ATT_SWAIT(); ATT_SWRITE(1, 1);
    ATT_RESC(alA); __syncthreads();
  }
  ATT_SBAR(); qkt(pB0, pB1, K_lds + SHM_K, qr, r32, hi, mofs);
  finishSM(pA0, pA1, alA, l_reg, pa0, pa1, pa2, pa3); ATT_SBAR();
  pv_d0(o, vb0, pa0, pa1, pa2, pa3); partialSM(pB0, pB1, m_reg, alB);
  __syncthreads(); ATT_RESC(alB);
  finishSM(pB0, pB1, alB, l_reg, pa0, pa1, pa2, pa3); ATT_SBAR();
  pv_d0(o, vb0 + SHM_V, pa0, pa1, pa2, pa3);
  if (hi == 0) li_l[r32] = l_reg; asm volatile("s_waitcnt lgkmcnt(0)" ::: "memory");
  float rli[16];
#pragma unroll
  for (int r = 0; r < 16; ++r) rli[r] = __builtin_amdgcn_rcpf(li_l[crow(r, hi)]);
#pragma unroll
  for (int d0 = 0; d0 < 4; ++d0)
#pragma unroll
    for (int r = 0; r < 16; ++r) o[d0][r] *= rli[r];
  __syncthreads();
  float* X = (float*)lds;
  if (mp == 1) {
#pragma unroll
    for (int r = 0; r < 16; ++r)
#pragma unroll
      for (int d0 = 0; d0 < 4; ++d0) X[(wl * 32 + crow(r, hi)) * 128 + d0 * 32 + r32] = o[d0][r];
  }
  __syncthreads();
  if (mp == 0) {
    int layer_o = __builtin_amdgcn_readfirstlane(layer); asm volatile("" : "+s"(layer_o)); const float lam_init = layer_o == 0 ? 0.2f : 0.35550906759f;
    float lam; { float s1 = lamp[lane] * lamp[64 + lane], s2 = lamp[128 + lane] * lamp[192 + lane];
      s1 = xadd<1>(s1); s2 = xadd<1>(s2); s1 = xadd<2>(s1); s2 = xadd<2>(s2); s1 = xadd<4>(s1); s2 = xadd<4>(s2); s1 = xadd<8>(s1); s2 = xadd<8>(s2); s1 = xadd<16>(s1); s2 = xadd<16>(s2); s1 = xadd<32>(s1); s2 = xadd<32>(s2);
      lam = __expf(s1) - __expf(s2) + lam_init; }
    float gq[4];
#pragma unroll
    for (int d0 = 0; d0 < 4; ++d0) gq[d0] = dgv[d0 * 32 + r32] * (1.f - lam_init);
#pragma unroll
    for (int r = 0; r < 16; ++r) {
      float ssq = 0.f;
#pragma unroll
      for (int d0 = 0; d0 < 4; ++d0) { const float df = o[d0][r] - lam * X[(wl * 32 + crow(r, hi)) * 128 + d0 * 32 + r32]; o[d0][r] = df; ssq += df * df; }
      ssq = xadd<1>(ssq); ssq = xadd<2>(ssq); ssq = xadd<4>(ssq); ssq = xadd<8>(ssq); ssq = xadd<16>(ssq);
      const float rn = rsqrtf(ssq * (1.f / 128.f) + cfg::EPS);
      bf16_t* dst = OC + (size_t)(b * cfg::S + q0 + crow(r, hi)) * 1024 + h * 128 + r32;
#pragma unroll
      for (int d0 = 0; d0 < 4; ++d0) dst[d0 * 32] = (bf16_t)(cvtpk(o[d0][r] * rn * gq[d0], 0.f) & 0xffffu);
    }
  }
  __syncthreads();
#undef ATT_SLOAD
#undef ATT_SWRITE
#undef ATT_SWAIT
#undef ATT_RESC
}
#undef ATT_KSWZ
#undef ATT_SBAR
}
namespace gla {
using att::bf16x8; using att::s16x4; using att::f32x16; using att::u32x4; using att::crow; using att::cvtpk; using att::tr_read;
typedef float f32x4 __attribute__((ext_vector_type(4)));
typedef unsigned u32x2 __attribute__((ext_vector_type(2)));
#define GLAS __attribute__((address_space(3)))
constexpr int KT_STRIDE = 144;
constexpr int A_KT = 0, A_V = 36864, A_BEND = A_V + 32768;
constexpr int B_QT = 0, B_KT = 32768, B_V = 65536, B_SC = 98304;
__device__ __forceinline__ int v_st64(int k, int c) { const int kk = (k & ~0xC) | ((k & 4) << 1) | ((k & 8) >> 1); return ((kk >> 3) * 2 + (c >> 5)) * 512 + ((kk & 7) * 32 + (c & 31)) * 2; }
constexpr int v_off64(int d0, int ks, int half) { return d0 * 512 + ks * 2048 + half * 1024; }
__device__ __forceinline__ float bf2f_(unsigned short v) { return __uint_as_float((unsigned)v << 16); }
__device__ __forceinline__ void load_v_tile(const bf16_t* __restrict__ src, GLAS unsigned char* dst, int lane) {
    u32x4 tv[8];
#pragma unroll
    for (int i = 0; i < 8; ++i) { const int row = (lane >> 3) + 8 * i, ch = lane & 7; tv[i] = *(const u32x4*)(src + (size_t)row * 256 + ch * 8); }
#pragma unroll
    for (int i = 0; i < 8; ++i) { const int row = (lane >> 3) + 8 * i, ch = lane & 7; *(GLAS u32x4*)(dst + v_st64(row, ch * 8)) = tv[i]; }
}
#define GLA_PK(L, H) (bf16x8){L[0], L[1], L[2], L[3], H[0], H[1], H[2], H[3]}
#define GLA_MM4(o0, o1, vb, AF) do { \
    const s16x4 l00 = tr_read<v_off64(0, 0, 0)>(vb), h00 = tr_read<v_off64(0, 0, 1)>(vb), l01 = tr_read<v_off64(0, 1, 0)>(vb), h01 = tr_read<v_off64(0, 1, 1)>(vb); \
    const s16x4 l02 = tr_read<v_off64(0, 2, 0)>(vb), h02 = tr_read<v_off64(0, 2, 1)>(vb), l03 = tr_read<v_off64(0, 3, 0)>(vb), h03 = tr_read<v_off64(0, 3, 1)>(vb); \
    const s16x4 l10 = tr_read<v_off64(1, 0, 0)>(vb), h10 = tr_read<v_off64(1, 0, 1)>(vb), l11 = tr_read<v_off64(1, 1, 0)>(vb), h11 = tr_read<v_off64(1, 1, 1)>(vb); \
    const s16x4 l12 = tr_read<v_off64(1, 2, 0)>(vb), h12 = tr_read<v_off64(1, 2, 1)>(vb), l13 = tr_read<v_off64(1, 3, 0)>(vb), h13 = tr_read<v_off64(1, 3, 1)>(vb); \
    asm volatile("s_waitcnt lgkmcnt(0)" ::: "memory"); __builtin_amdgcn_sched_barrier(0); \
    o0 = __builtin_amdgcn_mfma_f32_32x32x16_bf16(AF(0), GLA_PK(l00, h00), o0, 0, 0, 0); o1 = __builtin_amdgcn_mfma_f32_32x32x16_bf16(AF(0), GLA_PK(l10, h10), o1, 0, 0, 0); \
    o0 = __builtin_amdgcn_mfma_f32_32x32x16_bf16(AF(1), GLA_PK(l01, h01), o0, 0, 0, 0); o1 = __builtin_amdgcn_mfma_f32_32x32x16_bf16(AF(1), GLA_PK(l11, h11), o1, 0, 0, 0); \
    o0 = __builtin_amdgcn_mfma_f32_32x32x16_bf16(AF(2), GLA_PK(l02, h02), o0, 0, 0, 0); o1 = __builtin_amdgcn_mfma_f32_32x32x16_bf16(AF(2), GLA_PK(l12, h12), o1, 0, 0, 0); \
    o0 = __builtin_amdgcn_mfma_f32_32x32x16_bf16(AF(3), GLA_PK(l03, h03), o0, 0, 0, 0); o1 = __builtin_amdgcn_mfma_f32_32x32x16_bf16(AF(3), GLA_PK(l13, h13), o1, 0, 0, 0); } while (0)
__device__ __forceinline__ bf16x8 afrag_tr(const GLAS unsigned char* row, int ks, int hi) { return *(const GLAS bf16x8*)(row + (16 * ks + 8 * hi) * 2); }

__device__ __forceinline__ void gla_a_item(int b, int h, int g, unsigned char* ws, GLAS unsigned char* lds) {
    int tid_o = threadIdx.x; asm volatile("" : "+v"(tid_o));
    const int tid = tid_o, wave = __builtin_amdgcn_readfirstlane(tid >> 6), lane = tid & 63, r32 = lane & 31, hi = lane >> 5;
    const float* GL = (const float*)(ws + cfg::WS_GL); const bf16_t* GQK = (const bf16_t*)(ws + cfg::WS_GQK); const bf16_t* GV = (const bf16_t*)(ws + cfg::WS_GV);
    float* KVC = (float*)(ws + cfg::WS_OF); float* DEC = (float*)(ws + cfg::WS_DEC);
    const size_t tok0 = (size_t)b * 2048 + g * 256;
    GLAS float* bend_s = (GLAS float*)(lds + A_BEND);
    if (wave < 4) {
        const int c = wave, dir = lane >> 5, d = lane & 31;
        const float* gl = GL + (tok0 + c * 64) * 256 + dir * 128 + h * 32 + d; const bf16_t* kp = GQK + (tok0 + c * 64) * 256 + 128 + h * 32 + d;
        GLAS unsigned char* row = lds + A_KT + ((c * 2 + dir) * 32 + d) * KT_STRIDE; float bsum = 0.f; float gA[8], gB[8]; unsigned short kA[8], kB[8];
#define GLA_LOAD(G, K, blk) do { const int t0_ = dir ? 56 - 8 * (blk) : 8 * (blk); _Pragma("unroll") for (int i = 0; i < 8; ++i) { G[i] = gl[(size_t)(t0_ + i) * 256]; K[i] = kp[(size_t)(t0_ + i) * 256]; } } while (0)
#define GLA_PROC(G, K, blk) do { const int t0_ = dir ? 56 - 8 * (blk) : 8 * (blk); float kt[8]; \
            if (dir == 0) { _Pragma("unroll") for (int i = 0; i < 8; ++i) { bsum += G[i]; kt[i] = bf2f_(K[i]) * __expf(-bsum); } } \
            else { _Pragma("unroll") for (int i = 7; i >= 0; --i) { bsum += G[i]; kt[i] = bf2f_(K[i]) * __expf(-bsum); } } \
            u32x4 w; w.x = cvtpk(kt[0], kt[1]); w.y = cvtpk(kt[2], kt[3]); w.z = cvtpk(kt[4], kt[5]); w.w = cvtpk(kt[6], kt[7]); *(GLAS u32x4*)(row + t0_ * 2) = w; } while (0)
        GLA_LOAD(gA, kA, 0);
#pragma unroll
        for (int bp = 0; bp < 4; ++bp) { GLA_LOAD(gB, kB, 2 * bp + 1); GLA_PROC(gA, kA, 2 * bp); if (bp < 3) GLA_LOAD(gA, kA, 2 * bp + 2); GLA_PROC(gB, kB, 2 * bp + 1); }
#undef GLA_LOAD
#undef GLA_PROC
        bend_s[(c * 2 + dir) * 32 + d] = bsum;
        DEC[((size_t)((b * 4 + h) * 32 + g * 4 + c) * 2 + dir) * 32 + d] = __expf(bsum);
    } else { const int c = wave - 4; load_v_tile(GV + (tok0 + c * 64) * 256 + h * 64, lds + A_V + c * 8192, lane); }
    __syncthreads();
    {
        const int c = wave >> 1, dir = wave & 1; f32x16 o0 = {}, o1 = {};
        const int vb = (int)(unsigned)(uintptr_t)(lds + A_V + c * 8192) + att::v_rd_base(lane);
        const GLAS unsigned char* arow = lds + A_KT + ((c * 2 + dir) * 32 + r32) * KT_STRIDE;
#define GLA_AF(ks) afrag_tr(arow, ks, hi)
        GLA_MM4(o0, o1, vb, GLA_AF);
#undef GLA_AF
        float* dst = KVC + ((size_t)((b * 4 + h) * 32 + g * 4 + c) * 2 + dir) * 2048 + r32;
#pragma unroll
        for (int r = 0; r < 16; ++r) { const int d = crow(r, hi); const float sc = __expf(bend_s[(c * 2 + dir) * 32 + d]); dst[d * 64] = o0[r] * sc; dst[d * 64 + 32] = o1[r] * sc; }
    }
    __syncthreads();
}

__device__ __forceinline__ void gla_b_item(int b, int h, int g, unsigned char* ws, const float* __restrict__ gng, bf16_t* __restrict__ OC, GLAS unsigned char* lds) {
    int tid_o = threadIdx.x; asm volatile("" : "+v"(tid_o));
    const int tid = tid_o, wave = __builtin_amdgcn_readfirstlane(tid >> 6), lane = tid & 63, r32 = lane & 31, hi = lane >> 5;
    const float* GL = (const float*)(ws + cfg::WS_GL); const bf16_t* GQK = (const bf16_t*)(ws + cfg::WS_GQK); const bf16_t* GV = (const bf16_t*)(ws + cfg::WS_GV); const bf16_t* GR = (const bf16_t*)(ws + cfg::WS_GR);
    const float* KVC = (const float*)(ws + cfg::WS_OF) + (size_t)((b * 4 + h) * 32) * 2 * 2048; const float* DEC = (const float*)(ws + cfg::WS_DEC) + (size_t)((b * 4 + h) * 32) * 2 * 32;
    const size_t tok0 = (size_t)b * 2048 + g * 256;
    if (wave < 4) {
        const int c = wave, dir = lane >> 5, d = lane & 31;
        const float* gl = GL + (tok0 + c * 64) * 256 + dir * 128 + h * 32 + d; const bf16_t* qp = GQK + (tok0 + c * 64) * 256 + h * 32 + d;
        GLAS unsigned short* qt = (GLAS unsigned short*)(lds + B_QT + c * 8192) + dir * 32 + d;
        GLAS unsigned short* kt = (GLAS unsigned short*)(lds + B_KT + c * 8192 + dir * 4096) + d;
        float bsum = 0.f; float gA[8], gB[8]; unsigned short qA[8], kA[8], qB[8], kB[8];
#define GLB_LOAD(G, Q, K, blk) do { const int t0_ = dir ? 56 - 8 * (blk) : 8 * (blk); _Pragma("unroll") for (int i = 0; i < 8; ++i) { G[i] = gl[(size_t)(t0_ + i) * 256]; Q[i] = qp[(size_t)(t0_ + i) * 256]; K[i] = qp[(size_t)(t0_ + i) * 256 + 128]; } } while (0)
#define GLB_PROC(G, Q, K, blk) do { const int t0_ = dir ? 56 - 8 * (blk) : 8 * (blk); _Pragma("unroll") for (int ii = 0; ii < 8; ++ii) { \
            const float gi = dir ? G[7 - ii] : G[ii], qi = bf2f_(dir ? Q[7 - ii] : Q[ii]), ki = bf2f_(dir ? K[7 - ii] : K[ii]); const int tt = t0_ + (dir ? 7 - ii : ii); \
            bsum += gi; const float e = __expf(bsum), ei = __expf(-bsum); \
            qt[tt * 64] = (unsigned short)(cvtpk(qi * e, 0.f) & 0xffffu); kt[tt * 32] = (unsigned short)(cvtpk(ki * ei, 0.f) & 0xffffu); } } while (0)
        GLB_LOAD(gA, qA, kA, 0);
#pragma unroll
        for (int bp = 0; bp < 4; ++bp) { GLB_LOAD(gB, qB, kB, 2 * bp + 1); GLB_PROC(gA, qA, kA, 2 * bp); if (bp < 3) GLB_LOAD(gA, qA, kA, 2 * bp + 2); GLB_PROC(gB, qB, kB, 2 * bp + 1); }
#undef GLB_LOAD
#undef GLB_PROC
    } else {
        const int c = wave - 4; load_v_tile(GV + (tok0 + c * 64) * 256 + h * 64, lds + B_V + c * 8192, lane);
        const int t2 = tid - 256, d = t2 >> 3, v8 = (t2 & 7) * 8;
        const float* kvp = KVC + d * 64 + v8; const float* dcp = DEC + d;
        f32x4 own[4][2][2]; float dow[4][2];
#pragma unroll
        for (int c4 = 0; c4 < 4; ++c4)
#pragma unroll
            for (int dr = 0; dr < 2; ++dr) { const int n = 4 * g + c4; own[c4][dr][0] = *(const f32x4*)(kvp + (size_t)(n * 2 + dr) * 2048); own[c4][dr][1] = *(const f32x4*)(kvp + (size_t)(n * 2 + dr) * 2048 + 4); dow[c4][dr] = dcp[(n * 2 + dr) * 32]; }
        f32x4 Sf0 = {0.f, 0.f, 0.f, 0.f}, Sf1 = Sf0, Sb0 = Sf0, Sb1 = Sf0;
#pragma unroll 8
        for (int n = 0; n < 4 * g; ++n) { const float dc = dcp[(n * 2) * 32]; Sf0 = dc * Sf0 + *(const f32x4*)(kvp + (size_t)(n * 2) * 2048); Sf1 = dc * Sf1 + *(const f32x4*)(kvp + (size_t)(n * 2) * 2048 + 4); }
#pragma unroll 8
        for (int n = 31; n >= 4 * g + 4; --n) { const float dc = dcp[(n * 2 + 1) * 32]; Sb0 = dc * Sb0 + *(const f32x4*)(kvp + (size_t)(n * 2 + 1) * 2048); Sb1 = dc * Sb1 + *(const f32x4*)(kvp + (size_t)(n * 2 + 1) * 2048 + 4); }
#pragma unroll
        for (int c4 = 0; c4 < 4; ++c4) { u32x4 w; w.x = cvtpk(Sf0[0], Sf0[1]); w.y = cvtpk(Sf0[2], Sf0[3]); w.z = cvtpk(Sf1[0], Sf1[1]); w.w = cvtpk(Sf1[2], Sf1[3]);
            *(GLAS u32x4*)(lds + B_SC + c4 * 8192 + v_st64(d, v8)) = w; Sf0 = dow[c4][0] * Sf0 + own[c4][0][0]; Sf1 = dow[c4][0] * Sf1 + own[c4][0][1]; }
#pragma unroll
        for (int c4 = 3; c4 >= 0; --c4) { u32x4 w; w.x = cvtpk(Sb0[0], Sb0[1]); w.y = cvtpk(Sb0[2], Sb0[3]); w.z = cvtpk(Sb1[0], Sb1[1]); w.w = cvtpk(Sb1[2], Sb1[3]);
            *(GLAS u32x4*)(lds + B_SC + c4 * 8192 + v_st64(32 + d, v8)) = w; Sb0 = dow[c4][1] * Sb0 + own[c4][1][0]; Sb1 = dow[c4][1] * Sb1 + own[c4][1][1]; }
    }
    __syncthreads();
    {
        const int c = wave >> 1, th = wave & 1, t = 32 * th + r32;
        const GLAS unsigned char* qrow = lds + B_QT + c * 8192 + t * 128;
        f32x16 pf0 = {}, pf1 = {}, pb0 = {}, pb1 = {};
#pragma unroll
        for (int ks = 0; ks < 2; ++ks) {
            const bf16x8 qf = *(const GLAS bf16x8*)(qrow + (16 * ks + 8 * hi) * 2), qb = *(const GLAS bf16x8*)(qrow + (32 + 16 * ks + 8 * hi) * 2);
            const GLAS unsigned char* kf = lds + B_KT + c * 8192 + r32 * 64 + (16 * ks + 8 * hi) * 2; const GLAS unsigned char* kb = kf + 4096;
            pf0 = __builtin_amdgcn_mfma_f32_32x32x16_bf16(*(const GLAS bf16x8*)kf, qf, pf0, 0, 0, 0); pf1 = __builtin_amdgcn_mfma_f32_32x32x16_bf16(*(const GLAS bf16x8*)(kf + 2048), qf, pf1, 0, 0, 0);
            pb0 = __builtin_amdgcn_mfma_f32_32x32x16_bf16(*(const GLAS bf16x8*)kb, qb, pb0, 0, 0, 0); pb1 = __builtin_amdgcn_mfma_f32_32x32x16_bf16(*(const GLAS bf16x8*)(kb + 2048), qb, pb1, 0, 0, 0);
        }
#pragma unroll
        for (int r = 0; r < 16; ++r) { const int j0 = crow(r, hi), j1 = 32 + j0;
            pf0[r] = (j0 <= t ? pf0[r] : 0.f) + (j0 >= t ? pb0[r] : 0.f); pf1[r] = (j1 <= t ? pf1[r] : 0.f) + (j1 >= t ? pb1[r] : 0.f); }
        bf16x8 pa0, pa1, pa2, pa3;
#define GLA_PK4(P, BASE, OUT) do { unsigned a0 = cvtpk(P[BASE + 0], P[BASE + 1]), a1 = cvtpk(P[BASE + 2], P[BASE + 3]); unsigned b0 = cvtpk(P[BASE + 4], P[BASE + 5]), b1 = cvtpk(P[BASE + 6], P[BASE + 7]); \
    auto r0 = __builtin_amdgcn_permlane32_swap(a0, b0, false, false); auto r1 = __builtin_amdgcn_permlane32_swap(a1, b1, false, false); \
    u32x4 w = {r0[0], r1[0], r0[1], r1[1]}; OUT = *reinterpret_cast<bf16x8*>(&w); } while (0)
        GLA_PK4(pf0, 0, pa0); GLA_PK4(pf0, 8, pa1); GLA_PK4(pf1, 0, pa2); GLA_PK4(pf1, 8, pa3);
#undef GLA_PK4
        f32x16 o0 = {}, o1 = {};
        { const int vb = (int)(unsigned)(uintptr_t)(lds + B_V + c * 8192) + att::v_rd_base(lane);
#define GLA_AF(ks) ((ks) == 0 ? pa0 : (ks) == 1 ? pa1 : (ks) == 2 ? pa2 : pa3)
          GLA_MM4(o0, o1, vb, GLA_AF);
#undef GLA_AF
        }
        { const int vb = (int)(unsigned)(uintptr_t)(lds + B_SC + c * 8192) + att::v_rd_base(lane);
#define GLA_AF(ks) afrag_tr(qrow, ks, hi)
          GLA_MM4(o0, o1, vb, GLA_AF);
#undef GLA_AF
        }
        const float g0 = gng[r32], g1 = gng[32 + r32];
#pragma unroll
        for (int r = 0; r < 16; ++r) {
            float ssq = o0[r] * o0[r] + o1[r] * o1[r];
            ssq = xadd<1>(ssq); ssq = xadd<2>(ssq); ssq = xadd<4>(ssq); ssq = xadd<8>(ssq); ssq = xadd<16>(ssq);
            const float rn = rsqrtf(ssq * (1.f / 64.f) + cfg::EPS);
            const size_t tok = tok0 + c * 64 + 32 * th + crow(r, hi);
            const bf16_t* gr = GR + tok * 256 + h * 64 + r32; bf16_t* dst = OC + tok * 1024 + 768 + h * 64 + r32;
            dst[0] = (bf16_t)(cvtpk(o0[r] * rn * g0 * bf2f_(gr[0]), 0.f) & 0xffffu); dst[32] = (bf16_t)(cvtpk(o1[r] * rn * g1 * bf2f_(gr[32]), 0.f) & 0xffffu);
        }
    }
    __syncthreads();
}
#undef GLA_MM4
#undef GLA_PK
#undef GLAS
}
namespace fft {
using att::bf16x8; using att::s16x4; using att::f32x16; using att::u32x4; using att::crow; using att::cvtpk; using att::tr_read;
#define FLAS __attribute__((address_space(3)))
__device__ __forceinline__ int img_off(int k, int c) { const int kk = (k & ~0xC) | ((k & 4) << 1) | ((k & 8) >> 1); return ((kk >> 3) * 8 + (c >> 5)) * 512 + ((kk & 7) * 32 + (c & 31)) * 2; }
constexpr int rd_off(int ks, int half) { return ks * 8192 + half * 4096; }
#define FFT_PK(L, H) (bf16x8){L[0], L[1], L[2], L[3], H[0], H[1], H[2], H[3]}
typedef float f32x2_t __attribute__((ext_vector_type(2))); typedef __bf16 bf16x2_t __attribute__((ext_vector_type(2)));
__device__ __forceinline__ unsigned pk2f(float a, float b) { f32x2_t v = {a, b}; bf16x2_t r = __builtin_convertvector(v, bf16x2_t); return __builtin_bit_cast(unsigned, r); }

__device__ __forceinline__ void stage1_item(int b, int s2, const bf16_t* __restrict__ FX, bf16_t* __restrict__ I1, FLAS unsigned char* lds) {
    int tid_o = threadIdx.x; asm volatile("" : "+v"(tid_o));
    const int tid = tid_o, wave = __builtin_amdgcn_readfirstlane(tid >> 6), lane = tid & 63, r32 = lane & 31, hi = lane >> 5;
    bf16x8 F1[2][4];
#pragma unroll
    for (int ks = 0; ks < 4; ++ks) { float cr[8], ci[8];
#pragma unroll
        for (int j = 0; j < 8; ++j) { const int k = 16 * ks + 8 * hi + j, s1 = k & 31; const float rev = (float)((r32 * s1) & 31) * (1.f / 32.f); const float c = __builtin_amdgcn_cosf(rev), sn = __builtin_amdgcn_sinf(rev);
            const bool p1 = (k >> 5) != 0; cr[j] = p1 ? -sn : c; ci[j] = p1 ? -c : -sn; }
        u32x4 wr = {pk2f(cr[0], cr[1]), pk2f(cr[2], cr[3]), pk2f(cr[4], cr[5]), pk2f(cr[6], cr[7])}, wi = {pk2f(ci[0], ci[1]), pk2f(ci[2], ci[3]), pk2f(ci[4], ci[5]), pk2f(ci[6], ci[7])};
        F1[0][ks] = *reinterpret_cast<bf16x8*>(&wr); F1[1][ks] = *reinterpret_cast<bf16x8*>(&wi); }
    { u32x4 tv[4];
#pragma unroll
      for (int i = 0; i < 4; ++i) { const int p = tid + 512 * i, k = p >> 5, c8 = (p & 31) * 8; tv[i] = *(const u32x4*)(FX + (size_t)(b * 2048 + 64 * (k & 31) + s2) * 512 + (k >> 5) * 256 + c8); }
#pragma unroll
      for (int i = 0; i < 4; ++i) { const int p = tid + 512 * i, k = p >> 5, c8 = (p & 31) * 8; *(FLAS u32x4*)(lds + img_off(k, c8)) = tv[i]; } }
    __syncthreads();
    f32x16 re = {}, im = {};
    { const int vb = (int)(unsigned)(uintptr_t)lds + att::v_rd_base(lane) + wave * 512;
      const s16x4 l0 = tr_read<rd_off(0, 0)>(vb), h0 = tr_read<rd_off(0, 1)>(vb), l1 = tr_read<rd_off(1, 0)>(vb), h1 = tr_read<rd_off(1, 1)>(vb);
      const s16x4 l2 = tr_read<rd_off(2, 0)>(vb), h2 = tr_read<rd_off(2, 1)>(vb), l3 = tr_read<rd_off(3, 0)>(vb), h3 = tr_read<rd_off(3, 1)>(vb);
      asm volatile("s_waitcnt lgkmcnt(0)" ::: "memory"); __builtin_amdgcn_sched_barrier(0);
      re = __builtin_amdgcn_mfma_f32_32x32x16_bf16(F1[0][0], FFT_PK(l0, h0), re, 0, 0, 0); im = __builtin_amdgcn_mfma_f32_32x32x16_bf16(F1[1][0], FFT_PK(l0, h0), im, 0, 0, 0);
      re = __builtin_amdgcn_mfma_f32_32x32x16_bf16(F1[0][1], FFT_PK(l1, h1), re, 0, 0, 0); im = __builtin_amdgcn_mfma_f32_32x32x16_bf16(F1[1][1], FFT_PK(l1, h1), im, 0, 0, 0);
      re = __builtin_amdgcn_mfma_f32_32x32x16_bf16(F1[0][2], FFT_PK(l2, h2), re, 0, 0, 0); im = __builtin_amdgcn_mfma_f32_32x32x16_bf16(F1[1][2], FFT_PK(l2, h2), im, 0, 0, 0);
      re = __builtin_amdgcn_mfma_f32_32x32x16_bf16(F1[0][3], FFT_PK(l3, h3), re, 0, 0, 0); im = __builtin_amdgcn_mfma_f32_32x32x16_bf16(F1[1][3], FFT_PK(l3, h3), im, 0, 0, 0); }
    bf16_t* dst = I1 + (size_t)(b * 32) * 128 * 256 + (size_t)s2 * 256 + 32 * wave + r32;
#pragma unroll
    for (int r = 0; r < 16; ++r) { const int k1 = crow(r, hi); const float rev = (float)((k1 * s2) & 2047) * (1.f / 2048.f); const float ct = __builtin_amdgcn_cosf(rev), st = __builtin_amdgcn_sinf(rev);
        const float ar = re[r] * ct + im[r] * st, ai = im[r] * ct - re[r] * st; const unsigned w = pk2f(ar, ai);
        dst[(size_t)k1 * 128 * 256] = (bf16_t)(w & 0xffffu); dst[(size_t)k1 * 128 * 256 + 64 * 256] = (bf16_t)(w >> 16); }
    __syncthreads();
}

__device__ __forceinline__ void stage2_item(int b, int k1, const bf16_t* __restrict__ I1, bf16_t* __restrict__ OC, FLAS unsigned char* lds) {
    int tid_o = threadIdx.x; asm volatile("" : "+v"(tid_o));
    const int tid = tid_o, wave = __builtin_amdgcn_readfirstlane(tid >> 6), lane = tid & 63, r32 = lane & 31, hi = lane >> 5;
    const bf16_t* src = I1 + (size_t)(b * 32 + k1) * 128 * 256;
    { u32x4 tv[8];
#pragma unroll
      for (int i = 0; i < 8; ++i) { const int p = tid + 512 * i, k = p >> 5, c8 = (p & 31) * 8; tv[i] = *(const u32x4*)(src + (size_t)k * 256 + c8); }
#pragma unroll
      for (int i = 0; i < 8; ++i) { const int p = tid + 512 * i, k = p >> 5, c8 = (p & 31) * 8; *(FLAS u32x4*)(lds + img_off(k, c8)) = tv[i]; } }
    f32x16 y0 = {}, y1 = {};
    __syncthreads();
    const int vb = (int)(unsigned)(uintptr_t)lds + att::v_rd_base(lane) + wave * 512, vb2 = vb + 32768;
    bf16x8 F2[2][8];
#pragma unroll
    for (int ks = 0; ks < 8; ++ks) { float c0[8], c1[8];
#pragma unroll
        for (int j = 0; j < 8; ++j) { const int k = 16 * ks + 8 * hi + j, s2 = k & 63; const float r0 = (float)((r32 * s2) & 63) * (1.f / 64.f), r1 = (float)(((32 + r32) * s2) & 63) * (1.f / 64.f);
            c0[j] = (k >> 6) ? __builtin_amdgcn_sinf(r0) : __builtin_amdgcn_cosf(r0); c1[j] = (k >> 6) ? __builtin_amdgcn_sinf(r1) : __builtin_amdgcn_cosf(r1); }
        u32x4 w0 = {pk2f(c0[0], c0[1]), pk2f(c0[2], c0[3]), pk2f(c0[4], c0[5]), pk2f(c0[6], c0[7])}, w1 = {pk2f(c1[0], c1[1]), pk2f(c1[2], c1[3]), pk2f(c1[4], c1[5]), pk2f(c1[6], c1[7])};
        F2[0][ks] = *reinterpret_cast<bf16x8*>(&w0); F2[1][ks] = *reinterpret_cast<bf16x8*>(&w1); }
#define FFT_STEP(ks) do { \
      const s16x4 lo_ = tr_read<rd_off((ks) & 3, 0)>((ks) < 4 ? vb : vb2), hi_ = tr_read<rd_off((ks) & 3, 1)>((ks) < 4 ? vb : vb2); asm volatile("s_waitcnt lgkmcnt(0)" ::: "memory"); __builtin_amdgcn_sched_barrier(0); \
      y0 = __builtin_amdgcn_mfma_f32_32x32x16_bf16(F2[0][ks], FFT_PK(lo_, hi_), y0, 0, 0, 0); y1 = __builtin_amdgcn_mfma_f32_32x32x16_bf16(F2[1][ks], FFT_PK(lo_, hi_), y1, 0, 0, 0); } while (0)
    FFT_STEP(0); FFT_STEP(1); FFT_STEP(2); FFT_STEP(3); FFT_STEP(4); FFT_STEP(5); FFT_STEP(6); FFT_STEP(7);
#undef FFT_STEP
    bf16_t* dst = OC + (size_t)(b * 2048 + k1) * 1024 + 512 + 32 * wave + r32;
#pragma unroll
    for (int r = 0; r < 16; ++r) { const int k2 = crow(r, hi); const unsigned w = pk2f(y0[r], y1[r]);
        dst[(size_t)(32 * k2) * 1024] = (bf16_t)(w & 0xffffu); dst[(size_t)(32 * (32 + k2)) * 1024] = (bf16_t)(w >> 16); }
    __syncthreads();
}
#undef FFT_PK
#undef FLAS
}
namespace pro {
#define PLAS __attribute__((address_space(3)))
typedef float f32x4 __attribute__((ext_vector_type(4)));
typedef unsigned u32x4 __attribute__((ext_vector_type(4)));
__device__ __forceinline__ unsigned pk2(float lo, float hi) { unsigned r; asm volatile("v_cvt_pk_bf16_f32 %0, %1, %2" : "=v"(r) : "v"(lo), "v"(hi)); return r; }
__device__ __forceinline__ float lo_f(unsigned w) { return __uint_as_float(w << 16); }
__device__ __forceinline__ float hi_f(unsigned w) { return __uint_as_float(w & 0xffff0000u); }
template <bool SUMS, int STRIDE> __device__ __forceinline__ void tile_emit(int K, bf16_t* WT, const float* gain, const float* lnb, float (&a1)[4], float (&a2)[4], const PLAS float* scr, int lane) {
    const int c = lane & 7; float gk[8], bk[8];
#pragma unroll
    for (int q = 0; q < 8; ++q) { gk[q] = gain ? gain[8 * c + q] : 1.f; bk[q] = lnb ? lnb[8 * c + q] : 0.f; }
#pragma unroll
    for (int j = 0; j < 4; ++j) { const int n = (lane >> 3) + 8 * j; const PLAS float* s = scr + (8 * c) * STRIDE + n; float v[8];
#pragma unroll
        for (int q = 0; q < 8; ++q) v[q] = s[q * STRIDE];
        u32x4 o; o.x = pk2(v[0] * gk[0], v[1] * gk[1]); o.y = pk2(v[2] * gk[2], v[3] * gk[3]); o.z = pk2(v[4] * gk[4], v[5] * gk[5]); o.w = pk2(v[6] * gk[6], v[7] * gk[7]);
        *(u32x4*)(WT + (size_t)n * K + 8 * c) = o;
        if (SUMS) { float p1 = (lo_f(o.x) + hi_f(o.x)) + (lo_f(o.y) + hi_f(o.y)) + (lo_f(o.z) + hi_f(o.z)) + (lo_f(o.w) + hi_f(o.w)); float p2 = 0.f;
#pragma unroll
            for (int q = 0; q < 8; ++q) p2 += bk[q] * v[q];
            p1 = xadd<1>(p1); p2 = xadd<1>(p2); p1 = xadd<2>(p1); p2 = xadd<2>(p2); p1 = xadd<4>(p1); p2 = xadd<4>(p2);
            a1[j] += p1; a2[j] += p2; }
    }
    asm volatile("s_waitcnt lgkmcnt(0)" ::: "memory");
}
__device__ __forceinline__ void tile_dma(const float* W, int N, PLAS float* scr, int lane) {
    const float* src = W + (size_t)(lane >> 3) * N + (lane & 7) * 4;
#pragma unroll
    for (int i = 0; i < 8; ++i) __builtin_amdgcn_global_load_lds((const unsigned*)(src + (size_t)(8 * i) * N), (PLAS unsigned*)(scr + i * 256), 16, 0, 0);
}
template <bool SUMS, class Val> __device__ __forceinline__ void tile_item(const Val& val, int K, bf16_t* WT, const float* gain, const float* lnb, float (&a1)[4], float (&a2)[4], PLAS float* scr, int lane) {
#pragma unroll 2
    for (int i = 0; i < 32; ++i) { const int kk = 2 * i + (lane >> 5); scr[kk * 33 + (lane & 31)] = val(kk, lane & 31); }
    asm volatile("s_waitcnt lgkmcnt(0)" ::: "memory");
    tile_emit<SUMS, 33>(K, WT, gain, lnb, a1, a2, scr, lane);
}
struct ValPlain { static constexpr int BATCH = 32; const float* W; int N; __device__ __forceinline__ float operator()(int kk, int j) const { return W[(size_t)kk * N + j]; } };
struct ValGate { static constexpr int BATCH = 2; const float* W; const float* w2; __device__ __forceinline__ float operator()(int kk, int j) const {
    const float* wr = W + (size_t)kk * cfg::INW; float a = 0.f;
#pragma unroll
    for (int r = 0; r < 16; ++r) a += wr[r] * w2[r * 128 + j]; return a; } };

__device__ __forceinline__ void fold_item(int item, unsigned char* ws, const float* w_in, const float* fw, const float* lng, const float* lnb, PLAS unsigned char* lds, int tid) {
    const int l = item >> 5, g = (item >> 3) & 3, part = (item >> 2) & 1, kq = item & 3;
    PLAS float* M = (PLAS float*)lds;
    { const int c = tid >> 3, e0 = (tid & 7) * 8; float acc[8];
#pragma unroll
      for (int q = 0; q < 8; ++q) acc[q] = 0.f;
      const float* w = fw + (size_t)((l * 4 + g) * 64) * 64 + e0;
      for (int k2 = 0; k2 < 64; ++k2) { float rev = (float)((k2 * c) & 63) * (1.f / 64.f); asm volatile("" : "+v"(rev)); const float tr = part ? __builtin_amdgcn_sinf(rev) : __builtin_amdgcn_cosf(rev);
          const f32x4 w0 = *(const f32x4*)(w + k2 * 64), w1 = *(const f32x4*)(w + k2 * 64 + 4);
#pragma unroll
          for (int q = 0; q < 4; ++q) { acc[q] += tr * w0[q]; acc[4 + q] += tr * w1[q]; } }
      const float sc = 0.00276213586400995f;
#pragma unroll
      for (int q = 0; q < 8; ++q) M[c * 64 + e0 + q] = acc[q] * sc; }
    __syncthreads();
    PLAS float* Wl = (PLAS float*)(lds + 16384);
    { const float* wsrc = w_in + ((size_t)l * 1024 + kq * 256) * cfg::INW + 1536 + 64 * g; f32x4 tv[8];
#pragma unroll
      for (int i = 0; i < 8; ++i) tv[i] = *(const f32x4*)(wsrc + (size_t)((tid >> 4) + 32 * i) * cfg::INW + (tid & 15) * 4);
#pragma unroll
      for (int i = 0; i < 8; ++i) *(PLAS f32x4*)(Wl + ((tid >> 4) + 32 * i) * 64 + (tid & 15) * 4) = tv[i]; }
    __syncthreads();
    { const int e = tid & 63, kg = tid >> 6, k0 = kq * 256 + kg * 32, np = 1536 + part * 256 + g * 64 + e; float mc[64];
#pragma unroll
      for (int c = 0; c < 64; ++c) mc[c] = M[c * 64 + e];
      bf16_t* dst = (bf16_t*)(ws + cfg::WS_WIN + l * cfg::SZ_WIN) + (size_t)np * 1024 + k0; float s1 = 0.f, s2 = 0.f;
      for (int kb = 0; kb < 4; ++kb) { float o[8];
#pragma unroll
          for (int q = 0; q < 8; ++q) { const int k = k0 + kb * 8 + q; const PLAS f32x4* wr = (const PLAS f32x4*)(Wl + (kg * 32 + kb * 8 + q) * 64); float a = 0.f;
#pragma unroll
              for (int c4 = 0; c4 < 16; ++c4) { const f32x4 w4 = wr[c4]; a += w4[0] * mc[4 * c4] + w4[1] * mc[4 * c4 + 1] + w4[2] * mc[4 * c4 + 2] + w4[3] * mc[4 * c4 + 3]; }
              o[q] = a * (lng ? lng[k] : 1.f); s2 += lnb ? lnb[k] * a : 0.f; }
          u32x4 w; w.x = pk2(o[0], o[1]); w.y = pk2(o[2], o[3]); w.z = pk2(o[4], o[5]); w.w = pk2(o[6], o[7]); *(u32x4*)(dst + kb * 8) = w;
          s1 += (lo_f(w.x) + hi_f(w.x)) + (lo_f(w.y) + hi_f(w.y)) + (lo_f(w.z) + hi_f(w.z)) + (lo_f(w.w) + hi_f(w.w)); }
      __syncthreads();
      PLAS float* red = (PLAS float*)lds; red[(kg * 64 + e) * 2] = s1; red[(kg * 64 + e) * 2 + 1] = s2;
      __syncthreads();
      if (kg == 0) { float t1 = 0.f, t2 = 0.f;
#pragma unroll
          for (int w = 0; w < 8; ++w) { t1 += red[(w * 64 + e) * 2]; t2 += red[(w * 64 + e) * 2 + 1]; }
          float* fp = (float*)(ws + cfg::V_MF) + (size_t)((l * 4 + kq) * 2) * 512 + part * 256 + g * 64 + e; fp[0] = t1; fp[512] = t2; } }
    __syncthreads();
}

struct Inputs { const float *x, *w_in, *fw, *gw2, *w_out, *ln1g, *ln1b, *wg, *wu, *wd, *ln2g, *ln2b; };
__device__ __forceinline__ void prologue(unsigned char* ws, const Inputs& in, PLAS unsigned char* lds, int vcu, int G) {
    int tid_o = threadIdx.x; asm volatile("" : "+v"(tid_o));
    const int tid = tid_o, wave = __builtin_amdgcn_readfirstlane(tid >> 6), lane = tid & 63;
    const float* x = in.x; const float* w_in = in.w_in; const float* fw = in.fw; const float* gw2 = in.gw2; const float* w_out = in.w_out; const float* ln1g = in.ln1g; const float* ln1b = in.ln1b;
    const float* wg = in.wg; const float* wu = in.wu; const float* wd = in.wd; const float* ln2g = in.ln2g; const float* ln2b = in.ln2b;
    if (vcu < 64) { const int l = vcu >> 5; fold_item(vcu, ws, w_in, fw, l ? ln2g : (const float*)nullptr, l ? ln2b : (const float*)nullptr, lds, tid); }
    PLAS float* scr = (PLAS float*)(lds + wave * 16384); PLAS float* scr1 = scr + 2048; PLAS float* redw = (PLAS float*)(lds + 131072 + 1024 + wave * 256);
    const int gw = vcu * 8 + wave, NGW = G * 8;
    for (int it = vcu; it < 512; it += G) {
        const int l = it >> 8, r = it & 255; float a1[4] = {0.f, 0.f, 0.f, 0.f}, a2[4] = {0.f, 0.f, 0.f, 0.f}; float* c1o; float* c2o;
        const int k0 = wave * 64, k1 = k0 + 512;
        if (r < 80) { const int nb = r; const float* lngb = l ? ln2g : (const float*)nullptr; const float* lnbb = l ? ln2b : (const float*)nullptr;
            bf16_t* Wt = (bf16_t*)(ws + cfg::WS_WIN + l * cfg::SZ_WIN);
            if (nb < 72) { int np0, src;
                if (nb < 32) { const int pn = nb >> 3, p = (nb & 7) * 32, wc = (p >> 5) & 3, bj = p >> 7; np0 = pn * 256 + p; src = (pn >> 1) * 512 + (pn & 1) * 256 + 64 * wc + 32 * bj; }
                else if (nb < 48) { np0 = 1024 + (nb - 32) * 32; src = np0; }
                else { np0 = 2048 + (nb - 48) * 32; src = 1792 + (nb - 48) * 32; }
                tile_dma(w_in + ((size_t)l * 1024 + k0) * cfg::INW + src, cfg::INW, scr, lane); tile_dma(w_in + ((size_t)l * 1024 + k1) * cfg::INW + src, cfg::INW, scr1, lane);
                asm volatile("s_waitcnt vmcnt(0)" ::: "memory");
                tile_emit<true, 32>(1024, Wt + (size_t)np0 * 1024 + k0, lngb ? lngb + k0 : lngb, lnbb ? lnbb + k0 : lnbb, a1, a2, scr, lane);
                tile_emit<true, 32>(1024, Wt + (size_t)np0 * 1024 + k1, lngb ? lngb + k1 : lngb, lnbb ? lnbb + k1 : lnbb, a1, a2, scr1, lane);
                c1o = (float*)(ws + cfg::V_C1IN) + l * cfg::NIN + np0; c2o = (float*)(ws + cfg::V_C2IN) + l * cfg::NIN + np0;
            } else { const int p0 = (nb - 72) * 32, dir = p0 >> 7, kk0 = p0 & 127, np0 = 2816 + p0;
                for (int kb = wave; kb < 16; kb += 8) { const int kq = kb * 64; ValGate v{w_in + ((size_t)l * 1024 + kq) * cfg::INW + 2560 + 16 * dir, gw2 + (size_t)((l * 2 + dir) * 16) * 128 + kk0};
                    tile_item<true>(v, 1024, Wt + (size_t)np0 * 1024 + kq, lngb ? lngb + kq : lngb, lnbb ? lnbb + kq : lnbb, a1, a2, scr, lane); }
                c1o = (float*)(ws + cfg::V_C1IN) + l * cfg::NIN + np0; c2o = (float*)(ws + cfg::V_C2IN) + l * cfg::NIN + np0; }
        } else { const int nb = r - 80, np0 = nb * 32, pn = np0 >> 8, p = np0 & 255, bj = p >> 7, f0 = 128 * pn + (p & 127);
            const float* W = (bj ? wu : wg) + (size_t)l * 1024 * cfg::FF + f0; bf16_t* Wt = (bf16_t*)(ws + cfg::WS_WGU + l * cfg::SZ_WGU) + (size_t)np0 * 1024;
            tile_dma(W + (size_t)k0 * cfg::FF, cfg::FF, scr, lane); tile_dma(W + (size_t)k1 * cfg::FF, cfg::FF, scr1, lane);
            asm volatile("s_waitcnt vmcnt(0)" ::: "memory");
            tile_emit<true, 32>(1024, Wt + k0, ln1g + l * 1024 + k0, ln1b + l * 1024 + k0, a1, a2, scr, lane);
            tile_emit<true, 32>(1024, Wt + k1, ln1g + l * 1024 + k1, ln1b + l * 1024 + k1, a1, a2, scr1, lane);
            c1o = (float*)(ws + cfg::V_C1GU) + l * cfg::NGU + np0; c2o = (float*)(ws + cfg::V_C2GU) + l * cfg::NGU + np0; }
        if ((lane & 7) == 0) {
#pragma unroll
            for (int j = 0; j < 4; ++j) { const int n = (lane >> 3) + 8 * j; redw[n * 2] = a1[j]; redw[n * 2 + 1] = a2[j]; } }
        __syncthreads();
        if (wave == 0 && lane < 32) { float t1 = 0.f, t2 = 0.f;
#pragma unroll
            for (int w = 0; w < 8; ++w) { const PLAS float* rw = (const PLAS float*)(lds + 131072 + 1024 + w * 256); t1 += rw[lane * 2]; t2 += rw[lane * 2 + 1]; }
            c1o[lane] = t1; c2o[lane] = t2; }
        __syncthreads();
    }
    constexpr int I_OUT = 32 * 16, I_DN = 32 * 44, I_L = I_OUT + I_DN;
    for (int it = gw; it < 2 * I_L; it += 2 * NGW) {
        const float* Ws[2]; int Ns[2], Ks[2]; bf16_t* Wd[2]; float d1[4], d2[4];
#pragma unroll
        for (int q = 0; q < 2; ++q) { const int itq = it + q * NGW; const int ic = itq < 2 * I_L ? itq : it; const int l = ic / I_L; int r = ic - l * I_L;
            if (r < I_OUT) { const int nb = r >> 4, kb = r & 15, k0 = kb * 64, n0 = nb * 32; Ws[q] = w_out + ((size_t)l * 1024 + k0) * 1024 + n0; Ns[q] = 1024; Ks[q] = 1024;
                Wd[q] = (bf16_t*)(ws + cfg::WS_WOUT + l * cfg::SZ_WOUT) + (size_t)n0 * 1024 + k0; }
            else { r -= I_OUT; const int nb = r / 44, kb = r - nb * 44, k0 = kb * 64, n0 = nb * 32; Ws[q] = wd + ((size_t)l * cfg::FF + k0) * 1024 + n0; Ns[q] = 1024; Ks[q] = cfg::FF;
                Wd[q] = (bf16_t*)(ws + cfg::WS_WDN + l * cfg::SZ_WDN) + (size_t)n0 * cfg::FF + k0; } }
        tile_dma(Ws[0], Ns[0], scr, lane); tile_dma(Ws[1], Ns[1], scr1, lane);
        asm volatile("s_waitcnt vmcnt(0)" ::: "memory");
        tile_emit<false, 32>(Ks[0], Wd[0], (const float*)nullptr, (const float*)nullptr, d1, d2, scr, lane);
        if (it + NGW < 2 * I_L) tile_emit<false, 32>(Ks[1], Wd[1], (const float*)nullptr, (const float*)nullptr, d1, d2, scr1, lane);
    }
    const int xw = (vcu - 64) * 8 + wave, NXW = (G - 64) * 8;
    if (vcu >= 64 && G > 64)
    for (int m = xw; m < cfg::T; m += 4 * NXW) {
        f32x4 v[4][4];
#pragma unroll
        for (int q = 0; q < 4; ++q) { const int mr = (m + q * NXW) < cfg::T ? (m + q * NXW) : m; const f32x4* xr = (const f32x4*)(x + (size_t)mr * 1024) + lane;
#pragma unroll
            for (int j = 0; j < 4; ++j) v[q][j] = xr[64 * j]; }
#pragma unroll
        for (int q = 0; q < 4; ++q) { const int mr = (m + q * NXW) < cfg::T ? (m + q * NXW) : m; unsigned long long* o8 = (unsigned long long*)((bf16_t*)(ws + cfg::WS_XB) + (size_t)mr * 1024) + lane;
#pragma unroll
            for (int j = 0; j < 4; ++j) o8[64 * j] = (unsigned long long)pk2(v[q][j][0], v[q][j][1]) | ((unsigned long long)pk2(v[q][j][2], v[q][j][3]) << 32); } }
    for (int i = gw * 64 + lane; i < 2048 * 32; i += NGW * 64) { const int pos = i >> 5, f = i & 31; const float inv = exp2f(-(float)f * (13.287712379549449f / 32.f)); const float ang = (float)pos * inv;
        double rv = (double)ang * 0.15915494309189535; rv -= floor(rv); const float rev = (float)rv;
        ((float*)(ws + cfg::V_ROPEC))[i] = __builtin_amdgcn_cosf(rev); ((float*)(ws + cfg::V_ROPES))[i] = __builtin_amdgcn_sinf(rev); }
}
#undef PLAS
}
constexpr int NWAVES = 8;
constexpr int RING_OFF = 0, RING_BYTES = 131072;
constexpr int LDSCTL_OFF = RING_BYTES, MISC_OFF = LDSCTL_OFF + 320;
constexpr int LDS_BYTES = 147456;
constexpr int CW_BAR = 4096;
constexpr size_t CTL_ZERO_BYTES = 64 * 1024;
#define GAS __attribute__((address_space(1)))
#define LAS __attribute__((address_space(3)))
typedef GAS unsigned gu32;
#define RLX_AGENT __ATOMIC_RELAXED, __HIP_MEMORY_SCOPE_AGENT
#define XB_TMO      128
#define XB_XCNT(j)  (256  + 64 * (j))
#define XB_XSUB(j)  (1280 + 64 * (j))
#define XB_XGEN(j)  (2304 + 64 * (j))
#define XB_TOP      3328
#define XB_TOPGEN   3392
#define XCD_BAR_WORDS 3456
#define XB_SPIN_CAP (1u << 18)

__device__ __forceinline__ unsigned xb_ld(unsigned* p)              { return __hip_atomic_load(p, __ATOMIC_RELAXED, __HIP_MEMORY_SCOPE_AGENT); }
__device__ __forceinline__ unsigned xb_add(unsigned* p, unsigned v) { return __hip_atomic_fetch_add(p, v, __ATOMIC_RELAXED, __HIP_MEMORY_SCOPE_AGENT); }
__device__ __forceinline__ unsigned xb_xcc_id() { return (unsigned)__builtin_amdgcn_s_getreg((3 << 11) | 20) & 0xFu; }
#define XB_SPIN(cond, bar) do { unsigned _sp = 0; while (cond) { __builtin_amdgcn_s_sleep(1); \
    if ((++_sp & 255u) == 0u) { if (xb_ld(&(bar)[XB_TMO])) break; if (_sp > XB_SPIN_CAP) { atomicAdd(&(bar)[XB_TMO], 1u); break; } } } } while (0)

struct XcdBarrier {
    unsigned* bar; unsigned x;
    volatile LAS unsigned* st;
};

__device__ __forceinline__ XcdBarrier xcd_barrier_post(unsigned* bar, volatile LAS unsigned* st) {
    XcdBarrier b; b.bar = bar; b.x = xb_xcc_id(); b.st = st;
    if (threadIdx.x == 0) (void)xb_add(&bar[XB_XCNT(b.x)], 1u);
    return b;
}
__device__ __forceinline__ void xcd_barrier_complete(unsigned* bar, unsigned x, unsigned& nloc, unsigned& nx) {
    const unsigned G = gridDim.x * gridDim.y * gridDim.z;
    unsigned sum, cnt, mine, sp = 0u;
    for (;;) {
        sum = 0u; cnt = 0u; mine = 0u;
#pragma unroll
        for (unsigned j = 0; j < 16; ++j) { const unsigned c = xb_ld(&bar[XB_XCNT(j)]); sum += c; cnt += (c > 0u) ? 1u : 0u; mine = (j == x) ? c : mine; }
        if (sum == G) break;
        __builtin_amdgcn_s_sleep(1);
        if ((++sp & 255u) == 0u) { if (xb_ld(&bar[XB_TMO])) break; if (sp > XB_SPIN_CAP) { atomicAdd(&bar[XB_TMO], 1u); break; } }
    }
    nloc = mine > 0u ? mine : 1u; nx = cnt > 0u ? cnt : 1u;
}

__device__ __forceinline__ void xcd_barrier(const XcdBarrier& b) {
    asm volatile("s_waitcnt vmcnt(0)" ::: "memory");
    __syncthreads();
    if (threadIdx.x == 0) {
        unsigned* bar = b.bar;
        __builtin_amdgcn_s_waitcnt(0);
        unsigned nloc = b.st[0], nx = b.st[1];
        if (nloc == 0u) { xcd_barrier_complete(bar, b.x, nloc, nx); b.st[0] = nloc; b.st[1] = nx; }
        const unsigned old = xb_add(&bar[XB_XSUB(b.x)], 1u);
        const unsigned gen = old / nloc;
        if (old + 1u == (gen + 1u) * nloc) {
            __builtin_amdgcn_fence(__ATOMIC_RELEASE, "agent");
            asm volatile("s_waitcnt vmcnt(0)" ::: "memory");
            const unsigned og = xb_add(&bar[XB_TOP], 1u);
            const unsigned tg = og / nx;
            if (og + 1u == (tg + 1u) * nx) xb_add(&bar[XB_TOPGEN], 1u);
            else XB_SPIN(xb_ld(&bar[XB_TOPGEN]) == tg, bar);
            __builtin_amdgcn_fence(__ATOMIC_ACQUIRE, "agent");
            xb_add(&bar[XB_XGEN(b.x)], 1u);
            asm volatile("s_waitcnt vmcnt(0)" ::: "memory");
        } else {
            XB_SPIN(xb_ld(&bar[XB_XGEN(b.x)]) == gen, bar);
            __builtin_amdgcn_fence(__ATOMIC_ACQUIRE, "agent");
            asm volatile("s_waitcnt vmcnt(0)" ::: "memory");
        }
    }
    __syncthreads();
}


enum { PH_PRO = 0, PH_IN = 1, PH_ATT = 2, PH_MIXB = 3, PH_OUT = 4, PH_GU = 5, PH_DN = 6, PH_FIN = 13, N_PHASES = 14 };
struct MArgs { const float* in[16]; float* out; unsigned char* ws; int ph_lo, ph_hi, li, pad; };

__global__ void __launch_bounds__(NWAVES * 64, 2) mk_fwd(MArgs a) {
    extern __shared__ __attribute__((aligned(16))) unsigned char lds[];
    LAS unsigned char* ldsl = (LAS unsigned char*)lds;
    volatile LAS unsigned* MISC = (volatile LAS unsigned*)(ldsl + MISC_OFF);
    const int tid = threadIdx.x;
    const int G = gridDim.x, bx = blockIdx.x, vcu = (G % 8 == 0) ? (bx % 8) * (G / 8) + bx / 8 : bx;
    unsigned char* ws = a.ws;
    for (int u = tid; u < (LDS_BYTES - LDSCTL_OFF) / 4; u += NWAVES * 64) ((LAS unsigned*)(ldsl + LDSCTL_OFF))[u] = 0u;
    __syncthreads();
    XcdBarrier bar; bar.bar = (unsigned*)(ws + WS_CTL) + CW_BAR + a.li * XCD_BAR_WORDS; bar.x = 0; bar.st = nullptr;
    if (a.ph_hi - a.ph_lo > 1) bar = xcd_barrier_post((unsigned*)(ws + WS_CTL) + CW_BAR + a.li * XCD_BAR_WORDS, MISC + 8);
    const int G0 = G, bx0 = bx, vcu0 = vcu; unsigned char* const ws0 = ws;
    for (int ph = a.ph_lo; ph < a.ph_hi; ++ph) {
        int G = G0, bx = bx0, vcu = vcu0; unsigned zo = 0u; asm volatile("" : "+s"(G), "+s"(bx), "+s"(vcu), "+s"(zo)); unsigned char* ws = ws0 + zo;
        const int l = (ph >= 1 && ph <= 12) ? (ph - 1) / 6 : 0;
        const int kind = (ph == 0) ? PH_PRO : (ph == PH_FIN ? PH_FIN : 1 + (ph - 1) % 6);
        if (kind == PH_PRO) {
            { pro::Inputs pin{a.in[0], a.in[1], a.in[4], a.in[5], a.in[8], a.in[9], a.in[10], a.in[11], a.in[12], a.in[13], a.in[14], a.in[15]}; pro::prologue(ws, pin, ldsl + RING_OFF, vcu, G); }
        } else if (kind == PH_IN) {
            pg8::Gemm g{(const bf16_t*)(ws + WS_XB), (const bf16_t*)(ws + WS_WIN + l * SZ_WIN), T, NIN, D}; pg8::StaticOrder S; S.init(T, NIN, G, bx);
            pg8::FEpiIn E{ws, a.in[6] + l * 256, l};
            pg8::gemm_phase<pg8::FEpiIn, pg8::StaticOrder, true, true>(ldsl + RING_OFF, g, S, E);
        } else if (kind == PH_ATT) {
            for (int i = 0; i < 2; ++i) { const int idx = vcu * 2 + i; if (idx >= 512) break; const int bh = idx >> 4, qb = idx & 15;
                att::attn_unit(bh >> 2, bh & 3, qb, (const bf16_t*)(ws + WS_Q), (const bf16_t*)(ws + WS_K), (const bf16_t*)(ws + WS_V), (bf16_t*)(ws + WS_OC), a.in[2] + l * 256, a.in[3] + l * 128, l, (char*)lds + RING_OFF); }
            for (int i = 0; i < 2; ++i) { const int it = vcu * 2 + i; if (it >= 512) break;
                                fft::stage1_item(it >> 6, it & 63, (const bf16_t*)(ws + WS_TAB), (bf16_t*)(ws + WS_XT), ldsl + RING_OFF); }

            if (vcu < 256) gla::gla_a_item(vcu >> 5, (vcu >> 3) & 3, vcu & 7, ws, ldsl + RING_OFF);
        } else if (kind == PH_MIXB) {
            if (vcu < 256) fft::stage2_item(vcu >> 5, vcu & 31, (const bf16_t*)(ws + WS_XT), (bf16_t*)(ws + WS_OC), ldsl + RING_OFF);
            if (vcu < 256) gla::gla_b_item(vcu >> 5, (vcu >> 3) & 3, vcu & 7, ws, a.in[7] + l * 64, (bf16_t*)(ws + WS_OC), ldsl + RING_OFF);
        } else if (kind == PH_OUT) {
            pg8::Gemm g{(const bf16_t*)(ws + WS_OC), (const bf16_t*)(ws + WS_WOUT + l * SZ_WOUT), T, D, D}; pg8::StaticOrder S; S.init(T, D, G, bx);
            pg8::FEpiRes E{l ? (const float*)(ws + WS_ST2) : (const float*)nullptr, a.in[14] + (l ? l - 1 : 0) * 1024, a.in[15] + (l ? l - 1 : 0) * 1024, (bf16_t*)(ws + WS_XB), (float*)(ws + WS_ST1)};
            pg8::gemm_phase<pg8::FEpiRes, pg8::StaticOrder, true, true>(ldsl + RING_OFF, g, S, E);
        } else if (kind == PH_GU) {
            pg8::Gemm g{(const bf16_t*)(ws + WS_XB), (const bf16_t*)(ws + WS_WGU + l * SZ_WGU), T, NGU, D}; pg8::StaticOrder S; S.init(T, NGU, G, bx);
            pg8::FEpiGU E{(const float*)(ws + WS_ST1), (const float*)(ws + V_C1GU) + l * NGU, (const float*)(ws + V_C2GU) + l * NGU, (bf16_t*)(ws + WS_ACT)};
            pg8::gemm_phase<pg8::FEpiGU, pg8::StaticOrder, true, true>(ldsl + RING_OFF, g, S, E);
        } else if (kind == PH_DN) {
            pg8::Gemm g{(const bf16_t*)(ws + WS_ACT), (const bf16_t*)(ws + WS_WDN + l * SZ_WDN), T, D, FF}; pg8::StaticOrder S; S.init(T, D, G, bx);
            pg8::FEpiRes E{(const float*)(ws + WS_ST1), a.in[9] + l * 1024, a.in[10] + l * 1024, (bf16_t*)(ws + WS_XB), (float*)(ws + WS_ST2)};
            pg8::gemm_phase<pg8::FEpiRes, pg8::StaticOrder, true, true>(ldsl + RING_OFF, g, S, E);
        } else if (kind == PH_FIN) {
            const float* g2 = a.in[14] + 1024; const float* b2v = a.in[15] + 1024; const float* ST2 = (const float*)(ws + WS_ST2); const bf16_t* XB = (const bf16_t*)(ws + WS_XB); float* Y2 = a.out;
            int tid_f = threadIdx.x; asm volatile("" : "+v"(tid_f)); const int lane = tid_f & 63, wave = __builtin_amdgcn_readfirstlane(tid_f >> 6);
            typedef float f32x4 __attribute__((ext_vector_type(4))); typedef unsigned u32x2 __attribute__((ext_vector_type(2)));
            f32x4 gg[4], bq[4];
#pragma unroll
            for (int j = 0; j < 4; ++j) { gg[j] = *((const f32x4*)g2 + lane + 64 * j); bq[j] = *((const f32x4*)b2v + lane + 64 * j); }
            for (int row = vcu * NWAVES + wave; row < T; row += G * NWAVES) { const RowStat rs = row_stat(ST2, row);
                const u32x2* xr = (const u32x2*)(XB + (size_t)row * 1024) + lane; f32x4* yr = (f32x4*)(Y2 + (size_t)row * 1024) + lane;
#pragma unroll
                for (int j = 0; j < 4; ++j) { const u32x2 w = xr[64 * j]; const f32x4 v = {__uint_as_float(w.x << 16), __uint_as_float(w.x & 0xffff0000u), __uint_as_float(w.y << 16), __uint_as_float(w.y & 0xffff0000u)};
                    yr[64 * j] = (v - rs.mu) * rs.rstd * gg[j] + bq[j]; } }
        }
        if (ph + 1 < a.ph_hi) xcd_barrier(bar);
    }
}

static void launch_frame(const MArgs& base, int lo, int hi, int grid, hipStream_t stream, int li = 0) {
    MArgs a = base; a.ph_lo = lo; a.ph_hi = hi; a.li = li;
    hipLaunchKernelGGL(mk_fwd, dim3(grid), dim3(NWAVES * 64), LDS_BYTES, stream, a);
}
extern "C" void kernel_launch(void* const* d_in, const int* in_sizes, int n_in, void* d_out, int out_size, void* d_ws, size_t ws_size, hipStream_t stream) {
    static int grid = 0;
    if (grid == 0) {
        if (n_in != 16 || in_sizes[0] != T * D || out_size != T * D || ws_size < WS_END) { fprintf(stderr, "kernel_launch: unexpected shapes (n_in %d, in0 %d, out %d, ws %zu)\n", n_in, n_in > 0 ? in_sizes[0] : -1, out_size, ws_size); grid = -1; return; }
        int dev = 0, cus = 0, per_cu = 0;
        if (hipGetDevice(&dev) != hipSuccess || hipDeviceGetAttribute(&cus, hipDeviceAttributeMultiprocessorCount, dev) != hipSuccess) { grid = -1; return; }
        if (hipFuncSetAttribute((const void*)mk_fwd, hipFuncAttributeMaxDynamicSharedMemorySize, LDS_BYTES) != hipSuccess) { fprintf(stderr, "kernel_launch: hipFuncSetAttribute failed\n"); grid = -1; return; }
        if (hipOccupancyMaxActiveBlocksPerMultiprocessor(&per_cu, (const void*)mk_fwd, NWAVES * 64, LDS_BYTES) != hipSuccess || per_cu < 1) { fprintf(stderr, "kernel_launch: occupancy query says %d workgroups per CU\n", per_cu); per_cu = 1; }
        (void)hipGetLastError();
        grid = cus;
        if (grid != 256) { fprintf(stderr, "kernel_launch: this kernel's work split is built for the 256 CUs of an MI355X, found %d; nothing launched\n", cus); grid = -1; return; }
    }
    if (grid < 0) return;
    const float* x = (const float*)d_in[0]; const float* w_in = (const float*)d_in[1]; const float* dlam = (const float*)d_in[2]; const float* dng = (const float*)d_in[3];
    const float* fw = (const float*)d_in[4]; const float* gw2 = (const float*)d_in[5]; const float* gb2 = (const float*)d_in[6]; const float* gng = (const float*)d_in[7];
    const float* w_out = (const float*)d_in[8]; const float* ln1g = (const float*)d_in[9]; const float* ln1b = (const float*)d_in[10];
    const float* wg = (const float*)d_in[11]; const float* wu = (const float*)d_in[12]; const float* wd = (const float*)d_in[13]; const float* ln2g = (const float*)d_in[14]; const float* ln2b = (const float*)d_in[15];
    char* ws = (char*)d_ws;
    float* ropec = (float*)(ws + V_ROPEC); float* ropes = (float*)(ws + V_ROPES); float* MF = (float*)(ws + V_MF);
    float* c1in = (float*)(ws + V_C1IN); float* c2in = (float*)(ws + V_C2IN); float* c1gu = (float*)(ws + V_C1GU); float* c2gu = (float*)(ws + V_C2GU);
    bf16_t* TAB = (bf16_t*)(ws + WS_TAB); bf16_t* XB = (bf16_t*)(ws + WS_XB);
    bf16_t* Q = (bf16_t*)(ws + WS_Q); bf16_t* K = (bf16_t*)(ws + WS_K); bf16_t* V = (bf16_t*)(ws + WS_V);
    bf16_t* GQK = (bf16_t*)(ws + WS_GQK); bf16_t* GV = (bf16_t*)(ws + WS_GV); bf16_t* GR = (bf16_t*)(ws + WS_GR); float* GL = (float*)(ws + WS_GL);
    bf16_t* OC = (bf16_t*)(ws + WS_OC); float* OF = (float*)(ws + WS_OF);
    (void)hipMemsetAsync(ws + WS_CTL, 0, CTL_ZERO_BYTES, stream);
    MArgs base{}; for (int i = 0; i < 16; ++i) base.in[i] = (const float*)d_in[i]; base.out = (float*)d_out; base.ws = (unsigned char*)d_ws;
    launch_frame(base, 0, N_PHASES, grid, stream, 0);
}
```

```cpp
#include <hip/hip_runtime.h>
#include <cstdint>
#include <cstdio>
#include <cmath>

typedef unsigned short bf16_t;
namespace cfg {
constexpr int B = 8, S = 2048, D = 1024, T = B * S, L = 2;
constexpr int INW = 2592, NIN = 3072, FF = 2816, NGU = 2 * FF;
constexpr float ALPHA = 1.41421356237309515f;
constexpr float EPS = 1e-5f;
constexpr float QSCALE = 0.125f * 1.4426950408889634f;
constexpr float GQSCALE = 0.17677669529663687f;
constexpr size_t MiB = 1u << 20;
constexpr size_t WS_CTL = 0;
constexpr size_t WS_VEC = 1 * MiB;
constexpr size_t V_ROPEC = WS_VEC, V_ROPES = WS_VEC + 256 * 1024, V_MF = WS_VEC + 512 * 1024;
constexpr size_t V_C1IN = WS_VEC + 768 * 1024, V_C2IN = V_C1IN + 24 * 1024, V_C1GU = V_C2IN + 24 * 1024, V_C2GU = V_C1GU + 44 * 1024;
constexpr size_t WS_WIN = 2 * MiB, WS_WOUT = 14 * MiB, WS_WGU = 18 * MiB, WS_WDN = 40 * MiB, WS_TAB = 51 * MiB;
constexpr size_t SZ_WIN = 6 * MiB, SZ_WOUT = 2 * MiB, SZ_WGU = 11 * MiB, SZ_WDN = 5632 * 1024;
constexpr size_t WS_XB = 67 * MiB;
constexpr size_t WS_Y1 = 99 * MiB, WS_Q = 99 * MiB, WS_K = 115 * MiB, WS_V = 131 * MiB, WS_XT = 147 * MiB;
constexpr size_t WS_ACT = 163 * MiB, WS_GQK = 163 * MiB, WS_GV = 171 * MiB, WS_GR = 179 * MiB, WS_GL = 187 * MiB, WS_OC = 203 * MiB, WS_OF = 235 * MiB;
constexpr size_t WS_ST1 = 251 * MiB, WS_ST2 = 253 * MiB, WS_DEC = 255 * MiB, WS_END = 256 * MiB;
}
using namespace cfg;

__device__ __forceinline__ float bf2f(bf16_t v) { return __uint_as_float((unsigned)v << 16); }
__device__ __forceinline__ bf16_t f2bf(float f) { unsigned u = __float_as_uint(f); return (bf16_t)((u + 0x7fffu + ((u >> 16) & 1u)) >> 16); }


template <int M> __device__ __forceinline__ float xadd(float v) {
    if constexpr (M == 32) { auto r = __builtin_amdgcn_permlane32_swap(__float_as_uint(v), __float_as_uint(v), false, false); return __uint_as_float(r[0]) + __uint_as_float(r[1]); }
    else return v + __int_as_float(__builtin_amdgcn_ds_swizzle(__float_as_int(v), (M << 10) | 0x1f));
}
struct RowStat { float mu, rstd; };
__device__ __forceinline__ RowStat row_stat(const float* ST, int row) {
    float s = 0.f, ss = 0.f;
    for (int i = 0; i < 8; ++i) { const float4 a = *(const float4*)(ST + (size_t)row * 32 + 4 * i); s += a.x + a.z; ss += a.y + a.w; }
    const float mu = s * (1.f / 1024.f); const float var = ss * (1.f / 1024.f) - mu * mu;
    RowStat r; r.mu = mu; r.rstd = rsqrtf(fmaxf(var, 0.f) + EPS); return r;
}
namespace pg8 {
#define PG8_LAS __attribute__((address_space(3)))
typedef unsigned short bf16_t;
typedef short bf16x8 __attribute__((ext_vector_type(8)));
typedef float f32x4 __attribute__((ext_vector_type(4)));
typedef unsigned u32x4 __attribute__((ext_vector_type(4)));
constexpr int BM = 256, BK = 64, HALF = 128, HTB = HALF * BK * 2  , STAGE_BYTES = 8 * HTB, NXCD = 8, WGM = 8;

__host__ __device__ __forceinline__ int lds_byte(int r, int c) { const int st = (r >> 4) * 2 + (c >> 5), rr = r & 15, cc = c & 31, ob = rr * 64 + cc * 2; return st * 1024 + (ob ^ (((ob >> 9) & 1) << 5)); }
__host__ __device__ __forceinline__ void stage_rc(int b, int& R, int& C) { const int st = b / 1024, sb = b % 1024, swz = sb ^ (((sb >> 9) & 1) << 5); R = (st >> 1) * 16 + swz / 64; C = (st & 1) * 32 + (swz % 64) / 2; }
__host__ __device__ __forceinline__ int perm32(int rho) { const int n = rho >> 4, i = rho & 15; return 8 * (i >> 2) + 4 * n + (i & 3); }

struct Unit { int pm, pn; };
struct Gemm { const bf16_t* A; const bf16_t* Bt; int M, N, K; };

struct StaticOrder {
    int nM, nN, nwg, G, c;
    __host__ __device__ void init(int M, int N, int G_, int c_) { nM = M / BM; nN = N / BM; nwg = nM * nN; G = G_; c = c_; }
    __host__ __device__ bool next(int i, Unit& u) const {
        const long L = (long)i * G + c; if (L >= nwg) return false;
        int wgid = (int)L; { const int q = nwg / NXCD, r = nwg % NXCD, xcd = wgid % NXCD, off = wgid / NXCD; wgid = (xcd < r ? xcd * (q + 1) : r * (q + 1) + (xcd - r) * q) + off; }
        const int nig = WGM * nN, gid = wgid / nig, fm = gid * WGM, gsz = (nM - fm) < WGM ? (nM - fm) : WGM;
        u.pm = fm + ((wgid % nig) % gsz); u.pn = (wgid % nig) / gsz; return true;
    }
    __device__ __forceinline__ void a_ready(const Unit&) const {}
    __device__ __forceinline__ void done(const Unit&) const {}
};
template <class Epi, class Sched, bool ALIGN_EPI = false, bool SP2 = false>
__device__ __forceinline__ void gemm_phase(PG8_LAS unsigned char* lds, const Gemm g, const Sched& S, const Epi& E) {
    int tid_o = threadIdx.x; asm volatile("" : "+v"(tid_o));
    const int tid = tid_o, wid = __builtin_amdgcn_readfirstlane(tid >> 6), lane = tid & 63, wr = wid >> 2, wc = wid & 3, fr = lane & 15, fq = lane >> 4;
    const int K = g.K, nt = K / BK;
    unsigned voffA[2], voffB[2];
#pragma unroll
    for (int i = 0; i < 2; ++i) { int R, C; stage_rc(tid * 16 + i * 8192, R, C); const int Rb = Epi::PERM ? ((R & ~31) + perm32(R & 31)) : R;
        voffA[i] = (unsigned)(R * K + C) * 2u; voffB[i] = (unsigned)(Rb * K + C) * 2u; }
    const size_t kstep = (size_t)(BK * 2);
    const size_t hstep = (size_t)HALF * K * 2;
    const size_t tstep = 2 * hstep;
    const unsigned ldsw = (unsigned)wid * 1024u;
    const int aoff = lds_byte(wr * 64 + fr, fq * 8), boff = lds_byte(wc * 32 + fr, fq * 8);
#define PG8_SA(b, h) (((b) * 2 + (h)) * HTB)
#define PG8_SB(b, h) ((4 + (b) * 2 + (h)) * HTB)
#define PG8_STAGE(bufoff, gbase, voff) do { _Pragma("unroll") for (int _i = 0; _i < 2; ++_i) \
        __builtin_amdgcn_global_load_lds((const unsigned*)((const char*)(gbase) + (voff)[_i]), (PG8_LAS unsigned*)(lds + (bufoff) + ldsw + _i * 8192), 16, 0, 0); } while (0)
#define PG8_LDA(dst, b, h) do { _Pragma("unroll") for (int m = 0; m < 4; ++m) _Pragma("unroll") for (int k = 0; k < 2; ++k) dst[m][k] = *(const PG8_LAS bf16x8*)(lds + PG8_SA(b, h) + aoff + m * 2048 + k * 1024); } while (0)
#define PG8_LDB(dst, b, h) do { _Pragma("unroll") for (int n = 0; n < 2; ++n) _Pragma("unroll") for (int k = 0; k < 2; ++k) dst[n][k] = *(const PG8_LAS bf16x8*)(lds + PG8_SB(b, h) + boff + n * 2048 + k * 1024); } while (0)
#define PG8_MMA(ai, bj, At, Bt) do { __builtin_amdgcn_s_setprio(1); _Pragma("unroll") for (int m = 0; m < 4; ++m) _Pragma("unroll") for (int n = 0; n < 2; ++n) _Pragma("unroll") for (int k = 0; k < 2; ++k) \
        acc[ai][bj][m][n] = __builtin_amdgcn_mfma_f32_16x16x32_bf16(Bt[n][k], At[m][k], acc[ai][bj][m][n], 0, 0, 0); __builtin_amdgcn_s_setprio(0); } while (0)
#define PG8_WAIT_V(n) asm volatile("s_waitcnt vmcnt(" #n ")" ::: "memory")
#define PG8_WAIT_L(n) asm volatile("s_waitcnt lgkmcnt(" #n ")" ::: "memory")
#define PG8_BAR __builtin_amdgcn_s_barrier()
#define PG8_SCHED __builtin_amdgcn_sched_barrier(0)
    Unit cur, nxt; int ui = 0;
    if (!S.next(0, cur)) return;
    f32x4 acc[2][2][4][2];
#pragma unroll
    for (int a = 0; a < 2; ++a)
#pragma unroll
        for (int b = 0; b < 2; ++b)
#pragma unroll
            for (int m = 0; m < 4; ++m)
#pragma unroll
                for (int n = 0; n < 2; ++n) acc[a][b][m][n] = (f32x4){0.f, 0.f, 0.f, 0.f};
    bf16x8 At[4][2], B0[2][2], B1[2][2];
    const char* cA = (const char*)g.A + (size_t)cur.pm * tstep; const char* cB = (const char*)g.Bt + (size_t)cur.pn * tstep;
    S.a_ready(cur);
    if constexpr (SP2) {
        PG8_STAGE(PG8_SB(0, 0), cB, voffB); PG8_STAGE(PG8_SB(0, 1), cB + hstep, voffB); PG8_STAGE(PG8_SA(0, 0), cA, voffA); PG8_STAGE(PG8_SA(0, 1), cA + hstep, voffA);
        if (wr == 1) PG8_BAR;
        PG8_WAIT_V(2); PG8_BAR;
        PG8_STAGE(PG8_SB(1, 0), cB + kstep, voffB); PG8_STAGE(PG8_SA(1, 0), cA + kstep, voffA); PG8_STAGE(PG8_SB(1, 1), cB + hstep + kstep, voffB);
        PG8_WAIT_V(6); PG8_BAR;
    } else {
        PG8_STAGE(PG8_SB(0, 0), cB, voffB); PG8_STAGE(PG8_SA(0, 0), cA, voffA); PG8_STAGE(PG8_SB(0, 1), cB + hstep, voffB); PG8_STAGE(PG8_SA(0, 1), cA + hstep, voffA);
        if (wr == 1) PG8_BAR;
        PG8_WAIT_V(4); PG8_BAR;
        PG8_STAGE(PG8_SB(1, 0), cB + kstep, voffB); PG8_STAGE(PG8_SA(1, 0), cA + kstep, voffA); PG8_STAGE(PG8_SB(1, 1), cB + hstep + kstep, voffB);
        PG8_WAIT_V(6); PG8_BAR;
    }
    for (;;) {
        const bool has_next = S.next(ui + 1, nxt);
        const char* nA = has_next ? (const char*)g.A + (size_t)nxt.pm * tstep : cA; const char* nB = has_next ? (const char*)g.Bt + (size_t)nxt.pn * tstep : cB;
        for (int t = 0; t < nt; t += 2) {
            const bool last = (t == nt - 2);
            const char* a1 = cA + (size_t)(t + 1) * kstep;
            const char* a2 = last ? nA : cA + (size_t)(t + 2) * kstep; const char* b2 = last ? nB : cB + (size_t)(t + 2) * kstep;
            const char* a3 = a2 + kstep; const char* b3 = b2 + kstep;
            if (last && has_next) S.a_ready(nxt);
            if constexpr (SP2) {
            PG8_LDB(B0, 0, 0); PG8_LDB(B1, 0, 1); PG8_SCHED; PG8_LDA(At, 0, 0); PG8_STAGE(PG8_SA(1, 1), a1 + hstep, voffA);
            PG8_WAIT_V(8); PG8_WAIT_L(0); PG8_BAR; PG8_MMA(0, 0, At, B0); PG8_MMA(0, 1, At, B1); PG8_BAR; PG8_SCHED;
            PG8_LDA(At, 0, 1); PG8_STAGE(PG8_SB(0, 0), b2, voffB); PG8_STAGE(PG8_SB(0, 1), b2 + hstep, voffB); PG8_STAGE(PG8_SA(0, 0), a2, voffA);
            PG8_WAIT_V(8); PG8_WAIT_L(0); PG8_BAR; PG8_MMA(1, 0, At, B0); PG8_MMA(1, 1, At, B1); PG8_BAR; PG8_SCHED;
            PG8_LDB(B0, 1, 0); PG8_LDB(B1, 1, 1); PG8_SCHED; PG8_LDA(At, 1, 0); PG8_STAGE(PG8_SA(0, 1), a2 + hstep, voffA);
            PG8_WAIT_V(8); PG8_WAIT_L(0); PG8_BAR; PG8_MMA(0, 0, At, B0); PG8_MMA(0, 1, At, B1); PG8_BAR; PG8_SCHED;
            PG8_LDA(At, 1, 1); PG8_STAGE(PG8_SB(1, 0), b3, voffB); PG8_STAGE(PG8_SB(1, 1), b3 + hstep, voffB); PG8_STAGE(PG8_SA(1, 0), a3, voffA);
            PG8_WAIT_V(8); PG8_WAIT_L(0); PG8_BAR; PG8_MMA(1, 0, At, B0); PG8_MMA(1, 1, At, B1); PG8_BAR; PG8_SCHED;
            } else {
            PG8_LDB(B0, 0, 0); PG8_SCHED; PG8_LDA(At, 0, 0); PG8_STAGE(PG8_SA(1, 1), a1 + hstep, voffA);
            PG8_WAIT_L(8); PG8_BAR; PG8_WAIT_L(0); PG8_MMA(0, 0, At, B0); PG8_BAR; PG8_SCHED;
            PG8_LDB(B1, 0, 1); PG8_STAGE(PG8_SB(0, 0), b2, voffB);
            PG8_BAR; PG8_WAIT_L(0); PG8_MMA(0, 1, At, B1); PG8_BAR;
            PG8_LDA(At, 0, 1); PG8_STAGE(PG8_SA(0, 0), a2, voffA);
            PG8_BAR; PG8_WAIT_L(0); PG8_MMA(1, 0, At, B0); PG8_BAR; PG8_SCHED;
            PG8_STAGE(PG8_SB(0, 1), b2 + hstep, voffB);
            PG8_WAIT_V(6); PG8_BAR; PG8_MMA(1, 1, At, B1); PG8_BAR;
            PG8_LDB(B0, 1, 0); PG8_SCHED; PG8_LDA(At, 1, 0); PG8_STAGE(PG8_SA(0, 1), a2 + hstep, voffA);
            PG8_WAIT_L(8); PG8_BAR; PG8_WAIT_L(0); PG8_MMA(0, 0, At, B0); PG8_BAR; PG8_SCHED;
            PG8_LDB(B1, 1, 1); PG8_STAGE(PG8_SB(1, 0), b3, voffB);
            PG8_BAR; PG8_WAIT_L(0); PG8_MMA(0, 1, At, B1); PG8_BAR;
            PG8_LDA(At, 1, 1); PG8_STAGE(PG8_SA(1, 0), a3, voffA);
            PG8_BAR; PG8_WAIT_L(0); PG8_MMA(1, 0, At, B0); PG8_BAR; PG8_SCHED;
            PG8_STAGE(PG8_SB(1, 1), b3 + hstep, voffB);
            PG8_WAIT_V(6); PG8_BAR; PG8_MMA(1, 1, At, B1); PG8_BAR;
            }
        }
        if constexpr (ALIGN_EPI) { if (wr == 0) PG8_BAR; }
        if constexpr (!Epi::AFTER_DRAIN) { E(acc, cur, wr, wc, fr, fq); S.done(cur); }
        if (!has_next) break;
#pragma unroll
        for (int a = 0; a < 2; ++a)
#pragma unroll
            for (int b = 0; b < 2; ++b)
#pragma unroll
                for (int m = 0; m < 4; ++m)
#pragma unroll
                    for (int n = 0; n < 2; ++n) acc[a][b][m][n] = (f32x4){0.f, 0.f, 0.f, 0.f};
        cur = nxt; cA = nA; cB = nB; ++ui;
        if constexpr (ALIGN_EPI) { if (wr == 1) PG8_BAR; }
    }
    PG8_WAIT_V(0);
    if constexpr (!ALIGN_EPI) { if (wr == 0) PG8_BAR; }
    PG8_BAR;
    if constexpr (Epi::AFTER_DRAIN) { E.fused(acc, cur, wr, wc, fr, fq, lds, wid, lane); S.done(cur); }
#undef PG8_SA
#undef PG8_SB
#undef PG8_STAGE
#undef PG8_LDA
#undef PG8_LDB
#undef PG8_MMA
#undef PG8_WAIT_V
#undef PG8_WAIT_L
#undef PG8_BAR
#undef PG8_SCHED
}
}
namespace pg8 {
__device__ __forceinline__ unsigned cvt_pk_bf16(float lo, float hi) { unsigned r; asm volatile("v_cvt_pk_bf16_f32 %0, %1, %2" : "=v"(r) : "v"(lo), "v"(hi)); return r; }
__device__ __forceinline__ void st8(bf16_t* p, const f32x4 a, const f32x4 b) { u32x4 w; w.x = cvt_pk_bf16(a[0], a[1]); w.y = cvt_pk_bf16(a[2], a[3]); w.z = cvt_pk_bf16(b[0], b[1]); w.w = cvt_pk_bf16(b[2], b[3]); *(u32x4*)p = w; }
__device__ __forceinline__ void st8nt(bf16_t* p, const f32x4 a, const f32x4 b) { u32x4 w; w.x = cvt_pk_bf16(a[0], a[1]); w.y = cvt_pk_bf16(a[2], a[3]); w.z = cvt_pk_bf16(b[0], b[1]); w.w = cvt_pk_bf16(b[2], b[3]); __builtin_nontemporal_store(w, (u32x4*)p); }
struct RS { float a, b; };
struct StatLd { f32x4 x, y; };
__device__ __forceinline__ StatLd stat_load(const float* ST, int row, int fq) { const f32x4* p = (const f32x4*)(ST + (size_t)row * 32 + fq * 8); StatLd r; r.x = p[0]; r.y = p[1]; return r; }
__device__ __forceinline__ RS stat_fin(const StatLd& t) {
    float s = (t.x[0] + t.x[2]) + (t.y[0] + t.y[2]), ss = (t.x[1] + t.x[3]) + (t.y[1] + t.y[3]);
    s = xadd<16>(s); ss = xadd<16>(ss); s = xadd<32>(s); ss = xadd<32>(ss);
    const float mu = s * (1.f / 1024.f), var = ss * (1.f / 1024.f) - mu * mu, rstd = rsqrtf(fmaxf(var, 0.f) + cfg::EPS);
    RS r; r.a = rstd; r.b = -rstd * mu; return r;
}
__device__ __forceinline__ RS row_stat16(const float* ST, int row, int fq) { return stat_fin(stat_load(ST, row, fq)); }
__device__ __forceinline__ float fsilu(float x) { return x * __builtin_amdgcn_rcpf(1.f + __expf(-x)); }
__device__ __forceinline__ float flogsig16(float x) { return (fminf(x, 0.f) - __logf(1.f + __expf(-fabsf(x)))) * (1.f / 16.f); }

struct FEpiIn {
    static constexpr bool PERM = true, AFTER_DRAIN = false;
    unsigned char* ws; const float* b2; int l;
    struct RowLd { StatLd t; f32x4 rc[2], rsn[2]; };
    template <int KIND> __device__ __forceinline__ RowLd load_row(const float* st, int row, int fq) const {
        RowLd r; if constexpr (KIND != 0) { if (st) r.t = stat_load(st, row, fq); }
        if constexpr (KIND == 0) { const int pos = row & 2047; const float* cp = (const float*)(ws + cfg::V_ROPEC) + pos * 32 + 8 * fq; const float* sp = (const float*)(ws + cfg::V_ROPES) + pos * 32 + 8 * fq;
            r.rc[0] = *(const f32x4*)cp; r.rc[1] = *(const f32x4*)(cp + 4); r.rsn[0] = *(const f32x4*)sp; r.rsn[1] = *(const f32x4*)(sp + 4); }
        return r;
    }
    template <int KIND> __device__ __forceinline__ void rows(const f32x4 (&acc)[2][2][4][2], const Unit& u, int wr, int wc, int fr, int fq) const {
        const int pn = u.pn, cw = 32 * wc + 8 * fq, row0 = u.pm * BM + 64 * wr + fr;
        const float* st = l ? (const float*)(ws + cfg::WS_ST2) : (const float*)nullptr;
        f32x4 k1[2][2], k2[2][2], bias[2][2];
        const float qs = __uint_as_float(__builtin_amdgcn_readfirstlane(__float_as_uint(pn < 2 ? cfg::QSCALE : 1.f)));
        RS rsa[8];
        if constexpr (KIND == 0) { if (st) { StatLd t[8];
#pragma unroll
            for (int i = 0; i < 8; ++i) t[i] = stat_load(st, row0 + 128 * (i >> 2) + 16 * (i & 3), fq);
#pragma unroll
            for (int i = 0; i < 8; ++i) rsa[i] = stat_fin(t[i]); } }
        RowLd cur = load_row<KIND>(st, row0, fq), nxt;
        if (st) {
#pragma unroll
            for (int bj = 0; bj < 2; ++bj)
#pragma unroll
                for (int n = 0; n < 2; ++n) {
                    if constexpr (KIND == 2) {
                        const float* fp = (const float*)(ws + cfg::V_MF) + (size_t)(l * 8) * 512 + (pn - 6) * 256 + cw + 128 * bj + 4 * n;
                        k1[bj][n] = (*(const f32x4*)fp + *(const f32x4*)(fp + 1024)) + (*(const f32x4*)(fp + 2048) + *(const f32x4*)(fp + 3072));
                        k2[bj][n] = (*(const f32x4*)(fp + 512) + *(const f32x4*)(fp + 1536)) + (*(const f32x4*)(fp + 2560) + *(const f32x4*)(fp + 3584));
                    } else { const float* c1 = (const float*)(ws + cfg::V_C1IN) + l * cfg::NIN + pn * 256 + cw; const float* c2 = (const float*)(ws + cfg::V_C2IN) + l * cfg::NIN + pn * 256 + cw;
                        k1[bj][n] = *(const f32x4*)(c1 + 128 * bj + 4 * n); k2[bj][n] = *(const f32x4*)(c2 + 128 * bj + 4 * n); } } }
        if constexpr (KIND == 6) {
#pragma unroll
            for (int bj = 0; bj < 2; ++bj)
#pragma unroll
                for (int n = 0; n < 2; ++n) bias[bj][n] = *(const f32x4*)(b2 + 128 * bj + cw + 4 * n); }
#pragma unroll
        for (int i = 0; i < 8; ++i) {
            const int ai = i >> 2, m = i & 3, row = row0 + 128 * ai + 16 * m, pos = row & 2047;
            if (i < 7) nxt = load_row<KIND>(st, row0 + 128 * ((i + 1) >> 2) + 16 * ((i + 1) & 3), fq);
            f32x4 v[2][2];
            if (st) { RS rs; if constexpr (KIND == 0) rs = rsa[i]; else rs = stat_fin(cur.t);
#pragma unroll
                for (int bj = 0; bj < 2; ++bj)
#pragma unroll
                    for (int n = 0; n < 2; ++n) v[bj][n] = rs.a * acc[ai][bj][m][n] + (rs.b * k1[bj][n] + k2[bj][n]);
            } else {
#pragma unroll
                for (int bj = 0; bj < 2; ++bj)
#pragma unroll
                    for (int n = 0; n < 2; ++n) v[bj][n] = acc[ai][bj][m][n]; }
            if constexpr (KIND == 0) {
                f32x4 a0 = v[0][0] * cur.rc[0] - v[1][0] * cur.rsn[0], a1 = v[0][1] * cur.rc[1] - v[1][1] * cur.rsn[1];
                f32x4 b0 = v[1][0] * cur.rc[0] + v[0][0] * cur.rsn[0], b1 = v[1][1] * cur.rc[1] + v[0][1] * cur.rsn[1];
                a0 = a0 * qs; a1 = a1 * qs; b0 = b0 * qs; b1 = b1 * qs;
                bf16_t* dst = (bf16_t*)(ws + (pn < 2 ? cfg::WS_Q : cfg::WS_K)) + (size_t)row * 512 + (4 * (pn & 1) + wc) * 64 + 8 * fq;
                st8(dst, a0, a1); st8(dst + 32, b0, b1);
            } else if constexpr (KIND == 1) {
                bf16_t* dst = (bf16_t*)(ws + cfg::WS_V) + (size_t)row * 512 + (pn - 4) * 256 + cw; st8(dst, v[0][0], v[0][1]); st8(dst + 128, v[1][0], v[1][1]);
            } else if constexpr (KIND == 2) {
                bf16_t* dst = (bf16_t*)(ws + cfg::WS_TAB) + (size_t)row * 512 + (pn - 6) * 256 + cw; st8(dst, v[0][0], v[0][1]); st8(dst + 128, v[1][0], v[1][1]);
            } else if constexpr (KIND == 3) {
                bf16_t* dst = (bf16_t*)(ws + cfg::WS_GQK) + (size_t)row * 256 + cw; st8(dst, v[0][0] * cfg::GQSCALE, v[0][1] * cfg::GQSCALE); st8(dst + 128, v[1][0], v[1][1]);
            } else if constexpr (KIND == 4) {
                bf16_t* dst = (bf16_t*)(ws + cfg::WS_GV) + (size_t)row * 256 + cw; st8(dst, v[0][0], v[0][1]); st8(dst + 128, v[1][0], v[1][1]);
            } else if constexpr (KIND == 5) {
                bf16_t* dst = (bf16_t*)(ws + cfg::WS_GR) + (size_t)row * 256 + cw;
#pragma unroll
                for (int bj = 0; bj < 2; ++bj) { f32x4 x0 = v[bj][0], x1 = v[bj][1];
#pragma unroll
                    for (int e = 0; e < 4; ++e) { x0[e] = fsilu(x0[e]); x1[e] = fsilu(x1[e]); } st8(dst + 128 * bj, x0, x1); }
            } else {
                float* dst = (float*)(ws + cfg::WS_GL) + (size_t)row * 256 + cw;
#pragma unroll
                for (int bj = 0; bj < 2; ++bj)
#pragma unroll
                    for (int n = 0; n < 2; ++n) { f32x4 x = v[bj][n] + bias[bj][n];
#pragma unroll
                        for (int e = 0; e < 4; ++e) x[e] = flogsig16(x[e]); *(f32x4*)(dst + 128 * bj + 4 * n) = x; }
            }
            if (i < 7) cur = nxt;
        }
    }
    __device__ __forceinline__ void operator()(const f32x4 (&acc)[2][2][4][2], const Unit& u, int wr, int wc, int fr, int fq) const {
        asm volatile("" : "+v"(fr), "+v"(fq));
        unsigned zo = 0u; asm volatile("" : "+s"(zo)); FEpiIn me = *this; me.ws = ws + zo;
        const int pn = u.pn;
        if (pn < 4) me.rows<0>(acc, u, wr, wc, fr, fq); else if (pn < 6) me.rows<1>(acc, u, wr, wc, fr, fq); else if (pn < 8) me.rows<2>(acc, u, wr, wc, fr, fq);
        else if (pn == 8) me.rows<3>(acc, u, wr, wc, fr, fq); else if (pn == 9) me.rows<4>(acc, u, wr, wc, fr, fq); else if (pn == 10) me.rows<5>(acc, u, wr, wc, fr, fq); else me.rows<6>(acc, u, wr, wc, fr, fq);
    }
};
struct FEpiRes {
    static constexpr bool PERM = true, AFTER_DRAIN = false;
    const float* stprev; const float* g; const float* bb; bf16_t* XB; float* ST;
    struct RowLd { u32x4 xb[2]; StatLd t; };
    __device__ __forceinline__ RowLd load_row(int row, int col0, int fq) const {
        RowLd r; const size_t off = (size_t)row * 1024 + col0;
        r.xb[0] = *(const u32x4*)(XB + off); r.xb[1] = *(const u32x4*)(XB + off + 128); if (stprev) r.t = stat_load(stprev, row, fq);
        return r;
    }
    __device__ __forceinline__ void operator()(const f32x4 (&acc)[2][2][4][2], const Unit& u, int wr, int wc, int fr, int fq) const {
        asm volatile("" : "+v"(fr), "+v"(fq));
        const int col0 = u.pn * BM + 32 * wc + 8 * fq, row0 = u.pm * BM + 64 * wr + fr;
        f32x4 gv[2][2], bv[2][2];
        RowLd cur = load_row(row0, col0, fq), nxt;
        if (stprev) {
#pragma unroll
            for (int bj = 0; bj < 2; ++bj)
#pragma unroll
                for (int n = 0; n < 2; ++n) { gv[bj][n] = *(const f32x4*)(g + col0 + 128 * bj + 4 * n); bv[bj][n] = *(const f32x4*)(bb + col0 + 128 * bj + 4 * n); } }
#pragma unroll
        for (int i = 0; i < 8; ++i) { const int ai = i >> 2, m = i & 3, row = row0 + 128 * ai + 16 * m; const size_t off = (size_t)row * 1024 + col0;
            if (i < 7) nxt = load_row(row0 + 128 * ((i + 1) >> 2) + 16 * ((i + 1) & 3), col0, fq);
            RS rs; rs.a = 1.f; rs.b = 0.f; if (stprev) rs = stat_fin(cur.t);
            float s = 0.f, ss = 0.f;
#pragma unroll
            for (int bj = 0; bj < 2; ++bj) { f32x4 y[2];
#pragma unroll
                for (int n = 0; n < 2; ++n) { const unsigned w0 = cur.xb[bj][2 * n], w1 = cur.xb[bj][2 * n + 1];
                    f32x4 x = (f32x4){__uint_as_float(w0 << 16), __uint_as_float(w0 & 0xffff0000u), __uint_as_float(w1 << 16), __uint_as_float(w1 & 0xffff0000u)};
                    if (stprev) x = (rs.a * x + rs.b) * gv[bj][n] + bv[bj][n];
                    y[n] = cfg::ALPHA * x + acc[ai][bj][m][n];
                    s += (y[n][0] + y[n][1]) + (y[n][2] + y[n][3]); ss += (y[n][0] * y[n][0] + y[n][1] * y[n][1]) + (y[n][2] * y[n][2] + y[n][3] * y[n][3]); }
                st8nt(XB + off + 128 * bj, y[0], y[1]); }
            s = xadd<16>(s); ss = xadd<16>(ss); s = xadd<32>(s); ss = xadd<32>(ss);
            if (fq == 0) { typedef float f32x2 __attribute__((ext_vector_type(2))); *(f32x2*)(ST + (size_t)row * 32 + (u.pn * 4 + wc) * 2) = (f32x2){s, ss}; }
            if (i < 7) cur = nxt; }
    }
};
struct FEpiGU {
    static constexpr bool PERM = true, AFTER_DRAIN = false;
    const float* st; const float* c1; const float* c2; bf16_t* ACT;
    __device__ __forceinline__ void operator()(const f32x4 (&acc)[2][2][4][2], const Unit& u, int wr, int wc, int fr, int fq) const {
        asm volatile("" : "+v"(fr), "+v"(fq));
        const int cw = 32 * wc + 8 * fq, row0 = u.pm * BM + 64 * wr + fr; const float* c1p = c1 + u.pn * 256 + cw; const float* c2p = c2 + u.pn * 256 + cw;
        f32x4 k1[2][2], k2[2][2];
#pragma unroll
        for (int hb = 0; hb < 2; ++hb) {
            asm volatile("" ::: "memory");
            StatLd t[4]; RS rs[4];
#pragma unroll
            for (int i = 0; i < 4; ++i) t[i] = stat_load(st, row0 + 128 * hb + 16 * i, fq);
            if (hb == 0) {
#pragma unroll
                for (int bj = 0; bj < 2; ++bj)
#pragma unroll
                    for (int n = 0; n < 2; ++n) { k1[bj][n] = *(const f32x4*)(c1p + 128 * bj + 4 * n); k2[bj][n] = *(const f32x4*)(c2p + 128 * bj + 4 * n); } }
#pragma unroll
            for (int i = 0; i < 4; ++i) rs[i] = stat_fin(t[i]);
#pragma unroll
            for (int m = 0; m < 4; ++m) { const int ai = hb; f32x4 a[2];
#pragma unroll
                for (int n = 0; n < 2; ++n) { const f32x4 hg = rs[m].a * acc[ai][0][m][n] + (rs[m].b * k1[0][n] + k2[0][n]), hu = rs[m].a * acc[ai][1][m][n] + (rs[m].b * k1[1][n] + k2[1][n]);
#pragma unroll
                    for (int e = 0; e < 4; ++e) a[n][e] = fsilu(hg[e]) * hu[e]; }
                st8nt(ACT + (size_t)(row0 + 128 * ai + 16 * m) * cfg::FF + 128 * u.pn + cw, a[0], a[1]); } }
    }
};
struct FEpiFour {
    static constexpr bool PERM = true, AFTER_DRAIN = false;
    bf16_t* OC;
    __device__ __forceinline__ void operator()(const f32x4 (&acc)[2][2][4][2], const Unit& u, int wr, int wc, int fr, int fq) const {
        asm volatile("" : "+v"(fr), "+v"(fq));
        const int cw = 32 * wc + 8 * fq;
#pragma unroll
        for (int ai = 0; ai < 2; ++ai)
#pragma unroll
            for (int m = 0; m < 4; ++m) { const int row = u.pm * BM + 128 * ai + 64 * wr + 16 * m + fr; bf16_t* dst = OC + (size_t)(u.pn * 2048 + row) * 1024 + 512 + cw;
                st8(dst, acc[ai][0][m][0], acc[ai][0][m][1]); st8(dst + 128, acc[ai][1][m][0], acc[ai][1][m][1]); }
    }
};
}
namespace att {
using bf16x8 = __attribute__((ext_vector_type(8))) short;
using s16x4  = __attribute__((ext_vector_type(4))) short;
using f32x16 = __attribute__((ext_vector_type(16))) float;
using u32x4  = __attribute__((ext_vector_type(4))) unsigned;
constexpr int NW = 8, QBLK = 32, KVBLK = 64, LD = 512, NT = cfg::S / KVBLK;
constexpr int SHM_V = KVBLK * 128 * 2, SHM_K = KVBLK * 128 * 2, SHM_X = 2 * SHM_V + 2 * SHM_K, SHM_ATTN = SHM_X + NW * 64 * 4;
constexpr float THRL = 6.0f;
#define ATT_KSWZ(row, colB) ((row) * 256 + ((colB) ^ (((row) & 7) << 4)))
#define ATT_SBAR() __builtin_amdgcn_sched_barrier(0)
__device__ __forceinline__ int crow(int r, int hi) { return (r & 3) + 8 * (r >> 2) + 4 * hi; }
__device__ __forceinline__ unsigned cvtpk(float lo, float hi) { unsigned r; asm volatile("v_cvt_pk_bf16_f32 %0, %1, %2" : "=v"(r) : "v"(lo), "v"(hi)); return r; }
__device__ __forceinline__ void partialSM(f32x16& p0, f32x16& p1, float& m_reg, float& alpha) {
  float pmax = p0[0];
#pragma unroll
  for (int r = 1; r < 16; ++r) pmax = fmaxf(pmax, p0[r]);
#pragma unroll
  for (int r = 0; r < 16; ++r) pmax = fmaxf(pmax, p1[r]);
  { auto rr = __builtin_amdgcn_permlane32_swap(__float_as_uint(pmax), __float_as_uint(pmax), false, false); pmax = fmaxf(__uint_as_float(rr[0]), __uint_as_float(rr[1])); }
  float mn;
  if (__builtin_expect(__all(pmax - m_reg <= THRL), 1)) { mn = m_reg; alpha = 1.f; }
  else { mn = fmaxf(m_reg, pmax); alpha = __builtin_amdgcn_exp2f(m_reg - mn); m_reg = mn; }
#pragma unroll
  for (int r = 0; r < 16; ++r) p0[r] = p0[r] - mn;
#pragma unroll
  for (int r = 0; r < 16; ++r) p1[r] = p1[r] - mn;
#pragma unroll
  for (int r = 0; r < 16; ++r) p0[r] = __builtin_amdgcn_exp2f(p0[r]);
}
__device__ __forceinline__ void finishSM(f32x16& p0, f32x16& p1, float alpha, float& l_reg, bf16x8& pa0, bf16x8& pa1, bf16x8& pa2, bf16x8& pa3) {
#pragma unroll
  for (int r = 0; r < 16; ++r) p1[r] = __builtin_amdgcn_exp2f(p1[r]);
  float ps = 0;
#pragma unroll
  for (int r = 0; r < 16; ++r) ps += p0[r];
#pragma unroll
  for (int r = 0; r < 16; ++r) ps += p1[r];
  { auto rr = __builtin_amdgcn_permlane32_swap(__float_as_uint(ps), __float_as_uint(ps), false, false); ps = __uint_as_float(rr[0]) + __uint_as_float(rr[1]); }
  l_reg = l_reg * alpha + ps;
#define ATT_PK4(P, BASE, OUT) do { unsigned a0 = cvtpk(P[BASE + 0], P[BASE + 1]), a1 = cvtpk(P[BASE + 2], P[BASE + 3]);   \
    unsigned b0 = cvtpk(P[BASE + 4], P[BASE + 5]), b1 = cvtpk(P[BASE + 6], P[BASE + 7]);                              \
    auto r0 = __builtin_amdgcn_permlane32_swap(a0, b0, false, false); auto r1 = __builtin_amdgcn_permlane32_swap(a1, b1, false, false); \
    u32x4 w = {r0[0], r1[0], r0[1], r1[1]}; OUT = *reinterpret_cast<bf16x8*>(&w); } while (0)
  ATT_PK4(p0, 0, pa0); ATT_PK4(p0, 8, pa1); ATT_PK4(p1, 0, pa2); ATT_PK4(p1, 8, pa3);
#undef ATT_PK4
}
__device__ __forceinline__ void qkt(f32x16& p0, f32x16& p1, const char* Ks, const bf16x8* qr, int r32, int hi, int mofs) {
  p0 = f32x16{}; p1 = f32x16{};
#pragma unroll
  for (int d0 = 0; d0 < 4; ++d0) { const int cb = (mofs + d0 * 16 + hi * 8) * 2;
    const bf16x8 b0 = *reinterpret_cast<const bf16x8*>(Ks + ATT_KSWZ(r32, cb));
    const bf16x8 b1 = *reinterpret_cast<const bf16x8*>(Ks + ATT_KSWZ(32 + r32, cb));
    p0 = __builtin_amdgcn_mfma_f32_32x32x16_bf16(b0, qr[d0], p0, 0, 0, 0);
    p1 = __builtin_amdgcn_mfma_f32_32x32x16_bf16(b1, qr[d0], p1, 0, 0, 0); }
}
__device__ __forceinline__ int v_st(int k, int c) { const int kk = (k & ~0xC) | ((k & 4) << 1) | ((k & 8) >> 1); return ((kk >> 3) * 4 + (c >> 5)) * 512 + ((kk & 7) * 32 + (c & 31)) * 2; }
__device__ __forceinline__ int v_rd_base(int lane) { return ((lane & 3) << 3) | (((lane >> 2) & 3) << 6) | (((lane >> 4) & 1) << 5) | (((lane >> 5) & 1) << 8); }
constexpr int v_rd_off(int d0, int ks, int half) { return d0 * 512 + ks * 4096 + half * 2048; }
template <int OFF> __device__ __forceinline__ s16x4 tr_read(int vb) { s16x4 r; asm volatile("ds_read_b64_tr_b16 %0, %1 offset:%2" : "=&v"(r) : "v"(vb), "i"(OFF) : "memory"); return r; }
template <int D0> __device__ __forceinline__ void pv_one(f32x16& od, int vb, bf16x8 pa0, bf16x8 pa1, bf16x8 pa2, bf16x8 pa3) {
  const s16x4 l0 = tr_read<v_rd_off(D0, 0, 0)>(vb), h0 = tr_read<v_rd_off(D0, 0, 1)>(vb), l1 = tr_read<v_rd_off(D0, 1, 0)>(vb), h1 = tr_read<v_rd_off(D0, 1, 1)>(vb);
  const s16x4 l2 = tr_read<v_rd_off(D0, 2, 0)>(vb), h2 = tr_read<v_rd_off(D0, 2, 1)>(vb), l3 = tr_read<v_rd_off(D0, 3, 0)>(vb), h3 = tr_read<v_rd_off(D0, 3, 1)>(vb);
  asm volatile("s_waitcnt lgkmcnt(0)" ::: "memory"); ATT_SBAR();
#define ATT_PK(L, H) (bf16x8){L[0], L[1], L[2], L[3], H[0], H[1], H[2], H[3]}
  od = __builtin_amdgcn_mfma_f32_32x32x16_bf16(pa0, ATT_PK(l0, h0), od, 0, 0, 0);
  od = __builtin_amdgcn_mfma_f32_32x32x16_bf16(pa1, ATT_PK(l1, h1), od, 0, 0, 0);
  od = __builtin_amdgcn_mfma_f32_32x32x16_bf16(pa2, ATT_PK(l2, h2), od, 0, 0, 0);
  od = __builtin_amdgcn_mfma_f32_32x32x16_bf16(pa3, ATT_PK(l3, h3), od, 0, 0, 0);
#undef ATT_PK
}
__device__ __forceinline__ void pv_d0(f32x16* o, int vb, bf16x8 pa0, bf16x8 pa1, bf16x8 pa2, bf16x8 pa3) {
  pv_one<0>(o[0], vb, pa0, pa1, pa2, pa3); pv_one<1>(o[1], vb, pa0, pa1, pa2, pa3); pv_one<2>(o[2], vb, pa0, pa1, pa2, pa3); pv_one<3>(o[3], vb, pa0, pa1, pa2, pa3);
}

__device__ __forceinline__ void attn_unit(int b, int h, int qb, const bf16_t* __restrict__ Qg, const bf16_t* __restrict__ Kg, const bf16_t* __restrict__ Vg, bf16_t* __restrict__ OC,
                                          const float* __restrict__ lamp, const float* __restrict__ dgv, int layer, char* lds) {
  int tid_o = threadIdx.x; asm volatile("" : "+v"(tid_o));
  const int tid = tid_o, wid = __builtin_amdgcn_readfirstlane(tid >> 6), lane = tid & 63, r32 = lane & 31, hi = lane >> 5, mp = wid >> 2, wl = wid & 3, mofs = mp * 64;
  char* V_lds = lds; char* K_lds = lds + 2 * SHM_V;
  float* ws = (float*)(lds + SHM_X) + wid * 64; float* li_l = ws; float* al_l = ws + 32;
  float m_reg = -1e30f, l_reg = 0; f32x16 o[4] = {}; bf16x8 qr[4];
  const int q0 = qb * 128 + wl * QBLK;
  const bf16_t* Qw = Qg + (size_t)(b * cfg::S + q0 + r32) * LD + h * 128 + mofs + hi * 8;
#pragma unroll
  for (int d0 = 0; d0 < 4; ++d0) qr[d0] = *reinterpret_cast<const bf16x8*>(Qw + d0 * 16);
  const bf16_t* Kh = Kg + (size_t)b * cfg::S * LD + h * 128; const bf16_t* Vh = Vg + (size_t)b * cfg::S * LD + h * 128;
  const int sr = tid >> 4, sc = (tid & 15) * 8, vst0 = v_st(sr, sc), vst1 = v_st(32 + sr, sc);
  const int vb0 = (int)(uintptr_t)V_lds + v_rd_base(lane);
  struct { bf16x8 vs0, vs1, ks0, ks1; } sr_[2];
#define ATT_SLOAD(i, k0) do { sr_[i].vs0 = *reinterpret_cast<const bf16x8*>(&Vh[(size_t)((k0) + sr) * LD + sc]); sr_[i].vs1 = *reinterpret_cast<const bf16x8*>(&Vh[(size_t)((k0) + 32 + sr) * LD + sc]); \
    sr_[i].ks0 = *reinterpret_cast<const bf16x8*>(&Kh[(size_t)((k0) + sr) * LD + sc]); sr_[i].ks1 = *reinterpret_cast<const bf16x8*>(&Kh[(size_t)((k0) + 32 + sr) * LD + sc]); } while (0)
#define ATT_SWRITE(bf, i) do { *(bf16x8*)(V_lds + (bf) * SHM_V + vst0) = sr_[i].vs0; *(bf16x8*)(V_lds + (bf) * SHM_V + vst1) = sr_[i].vs1; const int kc = sc * 2; \
    *(bf16x8*)(K_lds + (bf) * SHM_K + ATT_KSWZ(sr, kc)) = sr_[i].ks0; *(bf16x8*)(K_lds + (bf) * SHM_K + ATT_KSWZ(32 + sr, kc)) = sr_[i].ks1; } while (0)
#define ATT_SWAIT() asm volatile("s_waitcnt vmcnt(4)" ::: "memory")
#define ATT_RESC(a) do { if (__any((a) < 1.f)) { if (hi == 0) al_l[r32] = (a); asm volatile("s_waitcnt lgkmcnt(0)" ::: "memory"); \
    _Pragma("unroll") for (int d = 0; d < 4; ++d) _Pragma("unroll") for (int r = 0; r < 16; ++r) o[d][r] *= al_l[crow(r, hi)]; } } while (0)
  f32x16 pA0, pA1, pB0, pB1; float alA, alB; bf16x8 pa0, pa1, pa2, pa3;
  ATT_SLOAD(0, 0); asm volatile("s_waitcnt vmcnt(0)" ::: "memory"); ATT_SWRITE(0, 0); __syncthreads();
  qkt(pA0, pA1, K_lds, qr, r32, hi, mofs); partialSM(pA0, pA1, m_reg, alA);
  ATT_SLOAD(1, KVBLK); ATT_SLOAD(0, 2 * KVBLK);
  ATT_SWAIT(); ATT_SWRITE(1, 1); __syncthreads();
  for (int j = 1; j + 1 < NT; j += 2) {
    ATT_SBAR(); qkt(pB0, pB1, K_lds + SHM_K, qr, r32, hi, mofs);
    finishSM(pA0, pA1, alA, l_reg, pa0, pa1, pa2, pa3); ATT_SBAR();
    ATT_SLOAD(1, (j + 2) * KVBLK); ATT_SBAR();
    pv_d0(o, vb0, pa0, pa1, pa2, pa3); partialSM(pB0, pB1, m_reg, alB);
    __syncthreads(); ATT_SWAIT(); ATT_SWRITE(0, 0);
    ATT_RESC(alB); __syncthreads();
    ATT_SBAR(); qkt(pA0, pA1, K_lds, qr, r32, hi, mofs);
    finishSM(pB0, pB1, alB, l_reg, pa0, pa1, pa2, pa3); ATT_SBAR();
    if (j + 3 < NT) ATT_SLOAD(0, (j + 3) * KVBLK); ATT_SBAR();
    pv_d0(o, vb0 + SHM_V, pa0, pa1, pa2, pa3); partialSM(pA0, pA1, m_reg, alA);
    __syncthreads(); ATT_SWAIT(); ATT_SWRITE(1, 1);
    ATT_RESC(alA); __syncthreads();
  }
  ATT_SBAR(); qkt(pB0, pB1, K_lds + SHM_K, qr, r32, hi, mofs);
  finishSM(pA0, pA1, alA, l_reg, pa0, pa1, pa2, pa3); ATT_SBAR();
  pv_d0(o, vb0, pa0, pa1, pa2, pa3); partialSM(pB0, pB1, m_reg, alB);
  __syncthreads(); ATT_RESC(alB);
  finishSM(pB0, pB1, alB, l_reg, pa0, pa1, pa2, pa3); ATT_SBAR();
  pv_d0(o, vb0 + SHM_V, pa0, pa1, pa2, pa3);
  if (hi == 0) li_l[r32] = l_reg; asm volatile("s_waitcnt lgkmcnt(0)" ::: "memory");
  float rli[16];
#pragma unroll
  for (int r = 0; r < 16; ++r) rli[r] = __builtin_amdgcn_rcpf(li_l[crow(r, hi)]);
#pragma unroll
  for (int d0 = 0; d0 < 4; ++d0)
#pragma unroll
    for (int r = 0; r < 16; ++r) o[d0][r] *= rli[r];
  __syncthreads();
  float* X = (float*)lds;
  if (mp == 1) {
#pragma unroll
    for (int r = 0; r < 16; ++r)
#pragma unroll
      for (int d0 = 0; d0 < 4; ++d0) X[(wl * 32 + crow(r, hi)) * 128 + d0 * 32 + r32] = o[d0][r];
  }
  __syncthreads();
  if (mp == 0) {
    int layer_o = __builtin_amdgcn_readfirstlane(layer); asm volatile("" : "+s"(layer_o)); const float lam_init = layer_o == 0 ? 0.2f : 0.35550906759f;
    float lam; { float s1 = lamp[lane] * lamp[64 + lane], s2 = lamp[128 + lane] * lamp[192 + lane];
      s1 = xadd<1>(s1); s2 = xadd<1>(s2); s1 = xadd<2>(s1); s2 = xadd<2>(s2); s1 = xadd<4>(s1); s2 = xadd<4>(s2); s1 = xadd<8>(s1); s2 = xadd<8>(s2); s1 = xadd<16>(s1); s2 = xadd<16>(s2); s1 = xadd<32>(s1); s2 = xadd<32>(s2);
      lam = __expf(s1) - __expf(s2) + lam_init; }
    float gq[4];
#pragma unroll
    for (int d0 = 0; d0 < 4; ++d0) gq[d0] = dgv[d0 * 32 + r32] * (1.f - lam_init);
#pragma unroll
    for (int r = 0; r < 16; ++r) {
      float ssq = 0.f;
#pragma unroll
      for (int d0 = 0; d0 < 4; ++d0) { const float df = o[d0][r] - lam * X[(wl * 32 + crow(r, hi)) * 128 + d0 * 32 + r32]; o[d0][r] = df; ssq += df * df; }
      ssq = xadd<1>(ssq); ssq = xadd<2>(ssq); ssq = xadd<4>(ssq); ssq = xadd<8>(ssq); ssq = xadd<16>(ssq);
      const float rn = rsqrtf(ssq * (1.f / 128.f) + cfg::EPS);
      bf16_t* dst = OC + (size_t)(b * cfg::S + q0 + crow(r, hi)) * 1024 + h * 128 + r32;
#pragma unroll
      for (int d0 = 0; d0 < 4; ++d0) dst[d0 * 32] = (bf16_t)(cvtpk(o[d0][r] * rn * gq[d0], 0.f) & 0xffffu);
    }
  }
  __syncthreads();
#undef ATT_SLOAD
#undef ATT_SWRITE
#undef ATT_SWAIT
#undef ATT_RESC
}
#undef ATT_KSWZ
#undef ATT_SBAR
}
namespace gla {
using att::bf16x8; using att::s16x4; using att::f32x16; using att::u32x4; using att::crow; using att::cvtpk; using att::tr_read;
typedef float f32x4 __attribute__((ext_vector_type(4)));
typedef unsigned u32x2 __attribute__((ext_vector_type(2)));
#define GLAS __attribute__((address_space(3)))
constexpr int KT_STRIDE = 144;
constexpr int A_KT = 0, A_V = 36864, A_BEND = A_V + 32768;
constexpr int B_QT = 0, B_KT = 32768, B_V = 65536, B_SC = 98304;
__device__ __forceinline__ int v_st64(int k, int c) { const int kk = (k & ~0xC) | ((k & 4) << 1) | ((k & 8) >> 1); return ((kk >> 3) * 2 + (c >> 5)) * 512 + ((kk & 7) * 32 + (c & 31)) * 2; }
constexpr int v_off64(int d0, int ks, int half) { return d0 * 512 + ks * 2048 + half * 1024; }
__device__ __forceinline__ float bf2f_(unsigned short v) { return __uint_as_float((unsigned)v << 16); }
__device__ __forceinline__ void load_v_tile(const bf16_t* __restrict__ src, GLAS unsigned char* dst, int lane) {
    u32x4 tv[8];
#pragma unroll
    for (int i = 0; i < 8; ++i) { const int row = (lane >> 3) + 8 * i, ch = lane & 7; tv[i] = *(const u32x4*)(src + (size_t)row * 256 + ch * 8); }
#pragma unroll
    for (int i = 0; i < 8; ++i) { const int row = (lane >> 3) + 8 * i, ch = lane & 7; *(GLAS u32x4*)(dst + v_st64(row, ch * 8)) = tv[i]; }
}
#define GLA_PK(L, H) (bf16x8){L[0], L[1], L[2], L[3], H[0], H[1], H[2], H[3]}
#define GLA_MM4(o0, o1, vb, AF) do { \
    const s16x4 l00 = tr_read<v_off64(0, 0, 0)>(vb), h00 = tr_read<v_off64(0, 0, 1)>(vb), l01 = tr_read<v_off64(0, 1, 0)>(vb), h01 = tr_read<v_off64(0, 1, 1)>(vb); \
    const s16x4 l02 = tr_read<v_off64(0, 2, 0)>(vb), h02 = tr_read<v_off64(0, 2, 1)>(vb), l03 = tr_read<v_off64(0, 3, 0)>(vb), h03 = tr_read<v_off64(0, 3, 1)>(vb); \
    const s16x4 l10 = tr_read<v_off64(1, 0, 0)>(vb), h10 = tr_read<v_off64(1, 0, 1)>(vb), l11 = tr_read<v_off64(1, 1, 0)>(vb), h11 = tr_read<v_off64(1, 1, 1)>(vb); \
    const s16x4 l12 = tr_read<v_off64(1, 2, 0)>(vb), h12 = tr_read<v_off64(1, 2, 1)>(vb), l13 = tr_read<v_off64(1, 3, 0)>(vb), h13 = tr_read<v_off64(1, 3, 1)>(vb); \
    asm volatile("s_waitcnt lgkmcnt(0)" ::: "memory"); __builtin_amdgcn_sched_barrier(0); \
    o0 = __builtin_amdgcn_mfma_f32_32x32x16_bf16(AF(0), GLA_PK(l00, h00), o0, 0, 0, 0); o1 = __builtin_amdgcn_mfma_f32_32x32x16_bf16(AF(0), GLA_PK(l10, h10), o1, 0, 0, 0); \
    o0 = __builtin_amdgcn_mfma_f32_32x32x16_bf16(AF(1), GLA_PK(l01, h01), o0, 0, 0, 0); o1 = __builtin_amdgcn_mfma_f32_32x32x16_bf16(AF(1), GLA_PK(l11, h11), o1, 0, 0, 0); \
    o0 = __builtin_amdgcn_mfma_f32_32x32x16_bf16(AF(2), GLA_PK(l02, h02), o0, 0, 0, 0); o1 = __builtin_amdgcn_mfma_f32_32x32x16_bf16(AF(2), GLA_PK(l12, h12), o1, 0, 0, 0); \
    o0 = __builtin_amdgcn_mfma_f32_32x32x16_bf16(AF(3), GLA_PK(l03, h03), o0, 0, 0, 0); o1 = __builtin_amdgcn_mfma_f32_32x32x16_bf16(AF(3), GLA_PK(l13, h13), o1, 0, 0, 0); } while (0)
__device__ __forceinline__ bf16x8 afrag_tr(const GLAS unsigned char* row, int ks, int hi) { return *(const GLAS bf16x8*)(row + (16 * ks + 8 * hi) * 2); }

__device__ __forceinline__ void gla_a_item(int b, int h, int g, unsigned char* ws, GLAS unsigned char* lds) {
    int tid_o = threadIdx.x; asm volatile("" : "+v"(tid_o));
    const int tid = tid_o, wave = __builtin_amdgcn_readfirstlane(tid >> 6), lane = tid & 63, r32 = lane & 31, hi = lane >> 5;
    const float* GL = (const float*)(ws + cfg::WS_GL); const bf16_t* GQK = (const bf16_t*)(ws + cfg::WS_GQK); const bf16_t* GV = (const bf16_t*)(ws + cfg::WS_GV);
    float* KVC = (float*)(ws + cfg::WS_OF); float* DEC = (float*)(ws + cfg::WS_DEC);
    const size_t tok0 = (size_t)b * 2048 + g * 256;
    GLAS float* bend_s = (GLAS float*)(lds + A_BEND);
    if (wave < 4) {
        const int c = wave, dir = lane >> 5, d = lane & 31;
        const float* gl = GL + (tok0 + c * 64) * 256 + dir * 128 + h * 32 + d; const bf16_t* kp = GQK + (tok0 + c * 64) * 256 + 128 + h * 32 + d;
        GLAS unsigned char* row = lds + A_KT + ((c * 2 + dir) * 32 + d) * KT_STRIDE; float bsum = 0.f; float gA[8], gB[8]; unsigned short kA[8], kB[8];
#define GLA_LOAD(G, K, blk) do { const int t0_ = dir ? 56 - 8 * (blk) : 8 * (blk); _Pragma("unroll") for (int i = 0; i < 8; ++i) { G[i] = gl[(size_t)(t0_ + i) * 256]; K[i] = kp[(size_t)(t0_ + i) * 256]; } } while (0)
#define GLA_PROC(G, K, blk) do { const int t0_ = dir ? 56 - 8 * (blk) : 8 * (blk); float kt[8]; \
            if (dir == 0) { _Pragma("unroll") for (int i = 0; i < 8; ++i) { bsum += G[i]; kt[i] = bf2f_(K[i]) * __expf(-bsum); } } \
            else { _Pragma("unroll") for (int i = 7; i >= 0; --i) { bsum += G[i]; kt[i] = bf2f_(K[i]) * __expf(-bsum); } } \
            u32x4 w; w.x = cvtpk(kt[0], kt[1]); w.y = cvtpk(kt[2], kt[3]); w.z = cvtpk(kt[4], kt[5]); w.w = cvtpk(kt[6], kt[7]); *(GLAS u32x4*)(row + t0_ * 2) = w; } while (0)
        GLA_LOAD(gA, kA, 0);
#pragma unroll
        for (int bp = 0; bp < 4; ++bp) { GLA_LOAD(gB, kB, 2 * bp + 1); GLA_PROC(gA, kA, 2 * bp); if (bp < 3) GLA_LOAD(gA, kA, 2 * bp + 2); GLA_PROC(gB, kB, 2 * bp + 1); }
#undef GLA_LOAD
#undef GLA_PROC
        bend_s[(c * 2 + dir) * 32 + d] = bsum;
        DEC[((size_t)((b * 4 + h) * 32 + g * 4 + c) * 2 + dir) * 32 + d] = __expf(bsum);
    } else { const int c = wave - 4; load_v_tile(GV + (tok0 + c * 64) * 256 + h * 64, lds + A_V + c * 8192, lane); }
    __syncthreads();
    {
        const int c = wave >> 1, dir = wave & 1; f32x16 o0 = {}, o1 = {};
        const int vb = (int)(unsigned)(uintptr_t)(lds + A_V + c * 8192) + att::v_rd_base(lane);
        const GLAS unsigned char* arow = lds + A_KT + ((c * 2 + dir) * 32 + r32) * KT_STRIDE;
#define GLA_AF(ks) afrag_tr(arow, ks, hi)
        GLA_MM4(o0, o1, vb, GLA_AF);
#undef GLA_AF
        float* dst = KVC + ((size_t)((b * 4 + h) * 32 + g * 4 + c) * 2 + dir) * 2048 + r32;
#pragma unroll
        for (int r = 0; r < 16; ++r) { const int d = crow(r, hi); const float sc = __expf(bend_s[(c * 2 + dir) * 32 + d]); dst[d * 64] = o0[r] * sc; dst[d * 64 + 32] = o1[r] * sc; }
    }
    __syncthreads();
}

__device__ __forceinline__ void gla_b_item(int b, int h, int g, unsigned char* ws, const float* __restrict__ gng, bf16_t* __restrict__ OC, GLAS unsigned char* lds) {
    int tid_o = threadIdx.x; asm volatile("" : "+v"(tid_o));
    const int tid = tid_o, wave = __builtin_amdgcn_readfirstlane(tid >> 6), lane = tid & 63, r32 = lane & 31, hi = lane >> 5;
    const float* GL = (const float*)(ws + cfg::WS_GL); const bf16_t* GQK = (const bf16_t*)(ws + cfg::WS_GQK); const bf16_t* GV = (const bf16_t*)(ws + cfg::WS_GV); const bf16_t* GR = (const bf16_t*)(ws + cfg::WS_GR);
    const float* KVC = (const float*)(ws + cfg::WS_OF) + (size_t)((b * 4 + h) * 32) * 2 * 2048; const float* DEC = (const float*)(ws + cfg::WS_DEC) + (size_t)((b * 4 + h) * 32) * 2 * 32;
    const size_t tok0 = (size_t)b * 2048 + g * 256;
    if (wave < 4) {
        const int c = wave, dir = lane >> 5, d = lane & 31;
        const float* gl = GL + (tok0 + c * 64) * 256 + dir * 128 + h * 32 + d; const bf16_t* qp = GQK + (tok0 + c * 64) * 256 + h * 32 + d;
        GLAS unsigned short* qt = (GLAS unsigned short*)(lds + B_QT + c * 8192) + dir * 32 + d;
        GLAS unsigned short* kt = (GLAS unsigned short*)(lds + B_KT + c * 8192 + dir * 4096) + d;
        float bsum = 0.f; float gA[8], gB[8]; unsigned short qA[8], kA[8], qB[8], kB[8];
#define GLB_LOAD(G, Q, K, blk) do { const int t0_ = dir ? 56 - 8 * (blk) : 8 * (blk); _Pragma("unroll") for (int i = 0; i < 8; ++i) { G[i] = gl[(size_t)(t0_ + i) * 256]; Q[i] = qp[(size_t)(t0_ + i) * 256]; K[i] = qp[(size_t)(t0_ + i) * 256 + 128]; } } while (0)
#define GLB_PROC(G, Q, K, blk) do { const int t0_ = dir ? 56 - 8 * (blk) : 8 * (blk); _Pragma("unroll") for (int ii = 0; ii < 8; ++ii) { \
            const float gi = dir ? G[7 - ii] : G[ii], qi = bf2f_(dir ? Q[7 - ii] : Q[ii]), ki = bf2f_(dir ? K[7 - ii] : K[ii]); const int tt = t0_ + (dir ? 7 - ii : ii); \
            bsum += gi; const float e = __expf(bsum), ei = __expf(-bsum); \
            qt[tt * 64] = (unsigned short)(cvtpk(qi * e, 0.f) & 0xffffu); kt[tt * 32] = (unsigned short)(cvtpk(ki * ei, 0.f) & 0xffffu); } } while (0)
        GLB_LOAD(gA, qA, kA, 0);
#pragma unroll
        for (int bp = 0; bp < 4; ++bp) { GLB_LOAD(gB, qB, kB, 2 * bp + 1); GLB_PROC(gA, qA, kA, 2 * bp); if (bp < 3) GLB_LOAD(gA, qA, kA, 2 * bp + 2); GLB_PROC(gB, qB, kB, 2 * bp + 1); }
#undef GLB_LOAD
#undef GLB_PROC
    } else {
        const int c = wave - 4; load_v_tile(GV + (tok0 + c * 64) * 256 + h * 64, lds + B_V + c * 8192, lane);
        const int t2 = tid - 256, d = t2 >> 3, v8 = (t2 & 7) * 8;
        const float* kvp = KVC + d * 64 + v8; const float* dcp = DEC + d;
        f32x4 own[4][2][2]; float dow[4][2];
#pragma unroll
        for (int c4 = 0; c4 < 4; ++c4)
#pragma unroll
            for (int dr = 0; dr < 2; ++dr) { const int n = 4 * g + c4; own[c4][dr][0] = *(const f32x4*)(kvp + (size_t)(n * 2 + dr) * 2048); own[c4][dr][1] = *(const f32x4*)(kvp + (size_t)(n * 2 + dr) * 2048 + 4); dow[c4][dr] = dcp[(n * 2 + dr) * 32]; }
        f32x4 Sf0 = {0.f, 0.f, 0.f, 0.f}, Sf1 = Sf0, Sb0 = Sf0, Sb1 = Sf0;
#pragma unroll 8
        for (int n = 0; n < 4 * g; ++n) { const float dc = dcp[(n * 2) * 32]; Sf0 = dc * Sf0 + *(const f32x4*)(kvp + (size_t)(n * 2) * 2048); Sf1 = dc * Sf1 + *(const f32x4*)(kvp + (size_t)(n * 2) * 2048 + 4); }
#pragma unroll 8
        for (int n = 31; n >= 4 * g + 4; --n) { const float dc = dcp[(n * 2 + 1) * 32]; Sb0 = dc * Sb0 + *(const f32x4*)(kvp + (size_t)(n * 2 + 1) * 2048); Sb1 = dc * Sb1 + *(const f32x4*)(kvp + (size_t)(n * 2 + 1) * 2048 + 4); }
#pragma unroll
        for (int c4 = 0; c4 < 4; ++c4) { u32x4 w; w.x = cvtpk(Sf0[0], Sf0[1]); w.y = cvtpk(Sf0[2], Sf0[3]); w.z = cvtpk(Sf1[0], Sf1[1]); w.w = cvtpk(Sf1[2], Sf1[3]);
            *(GLAS u32x4*)(lds + B_SC + c4 * 8192 + v_st64(d, v8)) = w; Sf0 = dow[c4][0] * Sf0 + own[c4][0][0]; Sf1 = dow[c4][0] * Sf1 + own[c4][0][1]; }
#pragma unroll
        for (int c4 = 3; c4 >= 0; --c4) { u32x4 w; w.x = cvtpk(Sb0[0], Sb0[1]); w.y = cvtpk(Sb0[2], Sb0[3]); w.z = cvtpk(Sb1[0], Sb1[1]); w.w = cvtpk(Sb1[2], Sb1[3]);
            *(GLAS u32x4*)(lds + B_SC + c4 * 8192 + v_st64(32 + d, v8)) = w; Sb0 = dow[c4][1] * Sb0 + own[c4][1][0]; Sb1 = dow[c4][1] * Sb1 + own[c4][1][1]; }
    }
    __syncthreads();
    {
        const int c = wave >> 1, th = wave & 1, t = 32 * th + r32;
        const GLAS unsigned char* qrow = lds + B_QT + c * 8192 + t * 128;
        f32x16 pf0 = {}, pf1 = {}, pb0 = {}, pb1 = {};
#pragma unroll
        for (int ks = 0; ks < 2; ++ks) {
            const bf16x8 qf = *(const GLAS bf16x8*)(qrow + (16 * ks + 8 * hi) * 2), qb = *(const GLAS bf16x8*)(qrow + (32 + 16 * ks + 8 * hi) * 2);
            const GLAS unsigned char* kf = lds + B_KT + c * 8192 + r32 * 64 + (16 * ks + 8 * hi) * 2; const GLAS unsigned char* kb = kf + 4096;
            pf0 = __builtin_amdgcn_mfma_f32_32x32x16_bf16(*(const GLAS bf16x8*)kf, qf, pf0, 0, 0, 0); pf1 = __builtin_amdgcn_mfma_f32_32x32x16_bf16(*(const GLAS bf16x8*)(kf + 2048), qf, pf1, 0, 0, 0);
            pb0 = __builtin_amdgcn_mfma_f32_32x32x16_bf16(*(const GLAS bf16x8*)kb, qb, pb0, 0, 0, 0); pb1 = __builtin_amdgcn_mfma_f32_32x32x16_bf16(*(const GLAS bf16x8*)(kb + 2048), qb, pb1, 0, 0, 0);
        }
#pragma unroll
        for (int r = 0; r < 16; ++r) { const int j0 = crow(r, hi), j1 = 32 + j0;
            pf0[r] = (j0 <= t ? pf0[r] : 0.f) + (j0 >= t ? pb0[r] : 0.f); pf1[r] = (j1 <= t ? pf1[r] : 0.f) + (j1 >= t ? pb1[r] : 0.f); }
        bf16x8 pa0, pa1, pa2, pa3;
#define GLA_PK4(P, BASE, OUT) do { unsigned a0 = cvtpk(P[BASE + 0], P[BASE + 1]), a1 = cvtpk(P[BASE + 2], P[BASE + 3]); unsigned b0 = cvtpk(P[BASE + 4], P[BASE + 5]), b1 = cvtpk(P[BASE + 6], P[BASE + 7]); \
    auto r0 = __builtin_amdgcn_permlane32_swap(a0, b0, false, false); auto r1 = __builtin_amdgcn_permlane32_swap(a1, b1, false, false); \
    u32x4 w = {r0[0], r1[0], r0[1], r1[1]}; OUT = *reinterpret_cast<bf16x8*>(&w); } while (0)
        GLA_PK4(pf0, 0, pa0); GLA_PK4(pf0, 8, pa1); GLA_PK4(pf1, 0, pa2); GLA_PK4(pf1, 8, pa3);
#undef GLA_PK4
        f32x16 o0 = {}, o1 = {};
        { const int vb = (int)(unsigned)(uintptr_t)(lds + B_V + c * 8192) + att::v_rd_base(lane);
#define GLA_AF(ks) ((ks) == 0 ? pa0 : (ks) == 1 ? pa1 : (ks) == 2 ? pa2 : pa3)
          GLA_MM4(o0, o1, vb, GLA_AF);
#undef GLA_AF
        }
        { const int vb = (int)(unsigned)(uintptr_t)(lds + B_SC + c * 8192) + att::v_rd_base(lane);
#define GLA_AF(ks) afrag_tr(qrow, ks, hi)
          GLA_MM4(o0, o1, vb, GLA_AF);
#undef GLA_AF
        }
        const float g0 = gng[r32], g1 = gng[32 + r32];
        const bf16_t* grb = GR + (tok0 + c * 64 + 32 * th) * 256 + h * 64 + r32; unsigned short gq0[16], gq1[16];
#pragma unroll
        for (int r = 0; r < 16; ++r) { gq0[r] = grb[(size_t)crow(r, hi) * 256]; gq1[r] = grb[(size_t)crow(r, hi) * 256 + 32]; }
#pragma unroll
        for (int r = 0; r < 16; ++r) {
            float ssq = o0[r] * o0[r] + o1[r] * o1[r];
            ssq = xadd<1>(ssq); ssq = xadd<2>(ssq); ssq = xadd<4>(ssq); ssq = xadd<8>(ssq); ssq = xadd<16>(ssq);
            const float rn = rsqrtf(ssq * (1.f / 64.f) + cfg::EPS);
            const size_t tok = tok0 + c * 64 + 32 * th + crow(r, hi);
            bf16_t* dst = OC + tok * 1024 + 768 + h * 64 + r32;
            dst[0] = (bf16_t)(cvtpk(o0[r] * rn * g0 * bf2f_(gq0[r]), 0.f) & 0xffffu); dst[32] = (bf16_t)(cvtpk(o1[r] * rn * g1 * bf2f_(gq1[r]), 0.f) & 0xffffu);
        }
    }
    __syncthreads();
}
#undef GLA_MM4
#undef GLA_PK
#undef GLAS
}
namespace fft {
using att::bf16x8; using att::s16x4; using att::f32x16; using att::u32x4; using att::crow; using att::cvtpk; using att::tr_read;
#define FLAS __attribute__((address_space(3)))
__device__ __forceinline__ int img_off(int k, int c) { const int kk = (k & ~0xC) | ((k & 4) << 1) | ((k & 8) >> 1); return ((kk >> 3) * 8 + (c >> 5)) * 512 + ((kk & 7) * 32 + (c & 31)) * 2; }
constexpr int rd_off(int ks, int half) { return ks * 8192 + half * 4096; }
#define FFT_PK(L, H) (bf16x8){L[0], L[1], L[2], L[3], H[0], H[1], H[2], H[3]}
typedef float f32x2_t __attribute__((ext_vector_type(2))); typedef __bf16 bf16x2_t __attribute__((ext_vector_type(2)));
__device__ __forceinline__ unsigned pk2f(float a, float b) { f32x2_t v = {a, b}; bf16x2_t r = __builtin_convertvector(v, bf16x2_t); return __builtin_bit_cast(unsigned, r); }

__device__ __forceinline__ void stage1_item(int b, int s2, const bf16_t* __restrict__ FX, bf16_t* __restrict__ I1, FLAS unsigned char* lds) {
    int tid_o = threadIdx.x; asm volatile("" : "+v"(tid_o));
    const int tid = tid_o, wave = __builtin_amdgcn_readfirstlane(tid >> 6), lane = tid & 63, r32 = lane & 31, hi = lane >> 5;
    bf16x8 F1[2][4];
#pragma unroll
    for (int ks = 0; ks < 4; ++ks) { float cr[8], ci[8];
#pragma unroll
        for (int j = 0; j < 8; ++j) { const int k = 16 * ks + 8 * hi + j, s1 = k & 31; const float rev = (float)((r32 * s1) & 31) * (1.f / 32.f); const float c = __builtin_amdgcn_cosf(rev), sn = __builtin_amdgcn_sinf(rev);
            const bool p1 = (k >> 5) != 0; cr[j] = p1 ? -sn : c; ci[j] = p1 ? -c : -sn; }
        u32x4 wr = {pk2f(cr[0], cr[1]), pk2f(cr[2], cr[3]), pk2f(cr[4], cr[5]), pk2f(cr[6], cr[7])}, wi = {pk2f(ci[0], ci[1]), pk2f(ci[2], ci[3]), pk2f(ci[4], ci[5]), pk2f(ci[6], ci[7])};
        F1[0][ks] = *reinterpret_cast<bf16x8*>(&wr); F1[1][ks] = *reinterpret_cast<bf16x8*>(&wi); }
    { u32x4 tv[4];
#pragma unroll
      for (int i = 0; i < 4; ++i) { const int p = tid + 512 * i, k = p >> 5, c8 = (p & 31) * 8; tv[i] = *(const u32x4*)(FX + (size_t)(b * 2048 + 64 * (k & 31) + s2) * 512 + (k >> 5) * 256 + c8); }
#pragma unroll
      for (int i = 0; i < 4; ++i) { const int p = tid + 512 * i, k = p >> 5, c8 = (p & 31) * 8; *(FLAS u32x4*)(lds + img_off(k, c8)) = tv[i]; } }
    __syncthreads();
    f32x16 re = {}, im = {};
    { const int vb = (int)(unsigned)(uintptr_t)lds + att::v_rd_base(lane) + wave * 512;
      const s16x4 l0 = tr_read<rd_off(0, 0)>(vb), h0 = tr_read<rd_off(0, 1)>(vb), l1 = tr_read<rd_off(1, 0)>(vb), h1 = tr_read<rd_off(1, 1)>(vb);
      const s16x4 l2 = tr_read<rd_off(2, 0)>(vb), h2 = tr_read<rd_off(2, 1)>(vb), l3 = tr_read<rd_off(3, 0)>(vb), h3 = tr_read<rd_off(3, 1)>(vb);
      asm volatile("s_waitcnt lgkmcnt(0)" ::: "memory"); __builtin_amdgcn_sched_barrier(0);
      re = __builtin_amdgcn_mfma_f32_32x32x16_bf16(F1[0][0], FFT_PK(l0, h0), re, 0, 0, 0); im = __builtin_amdgcn_mfma_f32_32x32x16_bf16(F1[1][0], FFT_PK(l0, h0), im, 0, 0, 0);
      re = __builtin_amdgcn_mfma_f32_32x32x16_bf16(F1[0][1], FFT_PK(l1, h1), re, 0, 0, 0); im = __builtin_amdgcn_mfma_f32_32x32x16_bf16(F1[1][1], FFT_PK(l1, h1), im, 0, 0, 0);
      re = __builtin_amdgcn_mfma_f32_32x32x16_bf16(F1[0][2], FFT_PK(l2, h2), re, 0, 0, 0); im = __builtin_amdgcn_mfma_f32_32x32x16_bf16(F1[1][2], FFT_PK(l2, h2), im, 0, 0, 0);
      re = __builtin_amdgcn_mfma_f32_32x32x16_bf16(F1[0][3], FFT_PK(l3, h3), re, 0, 0, 0); im = __builtin_amdgcn_mfma_f32_32x32x16_bf16(F1[1][3], FFT_PK(l3, h3), im, 0, 0, 0); }
    bf16_t* dst = I1 + (size_t)(b * 32) * 128 * 256 + (size_t)s2 * 256 + 32 * wave + r32;
#pragma unroll
    for (int r = 0; r < 16; ++r) { const int k1 = crow(r, hi); const float rev = (float)((k1 * s2) & 2047) * (1.f / 2048.f); const float ct = __builtin_amdgcn_cosf(rev), st = __builtin_amdgcn_sinf(rev);
        const float ar = re[r] * ct + im[r] * st, ai = im[r] * ct - re[r] * st; const unsigned w = pk2f(ar, ai);
        dst[(size_t)k1 * 128 * 256] = (bf16_t)(w & 0xffffu); dst[(size_t)k1 * 128 * 256 + 64 * 256] = (bf16_t)(w >> 16); }
    __syncthreads();
}

__device__ __forceinline__ void stage2_item(int b, int k1, const bf16_t* __restrict__ I1, bf16_t* __restrict__ OC, FLAS unsigned char* lds) {
    int tid_o = threadIdx.x; asm volatile("" : "+v"(tid_o));
    const int tid = tid_o, wave = __builtin_amdgcn_readfirstlane(tid >> 6), lane = tid & 63, r32 = lane & 31, hi = lane >> 5;
    const bf16_t* src = I1 + (size_t)(b * 32 + k1) * 128 * 256;
    { u32x4 tv[8];
#pragma unroll
      for (int i = 0; i < 8; ++i) { const int p = tid + 512 * i, k = p >> 5, c8 = (p & 31) * 8; tv[i] = *(const u32x4*)(src + (size_t)k * 256 + c8); }
#pragma unroll
      for (int i = 0; i < 8; ++i) { const int p = tid + 512 * i, k = p >> 5, c8 = (p & 31) * 8; *(FLAS u32x4*)(lds + img_off(k, c8)) = tv[i]; } }
    f32x16 y0 = {}, y1 = {};
    __syncthreads();
    const int vb = (int)(unsigned)(uintptr_t)lds + att::v_rd_base(lane) + wave * 512, vb2 = vb + 32768;
    bf16x8 F2[2][8];
#pragma unroll
    for (int ks = 0; ks < 8; ++ks) { float c0[8], c1[8];
#pragma unroll
        for (int j = 0; j < 8; ++j) { const int k = 16 * ks + 8 * hi + j, s2 = k & 63; const float r0 = (float)((r32 * s2) & 63) * (1.f / 64.f), r1 = (float)(((32 + r32) * s2) & 63) * (1.f / 64.f);
            c0[j] = (k >> 6) ? __builtin_amdgcn_sinf(r0) : __builtin_amdgcn_cosf(r0); c1[j] = (k >> 6) ? __builtin_amdgcn_sinf(r1) : __builtin_amdgcn_cosf(r1); }
        u32x4 w0 = {pk2f(c0[0], c0[1]), pk2f(c0[2], c0[3]), pk2f(c0[4], c0[5]), pk2f(c0[6], c0[7])}, w1 = {pk2f(c1[0], c1[1]), pk2f(c1[2], c1[3]), pk2f(c1[4], c1[5]), pk2f(c1[6], c1[7])};
        F2[0][ks] = *reinterpret_cast<bf16x8*>(&w0); F2[1][ks] = *reinterpret_cast<bf16x8*>(&w1); }
#define FFT_STEP(ks) do { \
      const s16x4 lo_ = tr_read<rd_off((ks) & 3, 0)>((ks) < 4 ? vb : vb2), hi_ = tr_read<rd_off((ks) & 3, 1)>((ks) < 4 ? vb : vb2); asm volatile("s_waitcnt lgkmcnt(0)" ::: "memory"); __builtin_amdgcn_sched_barrier(0); \
      y0 = __builtin_amdgcn_mfma_f32_32x32x16_bf16(F2[0][ks], FFT_PK(lo_, hi_), y0, 0, 0, 0); y1 = __builtin_amdgcn_mfma_f32_32x32x16_bf16(F2[1][ks], FFT_PK(lo_, hi_), y1, 0, 0, 0); } while (0)
    FFT_STEP(0); FFT_STEP(1); FFT_STEP(2); FFT_STEP(3); FFT_STEP(4); FFT_STEP(5); FFT_STEP(6); FFT_STEP(7);
#undef FFT_STEP
    bf16_t* dst = OC + (size_t)(b * 2048 + k1) * 1024 + 512 + 32 * wave + r32;
#pragma unroll
    for (int r = 0; r < 16; ++r) { const int k2 = crow(r, hi); const unsigned w = pk2f(y0[r], y1[r]);
        dst[(size_t)(32 * k2) * 1024] = (bf16_t)(w & 0xffffu); dst[(size_t)(32 * (32 + k2)) * 1024] = (bf16_t)(w >> 16); }
    __syncthreads();
}
#undef FFT_PK
#undef FLAS
}
namespace pro {
#define PLAS __attribute__((address_space(3)))
typedef float f32x4 __attribute__((ext_vector_type(4)));
typedef unsigned u32x4 __attribute__((ext_vector_type(4)));
__device__ __forceinline__ unsigned pk2(float lo, float hi) { unsigned r; asm volatile("v_cvt_pk_bf16_f32 %0, %1, %2" : "=v"(r) : "v"(lo), "v"(hi)); return r; }
__device__ __forceinline__ float lo_f(unsigned w) { return __uint_as_float(w << 16); }
__device__ __forceinline__ float hi_f(unsigned w) { return __uint_as_float(w & 0xffff0000u); }
template <bool SUMS, int STRIDE> __device__ __forceinline__ void tile_emit(int K, bf16_t* WT, const float* gain, const float* lnb, float (&a1)[4], float (&a2)[4], const PLAS float* scr, int lane) {
    const int c = lane & 7; float gk[8], bk[8];
#pragma unroll
    for (int q = 0; q < 8; ++q) { gk[q] = gain ? gain[8 * c + q] : 1.f; bk[q] = lnb ? lnb[8 * c + q] : 0.f; }
#pragma unroll
    for (int j = 0; j < 4; ++j) { const int n = (lane >> 3) + 8 * j; const PLAS float* s = scr + (8 * c) * STRIDE + n; float v[8];
#pragma unroll
        for (int q = 0; q < 8; ++q) v[q] = s[q * STRIDE];
        u32x4 o; o.x = pk2(v[0] * gk[0], v[1] * gk[1]); o.y = pk2(v[2] * gk[2], v[3] * gk[3]); o.z = pk2(v[4] * gk[4], v[5] * gk[5]); o.w = pk2(v[6] * gk[6], v[7] * gk[7]);
        *(u32x4*)(WT + (size_t)n * K + 8 * c) = o;
        if (SUMS) { float p1 = (lo_f(o.x) + hi_f(o.x)) + (lo_f(o.y) + hi_f(o.y)) + (lo_f(o.z) + hi_f(o.z)) + (lo_f(o.w) + hi_f(o.w)); float p2 = 0.f;
#pragma unroll
            for (int q = 0; q < 8; ++q) p2 += bk[q] * v[q];
            p1 = xadd<1>(p1); p2 = xadd<1>(p2); p1 = xadd<2>(p1); p2 = xadd<2>(p2); p1 = xadd<4>(p1); p2 = xadd<4>(p2);
            a1[j] += p1; a2[j] += p2; }
    }
    asm volatile("s_waitcnt lgkmcnt(0)" ::: "memory");
}
__device__ __forceinline__ void tile_dma(const float* W, int N, PLAS float* scr, int lane) {
    const float* src = W + (size_t)(lane >> 3) * N + (lane & 7) * 4;
#pragma unroll
    for (int i = 0; i < 8; ++i) __builtin_amdgcn_global_load_lds((const unsigned*)(src + (size_t)(8 * i) * N), (PLAS unsigned*)(scr + i * 256), 16, 0, 0);
}
template <bool SUMS, class Val> __device__ __forceinline__ void tile_item(const Val& val, int K, bf16_t* WT, const float* gain, const float* lnb, float (&a1)[4], float (&a2)[4], PLAS float* scr, int lane) {
#pragma unroll 2
    for (int i = 0; i < 32; ++i) { const int kk = 2 * i + (lane >> 5); scr[kk * 33 + (lane & 31)] = val(kk, lane & 31); }
    asm volatile("s_waitcnt lgkmcnt(0)" ::: "memory");
    tile_emit<SUMS, 33>(K, WT, gain, lnb, a1, a2, scr, lane);
}
struct ValPlain { static constexpr int BATCH = 32; const float* W; int N; __device__ __forceinline__ float operator()(int kk, int j) const { return W[(size_t)kk * N + j]; } };
struct ValGate { static constexpr int BATCH = 2; const float* W; const float* w2; __device__ __forceinline__ float operator()(int kk, int j) const {
    const float* wr = W + (size_t)kk * cfg::INW; float a = 0.f;
#pragma unroll
    for (int r = 0; r < 16; ++r) a += wr[r] * w2[r * 128 + j]; return a; } };

__device__ __forceinline__ void fold_item(int item, unsigned char* ws, const float* w_in, const float* fw, const float* lng, const float* lnb, PLAS unsigned char* lds, int tid) {
    const int l = item >> 5, g = (item >> 3) & 3, part = (item >> 2) & 1, kq = item & 3;
    PLAS float* M = (PLAS float*)lds;
    { const int c = tid >> 3, e0 = (tid & 7) * 8; float acc[8];
#pragma unroll
      for (int q = 0; q < 8; ++q) acc[q] = 0.f;
      const float* w = fw + (size_t)((l * 4 + g) * 64) * 64 + e0;
      for (int k2 = 0; k2 < 64; ++k2) { float rev = (float)((k2 * c) & 63) * (1.f / 64.f); asm volatile("" : "+v"(rev)); const float tr = part ? __builtin_amdgcn_sinf(rev) : __builtin_amdgcn_cosf(rev);
          const f32x4 w0 = *(const f32x4*)(w + k2 * 64), w1 = *(const f32x4*)(w + k2 * 64 + 4);
#pragma unroll
          for (int q = 0; q < 4; ++q) { acc[q] += tr * w0[q]; acc[4 + q] += tr * w1[q]; } }
      const float sc = 0.00276213586400995f;
#pragma unroll
      for (int q = 0; q < 8; ++q) M[c * 64 + e0 + q] = acc[q] * sc; }
    __syncthreads();
    PLAS float* Wl = (PLAS float*)(lds + 16384);
    { const float* wsrc = w_in + ((size_t)l * 1024 + kq * 256) * cfg::INW + 1536 + 64 * g; f32x4 tv[8];
#pragma unroll
      for (int i = 0; i < 8; ++i) tv[i] = *(const f32x4*)(wsrc + (size_t)((tid >> 4) + 32 * i) * cfg::INW + (tid & 15) * 4);
#pragma unroll
      for (int i = 0; i < 8; ++i) *(PLAS f32x4*)(Wl + ((tid >> 4) + 32 * i) * 64 + (tid & 15) * 4) = tv[i]; }
    __syncthreads();
    { const int e = tid & 63, kg = tid >> 6, k0 = kq * 256 + kg * 32, np = 1536 + part * 256 + g * 64 + e; float mc[64];
#pragma unroll
      for (int c = 0; c < 64; ++c) mc[c] = M[c * 64 + e];
      bf16_t* dst = (bf16_t*)(ws + cfg::WS_WIN + l * cfg::SZ_WIN) + (size_t)np * 1024 + k0; float s1 = 0.f, s2 = 0.f;
      for (int kb = 0; kb < 4; ++kb) { float o[8];
#pragma unroll
          for (int q = 0; q < 8; ++q) { const int k = k0 + kb * 8 + q; const PLAS f32x4* wr = (const PLAS f32x4*)(Wl + (kg * 32 + kb * 8 + q) * 64); float a = 0.f;
#pragma unroll
              for (int c4 = 0; c4 < 16; ++c4) { const f32x4 w4 = wr[c4]; a += w4[0] * mc[4 * c4] + w4[1] * mc[4 * c4 + 1] + w4[2] * mc[4 * c4 + 2] + w4[3] * mc[4 * c4 + 3]; }
              o[q] = a * (lng ? lng[k] : 1.f); s2 += lnb ? lnb[k] * a : 0.f; }
          u32x4 w; w.x = pk2(o[0], o[1]); w.y = pk2(o[2], o[3]); w.z = pk2(o[4], o[5]); w.w = pk2(o[6], o[7]); *(u32x4*)(dst + kb * 8) = w;
          s1 += (lo_f(w.x) + hi_f(w.x)) + (lo_f(w.y) + hi_f(w.y)) + (lo_f(w.z) + hi_f(w.z)) + (lo_f(w.w) + hi_f(w.w)); }
      __syncthreads();
      PLAS float* red = (PLAS float*)lds; red[(kg * 64 + e) * 2] = s1; red[(kg * 64 + e) * 2 + 1] = s2;
      __syncthreads();
      if (kg == 0) { float t1 = 0.f, t2 = 0.f;
#pragma unroll
          for (int w = 0; w < 8; ++w) { t1 += red[(w * 64 + e) * 2]; t2 += red[(w * 64 + e) * 2 + 1]; }
          float* fp = (float*)(ws + cfg::V_MF) + (size_t)((l * 4 + kq) * 2) * 512 + part * 256 + g * 64 + e; fp[0] = t1; fp[512] = t2; } }
    __syncthreads();
}

struct Inputs { const float *x, *w_in, *fw, *gw2, *w_out, *ln1g, *ln1b, *wg, *wu, *wd, *ln2g, *ln2b; };
__device__ __forceinline__ void prologue(unsigned char* ws, const Inputs& in, PLAS unsigned char* lds, int vcu, int G) {
    int tid_o = threadIdx.x; asm volatile("" : "+v"(tid_o));
    const int tid = tid_o, wave = __builtin_amdgcn_readfirstlane(tid >> 6), lane = tid & 63;
    const float* x = in.x; const float* w_in = in.w_in; const float* fw = in.fw; const float* gw2 = in.gw2; const float* w_out = in.w_out; const float* ln1g = in.ln1g; const float* ln1b = in.ln1b;
    const float* wg = in.wg; const float* wu = in.wu; const float* wd = in.wd; const float* ln2g = in.ln2g; const float* ln2b = in.ln2b;
    if (vcu < 64) { const int l = vcu >> 5; fold_item(vcu, ws, w_in, fw, l ? ln2g : (const float*)nullptr, l ? ln2b : (const float*)nullptr, lds, tid); }
    PLAS float* scr = (PLAS float*)(lds + wave * 16384); PLAS float* scr1 = scr + 2048; PLAS float* redw = (PLAS float*)(lds + 131072 + 1024 + wave * 256);
    const int gw = vcu * 8 + wave, NGW = G * 8;
    for (int it = vcu; it < 512; it += G) {
        const int l = it >> 8, r = it & 255; float a1[4] = {0.f, 0.f, 0.f, 0.f}, a2[4] = {0.f, 0.f, 0.f, 0.f}; float* c1o; float* c2o;
        const int k0 = wave * 64, k1 = k0 + 512;
        if (r < 80) { const int nb = r; const float* lngb = l ? ln2g : (const float*)nullptr; const float* lnbb = l ? ln2b : (const float*)nullptr;
            bf16_t* Wt = (bf16_t*)(ws + cfg::WS_WIN + l * cfg::SZ_WIN);
            if (nb < 72) { int np0, src;
                if (nb < 32) { const int pn = nb >> 3, p = (nb & 7) * 32, wc = (p >> 5) & 3, bj = p >> 7; np0 = pn * 256 + p; src = (pn >> 1) * 512 + (pn & 1) * 256 + 64 * wc + 32 * bj; }
                else if (nb < 48) { np0 = 1024 + (nb - 32) * 32; src = np0; }
                else { np0 = 2048 + (nb - 48) * 32; src = 1792 + (nb - 48) * 32; }
                tile_dma(w_in + ((size_t)l * 1024 + k0) * cfg::INW + src, cfg::INW, scr, lane); tile_dma(w_in + ((size_t)l * 1024 + k1) * cfg::INW + src, cfg::INW, scr1, lane);
                asm volatile("s_waitcnt vmcnt(0)" ::: "memory");
                tile_emit<true, 32>(1024, Wt + (size_t)np0 * 1024 + k0, lngb ? lngb + k0 : lngb, lnbb ? lnbb + k0 : lnbb, a1, a2, scr, lane);
                tile_emit<true, 32>(1024, Wt + (size_t)np0 * 1024 + k1, lngb ? lngb + k1 : lngb, lnbb ? lnbb + k1 : lnbb, a1, a2, scr1, lane);
                c1o = (float*)(ws + cfg::V_C1IN) + l * cfg::NIN + np0; c2o = (float*)(ws + cfg::V_C2IN) + l * cfg::NIN + np0;
            } else { const int p0 = (nb - 72) * 32, dir = p0 >> 7, kk0 = p0 & 127, np0 = 2816 + p0;
                for (int kb = wave; kb < 16; kb += 8) { const int kq = kb * 64; ValGate v{w_in + ((size_t)l * 1024 + kq) * cfg::INW + 2560 + 16 * dir, gw2 + (size_t)((l * 2 + dir) * 16) * 128 + kk0};
                    tile_item<true>(v, 1024, Wt + (size_t)np0 * 1024 + kq, lngb ? lngb + kq : lngb, lnbb ? lnbb + kq : lnbb, a1, a2, scr, lane); }
                c1o = (float*)(ws + cfg::V_C1IN) + l * cfg::NIN + np0; c2o = (float*)(ws + cfg::V_C2IN) + l * cfg::NIN + np0; }
        } else { const int nb = r - 80, np0 = nb * 32, pn = np0 >> 8, p = np0 & 255, bj = p >> 7, f0 = 128 * pn + (p & 127);
            const float* W = (bj ? wu : wg) + (size_t)l * 1024 * cfg::FF + f0; bf16_t* Wt = (bf16_t*)(ws + cfg::WS_WGU + l * cfg::SZ_WGU) + (size_t)np0 * 1024;
            tile_dma(W + (size_t)k0 * cfg::FF, cfg::FF, scr, lane); tile_dma(W + (size_t)k1 * cfg::FF, cfg::FF, scr1, lane);
            asm volatile("s_waitcnt vmcnt(0)" ::: "memory");
            tile_emit<true, 32>(1024, Wt + k0, ln1g + l * 1024 + k0, ln1b + l * 1024 + k0, a1, a2, scr, lane);
            tile_emit<true, 32>(1024, Wt + k1, ln1g + l * 1024 + k1, ln1b + l * 1024 + k1, a1, a2, scr1, lane);
            c1o = (float*)(ws + cfg::V_C1GU) + l * cfg::NGU + np0; c2o = (float*)(ws + cfg::V_C2GU) + l * cfg::NGU + np0; }
        if ((lane & 7) == 0) {
#pragma unroll
            for (int j = 0; j < 4; ++j) { const int n = (lane >> 3) + 8 * j; redw[n * 2] = a1[j]; redw[n * 2 + 1] = a2[j]; } }
        __syncthreads();
        if (wave == 0 && lane < 32) { float t1 = 0.f, t2 = 0.f;
#pragma unroll
            for (int w = 0; w < 8; ++w) { const PLAS float* rw = (const PLAS float*)(lds + 131072 + 1024 + w * 256); t1 += rw[lane * 2]; t2 += rw[lane * 2 + 1]; }
            c1o[lane] = t1; c2o[lane] = t2; }
        __syncthreads();
    }
    constexpr int I_OUT = 32 * 16, I_DN = 32 * 44, I_L = I_OUT + I_DN;
    for (int it = gw; it < 2 * I_L; it += 2 * NGW) {
        const float* Ws[2]; int Ns[2], Ks[2]; bf16_t* Wd[2]; float d1[4], d2[4];
#pragma unroll
        for (int q = 0; q < 2; ++q) { const int itq = it + q * NGW; const int ic = itq < 2 * I_L ? itq : it; const int l = ic / I_L; int r = ic - l * I_L;
            if (r < I_OUT) { const int nb = r >> 4, kb = r & 15, k0 = kb * 64, n0 = nb * 32; Ws[q] = w_out + ((size_t)l * 1024 + k0) * 1024 + n0; Ns[q] = 1024; Ks[q] = 1024;
                Wd[q] = (bf16_t*)(ws + cfg::WS_WOUT + l * cfg::SZ_WOUT) + (size_t)n0 * 1024 + k0; }
            else { r -= I_OUT; const int nb = r / 44, kb = r - nb * 44, k0 = kb * 64, n0 = nb * 32; Ws[q] = wd + ((size_t)l * cfg::FF + k0) * 1024 + n0; Ns[q] = 1024; Ks[q] = cfg::FF;
                Wd[q] = (bf16_t*)(ws + cfg::WS_WDN + l * cfg::SZ_WDN) + (size_t)n0 * cfg::FF + k0; } }
        tile_dma(Ws[0], Ns[0], scr, lane); tile_dma(Ws[1], Ns[1], scr1, lane);
        asm volatile("s_waitcnt vmcnt(0)" ::: "memory");
        tile_emit<false, 32>(Ks[0], Wd[0], (const float*)nullptr, (const float*)nullptr, d1, d2, scr, lane);
        if (it + NGW < 2 * I_L) tile_emit<false, 32>(Ks[1], Wd[1], (const float*)nullptr, (const float*)nullptr, d1, d2, scr1, lane);
    }
    const int xw = (vcu - 64) * 8 + wave, NXW = (G - 64) * 8;
    if (vcu >= 64 && G > 64)
    for (int m = xw; m < cfg::T; m += 4 * NXW) {
        f32x4 v[4][4];
#pragma unroll
        for (int q = 0; q < 4; ++q) { const int mr = (m + q * NXW) < cfg::T ? (m + q * NXW) : m; const f32x4* xr = (const f32x4*)(x + (size_t)mr * 1024) + lane;
#pragma unroll
            for (int j = 0; j < 4; ++j) v[q][j] = xr[64 * j]; }
#pragma unroll
        for (int q = 0; q < 4; ++q) { const int mr = (m + q * NXW) < cfg::T ? (m + q * NXW) : m; unsigned long long* o8 = (unsigned long long*)((bf16_t*)(ws + cfg::WS_XB) + (size_t)mr * 1024) + lane;
#pragma unroll
            for (int j = 0; j < 4; ++j) o8[64 * j] = (unsigned long long)pk2(v[q][j][0], v[q][j][1]) | ((unsigned long long)pk2(v[q][j][2], v[q][j][3]) << 32); } }
    for (int i = gw * 64 + lane; i < 2048 * 32; i += NGW * 64) { const int pos = i >> 5, f = i & 31; const float inv = exp2f(-(float)f * (13.287712379549449f / 32.f)); const float ang = (float)pos * inv;
        double rv = (double)ang * 0.15915494309189535; rv -= floor(rv); const float rev = (float)rv;
        ((float*)(ws + cfg::V_ROPEC))[i] = __builtin_amdgcn_cosf(rev); ((float*)(ws + cfg::V_ROPES))[i] = __builtin_amdgcn_sinf(rev); }
}
#undef PLAS
}
constexpr int NWAVES = 8;
constexpr int RING_OFF = 0, RING_BYTES = 131072;
constexpr int LDSCTL_OFF = RING_BYTES, MISC_OFF = LDSCTL_OFF + 320;
constexpr int LDS_BYTES = 147456;
constexpr int CW_BAR = 4096;
constexpr size_t CTL_ZERO_BYTES = 64 * 1024;
#define GAS __attribute__((address_space(1)))
#define LAS __attribute__((address_space(3)))
typedef GAS unsigned gu32;
#define RLX_AGENT __ATOMIC_RELAXED, __HIP_MEMORY_SCOPE_AGENT
#define XB_TMO      128
#define XB_XCNT(j)  (256  + 64 * (j))
#define XB_XSUB(j)  (1280 + 64 * (j))
#define XB_XGEN(j)  (2304 + 64 * (j))
#define XB_TOP      3328
#define XB_TOPGEN   3392
#define XCD_BAR_WORDS 3456
#define XB_SPIN_CAP (1u << 18)

__device__ __forceinline__ unsigned xb_ld(unsigned* p)              { return __hip_atomic_load(p, __ATOMIC_RELAXED, __HIP_MEMORY_SCOPE_AGENT); }
__device__ __forceinline__ unsigned xb_add(unsigned* p, unsigned v) { return __hip_atomic_fetch_add(p, v, __ATOMIC_RELAXED, __HIP_MEMORY_SCOPE_AGENT); }
__device__ __forceinline__ unsigned xb_xcc_id() { return (unsigned)__builtin_amdgcn_s_getreg((3 << 11) | 20) & 0xFu; }
#define XB_SPIN(cond, bar) do { unsigned _sp = 0; while (cond) { __builtin_amdgcn_s_sleep(1); \
    if ((++_sp & 255u) == 0u) { if (xb_ld(&(bar)[XB_TMO])) break; if (_sp > XB_SPIN_CAP) { atomicAdd(&(bar)[XB_TMO], 1u); break; } } } } while (0)

struct XcdBarrier {
    unsigned* bar; unsigned x;
    volatile LAS unsigned* st;
};

__device__ __forceinline__ XcdBarrier xcd_barrier_post(unsigned* bar, volatile LAS unsigned* st) {
    XcdBarrier b; b.bar = bar; b.x = xb_xcc_id(); b.st = st;
    if (threadIdx.x == 0) (void)xb_add(&bar[XB_XCNT(b.x)], 1u);
    return b;
}
__device__ __forceinline__ void xcd_barrier_complete(unsigned* bar, unsigned x, unsigned& nloc, unsigned& nx) {
    const unsigned G = gridDim.x * gridDim.y * gridDim.z;
    unsigned sum, cnt, mine, sp = 0u;
    for (;;) {
        sum = 0u; cnt = 0u; mine = 0u;
#pragma unroll
        for (unsigned j = 0; j < 16; ++j) { const unsigned c = xb_ld(&bar[XB_XCNT(j)]); sum += c; cnt += (c > 0u) ? 1u : 0u; mine = (j == x) ? c : mine; }
        if (sum == G) break;
        __builtin_amdgcn_s_sleep(1);
        if ((++sp & 255u) == 0u) { if (xb_ld(&bar[XB_TMO])) break; if (sp > XB_SPIN_CAP) { atomicAdd(&bar[XB_TMO], 1u); break; } }
    }
    nloc = mine > 0u ? mine : 1u; nx = cnt > 0u ? cnt : 1u;
}

__device__ __forceinline__ void xcd_barrier(const XcdBarrier& b) {
    asm volatile("s_waitcnt vmcnt(0)" ::: "memory");
    __syncthreads();
    if (threadIdx.x == 0) {
        unsigned* bar = b.bar;
        __builtin_amdgcn_s_waitcnt(0);
        unsigned nloc = b.st[0], nx = b.st[1];
        if (nloc == 0u) { xcd_barrier_complete(bar, b.x, nloc, nx); b.st[0] = nloc; b.st[1] = nx; }
        const unsigned old = xb_add(&bar[XB_XSUB(b.x)], 1u);
        const unsigned gen = old / nloc;
        if (old + 1u == (gen + 1u) * nloc) {
            __builtin_amdgcn_fence(__ATOMIC_RELEASE, "agent");
            asm volatile("s_waitcnt vmcnt(0)" ::: "memory");
            const unsigned og = xb_add(&bar[XB_TOP], 1u);
            const unsigned tg = og / nx;
            if (og + 1u == (tg + 1u) * nx) xb_add(&bar[XB_TOPGEN], 1u);
            else XB_SPIN(xb_ld(&bar[XB_TOPGEN]) == tg, bar);
            __builtin_amdgcn_fence(__ATOMIC_ACQUIRE, "agent");
            xb_add(&bar[XB_XGEN(b.x)], 1u);
            asm volatile("s_waitcnt vmcnt(0)" ::: "memory");
        } else {
            XB_SPIN(xb_ld(&bar[XB_XGEN(b.x)]) == gen, bar);
            __builtin_amdgcn_fence(__ATOMIC_ACQUIRE, "agent");
            asm volatile("s_waitcnt vmcnt(0)" ::: "memory");
        }
    }
    __syncthreads();
}


enum { PH_PRO = 0, PH_IN = 1, PH_ATT = 2, PH_MIXB = 3, PH_OUT = 4, PH_GU = 5, PH_DN = 6, PH_FIN = 13, N_PHASES = 14 };
struct MArgs { const float* in[16]; float* out; unsigned char* ws; int ph_lo, ph_hi, li, pad; };

__global__ void __launch_bounds__(NWAVES * 64, 2) mk_fwd(MArgs a) {
    extern __shared__ __attribute__((aligned(16))) unsigned char lds[];
    LAS unsigned char* ldsl = (LAS unsigned char*)lds;
    volatile LAS unsigned* MISC = (volatile LAS unsigned*)(ldsl + MISC_OFF);
    const int tid = threadIdx.x;
    const int G = gridDim.x, bx = blockIdx.x, vcu = (G % 8 == 0) ? (bx % 8) * (G / 8) + bx / 8 : bx;
    unsigned char* ws = a.ws;
    for (int u = tid; u < (LDS_BYTES - LDSCTL_OFF) / 4; u += NWAVES * 64) ((LAS unsigned*)(ldsl + LDSCTL_OFF))[u] = 0u;
    __syncthreads();
    XcdBarrier bar; bar.bar = (unsigned*)(ws + WS_CTL) + CW_BAR + a.li * XCD_BAR_WORDS; bar.x = 0; bar.st = nullptr;
    if (a.ph_hi - a.ph_lo > 1) bar = xcd_barrier_post((unsigned*)(ws + WS_CTL) + CW_BAR + a.li * XCD_BAR_WORDS, MISC + 8);
    const int G0 = G, bx0 = bx, vcu0 = vcu; unsigned char* const ws0 = ws;
    for (int ph = a.ph_lo; ph < a.ph_hi; ++ph) {
        int G = G0, bx = bx0, vcu = vcu0; unsigned zo = 0u; asm volatile("" : "+s"(G), "+s"(bx), "+s"(vcu), "+s"(zo)); unsigned char* ws = ws0 + zo;
        const int l = (ph >= 1 && ph <= 12) ? (ph - 1) / 6 : 0;
        const int kind = (ph == 0) ? PH_PRO : (ph == PH_FIN ? PH_FIN : 1 + (ph - 1) % 6);
        if (kind == PH_PRO) {
            { pro::Inputs pin{a.in[0], a.in[1], a.in[4], a.in[5], a.in[8], a.in[9], a.in[10], a.in[11], a.in[12], a.in[13], a.in[14], a.in[15]}; pro::prologue(ws, pin, ldsl + RING_OFF, vcu, G); }
        } else if (kind == PH_IN) {
            pg8::Gemm g{(const bf16_t*)(ws + WS_XB), (const bf16_t*)(ws + WS_WIN + l * SZ_WIN), T, NIN, D}; pg8::StaticOrder S; S.init(T, NIN, G, bx);
            pg8::FEpiIn E{ws, a.in[6] + l * 256, l};
            pg8::gemm_phase<pg8::FEpiIn, pg8::StaticOrder, true, true>(ldsl + RING_OFF, g, S, E);
        } else if (kind == PH_ATT) {
            for (int i = 0; i < 2; ++i) { const int idx = vcu * 2 + i; if (idx >= 512) break; const int bh = idx >> 4, qb = idx & 15;
                att::attn_unit(bh >> 2, bh & 3, qb, (const bf16_t*)(ws + WS_Q), (const bf16_t*)(ws + WS_K), (const bf16_t*)(ws + WS_V), (bf16_t*)(ws + WS_OC), a.in[2] + l * 256, a.in[3] + l * 128, l, (char*)lds + RING_OFF); }
            for (int i = 0; i < 2; ++i) { const int it = vcu * 2 + i; if (it >= 512) break;
                                fft::stage1_item(it >> 6, it & 63, (const bf16_t*)(ws + WS_TAB), (bf16_t*)(ws + WS_XT), ldsl + RING_OFF); }

            if (vcu < 256) gla::gla_a_item(vcu >> 5, (vcu >> 3) & 3, vcu & 7, ws, ldsl + RING_OFF);
        } else if (kind == PH_MIXB) {
            if (vcu < 256) fft::stage2_item(vcu >> 5, vcu & 31, (const bf16_t*)(ws + WS_XT), (bf16_t*)(ws + WS_OC), ldsl + RING_OFF);
            if (vcu < 256) gla::gla_b_item(vcu >> 5, (vcu >> 3) & 3, vcu & 7, ws, a.in[7] + l * 64, (bf16_t*)(ws + WS_OC), ldsl + RING_OFF);
        } else if (kind == PH_OUT) {
            pg8::Gemm g{(const bf16_t*)(ws + WS_OC), (const bf16_t*)(ws + WS_WOUT + l * SZ_WOUT), T, D, D}; pg8::StaticOrder S; S.init(T, D, G, bx);
            pg8::FEpiRes E{l ? (const float*)(ws + WS_ST2) : (const float*)nullptr, a.in[14] + (l ? l - 1 : 0) * 1024, a.in[15] + (l ? l - 1 : 0) * 1024, (bf16_t*)(ws + WS_XB), (float*)(ws + WS_ST1)};
            pg8::gemm_phase<pg8::FEpiRes, pg8::StaticOrder, true, true>(ldsl + RING_OFF, g, S, E);
        } else if (kind == PH_GU) {
            pg8::Gemm g{(const bf16_t*)(ws + WS_XB), (const bf16_t*)(ws + WS_WGU + l * SZ_WGU), T, NGU, D}; pg8::StaticOrder S; S.init(T, NGU, G, bx);
            pg8::FEpiGU E{(const float*)(ws + WS_ST1), (const float*)(ws + V_C1GU) + l * NGU, (const float*)(ws + V_C2GU) + l * NGU, (bf16_t*)(ws + WS_ACT)};
            pg8::gemm_phase<pg8::FEpiGU, pg8::StaticOrder, true, true>(ldsl + RING_OFF, g, S, E);
        } else if (kind == PH_DN) {
            pg8::Gemm g{(const bf16_t*)(ws + WS_ACT), (const bf16_t*)(ws + WS_WDN + l * SZ_WDN), T, D, FF}; pg8::StaticOrder S; S.init(T, D, G, bx);
            pg8::FEpiRes E{(const float*)(ws + WS_ST1), a.in[9] + l * 1024, a.in[10] + l * 1024, (bf16_t*)(ws + WS_XB), (float*)(ws + WS_ST2)};
            pg8::gemm_phase<pg8::FEpiRes, pg8::StaticOrder, true, true>(ldsl + RING_OFF, g, S, E);
        } else if (kind == PH_FIN) {
            const float* g2 = a.in[14] + 1024; const float* b2v = a.in[15] + 1024; const float* ST2 = (const float*)(ws + WS_ST2); const bf16_t* XB = (const bf16_t*)(ws + WS_XB); float* Y2 = a.out;
            int tid_f = threadIdx.x; asm volatile("" : "+v"(tid_f)); const int lane = tid_f & 63, wave = __builtin_amdgcn_readfirstlane(tid_f >> 6);
            typedef float f32x4 __attribute__((ext_vector_type(4))); typedef unsigned u32x2 __attribute__((ext_vector_type(2)));
            f32x4 gg[4], bq[4];
#pragma unroll
            for (int j = 0; j < 4; ++j) { gg[j] = *((const f32x4*)g2 + lane + 64 * j); bq[j] = *((const f32x4*)b2v + lane + 64 * j); }
            for (int row = vcu * NWAVES + wave; row < T; row += G * NWAVES) { const RowStat rs = row_stat(ST2, row);
                const u32x2* xr = (const u32x2*)(XB + (size_t)row * 1024) + lane; f32x4* yr = (f32x4*)(Y2 + (size_t)row * 1024) + lane;
#pragma unroll
                for (int j = 0; j < 4; ++j) { const u32x2 w = xr[64 * j]; const f32x4 v = {__uint_as_float(w.x << 16), __uint_as_float(w.x & 0xffff0000u), __uint_as_float(w.y << 16), __uint_as_float(w.y & 0xffff0000u)};
                    yr[64 * j] = (v - rs.mu) * rs.rstd * gg[j] + bq[j]; } }
        }
        if (ph + 1 < a.ph_hi) xcd_barrier(bar);
    }
}

static void launch_frame(const MArgs& base, int lo, int hi, int grid, hipStream_t stream, int li = 0) {
    MArgs a = base; a.ph_lo = lo; a.ph_hi = hi; a.li = li;
    hipLaunchKernelGGL(mk_fwd, dim3(grid), dim3(NWAVES * 64), LDS_BYTES, stream, a);
}
extern "C" void kernel_launch(void* const* d_in, const int* in_sizes, int n_in, void* d_out, int out_size, void* d_ws, size_t ws_size, hipStream_t stream) {
    static int grid = 0;
    if (grid == 0) {
        if (n_in != 16 || in_sizes[0] != T * D || out_size != T * D || ws_size < WS_END) { fprintf(stderr, "kernel_launch: unexpected shapes (n_in %d, in0 %d, out %d, ws %zu)\n", n_in, n_in > 0 ? in_sizes[0] : -1, out_size, ws_size); grid = -1; return; }
        int dev = 0, cus = 0, per_cu = 0;
        if (hipGetDevice(&dev) != hipSuccess || hipDeviceGetAttribute(&cus, hipDeviceAttributeMultiprocessorCount, dev) != hipSuccess) { grid = -1; return; }
        if (hipFuncSetAttribute((const void*)mk_fwd, hipFuncAttributeMaxDynamicSharedMemorySize, LDS_BYTES) != hipSuccess) { fprintf(stderr, "kernel_launch: hipFuncSetAttribute failed\n"); grid = -1; return; }
        if (hipOccupancyMaxActiveBlocksPerMultiprocessor(&per_cu, (const void*)mk_fwd, NWAVES * 64, LDS_BYTES) != hipSuccess || per_cu < 1) { fprintf(stderr, "kernel_launch: occupancy query says %d workgroups per CU\n", per_cu); per_cu = 1; }
        (void)hipGetLastError();
        grid = cus;
        if (grid != 256) { fprintf(stderr, "kernel_launch: this kernel's work split is built for the 256 CUs of an MI355X, found %d; nothing launched\n", cus); grid = -1; return; }
    }
    if (grid < 0) return;
    const float* x = (const float*)d_in[0]; const float* w_in = (const float*)d_in[1]; const float* dlam = (const float*)d_in[2]; const float* dng = (const float*)d_in[3];
    const float* fw = (const float*)d_in[4]; const float* gw2 = (const float*)d_in[5]; const float* gb2 = (const float*)d_in[6]; const float* gng = (const float*)d_in[7];
    const float* w_out = (const float*)d_in[8]; const float* ln1g = (const float*)d_in[9]; const float* ln1b = (const float*)d_in[10];
    const float* wg = (const float*)d_in[11]; const float* wu = (const float*)d_in[12]; const float* wd = (const float*)d_in[13]; const float* ln2g = (const float*)d_in[14]; const float* ln2b = (const float*)d_in[15];
    char* ws = (char*)d_ws;
    float* ropec = (float*)(ws + V_ROPEC); float* ropes = (float*)(ws + V_ROPES); float* MF = (float*)(ws + V_MF);
    float* c1in = (float*)(ws + V_C1IN); float* c2in = (float*)(ws + V_C2IN); float* c1gu = (float*)(ws + V_C1GU); float* c2gu = (float*)(ws + V_C2GU);
    bf16_t* TAB = (bf16_t*)(ws + WS_TAB); bf16_t* XB = (bf16_t*)(ws + WS_XB);
    bf16_t* Q = (bf16_t*)(ws + WS_Q); bf16_t* K = (bf16_t*)(ws + WS_K); bf16_t* V = (bf16_t*)(ws + WS_V);
    bf16_t* GQK = (bf16_t*)(ws + WS_GQK); bf16_t* GV = (bf16_t*)(ws + WS_GV); bf16_t* GR = (bf16_t*)(ws + WS_GR); float* GL = (float*)(ws + WS_GL);
    bf16_t* OC = (bf16_t*)(ws + WS_OC); float* OF = (float*)(ws + WS_OF);
    (void)hipMemsetAsync(ws + WS_CTL, 0, CTL_ZERO_BYTES, stream);
    MArgs base{}; for (int i = 0; i < 16; ++i) base.in[i] = (const float*)d_in[i]; base.out = (float*)d_out; base.ws = (unsigned char*)d_ws;
    launch_frame(base, 0, N_PHASES, grid, stream, 0);
}
```

```cpp
#include <hip/hip_runtime.h>
#include <cstdint>
#include <cstdio>
#include <cmath>

typedef unsigned short bf16_t;
namespace cfg {
constexpr int B = 8, S = 2048, D = 1024, T = B * S, L = 2;
constexpr int INW = 2592, NIN = 3072, FF = 2816, NGU = 2 * FF;
constexpr float ALPHA = 1.41421356237309515f;
constexpr float EPS = 1e-5f;
constexpr float QSCALE = 0.125f * 1.4426950408889634f;
constexpr float GQSCALE = 0.17677669529663687f;
constexpr size_t MiB = 1u << 20;
constexpr size_t WS_CTL = 0;
constexpr size_t WS_VEC = 1 * MiB;
constexpr size_t V_ROPEC = WS_VEC, V_ROPES = WS_VEC + 256 * 1024, V_MF = WS_VEC + 512 * 1024;
constexpr size_t V_C1IN = WS_VEC + 768 * 1024, V_C2IN = V_C1IN + 24 * 1024, V_C1GU = V_C2IN + 24 * 1024, V_C2GU = V_C1GU + 44 * 1024;
constexpr size_t WS_WIN = 2 * MiB, WS_WOUT = 14 * MiB, WS_WGU = 18 * MiB, WS_WDN = 40 * MiB, WS_TAB = 51 * MiB;
constexpr size_t SZ_WIN = 6 * MiB, SZ_WOUT = 2 * MiB, SZ_WGU = 11 * MiB, SZ_WDN = 5632 * 1024;
constexpr size_t WS_XB = 67 * MiB;
constexpr size_t WS_Y1 = 99 * MiB, WS_Q = 99 * MiB, WS_K = 115 * MiB, WS_V = 131 * MiB, WS_XT = 147 * MiB;
constexpr size_t WS_ACT = 163 * MiB, WS_GQK = 163 * MiB, WS_GV = 171 * MiB, WS_GR = 179 * MiB, WS_GL = 187 * MiB, WS_OC = 203 * MiB, WS_OF = 235 * MiB;
constexpr size_t WS_ST1 = 251 * MiB, WS_ST2 = 253 * MiB, WS_DEC = 255 * MiB, WS_END = 256 * MiB;
}
using namespace cfg;

__device__ __forceinline__ float bf2f(bf16_t v) { return __uint_as_float((unsigned)v << 16); }
__device__ __forceinline__ bf16_t f2bf(float f) { unsigned u = __float_as_uint(f); return (bf16_t)((u + 0x7fffu + ((u >> 16) & 1u)) >> 16); }


template <int M> __device__ __forceinline__ float xadd(float v) {
    if constexpr (M == 32) { auto r = __builtin_amdgcn_permlane32_swap(__float_as_uint(v), __float_as_uint(v), false, false); return __uint_as_float(r[0]) + __uint_as_float(r[1]); }
    else return v + __int_as_float(__builtin_amdgcn_ds_swizzle(__float_as_int(v), (M << 10) | 0x1f));
}
struct RowStat { float mu, rstd; };
__device__ __forceinline__ RowStat row_stat(const float* ST, int row) {
    float s = 0.f, ss = 0.f;
    for (int i = 0; i < 8; ++i) { const float4 a = *(const float4*)(ST + (size_t)row * 32 + 4 * i); s += a.x + a.z; ss += a.y + a.w; }
    const float mu = s * (1.f / 1024.f); const float var = ss * (1.f / 1024.f) - mu * mu;
    RowStat r; r.mu = mu; r.rstd = rsqrtf(fmaxf(var, 0.f) + EPS); return r;
}
namespace pg8 {
#define PG8_LAS __attribute__((address_space(3)))
typedef unsigned short bf16_t;
typedef short bf16x8 __attribute__((ext_vector_type(8)));
typedef float f32x4 __attribute__((ext_vector_type(4)));
typedef unsigned u32x4 __attribute__((ext_vector_type(4)));
constexpr int BM = 256, BK = 64, HALF = 128, HTB = HALF * BK * 2  , STAGE_BYTES = 8 * HTB, NXCD = 8, WGM = 8;

__host__ __device__ __forceinline__ int lds_byte(int r, int c) { const int st = (r >> 4) * 2 + (c >> 5), rr = r & 15, cc = c & 31, ob = rr * 64 + cc * 2; return st * 1024 + (ob ^ (((ob >> 9) & 1) << 5)); }
__host__ __device__ __forceinline__ void stage_rc(int b, int& R, int& C) { const int st = b / 1024, sb = b % 1024, swz = sb ^ (((sb >> 9) & 1) << 5); R = (st >> 1) * 16 + swz / 64; C = (st & 1) * 32 + (swz % 64) / 2; }
__host__ __device__ __forceinline__ int perm32(int rho) { const int n = rho >> 4, i = rho & 15; return 8 * (i >> 2) + 4 * n + (i & 3); }

struct Unit { int pm, pn; };
struct Gemm { const bf16_t* A; const bf16_t* Bt; int M, N, K; };

struct StaticOrder {
    int nM, nN, nwg, G, c;
    __host__ __device__ void init(int M, int N, int G_, int c_) { nM = M / BM; nN = N / BM; nwg = nM * nN; G = G_; c = c_; }
    __host__ __device__ bool next(int i, Unit& u) const {
        const long L = (long)i * G + c; if (L >= nwg) return false;
        int wgid = (int)L; { const int q = nwg / NXCD, r = nwg % NXCD, xcd = wgid % NXCD, off = wgid / NXCD; wgid = (xcd < r ? xcd * (q + 1) : r * (q + 1) + (xcd - r) * q) + off; }
        const int nig = WGM * nN, gid = wgid / nig, fm = gid * WGM, gsz = (nM - fm) < WGM ? (nM - fm) : WGM;
        u.pm = fm + ((wgid % nig) % gsz); u.pn = (wgid % nig) / gsz; return true;
    }
    __device__ __forceinline__ void a_ready(const Unit&) const {}
    __device__ __forceinline__ void done(const Unit&) const {}
};
template <class Epi, class Sched, bool ALIGN_EPI = false, bool SP2 = false>
__device__ __forceinline__ void gemm_phase(PG8_LAS unsigned char* lds, const Gemm g, const Sched& S, const Epi& E) {
    int tid_o = threadIdx.x; asm volatile("" : "+v"(tid_o));
    const int tid = tid_o, wid = __builtin_amdgcn_readfirstlane(tid >> 6), lane = tid & 63, wr = wid >> 2, wc = wid & 3, fr = lane & 15, fq = lane >> 4;
    const int K = g.K, nt = K / BK;
    unsigned voffA[2], voffB[2];
#pragma unroll
    for (int i = 0; i < 2; ++i) { int R, C; stage_rc(tid * 16 + i * 8192, R, C); const int Rb = Epi::PERM ? ((R & ~31) + perm32(R & 31)) : R;
        voffA[i] = (unsigned)(R * K + C) * 2u; voffB[i] = (unsigned)(Rb * K + C) * 2u; }
    const size_t kstep = (size_t)(BK * 2);
    const size_t hstep = (size_t)HALF * K * 2;
    const size_t tstep = 2 * hstep;
    const unsigned ldsw = (unsigned)wid * 1024u;
    const int aoff = lds_byte(wr * 64 + fr, fq * 8), boff = lds_byte(wc * 32 + fr, fq * 8);
#define PG8_SA(b, h) (((b) * 2 + (h)) * HTB)
#define PG8_SB(b, h) ((4 + (b) * 2 + (h)) * HTB)
#define PG8_STAGE(bufoff, gbase, voff) do { _Pragma("unroll") for (int _i = 0; _i < 2; ++_i) \
        __builtin_amdgcn_global_load_lds((const unsigned*)((const char*)(gbase) + (voff)[_i]), (PG8_LAS unsigned*)(lds + (bufoff) + ldsw + _i * 8192), 16, 0, 0); } while (0)
#define PG8_LDA(dst, b, h) do { _Pragma("unroll") for (int m = 0; m < 4; ++m) _Pragma("unroll") for (int k = 0; k < 2; ++k) dst[m][k] = *(const PG8_LAS bf16x8*)(lds + PG8_SA(b, h) + aoff + m * 2048 + k * 1024); } while (0)
#define PG8_LDB(dst, b, h) do { _Pragma("unroll") for (int n = 0; n < 2; ++n) _Pragma("unroll") for (int k = 0; k < 2; ++k) dst[n][k] = *(const PG8_LAS bf16x8*)(lds + PG8_SB(b, h) + boff + n * 2048 + k * 1024); } while (0)
#define PG8_MMA(ai, bj, At, Bt) do { __builtin_amdgcn_s_setprio(1); _Pragma("unroll") for (int m = 0; m < 4; ++m) _Pragma("unroll") for (int n = 0; n < 2; ++n) _Pragma("unroll") for (int k = 0; k < 2; ++k) \
        acc[ai][bj][m][n] = __builtin_amdgcn_mfma_f32_16x16x32_bf16(Bt[n][k], At[m][k], acc[ai][bj][m][n], 0, 0, 0); __builtin_amdgcn_s_setprio(0); } while (0)
#define PG8_WAIT_V(n) asm volatile("s_waitcnt vmcnt(" #n ")" ::: "memory")
#define PG8_WAIT_L(n) asm volatile("s_waitcnt lgkmcnt(" #n ")" ::: "memory")
#define PG8_BAR __builtin_amdgcn_s_barrier()
#define PG8_SCHED __builtin_amdgcn_sched_barrier(0)
    Unit cur, nxt; int ui = 0;
    if (!S.next(0, cur)) return;
    f32x4 acc[2][2][4][2];
#pragma unroll
    for (int a = 0; a < 2; ++a)
#pragma unroll
        for (int b = 0; b < 2; ++b)
#pragma unroll
            for (int m = 0; m < 4; ++m)
#pragma unroll
                for (int n = 0; n < 2; ++n) acc[a][b][m][n] = (f32x4){0.f, 0.f, 0.f, 0.f};
    bf16x8 At[4][2], B0[2][2], B1[2][2];
    const char* cA = (const char*)g.A + (size_t)cur.pm * tstep; const char* cB = (const char*)g.Bt + (size_t)cur.pn * tstep;
    S.a_ready(cur);
    if constexpr (SP2) {
        PG8_STAGE(PG8_SB(0, 0), cB, voffB); PG8_STAGE(PG8_SB(0, 1), cB + hstep, voffB); PG8_STAGE(PG8_SA(0, 0), cA, voffA); PG8_STAGE(PG8_SA(0, 1), cA + hstep, voffA);
        if (wr == 1) PG8_BAR;
        PG8_WAIT_V(2); PG8_BAR;
        PG8_STAGE(PG8_SB(1, 0), cB + kstep, voffB); PG8_STAGE(PG8_SA(1, 0), cA + kstep, voffA); PG8_STAGE(PG8_SB(1, 1), cB + hstep + kstep, voffB);
        PG8_WAIT_V(6); PG8_BAR;
    } else {
        PG8_STAGE(PG8_SB(0, 0), cB, voffB); PG8_STAGE(PG8_SA(0, 0), cA, voffA); PG8_STAGE(PG8_SB(0, 1), cB + hstep, voffB); PG8_STAGE(PG8_SA(0, 1), cA + hstep, voffA);
        if (wr == 1) PG8_BAR;
        PG8_WAIT_V(4); PG8_BAR;
        PG8_STAGE(PG8_SB(1, 0), cB + kstep, voffB); PG8_STAGE(PG8_SA(1, 0), cA + kstep, voffA); PG8_STAGE(PG8_SB(1, 1), cB + hstep + kstep, voffB);
        PG8_WAIT_V(6); PG8_BAR;
    }
    for (;;) {
        const bool has_next = S.next(ui + 1, nxt);
        const char* nA = has_next ? (const char*)g.A + (size_t)nxt.pm * tstep : cA; const char* nB = has_next ? (const char*)g.Bt + (size_t)nxt.pn * tstep : cB;
        for (int t = 0; t < nt; t += 2) {
            const bool last = (t == nt - 2);
            const char* a1 = cA + (size_t)(t + 1) * kstep;
            const char* a2 = last ? nA : cA + (size_t)(t + 2) * kstep; const char* b2 = last ? nB : cB + (size_t)(t + 2) * kstep;
            const char* a3 = a2 + kstep; const char* b3 = b2 + kstep;
            if (last && has_next) S.a_ready(nxt);
            if constexpr (SP2) {
            PG8_LDB(B0, 0, 0); PG8_LDB(B1, 0, 1); PG8_SCHED; PG8_LDA(At, 0, 0); PG8_STAGE(PG8_SA(1, 1), a1 + hstep, voffA);
            PG8_WAIT_V(8); PG8_WAIT_L(0); PG8_BAR; PG8_MMA(0, 0, At, B0); PG8_MMA(0, 1, At, B1); PG8_BAR; PG8_SCHED;
            PG8_LDA(At, 0, 1); PG8_STAGE(PG8_SB(0, 0), b2, voffB); PG8_STAGE(PG8_SB(0, 1), b2 + hstep, voffB); PG8_STAGE(PG8_SA(0, 0), a2, voffA);
            PG8_WAIT_V(8); PG8_WAIT_L(0); PG8_BAR; PG8_MMA(1, 0, At, B0); PG8_MMA(1, 1, At, B1); PG8_BAR; PG8_SCHED;
            PG8_LDB(B0, 1, 0); PG8_LDB(B1, 1, 1); PG8_SCHED; PG8_LDA(At, 1, 0); PG8_STAGE(PG8_SA(0, 1), a2 + hstep, voffA);
            PG8_WAIT_V(8); PG8_WAIT_L(0); PG8_BAR; PG8_MMA(0, 0, At, B0); PG8_MMA(0, 1, At, B1); PG8_BAR; PG8_SCHED;
            PG8_LDA(At, 1, 1); PG8_STAGE(PG8_SB(1, 0), b3, voffB); PG8_STAGE(PG8_SB(1, 1), b3 + hstep, voffB); PG8_STAGE(PG8_SA(1, 0), a3, voffA);
            PG8_WAIT_V(8); PG8_WAIT_L(0); PG8_BAR; PG8_MMA(1, 0, At, B0); PG8_MMA(1, 1, At, B1); PG8_BAR; PG8_SCHED;
            } else {
            PG8_LDB(B0, 0, 0); PG8_SCHED; PG8_LDA(At, 0, 0); PG8_STAGE(PG8_SA(1, 1), a1 + hstep, voffA);
            PG8_WAIT_L(8); PG8_BAR; PG8_WAIT_L(0); PG8_MMA(0, 0, At, B0); PG8_BAR; PG8_SCHED;
            PG8_LDB(B1, 0, 1); PG8_STAGE(PG8_SB(0, 0), b2, voffB);
            PG8_BAR; PG8_WAIT_L(0); PG8_MMA(0, 1, At, B1); PG8_BAR;
            PG8_LDA(At, 0, 1); PG8_STAGE(PG8_SA(0, 0), a2, voffA);
            PG8_BAR; PG8_WAIT_L(0); PG8_MMA(1, 0, At, B0); PG8_BAR; PG8_SCHED;
            PG8_STAGE(PG8_SB(0, 1), b2 + hstep, voffB);
            PG8_WAIT_V(6); PG8_BAR; PG8_MMA(1, 1, At, B1); PG8_BAR;
            PG8_LDB(B0, 1, 0); PG8_SCHED; PG8_LDA(At, 1, 0); PG8_STAGE(PG8_SA(0, 1), a2 + hstep, voffA);
            PG8_WAIT_L(8); PG8_BAR; PG8_WAIT_L(0); PG8_MMA(0, 0, At, B0); PG8_BAR; PG8_SCHED;
            PG8_LDB(B1, 1, 1); PG8_STAGE(PG8_SB(1, 0), b3, voffB);
            PG8_BAR; PG8_WAIT_L(0); PG8_MMA(0, 1, At, B1); PG8_BAR;
            PG8_LDA(At, 1, 1); PG8_STAGE(PG8_SA(1, 0), a3, voffA);
            PG8_BAR; PG8_WAIT_L(0); PG8_MMA(1, 0, At, B0); PG8_BAR; PG8_SCHED;
            PG8_STAGE(PG8_SB(1, 1), b3 + hstep, voffB);
            PG8_WAIT_V(6); PG8_BAR; PG8_MMA(1, 1, At, B1); PG8_BAR;
            }
        }
        if constexpr (ALIGN_EPI) { if (wr == 0) PG8_BAR; }
        if constexpr (!Epi::AFTER_DRAIN) { E(acc, cur, wr, wc, fr, fq); S.done(cur); }
        if (!has_next) break;
#pragma unroll
        for (int a = 0; a < 2; ++a)
#pragma unroll
            for (int b = 0; b < 2; ++b)
#pragma unroll
                for (int m = 0; m < 4; ++m)
#pragma unroll
                    for (int n = 0; n < 2; ++n) acc[a][b][m][n] = (f32x4){0.f, 0.f, 0.f, 0.f};
        cur = nxt; cA = nA; cB = nB; ++ui;
        if constexpr (ALIGN_EPI) { if (wr == 1) PG8_BAR; }
    }
    PG8_WAIT_V(0);
    if constexpr (!ALIGN_EPI) { if (wr == 0) PG8_BAR; }
    PG8_BAR;
    if constexpr (Epi::AFTER_DRAIN) { E.fused(acc, cur, wr, wc, fr, fq, lds, wid, lane); S.done(cur); }
#undef PG8_SA
#undef PG8_SB
#undef PG8_STAGE
#undef PG8_LDA
#undef PG8_LDB
#undef PG8_MMA
#undef PG8_WAIT_V
#undef PG8_WAIT_L
#undef PG8_BAR
#undef PG8_SCHED
}
}
namespace pg8 {
__device__ __forceinline__ unsigned cvt_pk_bf16(float lo, float hi) { unsigned r; asm volatile("v_cvt_pk_bf16_f32 %0, %1, %2" : "=v"(r) : "v"(lo), "v"(hi)); return r; }
__device__ __forceinline__ void st8(bf16_t* p, const f32x4 a, const f32x4 b) { u32x4 w; w.x = cvt_pk_bf16(a[0], a[1]); w.y = cvt_pk_bf16(a[2], a[3]); w.z = cvt_pk_bf16(b[0], b[1]); w.w = cvt_pk_bf16(b[2], b[3]); *(u32x4*)p = w; }
__device__ __forceinline__ void st8nt(bf16_t* p, const f32x4 a, const f32x4 b) { u32x4 w; w.x = cvt_pk_bf16(a[0], a[1]); w.y = cvt_pk_bf16(a[2], a[3]); w.z = cvt_pk_bf16(b[0], b[1]); w.w = cvt_pk_bf16(b[2], b[3]); __builtin_nontemporal_store(w, (u32x4*)p); }
struct RS { float a, b; };
struct StatLd { f32x4 x, y; };
__device__ __forceinline__ StatLd stat_load(const float* ST, int row, int fq) { const f32x4* p = (const f32x4*)(ST + (size_t)row * 32 + fq * 8); StatLd r; r.x = p[0]; r.y = p[1]; return r; }
__device__ __forceinline__ RS stat_fin(const StatLd& t) {
    float s = (t.x[0] + t.x[2]) + (t.y[0] + t.y[2]), ss = (t.x[1] + t.x[3]) + (t.y[1] + t.y[3]);
    s = xadd<16>(s); ss = xadd<16>(ss); s = xadd<32>(s); ss = xadd<32>(ss);
    const float mu = s * (1.f / 1024.f), var = ss * (1.f / 1024.f) - mu * mu, rstd = rsqrtf(fmaxf(var, 0.f) + cfg::EPS);
    RS r; r.a = rstd; r.b = -rstd * mu; return r;
}
__device__ __forceinline__ RS row_stat16(const float* ST, int row, int fq) { return stat_fin(stat_load(ST, row, fq)); }
__device__ __forceinline__ float fsilu(float x) { return x * __builtin_amdgcn_rcpf(1.f + __expf(-x)); }
__device__ __forceinline__ float flogsig16(float x) { return (fminf(x, 0.f) - __logf(1.f + __expf(-fabsf(x)))) * (1.f / 16.f); }

struct FEpiIn {
    static constexpr bool PERM = true, AFTER_DRAIN = false;
    unsigned char* ws; const float* b2; int l; const PG8_LAS float* rsl;
    struct RowLd { f32x4 rc[2], rsn[2]; };
    template <int KIND> __device__ __forceinline__ RowLd load_row(int row, int fq) const {
        RowLd r;
        if constexpr (KIND == 0) { const int pos = row & 2047; const float* cp = (const float*)(ws + cfg::V_ROPEC) + pos * 32 + 8 * fq; const float* sp = (const float*)(ws + cfg::V_ROPES) + pos * 32 + 8 * fq;
            r.rc[0] = *(const f32x4*)cp; r.rc[1] = *(const f32x4*)(cp + 4); r.rsn[0] = *(const f32x4*)sp; r.rsn[1] = *(const f32x4*)(sp + 4); }
        return r;
    }
    template <int KIND> __device__ __forceinline__ void rows(const f32x4 (&acc)[2][2][4][2], const Unit& u, int wr, int wc, int fr, int fq) const {
        const int pn = u.pn, cw = 32 * wc + 8 * fq, row0 = u.pm * BM + 64 * wr + fr;
        const bool st = l != 0;
        f32x4 k1[2][2], k2[2][2], bias[2][2];
        const float qs = __uint_as_float(__builtin_amdgcn_readfirstlane(__float_as_uint(pn < 2 ? cfg::QSCALE : 1.f)));
        RowLd cur = load_row<KIND>(row0, fq), nxt;
        if (st) {
#pragma unroll
            for (int bj = 0; bj < 2; ++bj)
#pragma unroll
                for (int n = 0; n < 2; ++n) {
                    if constexpr (KIND == 2) {
                        const float* fp = (const float*)(ws + cfg::V_MF) + (size_t)(l * 8) * 512 + (pn - 6) * 256 + cw + 128 * bj + 4 * n;
                        k1[bj][n] = (*(const f32x4*)fp + *(const f32x4*)(fp + 1024)) + (*(const f32x4*)(fp + 2048) + *(const f32x4*)(fp + 3072));
                        k2[bj][n] = (*(const f32x4*)(fp + 512) + *(const f32x4*)(fp + 1536)) + (*(const f32x4*)(fp + 2560) + *(const f32x4*)(fp + 3584));
                    } else { const float* c1 = (const float*)(ws + cfg::V_C1IN) + l * cfg::NIN + pn * 256 + cw; const float* c2 = (const float*)(ws + cfg::V_C2IN) + l * cfg::NIN + pn * 256 + cw;
                        k1[bj][n] = *(const f32x4*)(c1 + 128 * bj + 4 * n); k2[bj][n] = *(const f32x4*)(c2 + 128 * bj + 4 * n); } } }
        if constexpr (KIND == 6) {
#pragma unroll
            for (int bj = 0; bj < 2; ++bj)
#pragma unroll
                for (int n = 0; n < 2; ++n) bias[bj][n] = *(const f32x4*)(b2 + 128 * bj + cw + 4 * n); }
#pragma unroll
        for (int i = 0; i < 8; ++i) {
            const int ai = i >> 2, m = i & 3, row = row0 + 128 * ai + 16 * m, pos = row & 2047;
            if (i < 7) nxt = load_row<KIND>(row0 + 128 * ((i + 1) >> 2) + 16 * ((i + 1) & 3), fq);
            f32x4 v[2][2];
            if (st) { typedef float f32x2 __attribute__((ext_vector_type(2))); const f32x2 t2 = *(const PG8_LAS f32x2*)(rsl + 2 * (128 * ai + 64 * wr + 16 * m + fr)); RS rs; rs.a = t2[0]; rs.b = t2[1];
#pragma unroll
                for (int bj = 0; bj < 2; ++bj)
#pragma unroll
                    for (int n = 0; n < 2; ++n) v[bj][n] = rs.a * acc[ai][bj][m][n] + (rs.b * k1[bj][n] + k2[bj][n]);
            } else {
#pragma unroll
                for (int bj = 0; bj < 2; ++bj)
#pragma unroll
                    for (int n = 0; n < 2; ++n) v[bj][n] = acc[ai][bj][m][n]; }
            if constexpr (KIND == 0) {
                f32x4 a0 = v[0][0] * cur.rc[0] - v[1][0] * cur.rsn[0], a1 = v[0][1] * cur.rc[1] - v[1][1] * cur.rsn[1];
                f32x4 b0 = v[1][0] * cur.rc[0] + v[0][0] * cur.rsn[0], b1 = v[1][1] * cur.rc[1] + v[0][1] * cur.rsn[1];
                a0 = a0 * qs; a1 = a1 * qs; b0 = b0 * qs; b1 = b1 * qs;
                bf16_t* dst = (bf16_t*)(ws + (pn < 2 ? cfg::WS_Q : cfg::WS_K)) + (size_t)row * 512 + (4 * (pn & 1) + wc) * 64 + 8 * fq;
                st8(dst, a0, a1); st8(dst + 32, b0, b1);
            } else if constexpr (KIND == 1) {
                bf16_t* dst = (bf16_t*)(ws + cfg::WS_V) + (size_t)row * 512 + (pn - 4) * 256 + cw; st8(dst, v[0][0], v[0][1]); st8(dst + 128, v[1][0], v[1][1]);
            } else if constexpr (KIND == 2) {
                bf16_t* dst = (bf16_t*)(ws + cfg::WS_TAB) + (size_t)row * 512 + (pn - 6) * 256 + cw; st8(dst, v[0][0], v[0][1]); st8(dst + 128, v[1][0], v[1][1]);
            } else if constexpr (KIND == 3) {
                bf16_t* dst = (bf16_t*)(ws + cfg::WS_GQK) + (size_t)row * 256 + cw; st8(dst, v[0][0] * cfg::GQSCALE, v[0][1] * cfg::GQSCALE); st8(dst + 128, v[1][0], v[1][1]);
            } else if constexpr (KIND == 4) {
                bf16_t* dst = (bf16_t*)(ws + cfg::WS_GV) + (size_t)row * 256 + cw; st8(dst, v[0][0], v[0][1]); st8(dst + 128, v[1][0], v[1][1]);
            } else if constexpr (KIND == 5) {
                bf16_t* dst = (bf16_t*)(ws + cfg::WS_GR) + (size_t)row * 256 + cw;
#pragma unroll
                for (int bj = 0; bj < 2; ++bj) { f32x4 x0 = v[bj][0], x1 = v[bj][1];
#pragma unroll
                    for (int e = 0; e < 4; ++e) { x0[e] = fsilu(x0[e]); x1[e] = fsilu(x1[e]); } st8(dst + 128 * bj, x0, x1); }
            } else {
                float* dst = (float*)(ws + cfg::WS_GL) + (size_t)row * 256 + cw;
#pragma unroll
                for (int bj = 0; bj < 2; ++bj)
#pragma unroll
                    for (int n = 0; n < 2; ++n) { f32x4 x = v[bj][n] + bias[bj][n];
#pragma unroll
                        for (int e = 0; e < 4; ++e) x[e] = flogsig16(x[e]); *(f32x4*)(dst + 128 * bj + 4 * n) = x; }
            }
            if (i < 7) cur = nxt;
        }
    }
    __device__ __forceinline__ void operator()(const f32x4 (&acc)[2][2][4][2], const Unit& u, int wr, int wc, int fr, int fq) const {
        asm volatile("" : "+v"(fr), "+v"(fq));
        unsigned zo = 0u; asm volatile("" : "+s"(zo)); FEpiIn me = *this; me.ws = ws + zo;
        const int pn = u.pn;
        if (pn < 4) me.rows<0>(acc, u, wr, wc, fr, fq); else if (pn < 6) me.rows<1>(acc, u, wr, wc, fr, fq); else if (pn < 8) me.rows<2>(acc, u, wr, wc, fr, fq);
        else if (pn == 8) me.rows<3>(acc, u, wr, wc, fr, fq); else if (pn == 9) me.rows<4>(acc, u, wr, wc, fr, fq); else if (pn == 10) me.rows<5>(acc, u, wr, wc, fr, fq); else me.rows<6>(acc, u, wr, wc, fr, fq);
    }
};
struct FEpiRes {
    static constexpr bool PERM = true, AFTER_DRAIN = false;
    const PG8_LAS float* stprev;
    const float* g; const float* bb; bf16_t* XB; float* ST;
    struct RowLd { u32x4 xb[2]; };
    __device__ __forceinline__ RowLd load_row(int row, int col0, int fq) const {
        RowLd r; const size_t off = (size_t)row * 1024 + col0;
        r.xb[0] = *(const u32x4*)(XB + off); r.xb[1] = *(const u32x4*)(XB + off + 128);
        return r;
    }
    __device__ __forceinline__ void operator()(const f32x4 (&acc)[2][2][4][2], const Unit& u, int wr, int wc, int fr, int fq) const {
        asm volatile("" : "+v"(fr), "+v"(fq));
        const int col0 = u.pn * BM + 32 * wc + 8 * fq, row0 = u.pm * BM + 64 * wr + fr;
        f32x4 gv[2][2], bv[2][2];
        RowLd cur = load_row(row0, col0, fq), nxt;
        if (stprev) {
#pragma unroll
            for (int bj = 0; bj < 2; ++bj)
#pragma unroll
                for (int n = 0; n < 2; ++n) { gv[bj][n] = *(const f32x4*)(g + col0 + 128 * bj + 4 * n); bv[bj][n] = *(const f32x4*)(bb + col0 + 128 * bj + 4 * n); } }
#pragma unroll
        for (int i = 0; i < 8; ++i) { const int ai = i >> 2, m = i & 3, row = row0 + 128 * ai + 16 * m; const size_t off = (size_t)row * 1024 + col0;
            if (i < 7) nxt = load_row(row0 + 128 * ((i + 1) >> 2) + 16 * ((i + 1) & 3), col0, fq);
            RS rs; rs.a = 1.f; rs.b = 0.f; if (stprev) { typedef float f32x2 __attribute__((ext_vector_type(2))); const f32x2 t2 = *(const PG8_LAS f32x2*)(stprev + 2 * (128 * ai + 64 * wr + 16 * m + fr)); rs.a = t2[0]; rs.b = t2[1]; }
            float s = 0.f, ss = 0.f;
#pragma unroll
            for (int bj = 0; bj < 2; ++bj) { f32x4 y[2];
#pragma unroll
                for (int n = 0; n < 2; ++n) { const unsigned w0 = cur.xb[bj][2 * n], w1 = cur.xb[bj][2 * n + 1];
                    f32x4 x = (f32x4){__uint_as_float(w0 << 16), __uint_as_float(w0 & 0xffff0000u), __uint_as_float(w1 << 16), __uint_as_float(w1 & 0xffff0000u)};
                    if (stprev) x = (rs.a * x + rs.b) * gv[bj][n] + bv[bj][n];
                    y[n] = cfg::ALPHA * x + acc[ai][bj][m][n];
                    s += (y[n][0] + y[n][1]) + (y[n][2] + y[n][3]); ss += (y[n][0] * y[n][0] + y[n][1] * y[n][1]) + (y[n][2] * y[n][2] + y[n][3] * y[n][3]); }
                st8nt(XB + off + 128 * bj, y[0], y[1]); }
            s = xadd<16>(s); ss = xadd<16>(ss); s = xadd<32>(s); ss = xadd<32>(ss);
            if (fq == 0) { typedef float f32x2 __attribute__((ext_vector_type(2))); *(f32x2*)(ST + (size_t)row * 32 + (u.pn * 4 + wc) * 2) = (f32x2){s, ss}; }
            if (i < 7) cur = nxt; }
    }
};
struct FEpiGU {
    static constexpr bool PERM = true, AFTER_DRAIN = false;
    const PG8_LAS float* rsl;
    const float* c1; const float* c2; bf16_t* ACT;
    __device__ __forceinline__ void operator()(const f32x4 (&acc)[2][2][4][2], const Unit& u, int wr, int wc, int fr, int fq) const {
        asm volatile("" : "+v"(fr), "+v"(fq));
        const int cw = 32 * wc + 8 * fq, row0 = u.pm * BM + 64 * wr + fr; const float* c1p = c1 + u.pn * 256 + cw; const float* c2p = c2 + u.pn * 256 + cw;
        typedef float f32x2 __attribute__((ext_vector_type(2)));
        f32x4 k1[2][2], k2[2][2];
#pragma unroll
        for (int bj = 0; bj < 2; ++bj)
#pragma unroll
            for (int n = 0; n < 2; ++n) { k1[bj][n] = *(const f32x4*)(c1p + 128 * bj + 4 * n); k2[bj][n] = *(const f32x4*)(c2p + 128 * bj + 4 * n); }
#pragma unroll
        for (int i = 0; i < 8; ++i) { const int ai = i >> 2, m = i & 3; const f32x2 rs = *(const PG8_LAS f32x2*)(rsl + 2 * (128 * ai + 64 * wr + 16 * m + fr)); f32x4 a[2];
#pragma unroll
            for (int n = 0; n < 2; ++n) { const f32x4 hg = rs[0] * acc[ai][0][m][n] + (rs[1] * k1[0][n] + k2[0][n]), hu = rs[0] * acc[ai][1][m][n] + (rs[1] * k1[1][n] + k2[1][n]);
#pragma unroll
                for (int e = 0; e < 4; ++e) a[n][e] = fsilu(hg[e]) * hu[e]; }
            st8nt(ACT + (size_t)(row0 + 128 * ai + 16 * m) * cfg::FF + 128 * u.pn + cw, a[0], a[1]); }
    }
};
struct FEpiFour {
    static constexpr bool PERM = true, AFTER_DRAIN = false;
    bf16_t* OC;
    __device__ __forceinline__ void operator()(const f32x4 (&acc)[2][2][4][2], const Unit& u, int wr, int wc, int fr, int fq) const {
        asm volatile("" : "+v"(fr), "+v"(fq));
        const int cw = 32 * wc + 8 * fq;
#pragma unroll
        for (int ai = 0; ai < 2; ++ai)
#pragma unroll
            for (int m = 0; m < 4; ++m) { const int row = u.pm * BM + 128 * ai + 64 * wr + 16 * m + fr; bf16_t* dst = OC + (size_t)(u.pn * 2048 + row) * 1024 + 512 + cw;
                st8(dst, acc[ai][0][m][0], acc[ai][0][m][1]); st8(dst + 128, acc[ai][1][m][0], acc[ai][1][m][1]); }
    }
};
}
namespace att {
using bf16x8 = __attribute__((ext_vector_type(8))) short;
using s16x4  = __attribute__((ext_vector_type(4))) short;
using f32x16 = __attribute__((ext_vector_type(16))) float;
using u32x4  = __attribute__((ext_vector_type(4))) unsigned;
constexpr int NW = 8, QBLK = 32, KVBLK = 64, LD = 512, NT = cfg::S / KVBLK;
constexpr int SHM_V = KVBLK * 128 * 2, SHM_K = KVBLK * 128 * 2, SHM_X = 2 * SHM_V + 2 * SHM_K, SHM_ATTN = SHM_X + NW * 64 * 4;
constexpr float THRL = 6.0f;
#define ATT_KSWZ(row, colB) ((row) * 256 + ((colB) ^ (((row) & 7) << 4)))
#define ATT_SBAR() __builtin_amdgcn_sched_barrier(0)
__device__ __forceinline__ int crow(int r, int hi) { return (r & 3) + 8 * (r >> 2) + 4 * hi; }
__device__ __forceinline__ unsigned cvtpk(float lo, float hi) { unsigned r; asm volatile("v_cvt_pk_bf16_f32 %0, %1, %2" : "=v"(r) : "v"(lo), "v"(hi)); return r; }
__device__ __forceinline__ void partialSM(f32x16& p0, f32x16& p1, float& m_reg, float& alpha) {
  float pmax = p0[0];
#pragma unroll
  for (int r = 1; r < 16; ++r) pmax = fmaxf(pmax, p0[r]);
#pragma unroll
  for (int r = 0; r < 16; ++r) pmax = fmaxf(pmax, p1[r]);
  { auto rr = __builtin_amdgcn_permlane32_swap(__float_as_uint(pmax), __float_as_uint(pmax), false, false); pmax = fmaxf(__uint_as_float(rr[0]), __uint_as_float(rr[1])); }
  float mn;
  if (__builtin_expect(__all(pmax - m_reg <= THRL), 1)) { mn = m_reg; alpha = 1.f; }
  else { mn = fmaxf(m_reg, pmax); alpha = __builtin_amdgcn_exp2f(m_reg - mn); m_reg = mn; }
#pragma unroll
  for (int r = 0; r < 16; ++r) p0[r] = p0[r] - mn;
#pragma unroll
  for (int r = 0; r < 16; ++r) p1[r] = p1[r] - mn;
#pragma unroll
  for (int r = 0; r < 16; ++r) p0[r] = __builtin_amdgcn_exp2f(p0[r]);
}
__device__ __forceinline__ void finishSM(f32x16& p0, f32x16& p1, float alpha, float& l_reg, bf16x8& pa0, bf16x8& pa1, bf16x8& pa2, bf16x8& pa3) {
#pragma unroll
  for (int r = 0; r < 16; ++r) p1[r] = __builtin_amdgcn_exp2f(p1[r]);
  float ps = 0;
#pragma unroll
  for (int r = 0; r < 16; ++r) ps += p0[r];
#pragma unroll
  for (int r = 0; r < 16; ++r) ps += p1[r];
  { auto rr = __builtin_amdgcn_permlane32_swap(__float_as_uint(ps), __float_as_uint(ps), false, false); ps = __uint_as_float(rr[0]) + __uint_as_float(rr[1]); }
  l_reg = l_reg * alpha + ps;
#define ATT_PK4(P, BASE, OUT) do { unsigned a0 = cvtpk(P[BASE + 0], P[BASE + 1]), a1 = cvtpk(P[BASE + 2], P[BASE + 3]);   \
    unsigned b0 = cvtpk(P[BASE + 4], P[BASE + 5]), b1 = cvtpk(P[BASE + 6], P[BASE + 7]);                              \
    auto r0 = __builtin_amdgcn_permlane32_swap(a0, b0, false, false); auto r1 = __builtin_amdgcn_permlane32_swap(a1, b1, false, false); \
    u32x4 w = {r0[0], r1[0], r0[1], r1[1]}; OUT = *reinterpret_cast<bf16x8*>(&w); } while (0)
  ATT_PK4(p0, 0, pa0); ATT_PK4(p0, 8, pa1); ATT_PK4(p1, 0, pa2); ATT_PK4(p1, 8, pa3);
#undef ATT_PK4
}
__device__ __forceinline__ void qkt(f32x16& p0, f32x16& p1, const char* Ks, const bf16x8* qr, int r32, int hi, int mofs) {
  p0 = f32x16{}; p1 = f32x16{};
#pragma unroll
  for (int d0 = 0; d0 < 4; ++d0) { const int cb = (mofs + d0 * 16 + hi * 8) * 2;
    const bf16x8 b0 = *reinterpret_cast<const bf16x8*>(Ks + ATT_KSWZ(r32, cb));
    const bf16x8 b1 = *reinterpret_cast<const bf16x8*>(Ks + ATT_KSWZ(32 + r32, cb));
    p0 = __builtin_amdgcn_mfma_f32_32x32x16_bf16(b0, qr[d0], p0, 0, 0, 0);
    p1 = __builtin_amdgcn_mfma_f32_32x32x16_bf16(b1, qr[d0], p1, 0, 0, 0); }
}
__device__ __forceinline__ int v_st(int k, int c) { const int kk = (k & ~0xC) | ((k & 4) << 1) | ((k & 8) >> 1); return ((kk >> 3) * 4 + (c >> 5)) * 512 + ((kk & 7) * 32 + (c & 31)) * 2; }
__device__ __forceinline__ int v_rd_base(int lane) { return ((lane & 3) << 3) | (((lane >> 2) & 3) << 6) | (((lane >> 4) & 1) << 5) | (((lane >> 5) & 1) << 8); }
constexpr int v_rd_off(int d0, int ks, int half) { return d0 * 512 + ks * 4096 + half * 2048; }
template <int OFF> __device__ __forceinline__ s16x4 tr_read(int vb) { s16x4 r; asm volatile("ds_read_b64_tr_b16 %0, %1 offset:%2" : "=&v"(r) : "v"(vb), "i"(OFF) : "memory"); return r; }
template <int D0> __device__ __forceinline__ void pv_one(f32x16& od, int vb, bf16x8 pa0, bf16x8 pa1, bf16x8 pa2, bf16x8 pa3) {
  const s16x4 l0 = tr_read<v_rd_off(D0, 0, 0)>(vb), h0 = tr_read<v_rd_off(D0, 0, 1)>(vb), l1 = tr_read<v_rd_off(D0, 1, 0)>(vb), h1 = tr_read<v_rd_off(D0, 1, 1)>(vb);
  const s16x4 l2 = tr_read<v_rd_off(D0, 2, 0)>(vb), h2 = tr_read<v_rd_off(D0, 2, 1)>(vb), l3 = tr_read<v_rd_off(D0, 3, 0)>(vb), h3 = tr_read<v_rd_off(D0, 3, 1)>(vb);
  asm volatile("s_waitcnt lgkmcnt(0)" ::: "memory"); ATT_SBAR();
#define ATT_PK(L, H) (bf16x8){L[0], L[1], L[2], L[3], H[0], H[1], H[2], H[3]}
  od = __builtin_amdgcn_mfma_f32_32x32x16_bf16(pa0, ATT_PK(l0, h0), od, 0, 0, 0);
  od = __builtin_amdgcn_mfma_f32_32x32x16_bf16(pa1, ATT_PK(l1, h1), od, 0, 0, 0);
  od = __builtin_amdgcn_mfma_f32_32x32x16_bf16(pa2, ATT_PK(l2, h2), od, 0, 0, 0);
  od = __builtin_amdgcn_mfma_f32_32x32x16_bf16(pa3, ATT_PK(l3, h3), od, 0, 0, 0);
#undef ATT_PK
}
__device__ __forceinline__ void pv_d0(f32x16* o, int vb, bf16x8 pa0, bf16x8 pa1, bf16x8 pa2, bf16x8 pa3) {
  pv_one<0>(o[0], vb, pa0, pa1, pa2, pa3); pv_one<1>(o[1], vb, pa0, pa1, pa2, pa3); pv_one<2>(o[2], vb, pa0, pa1, pa2, pa3); pv_one<3>(o[3], vb, pa0, pa1, pa2, pa3);
}

__device__ __forceinline__ void attn_unit(int b, int h, int qb, const bf16_t* __restrict__ Qg, const bf16_t* __restrict__ Kg, const bf16_t* __restrict__ Vg, bf16_t* __restrict__ OC,
                                          const float* __restrict__ lamp, const float* __restrict__ dgv, int layer, char* lds) {
  int tid_o = threadIdx.x; asm volatile("" : "+v"(tid_o));
  const int tid = tid_o, wid = __builtin_amdgcn_readfirstlane(tid >> 6), lane = tid & 63, r32 = lane & 31, hi = lane >> 5, mp = wid >> 2, wl = wid & 3, mofs = mp * 64;
  char* V_lds = lds; char* K_lds = lds + 2 * SHM_V;
  float* ws = (float*)(lds + SHM_X) + wid * 64; float* li_l = ws; float* al_l = ws + 32;
  float m_reg = -1e30f, l_reg = 0; f32x16 o[4] = {}; bf16x8 qr[4];
  const int q0 = qb * 128 + wl * QBLK;
  const bf16_t* Qw = Qg + (size_t)(b * cfg::S + q0 + r32) * LD + h * 128 + mofs + hi * 8;
#pragma unroll
  for (int d0 = 0; d0 < 4; ++d0) qr[d0] = *reinterpret_cast<const bf16x8*>(Qw + d0 * 16);
  const bf16_t* Kh = Kg + (size_t)b * cfg::S * LD + h * 128; const bf16_t* Vh = Vg + (size_t)b * cfg::S * LD + h * 128;
  const int sr = tid >> 4, sc = (tid & 15) * 8, vst0 = v_st(sr, sc), vst1 = v_st(32 + sr, sc);
  const int vb0 = (int)(uintptr_t)V_lds + v_rd_base(lane);
  struct { bf16x8 vs0, vs1, ks0, ks1; } sr_[2];
#define ATT_SLOAD(i, k0) do { sr_[i].vs0 = *reinterpret_cast<const bf16x8*>(&Vh[(size_t)((k0) + sr) * LD + sc]); sr_[i].vs1 = *reinterpret_cast<const bf16x8*>(&Vh[(size_t)((k0) + 32 + sr) * LD + sc]); \
    sr_[i].ks0 = *reinterpret_cast<const bf16x8*>(&Kh[(size_t)((k0) + sr) * LD + sc]); sr_[i].ks1 = *reinterpret_cast<const bf16x8*>(&Kh[(size_t)((k0) + 32 + sr) * LD + sc]); } while (0)
#define ATT_SWRITE(bf, i) do { *(bf16x8*)(V_lds + (bf) * SHM_V + vst0) = sr_[i].vs0; *(bf16x8*)(V_lds + (bf) * SHM_V + vst1) = sr_[i].vs1; const int kc = sc * 2; \
    *(bf16x8*)(K_lds + (bf) * SHM_K + ATT_KSWZ(sr, kc)) = sr_[i].ks0; *(bf16x8*)(K_lds + (bf) * SHM_K + ATT_KSWZ(32 + sr, kc)) = sr_[i].ks1; } while (0)
#define ATT_SWAIT() asm volatile("s_waitcnt vmcnt(4)" ::: "memory")
#define ATT_RESC(a) do { if (__any((a) < 1.f)) { if (hi == 0) al_l[r32] = (a); asm volatile("s_waitcnt lgkmcnt(0)" ::: "memory"); \
    _Pragma("unroll") for (int d = 0; d < 4; ++d) _Pragma("unroll") for (int r = 0; r < 16; ++r) o[d][r] *= al_l[crow(r, hi)]; } } while (0)
  f32x16 pA0, pA1, pB0, pB1; float alA, alB; bf16x8 pa0, pa1, pa2, pa3;
  ATT_SLOAD(0, 0); asm volatile("s_waitcnt vmcnt(0)" ::: "memory"); ATT_SWRITE(0, 0); __syncthreads();
  qkt(pA0, pA1, K_lds, qr, r32, hi, mofs); partialSM(pA0, pA1, m_reg, alA);
  ATT_SLOAD(1, KVBLK); ATT_SLOAD(0, 2 * KVBLK);
  ATT_SWAIT(); ATT_SWRITE(1, 1); __syncthreads();
  for (int j = 1; j + 1 < NT; j += 2) {
    ATT_SBAR(); qkt(pB0, pB1, K_lds + SHM_K, qr, r32, hi, mofs);
    finishSM(pA0, pA1, alA, l_reg, pa0, pa1, pa2, pa3); ATT_SBAR();
    ATT_SLOAD(1, (j + 2) * KVBLK); ATT_SBAR();
    pv_d0(o, vb0, pa0, pa1, pa2, pa3); partialSM(pB0, pB1, m_reg, alB);
    __syncthreads(); ATT_SWAIT(); ATT_SWRITE(0, 0);
    ATT_RESC(alB); __syncthreads();
    ATT_SBAR(); qkt(pA0, pA1, K_lds, qr, r32, hi, mofs);
    finishSM(pB0, pB1, alB, l_reg, pa0, pa1, pa2, pa3); ATT_SBAR();
    if (j + 3 < NT) ATT_SLOAD(0, (j + 3) * KVBLK); ATT_SBAR();
    pv_d0(o, vb0 + SHM_V, pa0, pa1, pa2, pa3); partialSM(pA0, pA1, m_reg, alA);
    __syncthreads(); ATT_SWAIT(); ATT_SWRITE(1, 1);
    ATT_RESC(alA); __syncthreads();
  }
  ATT_SBAR(); qkt(pB0, pB1, K_lds + SHM_K, qr, r32, hi, mofs);
  finishSM(pA0, pA1, alA, l_reg, pa0, pa1, pa2, pa3); ATT_SBAR();
  pv_d0(o, vb0, pa0, pa1, pa2, pa3); partialSM(pB0, pB1, m_reg, alB);
  __syncthreads(); ATT_RESC(alB);
  finishSM(pB0, pB1, alB, l_reg, pa0, pa1, pa2, pa3); ATT_SBAR();
  pv_d0(o, vb0 + SHM_V, pa0, pa1, pa2, pa3);
  if (hi == 0) li_l[r32] = l_reg; asm volatile("s_waitcnt lgkmcnt(0)" ::: "memory");
  float rli[16];
#pragma unroll
  for (int r = 0; r < 16; ++r) rli[r] = __builtin_amdgcn_rcpf(li_l[crow(r, hi)]);
#pragma unroll
  for (int d0 = 0; d0 < 4; ++d0)
#pragma unroll
    for (int r = 0; r < 16; ++r) o[d0][r] *= rli[r];
  __syncthreads();
  float* X = (float*)lds;
  if (mp == 1) {
#pragma unroll
    for (int r = 0; r < 16; ++r)
#pragma unroll
      for (int d0 = 0; d0 < 4; ++d0) X[(wl * 32 + crow(r, hi)) * 128 + d0 * 32 + r32] = o[d0][r];
  }
  __syncthreads();
  if (mp == 0) {
    int layer_o = __builtin_amdgcn_readfirstlane(layer); asm volatile("" : "+s"(layer_o)); const float lam_init = layer_o == 0 ? 0.2f : 0.35550906759f;
    float lam; { float s1 = lamp[lane] * lamp[64 + lane], s2 = lamp[128 + lane] * lamp[192 + lane];
      s1 = xadd<1>(s1); s2 = xadd<1>(s2); s1 = xadd<2>(s1); s2 = xadd<2>(s2); s1 = xadd<4>(s1); s2 = xadd<4>(s2); s1 = xadd<8>(s1); s2 = xadd<8>(s2); s1 = xadd<16>(s1); s2 = xadd<16>(s2); s1 = xadd<32>(s1); s2 = xadd<32>(s2);
      lam = __expf(s1) - __expf(s2) + lam_init; }
    float gq[4];
#pragma unroll
    for (int d0 = 0; d0 < 4; ++d0) gq[d0] = dgv[d0 * 32 + r32] * (1.f - lam_init);
#pragma unroll
    for (int r = 0; r < 16; ++r) {
      float ssq = 0.f;
#pragma unroll
      for (int d0 = 0; d0 < 4; ++d0) { const float df = o[d0][r] - lam * X[(wl * 32 + crow(r, hi)) * 128 + d0 * 32 + r32]; o[d0][r] = df; ssq += df * df; }
      ssq = xadd<1>(ssq); ssq = xadd<2>(ssq); ssq = xadd<4>(ssq); ssq = xadd<8>(ssq); ssq = xadd<16>(ssq);
      const float rn = rsqrtf(ssq * (1.f / 128.f) + cfg::EPS);
      bf16_t* dst = OC + (size_t)(b * cfg::S + q0 + crow(r, hi)) * 1024 + h * 128 + r32;
#pragma unroll
      for (int d0 = 0; d0 < 4; ++d0) dst[d0 * 32] = (bf16_t)(cvtpk(o[d0][r] * rn * gq[d0], 0.f) & 0xffffu);
    }
  }
  __syncthreads();
#undef ATT_SLOAD
#undef ATT_SWRITE
#undef ATT_SWAIT
#undef ATT_RESC
}
#undef ATT_KSWZ
#undef ATT_SBAR
}
namespace gla {
using att::bf16x8; using att::s16x4; using att::f32x16; using att::u32x4; using att::crow; using att::cvtpk; using att::tr_read;
typedef float f32x4 __attribute__((ext_vector_type(4)));
typedef unsigned u32x2 __attribute__((ext_vector_type(2)));
#define GLAS __attribute__((address_space(3)))
constexpr int KT_STRIDE = 144;
constexpr int A_KT = 0, A_V = 36864, A_BEND = A_V + 32768;
constexpr int B_QT = 0, B_KT = 32768, B_V = 65536, B_SC = 98304;
__device__ __forceinline__ int v_st64(int k, int c) { const int kk = (k & ~0xC) | ((k & 4) << 1) | ((k & 8) >> 1); return ((kk >> 3) * 2 + (c >> 5)) * 512 + ((kk & 7) * 32 + (c & 31)) * 2; }
constexpr int v_off64(int d0, int ks, int half) { return d0 * 512 + ks * 2048 + half * 1024; }
__device__ __forceinline__ float bf2f_(unsigned short v) { return __uint_as_float((unsigned)v << 16); }
__device__ __forceinline__ void load_v_tile(const bf16_t* __restrict__ src, GLAS unsigned char* dst, int lane) {
    u32x4 tv[8];
#pragma unroll
    for (int i = 0; i < 8; ++i) { const int row = (lane >> 3) + 8 * i, ch = lane & 7; tv[i] = *(const u32x4*)(src + (size_t)row * 256 + ch * 8); }
#pragma unroll
    for (int i = 0; i < 8; ++i) { const int row = (lane >> 3) + 8 * i, ch = lane & 7; *(GLAS u32x4*)(dst + v_st64(row, ch * 8)) = tv[i]; }
}
#define GLA_PK(L, H) (bf16x8){L[0], L[1], L[2], L[3], H[0], H[1], H[2], H[3]}
#define GLA_MM4(o0, o1, vb, AF) do { \
    const s16x4 l00 = tr_read<v_off64(0, 0, 0)>(vb), h00 = tr_read<v_off64(0, 0, 1)>(vb), l01 = tr_read<v_off64(0, 1, 0)>(vb), h01 = tr_read<v_off64(0, 1, 1)>(vb); \
    const s16x4 l02 = tr_read<v_off64(0, 2, 0)>(vb), h02 = tr_read<v_off64(0, 2, 1)>(vb), l03 = tr_read<v_off64(0, 3, 0)>(vb), h03 = tr_read<v_off64(0, 3, 1)>(vb); \
    const s16x4 l10 = tr_read<v_off64(1, 0, 0)>(vb), h10 = tr_read<v_off64(1, 0, 1)>(vb), l11 = tr_read<v_off64(1, 1, 0)>(vb), h11 = tr_read<v_off64(1, 1, 1)>(vb); \
    const s16x4 l12 = tr_read<v_off64(1, 2, 0)>(vb), h12 = tr_read<v_off64(1, 2, 1)>(vb), l13 = tr_read<v_off64(1, 3, 0)>(vb), h13 = tr_read<v_off64(1, 3, 1)>(vb); \
    asm volatile("s_waitcnt lgkmcnt(0)" ::: "memory"); __builtin_amdgcn_sched_barrier(0); \
    o0 = __builtin_amdgcn_mfma_f32_32x32x16_bf16(AF(0), GLA_PK(l00, h00), o0, 0, 0, 0); o1 = __builtin_amdgcn_mfma_f32_32x32x16_bf16(AF(0), GLA_PK(l10, h10), o1, 0, 0, 0); \
    o0 = __builtin_amdgcn_mfma_f32_32x32x16_bf16(AF(1), GLA_PK(l01, h01), o0, 0, 0, 0); o1 = __builtin_amdgcn_mfma_f32_32x32x16_bf16(AF(1), GLA_PK(l11, h11), o1, 0, 0, 0); \
    o0 = __builtin_amdgcn_mfma_f32_32x32x16_bf16(AF(2), GLA_PK(l02, h02), o0, 0, 0, 0); o1 = __builtin_amdgcn_mfma_f32_32x32x16_bf16(AF(2), GLA_PK(l12, h12), o1, 0, 0, 0); \
    o0 = __builtin_amdgcn_mfma_f32_32x32x16_bf16(AF(3), GLA_PK(l03, h03), o0, 0, 0, 0); o1 = __builtin_amdgcn_mfma_f32_32x32x16_bf16(AF(3), GLA_PK(l13, h13), o1, 0, 0, 0); } while (0)
__device__ __forceinline__ bf16x8 afrag_tr(const GLAS unsigned char* row, int ks, int hi) { return *(const GLAS bf16x8*)(row + (16 * ks + 8 * hi) * 2); }

__device__ __forceinline__ void gla_a_item(int b, int h, int g, unsigned char* ws, GLAS unsigned char* lds) {
    int tid_o = threadIdx.x; asm volatile("" : "+v"(tid_o));
    const int tid = tid_o, wave = __builtin_amdgcn_readfirstlane(tid >> 6), lane = tid & 63, r32 = lane & 31, hi = lane >> 5;
    const float* GL = (const float*)(ws + cfg::WS_GL); const bf16_t* GQK = (const bf16_t*)(ws + cfg::WS_GQK); const bf16_t* GV = (const bf16_t*)(ws + cfg::WS_GV);
    float* KVC = (float*)(ws + cfg::WS_OF); float* DEC = (float*)(ws + cfg::WS_DEC);
    const size_t tok0 = (size_t)b * 2048 + g * 256;
    GLAS float* bend_s = (GLAS float*)(lds + A_BEND);
    if (wave < 4) {
        const int c = wave, dir = lane >> 5, d = lane & 31;
        const float* gl = GL + (tok0 + c * 64) * 256 + dir * 128 + h * 32 + d; const bf16_t* kp = GQK + (tok0 + c * 64) * 256 + 128 + h * 32 + d;
        GLAS unsigned char* row = lds + A_KT + ((c * 2 + dir) * 32 + d) * KT_STRIDE; float bsum = 0.f; float gA[8], gB[8]; unsigned short kA[8], kB[8];
#define GLA_LOAD(G, K, blk) do { const int t0_ = dir ? 56 - 8 * (blk) : 8 * (blk); _Pragma("unroll") for (int i = 0; i < 8; ++i) { G[i] = gl[(size_t)(t0_ + i) * 256]; K[i] = kp[(size_t)(t0_ + i) * 256]; } } while (0)
#define GLA_PROC(G, K, blk) do { const int t0_ = dir ? 56 - 8 * (blk) : 8 * (blk); float kt[8]; \
            if (dir == 0) { _Pragma("unroll") for (int i = 0; i < 8; ++i) { bsum += G[i]; kt[i] = bf2f_(K[i]) * __expf(-bsum); } } \
            else { _Pragma("unroll") for (int i = 7; i >= 0; --i) { bsum += G[i]; kt[i] = bf2f_(K[i]) * __expf(-bsum); } } \
            u32x4 w; w.x = cvtpk(kt[0], kt[1]); w.y = cvtpk(kt[2], kt[3]); w.z = cvtpk(kt[4], kt[5]); w.w = cvtpk(kt[6], kt[7]); *(GLAS u32x4*)(row + t0_ * 2) = w; } while (0)
        GLA_LOAD(gA, kA, 0);
#pragma unroll
        for (int bp = 0; bp < 4; ++bp) { GLA_LOAD(gB, kB, 2 * bp + 1); GLA_PROC(gA, kA, 2 * bp); if (bp < 3) GLA_LOAD(gA, kA, 2 * bp + 2); GLA_PROC(gB, kB, 2 * bp + 1); }
#undef GLA_LOAD
#undef GLA_PROC
        bend_s[(c * 2 + dir) * 32 + d] = bsum;
        DEC[((size_t)((b * 4 + h) * 32 + g * 4 + c) * 2 + dir) * 32 + d] = __expf(bsum);
    } else { const int c = wave - 4; load_v_tile(GV + (tok0 + c * 64) * 256 + h * 64, lds + A_V + c * 8192, lane); }
    __syncthreads();
    {
        const int c = wave >> 1, dir = wave & 1; f32x16 o0 = {}, o1 = {};
        const int vb = (int)(unsigned)(uintptr_t)(lds + A_V + c * 8192) + att::v_rd_base(lane);
        const GLAS unsigned char* arow = lds + A_KT + ((c * 2 + dir) * 32 + r32) * KT_STRIDE;
#define GLA_AF(ks) afrag_tr(arow, ks, hi)
        GLA_MM4(o0, o1, vb, GLA_AF);
#undef GLA_AF
        float* dst = KVC + ((size_t)((b * 4 + h) * 32 + g * 4 + c) * 2 + dir) * 2048 + r32;
#pragma unroll
        for (int r = 0; r < 16; ++r) { const int d = crow(r, hi); const float sc = __expf(bend_s[(c * 2 + dir) * 32 + d]); dst[d * 64] = o0[r] * sc; dst[d * 64 + 32] = o1[r] * sc; }
    }
    __syncthreads();
}

__device__ __forceinline__ void gla_b_item(int b, int h, int g, unsigned char* ws, const float* __restrict__ gng, bf16_t* __restrict__ OC, GLAS unsigned char* lds) {
    int tid_o = threadIdx.x; asm volatile("" : "+v"(tid_o));
    const int tid = tid_o, wave = __builtin_amdgcn_readfirstlane(tid >> 6), lane = tid & 63, r32 = lane & 31, hi = lane >> 5;
    const float* GL = (const float*)(ws + cfg::WS_GL); const bf16_t* GQK = (const bf16_t*)(ws + cfg::WS_GQK); const bf16_t* GV = (const bf16_t*)(ws + cfg::WS_GV); const bf16_t* GR = (const bf16_t*)(ws + cfg::WS_GR);
    const float* KVC = (const float*)(ws + cfg::WS_OF) + (size_t)((b * 4 + h) * 32) * 2 * 2048; const float* DEC = (const float*)(ws + cfg::WS_DEC) + (size_t)((b * 4 + h) * 32) * 2 * 32;
    const size_t tok0 = (size_t)b * 2048 + g * 256;
    if (wave < 4) {
        const int c = wave, dir = lane >> 5, d = lane & 31;
        const float* gl = GL + (tok0 + c * 64) * 256 + dir * 128 + h * 32 + d; const bf16_t* qp = GQK + (tok0 + c * 64) * 256 + h * 32 + d;
        GLAS unsigned short* qt = (GLAS unsigned short*)(lds + B_QT + c * 8192) + dir * 32 + d;
        GLAS unsigned short* kt = (GLAS unsigned short*)(lds + B_KT + c * 8192 + dir * 4096) + d;
        float bsum = 0.f; float gA[8], gB[8]; unsigned short qA[8], kA[8], qB[8], kB[8];
#define GLB_LOAD(G, Q, K, blk) do { const int t0_ = dir ? 56 - 8 * (blk) : 8 * (blk); _Pragma("unroll") for (int i = 0; i < 8; ++i) { G[i] = gl[(size_t)(t0_ + i) * 256]; Q[i] = qp[(size_t)(t0_ + i) * 256]; K[i] = qp[(size_t)(t0_ + i) * 256 + 128]; } } while (0)
#define GLB_PROC(G, Q, K, blk) do { const int t0_ = dir ? 56 - 8 * (blk) : 8 * (blk); _Pragma("unroll") for (int ii = 0; ii < 8; ++ii) { \
            const float gi = dir ? G[7 - ii] : G[ii], qi = bf2f_(dir ? Q[7 - ii] : Q[ii]), ki = bf2f_(dir ? K[7 - ii] : K[ii]); const int tt = t0_ + (dir ? 7 - ii : ii); \
            bsum += gi; const float e = __expf(bsum), ei = __expf(-bsum); \
            qt[tt * 64] = (unsigned short)(cvtpk(qi * e, 0.f) & 0xffffu); kt[tt * 32] = (unsigned short)(cvtpk(ki * ei, 0.f) & 0xffffu); } } while (0)
        GLB_LOAD(gA, qA, kA, 0);
#pragma unroll
        for (int bp = 0; bp < 4; ++bp) { GLB_LOAD(gB, qB, kB, 2 * bp + 1); GLB_PROC(gA, qA, kA, 2 * bp); if (bp < 3) GLB_LOAD(gA, qA, kA, 2 * bp + 2); GLB_PROC(gB, qB, kB, 2 * bp + 1); }
#undef GLB_LOAD
#undef GLB_PROC
    } else {
        const int c = wave - 4; load_v_tile(GV + (tok0 + c * 64) * 256 + h * 64, lds + B_V + c * 8192, lane);
        const int t2 = tid - 256, d = t2 >> 3, v8 = (t2 & 7) * 8;
        const float* kvp = KVC + d * 64 + v8; const float* dcp = DEC + d;
        f32x4 own[4][2][2]; float dow[4][2];
#pragma unroll
        for (int c4 = 0; c4 < 4; ++c4)
#pragma unroll
            for (int dr = 0; dr < 2; ++dr) { const int n = 4 * g + c4; own[c4][dr][0] = *(const f32x4*)(kvp + (size_t)(n * 2 + dr) * 2048); own[c4][dr][1] = *(const f32x4*)(kvp + (size_t)(n * 2 + dr) * 2048 + 4); dow[c4][dr] = dcp[(n * 2 + dr) * 32]; }
        f32x4 Sf0 = {0.f, 0.f, 0.f, 0.f}, Sf1 = Sf0, Sb0 = Sf0, Sb1 = Sf0;
#pragma unroll 8
        for (int n = 0; n < 4 * g; ++n) { const float dc = dcp[(n * 2) * 32]; Sf0 = dc * Sf0 + *(const f32x4*)(kvp + (size_t)(n * 2) * 2048); Sf1 = dc * Sf1 + *(const f32x4*)(kvp + (size_t)(n * 2) * 2048 + 4); }
#pragma unroll 8
        for (int n = 31; n >= 4 * g + 4; --n) { const float dc = dcp[(n * 2 + 1) * 32]; Sb0 = dc * Sb0 + *(const f32x4*)(kvp + (size_t)(n * 2 + 1) * 2048); Sb1 = dc * Sb1 + *(const f32x4*)(kvp + (size_t)(n * 2 + 1) * 2048 + 4); }
#pragma unroll
        for (int c4 = 0; c4 < 4; ++c4) { u32x4 w; w.x = cvtpk(Sf0[0], Sf0[1]); w.y = cvtpk(Sf0[2], Sf0[3]); w.z = cvtpk(Sf1[0], Sf1[1]); w.w = cvtpk(Sf1[2], Sf1[3]);
            *(GLAS u32x4*)(lds + B_SC + c4 * 8192 + v_st64(d, v8)) = w; Sf0 = dow[c4][0] * Sf0 + own[c4][0][0]; Sf1 = dow[c4][0] * Sf1 + own[c4][0][1]; }
#pragma unroll
        for (int c4 = 3; c4 >= 0; --c4) { u32x4 w; w.x = cvtpk(Sb0[0], Sb0[1]); w.y = cvtpk(Sb0[2], Sb0[3]); w.z = cvtpk(Sb1[0], Sb1[1]); w.w = cvtpk(Sb1[2], Sb1[3]);
            *(GLAS u32x4*)(lds + B_SC + c4 * 8192 + v_st64(32 + d, v8)) = w; Sb0 = dow[c4][1] * Sb0 + own[c4][1][0]; Sb1 = dow[c4][1] * Sb1 + own[c4][1][1]; }
    }
    __syncthreads();
    {
        const int c = wave >> 1, th = wave & 1, t = 32 * th + r32;
        const GLAS unsigned char* qrow = lds + B_QT + c * 8192 + t * 128;
        f32x16 pf0 = {}, pf1 = {}, pb0 = {}, pb1 = {};
#pragma unroll
        for (int ks = 0; ks < 2; ++ks) {
            const bf16x8 qf = *(const GLAS bf16x8*)(qrow + (16 * ks + 8 * hi) * 2), qb = *(const GLAS bf16x8*)(qrow + (32 + 16 * ks + 8 * hi) * 2);
            const GLAS unsigned char* kf = lds + B_KT + c * 8192 + r32 * 64 + (16 * ks + 8 * hi) * 2; const GLAS unsigned char* kb = kf + 4096;
            pf0 = __builtin_amdgcn_mfma_f32_32x32x16_bf16(*(const GLAS bf16x8*)kf, qf, pf0, 0, 0, 0); pf1 = __builtin_amdgcn_mfma_f32_32x32x16_bf16(*(const GLAS bf16x8*)(kf + 2048), qf, pf1, 0, 0, 0);
            pb0 = __builtin_amdgcn_mfma_f32_32x32x16_bf16(*(const GLAS bf16x8*)kb, qb, pb0, 0, 0, 0); pb1 = __builtin_amdgcn_mfma_f32_32x32x16_bf16(*(const GLAS bf16x8*)(kb + 2048), qb, pb1, 0, 0, 0);
        }
#pragma unroll
        for (int r = 0; r < 16; ++r) { const int j0 = crow(r, hi), j1 = 32 + j0;
            pf0[r] = (j0 <= t ? pf0[r] : 0.f) + (j0 >= t ? pb0[r] : 0.f); pf1[r] = (j1 <= t ? pf1[r] : 0.f) + (j1 >= t ? pb1[r] : 0.f); }
        bf16x8 pa0, pa1, pa2, pa3;
#define GLA_PK4(P, BASE, OUT) do { unsigned a0 = cvtpk(P[BASE + 0], P[BASE + 1]), a1 = cvtpk(P[BASE + 2], P[BASE + 3]); unsigned b0 = cvtpk(P[BASE + 4], P[BASE + 5]), b1 = cvtpk(P[BASE + 6], P[BASE + 7]); \
    auto r0 = __builtin_amdgcn_permlane32_swap(a0, b0, false, false); auto r1 = __builtin_amdgcn_permlane32_swap(a1, b1, false, false); \
    u32x4 w = {r0[0], r1[0], r0[1], r1[1]}; OUT = *reinterpret_cast<bf16x8*>(&w); } while (0)
        GLA_PK4(pf0, 0, pa0); GLA_PK4(pf0, 8, pa1); GLA_PK4(pf1, 0, pa2); GLA_PK4(pf1, 8, pa3);
#undef GLA_PK4
        f32x16 o0 = {}, o1 = {};
        { const int vb = (int)(unsigned)(uintptr_t)(lds + B_V + c * 8192) + att::v_rd_base(lane);
#define GLA_AF(ks) ((ks) == 0 ? pa0 : (ks) == 1 ? pa1 : (ks) == 2 ? pa2 : pa3)
          GLA_MM4(o0, o1, vb, GLA_AF);
#undef GLA_AF
        }
        { const int vb = (int)(unsigned)(uintptr_t)(lds + B_SC + c * 8192) + att::v_rd_base(lane);
#define GLA_AF(ks) afrag_tr(qrow, ks, hi)
          GLA_MM4(o0, o1, vb, GLA_AF);
#undef GLA_AF
        }
        const float g0 = gng[r32], g1 = gng[32 + r32];
        const bf16_t* grb = GR + (tok0 + c * 64 + 32 * th) * 256 + h * 64 + r32; unsigned short gq0[16], gq1[16];
#pragma unroll
        for (int r = 0; r < 16; ++r) { gq0[r] = grb[(size_t)crow(r, hi) * 256]; gq1[r] = grb[(size_t)crow(r, hi) * 256 + 32]; }
#pragma unroll
        for (int r = 0; r < 16; ++r) {
            float ssq = o0[r] * o0[r] + o1[r] * o1[r];
            ssq = xadd<1>(ssq); ssq = xadd<2>(ssq); ssq = xadd<4>(ssq); ssq = xadd<8>(ssq); ssq = xadd<16>(ssq);
            const float rn = rsqrtf(ssq * (1.f / 64.f) + cfg::EPS);
            const size_t tok = tok0 + c * 64 + 32 * th + crow(r, hi);
            bf16_t* dst = OC + tok * 1024 + 768 + h * 64 + r32;
            dst[0] = (bf16_t)(cvtpk(o0[r] * rn * g0 * bf2f_(gq0[r]), 0.f) & 0xffffu); dst[32] = (bf16_t)(cvtpk(o1[r] * rn * g1 * bf2f_(gq1[r]), 0.f) & 0xffffu);
        }
    }
    __syncthreads();
}
#undef GLA_MM4
#undef GLA_PK
#undef GLAS
}
namespace fft {
using att::bf16x8; using att::s16x4; using att::f32x16; using att::u32x4; using att::crow; using att::cvtpk; using att::tr_read;
#define FLAS __attribute__((address_space(3)))
__device__ __forceinline__ int img_off(int k, int c) { const int kk = (k & ~0xC) | ((k & 4) << 1) | ((k & 8) >> 1); return ((kk >> 3) * 8 + (c >> 5)) * 512 + ((kk & 7) * 32 + (c & 31)) * 2; }
constexpr int rd_off(int ks, int half) { return ks * 8192 + half * 4096; }
#define FFT_PK(L, H) (bf16x8){L[0], L[1], L[2], L[3], H[0], H[1], H[2], H[3]}
typedef float f32x2_t __attribute__((ext_vector_type(2))); typedef __bf16 bf16x2_t __attribute__((ext_vector_type(2)));
__device__ __forceinline__ unsigned pk2f(float a, float b) { f32x2_t v = {a, b}; bf16x2_t r = __builtin_convertvector(v, bf16x2_t); return __builtin_bit_cast(unsigned, r); }

__device__ __forceinline__ void stage1_item(int b, int s2, const bf16_t* __restrict__ FX, bf16_t* __restrict__ I1, FLAS unsigned char* lds) {
    int tid_o = threadIdx.x; asm volatile("" : "+v"(tid_o));
    const int tid = tid_o, wave = __builtin_amdgcn_readfirstlane(tid >> 6), lane = tid & 63, r32 = lane & 31, hi = lane >> 5;
    bf16x8 F1[2][4];
#pragma unroll
    for (int ks = 0; ks < 4; ++ks) { float cr[8], ci[8];
#pragma unroll
        for (int j = 0; j < 8; ++j) { const int k = 16 * ks + 8 * hi + j, s1 = k & 31; const float rev = (float)((r32 * s1) & 31) * (1.f / 32.f); const float c = __builtin_amdgcn_cosf(rev), sn = __builtin_amdgcn_sinf(rev);
            const bool p1 = (k >> 5) != 0; cr[j] = p1 ? -sn : c; ci[j] = p1 ? -c : -sn; }
        u32x4 wr = {pk2f(cr[0], cr[1]), pk2f(cr[2], cr[3]), pk2f(cr[4], cr[5]), pk2f(cr[6], cr[7])}, wi = {pk2f(ci[0], ci[1]), pk2f(ci[2], ci[3]), pk2f(ci[4], ci[5]), pk2f(ci[6], ci[7])};
        F1[0][ks] = *reinterpret_cast<bf16x8*>(&wr); F1[1][ks] = *reinterpret_cast<bf16x8*>(&wi); }
    { u32x4 tv[4];
#pragma unroll
      for (int i = 0; i < 4; ++i) { const int p = tid + 512 * i, k = p >> 5, c8 = (p & 31) * 8; tv[i] = *(const u32x4*)(FX + (size_t)(b * 2048 + 64 * (k & 31) + s2) * 512 + (k >> 5) * 256 + c8); }
#pragma unroll
      for (int i = 0; i < 4; ++i) { const int p = tid + 512 * i, k = p >> 5, c8 = (p & 31) * 8; *(FLAS u32x4*)(lds + img_off(k, c8)) = tv[i]; } }
    __syncthreads();
    f32x16 re = {}, im = {};
    { const int vb = (int)(unsigned)(uintptr_t)lds + att::v_rd_base(lane) + wave * 512;
      const s16x4 l0 = tr_read<rd_off(0, 0)>(vb), h0 = tr_read<rd_off(0, 1)>(vb), l1 = tr_read<rd_off(1, 0)>(vb), h1 = tr_read<rd_off(1, 1)>(vb);
      const s16x4 l2 = tr_read<rd_off(2, 0)>(vb), h2 = tr_read<rd_off(2, 1)>(vb), l3 = tr_read<rd_off(3, 0)>(vb), h3 = tr_read<rd_off(3, 1)>(vb);
      asm volatile("s_waitcnt lgkmcnt(0)" ::: "memory"); __builtin_amdgcn_sched_barrier(0);
      re = __builtin_amdgcn_mfma_f32_32x32x16_bf16(F1[0][0], FFT_PK(l0, h0), re, 0, 0, 0); im = __builtin_amdgcn_mfma_f32_32x32x16_bf16(F1[1][0], FFT_PK(l0, h0), im, 0, 0, 0);
      re = __builtin_amdgcn_mfma_f32_32x32x16_bf16(F1[0][1], FFT_PK(l1, h1), re, 0, 0, 0); im = __builtin_amdgcn_mfma_f32_32x32x16_bf16(F1[1][1], FFT_PK(l1, h1), im, 0, 0, 0);
      re = __builtin_amdgcn_mfma_f32_32x32x16_bf16(F1[0][2], FFT_PK(l2, h2), re, 0, 0, 0); im = __builtin_amdgcn_mfma_f32_32x32x16_bf16(F1[1][2], FFT_PK(l2, h2), im, 0, 0, 0);
      re = __builtin_amdgcn_mfma_f32_32x32x16_bf16(F1[0][3], FFT_PK(l3, h3), re, 0, 0, 0); im = __builtin_amdgcn_mfma_f32_32x32x16_bf16(F1[1][3], FFT_PK(l3, h3), im, 0, 0, 0); }
    bf16_t* dst = I1 + (size_t)(b * 32) * 128 * 256 + (size_t)s2 * 256 + 32 * wave + r32;
#pragma unroll
    for (int r = 0; r < 16; ++r) { const int k1 = crow(r, hi); const float rev = (float)((k1 * s2) & 2047) * (1.f / 2048.f); const float ct = __builtin_amdgcn_cosf(rev), st = __builtin_amdgcn_sinf(rev);
        const float ar = re[r] * ct + im[r] * st, ai = im[r] * ct - re[r] * st; const unsigned w = pk2f(ar, ai);
        dst[(size_t)k1 * 128 * 256] = (bf16_t)(w & 0xffffu); dst[(size_t)k1 * 128 * 256 + 64 * 256] = (bf16_t)(w >> 16); }
    __syncthreads();
}

__device__ __forceinline__ void stage2_item(int b, int k1, const bf16_t* __restrict__ I1, bf16_t* __restrict__ OC, FLAS unsigned char* lds) {
    int tid_o = threadIdx.x; asm volatile("" : "+v"(tid_o));
    const int tid = tid_o, wave = __builtin_amdgcn_readfirstlane(tid >> 6), lane = tid & 63, r32 = lane & 31, hi = lane >> 5;
    const bf16_t* src = I1 + (size_t)(b * 32 + k1) * 128 * 256;
    { u32x4 tv[8];
#pragma unroll
      for (int i = 0; i < 8; ++i) { const int p = tid + 512 * i, k = p >> 5, c8 = (p & 31) * 8; tv[i] = *(const u32x4*)(src + (size_t)k * 256 + c8); }
#pragma unroll
      for (int i = 0; i < 8; ++i) { const int p = tid + 512 * i, k = p >> 5, c8 = (p & 31) * 8; *(FLAS u32x4*)(lds + img_off(k, c8)) = tv[i]; } }
    f32x16 y0 = {}, y1 = {};
    __syncthreads();
    const int vb = (int)(unsigned)(uintptr_t)lds + att::v_rd_base(lane) + wave * 512, vb2 = vb + 32768;
    bf16x8 F2[2][8];
#pragma unroll
    for (int ks = 0; ks < 8; ++ks) { float c0[8], c1[8];
#pragma unroll
        for (int j = 0; j < 8; ++j) { const int k = 16 * ks + 8 * hi + j, s2 = k & 63; const float r0 = (float)((r32 * s2) & 63) * (1.f / 64.f), r1 = (float)(((32 + r32) * s2) & 63) * (1.f / 64.f);
            c0[j] = (k >> 6) ? __builtin_amdgcn_sinf(r0) : __builtin_amdgcn_cosf(r0); c1[j] = (k >> 6) ? __builtin_amdgcn_sinf(r1) : __builtin_amdgcn_cosf(r1); }
        u32x4 w0 = {pk2f(c0[0], c0[1]), pk2f(c0[2], c0[3]), pk2f(c0[4], c0[5]), pk2f(c0[6], c0[7])}, w1 = {pk2f(c1[0], c1[1]), pk2f(c1[2], c1[3]), pk2f(c1[4], c1[5]), pk2f(c1[6], c1[7])};
        F2[0][ks] = *reinterpret_cast<bf16x8*>(&w0); F2[1][ks] = *reinterpret_cast<bf16x8*>(&w1); }
#define FFT_STEP(ks) do { \
      const s16x4 lo_ = tr_read<rd_off((ks) & 3, 0)>((ks) < 4 ? vb : vb2), hi_ = tr_read<rd_off((ks) & 3, 1)>((ks) < 4 ? vb : vb2); asm volatile("s_waitcnt lgkmcnt(0)" ::: "memory"); __builtin_amdgcn_sched_barrier(0); \
      y0 = __builtin_amdgcn_mfma_f32_32x32x16_bf16(F2[0][ks], FFT_PK(lo_, hi_), y0, 0, 0, 0); y1 = __builtin_amdgcn_mfma_f32_32x32x16_bf16(F2[1][ks], FFT_PK(lo_, hi_), y1, 0, 0, 0); } while (0)
    FFT_STEP(0); FFT_STEP(1); FFT_STEP(2); FFT_STEP(3); FFT_STEP(4); FFT_STEP(5); FFT_STEP(6); FFT_STEP(7);
#undef FFT_STEP
    bf16_t* dst = OC + (size_t)(b * 2048 + k1) * 1024 + 512 + 32 * wave + r32;
#pragma unroll
    for (int r = 0; r < 16; ++r) { const int k2 = crow(r, hi); const unsigned w = pk2f(y0[r], y1[r]);
        dst[(size_t)(32 * k2) * 1024] = (bf16_t)(w & 0xffffu); dst[(size_t)(32 * (32 + k2)) * 1024] = (bf16_t)(w >> 16); }
    __syncthreads();
}
#undef FFT_PK
#undef FLAS
}
namespace pro {
#define PLAS __attribute__((address_space(3)))
typedef float f32x4 __attribute__((ext_vector_type(4)));
typedef unsigned u32x4 __attribute__((ext_vector_type(4)));
__device__ __forceinline__ unsigned pk2(float lo, float hi) { unsigned r; asm volatile("v_cvt_pk_bf16_f32 %0, %1, %2" : "=v"(r) : "v"(lo), "v"(hi)); return r; }
__device__ __forceinline__ float lo_f(unsigned w) { return __uint_as_float(w << 16); }
__device__ __forceinline__ float hi_f(unsigned w) { return __uint_as_float(w & 0xffff0000u); }
template <bool SUMS, int STRIDE> __device__ __forceinline__ void tile_emit(int K, bf16_t* WT, const float* gain, const float* lnb, float (&a1)[4], float (&a2)[4], const PLAS float* scr, int lane) {
    const int c = lane & 7; float gk[8], bk[8];
#pragma unroll
    for (int q = 0; q < 8; ++q) { gk[q] = gain ? gain[8 * c + q] : 1.f; bk[q] = lnb ? lnb[8 * c + q] : 0.f; }
#pragma unroll
    for (int j = 0; j < 4; ++j) { const int n = (lane >> 3) + 8 * j; const PLAS float* s = scr + (8 * c) * STRIDE + n; float v[8];
#pragma unroll
        for (int q = 0; q < 8; ++q) v[q] = s[q * STRIDE];
        u32x4 o; o.x = pk2(v[0] * gk[0], v[1] * gk[1]); o.y = pk2(v[2] * gk[2], v[3] * gk[3]); o.z = pk2(v[4] * gk[4], v[5] * gk[5]); o.w = pk2(v[6] * gk[6], v[7] * gk[7]);
        *(u32x4*)(WT + (size_t)n * K + 8 * c) = o;
        if (SUMS) { float p1 = (lo_f(o.x) + hi_f(o.x)) + (lo_f(o.y) + hi_f(o.y)) + (lo_f(o.z) + hi_f(o.z)) + (lo_f(o.w) + hi_f(o.w)); float p2 = 0.f;
#pragma unroll
            for (int q = 0; q < 8; ++q) p2 += bk[q] * v[q];
            p1 = xadd<1>(p1); p2 = xadd<1>(p2); p1 = xadd<2>(p1); p2 = xadd<2>(p2); p1 = xadd<4>(p1); p2 = xadd<4>(p2);
            a1[j] += p1; a2[j] += p2; }
    }
    asm volatile("s_waitcnt lgkmcnt(0)" ::: "memory");
}
__device__ __forceinline__ void tile_dma(const float* W, int N, PLAS float* scr, int lane) {
    const float* src = W + (size_t)(lane >> 3) * N + (lane & 7) * 4;
#pragma unroll
    for (int i = 0; i < 8; ++i) __builtin_amdgcn_global_load_lds((const unsigned*)(src + (size_t)(8 * i) * N), (PLAS unsigned*)(scr + i * 256), 16, 0, 0);
}
template <bool SUMS, class Val> __device__ __forceinline__ void tile_item(const Val& val, int K, bf16_t* WT, const float* gain, const float* lnb, float (&a1)[4], float (&a2)[4], PLAS float* scr, int lane) {
#pragma unroll 2
    for (int i = 0; i < 32; ++i) { const int kk = 2 * i + (lane >> 5); scr[kk * 33 + (lane & 31)] = val(kk, lane & 31); }
    asm volatile("s_waitcnt lgkmcnt(0)" ::: "memory");
    tile_emit<SUMS, 33>(K, WT, gain, lnb, a1, a2, scr, lane);
}
struct ValPlain { static constexpr int BATCH = 32; const float* W; int N; __device__ __forceinline__ float operator()(int kk, int j) const { return W[(size_t)kk * N + j]; } };
struct ValGate { static constexpr int BATCH = 2; const float* W; const float* w2; __device__ __forceinline__ float operator()(int kk, int j) const {
    const float* wr = W + (size_t)kk * cfg::INW; float a = 0.f;
#pragma unroll
    for (int r = 0; r < 16; ++r) a += wr[r] * w2[r * 128 + j]; return a; } };

__device__ __forceinline__ void fold_item(int item, unsigned char* ws, const float* w_in, const float* fw, const float* lng, const float* lnb, PLAS unsigned char* lds, int tid) {
    const int l = item >> 5, g = (item >> 3) & 3, part = (item >> 2) & 1, kq = item & 3;
    PLAS float* M = (PLAS float*)lds;
    { const int c = tid >> 3, e0 = (tid & 7) * 8; float acc[8];
#pragma unroll
      for (int q = 0; q < 8; ++q) acc[q] = 0.f;
      const float* w = fw + (size_t)((l * 4 + g) * 64) * 64 + e0;
      for (int k2 = 0; k2 < 64; ++k2) { float rev = (float)((k2 * c) & 63) * (1.f / 64.f); asm volatile("" : "+v"(rev)); const float tr = part ? __builtin_amdgcn_sinf(rev) : __builtin_amdgcn_cosf(rev);
          const f32x4 w0 = *(const f32x4*)(w + k2 * 64), w1 = *(const f32x4*)(w + k2 * 64 + 4);
#pragma unroll
          for (int q = 0; q < 4; ++q) { acc[q] += tr * w0[q]; acc[4 + q] += tr * w1[q]; } }
      const float sc = 0.00276213586400995f;
#pragma unroll
      for (int q = 0; q < 8; ++q) M[c * 64 + e0 + q] = acc[q] * sc; }
    __syncthreads();
    PLAS float* Wl = (PLAS float*)(lds + 16384);
    { const float* wsrc = w_in + ((size_t)l * 1024 + kq * 256) * cfg::INW + 1536 + 64 * g; f32x4 tv[8];
#pragma unroll
      for (int i = 0; i < 8; ++i) tv[i] = *(const f32x4*)(wsrc + (size_t)((tid >> 4) + 32 * i) * cfg::INW + (tid & 15) * 4);
#pragma unroll
      for (int i = 0; i < 8; ++i) *(PLAS f32x4*)(Wl + ((tid >> 4) + 32 * i) * 64 + (tid & 15) * 4) = tv[i]; }
    __syncthreads();
    { const int e = tid & 63, kg = tid >> 6, k0 = kq * 256 + kg * 32, np = 1536 + part * 256 + g * 64 + e; float mc[64];
#pragma unroll
      for (int c = 0; c < 64; ++c) mc[c] = M[c * 64 + e];
      bf16_t* dst = (bf16_t*)(ws + cfg::WS_WIN + l * cfg::SZ_WIN) + (size_t)np * 1024 + k0; float s1 = 0.f, s2 = 0.f;
      for (int kb = 0; kb < 4; ++kb) { float o[8];
#pragma unroll
          for (int q = 0; q < 8; ++q) { const int k = k0 + kb * 8 + q; const PLAS f32x4* wr = (const PLAS f32x4*)(Wl + (kg * 32 + kb * 8 + q) * 64); float a = 0.f;
#pragma unroll
              for (int c4 = 0; c4 < 16; ++c4) { const f32x4 w4 = wr[c4]; a += w4[0] * mc[4 * c4] + w4[1] * mc[4 * c4 + 1] + w4[2] * mc[4 * c4 + 2] + w4[3] * mc[4 * c4 + 3]; }
              o[q] = a * (lng ? lng[k] : 1.f); s2 += lnb ? lnb[k] * a : 0.f; }
          u32x4 w; w.x = pk2(o[0], o[1]); w.y = pk2(o[2], o[3]); w.z = pk2(o[4], o[5]); w.w = pk2(o[6], o[7]); *(u32x4*)(dst + kb * 8) = w;
          s1 += (lo_f(w.x) + hi_f(w.x)) + (lo_f(w.y) + hi_f(w.y)) + (lo_f(w.z) + hi_f(w.z)) + (lo_f(w.w) + hi_f(w.w)); }
      __syncthreads();
      PLAS float* red = (PLAS float*)lds; red[(kg * 64 + e) * 2] = s1; red[(kg * 64 + e) * 2 + 1] = s2;
      __syncthreads();
      if (kg == 0) { float t1 = 0.f, t2 = 0.f;
#pragma unroll
          for (int w = 0; w < 8; ++w) { t1 += red[(w * 64 + e) * 2]; t2 += red[(w * 64 + e) * 2 + 1]; }
          float* fp = (float*)(ws + cfg::V_MF) + (size_t)((l * 4 + kq) * 2) * 512 + part * 256 + g * 64 + e; fp[0] = t1; fp[512] = t2; } }
    __syncthreads();
}

struct Inputs { const float *x, *w_in, *fw, *gw2, *w_out, *ln1g, *ln1b, *wg, *wu, *wd, *ln2g, *ln2b; };
__device__ __forceinline__ void prologue(unsigned char* ws, const Inputs& in, PLAS unsigned char* lds, int vcu, int G) {
    int tid_o = threadIdx.x; asm volatile("" : "+v"(tid_o));
    const int tid = tid_o, wave = __builtin_amdgcn_readfirstlane(tid >> 6), lane = tid & 63;
    const float* x = in.x; const float* w_in = in.w_in; const float* fw = in.fw; const float* gw2 = in.gw2; const float* w_out = in.w_out; const float* ln1g = in.ln1g; const float* ln1b = in.ln1b;
    const float* wg = in.wg; const float* wu = in.wu; const float* wd = in.wd; const float* ln2g = in.ln2g; const float* ln2b = in.ln2b;
    if (vcu < 64) { const int l = vcu >> 5; fold_item(vcu, ws, w_in, fw, l ? ln2g : (const float*)nullptr, l ? ln2b : (const float*)nullptr, lds, tid); }
    PLAS float* scr = (PLAS float*)(lds + wave * 16384); PLAS float* scr1 = scr + 2048; PLAS float* redw = (PLAS float*)(lds + 131072 + 1024 + wave * 256);
    const int gw = vcu * 8 + wave, NGW = G * 8;
    for (int it = vcu; it < 512; it += G) {
        const int l = it >> 8, r = it & 255; float a1[4] = {0.f, 0.f, 0.f, 0.f}, a2[4] = {0.f, 0.f, 0.f, 0.f}; float* c1o; float* c2o;
        const int k0 = wave * 64, k1 = k0 + 512;
        if (r < 80) { const int nb = r; const float* lngb = l ? ln2g : (const float*)nullptr; const float* lnbb = l ? ln2b : (const float*)nullptr;
            bf16_t* Wt = (bf16_t*)(ws + cfg::WS_WIN + l * cfg::SZ_WIN);
            if (nb < 72) { int np0, src;
                if (nb < 32) { const int pn = nb >> 3, p = (nb & 7) * 32, wc = (p >> 5) & 3, bj = p >> 7; np0 = pn * 256 + p; src = (pn >> 1) * 512 + (pn & 1) * 256 + 64 * wc + 32 * bj; }
                else if (nb < 48) { np0 = 1024 + (nb - 32) * 32; src = np0; }
                else { np0 = 2048 + (nb - 48) * 32; src = 1792 + (nb - 48) * 32; }
                tile_dma(w_in + ((size_t)l * 1024 + k0) * cfg::INW + src, cfg::INW, scr, lane); tile_dma(w_in + ((size_t)l * 1024 + k1) * cfg::INW + src, cfg::INW, scr1, lane);
                asm volatile("s_waitcnt vmcnt(0)" ::: "memory");
                tile_emit<true, 32>(1024, Wt + (size_t)np0 * 1024 + k0, lngb ? lngb + k0 : lngb, lnbb ? lnbb + k0 : lnbb, a1, a2, scr, lane);
                tile_emit<true, 32>(1024, Wt + (size_t)np0 * 1024 + k1, lngb ? lngb + k1 : lngb, lnbb ? lnbb + k1 : lnbb, a1, a2, scr1, lane);
                c1o = (float*)(ws + cfg::V_C1IN) + l * cfg::NIN + np0; c2o = (float*)(ws + cfg::V_C2IN) + l * cfg::NIN + np0;
            } else { const int p0 = (nb - 72) * 32, dir = p0 >> 7, kk0 = p0 & 127, np0 = 2816 + p0;
                for (int kb = wave; kb < 16; kb += 8) { const int kq = kb * 64; ValGate v{w_in + ((size_t)l * 1024 + kq) * cfg::INW + 2560 + 16 * dir, gw2 + (size_t)((l * 2 + dir) * 16) * 128 + kk0};
                    tile_item<true>(v, 1024, Wt + (size_t)np0 * 1024 + kq, lngb ? lngb + kq : lngb, lnbb ? lnbb + kq : lnbb, a1, a2, scr, lane); }
                c1o = (float*)(ws + cfg::V_C1IN) + l * cfg::NIN + np0; c2o = (float*)(ws + cfg::V_C2IN) + l * cfg::NIN + np0; }
        } else { const int nb = r - 80, np0 = nb * 32, pn = np0 >> 8, p = np0 & 255, bj = p >> 7, f0 = 128 * pn + (p & 127);
            const float* W = (bj ? wu : wg) + (size_t)l * 1024 * cfg::FF + f0; bf16_t* Wt = (bf16_t*)(ws + cfg::WS_WGU + l * cfg::SZ_WGU) + (size_t)np0 * 1024;
            tile_dma(W + (size_t)k0 * cfg::FF, cfg::FF, scr, lane); tile_dma(W + (size_t)k1 * cfg::FF, cfg::FF, scr1, lane);
            asm volatile("s_waitcnt vmcnt(0)" ::: "memory");
            tile_emit<true, 32>(1024, Wt + k0, ln1g + l * 1024 + k0, ln1b + l * 1024 + k0, a1, a2, scr, lane);
            tile_emit<true, 32>(1024, Wt + k1, ln1g + l * 1024 + k1, ln1b + l * 1024 + k1, a1, a2, scr1, lane);
            c1o = (float*)(ws + cfg::V_C1GU) + l * cfg::NGU + np0; c2o = (float*)(ws + cfg::V_C2GU) + l * cfg::NGU + np0; }
        if ((lane & 7) == 0) {
#pragma unroll
            for (int j = 0; j < 4; ++j) { const int n = (lane >> 3) + 8 * j; redw[n * 2] = a1[j]; redw[n * 2 + 1] = a2[j]; } }
        __syncthreads();
        if (wave == 0 && lane < 32) { float t1 = 0.f, t2 = 0.f;
#pragma unroll
            for (int w = 0; w < 8; ++w) { const PLAS float* rw = (const PLAS float*)(lds + 131072 + 1024 + w * 256); t1 += rw[lane * 2]; t2 += rw[lane * 2 + 1]; }
            c1o[lane] = t1; c2o[lane] = t2; }
        __syncthreads();
    }
    constexpr int I_OUT = 32 * 16, I_DN = 32 * 44, I_L = I_OUT + I_DN;
    for (int it = gw; it < 2 * I_L; it += 2 * NGW) {
        const float* Ws[2]; int Ns[2], Ks[2]; bf16_t* Wd[2]; float d1[4], d2[4];
#pragma unroll
        for (int q = 0; q < 2; ++q) { const int itq = it + q * NGW; const int ic = itq < 2 * I_L ? itq : it; const int l = ic / I_L; int r = ic - l * I_L;
            if (r < I_OUT) { const int nb = r >> 4, kb = r & 15, k0 = kb * 64, n0 = nb * 32; Ws[q] = w_out + ((size_t)l * 1024 + k0) * 1024 + n0; Ns[q] = 1024; Ks[q] = 1024;
                Wd[q] = (bf16_t*)(ws + cfg::WS_WOUT + l * cfg::SZ_WOUT) + (size_t)n0 * 1024 + k0; }
            else { r -= I_OUT; const int nb = r / 44, kb = r - nb * 44, k0 = kb * 64, n0 = nb * 32; Ws[q] = wd + ((size_t)l * cfg::FF + k0) * 1024 + n0; Ns[q] = 1024; Ks[q] = cfg::FF;
                Wd[q] = (bf16_t*)(ws + cfg::WS_WDN + l * cfg::SZ_WDN) + (size_t)n0 * cfg::FF + k0; } }
        tile_dma(Ws[0], Ns[0], scr, lane); tile_dma(Ws[1], Ns[1], scr1, lane);
        asm volatile("s_waitcnt vmcnt(0)" ::: "memory");
        tile_emit<false, 32>(Ks[0], Wd[0], (const float*)nullptr, (const float*)nullptr, d1, d2, scr, lane);
        if (it + NGW < 2 * I_L) tile_emit<false, 32>(Ks[1], Wd[1], (const float*)nullptr, (const float*)nullptr, d1, d2, scr1, lane);
    }
    const int xw = (vcu - 64) * 8 + wave, NXW = (G - 64) * 8;
    if (vcu >= 64 && G > 64)
    for (int m = xw; m < cfg::T; m += 4 * NXW) {
        f32x4 v[4][4];
#pragma unroll
        for (int q = 0; q < 4; ++q) { const int mr = (m + q * NXW) < cfg::T ? (m + q * NXW) : m; const f32x4* xr = (const f32x4*)(x + (size_t)mr * 1024) + lane;
#pragma unroll
            for (int j = 0; j < 4; ++j) v[q][j] = xr[64 * j]; }
#pragma unroll
        for (int q = 0; q < 4; ++q) { const int mr = (m + q * NXW) < cfg::T ? (m + q * NXW) : m; unsigned long long* o8 = (unsigned long long*)((bf16_t*)(ws + cfg::WS_XB) + (size_t)mr * 1024) + lane;
#pragma unroll
            for (int j = 0; j < 4; ++j) o8[64 * j] = (unsigned long long)pk2(v[q][j][0], v[q][j][1]) | ((unsigned long long)pk2(v[q][j][2], v[q][j][3]) << 32); } }
    for (int i = gw * 64 + lane; i < 2048 * 32; i += NGW * 64) { const int pos = i >> 5, f = i & 31; const float inv = exp2f(-(float)f * (13.287712379549449f / 32.f)); const float ang = (float)pos * inv;
        double rv = (double)ang * 0.15915494309189535; rv -= floor(rv); const float rev = (float)rv;
        ((float*)(ws + cfg::V_ROPEC))[i] = __builtin_amdgcn_cosf(rev); ((float*)(ws + cfg::V_ROPES))[i] = __builtin_amdgcn_sinf(rev); }
}
#undef PLAS
}
constexpr int NWAVES = 8;
constexpr int RING_OFF = 0, RING_BYTES = 131072;
constexpr int LDSCTL_OFF = RING_BYTES, MISC_OFF = LDSCTL_OFF + 320;
constexpr int RSL_OFF = 131072 + 4096;
constexpr int LDS_BYTES = 147456;
constexpr int CW_BAR = 4096;
constexpr size_t CTL_ZERO_BYTES = 64 * 1024;
#define GAS __attribute__((address_space(1)))
#define LAS __attribute__((address_space(3)))
typedef GAS unsigned gu32;
#define RLX_AGENT __ATOMIC_RELAXED, __HIP_MEMORY_SCOPE_AGENT
#define XB_TMO      128
#define XB_XCNT(j)  (256  + 64 * (j))
#define XB_XSUB(j)  (1280 + 64 * (j))
#define XB_XGEN(j)  (2304 + 64 * (j))
#define XB_TOP      3328
#define XB_TOPGEN   3392
#define XCD_BAR_WORDS 3456
#define XB_SPIN_CAP (1u << 18)

__device__ __forceinline__ unsigned xb_ld(unsigned* p)              { return __hip_atomic_load(p, __ATOMIC_RELAXED, __HIP_MEMORY_SCOPE_AGENT); }
__device__ __forceinline__ unsigned xb_add(unsigned* p, unsigned v) { return __hip_atomic_fetch_add(p, v, __ATOMIC_RELAXED, __HIP_MEMORY_SCOPE_AGENT); }
__device__ __forceinline__ unsigned xb_xcc_id() { return (unsigned)__builtin_amdgcn_s_getreg((3 << 11) | 20) & 0xFu; }
#define XB_SPIN(cond, bar) do { unsigned _sp = 0; while (cond) { __builtin_amdgcn_s_sleep(1); \
    if ((++_sp & 255u) == 0u) { if (xb_ld(&(bar)[XB_TMO])) break; if (_sp > XB_SPIN_CAP) { atomicAdd(&(bar)[XB_TMO], 1u); break; } } } } while (0)

struct XcdBarrier {
    unsigned* bar; unsigned x;
    volatile LAS unsigned* st;
};

__device__ __forceinline__ XcdBarrier xcd_barrier_post(unsigned* bar, volatile LAS unsigned* st) {
    XcdBarrier b; b.bar = bar; b.x = xb_xcc_id(); b.st = st;
    if (threadIdx.x == 0) (void)xb_add(&bar[XB_XCNT(b.x)], 1u);
    return b;
}
__device__ __forceinline__ void xcd_barrier_complete(unsigned* bar, unsigned x, unsigned& nloc, unsigned& nx) {
    const unsigned G = gridDim.x * gridDim.y * gridDim.z;
    unsigned sum, cnt, mine, sp = 0u;
    for (;;) {
        sum = 0u; cnt = 0u; mine = 0u;
#pragma unroll
        for (unsigned j = 0; j < 16; ++j) { const unsigned c = xb_ld(&bar[XB_XCNT(j)]); sum += c; cnt += (c > 0u) ? 1u : 0u; mine = (j == x) ? c : mine; }
        if (sum == G) break;
        __builtin_amdgcn_s_sleep(1);
        if ((++sp & 255u) == 0u) { if (xb_ld(&bar[XB_TMO])) break; if (sp > XB_SPIN_CAP) { atomicAdd(&bar[XB_TMO], 1u); break; } }
    }
    nloc = mine > 0u ? mine : 1u; nx = cnt > 0u ? cnt : 1u;
}

__device__ __forceinline__ void xcd_barrier(const XcdBarrier& b) {
    asm volatile("s_waitcnt vmcnt(0)" ::: "memory");
    __syncthreads();
    if (threadIdx.x == 0) {
        unsigned* bar = b.bar;
        __builtin_amdgcn_s_waitcnt(0);
        unsigned nloc = b.st[0], nx = b.st[1];
        if (nloc == 0u) { xcd_barrier_complete(bar, b.x, nloc, nx); b.st[0] = nloc; b.st[1] = nx; }
        const unsigned old = xb_add(&bar[XB_XSUB(b.x)], 1u);
        const unsigned gen = old / nloc;
        if (old + 1u == (gen + 1u) * nloc) {
            __builtin_amdgcn_fence(__ATOMIC_RELEASE, "agent");
            asm volatile("s_waitcnt vmcnt(0)" ::: "memory");
            const unsigned og = xb_add(&bar[XB_TOP], 1u);
            const unsigned tg = og / nx;
            if (og + 1u == (tg + 1u) * nx) xb_add(&bar[XB_TOPGEN], 1u);
            else XB_SPIN(xb_ld(&bar[XB_TOPGEN]) == tg, bar);
            __builtin_amdgcn_fence(__ATOMIC_ACQUIRE, "agent");
            xb_add(&bar[XB_XGEN(b.x)], 1u);
            asm volatile("s_waitcnt vmcnt(0)" ::: "memory");
        } else {
            XB_SPIN(xb_ld(&bar[XB_XGEN(b.x)]) == gen, bar);
            __builtin_amdgcn_fence(__ATOMIC_ACQUIRE, "agent");
            asm volatile("s_waitcnt vmcnt(0)" ::: "memory");
        }
    }
    __syncthreads();
}


#define FILL_RSL(STP) do { pg8::Unit u0_; if (S.next(0, u0_)) { int tq_ = threadIdx.x; asm volatile("" : "+v"(tq_)); const int row_ = u0_.pm * 256 + (tq_ >> 1), hf_ = tq_ & 1; \
    typedef float f32x4_ __attribute__((ext_vector_type(4))); typedef float f32x2_ __attribute__((ext_vector_type(2))); \
    const f32x4_* sp_ = (const f32x4_*)((STP) + (size_t)row_ * 32 + hf_ * 16); const f32x4_ x0 = sp_[0], x1 = sp_[1], x2 = sp_[2], x3 = sp_[3]; \
    float sm_ = ((x0[0] + x0[2]) + (x1[0] + x1[2])) + ((x2[0] + x2[2]) + (x3[0] + x3[2])), sq_ = ((x0[1] + x0[3]) + (x1[1] + x1[3])) + ((x2[1] + x2[3]) + (x3[1] + x3[3])); \
    sm_ = xadd<1>(sm_); sq_ = xadd<1>(sq_); const float mu_ = sm_ * (1.f / 1024.f), rstd_ = rsqrtf(fmaxf(sq_ * (1.f / 1024.f) - mu_ * mu_, 0.f) + EPS); \
    if (hf_ == 0) *(LAS f32x2_*)(ldsl + RSL_OFF + 8 * (tq_ >> 1)) = (f32x2_){rstd_, -rstd_ * mu_}; } \
    __syncthreads(); } while (0)

enum { PH_PRO = 0, PH_IN = 1, PH_ATT = 2, PH_MIXB = 3, PH_OUT = 4, PH_GU = 5, PH_DN = 6, PH_FIN = 13, N_PHASES = 14 };
struct MArgs { const float* in[16]; float* out; unsigned char* ws; int ph_lo, ph_hi, li, pad; };

__global__ void __launch_bounds__(NWAVES * 64, 2) mk_fwd(MArgs a) {
    extern __shared__ __attribute__((aligned(16))) unsigned char lds[];
    LAS unsigned char* ldsl = (LAS unsigned char*)lds;
    volatile LAS unsigned* MISC = (volatile LAS unsigned*)(ldsl + MISC_OFF);
    const int tid = threadIdx.x;
    const int G = gridDim.x, bx = blockIdx.x, vcu = (G % 8 == 0) ? (bx % 8) * (G / 8) + bx / 8 : bx;
    unsigned char* ws = a.ws;
    for (int u = tid; u < (LDS_BYTES - LDSCTL_OFF) / 4; u += NWAVES * 64) ((LAS unsigned*)(ldsl + LDSCTL_OFF))[u] = 0u;
    __syncthreads();
    XcdBarrier bar; bar.bar = (unsigned*)(ws + WS_CTL) + CW_BAR + a.li * XCD_BAR_WORDS; bar.x = 0; bar.st = nullptr;
    if (a.ph_hi - a.ph_lo > 1) bar = xcd_barrier_post((unsigned*)(ws + WS_CTL) + CW_BAR + a.li * XCD_BAR_WORDS, MISC + 8);
    const int G0 = G, bx0 = bx, vcu0 = vcu; unsigned char* const ws0 = ws;
    for (int ph = a.ph_lo; ph < a.ph_hi; ++ph) {
        int G = G0, bx = bx0, vcu = vcu0; unsigned zo = 0u; asm volatile("" : "+s"(G), "+s"(bx), "+s"(vcu), "+s"(zo)); unsigned char* ws = ws0 + zo;
        const int l = (ph >= 1 && ph <= 12) ? (ph - 1) / 6 : 0;
        const int kind = (ph == 0) ? PH_PRO : (ph == PH_FIN ? PH_FIN : 1 + (ph - 1) % 6);
        if (kind == PH_PRO) {
            { pro::Inputs pin{a.in[0], a.in[1], a.in[4], a.in[5], a.in[8], a.in[9], a.in[10], a.in[11], a.in[12], a.in[13], a.in[14], a.in[15]}; pro::prologue(ws, pin, ldsl + RING_OFF, vcu, G); }
        } else if (kind == PH_IN) {
            pg8::Gemm g{(const bf16_t*)(ws + WS_XB), (const bf16_t*)(ws + WS_WIN + l * SZ_WIN), T, NIN, D}; pg8::StaticOrder S; S.init(T, NIN, G, bx);
            if (l) FILL_RSL((const float*)(ws + WS_ST2));
            pg8::FEpiIn E{ws, a.in[6] + l * 256, l, (const LAS float*)(ldsl + RSL_OFF)};
            pg8::gemm_phase<pg8::FEpiIn, pg8::StaticOrder, true, true>(ldsl + RING_OFF, g, S, E);
        } else if (kind == PH_ATT) {
            for (int i = 0; i < 2; ++i) { const int idx = vcu * 2 + i; if (idx >= 512) break; const int bh = idx >> 4, qb = idx & 15;
                att::attn_unit(bh >> 2, bh & 3, qb, (const bf16_t*)(ws + WS_Q), (const bf16_t*)(ws + WS_K), (const bf16_t*)(ws + WS_V), (bf16_t*)(ws + WS_OC), a.in[2] + l * 256, a.in[3] + l * 128, l, (char*)lds + RING_OFF); }
            for (int i = 0; i < 2; ++i) { const int it = vcu * 2 + i; if (it >= 512) break;
                                fft::stage1_item(it >> 6, it & 63, (const bf16_t*)(ws + WS_TAB), (bf16_t*)(ws + WS_XT), ldsl + RING_OFF); }

            if (vcu < 256) gla::gla_a_item(vcu >> 5, (vcu >> 3) & 3, vcu & 7, ws, ldsl + RING_OFF);
        } else if (kind == PH_MIXB) {
            if (vcu < 256) fft::stage2_item(vcu >> 5, vcu & 31, (const bf16_t*)(ws + WS_XT), (bf16_t*)(ws + WS_OC), ldsl + RING_OFF);
            if (vcu < 256) gla::gla_b_item(vcu >> 5, (vcu >> 3) & 3, vcu & 7, ws, a.in[7] + l * 64, (bf16_t*)(ws + WS_OC), ldsl + RING_OFF);
        } else if (kind == PH_OUT) {
            pg8::Gemm g{(const bf16_t*)(ws + WS_OC), (const bf16_t*)(ws + WS_WOUT + l * SZ_WOUT), T, D, D}; pg8::StaticOrder S; S.init(T, D, G, bx);
            if (l) FILL_RSL((const float*)(ws + WS_ST2));
            pg8::FEpiRes E{l ? (const LAS float*)(ldsl + RSL_OFF) : (const LAS float*)nullptr, a.in[14] + (l ? l - 1 : 0) * 1024, a.in[15] + (l ? l - 1 : 0) * 1024, (bf16_t*)(ws + WS_XB), (float*)(ws + WS_ST1)};
            pg8::gemm_phase<pg8::FEpiRes, pg8::StaticOrder, true, true>(ldsl + RING_OFF, g, S, E);
        } else if (kind == PH_GU) {
            pg8::Gemm g{(const bf16_t*)(ws + WS_XB), (const bf16_t*)(ws + WS_WGU + l * SZ_WGU), T, NGU, D}; pg8::StaticOrder S; S.init(T, NGU, G, bx);
            FILL_RSL((const float*)(ws + WS_ST1));
            pg8::FEpiGU E{(const LAS float*)(ldsl + RSL_OFF), (const float*)(ws + V_C1GU) + l * NGU, (const float*)(ws + V_C2GU) + l * NGU, (bf16_t*)(ws + WS_ACT)};
            pg8::gemm_phase<pg8::FEpiGU, pg8::StaticOrder, true, true>(ldsl + RING_OFF, g, S, E);
        } else if (kind == PH_DN) {
            pg8::Gemm g{(const bf16_t*)(ws + WS_ACT), (const bf16_t*)(ws + WS_WDN + l * SZ_WDN), T, D, FF}; pg8::StaticOrder S; S.init(T, D, G, bx);
            FILL_RSL((const float*)(ws + WS_ST1));
            pg8::FEpiRes E{(const LAS float*)(ldsl + RSL_OFF), a.in[9] + l * 1024, a.in[10] + l * 1024, (bf16_t*)(ws + WS_XB), (float*)(ws + WS_ST2)};
            pg8::gemm_phase<pg8::FEpiRes, pg8::StaticOrder, true, true>(ldsl + RING_OFF, g, S, E);
        } else if (kind == PH_FIN) {
            const float* g2 = a.in[14] + 1024; const float* b2v = a.in[15] + 1024; const float* ST2 = (const float*)(ws + WS_ST2); const bf16_t* XB = (const bf16_t*)(ws + WS_XB); float* Y2 = a.out;
            int tid_f = threadIdx.x; asm volatile("" : "+v"(tid_f)); const int lane = tid_f & 63, wave = __builtin_amdgcn_readfirstlane(tid_f >> 6);
            typedef float f32x4 __attribute__((ext_vector_type(4))); typedef unsigned u32x2 __attribute__((ext_vector_type(2)));
            f32x4 gg[4], bq[4];
#pragma unroll
            for (int j = 0; j < 4; ++j) { gg[j] = *((const f32x4*)g2 + lane + 64 * j); bq[j] = *((const f32x4*)b2v + lane + 64 * j); }
            for (int row = vcu * NWAVES + wave; row < T; row += G * NWAVES) { const RowStat rs = row_stat(ST2, row);
                const u32x2* xr = (const u32x2*)(XB + (size_t)row * 1024) + lane; f32x4* yr = (f32x4*)(Y2 + (size_t)row * 1024) + lane;
#pragma unroll
                for (int j = 0; j < 4; ++j) { const u32x2 w = xr[64 * j]; const f32x4 v = {__uint_as_float(w.x << 16), __uint_as_float(w.x & 0xffff0000u), __uint_as_float(w.y << 16), __uint_as_float(w.y & 0xffff0000u)};
                    yr[64 * j] = (v - rs.mu) * rs.rstd * gg[j] + bq[j]; } }
        }
        if (ph + 1 < a.ph_hi) xcd_barrier(bar);
    }
}

static void launch_frame(const MArgs& base, int lo, int hi, int grid, hipStream_t stream, int li = 0) {
    MArgs a = base; a.ph_lo = lo; a.ph_hi = hi; a.li = li;
    hipLaunchKernelGGL(mk_fwd, dim3(grid), dim3(NWAVES * 64), LDS_BYTES, stream, a);
}
extern "C" void kernel_launch(void* const* d_in, const int* in_sizes, int n_in, void* d_out, int out_size, void* d_ws, size_t ws_size, hipStream_t stream) {
    static int grid = 0;
    if (grid == 0) {
        if (n_in != 16 || in_sizes[0] != T * D || out_size != T * D || ws_size < WS_END) { fprintf(stderr, "kernel_launch: unexpected shapes (n_in %d, in0 %d, out %d, ws %zu)\n", n_in, n_in > 0 ? in_sizes[0] : -1, out_size, ws_size); grid = -1; return; }
        int dev = 0, cus = 0, per_cu = 0;
        if (hipGetDevice(&dev) != hipSuccess || hipDeviceGetAttribute(&cus, hipDeviceAttributeMultiprocessorCount, dev) != hipSuccess) { grid = -1; return; }
        if (hipFuncSetAttribute((const void*)mk_fwd, hipFuncAttributeMaxDynamicSharedMemorySize, LDS_BYTES) != hipSuccess) { fprintf(stderr, "kernel_launch: hipFuncSetAttribute failed\n"); grid = -1; return; }
        if (hipOccupancyMaxActiveBlocksPerMultiprocessor(&per_cu, (const void*)mk_fwd, NWAVES * 64, LDS_BYTES) != hipSuccess || per_cu < 1) { fprintf(stderr, "kernel_launch: occupancy query says %d workgroups per CU\n", per_cu); per_cu = 1; }
        (void)hipGetLastError();
        grid = cus;
        if (grid != 256) { fprintf(stderr, "kernel_launch: this kernel's work split is built for the 256 CUs of an MI355X, found %d; nothing launched\n", cus); grid = -1; return; }
    }
    if (grid < 0) return;
    const float* x = (const float*)d_in[0]; const float* w_in = (const float*)d_in[1]; const float* dlam = (const float*)d_in[2]; const float* dng = (const float*)d_in[3];
    const float* fw = (const float*)d_in[4]; const float* gw2 = (const float*)d_in[5]; const float* gb2 = (const float*)d_in[6]; const float* gng = (const float*)d_in[7];
    const float* w_out = (const float*)d_in[8]; const float* ln1g = (const float*)d_in[9]; const float* ln1b = (const float*)d_in[10];
    const float* wg = (const float*)d_in[11]; const float* wu = (const float*)d_in[12]; const float* wd = (const float*)d_in[13]; const float* ln2g = (const float*)d_in[14]; const float* ln2b = (const float*)d_in[15];
    char* ws = (char*)d_ws;
    float* ropec = (float*)(ws + V_ROPEC); float* ropes = (float*)(ws + V_ROPES); float* MF = (float*)(ws + V_MF);
    float* c1in = (float*)(ws + V_C1IN); float* c2in = (float*)(ws + V_C2IN); float* c1gu = (float*)(ws + V_C1GU); float* c2gu = (float*)(ws + V_C2GU);
    bf16_t* TAB = (bf16_t*)(ws + WS_TAB); bf16_t* XB = (bf16_t*)(ws + WS_XB);
    bf16_t* Q = (bf16_t*)(ws + WS_Q); bf16_t* K = (bf16_t*)(ws + WS_K); bf16_t* V = (bf16_t*)(ws + WS_V);
    bf16_t* GQK = (bf16_t*)(ws + WS_GQK); bf16_t* GV = (bf16_t*)(ws + WS_GV); bf16_t* GR = (bf16_t*)(ws + WS_GR); float* GL = (float*)(ws + WS_GL);
    bf16_t* OC = (bf16_t*)(ws + WS_OC); float* OF = (float*)(ws + WS_OF);
    (void)hipMemsetAsync(ws + WS_CTL, 0, CTL_ZERO_BYTES, stream);
    MArgs base{}; for (int i = 0; i < 16; ++i) base.in[i] = (const float*)d_in[i]; base.out = (float*)d_out; base.ws = (unsigned char*)d_ws;
    launch_frame(base, 0, N_PHASES, grid, stream, 0);
}
```

```cpp
#include <hip/hip_runtime.h>
#include <cstdint>
#include <cstdio>
#include <cmath>

typedef unsigned short bf16_t;
namespace cfg {
constexpr int B = 8, S = 2048, D = 1024, T = B * S, L = 2;
constexpr int INW = 2592, NIN = 3072, FF = 2816, NGU = 2 * FF;
constexpr float ALPHA = 1.41421356237309515f;
constexpr float EPS = 1e-5f;
constexpr float QSCALE = 0.125f * 1.4426950408889634f;
constexpr float GQSCALE = 0.17677669529663687f;
constexpr size_t MiB = 1u << 20;
constexpr size_t WS_CTL = 0;
constexpr size_t WS_VEC = 1 * MiB;
constexpr size_t V_ROPEC = WS_VEC, V_ROPES = WS_VEC + 256 * 1024, V_MF = WS_VEC + 512 * 1024;
constexpr size_t V_C1IN = WS_VEC + 768 * 1024, V_C2IN = V_C1IN + 24 * 1024, V_C1GU = V_C2IN + 24 * 1024, V_C2GU = V_C1GU + 44 * 1024;
constexpr size_t WS_WIN = 2 * MiB, WS_WOUT = 14 * MiB, WS_WGU = 18 * MiB, WS_WDN = 40 * MiB, WS_TAB = 51 * MiB;
constexpr size_t SZ_WIN = 6 * MiB, SZ_WOUT = 2 * MiB, SZ_WGU = 11 * MiB, SZ_WDN = 5632 * 1024;
constexpr size_t WS_XB = 67 * MiB;
constexpr size_t WS_Y1 = 99 * MiB, WS_Q = 99 * MiB, WS_K = 115 * MiB, WS_V = 131 * MiB, WS_XT = 147 * MiB;
constexpr size_t WS_ACT = 163 * MiB, WS_GQK = 163 * MiB, WS_GV = 171 * MiB, WS_GR = 179 * MiB, WS_GL = 187 * MiB, WS_OC = 203 * MiB, WS_OF = 235 * MiB;
constexpr size_t WS_ST1 = 251 * MiB, WS_ST2 = 253 * MiB, WS_DEC = 255 * MiB, WS_END = 256 * MiB;
}
using namespace cfg;

__device__ __forceinline__ float bf2f(bf16_t v) { return __uint_as_float((unsigned)v << 16); }
__device__ __forceinline__ bf16_t f2bf(float f) { unsigned u = __float_as_uint(f); return (bf16_t)((u + 0x7fffu + ((u >> 16) & 1u)) >> 16); }


template <int M> __device__ __forceinline__ float xadd(float v) {
    if constexpr (M == 32) { auto r = __builtin_amdgcn_permlane32_swap(__float_as_uint(v), __float_as_uint(v), false, false); return __uint_as_float(r[0]) + __uint_as_float(r[1]); }
    else return v + __int_as_float(__builtin_amdgcn_ds_swizzle(__float_as_int(v), (M << 10) | 0x1f));
}
struct RowStat { float mu, rstd; };
__device__ __forceinline__ RowStat row_stat(const float* ST, int row) {
    float s = 0.f, ss = 0.f;
    for (int i = 0; i < 8; ++i) { const float4 a = *(const float4*)(ST + (size_t)row * 32 + 4 * i); s += a.x + a.z; ss += a.y + a.w; }
    const float mu = s * (1.f / 1024.f); const float var = ss * (1.f / 1024.f) - mu * mu;
    RowStat r; r.mu = mu; r.rstd = rsqrtf(fmaxf(var, 0.f) + EPS); return r;
}
namespace pg8 {
#define PG8_LAS __attribute__((address_space(3)))
typedef unsigned short bf16_t;
typedef short bf16x8 __attribute__((ext_vector_type(8)));
typedef float f32x4 __attribute__((ext_vector_type(4)));
typedef unsigned u32x4 __attribute__((ext_vector_type(4)));
constexpr int BM = 256, BK = 64, HALF = 128, HTB = HALF * BK * 2  , STAGE_BYTES = 8 * HTB, NXCD = 8, WGM = 8;

__host__ __device__ __forceinline__ int lds_byte(int r, int c) { const int st = (r >> 4) * 2 + (c >> 5), rr = r & 15, cc = c & 31, ob = rr * 64 + cc * 2; return st * 1024 + (ob ^ (((ob >> 9) & 1) << 5)); }
__host__ __device__ __forceinline__ void stage_rc(int b, int& R, int& C) { const int st = b / 1024, sb = b % 1024, swz = sb ^ (((sb >> 9) & 1) << 5); R = (st >> 1) * 16 + swz / 64; C = (st & 1) * 32 + (swz % 64) / 2; }
__host__ __device__ __forceinline__ int perm32(int rho) { const int n = rho >> 4, i = rho & 15; return 8 * (i >> 2) + 4 * n + (i & 3); }

struct Unit { int pm, pn; };
struct Gemm { const bf16_t* A; const bf16_t* Bt; int M, N, K; };

struct StaticOrder {
    int nM, nN, nwg, G, c;
    __host__ __device__ void init(int M, int N, int G_, int c_) { nM = M / BM; nN = N / BM; nwg = nM * nN; G = G_; c = c_; }
    __host__ __device__ bool next(int i, Unit& u) const {
        const long L = (long)i * G + c; if (L >= nwg) return false;
        int wgid = (int)L; { const int q = nwg / NXCD, r = nwg % NXCD, xcd = wgid % NXCD, off = wgid / NXCD; wgid = (xcd < r ? xcd * (q + 1) : r * (q + 1) + (xcd - r) * q) + off; }
        const int nig = WGM * nN, gid = wgid / nig, fm = gid * WGM, gsz = (nM - fm) < WGM ? (nM - fm) : WGM;
        u.pm = fm + ((wgid % nig) % gsz); u.pn = (wgid % nig) / gsz; return true;
    }
    __device__ __forceinline__ void a_ready(const Unit&) const {}
    __device__ __forceinline__ void done(const Unit&) const {}
};
template <class Epi, class Sched, bool ALIGN_EPI = false, bool SP2 = false>
__device__ __forceinline__ void gemm_phase(PG8_LAS unsigned char* lds, const Gemm g, const Sched& S, const Epi& E) {
    int tid_o = threadIdx.x; asm volatile("" : "+v"(tid_o));
    const int tid = tid_o, wid = __builtin_amdgcn_readfirstlane(tid >> 6), lane = tid & 63, wr = wid >> 2, wc = wid & 3, fr = lane & 15, fq = lane >> 4;
    const int K = g.K, nt = K / BK;
    unsigned voffA[2], voffB[2];
#pragma unroll
    for (int i = 0; i < 2; ++i) { int R, C; stage_rc(tid * 16 + i * 8192, R, C); const int Rb = Epi::PERM ? ((R & ~31) + perm32(R & 31)) : R;
        voffA[i] = (unsigned)(R * K + C) * 2u; voffB[i] = (unsigned)(Rb * K + C) * 2u; }
    const size_t kstep = (size_t)(BK * 2);
    const size_t hstep = (size_t)HALF * K * 2;
    const size_t tstep = 2 * hstep;
    const unsigned ldsw = (unsigned)wid * 1024u;
    const int aoff = lds_byte(wr * 64 + fr, fq * 8), boff = lds_byte(wc * 32 + fr, fq * 8);
#define PG8_SA(b, h) (((b) * 2 + (h)) * HTB)
#define PG8_SB(b, h) ((4 + (b) * 2 + (h)) * HTB)
#define PG8_STAGE(bufoff, gbase, voff) do { _Pragma("unroll") for (int _i = 0; _i < 2; ++_i) \
        __builtin_amdgcn_global_load_lds((const unsigned*)((const char*)(gbase) + (voff)[_i]), (PG8_LAS unsigned*)(lds + (bufoff) + ldsw + _i * 8192), 16, 0, 0); } while (0)
#define PG8_LDA(dst, b, h) do { _Pragma("unroll") for (int m = 0; m < 4; ++m) _Pragma("unroll") for (int k = 0; k < 2; ++k) dst[m][k] = *(const PG8_LAS bf16x8*)(lds + PG8_SA(b, h) + aoff + m * 2048 + k * 1024); } while (0)
#define PG8_LDB(dst, b, h) do { _Pragma("unroll") for (int n = 0; n < 2; ++n) _Pragma("unroll") for (int k = 0; k < 2; ++k) dst[n][k] = *(const PG8_LAS bf16x8*)(lds + PG8_SB(b, h) + boff + n * 2048 + k * 1024); } while (0)
#define PG8_MMA(ai, bj, At, Bt) do { __builtin_amdgcn_s_setprio(1); _Pragma("unroll") for (int m = 0; m < 4; ++m) _Pragma("unroll") for (int n = 0; n < 2; ++n) _Pragma("unroll") for (int k = 0; k < 2; ++k) \
        acc[ai][bj][m][n] = __builtin_amdgcn_mfma_f32_16x16x32_bf16(Bt[n][k], At[m][k], acc[ai][bj][m][n], 0, 0, 0); __builtin_amdgcn_s_setprio(0); } while (0)
#define PG8_WAIT_V(n) asm volatile("s_waitcnt vmcnt(" #n ")" ::: "memory")
#define PG8_WAIT_L(n) asm volatile("s_waitcnt lgkmcnt(" #n ")" ::: "memory")
#define PG8_BAR __builtin_amdgcn_s_barrier()
#define PG8_SCHED __builtin_amdgcn_sched_barrier(0)
    Unit cur, nxt; int ui = 0;
    if (!S.next(0, cur)) return;
    f32x4 acc[2][2][4][2];
#pragma unroll
    for (int a = 0; a < 2; ++a)
#pragma unroll
        for (int b = 0; b < 2; ++b)
#pragma unroll
            for (int m = 0; m < 4; ++m)
#pragma unroll
                for (int n = 0; n < 2; ++n) acc[a][b][m][n] = (f32x4){0.f, 0.f, 0.f, 0.f};
    bf16x8 At[4][2], B0[2][2], B1[2][2];
    const char* cA = (const char*)g.A + (size_t)cur.pm * tstep; const char* cB = (const char*)g.Bt + (size_t)cur.pn * tstep;
    S.a_ready(cur);
    if constexpr (SP2) {
        PG8_STAGE(PG8_SB(0, 0), cB, voffB); PG8_STAGE(PG8_SB(0, 1), cB + hstep, voffB); PG8_STAGE(PG8_SA(0, 0), cA, voffA); PG8_STAGE(PG8_SA(0, 1), cA + hstep, voffA);
        if (wr == 1) PG8_BAR;
        PG8_WAIT_V(2); PG8_BAR;
        PG8_STAGE(PG8_SB(1, 0), cB + kstep, voffB); PG8_STAGE(PG8_SA(1, 0), cA + kstep, voffA); PG8_STAGE(PG8_SB(1, 1), cB + hstep + kstep, voffB);
        PG8_WAIT_V(6); PG8_BAR;
    } else {
        PG8_STAGE(PG8_SB(0, 0), cB, voffB); PG8_STAGE(PG8_SA(0, 0), cA, voffA); PG8_STAGE(PG8_SB(0, 1), cB + hstep, voffB); PG8_STAGE(PG8_SA(0, 1), cA + hstep, voffA);
        if (wr == 1) PG8_BAR;
        PG8_WAIT_V(4); PG8_BAR;
        PG8_STAGE(PG8_SB(1, 0), cB + kstep, voffB); PG8_STAGE(PG8_SA(1, 0), cA + kstep, voffA); PG8_STAGE(PG8_SB(1, 1), cB + hstep + kstep, voffB);
        PG8_WAIT_V(6); PG8_BAR;
    }
    for (;;) {
        const bool has_next = S.next(ui + 1, nxt);
        const char* nA = has_next ? (const char*)g.A + (size_t)nxt.pm * tstep : cA; const char* nB = has_next ? (const char*)g.Bt + (size_t)nxt.pn * tstep : cB;
        for (int t = 0; t < nt; t += 2) {
            const bool last = (t == nt - 2);
            const char* a1 = cA + (size_t)(t + 1) * kstep;
            const char* a2 = last ? nA : cA + (size_t)(t + 2) * kstep; const char* b2 = last ? nB : cB + (size_t)(t + 2) * kstep;
            const char* a3 = a2 + kstep; const char* b3 = b2 + kstep;
            if (last && has_next) S.a_ready(nxt);
            if constexpr (SP2) {
            PG8_LDB(B0, 0, 0); PG8_LDB(B1, 0, 1); PG8_SCHED; PG8_LDA(At, 0, 0); PG8_STAGE(PG8_SA(1, 1), a1 + hstep, voffA);
            PG8_WAIT_V(8); PG8_WAIT_L(0); PG8_BAR; PG8_MMA(0, 0, At, B0); PG8_MMA(0, 1, At, B1); PG8_BAR; PG8_SCHED;
            PG8_LDA(At, 0, 1); PG8_STAGE(PG8_SB(0, 0), b2, voffB); PG8_STAGE(PG8_SB(0, 1), b2 + hstep, voffB); PG8_STAGE(PG8_SA(0, 0), a2, voffA);
            PG8_WAIT_V(8); PG8_WAIT_L(0); PG8_BAR; PG8_MMA(1, 0, At, B0); PG8_MMA(1, 1, At, B1); PG8_BAR; PG8_SCHED;
            PG8_LDB(B0, 1, 0); PG8_LDB(B1, 1, 1); PG8_SCHED; PG8_LDA(At, 1, 0); PG8_STAGE(PG8_SA(0, 1), a2 + hstep, voffA);
            PG8_WAIT_V(8); PG8_WAIT_L(0); PG8_BAR; PG8_MMA(0, 0, At, B0); PG8_MMA(0, 1, At, B1); PG8_BAR; PG8_SCHED;
            PG8_LDA(At, 1, 1); PG8_STAGE(PG8_SB(1, 0), b3, voffB); PG8_STAGE(PG8_SB(1, 1), b3 + hstep, voffB); PG8_STAGE(PG8_SA(1, 0), a3, voffA);
            PG8_WAIT_V(8); PG8_WAIT_L(0); PG8_BAR; PG8_MMA(1, 0, At, B0); PG8_MMA(1, 1, At, B1); PG8_BAR; PG8_SCHED;
            } else {
            PG8_LDB(B0, 0, 0); PG8_SCHED; PG8_LDA(At, 0, 0); PG8_STAGE(PG8_SA(1, 1), a1 + hstep, voffA);
            PG8_WAIT_L(8); PG8_BAR; PG8_WAIT_L(0); PG8_MMA(0, 0, At, B0); PG8_BAR; PG8_SCHED;
            PG8_LDB(B1, 0, 1); PG8_STAGE(PG8_SB(0, 0), b2, voffB);
            PG8_BAR; PG8_WAIT_L(0); PG8_MMA(0, 1, At, B1); PG8_BAR;
            PG8_LDA(At, 0, 1); PG8_STAGE(PG8_SA(0, 0), a2, voffA);
            PG8_BAR; PG8_WAIT_L(0); PG8_MMA(1, 0, At, B0); PG8_BAR; PG8_SCHED;
            PG8_STAGE(PG8_SB(0, 1), b2 + hstep, voffB);
            PG8_WAIT_V(6); PG8_BAR; PG8_MMA(1, 1, At, B1); PG8_BAR;
            PG8_LDB(B0, 1, 0); PG8_SCHED; PG8_LDA(At, 1, 0); PG8_STAGE(PG8_SA(0, 1), a2 + hstep, voffA);
            PG8_WAIT_L(8); PG8_BAR; PG8_WAIT_L(0); PG8_MMA(0, 0, At, B0); PG8_BAR; PG8_SCHED;
            PG8_LDB(B1, 1, 1); PG8_STAGE(PG8_SB(1, 0), b3, voffB);
            PG8_BAR; PG8_WAIT_L(0); PG8_MMA(0, 1, At, B1); PG8_BAR;
            PG8_LDA(At, 1, 1); PG8_STAGE(PG8_SA(1, 0), a3, voffA);
            PG8_BAR; PG8_WAIT_L(0); PG8_MMA(1, 0, At, B0); PG8_BAR; PG8_SCHED;
            PG8_STAGE(PG8_SB(1, 1), b3 + hstep, voffB);
            PG8_WAIT_V(6); PG8_BAR; PG8_MMA(1, 1, At, B1); PG8_BAR;
            }
        }
        if constexpr (ALIGN_EPI) { if (wr == 0) PG8_BAR; }
        if constexpr (!Epi::AFTER_DRAIN) { E(acc, cur, wr, wc, fr, fq); S.done(cur); }
        if (!has_next) break;
#pragma unroll
        for (int a = 0; a < 2; ++a)
#pragma unroll
            for (int b = 0; b < 2; ++b)
#pragma unroll
                for (int m = 0; m < 4; ++m)
#pragma unroll
                    for (int n = 0; n < 2; ++n) acc[a][b][m][n] = (f32x4){0.f, 0.f, 0.f, 0.f};
        cur = nxt; cA = nA; cB = nB; ++ui;
        if constexpr (ALIGN_EPI) { if (wr == 1) PG8_BAR; }
    }
    PG8_WAIT_V(0);
    if constexpr (!ALIGN_EPI) { if (wr == 0) PG8_BAR; }
    PG8_BAR;
    if constexpr (Epi::AFTER_DRAIN) { E.fused(acc, cur, wr, wc, fr, fq, lds, wid, lane); S.done(cur); }
#undef PG8_SA
#undef PG8_SB
#undef PG8_STAGE
#undef PG8_LDA
#undef PG8_LDB
#undef PG8_MMA
#undef PG8_WAIT_V
#undef PG8_WAIT_L
#undef PG8_BAR
#undef PG8_SCHED
}
}
namespace pg8 {
__device__ __forceinline__ unsigned cvt_pk_bf16(float lo, float hi) { unsigned r; asm volatile("v_cvt_pk_bf16_f32 %0, %1, %2" : "=v"(r) : "v"(lo), "v"(hi)); return r; }
__device__ __forceinline__ void st8(bf16_t* p, const f32x4 a, const f32x4 b) { u32x4 w; w.x = cvt_pk_bf16(a[0], a[1]); w.y = cvt_pk_bf16(a[2], a[3]); w.z = cvt_pk_bf16(b[0], b[1]); w.w = cvt_pk_bf16(b[2], b[3]); *(u32x4*)p = w; }
__device__ __forceinline__ void st8nt(bf16_t* p, const f32x4 a, const f32x4 b) { u32x4 w; w.x = cvt_pk_bf16(a[0], a[1]); w.y = cvt_pk_bf16(a[2], a[3]); w.z = cvt_pk_bf16(b[0], b[1]); w.w = cvt_pk_bf16(b[2], b[3]); __builtin_nontemporal_store(w, (u32x4*)p); }
struct RS { float a, b; };
struct StatLd { f32x4 x, y; };
__device__ __forceinline__ StatLd stat_load(const float* ST, int row, int fq) { const f32x4* p = (const f32x4*)(ST + (size_t)row * 32 + fq * 8); StatLd r; r.x = p[0]; r.y = p[1]; return r; }
__device__ __forceinline__ RS stat_fin(const StatLd& t) {
    float s = (t.x[0] + t.x[2]) + (t.y[0] + t.y[2]), ss = (t.x[1] + t.x[3]) + (t.y[1] + t.y[3]);
    s = xadd<16>(s); ss = xadd<16>(ss); s = xadd<32>(s); ss = xadd<32>(ss);
    const float mu = s * (1.f / 1024.f), var = ss * (1.f / 1024.f) - mu * mu, rstd = rsqrtf(fmaxf(var, 0.f) + cfg::EPS);
    RS r; r.a = rstd; r.b = -rstd * mu; return r;
}
__device__ __forceinline__ RS row_stat16(const float* ST, int row, int fq) { return stat_fin(stat_load(ST, row, fq)); }
__device__ __forceinline__ float fsilu(float x) { return x * __builtin_amdgcn_rcpf(1.f + __expf(-x)); }
__device__ __forceinline__ float flogsig16(float x) { return (fminf(x, 0.f) - __logf(1.f + __expf(-fabsf(x)))) * (1.f / 16.f); }

struct FEpiIn {
    static constexpr bool PERM = true, AFTER_DRAIN = false;
    unsigned char* ws; const float* b2; int l; const PG8_LAS float* rsl;
    struct RowLd { f32x4 rc[2], rsn[2]; };
    template <int KIND> __device__ __forceinline__ RowLd load_row(int row, int fq) const {
        RowLd r;
        if constexpr (KIND == 0) { const int pos = row & 2047; const float* cp = (const float*)(ws + cfg::V_ROPEC) + pos * 32 + 8 * fq; const float* sp = (const float*)(ws + cfg::V_ROPES) + pos * 32 + 8 * fq;
            r.rc[0] = *(const f32x4*)cp; r.rc[1] = *(const f32x4*)(cp + 4); r.rsn[0] = *(const f32x4*)sp; r.rsn[1] = *(const f32x4*)(sp + 4); }
        return r;
    }
    template <int KIND> __device__ __forceinline__ void rows(const f32x4 (&acc)[2][2][4][2], const Unit& u, int wr, int wc, int fr, int fq) const {
        const int pn = u.pn, cw = 32 * wc + 8 * fq, row0 = u.pm * BM + 64 * wr + fr;
        const bool st = l != 0;
        f32x4 k1[2][2], k2[2][2], bias[2][2];
        const float qs = __uint_as_float(__builtin_amdgcn_readfirstlane(__float_as_uint(pn < 2 ? cfg::QSCALE : 1.f)));
        RowLd cur = load_row<KIND>(row0, fq), nxt;
        if (st) {
#pragma unroll
            for (int bj = 0; bj < 2; ++bj)
#pragma unroll
                for (int n = 0; n < 2; ++n) {
                    if constexpr (KIND == 2) {
                        const float* fp = (const float*)(ws + cfg::V_MF) + (size_t)(l * 8) * 512 + (pn - 6) * 256 + cw + 128 * bj + 4 * n;
                        k1[bj][n] = (*(const f32x4*)fp + *(const f32x4*)(fp + 1024)) + (*(const f32x4*)(fp + 2048) + *(const f32x4*)(fp + 3072));
                        k2[bj][n] = (*(const f32x4*)(fp + 512) + *(const f32x4*)(fp + 1536)) + (*(const f32x4*)(fp + 2560) + *(const f32x4*)(fp + 3584));
                    } else { const float* c1 = (const float*)(ws + cfg::V_C1IN) + l * cfg::NIN + pn * 256 + cw; const float* c2 = (const float*)(ws + cfg::V_C2IN) + l * cfg::NIN + pn * 256 + cw;
                        k1[bj][n] = *(const f32x4*)(c1 + 128 * bj + 4 * n); k2[bj][n] = *(const f32x4*)(c2 + 128 * bj + 4 * n); } } }
        if constexpr (KIND == 6) {
#pragma unroll
            for (int bj = 0; bj < 2; ++bj)
#pragma unroll
                for (int n = 0; n < 2; ++n) bias[bj][n] = *(const f32x4*)(b2 + 128 * bj + cw + 4 * n); }
#pragma unroll
        for (int i = 0; i < 8; ++i) {
            const int ai = i >> 2, m = i & 3, row = row0 + 128 * ai + 16 * m, pos = row & 2047;
            if (i < 7) nxt = load_row<KIND>(row0 + 128 * ((i + 1) >> 2) + 16 * ((i + 1) & 3), fq);
            f32x4 v[2][2];
            if (st) { typedef float f32x2 __attribute__((ext_vector_type(2))); const f32x2 t2 = *(const PG8_LAS f32x2*)(rsl + 2 * (128 * ai + 64 * wr + 16 * m + fr)); RS rs; rs.a = t2[0]; rs.b = t2[1];
#pragma unroll
                for (int bj = 0; bj < 2; ++bj)
#pragma unroll
                    for (int n = 0; n < 2; ++n) v[bj][n] = rs.a * acc[ai][bj][m][n] + (rs.b * k1[bj][n] + k2[bj][n]);
            } else {
#pragma unroll
                for (int bj = 0; bj < 2; ++bj)
#pragma unroll
                    for (int n = 0; n < 2; ++n) v[bj][n] = acc[ai][bj][m][n]; }
            if constexpr (KIND == 0) {
                f32x4 a0 = v[0][0] * cur.rc[0] - v[1][0] * cur.rsn[0], a1 = v[0][1] * cur.rc[1] - v[1][1] * cur.rsn[1];
                f32x4 b0 = v[1][0] * cur.rc[0] + v[0][0] * cur.rsn[0], b1 = v[1][1] * cur.rc[1] + v[0][1] * cur.rsn[1];
                a0 = a0 * qs; a1 = a1 * qs; b0 = b0 * qs; b1 = b1 * qs;
                bf16_t* dst = (bf16_t*)(ws + (pn < 2 ? cfg::WS_Q : cfg::WS_K)) + (size_t)row * 512 + (4 * (pn & 1) + wc) * 64 + 8 * fq;
                st8(dst, a0, a1); st8(dst + 32, b0, b1);
            } else if constexpr (KIND == 1) {
                bf16_t* dst = (bf16_t*)(ws + cfg::WS_V) + (size_t)row * 512 + (pn - 4) * 256 + cw; st8(dst, v[0][0], v[0][1]); st8(dst + 128, v[1][0], v[1][1]);
            } else if constexpr (KIND == 2) {
                bf16_t* dst = (bf16_t*)(ws + cfg::WS_TAB) + (size_t)row * 512 + (pn - 6) * 256 + cw; st8(dst, v[0][0], v[0][1]); st8(dst + 128, v[1][0], v[1][1]);
            } else if constexpr (KIND == 3) {
                bf16_t* dst = (bf16_t*)(ws + cfg::WS_GQK) + (size_t)row * 256 + cw; st8(dst, v[0][0] * cfg::GQSCALE, v[0][1] * cfg::GQSCALE); st8(dst + 128, v[1][0], v[1][1]);
            } else if constexpr (KIND == 4) {
                bf16_t* dst = (bf16_t*)(ws + cfg::WS_GV) + (size_t)row * 256 + cw; st8(dst, v[0][0], v[0][1]); st8(dst + 128, v[1][0], v[1][1]);
            } else if constexpr (KIND == 5) {
                bf16_t* dst = (bf16_t*)(ws + cfg::WS_GR) + (size_t)row * 256 + cw;
#pragma unroll
                for (int bj = 0; bj < 2; ++bj) { f32x4 x0 = v[bj][0], x1 = v[bj][1];
#pragma unroll
                    for (int e = 0; e < 4; ++e) { x0[e] = fsilu(x0[e]); x1[e] = fsilu(x1[e]); } st8(dst + 128 * bj, x0, x1); }
            } else {
                float* dst = (float*)(ws + cfg::WS_GL) + (size_t)row * 256 + cw;
#pragma unroll
                for (int bj = 0; bj < 2; ++bj)
#pragma unroll
                    for (int n = 0; n < 2; ++n) { f32x4 x = v[bj][n] + bias[bj][n];
#pragma unroll
                        for (int e = 0; e < 4; ++e) x[e] = flogsig16(x[e]); *(f32x4*)(dst + 128 * bj + 4 * n) = x; }
            }
            if (i < 7) cur = nxt;
        }
    }
    __device__ __forceinline__ void operator()(const f32x4 (&acc)[2][2][4][2], const Unit& u, int wr, int wc, int fr, int fq) const {
        asm volatile("" : "+v"(fr), "+v"(fq));
        unsigned zo = 0u; asm volatile("" : "+s"(zo)); FEpiIn me = *this; me.ws = ws + zo;
        const int pn = u.pn;
        if (pn < 4) me.rows<0>(acc, u, wr, wc, fr, fq); else if (pn < 6) me.rows<1>(acc, u, wr, wc, fr, fq); else if (pn < 8) me.rows<2>(acc, u, wr, wc, fr, fq);
        else if (pn == 8) me.rows<3>(acc, u, wr, wc, fr, fq); else if (pn == 9) me.rows<4>(acc, u, wr, wc, fr, fq); else if (pn == 10) me.rows<5>(acc, u, wr, wc, fr, fq); else me.rows<6>(acc, u, wr, wc, fr, fq);
    }
};
struct FEpiRes {
    static constexpr bool PERM = true, AFTER_DRAIN = false;
    const PG8_LAS float* stprev;
    const float* g; const float* bb; bf16_t* XB; float* ST;
    struct RowLd { u32x4 xb[2]; };
    __device__ __forceinline__ RowLd load_row(int row, int col0, int fq) const {
        RowLd r; const size_t off = (size_t)row * 1024 + col0;
        r.xb[0] = *(const u32x4*)(XB + off); r.xb[1] = *(const u32x4*)(XB + off + 128);
        return r;
    }
    __device__ __forceinline__ void operator()(const f32x4 (&acc)[2][2][4][2], const Unit& u, int wr, int wc, int fr, int fq) const {
        asm volatile("" : "+v"(fr), "+v"(fq));
        const int col0 = u.pn * BM + 32 * wc + 8 * fq, row0 = u.pm * BM + 64 * wr + fr;
        f32x4 gv[2][2], bv[2][2];
        RowLd cur = load_row(row0, col0, fq), nxt;
        if (stprev) {
#pragma unroll
            for (int bj = 0; bj < 2; ++bj)
#pragma unroll
                for (int n = 0; n < 2; ++n) { gv[bj][n] = *(const f32x4*)(g + col0 + 128 * bj + 4 * n); bv[bj][n] = *(const f32x4*)(bb + col0 + 128 * bj + 4 * n); } }
#pragma unroll
        for (int i = 0; i < 8; ++i) { const int ai = i >> 2, m = i & 3, row = row0 + 128 * ai + 16 * m; const size_t off = (size_t)row * 1024 + col0;
            if (i < 7) nxt = load_row(row0 + 128 * ((i + 1) >> 2) + 16 * ((i + 1) & 3), col0, fq);
            RS rs; rs.a = 1.f; rs.b = 0.f; if (stprev) { typedef float f32x2 __attribute__((ext_vector_type(2))); const f32x2 t2 = *(const PG8_LAS f32x2*)(stprev + 2 * (128 * ai + 64 * wr + 16 * m + fr)); rs.a = t2[0]; rs.b = t2[1]; }
            float s = 0.f, ss = 0.f;
#pragma unroll
            for (int bj = 0; bj < 2; ++bj) { f32x4 y[2];
#pragma unroll
                for (int n = 0; n < 2; ++n) { const unsigned w0 = cur.xb[bj][2 * n], w1 = cur.xb[bj][2 * n + 1];
                    f32x4 x = (f32x4){__uint_as_float(w0 << 16), __uint_as_float(w0 & 0xffff0000u), __uint_as_float(w1 << 16), __uint_as_float(w1 & 0xffff0000u)};
                    if (stprev) x = (rs.a * x + rs.b) * gv[bj][n] + bv[bj][n];
                    y[n] = cfg::ALPHA * x + acc[ai][bj][m][n];
                    s += (y[n][0] + y[n][1]) + (y[n][2] + y[n][3]); ss += (y[n][0] * y[n][0] + y[n][1] * y[n][1]) + (y[n][2] * y[n][2] + y[n][3] * y[n][3]); }
                st8nt(XB + off + 128 * bj, y[0], y[1]); }
            s = xadd<16>(s); ss = xadd<16>(ss); s = xadd<32>(s); ss = xadd<32>(ss);
            if (fq == 0) { typedef float f32x2 __attribute__((ext_vector_type(2))); *(f32x2*)(ST + (size_t)row * 32 + (u.pn * 4 + wc) * 2) = (f32x2){s, ss}; }
            if (i < 7) cur = nxt; }
    }
};
struct FEpiGU {
    static constexpr bool PERM = true, AFTER_DRAIN = false;
    const PG8_LAS float* rsl;
    const float* c1; const float* c2; bf16_t* ACT;
    __device__ __forceinline__ void operator()(const f32x4 (&acc)[2][2][4][2], const Unit& u, int wr, int wc, int fr, int fq) const {
        asm volatile("" : "+v"(fr), "+v"(fq));
        const int cw = 32 * wc + 8 * fq, row0 = u.pm * BM + 64 * wr + fr; const float* c1p = c1 + u.pn * 256 + cw; const float* c2p = c2 + u.pn * 256 + cw;
        typedef float f32x2 __attribute__((ext_vector_type(2)));
        f32x4 k1[2][2], k2[2][2];
#pragma unroll
        for (int bj = 0; bj < 2; ++bj)
#pragma unroll
            for (int n = 0; n < 2; ++n) { k1[bj][n] = *(const f32x4*)(c1p + 128 * bj + 4 * n); k2[bj][n] = *(const f32x4*)(c2p + 128 * bj + 4 * n); }
#pragma unroll
        for (int i = 0; i < 8; ++i) { const int ai = i >> 2, m = i & 3; const f32x2 rs = *(const PG8_LAS f32x2*)(rsl + 2 * (128 * ai + 64 * wr + 16 * m + fr)); f32x4 a[2];
#pragma unroll
            for (int n = 0; n < 2; ++n) { const f32x4 hg = rs[0] * acc[ai][0][m][n] + (rs[1] * k1[0][n] + k2[0][n]), hu = rs[0] * acc[ai][1][m][n] + (rs[1] * k1[1][n] + k2[1][n]);
#pragma unroll
                for (int e = 0; e < 4; ++e) a[n][e] = fsilu(hg[e]) * hu[e]; }
            st8nt(ACT + (size_t)(row0 + 128 * ai + 16 * m) * cfg::FF + 128 * u.pn + cw, a[0], a[1]); }
    }
};
struct FEpiFour {
    static constexpr bool PERM = true, AFTER_DRAIN = false;
    bf16_t* OC;
    __device__ __forceinline__ void operator()(const f32x4 (&acc)[2][2][4][2], const Unit& u, int wr, int wc, int fr, int fq) const {
        asm volatile("" : "+v"(fr), "+v"(fq));
        const int cw = 32 * wc + 8 * fq;
#pragma unroll
        for (int ai = 0; ai < 2; ++ai)
#pragma unroll
            for (int m = 0; m < 4; ++m) { const int row = u.pm * BM + 128 * ai + 64 * wr + 16 * m + fr; bf16_t* dst = OC + (size_t)(u.pn * 2048 + row) * 1024 + 512 + cw;
                st8(dst, acc[ai][0][m][0], acc[ai][0][m][1]); st8(dst + 128, acc[ai][1][m][0], acc[ai][1][m][1]); }
    }
};
}
namespace att {
using bf16x8 = __attribute__((ext_vector_type(8))) short;
using s16x4  = __attribute__((ext_vector_type(4))) short;
using f32x16 = __attribute__((ext_vector_type(16))) float;
using u32x4  = __attribute__((ext_vector_type(4))) unsigned;
constexpr int NW = 8, QBLK = 32, KVBLK = 64, LD = 512, NT = cfg::S / KVBLK;
constexpr int SHM_V = KVBLK * 128 * 2, SHM_K = KVBLK * 128 * 2, SHM_X = 2 * SHM_V + 2 * SHM_K, SHM_ATTN = SHM_X + NW * 64 * 4;
constexpr float THRL = 6.0f;
#define ATT_KSWZ(row, colB) ((row) * 256 + ((colB) ^ (((row) & 7) << 4)))
#define ATT_SBAR() __builtin_amdgcn_sched_barrier(0)
__device__ __forceinline__ int crow(int r, int hi) { return (r & 3) + 8 * (r >> 2) + 4 * hi; }
__device__ __forceinline__ unsigned cvtpk(float lo, float hi) { unsigned r; asm volatile("v_cvt_pk_bf16_f32 %0, %1, %2" : "=v"(r) : "v"(lo), "v"(hi)); return r; }
__device__ __forceinline__ void softmaxP(f32x16& p0, f32x16& p1, float& m_reg, f32x16& negm, float& alpha, bool first, bf16x8& pa0, bf16x8& pa1, bf16x8& pa2, bf16x8& pa3) {
#define ATT_M3(a, b, c) fmaxf(fmaxf(a, b), c)
  const float t0 = ATT_M3(p0[0], p0[1], p0[2]), t1 = ATT_M3(p0[3], p0[4], p0[5]), t2 = ATT_M3(p0[6], p0[7], p0[8]), t3 = ATT_M3(p0[9], p0[10], p0[11]), t4 = ATT_M3(p0[12], p0[13], p0[14]);
  const float t5 = ATT_M3(p0[15], p1[0], p1[1]), t6 = ATT_M3(p1[2], p1[3], p1[4]), t7 = ATT_M3(p1[5], p1[6], p1[7]), t8 = ATT_M3(p1[8], p1[9], p1[10]), t9 = ATT_M3(p1[11], p1[12], p1[13]);
  const float u0 = ATT_M3(t0, t1, t2), u1 = ATT_M3(t3, t4, t5), u2 = ATT_M3(t6, t7, t8), u3 = ATT_M3(t9, p1[14], p1[15]);
  float pmax = fmaxf(fmaxf(u0, u1), fmaxf(u2, u3));
#undef ATT_M3
  { auto rr = __builtin_amdgcn_permlane32_swap(__float_as_uint(pmax), __float_as_uint(pmax), false, false); pmax = fmaxf(__uint_as_float(rr[0]), __uint_as_float(rr[1])); }
  const float thr = first ? -3.0e38f : THRL;
  if (__builtin_expect(__all(pmax <= thr), 1)) { alpha = 1.f; }
  else { const float dl = first ? pmax : fmaxf(pmax, 0.f); alpha = first ? 0.f : __builtin_amdgcn_exp2f(-dl); m_reg += dl;
#pragma unroll
    for (int r = 0; r < 16; ++r) { p0[r] -= dl; p1[r] -= dl; negm[r] = -m_reg; } }
#pragma unroll
  for (int r = 0; r < 16; ++r) p0[r] = __builtin_amdgcn_exp2f(p0[r]);
#pragma unroll
  for (int r = 0; r < 16; ++r) p1[r] = __builtin_amdgcn_exp2f(p1[r]);
#define ATT_PK4(P, BASE, OUT) do { unsigned a0 = cvtpk(P[BASE + 0], P[BASE + 1]), a1 = cvtpk(P[BASE + 2], P[BASE + 3]);   \
    unsigned b0 = cvtpk(P[BASE + 4], P[BASE + 5]), b1 = cvtpk(P[BASE + 6], P[BASE + 7]);                              \
    auto r0 = __builtin_amdgcn_permlane32_swap(a0, b0, false, false); auto r1 = __builtin_amdgcn_permlane32_swap(a1, b1, false, false); \
    u32x4 w = {r0[0], r1[0], r0[1], r1[1]}; OUT = *reinterpret_cast<bf16x8*>(&w); } while (0)
  ATT_PK4(p0, 0, pa0); ATT_PK4(p0, 8, pa1); ATT_PK4(p1, 0, pa2); ATT_PK4(p1, 8, pa3);
#undef ATT_PK4
}
template <int OFF> __device__ __forceinline__ bf16x8 k_read(int ka) { bf16x8 r; asm volatile("ds_read_b128 %0, %1 offset:%2" : "=&v"(r) : "v"(ka), "i"(OFF) : "memory"); return r; }
template <int KB> __device__ __forceinline__ void k_load2(bf16x8* kf, int ka0, int ka1) {
  kf[0] = k_read<KB * SHM_K>(ka0); kf[1] = k_read<KB * SHM_K + 8192>(ka0); kf[2] = k_read<KB * SHM_K>(ka1); kf[3] = k_read<KB * SHM_K + 8192>(ka1);
}
__device__ __forceinline__ void qk_mma2(f32x16& p0, f32x16& p1, const bf16x8* kf, bf16x8 q0, bf16x8 q1) {
  p0 = __builtin_amdgcn_mfma_f32_32x32x16_bf16(kf[0], q0, p0, 0, 0, 0); p1 = __builtin_amdgcn_mfma_f32_32x32x16_bf16(kf[1], q0, p1, 0, 0, 0);
  p0 = __builtin_amdgcn_mfma_f32_32x32x16_bf16(kf[2], q1, p0, 0, 0, 0); p1 = __builtin_amdgcn_mfma_f32_32x32x16_bf16(kf[3], q1, p1, 0, 0, 0);
}
__device__ __forceinline__ int v_st(int k, int c) { const int kk = (k & ~0xC) | ((k & 4) << 1) | ((k & 8) >> 1); return ((kk >> 3) * 4 + (c >> 5)) * 512 + ((kk & 7) * 32 + (c & 31)) * 2; }
__device__ __forceinline__ int v_rd_base(int lane) { return ((lane & 3) << 3) | (((lane >> 2) & 3) << 6) | (((lane >> 4) & 1) << 5) | (((lane >> 5) & 1) << 8); }
constexpr int v_rd_off(int d0, int ks, int half) { return d0 * 512 + ks * 4096 + half * 2048; }
template <int OFF> __device__ __forceinline__ s16x4 tr_read(int vb) { s16x4 r; asm volatile("ds_read_b64_tr_b16 %0, %1 offset:%2" : "=&v"(r) : "v"(vb), "i"(OFF) : "memory"); return r; }
struct VF { s16x4 l[4], h[4]; };
template <int KS> __device__ __forceinline__ void vf_load(VF& f, int vb) {
  f.l[0] = tr_read<v_rd_off(0, KS, 0)>(vb); f.h[0] = tr_read<v_rd_off(0, KS, 1)>(vb); f.l[1] = tr_read<v_rd_off(1, KS, 0)>(vb); f.h[1] = tr_read<v_rd_off(1, KS, 1)>(vb);
  f.l[2] = tr_read<v_rd_off(2, KS, 0)>(vb); f.h[2] = tr_read<v_rd_off(2, KS, 1)>(vb); f.l[3] = tr_read<v_rd_off(3, KS, 0)>(vb); f.h[3] = tr_read<v_rd_off(3, KS, 1)>(vb);
}
__device__ __forceinline__ void pv_step(f32x16* o, bf16x8 pa, const VF& f) {
#define ATT_PK(L, H) (bf16x8){L[0], L[1], L[2], L[3], H[0], H[1], H[2], H[3]}
  o[0] = __builtin_amdgcn_mfma_f32_32x32x16_bf16(pa, ATT_PK(f.l[0], f.h[0]), o[0], 0, 0, 0);
  o[1] = __builtin_amdgcn_mfma_f32_32x32x16_bf16(pa, ATT_PK(f.l[1], f.h[1]), o[1], 0, 0, 0);
  o[2] = __builtin_amdgcn_mfma_f32_32x32x16_bf16(pa, ATT_PK(f.l[2], f.h[2]), o[2], 0, 0, 0);
  o[3] = __builtin_amdgcn_mfma_f32_32x32x16_bf16(pa, ATT_PK(f.l[3], f.h[3]), o[3], 0, 0, 0);
#undef ATT_PK
}
#define ATT_LWAIT(n) do { asm volatile("s_waitcnt lgkmcnt(" #n ")" ::: "memory"); ATT_SBAR(); } while (0)
template <int MP> __device__ __forceinline__ void att_give(const f32x16* o, float* Xw, int r32, int hi) {
  constexpr int RG = MP ? 0 : 8;
#pragma unroll
  for (int rr = 0; rr < 8; ++rr)
#pragma unroll
    for (int d0 = 0; d0 < 4; ++d0) Xw[(crow(RG + rr, hi) & 15) * 128 + d0 * 32 + r32] = o[d0][RG + rr];
}
template <int MP> __device__ __forceinline__ void att_fin(const f32x16* o, const float* Xr, float lam, const float (&gq)[4], bf16_t* OCw, int r32, int hi, int lane) {
  constexpr int RK = MP ? 8 : 0;
  unsigned pk[8][4];
#pragma unroll
  for (int rr = 0; rr < 8; ++rr) { const int lr = crow(RK + rr, hi) & 15;
    float df[4], ssq = 0.f;
#pragma unroll
    for (int d0 = 0; d0 < 4; ++d0) { const float x = Xr[lr * 128 + d0 * 32 + r32]; df[d0] = MP ? x - lam * o[d0][RK + rr] : o[d0][RK + rr] - lam * x; ssq += df[d0] * df[d0]; }
    ssq = xadd<1>(ssq); ssq = xadd<2>(ssq); ssq = xadd<4>(ssq); ssq = xadd<8>(ssq); ssq = xadd<16>(ssq);
    const float rn = rsqrtf(ssq * (1.f / 128.f) + cfg::EPS);
#pragma unroll
    for (int d0 = 0; d0 < 4; ++d0) pk[rr][d0] = cvtpk(df[d0] * rn * gq[d0], 0.f); }
  char* stg = (char*)Xr;
#pragma unroll
  for (int rr = 0; rr < 8; ++rr) { const int lr = crow(RK + rr, hi) & 15;
#pragma unroll
    for (int d0 = 0; d0 < 4; ++d0) *(unsigned short*)(stg + lr * 272 + (d0 * 32 + r32) * 2) = (unsigned short)pk[rr][d0]; }
#pragma unroll
  for (int i = 0; i < 4; ++i) { const int c = lane + 64 * i, row = c >> 4, cc = c & 15;
    const u32x4 v = *(const u32x4*)(stg + row * 272 + cc * 16); *(u32x4*)(OCw + (size_t)row * 1024 + cc * 8) = v; }
}
__device__ __forceinline__ void attn_unit(int b, int h, int qb, const bf16_t* __restrict__ Qg, const bf16_t* __restrict__ Kg, const bf16_t* __restrict__ Vg, bf16_t* __restrict__ OC,
                                          const float* __restrict__ lamp, const float* __restrict__ dgv, int layer, char* lds) {
  int tid_o = threadIdx.x; asm volatile("" : "+v"(tid_o));
  const int tid = tid_o, wid = __builtin_amdgcn_readfirstlane(tid >> 6), lane = tid & 63, r32 = lane & 31, hi = lane >> 5, mp = wid >> 2, wl = wid & 3, mofs = mp * 64;
  char* V_lds = lds; char* K_lds = lds + 2 * SHM_V;
  float* ws = (float*)(lds + SHM_X) + wid * 64; float* al_l = ws + 32;
  float m_reg = 0.f; f32x16 o[4] = {}, ol = {}, negm = {}; bf16x8 qr[4];
  const int q0 = qb * 128 + wl * QBLK;
  const bf16_t* Qw = Qg + (size_t)(b * cfg::S + q0 + r32) * LD + h * 128 + mofs + hi * 8;
#pragma unroll
  for (int d0 = 0; d0 < 4; ++d0) qr[d0] = *reinterpret_cast<const bf16x8*>(Qw + d0 * 16);
  const bf16_t* Kh = Kg + (size_t)b * cfg::S * LD + h * 128; const bf16_t* Vh = Vg + (size_t)b * cfg::S * LD + h * 128;
  const int vb0 = (int)(uintptr_t)V_lds + v_rd_base(lane);
  const int ka0 = (int)(uintptr_t)K_lds + ATT_KSWZ(r32, (mofs + hi * 8) * 2);
  const bf16x8 ones = {0x3F80, 0x3F80, 0x3F80, 0x3F80, 0x3F80, 0x3F80, 0x3F80, 0x3F80};
  const int gt = tid & 255, gr = gt >> 4, gc = (gt & 15) * 8;
  const bf16_t* gsrc = (mp ? Kh : Vh) + (size_t)gr * LD + gc;
  char* gdst = mp ? K_lds + ATT_KSWZ(gr, gc * 2) : V_lds + v_st(gr, gc);
  const int tofs = mp ? 2 : 0;
  bf16x8 st_[2][4];
#define ATT_GLOAD(i, t) do { const int t_ = (t) < NT ? (t) : NT - 1;     \
    _Pragma("unroll") for (int q_ = 0; q_ < 4; ++q_) st_[i][q_] = *reinterpret_cast<const bf16x8*>(gsrc + (size_t)(t_ * 64 + 16 * q_) * LD); } while (0)
#define ATT_GWRITE(i, t) do { asm volatile("s_waitcnt vmcnt(4)" ::: "memory"); if ((t) < NT) { \
    _Pragma("unroll") for (int q_ = 0; q_ < 4; ++q_) *(bf16x8*)(gdst + (i) * 16384 + q_ * 4096) = st_[i][q_]; } } while (0)
#define ATT_RESC(a) do { if (__any((a) < 1.f)) { if (hi == 0) al_l[r32] = (a); asm volatile("s_waitcnt lgkmcnt(0)" ::: "memory"); \
    _Pragma("unroll") for (int r = 0; r < 16; ++r) { const float a_ = al_l[crow(r, hi)]; ol[r] *= a_; _Pragma("unroll") for (int d = 0; d < 4; ++d) o[d][r] *= a_; } } } while (0)
  f32x16 s0, s1; float al; bf16x8 pa0, pa1, pa2, pa3, kf[8]; VF f0, f1;
#define ATT_VSEG(I, p) do { ATT_GWRITE(I, (p) + tofs); ATT_GLOAD(I, (p) + tofs + 2); ATT_SBAR(); \
    softmaxP(s0, s1, m_reg, negm, al, (p) == 0, pa0, pa1, pa2, pa3); ATT_RESC(al); } while (0)
#define ATT_OL(pa) ol = __builtin_amdgcn_mfma_f32_32x32x16_bf16(pa, ones, ol, 0, 0, 0)
#define ATT_QK(KB) do { k_load2<KB>(kf, ka0, ka0 ^ 32); k_load2<KB>(kf + 4, ka0 ^ 64, ka0 ^ 96); ATT_LWAIT(4); s0 = negm; s1 = negm; qk_mma2(s0, s1, kf, qr[0], qr[1]); ATT_LWAIT(0); qk_mma2(s0, s1, kf + 4, qr[2], qr[3]); ATT_SBAR(); } while (0)
#define ATT_MSEG(VB, KB, QK) do { vf_load<0>(f0, vb0 + (VB) * SHM_V); vf_load<1>(f1, vb0 + (VB) * SHM_V); ATT_SBAR(); \
    ATT_LWAIT(8); pv_step(o, pa0, f0); ATT_OL(pa0); vf_load<2>(f0, vb0 + (VB) * SHM_V); \
    ATT_LWAIT(8); pv_step(o, pa1, f1); ATT_OL(pa1); vf_load<3>(f1, vb0 + (VB) * SHM_V); \
    if constexpr (QK) { k_load2<KB>(kf, ka0, ka0 ^ 32); ATT_LWAIT(12); } else ATT_LWAIT(8); \
    pv_step(o, pa2, f0); ATT_OL(pa2); \
    if constexpr (QK) ATT_LWAIT(4); else ATT_LWAIT(0); \
    pv_step(o, pa3, f1); ATT_OL(pa3); \
    if constexpr (QK) { k_load2<KB>(kf + 4, ka0 ^ 64, ka0 ^ 96); ATT_LWAIT(4); s0 = negm; s1 = negm; qk_mma2(s0, s1, kf, qr[0], qr[1]); ATT_LWAIT(0); qk_mma2(s0, s1, kf + 4, qr[2], qr[3]); } ATT_SBAR(); } while (0)
  { const int kr = tid >> 4, kc = (tid & 15) * 8;
    const bf16x8 k0 = *reinterpret_cast<const bf16x8*>(&Kh[(size_t)kr * LD + kc]), k1 = *reinterpret_cast<const bf16x8*>(&Kh[(size_t)(32 + kr) * LD + kc]);
    const bf16x8 k2 = *reinterpret_cast<const bf16x8*>(&Kh[(size_t)(64 + kr) * LD + kc]), k3 = *reinterpret_cast<const bf16x8*>(&Kh[(size_t)(96 + kr) * LD + kc]);
    ATT_GLOAD(0, tofs); ATT_GLOAD(1, tofs + 1);
    asm volatile("s_waitcnt vmcnt(8)" ::: "memory");
    *(bf16x8*)(K_lds + ATT_KSWZ(kr, kc * 2)) = k0; *(bf16x8*)(K_lds + ATT_KSWZ(32 + kr, kc * 2)) = k1;
    *(bf16x8*)(K_lds + SHM_K + ATT_KSWZ(kr, kc * 2)) = k2; *(bf16x8*)(K_lds + SHM_K + ATT_KSWZ(32 + kr, kc * 2)) = k3; }
  __syncthreads();
  if (mp) __syncthreads();
  ATT_QK(0); __syncthreads();
  for (int p = 0; p + 2 < NT; p += 2) {
    ATT_VSEG(0, p);           __syncthreads();
    ATT_MSEG(0, 1, true);     __syncthreads();
    ATT_VSEG(1, p + 1);       __syncthreads();
    ATT_MSEG(1, 0, true);     __syncthreads();
  }
  ATT_VSEG(0, NT - 2);   __syncthreads();
  ATT_MSEG(0, 1, true);   __syncthreads();
  ATT_VSEG(1, NT - 1);   __syncthreads();
  ATT_MSEG(1, 0, false);  __syncthreads();
  if (!mp) __syncthreads();
#pragma unroll
  for (int r = 0; r < 16; ++r) { const float rl = __builtin_amdgcn_rcpf(ol[r]);
#pragma unroll
    for (int d0 = 0; d0 < 4; ++d0) o[d0][r] *= rl; }
  __syncthreads();
  float* X = (float*)lds;
  const float* Xr = X + wid * 2048; float* Xw = X + (wid ^ 4) * 2048;
  int layer_o = __builtin_amdgcn_readfirstlane(layer); asm volatile("" : "+s"(layer_o)); const float lam_init = layer_o == 0 ? 0.2f : 0.35550906759f;
  if (mp == 0) att_give<0>(o, Xw, r32, hi); else att_give<1>(o, Xw, r32, hi);
  float lam; { float s1 = lamp[lane] * lamp[64 + lane], s2 = lamp[128 + lane] * lamp[192 + lane];
    s1 = xadd<1>(s1); s2 = xadd<1>(s2); s1 = xadd<2>(s1); s2 = xadd<2>(s2); s1 = xadd<4>(s1); s2 = xadd<4>(s2); s1 = xadd<8>(s1); s2 = xadd<8>(s2); s1 = xadd<16>(s1); s2 = xadd<16>(s2); s1 = xadd<32>(s1); s2 = xadd<32>(s2);
    lam = __expf(s1) - __expf(s2) + lam_init; }
  float gq[4];
#pragma unroll
  for (int d0 = 0; d0 < 4; ++d0) gq[d0] = dgv[d0 * 32 + r32] * (1.f - lam_init);
  __syncthreads();
  bf16_t* OCw = OC + (size_t)(b * cfg::S + q0 + 16 * mp) * 1024 + h * 128;
  if (mp == 0) att_fin<0>(o, Xr, lam, gq, OCw, r32, hi, lane); else att_fin<1>(o, Xr, lam, gq, OCw, r32, hi, lane);
  __syncthreads();
#undef ATT_GLOAD
#undef ATT_GWRITE
#undef ATT_VSEG
#undef ATT_MSEG
#undef ATT_RESC
#undef ATT_OL
#undef ATT_QK
}
#undef ATT_KSWZ
#undef ATT_SBAR
}
namespace gla {
using att::bf16x8; using att::s16x4; using att::f32x16; using att::u32x4; using att::crow; using att::cvtpk; using att::tr_read;
typedef float f32x4 __attribute__((ext_vector_type(4)));
typedef unsigned u32x2 __attribute__((ext_vector_type(2)));
#define GLAS __attribute__((address_space(3)))
constexpr int KT_STRIDE = 144;
constexpr int A_KT = 0, A_V = 36864, A_BEND = A_V + 32768;
constexpr int B_QT = 0, B_KT = 32768, B_V = 65536, B_SC = 98304;
__device__ __forceinline__ int v_st64(int k, int c) { const int kk = (k & ~0xC) | ((k & 4) << 1) | ((k & 8) >> 1); return ((kk >> 3) * 2 + (c >> 5)) * 512 + ((kk & 7) * 32 + (c & 31)) * 2; }
constexpr int v_off64(int d0, int ks, int half) { return d0 * 512 + ks * 2048 + half * 1024; }
__device__ __forceinline__ float bf2f_(unsigned short v) { return __uint_as_float((unsigned)v << 16); }
__device__ __forceinline__ void load_v_tile(const bf16_t* __restrict__ src, GLAS unsigned char* dst, int lane) {
    u32x4 tv[8];
#pragma unroll
    for (int i = 0; i < 8; ++i) { const int row = (lane >> 3) + 8 * i, ch = lane & 7; tv[i] = *(const u32x4*)(src + (size_t)row * 256 + ch * 8); }
#pragma unroll
    for (int i = 0; i < 8; ++i) { const int row = (lane >> 3) + 8 * i, ch = lane & 7; *(GLAS u32x4*)(dst + v_st64(row, ch * 8)) = tv[i]; }
}
#define GLA_PK(L, H) (bf16x8){L[0], L[1], L[2], L[3], H[0], H[1], H[2], H[3]}
#define GLA_MM4(o0, o1, vb, AF) do { \
    const s16x4 l00 = tr_read<v_off64(0, 0, 0)>(vb), h00 = tr_read<v_off64(0, 0, 1)>(vb), l01 = tr_read<v_off64(0, 1, 0)>(vb), h01 = tr_read<v_off64(0, 1, 1)>(vb); \
    const s16x4 l02 = tr_read<v_off64(0, 2, 0)>(vb), h02 = tr_read<v_off64(0, 2, 1)>(vb), l03 = tr_read<v_off64(0, 3, 0)>(vb), h03 = tr_read<v_off64(0, 3, 1)>(vb); \
    const s16x4 l10 = tr_read<v_off64(1, 0, 0)>(vb), h10 = tr_read<v_off64(1, 0, 1)>(vb), l11 = tr_read<v_off64(1, 1, 0)>(vb), h11 = tr_read<v_off64(1, 1, 1)>(vb); \
    const s16x4 l12 = tr_read<v_off64(1, 2, 0)>(vb), h12 = tr_read<v_off64(1, 2, 1)>(vb), l13 = tr_read<v_off64(1, 3, 0)>(vb), h13 = tr_read<v_off64(1, 3, 1)>(vb); \
    asm volatile("s_waitcnt lgkmcnt(0)" ::: "memory"); __builtin_amdgcn_sched_barrier(0); \
    o0 = __builtin_amdgcn_mfma_f32_32x32x16_bf16(AF(0), GLA_PK(l00, h00), o0, 0, 0, 0); o1 = __builtin_amdgcn_mfma_f32_32x32x16_bf16(AF(0), GLA_PK(l10, h10), o1, 0, 0, 0); \
    o0 = __builtin_amdgcn_mfma_f32_32x32x16_bf16(AF(1), GLA_PK(l01, h01), o0, 0, 0, 0); o1 = __builtin_amdgcn_mfma_f32_32x32x16_bf16(AF(1), GLA_PK(l11, h11), o1, 0, 0, 0); \
    o0 = __builtin_amdgcn_mfma_f32_32x32x16_bf16(AF(2), GLA_PK(l02, h02), o0, 0, 0, 0); o1 = __builtin_amdgcn_mfma_f32_32x32x16_bf16(AF(2), GLA_PK(l12, h12), o1, 0, 0, 0); \
    o0 = __builtin_amdgcn_mfma_f32_32x32x16_bf16(AF(3), GLA_PK(l03, h03), o0, 0, 0, 0); o1 = __builtin_amdgcn_mfma_f32_32x32x16_bf16(AF(3), GLA_PK(l13, h13), o1, 0, 0, 0); } while (0)
__device__ __forceinline__ bf16x8 afrag_tr(const GLAS unsigned char* row, int ks, int hi) { return *(const GLAS bf16x8*)(row + (16 * ks + 8 * hi) * 2); }

__device__ __forceinline__ void gla_a_item(int b, int h, int g, unsigned char* ws, GLAS unsigned char* lds) {
    int tid_o = threadIdx.x; asm volatile("" : "+v"(tid_o));
    const int tid = tid_o, wave = __builtin_amdgcn_readfirstlane(tid >> 6), lane = tid & 63, r32 = lane & 31, hi = lane >> 5;
    const float* GL = (const float*)(ws + cfg::WS_GL); const bf16_t* GQK = (const bf16_t*)(ws + cfg::WS_GQK); const bf16_t* GV = (const bf16_t*)(ws + cfg::WS_GV);
    float* KVC = (float*)(ws + cfg::WS_OF); float* DEC = (float*)(ws + cfg::WS_DEC);
    const size_t tok0 = (size_t)b * 2048 + g * 256;
    GLAS float* bend_s = (GLAS float*)(lds + A_BEND);
    if (wave < 4) {
        const int c = wave, dir = lane >> 5, d = lane & 31;
        const float* gl = GL + (tok0 + c * 64) * 256 + dir * 128 + h * 32 + d; const bf16_t* kp = GQK + (tok0 + c * 64) * 256 + 128 + h * 32 + d;
        GLAS unsigned char* row = lds + A_KT + ((c * 2 + dir) * 32 + d) * KT_STRIDE; float bsum = 0.f; float gA[8], gB[8]; unsigned short kA[8], kB[8];
#define GLA_LOAD(G, K, blk) do { const int t0_ = dir ? 56 - 8 * (blk) : 8 * (blk); _Pragma("unroll") for (int i = 0; i < 8; ++i) { G[i] = gl[(size_t)(t0_ + i) * 256]; K[i] = kp[(size_t)(t0_ + i) * 256]; } } while (0)
#define GLA_PROC(G, K, blk) do { const int t0_ = dir ? 56 - 8 * (blk) : 8 * (blk); float kt[8]; \
            if (dir == 0) { _Pragma("unroll") for (int i = 0; i < 8; ++i) { bsum += G[i]; kt[i] = bf2f_(K[i]) * __expf(-bsum); } } \
            else { _Pragma("unroll") for (int i = 7; i >= 0; --i) { bsum += G[i]; kt[i] = bf2f_(K[i]) * __expf(-bsum); } } \
            u32x4 w; w.x = cvtpk(kt[0], kt[1]); w.y = cvtpk(kt[2], kt[3]); w.z = cvtpk(kt[4], kt[5]); w.w = cvtpk(kt[6], kt[7]); *(GLAS u32x4*)(row + t0_ * 2) = w; } while (0)
        GLA_LOAD(gA, kA, 0);
#pragma unroll
        for (int bp = 0; bp < 4; ++bp) { GLA_LOAD(gB, kB, 2 * bp + 1); GLA_PROC(gA, kA, 2 * bp); if (bp < 3) GLA_LOAD(gA, kA, 2 * bp + 2); GLA_PROC(gB, kB, 2 * bp + 1); }
#undef GLA_LOAD
#undef GLA_PROC
        bend_s[(c * 2 + dir) * 32 + d] = bsum;
        DEC[((size_t)((b * 4 + h) * 32 + g * 4 + c) * 2 + dir) * 32 + d] = __expf(bsum);
    } else { const int c = wave - 4; load_v_tile(GV + (tok0 + c * 64) * 256 + h * 64, lds + A_V + c * 8192, lane); }
    __syncthreads();
    {
        const int c = wave >> 1, dir = wave & 1; f32x16 o0 = {}, o1 = {};
        const int vb = (int)(unsigned)(uintptr_t)(lds + A_V + c * 8192) + att::v_rd_base(lane);
        const GLAS unsigned char* arow = lds + A_KT + ((c * 2 + dir) * 32 + r32) * KT_STRIDE;
#define GLA_AF(ks) afrag_tr(arow, ks, hi)
        GLA_MM4(o0, o1, vb, GLA_AF);
#undef GLA_AF
        float* dst = KVC + ((size_t)((b * 4 + h) * 32 + g * 4 + c) * 2 + dir) * 2048 + r32;
#pragma unroll
        for (int r = 0; r < 16; ++r) { const int d = crow(r, hi); const float sc = __expf(bend_s[(c * 2 + dir) * 32 + d]); dst[d * 64] = o0[r] * sc; dst[d * 64 + 32] = o1[r] * sc; }
    }
    __syncthreads();
}

__device__ __forceinline__ void gla_b_item(int b, int h, int g, unsigned char* ws, const float* __restrict__ gng, bf16_t* __restrict__ OC, GLAS unsigned char* lds) {
    int tid_o = threadIdx.x; asm volatile("" : "+v"(tid_o));
    const int tid = tid_o, wave = __builtin_amdgcn_readfirstlane(tid >> 6), lane = tid & 63, r32 = lane & 31, hi = lane >> 5;
    const float* GL = (const float*)(ws + cfg::WS_GL); const bf16_t* GQK = (const bf16_t*)(ws + cfg::WS_GQK); const bf16_t* GV = (const bf16_t*)(ws + cfg::WS_GV); const bf16_t* GR = (const bf16_t*)(ws + cfg::WS_GR);
    const float* KVC = (const float*)(ws + cfg::WS_OF) + (size_t)((b * 4 + h) * 32) * 2 * 2048; const float* DEC = (const float*)(ws + cfg::WS_DEC) + (size_t)((b * 4 + h) * 32) * 2 * 32;
    const size_t tok0 = (size_t)b * 2048 + g * 256;
    if (wave < 4) {
        const int c = wave, dir = lane >> 5, d = lane & 31;
        const float* gl = GL + (tok0 + c * 64) * 256 + dir * 128 + h * 32 + d; const bf16_t* qp = GQK + (tok0 + c * 64) * 256 + h * 32 + d;
        GLAS unsigned short* qt = (GLAS unsigned short*)(lds + B_QT + c * 8192) + dir * 32 + d;
        GLAS unsigned short* kt = (GLAS unsigned short*)(lds + B_KT + c * 8192 + dir * 4096) + d;
        float bsum = 0.f; float gA[8], gB[8]; unsigned short qA[8], kA[8], qB[8], kB[8];
#define GLB_LOAD(G, Q, K, blk) do { const int t0_ = dir ? 56 - 8 * (blk) : 8 * (blk); _Pragma("unroll") for (int i = 0; i < 8; ++i) { G[i] = gl[(size_t)(t0_ + i) * 256]; Q[i] = qp[(size_t)(t0_ + i) * 256]; K[i] = qp[(size_t)(t0_ + i) * 256 + 128]; } } while (0)
#define GLB_PROC(G, Q, K, blk) do { const int t0_ = dir ? 56 - 8 * (blk) : 8 * (blk); _Pragma("unroll") for (int ii = 0; ii < 8; ++ii) { \
            const float gi = dir ? G[7 - ii] : G[ii], qi = bf2f_(dir ? Q[7 - ii] : Q[ii]), ki = bf2f_(dir ? K[7 - ii] : K[ii]); const int tt = t0_ + (dir ? 7 - ii : ii); \
            bsum += gi; const float e = __expf(bsum), ei = __expf(-bsum); \
            qt[tt * 64] = (unsigned short)(cvtpk(qi * e, 0.f) & 0xffffu); kt[tt * 32] = (unsigned short)(cvtpk(ki * ei, 0.f) & 0xffffu); } } while (0)
        GLB_LOAD(gA, qA, kA, 0);
#pragma unroll
        for (int bp = 0; bp < 4; ++bp) { GLB_LOAD(gB, qB, kB, 2 * bp + 1); GLB_PROC(gA, qA, kA, 2 * bp); if (bp < 3) GLB_LOAD(gA, qA, kA, 2 * bp + 2); GLB_PROC(gB, qB, kB, 2 * bp + 1); }
#undef GLB_LOAD
#undef GLB_PROC
    } else {
        const int c = wave - 4; load_v_tile(GV + (tok0 + c * 64) * 256 + h * 64, lds + B_V + c * 8192, lane);
        const int t2 = tid - 256, d = t2 >> 3, v8 = (t2 & 7) * 8;
        const float* kvp = KVC + d * 64 + v8; const float* dcp = DEC + d;
        f32x4 own[4][2][2]; float dow[4][2];
#pragma unroll
        for (int c4 = 0; c4 < 4; ++c4)
#pragma unroll
            for (int dr = 0; dr < 2; ++dr) { const int n = 4 * g + c4; own[c4][dr][0] = *(const f32x4*)(kvp + (size_t)(n * 2 + dr) * 2048); own[c4][dr][1] = *(const f32x4*)(kvp + (size_t)(n * 2 + dr) * 2048 + 4); dow[c4][dr] = dcp[(n * 2 + dr) * 32]; }
        f32x4 Sf0 = {0.f, 0.f, 0.f, 0.f}, Sf1 = Sf0, Sb0 = Sf0, Sb1 = Sf0;
#pragma unroll 8
        for (int n = 0; n < 4 * g; ++n) { const float dc = dcp[(n * 2) * 32]; Sf0 = dc * Sf0 + *(const f32x4*)(kvp + (size_t)(n * 2) * 2048); Sf1 = dc * Sf1 + *(const f32x4*)(kvp + (size_t)(n * 2) * 2048 + 4); }
#pragma unroll 8
        for (int n = 31; n >= 4 * g + 4; --n) { const float dc = dcp[(n * 2 + 1) * 32]; Sb0 = dc * Sb0 + *(const f32x4*)(kvp + (size_t)(n * 2 + 1) * 2048); Sb1 = dc * Sb1 + *(const f32x4*)(kvp + (size_t)(n * 2 + 1) * 2048 + 4); }
#pragma unroll
        for (int c4 = 0; c4 < 4; ++c4) { u32x4 w; w.x = cvtpk(Sf0[0], Sf0[1]); w.y = cvtpk(Sf0[2], Sf0[3]); w.z = cvtpk(Sf1[0], Sf1[1]); w.w = cvtpk(Sf1[2], Sf1[3]);
            *(GLAS u32x4*)(lds + B_SC + c4 * 8192 + v_st64(d, v8)) = w; Sf0 = dow[c4][0] * Sf0 + own[c4][0][0]; Sf1 = dow[c4][0] * Sf1 + own[c4][0][1]; }
#pragma unroll
        for (int c4 = 3; c4 >= 0; --c4) { u32x4 w; w.x = cvtpk(Sb0[0], Sb0[1]); w.y = cvtpk(Sb0[2], Sb0[3]); w.z = cvtpk(Sb1[0], Sb1[1]); w.w = cvtpk(Sb1[2], Sb1[3]);
            *(GLAS u32x4*)(lds + B_SC + c4 * 8192 + v_st64(32 + d, v8)) = w; Sb0 = dow[c4][1] * Sb0 + own[c4][1][0]; Sb1 = dow[c4][1] * Sb1 + own[c4][1][1]; }
    }
    __syncthreads();
    {
        const int c = wave >> 1, th = wave & 1, t = 32 * th + r32;
        const GLAS unsigned char* qrow = lds + B_QT + c * 8192 + t * 128;
        f32x16 pf0 = {}, pf1 = {}, pb0 = {}, pb1 = {};
#pragma unroll
        for (int ks = 0; ks < 2; ++ks) {
            const bf16x8 qf = *(const GLAS bf16x8*)(qrow + (16 * ks + 8 * hi) * 2), qb = *(const GLAS bf16x8*)(qrow + (32 + 16 * ks + 8 * hi) * 2);
            const GLAS unsigned char* kf = lds + B_KT + c * 8192 + r32 * 64 + (16 * ks + 8 * hi) * 2; const GLAS unsigned char* kb = kf + 4096;
            pf0 = __builtin_amdgcn_mfma_f32_32x32x16_bf16(*(const GLAS bf16x8*)kf, qf, pf0, 0, 0, 0); pf1 = __builtin_amdgcn_mfma_f32_32x32x16_bf16(*(const GLAS bf16x8*)(kf + 2048), qf, pf1, 0, 0, 0);
            pb0 = __builtin_amdgcn_mfma_f32_32x32x16_bf16(*(const GLAS bf16x8*)kb, qb, pb0, 0, 0, 0); pb1 = __builtin_amdgcn_mfma_f32_32x32x16_bf16(*(const GLAS bf16x8*)(kb + 2048), qb, pb1, 0, 0, 0);
        }
#pragma unroll
        for (int r = 0; r < 16; ++r) { const int j0 = crow(r, hi), j1 = 32 + j0;
            pf0[r] = (j0 <= t ? pf0[r] : 0.f) + (j0 >= t ? pb0[r] : 0.f); pf1[r] = (j1 <= t ? pf1[r] : 0.f) + (j1 >= t ? pb1[r] : 0.f); }
        bf16x8 pa0, pa1, pa2, pa3;
#define GLA_PK4(P, BASE, OUT) do { unsigned a0 = cvtpk(P[BASE + 0], P[BASE + 1]), a1 = cvtpk(P[BASE + 2], P[BASE + 3]); unsigned b0 = cvtpk(P[BASE + 4], P[BASE + 5]), b1 = cvtpk(P[BASE + 6], P[BASE + 7]); \
    auto r0 = __builtin_amdgcn_permlane32_swap(a0, b0, false, false); auto r1 = __builtin_amdgcn_permlane32_swap(a1, b1, false, false); \
    u32x4 w = {r0[0], r1[0], r0[1], r1[1]}; OUT = *reinterpret_cast<bf16x8*>(&w); } while (0)
        GLA_PK4(pf0, 0, pa0); GLA_PK4(pf0, 8, pa1); GLA_PK4(pf1, 0, pa2); GLA_PK4(pf1, 8, pa3);
#undef GLA_PK4
        f32x16 o0 = {}, o1 = {};
        { const int vb = (int)(unsigned)(uintptr_t)(lds + B_V + c * 8192) + att::v_rd_base(lane);
#define GLA_AF(ks) ((ks) == 0 ? pa0 : (ks) == 1 ? pa1 : (ks) == 2 ? pa2 : pa3)
          GLA_MM4(o0, o1, vb, GLA_AF);
#undef GLA_AF
        }
        { const int vb = (int)(unsigned)(uintptr_t)(lds + B_SC + c * 8192) + att::v_rd_base(lane);
#define GLA_AF(ks) afrag_tr(qrow, ks, hi)
          GLA_MM4(o0, o1, vb, GLA_AF);
#undef GLA_AF
        }
        const float g0 = gng[r32], g1 = gng[32 + r32];
        const bf16_t* grb = GR + (tok0 + c * 64 + 32 * th) * 256 + h * 64 + r32; unsigned short gq0[16], gq1[16];
#pragma unroll
        for (int r = 0; r < 16; ++r) { gq0[r] = grb[(size_t)crow(r, hi) * 256]; gq1[r] = grb[(size_t)crow(r, hi) * 256 + 32]; }
#pragma unroll
        for (int r = 0; r < 16; ++r) {
            float ssq = o0[r] * o0[r] + o1[r] * o1[r];
            ssq = xadd<1>(ssq); ssq = xadd<2>(ssq); ssq = xadd<4>(ssq); ssq = xadd<8>(ssq); ssq = xadd<16>(ssq);
            const float rn = rsqrtf(ssq * (1.f / 64.f) + cfg::EPS);
            const size_t tok = tok0 + c * 64 + 32 * th + crow(r, hi);
            bf16_t* dst = OC + tok * 1024 + 768 + h * 64 + r32;
            dst[0] = (bf16_t)(cvtpk(o0[r] * rn * g0 * bf2f_(gq0[r]), 0.f) & 0xffffu); dst[32] = (bf16_t)(cvtpk(o1[r] * rn * g1 * bf2f_(gq1[r]), 0.f) & 0xffffu);
        }
    }
    __syncthreads();
}
#undef GLA_MM4
#undef GLA_PK
#undef GLAS
}
namespace fft {
using att::bf16x8; using att::s16x4; using att::f32x16; using att::u32x4; using att::crow; using att::cvtpk; using att::tr_read;
#define FLAS __attribute__((address_space(3)))
__device__ __forceinline__ int img_off(int k, int c) { const int kk = (k & ~0xC) | ((k & 4) << 1) | ((k & 8) >> 1); return ((kk >> 3) * 8 + (c >> 5)) * 512 + ((kk & 7) * 32 + (c & 31)) * 2; }
constexpr int rd_off(int ks, int half) { return ks * 8192 + half * 4096; }
#define FFT_PK(L, H) (bf16x8){L[0], L[1], L[2], L[3], H[0], H[1], H[2], H[3]}
typedef float f32x2_t __attribute__((ext_vector_type(2))); typedef __bf16 bf16x2_t __attribute__((ext_vector_type(2)));
__device__ __forceinline__ unsigned pk2f(float a, float b) { f32x2_t v = {a, b}; bf16x2_t r = __builtin_convertvector(v, bf16x2_t); return __builtin_bit_cast(unsigned, r); }

__device__ __forceinline__ void stage1_item(int b, int s2, const bf16_t* __restrict__ FX, bf16_t* __restrict__ I1, FLAS unsigned char* lds) {
    int tid_o = threadIdx.x; asm volatile("" : "+v"(tid_o));
    const int tid = tid_o, wave = __builtin_amdgcn_readfirstlane(tid >> 6), lane = tid & 63, r32 = lane & 31, hi = lane >> 5;
    bf16x8 F1[2][4];
#pragma unroll
    for (int ks = 0; ks < 4; ++ks) { float cr[8], ci[8];
#pragma unroll
        for (int j = 0; j < 8; ++j) { const int k = 16 * ks + 8 * hi + j, s1 = k & 31; const float rev = (float)((r32 * s1) & 31) * (1.f / 32.f); const float c = __builtin_amdgcn_cosf(rev), sn = __builtin_amdgcn_sinf(rev);
            const bool p1 = (k >> 5) != 0; cr[j] = p1 ? -sn : c; ci[j] = p1 ? -c : -sn; }
        u32x4 wr = {pk2f(cr[0], cr[1]), pk2f(cr[2], cr[3]), pk2f(cr[4], cr[5]), pk2f(cr[6], cr[7])}, wi = {pk2f(ci[0], ci[1]), pk2f(ci[2], ci[3]), pk2f(ci[4], ci[5]), pk2f(ci[6], ci[7])};
        F1[0][ks] = *reinterpret_cast<bf16x8*>(&wr); F1[1][ks] = *reinterpret_cast<bf16x8*>(&wi); }
    { u32x4 tv[4];
#pragma unroll
      for (int i = 0; i < 4; ++i) { const int p = tid + 512 * i, k = p >> 5, c8 = (p & 31) * 8; tv[i] = *(const u32x4*)(FX + (size_t)(b * 2048 + 64 * (k & 31) + s2) * 512 + (k >> 5) * 256 + c8); }
#pragma unroll
      for (int i = 0; i < 4; ++i) { const int p = tid + 512 * i, k = p >> 5, c8 = (p & 31) * 8; *(FLAS u32x4*)(lds + img_off(k, c8)) = tv[i]; } }
    __syncthreads();
    f32x16 re = {}, im = {};
    { const int vb = (int)(unsigned)(uintptr_t)lds + att::v_rd_base(lane) + wave * 512;
      const s16x4 l0 = tr_read<rd_off(0, 0)>(vb), h0 = tr_read<rd_off(0, 1)>(vb), l1 = tr_read<rd_off(1, 0)>(vb), h1 = tr_read<rd_off(1, 1)>(vb);
      const s16x4 l2 = tr_read<rd_off(2, 0)>(vb), h2 = tr_read<rd_off(2, 1)>(vb), l3 = tr_read<rd_off(3, 0)>(vb), h3 = tr_read<rd_off(3, 1)>(vb);
      asm volatile("s_waitcnt lgkmcnt(0)" ::: "memory"); __builtin_amdgcn_sched_barrier(0);
      re = __builtin_amdgcn_mfma_f32_32x32x16_bf16(F1[0][0], FFT_PK(l0, h0), re, 0, 0, 0); im = __builtin_amdgcn_mfma_f32_32x32x16_bf16(F1[1][0], FFT_PK(l0, h0), im, 0, 0, 0);
      re = __builtin_amdgcn_mfma_f32_32x32x16_bf16(F1[0][1], FFT_PK(l1, h1), re, 0, 0, 0); im = __builtin_amdgcn_mfma_f32_32x32x16_bf16(F1[1][1], FFT_PK(l1, h1), im, 0, 0, 0);
      re = __builtin_amdgcn_mfma_f32_32x32x16_bf16(F1[0][2], FFT_PK(l2, h2), re, 0, 0, 0); im = __builtin_amdgcn_mfma_f32_32x32x16_bf16(F1[1][2], FFT_PK(l2, h2), im, 0, 0, 0);
      re = __builtin_amdgcn_mfma_f32_32x32x16_bf16(F1[0][3], FFT_PK(l3, h3), re, 0, 0, 0); im = __builtin_amdgcn_mfma_f32_32x32x16_bf16(F1[1][3], FFT_PK(l3, h3), im, 0, 0, 0); }
    bf16_t* dst = I1 + (size_t)(b * 32) * 128 * 256 + (size_t)s2 * 256 + 32 * wave + r32;
#pragma unroll
    for (int r = 0; r < 16; ++r) { const int k1 = crow(r, hi); const float rev = (float)((k1 * s2) & 2047) * (1.f / 2048.f); const float ct = __builtin_amdgcn_cosf(rev), st = __builtin_amdgcn_sinf(rev);
        const float ar = re[r] * ct + im[r] * st, ai = im[r] * ct - re[r] * st; const unsigned w = pk2f(ar, ai);
        dst[(size_t)k1 * 128 * 256] = (bf16_t)(w & 0xffffu); dst[(size_t)k1 * 128 * 256 + 64 * 256] = (bf16_t)(w >> 16); }
    __syncthreads();
}

__device__ __forceinline__ void stage2_item(int b, int k1, const bf16_t* __restrict__ I1, bf16_t* __restrict__ OC, FLAS unsigned char* lds) {
    int tid_o = threadIdx.x; asm volatile("" : "+v"(tid_o));
    const int tid = tid_o, wave = __builtin_amdgcn_readfirstlane(tid >> 6), lane = tid & 63, r32 = lane & 31, hi = lane >> 5;
    const bf16_t* src = I1 + (size_t)(b * 32 + k1) * 128 * 256;
    { u32x4 tv[8];
#pragma unroll
      for (int i = 0; i < 8; ++i) { const int p = tid + 512 * i, k = p >> 5, c8 = (p & 31) * 8; tv[i] = *(const u32x4*)(src + (size_t)k * 256 + c8); }
#pragma unroll
      for (int i = 0; i < 8; ++i) { const int p = tid + 512 * i, k = p >> 5, c8 = (p & 31) * 8; *(FLAS u32x4*)(lds + img_off(k, c8)) = tv[i]; } }
    f32x16 y0 = {}, y1 = {};
    __syncthreads();
    const int vb = (int)(unsigned)(uintptr_t)lds + att::v_rd_base(lane) + wave * 512, vb2 = vb + 32768;
    bf16x8 F2[2][8];
#pragma unroll
    for (int ks = 0; ks < 8; ++ks) { float c0[8], c1[8];
#pragma unroll
        for (int j = 0; j < 8; ++j) { const int k = 16 * ks + 8 * hi + j, s2 = k & 63; const float r0 = (float)((r32 * s2) & 63) * (1.f / 64.f), r1 = (float)(((32 + r32) * s2) & 63) * (1.f / 64.f);
            c0[j] = (k >> 6) ? __builtin_amdgcn_sinf(r0) : __builtin_amdgcn_cosf(r0); c1[j] = (k >> 6) ? __builtin_amdgcn_sinf(r1) : __builtin_amdgcn_cosf(r1); }
        u32x4 w0 = {pk2f(c0[0], c0[1]), pk2f(c0[2], c0[3]), pk2f(c0[4], c0[5]), pk2f(c0[6], c0[7])}, w1 = {pk2f(c1[0], c1[1]), pk2f(c1[2], c1[3]), pk2f(c1[4], c1[5]), pk2f(c1[6], c1[7])};
        F2[0][ks] = *reinterpret_cast<bf16x8*>(&w0); F2[1][ks] = *reinterpret_cast<bf16x8*>(&w1); }
#define FFT_STEP(ks) do { \
      const s16x4 lo_ = tr_read<rd_off((ks) & 3, 0)>((ks) < 4 ? vb : vb2), hi_ = tr_read<rd_off((ks) & 3, 1)>((ks) < 4 ? vb : vb2); asm volatile("s_waitcnt lgkmcnt(0)" ::: "memory"); __builtin_amdgcn_sched_barrier(0); \
      y0 = __builtin_amdgcn_mfma_f32_32x32x16_bf16(F2[0][ks], FFT_PK(lo_, hi_), y0, 0, 0, 0); y1 = __builtin_amdgcn_mfma_f32_32x32x16_bf16(F2[1][ks], FFT_PK(lo_, hi_), y1, 0, 0, 0); } while (0)
    FFT_STEP(0); FFT_STEP(1); FFT_STEP(2); FFT_STEP(3); FFT_STEP(4); FFT_STEP(5); FFT_STEP(6); FFT_STEP(7);
#undef FFT_STEP
    bf16_t* dst = OC + (size_t)(b * 2048 + k1) * 1024 + 512 + 32 * wave + r32;
#pragma unroll
    for (int r = 0; r < 16; ++r) { const int k2 = crow(r, hi); const unsigned w = pk2f(y0[r], y1[r]);
        dst[(size_t)(32 * k2) * 1024] = (bf16_t)(w & 0xffffu); dst[(size_t)(32 * (32 + k2)) * 1024] = (bf16_t)(w >> 16); }
    __syncthreads();
}
#undef FFT_PK
#undef FLAS
}
namespace pro {
#define PLAS __attribute__((address_space(3)))
typedef float f32x4 __attribute__((ext_vector_type(4)));
typedef unsigned u32x4 __attribute__((ext_vector_type(4)));
__device__ __forceinline__ unsigned pk2(float lo, float hi) { unsigned r; asm volatile("v_cvt_pk_bf16_f32 %0, %1, %2" : "=v"(r) : "v"(lo), "v"(hi)); return r; }
__device__ __forceinline__ float lo_f(unsigned w) { return __uint_as_float(w << 16); }
__device__ __forceinline__ float hi_f(unsigned w) { return __uint_as_float(w & 0xffff0000u); }
template <bool SUMS, int STRIDE> __device__ __forceinline__ void tile_emit(int K, bf16_t* WT, const float* gain, const float* lnb, float (&a1)[4], float (&a2)[4], const PLAS float* scr, int lane) {
    const int c = lane & 7; float gk[8], bk[8];
#pragma unroll
    for (int q = 0; q < 8; ++q) { gk[q] = gain ? gain[8 * c + q] : 1.f; bk[q] = lnb ? lnb[8 * c + q] : 0.f; }
#pragma unroll
    for (int j = 0; j < 4; ++j) { const int n = (lane >> 3) + 8 * j; const PLAS float* s = scr + (8 * c) * STRIDE + n; float v[8];
#pragma unroll
        for (int q = 0; q < 8; ++q) v[q] = s[q * STRIDE];
        u32x4 o; o.x = pk2(v[0] * gk[0], v[1] * gk[1]); o.y = pk2(v[2] * gk[2], v[3] * gk[3]); o.z = pk2(v[4] * gk[4], v[5] * gk[5]); o.w = pk2(v[6] * gk[6], v[7] * gk[7]);
        *(u32x4*)(WT + (size_t)n * K + 8 * c) = o;
        if (SUMS) { float p1 = (lo_f(o.x) + hi_f(o.x)) + (lo_f(o.y) + hi_f(o.y)) + (lo_f(o.z) + hi_f(o.z)) + (lo_f(o.w) + hi_f(o.w)); float p2 = 0.f;
#pragma unroll
            for (int q = 0; q < 8; ++q) p2 += bk[q] * v[q];
            p1 = xadd<1>(p1); p2 = xadd<1>(p2); p1 = xadd<2>(p1); p2 = xadd<2>(p2); p1 = xadd<4>(p1); p2 = xadd<4>(p2);
            a1[j] += p1; a2[j] += p2; }
    }
    asm volatile("s_waitcnt lgkmcnt(0)" ::: "memory");
}
__device__ __forceinline__ void tile_dma(const float* W, int N, PLAS float* scr, int lane) {
    const float* src = W + (size_t)(lane >> 3) * N + (lane & 7) * 4;
#pragma unroll
    for (int i = 0; i < 8; ++i) __builtin_amdgcn_global_load_lds((const unsigned*)(src + (size_t)(8 * i) * N), (PLAS unsigned*)(scr + i * 256), 16, 0, 0);
}
template <bool SUMS, class Val> __device__ __forceinline__ void tile_item(const Val& val, int K, bf16_t* WT, const float* gain, const float* lnb, float (&a1)[4], float (&a2)[4], PLAS float* scr, int lane) {
#pragma unroll 2
    for (int i = 0; i < 32; ++i) { const int kk = 2 * i + (lane >> 5); scr[kk * 33 + (lane & 31)] = val(kk, lane & 31); }
    asm volatile("s_waitcnt lgkmcnt(0)" ::: "memory");
    tile_emit<SUMS, 33>(K, WT, gain, lnb, a1, a2, scr, lane);
}
struct ValPlain { static constexpr int BATCH = 32; const float* W; int N; __device__ __forceinline__ float operator()(int kk, int j) const { return W[(size_t)kk * N + j]; } };
struct ValGate { static constexpr int BATCH = 2; const float* W; const float* w2; __device__ __forceinline__ float operator()(int kk, int j) const {
    const float* wr = W + (size_t)kk * cfg::INW; float a = 0.f;
#pragma unroll
    for (int r = 0; r < 16; ++r) a += wr[r] * w2[r * 128 + j]; return a; } };

__device__ __forceinline__ void fold_item(int item, unsigned char* ws, const float* w_in, const float* fw, const float* lng, const float* lnb, PLAS unsigned char* lds, int tid) {
    const int l = item >> 5, g = (item >> 3) & 3, part = (item >> 2) & 1, kq = item & 3;
    PLAS float* M = (PLAS float*)lds;
    { const int c = tid >> 3, e0 = (tid & 7) * 8; float acc[8];
#pragma unroll
      for (int q = 0; q < 8; ++q) acc[q] = 0.f;
      const float* w = fw + (size_t)((l * 4 + g) * 64) * 64 + e0;
      for (int k2 = 0; k2 < 64; ++k2) { float rev = (float)((k2 * c) & 63) * (1.f / 64.f); asm volatile("" : "+v"(rev)); const float tr = part ? __builtin_amdgcn_sinf(rev) : __builtin_amdgcn_cosf(rev);
          const f32x4 w0 = *(const f32x4*)(w + k2 * 64), w1 = *(const f32x4*)(w + k2 * 64 + 4);
#pragma unroll
          for (int q = 0; q < 4; ++q) { acc[q] += tr * w0[q]; acc[4 + q] += tr * w1[q]; } }
      const float sc = 0.00276213586400995f;
#pragma unroll
      for (int q = 0; q < 8; ++q) M[c * 64 + e0 + q] = acc[q] * sc; }
    __syncthreads();
    PLAS float* Wl = (PLAS float*)(lds + 16384);
    { const float* wsrc = w_in + ((size_t)l * 1024 + kq * 256) * cfg::INW + 1536 + 64 * g; f32x4 tv[8];
#pragma unroll
      for (int i = 0; i < 8; ++i) tv[i] = *(const f32x4*)(wsrc + (size_t)((tid >> 4) + 32 * i) * cfg::INW + (tid & 15) * 4);
#pragma unroll
      for (int i = 0; i < 8; ++i) *(PLAS f32x4*)(Wl + ((tid >> 4) + 32 * i) * 64 + (tid & 15) * 4) = tv[i]; }
    __syncthreads();
    { const int e = tid & 63, kg = tid >> 6, k0 = kq * 256 + kg * 32, np = 1536 + part * 256 + g * 64 + e; float mc[64];
#pragma unroll
      for (int c = 0; c < 64; ++c) mc[c] = M[c * 64 + e];
      bf16_t* dst = (bf16_t*)(ws + cfg::WS_WIN + l * cfg::SZ_WIN) + (size_t)np * 1024 + k0; float s1 = 0.f, s2 = 0.f;
      for (int kb = 0; kb < 4; ++kb) { float o[8];
#pragma unroll
          for (int q = 0; q < 8; ++q) { const int k = k0 + kb * 8 + q; const PLAS f32x4* wr = (const PLAS f32x4*)(Wl + (kg * 32 + kb * 8 + q) * 64); float a = 0.f;
#pragma unroll
              for (int c4 = 0; c4 < 16; ++c4) { const f32x4 w4 = wr[c4]; a += w4[0] * mc[4 * c4] + w4[1] * mc[4 * c4 + 1] + w4[2] * mc[4 * c4 + 2] + w4[3] * mc[4 * c4 + 3]; }
              o[q] = a * (lng ? lng[k] : 1.f); s2 += lnb ? lnb[k] * a : 0.f; }
          u32x4 w; w.x = pk2(o[0], o[1]); w.y = pk2(o[2], o[3]); w.z = pk2(o[4], o[5]); w.w = pk2(o[6], o[7]); *(u32x4*)(dst + kb * 8) = w;
          s1 += (lo_f(w.x) + hi_f(w.x)) + (lo_f(w.y) + hi_f(w.y)) + (lo_f(w.z) + hi_f(w.z)) + (lo_f(w.w) + hi_f(w.w)); }
      __syncthreads();
      PLAS float* red = (PLAS float*)lds; red[(kg * 64 + e) * 2] = s1; red[(kg * 64 + e) * 2 + 1] = s2;
      __syncthreads();
      if (kg == 0) { float t1 = 0.f, t2 = 0.f;
#pragma unroll
          for (int w = 0; w < 8; ++w) { t1 += red[(w * 64 + e) * 2]; t2 += red[(w * 64 + e) * 2 + 1]; }
          float* fp = (float*)(ws + cfg::V_MF) + (size_t)((l * 4 + kq) * 2) * 512 + part * 256 + g * 64 + e; fp[0] = t1; fp[512] = t2; } }
    __syncthreads();
}

struct Inputs { const float *x, *w_in, *fw, *gw2, *w_out, *ln1g, *ln1b, *wg, *wu, *wd, *ln2g, *ln2b; };
__device__ __forceinline__ void prologue(unsigned char* ws, const Inputs& in, PLAS unsigned char* lds, int vcu, int G) {
    int tid_o = threadIdx.x; asm volatile("" : "+v"(tid_o));
    const int tid = tid_o, wave = __builtin_amdgcn_readfirstlane(tid >> 6), lane = tid & 63;
    const float* x = in.x; const float* w_in = in.w_in; const float* fw = in.fw; const float* gw2 = in.gw2; const float* w_out = in.w_out; const float* ln1g = in.ln1g; const float* ln1b = in.ln1b;
    const float* wg = in.wg; const float* wu = in.wu; const float* wd = in.wd; const float* ln2g = in.ln2g; const float* ln2b = in.ln2b;
    if (vcu < 64) { const int l = vcu >> 5; fold_item(vcu, ws, w_in, fw, l ? ln2g : (const float*)nullptr, l ? ln2b : (const float*)nullptr, lds, tid); }
    PLAS float* scr = (PLAS float*)(lds + wave * 16384); PLAS float* scr1 = scr + 2048; PLAS float* redw = (PLAS float*)(lds + 131072 + 1024 + wave * 256);
    const int gw = vcu * 8 + wave, NGW = G * 8;
    for (int it = vcu; it < 512; it += G) {
        const int l = it >> 8, r = it & 255; float a1[4] = {0.f, 0.f, 0.f, 0.f}, a2[4] = {0.f, 0.f, 0.f, 0.f}; float* c1o; float* c2o;
        const int k0 = wave * 64, k1 = k0 + 512;
        if (r < 80) { const int nb = r; const float* lngb = l ? ln2g : (const float*)nullptr; const float* lnbb = l ? ln2b : (const float*)nullptr;
            bf16_t* Wt = (bf16_t*)(ws + cfg::WS_WIN + l * cfg::SZ_WIN);
            if (nb < 72) { int np0, src;
                if (nb < 32) { const int pn = nb >> 3, p = (nb & 7) * 32, wc = (p >> 5) & 3, bj = p >> 7; np0 = pn * 256 + p; src = (pn >> 1) * 512 + (pn & 1) * 256 + 64 * wc + 32 * bj; }
                else if (nb < 48) { np0 = 1024 + (nb - 32) * 32; src = np0; }
                else { np0 = 2048 + (nb - 48) * 32; src = 1792 + (nb - 48) * 32; }
                tile_dma(w_in + ((size_t)l * 1024 + k0) * cfg::INW + src, cfg::INW, scr, lane); tile_dma(w_in + ((size_t)l * 1024 + k1) * cfg::INW + src, cfg::INW, scr1, lane);
                asm volatile("s_waitcnt vmcnt(0)" ::: "memory");
                tile_emit<true, 32>(1024, Wt + (size_t)np0 * 1024 + k0, lngb ? lngb + k0 : lngb, lnbb ? lnbb + k0 : lnbb, a1, a2, scr, lane);
                tile_emit<true, 32>(1024, Wt + (size_t)np0 * 1024 + k1, lngb ? lngb + k1 : lngb, lnbb ? lnbb + k1 : lnbb, a1, a2, scr1, lane);
                c1o = (float*)(ws + cfg::V_C1IN) + l * cfg::NIN + np0; c2o = (float*)(ws + cfg::V_C2IN) + l * cfg::NIN + np0;
            } else { const int p0 = (nb - 72) * 32, dir = p0 >> 7, kk0 = p0 & 127, np0 = 2816 + p0;
                for (int kb = wave; kb < 16; kb += 8) { const int kq = kb * 64; ValGate v{w_in + ((size_t)l * 1024 + kq) * cfg::INW + 2560 + 16 * dir, gw2 + (size_t)((l * 2 + dir) * 16) * 128 + kk0};
                    tile_item<true>(v, 1024, Wt + (size_t)np0 * 1024 + kq, lngb ? lngb + kq : lngb, lnbb ? lnbb + kq : lnbb, a1, a2, scr, lane); }
                c1o = (float*)(ws + cfg::V_C1IN) + l * cfg::NIN + np0; c2o = (float*)(ws + cfg::V_C2IN) + l * cfg::NIN + np0; }
        } else { const int nb = r - 80, np0 = nb * 32, pn = np0 >> 8, p = np0 & 255, bj = p >> 7, f0 = 128 * pn + (p & 127);
            const float* W = (bj ? wu : wg) + (size_t)l * 1024 * cfg::FF + f0; bf16_t* Wt = (bf16_t*)(ws + cfg::WS_WGU + l * cfg::SZ_WGU) + (size_t)np0 * 1024;
            tile_dma(W + (size_t)k0 * cfg::FF, cfg::FF, scr, lane); tile_dma(W + (size_t)k1 * cfg::FF, cfg::FF, scr1, lane);
            asm volatile("s_waitcnt vmcnt(0)" ::: "memory");
            tile_emit<true, 32>(1024, Wt + k0, ln1g + l * 1024 + k0, ln1b + l * 1024 + k0, a1, a2, scr, lane);
            tile_emit<true, 32>(1024, Wt + k1, ln1g + l * 1024 + k1, ln1b + l * 1024 + k1, a1, a2, scr1, lane);
            c1o = (float*)(ws + cfg::V_C1GU) + l * cfg::NGU + np0; c2o = (float*)(ws + cfg::V_C2GU) + l * cfg::NGU + np0; }
        if ((lane & 7) == 0) {
#pragma unroll
            for (int j = 0; j < 4; ++j) { const int n = (lane >> 3) + 8 * j; redw[n * 2] = a1[j]; redw[n * 2 + 1] = a2[j]; } }
        __syncthreads();
        if (wave == 0 && lane < 32) { float t1 = 0.f, t2 = 0.f;
#pragma unroll
            for (int w = 0; w < 8; ++w) { const PLAS float* rw = (const PLAS float*)(lds + 131072 + 1024 + w * 256); t1 += rw[lane * 2]; t2 += rw[lane * 2 + 1]; }
            c1o[lane] = t1; c2o[lane] = t2; }
        __syncthreads();
    }
    constexpr int I_OUT = 32 * 16, I_DN = 32 * 44, I_L = I_OUT + I_DN;
    for (int it = gw; it < 2 * I_L; it += 2 * NGW) {
        const float* Ws[2]; int Ns[2], Ks[2]; bf16_t* Wd[2]; float d1[4], d2[4];
#pragma unroll
        for (int q = 0; q < 2; ++q) { const int itq = it + q * NGW; const int ic = itq < 2 * I_L ? itq : it; const int l = ic / I_L; int r = ic - l * I_L;
            if (r < I_OUT) { const int nb = r >> 4, kb = r & 15, k0 = kb * 64, n0 = nb * 32; Ws[q] = w_out + ((size_t)l * 1024 + k0) * 1024 + n0; Ns[q] = 1024; Ks[q] = 1024;
                Wd[q] = (bf16_t*)(ws + cfg::WS_WOUT + l * cfg::SZ_WOUT) + (size_t)n0 * 1024 + k0; }
            else { r -= I_OUT; const int nb = r / 44, kb = r - nb * 44, k0 = kb * 64, n0 = nb * 32; Ws[q] = wd + ((size_t)l * cfg::FF + k0) * 1024 + n0; Ns[q] = 1024; Ks[q] = cfg::FF;
                Wd[q] = (bf16_t*)(ws + cfg::WS_WDN + l * cfg::SZ_WDN) + (size_t)n0 * cfg::FF + k0; } }
        tile_dma(Ws[0], Ns[0], scr, lane); tile_dma(Ws[1], Ns[1], scr1, lane);
        asm volatile("s_waitcnt vmcnt(0)" ::: "memory");
        tile_emit<false, 32>(Ks[0], Wd[0], (const float*)nullptr, (const float*)nullptr, d1, d2, scr, lane);
        if (it + NGW < 2 * I_L) tile_emit<false, 32>(Ks[1], Wd[1], (const float*)nullptr, (const float*)nullptr, d1, d2, scr1, lane);
    }
    const int xw = (vcu - 64) * 8 + wave, NXW = (G - 64) * 8;
    if (vcu >= 64 && G > 64)
    for (int m = xw; m < cfg::T; m += 4 * NXW) {
        f32x4 v[4][4];
#pragma unroll
        for (int q = 0; q < 4; ++q) { const int mr = (m + q * NXW) < cfg::T ? (m + q * NXW) : m; const f32x4* xr = (const f32x4*)(x + (size_t)mr * 1024) + lane;
#pragma unroll
            for (int j = 0; j < 4; ++j) v[q][j] = xr[64 * j]; }
#pragma unroll
        for (int q = 0; q < 4; ++q) { const int mr = (m + q * NXW) < cfg::T ? (m + q * NXW) : m; unsigned long long* o8 = (unsigned long long*)((bf16_t*)(ws + cfg::WS_XB) + (size_t)mr * 1024) + lane;
#pragma unroll
            for (int j = 0; j < 4; ++j) o8[64 * j] = (unsigned long long)pk2(v[q][j][0], v[q][j][1]) | ((unsigned long long)pk2(v[q][j][2], v[q][j][3]) << 32); } }
    for (int i = gw * 64 + lane; i < 2048 * 32; i += NGW * 64) { const int pos = i >> 5, f = i & 31; const float inv = exp2f(-(float)f * (13.287712379549449f / 32.f)); const float ang = (float)pos * inv;
        double rv = (double)ang * 0.15915494309189535; rv -= floor(rv); const float rev = (float)rv;
        ((float*)(ws + cfg::V_ROPEC))[i] = __builtin_amdgcn_cosf(rev); ((float*)(ws + cfg::V_ROPES))[i] = __builtin_amdgcn_sinf(rev); }
}
#undef PLAS
}
constexpr int NWAVES = 8;
constexpr int RING_OFF = 0, RING_BYTES = 131072;
constexpr int LDSCTL_OFF = RING_BYTES, MISC_OFF = LDSCTL_OFF + 320;
constexpr int RSL_OFF = 131072 + 4096;
constexpr int LDS_BYTES = 147456;
constexpr int CW_BAR = 4096;
constexpr size_t CTL_ZERO_BYTES = 64 * 1024;
#define GAS __attribute__((address_space(1)))
#define LAS __attribute__((address_space(3)))
typedef GAS unsigned gu32;
#define RLX_AGENT __ATOMIC_RELAXED, __HIP_MEMORY_SCOPE_AGENT
#define XB_TMO      128
#define XB_XCNT(j)  (256  + 64 * (j))
#define XB_XSUB(j)  (1280 + 64 * (j))
#define XB_XGEN(j)  (2304 + 64 * (j))
#define XB_TOP      3328
#define XB_TOPGEN   3392
#define XCD_BAR_WORDS 3456
#define XB_SPIN_CAP (1u << 18)

__device__ __forceinline__ unsigned xb_ld(unsigned* p)              { return __hip_atomic_load(p, __ATOMIC_RELAXED, __HIP_MEMORY_SCOPE_AGENT); }
__device__ __forceinline__ unsigned xb_add(unsigned* p, unsigned v) { return __hip_atomic_fetch_add(p, v, __ATOMIC_RELAXED, __HIP_MEMORY_SCOPE_AGENT); }
__device__ __forceinline__ unsigned xb_xcc_id() { return (unsigned)__builtin_amdgcn_s_getreg((3 << 11) | 20) & 0xFu; }
#define XB_SPIN(cond, bar) do { unsigned _sp = 0; while (cond) { __builtin_amdgcn_s_sleep(1); \
    if ((++_sp & 255u) == 0u) { if (xb_ld(&(bar)[XB_TMO])) break; if (_sp > XB_SPIN_CAP) { atomicAdd(&(bar)[XB_TMO], 1u); break; } } } } while (0)

struct XcdBarrier {
    unsigned* bar; unsigned x;
    volatile LAS unsigned* st;
};

__device__ __forceinline__ XcdBarrier xcd_barrier_post(unsigned* bar, volatile LAS unsigned* st) {
    XcdBarrier b; b.bar = bar; b.x = xb_xcc_id(); b.st = st;
    if (threadIdx.x == 0) (void)xb_add(&bar[XB_XCNT(b.x)], 1u);
    return b;
}
__device__ __forceinline__ void xcd_barrier_complete(unsigned* bar, unsigned x, unsigned& nloc, unsigned& nx) {
    const unsigned G = gridDim.x * gridDim.y * gridDim.z;
    unsigned sum, cnt, mine, sp = 0u;
    for (;;) {
        sum = 0u; cnt = 0u; mine = 0u;
#pragma unroll
        for (unsigned j = 0; j < 16; ++j) { const unsigned c = xb_ld(&bar[XB_XCNT(j)]); sum += c; cnt += (c > 0u) ? 1u : 0u; mine = (j == x) ? c : mine; }
        if (sum == G) break;
        __builtin_amdgcn_s_sleep(1);
        if ((++sp & 255u) == 0u) { if (xb_ld(&bar[XB_TMO])) break; if (sp > XB_SPIN_CAP) { atomicAdd(&bar[XB_TMO], 1u); break; } }
    }
    nloc = mine > 0u ? mine : 1u; nx = cnt > 0u ? cnt : 1u;
}

__device__ __forceinline__ void xcd_barrier(const XcdBarrier& b) {
    asm volatile("s_waitcnt vmcnt(0)" ::: "memory");
    __syncthreads();
    if (threadIdx.x == 0) {
        unsigned* bar = b.bar;
        __builtin_amdgcn_s_waitcnt(0);
        unsigned nloc = b.st[0], nx = b.st[1];
        if (nloc == 0u) { xcd_barrier_complete(bar, b.x, nloc, nx); b.st[0] = nloc; b.st[1] = nx; }
        const unsigned old = xb_add(&bar[XB_XSUB(b.x)], 1u);
        const unsigned gen = old / nloc;
        if (old + 1u == (gen + 1u) * nloc) {
            __builtin_amdgcn_fence(__ATOMIC_RELEASE, "agent");
            asm volatile("s_waitcnt vmcnt(0)" ::: "memory");
            const unsigned og = xb_add(&bar[XB_TOP], 1u);
            const unsigned tg = og / nx;
            if (og + 1u == (tg + 1u) * nx) xb_add(&bar[XB_TOPGEN], 1u);
            else XB_SPIN(xb_ld(&bar[XB_TOPGEN]) == tg, bar);
            __builtin_amdgcn_fence(__ATOMIC_ACQUIRE, "agent");
            xb_add(&bar[XB_XGEN(b.x)], 1u);
            asm volatile("s_waitcnt vmcnt(0)" ::: "memory");
        } else {
            XB_SPIN(xb_ld(&bar[XB_XGEN(b.x)]) == gen, bar);
            __builtin_amdgcn_fence(__ATOMIC_ACQUIRE, "agent");
            asm volatile("s_waitcnt vmcnt(0)" ::: "memory");
        }
    }
    __syncthreads();
}


#define FILL_RSL(STP) do { pg8::Unit u0_; if (S.next(0, u0_)) { int tq_ = threadIdx.x; asm volatile("" : "+v"(tq_)); const int row_ = u0_.pm * 256 + (tq_ >> 1), hf_ = tq_ & 1; \
    typedef float f32x4_ __attribute__((ext_vector_type(4))); typedef float f32x2_ __attribute__((ext_vector_type(2))); \
    const f32x4_* sp_ = (const f32x4_*)((STP) + (size_t)row_ * 32 + hf_ * 16); const f32x4_ x0 = sp_[0], x1 = sp_[1], x2 = sp_[2], x3 = sp_[3]; \
    float sm_ = ((x0[0] + x0[2]) + (x1[0] + x1[2])) + ((x2[0] + x2[2]) + (x3[0] + x3[2])), sq_ = ((x0[1] + x0[3]) + (x1[1] + x1[3])) + ((x2[1] + x2[3]) + (x3[1] + x3[3])); \
    sm_ = xadd<1>(sm_); sq_ = xadd<1>(sq_); const float mu_ = sm_ * (1.f / 1024.f), rstd_ = rsqrtf(fmaxf(sq_ * (1.f / 1024.f) - mu_ * mu_, 0.f) + EPS); \
    if (hf_ == 0) *(LAS f32x2_*)(ldsl + RSL_OFF + 8 * (tq_ >> 1)) = (f32x2_){rstd_, -rstd_ * mu_}; } \
    __syncthreads(); } while (0)

enum { PH_PRO = 0, PH_IN = 1, PH_ATT = 2, PH_MIXB = 3, PH_OUT = 4, PH_GU = 5, PH_DN = 6, PH_FIN = 13, N_PHASES = 14 };
struct MArgs { const float* in[16]; float* out; unsigned char* ws; int ph_lo, ph_hi, li, pad; };

__global__ void __launch_bounds__(NWAVES * 64, 2) mk_fwd(MArgs a) {
    extern __shared__ __attribute__((aligned(128))) unsigned char lds[];
    LAS unsigned char* ldsl = (LAS unsigned char*)lds;
    volatile LAS unsigned* MISC = (volatile LAS unsigned*)(ldsl + MISC_OFF);
    const int tid = threadIdx.x;
    const int G = gridDim.x, bx = blockIdx.x, vcu = (G % 8 == 0) ? (bx % 8) * (G / 8) + bx / 8 : bx;
    unsigned char* ws = a.ws;
    for (int u = tid; u < (LDS_BYTES - LDSCTL_OFF) / 4; u += NWAVES * 64) ((LAS unsigned*)(ldsl + LDSCTL_OFF))[u] = 0u;
    __syncthreads();
    XcdBarrier bar; bar.bar = (unsigned*)(ws + WS_CTL) + CW_BAR + a.li * XCD_BAR_WORDS; bar.x = 0; bar.st = nullptr;
    if (a.ph_hi - a.ph_lo > 1) bar = xcd_barrier_post((unsigned*)(ws + WS_CTL) + CW_BAR + a.li * XCD_BAR_WORDS, MISC + 8);
    const int G0 = G, bx0 = bx, vcu0 = vcu; unsigned char* const ws0 = ws;
    for (int ph = a.ph_lo; ph < a.ph_hi; ++ph) {
        int G = G0, bx = bx0, vcu = vcu0; unsigned zo = 0u; asm volatile("" : "+s"(G), "+s"(bx), "+s"(vcu), "+s"(zo)); unsigned char* ws = ws0 + zo;
        const int l = (ph >= 1 && ph <= 12) ? (ph - 1) / 6 : 0;
        const int kind = (ph == 0) ? PH_PRO : (ph == PH_FIN ? PH_FIN : 1 + (ph - 1) % 6);
        if (kind == PH_PRO) {
            { pro::Inputs pin{a.in[0], a.in[1], a.in[4], a.in[5], a.in[8], a.in[9], a.in[10], a.in[11], a.in[12], a.in[13], a.in[14], a.in[15]}; pro::prologue(ws, pin, ldsl + RING_OFF, vcu, G); }
        } else if (kind == PH_IN) {
            pg8::Gemm g{(const bf16_t*)(ws + WS_XB), (const bf16_t*)(ws + WS_WIN + l * SZ_WIN), T, NIN, D}; pg8::StaticOrder S; S.init(T, NIN, G, bx);
            if (l) FILL_RSL((const float*)(ws + WS_ST2));
            pg8::FEpiIn E{ws, a.in[6] + l * 256, l, (const LAS float*)(ldsl + RSL_OFF)};
            pg8::gemm_phase<pg8::FEpiIn, pg8::StaticOrder, true, true>(ldsl + RING_OFF, g, S, E);
        } else if (kind == PH_ATT) {
            for (int i = 0; i < 2; ++i) { const int idx = vcu * 2 + i; if (idx >= 512) break; const int bh = idx >> 4, qb = idx & 15;
                att::attn_unit(bh >> 2, bh & 3, qb, (const bf16_t*)(ws + WS_Q), (const bf16_t*)(ws + WS_K), (const bf16_t*)(ws + WS_V), (bf16_t*)(ws + WS_OC), a.in[2] + l * 256, a.in[3] + l * 128, l, (char*)lds + RING_OFF); }
            for (int i = 0; i < 2; ++i) { const int it = vcu * 2 + i; if (it >= 512) break;
                                fft::stage1_item(it >> 6, it & 63, (const bf16_t*)(ws + WS_TAB), (bf16_t*)(ws + WS_XT), ldsl + RING_OFF); }

            if (vcu < 256) gla::gla_a_item(vcu >> 5, (vcu >> 3) & 3, vcu & 7, ws, ldsl + RING_OFF);
        } else if (kind == PH_MIXB) {
            if (vcu < 256) fft::stage2_item(vcu >> 5, vcu & 31, (const bf16_t*)(ws + WS_XT), (bf16_t*)(ws + WS_OC), ldsl + RING_OFF);
            if (vcu < 256) gla::gla_b_item(vcu >> 5, (vcu >> 3) & 3, vcu & 7, ws, a.in[7] + l * 64, (bf16_t*)(ws + WS_OC), ldsl + RING_OFF);
        } else if (kind == PH_OUT) {
            pg8::Gemm g{(const bf16_t*)(ws + WS_OC), (const bf16_t*)(ws + WS_WOUT + l * SZ_WOUT), T, D, D}; pg8::StaticOrder S; S.init(T, D, G, bx);
            if (l) FILL_RSL((const float*)(ws + WS_ST2));
            pg8::FEpiRes E{l ? (const LAS float*)(ldsl + RSL_OFF) : (const LAS float*)nullptr, a.in[14] + (l ? l - 1 : 0) * 1024, a.in[15] + (l ? l - 1 : 0) * 1024, (bf16_t*)(ws + WS_XB), (float*)(ws + WS_ST1)};
            pg8::gemm_phase<pg8::FEpiRes, pg8::StaticOrder, true, true>(ldsl + RING_OFF, g, S, E);
        } else if (kind == PH_GU) {
            pg8::Gemm g{(const bf16_t*)(ws + WS_XB), (const bf16_t*)(ws + WS_WGU + l * SZ_WGU), T, NGU, D}; pg8::StaticOrder S; S.init(T, NGU, G, bx);
            FILL_RSL((const float*)(ws + WS_ST1));
            pg8::FEpiGU E{(const LAS float*)(ldsl + RSL_OFF), (const float*)(ws + V_C1GU) + l * NGU, (const float*)(ws + V_C2GU) + l * NGU, (bf16_t*)(ws + WS_ACT)};
            pg8::gemm_phase<pg8::FEpiGU, pg8::StaticOrder, true, true>(ldsl + RING_OFF, g, S, E);
        } else if (kind == PH_DN) {
            pg8::Gemm g{(const bf16_t*)(ws + WS_ACT), (const bf16_t*)(ws + WS_WDN + l * SZ_WDN), T, D, FF}; pg8::StaticOrder S; S.init(T, D, G, bx);
            FILL_RSL((const float*)(ws + WS_ST1));
            pg8::FEpiRes E{(const LAS float*)(ldsl + RSL_OFF), a.in[9] + l * 1024, a.in[10] + l * 1024, (bf16_t*)(ws + WS_XB), (float*)(ws + WS_ST2)};
            pg8::gemm_phase<pg8::FEpiRes, pg8::StaticOrder, true, true>(ldsl + RING_OFF, g, S, E);
        } else if (kind == PH_FIN) {
            const float* g2 = a.in[14] + 1024; const float* b2v = a.in[15] + 1024; const float* ST2 = (const float*)(ws + WS_ST2); const bf16_t* XB = (const bf16_t*)(ws + WS_XB); float* Y2 = a.out;
            int tid_f = threadIdx.x; asm volatile("" : "+v"(tid_f)); const int lane = tid_f & 63, wave = __builtin_amdgcn_readfirstlane(tid_f >> 6);
            typedef float f32x4 __attribute__((ext_vector_type(4))); typedef unsigned u32x2 __attribute__((ext_vector_type(2)));
            f32x4 gg[4], bq[4];
#pragma unroll
            for (int j = 0; j < 4; ++j) { gg[j] = *((const f32x4*)g2 + lane + 64 * j); bq[j] = *((const f32x4*)b2v + lane + 64 * j); }
            for (int row = vcu * NWAVES + wave; row < T; row += G * NWAVES) { const RowStat rs = row_stat(ST2, row);
                const u32x2* xr = (const u32x2*)(XB + (size_t)row * 1024) + lane; f32x4* yr = (f32x4*)(Y2 + (size_t)row * 1024) + lane;
#pragma unroll
                for (int j = 0; j < 4; ++j) { const u32x2 w = xr[64 * j]; const f32x4 v = {__uint_as_float(w.x << 16), __uint_as_float(w.x & 0xffff0000u), __uint_as_float(w.y << 16), __uint_as_float(w.y & 0xffff0000u)};
                    yr[64 * j] = (v - rs.mu) * rs.rstd * gg[j] + bq[j]; } }
        }
        if (ph + 1 < a.ph_hi) xcd_barrier(bar);
    }
}

static void launch_frame(const MArgs& base, int lo, int hi, int grid, hipStream_t stream, int li = 0) {
    MArgs a = base; a.ph_lo = lo; a.ph_hi = hi; a.li = li;
    hipLaunchKernelGGL(mk_fwd, dim3(grid), dim3(NWAVES * 64), LDS_BYTES, stream, a);
}
extern "C" void kernel_launch(void* const* d_in, const int* in_sizes, int n_in, void* d_out, int out_size, void* d_ws, size_t ws_size, hipStream_t stream) {
    static int grid = 0;
    if (grid == 0) {
        if (n_in != 16 || in_sizes[0] != T * D || out_size != T * D || ws_size < WS_END) { fprintf(stderr, "kernel_launch: unexpected shapes (n_in %d, in0 %d, out %d, ws %zu)\n", n_in, n_in > 0 ? in_sizes[0] : -1, out_size, ws_size); grid = -1; return; }
        int dev = 0, cus = 0, per_cu = 0;
        if (hipGetDevice(&dev) != hipSuccess || hipDeviceGetAttribute(&cus, hipDeviceAttributeMultiprocessorCount, dev) != hipSuccess) { grid = -1; return; }
        if (hipFuncSetAttribute((const void*)mk_fwd, hipFuncAttributeMaxDynamicSharedMemorySize, LDS_BYTES) != hipSuccess) { fprintf(stderr, "kernel_launch: hipFuncSetAttribute failed\n"); grid = -1; return; }
        if (hipOccupancyMaxActiveBlocksPerMultiprocessor(&per_cu, (const void*)mk_fwd, NWAVES * 64, LDS_BYTES) != hipSuccess || per_cu < 1) { fprintf(stderr, "kernel_launch: occupancy query says %d workgroups per CU\n", per_cu); per_cu = 1; }
        (void)hipGetLastError();
        grid = cus;
        if (grid != 256) { fprintf(stderr, "kernel_launch: this kernel's work split is built for the 256 CUs of an MI355X, found %d; nothing launched\n", cus); grid = -1; return; }
    }
    if (grid < 0) return;
    const float* x = (const float*)d_in[0]; const float* w_in = (const float*)d_in[1]; const float* dlam = (const float*)d_in[2]; const float* dng = (const float*)d_in[3];
    const float* fw = (const float*)d_in[4]; const float* gw2 = (const float*)d_in[5]; const float* gb2 = (const float*)d_in[6]; const float* gng = (const float*)d_in[7];
    const float* w_out = (const float*)d_in[8]; const float* ln1g = (const float*)d_in[9]; const float* ln1b = (const float*)d_in[10];
    const float* wg = (const float*)d_in[11]; const float* wu = (const float*)d_in[12]; const float* wd = (const float*)d_in[13]; const float* ln2g = (const float*)d_in[14]; const float* ln2b = (const float*)d_in[15];
    char* ws = (char*)d_ws;
    float* ropec = (float*)(ws + V_ROPEC); float* ropes = (float*)(ws + V_ROPES); float* MF = (float*)(ws + V_MF);
    float* c1in = (float*)(ws + V_C1IN); float* c2in = (float*)(ws + V_C2IN); float* c1gu = (float*)(ws + V_C1GU); float* c2gu = (float*)(ws + V_C2GU);
    bf16_t* TAB = (bf16_t*)(ws + WS_TAB); bf16_t* XB = (bf16_t*)(ws + WS_XB);
    bf16_t* Q = (bf16_t*)(ws + WS_Q); bf16_t* K = (bf16_t*)(ws + WS_K); bf16_t* V = (bf16_t*)(ws + WS_V);
    bf16_t* GQK = (bf16_t*)(ws + WS_GQK); bf16_t* GV = (bf16_t*)(ws + WS_GV); bf16_t* GR = (bf16_t*)(ws + WS_GR); float* GL = (float*)(ws + WS_GL);
    bf16_t* OC = (bf16_t*)(ws + WS_OC); float* OF = (float*)(ws + WS_OF);
    (void)hipMemsetAsync(ws + WS_CTL, 0, CTL_ZERO_BYTES, stream);
    MArgs base{}; for (int i = 0; i < 16; ++i) base.in[i] = (const float*)d_in[i]; base.out = (float*)d_out; base.ws = (unsigned char*)d_ws;
    launch_frame(base, 0, N_PHASES, grid, stream, 0);
}
```

```cpp
#include <hip/hip_runtime.h>
#include <cstdint>
#include <cstdio>
#include <cmath>

typedef unsigned short bf16_t;
namespace cfg {
constexpr int B = 8, S = 2048, D = 1024, T = B * S, L = 2;
constexpr int INW = 2592, NIN = 3072, FF = 2816, NGU = 2 * FF;
constexpr float ALPHA = 1.41421356237309515f;
constexpr float EPS = 1e-5f;
constexpr float QSCALE = 0.125f * 1.4426950408889634f;
constexpr float GQSCALE = 0.17677669529663687f;
constexpr size_t MiB = 1u << 20;
constexpr size_t WS_CTL = 0;
constexpr size_t WS_VEC = 1 * MiB;
constexpr size_t V_ROPEC = WS_VEC, V_ROPES = WS_VEC + 256 * 1024, V_MF = WS_VEC + 512 * 1024;
constexpr size_t V_C1IN = WS_VEC + 768 * 1024, V_C2IN = V_C1IN + 24 * 1024, V_C1GU = V_C2IN + 24 * 1024, V_C2GU = V_C1GU + 44 * 1024;
constexpr size_t WS_WIN = 2 * MiB, WS_WOUT = 14 * MiB, WS_WGU = 18 * MiB, WS_WDN = 40 * MiB, WS_TAB = 51 * MiB;
constexpr size_t SZ_WIN = 6 * MiB, SZ_WOUT = 2 * MiB, SZ_WGU = 11 * MiB, SZ_WDN = 5632 * 1024;
constexpr size_t WS_XB = 67 * MiB;
constexpr size_t WS_Y1 = 99 * MiB, WS_Q = 99 * MiB, WS_K = 115 * MiB, WS_V = 131 * MiB, WS_XT = 147 * MiB;
constexpr size_t WS_ACT = 163 * MiB, WS_GQK = 163 * MiB, WS_GV = 171 * MiB, WS_GR = 179 * MiB, WS_GL = 187 * MiB, WS_OC = 203 * MiB, WS_OF = 235 * MiB;
constexpr size_t WS_ST1 = 251 * MiB, WS_ST2 = 253 * MiB, WS_DEC = 255 * MiB, WS_END = 256 * MiB;
}
using namespace cfg;

__device__ __forceinline__ float bf2f(bf16_t v) { return __uint_as_float((unsigned)v << 16); }
__device__ __forceinline__ bf16_t f2bf(float f) { unsigned u = __float_as_uint(f); return (bf16_t)((u + 0x7fffu + ((u >> 16) & 1u)) >> 16); }


template <int M> __device__ __forceinline__ float xadd(float v) {
    if constexpr (M == 32) { auto r = __builtin_amdgcn_permlane32_swap(__float_as_uint(v), __float_as_uint(v), false, false); return __uint_as_float(r[0]) + __uint_as_float(r[1]); }
    else return v + __int_as_float(__builtin_amdgcn_ds_swizzle(__float_as_int(v), (M << 10) | 0x1f));
}
struct RowStat { float mu, rstd; };
__device__ __forceinline__ RowStat row_stat(const float* ST, int row) {
    float s = 0.f, ss = 0.f;
    for (int i = 0; i < 8; ++i) { const float4 a = *(const float4*)(ST + (size_t)row * 32 + 4 * i); s += a.x + a.z; ss += a.y + a.w; }
    const float mu = s * (1.f / 1024.f); const float var = ss * (1.f / 1024.f) - mu * mu;
    RowStat r; r.mu = mu; r.rstd = rsqrtf(fmaxf(var, 0.f) + EPS); return r;
}
namespace pg8 {
#define PG8_LAS __attribute__((address_space(3)))
typedef unsigned short bf16_t;
typedef short bf16x8 __attribute__((ext_vector_type(8)));
typedef float f32x4 __attribute__((ext_vector_type(4)));
typedef unsigned u32x4 __attribute__((ext_vector_type(4)));
constexpr int BM = 256, BK = 64, HALF = 128, HTB = HALF * BK * 2  , STAGE_BYTES = 8 * HTB, NXCD = 8, WGM = 8;

__host__ __device__ __forceinline__ int lds_byte(int r, int c) { const int st = (r >> 4) * 2 + (c >> 5), rr = r & 15, cc = c & 31, ob = rr * 64 + cc * 2; return st * 1024 + (ob ^ (((ob >> 9) & 1) << 5)); }
__host__ __device__ __forceinline__ void stage_rc(int b, int& R, int& C) { const int st = b / 1024, sb = b % 1024, swz = sb ^ (((sb >> 9) & 1) << 5); R = (st >> 1) * 16 + swz / 64; C = (st & 1) * 32 + (swz % 64) / 2; }
__host__ __device__ __forceinline__ int perm32(int rho) { const int n = rho >> 4, i = rho & 15; return 8 * (i >> 2) + 4 * n + (i & 3); }

struct Unit { int pm, pn; };
struct Gemm { const bf16_t* A; const bf16_t* Bt; int M, N, K; };

struct StaticOrder {
    int nM, nN, nwg, G, c;
    __host__ __device__ void init(int M, int N, int G_, int c_) { nM = M / BM; nN = N / BM; nwg = nM * nN; G = G_; c = c_; }
    __host__ __device__ bool next(int i, Unit& u) const {
        const long L = (long)i * G + c; if (L >= nwg) return false;
        int wgid = (int)L; { const int q = nwg / NXCD, r = nwg % NXCD, xcd = wgid % NXCD, off = wgid / NXCD; wgid = (xcd < r ? xcd * (q + 1) : r * (q + 1) + (xcd - r) * q) + off; }
        const int nig = WGM * nN, gid = wgid / nig, fm = gid * WGM, gsz = (nM - fm) < WGM ? (nM - fm) : WGM;
        u.pm = fm + ((wgid % nig) % gsz); u.pn = (wgid % nig) / gsz; return true;
    }
    __device__ __forceinline__ void a_ready(const Unit&) const {}
    __device__ __forceinline__ void done(const Unit&) const {}
};
template <class Epi, class Sched, bool ALIGN_EPI = false, bool SP2 = false>
__device__ __forceinline__ void gemm_phase(PG8_LAS unsigned char* lds, const Gemm g, const Sched& S, const Epi& E) {
    int tid_o = threadIdx.x; asm volatile("" : "+v"(tid_o));
    const int tid = tid_o, wid = __builtin_amdgcn_readfirstlane(tid >> 6), lane = tid & 63, wr = wid >> 2, wc = wid & 3, fr = lane & 15, fq = lane >> 4;
    const int K = g.K, nt = K / BK;
    unsigned voffA[2], voffB[2];
#pragma unroll
    for (int i = 0; i < 2; ++i) { int R, C; stage_rc(tid * 16 + i * 8192, R, C); const int Rb = Epi::PERM ? ((R & ~31) + perm32(R & 31)) : R;
        voffA[i] = (unsigned)(R * K + C) * 2u; voffB[i] = (unsigned)(Rb * K + C) * 2u; }
    const size_t kstep = (size_t)(BK * 2);
    const size_t hstep = (size_t)HALF * K * 2;
    const size_t tstep = 2 * hstep;
    const unsigned ldsw = (unsigned)wid * 1024u;
    const int aoff = lds_byte(wr * 64 + fr, fq * 8), boff = lds_byte(wc * 32 + fr, fq * 8);
#define PG8_SA(b, h) (((b) * 2 + (h)) * HTB)
#define PG8_SB(b, h) ((4 + (b) * 2 + (h)) * HTB)
#define PG8_STAGE(bufoff, gbase, voff) do { _Pragma("unroll") for (int _i = 0; _i < 2; ++_i) \
        __builtin_amdgcn_global_load_lds((const unsigned*)((const char*)(gbase) + (voff)[_i]), (PG8_LAS unsigned*)(lds + (bufoff) + ldsw + _i * 8192), 16, 0, 0); } while (0)
#define PG8_LDA(dst, b, h) do { _Pragma("unroll") for (int m = 0; m < 4; ++m) _Pragma("unroll") for (int k = 0; k < 2; ++k) dst[m][k] = *(const PG8_LAS bf16x8*)(lds + PG8_SA(b, h) + aoff + m * 2048 + k * 1024); } while (0)
#define PG8_LDB(dst, b, h) do { _Pragma("unroll") for (int n = 0; n < 2; ++n) _Pragma("unroll") for (int k = 0; k < 2; ++k) dst[n][k] = *(const PG8_LAS bf16x8*)(lds + PG8_SB(b, h) + boff + n * 2048 + k * 1024); } while (0)
#define PG8_MMA(ai, bj, At, Bt) do { __builtin_amdgcn_s_setprio(1); _Pragma("unroll") for (int m = 0; m < 4; ++m) _Pragma("unroll") for (int n = 0; n < 2; ++n) _Pragma("unroll") for (int k = 0; k < 2; ++k) \
        acc[ai][bj][m][n] = __builtin_amdgcn_mfma_f32_16x16x32_bf16(Bt[n][k], At[m][k], acc[ai][bj][m][n], 0, 0, 0); __builtin_amdgcn_s_setprio(0); } while (0)
#define PG8_WAIT_V(n) asm volatile("s_waitcnt vmcnt(" #n ")" ::: "memory")
#define PG8_WAIT_L(n) asm volatile("s_waitcnt lgkmcnt(" #n ")" ::: "memory")
#define PG8_BAR __builtin_amdgcn_s_barrier()
#define PG8_SCHED __builtin_amdgcn_sched_barrier(0)
    Unit cur, nxt; int ui = 0;
    if (!S.next(0, cur)) return;
    f32x4 acc[2][2][4][2];
#pragma unroll
    for (int a = 0; a < 2; ++a)
#pragma unroll
        for (int b = 0; b < 2; ++b)
#pragma unroll
            for (int m = 0; m < 4; ++m)
#pragma unroll
                for (int n = 0; n < 2; ++n) acc[a][b][m][n] = (f32x4){0.f, 0.f, 0.f, 0.f};
    bf16x8 At[4][2], B0[2][2], B1[2][2];
    const char* cA = (const char*)g.A + (size_t)cur.pm * tstep; const char* cB = (const char*)g.Bt + (size_t)cur.pn * tstep;
    S.a_ready(cur);
    if constexpr (SP2) {
        PG8_STAGE(PG8_SB(0, 0), cB, voffB); PG8_STAGE(PG8_SB(0, 1), cB + hstep, voffB); PG8_STAGE(PG8_SA(0, 0), cA, voffA); PG8_STAGE(PG8_SA(0, 1), cA + hstep, voffA);
        if (wr == 1) PG8_BAR;
        PG8_WAIT_V(2); PG8_BAR;
        PG8_STAGE(PG8_SB(1, 0), cB + kstep, voffB); PG8_STAGE(PG8_SA(1, 0), cA + kstep, voffA); PG8_STAGE(PG8_SB(1, 1), cB + hstep + kstep, voffB);
        PG8_WAIT_V(6); PG8_BAR;
    } else {
        PG8_STAGE(PG8_SB(0, 0), cB, voffB); PG8_STAGE(PG8_SA(0, 0), cA, voffA); PG8_STAGE(PG8_SB(0, 1), cB + hstep, voffB); PG8_STAGE(PG8_SA(0, 1), cA + hstep, voffA);
        if (wr == 1) PG8_BAR;
        PG8_WAIT_V(4); PG8_BAR;
        PG8_STAGE(PG8_SB(1, 0), cB + kstep, voffB); PG8_STAGE(PG8_SA(1, 0), cA + kstep, voffA); PG8_STAGE(PG8_SB(1, 1), cB + hstep + kstep, voffB);
        PG8_WAIT_V(6); PG8_BAR;
    }
    for (;;) {
        const bool has_next = S.next(ui + 1, nxt);
        const char* nA = has_next ? (const char*)g.A + (size_t)nxt.pm * tstep : cA; const char* nB = has_next ? (const char*)g.Bt + (size_t)nxt.pn * tstep : cB;
        for (int t = 0; t < nt; t += 2) {
            const bool last = (t == nt - 2);
            const char* a1 = cA + (size_t)(t + 1) * kstep;
            const char* a2 = last ? nA : cA + (size_t)(t + 2) * kstep; const char* b2 = last ? nB : cB + (size_t)(t + 2) * kstep;
            const char* a3 = a2 + kstep; const char* b3 = b2 + kstep;
            if (last && has_next) S.a_ready(nxt);
            if constexpr (SP2) {
            PG8_LDB(B0, 0, 0); PG8_LDB(B1, 0, 1); PG8_SCHED; PG8_LDA(At, 0, 0); PG8_STAGE(PG8_SA(1, 1), a1 + hstep, voffA);
            PG8_WAIT_V(8); PG8_WAIT_L(0); PG8_BAR; PG8_MMA(0, 0, At, B0); PG8_MMA(0, 1, At, B1); PG8_BAR; PG8_SCHED;
            PG8_LDA(At, 0, 1); PG8_STAGE(PG8_SB(0, 0), b2, voffB); PG8_STAGE(PG8_SB(0, 1), b2 + hstep, voffB); PG8_STAGE(PG8_SA(0, 0), a2, voffA);
            PG8_WAIT_V(8); PG8_WAIT_L(0); PG8_BAR; PG8_MMA(1, 0, At, B0); PG8_MMA(1, 1, At, B1); PG8_BAR; PG8_SCHED;
            PG8_LDB(B0, 1, 0); PG8_LDB(B1, 1, 1); PG8_SCHED; PG8_LDA(At, 1, 0); PG8_STAGE(PG8_SA(0, 1), a2 + hstep, voffA);
            PG8_WAIT_V(8); PG8_WAIT_L(0); PG8_BAR; PG8_MMA(0, 0, At, B0); PG8_MMA(0, 1, At, B1); PG8_BAR; PG8_SCHED;
            PG8_LDA(At, 1, 1); PG8_STAGE(PG8_SB(1, 0), b3, voffB); PG8_STAGE(PG8_SB(1, 1), b3 + hstep, voffB); PG8_STAGE(PG8_SA(1, 0), a3, voffA);
            PG8_WAIT_V(8); PG8_WAIT_L(0); PG8_BAR; PG8_MMA(1, 0, At, B0); PG8_MMA(1, 1, At, B1); PG8_BAR; PG8_SCHED;
            } else {
            PG8_LDB(B0, 0, 0); PG8_SCHED; PG8_LDA(At, 0, 0); PG8_STAGE(PG8_SA(1, 1), a1 + hstep, voffA);
            PG8_WAIT_L(8); PG8_BAR; PG8_WAIT_L(0); PG8_MMA(0, 0, At, B0); PG8_BAR; PG8_SCHED;
            PG8_LDB(B1, 0, 1); PG8_STAGE(PG8_SB(0, 0), b2, voffB);
            PG8_BAR; PG8_WAIT_L(0); PG8_MMA(0, 1, At, B1); PG8_BAR;
            PG8_LDA(At, 0, 1); PG8_STAGE(PG8_SA(0, 0), a2, voffA);
            PG8_BAR; PG8_WAIT_L(0); PG8_MMA(1, 0, At, B0); PG8_BAR; PG8_SCHED;
            PG8_STAGE(PG8_SB(0, 1), b2 + hstep, voffB);
            PG8_WAIT_V(6); PG8_BAR; PG8_MMA(1, 1, At, B1); PG8_BAR;
            PG8_LDB(B0, 1, 0); PG8_SCHED; PG8_LDA(At, 1, 0); PG8_STAGE(PG8_SA(0, 1), a2 + hstep, voffA);
            PG8_WAIT_L(8); PG8_BAR; PG8_WAIT_L(0); PG8_MMA(0, 0, At, B0); PG8_BAR; PG8_SCHED;
            PG8_LDB(B1, 1, 1); PG8_STAGE(PG8_SB(1, 0), b3, voffB);
            PG8_BAR; PG8_WAIT_L(0); PG8_MMA(0, 1, At, B1); PG8_BAR;
            PG8_LDA(At, 1, 1); PG8_STAGE(PG8_SA(1, 0), a3, voffA);
            PG8_BAR; PG8_WAIT_L(0); PG8_MMA(1, 0, At, B0); PG8_BAR; PG8_SCHED;
            PG8_STAGE(PG8_SB(1, 1), b3 + hstep, voffB);
            PG8_WAIT_V(6); PG8_BAR; PG8_MMA(1, 1, At, B1); PG8_BAR;
            }
        }
        if constexpr (ALIGN_EPI) { if (wr == 0) PG8_BAR; }
        if constexpr (!Epi::AFTER_DRAIN) { E(acc, cur, wr, wc, fr, fq); S.done(cur); }
        if (!has_next) break;
#pragma unroll
        for (int a = 0; a < 2; ++a)
#pragma unroll
            for (int b = 0; b < 2; ++b)
#pragma unroll
                for (int m = 0; m < 4; ++m)
#pragma unroll
                    for (int n = 0; n < 2; ++n) acc[a][b][m][n] = (f32x4){0.f, 0.f, 0.f, 0.f};
        cur = nxt; cA = nA; cB = nB; ++ui;
        if constexpr (ALIGN_EPI) { if (wr == 1) PG8_BAR; }
    }
    PG8_WAIT_V(0);
    if constexpr (!ALIGN_EPI) { if (wr == 0) PG8_BAR; }
    PG8_BAR;
    if constexpr (Epi::AFTER_DRAIN) { E.fused(acc, cur, wr, wc, fr, fq, lds, wid, lane); S.done(cur); }
#undef PG8_SA
#undef PG8_SB
#undef PG8_STAGE
#undef PG8_LDA
#undef PG8_LDB
#undef PG8_MMA
#undef PG8_WAIT_V
#undef PG8_WAIT_L
#undef PG8_BAR
#undef PG8_SCHED
}
}
namespace pg8 {
__device__ __forceinline__ unsigned cvt_pk_bf16(float lo, float hi) { unsigned r; asm volatile("v_cvt_pk_bf16_f32 %0, %1, %2" : "=v"(r) : "v"(lo), "v"(hi)); return r; }
__device__ __forceinline__ void st8(bf16_t* p, const f32x4 a, const f32x4 b) { u32x4 w; w.x = cvt_pk_bf16(a[0], a[1]); w.y = cvt_pk_bf16(a[2], a[3]); w.z = cvt_pk_bf16(b[0], b[1]); w.w = cvt_pk_bf16(b[2], b[3]); *(u32x4*)p = w; }
__device__ __forceinline__ void st8nt(bf16_t* p, const f32x4 a, const f32x4 b) { u32x4 w; w.x = cvt_pk_bf16(a[0], a[1]); w.y = cvt_pk_bf16(a[2], a[3]); w.z = cvt_pk_bf16(b[0], b[1]); w.w = cvt_pk_bf16(b[2], b[3]); __builtin_nontemporal_store(w, (u32x4*)p); }
struct RS { float a, b; };
struct StatLd { f32x4 x, y; };
__device__ __forceinline__ StatLd stat_load(const float* ST, int row, int fq) { const f32x4* p = (const f32x4*)(ST + (size_t)row * 32 + fq * 8); StatLd r; r.x = p[0]; r.y = p[1]; return r; }
__device__ __forceinline__ RS stat_fin(const StatLd& t) {
    float s = (t.x[0] + t.x[2]) + (t.y[0] + t.y[2]), ss = (t.x[1] + t.x[3]) + (t.y[1] + t.y[3]);
    s = xadd<16>(s); ss = xadd<16>(ss); s = xadd<32>(s); ss = xadd<32>(ss);
    const float mu = s * (1.f / 1024.f), var = ss * (1.f / 1024.f) - mu * mu, rstd = rsqrtf(fmaxf(var, 0.f) + cfg::EPS);
    RS r; r.a = rstd; r.b = -rstd * mu; return r;
}
__device__ __forceinline__ RS row_stat16(const float* ST, int row, int fq) { return stat_fin(stat_load(ST, row, fq)); }
__device__ __forceinline__ float fsilu(float x) { return x * __builtin_amdgcn_rcpf(1.f + __expf(-x)); }
__device__ __forceinline__ float flogsig16(float x) { return (fminf(x, 0.f) - __logf(1.f + __expf(-fabsf(x)))) * (1.f / 16.f); }

struct FEpiIn {
    static constexpr bool PERM = true, AFTER_DRAIN = false;
    unsigned char* ws; const float* b2; int l; const PG8_LAS float* rsl;
    struct RowLd { f32x4 rc[2], rsn[2]; };
    template <int KIND> __device__ __forceinline__ RowLd load_row(int row, int fq) const {
        RowLd r;
        if constexpr (KIND == 0) { const int pos = row & 2047; const float* cp = (const float*)(ws + cfg::V_ROPEC) + pos * 32 + 8 * fq; const float* sp = (const float*)(ws + cfg::V_ROPES) + pos * 32 + 8 * fq;
            r.rc[0] = *(const f32x4*)cp; r.rc[1] = *(const f32x4*)(cp + 4); r.rsn[0] = *(const f32x4*)sp; r.rsn[1] = *(const f32x4*)(sp + 4); }
        return r;
    }
    template <int KIND> __device__ __forceinline__ void rows(const f32x4 (&acc)[2][2][4][2], const Unit& u, int wr, int wc, int fr, int fq) const {
        const int pn = u.pn, cw = 32 * wc + 8 * fq, row0 = u.pm * BM + 64 * wr + fr;
        const bool st = l != 0;
        f32x4 k1[2][2], k2[2][2], bias[2][2];
        const float qs = __uint_as_float(__builtin_amdgcn_readfirstlane(__float_as_uint(pn < 2 ? cfg::QSCALE : 1.f)));
        RowLd cur = load_row<KIND>(row0, fq), nxt;
        if (st) {
#pragma unroll
            for (int bj = 0; bj < 2; ++bj)
#pragma unroll
                for (int n = 0; n < 2; ++n) {
                    if constexpr (KIND == 2) {
                        const float* fp = (const float*)(ws + cfg::V_MF) + (size_t)(l * 8) * 512 + (pn - 6) * 256 + cw + 128 * bj + 4 * n;
                        k1[bj][n] = (*(const f32x4*)fp + *(const f32x4*)(fp + 1024)) + (*(const f32x4*)(fp + 2048) + *(const f32x4*)(fp + 3072));
                        k2[bj][n] = (*(const f32x4*)(fp + 512) + *(const f32x4*)(fp + 1536)) + (*(const f32x4*)(fp + 2560) + *(const f32x4*)(fp + 3584));
                    } else { const float* c1 = (const float*)(ws + cfg::V_C1IN) + l * cfg::NIN + pn * 256 + cw; const float* c2 = (const float*)(ws + cfg::V_C2IN) + l * cfg::NIN + pn * 256 + cw;
                        k1[bj][n] = *(const f32x4*)(c1 + 128 * bj + 4 * n); k2[bj][n] = *(const f32x4*)(c2 + 128 * bj + 4 * n); } } }
        if constexpr (KIND == 6) {
#pragma unroll
            for (int bj = 0; bj < 2; ++bj)
#pragma unroll
                for (int n = 0; n < 2; ++n) bias[bj][n] = *(const f32x4*)(b2 + 128 * bj + cw + 4 * n); }
#pragma unroll
        for (int i = 0; i < 8; ++i) {
            const int ai = i >> 2, m = i & 3, row = row0 + 128 * ai + 16 * m, pos = row & 2047;
            if (i < 7) nxt = load_row<KIND>(row0 + 128 * ((i + 1) >> 2) + 16 * ((i + 1) & 3), fq);
            f32x4 v[2][2];
            if (st) { typedef float f32x2 __attribute__((ext_vector_type(2))); const f32x2 t2 = *(const PG8_LAS f32x2*)(rsl + 2 * (128 * ai + 64 * wr + 16 * m + fr)); RS rs; rs.a = t2[0]; rs.b = t2[1];
#pragma unroll
                for (int bj = 0; bj < 2; ++bj)
#pragma unroll
                    for (int n = 0; n < 2; ++n) v[bj][n] = rs.a * acc[ai][bj][m][n] + (rs.b * k1[bj][n] + k2[bj][n]);
            } else {
#pragma unroll
                for (int bj = 0; bj < 2; ++bj)
#pragma unroll
                    for (int n = 0; n < 2; ++n) v[bj][n] = acc[ai][bj][m][n]; }
            if constexpr (KIND == 0) {
                f32x4 a0 = v[0][0] * cur.rc[0] - v[1][0] * cur.rsn[0], a1 = v[0][1] * cur.rc[1] - v[1][1] * cur.rsn[1];
                f32x4 b0 = v[1][0] * cur.rc[0] + v[0][0] * cur.rsn[0], b1 = v[1][1] * cur.rc[1] + v[0][1] * cur.rsn[1];
                a0 = a0 * qs; a1 = a1 * qs; b0 = b0 * qs; b1 = b1 * qs;
                bf16_t* dst = (bf16_t*)(ws + (pn < 2 ? cfg::WS_Q : cfg::WS_K)) + (size_t)row * 512 + (4 * (pn & 1) + wc) * 64 + 8 * fq;
                st8(dst, a0, a1); st8(dst + 32, b0, b1);
            } else if constexpr (KIND == 1) {
                bf16_t* dst = (bf16_t*)(ws + cfg::WS_V) + (size_t)row * 512 + (pn - 4) * 256 + cw; st8(dst, v[0][0], v[0][1]); st8(dst + 128, v[1][0], v[1][1]);
            } else if constexpr (KIND == 2) {
                bf16_t* dst = (bf16_t*)(ws + cfg::WS_TAB) + (size_t)row * 512 + (pn - 6) * 256 + cw; st8(dst, v[0][0], v[0][1]); st8(dst + 128, v[1][0], v[1][1]);
            } else if constexpr (KIND == 3) {
                bf16_t* dst = (bf16_t*)(ws + cfg::WS_GQK) + (size_t)row * 256 + cw; st8(dst, v[0][0] * cfg::GQSCALE, v[0][1] * cfg::GQSCALE); st8(dst + 128, v[1][0], v[1][1]);
            } else if constexpr (KIND == 4) {
                bf16_t* dst = (bf16_t*)(ws + cfg::WS_GV) + (size_t)row * 256 + cw; st8(dst, v[0][0], v[0][1]); st8(dst + 128, v[1][0], v[1][1]);
            } else if constexpr (KIND == 5) {
                bf16_t* dst = (bf16_t*)(ws + cfg::WS_GR) + (size_t)row * 256 + cw;
#pragma unroll
                for (int bj = 0; bj < 2; ++bj) { f32x4 x0 = v[bj][0], x1 = v[bj][1];
#pragma unroll
                    for (int e = 0; e < 4; ++e) { x0[e] = fsilu(x0[e]); x1[e] = fsilu(x1[e]); } st8(dst + 128 * bj, x0, x1); }
            } else {
                float* dst = (float*)(ws + cfg::WS_GL) + (size_t)row * 256 + cw;
#pragma unroll
                for (int bj = 0; bj < 2; ++bj)
#pragma unroll
                    for (int n = 0; n < 2; ++n) { f32x4 x = v[bj][n] + bias[bj][n];
#pragma unroll
                        for (int e = 0; e < 4; ++e) x[e] = flogsig16(x[e]); *(f32x4*)(dst + 128 * bj + 4 * n) = x; }
            }
            if (i < 7) cur = nxt;
        }
    }
    __device__ __forceinline__ void operator()(const f32x4 (&acc)[2][2][4][2], const Unit& u, int wr, int wc, int fr, int fq) const {
        asm volatile("" : "+v"(fr), "+v"(fq));
        unsigned zo = 0u; asm volatile("" : "+s"(zo)); FEpiIn me = *this; me.ws = ws + zo;
        const int pn = u.pn;
        if (pn < 4) me.rows<0>(acc, u, wr, wc, fr, fq); else if (pn < 6) me.rows<1>(acc, u, wr, wc, fr, fq); else if (pn < 8) me.rows<2>(acc, u, wr, wc, fr, fq);
        else if (pn == 8) me.rows<3>(acc, u, wr, wc, fr, fq); else if (pn == 9) me.rows<4>(acc, u, wr, wc, fr, fq); else if (pn == 10) me.rows<5>(acc, u, wr, wc, fr, fq); else me.rows<6>(acc, u, wr, wc, fr, fq);
    }
};
struct FEpiRes {
    static constexpr bool PERM = true, AFTER_DRAIN = false;
    const PG8_LAS float* stprev;
    const float* g; const float* bb; bf16_t* XB; float* ST;
    struct RowLd { u32x4 xb[2]; };
    __device__ __forceinline__ RowLd load_row(int row, int col0, int fq) const {
        RowLd r; const size_t off = (size_t)row * 1024 + col0;
        r.xb[0] = *(const u32x4*)(XB + off); r.xb[1] = *(const u32x4*)(XB + off + 128);
        return r;
    }
    __device__ __forceinline__ void operator()(const f32x4 (&acc)[2][2][4][2], const Unit& u, int wr, int wc, int fr, int fq) const {
        asm volatile("" : "+v"(fr), "+v"(fq));
        const int col0 = u.pn * BM + 32 * wc + 8 * fq, row0 = u.pm * BM + 64 * wr + fr;
        f32x4 gv[2][2], bv[2][2];
        RowLd cur = load_row(row0, col0, fq), nxt;
        if (stprev) {
#pragma unroll
            for (int bj = 0; bj < 2; ++bj)
#pragma unroll
                for (int n = 0; n < 2; ++n) { gv[bj][n] = *(const f32x4*)(g + col0 + 128 * bj + 4 * n); bv[bj][n] = *(const f32x4*)(bb + col0 + 128 * bj + 4 * n); } }
#pragma unroll
        for (int i = 0; i < 8; ++i) { const int ai = i >> 2, m = i & 3, row = row0 + 128 * ai + 16 * m; const size_t off = (size_t)row * 1024 + col0;
            if (i < 7) nxt = load_row(row0 + 128 * ((i + 1) >> 2) + 16 * ((i + 1) & 3), col0, fq);
            RS rs; rs.a = 1.f; rs.b = 0.f; if (stprev) { typedef float f32x2 __attribute__((ext_vector_type(2))); const f32x2 t2 = *(const PG8_LAS f32x2*)(stprev + 2 * (128 * ai + 64 * wr + 16 * m + fr)); rs.a = t2[0]; rs.b = t2[1]; }
            float s = 0.f, ss = 0.f;
#pragma unroll
            for (int bj = 0; bj < 2; ++bj) { f32x4 y[2];
#pragma unroll
                for (int n = 0; n < 2; ++n) { const unsigned w0 = cur.xb[bj][2 * n], w1 = cur.xb[bj][2 * n + 1];
                    f32x4 x = (f32x4){__uint_as_float(w0 << 16), __uint_as_float(w0 & 0xffff0000u), __uint_as_float(w1 << 16), __uint_as_float(w1 & 0xffff0000u)};
                    if (stprev) x = (rs.a * x + rs.b) * gv[bj][n] + bv[bj][n];
                    y[n] = cfg::ALPHA * x + acc[ai][bj][m][n];
                    s += (y[n][0] + y[n][1]) + (y[n][2] + y[n][3]); ss += (y[n][0] * y[n][0] + y[n][1] * y[n][1]) + (y[n][2] * y[n][2] + y[n][3] * y[n][3]); }
                st8nt(XB + off + 128 * bj, y[0], y[1]); }
            s = xadd<16>(s); ss = xadd<16>(ss); s = xadd<32>(s); ss = xadd<32>(ss);
            if (fq == 0) { typedef float f32x2 __attribute__((ext_vector_type(2))); *(f32x2*)(ST + (size_t)row * 32 + (u.pn * 4 + wc) * 2) = (f32x2){s, ss}; }
            if (i < 7) cur = nxt; }
    }
};
struct FEpiGU {
    static constexpr bool PERM = true, AFTER_DRAIN = false;
    const PG8_LAS float* rsl;
    const float* c1; const float* c2; bf16_t* ACT;
    __device__ __forceinline__ void operator()(const f32x4 (&acc)[2][2][4][2], const Unit& u, int wr, int wc, int fr, int fq) const {
        asm volatile("" : "+v"(fr), "+v"(fq));
        const int cw = 32 * wc + 8 * fq, row0 = u.pm * BM + 64 * wr + fr; const float* c1p = c1 + u.pn * 256 + cw; const float* c2p = c2 + u.pn * 256 + cw;
        typedef float f32x2 __attribute__((ext_vector_type(2)));
        f32x4 k1[2][2], k2[2][2];
#pragma unroll
        for (int bj = 0; bj < 2; ++bj)
#pragma unroll
            for (int n = 0; n < 2; ++n) { k1[bj][n] = *(const f32x4*)(c1p + 128 * bj + 4 * n); k2[bj][n] = *(const f32x4*)(c2p + 128 * bj + 4 * n); }
#pragma unroll
        for (int i = 0; i < 8; ++i) { const int ai = i >> 2, m = i & 3; const f32x2 rs = *(const PG8_LAS f32x2*)(rsl + 2 * (128 * ai + 64 * wr + 16 * m + fr)); f32x4 a[2];
#pragma unroll
            for (int n = 0; n < 2; ++n) { const f32x4 hg = rs[0] * acc[ai][0][m][n] + (rs[1] * k1[0][n] + k2[0][n]), hu = rs[0] * acc[ai][1][m][n] + (rs[1] * k1[1][n] + k2[1][n]);
#pragma unroll
                for (int e = 0; e < 4; ++e) a[n][e] = fsilu(hg[e]) * hu[e]; }
            st8nt(ACT + (size_t)(row0 + 128 * ai + 16 * m) * cfg::FF + 128 * u.pn + cw, a[0], a[1]); }
    }
};
struct FEpiFour {
    static constexpr bool PERM = true, AFTER_DRAIN = false;
    bf16_t* OC;
    __device__ __forceinline__ void operator()(const f32x4 (&acc)[2][2][4][2], const Unit& u, int wr, int wc, int fr, int fq) const {
        asm volatile("" : "+v"(fr), "+v"(fq));
        const int cw = 32 * wc + 8 * fq;
#pragma unroll
        for (int ai = 0; ai < 2; ++ai)
#pragma unroll
            for (int m = 0; m < 4; ++m) { const int row = u.pm * BM + 128 * ai + 64 * wr + 16 * m + fr; bf16_t* dst = OC + (size_t)(u.pn * 2048 + row) * 1024 + 512 + cw;
                st8(dst, acc[ai][0][m][0], acc[ai][0][m][1]); st8(dst + 128, acc[ai][1][m][0], acc[ai][1][m][1]); }
    }
};
}
namespace att {
using bf16x8 = __attribute__((ext_vector_type(8))) short;
using s16x4  = __attribute__((ext_vector_type(4))) short;
using f32x16 = __attribute__((ext_vector_type(16))) float;
using u32x4  = __attribute__((ext_vector_type(4))) unsigned;
constexpr int NW = 8, QBLK = 32, KVBLK = 64, LD = 512, NT = cfg::S / KVBLK;
constexpr int SHM_V = KVBLK * 128 * 2, SHM_K = KVBLK * 128 * 2, SHM_X = 2 * SHM_V + 2 * SHM_K, SHM_ATTN = SHM_X + NW * 64 * 4;
constexpr float THRL = 6.0f;
#define ATT_KSWZ(row, colB) ((row) * 256 + ((colB) ^ (((row) & 7) << 4)))
#define ATT_SBAR() __builtin_amdgcn_sched_barrier(0)
__device__ __forceinline__ int crow(int r, int hi) { return (r & 3) + 8 * (r >> 2) + 4 * hi; }
__device__ __forceinline__ unsigned cvtpk(float lo, float hi) { unsigned r; asm volatile("v_cvt_pk_bf16_f32 %0, %1, %2" : "=v"(r) : "v"(lo), "v"(hi)); return r; }
__device__ __forceinline__ void softmaxP(f32x16& p0, f32x16& p1, float& m_reg, f32x16& negm, float& alpha, bool first, bf16x8& pa0, bf16x8& pa1, bf16x8& pa2, bf16x8& pa3) {
#define ATT_M3(a, b, c) fmaxf(fmaxf(a, b), c)
  const float t0 = ATT_M3(p0[0], p0[1], p0[2]), t1 = ATT_M3(p0[3], p0[4], p0[5]), t2 = ATT_M3(p0[6], p0[7], p0[8]), t3 = ATT_M3(p0[9], p0[10], p0[11]), t4 = ATT_M3(p0[12], p0[13], p0[14]);
  const float t5 = ATT_M3(p0[15], p1[0], p1[1]), t6 = ATT_M3(p1[2], p1[3], p1[4]), t7 = ATT_M3(p1[5], p1[6], p1[7]), t8 = ATT_M3(p1[8], p1[9], p1[10]), t9 = ATT_M3(p1[11], p1[12], p1[13]);
  const float u0 = ATT_M3(t0, t1, t2), u1 = ATT_M3(t3, t4, t5), u2 = ATT_M3(t6, t7, t8), u3 = ATT_M3(t9, p1[14], p1[15]);
  float pmax = fmaxf(fmaxf(u0, u1), fmaxf(u2, u3));
#undef ATT_M3
  { auto rr = __builtin_amdgcn_permlane32_swap(__float_as_uint(pmax), __float_as_uint(pmax), false, false); pmax = fmaxf(__uint_as_float(rr[0]), __uint_as_float(rr[1])); }
  const float thr = first ? -3.0e38f : THRL;
  if (__builtin_expect(__all(pmax <= thr), 1)) { alpha = 1.f; }
  else { const float dl = first ? pmax : fmaxf(pmax, 0.f); alpha = first ? 0.f : __builtin_amdgcn_exp2f(-dl); m_reg += dl;
#pragma unroll
    for (int r = 0; r < 16; ++r) { p0[r] -= dl; p1[r] -= dl; negm[r] -= dl; } }
#pragma unroll
  for (int r = 0; r < 16; ++r) p0[r] = __builtin_amdgcn_exp2f(p0[r]);
#pragma unroll
  for (int r = 0; r < 16; ++r) p1[r] = __builtin_amdgcn_exp2f(p1[r]);
#define ATT_PK4(P, BASE, OUT) do { u32x4 w = {cvtpk(P[BASE + 0], P[BASE + 1]), cvtpk(P[BASE + 2], P[BASE + 3]), cvtpk(P[BASE + 4], P[BASE + 5]), cvtpk(P[BASE + 6], P[BASE + 7])}; \
    OUT = *reinterpret_cast<bf16x8*>(&w); } while (0)
  ATT_PK4(p0, 0, pa0); ATT_PK4(p0, 8, pa1); ATT_PK4(p1, 0, pa2); ATT_PK4(p1, 8, pa3);
#undef ATT_PK4
}
template <int OFF> __device__ __forceinline__ bf16x8 k_read(int ka) { bf16x8 r; asm volatile("ds_read_b128 %0, %1 offset:%2" : "=&v"(r) : "v"(ka), "i"(OFF) : "memory"); return r; }
template <int KB> __device__ __forceinline__ void k_load2(bf16x8* kf, int ka0, int ka1) {
  kf[0] = k_read<KB * SHM_K>(ka0); kf[1] = k_read<KB * SHM_K + 8192>(ka0); kf[2] = k_read<KB * SHM_K>(ka1); kf[3] = k_read<KB * SHM_K + 8192>(ka1);
}
__device__ __forceinline__ void qk_mma2(f32x16& p0, f32x16& p1, const bf16x8* kf, bf16x8 q0, bf16x8 q1) {
  p0 = __builtin_amdgcn_mfma_f32_32x32x16_bf16(kf[0], q0, p0, 0, 0, 0); p1 = __builtin_amdgcn_mfma_f32_32x32x16_bf16(kf[1], q0, p1, 0, 0, 0);
  p0 = __builtin_amdgcn_mfma_f32_32x32x16_bf16(kf[2], q1, p0, 0, 0, 0); p1 = __builtin_amdgcn_mfma_f32_32x32x16_bf16(kf[3], q1, p1, 0, 0, 0);
}
__device__ __forceinline__ int v_st(int k, int c) { return ((k >> 3) * 4 + (c >> 5)) * 512 + ((k & 7) * 32 + (c & 31)) * 2; }
__device__ __forceinline__ int v_rd_base(int lane) { return ((lane & 3) << 3) | (((lane >> 2) & 3) << 6) | (((lane >> 4) & 1) << 5) | (((lane >> 5) & 1) << 8); }
constexpr int v_rd_off(int d0, int ks, int half) { return d0 * 512 + ks * 4096 + half * 2048; }
template <int OFF> __device__ __forceinline__ s16x4 tr_read(int vb) { s16x4 r; asm volatile("ds_read_b64_tr_b16 %0, %1 offset:%2" : "=&v"(r) : "v"(vb), "i"(OFF) : "memory"); return r; }
struct VF { s16x4 l[4], h[4]; };
template <int KS> __device__ __forceinline__ void vf_load(VF& f, int vb) {
  f.l[0] = tr_read<v_rd_off(0, KS, 0)>(vb); f.h[0] = tr_read<v_rd_off(0, KS, 1)>(vb); f.l[1] = tr_read<v_rd_off(1, KS, 0)>(vb); f.h[1] = tr_read<v_rd_off(1, KS, 1)>(vb);
  f.l[2] = tr_read<v_rd_off(2, KS, 0)>(vb); f.h[2] = tr_read<v_rd_off(2, KS, 1)>(vb); f.l[3] = tr_read<v_rd_off(3, KS, 0)>(vb); f.h[3] = tr_read<v_rd_off(3, KS, 1)>(vb);
}
__device__ __forceinline__ void pv_step(f32x16* o, bf16x8 pa, const VF& f) {
#define ATT_PK(L, H) (bf16x8){L[0], L[1], L[2], L[3], H[0], H[1], H[2], H[3]}
  o[0] = __builtin_amdgcn_mfma_f32_32x32x16_bf16(pa, ATT_PK(f.l[0], f.h[0]), o[0], 0, 0, 0);
  o[1] = __builtin_amdgcn_mfma_f32_32x32x16_bf16(pa, ATT_PK(f.l[1], f.h[1]), o[1], 0, 0, 0);
  o[2] = __builtin_amdgcn_mfma_f32_32x32x16_bf16(pa, ATT_PK(f.l[2], f.h[2]), o[2], 0, 0, 0);
  o[3] = __builtin_amdgcn_mfma_f32_32x32x16_bf16(pa, ATT_PK(f.l[3], f.h[3]), o[3], 0, 0, 0);
#undef ATT_PK
}
#define ATT_LWAIT(n) do { asm volatile("s_waitcnt lgkmcnt(" #n ")" ::: "memory"); ATT_SBAR(); } while (0)
template <int MP> __device__ __forceinline__ void att_give(const f32x16* o, float* Xw, int r32, int hi) {
  constexpr int RG = MP ? 0 : 8;
#pragma unroll
  for (int rr = 0; rr < 8; ++rr)
#pragma unroll
    for (int d0 = 0; d0 < 4; ++d0) Xw[(crow(RG + rr, hi) & 15) * 128 + d0 * 32 + r32] = o[d0][RG + rr];
}
template <int MP> __device__ __forceinline__ void att_fin(const f32x16* o, const float* Xr, float lam, const float (&gq)[4], bf16_t* OCw, int r32, int hi, int lane) {
  constexpr int RK = MP ? 8 : 0;
  unsigned pk[8][4];
#pragma unroll
  for (int rr = 0; rr < 8; ++rr) { const int lr = crow(RK + rr, hi) & 15;
    float df[4], ssq = 0.f;
#pragma unroll
    for (int d0 = 0; d0 < 4; ++d0) { const float x = Xr[lr * 128 + d0 * 32 + r32]; df[d0] = MP ? x - lam * o[d0][RK + rr] : o[d0][RK + rr] - lam * x; ssq += df[d0] * df[d0]; }
    ssq = xadd<1>(ssq); ssq = xadd<2>(ssq); ssq = xadd<4>(ssq); ssq = xadd<8>(ssq); ssq = xadd<16>(ssq);
    const float rn = rsqrtf(ssq * (1.f / 128.f) + cfg::EPS);
#pragma unroll
    for (int d0 = 0; d0 < 4; ++d0) pk[rr][d0] = cvtpk(df[d0] * rn * gq[d0], 0.f); }
  char* stg = (char*)Xr;
#pragma unroll
  for (int rr = 0; rr < 8; ++rr) { const int lr = crow(RK + rr, hi) & 15;
#pragma unroll
    for (int d0 = 0; d0 < 4; ++d0) *(unsigned short*)(stg + lr * 272 + (d0 * 32 + r32) * 2) = (unsigned short)pk[rr][d0]; }
#pragma unroll
  for (int i = 0; i < 4; ++i) { const int c = lane + 64 * i, row = c >> 4, cc = c & 15;
    const u32x4 v = *(const u32x4*)(stg + row * 272 + cc * 16); *(u32x4*)(OCw + (size_t)row * 1024 + cc * 8) = v; }
}
__device__ __forceinline__ void attn_unit(int b, int h, int qb, const bf16_t* __restrict__ Qg, const bf16_t* __restrict__ Kg, const bf16_t* __restrict__ Vg, bf16_t* __restrict__ OC,
                                          const float* __restrict__ lamp, const float* __restrict__ dgv, int layer, char* lds) {
  int tid_o = threadIdx.x; asm volatile("" : "+v"(tid_o));
  const int tid = tid_o, wid = __builtin_amdgcn_readfirstlane(tid >> 6), lane = tid & 63, r32 = lane & 31, hi = lane >> 5, mp = wid >> 2, wl = wid & 3, mofs = mp * 64;
  char* V_lds = lds; char* K_lds = lds + 2 * SHM_V;
  float* ws = (float*)(lds + SHM_X) + wid * 64; float* al_l = ws + 32;
  float m_reg = 0.f; f32x16 o[4] = {}, ol = {}, negm = {}; bf16x8 qr[4];
  const int q0 = qb * 128 + wl * QBLK;
  const bf16_t* Qw = Qg + (size_t)(b * cfg::S + q0 + r32) * LD + h * 128 + mofs + hi * 8;
#pragma unroll
  for (int d0 = 0; d0 < 4; ++d0) qr[d0] = *reinterpret_cast<const bf16x8*>(Qw + d0 * 16);
  const bf16_t* Kh = Kg + (size_t)b * cfg::S * LD + h * 128; const bf16_t* Vh = Vg + (size_t)b * cfg::S * LD + h * 128;
  const int vb0 = (int)(uintptr_t)V_lds + v_rd_base(lane);
  const int ka0 = (int)(uintptr_t)K_lds + ATT_KSWZ(r32, (mofs + hi * 8) * 2);
  const bf16x8 ones = {0x3F80, 0x3F80, 0x3F80, 0x3F80, 0x3F80, 0x3F80, 0x3F80, 0x3F80};
  const int gt = tid & 255, gr = gt >> 4, gc = (gt & 15) * 8;
  const bf16_t* gsrc = (mp ? Kh : Vh) + (size_t)gr * LD + gc;
  char* gdst = mp ? K_lds + ATT_KSWZ(gr, gc * 2) : V_lds + v_st(gr, gc);
  const int tofs = mp ? 2 : 0;
  bf16x8 st_[2][4];
#define ATT_GLOAD(i, t) do { const int t_ = (t) < NT ? (t) : NT - 1;     \
    _Pragma("unroll") for (int q_ = 0; q_ < 4; ++q_) st_[i][q_] = *reinterpret_cast<const bf16x8*>(gsrc + (size_t)(t_ * 64 + 16 * q_) * LD); } while (0)
#define ATT_GWRITE(i, t) do { asm volatile("s_waitcnt vmcnt(4)" ::: "memory"); if ((t) < NT) { \
    _Pragma("unroll") for (int q_ = 0; q_ < 4; ++q_) *(bf16x8*)(gdst + (i) * 16384 + q_ * 4096) = st_[i][q_]; } } while (0)
#define ATT_RESC(a) do { if (__any((a) < 1.f)) { if (hi == 0) al_l[r32] = (a); asm volatile("s_waitcnt lgkmcnt(0)" ::: "memory"); \
    _Pragma("unroll") for (int r = 0; r < 16; ++r) { const float a_ = al_l[crow(r, hi)]; ol[r] *= a_; _Pragma("unroll") for (int d = 0; d < 4; ++d) o[d][r] *= a_; } } } while (0)
  f32x16 s0, s1; float al; bf16x8 pa0, pa1, pa2, pa3, kf[8]; VF f0, f1;
#define ATT_VSEG(I, p) do { ATT_GWRITE(I, (p) + tofs); ATT_GLOAD(I, (p) + tofs + 2); ATT_SBAR(); \
    softmaxP(s0, s1, m_reg, negm, al, (p) == 0, pa0, pa1, pa2, pa3); ATT_RESC(al); } while (0)
#define ATT_OL(pa) ol = __builtin_amdgcn_mfma_f32_32x32x16_bf16(pa, ones, ol, 0, 0, 0)
#define ATT_QK(KB) do { k_load2<KB>(kf, ka0, ka0 ^ 32); k_load2<KB>(kf + 4, ka0 ^ 64, ka0 ^ 96); ATT_LWAIT(4); s0 = negm; s1 = negm; qk_mma2(s0, s1, kf, qr[0], qr[1]); ATT_LWAIT(0); qk_mma2(s0, s1, kf + 4, qr[2], qr[3]); ATT_SBAR(); } while (0)
#define ATT_MSEG(VB, KB, QK) do { vf_load<0>(f0, vb0 + (VB) * SHM_V); vf_load<1>(f1, vb0 + (VB) * SHM_V); ATT_SBAR(); \
    ATT_LWAIT(8); pv_step(o, pa0, f0); ATT_OL(pa0); vf_load<2>(f0, vb0 + (VB) * SHM_V); \
    ATT_LWAIT(8); pv_step(o, pa1, f1); ATT_OL(pa1); vf_load<3>(f1, vb0 + (VB) * SHM_V); \
    if constexpr (QK) { k_load2<KB>(kf, ka0, ka0 ^ 32); ATT_LWAIT(12); } else ATT_LWAIT(8); \
    pv_step(o, pa2, f0); ATT_OL(pa2); \
    if constexpr (QK) ATT_LWAIT(4); else ATT_LWAIT(0); \
    pv_step(o, pa3, f1); ATT_OL(pa3); \
    if constexpr (QK) { k_load2<KB>(kf + 4, ka0 ^ 64, ka0 ^ 96); ATT_LWAIT(4); s0 = negm; s1 = negm; qk_mma2(s0, s1, kf, qr[0], qr[1]); ATT_LWAIT(0); qk_mma2(s0, s1, kf + 4, qr[2], qr[3]); } ATT_SBAR(); } while (0)
  { const int kr = tid >> 4, kc = (tid & 15) * 8;
    const bf16x8 k0 = *reinterpret_cast<const bf16x8*>(&Kh[(size_t)kr * LD + kc]), k1 = *reinterpret_cast<const bf16x8*>(&Kh[(size_t)(32 + kr) * LD + kc]);
    const bf16x8 k2 = *reinterpret_cast<const bf16x8*>(&Kh[(size_t)(64 + kr) * LD + kc]), k3 = *reinterpret_cast<const bf16x8*>(&Kh[(size_t)(96 + kr) * LD + kc]);
    ATT_GLOAD(0, tofs); ATT_GLOAD(1, tofs + 1);
    asm volatile("s_waitcnt vmcnt(8)" ::: "memory");
    *(bf16x8*)(K_lds + ATT_KSWZ(kr, kc * 2)) = k0; *(bf16x8*)(K_lds + ATT_KSWZ(32 + kr, kc * 2)) = k1;
    *(bf16x8*)(K_lds + SHM_K + ATT_KSWZ(kr, kc * 2)) = k2; *(bf16x8*)(K_lds + SHM_K + ATT_KSWZ(32 + kr, kc * 2)) = k3; }
  __syncthreads();
  if (mp) __syncthreads();
  ATT_QK(0); __syncthreads();
  for (int p = 0; p + 2 < NT; p += 2) {
    ATT_VSEG(0, p);           __syncthreads();
    ATT_MSEG(0, 1, true);     __syncthreads();
    ATT_VSEG(1, p + 1);       __syncthreads();
    ATT_MSEG(1, 0, true);     __syncthreads();
  }
  ATT_VSEG(0, NT - 2);   __syncthreads();
  ATT_MSEG(0, 1, true);   __syncthreads();
  ATT_VSEG(1, NT - 1);   __syncthreads();
  ATT_MSEG(1, 0, false);  __syncthreads();
  if (!mp) __syncthreads();
#pragma unroll
  for (int r = 0; r < 16; ++r) { const float rl = __builtin_amdgcn_rcpf(ol[r]);
#pragma unroll
    for (int d0 = 0; d0 < 4; ++d0) o[d0][r] *= rl; }
  __syncthreads();
  float* X = (float*)lds;
  const float* Xr = X + wid * 2048; float* Xw = X + (wid ^ 4) * 2048;
  int layer_o = __builtin_amdgcn_readfirstlane(layer); asm volatile("" : "+s"(layer_o)); const float lam_init = layer_o == 0 ? 0.2f : 0.35550906759f;
  if (mp == 0) att_give<0>(o, Xw, r32, hi); else att_give<1>(o, Xw, r32, hi);
  float lam; { float s1 = lamp[lane] * lamp[64 + lane], s2 = lamp[128 + lane] * lamp[192 + lane];
    s1 = xadd<1>(s1); s2 = xadd<1>(s2); s1 = xadd<2>(s1); s2 = xadd<2>(s2); s1 = xadd<4>(s1); s2 = xadd<4>(s2); s1 = xadd<8>(s1); s2 = xadd<8>(s2); s1 = xadd<16>(s1); s2 = xadd<16>(s2); s1 = xadd<32>(s1); s2 = xadd<32>(s2);
    lam = __expf(s1) - __expf(s2) + lam_init; }
  float gq[4];
#pragma unroll
  for (int d0 = 0; d0 < 4; ++d0) gq[d0] = dgv[d0 * 32 + r32] * (1.f - lam_init);
  __syncthreads();
  bf16_t* OCw = OC + (size_t)(b * cfg::S + q0 + 16 * mp) * 1024 + h * 128;
  if (mp == 0) att_fin<0>(o, Xr, lam, gq, OCw, r32, hi, lane); else att_fin<1>(o, Xr, lam, gq, OCw, r32, hi, lane);
  __syncthreads();
#undef ATT_GLOAD
#undef ATT_GWRITE
#undef ATT_VSEG
#undef ATT_MSEG
#undef ATT_RESC
#undef ATT_OL
#undef ATT_QK
}
#undef ATT_KSWZ
#undef ATT_SBAR
}
namespace gla {
using att::bf16x8; using att::s16x4; using att::f32x16; using att::u32x4; using att::crow; using att::cvtpk; using att::tr_read;
typedef float f32x4 __attribute__((ext_vector_type(4)));
typedef unsigned u32x2 __attribute__((ext_vector_type(2)));
#define GLAS __attribute__((address_space(3)))
constexpr int KT_STRIDE = 144;
constexpr int A_KT = 0, A_V = 36864, A_BEND = A_V + 32768;
constexpr int B_QT = 0, B_KT = 32768, B_V = 65536, B_SC = 98304;
__device__ __forceinline__ int v_st64(int k, int c) { const int kk = (k & ~0xC) | ((k & 4) << 1) | ((k & 8) >> 1); return ((kk >> 3) * 2 + (c >> 5)) * 512 + ((kk & 7) * 32 + (c & 31)) * 2; }
constexpr int v_off64(int d0, int ks, int half) { return d0 * 512 + ks * 2048 + half * 1024; }
__device__ __forceinline__ float bf2f_(unsigned short v) { return __uint_as_float((unsigned)v << 16); }
__device__ __forceinline__ void load_v_tile(const bf16_t* __restrict__ src, GLAS unsigned char* dst, int lane) {
    u32x4 tv[8];
#pragma unroll
    for (int i = 0; i < 8; ++i) { const int row = (lane >> 3) + 8 * i, ch = lane & 7; tv[i] = *(const u32x4*)(src + (size_t)row * 256 + ch * 8); }
#pragma unroll
    for (int i = 0; i < 8; ++i) { const int row = (lane >> 3) + 8 * i, ch = lane & 7; *(GLAS u32x4*)(dst + v_st64(row, ch * 8)) = tv[i]; }
}
#define GLA_PK(L, H) (bf16x8){L[0], L[1], L[2], L[3], H[0], H[1], H[2], H[3]}
#define GLA_MM4(o0, o1, vb, AF) do { \
    const s16x4 l00 = tr_read<v_off64(0, 0, 0)>(vb), h00 = tr_read<v_off64(0, 0, 1)>(vb), l01 = tr_read<v_off64(0, 1, 0)>(vb), h01 = tr_read<v_off64(0, 1, 1)>(vb); \
    const s16x4 l02 = tr_read<v_off64(0, 2, 0)>(vb), h02 = tr_read<v_off64(0, 2, 1)>(vb), l03 = tr_read<v_off64(0, 3, 0)>(vb), h03 = tr_read<v_off64(0, 3, 1)>(vb); \
    const s16x4 l10 = tr_read<v_off64(1, 0, 0)>(vb), h10 = tr_read<v_off64(1, 0, 1)>(vb), l11 = tr_read<v_off64(1, 1, 0)>(vb), h11 = tr_read<v_off64(1, 1, 1)>(vb); \
    const s16x4 l12 = tr_read<v_off64(1, 2, 0)>(vb), h12 = tr_read<v_off64(1, 2, 1)>(vb), l13 = tr_read<v_off64(1, 3, 0)>(vb), h13 = tr_read<v_off64(1, 3, 1)>(vb); \
    asm volatile("s_waitcnt lgkmcnt(0)" ::: "memory"); __builtin_amdgcn_sched_barrier(0); \
    o0 = __builtin_amdgcn_mfma_f32_32x32x16_bf16(AF(0), GLA_PK(l00, h00), o0, 0, 0, 0); o1 = __builtin_amdgcn_mfma_f32_32x32x16_bf16(AF(0), GLA_PK(l10, h10), o1, 0, 0, 0); \
    o0 = __builtin_amdgcn_mfma_f32_32x32x16_bf16(AF(1), GLA_PK(l01, h01), o0, 0, 0, 0); o1 = __builtin_amdgcn_mfma_f32_32x32x16_bf16(AF(1), GLA_PK(l11, h11), o1, 0, 0, 0); \
    o0 = __builtin_amdgcn_mfma_f32_32x32x16_bf16(AF(2), GLA_PK(l02, h02), o0, 0, 0, 0); o1 = __builtin_amdgcn_mfma_f32_32x32x16_bf16(AF(2), GLA_PK(l12, h12), o1, 0, 0, 0); \
    o0 = __builtin_amdgcn_mfma_f32_32x32x16_bf16(AF(3), GLA_PK(l03, h03), o0, 0, 0, 0); o1 = __builtin_amdgcn_mfma_f32_32x32x16_bf16(AF(3), GLA_PK(l13, h13), o1, 0, 0, 0); } while (0)
__device__ __forceinline__ bf16x8 afrag_tr(const GLAS unsigned char* row, int ks, int hi) { return *(const GLAS bf16x8*)(row + (16 * ks + 8 * hi) * 2); }

__device__ __forceinline__ void gla_a_item(int b, int h, int g, unsigned char* ws, GLAS unsigned char* lds) {
    int tid_o = threadIdx.x; asm volatile("" : "+v"(tid_o));
    const int tid = tid_o, wave = __builtin_amdgcn_readfirstlane(tid >> 6), lane = tid & 63, r32 = lane & 31, hi = lane >> 5;
    const float* GL = (const float*)(ws + cfg::WS_GL); const bf16_t* GQK = (const bf16_t*)(ws + cfg::WS_GQK); const bf16_t* GV = (const bf16_t*)(ws + cfg::WS_GV);
    float* KVC = (float*)(ws + cfg::WS_OF); float* DEC = (float*)(ws + cfg::WS_DEC);
    const size_t tok0 = (size_t)b * 2048 + g * 256;
    GLAS float* bend_s = (GLAS float*)(lds + A_BEND);
    if (wave < 4) {
        const int c = wave, dir = lane >> 5, d = lane & 31;
        const float* gl = GL + (tok0 + c * 64) * 256 + dir * 128 + h * 32 + d; const bf16_t* kp = GQK + (tok0 + c * 64) * 256 + 128 + h * 32 + d;
        GLAS unsigned char* row = lds + A_KT + ((c * 2 + dir) * 32 + d) * KT_STRIDE; float bsum = 0.f; float gA[8], gB[8]; unsigned short kA[8], kB[8];
#define GLA_LOAD(G, K, blk) do { const int t0_ = dir ? 56 - 8 * (blk) : 8 * (blk); _Pragma("unroll") for (int i = 0; i < 8; ++i) { G[i] = gl[(size_t)(t0_ + i) * 256]; K[i] = kp[(size_t)(t0_ + i) * 256]; } } while (0)
#define GLA_PROC(G, K, blk) do { const int t0_ = dir ? 56 - 8 * (blk) : 8 * (blk); float kt[8]; \
            if (dir == 0) { _Pragma("unroll") for (int i = 0; i < 8; ++i) { bsum += G[i]; kt[i] = bf2f_(K[i]) * __expf(-bsum); } } \
            else { _Pragma("unroll") for (int i = 7; i >= 0; --i) { bsum += G[i]; kt[i] = bf2f_(K[i]) * __expf(-bsum); } } \
            u32x4 w; w.x = cvtpk(kt[0], kt[1]); w.y = cvtpk(kt[2], kt[3]); w.z = cvtpk(kt[4], kt[5]); w.w = cvtpk(kt[6], kt[7]); *(GLAS u32x4*)(row + t0_ * 2) = w; } while (0)
        GLA_LOAD(gA, kA, 0);
#pragma unroll
        for (int bp = 0; bp < 4; ++bp) { GLA_LOAD(gB, kB, 2 * bp + 1); GLA_PROC(gA, kA, 2 * bp); if (bp < 3) GLA_LOAD(gA, kA, 2 * bp + 2); GLA_PROC(gB, kB, 2 * bp + 1); }
#undef GLA_LOAD
#undef GLA_PROC
        bend_s[(c * 2 + dir) * 32 + d] = bsum;
        DEC[((size_t)((b * 4 + h) * 32 + g * 4 + c) * 2 + dir) * 32 + d] = __expf(bsum);
    } else { const int c = wave - 4; load_v_tile(GV + (tok0 + c * 64) * 256 + h * 64, lds + A_V + c * 8192, lane); }
    __syncthreads();
    {
        const int c = wave >> 1, dir = wave & 1; f32x16 o0 = {}, o1 = {};
        const int vb = (int)(unsigned)(uintptr_t)(lds + A_V + c * 8192) + att::v_rd_base(lane);
        const GLAS unsigned char* arow = lds + A_KT + ((c * 2 + dir) * 32 + r32) * KT_STRIDE;
#define GLA_AF(ks) afrag_tr(arow, ks, hi)
        GLA_MM4(o0, o1, vb, GLA_AF);
#undef GLA_AF
        float* dst = KVC + ((size_t)((b * 4 + h) * 32 + g * 4 + c) * 2 + dir) * 2048 + r32;
#pragma unroll
        for (int r = 0; r < 16; ++r) { const int d = crow(r, hi); const float sc = __expf(bend_s[(c * 2 + dir) * 32 + d]); dst[d * 64] = o0[r] * sc; dst[d * 64 + 32] = o1[r] * sc; }
    }
    __syncthreads();
}

__device__ __forceinline__ void gla_b_item(int b, int h, int g, unsigned char* ws, const float* __restrict__ gng, bf16_t* __restrict__ OC, GLAS unsigned char* lds) {
    int tid_o = threadIdx.x; asm volatile("" : "+v"(tid_o));
    const int tid = tid_o, wave = __builtin_amdgcn_readfirstlane(tid >> 6), lane = tid & 63, r32 = lane & 31, hi = lane >> 5;
    const float* GL = (const float*)(ws + cfg::WS_GL); const bf16_t* GQK = (const bf16_t*)(ws + cfg::WS_GQK); const bf16_t* GV = (const bf16_t*)(ws + cfg::WS_GV); const bf16_t* GR = (const bf16_t*)(ws + cfg::WS_GR);
    const float* KVC = (const float*)(ws + cfg::WS_OF) + (size_t)((b * 4 + h) * 32) * 2 * 2048; const float* DEC = (const float*)(ws + cfg::WS_DEC) + (size_t)((b * 4 + h) * 32) * 2 * 32;
    const size_t tok0 = (size_t)b * 2048 + g * 256;
    if (wave < 4) {
        const int c = wave, dir = lane >> 5, d = lane & 31;
        const float* gl = GL + (tok0 + c * 64) * 256 + dir * 128 + h * 32 + d; const bf16_t* qp = GQK + (tok0 + c * 64) * 256 + h * 32 + d;
        GLAS unsigned short* qt = (GLAS unsigned short*)(lds + B_QT + c * 8192) + dir * 32 + d;
        GLAS unsigned short* kt = (GLAS unsigned short*)(lds + B_KT + c * 8192 + dir * 4096) + d;
        float bsum = 0.f; float gA[8], gB[8]; unsigned short qA[8], kA[8], qB[8], kB[8];
#define GLB_LOAD(G, Q, K, blk) do { const int t0_ = dir ? 56 - 8 * (blk) : 8 * (blk); _Pragma("unroll") for (int i = 0; i < 8; ++i) { G[i] = gl[(size_t)(t0_ + i) * 256]; Q[i] = qp[(size_t)(t0_ + i) * 256]; K[i] = qp[(size_t)(t0_ + i) * 256 + 128]; } } while (0)
#define GLB_PROC(G, Q, K, blk) do { const int t0_ = dir ? 56 - 8 * (blk) : 8 * (blk); _Pragma("unroll") for (int ii = 0; ii < 8; ++ii) { \
            const float gi = dir ? G[7 - ii] : G[ii], qi = bf2f_(dir ? Q[7 - ii] : Q[ii]), ki = bf2f_(dir ? K[7 - ii] : K[ii]); const int tt = t0_ + (dir ? 7 - ii : ii); \
            bsum += gi; const float e = __expf(bsum), ei = __expf(-bsum); \
            qt[tt * 64] = (unsigned short)(cvtpk(qi * e, 0.f) & 0xffffu); kt[tt * 32] = (unsigned short)(cvtpk(ki * ei, 0.f) & 0xffffu); } } while (0)
        GLB_LOAD(gA, qA, kA, 0);
#pragma unroll
        for (int bp = 0; bp < 4; ++bp) { GLB_LOAD(gB, qB, kB, 2 * bp + 1); GLB_PROC(gA, qA, kA, 2 * bp); if (bp < 3) GLB_LOAD(gA, qA, kA, 2 * bp + 2); GLB_PROC(gB, qB, kB, 2 * bp + 1); }
#undef GLB_LOAD
#undef GLB_PROC
    } else {
        const int c = wave - 4; load_v_tile(GV + (tok0 + c * 64) * 256 + h * 64, lds + B_V + c * 8192, lane);
        const int t2 = tid - 256, d = t2 >> 3, v8 = (t2 & 7) * 8;
        const float* kvp = KVC + d * 64 + v8; const float* dcp = DEC + d;
        f32x4 own[4][2][2]; float dow[4][2];
#pragma unroll
        for (int c4 = 0; c4 < 4; ++c4)
#pragma unroll
            for (int dr = 0; dr < 2; ++dr) { const int n = 4 * g + c4; own[c4][dr][0] = *(const f32x4*)(kvp + (size_t)(n * 2 + dr) * 2048); own[c4][dr][1] = *(const f32x4*)(kvp + (size_t)(n * 2 + dr) * 2048 + 4); dow[c4][dr] = dcp[(n * 2 + dr) * 32]; }
        f32x4 Sf0 = {0.f, 0.f, 0.f, 0.f}, Sf1 = Sf0, Sb0 = Sf0, Sb1 = Sf0;
#pragma unroll 8
        for (int n = 0; n < 4 * g; ++n) { const float dc = dcp[(n * 2) * 32]; Sf0 = dc * Sf0 + *(const f32x4*)(kvp + (size_t)(n * 2) * 2048); Sf1 = dc * Sf1 + *(const f32x4*)(kvp + (size_t)(n * 2) * 2048 + 4); }
#pragma unroll 8
        for (int n = 31; n >= 4 * g + 4; --n) { const float dc = dcp[(n * 2 + 1) * 32]; Sb0 = dc * Sb0 + *(const f32x4*)(kvp + (size_t)(n * 2 + 1) * 2048); Sb1 = dc * Sb1 + *(const f32x4*)(kvp + (size_t)(n * 2 + 1) * 2048 + 4); }
#pragma unroll
        for (int c4 = 0; c4 < 4; ++c4) { u32x4 w; w.x = cvtpk(Sf0[0], Sf0[1]); w.y = cvtpk(Sf0[2], Sf0[3]); w.z = cvtpk(Sf1[0], Sf1[1]); w.w = cvtpk(Sf1[2], Sf1[3]);
            *(GLAS u32x4*)(lds + B_SC + c4 * 8192 + v_st64(d, v8)) = w; Sf0 = dow[c4][0] * Sf0 + own[c4][0][0]; Sf1 = dow[c4][0] * Sf1 + own[c4][0][1]; }
#pragma unroll
        for (int c4 = 3; c4 >= 0; --c4) { u32x4 w; w.x = cvtpk(Sb0[0], Sb0[1]); w.y = cvtpk(Sb0[2], Sb0[3]); w.z = cvtpk(Sb1[0], Sb1[1]); w.w = cvtpk(Sb1[2], Sb1[3]);
            *(GLAS u32x4*)(lds + B_SC + c4 * 8192 + v_st64(32 + d, v8)) = w; Sb0 = dow[c4][1] * Sb0 + own[c4][1][0]; Sb1 = dow[c4][1] * Sb1 + own[c4][1][1]; }
    }
    __syncthreads();
    {
        const int c = wave >> 1, th = wave & 1, t = 32 * th + r32;
        const GLAS unsigned char* qrow = lds + B_QT + c * 8192 + t * 128;
        f32x16 pf0 = {}, pf1 = {}, pb0 = {}, pb1 = {};
#pragma unroll
        for (int ks = 0; ks < 2; ++ks) {
            const bf16x8 qf = *(const GLAS bf16x8*)(qrow + (16 * ks + 8 * hi) * 2), qb = *(const GLAS bf16x8*)(qrow + (32 + 16 * ks + 8 * hi) * 2);
            const GLAS unsigned char* kf = lds + B_KT + c * 8192 + r32 * 64 + (16 * ks + 8 * hi) * 2; const GLAS unsigned char* kb = kf + 4096;
            pf0 = __builtin_amdgcn_mfma_f32_32x32x16_bf16(*(const GLAS bf16x8*)kf, qf, pf0, 0, 0, 0); pf1 = __builtin_amdgcn_mfma_f32_32x32x16_bf16(*(const GLAS bf16x8*)(kf + 2048), qf, pf1, 0, 0, 0);
            pb0 = __builtin_amdgcn_mfma_f32_32x32x16_bf16(*(const GLAS bf16x8*)kb, qb, pb0, 0, 0, 0); pb1 = __builtin_amdgcn_mfma_f32_32x32x16_bf16(*(const GLAS bf16x8*)(kb + 2048), qb, pb1, 0, 0, 0);
        }
#pragma unroll
        for (int r = 0; r < 16; ++r) { const int j0 = crow(r, hi), j1 = 32 + j0;
            pf0[r] = (j0 <= t ? pf0[r] : 0.f) + (j0 >= t ? pb0[r] : 0.f); pf1[r] = (j1 <= t ? pf1[r] : 0.f) + (j1 >= t ? pb1[r] : 0.f); }
        bf16x8 pa0, pa1, pa2, pa3;
#define GLA_PK4(P, BASE, OUT) do { unsigned a0 = cvtpk(P[BASE + 0], P[BASE + 1]), a1 = cvtpk(P[BASE + 2], P[BASE + 3]); unsigned b0 = cvtpk(P[BASE + 4], P[BASE + 5]), b1 = cvtpk(P[BASE + 6], P[BASE + 7]); \
    auto r0 = __builtin_amdgcn_permlane32_swap(a0, b0, false, false); auto r1 = __builtin_amdgcn_permlane32_swap(a1, b1, false, false); \
    u32x4 w = {r0[0], r1[0], r0[1], r1[1]}; OUT = *reinterpret_cast<bf16x8*>(&w); } while (0)
        GLA_PK4(pf0, 0, pa0); GLA_PK4(pf0, 8, pa1); GLA_PK4(pf1, 0, pa2); GLA_PK4(pf1, 8, pa3);
#undef GLA_PK4
        f32x16 o0 = {}, o1 = {};
        { const int vb = (int)(unsigned)(uintptr_t)(lds + B_V + c * 8192) + att::v_rd_base(lane);
#define GLA_AF(ks) ((ks) == 0 ? pa0 : (ks) == 1 ? pa1 : (ks) == 2 ? pa2 : pa3)
          GLA_MM4(o0, o1, vb, GLA_AF);
#undef GLA_AF
        }
        { const int vb = (int)(unsigned)(uintptr_t)(lds + B_SC + c * 8192) + att::v_rd_base(lane);
#define GLA_AF(ks) afrag_tr(qrow, ks, hi)
          GLA_MM4(o0, o1, vb, GLA_AF);
#undef GLA_AF
        }
        const float g0 = gng[r32], g1 = gng[32 + r32];
        const bf16_t* grb = GR + (tok0 + c * 64 + 32 * th) * 256 + h * 64 + r32; unsigned short gq0[16], gq1[16];
#pragma unroll
        for (int r = 0; r < 16; ++r) { gq0[r] = grb[(size_t)crow(r, hi) * 256]; gq1[r] = grb[(size_t)crow(r, hi) * 256 + 32]; }
#pragma unroll
        for (int r = 0; r < 16; ++r) {
            float ssq = o0[r] * o0[r] + o1[r] * o1[r];
            ssq = xadd<1>(ssq); ssq = xadd<2>(ssq); ssq = xadd<4>(ssq); ssq = xadd<8>(ssq); ssq = xadd<16>(ssq);
            const float rn = rsqrtf(ssq * (1.f / 64.f) + cfg::EPS);
            const size_t tok = tok0 + c * 64 + 32 * th + crow(r, hi);
            bf16_t* dst = OC + tok * 1024 + 768 + h * 64 + r32;
            dst[0] = (bf16_t)(cvtpk(o0[r] * rn * g0 * bf2f_(gq0[r]), 0.f) & 0xffffu); dst[32] = (bf16_t)(cvtpk(o1[r] * rn * g1 * bf2f_(gq1[r]), 0.f) & 0xffffu);
        }
    }
    __syncthreads();
}
#undef GLA_MM4
#undef GLA_PK
#undef GLAS
}
namespace fft {
using att::bf16x8; using att::s16x4; using att::f32x16; using att::u32x4; using att::crow; using att::cvtpk; using att::tr_read;
#define FLAS __attribute__((address_space(3)))
__device__ __forceinline__ int img_off(int k, int c) { const int kk = (k & ~0xC) | ((k & 4) << 1) | ((k & 8) >> 1); return ((kk >> 3) * 8 + (c >> 5)) * 512 + ((kk & 7) * 32 + (c & 31)) * 2; }
constexpr int rd_off(int ks, int half) { return ks * 8192 + half * 4096; }
#define FFT_PK(L, H) (bf16x8){L[0], L[1], L[2], L[3], H[0], H[1], H[2], H[3]}
typedef float f32x2_t __attribute__((ext_vector_type(2))); typedef __bf16 bf16x2_t __attribute__((ext_vector_type(2)));
__device__ __forceinline__ unsigned pk2f(float a, float b) { f32x2_t v = {a, b}; bf16x2_t r = __builtin_convertvector(v, bf16x2_t); return __builtin_bit_cast(unsigned, r); }

__device__ __forceinline__ void stage1_item(int b, int s2, const bf16_t* __restrict__ FX, bf16_t* __restrict__ I1, FLAS unsigned char* lds) {
    int tid_o = threadIdx.x; asm volatile("" : "+v"(tid_o));
    const int tid = tid_o, wave = __builtin_amdgcn_readfirstlane(tid >> 6), lane = tid & 63, r32 = lane & 31, hi = lane >> 5;
    bf16x8 F1[2][4];
#pragma unroll
    for (int ks = 0; ks < 4; ++ks) { float cr[8], ci[8];
#pragma unroll
        for (int j = 0; j < 8; ++j) { const int k = 16 * ks + 8 * hi + j, s1 = k & 31; const float rev = (float)((r32 * s1) & 31) * (1.f / 32.f); const float c = __builtin_amdgcn_cosf(rev), sn = __builtin_amdgcn_sinf(rev);
            const bool p1 = (k >> 5) != 0; cr[j] = p1 ? -sn : c; ci[j] = p1 ? -c : -sn; }
        u32x4 wr = {pk2f(cr[0], cr[1]), pk2f(cr[2], cr[3]), pk2f(cr[4], cr[5]), pk2f(cr[6], cr[7])}, wi = {pk2f(ci[0], ci[1]), pk2f(ci[2], ci[3]), pk2f(ci[4], ci[5]), pk2f(ci[6], ci[7])};
        F1[0][ks] = *reinterpret_cast<bf16x8*>(&wr); F1[1][ks] = *reinterpret_cast<bf16x8*>(&wi); }
    { u32x4 tv[4];
#pragma unroll
      for (int i = 0; i < 4; ++i) { const int p = tid + 512 * i, k = p >> 5, c8 = (p & 31) * 8; tv[i] = *(const u32x4*)(FX + (size_t)(b * 2048 + 64 * (k & 31) + s2) * 512 + (k >> 5) * 256 + c8); }
#pragma unroll
      for (int i = 0; i < 4; ++i) { const int p = tid + 512 * i, k = p >> 5, c8 = (p & 31) * 8; *(FLAS u32x4*)(lds + img_off(k, c8)) = tv[i]; } }
    __syncthreads();
    f32x16 re = {}, im = {};
    { const int vb = (int)(unsigned)(uintptr_t)lds + att::v_rd_base(lane) + wave * 512;
      const s16x4 l0 = tr_read<rd_off(0, 0)>(vb), h0 = tr_read<rd_off(0, 1)>(vb), l1 = tr_read<rd_off(1, 0)>(vb), h1 = tr_read<rd_off(1, 1)>(vb);
      const s16x4 l2 = tr_read<rd_off(2, 0)>(vb), h2 = tr_read<rd_off(2, 1)>(vb), l3 = tr_read<rd_off(3, 0)>(vb), h3 = tr_read<rd_off(3, 1)>(vb);
      asm volatile("s_waitcnt lgkmcnt(0)" ::: "memory"); __builtin_amdgcn_sched_barrier(0);
      re = __builtin_amdgcn_mfma_f32_32x32x16_bf16(F1[0][0], FFT_PK(l0, h0), re, 0, 0, 0); im = __builtin_amdgcn_mfma_f32_32x32x16_bf16(F1[1][0], FFT_PK(l0, h0), im, 0, 0, 0);
      re = __builtin_amdgcn_mfma_f32_32x32x16_bf16(F1[0][1], FFT_PK(l1, h1), re, 0, 0, 0); im = __builtin_amdgcn_mfma_f32_32x32x16_bf16(F1[1][1], FFT_PK(l1, h1), im, 0, 0, 0);
      re = __builtin_amdgcn_mfma_f32_32x32x16_bf16(F1[0][2], FFT_PK(l2, h2), re, 0, 0, 0); im = __builtin_amdgcn_mfma_f32_32x32x16_bf16(F1[1][2], FFT_PK(l2, h2), im, 0, 0, 0);
      re = __builtin_amdgcn_mfma_f32_32x32x16_bf16(F1[0][3], FFT_PK(l3, h3), re, 0, 0, 0); im = __builtin_amdgcn_mfma_f32_32x32x16_bf16(F1[1][3], FFT_PK(l3, h3), im, 0, 0, 0); }
    bf16_t* dst = I1 + (size_t)(b * 32) * 128 * 256 + (size_t)s2 * 256 + 32 * wave + r32;
#pragma unroll
    for (int r = 0; r < 16; ++r) { const int k1 = crow(r, hi); const float rev = (float)((k1 * s2) & 2047) * (1.f / 2048.f); const float ct = __builtin_amdgcn_cosf(rev), st = __builtin_amdgcn_sinf(rev);
        const float ar = re[r] * ct + im[r] * st, ai = im[r] * ct - re[r] * st; const unsigned w = pk2f(ar, ai);
        dst[(size_t)k1 * 128 * 256] = (bf16_t)(w & 0xffffu); dst[(size_t)k1 * 128 * 256 + 64 * 256] = (bf16_t)(w >> 16); }
    __syncthreads();
}

__device__ __forceinline__ void stage2_item(int b, int k1, const bf16_t* __restrict__ I1, bf16_t* __restrict__ OC, FLAS unsigned char* lds) {
    int tid_o = threadIdx.x; asm volatile("" : "+v"(tid_o));
    const int tid = tid_o, wave = __builtin_amdgcn_readfirstlane(tid >> 6), lane = tid & 63, r32 = lane & 31, hi = lane >> 5;
    const bf16_t* src = I1 + (size_t)(b * 32 + k1) * 128 * 256;
    { u32x4 tv[8];
#pragma unroll
      for (int i = 0; i < 8; ++i) { const int p = tid + 512 * i, k = p >> 5, c8 = (p & 31) * 8; tv[i] = *(const u32x4*)(src + (size_t)k * 256 + c8); }
#pragma unroll
      for (int i = 0; i < 8; ++i) { const int p = tid + 512 * i, k = p >> 5, c8 = (p & 31) * 8; *(FLAS u32x4*)(lds + img_off(k, c8)) = tv[i]; } }
    f32x16 y0 = {}, y1 = {};
    __syncthreads();
    const int vb = (int)(unsigned)(uintptr_t)lds + att::v_rd_base(lane) + wave * 512, vb2 = vb + 32768;
    bf16x8 F2[2][8];
#pragma unroll
    for (int ks = 0; ks < 8; ++ks) { float c0[8], c1[8];
#pragma unroll
        for (int j = 0; j < 8; ++j) { const int k = 16 * ks + 8 * hi + j, s2 = k & 63; const float r0 = (float)((r32 * s2) & 63) * (1.f / 64.f), r1 = (float)(((32 + r32) * s2) & 63) * (1.f / 64.f);
            c0[j] = (k >> 6) ? __builtin_amdgcn_sinf(r0) : __builtin_amdgcn_cosf(r0); c1[j] = (k >> 6) ? __builtin_amdgcn_sinf(r1) : __builtin_amdgcn_cosf(r1); }
        u32x4 w0 = {pk2f(c0[0], c0[1]), pk2f(c0[2], c0[3]), pk2f(c0[4], c0[5]), pk2f(c0[6], c0[7])}, w1 = {pk2f(c1[0], c1[1]), pk2f(c1[2], c1[3]), pk2f(c1[4], c1[5]), pk2f(c1[6], c1[7])};
        F2[0][ks] = *reinterpret_cast<bf16x8*>(&w0); F2[1][ks] = *reinterpret_cast<bf16x8*>(&w1); }
#define FFT_STEP(ks) do { \
      const s16x4 lo_ = tr_read<rd_off((ks) & 3, 0)>((ks) < 4 ? vb : vb2), hi_ = tr_read<rd_off((ks) & 3, 1)>((ks) < 4 ? vb : vb2); asm volatile("s_waitcnt lgkmcnt(0)" ::: "memory"); __builtin_amdgcn_sched_barrier(0); \
      y0 = __builtin_amdgcn_mfma_f32_32x32x16_bf16(F2[0][ks], FFT_PK(lo_, hi_), y0, 0, 0, 0); y1 = __builtin_amdgcn_mfma_f32_32x32x16_bf16(F2[1][ks], FFT_PK(lo_, hi_), y1, 0, 0, 0); } while (0)
    FFT_STEP(0); FFT_STEP(1); FFT_STEP(2); FFT_STEP(3); FFT_STEP(4); FFT_STEP(5); FFT_STEP(6); FFT_STEP(7);
#undef FFT_STEP
    bf16_t* dst = OC + (size_t)(b * 2048 + k1) * 1024 + 512 + 32 * wave + r32;
#pragma unroll
    for (int r = 0; r < 16; ++r) { const int k2 = crow(r, hi); const unsigned w = pk2f(y0[r], y1[r]);
        dst[(size_t)(32 * k2) * 1024] = (bf16_t)(w & 0xffffu); dst[(size_t)(32 * (32 + k2)) * 1024] = (bf16_t)(w >> 16); }
    __syncthreads();
}
#undef FFT_PK
#undef FLAS
}
namespace pro {
#define PLAS __attribute__((address_space(3)))
typedef float f32x4 __attribute__((ext_vector_type(4)));
typedef unsigned u32x4 __attribute__((ext_vector_type(4)));
__device__ __forceinline__ unsigned pk2(float lo, float hi) { unsigned r; asm volatile("v_cvt_pk_bf16_f32 %0, %1, %2" : "=v"(r) : "v"(lo), "v"(hi)); return r; }
__device__ __forceinline__ float lo_f(unsigned w) { return __uint_as_float(w << 16); }
__device__ __forceinline__ float hi_f(unsigned w) { return __uint_as_float(w & 0xffff0000u); }
template <bool SUMS, int STRIDE> __device__ __forceinline__ void tile_emit(int K, bf16_t* WT, const float* gain, const float* lnb, float (&a1)[4], float (&a2)[4], const PLAS float* scr, int lane) {
    const int c = lane & 7; float gk[8], bk[8];
#pragma unroll
    for (int q = 0; q < 8; ++q) { gk[q] = gain ? gain[8 * c + q] : 1.f; bk[q] = lnb ? lnb[8 * c + q] : 0.f; }
#pragma unroll
    for (int j = 0; j < 4; ++j) { const int n = (lane >> 3) + 8 * j; const PLAS float* s = scr + (8 * c) * STRIDE + n; float v[8];
#pragma unroll
        for (int q = 0; q < 8; ++q) v[q] = s[q * STRIDE];
        u32x4 o; o.x = pk2(v[0] * gk[0], v[1] * gk[1]); o.y = pk2(v[2] * gk[2], v[3] * gk[3]); o.z = pk2(v[4] * gk[4], v[5] * gk[5]); o.w = pk2(v[6] * gk[6], v[7] * gk[7]);
        *(u32x4*)(WT + (size_t)n * K + 8 * c) = o;
        if (SUMS) { float p1 = (lo_f(o.x) + hi_f(o.x)) + (lo_f(o.y) + hi_f(o.y)) + (lo_f(o.z) + hi_f(o.z)) + (lo_f(o.w) + hi_f(o.w)); float p2 = 0.f;
#pragma unroll
            for (int q = 0; q < 8; ++q) p2 += bk[q] * v[q];
            p1 = xadd<1>(p1); p2 = xadd<1>(p2); p1 = xadd<2>(p1); p2 = xadd<2>(p2); p1 = xadd<4>(p1); p2 = xadd<4>(p2);
            a1[j] += p1; a2[j] += p2; }
    }
    asm volatile("s_waitcnt lgkmcnt(0)" ::: "memory");
}
__device__ __forceinline__ void tile_dma(const float* W, int N, PLAS float* scr, int lane) {
    const float* src = W + (size_t)(lane >> 3) * N + (lane & 7) * 4;
#pragma unroll
    for (int i = 0; i < 8; ++i) __builtin_amdgcn_global_load_lds((const unsigned*)(src + (size_t)(8 * i) * N), (PLAS unsigned*)(scr + i * 256), 16, 0, 0);
}
template <bool SUMS, class Val> __device__ __forceinline__ void tile_item(const Val& val, int K, bf16_t* WT, const float* gain, const float* lnb, float (&a1)[4], float (&a2)[4], PLAS float* scr, int lane) {
#pragma unroll 2
    for (int i = 0; i < 32; ++i) { const int kk = 2 * i + (lane >> 5); scr[kk * 33 + (lane & 31)] = val(kk, lane & 31); }
    asm volatile("s_waitcnt lgkmcnt(0)" ::: "memory");
    tile_emit<SUMS, 33>(K, WT, gain, lnb, a1, a2, scr, lane);
}
struct ValPlain { static constexpr int BATCH = 32; const float* W; int N; __device__ __forceinline__ float operator()(int kk, int j) const { return W[(size_t)kk * N + j]; } };
struct ValGate { static constexpr int BATCH = 2; const float* W; const float* w2; __device__ __forceinline__ float operator()(int kk, int j) const {
    const float* wr = W + (size_t)kk * cfg::INW; float a = 0.f;
#pragma unroll
    for (int r = 0; r < 16; ++r) a += wr[r] * w2[r * 128 + j]; return a; } };

__device__ __forceinline__ void fold_item(int item, unsigned char* ws, const float* w_in, const float* fw, const float* lng, const float* lnb, PLAS unsigned char* lds, int tid) {
    const int l = item >> 5, g = (item >> 3) & 3, part = (item >> 2) & 1, kq = item & 3;
    PLAS float* M = (PLAS float*)lds;
    { const int c = tid >> 3, e0 = (tid & 7) * 8; float acc[8];
#pragma unroll
      for (int q = 0; q < 8; ++q) acc[q] = 0.f;
      const float* w = fw + (size_t)((l * 4 + g) * 64) * 64 + e0;
      for (int k2 = 0; k2 < 64; ++k2) { float rev = (float)((k2 * c) & 63) * (1.f / 64.f); asm volatile("" : "+v"(rev)); const float tr = part ? __builtin_amdgcn_sinf(rev) : __builtin_amdgcn_cosf(rev);
          const f32x4 w0 = *(const f32x4*)(w + k2 * 64), w1 = *(const f32x4*)(w + k2 * 64 + 4);
#pragma unroll
          for (int q = 0; q < 4; ++q) { acc[q] += tr * w0[q]; acc[4 + q] += tr * w1[q]; } }
      const float sc = 0.00276213586400995f;
#pragma unroll
      for (int q = 0; q < 8; ++q) M[c * 64 + e0 + q] = acc[q] * sc; }
    __syncthreads();
    PLAS float* Wl = (PLAS float*)(lds + 16384);
    { const float* wsrc = w_in + ((size_t)l * 1024 + kq * 256) * cfg::INW + 1536 + 64 * g; f32x4 tv[8];
#pragma unroll
      for (int i = 0; i < 8; ++i) tv[i] = *(const f32x4*)(wsrc + (size_t)((tid >> 4) + 32 * i) * cfg::INW + (tid & 15) * 4);
#pragma unroll
      for (int i = 0; i < 8; ++i) *(PLAS f32x4*)(Wl + ((tid >> 4) + 32 * i) * 64 + (tid & 15) * 4) = tv[i]; }
    __syncthreads();
    { const int e = tid & 63, kg = tid >> 6, k0 = kq * 256 + kg * 32, np = 1536 + part * 256 + g * 64 + e; float mc[64];
#pragma unroll
      for (int c = 0; c < 64; ++c) mc[c] = M[c * 64 + e];
      bf16_t* dst = (bf16_t*)(ws + cfg::WS_WIN + l * cfg::SZ_WIN) + (size_t)np * 1024 + k0; float s1 = 0.f, s2 = 0.f;
      for (int kb = 0; kb < 4; ++kb) { float o[8];
#pragma unroll
          for (int q = 0; q < 8; ++q) { const int k = k0 + kb * 8 + q; const PLAS f32x4* wr = (const PLAS f32x4*)(Wl + (kg * 32 + kb * 8 + q) * 64); float a = 0.f;
#pragma unroll
              for (int c4 = 0; c4 < 16; ++c4) { const f32x4 w4 = wr[c4]; a += w4[0] * mc[4 * c4] + w4[1] * mc[4 * c4 + 1] + w4[2] * mc[4 * c4 + 2] + w4[3] * mc[4 * c4 + 3]; }
              o[q] = a * (lng ? lng[k] : 1.f); s2 += lnb ? lnb[k] * a : 0.f; }
          u32x4 w; w.x = pk2(o[0], o[1]); w.y = pk2(o[2], o[3]); w.z = pk2(o[4], o[5]); w.w = pk2(o[6], o[7]); *(u32x4*)(dst + kb * 8) = w;
          s1 += (lo_f(w.x) + hi_f(w.x)) + (lo_f(w.y) + hi_f(w.y)) + (lo_f(w.z) + hi_f(w.z)) + (lo_f(w.w) + hi_f(w.w)); }
      __syncthreads();
      PLAS float* red = (PLAS float*)lds; red[(kg * 64 + e) * 2] = s1; red[(kg * 64 + e) * 2 + 1] = s2;
      __syncthreads();
      if (kg == 0) { float t1 = 0.f, t2 = 0.f;
#pragma unroll
          for (int w = 0; w < 8; ++w) { t1 += red[(w * 64 + e) * 2]; t2 += red[(w * 64 + e) * 2 + 1]; }
          float* fp = (float*)(ws + cfg::V_MF) + (size_t)((l * 4 + kq) * 2) * 512 + part * 256 + g * 64 + e; fp[0] = t1; fp[512] = t2; } }
    __syncthreads();
}

struct Inputs { const float *x, *w_in, *fw, *gw2, *w_out, *ln1g, *ln1b, *wg, *wu, *wd, *ln2g, *ln2b; };
__device__ __forceinline__ void prologue(unsigned char* ws, const Inputs& in, PLAS unsigned char* lds, int vcu, int G) {
    int tid_o = threadIdx.x; asm volatile("" : "+v"(tid_o));
    const int tid = tid_o, wave = __builtin_amdgcn_readfirstlane(tid >> 6), lane = tid & 63;
    const float* x = in.x; const float* w_in = in.w_in; const float* fw = in.fw; const float* gw2 = in.gw2; const float* w_out = in.w_out; const float* ln1g = in.ln1g; const float* ln1b = in.ln1b;
    const float* wg = in.wg; const float* wu = in.wu; const float* wd = in.wd; const float* ln2g = in.ln2g; const float* ln2b = in.ln2b;
    if (vcu < 64) { const int l = vcu >> 5; fold_item(vcu, ws, w_in, fw, l ? ln2g : (const float*)nullptr, l ? ln2b : (const float*)nullptr, lds, tid); }
    PLAS float* scr = (PLAS float*)(lds + wave * 16384); PLAS float* scr1 = scr + 2048; PLAS float* redw = (PLAS float*)(lds + 131072 + 1024 + wave * 256);
    const int gw = vcu * 8 + wave, NGW = G * 8;
    for (int it = vcu; it < 512; it += G) {
        const int l = it >> 8, r = it & 255; float a1[4] = {0.f, 0.f, 0.f, 0.f}, a2[4] = {0.f, 0.f, 0.f, 0.f}; float* c1o; float* c2o;
        const int k0 = wave * 64, k1 = k0 + 512;
        if (r < 80) { const int nb = r; const float* lngb = l ? ln2g : (const float*)nullptr; const float* lnbb = l ? ln2b : (const float*)nullptr;
            bf16_t* Wt = (bf16_t*)(ws + cfg::WS_WIN + l * cfg::SZ_WIN);
            if (nb < 72) { int np0, src;
                if (nb < 32) { const int pn = nb >> 3, p = (nb & 7) * 32, wc = (p >> 5) & 3, bj = p >> 7; np0 = pn * 256 + p; src = (pn >> 1) * 512 + (pn & 1) * 256 + 64 * wc + 32 * bj; }
                else if (nb < 48) { np0 = 1024 + (nb - 32) * 32; src = np0; }
                else { np0 = 2048 + (nb - 48) * 32; src = 1792 + (nb - 48) * 32; }
                tile_dma(w_in + ((size_t)l * 1024 + k0) * cfg::INW + src, cfg::INW, scr, lane); tile_dma(w_in + ((size_t)l * 1024 + k1) * cfg::INW + src, cfg::INW, scr1, lane);
                asm volatile("s_waitcnt vmcnt(0)" ::: "memory");
                tile_emit<true, 32>(1024, Wt + (size_t)np0 * 1024 + k0, lngb ? lngb + k0 : lngb, lnbb ? lnbb + k0 : lnbb, a1, a2, scr, lane);
                tile_emit<true, 32>(1024, Wt + (size_t)np0 * 1024 + k1, lngb ? lngb + k1 : lngb, lnbb ? lnbb + k1 : lnbb, a1, a2, scr1, lane);
                c1o = (float*)(ws + cfg::V_C1IN) + l * cfg::NIN + np0; c2o = (float*)(ws + cfg::V_C2IN) + l * cfg::NIN + np0;
            } else { const int p0 = (nb - 72) * 32, dir = p0 >> 7, kk0 = p0 & 127, np0 = 2816 + p0;
                for (int kb = wave; kb < 16; kb += 8) { const int kq = kb * 64; ValGate v{w_in + ((size_t)l * 1024 + kq) * cfg::INW + 2560 + 16 * dir, gw2 + (size_t)((l * 2 + dir) * 16) * 128 + kk0};
                    tile_item<true>(v, 1024, Wt + (size_t)np0 * 1024 + kq, lngb ? lngb + kq : lngb, lnbb ? lnbb + kq : lnbb, a1, a2, scr, lane); }
                c1o = (float*)(ws + cfg::V_C1IN) + l * cfg::NIN + np0; c2o = (float*)(ws + cfg::V_C2IN) + l * cfg::NIN + np0; }
        } else { const int nb = r - 80, np0 = nb * 32, pn = np0 >> 8, p = np0 & 255, bj = p >> 7, f0 = 128 * pn + (p & 127);
            const float* W = (bj ? wu : wg) + (size_t)l * 1024 * cfg::FF + f0; bf16_t* Wt = (bf16_t*)(ws + cfg::WS_WGU + l * cfg::SZ_WGU) + (size_t)np0 * 1024;
            tile_dma(W + (size_t)k0 * cfg::FF, cfg::FF, scr, lane); tile_dma(W + (size_t)k1 * cfg::FF, cfg::FF, scr1, lane);
            asm volatile("s_waitcnt vmcnt(0)" ::: "memory");
            tile_emit<true, 32>(1024, Wt + k0, ln1g + l * 1024 + k0, ln1b + l * 1024 + k0, a1, a2, scr, lane);
            tile_emit<true, 32>(1024, Wt + k1, ln1g + l * 1024 + k1, ln1b + l * 1024 + k1, a1, a2, scr1, lane);
            c1o = (float*)(ws + cfg::V_C1GU) + l * cfg::NGU + np0; c2o = (float*)(ws + cfg::V_C2GU) + l * cfg::NGU + np0; }
        if ((lane & 7) == 0) {
#pragma unroll
            for (int j = 0; j < 4; ++j) { const int n = (lane >> 3) + 8 * j; redw[n * 2] = a1[j]; redw[n * 2 + 1] = a2[j]; } }
        __syncthreads();
        if (wave == 0 && lane < 32) { float t1 = 0.f, t2 = 0.f;
#pragma unroll
            for (int w = 0; w < 8; ++w) { const PLAS float* rw = (const PLAS float*)(lds + 131072 + 1024 + w * 256); t1 += rw[lane * 2]; t2 += rw[lane * 2 + 1]; }
            c1o[lane] = t1; c2o[lane] = t2; }
        __syncthreads();
    }
    constexpr int I_OUT = 32 * 16, I_DN = 32 * 44, I_L = I_OUT + I_DN;
    for (int it = gw; it < 2 * I_L; it += 2 * NGW) {
        const float* Ws[2]; int Ns[2], Ks[2]; bf16_t* Wd[2]; float d1[4], d2[4];
#pragma unroll
        for (int q = 0; q < 2; ++q) { const int itq = it + q * NGW; const int ic = itq < 2 * I_L ? itq : it; const int l = ic / I_L; int r = ic - l * I_L;
            if (r < I_OUT) { const int nb = r >> 4, kb = r & 15, k0 = kb * 64, n0 = nb * 32; Ws[q] = w_out + ((size_t)l * 1024 + k0) * 1024 + n0; Ns[q] = 1024; Ks[q] = 1024;
                Wd[q] = (bf16_t*)(ws + cfg::WS_WOUT + l * cfg::SZ_WOUT) + (size_t)n0 * 1024 + k0; }
            else { r -= I_OUT; const int nb = r / 44, kb = r - nb * 44, k0 = kb * 64, n0 = nb * 32; Ws[q] = wd + ((size_t)l * cfg::FF + k0) * 1024 + n0; Ns[q] = 1024; Ks[q] = cfg::FF;
                Wd[q] = (bf16_t*)(ws + cfg::WS_WDN + l * cfg::SZ_WDN) + (size_t)n0 * cfg::FF + k0; } }
        tile_dma(Ws[0], Ns[0], scr, lane); tile_dma(Ws[1], Ns[1], scr1, lane);
        asm volatile("s_waitcnt vmcnt(0)" ::: "memory");
        tile_emit<false, 32>(Ks[0], Wd[0], (const float*)nullptr, (const float*)nullptr, d1, d2, scr, lane);
        if (it + NGW < 2 * I_L) tile_emit<false, 32>(Ks[1], Wd[1], (const float*)nullptr, (const float*)nullptr, d1, d2, scr1, lane);
    }
    const int xw = (vcu - 64) * 8 + wave, NXW = (G - 64) * 8;
    if (vcu >= 64 && G > 64)
    for (int m = xw; m < cfg::T; m += 4 * NXW) {
        f32x4 v[4][4];
#pragma unroll
        for (int q = 0; q < 4; ++q) { const int mr = (m + q * NXW) < cfg::T ? (m + q * NXW) : m; const f32x4* xr = (const f32x4*)(x + (size_t)mr * 1024) + lane;
#pragma unroll
            for (int j = 0; j < 4; ++j) v[q][j] = xr[64 * j]; }
#pragma unroll
        for (int q = 0; q < 4; ++q) { const int mr = (m + q * NXW) < cfg::T ? (m + q * NXW) : m; unsigned long long* o8 = (unsigned long long*)((bf16_t*)(ws + cfg::WS_XB) + (size_t)mr * 1024) + lane;
#pragma unroll
            for (int j = 0; j < 4; ++j) o8[64 * j] = (unsigned long long)pk2(v[q][j][0], v[q][j][1]) | ((unsigned long long)pk2(v[q][j][2], v[q][j][3]) << 32); } }
    for (int i = gw * 64 + lane; i < 2048 * 32; i += NGW * 64) { const int pos = i >> 5, f = i & 31; const float inv = exp2f(-(float)f * (13.287712379549449f / 32.f)); const float ang = (float)pos * inv;
        double rv = (double)ang * 0.15915494309189535; rv -= floor(rv); const float rev = (float)rv;
        ((float*)(ws + cfg::V_ROPEC))[i] = __builtin_amdgcn_cosf(rev); ((float*)(ws + cfg::V_ROPES))[i] = __builtin_amdgcn_sinf(rev); }
}
#undef PLAS
}
constexpr int NWAVES = 8;
constexpr int RING_OFF = 0, RING_BYTES = 131072;
constexpr int LDSCTL_OFF = RING_BYTES, MISC_OFF = LDSCTL_OFF + 320;
constexpr int RSL_OFF = 131072 + 4096;
constexpr int LDS_BYTES = 147456;
constexpr int CW_BAR = 4096;
constexpr size_t CTL_ZERO_BYTES = 64 * 1024;
#define GAS __attribute__((address_space(1)))
#define LAS __attribute__((address_space(3)))
typedef GAS unsigned gu32;
#define RLX_AGENT __ATOMIC_RELAXED, __HIP_MEMORY_SCOPE_AGENT
#define XB_TMO      128
#define XB_XCNT(j)  (256  + 64 * (j))
#define XB_XSUB(j)  (1280 + 64 * (j))
#define XB_XGEN(j)  (2304 + 64 * (j))
#define XB_TOP      3328
#define XB_TOPGEN   3392
#define XCD_BAR_WORDS 3456
#define XB_SPIN_CAP (1u << 18)

__device__ __forceinline__ unsigned xb_ld(unsigned* p)              { return __hip_atomic_load(p, __ATOMIC_RELAXED, __HIP_MEMORY_SCOPE_AGENT); }
__device__ __forceinline__ unsigned xb_add(unsigned* p, unsigned v) { return __hip_atomic_fetch_add(p, v, __ATOMIC_RELAXED, __HIP_MEMORY_SCOPE_AGENT); }
__device__ __forceinline__ unsigned xb_xcc_id() { return (unsigned)__builtin_amdgcn_s_getreg((3 << 11) | 20) & 0xFu; }
#define XB_SPIN(cond, bar) do { unsigned _sp = 0; while (cond) { __builtin_amdgcn_s_sleep(1); \
    if ((++_sp & 255u) == 0u) { if (xb_ld(&(bar)[XB_TMO])) break; if (_sp > XB_SPIN_CAP) { atomicAdd(&(bar)[XB_TMO], 1u); break; } } } } while (0)

struct XcdBarrier {
    unsigned* bar; unsigned x;
    volatile LAS unsigned* st;
};

__device__ __forceinline__ XcdBarrier xcd_barrier_post(unsigned* bar, volatile LAS unsigned* st) {
    XcdBarrier b; b.bar = bar; b.x = xb_xcc_id(); b.st = st;
    if (threadIdx.x == 0) (void)xb_add(&bar[XB_XCNT(b.x)], 1u);
    return b;
}
__device__ __forceinline__ void xcd_barrier_complete(unsigned* bar, unsigned x, unsigned& nloc, unsigned& nx) {
    const unsigned G = gridDim.x * gridDim.y * gridDim.z;
    unsigned sum, cnt, mine, sp = 0u;
    for (;;) {
        sum = 0u; cnt = 0u; mine = 0u;
#pragma unroll
        for (unsigned j = 0; j < 16; ++j) { const unsigned c = xb_ld(&bar[XB_XCNT(j)]); sum += c; cnt += (c > 0u) ? 1u : 0u; mine = (j == x) ? c : mine; }
        if (sum == G) break;
        __builtin_amdgcn_s_sleep(1);
        if ((++sp & 255u) == 0u) { if (xb_ld(&bar[XB_TMO])) break; if (sp > XB_SPIN_CAP) { atomicAdd(&bar[XB_TMO], 1u); break; } }
    }
    nloc = mine > 0u ? mine : 1u; nx = cnt > 0u ? cnt : 1u;
}

__device__ __forceinline__ void xcd_barrier(const XcdBarrier& b) {
    asm volatile("s_waitcnt vmcnt(0)" ::: "memory");
    __syncthreads();
    if (threadIdx.x == 0) {
        unsigned* bar = b.bar;
        __builtin_amdgcn_s_waitcnt(0);
        unsigned nloc = b.st[0], nx = b.st[1];
        if (nloc == 0u) { xcd_barrier_complete(bar, b.x, nloc, nx); b.st[0] = nloc; b.st[1] = nx; }
        const unsigned old = xb_add(&bar[XB_XSUB(b.x)], 1u);
        const unsigned gen = old / nloc;
        if (old + 1u == (gen + 1u) * nloc) {
            __builtin_amdgcn_fence(__ATOMIC_RELEASE, "agent");
            asm volatile("s_waitcnt vmcnt(0)" ::: "memory");
            const unsigned og = xb_add(&bar[XB_TOP], 1u);
            const unsigned tg = og / nx;
            if (og + 1u == (tg + 1u) * nx) xb_add(&bar[XB_TOPGEN], 1u);
            else XB_SPIN(xb_ld(&bar[XB_TOPGEN]) == tg, bar);
            __builtin_amdgcn_fence(__ATOMIC_ACQUIRE, "agent");
            xb_add(&bar[XB_XGEN(b.x)], 1u);
            asm volatile("s_waitcnt vmcnt(0)" ::: "memory");
        } else {
            XB_SPIN(xb_ld(&bar[XB_XGEN(b.x)]) == gen, bar);
            __builtin_amdgcn_fence(__ATOMIC_ACQUIRE, "agent");
            asm volatile("s_waitcnt vmcnt(0)" ::: "memory");
        }
    }
    __syncthreads();
}


#define FILL_RSL(STP) do { pg8::Unit u0_; if (S.next(0, u0_)) { int tq_ = threadIdx.x; asm volatile("" : "+v"(tq_)); const int row_ = u0_.pm * 256 + (tq_ >> 1), hf_ = tq_ & 1; \
    typedef float f32x4_ __attribute__((ext_vector_type(4))); typedef float f32x2_ __attribute__((ext_vector_type(2))); \
    const f32x4_* sp_ = (const f32x4_*)((STP) + (size_t)row_ * 32 + hf_ * 16); const f32x4_ x0 = sp_[0], x1 = sp_[1], x2 = sp_[2], x3 = sp_[3]; \
    float sm_ = ((x0[0] + x0[2]) + (x1[0] + x1[2])) + ((x2[0] + x2[2]) + (x3[0] + x3[2])), sq_ = ((x0[1] + x0[3]) + (x1[1] + x1[3])) + ((x2[1] + x2[3]) + (x3[1] + x3[3])); \
    sm_ = xadd<1>(sm_); sq_ = xadd<1>(sq_); const float mu_ = sm_ * (1.f / 1024.f), rstd_ = rsqrtf(fmaxf(sq_ * (1.f / 1024.f) - mu_ * mu_, 0.f) + EPS); \
    if (hf_ == 0) *(LAS f32x2_*)(ldsl + RSL_OFF + 8 * (tq_ >> 1)) = (f32x2_){rstd_, -rstd_ * mu_}; } \
    __syncthreads(); } while (0)

enum { PH_PRO = 0, PH_IN = 1, PH_ATT = 2, PH_MIXB = 3, PH_OUT = 4, PH_GU = 5, PH_DN = 6, PH_FIN = 13, N_PHASES = 14 };
struct MArgs { const float* in[16]; float* out; unsigned char* ws; int ph_lo, ph_hi, li, pad; };

__global__ void __launch_bounds__(NWAVES * 64, 2) mk_fwd(MArgs a) {
    extern __shared__ __attribute__((aligned(128))) unsigned char lds[];
    LAS unsigned char* ldsl = (LAS unsigned char*)lds;
    volatile LAS unsigned* MISC = (volatile LAS unsigned*)(ldsl + MISC_OFF);
    const int tid = threadIdx.x;
    const int G = gridDim.x, bx = blockIdx.x, vcu = (G % 8 == 0) ? (bx % 8) * (G / 8) + bx / 8 : bx;
    unsigned char* ws = a.ws;
    for (int u = tid; u < (LDS_BYTES - LDSCTL_OFF) / 4; u += NWAVES * 64) ((LAS unsigned*)(ldsl + LDSCTL_OFF))[u] = 0u;
    __syncthreads();
    XcdBarrier bar; bar.bar = (unsigned*)(ws + WS_CTL) + CW_BAR + a.li * XCD_BAR_WORDS; bar.x = 0; bar.st = nullptr;
    if (a.ph_hi - a.ph_lo > 1) bar = xcd_barrier_post((unsigned*)(ws + WS_CTL) + CW_BAR + a.li * XCD_BAR_WORDS, MISC + 8);
    const int G0 = G, bx0 = bx, vcu0 = vcu; unsigned char* const ws0 = ws;
    for (int ph = a.ph_lo; ph < a.ph_hi; ++ph) {
        int G = G0, bx = bx0, vcu = vcu0; unsigned zo = 0u; asm volatile("" : "+s"(G), "+s"(bx), "+s"(vcu), "+s"(zo)); unsigned char* ws = ws0 + zo;
        const int l = (ph >= 1 && ph <= 12) ? (ph - 1) / 6 : 0;
        const int kind = (ph == 0) ? PH_PRO : (ph == PH_FIN ? PH_FIN : 1 + (ph - 1) % 6);
        if (kind == PH_PRO) {
            { pro::Inputs pin{a.in[0], a.in[1], a.in[4], a.in[5], a.in[8], a.in[9], a.in[10], a.in[11], a.in[12], a.in[13], a.in[14], a.in[15]}; pro::prologue(ws, pin, ldsl + RING_OFF, vcu, G); }
        } else if (kind == PH_IN) {
            pg8::Gemm g{(const bf16_t*)(ws + WS_XB), (const bf16_t*)(ws + WS_WIN + l * SZ_WIN), T, NIN, D}; pg8::StaticOrder S; S.init(T, NIN, G, bx);
            if (l) FILL_RSL((const float*)(ws + WS_ST2));
            pg8::FEpiIn E{ws, a.in[6] + l * 256, l, (const LAS float*)(ldsl + RSL_OFF)};
            pg8::gemm_phase<pg8::FEpiIn, pg8::StaticOrder, true, true>(ldsl + RING_OFF, g, S, E);
        } else if (kind == PH_ATT) {
            for (int i = 0; i < 2; ++i) { const int idx = vcu * 2 + i; if (idx >= 512) break; const int bh = idx >> 4, qb = idx & 15;
                att::attn_unit(bh >> 2, bh & 3, qb, (const bf16_t*)(ws + WS_Q), (const bf16_t*)(ws + WS_K), (const bf16_t*)(ws + WS_V), (bf16_t*)(ws + WS_OC), a.in[2] + l * 256, a.in[3] + l * 128, l, (char*)lds + RING_OFF); }
            for (int i = 0; i < 2; ++i) { const int it = vcu * 2 + i; if (it >= 512) break;
                                fft::stage1_item(it >> 6, it & 63, (const bf16_t*)(ws + WS_TAB), (bf16_t*)(ws + WS_XT), ldsl + RING_OFF); }

            if (vcu < 256) gla::gla_a_item(vcu >> 5, (vcu >> 3) & 3, vcu & 7, ws, ldsl + RING_OFF);
        } else if (kind == PH_MIXB) {
            if (vcu < 256) fft::stage2_item(vcu >> 5, vcu & 31, (const bf16_t*)(ws + WS_XT), (bf16_t*)(ws + WS_OC), ldsl + RING_OFF);
            if (vcu < 256) gla::gla_b_item(vcu >> 5, (vcu >> 3) & 3, vcu & 7, ws, a.in[7] + l * 64, (bf16_t*)(ws + WS_OC), ldsl + RING_OFF);
        } else if (kind == PH_OUT) {
            pg8::Gemm g{(const bf16_t*)(ws + WS_OC), (const bf16_t*)(ws + WS_WOUT + l * SZ_WOUT), T, D, D}; pg8::StaticOrder S; S.init(T, D, G, bx);
            if (l) FILL_RSL((const float*)(ws + WS_ST2));
            pg8::FEpiRes E{l ? (const LAS float*)(ldsl + RSL_OFF) : (const LAS float*)nullptr, a.in[14] + (l ? l - 1 : 0) * 1024, a.in[15] + (l ? l - 1 : 0) * 1024, (bf16_t*)(ws + WS_XB), (float*)(ws + WS_ST1)};
            pg8::gemm_phase<pg8::FEpiRes, pg8::StaticOrder, true, true>(ldsl + RING_OFF, g, S, E);
        } else if (kind == PH_GU) {
            pg8::Gemm g{(const bf16_t*)(ws + WS_XB), (const bf16_t*)(ws + WS_WGU + l * SZ_WGU), T, NGU, D}; pg8::StaticOrder S; S.init(T, NGU, G, bx);
            FILL_RSL((const float*)(ws + WS_ST1));
            pg8::FEpiGU E{(const LAS float*)(ldsl + RSL_OFF), (const float*)(ws + V_C1GU) + l * NGU, (const float*)(ws + V_C2GU) + l * NGU, (bf16_t*)(ws + WS_ACT)};
            pg8::gemm_phase<pg8::FEpiGU, pg8::StaticOrder, true, true>(ldsl + RING_OFF, g, S, E);
        } else if (kind == PH_DN) {
            pg8::Gemm g{(const bf16_t*)(ws + WS_ACT), (const bf16_t*)(ws + WS_WDN + l * SZ_WDN), T, D, FF}; pg8::StaticOrder S; S.init(T, D, G, bx);
            FILL_RSL((const float*)(ws + WS_ST1));
            pg8::FEpiRes E{(const LAS float*)(ldsl + RSL_OFF), a.in[9] + l * 1024, a.in[10] + l * 1024, (bf16_t*)(ws + WS_XB), (float*)(ws + WS_ST2)};
            pg8::gemm_phase<pg8::FEpiRes, pg8::StaticOrder, true, true>(ldsl + RING_OFF, g, S, E);
        } else if (kind == PH_FIN) {
            const float* g2 = a.in[14] + 1024; const float* b2v = a.in[15] + 1024; const float* ST2 = (const float*)(ws + WS_ST2); const bf16_t* XB = (const bf16_t*)(ws + WS_XB); float* Y2 = a.out;
            int tid_f = threadIdx.x; asm volatile("" : "+v"(tid_f)); const int lane = tid_f & 63, wave = __builtin_amdgcn_readfirstlane(tid_f >> 6);
            typedef float f32x4 __attribute__((ext_vector_type(4))); typedef unsigned u32x2 __attribute__((ext_vector_type(2)));
            f32x4 gg[4], bq[4];
#pragma unroll
            for (int j = 0; j < 4; ++j) { gg[j] = *((const f32x4*)g2 + lane + 64 * j); bq[j] = *((const f32x4*)b2v + lane + 64 * j); }
            for (int row = vcu * NWAVES + wave; row < T; row += G * NWAVES) { const RowStat rs = row_stat(ST2, row);
                const u32x2* xr = (const u32x2*)(XB + (size_t)row * 1024) + lane; f32x4* yr = (f32x4*)(Y2 + (size_t)row * 1024) + lane;
#pragma unroll
                for (int j = 0; j < 4; ++j) { const u32x2 w = xr[64 * j]; const f32x4 v = {__uint_as_float(w.x << 16), __uint_as_float(w.x & 0xffff0000u), __uint_as_float(w.y << 16), __uint_as_float(w.y & 0xffff0000u)};
                    yr[64 * j] = (v - rs.mu) * rs.rstd * gg[j] + bq[j]; } }
        }
        if (ph + 1 < a.ph_hi) xcd_barrier(bar);
    }
}

static void launch_frame(const MArgs& base, int lo, int hi, int grid, hipStream_t stream, int li = 0) {
    MArgs a = base; a.ph_lo = lo; a.ph_hi = hi; a.li = li;
    hipLaunchKernelGGL(mk_fwd, dim3(grid), dim3(NWAVES * 64), LDS_BYTES, stream, a);
}
extern "C" void kernel_launch(void* const* d_in, const int* in_sizes, int n_in, void* d_out, int out_size, void* d_ws, size_t ws_size, hipStream_t stream) {
    static int grid = 0;
    if (grid == 0) {
        if (n_in != 16 || in_sizes[0] != T * D || out_size != T * D || ws_size < WS_END) { fprintf(stderr, "kernel_launch: unexpected shapes (n_in %d, in0 %d, out %d, ws %zu)\n", n_in, n_in > 0 ? in_sizes[0] : -1, out_size, ws_size); grid = -1; return; }
        int dev = 0, cus = 0, per_cu = 0;
        if (hipGetDevice(&dev) != hipSuccess || hipDeviceGetAttribute(&cus, hipDeviceAttributeMultiprocessorCount, dev) != hipSuccess) { grid = -1; return; }
        if (hipFuncSetAttribute((const void*)mk_fwd, hipFuncAttributeMaxDynamicSharedMemorySize, LDS_BYTES) != hipSuccess) { fprintf(stderr, "kernel_launch: hipFuncSetAttribute failed\n"); grid = -1; return; }
        if (hipOccupancyMaxActiveBlocksPerMultiprocessor(&per_cu, (const void*)mk_fwd, NWAVES * 64, LDS_BYTES) != hipSuccess || per_cu < 1) { fprintf(stderr, "kernel_launch: occupancy query says %d workgroups per CU\n", per_cu); per_cu = 1; }
        (void)hipGetLastError();
        grid = cus;
        if (grid != 256) { fprintf(stderr, "kernel_launch: this kernel's work split is built for the 256 CUs of an MI355X, found %d; nothing launched\n", cus); grid = -1; return; }
    }
    if (grid < 0) return;
    const float* x = (const float*)d_in[0]; const float* w_in = (const float*)d_in[1]; const float* dlam = (const float*)d_in[2]; const float* dng = (const float*)d_in[3];
    const float* fw = (const float*)d_in[4]; const float* gw2 = (const float*)d_in[5]; const float* gb2 = (const float*)d_in[6]; const float* gng = (const float*)d_in[7];
    const float* w_out = (const float*)d_in[8]; const float* ln1g = (const float*)d_in[9]; const float* ln1b = (const float*)d_in[10];
    const float* wg = (const float*)d_in[11]; const float* wu = (const float*)d_in[12]; const float* wd = (const float*)d_in[13]; const float* ln2g = (const float*)d_in[14]; const float* ln2b = (const float*)d_in[15];
    char* ws = (char*)d_ws;
    float* ropec = (float*)(ws + V_ROPEC); float* ropes = (float*)(ws + V_ROPES); float* MF = (float*)(ws + V_MF);
    float* c1in = (float*)(ws + V_C1IN); float* c2in = (float*)(ws + V_C2IN); float* c1gu = (float*)(ws + V_C1GU); float* c2gu = (float*)(ws + V_C2GU);
    bf16_t* TAB = (bf16_t*)(ws + WS_TAB); bf16_t* XB = (bf16_t*)(ws + WS_XB);
    bf16_t* Q = (bf16_t*)(ws + WS_Q); bf16_t* K = (bf16_t*)(ws + WS_K); bf16_t* V = (bf16_t*)(ws + WS_V);
    bf16_t* GQK = (bf16_t*)(ws + WS_GQK); bf16_t* GV = (bf16_t*)(ws + WS_GV); bf16_t* GR = (bf16_t*)(ws + WS_GR); float* GL = (float*)(ws + WS_GL);
    bf16_t* OC = (bf16_t*)(ws + WS_OC); float* OF = (float*)(ws + WS_OF);
    (void)hipMemsetAsync(ws + WS_CTL, 0, CTL_ZERO_BYTES, stream);
    MArgs base{}; for (int i = 0; i < 16; ++i) base.in[i] = (const float*)d_in[i]; base.out = (float*)d_out; base.ws = (unsigned char*)d_ws;
    launch_frame(base, 0, N_PHASES, grid, stream, 0);
}
```

```cpp
#include <hip/hip_runtime.h>
#include <cstdint>
#include <cstdio>
#include <cmath>

typedef unsigned short bf16_t;
namespace cfg {
constexpr int B = 8, S = 2048, D = 1024, T = B * S, L = 2;
constexpr int INW = 2592, NIN = 3072, FF = 2816, NGU = 2 * FF;
constexpr float ALPHA = 1.41421356237309515f;
constexpr float EPS = 1e-5f;
constexpr float QSCALE = 0.125f * 1.4426950408889634f;
constexpr float GQSCALE = 0.17677669529663687f;
constexpr size_t MiB = 1u << 20;
constexpr size_t WS_CTL = 0;
constexpr size_t WS_VEC = 1 * MiB;
constexpr size_t V_ROPEC = WS_VEC, V_ROPES = WS_VEC + 256 * 1024, V_MF = WS_VEC + 512 * 1024;
constexpr size_t V_C1IN = WS_VEC + 768 * 1024, V_C2IN = V_C1IN + 24 * 1024, V_C1GU = V_C2IN + 24 * 1024, V_C2GU = V_C1GU + 44 * 1024;
constexpr size_t WS_WIN = 2 * MiB, WS_WOUT = 14 * MiB, WS_WGU = 18 * MiB, WS_WDN = 40 * MiB, WS_TAB = 51 * MiB;
constexpr size_t SZ_WIN = 6 * MiB, SZ_WOUT = 2 * MiB, SZ_WGU = 11 * MiB, SZ_WDN = 5632 * 1024;
constexpr size_t WS_XB = 67 * MiB;
constexpr size_t WS_Y1 = 99 * MiB, WS_Q = 99 * MiB, WS_K = 115 * MiB, WS_V = 131 * MiB, WS_XT = 147 * MiB;
constexpr size_t WS_ACT = 163 * MiB, WS_GQK = 163 * MiB, WS_GV = 171 * MiB, WS_GR = 179 * MiB, WS_GL = 187 * MiB, WS_OC = 203 * MiB, WS_OF = 235 * MiB;
constexpr size_t WS_ST1 = 251 * MiB, WS_ST2 = 253 * MiB, WS_DEC = 255 * MiB, WS_END = 256 * MiB;
}
using namespace cfg;

__device__ __forceinline__ float bf2f(bf16_t v) { return __uint_as_float((unsigned)v << 16); }
__device__ __forceinline__ bf16_t f2bf(float f) { unsigned u = __float_as_uint(f); return (bf16_t)((u + 0x7fffu + ((u >> 16) & 1u)) >> 16); }


template <int M> __device__ __forceinline__ float xadd(float v) {
    if constexpr (M == 32) { auto r = __builtin_amdgcn_permlane32_swap(__float_as_uint(v), __float_as_uint(v), false, false); return __uint_as_float(r[0]) + __uint_as_float(r[1]); }
    else return v + __int_as_float(__builtin_amdgcn_ds_swizzle(__float_as_int(v), (M << 10) | 0x1f));
}
struct RowStat { float mu, rstd; };
__device__ __forceinline__ RowStat row_stat(const float* ST, int row) {
    float s = 0.f, ss = 0.f;
    for (int i = 0; i < 8; ++i) { const float4 a = *(const float4*)(ST + (size_t)row * 32 + 4 * i); s += a.x + a.z; ss += a.y + a.w; }
    const float mu = s * (1.f / 1024.f); const float var = ss * (1.f / 1024.f) - mu * mu;
    RowStat r; r.mu = mu; r.rstd = rsqrtf(fmaxf(var, 0.f) + EPS); return r;
}
namespace pg8 {
#define PG8_LAS __attribute__((address_space(3)))
typedef unsigned short bf16_t;
typedef short bf16x8 __attribute__((ext_vector_type(8)));
typedef float f32x4 __attribute__((ext_vector_type(4)));
typedef unsigned u32x4 __attribute__((ext_vector_type(4)));
constexpr int BM = 256, BK = 64, HALF = 128, HTB = HALF * BK * 2  , STAGE_BYTES = 8 * HTB, NXCD = 8, WGM = 8;

__host__ __device__ __forceinline__ int lds_byte(int r, int c) { const int st = (r >> 4) * 2 + (c >> 5), rr = r & 15, cc = c & 31, ob = rr * 64 + cc * 2; return st * 1024 + (ob ^ (((ob >> 9) & 1) << 5)); }
__host__ __device__ __forceinline__ void stage_rc(int b, int& R, int& C) { const int st = b / 1024, sb = b % 1024, swz = sb ^ (((sb >> 9) & 1) << 5); R = (st >> 1) * 16 + swz / 64; C = (st & 1) * 32 + (swz % 64) / 2; }
__host__ __device__ __forceinline__ int perm32(int rho) { const int n = rho >> 4, i = rho & 15; return 8 * (i >> 2) + 4 * n + (i & 3); }

struct Unit { int pm, pn; };
struct Gemm { const bf16_t* A; const bf16_t* Bt; int M, N, K; };

struct StaticOrder {
    int nM, nN, nwg, G, c;
    __host__ __device__ void init(int M, int N, int G_, int c_) { nM = M / BM; nN = N / BM; nwg = nM * nN; G = G_; c = c_; }
    __host__ __device__ bool next(int i, Unit& u) const {
        const long L = (long)i * G + c; if (L >= nwg) return false;
        int wgid = (int)L; { const int q = nwg / NXCD, r = nwg % NXCD, xcd = wgid % NXCD, off = wgid / NXCD; wgid = (xcd < r ? xcd * (q + 1) : r * (q + 1) + (xcd - r) * q) + off; }
        const int nig = WGM * nN, gid = wgid / nig, fm = gid * WGM, gsz = (nM - fm) < WGM ? (nM - fm) : WGM;
        u.pm = fm + ((wgid % nig) % gsz); u.pn = (wgid % nig) / gsz; return true;
    }
    __device__ __forceinline__ void a_ready(const Unit&) const {}
    __device__ __forceinline__ void done(const Unit&) const {}
};
template <class Epi, class Sched, bool ALIGN_EPI = false, bool SP2 = false>
__device__ __forceinline__ void gemm_phase(PG8_LAS unsigned char* lds, const Gemm g, const Sched& S, const Epi& E) {
    int tid_o = threadIdx.x; asm volatile("" : "+v"(tid_o));
    const int tid = tid_o, wid = __builtin_amdgcn_readfirstlane(tid >> 6), lane = tid & 63, wr = wid >> 2, wc = wid & 3, fr = lane & 15, fq = lane >> 4;
    const int K = g.K, nt = K / BK;
    unsigned voffA[2], voffB[2];
#pragma unroll
    for (int i = 0; i < 2; ++i) { int R, C; stage_rc(tid * 16 + i * 8192, R, C); const int Rb = Epi::PERM ? ((R & ~31) + perm32(R & 31)) : R;
        voffA[i] = (unsigned)(R * K + C) * 2u; voffB[i] = (unsigned)(Rb * K + C) * 2u; }
    const size_t kstep = (size_t)(BK * 2);
    const size_t hstep = (size_t)HALF * K * 2;
    const size_t tstep = 2 * hstep;
    const unsigned ldsw = (unsigned)wid * 1024u;
    const int aoff = lds_byte(wr * 64 + fr, fq * 8), boff = lds_byte(wc * 32 + fr, fq * 8);
#define PG8_SA(b, h) (((b) * 2 + (h)) * HTB)
#define PG8_SB(b, h) ((4 + (b) * 2 + (h)) * HTB)
#define PG8_STAGE(bufoff, gbase, voff) do { _Pragma("unroll") for (int _i = 0; _i < 2; ++_i) \
        __builtin_amdgcn_global_load_lds((const unsigned*)((const char*)(gbase) + (voff)[_i]), (PG8_LAS unsigned*)(lds + (bufoff) + ldsw + _i * 8192), 16, 0, 0); } while (0)
#define PG8_LDA(dst, b, h) do { _Pragma("unroll") for (int m = 0; m < 4; ++m) _Pragma("unroll") for (int k = 0; k < 2; ++k) dst[m][k] = *(const PG8_LAS bf16x8*)(lds + PG8_SA(b, h) + aoff + m * 2048 + k * 1024); } while (0)
#define PG8_LDB(dst, b, h) do { _Pragma("unroll") for (int n = 0; n < 2; ++n) _Pragma("unroll") for (int k = 0; k < 2; ++k) dst[n][k] = *(const PG8_LAS bf16x8*)(lds + PG8_SB(b, h) + boff + n * 2048 + k * 1024); } while (0)
#define PG8_MMA(ai, bj, At, Bt) do { __builtin_amdgcn_s_setprio(1); _Pragma("unroll") for (int m = 0; m < 4; ++m) _Pragma("unroll") for (int n = 0; n < 2; ++n) _Pragma("unroll") for (int k = 0; k < 2; ++k) \
        acc[ai][bj][m][n] = __builtin_amdgcn_mfma_f32_16x16x32_bf16(Bt[n][k], At[m][k], acc[ai][bj][m][n], 0, 0, 0); __builtin_amdgcn_s_setprio(0); } while (0)
#define PG8_WAIT_V(n) asm volatile("s_waitcnt vmcnt(" #n ")" ::: "memory")
#define PG8_WAIT_L(n) asm volatile("s_waitcnt lgkmcnt(" #n ")" ::: "memory")
#define PG8_BAR __builtin_amdgcn_s_barrier()
#define PG8_SCHED __builtin_amdgcn_sched_barrier(0)
    Unit cur, nxt; int ui = 0;
    if (!S.next(0, cur)) return;
    f32x4 acc[2][2][4][2];
#pragma unroll
    for (int a = 0; a < 2; ++a)
#pragma unroll
        for (int b = 0; b < 2; ++b)
#pragma unroll
            for (int m = 0; m < 4; ++m)
#pragma unroll
                for (int n = 0; n < 2; ++n) acc[a][b][m][n] = (f32x4){0.f, 0.f, 0.f, 0.f};
    bf16x8 At[4][2], B0[2][2], B1[2][2];
    const char* cA = (const char*)g.A + (size_t)cur.pm * tstep; const char* cB = (const char*)g.Bt + (size_t)cur.pn * tstep;
    S.a_ready(cur);
    if constexpr (SP2) {
        PG8_STAGE(PG8_SB(0, 0), cB, voffB); PG8_STAGE(PG8_SB(0, 1), cB + hstep, voffB); PG8_STAGE(PG8_SA(0, 0), cA, voffA); PG8_STAGE(PG8_SA(0, 1), cA + hstep, voffA);
        if (wr == 1) PG8_BAR;
        PG8_WAIT_V(2); PG8_BAR;
        PG8_STAGE(PG8_SB(1, 0), cB + kstep, voffB); PG8_STAGE(PG8_SA(1, 0), cA + kstep, voffA); PG8_STAGE(PG8_SB(1, 1), cB + hstep + kstep, voffB);
        PG8_WAIT_V(6); PG8_BAR;
    } else {
        PG8_STAGE(PG8_SB(0, 0), cB, voffB); PG8_STAGE(PG8_SA(0, 0), cA, voffA); PG8_STAGE(PG8_SB(0, 1), cB + hstep, voffB); PG8_STAGE(PG8_SA(0, 1), cA + hstep, voffA);
        if (wr == 1) PG8_BAR;
        PG8_WAIT_V(4); PG8_BAR;
        PG8_STAGE(PG8_SB(1, 0), cB + kstep, voffB); PG8_STAGE(PG8_SA(1, 0), cA + kstep, voffA); PG8_STAGE(PG8_SB(1, 1), cB + hstep + kstep, voffB);
        PG8_WAIT_V(6); PG8_BAR;
    }
    for (;;) {
        const bool has_next = S.next(ui + 1, nxt);
        const char* nA = has_next ? (const char*)g.A + (size_t)nxt.pm * tstep : cA; const char* nB = has_next ? (const char*)g.Bt + (size_t)nxt.pn * tstep : cB;
        for (int t = 0; t < nt; t += 2) {
            const bool last = (t == nt - 2);
            const char* a1 = cA + (size_t)(t + 1) * kstep;
            const char* a2 = last ? nA : cA + (size_t)(t + 2) * kstep; const char* b2 = last ? nB : cB + (size_t)(t + 2) * kstep;
            const char* a3 = a2 + kstep; const char* b3 = b2 + kstep;
            if (last && has_next) S.a_ready(nxt);
            if constexpr (SP2) {
            PG8_LDB(B0, 0, 0); PG8_LDB(B1, 0, 1); PG8_SCHED; PG8_LDA(At, 0, 0); PG8_STAGE(PG8_SA(1, 1), a1 + hstep, voffA);
            PG8_WAIT_V(8); PG8_WAIT_L(0); PG8_BAR; PG8_MMA(0, 0, At, B0); PG8_MMA(0, 1, At, B1); PG8_BAR; PG8_SCHED;
            PG8_LDA(At, 0, 1); PG8_STAGE(PG8_SB(0, 0), b2, voffB); PG8_STAGE(PG8_SB(0, 1), b2 + hstep, voffB); PG8_STAGE(PG8_SA(0, 0), a2, voffA);
            PG8_WAIT_V(8); PG8_WAIT_L(0); PG8_BAR; PG8_MMA(1, 0, At, B0); PG8_MMA(1, 1, At, B1); PG8_BAR; PG8_SCHED;
            PG8_LDB(B0, 1, 0); PG8_LDB(B1, 1, 1); PG8_SCHED; PG8_LDA(At, 1, 0); PG8_STAGE(PG8_SA(0, 1), a2 + hstep, voffA);
            PG8_WAIT_V(8); PG8_WAIT_L(0); PG8_BAR; PG8_MMA(0, 0, At, B0); PG8_MMA(0, 1, At, B1); PG8_BAR; PG8_SCHED;
            PG8_LDA(At, 1, 1); PG8_STAGE(PG8_SB(1, 0), b3, voffB); PG8_STAGE(PG8_SB(1, 1), b3 + hstep, voffB); PG8_STAGE(PG8_SA(1, 0), a3, voffA);
            PG8_WAIT_V(8); PG8_WAIT_L(0); PG8_BAR; PG8_MMA(1, 0, At, B0); PG8_MMA(1, 1, At, B1); PG8_BAR; PG8_SCHED;
            } else {
            PG8_LDB(B0, 0, 0); PG8_SCHED; PG8_LDA(At, 0, 0); PG8_STAGE(PG8_SA(1, 1), a1 + hstep, voffA);
            PG8_WAIT_L(8); PG8_BAR; PG8_WAIT_L(0); PG8_MMA(0, 0, At, B0); PG8_BAR; PG8_SCHED;
            PG8_LDB(B1, 0, 1); PG8_STAGE(PG8_SB(0, 0), b2, voffB);
            PG8_BAR; PG8_WAIT_L(0); PG8_MMA(0, 1, At, B1); PG8_BAR;
            PG8_LDA(At, 0, 1); PG8_STAGE(PG8_SA(0, 0), a2, voffA);
            PG8_BAR; PG8_WAIT_L(0); PG8_MMA(1, 0, At, B0); PG8_BAR; PG8_SCHED;
            PG8_STAGE(PG8_SB(0, 1), b2 + hstep, voffB);
            PG8_WAIT_V(6); PG8_BAR; PG8_MMA(1, 1, At, B1); PG8_BAR;
            PG8_LDB(B0, 1, 0); PG8_SCHED; PG8_LDA(At, 1, 0); PG8_STAGE(PG8_SA(0, 1), a2 + hstep, voffA);
            PG8_WAIT_L(8); PG8_BAR; PG8_WAIT_L(0); PG8_MMA(0, 0, At, B0); PG8_BAR; PG8_SCHED;
            PG8_LDB(B1, 1, 1); PG8_STAGE(PG8_SB(1, 0), b3, voffB);
            PG8_BAR; PG8_WAIT_L(0); PG8_MMA(0, 1, At, B1); PG8_BAR;
            PG8_LDA(At, 1, 1); PG8_STAGE(PG8_SA(1, 0), a3, voffA);
            PG8_BAR; PG8_WAIT_L(0); PG8_MMA(1, 0, At, B0); PG8_BAR; PG8_SCHED;
            PG8_STAGE(PG8_SB(1, 1), b3 + hstep, voffB);
            PG8_WAIT_V(6); PG8_BAR; PG8_MMA(1, 1, At, B1); PG8_BAR;
            }
        }
        if constexpr (ALIGN_EPI) { if (wr == 0) PG8_BAR; }
        if constexpr (!Epi::AFTER_DRAIN) { E(acc, cur, wr, wc, fr, fq); S.done(cur); }
        if (!has_next) break;
#pragma unroll
        for (int a = 0; a < 2; ++a)
#pragma unroll
            for (int b = 0; b < 2; ++b)
#pragma unroll
                for (int m = 0; m < 4; ++m)
#pragma unroll
                    for (int n = 0; n < 2; ++n) acc[a][b][m][n] = (f32x4){0.f, 0.f, 0.f, 0.f};
        cur = nxt; cA = nA; cB = nB; ++ui;
        if constexpr (ALIGN_EPI) { if (wr == 1) PG8_BAR; }
    }
    PG8_WAIT_V(0);
    if constexpr (!ALIGN_EPI) { if (wr == 0) PG8_BAR; }
    PG8_BAR;
    if constexpr (Epi::AFTER_DRAIN) { E.fused(acc, cur, wr, wc, fr, fq, lds, wid, lane); S.done(cur); }
#undef PG8_SA
#undef PG8_SB
#undef PG8_STAGE
#undef PG8_LDA
#undef PG8_LDB
#undef PG8_MMA
#undef PG8_WAIT_V
#undef PG8_WAIT_L
#undef PG8_BAR
#undef PG8_SCHED
}
}
namespace pg8 {
__device__ __forceinline__ unsigned cvt_pk_bf16(float lo, float hi) { unsigned r; asm volatile("v_cvt_pk_bf16_f32 %0, %1, %2" : "=v"(r) : "v"(lo), "v"(hi)); return r; }
__device__ __forceinline__ void st8(bf16_t* p, const f32x4 a, const f32x4 b) { u32x4 w; w.x = cvt_pk_bf16(a[0], a[1]); w.y = cvt_pk_bf16(a[2], a[3]); w.z = cvt_pk_bf16(b[0], b[1]); w.w = cvt_pk_bf16(b[2], b[3]); *(u32x4*)p = w; }
__device__ __forceinline__ void st8nt(bf16_t* p, const f32x4 a, const f32x4 b) { u32x4 w; w.x = cvt_pk_bf16(a[0], a[1]); w.y = cvt_pk_bf16(a[2], a[3]); w.z = cvt_pk_bf16(b[0], b[1]); w.w = cvt_pk_bf16(b[2], b[3]); __builtin_nontemporal_store(w, (u32x4*)p); }
struct RS { float a, b; };
struct StatLd { f32x4 x, y; };
__device__ __forceinline__ StatLd stat_load(const float* ST, int row, int fq) { const f32x4* p = (const f32x4*)(ST + (size_t)row * 32 + fq * 8); StatLd r; r.x = p[0]; r.y = p[1]; return r; }
__device__ __forceinline__ RS stat_fin(const StatLd& t) {
    float s = (t.x[0] + t.x[2]) + (t.y[0] + t.y[2]), ss = (t.x[1] + t.x[3]) + (t.y[1] + t.y[3]);
    s = xadd<16>(s); ss = xadd<16>(ss); s = xadd<32>(s); ss = xadd<32>(ss);
    const float mu = s * (1.f / 1024.f), var = ss * (1.f / 1024.f) - mu * mu, rstd = rsqrtf(fmaxf(var, 0.f) + cfg::EPS);
    RS r; r.a = rstd; r.b = -rstd * mu; return r;
}
__device__ __forceinline__ RS row_stat16(const float* ST, int row, int fq) { return stat_fin(stat_load(ST, row, fq)); }
__device__ __forceinline__ float fsilu(float x) { return x * __builtin_amdgcn_rcpf(1.f + __expf(-x)); }
__device__ __forceinline__ float flogsig16(float x) { return (fminf(x, 0.f) - __logf(1.f + __expf(-fabsf(x)))) * (1.f / 16.f); }

struct FEpiIn {
    static constexpr bool PERM = true, AFTER_DRAIN = false;
    unsigned char* ws; const float* b2; int l; const PG8_LAS float* rsl;
    struct RowLd { f32x4 rc[2], rsn[2]; };
    template <int KIND> __device__ __forceinline__ RowLd load_row(int row, const float (&invf)[8]) const {
        RowLd r;
        if constexpr (KIND == 0) { const float pos = (float)(row & 2047);
#pragma unroll
            for (int e = 0; e < 8; ++e) { const float ang = pos * invf[e]; double rv = (double)ang * 0.15915494309189535; rv -= floor(rv); const float rev = (float)rv;
                r.rc[e >> 2][e & 3] = __builtin_amdgcn_cosf(rev); r.rsn[e >> 2][e & 3] = __builtin_amdgcn_sinf(rev); } }
        return r;
    }
    template <int KIND> __device__ __forceinline__ void rows(const f32x4 (&acc)[2][2][4][2], const Unit& u, int wr, int wc, int fr, int fq) const {
        const int pn = u.pn, cw = 32 * wc + 8 * fq, row0 = u.pm * BM + 64 * wr + fr;
        const bool st = l != 0;
        f32x4 k1[2][2], k2[2][2], bias[2][2];
        const float qs = __uint_as_float(__builtin_amdgcn_readfirstlane(__float_as_uint(pn < 2 ? cfg::QSCALE : 1.f)));
        float invf[8];
        if constexpr (KIND == 0) {
#pragma unroll
            for (int e = 0; e < 8; ++e) invf[e] = exp2f(-(float)(8 * fq + e) * (13.287712379549449f / 32.f)); }
        RowLd cur = load_row<KIND>(row0, invf), nxt;
        if (st) {
#pragma unroll
            for (int bj = 0; bj < 2; ++bj)
#pragma unroll
                for (int n = 0; n < 2; ++n) {
                    if constexpr (KIND == 2) {
                        const float* fp = (const float*)(ws + cfg::V_MF) + (size_t)(l * 8) * 512 + (pn - 6) * 256 + cw + 128 * bj + 4 * n;
                        k1[bj][n] = (*(const f32x4*)fp + *(const f32x4*)(fp + 1024)) + (*(const f32x4*)(fp + 2048) + *(const f32x4*)(fp + 3072));
                        k2[bj][n] = (*(const f32x4*)(fp + 512) + *(const f32x4*)(fp + 1536)) + (*(const f32x4*)(fp + 2560) + *(const f32x4*)(fp + 3584));
                    } else { const float* c1 = (const float*)(ws + cfg::V_C1IN) + l * cfg::NIN + pn * 256 + cw; const float* c2 = (const float*)(ws + cfg::V_C2IN) + l * cfg::NIN + pn * 256 + cw;
                        k1[bj][n] = *(const f32x4*)(c1 + 128 * bj + 4 * n); k2[bj][n] = *(const f32x4*)(c2 + 128 * bj + 4 * n); } } }
        if constexpr (KIND == 6) {
#pragma unroll
            for (int bj = 0; bj < 2; ++bj)
#pragma unroll
                for (int n = 0; n < 2; ++n) bias[bj][n] = *(const f32x4*)(b2 + 128 * bj + cw + 4 * n); }
#pragma unroll
        for (int i = 0; i < 8; ++i) {
            const int ai = i >> 2, m = i & 3, row = row0 + 128 * ai + 16 * m, pos = row & 2047;
            if (i < 7) nxt = load_row<KIND>(row0 + 128 * ((i + 1) >> 2) + 16 * ((i + 1) & 3), invf);
            f32x4 v[2][2];
            if (st) { typedef float f32x2 __attribute__((ext_vector_type(2))); const f32x2 t2 = *(const PG8_LAS f32x2*)(rsl + 2 * (128 * ai + 64 * wr + 16 * m + fr)); RS rs; rs.a = t2[0]; rs.b = t2[1];
#pragma unroll
                for (int bj = 0; bj < 2; ++bj)
#pragma unroll
                    for (int n = 0; n < 2; ++n) v[bj][n] = rs.a * acc[ai][bj][m][n] + (rs.b * k1[bj][n] + k2[bj][n]);
            } else {
#pragma unroll
                for (int bj = 0; bj < 2; ++bj)
#pragma unroll
                    for (int n = 0; n < 2; ++n) v[bj][n] = acc[ai][bj][m][n]; }
            if constexpr (KIND == 0) {
                f32x4 a0 = v[0][0] * cur.rc[0] - v[1][0] * cur.rsn[0], a1 = v[0][1] * cur.rc[1] - v[1][1] * cur.rsn[1];
                f32x4 b0 = v[1][0] * cur.rc[0] + v[0][0] * cur.rsn[0], b1 = v[1][1] * cur.rc[1] + v[0][1] * cur.rsn[1];
                a0 = a0 * qs; a1 = a1 * qs; b0 = b0 * qs; b1 = b1 * qs;
                bf16_t* dst = (bf16_t*)(ws + (pn < 2 ? cfg::WS_Q : cfg::WS_K)) + (size_t)row * 512 + (4 * (pn & 1) + wc) * 64 + 8 * fq;
                st8(dst, a0, a1); st8(dst + 32, b0, b1);
            } else if constexpr (KIND == 1) {
                bf16_t* dst = (bf16_t*)(ws + cfg::WS_V) + (size_t)row * 512 + (pn - 4) * 256 + cw; st8(dst, v[0][0], v[0][1]); st8(dst + 128, v[1][0], v[1][1]);
            } else if constexpr (KIND == 2) {
                bf16_t* dst = (bf16_t*)(ws + cfg::WS_TAB) + (size_t)row * 512 + (pn - 6) * 256 + cw; st8(dst, v[0][0], v[0][1]); st8(dst + 128, v[1][0], v[1][1]);
            } else if constexpr (KIND == 3) {
                bf16_t* dst = (bf16_t*)(ws + cfg::WS_GQK) + (size_t)row * 256 + cw; st8(dst, v[0][0] * cfg::GQSCALE, v[0][1] * cfg::GQSCALE); st8(dst + 128, v[1][0], v[1][1]);
            } else if constexpr (KIND == 4) {
                bf16_t* dst = (bf16_t*)(ws + cfg::WS_GV) + (size_t)row * 256 + cw; st8(dst, v[0][0], v[0][1]); st8(dst + 128, v[1][0], v[1][1]);
            } else if constexpr (KIND == 5) {
                bf16_t* dst = (bf16_t*)(ws + cfg::WS_GR) + (size_t)row * 256 + cw;
#pragma unroll
                for (int bj = 0; bj < 2; ++bj) { f32x4 x0 = v[bj][0], x1 = v[bj][1];
#pragma unroll
                    for (int e = 0; e < 4; ++e) { x0[e] = fsilu(x0[e]); x1[e] = fsilu(x1[e]); } st8(dst + 128 * bj, x0, x1); }
            } else {
                float* dst = (float*)(ws + cfg::WS_GL) + (size_t)row * 256 + cw;
#pragma unroll
                for (int bj = 0; bj < 2; ++bj)
#pragma unroll
                    for (int n = 0; n < 2; ++n) { f32x4 x = v[bj][n] + bias[bj][n];
#pragma unroll
                        for (int e = 0; e < 4; ++e) x[e] = flogsig16(x[e]); *(f32x4*)(dst + 128 * bj + 4 * n) = x; }
            }
            if (i < 7) cur = nxt;
        }
    }
    __device__ __forceinline__ void operator()(const f32x4 (&acc)[2][2][4][2], const Unit& u, int wr, int wc, int fr, int fq) const {
        asm volatile("" : "+v"(fr), "+v"(fq));
        unsigned zo = 0u; asm volatile("" : "+s"(zo)); FEpiIn me = *this; me.ws = ws + zo;
        const int pn = u.pn;
        if (pn < 4) me.rows<0>(acc, u, wr, wc, fr, fq); else if (pn < 6) me.rows<1>(acc, u, wr, wc, fr, fq); else if (pn < 8) me.rows<2>(acc, u, wr, wc, fr, fq);
        else if (pn == 8) me.rows<3>(acc, u, wr, wc, fr, fq); else if (pn == 9) me.rows<4>(acc, u, wr, wc, fr, fq); else if (pn == 10) me.rows<5>(acc, u, wr, wc, fr, fq); else me.rows<6>(acc, u, wr, wc, fr, fq);
    }
};
struct FEpiRes {
    static constexpr bool PERM = true, AFTER_DRAIN = false;
    const PG8_LAS float* stprev;
    const float* g; const float* bb; bf16_t* XB; float* ST;
    struct RowLd { u32x4 xb[2]; };
    __device__ __forceinline__ RowLd load_row(int row, int col0, int fq) const {
        RowLd r; const size_t off = (size_t)row * 1024 + col0;
        r.xb[0] = *(const u32x4*)(XB + off); r.xb[1] = *(const u32x4*)(XB + off + 128);
        return r;
    }
    __device__ __forceinline__ void operator()(const f32x4 (&acc)[2][2][4][2], const Unit& u, int wr, int wc, int fr, int fq) const {
        asm volatile("" : "+v"(fr), "+v"(fq));
        const int col0 = u.pn * BM + 32 * wc + 8 * fq, row0 = u.pm * BM + 64 * wr + fr;
        f32x4 gv[2][2], bv[2][2];
        RowLd cur = load_row(row0, col0, fq), nxt;
        if (stprev) {
#pragma unroll
            for (int bj = 0; bj < 2; ++bj)
#pragma unroll
                for (int n = 0; n < 2; ++n) { gv[bj][n] = *(const f32x4*)(g + col0 + 128 * bj + 4 * n); bv[bj][n] = *(const f32x4*)(bb + col0 + 128 * bj + 4 * n); } }
#pragma unroll
        for (int i = 0; i < 8; ++i) { const int ai = i >> 2, m = i & 3, row = row0 + 128 * ai + 16 * m; const size_t off = (size_t)row * 1024 + col0;
            if (i < 7) nxt = load_row(row0 + 128 * ((i + 1) >> 2) + 16 * ((i + 1) & 3), col0, fq);
            RS rs; rs.a = 1.f; rs.b = 0.f; if (stprev) { typedef float f32x2 __attribute__((ext_vector_type(2))); const f32x2 t2 = *(const PG8_LAS f32x2*)(stprev + 2 * (128 * ai + 64 * wr + 16 * m + fr)); rs.a = t2[0]; rs.b = t2[1]; }
            float s = 0.f, ss = 0.f;
#pragma unroll
            for (int bj = 0; bj < 2; ++bj) { f32x4 y[2];
#pragma unroll
                for (int n = 0; n < 2; ++n) { const unsigned w0 = cur.xb[bj][2 * n], w1 = cur.xb[bj][2 * n + 1];
                    f32x4 x = (f32x4){__uint_as_float(w0 << 16), __uint_as_float(w0 & 0xffff0000u), __uint_as_float(w1 << 16), __uint_as_float(w1 & 0xffff0000u)};
                    if (stprev) x = (rs.a * x + rs.b) * gv[bj][n] + bv[bj][n];
                    y[n] = cfg::ALPHA * x + acc[ai][bj][m][n];
                    s += (y[n][0] + y[n][1]) + (y[n][2] + y[n][3]); ss += (y[n][0] * y[n][0] + y[n][1] * y[n][1]) + (y[n][2] * y[n][2] + y[n][3] * y[n][3]); }
                st8nt(XB + off + 128 * bj, y[0], y[1]); }
            s = xadd<16>(s); ss = xadd<16>(ss); s = xadd<32>(s); ss = xadd<32>(ss);
            if (fq == 0) { typedef float f32x2 __attribute__((ext_vector_type(2))); *(f32x2*)(ST + (size_t)row * 32 + (u.pn * 4 + wc) * 2) = (f32x2){s, ss}; }
            if (i < 7) cur = nxt; }
    }
};
struct FEpiGU {
    static constexpr bool PERM = true, AFTER_DRAIN = false;
    const PG8_LAS float* rsl;
    const float* c1; const float* c2; bf16_t* ACT;
    __device__ __forceinline__ void operator()(const f32x4 (&acc)[2][2][4][2], const Unit& u, int wr, int wc, int fr, int fq) const {
        asm volatile("" : "+v"(fr), "+v"(fq));
        const int cw = 32 * wc + 8 * fq, row0 = u.pm * BM + 64 * wr + fr; const float* c1p = c1 + u.pn * 256 + cw; const float* c2p = c2 + u.pn * 256 + cw;
        typedef float f32x2 __attribute__((ext_vector_type(2)));
        f32x4 k1[2][2], k2[2][2];
#pragma unroll
        for (int bj = 0; bj < 2; ++bj)
#pragma unroll
            for (int n = 0; n < 2; ++n) { k1[bj][n] = *(const f32x4*)(c1p + 128 * bj + 4 * n); k2[bj][n] = *(const f32x4*)(c2p + 128 * bj + 4 * n); }
#pragma unroll
        for (int i = 0; i < 8; ++i) { const int ai = i >> 2, m = i & 3; const f32x2 rs = *(const PG8_LAS f32x2*)(rsl + 2 * (128 * ai + 64 * wr + 16 * m + fr)); f32x4 a[2];
#pragma unroll
            for (int n = 0; n < 2; ++n) { const f32x4 hg = rs[0] * acc[ai][0][m][n] + (rs[1] * k1[0][n] + k2[0][n]), hu = rs[0] * acc[ai][1][m][n] + (rs[1] * k1[1][n] + k2[1][n]);
#pragma unroll
                for (int e = 0; e < 4; ++e) a[n][e] = fsilu(hg[e]) * hu[e]; }
            st8nt(ACT + (size_t)(row0 + 128 * ai + 16 * m) * cfg::FF + 128 * u.pn + cw, a[0], a[1]); }
    }
};
struct FEpiFour {
    static constexpr bool PERM = true, AFTER_DRAIN = false;
    bf16_t* OC;
    __device__ __forceinline__ void operator()(const f32x4 (&acc)[2][2][4][2], const Unit& u, int wr, int wc, int fr, int fq) const {
        asm volatile("" : "+v"(fr), "+v"(fq));
        const int cw = 32 * wc + 8 * fq;
#pragma unroll
        for (int ai = 0; ai < 2; ++ai)
#pragma unroll
            for (int m = 0; m < 4; ++m) { const int row = u.pm * BM + 128 * ai + 64 * wr + 16 * m + fr; bf16_t* dst = OC + (size_t)(u.pn * 2048 + row) * 1024 + 512 + cw;
                st8(dst, acc[ai][0][m][0], acc[ai][0][m][1]); st8(dst + 128, acc[ai][1][m][0], acc[ai][1][m][1]); }
    }
};
}
namespace att {
using bf16x8 = __attribute__((ext_vector_type(8))) short;
using s16x4  = __attribute__((ext_vector_type(4))) short;
using f32x16 = __attribute__((ext_vector_type(16))) float;
using u32x4  = __attribute__((ext_vector_type(4))) unsigned;
constexpr int NW = 8, QBLK = 32, KVBLK = 64, LD = 512, NT = cfg::S / KVBLK;
constexpr int SHM_V = KVBLK * 128 * 2, SHM_K = KVBLK * 128 * 2, SHM_X = 2 * SHM_V + 2 * SHM_K, SHM_ATTN = SHM_X + NW * 64 * 4;
constexpr float THRL = 6.0f;
#define ATT_KSWZ(row, colB) ((row) * 256 + ((colB) ^ (((row) & 7) << 4)))
#define ATT_SBAR() __builtin_amdgcn_sched_barrier(0)
__device__ __forceinline__ int crow(int r, int hi) { return (r & 3) + 8 * (r >> 2) + 4 * hi; }
__device__ __forceinline__ unsigned cvtpk(float lo, float hi) { unsigned r; asm volatile("v_cvt_pk_bf16_f32 %0, %1, %2" : "=v"(r) : "v"(lo), "v"(hi)); return r; }
__device__ __forceinline__ void softmaxP(f32x16& p0, f32x16& p1, float& m_reg, f32x16& negm, float& alpha, bool first, bf16x8& pa0, bf16x8& pa1, bf16x8& pa2, bf16x8& pa3) {
#define ATT_M3(a, b, c) fmaxf(fmaxf(a, b), c)
  const float t0 = ATT_M3(p0[0], p0[1], p0[2]), t1 = ATT_M3(p0[3], p0[4], p0[5]), t2 = ATT_M3(p0[6], p0[7], p0[8]), t3 = ATT_M3(p0[9], p0[10], p0[11]), t4 = ATT_M3(p0[12], p0[13], p0[14]);
  const float t5 = ATT_M3(p0[15], p1[0], p1[1]), t6 = ATT_M3(p1[2], p1[3], p1[4]), t7 = ATT_M3(p1[5], p1[6], p1[7]), t8 = ATT_M3(p1[8], p1[9], p1[10]), t9 = ATT_M3(p1[11], p1[12], p1[13]);
  const float u0 = ATT_M3(t0, t1, t2), u1 = ATT_M3(t3, t4, t5), u2 = ATT_M3(t6, t7, t8), u3 = ATT_M3(t9, p1[14], p1[15]);
  float pmax = fmaxf(fmaxf(u0, u1), fmaxf(u2, u3));
#undef ATT_M3
  { auto rr = __builtin_amdgcn_permlane32_swap(__float_as_uint(pmax), __float_as_uint(pmax), false, false); pmax = fmaxf(__uint_as_float(rr[0]), __uint_as_float(rr[1])); }
  const float thr = first ? -3.0e38f : THRL;
  if (__builtin_expect(__all(pmax <= thr), 1)) { alpha = 1.f; }
  else { const float dl = first ? pmax : fmaxf(pmax, 0.f); alpha = first ? 0.f : __builtin_amdgcn_exp2f(-dl); m_reg += dl;
#pragma unroll
    for (int r = 0; r < 16; ++r) { p0[r] -= dl; p1[r] -= dl; negm[r] -= dl; } }
#pragma unroll
  for (int r = 0; r < 16; ++r) p0[r] = __builtin_amdgcn_exp2f(p0[r]);
#pragma unroll
  for (int r = 0; r < 16; ++r) p1[r] = __builtin_amdgcn_exp2f(p1[r]);
#define ATT_PK4(P, BASE, OUT) do { u32x4 w = {cvtpk(P[BASE + 0], P[BASE + 1]), cvtpk(P[BASE + 2], P[BASE + 3]), cvtpk(P[BASE + 4], P[BASE + 5]), cvtpk(P[BASE + 6], P[BASE + 7])}; \
    OUT = *reinterpret_cast<bf16x8*>(&w); } while (0)
  ATT_PK4(p0, 0, pa0); ATT_PK4(p0, 8, pa1); ATT_PK4(p1, 0, pa2); ATT_PK4(p1, 8, pa3);
#undef ATT_PK4
}
template <int OFF> __device__ __forceinline__ bf16x8 k_read(int ka) { bf16x8 r; asm volatile("ds_read_b128 %0, %1 offset:%2" : "=&v"(r) : "v"(ka), "i"(OFF) : "memory"); return r; }
template <int KB> __device__ __forceinline__ void k_load2(bf16x8* kf, int ka0, int ka1) {
  kf[0] = k_read<KB * SHM_K>(ka0); kf[1] = k_read<KB * SHM_K + 8192>(ka0); kf[2] = k_read<KB * SHM_K>(ka1); kf[3] = k_read<KB * SHM_K + 8192>(ka1);
}
__device__ __forceinline__ void qk_mma2(f32x16& p0, f32x16& p1, const bf16x8* kf, bf16x8 q0, bf16x8 q1) {
  p0 = __builtin_amdgcn_mfma_f32_32x32x16_bf16(kf[0], q0, p0, 0, 0, 0); p1 = __builtin_amdgcn_mfma_f32_32x32x16_bf16(kf[1], q0, p1, 0, 0, 0);
  p0 = __builtin_amdgcn_mfma_f32_32x32x16_bf16(kf[2], q1, p0, 0, 0, 0); p1 = __builtin_amdgcn_mfma_f32_32x32x16_bf16(kf[3], q1, p1, 0, 0, 0);
}
__device__ __forceinline__ int v_st(int k, int c) { return ((k >> 3) * 4 + (c >> 5)) * 512 + ((k & 7) * 32 + (c & 31)) * 2; }
__device__ __forceinline__ int v_rd_base(int lane) { return ((lane & 3) << 3) | (((lane >> 2) & 3) << 6) | (((lane >> 4) & 1) << 5) | (((lane >> 5) & 1) << 8); }
constexpr int v_rd_off(int d0, int ks, int half) { return d0 * 512 + ks * 4096 + half * 2048; }
template <int OFF> __device__ __forceinline__ s16x4 tr_read(int vb) { s16x4 r; asm volatile("ds_read_b64_tr_b16 %0, %1 offset:%2" : "=&v"(r) : "v"(vb), "i"(OFF) : "memory"); return r; }
struct VF { s16x4 l[4], h[4]; };
template <int KS> __device__ __forceinline__ void vf_load(VF& f, int vb) {
  f.l[0] = tr_read<v_rd_off(0, KS, 0)>(vb); f.h[0] = tr_read<v_rd_off(0, KS, 1)>(vb); f.l[1] = tr_read<v_rd_off(1, KS, 0)>(vb); f.h[1] = tr_read<v_rd_off(1, KS, 1)>(vb);
  f.l[2] = tr_read<v_rd_off(2, KS, 0)>(vb); f.h[2] = tr_read<v_rd_off(2, KS, 1)>(vb); f.l[3] = tr_read<v_rd_off(3, KS, 0)>(vb); f.h[3] = tr_read<v_rd_off(3, KS, 1)>(vb);
}
__device__ __forceinline__ void pv_step(f32x16* o, bf16x8 pa, const VF& f) {
#define ATT_PK(L, H) (bf16x8){L[0], L[1], L[2], L[3], H[0], H[1], H[2], H[3]}
  o[0] = __builtin_amdgcn_mfma_f32_32x32x16_bf16(pa, ATT_PK(f.l[0], f.h[0]), o[0], 0, 0, 0);
  o[1] = __builtin_amdgcn_mfma_f32_32x32x16_bf16(pa, ATT_PK(f.l[1], f.h[1]), o[1], 0, 0, 0);
  o[2] = __builtin_amdgcn_mfma_f32_32x32x16_bf16(pa, ATT_PK(f.l[2], f.h[2]), o[2], 0, 0, 0);
  o[3] = __builtin_amdgcn_mfma_f32_32x32x16_bf16(pa, ATT_PK(f.l[3], f.h[3]), o[3], 0, 0, 0);
#undef ATT_PK
}
#define ATT_LWAIT(n) do { asm volatile("s_waitcnt lgkmcnt(" #n ")" ::: "memory"); ATT_SBAR(); } while (0)
template <int MP> __device__ __forceinline__ void att_give(const f32x16* o, float* Xw, int r32, int hi) {
  constexpr int RG = MP ? 0 : 8;
#pragma unroll
  for (int rr = 0; rr < 8; ++rr)
#pragma unroll
    for (int d0 = 0; d0 < 4; ++d0) Xw[(crow(RG + rr, hi) & 15) * 128 + d0 * 32 + r32] = o[d0][RG + rr];
}
template <int MP> __device__ __forceinline__ void att_fin(const f32x16* o, const float* Xr, float lam, const float (&gq)[4], bf16_t* OCw, int r32, int hi, int lane) {
  constexpr int RK = MP ? 8 : 0;
  unsigned pk[8][4];
#pragma unroll
  for (int rr = 0; rr < 8; ++rr) { const int lr = crow(RK + rr, hi) & 15;
    float df[4], ssq = 0.f;
#pragma unroll
    for (int d0 = 0; d0 < 4; ++d0) { const float x = Xr[lr * 128 + d0 * 32 + r32]; df[d0] = MP ? x - lam * o[d0][RK + rr] : o[d0][RK + rr] - lam * x; ssq += df[d0] * df[d0]; }
    ssq = xadd<1>(ssq); ssq = xadd<2>(ssq); ssq = xadd<4>(ssq); ssq = xadd<8>(ssq); ssq = xadd<16>(ssq);
    const float rn = rsqrtf(ssq * (1.f / 128.f) + cfg::EPS);
#pragma unroll
    for (int d0 = 0; d0 < 4; ++d0) pk[rr][d0] = cvtpk(df[d0] * rn * gq[d0], 0.f); }
  char* stg = (char*)Xr;
#pragma unroll
  for (int rr = 0; rr < 8; ++rr) { const int lr = crow(RK + rr, hi) & 15;
#pragma unroll
    for (int d0 = 0; d0 < 4; ++d0) *(unsigned short*)(stg + lr * 272 + (d0 * 32 + r32) * 2) = (unsigned short)pk[rr][d0]; }
#pragma unroll
  for (int i = 0; i < 4; ++i) { const int c = lane + 64 * i, row = c >> 4, cc = c & 15;
    const u32x4 v = *(const u32x4*)(stg + row * 272 + cc * 16); *(u32x4*)(OCw + (size_t)row * 1024 + cc * 8) = v; }
}
__device__ __forceinline__ void attn_unit(int b, int h, int qb, const bf16_t* __restrict__ Qg, const bf16_t* __restrict__ Kg, const bf16_t* __restrict__ Vg, bf16_t* __restrict__ OC,
                                          const float* __restrict__ lamp, const float* __restrict__ dgv, int layer, char* lds) {
  int tid_o = threadIdx.x; asm volatile("" : "+v"(tid_o));
  const int tid = tid_o, wid = __builtin_amdgcn_readfirstlane(tid >> 6), lane = tid & 63, r32 = lane & 31, hi = lane >> 5, mp = wid >> 2, wl = wid & 3, mofs = mp * 64;
  char* V_lds = lds; char* K_lds = lds + 2 * SHM_V;
  float* ws = (float*)(lds + SHM_X) + wid * 64; float* al_l = ws + 32;
  float m_reg = 0.f; f32x16 o[4] = {}, ol = {}, negm = {}; bf16x8 qr[4];
  const int q0 = qb * 128 + wl * QBLK;
  const bf16_t* Qw = Qg + (size_t)(b * cfg::S + q0 + r32) * LD + h * 128 + mofs + hi * 8;
#pragma unroll
  for (int d0 = 0; d0 < 4; ++d0) qr[d0] = *reinterpret_cast<const bf16x8*>(Qw + d0 * 16);
  const bf16_t* Kh = Kg + (size_t)b * cfg::S * LD + h * 128; const bf16_t* Vh = Vg + (size_t)b * cfg::S * LD + h * 128;
  const int vb0 = (int)(uintptr_t)V_lds + v_rd_base(lane);
  const int ka0 = (int)(uintptr_t)K_lds + ATT_KSWZ(r32, (mofs + hi * 8) * 2);
  const bf16x8 ones = {0x3F80, 0x3F80, 0x3F80, 0x3F80, 0x3F80, 0x3F80, 0x3F80, 0x3F80};
  const int gt = tid & 255, gr = gt >> 4, gc = (gt & 15) * 8;
  const bf16_t* gsrc = (mp ? Kh : Vh) + (size_t)gr * LD + gc;
  char* gdst = mp ? K_lds + ATT_KSWZ(gr, gc * 2) : V_lds + v_st(gr, gc);
  const int tofs = mp ? 2 : 0;
  bf16x8 st_[2][4];
#define ATT_GLOAD(i, t) do { const int t_ = (t) < NT ? (t) : NT - 1;     \
    _Pragma("unroll") for (int q_ = 0; q_ < 4; ++q_) st_[i][q_] = *reinterpret_cast<const bf16x8*>(gsrc + (size_t)(t_ * 64 + 16 * q_) * LD); } while (0)
#define ATT_GWRITE(i, t) do { asm volatile("s_waitcnt vmcnt(4)" ::: "memory"); if ((t) < NT) { \
    _Pragma("unroll") for (int q_ = 0; q_ < 4; ++q_) *(bf16x8*)(gdst + (i) * 16384 + q_ * 4096) = st_[i][q_]; } } while (0)
#define ATT_RESC(a) do { if (__any((a) < 1.f)) { if (hi == 0) al_l[r32] = (a); asm volatile("s_waitcnt lgkmcnt(0)" ::: "memory"); \
    _Pragma("unroll") for (int r = 0; r < 16; ++r) { const float a_ = al_l[crow(r, hi)]; ol[r] *= a_; _Pragma("unroll") for (int d = 0; d < 4; ++d) o[d][r] *= a_; } } } while (0)
  f32x16 s0, s1; float al; bf16x8 pa0, pa1, pa2, pa3, kf[8]; VF f0, f1;
#define ATT_VSEG(I, p) do { ATT_GWRITE(I, (p) + tofs); ATT_GLOAD(I, (p) + tofs + 2); ATT_SBAR(); \
    softmaxP(s0, s1, m_reg, negm, al, (p) == 0, pa0, pa1, pa2, pa3); ATT_RESC(al); } while (0)
#define ATT_OL(pa) ol = __builtin_amdgcn_mfma_f32_32x32x16_bf16(pa, ones, ol, 0, 0, 0)
#define ATT_QK(KB) do { k_load2<KB>(kf, ka0, ka0 ^ 32); k_load2<KB>(kf + 4, ka0 ^ 64, ka0 ^ 96); ATT_LWAIT(4); s0 = negm; s1 = negm; qk_mma2(s0, s1, kf, qr[0], qr[1]); ATT_LWAIT(0); qk_mma2(s0, s1, kf + 4, qr[2], qr[3]); ATT_SBAR(); } while (0)
#define ATT_MSEG(VB, KB, QK) do { vf_load<0>(f0, vb0 + (VB) * SHM_V); vf_load<1>(f1, vb0 + (VB) * SHM_V); ATT_SBAR(); \
    ATT_LWAIT(8); pv_step(o, pa0, f0); ATT_OL(pa0); vf_load<2>(f0, vb0 + (VB) * SHM_V); \
    ATT_LWAIT(8); pv_step(o, pa1, f1); ATT_OL(pa1); vf_load<3>(f1, vb0 + (VB) * SHM_V); \
    if constexpr (QK) { k_load2<KB>(kf, ka0, ka0 ^ 32); ATT_LWAIT(12); } else ATT_LWAIT(8); \
    pv_step(o, pa2, f0); ATT_OL(pa2); \
    if constexpr (QK) ATT_LWAIT(4); else ATT_LWAIT(0); \
    pv_step(o, pa3, f1); ATT_OL(pa3); \
    if constexpr (QK) { k_load2<KB>(kf + 4, ka0 ^ 64, ka0 ^ 96); ATT_LWAIT(4); s0 = negm; s1 = negm; qk_mma2(s0, s1, kf, qr[0], qr[1]); ATT_LWAIT(0); qk_mma2(s0, s1, kf + 4, qr[2], qr[3]); } ATT_SBAR(); } while (0)
  { const int kr = tid >> 4, kc = (tid & 15) * 8;
    const bf16x8 k0 = *reinterpret_cast<const bf16x8*>(&Kh[(size_t)kr * LD + kc]), k1 = *reinterpret_cast<const bf16x8*>(&Kh[(size_t)(32 + kr) * LD + kc]);
    const bf16x8 k2 = *reinterpret_cast<const bf16x8*>(&Kh[(size_t)(64 + kr) * LD + kc]), k3 = *reinterpret_cast<const bf16x8*>(&Kh[(size_t)(96 + kr) * LD + kc]);
    ATT_GLOAD(0, tofs); ATT_GLOAD(1, tofs + 1);
    asm volatile("s_waitcnt vmcnt(8)" ::: "memory");
    *(bf16x8*)(K_lds + ATT_KSWZ(kr, kc * 2)) = k0; *(bf16x8*)(K_lds + ATT_KSWZ(32 + kr, kc * 2)) = k1;
    *(bf16x8*)(K_lds + SHM_K + ATT_KSWZ(kr, kc * 2)) = k2; *(bf16x8*)(K_lds + SHM_K + ATT_KSWZ(32 + kr, kc * 2)) = k3; }
  __syncthreads();
  if (mp) __syncthreads();
  ATT_QK(0); __syncthreads();
  for (int p = 0; p + 2 < NT; p += 2) {
    ATT_VSEG(0, p);           __syncthreads();
    ATT_MSEG(0, 1, true);     __syncthreads();
    ATT_VSEG(1, p + 1);       __syncthreads();
    ATT_MSEG(1, 0, true);     __syncthreads();
  }
  ATT_VSEG(0, NT - 2);   __syncthreads();
  ATT_MSEG(0, 1, true);   __syncthreads();
  ATT_VSEG(1, NT - 1);   __syncthreads();
  ATT_MSEG(1, 0, false);  __syncthreads();
  if (!mp) __syncthreads();
#pragma unroll
  for (int r = 0; r < 16; ++r) { const float rl = __builtin_amdgcn_rcpf(ol[r]);
#pragma unroll
    for (int d0 = 0; d0 < 4; ++d0) o[d0][r] *= rl; }
  __syncthreads();
  float* X = (float*)lds;
  const float* Xr = X + wid * 2048; float* Xw = X + (wid ^ 4) * 2048;
  int layer_o = __builtin_amdgcn_readfirstlane(layer); asm volatile("" : "+s"(layer_o)); const float lam_init = layer_o == 0 ? 0.2f : 0.35550906759f;
  if (mp == 0) att_give<0>(o, Xw, r32, hi); else att_give<1>(o, Xw, r32, hi);
  float lam; { float s1 = lamp[lane] * lamp[64 + lane], s2 = lamp[128 + lane] * lamp[192 + lane];
    s1 = xadd<1>(s1); s2 = xadd<1>(s2); s1 = xadd<2>(s1); s2 = xadd<2>(s2); s1 = xadd<4>(s1); s2 = xadd<4>(s2); s1 = xadd<8>(s1); s2 = xadd<8>(s2); s1 = xadd<16>(s1); s2 = xadd<16>(s2); s1 = xadd<32>(s1); s2 = xadd<32>(s2);
    lam = __expf(s1) - __expf(s2) + lam_init; }
  float gq[4];
#pragma unroll
  for (int d0 = 0; d0 < 4; ++d0) gq[d0] = dgv[d0 * 32 + r32] * (1.f - lam_init);
  __syncthreads();
  bf16_t* OCw = OC + (size_t)(b * cfg::S + q0 + 16 * mp) * 1024 + h * 128;
  if (mp == 0) att_fin<0>(o, Xr, lam, gq, OCw, r32, hi, lane); else att_fin<1>(o, Xr, lam, gq, OCw, r32, hi, lane);
  __syncthreads();
#undef ATT_GLOAD
#undef ATT_GWRITE
#undef ATT_VSEG
#undef ATT_MSEG
#undef ATT_RESC
#undef ATT_OL
#undef ATT_QK
}
#undef ATT_KSWZ
#undef ATT_SBAR
}
namespace gla {
using att::bf16x8; using att::s16x4; using att::f32x16; using att::u32x4; using att::crow; using att::cvtpk; using att::tr_read;
typedef float f32x4 __attribute__((ext_vector_type(4)));
typedef unsigned u32x2 __attribute__((ext_vector_type(2)));
#define GLAS __attribute__((address_space(3)))
constexpr int KT_STRIDE = 144;
constexpr int A_KT = 0, A_V = 36864, A_BEND = A_V + 32768;
constexpr int B_QT = 0, B_KT = 32768, B_V = 65536, B_SC = 98304;
__device__ __forceinline__ int v_st64(int k, int c) { const int kk = (k & ~0xC) | ((k & 4) << 1) | ((k & 8) >> 1); return ((kk >> 3) * 2 + (c >> 5)) * 512 + ((kk & 7) * 32 + (c & 31)) * 2; }
constexpr int v_off64(int d0, int ks, int half) { return d0 * 512 + ks * 2048 + half * 1024; }
__device__ __forceinline__ float bf2f_(unsigned short v) { return __uint_as_float((unsigned)v << 16); }
__device__ __forceinline__ void load_v_tile(const bf16_t* __restrict__ src, GLAS unsigned char* dst, int lane) {
    u32x4 tv[8];
#pragma unroll
    for (int i = 0; i < 8; ++i) { const int row = (lane >> 3) + 8 * i, ch = lane & 7; tv[i] = *(const u32x4*)(src + (size_t)row * 256 + ch * 8); }
#pragma unroll
    for (int i = 0; i < 8; ++i) { const int row = (lane >> 3) + 8 * i, ch = lane & 7; *(GLAS u32x4*)(dst + v_st64(row, ch * 8)) = tv[i]; }
}
#define GLA_PK(L, H) (bf16x8){L[0], L[1], L[2], L[3], H[0], H[1], H[2], H[3]}
#define GLA_MM4(o0, o1, vb, AF) do { \
    const s16x4 l00 = tr_read<v_off64(0, 0, 0)>(vb), h00 = tr_read<v_off64(0, 0, 1)>(vb), l01 = tr_read<v_off64(0, 1, 0)>(vb), h01 = tr_read<v_off64(0, 1, 1)>(vb); \
    const s16x4 l02 = tr_read<v_off64(0, 2, 0)>(vb), h02 = tr_read<v_off64(0, 2, 1)>(vb), l03 = tr_read<v_off64(0, 3, 0)>(vb), h03 = tr_read<v_off64(0, 3, 1)>(vb); \
    const s16x4 l10 = tr_read<v_off64(1, 0, 0)>(vb), h10 = tr_read<v_off64(1, 0, 1)>(vb), l11 = tr_read<v_off64(1, 1, 0)>(vb), h11 = tr_read<v_off64(1, 1, 1)>(vb); \
    const s16x4 l12 = tr_read<v_off64(1, 2, 0)>(vb), h12 = tr_read<v_off64(1, 2, 1)>(vb), l13 = tr_read<v_off64(1, 3, 0)>(vb), h13 = tr_read<v_off64(1, 3, 1)>(vb); \
    asm volatile("s_waitcnt lgkmcnt(0)" ::: "memory"); __builtin_amdgcn_sched_barrier(0); \
    o0 = __builtin_amdgcn_mfma_f32_32x32x16_bf16(AF(0), GLA_PK(l00, h00), o0, 0, 0, 0); o1 = __builtin_amdgcn_mfma_f32_32x32x16_bf16(AF(0), GLA_PK(l10, h10), o1, 0, 0, 0); \
    o0 = __builtin_amdgcn_mfma_f32_32x32x16_bf16(AF(1), GLA_PK(l01, h01), o0, 0, 0, 0); o1 = __builtin_amdgcn_mfma_f32_32x32x16_bf16(AF(1), GLA_PK(l11, h11), o1, 0, 0, 0); \
    o0 = __builtin_amdgcn_mfma_f32_32x32x16_bf16(AF(2), GLA_PK(l02, h02), o0, 0, 0, 0); o1 = __builtin_amdgcn_mfma_f32_32x32x16_bf16(AF(2), GLA_PK(l12, h12), o1, 0, 0, 0); \
    o0 = __builtin_amdgcn_mfma_f32_32x32x16_bf16(AF(3), GLA_PK(l03, h03), o0, 0, 0, 0); o1 = __builtin_amdgcn_mfma_f32_32x32x16_bf16(AF(3), GLA_PK(l13, h13), o1, 0, 0, 0); } while (0)
__device__ __forceinline__ bf16x8 afrag_tr(const GLAS unsigned char* row, int ks, int hi) { return *(const GLAS bf16x8*)(row + (16 * ks + 8 * hi) * 2); }

__device__ __forceinline__ void gla_a_item(int b, int h, int g, unsigned char* ws, GLAS unsigned char* lds) {
    int tid_o = threadIdx.x; asm volatile("" : "+v"(tid_o));
    const int tid = tid_o, wave = __builtin_amdgcn_readfirstlane(tid >> 6), lane = tid & 63, r32 = lane & 31, hi = lane >> 5;
    const float* GL = (const float*)(ws + cfg::WS_GL); const bf16_t* GQK = (const bf16_t*)(ws + cfg::WS_GQK); const bf16_t* GV = (const bf16_t*)(ws + cfg::WS_GV);
    float* KVC = (float*)(ws + cfg::WS_OF); float* DEC = (float*)(ws + cfg::WS_DEC);
    const size_t tok0 = (size_t)b * 2048 + g * 256;
    GLAS float* bend_s = (GLAS float*)(lds + A_BEND);
    if (wave < 4) {
        const int c = wave, dir = lane >> 5, d = lane & 31;
        const float* gl = GL + (tok0 + c * 64) * 256 + dir * 128 + h * 32 + d; const bf16_t* kp = GQK + (tok0 + c * 64) * 256 + 128 + h * 32 + d;
        GLAS unsigned char* row = lds + A_KT + ((c * 2 + dir) * 32 + d) * KT_STRIDE; float bsum = 0.f; float gA[8], gB[8]; unsigned short kA[8], kB[8];
#define GLA_LOAD(G, K, blk) do { const int t0_ = dir ? 56 - 8 * (blk) : 8 * (blk); _Pragma("unroll") for (int i = 0; i < 8; ++i) { G[i] = gl[(size_t)(t0_ + i) * 256]; K[i] = kp[(size_t)(t0_ + i) * 256]; } } while (0)
#define GLA_PROC(G, K, blk) do { const int t0_ = dir ? 56 - 8 * (blk) : 8 * (blk); float kt[8]; \
            if (dir == 0) { _Pragma("unroll") for (int i = 0; i < 8; ++i) { bsum += G[i]; kt[i] = bf2f_(K[i]) * __expf(-bsum); } } \
            else { _Pragma("unroll") for (int i = 7; i >= 0; --i) { bsum += G[i]; kt[i] = bf2f_(K[i]) * __expf(-bsum); } } \
            u32x4 w; w.x = cvtpk(kt[0], kt[1]); w.y = cvtpk(kt[2], kt[3]); w.z = cvtpk(kt[4], kt[5]); w.w = cvtpk(kt[6], kt[7]); *(GLAS u32x4*)(row + t0_ * 2) = w; } while (0)
        GLA_LOAD(gA, kA, 0);
#pragma unroll
        for (int bp = 0; bp < 4; ++bp) { GLA_LOAD(gB, kB, 2 * bp + 1); GLA_PROC(gA, kA, 2 * bp); if (bp < 3) GLA_LOAD(gA, kA, 2 * bp + 2); GLA_PROC(gB, kB, 2 * bp + 1); }
#undef GLA_LOAD
#undef GLA_PROC
        bend_s[(c * 2 + dir) * 32 + d] = bsum;
        DEC[((size_t)((b * 4 + h) * 32 + g * 4 + c) * 2 + dir) * 32 + d] = __expf(bsum);
    } else { const int c = wave - 4; load_v_tile(GV + (tok0 + c * 64) * 256 + h * 64, lds + A_V + c * 8192, lane); }
    __syncthreads();
    {
        const int c = wave >> 1, dir = wave & 1; f32x16 o0 = {}, o1 = {};
        const int vb = (int)(unsigned)(uintptr_t)(lds + A_V + c * 8192) + att::v_rd_base(lane);
        const GLAS unsigned char* arow = lds + A_KT + ((c * 2 + dir) * 32 + r32) * KT_STRIDE;
#define GLA_AF(ks) afrag_tr(arow, ks, hi)
        GLA_MM4(o0, o1, vb, GLA_AF);
#undef GLA_AF
        float* dst = KVC + ((size_t)((b * 4 + h) * 32 + g * 4 + c) * 2 + dir) * 2048 + r32;
#pragma unroll
        for (int r = 0; r < 16; ++r) { const int d = crow(r, hi); const float sc = __expf(bend_s[(c * 2 + dir) * 32 + d]); dst[d * 64] = o0[r] * sc; dst[d * 64 + 32] = o1[r] * sc; }
    }
    __syncthreads();
}

__device__ __forceinline__ void gla_b_item(int b, int h, int g, unsigned char* ws, const float* __restrict__ gng, bf16_t* __restrict__ OC, GLAS unsigned char* lds) {
    int tid_o = threadIdx.x; asm volatile("" : "+v"(tid_o));
    const int tid = tid_o, wave = __builtin_amdgcn_readfirstlane(tid >> 6), lane = tid & 63, r32 = lane & 31, hi = lane >> 5;
    const float* GL = (const float*)(ws + cfg::WS_GL); const bf16_t* GQK = (const bf16_t*)(ws + cfg::WS_GQK); const bf16_t* GV = (const bf16_t*)(ws + cfg::WS_GV); const bf16_t* GR = (const bf16_t*)(ws + cfg::WS_GR);
    const float* KVC = (const float*)(ws + cfg::WS_OF) + (size_t)((b * 4 + h) * 32) * 2 * 2048; const float* DEC = (const float*)(ws + cfg::WS_DEC) + (size_t)((b * 4 + h) * 32) * 2 * 32;
    const size_t tok0 = (size_t)b * 2048 + g * 256;
    if (wave < 4) {
        const int c = wave, dir = lane >> 5, d = lane & 31;
        const float* gl = GL + (tok0 + c * 64) * 256 + dir * 128 + h * 32 + d; const bf16_t* qp = GQK + (tok0 + c * 64) * 256 + h * 32 + d;
        GLAS unsigned short* qt = (GLAS unsigned short*)(lds + B_QT + c * 8192) + dir * 32 + d;
        GLAS unsigned short* kt = (GLAS unsigned short*)(lds + B_KT + c * 8192 + dir * 4096) + d;
        float bsum = 0.f; float gA[8], gB[8]; unsigned short qA[8], kA[8], qB[8], kB[8];
#define GLB_LOAD(G, Q, K, blk) do { const int t0_ = dir ? 56 - 8 * (blk) : 8 * (blk); _Pragma("unroll") for (int i = 0; i < 8; ++i) { G[i] = gl[(size_t)(t0_ + i) * 256]; Q[i] = qp[(size_t)(t0_ + i) * 256]; K[i] = qp[(size_t)(t0_ + i) * 256 + 128]; } } while (0)
#define GLB_PROC(G, Q, K, blk) do { const int t0_ = dir ? 56 - 8 * (blk) : 8 * (blk); _Pragma("unroll") for (int ii = 0; ii < 8; ++ii) { \
            const float gi = dir ? G[7 - ii] : G[ii], qi = bf2f_(dir ? Q[7 - ii] : Q[ii]), ki = bf2f_(dir ? K[7 - ii] : K[ii]); const int tt = t0_ + (dir ? 7 - ii : ii); \
            bsum += gi; const float e = __expf(bsum), ei = __expf(-bsum); \
            qt[tt * 64] = (unsigned short)(cvtpk(qi * e, 0.f) & 0xffffu); kt[tt * 32] = (unsigned short)(cvtpk(ki * ei, 0.f) & 0xffffu); } } while (0)
        GLB_LOAD(gA, qA, kA, 0);
#pragma unroll
        for (int bp = 0; bp < 4; ++bp) { GLB_LOAD(gB, qB, kB, 2 * bp + 1); GLB_PROC(gA, qA, kA, 2 * bp); if (bp < 3) GLB_LOAD(gA, qA, kA, 2 * bp + 2); GLB_PROC(gB, qB, kB, 2 * bp + 1); }
#undef GLB_LOAD
#undef GLB_PROC
    } else {
        const int c = wave - 4; load_v_tile(GV + (tok0 + c * 64) * 256 + h * 64, lds + B_V + c * 8192, lane);
        const int t2 = tid - 256, d = t2 >> 3, v8 = (t2 & 7) * 8;
        const float* kvp = KVC + d * 64 + v8; const float* dcp = DEC + d;
        f32x4 own[4][2][2]; float dow[4][2];
#pragma unroll
        for (int c4 = 0; c4 < 4; ++c4)
#pragma unroll
            for (int dr = 0; dr < 2; ++dr) { const int n = 4 * g + c4; own[c4][dr][0] = *(const f32x4*)(kvp + (size_t)(n * 2 + dr) * 2048); own[c4][dr][1] = *(const f32x4*)(kvp + (size_t)(n * 2 + dr) * 2048 + 4); dow[c4][dr] = dcp[(n * 2 + dr) * 32]; }
        f32x4 Sf0 = {0.f, 0.f, 0.f, 0.f}, Sf1 = Sf0, Sb0 = Sf0, Sb1 = Sf0;
#pragma unroll 8
        for (int n = 0; n < 4 * g; ++n) { const float dc = dcp[(n * 2) * 32]; Sf0 = dc * Sf0 + *(const f32x4*)(kvp + (size_t)(n * 2) * 2048); Sf1 = dc * Sf1 + *(const f32x4*)(kvp + (size_t)(n * 2) * 2048 + 4); }
#pragma unroll 8
        for (int n = 31; n >= 4 * g + 4; --n) { const float dc = dcp[(n * 2 + 1) * 32]; Sb0 = dc * Sb0 + *(const f32x4*)(kvp + (size_t)(n * 2 + 1) * 2048); Sb1 = dc * Sb1 + *(const f32x4*)(kvp + (size_t)(n * 2 + 1) * 2048 + 4); }
#pragma unroll
        for (int c4 = 0; c4 < 4; ++c4) { u32x4 w; w.x = cvtpk(Sf0[0], Sf0[1]); w.y = cvtpk(Sf0[2], Sf0[3]); w.z = cvtpk(Sf1[0], Sf1[1]); w.w = cvtpk(Sf1[2], Sf1[3]);
            *(GLAS u32x4*)(lds + B_SC + c4 * 8192 + v_st64(d, v8)) = w; Sf0 = dow[c4][0] * Sf0 + own[c4][0][0]; Sf1 = dow[c4][0] * Sf1 + own[c4][0][1]; }
#pragma unroll
        for (int c4 = 3; c4 >= 0; --c4) { u32x4 w; w.x = cvtpk(Sb0[0], Sb0[1]); w.y = cvtpk(Sb0[2], Sb0[3]); w.z = cvtpk(Sb1[0], Sb1[1]); w.w = cvtpk(Sb1[2], Sb1[3]);
            *(GLAS u32x4*)(lds + B_SC + c4 * 8192 + v_st64(32 + d, v8)) = w; Sb0 = dow[c4][1] * Sb0 + own[c4][1][0]; Sb1 = dow[c4][1] * Sb1 + own[c4][1][1]; }
    }
    __syncthreads();
    {
        const int c = wave >> 1, th = wave & 1, t = 32 * th + r32;
        const GLAS unsigned char* qrow = lds + B_QT + c * 8192 + t * 128;
        f32x16 pf0 = {}, pf1 = {}, pb0 = {}, pb1 = {};
#pragma unroll
        for (int ks = 0; ks < 2; ++ks) {
            const bf16x8 qf = *(const GLAS bf16x8*)(qrow + (16 * ks + 8 * hi) * 2), qb = *(const GLAS bf16x8*)(qrow + (32 + 16 * ks + 8 * hi) * 2);
            const GLAS unsigned char* kf = lds + B_KT + c * 8192 + r32 * 64 + (16 * ks + 8 * hi) * 2; const GLAS unsigned char* kb = kf + 4096;
            pf0 = __builtin_amdgcn_mfma_f32_32x32x16_bf16(*(const GLAS bf16x8*)kf, qf, pf0, 0, 0, 0); pf1 = __builtin_amdgcn_mfma_f32_32x32x16_bf16(*(const GLAS bf16x8*)(kf + 2048), qf, pf1, 0, 0, 0);
            pb0 = __builtin_amdgcn_mfma_f32_32x32x16_bf16(*(const GLAS bf16x8*)kb, qb, pb0, 0, 0, 0); pb1 = __builtin_amdgcn_mfma_f32_32x32x16_bf16(*(const GLAS bf16x8*)(kb + 2048), qb, pb1, 0, 0, 0);
        }
#pragma unroll
        for (int r = 0; r < 16; ++r) { const int j0 = crow(r, hi), j1 = 32 + j0;
            pf0[r] = (j0 <= t ? pf0[r] : 0.f) + (j0 >= t ? pb0[r] : 0.f); pf1[r] = (j1 <= t ? pf1[r] : 0.f) + (j1 >= t ? pb1[r] : 0.f); }
        bf16x8 pa0, pa1, pa2, pa3;
#define GLA_PK4(P, BASE, OUT) do { unsigned a0 = cvtpk(P[BASE + 0], P[BASE + 1]), a1 = cvtpk(P[BASE + 2], P[BASE + 3]); unsigned b0 = cvtpk(P[BASE + 4], P[BASE + 5]), b1 = cvtpk(P[BASE + 6], P[BASE + 7]); \
    auto r0 = __builtin_amdgcn_permlane32_swap(a0, b0, false, false); auto r1 = __builtin_amdgcn_permlane32_swap(a1, b1, false, false); \
    u32x4 w = {r0[0], r1[0], r0[1], r1[1]}; OUT = *reinterpret_cast<bf16x8*>(&w); } while (0)
        GLA_PK4(pf0, 0, pa0); GLA_PK4(pf0, 8, pa1); GLA_PK4(pf1, 0, pa2); GLA_PK4(pf1, 8, pa3);
#undef GLA_PK4
        f32x16 o0 = {}, o1 = {};
        { const int vb = (int)(unsigned)(uintptr_t)(lds + B_V + c * 8192) + att::v_rd_base(lane);
#define GLA_AF(ks) ((ks) == 0 ? pa0 : (ks) == 1 ? pa1 : (ks) == 2 ? pa2 : pa3)
          GLA_MM4(o0, o1, vb, GLA_AF);
#undef GLA_AF
        }
        { const int vb = (int)(unsigned)(uintptr_t)(lds + B_SC + c * 8192) + att::v_rd_base(lane);
#define GLA_AF(ks) afrag_tr(qrow, ks, hi)
          GLA_MM4(o0, o1, vb, GLA_AF);
#undef GLA_AF
        }
        const float g0 = gng[r32], g1 = gng[32 + r32];
        const bf16_t* grb = GR + (tok0 + c * 64 + 32 * th) * 256 + h * 64 + r32; unsigned short gq0[16], gq1[16];
#pragma unroll
        for (int r = 0; r < 16; ++r) { gq0[r] = grb[(size_t)crow(r, hi) * 256]; gq1[r] = grb[(size_t)crow(r, hi) * 256 + 32]; }
#pragma unroll
        for (int r = 0; r < 16; ++r) {
            float ssq = o0[r] * o0[r] + o1[r] * o1[r];
            ssq = xadd<1>(ssq); ssq = xadd<2>(ssq); ssq = xadd<4>(ssq); ssq = xadd<8>(ssq); ssq = xadd<16>(ssq);
            const float rn = rsqrtf(ssq * (1.f / 64.f) + cfg::EPS);
            const size_t tok = tok0 + c * 64 + 32 * th + crow(r, hi);
            bf16_t* dst = OC + tok * 1024 + 768 + h * 64 + r32;
            dst[0] = (bf16_t)(cvtpk(o0[r] * rn * g0 * bf2f_(gq0[r]), 0.f) & 0xffffu); dst[32] = (bf16_t)(cvtpk(o1[r] * rn * g1 * bf2f_(gq1[r]), 0.f) & 0xffffu);
        }
    }
    __syncthreads();
}
#undef GLA_MM4
#undef GLA_PK
#undef GLAS
}
namespace fft {
using att::bf16x8; using att::s16x4; using att::f32x16; using att::u32x4; using att::crow; using att::cvtpk; using att::tr_read;
#define FLAS __attribute__((address_space(3)))
__device__ __forceinline__ int img_off(int k, int c) { const int kk = (k & ~0xC) | ((k & 4) << 1) | ((k & 8) >> 1); return ((kk >> 3) * 8 + (c >> 5)) * 512 + ((kk & 7) * 32 + (c & 31)) * 2; }
constexpr int rd_off(int ks, int half) { return ks * 8192 + half * 4096; }
#define FFT_PK(L, H) (bf16x8){L[0], L[1], L[2], L[3], H[0], H[1], H[2], H[3]}
typedef float f32x2_t __attribute__((ext_vector_type(2))); typedef __bf16 bf16x2_t __attribute__((ext_vector_type(2)));
__device__ __forceinline__ unsigned pk2f(float a, float b) { f32x2_t v = {a, b}; bf16x2_t r = __builtin_convertvector(v, bf16x2_t); return __builtin_bit_cast(unsigned, r); }

__device__ __forceinline__ void stage1_item(int b, int s2, const bf16_t* __restrict__ FX, bf16_t* __restrict__ I1, FLAS unsigned char* lds) {
    int tid_o = threadIdx.x; asm volatile("" : "+v"(tid_o));
    const int tid = tid_o, wave = __builtin_amdgcn_readfirstlane(tid >> 6), lane = tid & 63, r32 = lane & 31, hi = lane >> 5;
    bf16x8 F1[2][4];
#pragma unroll
    for (int ks = 0; ks < 4; ++ks) { float cr[8], ci[8];
#pragma unroll
        for (int j = 0; j < 8; ++j) { const int k = 16 * ks + 8 * hi + j, s1 = k & 31; const float rev = (float)((r32 * s1) & 31) * (1.f / 32.f); const float c = __builtin_amdgcn_cosf(rev), sn = __builtin_amdgcn_sinf(rev);
            const bool p1 = (k >> 5) != 0; cr[j] = p1 ? -sn : c; ci[j] = p1 ? -c : -sn; }
        u32x4 wr = {pk2f(cr[0], cr[1]), pk2f(cr[2], cr[3]), pk2f(cr[4], cr[5]), pk2f(cr[6], cr[7])}, wi = {pk2f(ci[0], ci[1]), pk2f(ci[2], ci[3]), pk2f(ci[4], ci[5]), pk2f(ci[6], ci[7])};
        F1[0][ks] = *reinterpret_cast<bf16x8*>(&wr); F1[1][ks] = *reinterpret_cast<bf16x8*>(&wi); }
    { u32x4 tv[4];
#pragma unroll
      for (int i = 0; i < 4; ++i) { const int p = tid + 512 * i, k = p >> 5, c8 = (p & 31) * 8; tv[i] = *(const u32x4*)(FX + (size_t)(b * 2048 + 64 * (k & 31) + s2) * 512 + (k >> 5) * 256 + c8); }
#pragma unroll
      for (int i = 0; i < 4; ++i) { const int p = tid + 512 * i, k = p >> 5, c8 = (p & 31) * 8; *(FLAS u32x4*)(lds + img_off(k, c8)) = tv[i]; } }
    __syncthreads();
    f32x16 re = {}, im = {};
    { const int vb = (int)(unsigned)(uintptr_t)lds + att::v_rd_base(lane) + wave * 512;
      const s16x4 l0 = tr_read<rd_off(0, 0)>(vb), h0 = tr_read<rd_off(0, 1)>(vb), l1 = tr_read<rd_off(1, 0)>(vb), h1 = tr_read<rd_off(1, 1)>(vb);
      const s16x4 l2 = tr_read<rd_off(2, 0)>(vb), h2 = tr_read<rd_off(2, 1)>(vb), l3 = tr_read<rd_off(3, 0)>(vb), h3 = tr_read<rd_off(3, 1)>(vb);
      asm volatile("s_waitcnt lgkmcnt(0)" ::: "memory"); __builtin_amdgcn_sched_barrier(0);
      re = __builtin_amdgcn_mfma_f32_32x32x16_bf16(F1[0][0], FFT_PK(l0, h0), re, 0, 0, 0); im = __builtin_amdgcn_mfma_f32_32x32x16_bf16(F1[1][0], FFT_PK(l0, h0), im, 0, 0, 0);
      re = __builtin_amdgcn_mfma_f32_32x32x16_bf16(F1[0][1], FFT_PK(l1, h1), re, 0, 0, 0); im = __builtin_amdgcn_mfma_f32_32x32x16_bf16(F1[1][1], FFT_PK(l1, h1), im, 0, 0, 0);
      re = __builtin_amdgcn_mfma_f32_32x32x16_bf16(F1[0][2], FFT_PK(l2, h2), re, 0, 0, 0); im = __builtin_amdgcn_mfma_f32_32x32x16_bf16(F1[1][2], FFT_PK(l2, h2), im, 0, 0, 0);
      re = __builtin_amdgcn_mfma_f32_32x32x16_bf16(F1[0][3], FFT_PK(l3, h3), re, 0, 0, 0); im = __builtin_amdgcn_mfma_f32_32x32x16_bf16(F1[1][3], FFT_PK(l3, h3), im, 0, 0, 0); }
    bf16_t* dst = I1 + (size_t)(b * 32) * 128 * 256 + (size_t)s2 * 256 + 32 * wave + r32;
#pragma unroll
    for (int r = 0; r < 16; ++r) { const int k1 = crow(r, hi); const float rev = (float)((k1 * s2) & 2047) * (1.f / 2048.f); const float ct = __builtin_amdgcn_cosf(rev), st = __builtin_amdgcn_sinf(rev);
        const float ar = re[r] * ct + im[r] * st, ai = im[r] * ct - re[r] * st; const unsigned w = pk2f(ar, ai);
        dst[(size_t)k1 * 128 * 256] = (bf16_t)(w & 0xffffu); dst[(size_t)k1 * 128 * 256 + 64 * 256] = (bf16_t)(w >> 16); }
    __syncthreads();
}

__device__ __forceinline__ void stage2_item(int b, int k1, const bf16_t* __restrict__ I1, bf16_t* __restrict__ OC, FLAS unsigned char* lds) {
    int tid_o = threadIdx.x; asm volatile("" : "+v"(tid_o));
    const int tid = tid_o, wave = __builtin_amdgcn_readfirstlane(tid >> 6), lane = tid & 63, r32 = lane & 31, hi = lane >> 5;
    const bf16_t* src = I1 + (size_t)(b * 32 + k1) * 128 * 256;
    { u32x4 tv[8];
#pragma unroll
      for (int i = 0; i < 8; ++i) { const int p = tid + 512 * i, k = p >> 5, c8 = (p & 31) * 8; tv[i] = *(const u32x4*)(src + (size_t)k * 256 + c8); }
#pragma unroll
      for (int i = 0; i < 8; ++i) { const int p = tid + 512 * i, k = p >> 5, c8 = (p & 31) * 8; *(FLAS u32x4*)(lds + img_off(k, c8)) = tv[i]; } }
    f32x16 y0 = {}, y1 = {};
    __syncthreads();
    const int vb = (int)(unsigned)(uintptr_t)lds + att::v_rd_base(lane) + wave * 512, vb2 = vb + 32768;
    bf16x8 F2[2][8];
#pragma unroll
    for (int ks = 0; ks < 8; ++ks) { float c0[8], c1[8];
#pragma unroll
        for (int j = 0; j < 8; ++j) { const int k = 16 * ks + 8 * hi + j, s2 = k & 63; const float r0 = (float)((r32 * s2) & 63) * (1.f / 64.f), r1 = (float)(((32 + r32) * s2) & 63) * (1.f / 64.f);
            c0[j] = (k >> 6) ? __builtin_amdgcn_sinf(r0) : __builtin_amdgcn_cosf(r0); c1[j] = (k >> 6) ? __builtin_amdgcn_sinf(r1) : __builtin_amdgcn_cosf(r1); }
        u32x4 w0 = {pk2f(c0[0], c0[1]), pk2f(c0[2], c0[3]), pk2f(c0[4], c0[5]), pk2f(c0[6], c0[7])}, w1 = {pk2f(c1[0], c1[1]), pk2f(c1[2], c1[3]), pk2f(c1[4], c1[5]), pk2f(c1[6], c1[7])};
        F2[0][ks] = *reinterpret_cast<bf16x8*>(&w0); F2[1][ks] = *reinterpret_cast<bf16x8*>(&w1); }
#define FFT_STEP(ks) do { \
      const s16x4 lo_ = tr_read<rd_off((ks) & 3, 0)>((ks) < 4 ? vb : vb2), hi_ = tr_read<rd_off((ks) & 3, 1)>((ks) < 4 ? vb : vb2); asm volatile("s_waitcnt lgkmcnt(0)" ::: "memory"); __builtin_amdgcn_sched_barrier(0); \
      y0 = __builtin_amdgcn_mfma_f32_32x32x16_bf16(F2[0][ks], FFT_PK(lo_, hi_), y0, 0, 0, 0); y1 = __builtin_amdgcn_mfma_f32_32x32x16_bf16(F2[1][ks], FFT_PK(lo_, hi_), y1, 0, 0, 0); } while (0)
    FFT_STEP(0); FFT_STEP(1); FFT_STEP(2); FFT_STEP(3); FFT_STEP(4); FFT_STEP(5); FFT_STEP(6); FFT_STEP(7);
#undef FFT_STEP
    bf16_t* dst = OC + (size_t)(b * 2048 + k1) * 1024 + 512 + 32 * wave + r32;
#pragma unroll
    for (int r = 0; r < 16; ++r) { const int k2 = crow(r, hi); const unsigned w = pk2f(y0[r], y1[r]);
        dst[(size_t)(32 * k2) * 1024] = (bf16_t)(w & 0xffffu); dst[(size_t)(32 * (32 + k2)) * 1024] = (bf16_t)(w >> 16); }
    __syncthreads();
}
#undef FFT_PK
#undef FLAS
}
namespace pro {
#define PLAS __attribute__((address_space(3)))
typedef float f32x4 __attribute__((ext_vector_type(4)));
typedef unsigned u32x4 __attribute__((ext_vector_type(4)));
__device__ __forceinline__ unsigned pk2(float lo, float hi) { unsigned r; asm volatile("v_cvt_pk_bf16_f32 %0, %1, %2" : "=v"(r) : "v"(lo), "v"(hi)); return r; }
__device__ __forceinline__ float lo_f(unsigned w) { return __uint_as_float(w << 16); }
__device__ __forceinline__ float hi_f(unsigned w) { return __uint_as_float(w & 0xffff0000u); }
template <bool SUMS, int STRIDE> __device__ __forceinline__ void tile_emit(int K, bf16_t* WT, const float* gain, const float* lnb, float (&a1)[4], float (&a2)[4], const PLAS float* scr, int lane) {
    const int c = lane & 7; float gk[8], bk[8];
#pragma unroll
    for (int q = 0; q < 8; ++q) { gk[q] = gain ? gain[8 * c + q] : 1.f; bk[q] = lnb ? lnb[8 * c + q] : 0.f; }
#pragma unroll
    for (int j = 0; j < 4; ++j) { const int n = (lane >> 3) + 8 * j; const PLAS float* s = scr + (8 * c) * STRIDE + n; float v[8];
#pragma unroll
        for (int q = 0; q < 8; ++q) v[q] = s[q * STRIDE];
        u32x4 o; o.x = pk2(v[0] * gk[0], v[1] * gk[1]); o.y = pk2(v[2] * gk[2], v[3] * gk[3]); o.z = pk2(v[4] * gk[4], v[5] * gk[5]); o.w = pk2(v[6] * gk[6], v[7] * gk[7]);
        *(u32x4*)(WT + (size_t)n * K + 8 * c) = o;
        if (SUMS) { float p1 = (lo_f(o.x) + hi_f(o.x)) + (lo_f(o.y) + hi_f(o.y)) + (lo_f(o.z) + hi_f(o.z)) + (lo_f(o.w) + hi_f(o.w)); float p2 = 0.f;
#pragma unroll
            for (int q = 0; q < 8; ++q) p2 += bk[q] * v[q];
            p1 = xadd<1>(p1); p2 = xadd<1>(p2); p1 = xadd<2>(p1); p2 = xadd<2>(p2); p1 = xadd<4>(p1); p2 = xadd<4>(p2);
            a1[j] += p1; a2[j] += p2; }
    }
    asm volatile("s_waitcnt lgkmcnt(0)" ::: "memory");
}
__device__ __forceinline__ void tile_dma(const float* W, int N, PLAS float* scr, int lane) {
    const float* src = W + (size_t)(lane >> 3) * N + (lane & 7) * 4;
#pragma unroll
    for (int i = 0; i < 8; ++i) __builtin_amdgcn_global_load_lds((const unsigned*)(src + (size_t)(8 * i) * N), (PLAS unsigned*)(scr + i * 256), 16, 0, 0);
}
template <bool SUMS, class Val> __device__ __forceinline__ void tile_item(const Val& val, int K, bf16_t* WT, const float* gain, const float* lnb, float (&a1)[4], float (&a2)[4], PLAS float* scr, int lane) {
#pragma unroll 2
    for (int i = 0; i < 32; ++i) { const int kk = 2 * i + (lane >> 5); scr[kk * 33 + (lane & 31)] = val(kk, lane & 31); }
    asm volatile("s_waitcnt lgkmcnt(0)" ::: "memory");
    tile_emit<SUMS, 33>(K, WT, gain, lnb, a1, a2, scr, lane);
}
struct ValPlain { static constexpr int BATCH = 32; const float* W; int N; __device__ __forceinline__ float operator()(int kk, int j) const { return W[(size_t)kk * N + j]; } };
struct ValGate { static constexpr int BATCH = 2; const float* W; const float* w2; __device__ __forceinline__ float operator()(int kk, int j) const {
    const float* wr = W + (size_t)kk * cfg::INW; float a = 0.f;
#pragma unroll
    for (int r = 0; r < 16; ++r) a += wr[r] * w2[r * 128 + j]; return a; } };

__device__ __forceinline__ void fold_item(int item, unsigned char* ws, const float* w_in, const float* fw, const float* lng, const float* lnb, PLAS unsigned char* lds, int tid) {
    const int l = item >> 5, g = (item >> 3) & 3, part = (item >> 2) & 1, kq = item & 3;
    PLAS float* M = (PLAS float*)lds;
    { const int c = tid >> 3, e0 = (tid & 7) * 8; float acc[8];
#pragma unroll
      for (int q = 0; q < 8; ++q) acc[q] = 0.f;
      const float* w = fw + (size_t)((l * 4 + g) * 64) * 64 + e0;
      for (int k2 = 0; k2 < 64; ++k2) { float rev = (float)((k2 * c) & 63) * (1.f / 64.f); asm volatile("" : "+v"(rev)); const float tr = part ? __builtin_amdgcn_sinf(rev) : __builtin_amdgcn_cosf(rev);
          const f32x4 w0 = *(const f32x4*)(w + k2 * 64), w1 = *(const f32x4*)(w + k2 * 64 + 4);
#pragma unroll
          for (int q = 0; q < 4; ++q) { acc[q] += tr * w0[q]; acc[4 + q] += tr * w1[q]; } }
      const float sc = 0.00276213586400995f;
#pragma unroll
      for (int q = 0; q < 8; ++q) M[c * 64 + e0 + q] = acc[q] * sc; }
    __syncthreads();
    PLAS float* Wl = (PLAS float*)(lds + 16384);
    { const float* wsrc = w_in + ((size_t)l * 1024 + kq * 256) * cfg::INW + 1536 + 64 * g; f32x4 tv[8];
#pragma unroll
      for (int i = 0; i < 8; ++i) tv[i] = *(const f32x4*)(wsrc + (size_t)((tid >> 4) + 32 * i) * cfg::INW + (tid & 15) * 4);
#pragma unroll
      for (int i = 0; i < 8; ++i) *(PLAS f32x4*)(Wl + ((tid >> 4) + 32 * i) * 64 + (tid & 15) * 4) = tv[i]; }
    __syncthreads();
    { const int e = tid & 63, kg = tid >> 6, k0 = kq * 256 + kg * 32, np = 1536 + part * 256 + g * 64 + e; float mc[64];
#pragma unroll
      for (int c = 0; c < 64; ++c) mc[c] = M[c * 64 + e];
      bf16_t* dst = (bf16_t*)(ws + cfg::WS_WIN + l * cfg::SZ_WIN) + (size_t)np * 1024 + k0; float s1 = 0.f, s2 = 0.f;
      for (int kb = 0; kb < 4; ++kb) { float o[8];
#pragma unroll
          for (int q = 0; q < 8; ++q) { const int k = k0 + kb * 8 + q; const PLAS f32x4* wr = (const PLAS f32x4*)(Wl + (kg * 32 + kb * 8 + q) * 64); float a = 0.f;
#pragma unroll
              for (int c4 = 0; c4 < 16; ++c4) { const f32x4 w4 = wr[c4]; a += w4[0] * mc[4 * c4] + w4[1] * mc[4 * c4 + 1] + w4[2] * mc[4 * c4 + 2] + w4[3] * mc[4 * c4 + 3]; }
              o[q] = a * (lng ? lng[k] : 1.f); s2 += lnb ? lnb[k] * a : 0.f; }
          u32x4 w; w.x = pk2(o[0], o[1]); w.y = pk2(o[2], o[3]); w.z = pk2(o[4], o[5]); w.w = pk2(o[6], o[7]); *(u32x4*)(dst + kb * 8) = w;
          s1 += (lo_f(w.x) + hi_f(w.x)) + (lo_f(w.y) + hi_f(w.y)) + (lo_f(w.z) + hi_f(w.z)) + (lo_f(w.w) + hi_f(w.w)); }
      __syncthreads();
      PLAS float* red = (PLAS float*)lds; red[(kg * 64 + e) * 2] = s1; red[(kg * 64 + e) * 2 + 1] = s2;
      __syncthreads();
      if (kg == 0) { float t1 = 0.f, t2 = 0.f;
#pragma unroll
          for (int w = 0; w < 8; ++w) { t1 += red[(w * 64 + e) * 2]; t2 += red[(w * 64 + e) * 2 + 1]; }
          float* fp = (float*)(ws + cfg::V_MF) + (size_t)((l * 4 + kq) * 2) * 512 + part * 256 + g * 64 + e; fp[0] = t1; fp[512] = t2; } }
    __syncthreads();
}

struct Inputs { const float *x, *w_in, *fw, *gw2, *w_out, *ln1g, *ln1b, *wg, *wu, *wd, *ln2g, *ln2b; };
__device__ __forceinline__ void prologue(unsigned char* ws, const Inputs& in, PLAS unsigned char* lds, int vcu, int G) {
    int tid_o = threadIdx.x; asm volatile("" : "+v"(tid_o));
    const int tid = tid_o, wave = __builtin_amdgcn_readfirstlane(tid >> 6), lane = tid & 63;
    const float* x = in.x; const float* w_in = in.w_in; const float* fw = in.fw; const float* gw2 = in.gw2; const float* w_out = in.w_out; const float* ln1g = in.ln1g; const float* ln1b = in.ln1b;
    const float* wg = in.wg; const float* wu = in.wu; const float* wd = in.wd; const float* ln2g = in.ln2g; const float* ln2b = in.ln2b;
    if (vcu < 64) { const int l = vcu >> 5; fold_item(vcu, ws, w_in, fw, l ? ln2g : (const float*)nullptr, l ? ln2b : (const float*)nullptr, lds, tid); }
    PLAS float* scr = (PLAS float*)(lds + wave * 16384); PLAS float* scr1 = scr + 2048; PLAS float* redw = (PLAS float*)(lds + 131072 + 1024 + wave * 256);
    const int gw = vcu * 8 + wave, NGW = G * 8;
    for (int it = vcu; it < 512; it += G) {
        const int l = it >> 8, r = it & 255; float a1[4] = {0.f, 0.f, 0.f, 0.f}, a2[4] = {0.f, 0.f, 0.f, 0.f}; float* c1o; float* c2o;
        const int k0 = wave * 64, k1 = k0 + 512;
        if (r < 80) { const int nb = r; const float* lngb = l ? ln2g : (const float*)nullptr; const float* lnbb = l ? ln2b : (const float*)nullptr;
            bf16_t* Wt = (bf16_t*)(ws + cfg::WS_WIN + l * cfg::SZ_WIN);
            if (nb < 72) { int np0, src;
                if (nb < 32) { const int pn = nb >> 3, p = (nb & 7) * 32, wc = (p >> 5) & 3, bj = p >> 7; np0 = pn * 256 + p; src = (pn >> 1) * 512 + (pn & 1) * 256 + 64 * wc + 32 * bj; }
                else if (nb < 48) { np0 = 1024 + (nb - 32) * 32; src = np0; }
                else { np0 = 2048 + (nb - 48) * 32; src = 1792 + (nb - 48) * 32; }
                tile_dma(w_in + ((size_t)l * 1024 + k0) * cfg::INW + src, cfg::INW, scr, lane); tile_dma(w_in + ((size_t)l * 1024 + k1) * cfg::INW + src, cfg::INW, scr1, lane);
                asm volatile("s_waitcnt vmcnt(0)" ::: "memory");
                tile_emit<true, 32>(1024, Wt + (size_t)np0 * 1024 + k0, lngb ? lngb + k0 : lngb, lnbb ? lnbb + k0 : lnbb, a1, a2, scr, lane);
                tile_emit<true, 32>(1024, Wt + (size_t)np0 * 1024 + k1, lngb ? lngb + k1 : lngb, lnbb ? lnbb + k1 : lnbb, a1, a2, scr1, lane);
                c1o = (float*)(ws + cfg::V_C1IN) + l * cfg::NIN + np0; c2o = (float*)(ws + cfg::V_C2IN) + l * cfg::NIN + np0;
            } else { const int p0 = (nb - 72) * 32, dir = p0 >> 7, kk0 = p0 & 127, np0 = 2816 + p0;
                for (int kb = wave; kb < 16; kb += 8) { const int kq = kb * 64; ValGate v{w_in + ((size_t)l * 1024 + kq) * cfg::INW + 2560 + 16 * dir, gw2 + (size_t)((l * 2 + dir) * 16) * 128 + kk0};
                    tile_item<true>(v, 1024, Wt + (size_t)np0 * 1024 + kq, lngb ? lngb + kq : lngb, lnbb ? lnbb + kq : lnbb, a1, a2, scr, lane); }
                c1o = (float*)(ws + cfg::V_C1IN) + l * cfg::NIN + np0; c2o = (float*)(ws + cfg::V_C2IN) + l * cfg::NIN + np0; }
        } else { const int nb = r - 80, np0 = nb * 32, pn = np0 >> 8, p = np0 & 255, bj = p >> 7, f0 = 128 * pn + (p & 127);
            const float* W = (bj ? wu : wg) + (size_t)l * 1024 * cfg::FF + f0; bf16_t* Wt = (bf16_t*)(ws + cfg::WS_WGU + l * cfg::SZ_WGU) + (size_t)np0 * 1024;
            tile_dma(W + (size_t)k0 * cfg::FF, cfg::FF, scr, lane); tile_dma(W + (size_t)k1 * cfg::FF, cfg::FF, scr1, lane);
            asm volatile("s_waitcnt vmcnt(0)" ::: "memory");
            tile_emit<true, 32>(1024, Wt + k0, ln1g + l * 1024 + k0, ln1b + l * 1024 + k0, a1, a2, scr, lane);
            tile_emit<true, 32>(1024, Wt + k1, ln1g + l * 1024 + k1, ln1b + l * 1024 + k1, a1, a2, scr1, lane);
            c1o = (float*)(ws + cfg::V_C1GU) + l * cfg::NGU + np0; c2o = (float*)(ws + cfg::V_C2GU) + l * cfg::NGU + np0; }
        if ((lane & 7) == 0) {
#pragma unroll
            for (int j = 0; j < 4; ++j) { const int n = (lane >> 3) + 8 * j; redw[n * 2] = a1[j]; redw[n * 2 + 1] = a2[j]; } }
        __syncthreads();
        if (wave == 0 && lane < 32) { float t1 = 0.f, t2 = 0.f;
#pragma unroll
            for (int w = 0; w < 8; ++w) { const PLAS float* rw = (const PLAS float*)(lds + 131072 + 1024 + w * 256); t1 += rw[lane * 2]; t2 += rw[lane * 2 + 1]; }
            c1o[lane] = t1; c2o[lane] = t2; }
        __syncthreads();
    }
    constexpr int I_OUT = 32 * 16, I_DN = 32 * 44, I_L = I_OUT + I_DN;
    for (int it = gw; it < 2 * I_L; it += 2 * NGW) {
        const float* Ws[2]; int Ns[2], Ks[2]; bf16_t* Wd[2]; float d1[4], d2[4];
#pragma unroll
        for (int q = 0; q < 2; ++q) { const int itq = it + q * NGW; const int ic = itq < 2 * I_L ? itq : it; const int l = ic / I_L; int r = ic - l * I_L;
            if (r < I_OUT) { const int nb = r >> 4, kb = r & 15, k0 = kb * 64, n0 = nb * 32; Ws[q] = w_out + ((size_t)l * 1024 + k0) * 1024 + n0; Ns[q] = 1024; Ks[q] = 1024;
                Wd[q] = (bf16_t*)(ws + cfg::WS_WOUT + l * cfg::SZ_WOUT) + (size_t)n0 * 1024 + k0; }
            else { r -= I_OUT; const int nb = r / 44, kb = r - nb * 44, k0 = kb * 64, n0 = nb * 32; Ws[q] = wd + ((size_t)l * cfg::FF + k0) * 1024 + n0; Ns[q] = 1024; Ks[q] = cfg::FF;
                Wd[q] = (bf16_t*)(ws + cfg::WS_WDN + l * cfg::SZ_WDN) + (size_t)n0 * cfg::FF + k0; } }
        tile_dma(Ws[0], Ns[0], scr, lane); tile_dma(Ws[1], Ns[1], scr1, lane);
        asm volatile("s_waitcnt vmcnt(0)" ::: "memory");
        tile_emit<false, 32>(Ks[0], Wd[0], (const float*)nullptr, (const float*)nullptr, d1, d2, scr, lane);
        if (it + NGW < 2 * I_L) tile_emit<false, 32>(Ks[1], Wd[1], (const float*)nullptr, (const float*)nullptr, d1, d2, scr1, lane);
    }
    const int xw = (vcu - 64) * 8 + wave, NXW = (G - 64) * 8;
    if (vcu >= 64 && G > 64)
    for (int m = xw; m < cfg::T; m += 4 * NXW) {
        f32x4 v[4][4];
#pragma unroll
        for (int q = 0; q < 4; ++q) { const int mr = (m + q * NXW) < cfg::T ? (m + q * NXW) : m; const f32x4* xr = (const f32x4*)(x + (size_t)mr * 1024) + lane;
#pragma unroll
            for (int j = 0; j < 4; ++j) v[q][j] = xr[64 * j]; }
#pragma unroll
        for (int q = 0; q < 4; ++q) { const int mr = (m + q * NXW) < cfg::T ? (m + q * NXW) : m; unsigned long long* o8 = (unsigned long long*)((bf16_t*)(ws + cfg::WS_XB) + (size_t)mr * 1024) + lane;
#pragma unroll
            for (int j = 0; j < 4; ++j) o8[64 * j] = (unsigned long long)pk2(v[q][j][0], v[q][j][1]) | ((unsigned long long)pk2(v[q][j][2], v[q][j][3]) << 32); } }
    for (int i = gw * 64 + lane; i < 2048 * 32; i += NGW * 64) { const int pos = i >> 5, f = i & 31; const float inv = exp2f(-(float)f * (13.287712379549449f / 32.f)); const float ang = (float)pos * inv;
        double rv = (double)ang * 0.15915494309189535; rv -= floor(rv); const float rev = (float)rv;
        ((float*)(ws + cfg::V_ROPEC))[i] = __builtin_amdgcn_cosf(rev); ((float*)(ws + cfg::V_ROPES))[i] = __builtin_amdgcn_sinf(rev); }
}
#undef PLAS
}
constexpr int NWAVES = 8;
constexpr int RING_OFF = 0, RING_BYTES = 131072;
constexpr int LDSCTL_OFF = RING_BYTES, MISC_OFF = LDSCTL_OFF + 320;
constexpr int RSL_OFF = 131072 + 4096;
constexpr int LDS_BYTES = 147456;
constexpr int CW_BAR = 4096;
constexpr size_t CTL_ZERO_BYTES = 64 * 1024;
#define GAS __attribute__((address_space(1)))
#define LAS __attribute__((address_space(3)))
typedef GAS unsigned gu32;
#define RLX_AGENT __ATOMIC_RELAXED, __HIP_MEMORY_SCOPE_AGENT
#define XB_TMO      128
#define XB_XCNT(j)  (256  + 64 * (j))
#define XB_XSUB(j)  (1280 + 64 * (j))
#define XB_XGEN(j)  (2304 + 64 * (j))
#define XB_TOP      3328
#define XB_TOPGEN   3392
#define XCD_BAR_WORDS 3456
#define XB_SPIN_CAP (1u << 18)

__device__ __forceinline__ unsigned xb_ld(unsigned* p)              { return __hip_atomic_load(p, __ATOMIC_RELAXED, __HIP_MEMORY_SCOPE_AGENT); }
__device__ __forceinline__ unsigned xb_add(unsigned* p, unsigned v) { return __hip_atomic_fetch_add(p, v, __ATOMIC_RELAXED, __HIP_MEMORY_SCOPE_AGENT); }
__device__ __forceinline__ unsigned xb_xcc_id() { return (unsigned)__builtin_amdgcn_s_getreg((3 << 11) | 20) & 0xFu; }
#define XB_SPIN(cond, bar) do { unsigned _sp = 0; while (cond) { __builtin_amdgcn_s_sleep(1); \
    if ((++_sp & 255u) == 0u) { if (xb_ld(&(bar)[XB_TMO])) break; if (_sp > XB_SPIN_CAP) { atomicAdd(&(bar)[XB_TMO], 1u); break; } } } } while (0)

struct XcdBarrier {
    unsigned* bar; unsigned x;
    volatile LAS unsigned* st;
};

__device__ __forceinline__ XcdBarrier xcd_barrier_post(unsigned* bar, volatile LAS unsigned* st) {
    XcdBarrier b; b.bar = bar; b.x = xb_xcc_id(); b.st = st;
    if (threadIdx.x == 0) (void)xb_add(&bar[XB_XCNT(b.x)], 1u);
    return b;
}
__device__ __forceinline__ void xcd_barrier_complete(unsigned* bar, unsigned x, unsigned& nloc, unsigned& nx) {
    const unsigned G = gridDim.x * gridDim.y * gridDim.z;
    unsigned sum, cnt, mine, sp = 0u;
    for (;;) {
        sum = 0u; cnt = 0u; mine = 0u;
#pragma unroll
        for (unsigned j = 0; j < 16; ++j) { const unsigned c = xb_ld(&bar[XB_XCNT(j)]); sum += c; cnt += (c > 0u) ? 1u : 0u; mine = (j == x) ? c : mine; }
        if (sum == G) break;
        __builtin_amdgcn_s_sleep(1);
        if ((++sp & 255u) == 0u) { if (xb_ld(&bar[XB_TMO])) break; if (sp > XB_SPIN_CAP) { atomicAdd(&bar[XB_TMO], 1u); break; } }
    }
    nloc = mine > 0u ? mine : 1u; nx = cnt > 0u ? cnt : 1u;
}

__device__ __forceinline__ void xcd_barrier(const XcdBarrier& b) {
    asm volatile("s_waitcnt vmcnt(0)" ::: "memory");
    __syncthreads();
    if (threadIdx.x == 0) {
        unsigned* bar = b.bar;
        __builtin_amdgcn_s_waitcnt(0);
        unsigned nloc = b.st[0], nx = b.st[1];
        if (nloc == 0u) { xcd_barrier_complete(bar, b.x, nloc, nx); b.st[0] = nloc; b.st[1] = nx; }
        const unsigned old = xb_add(&bar[XB_XSUB(b.x)], 1u);
        const unsigned gen = old / nloc;
        if (old + 1u == (gen + 1u) * nloc) {
            __builtin_amdgcn_fence(__ATOMIC_RELEASE, "agent");
            asm volatile("s_waitcnt vmcnt(0)" ::: "memory");
            const unsigned og = xb_add(&bar[XB_TOP], 1u);
            const unsigned tg = og / nx;
            if (og + 1u == (tg + 1u) * nx) xb_add(&bar[XB_TOPGEN], 1u);
            else XB_SPIN(xb_ld(&bar[XB_TOPGEN]) == tg, bar);
            __builtin_amdgcn_fence(__ATOMIC_ACQUIRE, "agent");
            xb_add(&bar[XB_XGEN(b.x)], 1u);
            asm volatile("s_waitcnt vmcnt(0)" ::: "memory");
        } else {
            XB_SPIN(xb_ld(&bar[XB_XGEN(b.x)]) == gen, bar);
            __builtin_amdgcn_fence(__ATOMIC_ACQUIRE, "agent");
            asm volatile("s_waitcnt vmcnt(0)" ::: "memory");
        }
    }
    __syncthreads();
}


#define FILL_RSL(STP) do { pg8::Unit u0_; if (S.next(0, u0_)) { int tq_ = threadIdx.x; asm volatile("" : "+v"(tq_)); const int row_ = u0_.pm * 256 + (tq_ >> 1), hf_ = tq_ & 1; \
    typedef float f32x4_ __attribute__((ext_vector_type(4))); typedef float f32x2_ __attribute__((ext_vector_type(2))); \
    const f32x4_* sp_ = (const f32x4_*)((STP) + (size_t)row_ * 32 + hf_ * 16); const f32x4_ x0 = sp_[0], x1 = sp_[1], x2 = sp_[2], x3 = sp_[3]; \
    float sm_ = ((x0[0] + x0[2]) + (x1[0] + x1[2])) + ((x2[0] + x2[2]) + (x3[0] + x3[2])), sq_ = ((x0[1] + x0[3]) + (x1[1] + x1[3])) + ((x2[1] + x2[3]) + (x3[1] + x3[3])); \
    sm_ = xadd<1>(sm_); sq_ = xadd<1>(sq_); const float mu_ = sm_ * (1.f / 1024.f), rstd_ = rsqrtf(fmaxf(sq_ * (1.f / 1024.f) - mu_ * mu_, 0.f) + EPS); \
    if (hf_ == 0) *(LAS f32x2_*)(ldsl + RSL_OFF + 8 * (tq_ >> 1)) = (f32x2_){rstd_, -rstd_ * mu_}; } \
    __syncthreads(); } while (0)

enum { PH_PRO = 0, PH_IN = 1, PH_ATT = 2, PH_MIXB = 3, PH_OUT = 4, PH_GU = 5, PH_DN = 6, PH_FIN = 13, N_PHASES = 14 };
struct MArgs { const float* in[16]; float* out; unsigned char* ws; int ph_lo, ph_hi, li, pad; };

__global__ void __launch_bounds__(NWAVES * 64, 2) mk_fwd(MArgs a) {
    extern __shared__ __attribute__((aligned(128))) unsigned char lds[];
    LAS unsigned char* ldsl = (LAS unsigned char*)lds;
    volatile LAS unsigned* MISC = (volatile LAS unsigned*)(ldsl + MISC_OFF);
    const int tid = threadIdx.x;
    const int G = gridDim.x, bx = blockIdx.x, vcu = (G % 8 == 0) ? (bx % 8) * (G / 8) + bx / 8 : bx;
    unsigned char* ws = a.ws;
    for (int u = tid; u < (LDS_BYTES - LDSCTL_OFF) / 4; u += NWAVES * 64) ((LAS unsigned*)(ldsl + LDSCTL_OFF))[u] = 0u;
    __syncthreads();
    XcdBarrier bar; bar.bar = (unsigned*)(ws + WS_CTL) + CW_BAR + a.li * XCD_BAR_WORDS; bar.x = 0; bar.st = nullptr;
    if (a.ph_hi - a.ph_lo > 1) bar = xcd_barrier_post((unsigned*)(ws + WS_CTL) + CW_BAR + a.li * XCD_BAR_WORDS, MISC + 8);
    const int G0 = G, bx0 = bx, vcu0 = vcu; unsigned char* const ws0 = ws;
    for (int ph = a.ph_lo; ph < a.ph_hi; ++ph) {
        int G = G0, bx = bx0, vcu = vcu0; unsigned zo = 0u; asm volatile("" : "+s"(G), "+s"(bx), "+s"(vcu), "+s"(zo)); unsigned char* ws = ws0 + zo;
        const int l = (ph >= 1 && ph <= 12) ? (ph - 1) / 6 : 0;
        const int kind = (ph == 0) ? PH_PRO : (ph == PH_FIN ? PH_FIN : 1 + (ph - 1) % 6);
        if (kind == PH_PRO) {
            { pro::Inputs pin{a.in[0], a.in[1], a.in[4], a.in[5], a.in[8], a.in[9], a.in[10], a.in[11], a.in[12], a.in[13], a.in[14], a.in[15]}; pro::prologue(ws, pin, ldsl + RING_OFF, vcu, G); }
        } else if (kind == PH_IN) {
            pg8::Gemm g{(const bf16_t*)(ws + WS_XB), (const bf16_t*)(ws + WS_WIN + l * SZ_WIN), T, NIN, D}; pg8::StaticOrder S; S.init(T, NIN, G, bx);
            if (l) FILL_RSL((const float*)(ws + WS_ST2));
            pg8::FEpiIn E{ws, a.in[6] + l * 256, l, (const LAS float*)(ldsl + RSL_OFF)};
            pg8::gemm_phase<pg8::FEpiIn, pg8::StaticOrder, true, true>(ldsl + RING_OFF, g, S, E);
        } else if (kind == PH_ATT) {
            for (int i = 0; i < 2; ++i) { const int idx = vcu * 2 + i; if (idx >= 512) break; const int bh = idx >> 4, qb = idx & 15;
                att::attn_unit(bh >> 2, bh & 3, qb, (const bf16_t*)(ws + WS_Q), (const bf16_t*)(ws + WS_K), (const bf16_t*)(ws + WS_V), (bf16_t*)(ws + WS_OC), a.in[2] + l * 256, a.in[3] + l * 128, l, (char*)lds + RING_OFF); }
            for (int i = 0; i < 2; ++i) { const int it = vcu * 2 + i; if (it >= 512) break;
                                fft::stage1_item(it >> 6, it & 63, (const bf16_t*)(ws + WS_TAB), (bf16_t*)(ws + WS_XT), ldsl + RING_OFF); }

            if (vcu < 256) gla::gla_a_item(vcu >> 5, (vcu >> 3) & 3, vcu & 7, ws, ldsl + RING_OFF);
        } else if (kind == PH_MIXB) {
            if (vcu < 256) fft::stage2_item(vcu >> 5, vcu & 31, (const bf16_t*)(ws + WS_XT), (bf16_t*)(ws + WS_OC), ldsl + RING_OFF);
            if (vcu < 256) gla::gla_b_item(vcu >> 5, (vcu >> 3) & 3, vcu & 7, ws, a.in[7] + l * 64, (bf16_t*)(ws + WS_OC), ldsl + RING_OFF);
        } else if (kind == PH_OUT) {
            pg8::Gemm g{(const bf16_t*)(ws + WS_OC), (const bf16_t*)(ws + WS_WOUT + l * SZ_WOUT), T, D, D}; pg8::StaticOrder S; S.init(T, D, G, bx);
            if (l) FILL_RSL((const float*)(ws + WS_ST2));
            pg8::FEpiRes E{l ? (const LAS float*)(ldsl + RSL_OFF) : (const LAS float*)nullptr, a.in[14] + (l ? l - 1 : 0) * 1024, a.in[15] + (l ? l - 1 : 0) * 1024, (bf16_t*)(ws + WS_XB), (float*)(ws + WS_ST1)};
            pg8::gemm_phase<pg8::FEpiRes, pg8::StaticOrder, true, true>(ldsl + RING_OFF, g, S, E);
        } else if (kind == PH_GU) {
            pg8::Gemm g{(const bf16_t*)(ws + WS_XB), (const bf16_t*)(ws + WS_WGU + l * SZ_WGU), T, NGU, D}; pg8::StaticOrder S; S.init(T, NGU, G, bx);
            FILL_RSL((const float*)(ws + WS_ST1));
            pg8::FEpiGU E{(const LAS float*)(ldsl + RSL_OFF), (const float*)(ws + V_C1GU) + l * NGU, (const float*)(ws + V_C2GU) + l * NGU, (bf16_t*)(ws + WS_ACT)};
            pg8::gemm_phase<pg8::FEpiGU, pg8::StaticOrder, true, true>(ldsl + RING_OFF, g, S, E);
        } else if (kind == PH_DN) {
            pg8::Gemm g{(const bf16_t*)(ws + WS_ACT), (const bf16_t*)(ws + WS_WDN + l * SZ_WDN), T, D, FF}; pg8::StaticOrder S; S.init(T, D, G, bx);
            FILL_RSL((const float*)(ws + WS_ST1));
            pg8::FEpiRes E{(const LAS float*)(ldsl + RSL_OFF), a.in[9] + l * 1024, a.in[10] + l * 1024, (bf16_t*)(ws + WS_XB), (float*)(ws + WS_ST2)};
            pg8::gemm_phase<pg8::FEpiRes, pg8::StaticOrder, true, true>(ldsl + RING_OFF, g, S, E);
        } else if (kind == PH_FIN) {
            const float* g2 = a.in[14] + 1024; const float* b2v = a.in[15] + 1024; const float* ST2 = (const float*)(ws + WS_ST2); const bf16_t* XB = (const bf16_t*)(ws + WS_XB); float* Y2 = a.out;
            int tid_f = threadIdx.x; asm volatile("" : "+v"(tid_f)); const int lane = tid_f & 63, wave = __builtin_amdgcn_readfirstlane(tid_f >> 6);
            typedef float f32x4 __attribute__((ext_vector_type(4))); typedef unsigned u32x2 __attribute__((ext_vector_type(2)));
            f32x4 gg[4], bq[4];
#pragma unroll
            for (int j = 0; j < 4; ++j) { gg[j] = *((const f32x4*)g2 + lane + 64 * j); bq[j] = *((const f32x4*)b2v + lane + 64 * j); }
            for (int row = vcu * NWAVES + wave; row < T; row += G * NWAVES) { const RowStat rs = row_stat(ST2, row);
                const u32x2* xr = (const u32x2*)(XB + (size_t)row * 1024) + lane; f32x4* yr = (f32x4*)(Y2 + (size_t)row * 1024) + lane;
#pragma unroll
                for (int j = 0; j < 4; ++j) { const u32x2 w = xr[64 * j]; const f32x4 v = {__uint_as_float(w.x << 16), __uint_as_float(w.x & 0xffff0000u), __uint_as_float(w.y << 16), __uint_as_float(w.y & 0xffff0000u)};
                    yr[64 * j] = (v - rs.mu) * rs.rstd * gg[j] + bq[j]; } }
        }
        if (ph + 1 < a.ph_hi) xcd_barrier(bar);
    }
}

static void launch_frame(const MArgs& base, int lo, int hi, int grid, hipStream_t stream, int li = 0) {
    MArgs a = base; a.ph_lo = lo; a.ph_hi = hi; a.li = li;
    hipLaunchKernelGGL(mk_fwd, dim3(grid), dim3(NWAVES * 64), LDS_BYTES, stream, a);
}
extern "C" void kernel_launch(void* const* d_in, const int* in_sizes, int n_in, void* d_out, int out_size, void* d_ws, size_t ws_size, hipStream_t stream) {
    static int grid = 0;
    if (grid == 0) {
        if (n_in != 16 || in_sizes[0] != T * D || out_size != T * D || ws_size < WS_END) { fprintf(stderr, "kernel_launch: unexpected shapes (n_in %d, in0 %d, out %d, ws %zu)\n", n_in, n_in > 0 ? in_sizes[0] : -1, out_size, ws_size); grid = -1; return; }
        int dev = 0, cus = 0, per_cu = 0;
        if (hipGetDevice(&dev) != hipSuccess || hipDeviceGetAttribute(&cus, hipDeviceAttributeMultiprocessorCount, dev) != hipSuccess) { grid = -1; return; }
        if (hipFuncSetAttribute((const void*)mk_fwd, hipFuncAttributeMaxDynamicSharedMemorySize, LDS_BYTES) != hipSuccess) { fprintf(stderr, "kernel_launch: hipFuncSetAttribute failed\n"); grid = -1; return; }
        if (hipOccupancyMaxActiveBlocksPerMultiprocessor(&per_cu, (const void*)mk_fwd, NWAVES * 64, LDS_BYTES) != hipSuccess || per_cu < 1) { fprintf(stderr, "kernel_launch: occupancy query says %d workgroups per CU\n", per_cu); per_cu = 1; }
        (void)hipGetLastError();
        grid = cus;
        if (grid != 256) { fprintf(stderr, "kernel_launch: this kernel's work split is built for the 256 CUs of an MI355X, found %d; nothing launched\n", cus); grid = -1; return; }
    }
    if (grid < 0) return;
    const float* x = (const float*)d_in[0]; const float* w_in = (const float*)d_in[1]; const float* dlam = (const float*)d_in[2]; const float* dng = (const float*)d_in[3];
    const float* fw = (const float*)d_in[4]; const float* gw2 = (const float*)d_in[5]; const float* gb2 = (const float*)d_in[6]; const float* gng = (const float*)d_in[7];
    const float* w_out = (const float*)d_in[8]; const float* ln1g = (const float*)d_in[9]; const float* ln1b = (const float*)d_in[10];
    const float* wg = (const float*)d_in[11]; const float* wu = (const float*)d_in[12]; const float* wd = (const float*)d_in[13]; const float* ln2g = (const float*)d_in[14]; const float* ln2b = (const float*)d_in[15];
    char* ws = (char*)d_ws;
    float* ropec = (float*)(ws + V_ROPEC); float* ropes = (float*)(ws + V_ROPES); float* MF = (float*)(ws + V_MF);
    float* c1in = (float*)(ws + V_C1IN); float* c2in = (float*)(ws + V_C2IN); float* c1gu = (float*)(ws + V_C1GU); float* c2gu = (float*)(ws + V_C2GU);
    bf16_t* TAB = (bf16_t*)(ws + WS_TAB); bf16_t* XB = (bf16_t*)(ws + WS_XB);
    bf16_t* Q = (bf16_t*)(ws + WS_Q); bf16_t* K = (bf16_t*)(ws + WS_K); bf16_t* V = (bf16_t*)(ws + WS_V);
    bf16_t* GQK = (bf16_t*)(ws + WS_GQK); bf16_t* GV = (bf16_t*)(ws + WS_GV); bf16_t* GR = (bf16_t*)(ws + WS_GR); float* GL = (float*)(ws + WS_GL);
    bf16_t* OC = (bf16_t*)(ws + WS_OC); float* OF = (float*)(ws + WS_OF);
    (void)hipMemsetAsync(ws + WS_CTL, 0, CTL_ZERO_BYTES, stream);
    MArgs base{}; for (int i = 0; i < 16; ++i) base.in[i] = (const float*)d_in[i]; base.out = (float*)d_out; base.ws = (unsigned char*)d_ws;
    launch_frame(base, 0, N_PHASES, grid, stream, 0);
}
```

```cpp
#include <hip/hip_runtime.h>
#include <cstdint>
#include <cstdio>
#include <cmath>

typedef unsigned short bf16_t;
namespace cfg {
constexpr int B = 8, S = 2048, D = 1024, T = B * S, L = 2;
constexpr int INW = 2592, NIN = 3072, FF = 2816, NGU = 2 * FF;
constexpr float ALPHA = 1.41421356237309515f;
constexpr float EPS = 1e-5f;
constexpr float QSCALE = 0.125f * 1.4426950408889634f;
constexpr float GQSCALE = 0.17677669529663687f;
constexpr size_t MiB = 1u << 20;
constexpr size_t WS_CTL = 0;
constexpr size_t WS_VEC = 1 * MiB;
constexpr size_t V_ROPEC = WS_VEC, V_ROPES = WS_VEC + 256 * 1024, V_MF = WS_VEC + 512 * 1024;
constexpr size_t V_C1IN = WS_VEC + 768 * 1024, V_C2IN = V_C1IN + 24 * 1024, V_C1GU = V_C2IN + 24 * 1024, V_C2GU = V_C1GU + 44 * 1024;
constexpr size_t WS_WIN = 2 * MiB, WS_WOUT = 14 * MiB, WS_WGU = 18 * MiB, WS_WDN = 40 * MiB, WS_TAB = 51 * MiB;
constexpr size_t SZ_WIN = 6 * MiB, SZ_WOUT = 2 * MiB, SZ_WGU = 11 * MiB, SZ_WDN = 5632 * 1024;
constexpr size_t WS_XB = 67 * MiB;
constexpr size_t WS_Y1 = 99 * MiB, WS_Q = 99 * MiB, WS_K = 115 * MiB, WS_V = 131 * MiB, WS_XT = 147 * MiB;
constexpr size_t WS_ACT = 163 * MiB, WS_GQK = 163 * MiB, WS_GV = 171 * MiB, WS_GR = 179 * MiB, WS_GL = 187 * MiB, WS_OC = 203 * MiB, WS_OF = 235 * MiB;
constexpr size_t WS_ST1 = 251 * MiB, WS_ST2 = 253 * MiB, WS_DEC = 255 * MiB, WS_END = 256 * MiB;
}
using namespace cfg;

__device__ __forceinline__ float bf2f(bf16_t v) { return __uint_as_float((unsigned)v << 16); }
__device__ __forceinline__ bf16_t f2bf(float f) { unsigned u = __float_as_uint(f); return (bf16_t)((u + 0x7fffu + ((u >> 16) & 1u)) >> 16); }


template <int M> __device__ __forceinline__ float xadd(float v) {
    if constexpr (M == 32) { auto r = __builtin_amdgcn_permlane32_swap(__float_as_uint(v), __float_as_uint(v), false, false); return __uint_as_float(r[0]) + __uint_as_float(r[1]); }
    else return v + __int_as_float(__builtin_amdgcn_ds_swizzle(__float_as_int(v), (M << 10) | 0x1f));
}
struct RowStat { float mu, rstd; };
__device__ __forceinline__ RowStat row_stat(const float* ST, int row) {
    float s = 0.f, ss = 0.f;
    for (int i = 0; i < 8; ++i) { const float4 a = *(const float4*)(ST + (size_t)row * 32 + 4 * i); s += a.x + a.z; ss += a.y + a.w; }
    const float mu = s * (1.f / 1024.f); const float var = ss * (1.f / 1024.f) - mu * mu;
    RowStat r; r.mu = mu; r.rstd = rsqrtf(fmaxf(var, 0.f) + EPS); return r;
}
namespace pg8 {
#define PG8_LAS __attribute__((address_space(3)))
typedef unsigned short bf16_t;
typedef short bf16x8 __attribute__((ext_vector_type(8)));
typedef float f32x4 __attribute__((ext_vector_type(4)));
typedef unsigned u32x4 __attribute__((ext_vector_type(4)));
constexpr int BM = 256, BK = 64, HALF = 128, HTB = HALF * BK * 2  , STAGE_BYTES = 8 * HTB, NXCD = 8, WGM = 8;

__host__ __device__ __forceinline__ int lds_byte(int r, int c) { const int st = (r >> 4) * 2 + (c >> 5), rr = r & 15, cc = c & 31, ob = rr * 64 + cc * 2; return st * 1024 + (ob ^ (((ob >> 9) & 1) << 5)); }
__host__ __device__ __forceinline__ void stage_rc(int b, int& R, int& C) { const int st = b / 1024, sb = b % 1024, swz = sb ^ (((sb >> 9) & 1) << 5); R = (st >> 1) * 16 + swz / 64; C = (st & 1) * 32 + (swz % 64) / 2; }
__host__ __device__ __forceinline__ int perm32(int rho) { const int n = rho >> 4, i = rho & 15; return 8 * (i >> 2) + 4 * n + (i & 3); }

struct Unit { int pm, pn; };
struct Gemm { const bf16_t* A; const bf16_t* Bt; int M, N, K; };

struct StaticOrder {
    int nM, nN, nwg, G, c;
    __host__ __device__ void init(int M, int N, int G_, int c_) { nM = M / BM; nN = N / BM; nwg = nM * nN; G = G_; c = c_; }
    __host__ __device__ bool next(int i, Unit& u) const {
        const long L = (long)i * G + c; if (L >= nwg) return false;
        int wgid = (int)L; { const int q = nwg / NXCD, r = nwg % NXCD, xcd = wgid % NXCD, off = wgid / NXCD; wgid = (xcd < r ? xcd * (q + 1) : r * (q + 1) + (xcd - r) * q) + off; }
        const int nig = WGM * nN, gid = wgid / nig, fm = gid * WGM, gsz = (nM - fm) < WGM ? (nM - fm) : WGM;
        u.pm = fm + ((wgid % nig) % gsz); u.pn = (wgid % nig) / gsz; return true;
    }
    __device__ __forceinline__ void a_ready(const Unit&) const {}
    __device__ __forceinline__ void done(const Unit&) const {}
};
template <class Epi, class Sched, bool ALIGN_EPI = false, bool SP2 = false>
__device__ __forceinline__ void gemm_phase(PG8_LAS unsigned char* lds, const Gemm g, const Sched& S, const Epi& E) {
    int tid_o = threadIdx.x; asm volatile("" : "+v"(tid_o));
    const int tid = tid_o, wid = __builtin_amdgcn_readfirstlane(tid >> 6), lane = tid & 63, wr = wid >> 2, wc = wid & 3, fr = lane & 15, fq = lane >> 4;
    const int K = g.K, nt = K / BK;
    unsigned voffA[2], voffB[2];
#pragma unroll
    for (int i = 0; i < 2; ++i) { int R, C; stage_rc(tid * 16 + i * 8192, R, C); const int Rb = Epi::PERM ? ((R & ~31) + perm32(R & 31)) : R;
        voffA[i] = (unsigned)(R * K + C) * 2u; voffB[i] = (unsigned)(Rb * K + C) * 2u; }
    const size_t kstep = (size_t)(BK * 2);
    const size_t hstep = (size_t)HALF * K * 2;
    const size_t tstep = 2 * hstep;
    const unsigned ldsw = (unsigned)wid * 1024u;
    const int aoff = lds_byte(wr * 64 + fr, fq * 8), boff = lds_byte(wc * 32 + fr, fq * 8);
#define PG8_SA(b, h) (((b) * 2 + (h)) * HTB)
#define PG8_SB(b, h) ((4 + (b) * 2 + (h)) * HTB)
#define PG8_STAGE(bufoff, gbase, voff) do { _Pragma("unroll") for (int _i = 0; _i < 2; ++_i) \
        __builtin_amdgcn_global_load_lds((const unsigned*)((const char*)(gbase) + (voff)[_i]), (PG8_LAS unsigned*)(lds + (bufoff) + ldsw + _i * 8192), 16, 0, 0); } while (0)
#define PG8_LDA(dst, b, h) do { _Pragma("unroll") for (int m = 0; m < 4; ++m) _Pragma("unroll") for (int k = 0; k < 2; ++k) dst[m][k] = *(const PG8_LAS bf16x8*)(lds + PG8_SA(b, h) + aoff + m * 2048 + k * 1024); } while (0)
#define PG8_LDB(dst, b, h) do { _Pragma("unroll") for (int n = 0; n < 2; ++n) _Pragma("unroll") for (int k = 0; k < 2; ++k) dst[n][k] = *(const PG8_LAS bf16x8*)(lds + PG8_SB(b, h) + boff + n * 2048 + k * 1024); } while (0)
#define PG8_MMA(ai, bj, At, Bt) do { __builtin_amdgcn_s_setprio(1); _Pragma("unroll") for (int m = 0; m < 4; ++m) _Pragma("unroll") for (int n = 0; n < 2; ++n) _Pragma("unroll") for (int k = 0; k < 2; ++k) \
        acc[ai][bj][m][n] = __builtin_amdgcn_mfma_f32_16x16x32_bf16(Bt[n][k], At[m][k], acc[ai][bj][m][n], 0, 0, 0); __builtin_amdgcn_s_setprio(0); } while (0)
#define PG8_WAIT_V(n) asm volatile("s_waitcnt vmcnt(" #n ")" ::: "memory")
#define PG8_WAIT_L(n) asm volatile("s_waitcnt lgkmcnt(" #n ")" ::: "memory")
#define PG8_BAR __builtin_amdgcn_s_barrier()
#define PG8_SCHED __builtin_amdgcn_sched_barrier(0)
    Unit cur, nxt; int ui = 0;
    if (!S.next(0, cur)) return;
    f32x4 acc[2][2][4][2];
#pragma unroll
    for (int a = 0; a < 2; ++a)
#pragma unroll
        for (int b = 0; b < 2; ++b)
#pragma unroll
            for (int m = 0; m < 4; ++m)
#pragma unroll
                for (int n = 0; n < 2; ++n) acc[a][b][m][n] = (f32x4){0.f, 0.f, 0.f, 0.f};
    bf16x8 At[4][2], B0[2][2], B1[2][2];
    const char* cA = (const char*)g.A + (size_t)cur.pm * tstep; const char* cB = (const char*)g.Bt + (size_t)cur.pn * tstep;
    S.a_ready(cur);
    if constexpr (SP2) {
        PG8_STAGE(PG8_SB(0, 0), cB, voffB); PG8_STAGE(PG8_SB(0, 1), cB + hstep, voffB); PG8_STAGE(PG8_SA(0, 0), cA, voffA); PG8_STAGE(PG8_SA(0, 1), cA + hstep, voffA);
        if (wr == 1) PG8_BAR;
        PG8_WAIT_V(2); PG8_BAR;
        PG8_STAGE(PG8_SB(1, 0), cB + kstep, voffB); PG8_STAGE(PG8_SA(1, 0), cA + kstep, voffA); PG8_STAGE(PG8_SB(1, 1), cB + hstep + kstep, voffB);
        PG8_WAIT_V(6); PG8_BAR;
    } else {
        PG8_STAGE(PG8_SB(0, 0), cB, voffB); PG8_STAGE(PG8_SA(0, 0), cA, voffA); PG8_STAGE(PG8_SB(0, 1), cB + hstep, voffB); PG8_STAGE(PG8_SA(0, 1), cA + hstep, voffA);
        if (wr == 1) PG8_BAR;
        PG8_WAIT_V(4); PG8_BAR;
        PG8_STAGE(PG8_SB(1, 0), cB + kstep, voffB); PG8_STAGE(PG8_SA(1, 0), cA + kstep, voffA); PG8_STAGE(PG8_SB(1, 1), cB + hstep + kstep, voffB);
        PG8_WAIT_V(6); PG8_BAR;
    }
    for (;;) {
        const bool has_next = S.next(ui + 1, nxt);
        const char* nA = has_next ? (const char*)g.A + (size_t)nxt.pm * tstep : cA; const char* nB = has_next ? (const char*)g.Bt + (size_t)nxt.pn * tstep : cB;
        for (int t = 0; t < nt; t += 2) {
            const bool last = (t == nt - 2);
            const char* a1 = cA + (size_t)(t + 1) * kstep;
            const char* a2 = last ? nA : cA + (size_t)(t + 2) * kstep; const char* b2 = last ? nB : cB + (size_t)(t + 2) * kstep;
            const char* a3 = a2 + kstep; const char* b3 = b2 + kstep;
            if (last && has_next) S.a_ready(nxt);
            if constexpr (SP2) {
            PG8_LDB(B0, 0, 0); PG8_LDB(B1, 0, 1); PG8_SCHED; PG8_LDA(At, 0, 0); PG8_STAGE(PG8_SA(1, 1), a1 + hstep, voffA);
            PG8_WAIT_V(8); PG8_WAIT_L(0); PG8_BAR; PG8_MMA(0, 0, At, B0); PG8_MMA(0, 1, At, B1); PG8_BAR; PG8_SCHED;
            PG8_LDA(At, 0, 1); PG8_STAGE(PG8_SB(0, 0), b2, voffB); PG8_STAGE(PG8_SB(0, 1), b2 + hstep, voffB); PG8_STAGE(PG8_SA(0, 0), a2, voffA);
            PG8_WAIT_V(8); PG8_WAIT_L(0); PG8_BAR; PG8_MMA(1, 0, At, B0); PG8_MMA(1, 1, At, B1); PG8_BAR; PG8_SCHED;
            PG8_LDB(B0, 1, 0); PG8_LDB(B1, 1, 1); PG8_SCHED; PG8_LDA(At, 1, 0); PG8_STAGE(PG8_SA(0, 1), a2 + hstep, voffA);
            PG8_WAIT_V(8); PG8_WAIT_L(0); PG8_BAR; PG8_MMA(0, 0, At, B0); PG8_MMA(0, 1, At, B1); PG8_BAR; PG8_SCHED;
            PG8_LDA(At, 1, 1); PG8_STAGE(PG8_SB(1, 0), b3, voffB); PG8_STAGE(PG8_SB(1, 1), b3 + hstep, voffB); PG8_STAGE(PG8_SA(1, 0), a3, voffA);
            PG8_WAIT_V(8); PG8_WAIT_L(0); PG8_BAR; PG8_MMA(1, 0, At, B0); PG8_MMA(1, 1, At, B1); PG8_BAR; PG8_SCHED;
            } else {
            PG8_LDB(B0, 0, 0); PG8_SCHED; PG8_LDA(At, 0, 0); PG8_STAGE(PG8_SA(1, 1), a1 + hstep, voffA);
            PG8_WAIT_L(8); PG8_BAR; PG8_WAIT_L(0); PG8_MMA(0, 0, At, B0); PG8_BAR; PG8_SCHED;
            PG8_LDB(B1, 0, 1); PG8_STAGE(PG8_SB(0, 0), b2, voffB);
            PG8_BAR; PG8_WAIT_L(0); PG8_MMA(0, 1, At, B1); PG8_BAR;
            PG8_LDA(At, 0, 1); PG8_STAGE(PG8_SA(0, 0), a2, voffA);
            PG8_BAR; PG8_WAIT_L(0); PG8_MMA(1, 0, At, B0); PG8_BAR; PG8_SCHED;
            PG8_STAGE(PG8_SB(0, 1), b2 + hstep, voffB);
            PG8_WAIT_V(6); PG8_BAR; PG8_MMA(1, 1, At, B1); PG8_BAR;
            PG8_LDB(B0, 1, 0); PG8_SCHED; PG8_LDA(At, 1, 0); PG8_STAGE(PG8_SA(0, 1), a2 + hstep, voffA);
            PG8_WAIT_L(8); PG8_BAR; PG8_WAIT_L(0); PG8_MMA(0, 0, At, B0); PG8_BAR; PG8_SCHED;
            PG8_LDB(B1, 1, 1); PG8_STAGE(PG8_SB(1, 0), b3, voffB);
            PG8_BAR; PG8_WAIT_L(0); PG8_MMA(0, 1, At, B1); PG8_BAR;
            PG8_LDA(At, 1, 1); PG8_STAGE(PG8_SA(1, 0), a3, voffA);
            PG8_BAR; PG8_WAIT_L(0); PG8_MMA(1, 0, At, B0); PG8_BAR; PG8_SCHED;
            PG8_STAGE(PG8_SB(1, 1), b3 + hstep, voffB);
            PG8_WAIT_V(6); PG8_BAR; PG8_MMA(1, 1, At, B1); PG8_BAR;
            }
        }
        if constexpr (ALIGN_EPI) { if (wr == 0) PG8_BAR; }
        if constexpr (!Epi::AFTER_DRAIN) { E(acc, cur, wr, wc, fr, fq); S.done(cur); }
        if (!has_next) break;
#pragma unroll
        for (int a = 0; a < 2; ++a)
#pragma unroll
            for (int b = 0; b < 2; ++b)
#pragma unroll
                for (int m = 0; m < 4; ++m)
#pragma unroll
                    for (int n = 0; n < 2; ++n) acc[a][b][m][n] = (f32x4){0.f, 0.f, 0.f, 0.f};
        cur = nxt; cA = nA; cB = nB; ++ui;
        if constexpr (ALIGN_EPI) { if (wr == 1) PG8_BAR; }
    }
    PG8_WAIT_V(0);
    if constexpr (!ALIGN_EPI) { if (wr == 0) PG8_BAR; }
    PG8_BAR;
    if constexpr (Epi::AFTER_DRAIN) { E.fused(acc, cur, wr, wc, fr, fq, lds, wid, lane); S.done(cur); }
#undef PG8_SA
#undef PG8_SB
#undef PG8_STAGE
#undef PG8_LDA
#undef PG8_LDB
#undef PG8_MMA
#undef PG8_WAIT_V
#undef PG8_WAIT_L
#undef PG8_BAR
#undef PG8_SCHED
}
}
namespace pg8 {
__device__ __forceinline__ unsigned cvt_pk_bf16(float lo, float hi) { unsigned r; asm volatile("v_cvt_pk_bf16_f32 %0, %1, %2" : "=v"(r) : "v"(lo), "v"(hi)); return r; }
__device__ __forceinline__ void st8(bf16_t* p, const f32x4 a, const f32x4 b) { u32x4 w; w.x = cvt_pk_bf16(a[0], a[1]); w.y = cvt_pk_bf16(a[2], a[3]); w.z = cvt_pk_bf16(b[0], b[1]); w.w = cvt_pk_bf16(b[2], b[3]); *(u32x4*)p = w; }
__device__ __forceinline__ void st8nt(bf16_t* p, const f32x4 a, const f32x4 b) { u32x4 w; w.x = cvt_pk_bf16(a[0], a[1]); w.y = cvt_pk_bf16(a[2], a[3]); w.z = cvt_pk_bf16(b[0], b[1]); w.w = cvt_pk_bf16(b[2], b[3]); __builtin_nontemporal_store(w, (u32x4*)p); }
struct RS { float a, b; };
struct StatLd { f32x4 x, y; };
__device__ __forceinline__ StatLd stat_load(const float* ST, int row, int fq) { const f32x4* p = (const f32x4*)(ST + (size_t)row * 32 + fq * 8); StatLd r; r.x = p[0]; r.y = p[1]; return r; }
__device__ __forceinline__ RS stat_fin(const StatLd& t) {
    float s = (t.x[0] + t.x[2]) + (t.y[0] + t.y[2]), ss = (t.x[1] + t.x[3]) + (t.y[1] + t.y[3]);
    s = xadd<16>(s); ss = xadd<16>(ss); s = xadd<32>(s); ss = xadd<32>(ss);
    const float mu = s * (1.f / 1024.f), var = ss * (1.f / 1024.f) - mu * mu, rstd = rsqrtf(fmaxf(var, 0.f) + cfg::EPS);
    RS r; r.a = rstd; r.b = -rstd * mu; return r;
}
__device__ __forceinline__ RS row_stat16(const float* ST, int row, int fq) { return stat_fin(stat_load(ST, row, fq)); }
__device__ __forceinline__ float fsilu(float x) { return x * __builtin_amdgcn_rcpf(1.f + __expf(-x)); }
__device__ __forceinline__ float flogsig16(float x) { return (fminf(x, 0.f) - __logf(1.f + __expf(-fabsf(x)))) * (1.f / 16.f); }

struct FEpiIn {
    static constexpr bool PERM = true, AFTER_DRAIN = false;
    unsigned char* ws; const float* b2; int l; const PG8_LAS float* rsl;
    struct RowLd { f32x4 rc[2], rsn[2]; };
    template <int KIND> __device__ __forceinline__ RowLd load_row(int row, const float (&invf)[8]) const {
        RowLd r;
        if constexpr (KIND == 0) { const float pos = (float)(row & 2047);
#pragma unroll
            for (int e = 0; e < 8; ++e) { const float ang = pos * invf[e]; double rv = (double)ang * 0.15915494309189535; rv -= floor(rv); const float rev = (float)rv;
                r.rc[e >> 2][e & 3] = __builtin_amdgcn_cosf(rev); r.rsn[e >> 2][e & 3] = __builtin_amdgcn_sinf(rev); } }
        return r;
    }
    template <int KIND> __device__ __forceinline__ void rows(const f32x4 (&acc)[2][2][4][2], const Unit& u, int wr, int wc, int fr, int fq) const {
        const int pn = u.pn, cw = 32 * wc + 8 * fq, row0 = u.pm * BM + 64 * wr + fr;
        const bool st = l != 0;
        f32x4 k1[2][2], k2[2][2], bias[2][2];
        const float qs = __uint_as_float(__builtin_amdgcn_readfirstlane(__float_as_uint(pn < 2 ? cfg::QSCALE : 1.f)));
        float invf[8];
        if constexpr (KIND == 0) {
#pragma unroll
            for (int e = 0; e < 8; ++e) invf[e] = exp2f(-(float)(8 * fq + e) * (13.287712379549449f / 32.f)); }
        RowLd cur = load_row<KIND>(row0, invf), nxt;
        if (st) {
#pragma unroll
            for (int bj = 0; bj < 2; ++bj)
#pragma unroll
                for (int n = 0; n < 2; ++n) {
                    if constexpr (KIND == 2) {
                        const float* fp = (const float*)(ws + cfg::V_MF) + (size_t)(l * 8) * 512 + (pn - 6) * 256 + cw + 128 * bj + 4 * n;
                        k1[bj][n] = (*(const f32x4*)fp + *(const f32x4*)(fp + 1024)) + (*(const f32x4*)(fp + 2048) + *(const f32x4*)(fp + 3072));
                        k2[bj][n] = (*(const f32x4*)(fp + 512) + *(const f32x4*)(fp + 1536)) + (*(const f32x4*)(fp + 2560) + *(const f32x4*)(fp + 3584));
                    } else { const float* c1 = (const float*)(ws + cfg::V_C1IN) + l * cfg::NIN + pn * 256 + cw; const float* c2 = (const float*)(ws + cfg::V_C2IN) + l * cfg::NIN + pn * 256 + cw;
                        k1[bj][n] = *(const f32x4*)(c1 + 128 * bj + 4 * n); k2[bj][n] = *(const f32x4*)(c2 + 128 * bj + 4 * n); } } }
        if constexpr (KIND == 6) {
#pragma unroll
            for (int bj = 0; bj < 2; ++bj)
#pragma unroll
                for (int n = 0; n < 2; ++n) bias[bj][n] = *(const f32x4*)(b2 + 128 * bj + cw + 4 * n); }
#pragma unroll
        for (int i = 0; i < 8; ++i) {
            const int ai = i >> 2, m = i & 3, row = row0 + 128 * ai + 16 * m, pos = row & 2047;
            if (i < 7) nxt = load_row<KIND>(row0 + 128 * ((i + 1) >> 2) + 16 * ((i + 1) & 3), invf);
            f32x4 v[2][2];
            if (st) { typedef float f32x2 __attribute__((ext_vector_type(2))); const f32x2 t2 = *(const PG8_LAS f32x2*)(rsl + 2 * (128 * ai + 64 * wr + 16 * m + fr)); RS rs; rs.a = t2[0]; rs.b = t2[1];
#pragma unroll
                for (int bj = 0; bj < 2; ++bj)
#pragma unroll
                    for (int n = 0; n < 2; ++n) v[bj][n] = rs.a * acc[ai][bj][m][n] + (rs.b * k1[bj][n] + k2[bj][n]);
            } else {
#pragma unroll
                for (int bj = 0; bj < 2; ++bj)
#pragma unroll
                    for (int n = 0; n < 2; ++n) v[bj][n] = acc[ai][bj][m][n]; }
            if constexpr (KIND == 0) {
                f32x4 a0 = v[0][0] * cur.rc[0] - v[1][0] * cur.rsn[0], a1 = v[0][1] * cur.rc[1] - v[1][1] * cur.rsn[1];
                f32x4 b0 = v[1][0] * cur.rc[0] + v[0][0] * cur.rsn[0], b1 = v[1][1] * cur.rc[1] + v[0][1] * cur.rsn[1];
                a0 = a0 * qs; a1 = a1 * qs; b0 = b0 * qs; b1 = b1 * qs;
                bf16_t* dst = (bf16_t*)(ws + (pn < 2 ? cfg::WS_Q : cfg::WS_K)) + (size_t)row * 512 + (4 * (pn & 1) + wc) * 64 + 8 * fq;
                st8(dst, a0, a1); st8(dst + 32, b0, b1);
            } else if constexpr (KIND == 1) {
                bf16_t* dst = (bf16_t*)(ws + cfg::WS_V) + (size_t)row * 512 + (pn - 4) * 256 + cw; st8(dst, v[0][0], v[0][1]); st8(dst + 128, v[1][0], v[1][1]);
            } else if constexpr (KIND == 2) {
                bf16_t* dst = (bf16_t*)(ws + cfg::WS_TAB) + (size_t)row * 512 + (pn - 6) * 256 + cw; st8(dst, v[0][0], v[0][1]); st8(dst + 128, v[1][0], v[1][1]);
            } else if constexpr (KIND == 3) {
                bf16_t* dst = (bf16_t*)(ws + cfg::WS_GQK) + (size_t)row * 256 + cw; st8(dst, v[0][0] * cfg::GQSCALE, v[0][1] * cfg::GQSCALE); st8(dst + 128, v[1][0], v[1][1]);
            } else if constexpr (KIND == 4) {
                bf16_t* dst = (bf16_t*)(ws + cfg::WS_GV) + (size_t)row * 256 + cw; st8(dst, v[0][0], v[0][1]); st8(dst + 128, v[1][0], v[1][1]);
            } else if constexpr (KIND == 5) {
                bf16_t* dst = (bf16_t*)(ws + cfg::WS_GR) + (size_t)row * 256 + cw;
#pragma unroll
                for (int bj = 0; bj < 2; ++bj) { f32x4 x0 = v[bj][0], x1 = v[bj][1];
#pragma unroll
                    for (int e = 0; e < 4; ++e) { x0[e] = fsilu(x0[e]); x1[e] = fsilu(x1[e]); } st8(dst + 128 * bj, x0, x1); }
            } else {
                float* dst = (float*)(ws + cfg::WS_GL) + (size_t)row * 256 + cw;
#pragma unroll
                for (int bj = 0; bj < 2; ++bj)
#pragma unroll
                    for (int n = 0; n < 2; ++n) { f32x4 x = v[bj][n] + bias[bj][n];
#pragma unroll
                        for (int e = 0; e < 4; ++e) x[e] = flogsig16(x[e]); *(f32x4*)(dst + 128 * bj + 4 * n) = x; }
            }
            if (i < 7) cur = nxt;
        }
    }
    __device__ __forceinline__ void operator()(const f32x4 (&acc)[2][2][4][2], const Unit& u, int wr, int wc, int fr, int fq) const {
        asm volatile("" : "+v"(fr), "+v"(fq));
        unsigned zo = 0u; asm volatile("" : "+s"(zo)); FEpiIn me = *this; me.ws = ws + zo;
        const int pn = u.pn;
        if (pn < 4) me.rows<0>(acc, u, wr, wc, fr, fq); else if (pn < 6) me.rows<1>(acc, u, wr, wc, fr, fq); else if (pn < 8) me.rows<2>(acc, u, wr, wc, fr, fq);
        else if (pn == 8) me.rows<3>(acc, u, wr, wc, fr, fq); else if (pn == 9) me.rows<4>(acc, u, wr, wc, fr, fq); else if (pn == 10) me.rows<5>(acc, u, wr, wc, fr, fq); else me.rows<6>(acc, u, wr, wc, fr, fq);
    }
};
struct FEpiRes {
    static constexpr bool PERM = true, AFTER_DRAIN = false;
    const PG8_LAS float* stprev;
    const float* g; const float* bb; bf16_t* XB; float* ST;
    struct RowLd { u32x4 xb[2]; };
    __device__ __forceinline__ RowLd load_row(int row, int col0, int fq) const {
        RowLd r; const size_t off = (size_t)row * 1024 + col0;
        r.xb[0] = *(const u32x4*)(XB + off); r.xb[1] = *(const u32x4*)(XB + off + 128);
        return r;
    }
    __device__ __forceinline__ void operator()(const f32x4 (&acc)[2][2][4][2], const Unit& u, int wr, int wc, int fr, int fq) const {
        asm volatile("" : "+v"(fr), "+v"(fq));
        const int col0 = u.pn * BM + 32 * wc + 8 * fq, row0 = u.pm * BM + 64 * wr + fr;
        f32x4 gv[2][2], bv[2][2];
        RowLd cur = load_row(row0, col0, fq), nxt;
        if (stprev) {
#pragma unroll
            for (int bj = 0; bj < 2; ++bj)
#pragma unroll
                for (int n = 0; n < 2; ++n) { gv[bj][n] = *(const f32x4*)(g + col0 + 128 * bj + 4 * n); bv[bj][n] = *(const f32x4*)(bb + col0 + 128 * bj + 4 * n); } }
#pragma unroll
        for (int i = 0; i < 8; ++i) { const int ai = i >> 2, m = i & 3, row = row0 + 128 * ai + 16 * m; const size_t off = (size_t)row * 1024 + col0;
            if (i < 7) nxt = load_row(row0 + 128 * ((i + 1) >> 2) + 16 * ((i + 1) & 3), col0, fq);
            RS rs; rs.a = 1.f; rs.b = 0.f; if (stprev) { typedef float f32x2 __attribute__((ext_vector_type(2))); const f32x2 t2 = *(const PG8_LAS f32x2*)(stprev + 2 * (128 * ai + 64 * wr + 16 * m + fr)); rs.a = t2[0]; rs.b = t2[1]; }
            float s = 0.f, ss = 0.f;
#pragma unroll
            for (int bj = 0; bj < 2; ++bj) { f32x4 y[2];
#pragma unroll
                for (int n = 0; n < 2; ++n) { const unsigned w0 = cur.xb[bj][2 * n], w1 = cur.xb[bj][2 * n + 1];
                    f32x4 x = (f32x4){__uint_as_float(w0 << 16), __uint_as_float(w0 & 0xffff0000u), __uint_as_float(w1 << 16), __uint_as_float(w1 & 0xffff0000u)};
                    if (stprev) x = (rs.a * x + rs.b) * gv[bj][n] + bv[bj][n];
                    y[n] = cfg::ALPHA * x + acc[ai][bj][m][n];
                    s += (y[n][0] + y[n][1]) + (y[n][2] + y[n][3]); ss += (y[n][0] * y[n][0] + y[n][1] * y[n][1]) + (y[n][2] * y[n][2] + y[n][3] * y[n][3]); }
                st8nt(XB + off + 128 * bj, y[0], y[1]); }
            s = xadd<16>(s); ss = xadd<16>(ss); s = xadd<32>(s); ss = xadd<32>(ss);
            if (fq == 0) { typedef float f32x2 __attribute__((ext_vector_type(2))); *(f32x2*)(ST + (size_t)row * 32 + (u.pn * 4 + wc) * 2) = (f32x2){s, ss}; }
            if (i < 7) cur = nxt; }
    }
};
struct FEpiGU {
    static constexpr bool PERM = true, AFTER_DRAIN = false;
    const PG8_LAS float* rsl;
    const float* c1; const float* c2; bf16_t* ACT;
    __device__ __forceinline__ void operator()(const f32x4 (&acc)[2][2][4][2], const Unit& u, int wr, int wc, int fr, int fq) const {
        asm volatile("" : "+v"(fr), "+v"(fq));
        const int cw = 32 * wc + 8 * fq, row0 = u.pm * BM + 64 * wr + fr; const float* c1p = c1 + u.pn * 256 + cw; const float* c2p = c2 + u.pn * 256 + cw;
        typedef float f32x2 __attribute__((ext_vector_type(2)));
        f32x4 k1[2][2], k2[2][2];
#pragma unroll
        for (int bj = 0; bj < 2; ++bj)
#pragma unroll
            for (int n = 0; n < 2; ++n) { k1[bj][n] = *(const f32x4*)(c1p + 128 * bj + 4 * n); k2[bj][n] = *(const f32x4*)(c2p + 128 * bj + 4 * n); }
#pragma unroll
        for (int i = 0; i < 8; ++i) { const int ai = i >> 2, m = i & 3; const f32x2 rs = *(const PG8_LAS f32x2*)(rsl + 2 * (128 * ai + 64 * wr + 16 * m + fr)); f32x4 a[2];
#pragma unroll
            for (int n = 0; n < 2; ++n) { const f32x4 hg = rs[0] * acc[ai][0][m][n] + (rs[1] * k1[0][n] + k2[0][n]), hu = rs[0] * acc[ai][1][m][n] + (rs[1] * k1[1][n] + k2[1][n]);
#pragma unroll
                for (int e = 0; e < 4; ++e) a[n][e] = fsilu(hg[e]) * hu[e]; }
            st8nt(ACT + (size_t)(row0 + 128 * ai + 16 * m) * cfg::FF + 128 * u.pn + cw, a[0], a[1]); }
    }
};
struct FEpiFour {
    static constexpr bool PERM = true, AFTER_DRAIN = false;
    bf16_t* OC;
    __device__ __forceinline__ void operator()(const f32x4 (&acc)[2][2][4][2], const Unit& u, int wr, int wc, int fr, int fq) const {
        asm volatile("" : "+v"(fr), "+v"(fq));
        const int cw = 32 * wc + 8 * fq;
#pragma unroll
        for (int ai = 0; ai < 2; ++ai)
#pragma unroll
            for (int m = 0; m < 4; ++m) { const int row = u.pm * BM + 128 * ai + 64 * wr + 16 * m + fr; bf16_t* dst = OC + (size_t)(u.pn * 2048 + row) * 1024 + 512 + cw;
                st8(dst, acc[ai][0][m][0], acc[ai][0][m][1]); st8(dst + 128, acc[ai][1][m][0], acc[ai][1][m][1]); }
    }
};
}
namespace att {
using bf16x8 = __attribute__((ext_vector_type(8))) short;
using s16x4  = __attribute__((ext_vector_type(4))) short;
using f32x16 = __attribute__((ext_vector_type(16))) float;
using u32x4  = __attribute__((ext_vector_type(4))) unsigned;
constexpr int NW = 8, QBLK = 32, KVBLK = 64, LD = 512, NT = cfg::S / KVBLK;
constexpr int SHM_V = KVBLK * 128 * 2, SHM_K = KVBLK * 128 * 2, SHM_X = 2 * SHM_V + 2 * SHM_K, SHM_ATTN = SHM_X + NW * 64 * 4;
constexpr float THRL = 6.0f;
#define ATT_KSWZ(row, colB) ((row) * 256 + ((colB) ^ (((row) & 7) << 4)))
#define ATT_SBAR() __builtin_amdgcn_sched_barrier(0)
__device__ __forceinline__ int crow(int r, int hi) { return (r & 3) + 8 * (r >> 2) + 4 * hi; }
__device__ __forceinline__ unsigned cvtpk(float lo, float hi) { unsigned r; asm volatile("v_cvt_pk_bf16_f32 %0, %1, %2" : "=v"(r) : "v"(lo), "v"(hi)); return r; }
__device__ __forceinline__ void softmaxP(f32x16& p0, f32x16& p1, float& m_reg, f32x16& negm, float& alpha, bool first, bf16x8& pa0, bf16x8& pa1, bf16x8& pa2, bf16x8& pa3) {
#define ATT_M3(a, b, c) fmaxf(fmaxf(a, b), c)
  const float t0 = ATT_M3(p0[0], p0[1], p0[2]), t1 = ATT_M3(p0[3], p0[4], p0[5]), t2 = ATT_M3(p0[6], p0[7], p0[8]), t3 = ATT_M3(p0[9], p0[10], p0[11]), t4 = ATT_M3(p0[12], p0[13], p0[14]);
  const float t5 = ATT_M3(p0[15], p1[0], p1[1]), t6 = ATT_M3(p1[2], p1[3], p1[4]), t7 = ATT_M3(p1[5], p1[6], p1[7]), t8 = ATT_M3(p1[8], p1[9], p1[10]), t9 = ATT_M3(p1[11], p1[12], p1[13]);
  const float u0 = ATT_M3(t0, t1, t2), u1 = ATT_M3(t3, t4, t5), u2 = ATT_M3(t6, t7, t8), u3 = ATT_M3(t9, p1[14], p1[15]);
  float pmax = fmaxf(fmaxf(u0, u1), fmaxf(u2, u3));
#undef ATT_M3
  { auto rr = __builtin_amdgcn_permlane32_swap(__float_as_uint(pmax), __float_as_uint(pmax), false, false); pmax = fmaxf(__uint_as_float(rr[0]), __uint_as_float(rr[1])); }
  const float thr = first ? -3.0e38f : THRL;
  if (__builtin_expect(__all(pmax <= thr), 1)) { alpha = 1.f; }
  else { const float dl = first ? pmax : fmaxf(pmax, 0.f); alpha = first ? 0.f : __builtin_amdgcn_exp2f(-dl); m_reg += dl;
#pragma unroll
    for (int r = 0; r < 16; ++r) { p0[r] -= dl; p1[r] -= dl; negm[r] -= dl; } }
#pragma unroll
  for (int r = 0; r < 16; ++r) p0[r] = __builtin_amdgcn_exp2f(p0[r]);
#pragma unroll
  for (int r = 0; r < 16; ++r) p1[r] = __builtin_amdgcn_exp2f(p1[r]);
#define ATT_PK4(P, BASE, OUT) do { u32x4 w = {cvtpk(P[BASE + 0], P[BASE + 1]), cvtpk(P[BASE + 2], P[BASE + 3]), cvtpk(P[BASE + 4], P[BASE + 5]), cvtpk(P[BASE + 6], P[BASE + 7])}; \
    OUT = *reinterpret_cast<bf16x8*>(&w); } while (0)
  ATT_PK4(p0, 0, pa0); ATT_PK4(p0, 8, pa1); ATT_PK4(p1, 0, pa2); ATT_PK4(p1, 8, pa3);
#undef ATT_PK4
}
template <int OFF> __device__ __forceinline__ bf16x8 k_read(int ka) { bf16x8 r; asm volatile("ds_read_b128 %0, %1 offset:%2" : "=&v"(r) : "v"(ka), "i"(OFF) : "memory"); return r; }
template <int KB> __device__ __forceinline__ void k_load2(bf16x8* kf, int ka0, int ka1) {
  kf[0] = k_read<KB * SHM_K>(ka0); kf[1] = k_read<KB * SHM_K + 8192>(ka0); kf[2] = k_read<KB * SHM_K>(ka1); kf[3] = k_read<KB * SHM_K + 8192>(ka1);
}
__device__ __forceinline__ void qk_mma2(f32x16& p0, f32x16& p1, const bf16x8* kf, bf16x8 q0, bf16x8 q1) {
  p0 = __builtin_amdgcn_mfma_f32_32x32x16_bf16(kf[0], q0, p0, 0, 0, 0); p1 = __builtin_amdgcn_mfma_f32_32x32x16_bf16(kf[1], q0, p1, 0, 0, 0);
  p0 = __builtin_amdgcn_mfma_f32_32x32x16_bf16(kf[2], q1, p0, 0, 0, 0); p1 = __builtin_amdgcn_mfma_f32_32x32x16_bf16(kf[3], q1, p1, 0, 0, 0);
}
__device__ __forceinline__ int v_st(int k, int c) { return ((k >> 3) * 4 + (c >> 5)) * 512 + ((k & 7) * 32 + (c & 31)) * 2; }
__device__ __forceinline__ int v_rd_base(int lane) { return ((lane & 3) << 3) | (((lane >> 2) & 3) << 6) | (((lane >> 4) & 1) << 5) | (((lane >> 5) & 1) << 8); }
constexpr int v_rd_off(int d0, int ks, int half) { return d0 * 512 + ks * 4096 + half * 2048; }
template <int OFF> __device__ __forceinline__ s16x4 tr_read(int vb) { s16x4 r; asm volatile("ds_read_b64_tr_b16 %0, %1 offset:%2" : "=&v"(r) : "v"(vb), "i"(OFF) : "memory"); return r; }
struct VF { s16x4 l[4], h[4]; };
template <int KS> __device__ __forceinline__ void vf_load(VF& f, int vb) {
  f.l[0] = tr_read<v_rd_off(0, KS, 0)>(vb); f.h[0] = tr_read<v_rd_off(0, KS, 1)>(vb); f.l[1] = tr_read<v_rd_off(1, KS, 0)>(vb); f.h[1] = tr_read<v_rd_off(1, KS, 1)>(vb);
  f.l[2] = tr_read<v_rd_off(2, KS, 0)>(vb); f.h[2] = tr_read<v_rd_off(2, KS, 1)>(vb); f.l[3] = tr_read<v_rd_off(3, KS, 0)>(vb); f.h[3] = tr_read<v_rd_off(3, KS, 1)>(vb);
}
__device__ __forceinline__ void pv_step(f32x16* o, bf16x8 pa, const VF& f) {
#define ATT_PK(L, H) (bf16x8){L[0], L[1], L[2], L[3], H[0], H[1], H[2], H[3]}
  o[0] = __builtin_amdgcn_mfma_f32_32x32x16_bf16(pa, ATT_PK(f.l[0], f.h[0]), o[0], 0, 0, 0);
  o[1] = __builtin_amdgcn_mfma_f32_32x32x16_bf16(pa, ATT_PK(f.l[1], f.h[1]), o[1], 0, 0, 0);
  o[2] = __builtin_amdgcn_mfma_f32_32x32x16_bf16(pa, ATT_PK(f.l[2], f.h[2]), o[2], 0, 0, 0);
  o[3] = __builtin_amdgcn_mfma_f32_32x32x16_bf16(pa, ATT_PK(f.l[3], f.h[3]), o[3], 0, 0, 0);
#undef ATT_PK
}
#define ATT_LWAIT(n) do { asm volatile("s_waitcnt lgkmcnt(" #n ")" ::: "memory"); ATT_SBAR(); } while (0)
template <int MP> __device__ __forceinline__ void att_give(const f32x16* o, float* Xw, int r32, int hi) {
  constexpr int RG = MP ? 0 : 8;
#pragma unroll
  for (int rr = 0; rr < 8; ++rr)
#pragma unroll
    for (int d0 = 0; d0 < 4; ++d0) Xw[(crow(RG + rr, hi) & 15) * 128 + d0 * 32 + r32] = o[d0][RG + rr];
}
template <int MP> __device__ __forceinline__ void att_fin(const f32x16* o, const float* Xr, float lam, const float (&gq)[4], bf16_t* OCw, int r32, int hi, int lane) {
  constexpr int RK = MP ? 8 : 0;
  unsigned pk[8][4];
#pragma unroll
  for (int rr = 0; rr < 8; ++rr) { const int lr = crow(RK + rr, hi) & 15;
    float df[4], ssq = 0.f;
#pragma unroll
    for (int d0 = 0; d0 < 4; ++d0) { const float x = Xr[lr * 128 + d0 * 32 + r32]; df[d0] = MP ? x - lam * o[d0][RK + rr] : o[d0][RK + rr] - lam * x; ssq += df[d0] * df[d0]; }
    ssq = xadd<1>(ssq); ssq = xadd<2>(ssq); ssq = xadd<4>(ssq); ssq = xadd<8>(ssq); ssq = xadd<16>(ssq);
    const float rn = rsqrtf(ssq * (1.f / 128.f) + cfg::EPS);
#pragma unroll
    for (int d0 = 0; d0 < 4; ++d0) pk[rr][d0] = cvtpk(df[d0] * rn * gq[d0], 0.f); }
  char* stg = (char*)Xr;
#pragma unroll
  for (int rr = 0; rr < 8; ++rr) { const int lr = crow(RK + rr, hi) & 15;
#pragma unroll
    for (int d0 = 0; d0 < 4; ++d0) *(unsigned short*)(stg + lr * 272 + (d0 * 32 + r32) * 2) = (unsigned short)pk[rr][d0]; }
#pragma unroll
  for (int i = 0; i < 4; ++i) { const int c = lane + 64 * i, row = c >> 4, cc = c & 15;
    const u32x4 v = *(const u32x4*)(stg + row * 272 + cc * 16); *(u32x4*)(OCw + (size_t)row * 1024 + cc * 8) = v; }
}
__device__ __forceinline__ void attn_unit(int b, int h, int qb, const bf16_t* __restrict__ Qg, const bf16_t* __restrict__ Kg, const bf16_t* __restrict__ Vg, bf16_t* __restrict__ OC,
                                          const float* __restrict__ lamp, const float* __restrict__ dgv, int layer, char* lds) {
  int tid_o = threadIdx.x; asm volatile("" : "+v"(tid_o));
  const int tid = tid_o, wid = __builtin_amdgcn_readfirstlane(tid >> 6), lane = tid & 63, r32 = lane & 31, hi = lane >> 5, mp = wid >> 2, wl = wid & 3, mofs = mp * 64;
  char* V_lds = lds; char* K_lds = lds + 2 * SHM_V;
  float* ws = (float*)(lds + SHM_X) + wid * 64; float* al_l = ws + 32;
  float m_reg = 0.f; f32x16 o[4] = {}, ol = {}, negm = {}; bf16x8 qr[4];
  const int q0 = qb * 128 + wl * QBLK;
  const bf16_t* Qw = Qg + (size_t)(b * cfg::S + q0 + r32) * LD + h * 128 + mofs + hi * 8;
#pragma unroll
  for (int d0 = 0; d0 < 4; ++d0) qr[d0] = *reinterpret_cast<const bf16x8*>(Qw + d0 * 16);
  const bf16_t* Kh = Kg + (size_t)b * cfg::S * LD + h * 128; const bf16_t* Vh = Vg + (size_t)b * cfg::S * LD + h * 128;
  const int vb0 = (int)(uintptr_t)V_lds + v_rd_base(lane);
  const int ka0 = (int)(uintptr_t)K_lds + ATT_KSWZ(r32, (mofs + hi * 8) * 2);
  const bf16x8 ones = {0x3F80, 0x3F80, 0x3F80, 0x3F80, 0x3F80, 0x3F80, 0x3F80, 0x3F80};
  const int gt = tid & 255, gr = gt >> 4, gc = (gt & 15) * 8;
  const bf16_t* gsrc = (mp ? Kh : Vh) + (size_t)gr * LD + gc;
  char* gdst = mp ? K_lds + ATT_KSWZ(gr, gc * 2) : V_lds + v_st(gr, gc);
  const int tofs = mp ? 2 : 0;
  bf16x8 st_[2][4];
#define ATT_GLOAD(i, t) do { const int t_ = (t) < NT ? (t) : NT - 1;     \
    _Pragma("unroll") for (int q_ = 0; q_ < 4; ++q_) st_[i][q_] = *reinterpret_cast<const bf16x8*>(gsrc + (size_t)(t_ * 64 + 16 * q_) * LD); } while (0)
#define ATT_GWRITE(i, t) do { asm volatile("s_waitcnt vmcnt(4)" ::: "memory"); if ((t) < NT) { \
    _Pragma("unroll") for (int q_ = 0; q_ < 4; ++q_) *(bf16x8*)(gdst + (i) * 16384 + q_ * 4096) = st_[i][q_]; } } while (0)
#define ATT_RESC(a) do { if (__any((a) < 1.f)) { if (hi == 0) al_l[r32] = (a); asm volatile("s_waitcnt lgkmcnt(0)" ::: "memory"); \
    _Pragma("unroll") for (int r = 0; r < 16; ++r) { const float a_ = al_l[crow(r, hi)]; ol[r] *= a_; _Pragma("unroll") for (int d = 0; d < 4; ++d) o[d][r] *= a_; } } } while (0)
  f32x16 s0, s1; float al; bf16x8 pa0, pa1, pa2, pa3, kf[8]; VF f0, f1;
#define ATT_VSEG(I, p) do { ATT_GWRITE(I, (p) + tofs); ATT_GLOAD(I, (p) + tofs + 2); ATT_SBAR(); \
    softmaxP(s0, s1, m_reg, negm, al, (p) == 0, pa0, pa1, pa2, pa3); ATT_RESC(al); } while (0)
#define ATT_OL(pa) ol = __builtin_amdgcn_mfma_f32_32x32x16_bf16(pa, ones, ol, 0, 0, 0)
#define ATT_QK(KB) do { k_load2<KB>(kf, ka0, ka0 ^ 32); k_load2<KB>(kf + 4, ka0 ^ 64, ka0 ^ 96); ATT_LWAIT(4); s0 = negm; s1 = negm; qk_mma2(s0, s1, kf, qr[0], qr[1]); ATT_LWAIT(0); qk_mma2(s0, s1, kf + 4, qr[2], qr[3]); ATT_SBAR(); } while (0)
#define ATT_MSEG(VB, KB, QK) do { vf_load<0>(f0, vb0 + (VB) * SHM_V); vf_load<1>(f1, vb0 + (VB) * SHM_V); ATT_SBAR(); \
    ATT_LWAIT(8); pv_step(o, pa0, f0); ATT_OL(pa0); vf_load<2>(f0, vb0 + (VB) * SHM_V); \
    ATT_LWAIT(8); pv_step(o, pa1, f1); ATT_OL(pa1); vf_load<3>(f1, vb0 + (VB) * SHM_V); \
    if constexpr (QK) { k_load2<KB>(kf, ka0, ka0 ^ 32); ATT_LWAIT(12); } else ATT_LWAIT(8); \
    pv_step(o, pa2, f0); ATT_OL(pa2); \
    if constexpr (QK) ATT_LWAIT(4); else ATT_LWAIT(0); \
    pv_step(o, pa3, f1); ATT_OL(pa3); \
    if constexpr (QK) { k_load2<KB>(kf + 4, ka0 ^ 64, ka0 ^ 96); ATT_LWAIT(4); s0 = negm; s1 = negm; qk_mma2(s0, s1, kf, qr[0], qr[1]); ATT_LWAIT(0); qk_mma2(s0, s1, kf + 4, qr[2], qr[3]); } ATT_SBAR(); } while (0)
  { const int kr = tid >> 4, kc = (tid & 15) * 8;
    const bf16x8 k0 = *reinterpret_cast<const bf16x8*>(&Kh[(size_t)kr * LD + kc]), k1 = *reinterpret_cast<const bf16x8*>(&Kh[(size_t)(32 + kr) * LD + kc]);
    const bf16x8 k2 = *reinterpret_cast<const bf16x8*>(&Kh[(size_t)(64 + kr) * LD + kc]), k3 = *reinterpret_cast<const bf16x8*>(&Kh[(size_t)(96 + kr) * LD + kc]);
    ATT_GLOAD(0, tofs); ATT_GLOAD(1, tofs + 1);
    asm volatile("s_waitcnt vmcnt(8)" ::: "memory");
    *(bf16x8*)(K_lds + ATT_KSWZ(kr, kc * 2)) = k0; *(bf16x8*)(K_lds + ATT_KSWZ(32 + kr, kc * 2)) = k1;
    *(bf16x8*)(K_lds + SHM_K + ATT_KSWZ(kr, kc * 2)) = k2; *(bf16x8*)(K_lds + SHM_K + ATT_KSWZ(32 + kr, kc * 2)) = k3; }
  __syncthreads();
  if (mp) __syncthreads();
  ATT_QK(0); __syncthreads();
  for (int p = 0; p + 2 < NT; p += 2) {
    ATT_VSEG(0, p);           __syncthreads();
    ATT_MSEG(0, 1, true);     __syncthreads();
    ATT_VSEG(1, p + 1);       __syncthreads();
    ATT_MSEG(1, 0, true);     __syncthreads();
  }
  ATT_VSEG(0, NT - 2);   __syncthreads();
  ATT_MSEG(0, 1, true);   __syncthreads();
  ATT_VSEG(1, NT - 1);   __syncthreads();
  ATT_MSEG(1, 0, false);  __syncthreads();
  if (!mp) __syncthreads();
#pragma unroll
  for (int r = 0; r < 16; ++r) { const float rl = __builtin_amdgcn_rcpf(ol[r]);
#pragma unroll
    for (int d0 = 0; d0 < 4; ++d0) o[d0][r] *= rl; }
  __syncthreads();
  float* X = (float*)lds;
  const float* Xr = X + wid * 2048; float* Xw = X + (wid ^ 4) * 2048;
  int layer_o = __builtin_amdgcn_readfirstlane(layer); asm volatile("" : "+s"(layer_o)); const float lam_init = layer_o == 0 ? 0.2f : 0.35550906759f;
  if (mp == 0) att_give<0>(o, Xw, r32, hi); else att_give<1>(o, Xw, r32, hi);
  float lam; { float s1 = lamp[lane] * lamp[64 + lane], s2 = lamp[128 + lane] * lamp[192 + lane];
    s1 = xadd<1>(s1); s2 = xadd<1>(s2); s1 = xadd<2>(s1); s2 = xadd<2>(s2); s1 = xadd<4>(s1); s2 = xadd<4>(s2); s1 = xadd<8>(s1); s2 = xadd<8>(s2); s1 = xadd<16>(s1); s2 = xadd<16>(s2); s1 = xadd<32>(s1); s2 = xadd<32>(s2);
    lam = __expf(s1) - __expf(s2) + lam_init; }
  float gq[4];
#pragma unroll
  for (int d0 = 0; d0 < 4; ++d0) gq[d0] = dgv[d0 * 32 + r32] * (1.f - lam_init);
  __syncthreads();
  bf16_t* OCw = OC + (size_t)(b * cfg::S + q0 + 16 * mp) * 1024 + h * 128;
  if (mp == 0) att_fin<0>(o, Xr, lam, gq, OCw, r32, hi, lane); else att_fin<1>(o, Xr, lam, gq, OCw, r32, hi, lane);
  __syncthreads();
#undef ATT_GLOAD
#undef ATT_GWRITE
#undef ATT_VSEG
#undef ATT_MSEG
#undef ATT_RESC
#undef ATT_OL
#undef ATT_QK
}
#undef ATT_KSWZ
#undef ATT_SBAR
}
namespace gla {
using att::bf16x8; using att::s16x4; using att::f32x16; using att::u32x4; using att::crow; using att::cvtpk; using att::tr_read;
typedef float f32x4 __attribute__((ext_vector_type(4)));
typedef unsigned u32x2 __attribute__((ext_vector_type(2)));
#define GLAS __attribute__((address_space(3)))
constexpr int KT_STRIDE = 144;
constexpr int A_KT = 0, A_V = 36864, A_BEND = A_V + 32768;
constexpr int B_QT = 0, B_KT = 32768, B_V = 65536, B_SC = 98304;
__device__ __forceinline__ int v_st64(int k, int c) { const int kk = (k & ~0xC) | ((k & 4) << 1) | ((k & 8) >> 1); return ((kk >> 3) * 2 + (c >> 5)) * 512 + ((kk & 7) * 32 + (c & 31)) * 2; }
constexpr int v_off64(int d0, int ks, int half) { return d0 * 512 + ks * 2048 + half * 1024; }
__device__ __forceinline__ float bf2f_(unsigned short v) { return __uint_as_float((unsigned)v << 16); }
__device__ __forceinline__ void load_v_tile(const bf16_t* __restrict__ src, GLAS unsigned char* dst, int lane) {
    u32x4 tv[8];
#pragma unroll
    for (int i = 0; i < 8; ++i) { const int row = (lane >> 3) + 8 * i, ch = lane & 7; tv[i] = *(const u32x4*)(src + (size_t)row * 256 + ch * 8); }
#pragma unroll
    for (int i = 0; i < 8; ++i) { const int row = (lane >> 3) + 8 * i, ch = lane & 7; *(GLAS u32x4*)(dst + v_st64(row, ch * 8)) = tv[i]; }
}
#define GLA_PK(L, H) (bf16x8){L[0], L[1], L[2], L[3], H[0], H[1], H[2], H[3]}
#define GLA_MM4(o0, o1, vb, AF) do { \
    const s16x4 l00 = tr_read<v_off64(0, 0, 0)>(vb), h00 = tr_read<v_off64(0, 0, 1)>(vb), l01 = tr_read<v_off64(0, 1, 0)>(vb), h01 = tr_read<v_off64(0, 1, 1)>(vb); \
    const s16x4 l02 = tr_read<v_off64(0, 2, 0)>(vb), h02 = tr_read<v_off64(0, 2, 1)>(vb), l03 = tr_read<v_off64(0, 3, 0)>(vb), h03 = tr_read<v_off64(0, 3, 1)>(vb); \
    const s16x4 l10 = tr_read<v_off64(1, 0, 0)>(vb), h10 = tr_read<v_off64(1, 0, 1)>(vb), l11 = tr_read<v_off64(1, 1, 0)>(vb), h11 = tr_read<v_off64(1, 1, 1)>(vb); \
    const s16x4 l12 = tr_read<v_off64(1, 2, 0)>(vb), h12 = tr_read<v_off64(1, 2, 1)>(vb), l13 = tr_read<v_off64(1, 3, 0)>(vb), h13 = tr_read<v_off64(1, 3, 1)>(vb); \
    asm volatile("s_waitcnt lgkmcnt(0)" ::: "memory"); __builtin_amdgcn_sched_barrier(0); \
    o0 = __builtin_amdgcn_mfma_f32_32x32x16_bf16(AF(0), GLA_PK(l00, h00), o0, 0, 0, 0); o1 = __builtin_amdgcn_mfma_f32_32x32x16_bf16(AF(0), GLA_PK(l10, h10), o1, 0, 0, 0); \
    o0 = __builtin_amdgcn_mfma_f32_32x32x16_bf16(AF(1), GLA_PK(l01, h01), o0, 0, 0, 0); o1 = __builtin_amdgcn_mfma_f32_32x32x16_bf16(AF(1), GLA_PK(l11, h11), o1, 0, 0, 0); \
    o0 = __builtin_amdgcn_mfma_f32_32x32x16_bf16(AF(2), GLA_PK(l02, h02), o0, 0, 0, 0); o1 = __builtin_amdgcn_mfma_f32_32x32x16_bf16(AF(2), GLA_PK(l12, h12), o1, 0, 0, 0); \
    o0 = __builtin_amdgcn_mfma_f32_32x32x16_bf16(AF(3), GLA_PK(l03, h03), o0, 0, 0, 0); o1 = __builtin_amdgcn_mfma_f32_32x32x16_bf16(AF(3), GLA_PK(l13, h13), o1, 0, 0, 0); } while (0)
__device__ __forceinline__ bf16x8 afrag_tr(const GLAS unsigned char* row, int ks, int hi) { return *(const GLAS bf16x8*)(row + (16 * ks + 8 * hi) * 2); }

__device__ __forceinline__ void gla_a_item(int b, int h, int g, unsigned char* ws, GLAS unsigned char* lds) {
    int tid_o = threadIdx.x; asm volatile("" : "+v"(tid_o));
    const int tid = tid_o, wave = __builtin_amdgcn_readfirstlane(tid >> 6), lane = tid & 63, r32 = lane & 31, hi = lane >> 5;
    const float* GL = (const float*)(ws + cfg::WS_GL); const bf16_t* GQK = (const bf16_t*)(ws + cfg::WS_GQK); const bf16_t* GV = (const bf16_t*)(ws + cfg::WS_GV);
    float* KVC = (float*)(ws + cfg::WS_OF); float* DEC = (float*)(ws + cfg::WS_DEC);
    const size_t tok0 = (size_t)b * 2048 + g * 256;
    GLAS float* bend_s = (GLAS float*)(lds + A_BEND);
    if (wave < 4) {
        const int c = wave, dir = lane >> 5, d = lane & 31;
        const float* gl = GL + (tok0 + c * 64) * 256 + dir * 128 + h * 32 + d; const bf16_t* kp = GQK + (tok0 + c * 64) * 256 + 128 + h * 32 + d;
        GLAS unsigned char* row = lds + A_KT + ((c * 2 + dir) * 32 + d) * KT_STRIDE; float bsum = 0.f; float gA[8], gB[8]; unsigned short kA[8], kB[8];
#define GLA_LOAD(G, K, blk) do { const int t0_ = dir ? 56 - 8 * (blk) : 8 * (blk); _Pragma("unroll") for (int i = 0; i < 8; ++i) { G[i] = gl[(size_t)(t0_ + i) * 256]; K[i] = kp[(size_t)(t0_ + i) * 256]; } } while (0)
#define GLA_PROC(G, K, blk) do { const int t0_ = dir ? 56 - 8 * (blk) : 8 * (blk); float kt[8]; \
            if (dir == 0) { _Pragma("unroll") for (int i = 0; i < 8; ++i) { bsum += G[i]; kt[i] = bf2f_(K[i]) * __expf(-bsum); } } \
            else { _Pragma("unroll") for (int i = 7; i >= 0; --i) { bsum += G[i]; kt[i] = bf2f_(K[i]) * __expf(-bsum); } } \
            u32x4 w; w.x = cvtpk(kt[0], kt[1]); w.y = cvtpk(kt[2], kt[3]); w.z = cvtpk(kt[4], kt[5]); w.w = cvtpk(kt[6], kt[7]); *(GLAS u32x4*)(row + t0_ * 2) = w; } while (0)
        GLA_LOAD(gA, kA, 0);
#pragma unroll
        for (int bp = 0; bp < 4; ++bp) { GLA_LOAD(gB, kB, 2 * bp + 1); GLA_PROC(gA, kA, 2 * bp); if (bp < 3) GLA_LOAD(gA, kA, 2 * bp + 2); GLA_PROC(gB, kB, 2 * bp + 1); }
#undef GLA_LOAD
#undef GLA_PROC
        bend_s[(c * 2 + dir) * 32 + d] = bsum;
        DEC[((size_t)((b * 4 + h) * 32 + g * 4 + c) * 2 + dir) * 32 + d] = __expf(bsum);
    } else { const int c = wave - 4; load_v_tile(GV + (tok0 + c * 64) * 256 + h * 64, lds + A_V + c * 8192, lane); }
    __syncthreads();
    {
        const int c = wave >> 1, dir = wave & 1; f32x16 o0 = {}, o1 = {};
        const int vb = (int)(unsigned)(uintptr_t)(lds + A_V + c * 8192) + att::v_rd_base(lane);
        const GLAS unsigned char* arow = lds + A_KT + ((c * 2 + dir) * 32 + r32) * KT_STRIDE;
#define GLA_AF(ks) afrag_tr(arow, ks, hi)
        GLA_MM4(o0, o1, vb, GLA_AF);
#undef GLA_AF
        float* dst = KVC + ((size_t)((b * 4 + h) * 32 + g * 4 + c) * 2 + dir) * 2048 + r32;
#pragma unroll
        for (int r = 0; r < 16; ++r) { const int d = crow(r, hi); const float sc = __expf(bend_s[(c * 2 + dir) * 32 + d]); dst[d * 64] = o0[r] * sc; dst[d * 64 + 32] = o1[r] * sc; }
    }
    __syncthreads();
}

__device__ __forceinline__ void gla_b_item(int b, int h, int g, unsigned char* ws, const float* __restrict__ gng, bf16_t* __restrict__ OC, GLAS unsigned char* lds) {
    int tid_o = threadIdx.x; asm volatile("" : "+v"(tid_o));
    const int tid = tid_o, wave = __builtin_amdgcn_readfirstlane(tid >> 6), lane = tid & 63, r32 = lane & 31, hi = lane >> 5;
    const float* GL = (const float*)(ws + cfg::WS_GL); const bf16_t* GQK = (const bf16_t*)(ws + cfg::WS_GQK); const bf16_t* GV = (const bf16_t*)(ws + cfg::WS_GV); const bf16_t* GR = (const bf16_t*)(ws + cfg::WS_GR);
    const float* KVC = (const float*)(ws + cfg::WS_OF) + (size_t)((b * 4 + h) * 32) * 2 * 2048; const float* DEC = (const float*)(ws + cfg::WS_DEC) + (size_t)((b * 4 + h) * 32) * 2 * 32;
    const size_t tok0 = (size_t)b * 2048 + g * 256;
    if (wave < 4) {
        const int c = wave, dir = lane >> 5, d = lane & 31;
        const float* gl = GL + (tok0 + c * 64) * 256 + dir * 128 + h * 32 + d; const bf16_t* qp = GQK + (tok0 + c * 64) * 256 + h * 32 + d;
        GLAS unsigned short* qt = (GLAS unsigned short*)(lds + B_QT + c * 8192) + dir * 32 + d;
        GLAS unsigned short* kt = (GLAS unsigned short*)(lds + B_KT + c * 8192 + dir * 4096) + d;
        float bsum = 0.f; float gA[8], gB[8]; unsigned short qA[8], kA[8], qB[8], kB[8];
#define GLB_LOAD(G, Q, K, blk) do { const int t0_ = dir ? 56 - 8 * (blk) : 8 * (blk); _Pragma("unroll") for (int i = 0; i < 8; ++i) { G[i] = gl[(size_t)(t0_ + i) * 256]; Q[i] = qp[(size_t)(t0_ + i) * 256]; K[i] = qp[(size_t)(t0_ + i) * 256 + 128]; } } while (0)
#define GLB_PROC(G, Q, K, blk) do { const int t0_ = dir ? 56 - 8 * (blk) : 8 * (blk); _Pragma("unroll") for (int ii = 0; ii < 8; ++ii) { \
            const float gi = dir ? G[7 - ii] : G[ii], qi = bf2f_(dir ? Q[7 - ii] : Q[ii]), ki = bf2f_(dir ? K[7 - ii] : K[ii]); const int tt = t0_ + (dir ? 7 - ii : ii); \
            bsum += gi; const float e = __expf(bsum), ei = __expf(-bsum); \
            qt[tt * 64] = (unsigned short)(cvtpk(qi * e, 0.f) & 0xffffu); kt[tt * 32] = (unsigned short)(cvtpk(ki * ei, 0.f) & 0xffffu); } } while (0)
        GLB_LOAD(gA, qA, kA, 0);
#pragma unroll
        for (int bp = 0; bp < 4; ++bp) { GLB_LOAD(gB, qB, kB, 2 * bp + 1); GLB_PROC(gA, qA, kA, 2 * bp); if (bp < 3) GLB_LOAD(gA, qA, kA, 2 * bp + 2); GLB_PROC(gB, qB, kB, 2 * bp + 1); }
#undef GLB_LOAD
#undef GLB_PROC
    } else {
        const int c = wave - 4; load_v_tile(GV + (tok0 + c * 64) * 256 + h * 64, lds + B_V + c * 8192, lane);
        const int t2 = tid - 256, d = t2 >> 3, v8 = (t2 & 7) * 8;
        const float* kvp = KVC + d * 64 + v8; const float* dcp = DEC + d;
        f32x4 own[4][2][2]; float dow[4][2];
#pragma unroll
        for (int c4 = 0; c4 < 4; ++c4)
#pragma unroll
            for (int dr = 0; dr < 2; ++dr) { const int n = 4 * g + c4; own[c4][dr][0] = *(const f32x4*)(kvp + (size_t)(n * 2 + dr) * 2048); own[c4][dr][1] = *(const f32x4*)(kvp + (size_t)(n * 2 + dr) * 2048 + 4); dow[c4][dr] = dcp[(n * 2 + dr) * 32]; }
        f32x4 Sf0 = {0.f, 0.f, 0.f, 0.f}, Sf1 = Sf0, Sb0 = Sf0, Sb1 = Sf0;
#pragma unroll 8
        for (int n = 0; n < 4 * g; ++n) { const float dc = dcp[(n * 2) * 32]; Sf0 = dc * Sf0 + *(const f32x4*)(kvp + (size_t)(n * 2) * 2048); Sf1 = dc * Sf1 + *(const f32x4*)(kvp + (size_t)(n * 2) * 2048 + 4); }
#pragma unroll 8
        for (int n = 31; n >= 4 * g + 4; --n) { const float dc = dcp[(n * 2 + 1) * 32]; Sb0 = dc * Sb0 + *(const f32x4*)(kvp + (size_t)(n * 2 + 1) * 2048); Sb1 = dc * Sb1 + *(const f32x4*)(kvp + (size_t)(n * 2 + 1) * 2048 + 4); }
#pragma unroll
        for (int c4 = 0; c4 < 4; ++c4) { u32x4 w; w.x = cvtpk(Sf0[0], Sf0[1]); w.y = cvtpk(Sf0[2], Sf0[3]); w.z = cvtpk(Sf1[0], Sf1[1]); w.w = cvtpk(Sf1[2], Sf1[3]);
            *(GLAS u32x4*)(lds + B_SC + c4 * 8192 + v_st64(d, v8)) = w; Sf0 = dow[c4][0] * Sf0 + own[c4][0][0]; Sf1 = dow[c4][0] * Sf1 + own[c4][0][1]; }
#pragma unroll
        for (int c4 = 3; c4 >= 0; --c4) { u32x4 w; w.x = cvtpk(Sb0[0], Sb0[1]); w.y = cvtpk(Sb0[2], Sb0[3]); w.z = cvtpk(Sb1[0], Sb1[1]); w.w = cvtpk(Sb1[2], Sb1[3]);
            *(GLAS u32x4*)(lds + B_SC + c4 * 8192 + v_st64(32 + d, v8)) = w; Sb0 = dow[c4][1] * Sb0 + own[c4][1][0]; Sb1 = dow[c4][1] * Sb1 + own[c4][1][1]; }
    }
    __syncthreads();
    {
        const int c = wave >> 1, th = wave & 1, t = 32 * th + r32;
        const GLAS unsigned char* qrow = lds + B_QT + c * 8192 + t * 128;
        f32x16 pf0 = {}, pf1 = {}, pb0 = {}, pb1 = {};
#pragma unroll
        for (int ks = 0; ks < 2; ++ks) {
            const bf16x8 qf = *(const GLAS bf16x8*)(qrow + (16 * ks + 8 * hi) * 2), qb = *(const GLAS bf16x8*)(qrow + (32 + 16 * ks + 8 * hi) * 2);
            const GLAS unsigned char* kf = lds + B_KT + c * 8192 + r32 * 64 + (16 * ks + 8 * hi) * 2; const GLAS unsigned char* kb = kf + 4096;
            pf0 = __builtin_amdgcn_mfma_f32_32x32x16_bf16(*(const GLAS bf16x8*)kf, qf, pf0, 0, 0, 0); pf1 = __builtin_amdgcn_mfma_f32_32x32x16_bf16(*(const GLAS bf16x8*)(kf + 2048), qf, pf1, 0, 0, 0);
            pb0 = __builtin_amdgcn_mfma_f32_32x32x16_bf16(*(const GLAS bf16x8*)kb, qb, pb0, 0, 0, 0); pb1 = __builtin_amdgcn_mfma_f32_32x32x16_bf16(*(const GLAS bf16x8*)(kb + 2048), qb, pb1, 0, 0, 0);
        }
#pragma unroll
        for (int r = 0; r < 16; ++r) { const int j0 = crow(r, hi), j1 = 32 + j0;
            pf0[r] = (j0 <= t ? pf0[r] : 0.f) + (j0 >= t ? pb0[r] : 0.f); pf1[r] = (j1 <= t ? pf1[r] : 0.f) + (j1 >= t ? pb1[r] : 0.f); }
        bf16x8 pa0, pa1, pa2, pa3;
#define GLA_PK4(P, BASE, OUT) do { unsigned a0 = cvtpk(P[BASE + 0], P[BASE + 1]), a1 = cvtpk(P[BASE + 2], P[BASE + 3]); unsigned b0 = cvtpk(P[BASE + 4], P[BASE + 5]), b1 = cvtpk(P[BASE + 6], P[BASE + 7]); \
    auto r0 = __builtin_amdgcn_permlane32_swap(a0, b0, false, false); auto r1 = __builtin_amdgcn_permlane32_swap(a1, b1, false, false); \
    u32x4 w = {r0[0], r1[0], r0[1], r1[1]}; OUT = *reinterpret_cast<bf16x8*>(&w); } while (0)
        GLA_PK4(pf0, 0, pa0); GLA_PK4(pf0, 8, pa1); GLA_PK4(pf1, 0, pa2); GLA_PK4(pf1, 8, pa3);
#undef GLA_PK4
        f32x16 o0 = {}, o1 = {};
        { const int vb = (int)(unsigned)(uintptr_t)(lds + B_V + c * 8192) + att::v_rd_base(lane);
#define GLA_AF(ks) ((ks) == 0 ? pa0 : (ks) == 1 ? pa1 : (ks) == 2 ? pa2 : pa3)
          GLA_MM4(o0, o1, vb, GLA_AF);
#undef GLA_AF
        }
        { const int vb = (int)(unsigned)(uintptr_t)(lds + B_SC + c * 8192) + att::v_rd_base(lane);
#define GLA_AF(ks) afrag_tr(qrow, ks, hi)
          GLA_MM4(o0, o1, vb, GLA_AF);
#undef GLA_AF
        }
        const float g0 = gng[r32], g1 = gng[32 + r32];
        const bf16_t* grb = GR + (tok0 + c * 64 + 32 * th) * 256 + h * 64 + r32; unsigned short gq0[16], gq1[16];
#pragma unroll
        for (int r = 0; r < 16; ++r) { gq0[r] = grb[(size_t)crow(r, hi) * 256]; gq1[r] = grb[(size_t)crow(r, hi) * 256 + 32]; }
#pragma unroll
        for (int r = 0; r < 16; ++r) {
            float ssq = o0[r] * o0[r] + o1[r] * o1[r];
            ssq = xadd<1>(ssq); ssq = xadd<2>(ssq); ssq = xadd<4>(ssq); ssq = xadd<8>(ssq); ssq = xadd<16>(ssq);
            const float rn = rsqrtf(ssq * (1.f / 64.f) + cfg::EPS);
            const size_t tok = tok0 + c * 64 + 32 * th + crow(r, hi);
            bf16_t* dst = OC + tok * 1024 + 768 + h * 64 + r32;
            dst[0] = (bf16_t)(cvtpk(o0[r] * rn * g0 * bf2f_(gq0[r]), 0.f) & 0xffffu); dst[32] = (bf16_t)(cvtpk(o1[r] * rn * g1 * bf2f_(gq1[r]), 0.f) & 0xffffu);
        }
    }
    __syncthreads();
}
#undef GLA_MM4
#undef GLA_PK
#undef GLAS
}
namespace fft {
using att::bf16x8; using att::s16x4; using att::f32x16; using att::u32x4; using att::crow; using att::cvtpk; using att::tr_read;
#define FLAS __attribute__((address_space(3)))
__device__ __forceinline__ int img_off(int k, int c) { const int kk = (k & ~0xC) | ((k & 4) << 1) | ((k & 8) >> 1); return ((kk >> 3) * 8 + (c >> 5)) * 512 + ((kk & 7) * 32 + (c & 31)) * 2; }
constexpr int rd_off(int ks, int half) { return ks * 8192 + half * 4096; }
#define FFT_PK(L, H) (bf16x8){L[0], L[1], L[2], L[3], H[0], H[1], H[2], H[3]}
typedef float f32x2_t __attribute__((ext_vector_type(2))); typedef __bf16 bf16x2_t __attribute__((ext_vector_type(2)));
__device__ __forceinline__ unsigned pk2f(float a, float b) { f32x2_t v = {a, b}; bf16x2_t r = __builtin_convertvector(v, bf16x2_t); return __builtin_bit_cast(unsigned, r); }

__device__ __forceinline__ void stage1_item(int b, int s2, const bf16_t* __restrict__ FX, bf16_t* __restrict__ I1, FLAS unsigned char* lds) {
    int tid_o = threadIdx.x; asm volatile("" : "+v"(tid_o));
    const int tid = tid_o, wave = __builtin_amdgcn_readfirstlane(tid >> 6), lane = tid & 63, r32 = lane & 31, hi = lane >> 5;
    bf16x8 F1[2][4];
#pragma unroll
    for (int ks = 0; ks < 4; ++ks) { float cr[8], ci[8];
#pragma unroll
        for (int j = 0; j < 8; ++j) { const int k = 16 * ks + 8 * hi + j, s1 = k & 31; const float rev = (float)((r32 * s1) & 31) * (1.f / 32.f); const float c = __builtin_amdgcn_cosf(rev), sn = __builtin_amdgcn_sinf(rev);
            const bool p1 = (k >> 5) != 0; cr[j] = p1 ? -sn : c; ci[j] = p1 ? -c : -sn; }
        u32x4 wr = {pk2f(cr[0], cr[1]), pk2f(cr[2], cr[3]), pk2f(cr[4], cr[5]), pk2f(cr[6], cr[7])}, wi = {pk2f(ci[0], ci[1]), pk2f(ci[2], ci[3]), pk2f(ci[4], ci[5]), pk2f(ci[6], ci[7])};
        F1[0][ks] = *reinterpret_cast<bf16x8*>(&wr); F1[1][ks] = *reinterpret_cast<bf16x8*>(&wi); }
    { u32x4 tv[4];
#pragma unroll
      for (int i = 0; i < 4; ++i) { const int p = tid + 512 * i, k = p >> 5, c8 = (p & 31) * 8; tv[i] = *(const u32x4*)(FX + (size_t)(b * 2048 + 64 * (k & 31) + s2) * 512 + (k >> 5) * 256 + c8); }
#pragma unroll
      for (int i = 0; i < 4; ++i) { const int p = tid + 512 * i, k = p >> 5, c8 = (p & 31) * 8; *(FLAS u32x4*)(lds + img_off(k, c8)) = tv[i]; } }
    __syncthreads();
    f32x16 re = {}, im = {};
    { const int vb = (int)(unsigned)(uintptr_t)lds + att::v_rd_base(lane) + wave * 512;
      const s16x4 l0 = tr_read<rd_off(0, 0)>(vb), h0 = tr_read<rd_off(0, 1)>(vb), l1 = tr_read<rd_off(1, 0)>(vb), h1 = tr_read<rd_off(1, 1)>(vb);
      const s16x4 l2 = tr_read<rd_off(2, 0)>(vb), h2 = tr_read<rd_off(2, 1)>(vb), l3 = tr_read<rd_off(3, 0)>(vb), h3 = tr_read<rd_off(3, 1)>(vb);
      asm volatile("s_waitcnt lgkmcnt(0)" ::: "memory"); __builtin_amdgcn_sched_barrier(0);
      re = __builtin_amdgcn_mfma_f32_32x32x16_bf16(F1[0][0], FFT_PK(l0, h0), re, 0, 0, 0); im = __builtin_amdgcn_mfma_f32_32x32x16_bf16(F1[1][0], FFT_PK(l0, h0), im, 0, 0, 0);
      re = __builtin_amdgcn_mfma_f32_32x32x16_bf16(F1[0][1], FFT_PK(l1, h1), re, 0, 0, 0); im = __builtin_amdgcn_mfma_f32_32x32x16_bf16(F1[1][1], FFT_PK(l1, h1), im, 0, 0, 0);
      re = __builtin_amdgcn_mfma_f32_32x32x16_bf16(F1[0][2], FFT_PK(l2, h2), re, 0, 0, 0); im = __builtin_amdgcn_mfma_f32_32x32x16_bf16(F1[1][2], FFT_PK(l2, h2), im, 0, 0, 0);
      re = __builtin_amdgcn_mfma_f32_32x32x16_bf16(F1[0][3], FFT_PK(l3, h3), re, 0, 0, 0); im = __builtin_amdgcn_mfma_f32_32x32x16_bf16(F1[1][3], FFT_PK(l3, h3), im, 0, 0, 0); }
    bf16_t* dst = I1 + (size_t)(b * 32) * 128 * 256 + (size_t)s2 * 256 + 32 * wave + r32;
#pragma unroll
    for (int r = 0; r < 16; ++r) { const int k1 = crow(r, hi); const float rev = (float)((k1 * s2) & 2047) * (1.f / 2048.f); const float ct = __builtin_amdgcn_cosf(rev), st = __builtin_amdgcn_sinf(rev);
        const float ar = re[r] * ct + im[r] * st, ai = im[r] * ct - re[r] * st; const unsigned w = pk2f(ar, ai);
        dst[(size_t)k1 * 128 * 256] = (bf16_t)(w & 0xffffu); dst[(size_t)k1 * 128 * 256 + 64 * 256] = (bf16_t)(w >> 16); }
    __syncthreads();
}

__device__ __forceinline__ void stage2_item(int b, int k1, const bf16_t* __restrict__ I1, bf16_t* __restrict__ OC, FLAS unsigned char* lds) {
    int tid_o = threadIdx.x; asm volatile("" : "+v"(tid_o));
    const int tid = tid_o, wave = __builtin_amdgcn_readfirstlane(tid >> 6), lane = tid & 63, r32 = lane & 31, hi = lane >> 5;
    const bf16_t* src = I1 + (size_t)(b * 32 + k1) * 128 * 256;
    { u32x4 tv[8];
#pragma unroll
      for (int i = 0; i < 8; ++i) { const int p = tid + 512 * i, k = p >> 5, c8 = (p & 31) * 8; tv[i] = *(const u32x4*)(src + (size_t)k * 256 + c8); }
#pragma unroll
      for (int i = 0; i < 8; ++i) { const int p = tid + 512 * i, k = p >> 5, c8 = (p & 31) * 8; *(FLAS u32x4*)(lds + img_off(k, c8)) = tv[i]; } }
    f32x16 y0 = {}, y1 = {};
    __syncthreads();
    const int vb = (int)(unsigned)(uintptr_t)lds + att::v_rd_base(lane) + wave * 512, vb2 = vb + 32768;
    bf16x8 F2[2][8];
#pragma unroll
    for (int ks = 0; ks < 8; ++ks) { float c0[8], c1[8];
#pragma unroll
        for (int j = 0; j < 8; ++j) { const int k = 16 * ks + 8 * hi + j, s2 = k & 63; const float r0 = (float)((r32 * s2) & 63) * (1.f / 64.f), r1 = (float)(((32 + r32) * s2) & 63) * (1.f / 64.f);
            c0[j] = (k >> 6) ? __builtin_amdgcn_sinf(r0) : __builtin_amdgcn_cosf(r0); c1[j] = (k >> 6) ? __builtin_amdgcn_sinf(r1) : __builtin_amdgcn_cosf(r1); }
        u32x4 w0 = {pk2f(c0[0], c0[1]), pk2f(c0[2], c0[3]), pk2f(c0[4], c0[5]), pk2f(c0[6], c0[7])}, w1 = {pk2f(c1[0], c1[1]), pk2f(c1[2], c1[3]), pk2f(c1[4], c1[5]), pk2f(c1[6], c1[7])};
        F2[0][ks] = *reinterpret_cast<bf16x8*>(&w0); F2[1][ks] = *reinterpret_cast<bf16x8*>(&w1); }
#define FFT_STEP(ks) do { \
      const s16x4 lo_ = tr_read<rd_off((ks) & 3, 0)>((ks) < 4 ? vb : vb2), hi_ = tr_read<rd_off((ks) & 3, 1)>((ks) < 4 ? vb : vb2); asm volatile("s_waitcnt lgkmcnt(0)" ::: "memory"); __builtin_amdgcn_sched_barrier(0); \
      y0 = __builtin_amdgcn_mfma_f32_32x32x16_bf16(F2[0][ks], FFT_PK(lo_, hi_), y0, 0, 0, 0); y1 = __builtin_amdgcn_mfma_f32_32x32x16_bf16(F2[1][ks], FFT_PK(lo_, hi_), y1, 0, 0, 0); } while (0)
    FFT_STEP(0); FFT_STEP(1); FFT_STEP(2); FFT_STEP(3); FFT_STEP(4); FFT_STEP(5); FFT_STEP(6); FFT_STEP(7);
#undef FFT_STEP
    bf16_t* dst = OC + (size_t)(b * 2048 + k1) * 1024 + 512 + 32 * wave + r32;
#pragma unroll
    for (int r = 0; r < 16; ++r) { const int k2 = crow(r, hi); const unsigned w = pk2f(y0[r], y1[r]);
        dst[(size_t)(32 * k2) * 1024] = (bf16_t)(w & 0xffffu); dst[(size_t)(32 * (32 + k2)) * 1024] = (bf16_t)(w >> 16); }
    __syncthreads();
}
#undef FFT_PK
#undef FLAS
}
namespace pro {
#define PLAS __attribute__((address_space(3)))
typedef float f32x4 __attribute__((ext_vector_type(4)));
typedef unsigned u32x4 __attribute__((ext_vector_type(4)));
__device__ __forceinline__ unsigned pk2(float lo, float hi) { unsigned r; asm volatile("v_cvt_pk_bf16_f32 %0, %1, %2" : "=v"(r) : "v"(lo), "v"(hi)); return r; }
__device__ __forceinline__ float lo_f(unsigned w) { return __uint_as_float(w << 16); }
__device__ __forceinline__ float hi_f(unsigned w) { return __uint_as_float(w & 0xffff0000u); }
template <bool SUMS, int STRIDE> __device__ __forceinline__ void tile_emit(int K, bf16_t* WT, const float* gain, const float* lnb, float (&a1)[4], float (&a2)[4], const PLAS float* scr, int lane) {
    const int c = lane & 7; float gk[8], bk[8];
#pragma unroll
    for (int q = 0; q < 8; ++q) { gk[q] = gain ? gain[8 * c + q] : 1.f; bk[q] = lnb ? lnb[8 * c + q] : 0.f; }
#pragma unroll
    for (int j = 0; j < 4; ++j) { const int n = (lane >> 3) + 8 * j; const PLAS float* s = scr + (8 * c) * STRIDE + n; float v[8];
#pragma unroll
        for (int q = 0; q < 8; ++q) v[q] = s[q * STRIDE];
        u32x4 o; o.x = pk2(v[0] * gk[0], v[1] * gk[1]); o.y = pk2(v[2] * gk[2], v[3] * gk[3]); o.z = pk2(v[4] * gk[4], v[5] * gk[5]); o.w = pk2(v[6] * gk[6], v[7] * gk[7]);
        *(u32x4*)(WT + (size_t)n * K + 8 * c) = o;
        if (SUMS) { float p1 = (lo_f(o.x) + hi_f(o.x)) + (lo_f(o.y) + hi_f(o.y)) + (lo_f(o.z) + hi_f(o.z)) + (lo_f(o.w) + hi_f(o.w)); float p2 = 0.f;
#pragma unroll
            for (int q = 0; q < 8; ++q) p2 += bk[q] * v[q];
            p1 = xadd<1>(p1); p2 = xadd<1>(p2); p1 = xadd<2>(p1); p2 = xadd<2>(p2); p1 = xadd<4>(p1); p2 = xadd<4>(p2);
            a1[j] += p1; a2[j] += p2; }
    }
    asm volatile("s_waitcnt lgkmcnt(0)" ::: "memory");
}
__device__ __forceinline__ void tile_dma(const float* W, int N, PLAS float* scr, int lane) {
    const float* src = W + (size_t)(lane >> 3) * N + (lane & 7) * 4;
#pragma unroll
    for (int i = 0; i < 8; ++i) __builtin_amdgcn_global_load_lds((const unsigned*)(src + (size_t)(8 * i) * N), (PLAS unsigned*)(scr + i * 256), 16, 0, 0);
}
template <bool SUMS, class Val> __device__ __forceinline__ void tile_item(const Val& val, int K, bf16_t* WT, const float* gain, const float* lnb, float (&a1)[4], float (&a2)[4], PLAS float* scr, int lane) {
#pragma unroll 2
    for (int i = 0; i < 32; ++i) { const int kk = 2 * i + (lane >> 5); scr[kk * 33 + (lane & 31)] = val(kk, lane & 31); }
    asm volatile("s_waitcnt lgkmcnt(0)" ::: "memory");
    tile_emit<SUMS, 33>(K, WT, gain, lnb, a1, a2, scr, lane);
}
struct ValPlain { static constexpr int BATCH = 32; const float* W; int N; __device__ __forceinline__ float operator()(int kk, int j) const { return W[(size_t)kk * N + j]; } };
struct ValGate { static constexpr int BATCH = 2; const float* W; const float* w2; __device__ __forceinline__ float operator()(int kk, int j) const {
    const float* wr = W + (size_t)kk * cfg::INW; float a = 0.f;
#pragma unroll
    for (int r = 0; r < 16; ++r) a += wr[r] * w2[r * 128 + j]; return a; } };

__device__ __forceinline__ void fold_item(int item, unsigned char* ws, const float* w_in, const float* fw, const float* lng, const float* lnb, PLAS unsigned char* lds, int tid) {
    const int l = item >> 5, g = (item >> 3) & 3, part = (item >> 2) & 1, kq = item & 3;
    PLAS float* M = (PLAS float*)lds;
    { const int c = tid >> 3, e0 = (tid & 7) * 8; float acc[8];
#pragma unroll
      for (int q = 0; q < 8; ++q) acc[q] = 0.f;
      const float* w = fw + (size_t)((l * 4 + g) * 64) * 64 + e0;
      for (int k2 = 0; k2 < 64; ++k2) { float rev = (float)((k2 * c) & 63) * (1.f / 64.f); asm volatile("" : "+v"(rev)); const float tr = part ? __builtin_amdgcn_sinf(rev) : __builtin_amdgcn_cosf(rev);
          const f32x4 w0 = *(const f32x4*)(w + k2 * 64), w1 = *(const f32x4*)(w + k2 * 64 + 4);
#pragma unroll
          for (int q = 0; q < 4; ++q) { acc[q] += tr * w0[q]; acc[4 + q] += tr * w1[q]; } }
      const float sc = 0.00276213586400995f;
#pragma unroll
      for (int q = 0; q < 8; ++q) M[c * 64 + e0 + q] = acc[q] * sc; }
    __syncthreads();
    PLAS float* Wl = (PLAS float*)(lds + 16384);
    { const float* wsrc = w_in + ((size_t)l * 1024 + kq * 256) * cfg::INW + 1536 + 64 * g; f32x4 tv[8];
#pragma unroll
      for (int i = 0; i < 8; ++i) tv[i] = *(const f32x4*)(wsrc + (size_t)((tid >> 4) + 32 * i) * cfg::INW + (tid & 15) * 4);
#pragma unroll
      for (int i = 0; i < 8; ++i) *(PLAS f32x4*)(Wl + ((tid >> 4) + 32 * i) * 64 + (tid & 15) * 4) = tv[i]; }
    __syncthreads();
    { const int e = tid & 63, kg = tid >> 6, k0 = kq * 256 + kg * 32, np = 1536 + part * 256 + g * 64 + e; float mc[64];
#pragma unroll
      for (int c = 0; c < 64; ++c) mc[c] = M[c * 64 + e];
      bf16_t* dst = (bf16_t*)(ws + cfg::WS_WIN + l * cfg::SZ_WIN) + (size_t)np * 1024 + k0; float s1 = 0.f, s2 = 0.f;
      for (int kb = 0; kb < 4; ++kb) { float o[8];
#pragma unroll
          for (int q = 0; q < 8; ++q) { const int k = k0 + kb * 8 + q; const PLAS f32x4* wr = (const PLAS f32x4*)(Wl + (kg * 32 + kb * 8 + q) * 64); float a = 0.f;
#pragma unroll
              for (int c4 = 0; c4 < 16; ++c4) { const f32x4 w4 = wr[c4]; a += w4[0] * mc[4 * c4] + w4[1] * mc[4 * c4 + 1] + w4[2] * mc[4 * c4 + 2] + w4[3] * mc[4 * c4 + 3]; }
              o[q] = a * (lng ? lng[k] : 1.f); s2 += lnb ? lnb[k] * a : 0.f; }
          u32x4 w; w.x = pk2(o[0], o[1]); w.y = pk2(o[2], o[3]); w.z = pk2(o[4], o[5]); w.w = pk2(o[6], o[7]); *(u32x4*)(dst + kb * 8) = w;
          s1 += (lo_f(w.x) + hi_f(w.x)) + (lo_f(w.y) + hi_f(w.y)) + (lo_f(w.z) + hi_f(w.z)) + (lo_f(w.w) + hi_f(w.w)); }
      __syncthreads();
      PLAS float* red = (PLAS float*)lds; red[(kg * 64 + e) * 2] = s1; red[(kg * 64 + e) * 2 + 1] = s2;
      __syncthreads();
      if (kg == 0) { float t1 = 0.f, t2 = 0.f;
#pragma unroll
          for (int w = 0; w < 8; ++w) { t1 += red[(w * 64 + e) * 2]; t2 += red[(w * 64 + e) * 2 + 1]; }
          float* fp = (float*)(ws + cfg::V_MF) + (size_t)((l * 4 + kq) * 2) * 512 + part * 256 + g * 64 + e; fp[0] = t1; fp[512] = t2; } }
    __syncthreads();
}

struct Inputs { const float *x, *w_in, *fw, *gw2, *w_out, *ln1g, *ln1b, *wg, *wu, *wd, *ln2g, *ln2b; };
__device__ __forceinline__ void prologue(unsigned char* ws, const Inputs& in, PLAS unsigned char* lds, int vcu, int G) {
    int tid_o = threadIdx.x; asm volatile("" : "+v"(tid_o));
    const int tid = tid_o, wave = __builtin_amdgcn_readfirstlane(tid >> 6), lane = tid & 63;
    const float* x = in.x; const float* w_in = in.w_in; const float* fw = in.fw; const float* gw2 = in.gw2; const float* w_out = in.w_out; const float* ln1g = in.ln1g; const float* ln1b = in.ln1b;
    const float* wg = in.wg; const float* wu = in.wu; const float* wd = in.wd; const float* ln2g = in.ln2g; const float* ln2b = in.ln2b;
    if (vcu < 64) { const int l = vcu >> 5; fold_item(vcu, ws, w_in, fw, l ? ln2g : (const float*)nullptr, l ? ln2b : (const float*)nullptr, lds, tid); }
    PLAS float* scr = (PLAS float*)(lds + wave * 16384); PLAS float* scr1 = scr + 2048; PLAS float* redw = (PLAS float*)(lds + 131072 + 1024 + wave * 256);
    const int gw = vcu * 8 + wave, NGW = G * 8;
    for (int it = vcu; it < 512; it += G) {
        const int l = it >> 8, r = it & 255; float a1[4] = {0.f, 0.f, 0.f, 0.f}, a2[4] = {0.f, 0.f, 0.f, 0.f}; float* c1o; float* c2o;
        const int k0 = wave * 64, k1 = k0 + 512;
        if (r < 80) { const int nb = r; const float* lngb = l ? ln2g : (const float*)nullptr; const float* lnbb = l ? ln2b : (const float*)nullptr;
            bf16_t* Wt = (bf16_t*)(ws + cfg::WS_WIN + l * cfg::SZ_WIN);
            if (nb < 72) { int np0, src;
                if (nb < 32) { const int pn = nb >> 3, p = (nb & 7) * 32, wc = (p >> 5) & 3, bj = p >> 7; np0 = pn * 256 + p; src = (pn >> 1) * 512 + (pn & 1) * 256 + 64 * wc + 32 * bj; }
                else if (nb < 48) { np0 = 1024 + (nb - 32) * 32; src = np0; }
                else { np0 = 2048 + (nb - 48) * 32; src = 1792 + (nb - 48) * 32; }
                tile_dma(w_in + ((size_t)l * 1024 + k0) * cfg::INW + src, cfg::INW, scr, lane); tile_dma(w_in + ((size_t)l * 1024 + k1) * cfg::INW + src, cfg::INW, scr1, lane);
                asm volatile("s_waitcnt vmcnt(0)" ::: "memory");
                tile_emit<true, 32>(1024, Wt + (size_t)np0 * 1024 + k0, lngb ? lngb + k0 : lngb, lnbb ? lnbb + k0 : lnbb, a1, a2, scr, lane);
                tile_emit<true, 32>(1024, Wt + (size_t)np0 * 1024 + k1, lngb ? lngb + k1 : lngb, lnbb ? lnbb + k1 : lnbb, a1, a2, scr1, lane);
                c1o = (float*)(ws + cfg::V_C1IN) + l * cfg::NIN + np0; c2o = (float*)(ws + cfg::V_C2IN) + l * cfg::NIN + np0;
            } else { const int p0 = (nb - 72) * 32, dir = p0 >> 7, kk0 = p0 & 127, np0 = 2816 + p0;
                for (int kb = wave; kb < 16; kb += 8) { const int kq = kb * 64; ValGate v{w_in + ((size_t)l * 1024 + kq) * cfg::INW + 2560 + 16 * dir, gw2 + (size_t)((l * 2 + dir) * 16) * 128 + kk0};
                    tile_item<true>(v, 1024, Wt + (size_t)np0 * 1024 + kq, lngb ? lngb + kq : lngb, lnbb ? lnbb + kq : lnbb, a1, a2, scr, lane); }
                c1o = (float*)(ws + cfg::V_C1IN) + l * cfg::NIN + np0; c2o = (float*)(ws + cfg::V_C2IN) + l * cfg::NIN + np0; }
        } else { const int nb = r - 80, np0 = nb * 32, pn = np0 >> 8, p = np0 & 255, bj = p >> 7, f0 = 128 * pn + (p & 127);
            const float* W = (bj ? wu : wg) + (size_t)l * 1024 * cfg::FF + f0; bf16_t* Wt = (bf16_t*)(ws + cfg::WS_WGU + l * cfg::SZ_WGU) + (size_t)np0 * 1024;
            tile_dma(W + (size_t)k0 * cfg::FF, cfg::FF, scr, lane); tile_dma(W + (size_t)k1 * cfg::FF, cfg::FF, scr1, lane);
            asm volatile("s_waitcnt vmcnt(0)" ::: "memory");
            tile_emit<true, 32>(1024, Wt + k0, ln1g + l * 1024 + k0, ln1b + l * 1024 + k0, a1, a2, scr, lane);
            tile_emit<true, 32>(1024, Wt + k1, ln1g + l * 1024 + k1, ln1b + l * 1024 + k1, a1, a2, scr1, lane);
            c1o = (float*)(ws + cfg::V_C1GU) + l * cfg::NGU + np0; c2o = (float*)(ws + cfg::V_C2GU) + l * cfg::NGU + np0; }
        if ((lane & 7) == 0) {
#pragma unroll
            for (int j = 0; j < 4; ++j) { const int n = (lane >> 3) + 8 * j; redw[n * 2] = a1[j]; redw[n * 2 + 1] = a2[j]; } }
        __syncthreads();
        if (wave == 0 && lane < 32) { float t1 = 0.f, t2 = 0.f;
#pragma unroll
            for (int w = 0; w < 8; ++w) { const PLAS float* rw = (const PLAS float*)(lds + 131072 + 1024 + w * 256); t1 += rw[lane * 2]; t2 += rw[lane * 2 + 1]; }
            c1o[lane] = t1; c2o[lane] = t2; }
        __syncthreads();
    }
    constexpr int I_OUT = 32 * 16, I_DN = 32 * 44, I_L = I_OUT + I_DN;
    for (int it = gw; it < 2 * I_L; it += 2 * NGW) {
        const float* Ws[2]; int Ns[2], Ks[2]; bf16_t* Wd[2]; float d1[4], d2[4];
#pragma unroll
        for (int q = 0; q < 2; ++q) { const int itq = it + q * NGW; const int ic = itq < 2 * I_L ? itq : it; const int l = ic / I_L; int r = ic - l * I_L;
            if (r < I_OUT) { const int nb = r >> 4, kb = r & 15, k0 = kb * 64, n0 = nb * 32; Ws[q] = w_out + ((size_t)l * 1024 + k0) * 1024 + n0; Ns[q] = 1024; Ks[q] = 1024;
                Wd[q] = (bf16_t*)(ws + cfg::WS_WOUT + l * cfg::SZ_WOUT) + (size_t)n0 * 1024 + k0; }
            else { r -= I_OUT; const int nb = r / 44, kb = r - nb * 44, k0 = kb * 64, n0 = nb * 32; Ws[q] = wd + ((size_t)l * cfg::FF + k0) * 1024 + n0; Ns[q] = 1024; Ks[q] = cfg::FF;
                Wd[q] = (bf16_t*)(ws + cfg::WS_WDN + l * cfg::SZ_WDN) + (size_t)n0 * cfg::FF + k0; } }
        tile_dma(Ws[0], Ns[0], scr, lane); tile_dma(Ws[1], Ns[1], scr1, lane);
        asm volatile("s_waitcnt vmcnt(0)" ::: "memory");
        tile_emit<false, 32>(Ks[0], Wd[0], (const float*)nullptr, (const float*)nullptr, d1, d2, scr, lane);
        if (it + NGW < 2 * I_L) tile_emit<false, 32>(Ks[1], Wd[1], (const float*)nullptr, (const float*)nullptr, d1, d2, scr1, lane);
    }
    const int xw = (vcu - 64) * 8 + wave, NXW = (G - 64) * 8;
    if (vcu >= 64 && G > 64)
    for (int m = xw; m < cfg::T; m += 4 * NXW) {
        f32x4 v[4][4];
#pragma unroll
        for (int q = 0; q < 4; ++q) { const int mr = (m + q * NXW) < cfg::T ? (m + q * NXW) : m; const f32x4* xr = (const f32x4*)(x + (size_t)mr * 1024) + lane;
#pragma unroll
            for (int j = 0; j < 4; ++j) v[q][j] = xr[64 * j]; }
#pragma unroll
        for (int q = 0; q < 4; ++q) { const int mr = (m + q * NXW) < cfg::T ? (m + q * NXW) : m; unsigned long long* o8 = (unsigned long long*)((bf16_t*)(ws + cfg::WS_XB) + (size_t)mr * 1024) + lane;
#pragma unroll
            for (int j = 0; j < 4; ++j) o8[64 * j] = (unsigned long long)pk2(v[q][j][0], v[q][j][1]) | ((unsigned long long)pk2(v[q][j][2], v[q][j][3]) << 32); } }
    for (int i = gw * 64 + lane; i < 2048 * 32; i += NGW * 64) { const int pos = i >> 5, f = i & 31; const float inv = exp2f(-(float)f * (13.287712379549449f / 32.f)); const float ang = (float)pos * inv;
        double rv = (double)ang * 0.15915494309189535; rv -= floor(rv); const float rev = (float)rv;
        ((float*)(ws + cfg::V_ROPEC))[i] = __builtin_amdgcn_cosf(rev); ((float*)(ws + cfg::V_ROPES))[i] = __builtin_amdgcn_sinf(rev); }
}
#undef PLAS
}
constexpr int NWAVES = 8;
constexpr int RING_OFF = 0, RING_BYTES = 131072;
constexpr int LDSCTL_OFF = RING_BYTES, MISC_OFF = LDSCTL_OFF + 320;
constexpr int RSL_OFF = 131072 + 4096;
constexpr int LDS_BYTES = 147456;
constexpr int CW_BAR = 4096;
constexpr int CW_GBAR = 8192, GBAR_STRIDE = 4096;
constexpr size_t CTL_ZERO_BYTES = 192 * 1024;
#define GAS __attribute__((address_space(1)))
#define LAS __attribute__((address_space(3)))
typedef GAS unsigned gu32;
#define RLX_AGENT __ATOMIC_RELAXED, __HIP_MEMORY_SCOPE_AGENT
#define XB_TMO      128
#define XB_XCNT(j)  (256  + 64 * (j))
#define XB_XSUB(j)  (1280 + 64 * (j))
#define XB_XGEN(j)  (2304 + 64 * (j))
#define XB_TOP      3328
#define XB_TOPGEN   3392
#define XCD_BAR_WORDS 3456
#define XB_SPIN_CAP (1u << 18)

__device__ __forceinline__ unsigned xb_ld(unsigned* p)              { return __hip_atomic_load(p, __ATOMIC_RELAXED, __HIP_MEMORY_SCOPE_AGENT); }
__device__ __forceinline__ unsigned xb_add(unsigned* p, unsigned v) { return __hip_atomic_fetch_add(p, v, __ATOMIC_RELAXED, __HIP_MEMORY_SCOPE_AGENT); }
__device__ __forceinline__ unsigned xb_xcc_id() { return (unsigned)__builtin_amdgcn_s_getreg((3 << 11) | 20) & 0xFu; }
#define XB_SPIN(cond, bar) do { unsigned _sp = 0; while (cond) { __builtin_amdgcn_s_sleep(1); \
    if ((++_sp & 255u) == 0u) { if (xb_ld(&(bar)[XB_TMO])) break; if (_sp > XB_SPIN_CAP) { atomicAdd(&(bar)[XB_TMO], 1u); break; } } } } while (0)

struct XcdBarrier {
    unsigned* bar; unsigned x; unsigned total;
    volatile LAS unsigned* st;
};

__device__ __forceinline__ XcdBarrier xcd_barrier_post(unsigned* bar, volatile LAS unsigned* st, unsigned total) {
    XcdBarrier b; b.bar = bar; b.x = xb_xcc_id(); b.st = st; b.total = total;
    if (threadIdx.x == 0) (void)xb_add(&bar[XB_XCNT(b.x)], 1u);
    return b;
}
__device__ __forceinline__ void xcd_barrier_complete(unsigned* bar, unsigned x, unsigned G, unsigned& nloc, unsigned& nx) {
    unsigned sum, cnt, mine, sp = 0u;
    for (;;) {
        sum = 0u; cnt = 0u; mine = 0u;
#pragma unroll
        for (unsigned j = 0; j < 16; ++j) { const unsigned c = xb_ld(&bar[XB_XCNT(j)]); sum += c; cnt += (c > 0u) ? 1u : 0u; mine = (j == x) ? c : mine; }
        if (sum == G) break;
        __builtin_amdgcn_s_sleep(1);
        if ((++sp & 255u) == 0u) { if (xb_ld(&bar[XB_TMO])) break; if (sp > XB_SPIN_CAP) { atomicAdd(&bar[XB_TMO], 1u); break; } }
    }
    nloc = mine > 0u ? mine : 1u; nx = cnt > 0u ? cnt : 1u;
}

__device__ __forceinline__ void xcd_barrier(const XcdBarrier& b) {
    asm volatile("s_waitcnt vmcnt(0)" ::: "memory");
    __syncthreads();
    if (threadIdx.x == 0) {
        unsigned* bar = b.bar;
        __builtin_amdgcn_s_waitcnt(0);
        unsigned nloc = b.st[0], nx = b.st[1];
        if (nloc == 0u) { xcd_barrier_complete(bar, b.x, b.total, nloc, nx); b.st[0] = nloc; b.st[1] = nx; }
        const unsigned old = xb_add(&bar[XB_XSUB(b.x)], 1u);
        const unsigned gen = old / nloc;
        if (old + 1u == (gen + 1u) * nloc) {
            __builtin_amdgcn_fence(__ATOMIC_RELEASE, "agent");
            asm volatile("s_waitcnt vmcnt(0)" ::: "memory");
            const unsigned og = xb_add(&bar[XB_TOP], 1u);
            const unsigned tg = og / nx;
            if (og + 1u == (tg + 1u) * nx) xb_add(&bar[XB_TOPGEN], 1u);
            else XB_SPIN(xb_ld(&bar[XB_TOPGEN]) == tg, bar);
            __builtin_amdgcn_fence(__ATOMIC_ACQUIRE, "agent");
            xb_add(&bar[XB_XGEN(b.x)], 1u);
            asm volatile("s_waitcnt vmcnt(0)" ::: "memory");
        } else {
            XB_SPIN(xb_ld(&bar[XB_XGEN(b.x)]) == gen, bar);
            __builtin_amdgcn_fence(__ATOMIC_ACQUIRE, "agent");
            asm volatile("s_waitcnt vmcnt(0)" ::: "memory");
        }
    }
    __syncthreads();
}


#define FILL_RSL(STP) do { pg8::Unit u0_; if (S.next(0, u0_)) { int tq_ = threadIdx.x; asm volatile("" : "+v"(tq_)); const int row_ = u0_.pm * 256 + (tq_ >> 1), hf_ = tq_ & 1; \
    typedef float f32x4_ __attribute__((ext_vector_type(4))); typedef float f32x2_ __attribute__((ext_vector_type(2))); \
    const f32x4_* sp_ = (const f32x4_*)((STP) + (size_t)row_ * 32 + hf_ * 16); const f32x4_ x0 = sp_[0], x1 = sp_[1], x2 = sp_[2], x3 = sp_[3]; \
    float sm_ = ((x0[0] + x0[2]) + (x1[0] + x1[2])) + ((x2[0] + x2[2]) + (x3[0] + x3[2])), sq_ = ((x0[1] + x0[3]) + (x1[1] + x1[3])) + ((x2[1] + x2[3]) + (x3[1] + x3[3])); \
    sm_ = xadd<1>(sm_); sq_ = xadd<1>(sq_); const float mu_ = sm_ * (1.f / 1024.f), rstd_ = rsqrtf(fmaxf(sq_ * (1.f / 1024.f) - mu_ * mu_, 0.f) + EPS); \
    if (hf_ == 0) *(LAS f32x2_*)(ldsl + RSL_OFF + 8 * (tq_ >> 1)) = (f32x2_){rstd_, -rstd_ * mu_}; } \
    __syncthreads(); } while (0)

enum { PH_PRO = 0, PH_IN = 1, PH_ATT = 2, PH_MIXB = 3, PH_OUT = 4, PH_GU = 5, PH_DN = 6, PH_FIN = 13, N_PHASES = 14 };
struct MArgs { const float* in[16]; float* out; unsigned char* ws; int ph_lo, ph_hi, li, pad; };

__global__ void __launch_bounds__(NWAVES * 64, 2) mk_fwd(MArgs a) {
    extern __shared__ __attribute__((aligned(128))) unsigned char lds[];
    LAS unsigned char* ldsl = (LAS unsigned char*)lds;
    volatile LAS unsigned* MISC = (volatile LAS unsigned*)(ldsl + MISC_OFF);
    const int tid = threadIdx.x;
    const int G = gridDim.x, bx = blockIdx.x, vcu = (G % 8 == 0) ? (bx % 8) * (G / 8) + bx / 8 : bx;
    unsigned char* ws = a.ws;
    for (int u = tid; u < (LDS_BYTES - LDSCTL_OFF) / 4; u += NWAVES * 64) ((LAS unsigned*)(ldsl + LDSCTL_OFF))[u] = 0u;
    __syncthreads();
    XcdBarrier bar; bar.bar = (unsigned*)(ws + WS_CTL) + CW_BAR + a.li * XCD_BAR_WORDS; bar.x = 0; bar.st = nullptr; bar.total = (unsigned)G;
    if (a.ph_hi - a.ph_lo > 1) bar = xcd_barrier_post((unsigned*)(ws + WS_CTL) + CW_BAR + a.li * XCD_BAR_WORDS, MISC + 8, (unsigned)G);
    const bool grp_ok = (G % 8 == 0) && (a.ph_hi - a.ph_lo > 1);
    XcdBarrier gbar = bar;
    if (grp_ok) gbar = xcd_barrier_post((unsigned*)(ws + WS_CTL) + CW_GBAR + (bx & 7) * GBAR_STRIDE, MISC + 10, (unsigned)(G / 8));
    const int G0 = G, bx0 = bx, vcu0 = vcu; unsigned char* const ws0 = ws;
    for (int ph = a.ph_lo; ph < a.ph_hi; ++ph) {
        int G = G0, bx = bx0, vcu = vcu0; unsigned zo = 0u; asm volatile("" : "+s"(G), "+s"(bx), "+s"(vcu), "+s"(zo)); unsigned char* ws = ws0 + zo;
        const int l = (ph >= 1 && ph <= 12) ? (ph - 1) / 6 : 0;
        const int kind = (ph == 0) ? PH_PRO : (ph == PH_FIN ? PH_FIN : 1 + (ph - 1) % 6);
        if (kind == PH_PRO) {
            { pro::Inputs pin{a.in[0], a.in[1], a.in[4], a.in[5], a.in[8], a.in[9], a.in[10], a.in[11], a.in[12], a.in[13], a.in[14], a.in[15]}; pro::prologue(ws, pin, ldsl + RING_OFF, vcu, G); }
        } else if (kind == PH_IN) {
            pg8::Gemm g{(const bf16_t*)(ws + WS_XB), (const bf16_t*)(ws + WS_WIN + l * SZ_WIN), T, NIN, D}; pg8::StaticOrder S; S.init(T, NIN, G, bx);
            if (l) FILL_RSL((const float*)(ws + WS_ST2));
            pg8::FEpiIn E{ws, a.in[6] + l * 256, l, (const LAS float*)(ldsl + RSL_OFF)};
            pg8::gemm_phase<pg8::FEpiIn, pg8::StaticOrder, true, true>(ldsl + RING_OFF, g, S, E);
        } else if (kind == PH_ATT) {
            for (int i = 0; i < 2; ++i) { const int idx = vcu * 2 + i; if (idx >= 512) break; const int bh = idx >> 4, qb = idx & 15;
                att::attn_unit(bh >> 2, bh & 3, qb, (const bf16_t*)(ws + WS_Q), (const bf16_t*)(ws + WS_K), (const bf16_t*)(ws + WS_V), (bf16_t*)(ws + WS_OC), a.in[2] + l * 256, a.in[3] + l * 128, l, (char*)lds + RING_OFF); }
            for (int i = 0; i < 2; ++i) { const int it = vcu * 2 + i; if (it >= 512) break;
                                fft::stage1_item(it >> 6, it & 63, (const bf16_t*)(ws + WS_TAB), (bf16_t*)(ws + WS_XT), ldsl + RING_OFF); }

            if (vcu < 256) gla::gla_a_item(vcu >> 5, (vcu >> 3) & 3, vcu & 7, ws, ldsl + RING_OFF);
        } else if (kind == PH_MIXB) {
            if (vcu < 256) fft::stage2_item(vcu >> 5, vcu & 31, (const bf16_t*)(ws + WS_XT), (bf16_t*)(ws + WS_OC), ldsl + RING_OFF);
            if (vcu < 256) gla::gla_b_item(vcu >> 5, (vcu >> 3) & 3, vcu & 7, ws, a.in[7] + l * 64, (bf16_t*)(ws + WS_OC), ldsl + RING_OFF);
        } else if (kind == PH_OUT) {
            pg8::Gemm g{(const bf16_t*)(ws + WS_OC), (const bf16_t*)(ws + WS_WOUT + l * SZ_WOUT), T, D, D}; pg8::StaticOrder S; S.init(T, D, G, bx);
            if (l) FILL_RSL((const float*)(ws + WS_ST2));
            pg8::FEpiRes E{l ? (const LAS float*)(ldsl + RSL_OFF) : (const LAS float*)nullptr, a.in[14] + (l ? l - 1 : 0) * 1024, a.in[15] + (l ? l - 1 : 0) * 1024, (bf16_t*)(ws + WS_XB), (float*)(ws + WS_ST1)};
            pg8::gemm_phase<pg8::FEpiRes, pg8::StaticOrder, true, true>(ldsl + RING_OFF, g, S, E);
        } else if (kind == PH_GU) {
            pg8::Gemm g{(const bf16_t*)(ws + WS_XB), (const bf16_t*)(ws + WS_WGU + l * SZ_WGU), T, NGU, D}; pg8::StaticOrder S; S.init(T, NGU, G, bx);
            FILL_RSL((const float*)(ws + WS_ST1));
            pg8::FEpiGU E{(const LAS float*)(ldsl + RSL_OFF), (const float*)(ws + V_C1GU) + l * NGU, (const float*)(ws + V_C2GU) + l * NGU, (bf16_t*)(ws + WS_ACT)};
            pg8::gemm_phase<pg8::FEpiGU, pg8::StaticOrder, true, true>(ldsl + RING_OFF, g, S, E);
        } else if (kind == PH_DN) {
            pg8::Gemm g{(const bf16_t*)(ws + WS_ACT), (const bf16_t*)(ws + WS_WDN + l * SZ_WDN), T, D, FF}; pg8::StaticOrder S; S.init(T, D, G, bx);
            FILL_RSL((const float*)(ws + WS_ST1));
            pg8::FEpiRes E{(const LAS float*)(ldsl + RSL_OFF), a.in[9] + l * 1024, a.in[10] + l * 1024, (bf16_t*)(ws + WS_XB), (float*)(ws + WS_ST2)};
            pg8::gemm_phase<pg8::FEpiRes, pg8::StaticOrder, true, true>(ldsl + RING_OFF, g, S, E);
        } else if (kind == PH_FIN) {
            const float* g2 = a.in[14] + 1024; const float* b2v = a.in[15] + 1024; const float* ST2 = (const float*)(ws + WS_ST2); const bf16_t* XB = (const bf16_t*)(ws + WS_XB); float* Y2 = a.out;
            int tid_f = threadIdx.x; asm volatile("" : "+v"(tid_f)); const int lane = tid_f & 63, wave = __builtin_amdgcn_readfirstlane(tid_f >> 6);
            typedef float f32x4 __attribute__((ext_vector_type(4))); typedef unsigned u32x2 __attribute__((ext_vector_type(2)));
            f32x4 gg[4], bq[4];
#pragma unroll
            for (int j = 0; j < 4; ++j) { gg[j] = *((const f32x4*)g2 + lane + 64 * j); bq[j] = *((const f32x4*)b2v + lane + 64 * j); }
            for (int row = vcu * NWAVES + wave; row < T; row += G * NWAVES) { const RowStat rs = row_stat(ST2, row);
                const u32x2* xr = (const u32x2*)(XB + (size_t)row * 1024) + lane; f32x4* yr = (f32x4*)(Y2 + (size_t)row * 1024) + lane;
#pragma unroll
                for (int j = 0; j < 4; ++j) { const u32x2 w = xr[64 * j]; const f32x4 v = {__uint_as_float(w.x << 16), __uint_as_float(w.x & 0xffff0000u), __uint_as_float(w.y << 16), __uint_as_float(w.y & 0xffff0000u)};
                    yr[64 * j] = (v - rs.mu) * rs.rstd * gg[j] + bq[j]; } }
        }
        if (ph + 1 < a.ph_hi) { const bool local = grp_ok && (kind == PH_IN || kind == PH_ATT || kind == PH_MIXB || kind == PH_GU); if (local) xcd_barrier(gbar); else xcd_barrier(bar); }
    }
}

static void launch_frame(const MArgs& base, int lo, int hi, int grid, hipStream_t stream, int li = 0) {
    MArgs a = base; a.ph_lo = lo; a.ph_hi = hi; a.li = li;
    hipLaunchKernelGGL(mk_fwd, dim3(grid), dim3(NWAVES * 64), LDS_BYTES, stream, a);
}
extern "C" void kernel_launch(void* const* d_in, const int* in_sizes, int n_in, void* d_out, int out_size, void* d_ws, size_t ws_size, hipStream_t stream) {
    static int grid = 0;
    if (grid == 0) {
        if (n_in != 16 || in_sizes[0] != T * D || out_size != T * D || ws_size < WS_END) { fprintf(stderr, "kernel_launch: unexpected shapes (n_in %d, in0 %d, out %d, ws %zu)\n", n_in, n_in > 0 ? in_sizes[0] : -1, out_size, ws_size); grid = -1; return; }
        int dev = 0, cus = 0, per_cu = 0;
        if (hipGetDevice(&dev) != hipSuccess || hipDeviceGetAttribute(&cus, hipDeviceAttributeMultiprocessorCount, dev) != hipSuccess) { grid = -1; return; }
        if (hipFuncSetAttribute((const void*)mk_fwd, hipFuncAttributeMaxDynamicSharedMemorySize, LDS_BYTES) != hipSuccess) { fprintf(stderr, "kernel_launch: hipFuncSetAttribute failed\n"); grid = -1; return; }
        if (hipOccupancyMaxActiveBlocksPerMultiprocessor(&per_cu, (const void*)mk_fwd, NWAVES * 64, LDS_BYTES) != hipSuccess || per_cu < 1) { fprintf(stderr, "kernel_launch: occupancy query says %d workgroups per CU\n", per_cu); per_cu = 1; }
        (void)hipGetLastError();
        grid = cus;
        if (grid != 256) { fprintf(stderr, "kernel_launch: this kernel's work split is built for the 256 CUs of an MI355X, found %d; nothing launched\n", cus); grid = -1; return; }
    }
    if (grid < 0) return;
    const float* x = (const float*)d_in[0]; const float* w_in = (const float*)d_in[1]; const float* dlam = (const float*)d_in[2]; const float* dng = (const float*)d_in[3];
    const float* fw = (const float*)d_in[4]; const float* gw2 = (const float*)d_in[5]; const float* gb2 = (const float*)d_in[6]; const float* gng = (const float*)d_in[7];
    const float* w_out = (const float*)d_in[8]; const float* ln1g = (const float*)d_in[9]; const float* ln1b = (const float*)d_in[10];
    const float* wg = (const float*)d_in[11]; const float* wu = (const float*)d_in[12]; const float* wd = (const float*)d_in[13]; const float* ln2g = (const float*)d_in[14]; const float* ln2b = (const float*)d_in[15];
    char* ws = (char*)d_ws;
    float* ropec = (float*)(ws + V_ROPEC); float* ropes = (float*)(ws + V_ROPES); float* MF = (float*)(ws + V_MF);
    float* c1in = (float*)(ws + V_C1IN); float* c2in = (float*)(ws + V_C2IN); float* c1gu = (float*)(ws + V_C1GU); float* c2gu = (float*)(ws + V_C2GU);
    bf16_t* TAB = (bf16_t*)(ws + WS_TAB); bf16_t* XB = (bf16_t*)(ws + WS_XB);
    bf16_t* Q = (bf16_t*)(ws + WS_Q); bf16_t* K = (bf16_t*)(ws + WS_K); bf16_t* V = (bf16_t*)(ws + WS_V);
    bf16_t* GQK = (bf16_t*)(ws + WS_GQK); bf16_t* GV = (bf16_t*)(ws + WS_GV); bf16_t* GR = (bf16_t*)(ws + WS_GR); float* GL = (float*)(ws + WS_GL);
    bf16_t* OC = (bf16_t*)(ws + WS_OC); float* OF = (float*)(ws + WS_OF);
    (void)hipMemsetAsync(ws + WS_CTL, 0, CTL_ZERO_BYTES, stream);
    MArgs base{}; for (int i = 0; i < 16; ++i) base.in[i] = (const float*)d_in[i]; base.out = (float*)d_out; base.ws = (unsigned char*)d_ws;
    launch_frame(base, 0, N_PHASES, grid, stream, 0);
}
```

```cpp
#include <hip/hip_runtime.h>
#include <cstdint>
#include <cstdio>
#include <cmath>

typedef unsigned short bf16_t;
namespace cfg {
constexpr int B = 8, S = 2048, D = 1024, T = B * S, L = 2;
constexpr int INW = 2592, NIN = 3072, FF = 2816, NGU = 2 * FF;
constexpr float ALPHA = 1.41421356237309515f;
constexpr float EPS = 1e-5f;
constexpr float QSCALE = 0.125f * 1.4426950408889634f;
constexpr float GQSCALE = 0.17677669529663687f;
constexpr size_t MiB = 1u << 20;
constexpr size_t WS_CTL = 0;
constexpr size_t WS_VEC = 1 * MiB;
constexpr size_t V_ROPEC = WS_VEC, V_ROPES = WS_VEC + 256 * 1024, V_MF = WS_VEC + 512 * 1024;
constexpr size_t V_C1IN = WS_VEC + 768 * 1024, V_C2IN = V_C1IN + 24 * 1024, V_C1GU = V_C2IN + 24 * 1024, V_C2GU = V_C1GU + 44 * 1024;
constexpr size_t WS_WIN = 2 * MiB, WS_WOUT = 14 * MiB, WS_WGU = 18 * MiB, WS_WDN = 40 * MiB, WS_TAB = 51 * MiB;
constexpr size_t SZ_WIN = 6 * MiB, SZ_WOUT = 2 * MiB, SZ_WGU = 11 * MiB, SZ_WDN = 5632 * 1024;
constexpr size_t WS_XB = 67 * MiB;
constexpr size_t WS_Y1 = 99 * MiB, WS_Q = 99 * MiB, WS_K = 115 * MiB, WS_V = 131 * MiB, WS_XT = 147 * MiB;
constexpr size_t WS_ACT = 163 * MiB, WS_GQK = 163 * MiB, WS_GV = 171 * MiB, WS_GR = 179 * MiB, WS_GL = 187 * MiB, WS_OC = 203 * MiB, WS_OF = 235 * MiB;
constexpr size_t WSB_GQK = WS_ACT, WSB_GV = WS_ACT + 1 * MiB, WSB_GR = WS_ACT + 2 * MiB, WSB_GL = WS_ACT + 3 * MiB, WSB_OC = WS_ACT + 5 * MiB, WSB_OF = WS_ACT + 9 * MiB;
constexpr size_t DLT_GQK = 10 * MiB, DLT_GV = 10 * MiB, DLT_GR = 10 * MiB, DLT_GL = 9 * MiB, DLT_OC = 7 * MiB, DLT_OF = 9 * MiB;
constexpr size_t WS_ST1 = 251 * MiB, WS_ST2 = 253 * MiB, WS_DEC = 255 * MiB, WS_END = 256 * MiB;
}
using namespace cfg;

__device__ __forceinline__ float bf2f(bf16_t v) { return __uint_as_float((unsigned)v << 16); }
__device__ __forceinline__ bf16_t f2bf(float f) { unsigned u = __float_as_uint(f); return (bf16_t)((u + 0x7fffu + ((u >> 16) & 1u)) >> 16); }


template <int M> __device__ __forceinline__ float xadd(float v) {
    if constexpr (M == 32) { auto r = __builtin_amdgcn_permlane32_swap(__float_as_uint(v), __float_as_uint(v), false, false); return __uint_as_float(r[0]) + __uint_as_float(r[1]); }
    else return v + __int_as_float(__builtin_amdgcn_ds_swizzle(__float_as_int(v), (M << 10) | 0x1f));
}
struct RowStat { float mu, rstd; };
__device__ __forceinline__ RowStat row_stat(const float* ST, int row) {
    float s = 0.f, ss = 0.f;
    for (int i = 0; i < 8; ++i) { const float4 a = *(const float4*)(ST + (size_t)row * 32 + 4 * i); s += a.x + a.z; ss += a.y + a.w; }
    const float mu = s * (1.f / 1024.f); const float var = ss * (1.f / 1024.f) - mu * mu;
    RowStat r; r.mu = mu; r.rstd = rsqrtf(fmaxf(var, 0.f) + EPS); return r;
}
namespace pg8 {
#define PG8_LAS __attribute__((address_space(3)))
typedef unsigned short bf16_t;
typedef short bf16x8 __attribute__((ext_vector_type(8)));
typedef float f32x4 __attribute__((ext_vector_type(4)));
typedef unsigned u32x4 __attribute__((ext_vector_type(4)));
constexpr int BM = 256, BK = 64, HALF = 128, HTB = HALF * BK * 2  , STAGE_BYTES = 8 * HTB, NXCD = 8, WGM = 8;

__host__ __device__ __forceinline__ int lds_byte(int r, int c) { const int st = (r >> 4) * 2 + (c >> 5), rr = r & 15, cc = c & 31, ob = rr * 64 + cc * 2; return st * 1024 + (ob ^ (((ob >> 9) & 1) << 5)); }
__host__ __device__ __forceinline__ void stage_rc(int b, int& R, int& C) { const int st = b / 1024, sb = b % 1024, swz = sb ^ (((sb >> 9) & 1) << 5); R = (st >> 1) * 16 + swz / 64; C = (st & 1) * 32 + (swz % 64) / 2; }
__host__ __device__ __forceinline__ int perm32(int rho) { const int n = rho >> 4, i = rho & 15; return 8 * (i >> 2) + 4 * n + (i & 3); }

struct Unit { int pm, pn; };
struct Gemm { const bf16_t* A; const bf16_t* Bt; int M, N, K; };

struct StaticOrder {
    int nM, nN, nwg, G, c;
    __host__ __device__ void init(int M, int N, int G_, int c_) { nM = M / BM; nN = N / BM; nwg = nM * nN; G = G_; c = c_; }
    __host__ __device__ bool next(int i, Unit& u) const {
        const long L = (long)i * G + c; if (L >= nwg) return false;
        int wgid = (int)L; { const int q = nwg / NXCD, r = nwg % NXCD, xcd = wgid % NXCD, off = wgid / NXCD; wgid = (xcd < r ? xcd * (q + 1) : r * (q + 1) + (xcd - r) * q) + off; }
        const int nig = WGM * nN, gid = wgid / nig, fm = gid * WGM, gsz = (nM - fm) < WGM ? (nM - fm) : WGM;
        u.pm = fm + ((wgid % nig) % gsz); u.pn = (wgid % nig) / gsz; return true;
    }
    __device__ __forceinline__ void a_ready(const Unit&) const {}
    __device__ __forceinline__ void done(const Unit&) const {}
};
template <class Epi, class Sched, bool ALIGN_EPI = false, bool SP2 = false>
__device__ __forceinline__ void gemm_phase(PG8_LAS unsigned char* lds, const Gemm g, const Sched& S, const Epi& E) {
    int tid_o = threadIdx.x; asm volatile("" : "+v"(tid_o));
    const int tid = tid_o, wid = __builtin_amdgcn_readfirstlane(tid >> 6), lane = tid & 63, wr = wid >> 2, wc = wid & 3, fr = lane & 15, fq = lane >> 4;
    const int K = g.K, nt = K / BK;
    unsigned voffA[2], voffB[2];
#pragma unroll
    for (int i = 0; i < 2; ++i) { int R, C; stage_rc(tid * 16 + i * 8192, R, C); const int Rb = Epi::PERM ? ((R & ~31) + perm32(R & 31)) : R;
        voffA[i] = (unsigned)(R * K + C) * 2u; voffB[i] = (unsigned)(Rb * K + C) * 2u; }
    const size_t kstep = (size_t)(BK * 2);
    const size_t hstep = (size_t)HALF * K * 2;
    const size_t tstep = 2 * hstep;
    const unsigned ldsw = (unsigned)wid * 1024u;
    const int aoff = lds_byte(wr * 64 + fr, fq * 8), boff = lds_byte(wc * 32 + fr, fq * 8);
#define PG8_SA(b, h) (((b) * 2 + (h)) * HTB)
#define PG8_SB(b, h) ((4 + (b) * 2 + (h)) * HTB)
#define PG8_STAGE(bufoff, gbase, voff) do { _Pragma("unroll") for (int _i = 0; _i < 2; ++_i) \
        __builtin_amdgcn_global_load_lds((const unsigned*)((const char*)(gbase) + (voff)[_i]), (PG8_LAS unsigned*)(lds + (bufoff) + ldsw + _i * 8192), 16, 0, 0); } while (0)
#define PG8_LDA(dst, b, h) do { _Pragma("unroll") for (int m = 0; m < 4; ++m) _Pragma("unroll") for (int k = 0; k < 2; ++k) dst[m][k] = *(const PG8_LAS bf16x8*)(lds + PG8_SA(b, h) + aoff + m * 2048 + k * 1024); } while (0)
#define PG8_LDB(dst, b, h) do { _Pragma("unroll") for (int n = 0; n < 2; ++n) _Pragma("unroll") for (int k = 0; k < 2; ++k) dst[n][k] = *(const PG8_LAS bf16x8*)(lds + PG8_SB(b, h) + boff + n * 2048 + k * 1024); } while (0)
#define PG8_MMA(ai, bj, At, Bt) do { __builtin_amdgcn_s_setprio(1); _Pragma("unroll") for (int m = 0; m < 4; ++m) _Pragma("unroll") for (int n = 0; n < 2; ++n) _Pragma("unroll") for (int k = 0; k < 2; ++k) \
        acc[ai][bj][m][n] = __builtin_amdgcn_mfma_f32_16x16x32_bf16(Bt[n][k], At[m][k], acc[ai][bj][m][n], 0, 0, 0); __builtin_amdgcn_s_setprio(0); } while (0)
#define PG8_WAIT_V(n) asm volatile("s_waitcnt vmcnt(" #n ")" ::: "memory")
#define PG8_WAIT_L(n) asm volatile("s_waitcnt lgkmcnt(" #n ")" ::: "memory")
#define PG8_BAR __builtin_amdgcn_s_barrier()
#define PG8_SCHED __builtin_amdgcn_sched_barrier(0)
    Unit cur, nxt; int ui = 0;
    if (!S.next(0, cur)) return;
    f32x4 acc[2][2][4][2];
#pragma unroll
    for (int a = 0; a < 2; ++a)
#pragma unroll
        for (int b = 0; b < 2; ++b)
#pragma unroll
            for (int m = 0; m < 4; ++m)
#pragma unroll
                for (int n = 0; n < 2; ++n) acc[a][b][m][n] = (f32x4){0.f, 0.f, 0.f, 0.f};
    bf16x8 At[4][2], B0[2][2], B1[2][2];
    const char* cA = (const char*)g.A + (size_t)cur.pm * tstep; const char* cB = (const char*)g.Bt + (size_t)cur.pn * tstep;
    S.a_ready(cur);
    if constexpr (SP2) {
        PG8_STAGE(PG8_SB(0, 0), cB, voffB); PG8_STAGE(PG8_SB(0, 1), cB + hstep, voffB); PG8_STAGE(PG8_SA(0, 0), cA, voffA); PG8_STAGE(PG8_SA(0, 1), cA + hstep, voffA);
        if (wr == 1) PG8_BAR;
        PG8_WAIT_V(2); PG8_BAR;
        PG8_STAGE(PG8_SB(1, 0), cB + kstep, voffB); PG8_STAGE(PG8_SA(1, 0), cA + kstep, voffA); PG8_STAGE(PG8_SB(1, 1), cB + hstep + kstep, voffB);
        PG8_WAIT_V(6); PG8_BAR;
    } else {
        PG8_STAGE(PG8_SB(0, 0), cB, voffB); PG8_STAGE(PG8_SA(0, 0), cA, voffA); PG8_STAGE(PG8_SB(0, 1), cB + hstep, voffB); PG8_STAGE(PG8_SA(0, 1), cA + hstep, voffA);
        if (wr == 1) PG8_BAR;
        PG8_WAIT_V(4); PG8_BAR;
        PG8_STAGE(PG8_SB(1, 0), cB + kstep, voffB); PG8_STAGE(PG8_SA(1, 0), cA + kstep, voffA); PG8_STAGE(PG8_SB(1, 1), cB + hstep + kstep, voffB);
        PG8_WAIT_V(6); PG8_BAR;
    }
    for (;;) {
        const bool has_next = S.next(ui + 1, nxt);
        const char* nA = has_next ? (const char*)g.A + (size_t)nxt.pm * tstep : cA; const char* nB = has_next ? (const char*)g.Bt + (size_t)nxt.pn * tstep : cB;
        for (int t = 0; t < nt; t += 2) {
            const bool last = (t == nt - 2);
            const char* a1 = cA + (size_t)(t + 1) * kstep;
            const char* a2 = last ? nA : cA + (size_t)(t + 2) * kstep; const char* b2 = last ? nB : cB + (size_t)(t + 2) * kstep;
            const char* a3 = a2 + kstep; const char* b3 = b2 + kstep;
            if (last && has_next) S.a_ready(nxt);
            if constexpr (SP2) {
            PG8_LDB(B0, 0, 0); PG8_LDB(B1, 0, 1); PG8_SCHED; PG8_LDA(At, 0, 0); PG8_STAGE(PG8_SA(1, 1), a1 + hstep, voffA);
            PG8_WAIT_V(8); PG8_WAIT_L(0); PG8_BAR; PG8_MMA(0, 0, At, B0); PG8_MMA(0, 1, At, B1); PG8_BAR; PG8_SCHED;
            PG8_LDA(At, 0, 1); PG8_STAGE(PG8_SB(0, 0), b2, voffB); PG8_STAGE(PG8_SB(0, 1), b2 + hstep, voffB); PG8_STAGE(PG8_SA(0, 0), a2, voffA);
            PG8_WAIT_V(8); PG8_WAIT_L(0); PG8_BAR; PG8_MMA(1, 0, At, B0); PG8_MMA(1, 1, At, B1); PG8_BAR; PG8_SCHED;
            PG8_LDB(B0, 1, 0); PG8_LDB(B1, 1, 1); PG8_SCHED; PG8_LDA(At, 1, 0); PG8_STAGE(PG8_SA(0, 1), a2 + hstep, voffA);
            PG8_WAIT_V(8); PG8_WAIT_L(0); PG8_BAR; PG8_MMA(0, 0, At, B0); PG8_MMA(0, 1, At, B1); PG8_BAR; PG8_SCHED;
            PG8_LDA(At, 1, 1); PG8_STAGE(PG8_SB(1, 0), b3, voffB); PG8_STAGE(PG8_SB(1, 1), b3 + hstep, voffB); PG8_STAGE(PG8_SA(1, 0), a3, voffA);
            PG8_WAIT_V(8); PG8_WAIT_L(0); PG8_BAR; PG8_MMA(1, 0, At, B0); PG8_MMA(1, 1, At, B1); PG8_BAR; PG8_SCHED;
            } else {
            PG8_LDB(B0, 0, 0); PG8_SCHED; PG8_LDA(At, 0, 0); PG8_STAGE(PG8_SA(1, 1), a1 + hstep, voffA);
            PG8_WAIT_L(8); PG8_BAR; PG8_WAIT_L(0); PG8_MMA(0, 0, At, B0); PG8_BAR; PG8_SCHED;
            PG8_LDB(B1, 0, 1); PG8_STAGE(PG8_SB(0, 0), b2, voffB);
            PG8_BAR; PG8_WAIT_L(0); PG8_MMA(0, 1, At, B1); PG8_BAR;
            PG8_LDA(At, 0, 1); PG8_STAGE(PG8_SA(0, 0), a2, voffA);
            PG8_BAR; PG8_WAIT_L(0); PG8_MMA(1, 0, At, B0); PG8_BAR; PG8_SCHED;
            PG8_STAGE(PG8_SB(0, 1), b2 + hstep, voffB);
            PG8_WAIT_V(6); PG8_BAR; PG8_MMA(1, 1, At, B1); PG8_BAR;
            PG8_LDB(B0, 1, 0); PG8_SCHED; PG8_LDA(At, 1, 0); PG8_STAGE(PG8_SA(0, 1), a2 + hstep, voffA);
            PG8_WAIT_L(8); PG8_BAR; PG8_WAIT_L(0); PG8_MMA(0, 0, At, B0); PG8_BAR; PG8_SCHED;
            PG8_LDB(B1, 1, 1); PG8_STAGE(PG8_SB(1, 0), b3, voffB);
            PG8_BAR; PG8_WAIT_L(0); PG8_MMA(0, 1, At, B1); PG8_BAR;
            PG8_LDA(At, 1, 1); PG8_STAGE(PG8_SA(1, 0), a3, voffA);
            PG8_BAR; PG8_WAIT_L(0); PG8_MMA(1, 0, At, B0); PG8_BAR; PG8_SCHED;
            PG8_STAGE(PG8_SB(1, 1), b3 + hstep, voffB);
            PG8_WAIT_V(6); PG8_BAR; PG8_MMA(1, 1, At, B1); PG8_BAR;
            }
        }
        if constexpr (ALIGN_EPI) { if (wr == 0) PG8_BAR; }
        if constexpr (!Epi::AFTER_DRAIN) { E(acc, cur, wr, wc, fr, fq); S.done(cur); }
        if (!has_next) break;
#pragma unroll
        for (int a = 0; a < 2; ++a)
#pragma unroll
            for (int b = 0; b < 2; ++b)
#pragma unroll
                for (int m = 0; m < 4; ++m)
#pragma unroll
                    for (int n = 0; n < 2; ++n) acc[a][b][m][n] = (f32x4){0.f, 0.f, 0.f, 0.f};
        cur = nxt; cA = nA; cB = nB; ++ui;
        if constexpr (ALIGN_EPI) { if (wr == 1) PG8_BAR; }
    }
    PG8_WAIT_V(0);
    if constexpr (!ALIGN_EPI) { if (wr == 0) PG8_BAR; }
    PG8_BAR;
    if constexpr (Epi::AFTER_DRAIN) { E.fused(acc, cur, wr, wc, fr, fq, lds, wid, lane); S.done(cur); }
#undef PG8_SA
#undef PG8_SB
#undef PG8_STAGE
#undef PG8_LDA
#undef PG8_LDB
#undef PG8_MMA
#undef PG8_WAIT_V
#undef PG8_WAIT_L
#undef PG8_BAR
#undef PG8_SCHED
}
}
namespace pg8 {
__device__ __forceinline__ unsigned cvt_pk_bf16(float lo, float hi) { unsigned r; asm volatile("v_cvt_pk_bf16_f32 %0, %1, %2" : "=v"(r) : "v"(lo), "v"(hi)); return r; }
__device__ __forceinline__ void st8(bf16_t* p, const f32x4 a, const f32x4 b) { u32x4 w; w.x = cvt_pk_bf16(a[0], a[1]); w.y = cvt_pk_bf16(a[2], a[3]); w.z = cvt_pk_bf16(b[0], b[1]); w.w = cvt_pk_bf16(b[2], b[3]); *(u32x4*)p = w; }
__device__ __forceinline__ void st8nt(bf16_t* p, const f32x4 a, const f32x4 b) { u32x4 w; w.x = cvt_pk_bf16(a[0], a[1]); w.y = cvt_pk_bf16(a[2], a[3]); w.z = cvt_pk_bf16(b[0], b[1]); w.w = cvt_pk_bf16(b[2], b[3]); __builtin_nontemporal_store(w, (u32x4*)p); }
struct RS { float a, b; };
struct StatLd { f32x4 x, y; };
__device__ __forceinline__ StatLd stat_load(const float* ST, int row, int fq) { const f32x4* p = (const f32x4*)(ST + (size_t)row * 32 + fq * 8); StatLd r; r.x = p[0]; r.y = p[1]; return r; }
__device__ __forceinline__ RS stat_fin(const StatLd& t) {
    float s = (t.x[0] + t.x[2]) + (t.y[0] + t.y[2]), ss = (t.x[1] + t.x[3]) + (t.y[1] + t.y[3]);
    s = xadd<16>(s); ss = xadd<16>(ss); s = xadd<32>(s); ss = xadd<32>(ss);
    const float mu = s * (1.f / 1024.f), var = ss * (1.f / 1024.f) - mu * mu, rstd = rsqrtf(fmaxf(var, 0.f) + cfg::EPS);
    RS r; r.a = rstd; r.b = -rstd * mu; return r;
}
__device__ __forceinline__ RS row_stat16(const float* ST, int row, int fq) { return stat_fin(stat_load(ST, row, fq)); }
__device__ __forceinline__ float fsilu(float x) { return x * __builtin_amdgcn_rcpf(1.f + __expf(-x)); }
__device__ __forceinline__ float flogsig16(float x) { return (fminf(x, 0.f) - __logf(1.f + __expf(-fabsf(x)))) * (1.f / 16.f); }

struct FEpiIn {
    static constexpr bool PERM = true, AFTER_DRAIN = false;
    unsigned char* ws; const float* b2; int l; const PG8_LAS float* rsl;
    struct RowLd { f32x4 rc[2], rsn[2]; };
    template <int KIND> __device__ __forceinline__ RowLd load_row(int row, const float (&invf)[8]) const {
        RowLd r;
        if constexpr (KIND == 0) { const float pos = (float)(row & 2047);
#pragma unroll
            for (int e = 0; e < 8; ++e) { const float ang = pos * invf[e]; double rv = (double)ang * 0.15915494309189535; rv -= floor(rv); const float rev = (float)rv;
                r.rc[e >> 2][e & 3] = __builtin_amdgcn_cosf(rev); r.rsn[e >> 2][e & 3] = __builtin_amdgcn_sinf(rev); } }
        return r;
    }
    template <int KIND> __device__ __forceinline__ void rows(const f32x4 (&acc)[2][2][4][2], const Unit& u, int wr, int wc, int fr, int fq) const {
        const int pn = u.pn, cw = 32 * wc + 8 * fq, row0 = u.pm * BM + 64 * wr + fr;
        const bool st = l != 0;
        f32x4 k1[2][2], k2[2][2], bias[2][2];
        const float qs = __uint_as_float(__builtin_amdgcn_readfirstlane(__float_as_uint(pn < 2 ? cfg::QSCALE : 1.f)));
        float invf[8];
        if constexpr (KIND == 0) {
#pragma unroll
            for (int e = 0; e < 8; ++e) invf[e] = exp2f(-(float)(8 * fq + e) * (13.287712379549449f / 32.f)); }
        RowLd cur = load_row<KIND>(row0, invf), nxt;
        if (st) {
#pragma unroll
            for (int bj = 0; bj < 2; ++bj)
#pragma unroll
                for (int n = 0; n < 2; ++n) {
                    if constexpr (KIND == 2) {
                        const float* fp = (const float*)(ws + cfg::V_MF) + (size_t)(l * 8) * 512 + (pn - 6) * 256 + cw + 128 * bj + 4 * n;
                        k1[bj][n] = (*(const f32x4*)fp + *(const f32x4*)(fp + 1024)) + (*(const f32x4*)(fp + 2048) + *(const f32x4*)(fp + 3072));
                        k2[bj][n] = (*(const f32x4*)(fp + 512) + *(const f32x4*)(fp + 1536)) + (*(const f32x4*)(fp + 2560) + *(const f32x4*)(fp + 3584));
                    } else { const float* c1 = (const float*)(ws + cfg::V_C1IN) + l * cfg::NIN + pn * 256 + cw; const float* c2 = (const float*)(ws + cfg::V_C2IN) + l * cfg::NIN + pn * 256 + cw;
                        k1[bj][n] = *(const f32x4*)(c1 + 128 * bj + 4 * n); k2[bj][n] = *(const f32x4*)(c2 + 128 * bj + 4 * n); } } }
        if constexpr (KIND == 6) {
#pragma unroll
            for (int bj = 0; bj < 2; ++bj)
#pragma unroll
                for (int n = 0; n < 2; ++n) bias[bj][n] = *(const f32x4*)(b2 + 128 * bj + cw + 4 * n); }
#pragma unroll
        for (int i = 0; i < 8; ++i) {
            const int ai = i >> 2, m = i & 3, row = row0 + 128 * ai + 16 * m, pos = row & 2047;
            if (i < 7) nxt = load_row<KIND>(row0 + 128 * ((i + 1) >> 2) + 16 * ((i + 1) & 3), invf);
            f32x4 v[2][2];
            if (st) { typedef float f32x2 __attribute__((ext_vector_type(2))); const f32x2 t2 = *(const PG8_LAS f32x2*)(rsl + 2 * (128 * ai + 64 * wr + 16 * m + fr)); RS rs; rs.a = t2[0]; rs.b = t2[1];
#pragma unroll
                for (int bj = 0; bj < 2; ++bj)
#pragma unroll
                    for (int n = 0; n < 2; ++n) v[bj][n] = rs.a * acc[ai][bj][m][n] + (rs.b * k1[bj][n] + k2[bj][n]);
            } else {
#pragma unroll
                for (int bj = 0; bj < 2; ++bj)
#pragma unroll
                    for (int n = 0; n < 2; ++n) v[bj][n] = acc[ai][bj][m][n]; }
            if constexpr (KIND == 0) {
                f32x4 a0 = v[0][0] * cur.rc[0] - v[1][0] * cur.rsn[0], a1 = v[0][1] * cur.rc[1] - v[1][1] * cur.rsn[1];
                f32x4 b0 = v[1][0] * cur.rc[0] + v[0][0] * cur.rsn[0], b1 = v[1][1] * cur.rc[1] + v[0][1] * cur.rsn[1];
                a0 = a0 * qs; a1 = a1 * qs; b0 = b0 * qs; b1 = b1 * qs;
                bf16_t* dst = (bf16_t*)(ws + (pn < 2 ? cfg::WS_Q : cfg::WS_K)) + (size_t)row * 512 + (4 * (pn & 1) + wc) * 64 + 8 * fq;
                st8(dst, a0, a1); st8(dst + 32, b0, b1);
            } else if constexpr (KIND == 1) {
                bf16_t* dst = (bf16_t*)(ws + cfg::WS_V) + (size_t)row * 512 + (pn - 4) * 256 + cw; st8(dst, v[0][0], v[0][1]); st8(dst + 128, v[1][0], v[1][1]);
            } else if constexpr (KIND == 2) {
                bf16_t* dst = (bf16_t*)(ws + cfg::WS_TAB) + (size_t)row * 512 + (pn - 6) * 256 + cw; st8(dst, v[0][0], v[0][1]); st8(dst + 128, v[1][0], v[1][1]);
            } else if constexpr (KIND == 3) {
                bf16_t* dst = (bf16_t*)(ws + cfg::WSB_GQK + (size_t)(u.pm >> 3) * cfg::DLT_GQK) + (size_t)row * 256 + cw; st8(dst, v[0][0] * cfg::GQSCALE, v[0][1] * cfg::GQSCALE); st8(dst + 128, v[1][0], v[1][1]);
            } else if constexpr (KIND == 4) {
                bf16_t* dst = (bf16_t*)(ws + cfg::WSB_GV + (size_t)(u.pm >> 3) * cfg::DLT_GV) + (size_t)row * 256 + cw; st8(dst, v[0][0], v[0][1]); st8(dst + 128, v[1][0], v[1][1]);
            } else if constexpr (KIND == 5) {
                bf16_t* dst = (bf16_t*)(ws + cfg::WSB_GR + (size_t)(u.pm >> 3) * cfg::DLT_GR) + (size_t)row * 256 + cw;
#pragma unroll
                for (int bj = 0; bj < 2; ++bj) { f32x4 x0 = v[bj][0], x1 = v[bj][1];
#pragma unroll
                    for (int e = 0; e < 4; ++e) { x0[e] = fsilu(x0[e]); x1[e] = fsilu(x1[e]); } st8(dst + 128 * bj, x0, x1); }
            } else {
                float* dst = (float*)(ws + cfg::WSB_GL + (size_t)(u.pm >> 3) * cfg::DLT_GL) + (size_t)row * 256 + cw;
#pragma unroll
                for (int bj = 0; bj < 2; ++bj)
#pragma unroll
                    for (int n = 0; n < 2; ++n) { f32x4 x = v[bj][n] + bias[bj][n];
#pragma unroll
                        for (int e = 0; e < 4; ++e) x[e] = flogsig16(x[e]); *(f32x4*)(dst + 128 * bj + 4 * n) = x; }
            }
            if (i < 7) cur = nxt;
        }
    }
    __device__ __forceinline__ void operator()(const f32x4 (&acc)[2][2][4][2], const Unit& u, int wr, int wc, int fr, int fq) const {
        asm volatile("" : "+v"(fr), "+v"(fq));
        unsigned zo = 0u; asm volatile("" : "+s"(zo)); FEpiIn me = *this; me.ws = ws + zo;
        const int pn = u.pn;
        if (pn < 4) me.rows<0>(acc, u, wr, wc, fr, fq); else if (pn < 6) me.rows<1>(acc, u, wr, wc, fr, fq); else if (pn < 8) me.rows<2>(acc, u, wr, wc, fr, fq);
        else if (pn == 8) me.rows<3>(acc, u, wr, wc, fr, fq); else if (pn == 9) me.rows<4>(acc, u, wr, wc, fr, fq); else if (pn == 10) me.rows<5>(acc, u, wr, wc, fr, fq); else me.rows<6>(acc, u, wr, wc, fr, fq);
    }
};
struct FEpiRes {
    static constexpr bool PERM = true, AFTER_DRAIN = false;
    const PG8_LAS float* stprev;
    const float* g; const float* bb; bf16_t* XB; float* ST;
    struct RowLd { u32x4 xb[2]; };
    __device__ __forceinline__ RowLd load_row(int row, int col0, int fq) const {
        RowLd r; const size_t off = (size_t)row * 1024 + col0;
        r.xb[0] = *(const u32x4*)(XB + off); r.xb[1] = *(const u32x4*)(XB + off + 128);
        return r;
    }
    __device__ __forceinline__ void operator()(const f32x4 (&acc)[2][2][4][2], const Unit& u, int wr, int wc, int fr, int fq) const {
        asm volatile("" : "+v"(fr), "+v"(fq));
        const int col0 = u.pn * BM + 32 * wc + 8 * fq, row0 = u.pm * BM + 64 * wr + fr;
        f32x4 gv[2][2], bv[2][2];
        RowLd cur = load_row(row0, col0, fq), nxt;
        if (stprev) {
#pragma unroll
            for (int bj = 0; bj < 2; ++bj)
#pragma unroll
                for (int n = 0; n < 2; ++n) { gv[bj][n] = *(const f32x4*)(g + col0 + 128 * bj + 4 * n); bv[bj][n] = *(const f32x4*)(bb + col0 + 128 * bj + 4 * n); } }
#pragma unroll
        for (int i = 0; i < 8; ++i) { const int ai = i >> 2, m = i & 3, row = row0 + 128 * ai + 16 * m; const size_t off = (size_t)row * 1024 + col0;
            if (i < 7) nxt = load_row(row0 + 128 * ((i + 1) >> 2) + 16 * ((i + 1) & 3), col0, fq);
            RS rs; rs.a = 1.f; rs.b = 0.f; if (stprev) { typedef float f32x2 __attribute__((ext_vector_type(2))); const f32x2 t2 = *(const PG8_LAS f32x2*)(stprev + 2 * (128 * ai + 64 * wr + 16 * m + fr)); rs.a = t2[0]; rs.b = t2[1]; }
            float s = 0.f, ss = 0.f;
#pragma unroll
            for (int bj = 0; bj < 2; ++bj) { f32x4 y[2];
#pragma unroll
                for (int n = 0; n < 2; ++n) { const unsigned w0 = cur.xb[bj][2 * n], w1 = cur.xb[bj][2 * n + 1];
                    f32x4 x = (f32x4){__uint_as_float(w0 << 16), __uint_as_float(w0 & 0xffff0000u), __uint_as_float(w1 << 16), __uint_as_float(w1 & 0xffff0000u)};
                    if (stprev) x = (rs.a * x + rs.b) * gv[bj][n] + bv[bj][n];
                    y[n] = cfg::ALPHA * x + acc[ai][bj][m][n];
                    s += (y[n][0] + y[n][1]) + (y[n][2] + y[n][3]); ss += (y[n][0] * y[n][0] + y[n][1] * y[n][1]) + (y[n][2] * y[n][2] + y[n][3] * y[n][3]); }
                st8nt(XB + off + 128 * bj, y[0], y[1]); }
            s = xadd<16>(s); ss = xadd<16>(ss); s = xadd<32>(s); ss = xadd<32>(ss);
            if (fq == 0) { typedef float f32x2 __attribute__((ext_vector_type(2))); *(f32x2*)(ST + (size_t)row * 32 + (u.pn * 4 + wc) * 2) = (f32x2){s, ss}; }
            if (i < 7) cur = nxt; }
    }
};
struct FEpiGU {
    static constexpr bool PERM = true, AFTER_DRAIN = false;
    const PG8_LAS float* rsl;
    const float* c1; const float* c2; bf16_t* ACT;
    __device__ __forceinline__ void operator()(const f32x4 (&acc)[2][2][4][2], const Unit& u, int wr, int wc, int fr, int fq) const {
        asm volatile("" : "+v"(fr), "+v"(fq));
        const int cw = 32 * wc + 8 * fq, row0 = u.pm * BM + 64 * wr + fr; const float* c1p = c1 + u.pn * 256 + cw; const float* c2p = c2 + u.pn * 256 + cw;
        typedef float f32x2 __attribute__((ext_vector_type(2)));
        f32x4 k1[2][2], k2[2][2];
#pragma unroll
        for (int bj = 0; bj < 2; ++bj)
#pragma unroll
            for (int n = 0; n < 2; ++n) { k1[bj][n] = *(const f32x4*)(c1p + 128 * bj + 4 * n); k2[bj][n] = *(const f32x4*)(c2p + 128 * bj + 4 * n); }
#pragma unroll
        for (int i = 0; i < 8; ++i) { const int ai = i >> 2, m = i & 3; const f32x2 rs = *(const PG8_LAS f32x2*)(rsl + 2 * (128 * ai + 64 * wr + 16 * m + fr)); f32x4 a[2];
#pragma unroll
            for (int n = 0; n < 2; ++n) { const f32x4 hg = rs[0] * acc[ai][0][m][n] + (rs[1] * k1[0][n] + k2[0][n]), hu = rs[0] * acc[ai][1][m][n] + (rs[1] * k1[1][n] + k2[1][n]);
#pragma unroll
                for (int e = 0; e < 4; ++e) a[n][e] = fsilu(hg[e]) * hu[e]; }
            st8nt(ACT + (size_t)(row0 + 128 * ai + 16 * m) * cfg::FF + 128 * u.pn + cw, a[0], a[1]); }
    }
};
struct FEpiFour {
    static constexpr bool PERM = true, AFTER_DRAIN = false;
    bf16_t* OC;
    __device__ __forceinline__ void operator()(const f32x4 (&acc)[2][2][4][2], const Unit& u, int wr, int wc, int fr, int fq) const {
        asm volatile("" : "+v"(fr), "+v"(fq));
        const int cw = 32 * wc + 8 * fq;
#pragma unroll
        for (int ai = 0; ai < 2; ++ai)
#pragma unroll
            for (int m = 0; m < 4; ++m) { const int row = u.pm * BM + 128 * ai + 64 * wr + 16 * m + fr; bf16_t* dst = OC + (size_t)(u.pn * 2048 + row) * 1024 + 512 + cw;
                st8(dst, acc[ai][0][m][0], acc[ai][0][m][1]); st8(dst + 128, acc[ai][1][m][0], acc[ai][1][m][1]); }
    }
};
}
namespace att {
using bf16x8 = __attribute__((ext_vector_type(8))) short;
using s16x4  = __attribute__((ext_vector_type(4))) short;
using f32x16 = __attribute__((ext_vector_type(16))) float;
using u32x4  = __attribute__((ext_vector_type(4))) unsigned;
constexpr int NW = 8, QBLK = 32, KVBLK = 64, LD = 512, NT = cfg::S / KVBLK;
constexpr int SHM_V = KVBLK * 128 * 2, SHM_K = KVBLK * 128 * 2, SHM_X = 2 * SHM_V + 2 * SHM_K, SHM_ATTN = SHM_X + NW * 64 * 4;
constexpr float THRL = 6.0f;
#define ATT_KSWZ(row, colB) ((row) * 256 + ((colB) ^ (((row) & 7) << 4)))
#define ATT_SBAR() __builtin_amdgcn_sched_barrier(0)
__device__ __forceinline__ int crow(int r, int hi) { return (r & 3) + 8 * (r >> 2) + 4 * hi; }
__device__ __forceinline__ unsigned cvtpk(float lo, float hi) { unsigned r; asm volatile("v_cvt_pk_bf16_f32 %0, %1, %2" : "=v"(r) : "v"(lo), "v"(hi)); return r; }
__device__ __forceinline__ void softmaxP(f32x16& p0, f32x16& p1, float& m_reg, f32x16& negm, float& alpha, bool first, bf16x8& pa0, bf16x8& pa1, bf16x8& pa2, bf16x8& pa3) {
#define ATT_M3(a, b, c) fmaxf(fmaxf(a, b), c)
  const float t0 = ATT_M3(p0[0], p0[1], p0[2]), t1 = ATT_M3(p0[3], p0[4], p0[5]), t2 = ATT_M3(p0[6], p0[7], p0[8]), t3 = ATT_M3(p0[9], p0[10], p0[11]), t4 = ATT_M3(p0[12], p0[13], p0[14]);
  const float t5 = ATT_M3(p0[15], p1[0], p1[1]), t6 = ATT_M3(p1[2], p1[3], p1[4]), t7 = ATT_M3(p1[5], p1[6], p1[7]), t8 = ATT_M3(p1[8], p1[9], p1[10]), t9 = ATT_M3(p1[11], p1[12], p1[13]);
  const float u0 = ATT_M3(t0, t1, t2), u1 = ATT_M3(t3, t4, t5), u2 = ATT_M3(t6, t7, t8), u3 = ATT_M3(t9, p1[14], p1[15]);
  float pmax = fmaxf(fmaxf(u0, u1), fmaxf(u2, u3));
#undef ATT_M3
  { auto rr = __builtin_amdgcn_permlane32_swap(__float_as_uint(pmax), __float_as_uint(pmax), false, false); pmax = fmaxf(__uint_as_float(rr[0]), __uint_as_float(rr[1])); }
  const float thr = first ? -3.0e38f : THRL;
  if (__builtin_expect(__all(pmax <= thr), 1)) { alpha = 1.f; }
  else { const float dl = first ? pmax : fmaxf(pmax, 0.f); alpha = first ? 0.f : __builtin_amdgcn_exp2f(-dl); m_reg += dl;
#pragma unroll
    for (int r = 0; r < 16; ++r) { p0[r] -= dl; p1[r] -= dl; negm[r] -= dl; } }
#pragma unroll
  for (int r = 0; r < 16; ++r) p0[r] = __builtin_amdgcn_exp2f(p0[r]);
#pragma unroll
  for (int r = 0; r < 16; ++r) p1[r] = __builtin_amdgcn_exp2f(p1[r]);
#define ATT_PK4(P, BASE, OUT) do { u32x4 w = {cvtpk(P[BASE + 0], P[BASE + 1]), cvtpk(P[BASE + 2], P[BASE + 3]), cvtpk(P[BASE + 4], P[BASE + 5]), cvtpk(P[BASE + 6], P[BASE + 7])}; \
    OUT = *reinterpret_cast<bf16x8*>(&w); } while (0)
  ATT_PK4(p0, 0, pa0); ATT_PK4(p0, 8, pa1); ATT_PK4(p1, 0, pa2); ATT_PK4(p1, 8, pa3);
#undef ATT_PK4
}
template <int OFF> __device__ __forceinline__ bf16x8 k_read(int ka) { bf16x8 r; asm volatile("ds_read_b128 %0, %1 offset:%2" : "=&v"(r) : "v"(ka), "i"(OFF) : "memory"); return r; }
template <int KB> __device__ __forceinline__ void k_load2(bf16x8* kf, int ka0, int ka1) {
  kf[0] = k_read<KB * SHM_K>(ka0); kf[1] = k_read<KB * SHM_K + 8192>(ka0); kf[2] = k_read<KB * SHM_K>(ka1); kf[3] = k_read<KB * SHM_K + 8192>(ka1);
}
__device__ __forceinline__ void qk_mma2(f32x16& p0, f32x16& p1, const bf16x8* kf, bf16x8 q0, bf16x8 q1) {
  p0 = __builtin_amdgcn_mfma_f32_32x32x16_bf16(kf[0], q0, p0, 0, 0, 0); p1 = __builtin_amdgcn_mfma_f32_32x32x16_bf16(kf[1], q0, p1, 0, 0, 0);
  p0 = __builtin_amdgcn_mfma_f32_32x32x16_bf16(kf[2], q1, p0, 0, 0, 0); p1 = __builtin_amdgcn_mfma_f32_32x32x16_bf16(kf[3], q1, p1, 0, 0, 0);
}
__device__ __forceinline__ int v_st(int k, int c) { return ((k >> 3) * 4 + (c >> 5)) * 512 + ((k & 7) * 32 + (c & 31)) * 2; }
__device__ __forceinline__ int v_rd_base(int lane) { return ((lane & 3) << 3) | (((lane >> 2) & 3) << 6) | (((lane >> 4) & 1) << 5) | (((lane >> 5) & 1) << 8); }
constexpr int v_rd_off(int d0, int ks, int half) { return d0 * 512 + ks * 4096 + half * 2048; }
template <int OFF> __device__ __forceinline__ s16x4 tr_read(int vb) { s16x4 r; asm volatile("ds_read_b64_tr_b16 %0, %1 offset:%2" : "=&v"(r) : "v"(vb), "i"(OFF) : "memory"); return r; }
struct VF { s16x4 l[4], h[4]; };
template <int KS> __device__ __forceinline__ void vf_load(VF& f, int vb) {
  f.l[0] = tr_read<v_rd_off(0, KS, 0)>(vb); f.h[0] = tr_read<v_rd_off(0, KS, 1)>(vb); f.l[1] = tr_read<v_rd_off(1, KS, 0)>(vb); f.h[1] = tr_read<v_rd_off(1, KS, 1)>(vb);
  f.l[2] = tr_read<v_rd_off(2, KS, 0)>(vb); f.h[2] = tr_read<v_rd_off(2, KS, 1)>(vb); f.l[3] = tr_read<v_rd_off(3, KS, 0)>(vb); f.h[3] = tr_read<v_rd_off(3, KS, 1)>(vb);
}
__device__ __forceinline__ void pv_step(f32x16* o, bf16x8 pa, const VF& f) {
#define ATT_PK(L, H) (bf16x8){L[0], L[1], L[2], L[3], H[0], H[1], H[2], H[3]}
  o[0] = __builtin_amdgcn_mfma_f32_32x32x16_bf16(pa, ATT_PK(f.l[0], f.h[0]), o[0], 0, 0, 0);
  o[1] = __builtin_amdgcn_mfma_f32_32x32x16_bf16(pa, ATT_PK(f.l[1], f.h[1]), o[1], 0, 0, 0);
  o[2] = __builtin_amdgcn_mfma_f32_32x32x16_bf16(pa, ATT_PK(f.l[2], f.h[2]), o[2], 0, 0, 0);
  o[3] = __builtin_amdgcn_mfma_f32_32x32x16_bf16(pa, ATT_PK(f.l[3], f.h[3]), o[3], 0, 0, 0);
#undef ATT_PK
}
#define ATT_LWAIT(n) do { asm volatile("s_waitcnt lgkmcnt(" #n ")" ::: "memory"); ATT_SBAR(); } while (0)
template <int MP> __device__ __forceinline__ void att_give(const f32x16* o, float* Xw, int r32, int hi) {
  constexpr int RG = MP ? 0 : 8;
#pragma unroll
  for (int rr = 0; rr < 8; ++rr)
#pragma unroll
    for (int d0 = 0; d0 < 4; ++d0) Xw[(crow(RG + rr, hi) & 15) * 128 + d0 * 32 + r32] = o[d0][RG + rr];
}
template <int MP> __device__ __forceinline__ void att_fin(const f32x16* o, const float* Xr, float lam, const float (&gq)[4], bf16_t* OCw, int r32, int hi, int lane) {
  constexpr int RK = MP ? 8 : 0;
  unsigned pk[8][4];
#pragma unroll
  for (int rr = 0; rr < 8; ++rr) { const int lr = crow(RK + rr, hi) & 15;
    float df[4], ssq = 0.f;
#pragma unroll
    for (int d0 = 0; d0 < 4; ++d0) { const float x = Xr[lr * 128 + d0 * 32 + r32]; df[d0] = MP ? x - lam * o[d0][RK + rr] : o[d0][RK + rr] - lam * x; ssq += df[d0] * df[d0]; }
    ssq = xadd<1>(ssq); ssq = xadd<2>(ssq); ssq = xadd<4>(ssq); ssq = xadd<8>(ssq); ssq = xadd<16>(ssq);
    const float rn = rsqrtf(ssq * (1.f / 128.f) + cfg::EPS);
#pragma unroll
    for (int d0 = 0; d0 < 4; ++d0) pk[rr][d0] = cvtpk(df[d0] * rn * gq[d0], 0.f); }
  char* stg = (char*)Xr;
#pragma unroll
  for (int rr = 0; rr < 8; ++rr) { const int lr = crow(RK + rr, hi) & 15;
#pragma unroll
    for (int d0 = 0; d0 < 4; ++d0) *(unsigned short*)(stg + lr * 272 + (d0 * 32 + r32) * 2) = (unsigned short)pk[rr][d0]; }
#pragma unroll
  for (int i = 0; i < 4; ++i) { const int c = lane + 64 * i, row = c >> 4, cc = c & 15;
    const u32x4 v = *(const u32x4*)(stg + row * 272 + cc * 16); *(u32x4*)(OCw + (size_t)row * 1024 + cc * 8) = v; }
}
__device__ __forceinline__ void attn_unit(int b, int h, int qb, const bf16_t* __restrict__ Qg, const bf16_t* __restrict__ Kg, const bf16_t* __restrict__ Vg, bf16_t* __restrict__ OC,
                                          const float* __restrict__ lamp, const float* __restrict__ dgv, int layer, char* lds) {
  int tid_o = threadIdx.x; asm volatile("" : "+v"(tid_o));
  const int tid = tid_o, wid = __builtin_amdgcn_readfirstlane(tid >> 6), lane = tid & 63, r32 = lane & 31, hi = lane >> 5, mp = wid >> 2, wl = wid & 3, mofs = mp * 64;
  char* V_lds = lds; char* K_lds = lds + 2 * SHM_V;
  float* ws = (float*)(lds + SHM_X) + wid * 64; float* al_l = ws + 32;
  float m_reg = 0.f; f32x16 o[4] = {}, ol = {}, negm = {}; bf16x8 qr[4];
  const int q0 = qb * 128 + wl * QBLK;
  const bf16_t* Qw = Qg + (size_t)(b * cfg::S + q0 + r32) * LD + h * 128 + mofs + hi * 8;
#pragma unroll
  for (int d0 = 0; d0 < 4; ++d0) qr[d0] = *reinterpret_cast<const bf16x8*>(Qw + d0 * 16);
  const bf16_t* Kh = Kg + (size_t)b * cfg::S * LD + h * 128; const bf16_t* Vh = Vg + (size_t)b * cfg::S * LD + h * 128;
  const int vb0 = (int)(uintptr_t)V_lds + v_rd_base(lane);
  const int ka0 = (int)(uintptr_t)K_lds + ATT_KSWZ(r32, (mofs + hi * 8) * 2);
  const bf16x8 ones = {0x3F80, 0x3F80, 0x3F80, 0x3F80, 0x3F80, 0x3F80, 0x3F80, 0x3F80};
  const int gt = tid & 255, gr = gt >> 4, gc = (gt & 15) * 8;
  const bf16_t* gsrc = (mp ? Kh : Vh) + (size_t)gr * LD + gc;
  char* gdst = mp ? K_lds + ATT_KSWZ(gr, gc * 2) : V_lds + v_st(gr, gc);
  const int tofs = mp ? 2 : 0;
  bf16x8 st_[2][4];
#define ATT_GLOAD(i, t) do { const int t_ = (t) < NT ? (t) : NT - 1;     \
    _Pragma("unroll") for (int q_ = 0; q_ < 4; ++q_) st_[i][q_] = *reinterpret_cast<const bf16x8*>(gsrc + (size_t)(t_ * 64 + 16 * q_) * LD); } while (0)
#define ATT_GWRITE(i, t) do { asm volatile("s_waitcnt vmcnt(4)" ::: "memory"); if ((t) < NT) { \
    _Pragma("unroll") for (int q_ = 0; q_ < 4; ++q_) *(bf16x8*)(gdst + (i) * 16384 + q_ * 4096) = st_[i][q_]; } } while (0)
#define ATT_RESC(a) do { if (__any((a) < 1.f)) { if (hi == 0) al_l[r32] = (a); asm volatile("s_waitcnt lgkmcnt(0)" ::: "memory"); \
    _Pragma("unroll") for (int r = 0; r < 16; ++r) { const float a_ = al_l[crow(r, hi)]; ol[r] *= a_; _Pragma("unroll") for (int d = 0; d < 4; ++d) o[d][r] *= a_; } } } while (0)
  f32x16 s0, s1; float al; bf16x8 pa0, pa1, pa2, pa3, kf[8]; VF f0, f1;
#define ATT_VSEG(I, p) do { ATT_GWRITE(I, (p) + tofs); ATT_GLOAD(I, (p) + tofs + 2); ATT_SBAR(); \
    softmaxP(s0, s1, m_reg, negm, al, (p) == 0, pa0, pa1, pa2, pa3); ATT_RESC(al); } while (0)
#define ATT_OL(pa) ol = __builtin_amdgcn_mfma_f32_32x32x16_bf16(pa, ones, ol, 0, 0, 0)
#define ATT_QK(KB) do { k_load2<KB>(kf, ka0, ka0 ^ 32); k_load2<KB>(kf + 4, ka0 ^ 64, ka0 ^ 96); ATT_LWAIT(4); s0 = negm; s1 = negm; qk_mma2(s0, s1, kf, qr[0], qr[1]); ATT_LWAIT(0); qk_mma2(s0, s1, kf + 4, qr[2], qr[3]); ATT_SBAR(); } while (0)
#define ATT_MSEG(VB, KB, QK) do { vf_load<0>(f0, vb0 + (VB) * SHM_V); vf_load<1>(f1, vb0 + (VB) * SHM_V); ATT_SBAR(); \
    ATT_LWAIT(8); pv_step(o, pa0, f0); ATT_OL(pa0); vf_load<2>(f0, vb0 + (VB) * SHM_V); \
    ATT_LWAIT(8); pv_step(o, pa1, f1); ATT_OL(pa1); vf_load<3>(f1, vb0 + (VB) * SHM_V); \
    if constexpr (QK) { k_load2<KB>(kf, ka0, ka0 ^ 32); ATT_LWAIT(12); } else ATT_LWAIT(8); \
    pv_step(o, pa2, f0); ATT_OL(pa2); \
    if constexpr (QK) ATT_LWAIT(4); else ATT_LWAIT(0); \
    pv_step(o, pa3, f1); ATT_OL(pa3); \
    if constexpr (QK) { k_load2<KB>(kf + 4, ka0 ^ 64, ka0 ^ 96); ATT_LWAIT(4); s0 = negm; s1 = negm; qk_mma2(s0, s1, kf, qr[0], qr[1]); ATT_LWAIT(0); qk_mma2(s0, s1, kf + 4, qr[2], qr[3]); } ATT_SBAR(); } while (0)
  { const int kr = tid >> 4, kc = (tid & 15) * 8;
    const bf16x8 k0 = *reinterpret_cast<const bf16x8*>(&Kh[(size_t)kr * LD + kc]), k1 = *reinterpret_cast<const bf16x8*>(&Kh[(size_t)(32 + kr) * LD + kc]);
    const bf16x8 k2 = *reinterpret_cast<const bf16x8*>(&Kh[(size_t)(64 + kr) * LD + kc]), k3 = *reinterpret_cast<const bf16x8*>(&Kh[(size_t)(96 + kr) * LD + kc]);
    ATT_GLOAD(0, tofs); ATT_GLOAD(1, tofs + 1);
    asm volatile("s_waitcnt vmcnt(8)" ::: "memory");
    *(bf16x8*)(K_lds + ATT_KSWZ(kr, kc * 2)) = k0; *(bf16x8*)(K_lds + ATT_KSWZ(32 + kr, kc * 2)) = k1;
    *(bf16x8*)(K_lds + SHM_K + ATT_KSWZ(kr, kc * 2)) = k2; *(bf16x8*)(K_lds + SHM_K + ATT_KSWZ(32 + kr, kc * 2)) = k3; }
  __syncthreads();
  if (mp) __syncthreads();
  ATT_QK(0); __syncthreads();
  for (int p = 0; p + 2 < NT; p += 2) {
    ATT_VSEG(0, p);           __syncthreads();
    ATT_MSEG(0, 1, true);     __syncthreads();
    ATT_VSEG(1, p + 1);       __syncthreads();
    ATT_MSEG(1, 0, true);     __syncthreads();
  }
  ATT_VSEG(0, NT - 2);   __syncthreads();
  ATT_MSEG(0, 1, true);   __syncthreads();
  ATT_VSEG(1, NT - 1);   __syncthreads();
  ATT_MSEG(1, 0, false);  __syncthreads();
  if (!mp) __syncthreads();
#pragma unroll
  for (int r = 0; r < 16; ++r) { const float rl = __builtin_amdgcn_rcpf(ol[r]);
#pragma unroll
    for (int d0 = 0; d0 < 4; ++d0) o[d0][r] *= rl; }
  __syncthreads();
  float* X = (float*)lds;
  const float* Xr = X + wid * 2048; float* Xw = X + (wid ^ 4) * 2048;
  int layer_o = __builtin_amdgcn_readfirstlane(layer); asm volatile("" : "+s"(layer_o)); const float lam_init = layer_o == 0 ? 0.2f : 0.35550906759f;
  if (mp == 0) att_give<0>(o, Xw, r32, hi); else att_give<1>(o, Xw, r32, hi);
  float lam; { float s1 = lamp[lane] * lamp[64 + lane], s2 = lamp[128 + lane] * lamp[192 + lane];
    s1 = xadd<1>(s1); s2 = xadd<1>(s2); s1 = xadd<2>(s1); s2 = xadd<2>(s2); s1 = xadd<4>(s1); s2 = xadd<4>(s2); s1 = xadd<8>(s1); s2 = xadd<8>(s2); s1 = xadd<16>(s1); s2 = xadd<16>(s2); s1 = xadd<32>(s1); s2 = xadd<32>(s2);
    lam = __expf(s1) - __expf(s2) + lam_init; }
  float gq[4];
#pragma unroll
  for (int d0 = 0; d0 < 4; ++d0) gq[d0] = dgv[d0 * 32 + r32] * (1.f - lam_init);
  __syncthreads();
  bf16_t* OCw = OC + (size_t)(b * cfg::S + q0 + 16 * mp) * 1024 + h * 128;
  if (mp == 0) att_fin<0>(o, Xr, lam, gq, OCw, r32, hi, lane); else att_fin<1>(o, Xr, lam, gq, OCw, r32, hi, lane);
  __syncthreads();
#undef ATT_GLOAD
#undef ATT_GWRITE
#undef ATT_VSEG
#undef ATT_MSEG
#undef ATT_RESC
#undef ATT_OL
#undef ATT_QK
}
#undef ATT_KSWZ
#undef ATT_SBAR
}
namespace gla {
using att::bf16x8; using att::s16x4; using att::f32x16; using att::u32x4; using att::crow; using att::cvtpk; using att::tr_read;
typedef float f32x4 __attribute__((ext_vector_type(4)));
typedef unsigned u32x2 __attribute__((ext_vector_type(2)));
#define GLAS __attribute__((address_space(3)))
constexpr int KT_STRIDE = 144;
constexpr int A_KT = 0, A_V = 36864, A_BEND = A_V + 32768;
constexpr int B_QT = 0, B_KT = 32768, B_V = 65536, B_SC = 98304;
__device__ __forceinline__ int v_st64(int k, int c) { const int kk = (k & ~0xC) | ((k & 4) << 1) | ((k & 8) >> 1); return ((kk >> 3) * 2 + (c >> 5)) * 512 + ((kk & 7) * 32 + (c & 31)) * 2; }
constexpr int v_off64(int d0, int ks, int half) { return d0 * 512 + ks * 2048 + half * 1024; }
__device__ __forceinline__ float bf2f_(unsigned short v) { return __uint_as_float((unsigned)v << 16); }
__device__ __forceinline__ void load_v_tile(const bf16_t* __restrict__ src, GLAS unsigned char* dst, int lane) {
    u32x4 tv[8];
#pragma unroll
    for (int i = 0; i < 8; ++i) { const int row = (lane >> 3) + 8 * i, ch = lane & 7; tv[i] = *(const u32x4*)(src + (size_t)row * 256 + ch * 8); }
#pragma unroll
    for (int i = 0; i < 8; ++i) { const int row = (lane >> 3) + 8 * i, ch = lane & 7; *(GLAS u32x4*)(dst + v_st64(row, ch * 8)) = tv[i]; }
}
#define GLA_PK(L, H) (bf16x8){L[0], L[1], L[2], L[3], H[0], H[1], H[2], H[3]}
#define GLA_MM4(o0, o1, vb, AF) do { \
    const s16x4 l00 = tr_read<v_off64(0, 0, 0)>(vb), h00 = tr_read<v_off64(0, 0, 1)>(vb), l01 = tr_read<v_off64(0, 1, 0)>(vb), h01 = tr_read<v_off64(0, 1, 1)>(vb); \
    const s16x4 l02 = tr_read<v_off64(0, 2, 0)>(vb), h02 = tr_read<v_off64(0, 2, 1)>(vb), l03 = tr_read<v_off64(0, 3, 0)>(vb), h03 = tr_read<v_off64(0, 3, 1)>(vb); \
    const s16x4 l10 = tr_read<v_off64(1, 0, 0)>(vb), h10 = tr_read<v_off64(1, 0, 1)>(vb), l11 = tr_read<v_off64(1, 1, 0)>(vb), h11 = tr_read<v_off64(1, 1, 1)>(vb); \
    const s16x4 l12 = tr_read<v_off64(1, 2, 0)>(vb), h12 = tr_read<v_off64(1, 2, 1)>(vb), l13 = tr_read<v_off64(1, 3, 0)>(vb), h13 = tr_read<v_off64(1, 3, 1)>(vb); \
    asm volatile("s_waitcnt lgkmcnt(0)" ::: "memory"); __builtin_amdgcn_sched_barrier(0); \
    o0 = __builtin_amdgcn_mfma_f32_32x32x16_bf16(AF(0), GLA_PK(l00, h00), o0, 0, 0, 0); o1 = __builtin_amdgcn_mfma_f32_32x32x16_bf16(AF(0), GLA_PK(l10, h10), o1, 0, 0, 0); \
    o0 = __builtin_amdgcn_mfma_f32_32x32x16_bf16(AF(1), GLA_PK(l01, h01), o0, 0, 0, 0); o1 = __builtin_amdgcn_mfma_f32_32x32x16_bf16(AF(1), GLA_PK(l11, h11), o1, 0, 0, 0); \
    o0 = __builtin_amdgcn_mfma_f32_32x32x16_bf16(AF(2), GLA_PK(l02, h02), o0, 0, 0, 0); o1 = __builtin_amdgcn_mfma_f32_32x32x16_bf16(AF(2), GLA_PK(l12, h12), o1, 0, 0, 0); \
    o0 = __builtin_amdgcn_mfma_f32_32x32x16_bf16(AF(3), GLA_PK(l03, h03), o0, 0, 0, 0); o1 = __builtin_amdgcn_mfma_f32_32x32x16_bf16(AF(3), GLA_PK(l13, h13), o1, 0, 0, 0); } while (0)
__device__ __forceinline__ bf16x8 afrag_tr(const GLAS unsigned char* row, int ks, int hi) { return *(const GLAS bf16x8*)(row + (16 * ks + 8 * hi) * 2); }

__device__ __forceinline__ void gla_a_item(int b, int h, int g, unsigned char* ws, GLAS unsigned char* lds) {
    int tid_o = threadIdx.x; asm volatile("" : "+v"(tid_o));
    const int tid = tid_o, wave = __builtin_amdgcn_readfirstlane(tid >> 6), lane = tid & 63, r32 = lane & 31, hi = lane >> 5;
    const float* GL = (const float*)(ws + cfg::WSB_GL + (size_t)b * cfg::DLT_GL); const bf16_t* GQK = (const bf16_t*)(ws + cfg::WSB_GQK + (size_t)b * cfg::DLT_GQK); const bf16_t* GV = (const bf16_t*)(ws + cfg::WSB_GV + (size_t)b * cfg::DLT_GV);
    float* KVC = (float*)(ws + cfg::WSB_OF + (size_t)b * cfg::DLT_OF); float* DEC = (float*)(ws + cfg::WS_DEC);
    const size_t tok0 = (size_t)b * 2048 + g * 256;
    GLAS float* bend_s = (GLAS float*)(lds + A_BEND);
    if (wave < 4) {
        const int c = wave, dir = lane >> 5, d = lane & 31;
        const float* gl = GL + (tok0 + c * 64) * 256 + dir * 128 + h * 32 + d; const bf16_t* kp = GQK + (tok0 + c * 64) * 256 + 128 + h * 32 + d;
        GLAS unsigned char* row = lds + A_KT + ((c * 2 + dir) * 32 + d) * KT_STRIDE; float bsum = 0.f; float gA[8], gB[8]; unsigned short kA[8], kB[8];
#define GLA_LOAD(G, K, blk) do { const int t0_ = dir ? 56 - 8 * (blk) : 8 * (blk); _Pragma("unroll") for (int i = 0; i < 8; ++i) { G[i] = gl[(size_t)(t0_ + i) * 256]; K[i] = kp[(size_t)(t0_ + i) * 256]; } } while (0)
#define GLA_PROC(G, K, blk) do { const int t0_ = dir ? 56 - 8 * (blk) : 8 * (blk); float kt[8]; \
            if (dir == 0) { _Pragma("unroll") for (int i = 0; i < 8; ++i) { bsum += G[i]; kt[i] = bf2f_(K[i]) * __expf(-bsum); } } \
            else { _Pragma("unroll") for (int i = 7; i >= 0; --i) { bsum += G[i]; kt[i] = bf2f_(K[i]) * __expf(-bsum); } } \
            u32x4 w; w.x = cvtpk(kt[0], kt[1]); w.y = cvtpk(kt[2], kt[3]); w.z = cvtpk(kt[4], kt[5]); w.w = cvtpk(kt[6], kt[7]); *(GLAS u32x4*)(row + t0_ * 2) = w; } while (0)
        GLA_LOAD(gA, kA, 0);
#pragma unroll
        for (int bp = 0; bp < 4; ++bp) { GLA_LOAD(gB, kB, 2 * bp + 1); GLA_PROC(gA, kA, 2 * bp); if (bp < 3) GLA_LOAD(gA, kA, 2 * bp + 2); GLA_PROC(gB, kB, 2 * bp + 1); }
#undef GLA_LOAD
#undef GLA_PROC
        bend_s[(c * 2 + dir) * 32 + d] = bsum;
        DEC[((size_t)((b * 4 + h) * 32 + g * 4 + c) * 2 + dir) * 32 + d] = __expf(bsum);
    } else { const int c = wave - 4; load_v_tile(GV + (tok0 + c * 64) * 256 + h * 64, lds + A_V + c * 8192, lane); }
    __syncthreads();
    {
        const int c = wave >> 1, dir = wave & 1; f32x16 o0 = {}, o1 = {};
        const int vb = (int)(unsigned)(uintptr_t)(lds + A_V + c * 8192) + att::v_rd_base(lane);
        const GLAS unsigned char* arow = lds + A_KT + ((c * 2 + dir) * 32 + r32) * KT_STRIDE;
#define GLA_AF(ks) afrag_tr(arow, ks, hi)
        GLA_MM4(o0, o1, vb, GLA_AF);
#undef GLA_AF
        float* dst = KVC + ((size_t)((b * 4 + h) * 32 + g * 4 + c) * 2 + dir) * 2048 + r32;
#pragma unroll
        for (int r = 0; r < 16; ++r) { const int d = crow(r, hi); const float sc = __expf(bend_s[(c * 2 + dir) * 32 + d]); dst[d * 64] = o0[r] * sc; dst[d * 64 + 32] = o1[r] * sc; }
    }
    __syncthreads();
}

__device__ __forceinline__ void gla_b_item(int b, int h, int g, unsigned char* ws, const float* __restrict__ gng, bf16_t* __restrict__ OC, GLAS unsigned char* lds) {
    int tid_o = threadIdx.x; asm volatile("" : "+v"(tid_o));
    const int tid = tid_o, wave = __builtin_amdgcn_readfirstlane(tid >> 6), lane = tid & 63, r32 = lane & 31, hi = lane >> 5;
    const float* GL = (const float*)(ws + cfg::WSB_GL + (size_t)b * cfg::DLT_GL); const bf16_t* GQK = (const bf16_t*)(ws + cfg::WSB_GQK + (size_t)b * cfg::DLT_GQK); const bf16_t* GV = (const bf16_t*)(ws + cfg::WSB_GV + (size_t)b * cfg::DLT_GV); const bf16_t* GR = (const bf16_t*)(ws + cfg::WSB_GR + (size_t)b * cfg::DLT_GR);
    const float* KVC = (const float*)(ws + cfg::WSB_OF + (size_t)b * cfg::DLT_OF) + (size_t)((b * 4 + h) * 32) * 2 * 2048; const float* DEC = (const float*)(ws + cfg::WS_DEC) + (size_t)((b * 4 + h) * 32) * 2 * 32;
    const size_t tok0 = (size_t)b * 2048 + g * 256;
    if (wave < 4) {
        const int c = wave, dir = lane >> 5, d = lane & 31;
        const float* gl = GL + (tok0 + c * 64) * 256 + dir * 128 + h * 32 + d; const bf16_t* qp = GQK + (tok0 + c * 64) * 256 + h * 32 + d;
        GLAS unsigned short* qt = (GLAS unsigned short*)(lds + B_QT + c * 8192) + dir * 32 + d;
        GLAS unsigned short* kt = (GLAS unsigned short*)(lds + B_KT + c * 8192 + dir * 4096) + d;
        float bsum = 0.f; float gA[8], gB[8]; unsigned short qA[8], kA[8], qB[8], kB[8];
#define GLB_LOAD(G, Q, K, blk) do { const int t0_ = dir ? 56 - 8 * (blk) : 8 * (blk); _Pragma("unroll") for (int i = 0; i < 8; ++i) { G[i] = gl[(size_t)(t0_ + i) * 256]; Q[i] = qp[(size_t)(t0_ + i) * 256]; K[i] = qp[(size_t)(t0_ + i) * 256 + 128]; } } while (0)
#define GLB_PROC(G, Q, K, blk) do { const int t0_ = dir ? 56 - 8 * (blk) : 8 * (blk); _Pragma("unroll") for (int ii = 0; ii < 8; ++ii) { \
            const float gi = dir ? G[7 - ii] : G[ii], qi = bf2f_(dir ? Q[7 - ii] : Q[ii]), ki = bf2f_(dir ? K[7 - ii] : K[ii]); const int tt = t0_ + (dir ? 7 - ii : ii); \
            bsum += gi; const float e = __expf(bsum), ei = __expf(-bsum); \
            qt[tt * 64] = (unsigned short)(cvtpk(qi * e, 0.f) & 0xffffu); kt[tt * 32] = (unsigned short)(cvtpk(ki * ei, 0.f) & 0xffffu); } } while (0)
        GLB_LOAD(gA, qA, kA, 0);
#pragma unroll
        for (int bp = 0; bp < 4; ++bp) { GLB_LOAD(gB, qB, kB, 2 * bp + 1); GLB_PROC(gA, qA, kA, 2 * bp); if (bp < 3) GLB_LOAD(gA, qA, kA, 2 * bp + 2); GLB_PROC(gB, qB, kB, 2 * bp + 1); }
#undef GLB_LOAD
#undef GLB_PROC
    } else {
        const int c = wave - 4; load_v_tile(GV + (tok0 + c * 64) * 256 + h * 64, lds + B_V + c * 8192, lane);
        const int t2 = tid - 256, d = t2 >> 3, v8 = (t2 & 7) * 8;
        const float* kvp = KVC + d * 64 + v8; const float* dcp = DEC + d;
        f32x4 own[4][2][2]; float dow[4][2];
#pragma unroll
        for (int c4 = 0; c4 < 4; ++c4)
#pragma unroll
            for (int dr = 0; dr < 2; ++dr) { const int n = 4 * g + c4; own[c4][dr][0] = *(const f32x4*)(kvp + (size_t)(n * 2 + dr) * 2048); own[c4][dr][1] = *(const f32x4*)(kvp + (size_t)(n * 2 + dr) * 2048 + 4); dow[c4][dr] = dcp[(n * 2 + dr) * 32]; }
        f32x4 Sf0 = {0.f, 0.f, 0.f, 0.f}, Sf1 = Sf0, Sb0 = Sf0, Sb1 = Sf0;
#pragma unroll 8
        for (int n = 0; n < 4 * g; ++n) { const float dc = dcp[(n * 2) * 32]; Sf0 = dc * Sf0 + *(const f32x4*)(kvp + (size_t)(n * 2) * 2048); Sf1 = dc * Sf1 + *(const f32x4*)(kvp + (size_t)(n * 2) * 2048 + 4); }
#pragma unroll 8
        for (int n = 31; n >= 4 * g + 4; --n) { const float dc = dcp[(n * 2 + 1) * 32]; Sb0 = dc * Sb0 + *(const f32x4*)(kvp + (size_t)(n * 2 + 1) * 2048); Sb1 = dc * Sb1 + *(const f32x4*)(kvp + (size_t)(n * 2 + 1) * 2048 + 4); }
#pragma unroll
        for (int c4 = 0; c4 < 4; ++c4) { u32x4 w; w.x = cvtpk(Sf0[0], Sf0[1]); w.y = cvtpk(Sf0[2], Sf0[3]); w.z = cvtpk(Sf1[0], Sf1[1]); w.w = cvtpk(Sf1[2], Sf1[3]);
            *(GLAS u32x4*)(lds + B_SC + c4 * 8192 + v_st64(d, v8)) = w; Sf0 = dow[c4][0] * Sf0 + own[c4][0][0]; Sf1 = dow[c4][0] * Sf1 + own[c4][0][1]; }
#pragma unroll
        for (int c4 = 3; c4 >= 0; --c4) { u32x4 w; w.x = cvtpk(Sb0[0], Sb0[1]); w.y = cvtpk(Sb0[2], Sb0[3]); w.z = cvtpk(Sb1[0], Sb1[1]); w.w = cvtpk(Sb1[2], Sb1[3]);
            *(GLAS u32x4*)(lds + B_SC + c4 * 8192 + v_st64(32 + d, v8)) = w; Sb0 = dow[c4][1] * Sb0 + own[c4][1][0]; Sb1 = dow[c4][1] * Sb1 + own[c4][1][1]; }
    }
    __syncthreads();
    {
        const int c = wave >> 1, th = wave & 1, t = 32 * th + r32;
        const GLAS unsigned char* qrow = lds + B_QT + c * 8192 + t * 128;
        f32x16 pf0 = {}, pf1 = {}, pb0 = {}, pb1 = {};
#pragma unroll
        for (int ks = 0; ks < 2; ++ks) {
            const bf16x8 qf = *(const GLAS bf16x8*)(qrow + (16 * ks + 8 * hi) * 2), qb = *(const GLAS bf16x8*)(qrow + (32 + 16 * ks + 8 * hi) * 2);
            const GLAS unsigned char* kf = lds + B_KT + c * 8192 + r32 * 64 + (16 * ks + 8 * hi) * 2; const GLAS unsigned char* kb = kf + 4096;
            pf0 = __builtin_amdgcn_mfma_f32_32x32x16_bf16(*(const GLAS bf16x8*)kf, qf, pf0, 0, 0, 0); pf1 = __builtin_amdgcn_mfma_f32_32x32x16_bf16(*(const GLAS bf16x8*)(kf + 2048), qf, pf1, 0, 0, 0);
            pb0 = __builtin_amdgcn_mfma_f32_32x32x16_bf16(*(const GLAS bf16x8*)kb, qb, pb0, 0, 0, 0); pb1 = __builtin_amdgcn_mfma_f32_32x32x16_bf16(*(const GLAS bf16x8*)(kb + 2048), qb, pb1, 0, 0, 0);
        }
#pragma unroll
        for (int r = 0; r < 16; ++r) { const int j0 = crow(r, hi), j1 = 32 + j0;
            pf0[r] = (j0 <= t ? pf0[r] : 0.f) + (j0 >= t ? pb0[r] : 0.f); pf1[r] = (j1 <= t ? pf1[r] : 0.f) + (j1 >= t ? pb1[r] : 0.f); }
        bf16x8 pa0, pa1, pa2, pa3;
#define GLA_PK4(P, BASE, OUT) do { unsigned a0 = cvtpk(P[BASE + 0], P[BASE + 1]), a1 = cvtpk(P[BASE + 2], P[BASE + 3]); unsigned b0 = cvtpk(P[BASE + 4], P[BASE + 5]), b1 = cvtpk(P[BASE + 6], P[BASE + 7]); \
    auto r0 = __builtin_amdgcn_permlane32_swap(a0, b0, false, false); auto r1 = __builtin_amdgcn_permlane32_swap(a1, b1, false, false); \
    u32x4 w = {r0[0], r1[0], r0[1], r1[1]}; OUT = *reinterpret_cast<bf16x8*>(&w); } while (0)
        GLA_PK4(pf0, 0, pa0); GLA_PK4(pf0, 8, pa1); GLA_PK4(pf1, 0, pa2); GLA_PK4(pf1, 8, pa3);
#undef GLA_PK4
        f32x16 o0 = {}, o1 = {};
        { const int vb = (int)(unsigned)(uintptr_t)(lds + B_V + c * 8192) + att::v_rd_base(lane);
#define GLA_AF(ks) ((ks) == 0 ? pa0 : (ks) == 1 ? pa1 : (ks) == 2 ? pa2 : pa3)
          GLA_MM4(o0, o1, vb, GLA_AF);
#undef GLA_AF
        }
        { const int vb = (int)(unsigned)(uintptr_t)(lds + B_SC + c * 8192) + att::v_rd_base(lane);
#define GLA_AF(ks) afrag_tr(qrow, ks, hi)
          GLA_MM4(o0, o1, vb, GLA_AF);
#undef GLA_AF
        }
        const float g0 = gng[r32], g1 = gng[32 + r32];
        const bf16_t* grb = GR + (tok0 + c * 64 + 32 * th) * 256 + h * 64 + r32; unsigned short gq0[16], gq1[16];
#pragma unroll
        for (int r = 0; r < 16; ++r) { gq0[r] = grb[(size_t)crow(r, hi) * 256]; gq1[r] = grb[(size_t)crow(r, hi) * 256 + 32]; }
#pragma unroll
        for (int r = 0; r < 16; ++r) {
            float ssq = o0[r] * o0[r] + o1[r] * o1[r];
            ssq = xadd<1>(ssq); ssq = xadd<2>(ssq); ssq = xadd<4>(ssq); ssq = xadd<8>(ssq); ssq = xadd<16>(ssq);
            const float rn = rsqrtf(ssq * (1.f / 64.f) + cfg::EPS);
            const size_t tok = tok0 + c * 64 + 32 * th + crow(r, hi);
            bf16_t* dst = OC + tok * 1024 + 768 + h * 64 + r32;
            dst[0] = (bf16_t)(cvtpk(o0[r] * rn * g0 * bf2f_(gq0[r]), 0.f) & 0xffffu); dst[32] = (bf16_t)(cvtpk(o1[r] * rn * g1 * bf2f_(gq1[r]), 0.f) & 0xffffu);
        }
    }
    __syncthreads();
}
#undef GLA_MM4
#undef GLA_PK
#undef GLAS
}
namespace fft {
using att::bf16x8; using att::s16x4; using att::f32x16; using att::u32x4; using att::crow; using att::cvtpk; using att::tr_read;
#define FLAS __attribute__((address_space(3)))
__device__ __forceinline__ int img_off(int k, int c) { const int kk = (k & ~0xC) | ((k & 4) << 1) | ((k & 8) >> 1); return ((kk >> 3) * 8 + (c >> 5)) * 512 + ((kk & 7) * 32 + (c & 31)) * 2; }
constexpr int rd_off(int ks, int half) { return ks * 8192 + half * 4096; }
#define FFT_PK(L, H) (bf16x8){L[0], L[1], L[2], L[3], H[0], H[1], H[2], H[3]}
typedef float f32x2_t __attribute__((ext_vector_type(2))); typedef __bf16 bf16x2_t __attribute__((ext_vector_type(2)));
__device__ __forceinline__ unsigned pk2f(float a, float b) { f32x2_t v = {a, b}; bf16x2_t r = __builtin_convertvector(v, bf16x2_t); return __builtin_bit_cast(unsigned, r); }

__device__ __forceinline__ void stage1_item(int b, int s2, const bf16_t* __restrict__ FX, bf16_t* __restrict__ I1, FLAS unsigned char* lds) {
    int tid_o = threadIdx.x; asm volatile("" : "+v"(tid_o));
    const int tid = tid_o, wave = __builtin_amdgcn_readfirstlane(tid >> 6), lane = tid & 63, r32 = lane & 31, hi = lane >> 5;
    bf16x8 F1[2][4];
#pragma unroll
    for (int ks = 0; ks < 4; ++ks) { float cr[8], ci[8];
#pragma unroll
        for (int j = 0; j < 8; ++j) { const int k = 16 * ks + 8 * hi + j, s1 = k & 31; const float rev = (float)((r32 * s1) & 31) * (1.f / 32.f); const float c = __builtin_amdgcn_cosf(rev), sn = __builtin_amdgcn_sinf(rev);
            const bool p1 = (k >> 5) != 0; cr[j] = p1 ? -sn : c; ci[j] = p1 ? -c : -sn; }
        u32x4 wr = {pk2f(cr[0], cr[1]), pk2f(cr[2], cr[3]), pk2f(cr[4], cr[5]), pk2f(cr[6], cr[7])}, wi = {pk2f(ci[0], ci[1]), pk2f(ci[2], ci[3]), pk2f(ci[4], ci[5]), pk2f(ci[6], ci[7])};
        F1[0][ks] = *reinterpret_cast<bf16x8*>(&wr); F1[1][ks] = *reinterpret_cast<bf16x8*>(&wi); }
    { u32x4 tv[4];
#pragma unroll
      for (int i = 0; i < 4; ++i) { const int p = tid + 512 * i, k = p >> 5, c8 = (p & 31) * 8; tv[i] = *(const u32x4*)(FX + (size_t)(b * 2048 + 64 * (k & 31) + s2) * 512 + (k >> 5) * 256 + c8); }
#pragma unroll
      for (int i = 0; i < 4; ++i) { const int p = tid + 512 * i, k = p >> 5, c8 = (p & 31) * 8; *(FLAS u32x4*)(lds + img_off(k, c8)) = tv[i]; } }
    __syncthreads();
    f32x16 re = {}, im = {};
    { const int vb = (int)(unsigned)(uintptr_t)lds + att::v_rd_base(lane) + wave * 512;
      const s16x4 l0 = tr_read<rd_off(0, 0)>(vb), h0 = tr_read<rd_off(0, 1)>(vb), l1 = tr_read<rd_off(1, 0)>(vb), h1 = tr_read<rd_off(1, 1)>(vb);
      const s16x4 l2 = tr_read<rd_off(2, 0)>(vb), h2 = tr_read<rd_off(2, 1)>(vb), l3 = tr_read<rd_off(3, 0)>(vb), h3 = tr_read<rd_off(3, 1)>(vb);
      asm volatile("s_waitcnt lgkmcnt(0)" ::: "memory"); __builtin_amdgcn_sched_barrier(0);
      re = __builtin_amdgcn_mfma_f32_32x32x16_bf16(F1[0][0], FFT_PK(l0, h0), re, 0, 0, 0); im = __builtin_amdgcn_mfma_f32_32x32x16_bf16(F1[1][0], FFT_PK(l0, h0), im, 0, 0, 0);
      re = __builtin_amdgcn_mfma_f32_32x32x16_bf16(F1[0][1], FFT_PK(l1, h1), re, 0, 0, 0); im = __builtin_amdgcn_mfma_f32_32x32x16_bf16(F1[1][1], FFT_PK(l1, h1), im, 0, 0, 0);
      re = __builtin_amdgcn_mfma_f32_32x32x16_bf16(F1[0][2], FFT_PK(l2, h2), re, 0, 0, 0); im = __builtin_amdgcn_mfma_f32_32x32x16_bf16(F1[1][2], FFT_PK(l2, h2), im, 0, 0, 0);
      re = __builtin_amdgcn_mfma_f32_32x32x16_bf16(F1[0][3], FFT_PK(l3, h3), re, 0, 0, 0); im = __builtin_amdgcn_mfma_f32_32x32x16_bf16(F1[1][3], FFT_PK(l3, h3), im, 0, 0, 0); }
    bf16_t* dst = I1 + (size_t)(b * 32) * 128 * 256 + (size_t)s2 * 256 + 32 * wave + r32;
#pragma unroll
    for (int r = 0; r < 16; ++r) { const int k1 = crow(r, hi); const float rev = (float)((k1 * s2) & 2047) * (1.f / 2048.f); const float ct = __builtin_amdgcn_cosf(rev), st = __builtin_amdgcn_sinf(rev);
        const float ar = re[r] * ct + im[r] * st, ai = im[r] * ct - re[r] * st; const unsigned w = pk2f(ar, ai);
        dst[(size_t)k1 * 128 * 256] = (bf16_t)(w & 0xffffu); dst[(size_t)k1 * 128 * 256 + 64 * 256] = (bf16_t)(w >> 16); }
    __syncthreads();
}

__device__ __forceinline__ void stage2_item(int b, int k1, const bf16_t* __restrict__ I1, bf16_t* __restrict__ OC, FLAS unsigned char* lds) {
    int tid_o = threadIdx.x; asm volatile("" : "+v"(tid_o));
    const int tid = tid_o, wave = __builtin_amdgcn_readfirstlane(tid >> 6), lane = tid & 63, r32 = lane & 31, hi = lane >> 5;
    const bf16_t* src = I1 + (size_t)(b * 32 + k1) * 128 * 256;
    { u32x4 tv[8];
#pragma unroll
      for (int i = 0; i < 8; ++i) { const int p = tid + 512 * i, k = p >> 5, c8 = (p & 31) * 8; tv[i] = *(const u32x4*)(src + (size_t)k * 256 + c8); }
#pragma unroll
      for (int i = 0; i < 8; ++i) { const int p = tid + 512 * i, k = p >> 5, c8 = (p & 31) * 8; *(FLAS u32x4*)(lds + img_off(k, c8)) = tv[i]; } }
    f32x16 y0 = {}, y1 = {};
    __syncthreads();
    const int vb = (int)(unsigned)(uintptr_t)lds + att::v_rd_base(lane) + wave * 512, vb2 = vb + 32768;
    bf16x8 F2[2][8];
#pragma unroll
    for (int ks = 0; ks < 8; ++ks) { float c0[8], c1[8];
#pragma unroll
        for (int j = 0; j < 8; ++j) { const int k = 16 * ks + 8 * hi + j, s2 = k & 63; const float r0 = (float)((r32 * s2) & 63) * (1.f / 64.f), r1 = (float)(((32 + r32) * s2) & 63) * (1.f / 64.f);
            c0[j] = (k >> 6) ? __builtin_amdgcn_sinf(r0) : __builtin_amdgcn_cosf(r0); c1[j] = (k >> 6) ? __builtin_amdgcn_sinf(r1) : __builtin_amdgcn_cosf(r1); }
        u32x4 w0 = {pk2f(c0[0], c0[1]), pk2f(c0[2], c0[3]), pk2f(c0[4], c0[5]), pk2f(c0[6], c0[7])}, w1 = {pk2f(c1[0], c1[1]), pk2f(c1[2], c1[3]), pk2f(c1[4], c1[5]), pk2f(c1[6], c1[7])};
        F2[0][ks] = *reinterpret_cast<bf16x8*>(&w0); F2[1][ks] = *reinterpret_cast<bf16x8*>(&w1); }
#define FFT_STEP(ks) do { \
      const s16x4 lo_ = tr_read<rd_off((ks) & 3, 0)>((ks) < 4 ? vb : vb2), hi_ = tr_read<rd_off((ks) & 3, 1)>((ks) < 4 ? vb : vb2); asm volatile("s_waitcnt lgkmcnt(0)" ::: "memory"); __builtin_amdgcn_sched_barrier(0); \
      y0 = __builtin_amdgcn_mfma_f32_32x32x16_bf16(F2[0][ks], FFT_PK(lo_, hi_), y0, 0, 0, 0); y1 = __builtin_amdgcn_mfma_f32_32x32x16_bf16(F2[1][ks], FFT_PK(lo_, hi_), y1, 0, 0, 0); } while (0)
    FFT_STEP(0); FFT_STEP(1); FFT_STEP(2); FFT_STEP(3); FFT_STEP(4); FFT_STEP(5); FFT_STEP(6); FFT_STEP(7);
#undef FFT_STEP
    bf16_t* dst = OC + (size_t)(b * 2048 + k1) * 1024 + 512 + 32 * wave + r32;
#pragma unroll
    for (int r = 0; r < 16; ++r) { const int k2 = crow(r, hi); const unsigned w = pk2f(y0[r], y1[r]);
        dst[(size_t)(32 * k2) * 1024] = (bf16_t)(w & 0xffffu); dst[(size_t)(32 * (32 + k2)) * 1024] = (bf16_t)(w >> 16); }
    __syncthreads();
}
#undef FFT_PK
#undef FLAS
}
namespace pro {
#define PLAS __attribute__((address_space(3)))
typedef float f32x4 __attribute__((ext_vector_type(4)));
typedef unsigned u32x4 __attribute__((ext_vector_type(4)));
__device__ __forceinline__ unsigned pk2(float lo, float hi) { unsigned r; asm volatile("v_cvt_pk_bf16_f32 %0, %1, %2" : "=v"(r) : "v"(lo), "v"(hi)); return r; }
__device__ __forceinline__ float lo_f(unsigned w) { return __uint_as_float(w << 16); }
__device__ __forceinline__ float hi_f(unsigned w) { return __uint_as_float(w & 0xffff0000u); }
template <bool SUMS, int STRIDE> __device__ __forceinline__ void tile_emit(int K, bf16_t* WT, const float* gain, const float* lnb, float (&a1)[4], float (&a2)[4], const PLAS float* scr, int lane) {
    const int c = lane & 7; float gk[8], bk[8];
#pragma unroll
    for (int q = 0; q < 8; ++q) { gk[q] = gain ? gain[8 * c + q] : 1.f; bk[q] = lnb ? lnb[8 * c + q] : 0.f; }
#pragma unroll
    for (int j = 0; j < 4; ++j) { const int n = (lane >> 3) + 8 * j; const PLAS float* s = scr + (8 * c) * STRIDE + n; float v[8];
#pragma unroll
        for (int q = 0; q < 8; ++q) v[q] = s[q * STRIDE];
        u32x4 o; o.x = pk2(v[0] * gk[0], v[1] * gk[1]); o.y = pk2(v[2] * gk[2], v[3] * gk[3]); o.z = pk2(v[4] * gk[4], v[5] * gk[5]); o.w = pk2(v[6] * gk[6], v[7] * gk[7]);
        *(u32x4*)(WT + (size_t)n * K + 8 * c) = o;
        if (SUMS) { float p1 = (lo_f(o.x) + hi_f(o.x)) + (lo_f(o.y) + hi_f(o.y)) + (lo_f(o.z) + hi_f(o.z)) + (lo_f(o.w) + hi_f(o.w)); float p2 = 0.f;
#pragma unroll
            for (int q = 0; q < 8; ++q) p2 += bk[q] * v[q];
            p1 = xadd<1>(p1); p2 = xadd<1>(p2); p1 = xadd<2>(p1); p2 = xadd<2>(p2); p1 = xadd<4>(p1); p2 = xadd<4>(p2);
            a1[j] += p1; a2[j] += p2; }
    }
    asm volatile("s_waitcnt lgkmcnt(0)" ::: "memory");
}
__device__ __forceinline__ void tile_dma(const float* W, int N, PLAS float* scr, int lane) {
    const float* src = W + (size_t)(lane >> 3) * N + (lane & 7) * 4;
#pragma unroll
    for (int i = 0; i < 8; ++i) __builtin_amdgcn_global_load_lds((const unsigned*)(src + (size_t)(8 * i) * N), (PLAS unsigned*)(scr + i * 256), 16, 0, 0);
}
template <bool SUMS, class Val> __device__ __forceinline__ void tile_item(const Val& val, int K, bf16_t* WT, const float* gain, const float* lnb, float (&a1)[4], float (&a2)[4], PLAS float* scr, int lane) {
#pragma unroll 2
    for (int i = 0; i < 32; ++i) { const int kk = 2 * i + (lane >> 5); scr[kk * 33 + (lane & 31)] = val(kk, lane & 31); }
    asm volatile("s_waitcnt lgkmcnt(0)" ::: "memory");
    tile_emit<SUMS, 33>(K, WT, gain, lnb, a1, a2, scr, lane);
}
struct ValPlain { static constexpr int BATCH = 32; const float* W; int N; __device__ __forceinline__ float operator()(int kk, int j) const { return W[(size_t)kk * N + j]; } };
struct ValGate { static constexpr int BATCH = 2; const float* W; const float* w2; __device__ __forceinline__ float operator()(int kk, int j) const {
    const float* wr = W + (size_t)kk * cfg::INW; float a = 0.f;
#pragma unroll
    for (int r = 0; r < 16; ++r) a += wr[r] * w2[r * 128 + j]; return a; } };

__device__ __forceinline__ void fold_item(int item, unsigned char* ws, const float* w_in, const float* fw, const float* lng, const float* lnb, PLAS unsigned char* lds, int tid) {
    const int l = item >> 5, g = (item >> 3) & 3, part = (item >> 2) & 1, kq = item & 3;
    PLAS float* M = (PLAS float*)lds;
    { const int c = tid >> 3, e0 = (tid & 7) * 8; float acc[8];
#pragma unroll
      for (int q = 0; q < 8; ++q) acc[q] = 0.f;
      const float* w = fw + (size_t)((l * 4 + g) * 64) * 64 + e0;
      for (int k2 = 0; k2 < 64; ++k2) { float rev = (float)((k2 * c) & 63) * (1.f / 64.f); asm volatile("" : "+v"(rev)); const float tr = part ? __builtin_amdgcn_sinf(rev) : __builtin_amdgcn_cosf(rev);
          const f32x4 w0 = *(const f32x4*)(w + k2 * 64), w1 = *(const f32x4*)(w + k2 * 64 + 4);
#pragma unroll
          for (int q = 0; q < 4; ++q) { acc[q] += tr * w0[q]; acc[4 + q] += tr * w1[q]; } }
      const float sc = 0.00276213586400995f;
#pragma unroll
      for (int q = 0; q < 8; ++q) M[c * 64 + e0 + q] = acc[q] * sc; }
    __syncthreads();
    PLAS float* Wl = (PLAS float*)(lds + 16384);
    { const float* wsrc = w_in + ((size_t)l * 1024 + kq * 256) * cfg::INW + 1536 + 64 * g; f32x4 tv[8];
#pragma unroll
      for (int i = 0; i < 8; ++i) tv[i] = *(const f32x4*)(wsrc + (size_t)((tid >> 4) + 32 * i) * cfg::INW + (tid & 15) * 4);
#pragma unroll
      for (int i = 0; i < 8; ++i) *(PLAS f32x4*)(Wl + ((tid >> 4) + 32 * i) * 64 + (tid & 15) * 4) = tv[i]; }
    __syncthreads();
    { const int e = tid & 63, kg = tid >> 6, k0 = kq * 256 + kg * 32, np = 1536 + part * 256 + g * 64 + e; float mc[64];
#pragma unroll
      for (int c = 0; c < 64; ++c) mc[c] = M[c * 64 + e];
      bf16_t* dst = (bf16_t*)(ws + cfg::WS_WIN + l * cfg::SZ_WIN) + (size_t)np * 1024 + k0; float s1 = 0.f, s2 = 0.f;
      for (int kb = 0; kb < 4; ++kb) { float o[8];
#pragma unroll
          for (int q = 0; q < 8; ++q) { const int k = k0 + kb * 8 + q; const PLAS f32x4* wr = (const PLAS f32x4*)(Wl + (kg * 32 + kb * 8 + q) * 64); float a = 0.f;
#pragma unroll
              for (int c4 = 0; c4 < 16; ++c4) { const f32x4 w4 = wr[c4]; a += w4[0] * mc[4 * c4] + w4[1] * mc[4 * c4 + 1] + w4[2] * mc[4 * c4 + 2] + w4[3] * mc[4 * c4 + 3]; }
              o[q] = a * (lng ? lng[k] : 1.f); s2 += lnb ? lnb[k] * a : 0.f; }
          u32x4 w; w.x = pk2(o[0], o[1]); w.y = pk2(o[2], o[3]); w.z = pk2(o[4], o[5]); w.w = pk2(o[6], o[7]); *(u32x4*)(dst + kb * 8) = w;
          s1 += (lo_f(w.x) + hi_f(w.x)) + (lo_f(w.y) + hi_f(w.y)) + (lo_f(w.z) + hi_f(w.z)) + (lo_f(w.w) + hi_f(w.w)); }
      __syncthreads();
      PLAS float* red = (PLAS float*)lds; red[(kg * 64 + e) * 2] = s1; red[(kg * 64 + e) * 2 + 1] = s2;
      __syncthreads();
      if (kg == 0) { float t1 = 0.f, t2 = 0.f;
#pragma unroll
          for (int w = 0; w < 8; ++w) { t1 += red[(w * 64 + e) * 2]; t2 += red[(w * 64 + e) * 2 + 1]; }
          float* fp = (float*)(ws + cfg::V_MF) + (size_t)((l * 4 + kq) * 2) * 512 + part * 256 + g * 64 + e; fp[0] = t1; fp[512] = t2; } }
    __syncthreads();
}

struct Inputs { const float *x, *w_in, *fw, *gw2, *w_out, *ln1g, *ln1b, *wg, *wu, *wd, *ln2g, *ln2b; };
__device__ __forceinline__ void prologue(unsigned char* ws, const Inputs& in, PLAS unsigned char* lds, int vcu, int G) {
    int tid_o = threadIdx.x; asm volatile("" : "+v"(tid_o));
    const int tid = tid_o, wave = __builtin_amdgcn_readfirstlane(tid >> 6), lane = tid & 63;
    const float* x = in.x; const float* w_in = in.w_in; const float* fw = in.fw; const float* gw2 = in.gw2; const float* w_out = in.w_out; const float* ln1g = in.ln1g; const float* ln1b = in.ln1b;
    const float* wg = in.wg; const float* wu = in.wu; const float* wd = in.wd; const float* ln2g = in.ln2g; const float* ln2b = in.ln2b;
    if (vcu < 64) { const int l = vcu >> 5; fold_item(vcu, ws, w_in, fw, l ? ln2g : (const float*)nullptr, l ? ln2b : (const float*)nullptr, lds, tid); }
    PLAS float* scr = (PLAS float*)(lds + wave * 16384); PLAS float* scr1 = scr + 2048; PLAS float* redw = (PLAS float*)(lds + 131072 + 1024 + wave * 256);
    const int gw = vcu * 8 + wave, NGW = G * 8;
    for (int it = vcu; it < 512; it += G) {
        const int l = it >> 8, r = it & 255; float a1[4] = {0.f, 0.f, 0.f, 0.f}, a2[4] = {0.f, 0.f, 0.f, 0.f}; float* c1o; float* c2o;
        const int k0 = wave * 64, k1 = k0 + 512;
        if (r < 80) { const int nb = r; const float* lngb = l ? ln2g : (const float*)nullptr; const float* lnbb = l ? ln2b : (const float*)nullptr;
            bf16_t* Wt = (bf16_t*)(ws + cfg::WS_WIN + l * cfg::SZ_WIN);
            if (nb < 72) { int np0, src;
                if (nb < 32) { const int pn = nb >> 3, p = (nb & 7) * 32, wc = (p >> 5) & 3, bj = p >> 7; np0 = pn * 256 + p; src = (pn >> 1) * 512 + (pn & 1) * 256 + 64 * wc + 32 * bj; }
                else if (nb < 48) { np0 = 1024 + (nb - 32) * 32; src = np0; }
                else { np0 = 2048 + (nb - 48) * 32; src = 1792 + (nb - 48) * 32; }
                tile_dma(w_in + ((size_t)l * 1024 + k0) * cfg::INW + src, cfg::INW, scr, lane); tile_dma(w_in + ((size_t)l * 1024 + k1) * cfg::INW + src, cfg::INW, scr1, lane);
                asm volatile("s_waitcnt vmcnt(0)" ::: "memory");
                tile_emit<true, 32>(1024, Wt + (size_t)np0 * 1024 + k0, lngb ? lngb + k0 : lngb, lnbb ? lnbb + k0 : lnbb, a1, a2, scr, lane);
                tile_emit<true, 32>(1024, Wt + (size_t)np0 * 1024 + k1, lngb ? lngb + k1 : lngb, lnbb ? lnbb + k1 : lnbb, a1, a2, scr1, lane);
                c1o = (float*)(ws + cfg::V_C1IN) + l * cfg::NIN + np0; c2o = (float*)(ws + cfg::V_C2IN) + l * cfg::NIN + np0;
            } else { const int p0 = (nb - 72) * 32, dir = p0 >> 7, kk0 = p0 & 127, np0 = 2816 + p0;
                for (int kb = wave; kb < 16; kb += 8) { const int kq = kb * 64; ValGate v{w_in + ((size_t)l * 1024 + kq) * cfg::INW + 2560 + 16 * dir, gw2 + (size_t)((l * 2 + dir) * 16) * 128 + kk0};
                    tile_item<true>(v, 1024, Wt + (size_t)np0 * 1024 + kq, lngb ? lngb + kq : lngb, lnbb ? lnbb + kq : lnbb, a1, a2, scr, lane); }
                c1o = (float*)(ws + cfg::V_C1IN) + l * cfg::NIN + np0; c2o = (float*)(ws + cfg::V_C2IN) + l * cfg::NIN + np0; }
        } else { const int nb = r - 80, np0 = nb * 32, pn = np0 >> 8, p = np0 & 255, bj = p >> 7, f0 = 128 * pn + (p & 127);
            const float* W = (bj ? wu : wg) + (size_t)l * 1024 * cfg::FF + f0; bf16_t* Wt = (bf16_t*)(ws + cfg::WS_WGU + l * cfg::SZ_WGU) + (size_t)np0 * 1024;
            tile_dma(W + (size_t)k0 * cfg::FF, cfg::FF, scr, lane); tile_dma(W + (size_t)k1 * cfg::FF, cfg::FF, scr1, lane);
            asm volatile("s_waitcnt vmcnt(0)" ::: "memory");
            tile_emit<true, 32>(1024, Wt + k0, ln1g + l * 1024 + k0, ln1b + l * 1024 + k0, a1, a2, scr, lane);
            tile_emit<true, 32>(1024, Wt + k1, ln1g + l * 1024 + k1, ln1b + l * 1024 + k1, a1, a2, scr1, lane);
            c1o = (float*)(ws + cfg::V_C1GU) + l * cfg::NGU + np0; c2o = (float*)(ws + cfg::V_C2GU) + l * cfg::NGU + np0; }
        if ((lane & 7) == 0) {
#pragma unroll
            for (int j = 0; j < 4; ++j) { const int n = (lane >> 3) + 8 * j; redw[n * 2] = a1[j]; redw[n * 2 + 1] = a2[j]; } }
        __syncthreads();
        if (wave == 0 && lane < 32) { float t1 = 0.f, t2 = 0.f;
#pragma unroll
            for (int w = 0; w < 8; ++w) { const PLAS float* rw = (const PLAS float*)(lds + 131072 + 1024 + w * 256); t1 += rw[lane * 2]; t2 += rw[lane * 2 + 1]; }
            c1o[lane] = t1; c2o[lane] = t2; }
        __syncthreads();
    }
    constexpr int I_OUT = 32 * 16, I_DN = 32 * 44, I_L = I_OUT + I_DN;
    for (int it = gw; it < 2 * I_L; it += 2 * NGW) {
        const float* Ws[2]; int Ns[2], Ks[2]; bf16_t* Wd[2]; float d1[4], d2[4];
#pragma unroll
        for (int q = 0; q < 2; ++q) { const int itq = it + q * NGW; const int ic = itq < 2 * I_L ? itq : it; const int l = ic / I_L; int r = ic - l * I_L;
            if (r < I_OUT) { const int nb = r >> 4, kb = r & 15, k0 = kb * 64, n0 = nb * 32; Ws[q] = w_out + ((size_t)l * 1024 + k0) * 1024 + n0; Ns[q] = 1024; Ks[q] = 1024;
                Wd[q] = (bf16_t*)(ws + cfg::WS_WOUT + l * cfg::SZ_WOUT) + (size_t)n0 * 1024 + k0; }
            else { r -= I_OUT; const int nb = r / 44, kb = r - nb * 44, k0 = kb * 64, n0 = nb * 32; Ws[q] = wd + ((size_t)l * cfg::FF + k0) * 1024 + n0; Ns[q] = 1024; Ks[q] = cfg::FF;
                Wd[q] = (bf16_t*)(ws + cfg::WS_WDN + l * cfg::SZ_WDN) + (size_t)n0 * cfg::FF + k0; } }
        tile_dma(Ws[0], Ns[0], scr, lane); tile_dma(Ws[1], Ns[1], scr1, lane);
        asm volatile("s_waitcnt vmcnt(0)" ::: "memory");
        tile_emit<false, 32>(Ks[0], Wd[0], (const float*)nullptr, (const float*)nullptr, d1, d2, scr, lane);
        if (it + NGW < 2 * I_L) tile_emit<false, 32>(Ks[1], Wd[1], (const float*)nullptr, (const float*)nullptr, d1, d2, scr1, lane);
    }
    const int xw = (vcu - 64) * 8 + wave, NXW = (G - 64) * 8;
    if (vcu >= 64 && G > 64)
    for (int m = xw; m < cfg::T; m += 4 * NXW) {
        f32x4 v[4][4];
#pragma unroll
        for (int q = 0; q < 4; ++q) { const int mr = (m + q * NXW) < cfg::T ? (m + q * NXW) : m; const f32x4* xr = (const f32x4*)(x + (size_t)mr * 1024) + lane;
#pragma unroll
            for (int j = 0; j < 4; ++j) v[q][j] = xr[64 * j]; }
#pragma unroll
        for (int q = 0; q < 4; ++q) { const int mr = (m + q * NXW) < cfg::T ? (m + q * NXW) : m; unsigned long long* o8 = (unsigned long long*)((bf16_t*)(ws + cfg::WS_XB) + (size_t)mr * 1024) + lane;
#pragma unroll
            for (int j = 0; j < 4; ++j) o8[64 * j] = (unsigned long long)pk2(v[q][j][0], v[q][j][1]) | ((unsigned long long)pk2(v[q][j][2], v[q][j][3]) << 32); } }
    for (int i = gw * 64 + lane; i < 2048 * 32; i += NGW * 64) { const int pos = i >> 5, f = i & 31; const float inv = exp2f(-(float)f * (13.287712379549449f / 32.f)); const float ang = (float)pos * inv;
        double rv = (double)ang * 0.15915494309189535; rv -= floor(rv); const float rev = (float)rv;
        ((float*)(ws + cfg::V_ROPEC))[i] = __builtin_amdgcn_cosf(rev); ((float*)(ws + cfg::V_ROPES))[i] = __builtin_amdgcn_sinf(rev); }
}
#undef PLAS
}
constexpr int NWAVES = 8;
constexpr int RING_OFF = 0, RING_BYTES = 131072;
constexpr int LDSCTL_OFF = RING_BYTES, MISC_OFF = LDSCTL_OFF + 320;
constexpr int RSL_OFF = 131072 + 4096;
constexpr int LDS_BYTES = 147456;
constexpr int CW_BAR = 4096;
constexpr int CW_GBAR = 8192, GBAR_STRIDE = 4096;
constexpr size_t CTL_ZERO_BYTES = 192 * 1024;
#define GAS __attribute__((address_space(1)))
#define LAS __attribute__((address_space(3)))
typedef GAS unsigned gu32;
#define RLX_AGENT __ATOMIC_RELAXED, __HIP_MEMORY_SCOPE_AGENT
#define XB_TMO      128
#define XB_XCNT(j)  (256  + 64 * (j))
#define XB_XSUB(j)  (1280 + 64 * (j))
#define XB_XGEN(j)  (2304 + 64 * (j))
#define XB_TOP      3328
#define XB_TOPGEN   3392
#define XCD_BAR_WORDS 3456
#define XB_SPIN_CAP (1u << 18)

__device__ __forceinline__ unsigned xb_ld(unsigned* p)              { return __hip_atomic_load(p, __ATOMIC_RELAXED, __HIP_MEMORY_SCOPE_AGENT); }
__device__ __forceinline__ unsigned xb_add(unsigned* p, unsigned v) { return __hip_atomic_fetch_add(p, v, __ATOMIC_RELAXED, __HIP_MEMORY_SCOPE_AGENT); }
__device__ __forceinline__ unsigned xb_xcc_id() { return (unsigned)__builtin_amdgcn_s_getreg((3 << 11) | 20) & 0xFu; }
#define XB_SPIN(cond, bar) do { unsigned _sp = 0; while (cond) { __builtin_amdgcn_s_sleep(1); \
    if ((++_sp & 255u) == 0u) { if (xb_ld(&(bar)[XB_TMO])) break; if (_sp > XB_SPIN_CAP) { atomicAdd(&(bar)[XB_TMO], 1u); break; } } } } while (0)

struct XcdBarrier {
    unsigned* bar; unsigned x; unsigned total;
    volatile LAS unsigned* st;
};

__device__ __forceinline__ XcdBarrier xcd_barrier_post(unsigned* bar, volatile LAS unsigned* st, unsigned total) {
    XcdBarrier b; b.bar = bar; b.x = xb_xcc_id(); b.st = st; b.total = total;
    if (threadIdx.x == 0) (void)xb_add(&bar[XB_XCNT(b.x)], 1u);
    return b;
}
__device__ __forceinline__ void xcd_barrier_complete(unsigned* bar, unsigned x, unsigned G, unsigned& nloc, unsigned& nx) {
    unsigned sum, cnt, mine, sp = 0u;
    for (;;) {
        sum = 0u; cnt = 0u; mine = 0u;
#pragma unroll
        for (unsigned j = 0; j < 16; ++j) { const unsigned c = xb_ld(&bar[XB_XCNT(j)]); sum += c; cnt += (c > 0u) ? 1u : 0u; mine = (j == x) ? c : mine; }
        if (sum == G) break;
        __builtin_amdgcn_s_sleep(1);
        if ((++sp & 255u) == 0u) { if (xb_ld(&bar[XB_TMO])) break; if (sp > XB_SPIN_CAP) { atomicAdd(&bar[XB_TMO], 1u); break; } }
    }
    nloc = mine > 0u ? mine : 1u; nx = cnt > 0u ? cnt : 1u;
}

__device__ __forceinline__ void xcd_barrier(const XcdBarrier& b) {
    asm volatile("s_waitcnt vmcnt(0)" ::: "memory");
    __syncthreads();
    if (threadIdx.x == 0) {
        unsigned* bar = b.bar;
        __builtin_amdgcn_s_waitcnt(0);
        unsigned nloc = b.st[0], nx = b.st[1];
        if (nloc == 0u) { xcd_barrier_complete(bar, b.x, b.total, nloc, nx); b.st[0] = nloc; b.st[1] = nx; }
        const unsigned old = xb_add(&bar[XB_XSUB(b.x)], 1u);
        const unsigned gen = old / nloc;
        if (old + 1u == (gen + 1u) * nloc) {
            __builtin_amdgcn_fence(__ATOMIC_RELEASE, "agent");
            asm volatile("s_waitcnt vmcnt(0)" ::: "memory");
            const unsigned og = xb_add(&bar[XB_TOP], 1u);
            const unsigned tg = og / nx;
            if (og + 1u == (tg + 1u) * nx) xb_add(&bar[XB_TOPGEN], 1u);
            else XB_SPIN(xb_ld(&bar[XB_TOPGEN]) == tg, bar);
            __builtin_amdgcn_fence(__ATOMIC_ACQUIRE, "agent");
            xb_add(&bar[XB_XGEN(b.x)], 1u);
            asm volatile("s_waitcnt vmcnt(0)" ::: "memory");
        } else {
            XB_SPIN(xb_ld(&bar[XB_XGEN(b.x)]) == gen, bar);
            __builtin_amdgcn_fence(__ATOMIC_ACQUIRE, "agent");
            asm volatile("s_waitcnt vmcnt(0)" ::: "memory");
        }
    }
    __syncthreads();
}


#define FILL_RSL(STP) do { pg8::Unit u0_; if (S.next(0, u0_)) { int tq_ = threadIdx.x; asm volatile("" : "+v"(tq_)); const int row_ = u0_.pm * 256 + (tq_ >> 1), hf_ = tq_ & 1; \
    typedef float f32x4_ __attribute__((ext_vector_type(4))); typedef float f32x2_ __attribute__((ext_vector_type(2))); \
    const f32x4_* sp_ = (const f32x4_*)((STP) + (size_t)row_ * 32 + hf_ * 16); const f32x4_ x0 = sp_[0], x1 = sp_[1], x2 = sp_[2], x3 = sp_[3]; \
    float sm_ = ((x0[0] + x0[2]) + (x1[0] + x1[2])) + ((x2[0] + x2[2]) + (x3[0] + x3[2])), sq_ = ((x0[1] + x0[3]) + (x1[1] + x1[3])) + ((x2[1] + x2[3]) + (x3[1] + x3[3])); \
    sm_ = xadd<1>(sm_); sq_ = xadd<1>(sq_); const float mu_ = sm_ * (1.f / 1024.f), rstd_ = rsqrtf(fmaxf(sq_ * (1.f / 1024.f) - mu_ * mu_, 0.f) + EPS); \
    if (hf_ == 0) *(LAS f32x2_*)(ldsl + RSL_OFF + 8 * (tq_ >> 1)) = (f32x2_){rstd_, -rstd_ * mu_}; } \
    __syncthreads(); } while (0)

enum { PH_PRO = 0, PH_IN = 1, PH_ATT = 2, PH_MIXB = 3, PH_OUT = 4, PH_GU = 5, PH_DN = 6, PH_FIN = 13, N_PHASES = 14 };
struct MArgs { const float* in[16]; float* out; unsigned char* ws; int ph_lo, ph_hi, li, pad; };

__global__ void __launch_bounds__(NWAVES * 64, 2) mk_fwd(MArgs a) {
    extern __shared__ __attribute__((aligned(128))) unsigned char lds[];
    LAS unsigned char* ldsl = (LAS unsigned char*)lds;
    volatile LAS unsigned* MISC = (volatile LAS unsigned*)(ldsl + MISC_OFF);
    const int tid = threadIdx.x;
    const int G = gridDim.x, bx = blockIdx.x, vcu = (G % 8 == 0) ? (bx % 8) * (G / 8) + bx / 8 : bx;
    unsigned char* ws = a.ws;
    for (int u = tid; u < (LDS_BYTES - LDSCTL_OFF) / 4; u += NWAVES * 64) ((LAS unsigned*)(ldsl + LDSCTL_OFF))[u] = 0u;
    __syncthreads();
    XcdBarrier bar; bar.bar = (unsigned*)(ws + WS_CTL) + CW_BAR + a.li * XCD_BAR_WORDS; bar.x = 0; bar.st = nullptr; bar.total = (unsigned)G;
    if (a.ph_hi - a.ph_lo > 1) bar = xcd_barrier_post((unsigned*)(ws + WS_CTL) + CW_BAR + a.li * XCD_BAR_WORDS, MISC + 8, (unsigned)G);
    const bool grp_ok = (G % 8 == 0) && (a.ph_hi - a.ph_lo > 1);
    XcdBarrier gbar = bar;
    if (grp_ok) gbar = xcd_barrier_post((unsigned*)(ws + WS_CTL) + CW_GBAR + (bx & 7) * GBAR_STRIDE, MISC + 10, (unsigned)(G / 8));
    const int G0 = G, bx0 = bx, vcu0 = vcu; unsigned char* const ws0 = ws;
    for (int ph = a.ph_lo; ph < a.ph_hi; ++ph) {
        int G = G0, bx = bx0, vcu = vcu0; unsigned zo = 0u; asm volatile("" : "+s"(G), "+s"(bx), "+s"(vcu), "+s"(zo)); unsigned char* ws = ws0 + zo;
        const int l = (ph >= 1 && ph <= 12) ? (ph - 1) / 6 : 0;
        const int kind = (ph == 0) ? PH_PRO : (ph == PH_FIN ? PH_FIN : 1 + (ph - 1) % 6);
        if (kind == PH_PRO) {
            { pro::Inputs pin{a.in[0], a.in[1], a.in[4], a.in[5], a.in[8], a.in[9], a.in[10], a.in[11], a.in[12], a.in[13], a.in[14], a.in[15]}; pro::prologue(ws, pin, ldsl + RING_OFF, vcu, G); }
        } else if (kind == PH_IN) {
            pg8::Gemm g{(const bf16_t*)(ws + WS_XB), (const bf16_t*)(ws + WS_WIN + l * SZ_WIN), T, NIN, D}; pg8::StaticOrder S; S.init(T, NIN, G, bx);
            if (l) FILL_RSL((const float*)(ws + WS_ST2));
            pg8::FEpiIn E{ws, a.in[6] + l * 256, l, (const LAS float*)(ldsl + RSL_OFF)};
            pg8::gemm_phase<pg8::FEpiIn, pg8::StaticOrder, true, true>(ldsl + RING_OFF, g, S, E);
        } else if (kind == PH_ATT) {
            for (int i = 0; i < 2; ++i) { const int idx = vcu * 2 + i; if (idx >= 512) break; const int bh = idx >> 4, qb = idx & 15;
                att::attn_unit(bh >> 2, bh & 3, qb, (const bf16_t*)(ws + WS_Q), (const bf16_t*)(ws + WS_K), (const bf16_t*)(ws + WS_V), (bf16_t*)(ws + WSB_OC + (size_t)(bh >> 2) * DLT_OC), a.in[2] + l * 256, a.in[3] + l * 128, l, (char*)lds + RING_OFF); }
            for (int i = 0; i < 2; ++i) { const int it = vcu * 2 + i; if (it >= 512) break;
                                fft::stage1_item(it >> 6, it & 63, (const bf16_t*)(ws + WS_TAB), (bf16_t*)(ws + WS_XT), ldsl + RING_OFF); }

            if (vcu < 256) gla::gla_a_item(vcu >> 5, (vcu >> 3) & 3, vcu & 7, ws, ldsl + RING_OFF);
        } else if (kind == PH_MIXB) {
            if (vcu < 256) fft::stage2_item(vcu >> 5, vcu & 31, (const bf16_t*)(ws + WS_XT), (bf16_t*)(ws + WSB_OC + (size_t)(vcu >> 5) * DLT_OC), ldsl + RING_OFF);
            if (vcu < 256) gla::gla_b_item(vcu >> 5, (vcu >> 3) & 3, vcu & 7, ws, a.in[7] + l * 64, (bf16_t*)(ws + WSB_OC + (size_t)(vcu >> 5) * DLT_OC), ldsl + RING_OFF);
        } else if (kind == PH_OUT) {
            pg8::Gemm g{(const bf16_t*)(ws + WSB_OC + (size_t)(bx & 7) * DLT_OC), (const bf16_t*)(ws + WS_WOUT + l * SZ_WOUT), T, D, D}; pg8::StaticOrder S; S.init(T, D, G, bx);
            if (l) FILL_RSL((const float*)(ws + WS_ST2));
            pg8::FEpiRes E{l ? (const LAS float*)(ldsl + RSL_OFF) : (const LAS float*)nullptr, a.in[14] + (l ? l - 1 : 0) * 1024, a.in[15] + (l ? l - 1 : 0) * 1024, (bf16_t*)(ws + WS_XB), (float*)(ws + WS_ST1)};
            pg8::gemm_phase<pg8::FEpiRes, pg8::StaticOrder, true, true>(ldsl + RING_OFF, g, S, E);
        } else if (kind == PH_GU) {
            pg8::Gemm g{(const bf16_t*)(ws + WS_XB), (const bf16_t*)(ws + WS_WGU + l * SZ_WGU), T, NGU, D}; pg8::StaticOrder S; S.init(T, NGU, G, bx);
            FILL_RSL((const float*)(ws + WS_ST1));
            pg8::FEpiGU E{(const LAS float*)(ldsl + RSL_OFF), (const float*)(ws + V_C1GU) + l * NGU, (const float*)(ws + V_C2GU) + l * NGU, (bf16_t*)(ws + WS_ACT)};
            pg8::gemm_phase<pg8::FEpiGU, pg8::StaticOrder, true, true>(ldsl + RING_OFF, g, S, E);
        } else if (kind == PH_DN) {
            pg8::Gemm g{(const bf16_t*)(ws + WS_ACT), (const bf16_t*)(ws + WS_WDN + l * SZ_WDN), T, D, FF}; pg8::StaticOrder S; S.init(T, D, G, bx);
            FILL_RSL((const float*)(ws + WS_ST1));
            pg8::FEpiRes E{(const LAS float*)(ldsl + RSL_OFF), a.in[9] + l * 1024, a.in[10] + l * 1024, (bf16_t*)(ws + WS_XB), (float*)(ws + WS_ST2)};
            pg8::gemm_phase<pg8::FEpiRes, pg8::StaticOrder, true, true>(ldsl + RING_OFF, g, S, E);
        } else if (kind == PH_FIN) {
            const float* g2 = a.in[14] + 1024; const float* b2v = a.in[15] + 1024; const float* ST2 = (const float*)(ws + WS_ST2); const bf16_t* XB = (const bf16_t*)(ws + WS_XB); float* Y2 = a.out;
            int tid_f = threadIdx.x; asm volatile("" : "+v"(tid_f)); const int lane = tid_f & 63, wave = __builtin_amdgcn_readfirstlane(tid_f >> 6);
            typedef float f32x4 __attribute__((ext_vector_type(4))); typedef unsigned u32x2 __attribute__((ext_vector_type(2)));
            f32x4 gg[4], bq[4];
#pragma unroll
            for (int j = 0; j < 4; ++j) { gg[j] = *((const f32x4*)g2 + lane + 64 * j); bq[j] = *((const f32x4*)b2v + lane + 64 * j); }
            const bool grp_rows = (G % 8 == 0) && (S % ((G / 8) * NWAVES) == 0);
            const int r_first = grp_rows ? (bx & 7) * S + (bx >> 3) * NWAVES + wave : vcu * NWAVES + wave, r_step = grp_rows ? (G / 8) * NWAVES : G * NWAVES, r_end = grp_rows ? (bx & 7) * S + S : T;
            for (int row = r_first; row < r_end; row += r_step) { const RowStat rs = row_stat(ST2, row);
                const u32x2* xr = (const u32x2*)(XB + (size_t)row * 1024) + lane; f32x4* yr = (f32x4*)(Y2 + (size_t)row * 1024) + lane;
#pragma unroll
                for (int j = 0; j < 4; ++j) { const u32x2 w = xr[64 * j]; const f32x4 v = {__uint_as_float(w.x << 16), __uint_as_float(w.x & 0xffff0000u), __uint_as_float(w.y << 16), __uint_as_float(w.y & 0xffff0000u)};
                    yr[64 * j] = (v - rs.mu) * rs.rstd * gg[j] + bq[j]; } }
        }
        if (ph + 1 < a.ph_hi) { const bool local = grp_ok && kind != PH_PRO; if (local) xcd_barrier(gbar); else xcd_barrier(bar); }
    }
}

static void launch_frame(const MArgs& base, int lo, int hi, int grid, hipStream_t stream, int li = 0) {
    MArgs a = base; a.ph_lo = lo; a.ph_hi = hi; a.li = li;
    hipLaunchKernelGGL(mk_fwd, dim3(grid), dim3(NWAVES * 64), LDS_BYTES, stream, a);
}
extern "C" void kernel_launch(void* const* d_in, const int* in_sizes, int n_in, void* d_out, int out_size, void* d_ws, size_t ws_size, hipStream_t stream) {
    static int grid = 0;
    if (grid == 0) {
        if (n_in != 16 || in_sizes[0] != T * D || out_size != T * D || ws_size < WS_END) { fprintf(stderr, "kernel_launch: unexpected shapes (n_in %d, in0 %d, out %d, ws %zu)\n", n_in, n_in > 0 ? in_sizes[0] : -1, out_size, ws_size); grid = -1; return; }
        int dev = 0, cus = 0, per_cu = 0;
        if (hipGetDevice(&dev) != hipSuccess || hipDeviceGetAttribute(&cus, hipDeviceAttributeMultiprocessorCount, dev) != hipSuccess) { grid = -1; return; }
        if (hipFuncSetAttribute((const void*)mk_fwd, hipFuncAttributeMaxDynamicSharedMemorySize, LDS_BYTES) != hipSuccess) { fprintf(stderr, "kernel_launch: hipFuncSetAttribute failed\n"); grid = -1; return; }
        if (hipOccupancyMaxActiveBlocksPerMultiprocessor(&per_cu, (const void*)mk_fwd, NWAVES * 64, LDS_BYTES) != hipSuccess || per_cu < 1) { fprintf(stderr, "kernel_launch: occupancy query says %d workgroups per CU\n", per_cu); per_cu = 1; }
        (void)hipGetLastError();
        grid = cus;
        if (grid != 256) { fprintf(stderr, "kernel_launch: this kernel's work split is built for the 256 CUs of an MI355X, found %d; nothing launched\n", cus); grid = -1; return; }
    }
    if (grid < 0) return;
    const float* x = (const float*)d_in[0]; const float* w_in = (const float*)d_in[1]; const float* dlam = (const float*)d_in[2]; const float* dng = (const float*)d_in[3];
    const float* fw = (const float*)d_in[4]; const float* gw2 = (const float*)d_in[5]; const float* gb2 = (const float*)d_in[6]; const float* gng = (const float*)d_in[7];
    const float* w_out = (const float*)d_in[8]; const float* ln1g = (const float*)d_in[9]; const float* ln1b = (const float*)d_in[10];
    const float* wg = (const float*)d_in[11]; const float* wu = (const float*)d_in[12]; const float* wd = (const float*)d_in[13]; const float* ln2g = (const float*)d_in[14]; const float* ln2b = (const float*)d_in[15];
    char* ws = (char*)d_ws;
    float* ropec = (float*)(ws + V_ROPEC); float* ropes = (float*)(ws + V_ROPES); float* MF = (float*)(ws + V_MF);
    float* c1in = (float*)(ws + V_C1IN); float* c2in = (float*)(ws + V_C2IN); float* c1gu = (float*)(ws + V_C1GU); float* c2gu = (float*)(ws + V_C2GU);
    bf16_t* TAB = (bf16_t*)(ws + WS_TAB); bf16_t* XB = (bf16_t*)(ws + WS_XB);
    bf16_t* Q = (bf16_t*)(ws + WS_Q); bf16_t* K = (bf16_t*)(ws + WS_K); bf16_t* V = (bf16_t*)(ws + WS_V);
    bf16_t* GQK = (bf16_t*)(ws + WS_GQK); bf16_t* GV = (bf16_t*)(ws + WS_GV); bf16_t* GR = (bf16_t*)(ws + WS_GR); float* GL = (float*)(ws + WS_GL);
    bf16_t* OC = (bf16_t*)(ws + WS_OC); float* OF = (float*)(ws + WS_OF);
    (void)hipMemsetAsync(ws + WS_CTL, 0, CTL_ZERO_BYTES, stream);
    MArgs base{}; for (int i = 0; i < 16; ++i) base.in[i] = (const float*)d_in[i]; base.out = (float*)d_out; base.ws = (unsigned char*)d_ws;
    launch_frame(base, 0, N_PHASES, grid, stream, 0);
}
```

```cpp
#include <hip/hip_runtime.h>
#include <cstdint>
#include <cstdio>
#include <cmath>

typedef unsigned short bf16_t;
namespace cfg {
constexpr int B = 8, S = 2048, D = 1024, T = B * S, L = 2;
constexpr int INW = 2592, NIN = 3072, FF = 2816, NGU = 2 * FF;
constexpr float ALPHA = 1.41421356237309515f;
constexpr float EPS = 1e-5f;
constexpr float QSCALE = 0.125f * 1.4426950408889634f;
constexpr float GQSCALE = 0.17677669529663687f;
constexpr size_t MiB = 1u << 20;
constexpr size_t WS_CTL = 0;
constexpr size_t WS_VEC = 1 * MiB;
constexpr size_t V_ROPEC = WS_VEC, V_ROPES = WS_VEC + 256 * 1024, V_MF = WS_VEC + 512 * 1024;
constexpr size_t V_C1IN = WS_VEC + 768 * 1024, V_C2IN = V_C1IN + 24 * 1024, V_C1GU = V_C2IN + 24 * 1024, V_C2GU = V_C1GU + 44 * 1024;
constexpr size_t WS_WIN = 2 * MiB, WS_WOUT = 14 * MiB, WS_WGU = 18 * MiB, WS_WDN = 40 * MiB, WS_TAB = 51 * MiB;
constexpr size_t SZ_WIN = 6 * MiB, SZ_WOUT = 2 * MiB, SZ_WGU = 11 * MiB, SZ_WDN = 5632 * 1024;
constexpr size_t WS_XB = 67 * MiB;
constexpr size_t WS_Y1 = 99 * MiB, WS_Q = 99 * MiB, WS_K = 115 * MiB, WS_V = 131 * MiB, WS_XT = 147 * MiB;
constexpr size_t WS_ACT = 163 * MiB, WS_GQK = 163 * MiB, WS_GV = 171 * MiB, WS_GR = 179 * MiB, WS_GL = 187 * MiB, WS_OC = 203 * MiB, WS_OF = 235 * MiB;
constexpr size_t WSB_GQK = WS_ACT, WSB_GV = WS_ACT + 1 * MiB, WSB_GR = WS_ACT + 2 * MiB, WSB_GL = WS_ACT + 3 * MiB, WSB_OC = WS_ACT + 5 * MiB, WSB_OF = WS_ACT + 9 * MiB;
constexpr size_t DLT_GQK = 10 * MiB, DLT_GV = 10 * MiB, DLT_GR = 10 * MiB, DLT_GL = 9 * MiB, DLT_OC = 7 * MiB, DLT_OF = 9 * MiB;
constexpr size_t WS_ST1 = 251 * MiB, WS_ST2 = 253 * MiB, WS_DEC = 255 * MiB, WS_END = 256 * MiB;
}
using namespace cfg;

__device__ __forceinline__ float bf2f(bf16_t v) { return __uint_as_float((unsigned)v << 16); }
__device__ __forceinline__ bf16_t f2bf(float f) { unsigned u = __float_as_uint(f); return (bf16_t)((u + 0x7fffu + ((u >> 16) & 1u)) >> 16); }


template <int M> __device__ __forceinline__ float xadd(float v) {
    if constexpr (M == 32) { auto r = __builtin_amdgcn_permlane32_swap(__float_as_uint(v), __float_as_uint(v), false, false); return __uint_as_float(r[0]) + __uint_as_float(r[1]); }
    else return v + __int_as_float(__builtin_amdgcn_ds_swizzle(__float_as_int(v), (M << 10) | 0x1f));
}
struct RowStat { float mu, rstd; };
__device__ __forceinline__ RowStat row_stat(const float* ST, int row) {
    float s = 0.f, ss = 0.f;
    for (int i = 0; i < 8; ++i) { const float4 a = *(const float4*)(ST + (size_t)row * 32 + 4 * i); s += a.x + a.z; ss += a.y + a.w; }
    const float mu = s * (1.f / 1024.f); const float var = ss * (1.f / 1024.f) - mu * mu;
    RowStat r; r.mu = mu; r.rstd = rsqrtf(fmaxf(var, 0.f) + EPS); return r;
}
namespace pg8 {
#define PG8_LAS __attribute__((address_space(3)))
typedef unsigned short bf16_t;
typedef short bf16x8 __attribute__((ext_vector_type(8)));
typedef float f32x4 __attribute__((ext_vector_type(4)));
typedef unsigned u32x4 __attribute__((ext_vector_type(4)));
constexpr int BM = 256, BK = 64, HALF = 128, HTB = HALF * BK * 2  , STAGE_BYTES = 8 * HTB, NXCD = 8, WGM = 8;

__host__ __device__ __forceinline__ int lds_byte(int r, int c) { const int st = (r >> 4) * 2 + (c >> 5), rr = r & 15, cc = c & 31, ob = rr * 64 + cc * 2; return st * 1024 + (ob ^ (((ob >> 9) & 1) << 5)); }
__host__ __device__ __forceinline__ void stage_rc(int b, int& R, int& C) { const int st = b / 1024, sb = b % 1024, swz = sb ^ (((sb >> 9) & 1) << 5); R = (st >> 1) * 16 + swz / 64; C = (st & 1) * 32 + (swz % 64) / 2; }
__host__ __device__ __forceinline__ int perm32(int rho) { const int n = rho >> 4, i = rho & 15; return 8 * (i >> 2) + 4 * n + (i & 3); }

struct Unit { int pm, pn; };
struct Gemm { const bf16_t* A; const bf16_t* Bt; int M, N, K; };

struct StaticOrder {
    int nM, nN, nwg, G, c;
    __host__ __device__ void init(int M, int N, int G_, int c_) { nM = M / BM; nN = N / BM; nwg = nM * nN; G = G_; c = c_; }
    __host__ __device__ bool next(int i, Unit& u) const {
        const long L = (long)i * G + c; if (L >= nwg) return false;
        int wgid = (int)L; { const int q = nwg / NXCD, r = nwg % NXCD, xcd = wgid % NXCD, off = wgid / NXCD; wgid = (xcd < r ? xcd * (q + 1) : r * (q + 1) + (xcd - r) * q) + off; }
        const int nig = WGM * nN, gid = wgid / nig, fm = gid * WGM, gsz = (nM - fm) < WGM ? (nM - fm) : WGM;
        u.pm = fm + ((wgid % nig) % gsz); u.pn = (wgid % nig) / gsz; return true;
    }
    __device__ __forceinline__ void a_ready(const Unit&) const {}
    __device__ __forceinline__ void done(const Unit&) const {}
};
template <class Epi, class Sched, bool ALIGN_EPI = false, bool SP2 = false>
__device__ __forceinline__ void gemm_phase(PG8_LAS unsigned char* lds, const Gemm g, const Sched& S, const Epi& E) {
    int tid_o = threadIdx.x; asm volatile("" : "+v"(tid_o));
    const int tid = tid_o, wid = __builtin_amdgcn_readfirstlane(tid >> 6), lane = tid & 63, wr = wid >> 2, wc = wid & 3, fr = lane & 15, fq = lane >> 4;
    const int K = g.K, nt = K / BK;
    unsigned voffA[2], voffB[2];
#pragma unroll
    for (int i = 0; i < 2; ++i) { int R, C; stage_rc(tid * 16 + i * 8192, R, C); const int Rb = Epi::PERM ? ((R & ~31) + perm32(R & 31)) : R;
        voffA[i] = (unsigned)(R * K + C) * 2u; voffB[i] = (unsigned)(Rb * K + C) * 2u; }
    const size_t kstep = (size_t)(BK * 2);
    const size_t hstep = (size_t)HALF * K * 2;
    const size_t tstep = 2 * hstep;
    const unsigned ldsw = (unsigned)wid * 1024u;
    const int aoff = lds_byte(wr * 64 + fr, fq * 8), boff = lds_byte(wc * 32 + fr, fq * 8);
#define PG8_SA(b, h) (((b) * 2 + (h)) * HTB)
#define PG8_SB(b, h) ((4 + (b) * 2 + (h)) * HTB)
#define PG8_STAGE(bufoff, gbase, voff) do { _Pragma("unroll") for (int _i = 0; _i < 2; ++_i) \
        __builtin_amdgcn_global_load_lds((const unsigned*)((const char*)(gbase) + (voff)[_i]), (PG8_LAS unsigned*)(lds + (bufoff) + ldsw + _i * 8192), 16, 0, 0); } while (0)
#define PG8_LDA(dst, b, h) do { _Pragma("unroll") for (int m = 0; m < 4; ++m) _Pragma("unroll") for (int k = 0; k < 2; ++k) dst[m][k] = *(const PG8_LAS bf16x8*)(lds + PG8_SA(b, h) + aoff + m * 2048 + k * 1024); } while (0)
#define PG8_LDB(dst, b, h) do { _Pragma("unroll") for (int n = 0; n < 2; ++n) _Pragma("unroll") for (int k = 0; k < 2; ++k) dst[n][k] = *(const PG8_LAS bf16x8*)(lds + PG8_SB(b, h) + boff + n * 2048 + k * 1024); } while (0)
#define PG8_MMA(ai, bj, At, Bt) do { __builtin_amdgcn_s_setprio(1); _Pragma("unroll") for (int m = 0; m < 4; ++m) _Pragma("unroll") for (int n = 0; n < 2; ++n) _Pragma("unroll") for (int k = 0; k < 2; ++k) \
        acc[ai][bj][m][n] = __builtin_amdgcn_mfma_f32_16x16x32_bf16(Bt[n][k], At[m][k], acc[ai][bj][m][n], 0, 0, 0); __builtin_amdgcn_s_setprio(0); } while (0)
#define PG8_WAIT_V(n) asm volatile("s_waitcnt vmcnt(" #n ")" ::: "memory")
#define PG8_WAIT_L(n) asm volatile("s_waitcnt lgkmcnt(" #n ")" ::: "memory")
#define PG8_BAR __builtin_amdgcn_s_barrier()
#define PG8_SCHED __builtin_amdgcn_sched_barrier(0)
    Unit cur, nxt; int ui = 0;
    if (!S.next(0, cur)) return;
    f32x4 acc[2][2][4][2];
#pragma unroll
    for (int a = 0; a < 2; ++a)
#pragma unroll
        for (int b = 0; b < 2; ++b)
#pragma unroll
            for (int m = 0; m < 4; ++m)
#pragma unroll
                for (int n = 0; n < 2; ++n) acc[a][b][m][n] = (f32x4){0.f, 0.f, 0.f, 0.f};
    bf16x8 At[4][2], B0[2][2], B1[2][2];
    const char* cA = (const char*)g.A + (size_t)cur.pm * tstep; const char* cB = (const char*)g.Bt + (size_t)cur.pn * tstep;
    S.a_ready(cur);
    if constexpr (SP2) {
        PG8_STAGE(PG8_SB(0, 0), cB, voffB); PG8_STAGE(PG8_SB(0, 1), cB + hstep, voffB); PG8_STAGE(PG8_SA(0, 0), cA, voffA); PG8_STAGE(PG8_SA(0, 1), cA + hstep, voffA);
        if (wr == 1) PG8_BAR;
        PG8_WAIT_V(2); PG8_BAR;
        PG8_STAGE(PG8_SB(1, 0), cB + kstep, voffB); PG8_STAGE(PG8_SA(1, 0), cA + kstep, voffA); PG8_STAGE(PG8_SB(1, 1), cB + hstep + kstep, voffB);
        PG8_WAIT_V(6); PG8_BAR;
    } else {
        PG8_STAGE(PG8_SB(0, 0), cB, voffB); PG8_STAGE(PG8_SA(0, 0), cA, voffA); PG8_STAGE(PG8_SB(0, 1), cB + hstep, voffB); PG8_STAGE(PG8_SA(0, 1), cA + hstep, voffA);
        if (wr == 1) PG8_BAR;
        PG8_WAIT_V(4); PG8_BAR;
        PG8_STAGE(PG8_SB(1, 0), cB + kstep, voffB); PG8_STAGE(PG8_SA(1, 0), cA + kstep, voffA); PG8_STAGE(PG8_SB(1, 1), cB + hstep + kstep, voffB);
        PG8_WAIT_V(6); PG8_BAR;
    }
    for (;;) {
        const bool has_next = S.next(ui + 1, nxt);
        const char* nA = has_next ? (const char*)g.A + (size_t)nxt.pm * tstep : cA; const char* nB = has_next ? (const char*)g.Bt + (size_t)nxt.pn * tstep : cB;
        for (int t = 0; t < nt; t += 2) {
            const bool last = (t == nt - 2);
            const char* a1 = cA + (size_t)(t + 1) * kstep;
            const char* a2 = last ? nA : cA + (size_t)(t + 2) * kstep; const char* b2 = last ? nB : cB + (size_t)(t + 2) * kstep;
            const char* a3 = a2 + kstep; const char* b3 = b2 + kstep;
            if (last && has_next) S.a_ready(nxt);
            if constexpr (SP2) {
            PG8_LDB(B0, 0, 0); PG8_LDB(B1, 0, 1); PG8_SCHED; PG8_LDA(At, 0, 0); PG8_STAGE(PG8_SA(1, 1), a1 + hstep, voffA);
            PG8_WAIT_V(8); PG8_WAIT_L(0); PG8_BAR; PG8_MMA(0, 0, At, B0); PG8_MMA(0, 1, At, B1); PG8_BAR; PG8_SCHED;
            PG8_LDA(At, 0, 1); PG8_STAGE(PG8_SB(0, 0), b2, voffB); PG8_STAGE(PG8_SB(0, 1), b2 + hstep, voffB); PG8_STAGE(PG8_SA(0, 0), a2, voffA);
            PG8_WAIT_V(8); PG8_WAIT_L(0); PG8_BAR; PG8_MMA(1, 0, At, B0); PG8_MMA(1, 1, At, B1); PG8_BAR; PG8_SCHED;
            PG8_LDB(B0, 1, 0); PG8_LDB(B1, 1, 1); PG8_SCHED; PG8_LDA(At, 1, 0); PG8_STAGE(PG8_SA(0, 1), a2 + hstep, voffA);
            PG8_WAIT_V(8); PG8_WAIT_L(0); PG8_BAR; PG8_MMA(0, 0, At, B0); PG8_MMA(0, 1, At, B1); PG8_BAR; PG8_SCHED;
            PG8_LDA(At, 1, 1); PG8_STAGE(PG8_SB(1, 0), b3, voffB); PG8_STAGE(PG8_SB(1, 1), b3 + hstep, voffB); PG8_STAGE(PG8_SA(1, 0), a3, voffA);
            PG8_WAIT_V(8); PG8_WAIT_L(0); PG8_BAR; PG8_MMA(1, 0, At, B0); PG8_MMA(1, 1, At, B1); PG8_BAR; PG8_SCHED;
            } else {
            PG8_LDB(B0, 0, 0); PG8_SCHED; PG8_LDA(At, 0, 0); PG8_STAGE(PG8_SA(1, 1), a1 + hstep, voffA);
            PG8_WAIT_L(8); PG8_BAR; PG8_WAIT_L(0); PG8_MMA(0, 0, At, B0); PG8_BAR; PG8_SCHED;
            PG8_LDB(B1, 0, 1); PG8_STAGE(PG8_SB(0, 0), b2, voffB);
            PG8_BAR; PG8_WAIT_L(0); PG8_MMA(0, 1, At, B1); PG8_BAR;
            PG8_LDA(At, 0, 1); PG8_STAGE(PG8_SA(0, 0), a2, voffA);
            PG8_BAR; PG8_WAIT_L(0); PG8_MMA(1, 0, At, B0); PG8_BAR; PG8_SCHED;
            PG8_STAGE(PG8_SB(0, 1), b2 + hstep, voffB);
            PG8_WAIT_V(6); PG8_BAR; PG8_MMA(1, 1, At, B1); PG8_BAR;
            PG8_LDB(B0, 1, 0); PG8_SCHED; PG8_LDA(At, 1, 0); PG8_STAGE(PG8_SA(0, 1), a2 + hstep, voffA);
            PG8_WAIT_L(8); PG8_BAR; PG8_WAIT_L(0); PG8_MMA(0, 0, At, B0); PG8_BAR; PG8_SCHED;
            PG8_LDB(B1, 1, 1); PG8_STAGE(PG8_SB(1, 0), b3, voffB);
            PG8_BAR; PG8_WAIT_L(0); PG8_MMA(0, 1, At, B1); PG8_BAR;
            PG8_LDA(At, 1, 1); PG8_STAGE(PG8_SA(1, 0), a3, voffA);
            PG8_BAR; PG8_WAIT_L(0); PG8_MMA(1, 0, At, B0); PG8_BAR; PG8_SCHED;
            PG8_STAGE(PG8_SB(1, 1), b3 + hstep, voffB);
            PG8_WAIT_V(6); PG8_BAR; PG8_MMA(1, 1, At, B1); PG8_BAR;
            }
        }
        if constexpr (ALIGN_EPI) { if (wr == 0) PG8_BAR; }
        if constexpr (!Epi::AFTER_DRAIN) { E(acc, cur, wr, wc, fr, fq); S.done(cur); }
        if (!has_next) break;
#pragma unroll
        for (int a = 0; a < 2; ++a)
#pragma unroll
            for (int b = 0; b < 2; ++b)
#pragma unroll
                for (int m = 0; m < 4; ++m)
#pragma unroll
                    for (int n = 0; n < 2; ++n) acc[a][b][m][n] = (f32x4){0.f, 0.f, 0.f, 0.f};
        cur = nxt; cA = nA; cB = nB; ++ui;
        if constexpr (ALIGN_EPI) { if (wr == 1) PG8_BAR; }
    }
    PG8_WAIT_V(0);
    if constexpr (!ALIGN_EPI) { if (wr == 0) PG8_BAR; }
    PG8_BAR;
    if constexpr (Epi::AFTER_DRAIN) { E.fused(acc, cur, wr, wc, fr, fq, lds, wid, lane); S.done(cur); }
#undef PG8_SA
#undef PG8_SB
#undef PG8_STAGE
#undef PG8_LDA
#undef PG8_LDB
#undef PG8_MMA
#undef PG8_WAIT_V
#undef PG8_WAIT_L
#undef PG8_BAR
#undef PG8_SCHED
}
}
namespace pg8 {
__device__ __forceinline__ unsigned cvt_pk_bf16(float lo, float hi) { unsigned r; asm volatile("v_cvt_pk_bf16_f32 %0, %1, %2" : "=v"(r) : "v"(lo), "v"(hi)); return r; }
__device__ __forceinline__ void st8(bf16_t* p, const f32x4 a, const f32x4 b) { u32x4 w; w.x = cvt_pk_bf16(a[0], a[1]); w.y = cvt_pk_bf16(a[2], a[3]); w.z = cvt_pk_bf16(b[0], b[1]); w.w = cvt_pk_bf16(b[2], b[3]); *(u32x4*)p = w; }
__device__ __forceinline__ void st8nt(bf16_t* p, const f32x4 a, const f32x4 b) { u32x4 w; w.x = cvt_pk_bf16(a[0], a[1]); w.y = cvt_pk_bf16(a[2], a[3]); w.z = cvt_pk_bf16(b[0], b[1]); w.w = cvt_pk_bf16(b[2], b[3]); __builtin_nontemporal_store(w, (u32x4*)p); }
struct RS { float a, b; };
struct StatLd { f32x4 x, y; };
__device__ __forceinline__ StatLd stat_load(const float* ST, int row, int fq) { const f32x4* p = (const f32x4*)(ST + (size_t)row * 32 + fq * 8); StatLd r; r.x = p[0]; r.y = p[1]; return r; }
__device__ __forceinline__ RS stat_fin(const StatLd& t) {
    float s = (t.x[0] + t.x[2]) + (t.y[0] + t.y[2]), ss = (t.x[1] + t.x[3]) + (t.y[1] + t.y[3]);
    s = xadd<16>(s); ss = xadd<16>(ss); s = xadd<32>(s); ss = xadd<32>(ss);
    const float mu = s * (1.f / 1024.f), var = ss * (1.f / 1024.f) - mu * mu, rstd = rsqrtf(fmaxf(var, 0.f) + cfg::EPS);
    RS r; r.a = rstd; r.b = -rstd * mu; return r;
}
__device__ __forceinline__ RS row_stat16(const float* ST, int row, int fq) { return stat_fin(stat_load(ST, row, fq)); }
__device__ __forceinline__ float fsilu(float x) { return x * __builtin_amdgcn_rcpf(1.f + __expf(-x)); }
__device__ __forceinline__ float flogsig16(float x) { return (fminf(x, 0.f) - __logf(1.f + __expf(-fabsf(x)))) * (1.f / 16.f); }

struct FEpiIn {
    static constexpr bool PERM = true, AFTER_DRAIN = false;
    unsigned char* ws; const float* b2; int l; const PG8_LAS float* rsl;
    struct RowLd { f32x4 rc[2], rsn[2]; };
    template <int KIND> __device__ __forceinline__ RowLd load_row(int row, const float (&invf)[8]) const {
        RowLd r;
        if constexpr (KIND == 0) { const float pos = (float)(row & 2047);
#pragma unroll
            for (int e = 0; e < 8; ++e) { const float ang = pos * invf[e]; double rv = (double)ang * 0.15915494309189535; rv -= floor(rv); const float rev = (float)rv;
                r.rc[e >> 2][e & 3] = __builtin_amdgcn_cosf(rev); r.rsn[e >> 2][e & 3] = __builtin_amdgcn_sinf(rev); } }
        return r;
    }
    template <int KIND> __device__ __forceinline__ void rows(const f32x4 (&acc)[2][2][4][2], const Unit& u, int wr, int wc, int fr, int fq) const {
        const int pn = u.pn, cw = 32 * wc + 8 * fq, row0 = u.pm * BM + 64 * wr + fr;
        const bool st = l != 0;
        f32x4 k1[2][2], k2[2][2], bias[2][2];
        const float qs = __uint_as_float(__builtin_amdgcn_readfirstlane(__float_as_uint(pn < 2 ? cfg::QSCALE : 1.f)));
        float invf[8];
        if constexpr (KIND == 0) {
#pragma unroll
            for (int e = 0; e < 8; ++e) invf[e] = exp2f(-(float)(8 * fq + e) * (13.287712379549449f / 32.f)); }
        RowLd cur = load_row<KIND>(row0, invf), nxt;
        if (st) {
#pragma unroll
            for (int bj = 0; bj < 2; ++bj)
#pragma unroll
                for (int n = 0; n < 2; ++n) {
                    if constexpr (KIND == 2) {
                        const float* fp = (const float*)(ws + cfg::V_MF) + (size_t)(l * 8) * 512 + (pn - 6) * 256 + cw + 128 * bj + 4 * n;
                        k1[bj][n] = (*(const f32x4*)fp + *(const f32x4*)(fp + 1024)) + (*(const f32x4*)(fp + 2048) + *(const f32x4*)(fp + 3072));
                        k2[bj][n] = (*(const f32x4*)(fp + 512) + *(const f32x4*)(fp + 1536)) + (*(const f32x4*)(fp + 2560) + *(const f32x4*)(fp + 3584));
                    } else { const float* c1 = (const float*)(ws + cfg::V_C1IN) + l * cfg::NIN + pn * 256 + cw; const float* c2 = (const float*)(ws + cfg::V_C2IN) + l * cfg::NIN + pn * 256 + cw;
                        k1[bj][n] = *(const f32x4*)(c1 + 128 * bj + 4 * n); k2[bj][n] = *(const f32x4*)(c2 + 128 * bj + 4 * n); } } }
        if constexpr (KIND == 6) {
#pragma unroll
            for (int bj = 0; bj < 2; ++bj)
#pragma unroll
                for (int n = 0; n < 2; ++n) bias[bj][n] = *(const f32x4*)(b2 + 128 * bj + cw + 4 * n); }
#pragma unroll
        for (int i = 0; i < 8; ++i) {
            const int ai = i >> 2, m = i & 3, row = row0 + 128 * ai + 16 * m, pos = row & 2047;
            if (i < 7) nxt = load_row<KIND>(row0 + 128 * ((i + 1) >> 2) + 16 * ((i + 1) & 3), invf);
            f32x4 v[2][2];
            if (st) { typedef float f32x2 __attribute__((ext_vector_type(2))); const f32x2 t2 = *(const PG8_LAS f32x2*)(rsl + 2 * (128 * ai + 64 * wr + 16 * m + fr)); RS rs; rs.a = t2[0]; rs.b = t2[1];
#pragma unroll
                for (int bj = 0; bj < 2; ++bj)
#pragma unroll
                    for (int n = 0; n < 2; ++n) v[bj][n] = rs.a * acc[ai][bj][m][n] + (rs.b * k1[bj][n] + k2[bj][n]);
            } else {
#pragma unroll
                for (int bj = 0; bj < 2; ++bj)
#pragma unroll
                    for (int n = 0; n < 2; ++n) v[bj][n] = acc[ai][bj][m][n]; }
            if constexpr (KIND == 0) {
                f32x4 a0 = v[0][0] * cur.rc[0] - v[1][0] * cur.rsn[0], a1 = v[0][1] * cur.rc[1] - v[1][1] * cur.rsn[1];
                f32x4 b0 = v[1][0] * cur.rc[0] + v[0][0] * cur.rsn[0], b1 = v[1][1] * cur.rc[1] + v[0][1] * cur.rsn[1];
                a0 = a0 * qs; a1 = a1 * qs; b0 = b0 * qs; b1 = b1 * qs;
                bf16_t* dst = (bf16_t*)(ws + (pn < 2 ? cfg::WS_Q : cfg::WS_K)) + (size_t)row * 512 + (4 * (pn & 1) + wc) * 64 + 8 * fq;
                st8(dst, a0, a1); st8(dst + 32, b0, b1);
            } else if constexpr (KIND == 1) {
                bf16_t* dst = (bf16_t*)(ws + cfg::WS_V) + (size_t)row * 512 + (pn - 4) * 256 + cw; st8(dst, v[0][0], v[0][1]); st8(dst + 128, v[1][0], v[1][1]);
            } else if constexpr (KIND == 2) {
                bf16_t* dst = (bf16_t*)(ws + cfg::WS_TAB) + (size_t)row * 512 + (pn - 6) * 256 + cw; st8(dst, v[0][0], v[0][1]); st8(dst + 128, v[1][0], v[1][1]);
            } else if constexpr (KIND == 3) {
                bf16_t* dst = (bf16_t*)(ws + cfg::WSB_GQK + (size_t)(u.pm >> 3) * cfg::DLT_GQK) + (size_t)row * 256 + cw; st8(dst, v[0][0] * cfg::GQSCALE, v[0][1] * cfg::GQSCALE); st8(dst + 128, v[1][0], v[1][1]);
            } else if constexpr (KIND == 4) {
                bf16_t* dst = (bf16_t*)(ws + cfg::WSB_GV + (size_t)(u.pm >> 3) * cfg::DLT_GV) + (size_t)row * 256 + cw; st8(dst, v[0][0], v[0][1]); st8(dst + 128, v[1][0], v[1][1]);
            } else if constexpr (KIND == 5) {
                bf16_t* dst = (bf16_t*)(ws + cfg::WSB_GR + (size_t)(u.pm >> 3) * cfg::DLT_GR) + (size_t)row * 256 + cw;
#pragma unroll
                for (int bj = 0; bj < 2; ++bj) { f32x4 x0 = v[bj][0], x1 = v[bj][1];
#pragma unroll
                    for (int e = 0; e < 4; ++e) { x0[e] = fsilu(x0[e]); x1[e] = fsilu(x1[e]); } st8(dst + 128 * bj, x0, x1); }
            } else {
                float* dst = (float*)(ws + cfg::WSB_GL + (size_t)(u.pm >> 3) * cfg::DLT_GL) + (size_t)row * 256 + cw;
#pragma unroll
                for (int bj = 0; bj < 2; ++bj)
#pragma unroll
                    for (int n = 0; n < 2; ++n) { f32x4 x = v[bj][n] + bias[bj][n];
#pragma unroll
                        for (int e = 0; e < 4; ++e) x[e] = flogsig16(x[e]); *(f32x4*)(dst + 128 * bj + 4 * n) = x; }
            }
            if (i < 7) cur = nxt;
        }
    }
    __device__ __forceinline__ void operator()(const f32x4 (&acc)[2][2][4][2], const Unit& u, int wr, int wc, int fr, int fq) const {
        asm volatile("" : "+v"(fr), "+v"(fq));
        unsigned zo = 0u; asm volatile("" : "+s"(zo)); FEpiIn me = *this; me.ws = ws + zo;
        const int pn = u.pn;
        if (pn < 4) me.rows<0>(acc, u, wr, wc, fr, fq); else if (pn < 6) me.rows<1>(acc, u, wr, wc, fr, fq); else if (pn < 8) me.rows<2>(acc, u, wr, wc, fr, fq);
        else if (pn == 8) me.rows<3>(acc, u, wr, wc, fr, fq); else if (pn == 9) me.rows<4>(acc, u, wr, wc, fr, fq); else if (pn == 10) me.rows<5>(acc, u, wr, wc, fr, fq); else me.rows<6>(acc, u, wr, wc, fr, fq);
    }
};
struct FEpiRes {
    static constexpr bool PERM = true, AFTER_DRAIN = false;
    const PG8_LAS float* stprev;
    const float* g; const float* bb; bf16_t* XB; float* ST;
    struct RowLd { u32x4 xb[2]; };
    __device__ __forceinline__ RowLd load_row(int row, int col0, int fq) const {
        RowLd r; const size_t off = (size_t)row * 1024 + col0;
        r.xb[0] = *(const u32x4*)(XB + off); r.xb[1] = *(const u32x4*)(XB + off + 128);
        return r;
    }
    __device__ __forceinline__ void operator()(const f32x4 (&acc)[2][2][4][2], const Unit& u, int wr, int wc, int fr, int fq) const {
        asm volatile("" : "+v"(fr), "+v"(fq));
        const int col0 = u.pn * BM + 32 * wc + 8 * fq, row0 = u.pm * BM + 64 * wr + fr;
        f32x4 gv[2][2], bv[2][2];
        RowLd cur = load_row(row0, col0, fq), nxt;
        if (stprev) {
#pragma unroll
            for (int bj = 0; bj < 2; ++bj)
#pragma unroll
                for (int n = 0; n < 2; ++n) { gv[bj][n] = *(const f32x4*)(g + col0 + 128 * bj + 4 * n); bv[bj][n] = *(const f32x4*)(bb + col0 + 128 * bj + 4 * n); } }
#pragma unroll
        for (int i = 0; i < 8; ++i) { const int ai = i >> 2, m = i & 3, row = row0 + 128 * ai + 16 * m; const size_t off = (size_t)row * 1024 + col0;
            if (i < 7) nxt = load_row(row0 + 128 * ((i + 1) >> 2) + 16 * ((i + 1) & 3), col0, fq);
            RS rs; rs.a = 1.f; rs.b = 0.f; if (stprev) { typedef float f32x2 __attribute__((ext_vector_type(2))); const f32x2 t2 = *(const PG8_LAS f32x2*)(stprev + 2 * (128 * ai + 64 * wr + 16 * m + fr)); rs.a = t2[0]; rs.b = t2[1]; }
            float s = 0.f, ss = 0.f;
#pragma unroll
            for (int bj = 0; bj < 2; ++bj) { f32x4 y[2];
#pragma unroll
                for (int n = 0; n < 2; ++n) { const unsigned w0 = cur.xb[bj][2 * n], w1 = cur.xb[bj][2 * n + 1];
                    f32x4 x = (f32x4){__uint_as_float(w0 << 16), __uint_as_float(w0 & 0xffff0000u), __uint_as_float(w1 << 16), __uint_as_float(w1 & 0xffff0000u)};
                    if (stprev) x = (rs.a * x + rs.b) * gv[bj][n] + bv[bj][n];
                    y[n] = cfg::ALPHA * x + acc[ai][bj][m][n];
                    s += (y[n][0] + y[n][1]) + (y[n][2] + y[n][3]); ss += (y[n][0] * y[n][0] + y[n][1] * y[n][1]) + (y[n][2] * y[n][2] + y[n][3] * y[n][3]); }
                st8nt(XB + off + 128 * bj, y[0], y[1]); }
            s = xadd<16>(s); ss = xadd<16>(ss); s = xadd<32>(s); ss = xadd<32>(ss);
            if (fq == 0) { typedef float f32x2 __attribute__((ext_vector_type(2))); *(f32x2*)(ST + (size_t)row * 32 + (u.pn * 4 + wc) * 2) = (f32x2){s, ss}; }
            if (i < 7) cur = nxt; }
    }
};
struct FEpiGU {
    static constexpr bool PERM = true, AFTER_DRAIN = false;
    const PG8_LAS float* rsl;
    const float* c1; const float* c2; bf16_t* ACT;
    __device__ __forceinline__ void operator()(const f32x4 (&acc)[2][2][4][2], const Unit& u, int wr, int wc, int fr, int fq) const {
        asm volatile("" : "+v"(fr), "+v"(fq));
        const int cw = 32 * wc + 8 * fq, row0 = u.pm * BM + 64 * wr + fr; const float* c1p = c1 + u.pn * 256 + cw; const float* c2p = c2 + u.pn * 256 + cw;
        typedef float f32x2 __attribute__((ext_vector_type(2)));
        f32x4 k1[2][2], k2[2][2];
#pragma unroll
        for (int bj = 0; bj < 2; ++bj)
#pragma unroll
            for (int n = 0; n < 2; ++n) { k1[bj][n] = *(const f32x4*)(c1p + 128 * bj + 4 * n); k2[bj][n] = *(const f32x4*)(c2p + 128 * bj + 4 * n); }
#pragma unroll
        for (int i = 0; i < 8; ++i) { const int ai = i >> 2, m = i & 3; const f32x2 rs = *(const PG8_LAS f32x2*)(rsl + 2 * (128 * ai + 64 * wr + 16 * m + fr)); f32x4 a[2];
#pragma unroll
            for (int n = 0; n < 2; ++n) { const f32x4 hg = rs[0] * acc[ai][0][m][n] + (rs[1] * k1[0][n] + k2[0][n]), hu = rs[0] * acc[ai][1][m][n] + (rs[1] * k1[1][n] + k2[1][n]);
#pragma unroll
                for (int e = 0; e < 4; ++e) a[n][e] = fsilu(hg[e]) * hu[e]; }
            st8nt(ACT + (size_t)(row0 + 128 * ai + 16 * m) * cfg::FF + 128 * u.pn + cw, a[0], a[1]); }
    }
};
struct FEpiFour {
    static constexpr bool PERM = true, AFTER_DRAIN = false;
    bf16_t* OC;
    __device__ __forceinline__ void operator()(const f32x4 (&acc)[2][2][4][2], const Unit& u, int wr, int wc, int fr, int fq) const {
        asm volatile("" : "+v"(fr), "+v"(fq));
        const int cw = 32 * wc + 8 * fq;
#pragma unroll
        for (int ai = 0; ai < 2; ++ai)
#pragma unroll
            for (int m = 0; m < 4; ++m) { const int row = u.pm * BM + 128 * ai + 64 * wr + 16 * m + fr; bf16_t* dst = OC + (size_t)(u.pn * 2048 + row) * 1024 + 512 + cw;
                st8(dst, acc[ai][0][m][0], acc[ai][0][m][1]); st8(dst + 128, acc[ai][1][m][0], acc[ai][1][m][1]); }
    }
};
}
namespace att {
using bf16x8 = __attribute__((ext_vector_type(8))) short;
using s16x4  = __attribute__((ext_vector_type(4))) short;
using f32x16 = __attribute__((ext_vector_type(16))) float;
using u32x4  = __attribute__((ext_vector_type(4))) unsigned;
constexpr int NW = 8, QBLK = 32, KVBLK = 64, LD = 512, NT = cfg::S / KVBLK;
constexpr int SHM_V = KVBLK * 128 * 2, SHM_K = KVBLK * 128 * 2, SHM_X = 2 * SHM_V + 2 * SHM_K, SHM_ATTN = SHM_X + NW * 64 * 4;
constexpr float THRL = 6.0f;
#define ATT_KSWZ(row, colB) ((row) * 256 + ((colB) ^ (((row) & 7) << 4)))
#define ATT_SBAR() __builtin_amdgcn_sched_barrier(0)
__device__ __forceinline__ int crow(int r, int hi) { return (r & 3) + 8 * (r >> 2) + 4 * hi; }
__device__ __forceinline__ unsigned cvtpk(float lo, float hi) { unsigned r; asm volatile("v_cvt_pk_bf16_f32 %0, %1, %2" : "=v"(r) : "v"(lo), "v"(hi)); return r; }
__device__ __forceinline__ void softmaxP(f32x16& p0, f32x16& p1, float& m_reg, f32x16& negm, float& alpha, bool first, bf16x8& pa0, bf16x8& pa1, bf16x8& pa2, bf16x8& pa3) {
#define ATT_M3(a, b, c) fmaxf(fmaxf(a, b), c)
  const float t0 = ATT_M3(p0[0], p0[1], p0[2]), t1 = ATT_M3(p0[3], p0[4], p0[5]), t2 = ATT_M3(p0[6], p0[7], p0[8]), t3 = ATT_M3(p0[9], p0[10], p0[11]), t4 = ATT_M3(p0[12], p0[13], p0[14]);
  const float t5 = ATT_M3(p0[15], p1[0], p1[1]), t6 = ATT_M3(p1[2], p1[3], p1[4]), t7 = ATT_M3(p1[5], p1[6], p1[7]), t8 = ATT_M3(p1[8], p1[9], p1[10]), t9 = ATT_M3(p1[11], p1[12], p1[13]);
  const float u0 = ATT_M3(t0, t1, t2), u1 = ATT_M3(t3, t4, t5), u2 = ATT_M3(t6, t7, t8), u3 = ATT_M3(t9, p1[14], p1[15]);
  float pmax = fmaxf(fmaxf(u0, u1), fmaxf(u2, u3));
#undef ATT_M3
  { auto rr = __builtin_amdgcn_permlane32_swap(__float_as_uint(pmax), __float_as_uint(pmax), false, false); pmax = fmaxf(__uint_as_float(rr[0]), __uint_as_float(rr[1])); }
  const float thr = first ? -3.0e38f : THRL;
  if (__builtin_expect(__all(pmax <= thr), 1)) { alpha = 1.f; }
  else { const float dl = first ? pmax : fmaxf(pmax, 0.f); alpha = first ? 0.f : __builtin_amdgcn_exp2f(-dl); m_reg += dl;
#pragma unroll
    for (int r = 0; r < 16; ++r) { p0[r] -= dl; p1[r] -= dl; negm[r] -= dl; } }
#pragma unroll
  for (int r = 0; r < 16; ++r) p0[r] = __builtin_amdgcn_exp2f(p0[r]);
#pragma unroll
  for (int r = 0; r < 16; ++r) p1[r] = __builtin_amdgcn_exp2f(p1[r]);
#define ATT_PK4(P, BASE, OUT) do { u32x4 w = {cvtpk(P[BASE + 0], P[BASE + 1]), cvtpk(P[BASE + 2], P[BASE + 3]), cvtpk(P[BASE + 4], P[BASE + 5]), cvtpk(P[BASE + 6], P[BASE + 7])}; \
    OUT = *reinterpret_cast<bf16x8*>(&w); } while (0)
  ATT_PK4(p0, 0, pa0); ATT_PK4(p0, 8, pa1); ATT_PK4(p1, 0, pa2); ATT_PK4(p1, 8, pa3);
#undef ATT_PK4
}
template <int OFF> __device__ __forceinline__ bf16x8 k_read(int ka) { bf16x8 r; asm volatile("ds_read_b128 %0, %1 offset:%2" : "=&v"(r) : "v"(ka), "i"(OFF) : "memory"); return r; }
template <int KB> __device__ __forceinline__ void k_load2(bf16x8* kf, int ka0, int ka1) {
  kf[0] = k_read<KB * SHM_K>(ka0); kf[1] = k_read<KB * SHM_K + 8192>(ka0); kf[2] = k_read<KB * SHM_K>(ka1); kf[3] = k_read<KB * SHM_K + 8192>(ka1);
}
__device__ __forceinline__ void qk_mma2(f32x16& p0, f32x16& p1, const bf16x8* kf, bf16x8 q0, bf16x8 q1) {
  p0 = __builtin_amdgcn_mfma_f32_32x32x16_bf16(kf[0], q0, p0, 0, 0, 0); p1 = __builtin_amdgcn_mfma_f32_32x32x16_bf16(kf[1], q0, p1, 0, 0, 0);
  p0 = __builtin_amdgcn_mfma_f32_32x32x16_bf16(kf[2], q1, p0, 0, 0, 0); p1 = __builtin_amdgcn_mfma_f32_32x32x16_bf16(kf[3], q1, p1, 0, 0, 0);
}
__device__ __forceinline__ int v_st(int k, int c) { return ((k >> 3) * 4 + (c >> 5)) * 512 + ((k & 7) * 32 + (c & 31)) * 2; }
__device__ __forceinline__ int v_rd_base(int lane) { return ((lane & 3) << 3) | (((lane >> 2) & 3) << 6) | (((lane >> 4) & 1) << 5) | (((lane >> 5) & 1) << 8); }
constexpr int v_rd_off(int d0, int ks, int half) { return d0 * 512 + ks * 4096 + half * 2048; }
template <int OFF> __device__ __forceinline__ s16x4 tr_read(int vb) { s16x4 r; asm volatile("ds_read_b64_tr_b16 %0, %1 offset:%2" : "=&v"(r) : "v"(vb), "i"(OFF) : "memory"); return r; }
struct VF { s16x4 l[4], h[4]; };
template <int KS> __device__ __forceinline__ void vf_load(VF& f, int vb) {
  f.l[0] = tr_read<v_rd_off(0, KS, 0)>(vb); f.h[0] = tr_read<v_rd_off(0, KS, 1)>(vb); f.l[1] = tr_read<v_rd_off(1, KS, 0)>(vb); f.h[1] = tr_read<v_rd_off(1, KS, 1)>(vb);
  f.l[2] = tr_read<v_rd_off(2, KS, 0)>(vb); f.h[2] = tr_read<v_rd_off(2, KS, 1)>(vb); f.l[3] = tr_read<v_rd_off(3, KS, 0)>(vb); f.h[3] = tr_read<v_rd_off(3, KS, 1)>(vb);
}
__device__ __forceinline__ void pv_step(f32x16* o, bf16x8 pa, const VF& f) {
#define ATT_PK(L, H) (bf16x8){L[0], L[1], L[2], L[3], H[0], H[1], H[2], H[3]}
  o[0] = __builtin_amdgcn_mfma_f32_32x32x16_bf16(pa, ATT_PK(f.l[0], f.h[0]), o[0], 0, 0, 0);
  o[1] = __builtin_amdgcn_mfma_f32_32x32x16_bf16(pa, ATT_PK(f.l[1], f.h[1]), o[1], 0, 0, 0);
  o[2] = __builtin_amdgcn_mfma_f32_32x32x16_bf16(pa, ATT_PK(f.l[2], f.h[2]), o[2], 0, 0, 0);
  o[3] = __builtin_amdgcn_mfma_f32_32x32x16_bf16(pa, ATT_PK(f.l[3], f.h[3]), o[3], 0, 0, 0);
#undef ATT_PK
}
#define ATT_LWAIT(n) do { asm volatile("s_waitcnt lgkmcnt(" #n ")" ::: "memory"); ATT_SBAR(); } while (0)
template <int MP> __device__ __forceinline__ void att_give(const f32x16* o, float* Xw, int r32, int hi) {
  constexpr int RG = MP ? 0 : 8;
#pragma unroll
  for (int rr = 0; rr < 8; ++rr)
#pragma unroll
    for (int d0 = 0; d0 < 4; ++d0) Xw[(crow(RG + rr, hi) & 15) * 128 + d0 * 32 + r32] = o[d0][RG + rr];
}
template <int MP> __device__ __forceinline__ void att_fin(const f32x16* o, const float* Xr, float lam, const float (&gq)[4], bf16_t* OCw, int r32, int hi, int lane) {
  constexpr int RK = MP ? 8 : 0;
  unsigned pk[8][4];
#pragma unroll
  for (int rr = 0; rr < 8; ++rr) { const int lr = crow(RK + rr, hi) & 15;
    float df[4], ssq = 0.f;
#pragma unroll
    for (int d0 = 0; d0 < 4; ++d0) { const float x = Xr[lr * 128 + d0 * 32 + r32]; df[d0] = MP ? x - lam * o[d0][RK + rr] : o[d0][RK + rr] - lam * x; ssq += df[d0] * df[d0]; }
    ssq = xadd<1>(ssq); ssq = xadd<2>(ssq); ssq = xadd<4>(ssq); ssq = xadd<8>(ssq); ssq = xadd<16>(ssq);
    const float rn = rsqrtf(ssq * (1.f / 128.f) + cfg::EPS);
#pragma unroll
    for (int d0 = 0; d0 < 4; ++d0) pk[rr][d0] = cvtpk(df[d0] * rn * gq[d0], 0.f); }
  char* stg = (char*)Xr;
#pragma unroll
  for (int rr = 0; rr < 8; ++rr) { const int lr = crow(RK + rr, hi) & 15;
#pragma unroll
    for (int d0 = 0; d0 < 4; ++d0) *(unsigned short*)(stg + lr * 272 + (d0 * 32 + r32) * 2) = (unsigned short)pk[rr][d0]; }
#pragma unroll
  for (int i = 0; i < 4; ++i) { const int c = lane + 64 * i, row = c >> 4, cc = c & 15;
    const u32x4 v = *(const u32x4*)(stg + row * 272 + cc * 16); *(u32x4*)(OCw + (size_t)row * 1024 + cc * 8) = v; }
}
__device__ __forceinline__ void attn_unit(int b, int h, int qb, const bf16_t* __restrict__ Qg, const bf16_t* __restrict__ Kg, const bf16_t* __restrict__ Vg, bf16_t* __restrict__ OC,
                                          const float* __restrict__ lamp, const float* __restrict__ dgv, int layer, char* lds) {
  int tid_o = threadIdx.x; asm volatile("" : "+v"(tid_o));
  const int tid = tid_o, wid = __builtin_amdgcn_readfirstlane(tid >> 6), lane = tid & 63, r32 = lane & 31, hi = lane >> 5, mp = wid >> 2, wl = wid & 3, mofs = mp * 64;
  char* V_lds = lds; char* K_lds = lds + 2 * SHM_V;
  float* ws = (float*)(lds + SHM_X) + wid * 64; float* al_l = ws + 32;
  float m_reg = 0.f; f32x16 o[4] = {}, ol = {}, negm = {}; bf16x8 qr[4];
  const int q0 = qb * 128 + wl * QBLK;
  const bf16_t* Qw = Qg + (size_t)(b * cfg::S + q0 + r32) * LD + h * 128 + mofs + hi * 8;
#pragma unroll
  for (int d0 = 0; d0 < 4; ++d0) qr[d0] = *reinterpret_cast<const bf16x8*>(Qw + d0 * 16);
  const bf16_t* Kh = Kg + (size_t)b * cfg::S * LD + h * 128; const bf16_t* Vh = Vg + (size_t)b * cfg::S * LD + h * 128;
  const int vb0 = (int)(uintptr_t)V_lds + v_rd_base(lane);
  const int ka0 = (int)(uintptr_t)K_lds + ATT_KSWZ(r32, (mofs + hi * 8) * 2);
  const bf16x8 ones = {0x3F80, 0x3F80, 0x3F80, 0x3F80, 0x3F80, 0x3F80, 0x3F80, 0x3F80};
  const int gt = tid & 255, gr = gt >> 4, gc = (gt & 15) * 8;
  const bf16_t* gsrc = (mp ? Kh : Vh) + (size_t)gr * LD + gc;
  char* gdst = mp ? K_lds + ATT_KSWZ(gr, gc * 2) : V_lds + v_st(gr, gc);
  const int tofs = mp ? 2 : 0;
  bf16x8 st_[2][4];
#define ATT_GLOAD(i, t) do { const int t_ = (t) < NT ? (t) : NT - 1;     \
    _Pragma("unroll") for (int q_ = 0; q_ < 4; ++q_) st_[i][q_] = *reinterpret_cast<const bf16x8*>(gsrc + (size_t)(t_ * 64 + 16 * q_) * LD); } while (0)
#define ATT_GWRITE(i, t) do { asm volatile("s_waitcnt vmcnt(4)" ::: "memory"); if ((t) < NT) { \
    _Pragma("unroll") for (int q_ = 0; q_ < 4; ++q_) *(bf16x8*)(gdst + (i) * 16384 + q_ * 4096) = st_[i][q_]; } } while (0)
#define ATT_RESC(a) do { if (__any((a) < 1.f)) { if (hi == 0) al_l[r32] = (a); asm volatile("s_waitcnt lgkmcnt(0)" ::: "memory"); \
    _Pragma("unroll") for (int r = 0; r < 16; ++r) { const float a_ = al_l[crow(r, hi)]; ol[r] *= a_; _Pragma("unroll") for (int d = 0; d < 4; ++d) o[d][r] *= a_; } } } while (0)
  f32x16 s0, s1; float al; bf16x8 pa0, pa1, pa2, pa3, kf[8]; VF f0, f1;
#define ATT_VSEG(I, p) do { ATT_GWRITE(I, (p) + tofs); ATT_GLOAD(I, (p) + tofs + 2); ATT_SBAR(); \
    softmaxP(s0, s1, m_reg, negm, al, (p) == 0, pa0, pa1, pa2, pa3); ATT_RESC(al); } while (0)
#define ATT_OL(pa) ol = __builtin_amdgcn_mfma_f32_32x32x16_bf16(pa, ones, ol, 0, 0, 0)
#define ATT_QK(KB) do { k_load2<KB>(kf, ka0, ka0 ^ 32); k_load2<KB>(kf + 4, ka0 ^ 64, ka0 ^ 96); ATT_LWAIT(4); s0 = negm; s1 = negm; qk_mma2(s0, s1, kf, qr[0], qr[1]); ATT_LWAIT(0); qk_mma2(s0, s1, kf + 4, qr[2], qr[3]); ATT_SBAR(); } while (0)
#define ATT_MSEG(VB, KB, QK) do { vf_load<0>(f0, vb0 + (VB) * SHM_V); vf_load<1>(f1, vb0 + (VB) * SHM_V); ATT_SBAR(); \
    ATT_LWAIT(8); pv_step(o, pa0, f0); ATT_OL(pa0); vf_load<2>(f0, vb0 + (VB) * SHM_V); \
    ATT_LWAIT(8); pv_step(o, pa1, f1); ATT_OL(pa1); vf_load<3>(f1, vb0 + (VB) * SHM_V); \
    if constexpr (QK) { k_load2<KB>(kf, ka0, ka0 ^ 32); ATT_LWAIT(12); } else ATT_LWAIT(8); \
    pv_step(o, pa2, f0); ATT_OL(pa2); \
    if constexpr (QK) ATT_LWAIT(4); else ATT_LWAIT(0); \
    pv_step(o, pa3, f1); ATT_OL(pa3); \
    if constexpr (QK) { k_load2<KB>(kf + 4, ka0 ^ 64, ka0 ^ 96); ATT_LWAIT(4); s0 = negm; s1 = negm; qk_mma2(s0, s1, kf, qr[0], qr[1]); ATT_LWAIT(0); qk_mma2(s0, s1, kf + 4, qr[2], qr[3]); } ATT_SBAR(); } while (0)
  { const int kr = tid >> 4, kc = (tid & 15) * 8;
    const bf16x8 k0 = *reinterpret_cast<const bf16x8*>(&Kh[(size_t)kr * LD + kc]), k1 = *reinterpret_cast<const bf16x8*>(&Kh[(size_t)(32 + kr) * LD + kc]);
    const bf16x8 k2 = *reinterpret_cast<const bf16x8*>(&Kh[(size_t)(64 + kr) * LD + kc]), k3 = *reinterpret_cast<const bf16x8*>(&Kh[(size_t)(96 + kr) * LD + kc]);
    ATT_GLOAD(0, tofs); ATT_GLOAD(1, tofs + 1);
    asm volatile("s_waitcnt vmcnt(8)" ::: "memory");
    *(bf16x8*)(K_lds + ATT_KSWZ(kr, kc * 2)) = k0; *(bf16x8*)(K_lds + ATT_KSWZ(32 + kr, kc * 2)) = k1;
    *(bf16x8*)(K_lds + SHM_K + ATT_KSWZ(kr, kc * 2)) = k2; *(bf16x8*)(K_lds + SHM_K + ATT_KSWZ(32 + kr, kc * 2)) = k3; }
  __syncthreads();
  if (mp) __syncthreads();
  ATT_QK(0); __syncthreads();
  for (int p = 0; p + 2 < NT; p += 2) {
    ATT_VSEG(0, p);           __syncthreads();
    ATT_MSEG(0, 1, true);     __syncthreads();
    ATT_VSEG(1, p + 1);       __syncthreads();
    ATT_MSEG(1, 0, true);     __syncthreads();
  }
  ATT_VSEG(0, NT - 2);   __syncthreads();
  ATT_MSEG(0, 1, true);   __syncthreads();
  ATT_VSEG(1, NT - 1);   __syncthreads();
  ATT_MSEG(1, 0, false);  __syncthreads();
  if (!mp) __syncthreads();
#pragma unroll
  for (int r = 0; r < 16; ++r) { const float rl = __builtin_amdgcn_rcpf(ol[r]);
#pragma unroll
    for (int d0 = 0; d0 < 4; ++d0) o[d0][r] *= rl; }
  __syncthreads();
  float* X = (float*)lds;
  const float* Xr = X + wid * 2048; float* Xw = X + (wid ^ 4) * 2048;
  int layer_o = __builtin_amdgcn_readfirstlane(layer); asm volatile("" : "+s"(layer_o)); const float lam_init = layer_o == 0 ? 0.2f : 0.35550906759f;
  if (mp == 0) att_give<0>(o, Xw, r32, hi); else att_give<1>(o, Xw, r32, hi);
  float lam; { float s1 = lamp[lane] * lamp[64 + lane], s2 = lamp[128 + lane] * lamp[192 + lane];
    s1 = xadd<1>(s1); s2 = xadd<1>(s2); s1 = xadd<2>(s1); s2 = xadd<2>(s2); s1 = xadd<4>(s1); s2 = xadd<4>(s2); s1 = xadd<8>(s1); s2 = xadd<8>(s2); s1 = xadd<16>(s1); s2 = xadd<16>(s2); s1 = xadd<32>(s1); s2 = xadd<32>(s2);
    lam = __expf(s1) - __expf(s2) + lam_init; }
  float gq[4];
#pragma unroll
  for (int d0 = 0; d0 < 4; ++d0) gq[d0] = dgv[d0 * 32 + r32] * (1.f - lam_init);
  __syncthreads();
  bf16_t* OCw = OC + (size_t)(b * cfg::S + q0 + 16 * mp) * 1024 + h * 128;
  if (mp == 0) att_fin<0>(o, Xr, lam, gq, OCw, r32, hi, lane); else att_fin<1>(o, Xr, lam, gq, OCw, r32, hi, lane);
  __syncthreads();
#undef ATT_GLOAD
#undef ATT_GWRITE
#undef ATT_VSEG
#undef ATT_MSEG
#undef ATT_RESC
#undef ATT_OL
#undef ATT_QK
}
#undef ATT_KSWZ
#undef ATT_SBAR
}
namespace gla {
using att::bf16x8; using att::s16x4; using att::f32x16; using att::u32x4; using att::crow; using att::cvtpk; using att::tr_read;
typedef float f32x4 __attribute__((ext_vector_type(4)));
typedef unsigned u32x2 __attribute__((ext_vector_type(2)));
#define GLAS __attribute__((address_space(3)))
constexpr int KT_STRIDE = 144;
constexpr int A_KT = 0, A_V = 36864, A_BEND = A_V + 32768;
constexpr int B_QT = 0, B_KT = 32768, B_V = 65536, B_SC = 98304;
__device__ __forceinline__ int v_st64(int k, int c) { const int kk = (k & ~0xC) | ((k & 4) << 1) | ((k & 8) >> 1); return ((kk >> 3) * 2 + (c >> 5)) * 512 + ((kk & 7) * 32 + (c & 31)) * 2; }
constexpr int v_off64(int d0, int ks, int half) { return d0 * 512 + ks * 2048 + half * 1024; }
__device__ __forceinline__ float bf2f_(unsigned short v) { return __uint_as_float((unsigned)v << 16); }
__device__ __forceinline__ void load_v_tile(const bf16_t* __restrict__ src, GLAS unsigned char* dst, int lane) {
    u32x4 tv[8];
#pragma unroll
    for (int i = 0; i < 8; ++i) { const int row = (lane >> 3) + 8 * i, ch = lane & 7; tv[i] = *(const u32x4*)(src + (size_t)row * 256 + ch * 8); }
#pragma unroll
    for (int i = 0; i < 8; ++i) { const int row = (lane >> 3) + 8 * i, ch = lane & 7; *(GLAS u32x4*)(dst + v_st64(row, ch * 8)) = tv[i]; }
}
#define GLA_PK(L, H) (bf16x8){L[0], L[1], L[2], L[3], H[0], H[1], H[2], H[3]}
#define GLA_MM4(o0, o1, vb, AF) do { \
    const s16x4 l00 = tr_read<v_off64(0, 0, 0)>(vb), h00 = tr_read<v_off64(0, 0, 1)>(vb), l01 = tr_read<v_off64(0, 1, 0)>(vb), h01 = tr_read<v_off64(0, 1, 1)>(vb); \
    const s16x4 l02 = tr_read<v_off64(0, 2, 0)>(vb), h02 = tr_read<v_off64(0, 2, 1)>(vb), l03 = tr_read<v_off64(0, 3, 0)>(vb), h03 = tr_read<v_off64(0, 3, 1)>(vb); \
    const s16x4 l10 = tr_read<v_off64(1, 0, 0)>(vb), h10 = tr_read<v_off64(1, 0, 1)>(vb), l11 = tr_read<v_off64(1, 1, 0)>(vb), h11 = tr_read<v_off64(1, 1, 1)>(vb); \
    const s16x4 l12 = tr_read<v_off64(1, 2, 0)>(vb), h12 = tr_read<v_off64(1, 2, 1)>(vb), l13 = tr_read<v_off64(1, 3, 0)>(vb), h13 = tr_read<v_off64(1, 3, 1)>(vb); \
    asm volatile("s_waitcnt lgkmcnt(0)" ::: "memory"); __builtin_amdgcn_sched_barrier(0); \
    o0 = __builtin_amdgcn_mfma_f32_32x32x16_bf16(AF(0), GLA_PK(l00, h00), o0, 0, 0, 0); o1 = __builtin_amdgcn_mfma_f32_32x32x16_bf16(AF(0), GLA_PK(l10, h10), o1, 0, 0, 0); \
    o0 = __builtin_amdgcn_mfma_f32_32x32x16_bf16(AF(1), GLA_PK(l01, h01), o0, 0, 0, 0); o1 = __builtin_amdgcn_mfma_f32_32x32x16_bf16(AF(1), GLA_PK(l11, h11), o1, 0, 0, 0); \
    o0 = __builtin_amdgcn_mfma_f32_32x32x16_bf16(AF(2), GLA_PK(l02, h02), o0, 0, 0, 0); o1 = __builtin_amdgcn_mfma_f32_32x32x16_bf16(AF(2), GLA_PK(l12, h12), o1, 0, 0, 0); \
    o0 = __builtin_amdgcn_mfma_f32_32x32x16_bf16(AF(3), GLA_PK(l03, h03), o0, 0, 0, 0); o1 = __builtin_amdgcn_mfma_f32_32x32x16_bf16(AF(3), GLA_PK(l13, h13), o1, 0, 0, 0); } while (0)
__device__ __forceinline__ bf16x8 afrag_tr(const GLAS unsigned char* row, int ks, int hi) { return *(const GLAS bf16x8*)(row + (16 * ks + 8 * hi) * 2); }

__device__ __forceinline__ void gla_a_item(int b, int h, int g, unsigned char* ws, GLAS unsigned char* lds) {
    int tid_o = threadIdx.x; asm volatile("" : "+v"(tid_o));
    const int tid = tid_o, wave = __builtin_amdgcn_readfirstlane(tid >> 6), lane = tid & 63, r32 = lane & 31, hi = lane >> 5;
    const float* GL = (const float*)(ws + cfg::WSB_GL + (size_t)b * cfg::DLT_GL); const bf16_t* GQK = (const bf16_t*)(ws + cfg::WSB_GQK + (size_t)b * cfg::DLT_GQK); const bf16_t* GV = (const bf16_t*)(ws + cfg::WSB_GV + (size_t)b * cfg::DLT_GV);
    float* KVC = (float*)(ws + cfg::WSB_OF + (size_t)b * cfg::DLT_OF); float* DEC = (float*)(ws + cfg::WS_DEC);
    const size_t tok0 = (size_t)b * 2048 + g * 256;
    GLAS float* bend_s = (GLAS float*)(lds + A_BEND);
    if (wave < 4) {
        const int c = wave, dir = lane >> 5, d = lane & 31;
        const float* gl = GL + (tok0 + c * 64) * 256 + dir * 128 + h * 32 + d; const bf16_t* kp = GQK + (tok0 + c * 64) * 256 + 128 + h * 32 + d;
        GLAS unsigned char* row = lds + A_KT + ((c * 2 + dir) * 32 + d) * KT_STRIDE; float bsum = 0.f; float gA[8], gB[8]; unsigned short kA[8], kB[8];
#define GLA_LOAD(G, K, blk) do { const int t0_ = dir ? 56 - 8 * (blk) : 8 * (blk); _Pragma("unroll") for (int i = 0; i < 8; ++i) { G[i] = gl[(size_t)(t0_ + i) * 256]; K[i] = kp[(size_t)(t0_ + i) * 256]; } } while (0)
#define GLA_PROC(G, K, blk) do { const int t0_ = dir ? 56 - 8 * (blk) : 8 * (blk); float kt[8]; \
            if (dir == 0) { _Pragma("unroll") for (int i = 0; i < 8; ++i) { bsum += G[i]; kt[i] = bf2f_(K[i]) * __expf(-bsum); } } \
            else { _Pragma("unroll") for (int i = 7; i >= 0; --i) { bsum += G[i]; kt[i] = bf2f_(K[i]) * __expf(-bsum); } } \
            u32x4 w; w.x = cvtpk(kt[0], kt[1]); w.y = cvtpk(kt[2], kt[3]); w.z = cvtpk(kt[4], kt[5]); w.w = cvtpk(kt[6], kt[7]); *(GLAS u32x4*)(row + t0_ * 2) = w; } while (0)
        GLA_LOAD(gA, kA, 0);
#pragma unroll
        for (int bp = 0; bp < 4; ++bp) { GLA_LOAD(gB, kB, 2 * bp + 1); GLA_PROC(gA, kA, 2 * bp); if (bp < 3) GLA_LOAD(gA, kA, 2 * bp + 2); GLA_PROC(gB, kB, 2 * bp + 1); }
#undef GLA_LOAD
#undef GLA_PROC
        bend_s[(c * 2 + dir) * 32 + d] = bsum;
        DEC[((size_t)((b * 4 + h) * 32 + g * 4 + c) * 2 + dir) * 32 + d] = __expf(bsum);
    } else { const int c = wave - 4; load_v_tile(GV + (tok0 + c * 64) * 256 + h * 64, lds + A_V + c * 8192, lane); }
    __syncthreads();
    {
        const int c = wave >> 1, dir = wave & 1; f32x16 o0 = {}, o1 = {};
        const int vb = (int)(unsigned)(uintptr_t)(lds + A_V + c * 8192) + att::v_rd_base(lane);
        const GLAS unsigned char* arow = lds + A_KT + ((c * 2 + dir) * 32 + r32) * KT_STRIDE;
#define GLA_AF(ks) afrag_tr(arow, ks, hi)
        GLA_MM4(o0, o1, vb, GLA_AF);
#undef GLA_AF
        float* dst = KVC + ((size_t)((b * 4 + h) * 32 + g * 4 + c) * 2 + dir) * 2048 + r32;
#pragma unroll
        for (int r = 0; r < 16; ++r) { const int d = crow(r, hi); const float sc = __expf(bend_s[(c * 2 + dir) * 32 + d]); dst[d * 64] = o0[r] * sc; dst[d * 64 + 32] = o1[r] * sc; }
    }
    __syncthreads();
}

__device__ __forceinline__ void gla_b_item(int b, int h, int g, unsigned char* ws, const float* __restrict__ gng, bf16_t* __restrict__ OC, GLAS unsigned char* lds) {
    int tid_o = threadIdx.x; asm volatile("" : "+v"(tid_o));
    const int tid = tid_o, wave = __builtin_amdgcn_readfirstlane(tid >> 6), lane = tid & 63, r32 = lane & 31, hi = lane >> 5;
    const float* GL = (const float*)(ws + cfg::WSB_GL + (size_t)b * cfg::DLT_GL); const bf16_t* GQK = (const bf16_t*)(ws + cfg::WSB_GQK + (size_t)b * cfg::DLT_GQK); const bf16_t* GV = (const bf16_t*)(ws + cfg::WSB_GV + (size_t)b * cfg::DLT_GV); const bf16_t* GR = (const bf16_t*)(ws + cfg::WSB_GR + (size_t)b * cfg::DLT_GR);
    const float* KVC = (const float*)(ws + cfg::WSB_OF + (size_t)b * cfg::DLT_OF) + (size_t)((b * 4 + h) * 32) * 2 * 2048; const float* DEC = (const float*)(ws + cfg::WS_DEC) + (size_t)((b * 4 + h) * 32) * 2 * 32;
    const size_t tok0 = (size_t)b * 2048 + g * 256;
    if (wave < 4) {
        const int c = wave, dir = lane >> 5, d = lane & 31;
        const float* gl = GL + (tok0 + c * 64) * 256 + dir * 128 + h * 32 + d; const bf16_t* qp = GQK + (tok0 + c * 64) * 256 + h * 32 + d;
        GLAS unsigned short* qt = (GLAS unsigned short*)(lds + B_QT + c * 8192) + dir * 32 + d;
        GLAS unsigned short* kt = (GLAS unsigned short*)(lds + B_KT + c * 8192 + dir * 4096) + d;
        float bsum = 0.f; float gA[8], gB[8]; unsigned short qA[8], kA[8], qB[8], kB[8];
#define GLB_LOAD(G, Q, K, blk) do { const int t0_ = dir ? 56 - 8 * (blk) : 8 * (blk); _Pragma("unroll") for (int i = 0; i < 8; ++i) { G[i] = gl[(size_t)(t0_ + i) * 256]; Q[i] = qp[(size_t)(t0_ + i) * 256]; K[i] = qp[(size_t)(t0_ + i) * 256 + 128]; } } while (0)
#define GLB_PROC(G, Q, K, blk) do { const int t0_ = dir ? 56 - 8 * (blk) : 8 * (blk); _Pragma("unroll") for (int ii = 0; ii < 8; ++ii) { \
            const float gi = dir ? G[7 - ii] : G[ii], qi = bf2f_(dir ? Q[7 - ii] : Q[ii]), ki = bf2f_(dir ? K[7 - ii] : K[ii]); const int tt = t0_ + (dir ? 7 - ii : ii); \
            bsum += gi; const float e = __expf(bsum), ei = __expf(-bsum); \
            qt[tt * 64] = (unsigned short)(cvtpk(qi * e, 0.f) & 0xffffu); kt[tt * 32] = (unsigned short)(cvtpk(ki * ei, 0.f) & 0xffffu); } } while (0)
        GLB_LOAD(gA, qA, kA, 0);
#pragma unroll
        for (int bp = 0; bp < 4; ++bp) { GLB_LOAD(gB, qB, kB, 2 * bp + 1); GLB_PROC(gA, qA, kA, 2 * bp); if (bp < 3) GLB_LOAD(gA, qA, kA, 2 * bp + 2); GLB_PROC(gB, qB, kB, 2 * bp + 1); }
#undef GLB_LOAD
#undef GLB_PROC
    } else {
        const int c = wave - 4;
        const int t2 = tid - 256, d = t2 >> 3, v8 = (t2 & 7) * 8;
        const float* kvp = KVC + d * 64 + v8; const float* dcp = DEC + d;
        const int F = 4 * g + 3;
        u32x4 tv[8];
#pragma unroll
        for (int i = 0; i < 8; ++i) { const int row = (lane >> 3) + 8 * i, ch = lane & 7; tv[i] = *(const u32x4*)(GV + (tok0 + c * 64) * 256 + h * 64 + (size_t)row * 256 + ch * 8); }
        f32x4 Sf0 = {0.f, 0.f, 0.f, 0.f}, Sf1 = Sf0, Sb0 = Sf0, Sb1 = Sf0;
        f32x4 a0A[8], a1A[8], a0B[8], a1B[8]; float dA[8], dB[8];
#define GLS_IDX(s_) (((s_) < F) ? (s_) * 2 : (31 - ((s_) - F)) * 2 + 1)
#define GLS_ISSUE(A0, A1, DD, s0) do { _Pragma("unroll") for (int j = 0; j < 8; ++j) { const int sc_ = (s0) + j < 34 ? (s0) + j : 33; const int ix_ = GLS_IDX(sc_); \
            A0[j] = *(const f32x4*)(kvp + (size_t)ix_ * 2048); A1[j] = *(const f32x4*)(kvp + (size_t)ix_ * 2048 + 4); DD[j] = dcp[ix_ * 32]; } } while (0)
#define GLS_WRITE(S0, S1, c4_, dofs_) do { u32x4 w; w.x = cvtpk(S0[0], S0[1]); w.y = cvtpk(S0[2], S0[3]); w.z = cvtpk(S1[0], S1[1]); w.w = cvtpk(S1[2], S1[3]); \
            *(GLAS u32x4*)(lds + B_SC + (c4_) * 8192 + v_st64((dofs_) + d, v8)) = w; } while (0)
#define GLS_PROC(A0, A1, DD, s0) do { _Pragma("unroll") for (int j = 0; j < 8; ++j) { const int s_ = (s0) + j; if (s_ < 34) { \
            if (s_ < F) { const int n_ = s_; if (n_ >= 4 * g) GLS_WRITE(Sf0, Sf1, n_ - 4 * g, 0); Sf0 = DD[j] * Sf0 + A0[j]; Sf1 = DD[j] * Sf1 + A1[j]; } \
            else { const int n_ = 31 - (s_ - F); if (n_ <= 4 * g + 3) GLS_WRITE(Sb0, Sb1, n_ - 4 * g, 32); Sb0 = DD[j] * Sb0 + A0[j]; Sb1 = DD[j] * Sb1 + A1[j]; } } } } while (0)
        GLS_ISSUE(a0A, a1A, dA, 0); GLS_ISSUE(a0B, a1B, dB, 8);
#pragma unroll
        for (int i = 0; i < 8; ++i) { const int row = (lane >> 3) + 8 * i, ch = lane & 7; *(GLAS u32x4*)(lds + B_V + c * 8192 + v_st64(row, ch * 8)) = tv[i]; }
        GLS_PROC(a0A, a1A, dA, 0);  GLS_ISSUE(a0A, a1A, dA, 16);
        GLS_PROC(a0B, a1B, dB, 8);  GLS_ISSUE(a0B, a1B, dB, 24);
        GLS_PROC(a0A, a1A, dA, 16); GLS_ISSUE(a0A, a1A, dA, 32);
        GLS_PROC(a0B, a1B, dB, 24);
        GLS_PROC(a0A, a1A, dA, 32);
        GLS_WRITE(Sf0, Sf1, 3, 0); GLS_WRITE(Sb0, Sb1, 0, 32);
#undef GLS_IDX
#undef GLS_ISSUE
#undef GLS_WRITE
#undef GLS_PROC
    }
    __syncthreads();
    {
        const int c = wave >> 1, th = wave & 1, t = 32 * th + r32;
        const GLAS unsigned char* qrow = lds + B_QT + c * 8192 + t * 128;
        f32x16 pf0 = {}, pf1 = {}, pb0 = {}, pb1 = {};
#pragma unroll
        for (int ks = 0; ks < 2; ++ks) {
            const bf16x8 qf = *(const GLAS bf16x8*)(qrow + (16 * ks + 8 * hi) * 2), qb = *(const GLAS bf16x8*)(qrow + (32 + 16 * ks + 8 * hi) * 2);
            const GLAS unsigned char* kf = lds + B_KT + c * 8192 + r32 * 64 + (16 * ks + 8 * hi) * 2; const GLAS unsigned char* kb = kf + 4096;
            pf0 = __builtin_amdgcn_mfma_f32_32x32x16_bf16(*(const GLAS bf16x8*)kf, qf, pf0, 0, 0, 0); pf1 = __builtin_amdgcn_mfma_f32_32x32x16_bf16(*(const GLAS bf16x8*)(kf + 2048), qf, pf1, 0, 0, 0);
            pb0 = __builtin_amdgcn_mfma_f32_32x32x16_bf16(*(const GLAS bf16x8*)kb, qb, pb0, 0, 0, 0); pb1 = __builtin_amdgcn_mfma_f32_32x32x16_bf16(*(const GLAS bf16x8*)(kb + 2048), qb, pb1, 0, 0, 0);
        }
#pragma unroll
        for (int r = 0; r < 16; ++r) { const int j0 = crow(r, hi), j1 = 32 + j0;
            pf0[r] = (j0 <= t ? pf0[r] : 0.f) + (j0 >= t ? pb0[r] : 0.f); pf1[r] = (j1 <= t ? pf1[r] : 0.f) + (j1 >= t ? pb1[r] : 0.f); }
        bf16x8 pa0, pa1, pa2, pa3;
#define GLA_PK4(P, BASE, OUT) do { unsigned a0 = cvtpk(P[BASE + 0], P[BASE + 1]), a1 = cvtpk(P[BASE + 2], P[BASE + 3]); unsigned b0 = cvtpk(P[BASE + 4], P[BASE + 5]), b1 = cvtpk(P[BASE + 6], P[BASE + 7]); \
    auto r0 = __builtin_amdgcn_permlane32_swap(a0, b0, false, false); auto r1 = __builtin_amdgcn_permlane32_swap(a1, b1, false, false); \
    u32x4 w = {r0[0], r1[0], r0[1], r1[1]}; OUT = *reinterpret_cast<bf16x8*>(&w); } while (0)
        GLA_PK4(pf0, 0, pa0); GLA_PK4(pf0, 8, pa1); GLA_PK4(pf1, 0, pa2); GLA_PK4(pf1, 8, pa3);
#undef GLA_PK4
        f32x16 o0 = {}, o1 = {};
        { const int vb = (int)(unsigned)(uintptr_t)(lds + B_V + c * 8192) + att::v_rd_base(lane);
#define GLA_AF(ks) ((ks) == 0 ? pa0 : (ks) == 1 ? pa1 : (ks) == 2 ? pa2 : pa3)
          GLA_MM4(o0, o1, vb, GLA_AF);
#undef GLA_AF
        }
        { const int vb = (int)(unsigned)(uintptr_t)(lds + B_SC + c * 8192) + att::v_rd_base(lane);
#define GLA_AF(ks) afrag_tr(qrow, ks, hi)
          GLA_MM4(o0, o1, vb, GLA_AF);
#undef GLA_AF
        }
        const float g0 = gng[r32], g1 = gng[32 + r32];
        const bf16_t* grb = GR + (tok0 + c * 64 + 32 * th) * 256 + h * 64 + r32; unsigned short gq0[16], gq1[16];
#pragma unroll
        for (int r = 0; r < 16; ++r) { gq0[r] = grb[(size_t)crow(r, hi) * 256]; gq1[r] = grb[(size_t)crow(r, hi) * 256 + 32]; }
#pragma unroll
        for (int r = 0; r < 16; ++r) {
            float ssq = o0[r] * o0[r] + o1[r] * o1[r];
            ssq = xadd<1>(ssq); ssq = xadd<2>(ssq); ssq = xadd<4>(ssq); ssq = xadd<8>(ssq); ssq = xadd<16>(ssq);
            const float rn = rsqrtf(ssq * (1.f / 64.f) + cfg::EPS);
            const size_t tok = tok0 + c * 64 + 32 * th + crow(r, hi);
            bf16_t* dst = OC + tok * 1024 + 768 + h * 64 + r32;
            dst[0] = (bf16_t)(cvtpk(o0[r] * rn * g0 * bf2f_(gq0[r]), 0.f) & 0xffffu); dst[32] = (bf16_t)(cvtpk(o1[r] * rn * g1 * bf2f_(gq1[r]), 0.f) & 0xffffu);
        }
    }
    __syncthreads();
}
#undef GLA_MM4
#undef GLA_PK
#undef GLAS
}
namespace fft {
using att::bf16x8; using att::s16x4; using att::f32x16; using att::u32x4; using att::crow; using att::cvtpk; using att::tr_read;
#define FLAS __attribute__((address_space(3)))
__device__ __forceinline__ int img_off(int k, int c) { const int kk = (k & ~0xC) | ((k & 4) << 1) | ((k & 8) >> 1); return ((kk >> 3) * 8 + (c >> 5)) * 512 + ((kk & 7) * 32 + (c & 31)) * 2; }
constexpr int rd_off(int ks, int half) { return ks * 8192 + half * 4096; }
#define FFT_PK(L, H) (bf16x8){L[0], L[1], L[2], L[3], H[0], H[1], H[2], H[3]}
typedef float f32x2_t __attribute__((ext_vector_type(2))); typedef __bf16 bf16x2_t __attribute__((ext_vector_type(2)));
__device__ __forceinline__ unsigned pk2f(float a, float b) { f32x2_t v = {a, b}; bf16x2_t r = __builtin_convertvector(v, bf16x2_t); return __builtin_bit_cast(unsigned, r); }

__device__ __forceinline__ void stage1_item(int b, int s2, const bf16_t* __restrict__ FX, bf16_t* __restrict__ I1, FLAS unsigned char* lds) {
    int tid_o = threadIdx.x; asm volatile("" : "+v"(tid_o));
    const int tid = tid_o, wave = __builtin_amdgcn_readfirstlane(tid >> 6), lane = tid & 63, r32 = lane & 31, hi = lane >> 5;
    bf16x8 F1[2][4];
#pragma unroll
    for (int ks = 0; ks < 4; ++ks) { float cr[8], ci[8];
#pragma unroll
        for (int j = 0; j < 8; ++j) { const int k = 16 * ks + 8 * hi + j, s1 = k & 31; const float rev = (float)((r32 * s1) & 31) * (1.f / 32.f); const float c = __builtin_amdgcn_cosf(rev), sn = __builtin_amdgcn_sinf(rev);
            const bool p1 = (k >> 5) != 0; cr[j] = p1 ? -sn : c; ci[j] = p1 ? -c : -sn; }
        u32x4 wr = {pk2f(cr[0], cr[1]), pk2f(cr[2], cr[3]), pk2f(cr[4], cr[5]), pk2f(cr[6], cr[7])}, wi = {pk2f(ci[0], ci[1]), pk2f(ci[2], ci[3]), pk2f(ci[4], ci[5]), pk2f(ci[6], ci[7])};
        F1[0][ks] = *reinterpret_cast<bf16x8*>(&wr); F1[1][ks] = *reinterpret_cast<bf16x8*>(&wi); }
    { u32x4 tv[4];
#pragma unroll
      for (int i = 0; i < 4; ++i) { const int p = tid + 512 * i, k = p >> 5, c8 = (p & 31) * 8; tv[i] = *(const u32x4*)(FX + (size_t)(b * 2048 + 64 * (k & 31) + s2) * 512 + (k >> 5) * 256 + c8); }
#pragma unroll
      for (int i = 0; i < 4; ++i) { const int p = tid + 512 * i, k = p >> 5, c8 = (p & 31) * 8; *(FLAS u32x4*)(lds + img_off(k, c8)) = tv[i]; } }
    __syncthreads();
    f32x16 re = {}, im = {};
    { const int vb = (int)(unsigned)(uintptr_t)lds + att::v_rd_base(lane) + wave * 512;
      const s16x4 l0 = tr_read<rd_off(0, 0)>(vb), h0 = tr_read<rd_off(0, 1)>(vb), l1 = tr_read<rd_off(1, 0)>(vb), h1 = tr_read<rd_off(1, 1)>(vb);
      const s16x4 l2 = tr_read<rd_off(2, 0)>(vb), h2 = tr_read<rd_off(2, 1)>(vb), l3 = tr_read<rd_off(3, 0)>(vb), h3 = tr_read<rd_off(3, 1)>(vb);
      asm volatile("s_waitcnt lgkmcnt(0)" ::: "memory"); __builtin_amdgcn_sched_barrier(0);
      re = __builtin_amdgcn_mfma_f32_32x32x16_bf16(F1[0][0], FFT_PK(l0, h0), re, 0, 0, 0); im = __builtin_amdgcn_mfma_f32_32x32x16_bf16(F1[1][0], FFT_PK(l0, h0), im, 0, 0, 0);
      re = __builtin_amdgcn_mfma_f32_32x32x16_bf16(F1[0][1], FFT_PK(l1, h1), re, 0, 0, 0); im = __builtin_amdgcn_mfma_f32_32x32x16_bf16(F1[1][1], FFT_PK(l1, h1), im, 0, 0, 0);
      re = __builtin_amdgcn_mfma_f32_32x32x16_bf16(F1[0][2], FFT_PK(l2, h2), re, 0, 0, 0); im = __builtin_amdgcn_mfma_f32_32x32x16_bf16(F1[1][2], FFT_PK(l2, h2), im, 0, 0, 0);
      re = __builtin_amdgcn_mfma_f32_32x32x16_bf16(F1[0][3], FFT_PK(l3, h3), re, 0, 0, 0); im = __builtin_amdgcn_mfma_f32_32x32x16_bf16(F1[1][3], FFT_PK(l3, h3), im, 0, 0, 0); }
    bf16_t* dst = I1 + (size_t)(b * 32) * 128 * 256 + (size_t)s2 * 256 + 32 * wave + r32;
#pragma unroll
    for (int r = 0; r < 16; ++r) { const int k1 = crow(r, hi); const float rev = (float)((k1 * s2) & 2047) * (1.f / 2048.f); const float ct = __builtin_amdgcn_cosf(rev), st = __builtin_amdgcn_sinf(rev);
        const float ar = re[r] * ct + im[r] * st, ai = im[r] * ct - re[r] * st; const unsigned w = pk2f(ar, ai);
        dst[(size_t)k1 * 128 * 256] = (bf16_t)(w & 0xffffu); dst[(size_t)k1 * 128 * 256 + 64 * 256] = (bf16_t)(w >> 16); }
    __syncthreads();
}

__device__ __forceinline__ void stage2_item(int b, int k1, const bf16_t* __restrict__ I1, bf16_t* __restrict__ OC, FLAS unsigned char* lds) {
    int tid_o = threadIdx.x; asm volatile("" : "+v"(tid_o));
    const int tid = tid_o, wave = __builtin_amdgcn_readfirstlane(tid >> 6), lane = tid & 63, r32 = lane & 31, hi = lane >> 5;
    const bf16_t* src = I1 + (size_t)(b * 32 + k1) * 128 * 256;
    { u32x4 tv[8];
#pragma unroll
      for (int i = 0; i < 8; ++i) { const int p = tid + 512 * i, k = p >> 5, c8 = (p & 31) * 8; tv[i] = *(const u32x4*)(src + (size_t)k * 256 + c8); }
#pragma unroll
      for (int i = 0; i < 8; ++i) { const int p = tid + 512 * i, k = p >> 5, c8 = (p & 31) * 8; *(FLAS u32x4*)(lds + img_off(k, c8)) = tv[i]; } }
    f32x16 y0 = {}, y1 = {};
    __syncthreads();
    const int vb = (int)(unsigned)(uintptr_t)lds + att::v_rd_base(lane) + wave * 512, vb2 = vb + 32768;
    bf16x8 F2[2][8];
#pragma unroll
    for (int ks = 0; ks < 8; ++ks) { float c0[8], c1[8];
#pragma unroll
        for (int j = 0; j < 8; ++j) { const int k = 16 * ks + 8 * hi + j, s2 = k & 63; const float r0 = (float)((r32 * s2) & 63) * (1.f / 64.f), r1 = (float)(((32 + r32) * s2) & 63) * (1.f / 64.f);
            c0[j] = (k >> 6) ? __builtin_amdgcn_sinf(r0) : __builtin_amdgcn_cosf(r0); c1[j] = (k >> 6) ? __builtin_amdgcn_sinf(r1) : __builtin_amdgcn_cosf(r1); }
        u32x4 w0 = {pk2f(c0[0], c0[1]), pk2f(c0[2], c0[3]), pk2f(c0[4], c0[5]), pk2f(c0[6], c0[7])}, w1 = {pk2f(c1[0], c1[1]), pk2f(c1[2], c1[3]), pk2f(c1[4], c1[5]), pk2f(c1[6], c1[7])};
        F2[0][ks] = *reinterpret_cast<bf16x8*>(&w0); F2[1][ks] = *reinterpret_cast<bf16x8*>(&w1); }
#define FFT_STEP(ks) do { \
      const s16x4 lo_ = tr_read<rd_off((ks) & 3, 0)>((ks) < 4 ? vb : vb2), hi_ = tr_read<rd_off((ks) & 3, 1)>((ks) < 4 ? vb : vb2); asm volatile("s_waitcnt lgkmcnt(0)" ::: "memory"); __builtin_amdgcn_sched_barrier(0); \
      y0 = __builtin_amdgcn_mfma_f32_32x32x16_bf16(F2[0][ks], FFT_PK(lo_, hi_), y0, 0, 0, 0); y1 = __builtin_amdgcn_mfma_f32_32x32x16_bf16(F2[1][ks], FFT_PK(lo_, hi_), y1, 0, 0, 0); } while (0)
    FFT_STEP(0); FFT_STEP(1); FFT_STEP(2); FFT_STEP(3); FFT_STEP(4); FFT_STEP(5); FFT_STEP(6); FFT_STEP(7);
#undef FFT_STEP
    bf16_t* dst = OC + (size_t)(b * 2048 + k1) * 1024 + 512 + 32 * wave + r32;
#pragma unroll
    for (int r = 0; r < 16; ++r) { const int k2 = crow(r, hi); const unsigned w = pk2f(y0[r], y1[r]);
        dst[(size_t)(32 * k2) * 1024] = (bf16_t)(w & 0xffffu); dst[(size_t)(32 * (32 + k2)) * 1024] = (bf16_t)(w >> 16); }
    __syncthreads();
}
#undef FFT_PK
#undef FLAS
}
namespace pro {
#define PLAS __attribute__((address_space(3)))
typedef float f32x4 __attribute__((ext_vector_type(4)));
typedef unsigned u32x4 __attribute__((ext_vector_type(4)));
__device__ __forceinline__ unsigned pk2(float lo, float hi) { unsigned r; asm volatile("v_cvt_pk_bf16_f32 %0, %1, %2" : "=v"(r) : "v"(lo), "v"(hi)); return r; }
__device__ __forceinline__ float lo_f(unsigned w) { return __uint_as_float(w << 16); }
__device__ __forceinline__ float hi_f(unsigned w) { return __uint_as_float(w & 0xffff0000u); }
template <bool SUMS, int STRIDE> __device__ __forceinline__ void tile_emit(int K, bf16_t* WT, const float* gain, const float* lnb, float (&a1)[4], float (&a2)[4], const PLAS float* scr, int lane) {
    const int c = lane & 7; float gk[8], bk[8];
#pragma unroll
    for (int q = 0; q < 8; ++q) { gk[q] = gain ? gain[8 * c + q] : 1.f; bk[q] = lnb ? lnb[8 * c + q] : 0.f; }
#pragma unroll
    for (int j = 0; j < 4; ++j) { const int n = (lane >> 3) + 8 * j; const PLAS float* s = scr + (8 * c) * STRIDE + n; float v[8];
#pragma unroll
        for (int q = 0; q < 8; ++q) v[q] = s[q * STRIDE];
        u32x4 o; o.x = pk2(v[0] * gk[0], v[1] * gk[1]); o.y = pk2(v[2] * gk[2], v[3] * gk[3]); o.z = pk2(v[4] * gk[4], v[5] * gk[5]); o.w = pk2(v[6] * gk[6], v[7] * gk[7]);
        *(u32x4*)(WT + (size_t)n * K + 8 * c) = o;
        if (SUMS) { float p1 = (lo_f(o.x) + hi_f(o.x)) + (lo_f(o.y) + hi_f(o.y)) + (lo_f(o.z) + hi_f(o.z)) + (lo_f(o.w) + hi_f(o.w)); float p2 = 0.f;
#pragma unroll
            for (int q = 0; q < 8; ++q) p2 += bk[q] * v[q];
            p1 = xadd<1>(p1); p2 = xadd<1>(p2); p1 = xadd<2>(p1); p2 = xadd<2>(p2); p1 = xadd<4>(p1); p2 = xadd<4>(p2);
            a1[j] += p1; a2[j] += p2; }
    }
    asm volatile("s_waitcnt lgkmcnt(0)" ::: "memory");
}
__device__ __forceinline__ void tile_dma(const float* W, int N, PLAS float* scr, int lane) {
    const float* src = W + (size_t)(lane >> 3) * N + (lane & 7) * 4;
#pragma unroll
    for (int i = 0; i < 8; ++i) __builtin_amdgcn_global_load_lds((const unsigned*)(src + (size_t)(8 * i) * N), (PLAS unsigned*)(scr + i * 256), 16, 0, 0);
}
template <bool SUMS, class Val> __device__ __forceinline__ void tile_item(const Val& val, int K, bf16_t* WT, const float* gain, const float* lnb, float (&a1)[4], float (&a2)[4], PLAS float* scr, int lane) {
#pragma unroll 2
    for (int i = 0; i < 32; ++i) { const int kk = 2 * i + (lane >> 5); scr[kk * 33 + (lane & 31)] = val(kk, lane & 31); }
    asm volatile("s_waitcnt lgkmcnt(0)" ::: "memory");
    tile_emit<SUMS, 33>(K, WT, gain, lnb, a1, a2, scr, lane);
}
struct ValPlain { static constexpr int BATCH = 32; const float* W; int N; __device__ __forceinline__ float operator()(int kk, int j) const { return W[(size_t)kk * N + j]; } };
struct ValGate { static constexpr int BATCH = 2; const float* W; const float* w2; __device__ __forceinline__ float operator()(int kk, int j) const {
    const float* wr = W + (size_t)kk * cfg::INW; float a = 0.f;
#pragma unroll
    for (int r = 0; r < 16; ++r) a += wr[r] * w2[r * 128 + j]; return a; } };

__device__ __forceinline__ void fold_item(int item, unsigned char* ws, const float* w_in, const float* fw, const float* lng, const float* lnb, PLAS unsigned char* lds, int tid) {
    const int l = item >> 5, g = (item >> 3) & 3, part = (item >> 2) & 1, kq = item & 3;
    PLAS float* M = (PLAS float*)lds;
    { const int c = tid >> 3, e0 = (tid & 7) * 8; float acc[8];
#pragma unroll
      for (int q = 0; q < 8; ++q) acc[q] = 0.f;
      const float* w = fw + (size_t)((l * 4 + g) * 64) * 64 + e0;
      for (int k2 = 0; k2 < 64; ++k2) { float rev = (float)((k2 * c) & 63) * (1.f / 64.f); asm volatile("" : "+v"(rev)); const float tr = part ? __builtin_amdgcn_sinf(rev) : __builtin_amdgcn_cosf(rev);
          const f32x4 w0 = *(const f32x4*)(w + k2 * 64), w1 = *(const f32x4*)(w + k2 * 64 + 4);
#pragma unroll
          for (int q = 0; q < 4; ++q) { acc[q] += tr * w0[q]; acc[4 + q] += tr * w1[q]; } }
      const float sc = 0.00276213586400995f;
#pragma unroll
      for (int q = 0; q < 8; ++q) M[c * 64 + e0 + q] = acc[q] * sc; }
    __syncthreads();
    PLAS float* Wl = (PLAS float*)(lds + 16384);
    { const float* wsrc = w_in + ((size_t)l * 1024 + kq * 256) * cfg::INW + 1536 + 64 * g; f32x4 tv[8];
#pragma unroll
      for (int i = 0; i < 8; ++i) tv[i] = *(const f32x4*)(wsrc + (size_t)((tid >> 4) + 32 * i) * cfg::INW + (tid & 15) * 4);
#pragma unroll
      for (int i = 0; i < 8; ++i) *(PLAS f32x4*)(Wl + ((tid >> 4) + 32 * i) * 64 + (tid & 15) * 4) = tv[i]; }
    __syncthreads();
    { const int e = tid & 63, kg = tid >> 6, k0 = kq * 256 + kg * 32, np = 1536 + part * 256 + g * 64 + e; float mc[64];
#pragma unroll
      for (int c = 0; c < 64; ++c) mc[c] = M[c * 64 + e];
      bf16_t* dst = (bf16_t*)(ws + cfg::WS_WIN + l * cfg::SZ_WIN) + (size_t)np * 1024 + k0; float s1 = 0.f, s2 = 0.f;
      for (int kb = 0; kb < 4; ++kb) { float o[8];
#pragma unroll
          for (int q = 0; q < 8; ++q) { const int k = k0 + kb * 8 + q; const PLAS f32x4* wr = (const PLAS f32x4*)(Wl + (kg * 32 + kb * 8 + q) * 64); float a = 0.f;
#pragma unroll
              for (int c4 = 0; c4 < 16; ++c4) { const f32x4 w4 = wr[c4]; a += w4[0] * mc[4 * c4] + w4[1] * mc[4 * c4 + 1] + w4[2] * mc[4 * c4 + 2] + w4[3] * mc[4 * c4 + 3]; }
              o[q] = a * (lng ? lng[k] : 1.f); s2 += lnb ? lnb[k] * a : 0.f; }
          u32x4 w; w.x = pk2(o[0], o[1]); w.y = pk2(o[2], o[3]); w.z = pk2(o[4], o[5]); w.w = pk2(o[6], o[7]); *(u32x4*)(dst + kb * 8) = w;
          s1 += (lo_f(w.x) + hi_f(w.x)) + (lo_f(w.y) + hi_f(w.y)) + (lo_f(w.z) + hi_f(w.z)) + (lo_f(w.w) + hi_f(w.w)); }
      __syncthreads();
      PLAS float* red = (PLAS float*)lds; red[(kg * 64 + e) * 2] = s1; red[(kg * 64 + e) * 2 + 1] = s2;
      __syncthreads();
      if (kg == 0) { float t1 = 0.f, t2 = 0.f;
#pragma unroll
          for (int w = 0; w < 8; ++w) { t1 += red[(w * 64 + e) * 2]; t2 += red[(w * 64 + e) * 2 + 1]; }
          float* fp = (float*)(ws + cfg::V_MF) + (size_t)((l * 4 + kq) * 2) * 512 + part * 256 + g * 64 + e; fp[0] = t1; fp[512] = t2; } }
    __syncthreads();
}

struct Inputs { const float *x, *w_in, *fw, *gw2, *w_out, *ln1g, *ln1b, *wg, *wu, *wd, *ln2g, *ln2b; };
__device__ __forceinline__ void prologue(unsigned char* ws, const Inputs& in, PLAS unsigned char* lds, int vcu, int G) {
    int tid_o = threadIdx.x; asm volatile("" : "+v"(tid_o));
    const int tid = tid_o, wave = __builtin_amdgcn_readfirstlane(tid >> 6), lane = tid & 63;
    const float* x = in.x; const float* w_in = in.w_in; const float* fw = in.fw; const float* gw2 = in.gw2; const float* w_out = in.w_out; const float* ln1g = in.ln1g; const float* ln1b = in.ln1b;
    const float* wg = in.wg; const float* wu = in.wu; const float* wd = in.wd; const float* ln2g = in.ln2g; const float* ln2b = in.ln2b;
    if (vcu < 64) { const int l = vcu >> 5; fold_item(vcu, ws, w_in, fw, l ? ln2g : (const float*)nullptr, l ? ln2b : (const float*)nullptr, lds, tid); }
    PLAS float* scr = (PLAS float*)(lds + wave * 16384); PLAS float* scr1 = scr + 2048; PLAS float* redw = (PLAS float*)(lds + 131072 + 1024 + wave * 256);
    const int gw = vcu * 8 + wave, NGW = G * 8;
    for (int it = vcu; it < 512; it += G) {
        const int l = it >> 8, r = it & 255; float a1[4] = {0.f, 0.f, 0.f, 0.f}, a2[4] = {0.f, 0.f, 0.f, 0.f}; float* c1o; float* c2o;
        const int k0 = wave * 64, k1 = k0 + 512;
        if (r < 80) { const int nb = r; const float* lngb = l ? ln2g : (const float*)nullptr; const float* lnbb = l ? ln2b : (const float*)nullptr;
            bf16_t* Wt = (bf16_t*)(ws + cfg::WS_WIN + l * cfg::SZ_WIN);
            if (nb < 72) { int np0, src;
                if (nb < 32) { const int pn = nb >> 3, p = (nb & 7) * 32, wc = (p >> 5) & 3, bj = p >> 7; np0 = pn * 256 + p; src = (pn >> 1) * 512 + (pn & 1) * 256 + 64 * wc + 32 * bj; }
                else if (nb < 48) { np0 = 1024 + (nb - 32) * 32; src = np0; }
                else { np0 = 2048 + (nb - 48) * 32; src = 1792 + (nb - 48) * 32; }
                tile_dma(w_in + ((size_t)l * 1024 + k0) * cfg::INW + src, cfg::INW, scr, lane); tile_dma(w_in + ((size_t)l * 1024 + k1) * cfg::INW + src, cfg::INW, scr1, lane);
                asm volatile("s_waitcnt vmcnt(0)" ::: "memory");
                tile_emit<true, 32>(1024, Wt + (size_t)np0 * 1024 + k0, lngb ? lngb + k0 : lngb, lnbb ? lnbb + k0 : lnbb, a1, a2, scr, lane);
                tile_emit<true, 32>(1024, Wt + (size_t)np0 * 1024 + k1, lngb ? lngb + k1 : lngb, lnbb ? lnbb + k1 : lnbb, a1, a2, scr1, lane);
                c1o = (float*)(ws + cfg::V_C1IN) + l * cfg::NIN + np0; c2o = (float*)(ws + cfg::V_C2IN) + l * cfg::NIN + np0;
            } else { const int p0 = (nb - 72) * 32, dir = p0 >> 7, kk0 = p0 & 127, np0 = 2816 + p0;
                for (int kb = wave; kb < 16; kb += 8) { const int kq = kb * 64; ValGate v{w_in + ((size_t)l * 1024 + kq) * cfg::INW + 2560 + 16 * dir, gw2 + (size_t)((l * 2 + dir) * 16) * 128 + kk0};
                    tile_item<true>(v, 1024, Wt + (size_t)np0 * 1024 + kq, lngb ? lngb + kq : lngb, lnbb ? lnbb + kq : lnbb, a1, a2, scr, lane); }
                c1o = (float*)(ws + cfg::V_C1IN) + l * cfg::NIN + np0; c2o = (float*)(ws + cfg::V_C2IN) + l * cfg::NIN + np0; }
        } else { const int nb = r - 80, np0 = nb * 32, pn = np0 >> 8, p = np0 & 255, bj = p >> 7, f0 = 128 * pn + (p & 127);
            const float* W = (bj ? wu : wg) + (size_t)l * 1024 * cfg::FF + f0; bf16_t* Wt = (bf16_t*)(ws + cfg::WS_WGU + l * cfg::SZ_WGU) + (size_t)np0 * 1024;
            tile_dma(W + (size_t)k0 * cfg::FF, cfg::FF, scr, lane); tile_dma(W + (size_t)k1 * cfg::FF, cfg::FF, scr1, lane);
            asm volatile("s_waitcnt vmcnt(0)" ::: "memory");
            tile_emit<true, 32>(1024, Wt + k0, ln1g + l * 1024 + k0, ln1b + l * 1024 + k0, a1, a2, scr, lane);
            tile_emit<true, 32>(1024, Wt + k1, ln1g + l * 1024 + k1, ln1b + l * 1024 + k1, a1, a2, scr1, lane);
            c1o = (float*)(ws + cfg::V_C1GU) + l * cfg::NGU + np0; c2o = (float*)(ws + cfg::V_C2GU) + l * cfg::NGU + np0; }
        if ((lane & 7) == 0) {
#pragma unroll
            for (int j = 0; j < 4; ++j) { const int n = (lane >> 3) + 8 * j; redw[n * 2] = a1[j]; redw[n * 2 + 1] = a2[j]; } }
        __syncthreads();
        if (wave == 0 && lane < 32) { float t1 = 0.f, t2 = 0.f;
#pragma unroll
            for (int w = 0; w < 8; ++w) { const PLAS float* rw = (const PLAS float*)(lds + 131072 + 1024 + w * 256); t1 += rw[lane * 2]; t2 += rw[lane * 2 + 1]; }
            c1o[lane] = t1; c2o[lane] = t2; }
        __syncthreads();
    }
    constexpr int I_OUT = 32 * 16, I_DN = 32 * 44, I_L = I_OUT + I_DN;
    for (int it = gw; it < 2 * I_L; it += 2 * NGW) {
        const float* Ws[2]; int Ns[2], Ks[2]; bf16_t* Wd[2]; float d1[4], d2[4];
#pragma unroll
        for (int q = 0; q < 2; ++q) { const int itq = it + q * NGW; const int ic = itq < 2 * I_L ? itq : it; const int l = ic / I_L; int r = ic - l * I_L;
            if (r < I_OUT) { const int nb = r >> 4, kb = r & 15, k0 = kb * 64, n0 = nb * 32; Ws[q] = w_out + ((size_t)l * 1024 + k0) * 1024 + n0; Ns[q] = 1024; Ks[q] = 1024;
                Wd[q] = (bf16_t*)(ws + cfg::WS_WOUT + l * cfg::SZ_WOUT) + (size_t)n0 * 1024 + k0; }
            else { r -= I_OUT; const int nb = r / 44, kb = r - nb * 44, k0 = kb * 64, n0 = nb * 32; Ws[q] = wd + ((size_t)l * cfg::FF + k0) * 1024 + n0; Ns[q] = 1024; Ks[q] = cfg::FF;
                Wd[q] = (bf16_t*)(ws + cfg::WS_WDN + l * cfg::SZ_WDN) + (size_t)n0 * cfg::FF + k0; } }
        tile_dma(Ws[0], Ns[0], scr, lane); tile_dma(Ws[1], Ns[1], scr1, lane);
        asm volatile("s_waitcnt vmcnt(0)" ::: "memory");
        tile_emit<false, 32>(Ks[0], Wd[0], (const float*)nullptr, (const float*)nullptr, d1, d2, scr, lane);
        if (it + NGW < 2 * I_L) tile_emit<false, 32>(Ks[1], Wd[1], (const float*)nullptr, (const float*)nullptr, d1, d2, scr1, lane);
    }
    const int xw = (vcu - 64) * 8 + wave, NXW = (G - 64) * 8;
    if (vcu >= 64 && G > 64)
    for (int m = xw; m < cfg::T; m += 4 * NXW) {
        f32x4 v[4][4];
#pragma unroll
        for (int q = 0; q < 4; ++q) { const int mr = (m + q * NXW) < cfg::T ? (m + q * NXW) : m; const f32x4* xr = (const f32x4*)(x + (size_t)mr * 1024) + lane;
#pragma unroll
            for (int j = 0; j < 4; ++j) v[q][j] = xr[64 * j]; }
#pragma unroll
        for (int q = 0; q < 4; ++q) { const int mr = (m + q * NXW) < cfg::T ? (m + q * NXW) : m; unsigned long long* o8 = (unsigned long long*)((bf16_t*)(ws + cfg::WS_XB) + (size_t)mr * 1024) + lane;
#pragma unroll
            for (int j = 0; j < 4; ++j) o8[64 * j] = (unsigned long long)pk2(v[q][j][0], v[q][j][1]) | ((unsigned long long)pk2(v[q][j][2], v[q][j][3]) << 32); } }
    for (int i = gw * 64 + lane; i < 2048 * 32; i += NGW * 64) { const int pos = i >> 5, f = i & 31; const float inv = exp2f(-(float)f * (13.287712379549449f / 32.f)); const float ang = (float)pos * inv;
        double rv = (double)ang * 0.15915494309189535; rv -= floor(rv); const float rev = (float)rv;
        ((float*)(ws + cfg::V_ROPEC))[i] = __builtin_amdgcn_cosf(rev); ((float*)(ws + cfg::V_ROPES))[i] = __builtin_amdgcn_sinf(rev); }
}
#undef PLAS
}
constexpr int NWAVES = 8;
constexpr int RING_OFF = 0, RING_BYTES = 131072;
constexpr int LDSCTL_OFF = RING_BYTES, MISC_OFF = LDSCTL_OFF + 320;
constexpr int RSL_OFF = 131072 + 4096;
constexpr int LDS_BYTES = 147456;
constexpr int CW_BAR = 4096;
constexpr int CW_GBAR = 8192, GBAR_STRIDE = 4096;
constexpr size_t CTL_ZERO_BYTES = 192 * 1024;
#define GAS __attribute__((address_space(1)))
#define LAS __attribute__((address_space(3)))
typedef GAS unsigned gu32;
#define RLX_AGENT __ATOMIC_RELAXED, __HIP_MEMORY_SCOPE_AGENT
#define XB_TMO      128
#define XB_XCNT(j)  (256  + 64 * (j))
#define XB_XSUB(j)  (1280 + 64 * (j))
#define XB_XGEN(j)  (2304 + 64 * (j))
#define XB_TOP      3328
#define XB_TOPGEN   3392
#define XCD_BAR_WORDS 3456
#define XB_SPIN_CAP (1u << 18)

__device__ __forceinline__ unsigned xb_ld(unsigned* p)              { return __hip_atomic_load(p, __ATOMIC_RELAXED, __HIP_MEMORY_SCOPE_AGENT); }
__device__ __forceinline__ unsigned xb_add(unsigned* p, unsigned v) { return __hip_atomic_fetch_add(p, v, __ATOMIC_RELAXED, __HIP_MEMORY_SCOPE_AGENT); }
__device__ __forceinline__ unsigned xb_xcc_id() { return (unsigned)__builtin_amdgcn_s_getreg((3 << 11) | 20) & 0xFu; }
#define XB_SPIN(cond, bar) do { unsigned _sp = 0; while (cond) { __builtin_amdgcn_s_sleep(1); \
    if ((++_sp & 255u) == 0u) { if (xb_ld(&(bar)[XB_TMO])) break; if (_sp > XB_SPIN_CAP) { atomicAdd(&(bar)[XB_TMO], 1u); break; } } } } while (0)

struct XcdBarrier {
    unsigned* bar; unsigned x; unsigned total;
    volatile LAS unsigned* st;
};

__device__ __forceinline__ XcdBarrier xcd_barrier_post(unsigned* bar, volatile LAS unsigned* st, unsigned total) {
    XcdBarrier b; b.bar = bar; b.x = xb_xcc_id(); b.st = st; b.total = total;
    if (threadIdx.x == 0) (void)xb_add(&bar[XB_XCNT(b.x)], 1u);
    return b;
}
__device__ __forceinline__ void xcd_barrier_complete(unsigned* bar, unsigned x, unsigned G, unsigned& nloc, unsigned& nx) {
    unsigned sum, cnt, mine, sp = 0u;
    for (;;) {
        sum = 0u; cnt = 0u; mine = 0u;
#pragma unroll
        for (unsigned j = 0; j < 16; ++j) { const unsigned c = xb_ld(&bar[XB_XCNT(j)]); sum += c; cnt += (c > 0u) ? 1u : 0u; mine = (j == x) ? c : mine; }
        if (sum == G) break;
        __builtin_amdgcn_s_sleep(1);
        if ((++sp & 255u) == 0u) { if (xb_ld(&bar[XB_TMO])) break; if (sp > XB_SPIN_CAP) { atomicAdd(&bar[XB_TMO], 1u); break; } }
    }
    nloc = mine > 0u ? mine : 1u; nx = cnt > 0u ? cnt : 1u;
}

__device__ __forceinline__ void xcd_barrier(const XcdBarrier& b) {
    asm volatile("s_waitcnt vmcnt(0)" ::: "memory");
    __syncthreads();
    if (threadIdx.x == 0) {
        unsigned* bar = b.bar;
        __builtin_amdgcn_s_waitcnt(0);
        unsigned nloc = b.st[0], nx = b.st[1];
        if (nloc == 0u) { xcd_barrier_complete(bar, b.x, b.total, nloc, nx); b.st[0] = nloc; b.st[1] = nx; }
        const unsigned old = xb_add(&bar[XB_XSUB(b.x)], 1u);
        const unsigned gen = old / nloc;
        if (old + 1u == (gen + 1u) * nloc) {
            __builtin_amdgcn_fence(__ATOMIC_RELEASE, "agent");
            asm volatile("s_waitcnt vmcnt(0)" ::: "memory");
            const unsigned og = xb_add(&bar[XB_TOP], 1u);
            const unsigned tg = og / nx;
            if (og + 1u == (tg + 1u) * nx) xb_add(&bar[XB_TOPGEN], 1u);
            else XB_SPIN(xb_ld(&bar[XB_TOPGEN]) == tg, bar);
            __builtin_amdgcn_fence(__ATOMIC_ACQUIRE, "agent");
            xb_add(&bar[XB_XGEN(b.x)], 1u);
            asm volatile("s_waitcnt vmcnt(0)" ::: "memory");
        } else {
            XB_SPIN(xb_ld(&bar[XB_XGEN(b.x)]) == gen, bar);
            __builtin_amdgcn_fence(__ATOMIC_ACQUIRE, "agent");
            asm volatile("s_waitcnt vmcnt(0)" ::: "memory");
        }
    }
    __syncthreads();
}


#define FILL_RSL(STP) do { pg8::Unit u0_; if (S.next(0, u0_)) { int tq_ = threadIdx.x; asm volatile("" : "+v"(tq_)); const int row_ = u0_.pm * 256 + (tq_ >> 1), hf_ = tq_ & 1; \
    typedef float f32x4_ __attribute__((ext_vector_type(4))); typedef float f32x2_ __attribute__((ext_vector_type(2))); \
    const f32x4_* sp_ = (const f32x4_*)((STP) + (size_t)row_ * 32 + hf_ * 16); const f32x4_ x0 = sp_[0], x1 = sp_[1], x2 = sp_[2], x3 = sp_[3]; \
    float sm_ = ((x0[0] + x0[2]) + (x1[0] + x1[2])) + ((x2[0] + x2[2]) + (x3[0] + x3[2])), sq_ = ((x0[1] + x0[3]) + (x1[1] + x1[3])) + ((x2[1] + x2[3]) + (x3[1] + x3[3])); \
    sm_ = xadd<1>(sm_); sq_ = xadd<1>(sq_); const float mu_ = sm_ * (1.f / 1024.f), rstd_ = rsqrtf(fmaxf(sq_ * (1.f / 1024.f) - mu_ * mu_, 0.f) + EPS); \
    if (hf_ == 0) *(LAS f32x2_*)(ldsl + RSL_OFF + 8 * (tq_ >> 1)) = (f32x2_){rstd_, -rstd_ * mu_}; } \
    __syncthreads(); } while (0)

enum { PH_PRO = 0, PH_IN = 1, PH_ATT = 2, PH_MIXB = 3, PH_OUT = 4, PH_GU = 5, PH_DN = 6, PH_FIN = 13, N_PHASES = 14 };
struct MArgs { const float* in[16]; float* out; unsigned char* ws; int ph_lo, ph_hi, li, pad; };

__global__ void __launch_bounds__(NWAVES * 64, 2) mk_fwd(MArgs a) {
    extern __shared__ __attribute__((aligned(128))) unsigned char lds[];
    LAS unsigned char* ldsl = (LAS unsigned char*)lds;
    volatile LAS unsigned* MISC = (volatile LAS unsigned*)(ldsl + MISC_OFF);
    const int tid = threadIdx.x;
    const int G = gridDim.x, bx = blockIdx.x, vcu = (G % 8 == 0) ? (bx % 8) * (G / 8) + bx / 8 : bx;
    unsigned char* ws = a.ws;
    for (int u = tid; u < (LDS_BYTES - LDSCTL_OFF) / 4; u += NWAVES * 64) ((LAS unsigned*)(ldsl + LDSCTL_OFF))[u] = 0u;
    __syncthreads();
    XcdBarrier bar; bar.bar = (unsigned*)(ws + WS_CTL) + CW_BAR + a.li * XCD_BAR_WORDS; bar.x = 0; bar.st = nullptr; bar.total = (unsigned)G;
    if (a.ph_hi - a.ph_lo > 1) bar = xcd_barrier_post((unsigned*)(ws + WS_CTL) + CW_BAR + a.li * XCD_BAR_WORDS, MISC + 8, (unsigned)G);
    const bool grp_ok = (G % 8 == 0) && (a.ph_hi - a.ph_lo > 1);
    XcdBarrier gbar = bar;
    if (grp_ok) gbar = xcd_barrier_post((unsigned*)(ws + WS_CTL) + CW_GBAR + (bx & 7) * GBAR_STRIDE, MISC + 10, (unsigned)(G / 8));
    const int G0 = G, bx0 = bx, vcu0 = vcu; unsigned char* const ws0 = ws;
    for (int ph = a.ph_lo; ph < a.ph_hi; ++ph) {
        int G = G0, bx = bx0, vcu = vcu0; unsigned zo = 0u; asm volatile("" : "+s"(G), "+s"(bx), "+s"(vcu), "+s"(zo)); unsigned char* ws = ws0 + zo;
        const int l = (ph >= 1 && ph <= 12) ? (ph - 1) / 6 : 0;
        const int kind = (ph == 0) ? PH_PRO : (ph == PH_FIN ? PH_FIN : 1 + (ph - 1) % 6);
        if (kind == PH_PRO) {
            { pro::Inputs pin{a.in[0], a.in[1], a.in[4], a.in[5], a.in[8], a.in[9], a.in[10], a.in[11], a.in[12], a.in[13], a.in[14], a.in[15]}; pro::prologue(ws, pin, ldsl + RING_OFF, vcu, G); }
        } else if (kind == PH_IN) {
            pg8::Gemm g{(const bf16_t*)(ws + WS_XB), (const bf16_t*)(ws + WS_WIN + l * SZ_WIN), T, NIN, D}; pg8::StaticOrder S; S.init(T, NIN, G, bx);
            if (l) FILL_RSL((const float*)(ws + WS_ST2));
            pg8::FEpiIn E{ws, a.in[6] + l * 256, l, (const LAS float*)(ldsl + RSL_OFF)};
            pg8::gemm_phase<pg8::FEpiIn, pg8::StaticOrder, true, true>(ldsl + RING_OFF, g, S, E);
        } else if (kind == PH_ATT) {
            for (int i = 0; i < 2; ++i) { const int idx = vcu * 2 + i; if (idx >= 512) break; const int bh = idx >> 4, qb = idx & 15;
                att::attn_unit(bh >> 2, bh & 3, qb, (const bf16_t*)(ws + WS_Q), (const bf16_t*)(ws + WS_K), (const bf16_t*)(ws + WS_V), (bf16_t*)(ws + WSB_OC + (size_t)(bh >> 2) * DLT_OC), a.in[2] + l * 256, a.in[3] + l * 128, l, (char*)lds + RING_OFF); }
            for (int i = 0; i < 2; ++i) { const int it = vcu * 2 + i; if (it >= 512) break;
                                fft::stage1_item(it >> 6, it & 63, (const bf16_t*)(ws + WS_TAB), (bf16_t*)(ws + WS_XT), ldsl + RING_OFF); }

            if (vcu < 256) gla::gla_a_item(vcu >> 5, (vcu >> 3) & 3, vcu & 7, ws, ldsl + RING_OFF);
        } else if (kind == PH_MIXB) {
            if (vcu < 256) fft::stage2_item(vcu >> 5, vcu & 31, (const bf16_t*)(ws + WS_XT), (bf16_t*)(ws + WSB_OC + (size_t)(vcu >> 5) * DLT_OC), ldsl + RING_OFF);
            if (vcu < 256) gla::gla_b_item(vcu >> 5, (vcu >> 3) & 3, vcu & 7, ws, a.in[7] + l * 64, (bf16_t*)(ws + WSB_OC + (size_t)(vcu >> 5) * DLT_OC), ldsl + RING_OFF);
        } else if (kind == PH_OUT) {
            pg8::Gemm g{(const bf16_t*)(ws + WSB_OC + (size_t)(bx & 7) * DLT_OC), (const bf16_t*)(ws + WS_WOUT + l * SZ_WOUT), T, D, D}; pg8::StaticOrder S; S.init(T, D, G, bx);
            if (l) FILL_RSL((const float*)(ws + WS_ST2));
            pg8::FEpiRes E{l ? (const LAS float*)(ldsl + RSL_OFF) : (const LAS float*)nullptr, a.in[14] + (l ? l - 1 : 0) * 1024, a.in[15] + (l ? l - 1 : 0) * 1024, (bf16_t*)(ws + WS_XB), (float*)(ws + WS_ST1)};
            pg8::gemm_phase<pg8::FEpiRes, pg8::StaticOrder, true, true>(ldsl + RING_OFF, g, S, E);
        } else if (kind == PH_GU) {
            pg8::Gemm g{(const bf16_t*)(ws + WS_XB), (const bf16_t*)(ws + WS_WGU + l * SZ_WGU), T, NGU, D}; pg8::StaticOrder S; S.init(T, NGU, G, bx);
            FILL_RSL((const float*)(ws + WS_ST1));
            pg8::FEpiGU E{(const LAS float*)(ldsl + RSL_OFF), (const float*)(ws + V_C1GU) + l * NGU, (const float*)(ws + V_C2GU) + l * NGU, (bf16_t*)(ws + WS_ACT)};
            pg8::gemm_phase<pg8::FEpiGU, pg8::StaticOrder, true, true>(ldsl + RING_OFF, g, S, E);
        } else if (kind == PH_DN) {
            pg8::Gemm g{(const bf16_t*)(ws + WS_ACT), (const bf16_t*)(ws + WS_WDN + l * SZ_WDN), T, D, FF}; pg8::StaticOrder S; S.init(T, D, G, bx);
            FILL_RSL((const float*)(ws + WS_ST1));
            pg8::FEpiRes E{(const LAS float*)(ldsl + RSL_OFF), a.in[9] + l * 1024, a.in[10] + l * 1024, (bf16_t*)(ws + WS_XB), (float*)(ws + WS_ST2)};
            pg8::gemm_phase<pg8::FEpiRes, pg8::StaticOrder, true, true>(ldsl + RING_OFF, g, S, E);
        } else if (kind == PH_FIN) {
            const float* g2 = a.in[14] + 1024; const float* b2v = a.in[15] + 1024; const float* ST2 = (const float*)(ws + WS_ST2); const bf16_t* XB = (const bf16_t*)(ws + WS_XB); float* Y2 = a.out;
            int tid_f = threadIdx.x; asm volatile("" : "+v"(tid_f)); const int lane = tid_f & 63, wave = __builtin_amdgcn_readfirstlane(tid_f >> 6);
            typedef float f32x4 __attribute__((ext_vector_type(4))); typedef unsigned u32x2 __attribute__((ext_vector_type(2)));
            f32x4 gg[4], bq[4];
#pragma unroll
            for (int j = 0; j < 4; ++j) { gg[j] = *((const f32x4*)g2 + lane + 64 * j); bq[j] = *((const f32x4*)b2v + lane + 64 * j); }
            const bool grp_rows = (G % 8 == 0) && (S % ((G / 8) * NWAVES) == 0);
            const int r_first = grp_rows ? (bx & 7) * S + (bx >> 3) * NWAVES + wave : vcu * NWAVES + wave, r_step = grp_rows ? (G / 8) * NWAVES : G * NWAVES, r_end = grp_rows ? (bx & 7) * S + S : T;
            for (int row = r_first; row < r_end; row += r_step) { const RowStat rs = row_stat(ST2, row);
                const u32x2* xr = (const u32x2*)(XB + (size_t)row * 1024) + lane; f32x4* yr = (f32x4*)(Y2 + (size_t)row * 1024) + lane;
#pragma unroll
                for (int j = 0; j < 4; ++j) { const u32x2 w = xr[64 * j]; const f32x4 v = {__uint_as_float(w.x << 16), __uint_as_float(w.x & 0xffff0000u), __uint_as_float(w.y << 16), __uint_as_float(w.y & 0xffff0000u)};
                    yr[64 * j] = (v - rs.mu) * rs.rstd * gg[j] + bq[j]; } }
        }
        if (ph + 1 < a.ph_hi) { const bool local = grp_ok && kind != PH_PRO; if (local) xcd_barrier(gbar); else xcd_barrier(bar); }
    }
}

static void launch_frame(const MArgs& base, int lo, int hi, int grid, hipStream_t stream, int li = 0) {
    MArgs a = base; a.ph_lo = lo; a.ph_hi = hi; a.li = li;
    hipLaunchKernelGGL(mk_fwd, dim3(grid), dim3(NWAVES * 64), LDS_BYTES, stream, a);
}
extern "C" void kernel_launch(void* const* d_in, const int* in_sizes, int n_in, void* d_out, int out_size, void* d_ws, size_t ws_size, hipStream_t stream) {
    static int grid = 0;
    if (grid == 0) {
        if (n_in != 16 || in_sizes[0] != T * D || out_size != T * D || ws_size < WS_END) { fprintf(stderr, "kernel_launch: unexpected shapes (n_in %d, in0 %d, out %d, ws %zu)\n", n_in, n_in > 0 ? in_sizes[0] : -1, out_size, ws_size); grid = -1; return; }
        int dev = 0, cus = 0, per_cu = 0;
        if (hipGetDevice(&dev) != hipSuccess || hipDeviceGetAttribute(&cus, hipDeviceAttributeMultiprocessorCount, dev) != hipSuccess) { grid = -1; return; }
        if (hipFuncSetAttribute((const void*)mk_fwd, hipFuncAttributeMaxDynamicSharedMemorySize, LDS_BYTES) != hipSuccess) { fprintf(stderr, "kernel_launch: hipFuncSetAttribute failed\n"); grid = -1; return; }
        if (hipOccupancyMaxActiveBlocksPerMultiprocessor(&per_cu, (const void*)mk_fwd, NWAVES * 64, LDS_BYTES) != hipSuccess || per_cu < 1) { fprintf(stderr, "kernel_launch: occupancy query says %d workgroups per CU\n", per_cu); per_cu = 1; }
        (void)hipGetLastError();
        grid = cus;
        if (grid != 256) { fprintf(stderr, "kernel_launch: this kernel's work split is built for the 256 CUs of an MI355X, found %d; nothing launched\n", cus); grid = -1; return; }
    }
    if (grid < 0) return;
    const float* x = (const float*)d_in[0]; const float* w_in = (const float*)d_in[1]; const float* dlam = (const float*)d_in[2]; const float* dng = (const float*)d_in[3];
    const float* fw = (const float*)d_in[4]; const float* gw2 = (const float*)d_in[5]; const float* gb2 = (const float*)d_in[6]; const float* gng = (const float*)d_in[7];
    const float* w_out = (const float*)d_in[8]; const float* ln1g = (const float*)d_in[9]; const float* ln1b = (const float*)d_in[10];
    const float* wg = (const float*)d_in[11]; const float* wu = (const float*)d_in[12]; const float* wd = (const float*)d_in[13]; const float* ln2g = (const float*)d_in[14]; const float* ln2b = (const float*)d_in[15];
    char* ws = (char*)d_ws;
    float* ropec = (float*)(ws + V_ROPEC); float* ropes = (float*)(ws + V_ROPES); float* MF = (float*)(ws + V_MF);
    float* c1in = (float*)(ws + V_C1IN); float* c2in = (float*)(ws + V_C2IN); float* c1gu = (float*)(ws + V_C1GU); float* c2gu = (float*)(ws + V_C2GU);
    bf16_t* TAB = (bf16_t*)(ws + WS_TAB); bf16_t* XB = (bf16_t*)(ws + WS_XB);
    bf16_t* Q = (bf16_t*)(ws + WS_Q); bf16_t* K = (bf16_t*)(ws + WS_K); bf16_t* V = (bf16_t*)(ws + WS_V);
    bf16_t* GQK = (bf16_t*)(ws + WS_GQK); bf16_t* GV = (bf16_t*)(ws + WS_GV); bf16_t* GR = (bf16_t*)(ws + WS_GR); float* GL = (float*)(ws + WS_GL);
    bf16_t* OC = (bf16_t*)(ws + WS_OC); float* OF = (float*)(ws + WS_OF);
    (void)hipMemsetAsync(ws + WS_CTL, 0, CTL_ZERO_BYTES, stream);
    MArgs base{}; for (int i = 0; i < 16; ++i) base.in[i] = (const float*)d_in[i]; base.out = (float*)d_out; base.ws = (unsigned char*)d_ws;
    launch_frame(base, 0, N_PHASES, grid, stream, 0);
}
```

```cpp
#include <hip/hip_runtime.h>
#include <cstdint>
#include <cstdio>
#include <cmath>

typedef unsigned short bf16_t;
namespace cfg {
constexpr int B = 8, S = 2048, D = 1024, T = B * S, L = 2;
constexpr int INW = 2592, NIN = 3072, FF = 2816, NGU = 2 * FF;
constexpr float ALPHA = 1.41421356237309515f;
constexpr float EPS = 1e-5f;
constexpr float QSCALE = 0.125f * 1.4426950408889634f;
constexpr float GQSCALE = 0.17677669529663687f;
constexpr size_t MiB = 1u << 20;
constexpr size_t WS_CTL = 0;
constexpr size_t WS_VEC = 1 * MiB;
constexpr size_t V_ROPEC = WS_VEC, V_ROPES = WS_VEC + 256 * 1024, V_MF = WS_VEC + 512 * 1024;
constexpr size_t V_C1IN = WS_VEC + 768 * 1024, V_C2IN = V_C1IN + 24 * 1024, V_C1GU = V_C2IN + 24 * 1024, V_C2GU = V_C1GU + 44 * 1024;
constexpr size_t WS_WIN = 2 * MiB, WS_WOUT = 14 * MiB, WS_WGU = 18 * MiB, WS_WDN = 40 * MiB, WS_TAB = 51 * MiB;
constexpr size_t SZ_WIN = 6 * MiB, SZ_WOUT = 2 * MiB, SZ_WGU = 11 * MiB, SZ_WDN = 5632 * 1024;
constexpr size_t WS_XB = 67 * MiB;
constexpr size_t WS_Y1 = 99 * MiB, WS_Q = 99 * MiB, WS_K = 115 * MiB, WS_V = 131 * MiB, WS_XT = 147 * MiB;
constexpr size_t WS_ACT = 163 * MiB, WS_GQK = 163 * MiB, WS_GV = 171 * MiB, WS_GR = 179 * MiB, WS_GL = 187 * MiB, WS_OC = 203 * MiB, WS_OF = 235 * MiB;
constexpr size_t WSB_GQK = WS_ACT, WSB_GV = WS_ACT + 1 * MiB, WSB_GR = WS_ACT + 2 * MiB, WSB_GL = WS_ACT + 3 * MiB, WSB_OC = WS_ACT + 5 * MiB, WSB_OF = WS_ACT + 9 * MiB;
constexpr size_t DLT_GQK = 10 * MiB, DLT_GV = 10 * MiB, DLT_GR = 10 * MiB, DLT_GL = 9 * MiB, DLT_OC = 7 * MiB, DLT_OF = 9 * MiB;
constexpr size_t WS_ST1 = 251 * MiB, WS_ST2 = 253 * MiB, WS_DEC = 255 * MiB, WS_END = 256 * MiB;
}
using namespace cfg;

__device__ __forceinline__ float bf2f(bf16_t v) { return __uint_as_float((unsigned)v << 16); }
__device__ __forceinline__ bf16_t f2bf(float f) { unsigned u = __float_as_uint(f); return (bf16_t)((u + 0x7fffu + ((u >> 16) & 1u)) >> 16); }


template <int M> __device__ __forceinline__ float xadd(float v) {
    if constexpr (M == 32) { auto r = __builtin_amdgcn_permlane32_swap(__float_as_uint(v), __float_as_uint(v), false, false); return __uint_as_float(r[0]) + __uint_as_float(r[1]); }
    else return v + __int_as_float(__builtin_amdgcn_ds_swizzle(__float_as_int(v), (M << 10) | 0x1f));
}
struct RowStat { float mu, rstd; };
__device__ __forceinline__ RowStat row_stat(const float* ST, int row) {
    float s = 0.f, ss = 0.f;
    for (int i = 0; i < 8; ++i) { const float4 a = *(const float4*)(ST + (size_t)row * 32 + 4 * i); s += a.x + a.z; ss += a.y + a.w; }
    const float mu = s * (1.f / 1024.f); const float var = ss * (1.f / 1024.f) - mu * mu;
    RowStat r; r.mu = mu; r.rstd = rsqrtf(fmaxf(var, 0.f) + EPS); return r;
}
namespace pg8 {
#define PG8_LAS __attribute__((address_space(3)))
typedef unsigned short bf16_t;
typedef short bf16x8 __attribute__((ext_vector_type(8)));
typedef float f32x4 __attribute__((ext_vector_type(4)));
typedef unsigned u32x4 __attribute__((ext_vector_type(4)));
constexpr int BM = 256, BK = 64, HALF = 128, HTB = HALF * BK * 2  , STAGE_BYTES = 8 * HTB, NXCD = 8, WGM = 8;

__host__ __device__ __forceinline__ int lds_byte(int r, int c) { const int st = (r >> 4) * 2 + (c >> 5), rr = r & 15, cc = c & 31, ob = rr * 64 + cc * 2; return st * 1024 + (ob ^ (((ob >> 9) & 1) << 5)); }
__host__ __device__ __forceinline__ void stage_rc(int b, int& R, int& C) { const int st = b / 1024, sb = b % 1024, swz = sb ^ (((sb >> 9) & 1) << 5); R = (st >> 1) * 16 + swz / 64; C = (st & 1) * 32 + (swz % 64) / 2; }
__host__ __device__ __forceinline__ int perm32(int rho) { const int n = rho >> 4, i = rho & 15; return 8 * (i >> 2) + 4 * n + (i & 3); }

struct Unit { int pm, pn; };
struct Gemm { const bf16_t* A; const bf16_t* Bt; int M, N, K; };

struct StaticOrder {
    int nM, nN, nwg, G, c;
    __host__ __device__ void init(int M, int N, int G_, int c_) { nM = M / BM; nN = N / BM; nwg = nM * nN; G = G_; c = c_; }
    __host__ __device__ bool next(int i, Unit& u) const {
        const long L = (long)i * G + c; if (L >= nwg) return false;
        int wgid = (int)L; { const int q = nwg / NXCD, r = nwg % NXCD, xcd = wgid % NXCD, off = wgid / NXCD; wgid = (xcd < r ? xcd * (q + 1) : r * (q + 1) + (xcd - r) * q) + off; }
        const int nig = WGM * nN, gid = wgid / nig, fm = gid * WGM, gsz = (nM - fm) < WGM ? (nM - fm) : WGM;
        u.pm = fm + ((wgid % nig) % gsz); u.pn = (wgid % nig) / gsz; return true;
    }
    __device__ __forceinline__ void a_ready(const Unit&) const {}
    __device__ __forceinline__ void done(const Unit&) const {}
};
template <class Epi, class Sched, bool ALIGN_EPI = false, bool SP2 = false>
__device__ __forceinline__ void gemm_phase(PG8_LAS unsigned char* lds, const Gemm g, const Sched& S, const Epi& E) {
    int tid_o = threadIdx.x; asm volatile("" : "+v"(tid_o));
    const int tid = tid_o, wid = __builtin_amdgcn_readfirstlane(tid >> 6), lane = tid & 63, wr = wid >> 2, wc = wid & 3, fr = lane & 15, fq = lane >> 4;
    const int K = g.K, nt = K / BK;
    unsigned voffA[2], voffB[2];
#pragma unroll
    for (int i = 0; i < 2; ++i) { int R, C; stage_rc(tid * 16 + i * 8192, R, C); const int Rb = Epi::PERM ? ((R & ~31) + perm32(R & 31)) : R;
        voffA[i] = (unsigned)(R * K + C) * 2u; voffB[i] = (unsigned)(Rb * K + C) * 2u; }
    const size_t kstep = (size_t)(BK * 2);
    const size_t hstep = (size_t)HALF * K * 2;
    const size_t tstep = 2 * hstep;
    const unsigned ldsw = (unsigned)wid * 1024u;
    const int aoff = lds_byte(wr * 64 + fr, fq * 8), boff = lds_byte(wc * 32 + fr, fq * 8);
#define PG8_SA(b, h) (((b) * 2 + (h)) * HTB)
#define PG8_SB(b, h) ((4 + (b) * 2 + (h)) * HTB)
#define PG8_STAGE(bufoff, gbase, voff) do { _Pragma("unroll") for (int _i = 0; _i < 2; ++_i) \
        __builtin_amdgcn_global_load_lds((const unsigned*)((const char*)(gbase) + (voff)[_i]), (PG8_LAS unsigned*)(lds + (bufoff) + ldsw + _i * 8192), 16, 0, 0); } while (0)
#define PG8_LDA(dst, b, h) do { _Pragma("unroll") for (int m = 0; m < 4; ++m) _Pragma("unroll") for (int k = 0; k < 2; ++k) dst[m][k] = *(const PG8_LAS bf16x8*)(lds + PG8_SA(b, h) + aoff + m * 2048 + k * 1024); } while (0)
#define PG8_LDB(dst, b, h) do { _Pragma("unroll") for (int n = 0; n < 2; ++n) _Pragma("unroll") for (int k = 0; k < 2; ++k) dst[n][k] = *(const PG8_LAS bf16x8*)(lds + PG8_SB(b, h) + boff + n * 2048 + k * 1024); } while (0)
#define PG8_MMA(ai, bj, At, Bt) do { __builtin_amdgcn_s_setprio(1); _Pragma("unroll") for (int m = 0; m < 4; ++m) _Pragma("unroll") for (int n = 0; n < 2; ++n) _Pragma("unroll") for (int k = 0; k < 2; ++k) \
        acc[ai][bj][m][n] = __builtin_amdgcn_mfma_f32_16x16x32_bf16(Bt[n][k], At[m][k], acc[ai][bj][m][n], 0, 0, 0); __builtin_amdgcn_s_setprio(0); } while (0)
#define PG8_WAIT_V(n) asm volatile("s_waitcnt vmcnt(" #n ")" ::: "memory")
#define PG8_WAIT_L(n) asm volatile("s_waitcnt lgkmcnt(" #n ")" ::: "memory")
#define PG8_BAR __builtin_amdgcn_s_barrier()
#define PG8_SCHED __builtin_amdgcn_sched_barrier(0)
    Unit cur, nxt; int ui = 0;
    if (!S.next(0, cur)) return;
    f32x4 acc[2][2][4][2];
#pragma unroll
    for (int a = 0; a < 2; ++a)
#pragma unroll
        for (int b = 0; b < 2; ++b)
#pragma unroll
            for (int m = 0; m < 4; ++m)
#pragma unroll
                for (int n = 0; n < 2; ++n) acc[a][b][m][n] = (f32x4){0.f, 0.f, 0.f, 0.f};
    bf16x8 At[4][2], B0[2][2], B1[2][2];
    const char* cA = (const char*)g.A + (size_t)cur.pm * tstep; const char* cB = (const char*)g.Bt + (size_t)cur.pn * tstep;
    S.a_ready(cur);
    if constexpr (SP2) {
        PG8_STAGE(PG8_SB(0, 0), cB, voffB); PG8_STAGE(PG8_SB(0, 1), cB + hstep, voffB); PG8_STAGE(PG8_SA(0, 0), cA, voffA); PG8_STAGE(PG8_SA(0, 1), cA + hstep, voffA);
        if (wr == 1) PG8_BAR;
        PG8_WAIT_V(2); PG8_BAR;
        PG8_STAGE(PG8_SB(1, 0), cB + kstep, voffB); PG8_STAGE(PG8_SA(1, 0), cA + kstep, voffA); PG8_STAGE(PG8_SB(1, 1), cB + hstep + kstep, voffB);
        PG8_WAIT_V(6); PG8_BAR;
    } else {
        PG8_STAGE(PG8_SB(0, 0), cB, voffB); PG8_STAGE(PG8_SA(0, 0), cA, voffA); PG8_STAGE(PG8_SB(0, 1), cB + hstep, voffB); PG8_STAGE(PG8_SA(0, 1), cA + hstep, voffA);
        if (wr == 1) PG8_BAR;
        PG8_WAIT_V(4); PG8_BAR;
        PG8_STAGE(PG8_SB(1, 0), cB + kstep, voffB); PG8_STAGE(PG8_SA(1, 0), cA + kstep, voffA); PG8_STAGE(PG8_SB(1, 1), cB + hstep + kstep, voffB);
        PG8_WAIT_V(6); PG8_BAR;
    }
    for (;;) {
        const bool has_next = S.next(ui + 1, nxt);
        const char* nA = has_next ? (const char*)g.A + (size_t)nxt.pm * tstep : cA; const char* nB = has_next ? (const char*)g.Bt + (size_t)nxt.pn * tstep : cB;
        for (int t = 0; t < nt; t += 2) {
            const bool last = (t == nt - 2);
            const char* a1 = cA + (size_t)(t + 1) * kstep;
            const char* a2 = last ? nA : cA + (size_t)(t + 2) * kstep; const char* b2 = last ? nB : cB + (size_t)(t + 2) * kstep;
            const char* a3 = a2 + kstep; const char* b3 = b2 + kstep;
            if (last && has_next) S.a_ready(nxt);
            if constexpr (SP2) {
            PG8_LDB(B0, 0, 0); PG8_LDB(B1, 0, 1); PG8_SCHED; PG8_LDA(At, 0, 0); PG8_STAGE(PG8_SA(1, 1), a1 + hstep, voffA);
            PG8_WAIT_V(8); PG8_WAIT_L(0); PG8_BAR; PG8_MMA(0, 0, At, B0); PG8_MMA(0, 1, At, B1); PG8_BAR; PG8_SCHED;
            PG8_LDA(At, 0, 1); PG8_STAGE(PG8_SB(0, 0), b2, voffB); PG8_STAGE(PG8_SB(0, 1), b2 + hstep, voffB); PG8_STAGE(PG8_SA(0, 0), a2, voffA);
            PG8_WAIT_V(8); PG8_WAIT_L(0); PG8_BAR; PG8_MMA(1, 0, At, B0); PG8_MMA(1, 1, At, B1); PG8_BAR; PG8_SCHED;
            PG8_LDB(B0, 1, 0); PG8_LDB(B1, 1, 1); PG8_SCHED; PG8_LDA(At, 1, 0); PG8_STAGE(PG8_SA(0, 1), a2 + hstep, voffA);
            PG8_WAIT_V(8); PG8_WAIT_L(0); PG8_BAR; PG8_MMA(0, 0, At, B0); PG8_MMA(0, 1, At, B1); PG8_BAR; PG8_SCHED;
            PG8_LDA(At, 1, 1); PG8_STAGE(PG8_SB(1, 0), b3, voffB); PG8_STAGE(PG8_SB(1, 1), b3 + hstep, voffB); PG8_STAGE(PG8_SA(1, 0), a3, voffA);
            PG8_WAIT_V(8); PG8_WAIT_L(0); PG8_BAR; PG8_MMA(1, 0, At, B0); PG8_MMA(1, 1, At, B1); PG8_BAR; PG8_SCHED;
            } else {
            PG8_LDB(B0, 0, 0); PG8_SCHED; PG8_LDA(At, 0, 0); PG8_STAGE(PG8_SA(1, 1), a1 + hstep, voffA);
            PG8_WAIT_L(8); PG8_BAR; PG8_WAIT_L(0); PG8_MMA(0, 0, At, B0); PG8_BAR; PG8_SCHED;
            PG8_LDB(B1, 0, 1); PG8_STAGE(PG8_SB(0, 0), b2, voffB);
            PG8_BAR; PG8_WAIT_L(0); PG8_MMA(0, 1, At, B1); PG8_BAR;
            PG8_LDA(At, 0, 1); PG8_STAGE(PG8_SA(0, 0), a2, voffA);
            PG8_BAR; PG8_WAIT_L(0); PG8_MMA(1, 0, At, B0); PG8_BAR; PG8_SCHED;
            PG8_STAGE(PG8_SB(0, 1), b2 + hstep, voffB);
            PG8_WAIT_V(6); PG8_BAR; PG8_MMA(1, 1, At, B1); PG8_BAR;
            PG8_LDB(B0, 1, 0); PG8_SCHED; PG8_LDA(At, 1, 0); PG8_STAGE(PG8_SA(0, 1), a2 + hstep, voffA);
            PG8_WAIT_L(8); PG8_BAR; PG8_WAIT_L(0); PG8_MMA(0, 0, At, B0); PG8_BAR; PG8_SCHED;
            PG8_LDB(B1, 1, 1); PG8_STAGE(PG8_SB(1, 0), b3, voffB);
            PG8_BAR; PG8_WAIT_L(0); PG8_MMA(0, 1, At, B1); PG8_BAR;
            PG8_LDA(At, 1, 1); PG8_STAGE(PG8_SA(1, 0), a3, voffA);
            PG8_BAR; PG8_WAIT_L(0); PG8_MMA(1, 0, At, B0); PG8_BAR; PG8_SCHED;
            PG8_STAGE(PG8_SB(1, 1), b3 + hstep, voffB);
            PG8_WAIT_V(6); PG8_BAR; PG8_MMA(1, 1, At, B1); PG8_BAR;
            }
        }
        if constexpr (ALIGN_EPI) { if (wr == 0) PG8_BAR; }
        if constexpr (!Epi::AFTER_DRAIN) { E(acc, cur, wr, wc, fr, fq); S.done(cur); }
        if (!has_next) break;
#pragma unroll
        for (int a = 0; a < 2; ++a)
#pragma unroll
            for (int b = 0; b < 2; ++b)
#pragma unroll
                for (int m = 0; m < 4; ++m)
#pragma unroll
                    for (int n = 0; n < 2; ++n) acc[a][b][m][n] = (f32x4){0.f, 0.f, 0.f, 0.f};
        cur = nxt; cA = nA; cB = nB; ++ui;
        if constexpr (ALIGN_EPI) { if (wr == 1) PG8_BAR; }
    }
    PG8_WAIT_V(0);
    if constexpr (!ALIGN_EPI) { if (wr == 0) PG8_BAR; }
    PG8_BAR;
    if constexpr (Epi::AFTER_DRAIN) { E.fused(acc, cur, wr, wc, fr, fq, lds, wid, lane); S.done(cur); }
#undef PG8_SA
#undef PG8_SB
#undef PG8_STAGE
#undef PG8_LDA
#undef PG8_LDB
#undef PG8_MMA
#undef PG8_WAIT_V
#undef PG8_WAIT_L
#undef PG8_BAR
#undef PG8_SCHED
}
}
namespace pg8 {
__device__ __forceinline__ unsigned cvt_pk_bf16(float lo, float hi) { unsigned r; asm volatile("v_cvt_pk_bf16_f32 %0, %1, %2" : "=v"(r) : "v"(lo), "v"(hi)); return r; }
__device__ __forceinline__ void st8(bf16_t* p, const f32x4 a, const f32x4 b) { u32x4 w; w.x = cvt_pk_bf16(a[0], a[1]); w.y = cvt_pk_bf16(a[2], a[3]); w.z = cvt_pk_bf16(b[0], b[1]); w.w = cvt_pk_bf16(b[2], b[3]); *(u32x4*)p = w; }
__device__ __forceinline__ void st8nt(bf16_t* p, const f32x4 a, const f32x4 b) { u32x4 w; w.x = cvt_pk_bf16(a[0], a[1]); w.y = cvt_pk_bf16(a[2], a[3]); w.z = cvt_pk_bf16(b[0], b[1]); w.w = cvt_pk_bf16(b[2], b[3]); __builtin_nontemporal_store(w, (u32x4*)p); }
struct RS { float a, b; };
struct StatLd { f32x4 x, y; };
__device__ __forceinline__ StatLd stat_load(const float* ST, int row, int fq) { const f32x4* p = (const f32x4*)(ST + (size_t)row * 32 + fq * 8); StatLd r; r.x = p[0]; r.y = p[1]; return r; }
__device__ __forceinline__ RS stat_fin(const StatLd& t) {
    float s = (t.x[0] + t.x[2]) + (t.y[0] + t.y[2]), ss = (t.x[1] + t.x[3]) + (t.y[1] + t.y[3]);
    s = xadd<16>(s); ss = xadd<16>(ss); s = xadd<32>(s); ss = xadd<32>(ss);
    const float mu = s * (1.f / 1024.f), var = ss * (1.f / 1024.f) - mu * mu, rstd = rsqrtf(fmaxf(var, 0.f) + cfg::EPS);
    RS r; r.a = rstd; r.b = -rstd * mu; return r;
}
__device__ __forceinline__ RS row_stat16(const float* ST, int row, int fq) { return stat_fin(stat_load(ST, row, fq)); }
__device__ __forceinline__ float fsilu(float x) { return x * __builtin_amdgcn_rcpf(1.f + __expf(-x)); }
__device__ __forceinline__ float flogsig16(float x) { return (fminf(x, 0.f) - __logf(1.f + __expf(-fabsf(x)))) * (1.f / 16.f); }

struct FEpiIn {
    static constexpr bool PERM = true, AFTER_DRAIN = false;
    unsigned char* ws; const float* b2; int l; const PG8_LAS float* rsl;
    struct RowLd { f32x4 rc[2], rsn[2]; };
    template <int KIND> __device__ __forceinline__ RowLd load_row(int row, const float (&invf)[8]) const {
        RowLd r;
        if constexpr (KIND == 0) { const float pos = (float)(row & 2047);
#pragma unroll
            for (int e = 0; e < 8; ++e) { const float ang = pos * invf[e]; double rv = (double)ang * 0.15915494309189535; rv -= floor(rv); const float rev = (float)rv;
                r.rc[e >> 2][e & 3] = __builtin_amdgcn_cosf(rev); r.rsn[e >> 2][e & 3] = __builtin_amdgcn_sinf(rev); } }
        return r;
    }
    template <int KIND> __device__ __forceinline__ void rows(const f32x4 (&acc)[2][2][4][2], const Unit& u, int wr, int wc, int fr, int fq) const {
        const int pn = u.pn, cw = 32 * wc + 8 * fq, row0 = u.pm * BM + 64 * wr + fr;
        const bool st = l != 0;
        f32x4 k1[2][2], k2[2][2], bias[2][2];
        const float qs = __uint_as_float(__builtin_amdgcn_readfirstlane(__float_as_uint(pn < 2 ? cfg::QSCALE : 1.f)));
        float invf[8];
        if constexpr (KIND == 0) {
#pragma unroll
            for (int e = 0; e < 8; ++e) invf[e] = exp2f(-(float)(8 * fq + e) * (13.287712379549449f / 32.f)); }
        RowLd cur = load_row<KIND>(row0, invf), nxt;
        if (st) {
#pragma unroll
            for (int bj = 0; bj < 2; ++bj)
#pragma unroll
                for (int n = 0; n < 2; ++n) {
                    if constexpr (KIND == 2) {
                        const float* fp = (const float*)(ws + cfg::V_MF) + (size_t)(l * 8) * 512 + (pn - 6) * 256 + cw + 128 * bj + 4 * n;
                        k1[bj][n] = (*(const f32x4*)fp + *(const f32x4*)(fp + 1024)) + (*(const f32x4*)(fp + 2048) + *(const f32x4*)(fp + 3072));
                        k2[bj][n] = (*(const f32x4*)(fp + 512) + *(const f32x4*)(fp + 1536)) + (*(const f32x4*)(fp + 2560) + *(const f32x4*)(fp + 3584));
                    } else { const float* c1 = (const float*)(ws + cfg::V_C1IN) + l * cfg::NIN + pn * 256 + cw; const float* c2 = (const float*)(ws + cfg::V_C2IN) + l * cfg::NIN + pn * 256 + cw;
                        k1[bj][n] = *(const f32x4*)(c1 + 128 * bj + 4 * n); k2[bj][n] = *(const f32x4*)(c2 + 128 * bj + 4 * n); } } }
        if constexpr (KIND == 6) {
#pragma unroll
            for (int bj = 0; bj < 2; ++bj)
#pragma unroll
                for (int n = 0; n < 2; ++n) bias[bj][n] = *(const f32x4*)(b2 + 128 * bj + cw + 4 * n); }
#pragma unroll
        for (int i = 0; i < 8; ++i) {
            const int ai = i >> 2, m = i & 3, row = row0 + 128 * ai + 16 * m, pos = row & 2047;
            if (i < 7) nxt = load_row<KIND>(row0 + 128 * ((i + 1) >> 2) + 16 * ((i + 1) & 3), invf);
            f32x4 v[2][2];
            if (st) { typedef float f32x2 __attribute__((ext_vector_type(2))); const f32x2 t2 = *(const PG8_LAS f32x2*)(rsl + 2 * (128 * ai + 64 * wr + 16 * m + fr)); RS rs; rs.a = t2[0]; rs.b = t2[1];
#pragma unroll
                for (int bj = 0; bj < 2; ++bj)
#pragma unroll
                    for (int n = 0; n < 2; ++n) v[bj][n] = rs.a * acc[ai][bj][m][n] + (rs.b * k1[bj][n] + k2[bj][n]);
            } else {
#pragma unroll
                for (int bj = 0; bj < 2; ++bj)
#pragma unroll
                    for (int n = 0; n < 2; ++n) v[bj][n] = acc[ai][bj][m][n]; }
            if constexpr (KIND == 0) {
                f32x4 a0 = v[0][0] * cur.rc[0] - v[1][0] * cur.rsn[0], a1 = v[0][1] * cur.rc[1] - v[1][1] * cur.rsn[1];
                f32x4 b0 = v[1][0] * cur.rc[0] + v[0][0] * cur.rsn[0], b1 = v[1][1] * cur.rc[1] + v[0][1] * cur.rsn[1];
                a0 = a0 * qs; a1 = a1 * qs; b0 = b0 * qs; b1 = b1 * qs;
                bf16_t* dst = (bf16_t*)(ws + (pn < 2 ? cfg::WS_Q : cfg::WS_K)) + (size_t)row * 512 + (4 * (pn & 1) + wc) * 64 + 8 * fq;
                st8(dst, a0, a1); st8(dst + 32, b0, b1);
            } else if constexpr (KIND == 1) {
                bf16_t* dst = (bf16_t*)(ws + cfg::WS_V) + (size_t)row * 512 + (pn - 4) * 256 + cw; st8(dst, v[0][0], v[0][1]); st8(dst + 128, v[1][0], v[1][1]);
            } else if constexpr (KIND == 2) {
                bf16_t* dst = (bf16_t*)(ws + cfg::WS_TAB) + (size_t)row * 512 + (pn - 6) * 256 + cw; st8(dst, v[0][0], v[0][1]); st8(dst + 128, v[1][0], v[1][1]);
            } else if constexpr (KIND == 3) {
                bf16_t* dst = (bf16_t*)(ws + cfg::WSB_GQK + (size_t)(u.pm >> 3) * cfg::DLT_GQK) + (size_t)row * 256 + cw; st8(dst, v[0][0] * cfg::GQSCALE, v[0][1] * cfg::GQSCALE); st8(dst + 128, v[1][0], v[1][1]);
            } else if constexpr (KIND == 4) {
                bf16_t* dst = (bf16_t*)(ws + cfg::WSB_GV + (size_t)(u.pm >> 3) * cfg::DLT_GV) + (size_t)row * 256 + cw; st8(dst, v[0][0], v[0][1]); st8(dst + 128, v[1][0], v[1][1]);
            } else if constexpr (KIND == 5) {
                bf16_t* dst = (bf16_t*)(ws + cfg::WSB_GR + (size_t)(u.pm >> 3) * cfg::DLT_GR) + (size_t)row * 256 + cw;
#pragma unroll
                for (int bj = 0; bj < 2; ++bj) { f32x4 x0 = v[bj][0], x1 = v[bj][1];
#pragma unroll
                    for (int e = 0; e < 4; ++e) { x0[e] = fsilu(x0[e]); x1[e] = fsilu(x1[e]); } st8(dst + 128 * bj, x0, x1); }
            } else {
                float* dst = (float*)(ws + cfg::WSB_GL + (size_t)(u.pm >> 3) * cfg::DLT_GL) + (size_t)row * 256 + cw;
#pragma unroll
                for (int bj = 0; bj < 2; ++bj)
#pragma unroll
                    for (int n = 0; n < 2; ++n) { f32x4 x = v[bj][n] + bias[bj][n];
#pragma unroll
                        for (int e = 0; e < 4; ++e) x[e] = flogsig16(x[e]); *(f32x4*)(dst + 128 * bj + 4 * n) = x; }
            }
            if (i < 7) cur = nxt;
        }
    }
    __device__ __forceinline__ void operator()(const f32x4 (&acc)[2][2][4][2], const Unit& u, int wr, int wc, int fr, int fq) const {
        asm volatile("" : "+v"(fr), "+v"(fq));
        unsigned zo = 0u; asm volatile("" : "+s"(zo)); FEpiIn me = *this; me.ws = ws + zo;
        const int pn = u.pn;
        if (pn < 4) me.rows<0>(acc, u, wr, wc, fr, fq); else if (pn < 6) me.rows<1>(acc, u, wr, wc, fr, fq); else if (pn < 8) me.rows<2>(acc, u, wr, wc, fr, fq);
        else if (pn == 8) me.rows<3>(acc, u, wr, wc, fr, fq); else if (pn == 9) me.rows<4>(acc, u, wr, wc, fr, fq); else if (pn == 10) me.rows<5>(acc, u, wr, wc, fr, fq); else me.rows<6>(acc, u, wr, wc, fr, fq);
    }
};
struct FEpiRes {
    static constexpr bool PERM = true, AFTER_DRAIN = false;
    const PG8_LAS float* stprev;
    const float* g; const float* bb; bf16_t* XB; float* ST;
    struct RowLd { u32x4 xb[2]; };
    __device__ __forceinline__ RowLd load_row(int row, int col0, int fq) const {
        RowLd r; const size_t off = (size_t)row * 1024 + col0;
        r.xb[0] = *(const u32x4*)(XB + off); r.xb[1] = *(const u32x4*)(XB + off + 128);
        return r;
    }
    __device__ __forceinline__ void operator()(const f32x4 (&acc)[2][2][4][2], const Unit& u, int wr, int wc, int fr, int fq) const {
        asm volatile("" : "+v"(fr), "+v"(fq));
        const int col0 = u.pn * BM + 32 * wc + 8 * fq, row0 = u.pm * BM + 64 * wr + fr;
        f32x4 gv[2][2], bv[2][2];
        RowLd cur = load_row(row0, col0, fq), nxt;
        if (stprev) {
#pragma unroll
            for (int bj = 0; bj < 2; ++bj)
#pragma unroll
                for (int n = 0; n < 2; ++n) { gv[bj][n] = *(const f32x4*)(g + col0 + 128 * bj + 4 * n); bv[bj][n] = *(const f32x4*)(bb + col0 + 128 * bj + 4 * n); } }
#pragma unroll
        for (int i = 0; i < 8; ++i) { const int ai = i >> 2, m = i & 3, row = row0 + 128 * ai + 16 * m; const size_t off = (size_t)row * 1024 + col0;
            if (i < 7) nxt = load_row(row0 + 128 * ((i + 1) >> 2) + 16 * ((i + 1) & 3), col0, fq);
            RS rs; rs.a = 1.f; rs.b = 0.f; if (stprev) { typedef float f32x2 __attribute__((ext_vector_type(2))); const f32x2 t2 = *(const PG8_LAS f32x2*)(stprev + 2 * (128 * ai + 64 * wr + 16 * m + fr)); rs.a = t2[0]; rs.b = t2[1]; }
            float s = 0.f, ss = 0.f;
#pragma unroll
            for (int bj = 0; bj < 2; ++bj) { f32x4 y[2];
#pragma unroll
                for (int n = 0; n < 2; ++n) { const unsigned w0 = cur.xb[bj][2 * n], w1 = cur.xb[bj][2 * n + 1];
                    f32x4 x = (f32x4){__uint_as_float(w0 << 16), __uint_as_float(w0 & 0xffff0000u), __uint_as_float(w1 << 16), __uint_as_float(w1 & 0xffff0000u)};
                    if (stprev) x = (rs.a * x + rs.b) * gv[bj][n] + bv[bj][n];
                    y[n] = cfg::ALPHA * x + acc[ai][bj][m][n];
                    s += (y[n][0] + y[n][1]) + (y[n][2] + y[n][3]); ss += (y[n][0] * y[n][0] + y[n][1] * y[n][1]) + (y[n][2] * y[n][2] + y[n][3] * y[n][3]); }
                st8nt(XB + off + 128 * bj, y[0], y[1]); }
            s = xadd<16>(s); ss = xadd<16>(ss); s = xadd<32>(s); ss = xadd<32>(ss);
            if (fq == 0) { typedef float f32x2 __attribute__((ext_vector_type(2))); *(f32x2*)(ST + (size_t)row * 32 + (u.pn * 4 + wc) * 2) = (f32x2){s, ss}; }
            if (i < 7) cur = nxt; }
    }
};
struct FEpiGU {
    static constexpr bool PERM = true, AFTER_DRAIN = false;
    const PG8_LAS float* rsl;
    const float* c1; const float* c2; bf16_t* ACT;
    __device__ __forceinline__ void operator()(const f32x4 (&acc)[2][2][4][2], const Unit& u, int wr, int wc, int fr, int fq) const {
        asm volatile("" : "+v"(fr), "+v"(fq));
        const int cw = 32 * wc + 8 * fq, row0 = u.pm * BM + 64 * wr + fr; const float* c1p = c1 + u.pn * 256 + cw; const float* c2p = c2 + u.pn * 256 + cw;
        typedef float f32x2 __attribute__((ext_vector_type(2)));
        f32x4 k1[2][2], k2[2][2];
#pragma unroll
        for (int bj = 0; bj < 2; ++bj)
#pragma unroll
            for (int n = 0; n < 2; ++n) { k1[bj][n] = *(const f32x4*)(c1p + 128 * bj + 4 * n); k2[bj][n] = *(const f32x4*)(c2p + 128 * bj + 4 * n); }
#pragma unroll
        for (int i = 0; i < 8; ++i) { const int ai = i >> 2, m = i & 3; const f32x2 rs = *(const PG8_LAS f32x2*)(rsl + 2 * (128 * ai + 64 * wr + 16 * m + fr)); f32x4 a[2];
#pragma unroll
            for (int n = 0; n < 2; ++n) { const f32x4 hg = rs[0] * acc[ai][0][m][n] + (rs[1] * k1[0][n] + k2[0][n]), hu = rs[0] * acc[ai][1][m][n] + (rs[1] * k1[1][n] + k2[1][n]);
#pragma unroll
                for (int e = 0; e < 4; ++e) a[n][e] = fsilu(hg[e]) * hu[e]; }
            st8nt(ACT + (size_t)(row0 + 128 * ai + 16 * m) * cfg::FF + 128 * u.pn + cw, a[0], a[1]); }
    }
};
struct FEpiFour {
    static constexpr bool PERM = true, AFTER_DRAIN = false;
    bf16_t* OC;
    __device__ __forceinline__ void operator()(const f32x4 (&acc)[2][2][4][2], const Unit& u, int wr, int wc, int fr, int fq) const {
        asm volatile("" : "+v"(fr), "+v"(fq));
        const int cw = 32 * wc + 8 * fq;
#pragma unroll
        for (int ai = 0; ai < 2; ++ai)
#pragma unroll
            for (int m = 0; m < 4; ++m) { const int row = u.pm * BM + 128 * ai + 64 * wr + 16 * m + fr; bf16_t* dst = OC + (size_t)(u.pn * 2048 + row) * 1024 + 512 + cw;
                st8(dst, acc[ai][0][m][0], acc[ai][0][m][1]); st8(dst + 128, acc[ai][1][m][0], acc[ai][1][m][1]); }
    }
};
}
namespace att {
using bf16x8 = __attribute__((ext_vector_type(8))) short;
using s16x4  = __attribute__((ext_vector_type(4))) short;
using f32x16 = __attribute__((ext_vector_type(16))) float;
using u32x4  = __attribute__((ext_vector_type(4))) unsigned;
constexpr int NW = 8, QBLK = 32, KVBLK = 64, LD = 512, NT = cfg::S / KVBLK;
constexpr int SHM_V = KVBLK * 128 * 2, SHM_K = KVBLK * 128 * 2, SHM_X = 2 * SHM_V + 2 * SHM_K, SHM_ATTN = SHM_X + NW * 64 * 4;
constexpr float THRL = 6.0f;
#define ATT_KSWZ(row, colB) ((row) * 256 + ((colB) ^ (((row) & 7) << 4)))
#define ATT_SBAR() __builtin_amdgcn_sched_barrier(0)
__device__ __forceinline__ int crow(int r, int hi) { return (r & 3) + 8 * (r >> 2) + 4 * hi; }
__device__ __forceinline__ unsigned cvtpk(float lo, float hi) { unsigned r; asm volatile("v_cvt_pk_bf16_f32 %0, %1, %2" : "=v"(r) : "v"(lo), "v"(hi)); return r; }
__device__ __forceinline__ void softmaxP(f32x16& p0, f32x16& p1, float& m_reg, f32x16& negm, float& alpha, bool first, bf16x8& pa0, bf16x8& pa1, bf16x8& pa2, bf16x8& pa3) {
#define ATT_M3(a, b, c) fmaxf(fmaxf(a, b), c)
  const float t0 = ATT_M3(p0[0], p0[1], p0[2]), t1 = ATT_M3(p0[3], p0[4], p0[5]), t2 = ATT_M3(p0[6], p0[7], p0[8]), t3 = ATT_M3(p0[9], p0[10], p0[11]), t4 = ATT_M3(p0[12], p0[13], p0[14]);
  const float t5 = ATT_M3(p0[15], p1[0], p1[1]), t6 = ATT_M3(p1[2], p1[3], p1[4]), t7 = ATT_M3(p1[5], p1[6], p1[7]), t8 = ATT_M3(p1[8], p1[9], p1[10]), t9 = ATT_M3(p1[11], p1[12], p1[13]);
  const float u0 = ATT_M3(t0, t1, t2), u1 = ATT_M3(t3, t4, t5), u2 = ATT_M3(t6, t7, t8), u3 = ATT_M3(t9, p1[14], p1[15]);
  float pmax = fmaxf(fmaxf(u0, u1), fmaxf(u2, u3));
#undef ATT_M3
  { auto rr = __builtin_amdgcn_permlane32_swap(__float_as_uint(pmax), __float_as_uint(pmax), false, false); pmax = fmaxf(__uint_as_float(rr[0]), __uint_as_float(rr[1])); }
  const float thr = first ? -3.0e38f : THRL;
  if (__builtin_expect(__all(pmax <= thr), 1)) { alpha = 1.f; }
  else { const float dl = first ? pmax : fmaxf(pmax, 0.f); alpha = first ? 0.f : __builtin_amdgcn_exp2f(-dl); m_reg += dl;
#pragma unroll
    for (int r = 0; r < 16; ++r) { p0[r] -= dl; p1[r] -= dl; negm[r] -= dl; } }
#pragma unroll
  for (int r = 0; r < 16; ++r) p0[r] = __builtin_amdgcn_exp2f(p0[r]);
#pragma unroll
  for (int r = 0; r < 16; ++r) p1[r] = __builtin_amdgcn_exp2f(p1[r]);
#define ATT_PK4(P, BASE, OUT) do { u32x4 w = {cvtpk(P[BASE + 0], P[BASE + 1]), cvtpk(P[BASE + 2], P[BASE + 3]), cvtpk(P[BASE + 4], P[BASE + 5]), cvtpk(P[BASE + 6], P[BASE + 7])}; \
    OUT = *reinterpret_cast<bf16x8*>(&w); } while (0)
  ATT_PK4(p0, 0, pa0); ATT_PK4(p0, 8, pa1); ATT_PK4(p1, 0, pa2); ATT_PK4(p1, 8, pa3);
#undef ATT_PK4
}
template <int OFF> __device__ __forceinline__ bf16x8 k_read(int ka) { bf16x8 r; asm volatile("ds_read_b128 %0, %1 offset:%2" : "=&v"(r) : "v"(ka), "i"(OFF) : "memory"); return r; }
template <int KB> __device__ __forceinline__ void k_load2(bf16x8* kf, int ka0, int ka1) {
  kf[0] = k_read<KB * SHM_K>(ka0); kf[1] = k_read<KB * SHM_K + 8192>(ka0); kf[2] = k_read<KB * SHM_K>(ka1); kf[3] = k_read<KB * SHM_K + 8192>(ka1);
}
__device__ __forceinline__ void qk_mma2(f32x16& p0, f32x16& p1, const bf16x8* kf, bf16x8 q0, bf16x8 q1) {
  p0 = __builtin_amdgcn_mfma_f32_32x32x16_bf16(kf[0], q0, p0, 0, 0, 0); p1 = __builtin_amdgcn_mfma_f32_32x32x16_bf16(kf[1], q0, p1, 0, 0, 0);
  p0 = __builtin_amdgcn_mfma_f32_32x32x16_bf16(kf[2], q1, p0, 0, 0, 0); p1 = __builtin_amdgcn_mfma_f32_32x32x16_bf16(kf[3], q1, p1, 0, 0, 0);
}
__device__ __forceinline__ int v_st(int k, int c) { return ((k >> 3) * 4 + (c >> 5)) * 512 + ((k & 7) * 32 + (c & 31)) * 2; }
__device__ __forceinline__ int v_rd_base(int lane) { return ((lane & 3) << 3) | (((lane >> 2) & 3) << 6) | (((lane >> 4) & 1) << 5) | (((lane >> 5) & 1) << 8); }
constexpr int v_rd_off(int d0, int ks, int half) { return d0 * 512 + ks * 4096 + half * 2048; }
template <int OFF> __device__ __forceinline__ s16x4 tr_read(int vb) { s16x4 r; asm volatile("ds_read_b64_tr_b16 %0, %1 offset:%2" : "=&v"(r) : "v"(vb), "i"(OFF) : "memory"); return r; }
struct VF { s16x4 l[4], h[4]; };
template <int KS> __device__ __forceinline__ void vf_load(VF& f, int vb) {
  f.l[0] = tr_read<v_rd_off(0, KS, 0)>(vb); f.h[0] = tr_read<v_rd_off(0, KS, 1)>(vb); f.l[1] = tr_read<v_rd_off(1, KS, 0)>(vb); f.h[1] = tr_read<v_rd_off(1, KS, 1)>(vb);
  f.l[2] = tr_read<v_rd_off(2, KS, 0)>(vb); f.h[2] = tr_read<v_rd_off(2, KS, 1)>(vb); f.l[3] = tr_read<v_rd_off(3, KS, 0)>(vb); f.h[3] = tr_read<v_rd_off(3, KS, 1)>(vb);
}
__device__ __forceinline__ void pv_step(f32x16* o, bf16x8 pa, const VF& f) {
#define ATT_PK(L, H) (bf16x8){L[0], L[1], L[2], L[3], H[0], H[1], H[2], H[3]}
  o[0] = __builtin_amdgcn_mfma_f32_32x32x16_bf16(pa, ATT_PK(f.l[0], f.h[0]), o[0], 0, 0, 0);
  o[1] = __builtin_amdgcn_mfma_f32_32x32x16_bf16(pa, ATT_PK(f.l[1], f.h[1]), o[1], 0, 0, 0);
  o[2] = __builtin_amdgcn_mfma_f32_32x32x16_bf16(pa, ATT_PK(f.l[2], f.h[2]), o[2], 0, 0, 0);
  o[3] = __builtin_amdgcn_mfma_f32_32x32x16_bf16(pa, ATT_PK(f.l[3], f.h[3]), o[3], 0, 0, 0);
#undef ATT_PK
}
#define ATT_LWAIT(n) do { asm volatile("s_waitcnt lgkmcnt(" #n ")" ::: "memory"); ATT_SBAR(); } while (0)
template <int MP> __device__ __forceinline__ void att_give(const f32x16* o, float* Xw, int r32, int hi) {
  constexpr int RG = MP ? 0 : 8;
#pragma unroll
  for (int rr = 0; rr < 8; ++rr)
#pragma unroll
    for (int d0 = 0; d0 < 4; ++d0) Xw[(crow(RG + rr, hi) & 15) * 128 + d0 * 32 + r32] = o[d0][RG + rr];
}
template <int MP> __device__ __forceinline__ void att_fin(const f32x16* o, const float* Xr, float lam, const float (&gq)[4], bf16_t* OCw, int r32, int hi, int lane) {
  constexpr int RK = MP ? 8 : 0;
  unsigned pk[8][4];
#pragma unroll
  for (int rr = 0; rr < 8; ++rr) { const int lr = crow(RK + rr, hi) & 15;
    float df[4], ssq = 0.f;
#pragma unroll
    for (int d0 = 0; d0 < 4; ++d0) { const float x = Xr[lr * 128 + d0 * 32 + r32]; df[d0] = MP ? x - lam * o[d0][RK + rr] : o[d0][RK + rr] - lam * x; ssq += df[d0] * df[d0]; }
    ssq = xadd<1>(ssq); ssq = xadd<2>(ssq); ssq = xadd<4>(ssq); ssq = xadd<8>(ssq); ssq = xadd<16>(ssq);
    const float rn = rsqrtf(ssq * (1.f / 128.f) + cfg::EPS);
#pragma unroll
    for (int d0 = 0; d0 < 4; ++d0) pk[rr][d0] = cvtpk(df[d0] * rn * gq[d0], 0.f); }
  char* stg = (char*)Xr;
#pragma unroll
  for (int rr = 0; rr < 8; ++rr) { const int lr = crow(RK + rr, hi) & 15;
#pragma unroll
    for (int d0 = 0; d0 < 4; ++d0) *(unsigned short*)(stg + lr * 272 + (d0 * 32 + r32) * 2) = (unsigned short)pk[rr][d0]; }
#pragma unroll
  for (int i = 0; i < 4; ++i) { const int c = lane + 64 * i, row = c >> 4, cc = c & 15;
    const u32x4 v = *(const u32x4*)(stg + row * 272 + cc * 16); *(u32x4*)(OCw + (size_t)row * 1024 + cc * 8) = v; }
}
__device__ __forceinline__ void attn_unit(int b, int h, int qb, const bf16_t* __restrict__ Qg, const bf16_t* __restrict__ Kg, const bf16_t* __restrict__ Vg, bf16_t* __restrict__ OC,
                                          const float* __restrict__ lamp, const float* __restrict__ dgv, int layer, char* lds) {
  int tid_o = threadIdx.x; asm volatile("" : "+v"(tid_o));
  const int tid = tid_o, wid = __builtin_amdgcn_readfirstlane(tid >> 6), lane = tid & 63, r32 = lane & 31, hi = lane >> 5, mp = wid >> 2, wl = wid & 3, mofs = mp * 64;
  char* V_lds = lds; char* K_lds = lds + 2 * SHM_V;
  float* ws = (float*)(lds + SHM_X) + wid * 64; float* al_l = ws + 32;
  float m_reg = 0.f; f32x16 o[4] = {}, ol = {}, negm = {}; bf16x8 qr[4];
  const int q0 = qb * 128 + wl * QBLK;
  const bf16_t* Qw = Qg + (size_t)(b * cfg::S + q0 + r32) * LD + h * 128 + mofs + hi * 8;
#pragma unroll
  for (int d0 = 0; d0 < 4; ++d0) qr[d0] = *reinterpret_cast<const bf16x8*>(Qw + d0 * 16);
  const bf16_t* Kh = Kg + (size_t)b * cfg::S * LD + h * 128; const bf16_t* Vh = Vg + (size_t)b * cfg::S * LD + h * 128;
  const int vb0 = (int)(uintptr_t)V_lds + v_rd_base(lane);
  const int ka0 = (int)(uintptr_t)K_lds + ATT_KSWZ(r32, (mofs + hi * 8) * 2);
  const bf16x8 ones = {0x3F80, 0x3F80, 0x3F80, 0x3F80, 0x3F80, 0x3F80, 0x3F80, 0x3F80};
  const int gt = tid & 255, gr = gt >> 4, gc = (gt & 15) * 8;
  const bf16_t* gsrc = (mp ? Kh : Vh) + (size_t)gr * LD + gc;
  char* gdst = mp ? K_lds + ATT_KSWZ(gr, gc * 2) : V_lds + v_st(gr, gc);
  const int tofs = mp ? 2 : 0;
  bf16x8 st_[2][4];
#define ATT_GLOAD(i, t) do { const int t_ = (t) < NT ? (t) : NT - 1;     \
    _Pragma("unroll") for (int q_ = 0; q_ < 4; ++q_) st_[i][q_] = *reinterpret_cast<const bf16x8*>(gsrc + (size_t)(t_ * 64 + 16 * q_) * LD); } while (0)
#define ATT_GWRITE(i, t) do { asm volatile("s_waitcnt vmcnt(4)" ::: "memory"); if ((t) < NT) { \
    _Pragma("unroll") for (int q_ = 0; q_ < 4; ++q_) *(bf16x8*)(gdst + (i) * 16384 + q_ * 4096) = st_[i][q_]; } } while (0)
#define ATT_RESC(a) do { if (__any((a) < 1.f)) { if (hi == 0) al_l[r32] = (a); asm volatile("s_waitcnt lgkmcnt(0)" ::: "memory"); \
    _Pragma("unroll") for (int r = 0; r < 16; ++r) { const float a_ = al_l[crow(r, hi)]; ol[r] *= a_; _Pragma("unroll") for (int d = 0; d < 4; ++d) o[d][r] *= a_; } } } while (0)
  f32x16 s0, s1; float al; bf16x8 pa0, pa1, pa2, pa3, kf[8]; VF f0, f1;
#define ATT_VSEG(I, p) do { ATT_GWRITE(I, (p) + tofs); ATT_GLOAD(I, (p) + tofs + 2); ATT_SBAR(); \
    softmaxP(s0, s1, m_reg, negm, al, (p) == 0, pa0, pa1, pa2, pa3); ATT_RESC(al); } while (0)
#define ATT_OL(pa) ol = __builtin_amdgcn_mfma_f32_32x32x16_bf16(pa, ones, ol, 0, 0, 0)
#define ATT_QK(KB) do { k_load2<KB>(kf, ka0, ka0 ^ 32); k_load2<KB>(kf + 4, ka0 ^ 64, ka0 ^ 96); ATT_LWAIT(4); s0 = negm; s1 = negm; qk_mma2(s0, s1, kf, qr[0], qr[1]); ATT_LWAIT(0); qk_mma2(s0, s1, kf + 4, qr[2], qr[3]); ATT_SBAR(); } while (0)
#define ATT_MSEG(VB, KB, QK) do { vf_load<0>(f0, vb0 + (VB) * SHM_V); vf_load<1>(f1, vb0 + (VB) * SHM_V); ATT_SBAR(); \
    ATT_LWAIT(8); pv_step(o, pa0, f0); ATT_OL(pa0); vf_load<2>(f0, vb0 + (VB) * SHM_V); \
    ATT_LWAIT(8); pv_step(o, pa1, f1); ATT_OL(pa1); vf_load<3>(f1, vb0 + (VB) * SHM_V); \
    if constexpr (QK) { k_load2<KB>(kf, ka0, ka0 ^ 32); ATT_LWAIT(12); } else ATT_LWAIT(8); \
    pv_step(o, pa2, f0); ATT_OL(pa2); \
    if constexpr (QK) ATT_LWAIT(4); else ATT_LWAIT(0); \
    pv_step(o, pa3, f1); ATT_OL(pa3); \
    if constexpr (QK) { k_load2<KB>(kf + 4, ka0 ^ 64, ka0 ^ 96); ATT_LWAIT(4); s0 = negm; s1 = negm; qk_mma2(s0, s1, kf, qr[0], qr[1]); ATT_LWAIT(0); qk_mma2(s0, s1, kf + 4, qr[2], qr[3]); } ATT_SBAR(); } while (0)
  { const int kr = tid >> 4, kc = (tid & 15) * 8;
    const bf16x8 k0 = *reinterpret_cast<const bf16x8*>(&Kh[(size_t)kr * LD + kc]), k1 = *reinterpret_cast<const bf16x8*>(&Kh[(size_t)(32 + kr) * LD + kc]);
    const bf16x8 k2 = *reinterpret_cast<const bf16x8*>(&Kh[(size_t)(64 + kr) * LD + kc]), k3 = *reinterpret_cast<const bf16x8*>(&Kh[(size_t)(96 + kr) * LD + kc]);
    ATT_GLOAD(0, tofs); ATT_GLOAD(1, tofs + 1);
    asm volatile("s_waitcnt vmcnt(8)" ::: "memory");
    *(bf16x8*)(K_lds + ATT_KSWZ(kr, kc * 2)) = k0; *(bf16x8*)(K_lds + ATT_KSWZ(32 + kr, kc * 2)) = k1;
    *(bf16x8*)(K_lds + SHM_K + ATT_KSWZ(kr, kc * 2)) = k2; *(bf16x8*)(K_lds + SHM_K + ATT_KSWZ(32 + kr, kc * 2)) = k3; }
  __syncthreads();
  if (mp) __syncthreads();
  ATT_QK(0); __syncthreads();
  for (int p = 0; p + 2 < NT; p += 2) {
    ATT_VSEG(0, p);           __syncthreads();
    ATT_MSEG(0, 1, true);     __syncthreads();
    ATT_VSEG(1, p + 1);       __syncthreads();
    ATT_MSEG(1, 0, true);     __syncthreads();
  }
  ATT_VSEG(0, NT - 2);   __syncthreads();
  ATT_MSEG(0, 1, true);   __syncthreads();
  ATT_VSEG(1, NT - 1);   __syncthreads();
  ATT_MSEG(1, 0, false);  __syncthreads();
  if (!mp) __syncthreads();
#pragma unroll
  for (int r = 0; r < 16; ++r) { const float rl = __builtin_amdgcn_rcpf(ol[r]);
#pragma unroll
    for (int d0 = 0; d0 < 4; ++d0) o[d0][r] *= rl; }
  __syncthreads();
  float* X = (float*)lds;
  const float* Xr = X + wid * 2048; float* Xw = X + (wid ^ 4) * 2048;
  int layer_o = __builtin_amdgcn_readfirstlane(layer); asm volatile("" : "+s"(layer_o)); const float lam_init = layer_o == 0 ? 0.2f : 0.35550906759f;
  if (mp == 0) att_give<0>(o, Xw, r32, hi); else att_give<1>(o, Xw, r32, hi);
  float lam; { float s1 = lamp[lane] * lamp[64 + lane], s2 = lamp[128 + lane] * lamp[192 + lane];
    s1 = xadd<1>(s1); s2 = xadd<1>(s2); s1 = xadd<2>(s1); s2 = xadd<2>(s2); s1 = xadd<4>(s1); s2 = xadd<4>(s2); s1 = xadd<8>(s1); s2 = xadd<8>(s2); s1 = xadd<16>(s1); s2 = xadd<16>(s2); s1 = xadd<32>(s1); s2 = xadd<32>(s2);
    lam = __expf(s1) - __expf(s2) + lam_init; }
  float gq[4];
#pragma unroll
  for (int d0 = 0; d0 < 4; ++d0) gq[d0] = dgv[d0 * 32 + r32] * (1.f - lam_init);
  __syncthreads();
  bf16_t* OCw = OC + (size_t)(b * cfg::S + q0 + 16 * mp) * 1024 + h * 128;
  if (mp == 0) att_fin<0>(o, Xr, lam, gq, OCw, r32, hi, lane); else att_fin<1>(o, Xr, lam, gq, OCw, r32, hi, lane);
  __syncthreads();
#undef ATT_GLOAD
#undef ATT_GWRITE
#undef ATT_VSEG
#undef ATT_MSEG
#undef ATT_RESC
#undef ATT_OL
#undef ATT_QK
}
#undef ATT_KSWZ
#undef ATT_SBAR
}
namespace gla {
using att::bf16x8; using att::s16x4; using att::f32x16; using att::u32x4; using att::crow; using att::cvtpk; using att::tr_read;
typedef float f32x4 __attribute__((ext_vector_type(4)));
typedef unsigned u32x2 __attribute__((ext_vector_type(2)));
#define GLAS __attribute__((address_space(3)))
constexpr int KT_STRIDE = 144;
constexpr int A_KT = 0, A_V = 36864, A_BEND = A_V + 32768;
constexpr int B_QT = 0, B_KT = 32768, B_V = 65536, B_SC = 98304;
__device__ __forceinline__ int v_st64(int k, int c) { const int kk = (k & ~0xC) | ((k & 4) << 1) | ((k & 8) >> 1); return ((kk >> 3) * 2 + (c >> 5)) * 512 + ((kk & 7) * 32 + (c & 31)) * 2; }
constexpr int v_off64(int d0, int ks, int half) { return d0 * 512 + ks * 2048 + half * 1024; }
__device__ __forceinline__ float bf2f_(unsigned short v) { return __uint_as_float((unsigned)v << 16); }
__device__ __forceinline__ void load_v_tile(const bf16_t* __restrict__ src, GLAS unsigned char* dst, int lane) {
    u32x4 tv[8];
#pragma unroll
    for (int i = 0; i < 8; ++i) { const int row = (lane >> 3) + 8 * i, ch = lane & 7; tv[i] = *(const u32x4*)(src + (size_t)row * 256 + ch * 8); }
#pragma unroll
    for (int i = 0; i < 8; ++i) { const int row = (lane >> 3) + 8 * i, ch = lane & 7; *(GLAS u32x4*)(dst + v_st64(row, ch * 8)) = tv[i]; }
}
#define GLA_PK(L, H) (bf16x8){L[0], L[1], L[2], L[3], H[0], H[1], H[2], H[3]}
#define GLA_MM4(o0, o1, vb, AF) do { \
    const s16x4 l00 = tr_read<v_off64(0, 0, 0)>(vb), h00 = tr_read<v_off64(0, 0, 1)>(vb), l01 = tr_read<v_off64(0, 1, 0)>(vb), h01 = tr_read<v_off64(0, 1, 1)>(vb); \
    const s16x4 l02 = tr_read<v_off64(0, 2, 0)>(vb), h02 = tr_read<v_off64(0, 2, 1)>(vb), l03 = tr_read<v_off64(0, 3, 0)>(vb), h03 = tr_read<v_off64(0, 3, 1)>(vb); \
    const s16x4 l10 = tr_read<v_off64(1, 0, 0)>(vb), h10 = tr_read<v_off64(1, 0, 1)>(vb), l11 = tr_read<v_off64(1, 1, 0)>(vb), h11 = tr_read<v_off64(1, 1, 1)>(vb); \
    const s16x4 l12 = tr_read<v_off64(1, 2, 0)>(vb), h12 = tr_read<v_off64(1, 2, 1)>(vb), l13 = tr_read<v_off64(1, 3, 0)>(vb), h13 = tr_read<v_off64(1, 3, 1)>(vb); \
    asm volatile("s_waitcnt lgkmcnt(0)" ::: "memory"); __builtin_amdgcn_sched_barrier(0); \
    o0 = __builtin_amdgcn_mfma_f32_32x32x16_bf16(AF(0), GLA_PK(l00, h00), o0, 0, 0, 0); o1 = __builtin_amdgcn_mfma_f32_32x32x16_bf16(AF(0), GLA_PK(l10, h10), o1, 0, 0, 0); \
    o0 = __builtin_amdgcn_mfma_f32_32x32x16_bf16(AF(1), GLA_PK(l01, h01), o0, 0, 0, 0); o1 = __builtin_amdgcn_mfma_f32_32x32x16_bf16(AF(1), GLA_PK(l11, h11), o1, 0, 0, 0); \
    o0 = __builtin_amdgcn_mfma_f32_32x32x16_bf16(AF(2), GLA_PK(l02, h02), o0, 0, 0, 0); o1 = __builtin_amdgcn_mfma_f32_32x32x16_bf16(AF(2), GLA_PK(l12, h12), o1, 0, 0, 0); \
    o0 = __builtin_amdgcn_mfma_f32_32x32x16_bf16(AF(3), GLA_PK(l03, h03), o0, 0, 0, 0); o1 = __builtin_amdgcn_mfma_f32_32x32x16_bf16(AF(3), GLA_PK(l13, h13), o1, 0, 0, 0); } while (0)
__device__ __forceinline__ bf16x8 afrag_tr(const GLAS unsigned char* row, int ks, int hi) { return *(const GLAS bf16x8*)(row + (16 * ks + 8 * hi) * 2); }

__device__ __forceinline__ void gla_a_item(int b, int h, int g, unsigned char* ws, GLAS unsigned char* lds) {
    int tid_o = threadIdx.x; asm volatile("" : "+v"(tid_o));
    const int tid = tid_o, wave = __builtin_amdgcn_readfirstlane(tid >> 6), lane = tid & 63, r32 = lane & 31, hi = lane >> 5;
    const float* GL = (const float*)(ws + cfg::WSB_GL + (size_t)b * cfg::DLT_GL); const bf16_t* GQK = (const bf16_t*)(ws + cfg::WSB_GQK + (size_t)b * cfg::DLT_GQK); const bf16_t* GV = (const bf16_t*)(ws + cfg::WSB_GV + (size_t)b * cfg::DLT_GV);
    float* KVC = (float*)(ws + cfg::WSB_OF + (size_t)b * cfg::DLT_OF); float* DEC = (float*)(ws + cfg::WS_DEC);
    const size_t tok0 = (size_t)b * 2048 + g * 256;
    GLAS float* bend_s = (GLAS float*)(lds + A_BEND);
    if (wave < 4) {
        const int c = wave, dir = lane >> 5, d = lane & 31;
        const float* gl = GL + (tok0 + c * 64) * 256 + dir * 128 + h * 32 + d; const bf16_t* kp = GQK + (tok0 + c * 64) * 256 + 128 + h * 32 + d;
        GLAS unsigned char* row = lds + A_KT + ((c * 2 + dir) * 32 + d) * KT_STRIDE; float bsum = 0.f; float gA[8], gB[8]; unsigned short kA[8], kB[8];
#define GLA_LOAD(G, K, blk) do { const int t0_ = dir ? 56 - 8 * (blk) : 8 * (blk); _Pragma("unroll") for (int i = 0; i < 8; ++i) { G[i] = gl[(size_t)(t0_ + i) * 256]; K[i] = kp[(size_t)(t0_ + i) * 256]; } } while (0)
#define GLA_PROC(G, K, blk) do { const int t0_ = dir ? 56 - 8 * (blk) : 8 * (blk); float kt[8]; \
            if (dir == 0) { _Pragma("unroll") for (int i = 0; i < 8; ++i) { bsum += G[i]; kt[i] = bf2f_(K[i]) * __expf(-bsum); } } \
            else { _Pragma("unroll") for (int i = 7; i >= 0; --i) { bsum += G[i]; kt[i] = bf2f_(K[i]) * __expf(-bsum); } } \
            u32x4 w; w.x = cvtpk(kt[0], kt[1]); w.y = cvtpk(kt[2], kt[3]); w.z = cvtpk(kt[4], kt[5]); w.w = cvtpk(kt[6], kt[7]); *(GLAS u32x4*)(row + t0_ * 2) = w; } while (0)
        GLA_LOAD(gA, kA, 0);
#pragma unroll
        for (int bp = 0; bp < 4; ++bp) { GLA_LOAD(gB, kB, 2 * bp + 1); GLA_PROC(gA, kA, 2 * bp); if (bp < 3) GLA_LOAD(gA, kA, 2 * bp + 2); GLA_PROC(gB, kB, 2 * bp + 1); }
#undef GLA_LOAD
#undef GLA_PROC
        bend_s[(c * 2 + dir) * 32 + d] = bsum;
        DEC[((size_t)((b * 4 + h) * 32 + g * 4 + c) * 2 + dir) * 32 + d] = __expf(bsum);
    } else { const int c = wave - 4; load_v_tile(GV + (tok0 + c * 64) * 256 + h * 64, lds + A_V + c * 8192, lane); }
    __syncthreads();
    {
        const int c = wave >> 1, dir = wave & 1; f32x16 o0 = {}, o1 = {};
        const int vb = (int)(unsigned)(uintptr_t)(lds + A_V + c * 8192) + att::v_rd_base(lane);
        const GLAS unsigned char* arow = lds + A_KT + ((c * 2 + dir) * 32 + r32) * KT_STRIDE;
#define GLA_AF(ks) afrag_tr(arow, ks, hi)
        GLA_MM4(o0, o1, vb, GLA_AF);
#undef GLA_AF
        float* dst = KVC + ((size_t)((b * 4 + h) * 32 + g * 4 + c) * 2 + dir) * 2048 + r32;
#pragma unroll
        for (int r = 0; r < 16; ++r) { const int d = crow(r, hi); const float sc = __expf(bend_s[(c * 2 + dir) * 32 + d]); dst[d * 64] = o0[r] * sc; dst[d * 64 + 32] = o1[r] * sc; }
    }
    __syncthreads();
}

__device__ __forceinline__ void gla_b_item(int b, int h, int g, unsigned char* ws, const float* __restrict__ gng, bf16_t* __restrict__ OC, GLAS unsigned char* lds) {
    int tid_o = threadIdx.x; asm volatile("" : "+v"(tid_o));
    const int tid = tid_o, wave = __builtin_amdgcn_readfirstlane(tid >> 6), lane = tid & 63, r32 = lane & 31, hi = lane >> 5;
    const float* GL = (const float*)(ws + cfg::WSB_GL + (size_t)b * cfg::DLT_GL); const bf16_t* GQK = (const bf16_t*)(ws + cfg::WSB_GQK + (size_t)b * cfg::DLT_GQK); const bf16_t* GV = (const bf16_t*)(ws + cfg::WSB_GV + (size_t)b * cfg::DLT_GV); const bf16_t* GR = (const bf16_t*)(ws + cfg::WSB_GR + (size_t)b * cfg::DLT_GR);
    const float* KVC = (const float*)(ws + cfg::WSB_OF + (size_t)b * cfg::DLT_OF) + (size_t)((b * 4 + h) * 32) * 2 * 2048; const float* DEC = (const float*)(ws + cfg::WS_DEC) + (size_t)((b * 4 + h) * 32) * 2 * 32;
    const size_t tok0 = (size_t)b * 2048 + g * 256;
    if (wave < 4) {
        const int c = wave, dir = lane >> 5, d = lane & 31;
        const float* gl = GL + (tok0 + c * 64) * 256 + dir * 128 + h * 32 + d; const bf16_t* qp = GQK + (tok0 + c * 64) * 256 + h * 32 + d;
        GLAS unsigned short* qt = (GLAS unsigned short*)(lds + B_QT + c * 8192) + dir * 32 + d;
        GLAS unsigned short* kt = (GLAS unsigned short*)(lds + B_KT + c * 8192 + dir * 4096) + d;
        float bsum = 0.f; float gA[8], gB[8]; unsigned short qA[8], kA[8], qB[8], kB[8];
#define GLB_LOAD(G, Q, K, blk) do { const int t0_ = dir ? 56 - 8 * (blk) : 8 * (blk); _Pragma("unroll") for (int i = 0; i < 8; ++i) { G[i] = gl[(size_t)(t0_ + i) * 256]; Q[i] = qp[(size_t)(t0_ + i) * 256]; K[i] = qp[(size_t)(t0_ + i) * 256 + 128]; } } while (0)
#define GLB_PROC(G, Q, K, blk) do { const int t0_ = dir ? 56 - 8 * (blk) : 8 * (blk); _Pragma("unroll") for (int ii = 0; ii < 8; ++ii) { \
            const float gi = dir ? G[7 - ii] : G[ii], qi = bf2f_(dir ? Q[7 - ii] : Q[ii]), ki = bf2f_(dir ? K[7 - ii] : K[ii]); const int tt = t0_ + (dir ? 7 - ii : ii); \
            bsum += gi; const float e = __expf(bsum), ei = __expf(-bsum); \
            qt[tt * 64] = (unsigned short)(cvtpk(qi * e, 0.f) & 0xffffu); kt[tt * 32] = (unsigned short)(cvtpk(ki * ei, 0.f) & 0xffffu); } } while (0)
        GLB_LOAD(gA, qA, kA, 0);
#pragma unroll
        for (int bp = 0; bp < 4; ++bp) { GLB_LOAD(gB, qB, kB, 2 * bp + 1); GLB_PROC(gA, qA, kA, 2 * bp); if (bp < 3) GLB_LOAD(gA, qA, kA, 2 * bp + 2); GLB_PROC(gB, qB, kB, 2 * bp + 1); }
#undef GLB_LOAD
#undef GLB_PROC
    } else {
        const int c = wave - 4;
        const int t2 = tid - 256, d = t2 >> 3, v8 = (t2 & 7) * 8;
        const float* kvp = KVC + d * 64 + v8; const float* dcp = DEC + d;
        const int F = 4 * g + 3;
        u32x4 tv[8];
#pragma unroll
        for (int i = 0; i < 8; ++i) { const int row = (lane >> 3) + 8 * i, ch = lane & 7; tv[i] = *(const u32x4*)(GV + (tok0 + c * 64) * 256 + h * 64 + (size_t)row * 256 + ch * 8); }
        f32x4 Sf0 = {0.f, 0.f, 0.f, 0.f}, Sf1 = Sf0, Sb0 = Sf0, Sb1 = Sf0;
        f32x4 a0A[8], a1A[8], a0B[8], a1B[8]; float dA[8], dB[8];
#define GLS_IDX(s_) (((s_) < F) ? (s_) * 2 : (31 - ((s_) - F)) * 2 + 1)
#define GLS_ISSUE(A0, A1, DD, s0) do { _Pragma("unroll") for (int j = 0; j < 8; ++j) { const int sc_ = (s0) + j < 34 ? (s0) + j : 33; const int ix_ = GLS_IDX(sc_); \
            A0[j] = *(const f32x4*)(kvp + (size_t)ix_ * 2048); A1[j] = *(const f32x4*)(kvp + (size_t)ix_ * 2048 + 4); DD[j] = dcp[ix_ * 32]; } } while (0)
#define GLS_WRITE(S0, S1, c4_, dofs_) do { u32x4 w; w.x = cvtpk(S0[0], S0[1]); w.y = cvtpk(S0[2], S0[3]); w.z = cvtpk(S1[0], S1[1]); w.w = cvtpk(S1[2], S1[3]); \
            *(GLAS u32x4*)(lds + B_SC + (c4_) * 8192 + v_st64((dofs_) + d, v8)) = w; } while (0)
#define GLS_PROC(A0, A1, DD, s0) do { _Pragma("unroll") for (int j = 0; j < 8; ++j) { const int s_ = (s0) + j; if (s_ < 34) { \
            if (s_ < F) { const int n_ = s_; if (n_ >= 4 * g) GLS_WRITE(Sf0, Sf1, n_ - 4 * g, 0); Sf0 = DD[j] * Sf0 + A0[j]; Sf1 = DD[j] * Sf1 + A1[j]; } \
            else { const int n_ = 31 - (s_ - F); if (n_ <= 4 * g + 3) GLS_WRITE(Sb0, Sb1, n_ - 4 * g, 32); Sb0 = DD[j] * Sb0 + A0[j]; Sb1 = DD[j] * Sb1 + A1[j]; } } } } while (0)
        GLS_ISSUE(a0A, a1A, dA, 0); GLS_ISSUE(a0B, a1B, dB, 8);
#pragma unroll
        for (int i = 0; i < 8; ++i) { const int row = (lane >> 3) + 8 * i, ch = lane & 7; *(GLAS u32x4*)(lds + B_V + c * 8192 + v_st64(row, ch * 8)) = tv[i]; }
        GLS_PROC(a0A, a1A, dA, 0);  GLS_ISSUE(a0A, a1A, dA, 16);
        GLS_PROC(a0B, a1B, dB, 8);  GLS_ISSUE(a0B, a1B, dB, 24);
        GLS_PROC(a0A, a1A, dA, 16); GLS_ISSUE(a0A, a1A, dA, 32);
        GLS_PROC(a0B, a1B, dB, 24);
        GLS_PROC(a0A, a1A, dA, 32);
        GLS_WRITE(Sf0, Sf1, 3, 0); GLS_WRITE(Sb0, Sb1, 0, 32);
#undef GLS_IDX
#undef GLS_ISSUE
#undef GLS_WRITE
#undef GLS_PROC
    }
    __syncthreads();
    {
        const int c = wave >> 1, th = wave & 1, t = 32 * th + r32;
        const GLAS unsigned char* qrow = lds + B_QT + c * 8192 + t * 128;
        f32x16 pf0 = {}, pf1 = {}, pb0 = {}, pb1 = {};
#pragma unroll
        for (int ks = 0; ks < 2; ++ks) {
            const bf16x8 qf = *(const GLAS bf16x8*)(qrow + (16 * ks + 8 * hi) * 2), qb = *(const GLAS bf16x8*)(qrow + (32 + 16 * ks + 8 * hi) * 2);
            const GLAS unsigned char* kf = lds + B_KT + c * 8192 + r32 * 64 + (16 * ks + 8 * hi) * 2; const GLAS unsigned char* kb = kf + 4096;
            pf0 = __builtin_amdgcn_mfma_f32_32x32x16_bf16(*(const GLAS bf16x8*)kf, qf, pf0, 0, 0, 0); pf1 = __builtin_amdgcn_mfma_f32_32x32x16_bf16(*(const GLAS bf16x8*)(kf + 2048), qf, pf1, 0, 0, 0);
            pb0 = __builtin_amdgcn_mfma_f32_32x32x16_bf16(*(const GLAS bf16x8*)kb, qb, pb0, 0, 0, 0); pb1 = __builtin_amdgcn_mfma_f32_32x32x16_bf16(*(const GLAS bf16x8*)(kb + 2048), qb, pb1, 0, 0, 0);
        }
#pragma unroll
        for (int r = 0; r < 16; ++r) { const int j0 = crow(r, hi), j1 = 32 + j0;
            pf0[r] = (j0 <= t ? pf0[r] : 0.f) + (j0 >= t ? pb0[r] : 0.f); pf1[r] = (j1 <= t ? pf1[r] : 0.f) + (j1 >= t ? pb1[r] : 0.f); }
        bf16x8 pa0, pa1, pa2, pa3;
#define GLA_PK4(P, BASE, OUT) do { unsigned a0 = cvtpk(P[BASE + 0], P[BASE + 1]), a1 = cvtpk(P[BASE + 2], P[BASE + 3]); unsigned b0 = cvtpk(P[BASE + 4], P[BASE + 5]), b1 = cvtpk(P[BASE + 6], P[BASE + 7]); \
    auto r0 = __builtin_amdgcn_permlane32_swap(a0, b0, false, false); auto r1 = __builtin_amdgcn_permlane32_swap(a1, b1, false, false); \
    u32x4 w = {r0[0], r1[0], r0[1], r1[1]}; OUT = *reinterpret_cast<bf16x8*>(&w); } while (0)
        GLA_PK4(pf0, 0, pa0); GLA_PK4(pf0, 8, pa1); GLA_PK4(pf1, 0, pa2); GLA_PK4(pf1, 8, pa3);
#undef GLA_PK4
        f32x16 o0 = {}, o1 = {};
        { const int vb = (int)(unsigned)(uintptr_t)(lds + B_V + c * 8192) + att::v_rd_base(lane);
#define GLA_AF(ks) ((ks) == 0 ? pa0 : (ks) == 1 ? pa1 : (ks) == 2 ? pa2 : pa3)
          GLA_MM4(o0, o1, vb, GLA_AF);
#undef GLA_AF
        }
        { const int vb = (int)(unsigned)(uintptr_t)(lds + B_SC + c * 8192) + att::v_rd_base(lane);
#define GLA_AF(ks) afrag_tr(qrow, ks, hi)
          GLA_MM4(o0, o1, vb, GLA_AF);
#undef GLA_AF
        }
        const float g0 = gng[r32], g1 = gng[32 + r32];
        const bf16_t* grb = GR + (tok0 + c * 64 + 32 * th) * 256 + h * 64 + r32; unsigned short gq0[16], gq1[16];
#pragma unroll
        for (int r = 0; r < 16; ++r) { gq0[r] = grb[(size_t)crow(r, hi) * 256]; gq1[r] = grb[(size_t)crow(r, hi) * 256 + 32]; }
#pragma unroll
        for (int r = 0; r < 16; ++r) {
            float ssq = o0[r] * o0[r] + o1[r] * o1[r];
            ssq = xadd<1>(ssq); ssq = xadd<2>(ssq); ssq = xadd<4>(ssq); ssq = xadd<8>(ssq); ssq = xadd<16>(ssq);
            const float rn = rsqrtf(ssq * (1.f / 64.f) + cfg::EPS);
            const size_t tok = tok0 + c * 64 + 32 * th + crow(r, hi);
            bf16_t* dst = OC + tok * 1024 + 768 + h * 64 + r32;
            dst[0] = (bf16_t)(cvtpk(o0[r] * rn * g0 * bf2f_(gq0[r]), 0.f) & 0xffffu); dst[32] = (bf16_t)(cvtpk(o1[r] * rn * g1 * bf2f_(gq1[r]), 0.f) & 0xffffu);
        }
    }
    __syncthreads();
}
#undef GLA_MM4
#undef GLA_PK
#undef GLAS
}
namespace fft {
using att::bf16x8; using att::s16x4; using att::f32x16; using att::u32x4; using att::crow; using att::cvtpk; using att::tr_read;
#define FLAS __attribute__((address_space(3)))
__device__ __forceinline__ int img_off(int k, int c) { const int kk = (k & ~0xC) | ((k & 4) << 1) | ((k & 8) >> 1); return ((kk >> 3) * 8 + (c >> 5)) * 512 + ((kk & 7) * 32 + (c & 31)) * 2; }
constexpr int rd_off(int ks, int half) { return ks * 8192 + half * 4096; }
#define FFT_PK(L, H) (bf16x8){L[0], L[1], L[2], L[3], H[0], H[1], H[2], H[3]}
typedef float f32x2_t __attribute__((ext_vector_type(2))); typedef __bf16 bf16x2_t __attribute__((ext_vector_type(2)));
__device__ __forceinline__ unsigned pk2f(float a, float b) { f32x2_t v = {a, b}; bf16x2_t r = __builtin_convertvector(v, bf16x2_t); return __builtin_bit_cast(unsigned, r); }

__device__ __forceinline__ void stage1_load(u32x4 (&tv)[4], int b, int s2, const bf16_t* __restrict__ FX) {
    int tid = threadIdx.x; asm volatile("" : "+v"(tid));
#pragma unroll
    for (int i = 0; i < 4; ++i) { const int p = tid + 512 * i, k = p >> 5, c8 = (p & 31) * 8; tv[i] = *(const u32x4*)(FX + (size_t)(b * 2048 + 64 * (k & 31) + s2) * 512 + (k >> 5) * 256 + c8); }
}
__device__ __forceinline__ void stage1_item(int b, int s2, const u32x4 (&tv)[4], bf16_t* __restrict__ I1, FLAS unsigned char* lds) {
    int tid_o = threadIdx.x; asm volatile("" : "+v"(tid_o));
    const int tid = tid_o, wave = __builtin_amdgcn_readfirstlane(tid >> 6), lane = tid & 63, r32 = lane & 31, hi = lane >> 5;
    bf16x8 F1[2][4];
#pragma unroll
    for (int ks = 0; ks < 4; ++ks) { float cr[8], ci[8];
#pragma unroll
        for (int j = 0; j < 8; ++j) { const int k = 16 * ks + 8 * hi + j, s1 = k & 31; const float rev = (float)((r32 * s1) & 31) * (1.f / 32.f); const float c = __builtin_amdgcn_cosf(rev), sn = __builtin_amdgcn_sinf(rev);
            const bool p1 = (k >> 5) != 0; cr[j] = p1 ? -sn : c; ci[j] = p1 ? -c : -sn; }
        u32x4 wr = {pk2f(cr[0], cr[1]), pk2f(cr[2], cr[3]), pk2f(cr[4], cr[5]), pk2f(cr[6], cr[7])}, wi = {pk2f(ci[0], ci[1]), pk2f(ci[2], ci[3]), pk2f(ci[4], ci[5]), pk2f(ci[6], ci[7])};
        F1[0][ks] = *reinterpret_cast<bf16x8*>(&wr); F1[1][ks] = *reinterpret_cast<bf16x8*>(&wi); }
    {
#pragma unroll
      for (int i = 0; i < 4; ++i) { const int p = tid + 512 * i, k = p >> 5, c8 = (p & 31) * 8; *(FLAS u32x4*)(lds + img_off(k, c8)) = tv[i]; } }
    __syncthreads();
    f32x16 re = {}, im = {};
    { const int vb = (int)(unsigned)(uintptr_t)lds + att::v_rd_base(lane) + wave * 512;
      const s16x4 l0 = tr_read<rd_off(0, 0)>(vb), h0 = tr_read<rd_off(0, 1)>(vb), l1 = tr_read<rd_off(1, 0)>(vb), h1 = tr_read<rd_off(1, 1)>(vb);
      const s16x4 l2 = tr_read<rd_off(2, 0)>(vb), h2 = tr_read<rd_off(2, 1)>(vb), l3 = tr_read<rd_off(3, 0)>(vb), h3 = tr_read<rd_off(3, 1)>(vb);
      asm volatile("s_waitcnt lgkmcnt(0)" ::: "memory"); __builtin_amdgcn_sched_barrier(0);
      re = __builtin_amdgcn_mfma_f32_32x32x16_bf16(F1[0][0], FFT_PK(l0, h0), re, 0, 0, 0); im = __builtin_amdgcn_mfma_f32_32x32x16_bf16(F1[1][0], FFT_PK(l0, h0), im, 0, 0, 0);
      re = __builtin_amdgcn_mfma_f32_32x32x16_bf16(F1[0][1], FFT_PK(l1, h1), re, 0, 0, 0); im = __builtin_amdgcn_mfma_f32_32x32x16_bf16(F1[1][1], FFT_PK(l1, h1), im, 0, 0, 0);
      re = __builtin_amdgcn_mfma_f32_32x32x16_bf16(F1[0][2], FFT_PK(l2, h2), re, 0, 0, 0); im = __builtin_amdgcn_mfma_f32_32x32x16_bf16(F1[1][2], FFT_PK(l2, h2), im, 0, 0, 0);
      re = __builtin_amdgcn_mfma_f32_32x32x16_bf16(F1[0][3], FFT_PK(l3, h3), re, 0, 0, 0); im = __builtin_amdgcn_mfma_f32_32x32x16_bf16(F1[1][3], FFT_PK(l3, h3), im, 0, 0, 0); }
    bf16_t* dst = I1 + (size_t)(b * 32) * 128 * 256 + (size_t)s2 * 256 + 32 * wave + r32;
#pragma unroll
    for (int r = 0; r < 16; ++r) { const int k1 = crow(r, hi); const float rev = (float)((k1 * s2) & 2047) * (1.f / 2048.f); const float ct = __builtin_amdgcn_cosf(rev), st = __builtin_amdgcn_sinf(rev);
        const float ar = re[r] * ct + im[r] * st, ai = im[r] * ct - re[r] * st; const unsigned w = pk2f(ar, ai);
        dst[(size_t)k1 * 128 * 256] = (bf16_t)(w & 0xffffu); dst[(size_t)k1 * 128 * 256 + 64 * 256] = (bf16_t)(w >> 16); }
    __syncthreads();
}

__device__ __forceinline__ void stage2_item(int b, int k1, const bf16_t* __restrict__ I1, bf16_t* __restrict__ OC, FLAS unsigned char* lds) {
    int tid_o = threadIdx.x; asm volatile("" : "+v"(tid_o));
    const int tid = tid_o, wave = __builtin_amdgcn_readfirstlane(tid >> 6), lane = tid & 63, r32 = lane & 31, hi = lane >> 5;
    const bf16_t* src = I1 + (size_t)(b * 32 + k1) * 128 * 256;
    { u32x4 tv[8];
#pragma unroll
      for (int i = 0; i < 8; ++i) { const int p = tid + 512 * i, k = p >> 5, c8 = (p & 31) * 8; tv[i] = *(const u32x4*)(src + (size_t)k * 256 + c8); }
#pragma unroll
      for (int i = 0; i < 8; ++i) { const int p = tid + 512 * i, k = p >> 5, c8 = (p & 31) * 8; *(FLAS u32x4*)(lds + img_off(k, c8)) = tv[i]; } }
    f32x16 y0 = {}, y1 = {};
    __syncthreads();
    const int vb = (int)(unsigned)(uintptr_t)lds + att::v_rd_base(lane) + wave * 512, vb2 = vb + 32768;
    bf16x8 F2[2][8];
#pragma unroll
    for (int ks = 0; ks < 8; ++ks) { float c0[8], c1[8];
#pragma unroll
        for (int j = 0; j < 8; ++j) { const int k = 16 * ks + 8 * hi + j, s2 = k & 63; const float r0 = (float)((r32 * s2) & 63) * (1.f / 64.f), r1 = (float)(((32 + r32) * s2) & 63) * (1.f / 64.f);
            c0[j] = (k >> 6) ? __builtin_amdgcn_sinf(r0) : __builtin_amdgcn_cosf(r0); c1[j] = (k >> 6) ? __builtin_amdgcn_sinf(r1) : __builtin_amdgcn_cosf(r1); }
        u32x4 w0 = {pk2f(c0[0], c0[1]), pk2f(c0[2], c0[3]), pk2f(c0[4], c0[5]), pk2f(c0[6], c0[7])}, w1 = {pk2f(c1[0], c1[1]), pk2f(c1[2], c1[3]), pk2f(c1[4], c1[5]), pk2f(c1[6], c1[7])};
        F2[0][ks] = *reinterpret_cast<bf16x8*>(&w0); F2[1][ks] = *reinterpret_cast<bf16x8*>(&w1); }
#define FFT_STEP(ks) do { \
      const s16x4 lo_ = tr_read<rd_off((ks) & 3, 0)>((ks) < 4 ? vb : vb2), hi_ = tr_read<rd_off((ks) & 3, 1)>((ks) < 4 ? vb : vb2); asm volatile("s_waitcnt lgkmcnt(0)" ::: "memory"); __builtin_amdgcn_sched_barrier(0); \
      y0 = __builtin_amdgcn_mfma_f32_32x32x16_bf16(F2[0][ks], FFT_PK(lo_, hi_), y0, 0, 0, 0); y1 = __builtin_amdgcn_mfma_f32_32x32x16_bf16(F2[1][ks], FFT_PK(lo_, hi_), y1, 0, 0, 0); } while (0)
    FFT_STEP(0); FFT_STEP(1); FFT_STEP(2); FFT_STEP(3); FFT_STEP(4); FFT_STEP(5); FFT_STEP(6); FFT_STEP(7);
#undef FFT_STEP
    bf16_t* dst = OC + (size_t)(b * 2048 + k1) * 1024 + 512 + 32 * wave + r32;
#pragma unroll
    for (int r = 0; r < 16; ++r) { const int k2 = crow(r, hi); const unsigned w = pk2f(y0[r], y1[r]);
        dst[(size_t)(32 * k2) * 1024] = (bf16_t)(w & 0xffffu); dst[(size_t)(32 * (32 + k2)) * 1024] = (bf16_t)(w >> 16); }
    __syncthreads();
}
#undef FFT_PK
#undef FLAS
}
namespace pro {
#define PLAS __attribute__((address_space(3)))
typedef float f32x4 __attribute__((ext_vector_type(4)));
typedef unsigned u32x4 __attribute__((ext_vector_type(4)));
__device__ __forceinline__ unsigned pk2(float lo, float hi) { unsigned r; asm volatile("v_cvt_pk_bf16_f32 %0, %1, %2" : "=v"(r) : "v"(lo), "v"(hi)); return r; }
__device__ __forceinline__ float lo_f(unsigned w) { return __uint_as_float(w << 16); }
__device__ __forceinline__ float hi_f(unsigned w) { return __uint_as_float(w & 0xffff0000u); }
template <bool SUMS, int STRIDE> __device__ __forceinline__ void tile_emit(int K, bf16_t* WT, const float* gain, const float* lnb, float (&a1)[4], float (&a2)[4], const PLAS float* scr, int lane) {
    const int c = lane & 7; float gk[8], bk[8];
#pragma unroll
    for (int q = 0; q < 8; ++q) { gk[q] = gain ? gain[8 * c + q] : 1.f; bk[q] = lnb ? lnb[8 * c + q] : 0.f; }
#pragma unroll
    for (int j = 0; j < 4; ++j) { const int n = (lane >> 3) + 8 * j; const PLAS float* s = scr + (8 * c) * STRIDE + n; float v[8];
#pragma unroll
        for (int q = 0; q < 8; ++q) v[q] = s[q * STRIDE];
        u32x4 o; o.x = pk2(v[0] * gk[0], v[1] * gk[1]); o.y = pk2(v[2] * gk[2], v[3] * gk[3]); o.z = pk2(v[4] * gk[4], v[5] * gk[5]); o.w = pk2(v[6] * gk[6], v[7] * gk[7]);
        *(u32x4*)(WT + (size_t)n * K + 8 * c) = o;
        if (SUMS) { float p1 = (lo_f(o.x) + hi_f(o.x)) + (lo_f(o.y) + hi_f(o.y)) + (lo_f(o.z) + hi_f(o.z)) + (lo_f(o.w) + hi_f(o.w)); float p2 = 0.f;
#pragma unroll
            for (int q = 0; q < 8; ++q) p2 += bk[q] * v[q];
            p1 = xadd<1>(p1); p2 = xadd<1>(p2); p1 = xadd<2>(p1); p2 = xadd<2>(p2); p1 = xadd<4>(p1); p2 = xadd<4>(p2);
            a1[j] += p1; a2[j] += p2; }
    }
    asm volatile("s_waitcnt lgkmcnt(0)" ::: "memory");
}
__device__ __forceinline__ void tile_dma(const float* W, int N, PLAS float* scr, int lane) {
    const float* src = W + (size_t)(lane >> 3) * N + (lane & 7) * 4;
#pragma unroll
    for (int i = 0; i < 8; ++i) __builtin_amdgcn_global_load_lds((const unsigned*)(src + (size_t)(8 * i) * N), (PLAS unsigned*)(scr + i * 256), 16, 0, 0);
}
template <bool SUMS, class Val> __device__ __forceinline__ void tile_item(const Val& val, int K, bf16_t* WT, const float* gain, const float* lnb, float (&a1)[4], float (&a2)[4], PLAS float* scr, int lane) {
#pragma unroll 2
    for (int i = 0; i < 32; ++i) { const int kk = 2 * i + (lane >> 5); scr[kk * 33 + (lane & 31)] = val(kk, lane & 31); }
    asm volatile("s_waitcnt lgkmcnt(0)" ::: "memory");
    tile_emit<SUMS, 33>(K, WT, gain, lnb, a1, a2, scr, lane);
}
struct ValPlain { static constexpr int BATCH = 32; const float* W; int N; __device__ __forceinline__ float operator()(int kk, int j) const { return W[(size_t)kk * N + j]; } };
struct ValGate { static constexpr int BATCH = 2; const float* W; const float* w2; __device__ __forceinline__ float operator()(int kk, int j) const {
    const float* wr = W + (size_t)kk * cfg::INW; float a = 0.f;
#pragma unroll
    for (int r = 0; r < 16; ++r) a += wr[r] * w2[r * 128 + j]; return a; } };

__device__ __forceinline__ void fold_item(int item, unsigned char* ws, const float* w_in, const float* fw, const float* lng, const float* lnb, PLAS unsigned char* lds, int tid) {
    const int l = item >> 5, g = (item >> 3) & 3, part = (item >> 2) & 1, kq = item & 3;
    PLAS float* M = (PLAS float*)lds;
    { const int c = tid >> 3, e0 = (tid & 7) * 8; float acc[8];
#pragma unroll
      for (int q = 0; q < 8; ++q) acc[q] = 0.f;
      const float* w = fw + (size_t)((l * 4 + g) * 64) * 64 + e0;
      for (int k2 = 0; k2 < 64; ++k2) { float rev = (float)((k2 * c) & 63) * (1.f / 64.f); asm volatile("" : "+v"(rev)); const float tr = part ? __builtin_amdgcn_sinf(rev) : __builtin_amdgcn_cosf(rev);
          const f32x4 w0 = *(const f32x4*)(w + k2 * 64), w1 = *(const f32x4*)(w + k2 * 64 + 4);
#pragma unroll
          for (int q = 0; q < 4; ++q) { acc[q] += tr * w0[q]; acc[4 + q] += tr * w1[q]; } }
      const float sc = 0.00276213586400995f;
#pragma unroll
      for (int q = 0; q < 8; ++q) M[c * 64 + e0 + q] = acc[q] * sc; }
    __syncthreads();
    PLAS float* Wl = (PLAS float*)(lds + 16384);
    { const float* wsrc = w_in + ((size_t)l * 1024 + kq * 256) * cfg::INW + 1536 + 64 * g; f32x4 tv[8];
#pragma unroll
      for (int i = 0; i < 8; ++i) tv[i] = *(const f32x4*)(wsrc + (size_t)((tid >> 4) + 32 * i) * cfg::INW + (tid & 15) * 4);
#pragma unroll
      for (int i = 0; i < 8; ++i) *(PLAS f32x4*)(Wl + ((tid >> 4) + 32 * i) * 64 + (tid & 15) * 4) = tv[i]; }
    __syncthreads();
    { const int e = tid & 63, kg = tid >> 6, k0 = kq * 256 + kg * 32, np = 1536 + part * 256 + g * 64 + e; float mc[64];
#pragma unroll
      for (int c = 0; c < 64; ++c) mc[c] = M[c * 64 + e];
      bf16_t* dst = (bf16_t*)(ws + cfg::WS_WIN + l * cfg::SZ_WIN) + (size_t)np * 1024 + k0; float s1 = 0.f, s2 = 0.f;
      for (int kb = 0; kb < 4; ++kb) { float o[8];
#pragma unroll
          for (int q = 0; q < 8; ++q) { const int k = k0 + kb * 8 + q; const PLAS f32x4* wr = (const PLAS f32x4*)(Wl + (kg * 32 + kb * 8 + q) * 64); float a = 0.f;
#pragma unroll
              for (int c4 = 0; c4 < 16; ++c4) { const f32x4 w4 = wr[c4]; a += w4[0] * mc[4 * c4] + w4[1] * mc[4 * c4 + 1] + w4[2] * mc[4 * c4 + 2] + w4[3] * mc[4 * c4 + 3]; }
              o[q] = a * (lng ? lng[k] : 1.f); s2 += lnb ? lnb[k] * a : 0.f; }
          u32x4 w; w.x = pk2(o[0], o[1]); w.y = pk2(o[2], o[3]); w.z = pk2(o[4], o[5]); w.w = pk2(o[6], o[7]); *(u32x4*)(dst + kb * 8) = w;
          s1 += (lo_f(w.x) + hi_f(w.x)) + (lo_f(w.y) + hi_f(w.y)) + (lo_f(w.z) + hi_f(w.z)) + (lo_f(w.w) + hi_f(w.w)); }
      __syncthreads();
      PLAS float* red = (PLAS float*)lds; red[(kg * 64 + e) * 2] = s1; red[(kg * 64 + e) * 2 + 1] = s2;
      __syncthreads();
      if (kg == 0) { float t1 = 0.f, t2 = 0.f;
#pragma unroll
          for (int w = 0; w < 8; ++w) { t1 += red[(w * 64 + e) * 2]; t2 += red[(w * 64 + e) * 2 + 1]; }
          float* fp = (float*)(ws + cfg::V_MF) + (size_t)((l * 4 + kq) * 2) * 512 + part * 256 + g * 64 + e; fp[0] = t1; fp[512] = t2; } }
    __syncthreads();
}

struct Inputs { const float *x, *w_in, *fw, *gw2, *w_out, *ln1g, *ln1b, *wg, *wu, *wd, *ln2g, *ln2b; };
__device__ __forceinline__ void prologue(unsigned char* ws, const Inputs& in, PLAS unsigned char* lds, int vcu, int G) {
    int tid_o = threadIdx.x; asm volatile("" : "+v"(tid_o));
    const int tid = tid_o, wave = __builtin_amdgcn_readfirstlane(tid >> 6), lane = tid & 63;
    const float* x = in.x; const float* w_in = in.w_in; const float* fw = in.fw; const float* gw2 = in.gw2; const float* w_out = in.w_out; const float* ln1g = in.ln1g; const float* ln1b = in.ln1b;
    const float* wg = in.wg; const float* wu = in.wu; const float* wd = in.wd; const float* ln2g = in.ln2g; const float* ln2b = in.ln2b;
    if (vcu < 64) { const int l = vcu >> 5; fold_item(vcu, ws, w_in, fw, l ? ln2g : (const float*)nullptr, l ? ln2b : (const float*)nullptr, lds, tid); }
    PLAS float* scr = (PLAS float*)(lds + wave * 16384); PLAS float* scr1 = scr + 2048; PLAS float* redw = (PLAS float*)(lds + 131072 + 1024 + wave * 256);
    const int gw = vcu * 8 + wave, NGW = G * 8;
    for (int it = vcu; it < 512; it += G) {
        const int l = it >> 8, r = it & 255; float a1[4] = {0.f, 0.f, 0.f, 0.f}, a2[4] = {0.f, 0.f, 0.f, 0.f}; float* c1o; float* c2o;
        const int k0 = wave * 64, k1 = k0 + 512;
        if (r < 80) { const int nb = r; const float* lngb = l ? ln2g : (const float*)nullptr; const float* lnbb = l ? ln2b : (const float*)nullptr;
            bf16_t* Wt = (bf16_t*)(ws + cfg::WS_WIN + l * cfg::SZ_WIN);
            if (nb < 72) { int np0, src;
                if (nb < 32) { const int pn = nb >> 3, p = (nb & 7) * 32, wc = (p >> 5) & 3, bj = p >> 7; np0 = pn * 256 + p; src = (pn >> 1) * 512 + (pn & 1) * 256 + 64 * wc + 32 * bj; }
                else if (nb < 48) { np0 = 1024 + (nb - 32) * 32; src = np0; }
                else { np0 = 2048 + (nb - 48) * 32; src = 1792 + (nb - 48) * 32; }
                tile_dma(w_in + ((size_t)l * 1024 + k0) * cfg::INW + src, cfg::INW, scr, lane); tile_dma(w_in + ((size_t)l * 1024 + k1) * cfg::INW + src, cfg::INW, scr1, lane);
                asm volatile("s_waitcnt vmcnt(0)" ::: "memory");
                tile_emit<true, 32>(1024, Wt + (size_t)np0 * 1024 + k0, lngb ? lngb + k0 : lngb, lnbb ? lnbb + k0 : lnbb, a1, a2, scr, lane);
                tile_emit<true, 32>(1024, Wt + (size_t)np0 * 1024 + k1, lngb ? lngb + k1 : lngb, lnbb ? lnbb + k1 : lnbb, a1, a2, scr1, lane);
                c1o = (float*)(ws + cfg::V_C1IN) + l * cfg::NIN + np0; c2o = (float*)(ws + cfg::V_C2IN) + l * cfg::NIN + np0;
            } else { const int p0 = (nb - 72) * 32, dir = p0 >> 7, kk0 = p0 & 127, np0 = 2816 + p0;
                for (int kb = wave; kb < 16; kb += 8) { const int kq = kb * 64; ValGate v{w_in + ((size_t)l * 1024 + kq) * cfg::INW + 2560 + 16 * dir, gw2 + (size_t)((l * 2 + dir) * 16) * 128 + kk0};
                    tile_item<true>(v, 1024, Wt + (size_t)np0 * 1024 + kq, lngb ? lngb + kq : lngb, lnbb ? lnbb + kq : lnbb, a1, a2, scr, lane); }
                c1o = (float*)(ws + cfg::V_C1IN) + l * cfg::NIN + np0; c2o = (float*)(ws + cfg::V_C2IN) + l * cfg::NIN + np0; }
        } else { const int nb = r - 80, np0 = nb * 32, pn = np0 >> 8, p = np0 & 255, bj = p >> 7, f0 = 128 * pn + (p & 127);
            const float* W = (bj ? wu : wg) + (size_t)l * 1024 * cfg::FF + f0; bf16_t* Wt = (bf16_t*)(ws + cfg::WS_WGU + l * cfg::SZ_WGU) + (size_t)np0 * 1024;
            tile_dma(W + (size_t)k0 * cfg::FF, cfg::FF, scr, lane); tile_dma(W + (size_t)k1 * cfg::FF, cfg::FF, scr1, lane);
            asm volatile("s_waitcnt vmcnt(0)" ::: "memory");
            tile_emit<true, 32>(1024, Wt + k0, ln1g + l * 1024 + k0, ln1b + l * 1024 + k0, a1, a2, scr, lane);
            tile_emit<true, 32>(1024, Wt + k1, ln1g + l * 1024 + k1, ln1b + l * 1024 + k1, a1, a2, scr1, lane);
            c1o = (float*)(ws + cfg::V_C1GU) + l * cfg::NGU + np0; c2o = (float*)(ws + cfg::V_C2GU) + l * cfg::NGU + np0; }
        if ((lane & 7) == 0) {
#pragma unroll
            for (int j = 0; j < 4; ++j) { const int n = (lane >> 3) + 8 * j; redw[n * 2] = a1[j]; redw[n * 2 + 1] = a2[j]; } }
        __syncthreads();
        if (wave == 0 && lane < 32) { float t1 = 0.f, t2 = 0.f;
#pragma unroll
            for (int w = 0; w < 8; ++w) { const PLAS float* rw = (const PLAS float*)(lds + 131072 + 1024 + w * 256); t1 += rw[lane * 2]; t2 += rw[lane * 2 + 1]; }
            c1o[lane] = t1; c2o[lane] = t2; }
        __syncthreads();
    }
    constexpr int I_OUT = 32 * 16, I_DN = 32 * 44, I_L = I_OUT + I_DN;
    for (int it = gw; it < 2 * I_L; it += 2 * NGW) {
        const float* Ws[2]; int Ns[2], Ks[2]; bf16_t* Wd[2]; float d1[4], d2[4];
#pragma unroll
        for (int q = 0; q < 2; ++q) { const int itq = it + q * NGW; const int ic = itq < 2 * I_L ? itq : it; const int l = ic / I_L; int r = ic - l * I_L;
            if (r < I_OUT) { const int nb = r >> 4, kb = r & 15, k0 = kb * 64, n0 = nb * 32; Ws[q] = w_out + ((size_t)l * 1024 + k0) * 1024 + n0; Ns[q] = 1024; Ks[q] = 1024;
                Wd[q] = (bf16_t*)(ws + cfg::WS_WOUT + l * cfg::SZ_WOUT) + (size_t)n0 * 1024 + k0; }
            else { r -= I_OUT; const int nb = r / 44, kb = r - nb * 44, k0 = kb * 64, n0 = nb * 32; Ws[q] = wd + ((size_t)l * cfg::FF + k0) * 1024 + n0; Ns[q] = 1024; Ks[q] = cfg::FF;
                Wd[q] = (bf16_t*)(ws + cfg::WS_WDN + l * cfg::SZ_WDN) + (size_t)n0 * cfg::FF + k0; } }
        tile_dma(Ws[0], Ns[0], scr, lane); tile_dma(Ws[1], Ns[1], scr1, lane);
        asm volatile("s_waitcnt vmcnt(0)" ::: "memory");
        tile_emit<false, 32>(Ks[0], Wd[0], (const float*)nullptr, (const float*)nullptr, d1, d2, scr, lane);
        if (it + NGW < 2 * I_L) tile_emit<false, 32>(Ks[1], Wd[1], (const float*)nullptr, (const float*)nullptr, d1, d2, scr1, lane);
    }
    const int xw = (vcu - 64) * 8 + wave, NXW = (G - 64) * 8;
    if (vcu >= 64 && G > 64)
    for (int m = xw; m < cfg::T; m += 4 * NXW) {
        f32x4 v[4][4];
#pragma unroll
        for (int q = 0; q < 4; ++q) { const int mr = (m + q * NXW) < cfg::T ? (m + q * NXW) : m; const f32x4* xr = (const f32x4*)(x + (size_t)mr * 1024) + lane;
#pragma unroll
            for (int j = 0; j < 4; ++j) v[q][j] = xr[64 * j]; }
#pragma unroll
        for (int q = 0; q < 4; ++q) { const int mr = (m + q * NXW) < cfg::T ? (m + q * NXW) : m; unsigned long long* o8 = (unsigned long long*)((bf16_t*)(ws + cfg::WS_XB) + (size_t)mr * 1024) + lane;
#pragma unroll
            for (int j = 0; j < 4; ++j) o8[64 * j] = (unsigned long long)pk2(v[q][j][0], v[q][j][1]) | ((unsigned long long)pk2(v[q][j][2], v[q][j][3]) << 32); } }
    for (int i = gw * 64 + lane; i < 2048 * 32; i += NGW * 64) { const int pos = i >> 5, f = i & 31; const float inv = exp2f(-(float)f * (13.287712379549449f / 32.f)); const float ang = (float)pos * inv;
        double rv = (double)ang * 0.15915494309189535; rv -= floor(rv); const float rev = (float)rv;
        ((float*)(ws + cfg::V_ROPEC))[i] = __builtin_amdgcn_cosf(rev); ((float*)(ws + cfg::V_ROPES))[i] = __builtin_amdgcn_sinf(rev); }
}
#undef PLAS
}
constexpr int NWAVES = 8;
constexpr int RING_OFF = 0, RING_BYTES = 131072;
constexpr int LDSCTL_OFF = RING_BYTES, MISC_OFF = LDSCTL_OFF + 320;
constexpr int RSL_OFF = 131072 + 4096;
constexpr int LDS_BYTES = 147456;
constexpr int CW_BAR = 4096;
constexpr int CW_GBAR = 8192, GBAR_STRIDE = 4096;
constexpr size_t CTL_ZERO_BYTES = 192 * 1024;
#define GAS __attribute__((address_space(1)))
#define LAS __attribute__((address_space(3)))
typedef GAS unsigned gu32;
#define RLX_AGENT __ATOMIC_RELAXED, __HIP_MEMORY_SCOPE_AGENT
#define XB_TMO      128
#define XB_XCNT(j)  (256  + 64 * (j))
#define XB_XSUB(j)  (1280 + 64 * (j))
#define XB_XGEN(j)  (2304 + 64 * (j))
#define XB_TOP      3328
#define XB_TOPGEN   3392
#define XCD_BAR_WORDS 3456
#define XB_SPIN_CAP (1u << 18)

__device__ __forceinline__ unsigned xb_ld(unsigned* p)              { return __hip_atomic_load(p, __ATOMIC_RELAXED, __HIP_MEMORY_SCOPE_AGENT); }
__device__ __forceinline__ unsigned xb_add(unsigned* p, unsigned v) { return __hip_atomic_fetch_add(p, v, __ATOMIC_RELAXED, __HIP_MEMORY_SCOPE_AGENT); }
__device__ __forceinline__ unsigned xb_xcc_id() { return (unsigned)__builtin_amdgcn_s_getreg((3 << 11) | 20) & 0xFu; }
#define XB_SPIN(cond, bar) do { unsigned _sp = 0; while (cond) { __builtin_amdgcn_s_sleep(1); \
    if ((++_sp & 255u) == 0u) { if (xb_ld(&(bar)[XB_TMO])) break; if (_sp > XB_SPIN_CAP) { atomicAdd(&(bar)[XB_TMO], 1u); break; } } } } while (0)

struct XcdBarrier {
    unsigned* bar; unsigned x; unsigned total;
    volatile LAS unsigned* st;
};

__device__ __forceinline__ XcdBarrier xcd_barrier_post(unsigned* bar, volatile LAS unsigned* st, unsigned total) {
    XcdBarrier b; b.bar = bar; b.x = xb_xcc_id(); b.st = st; b.total = total;
    if (threadIdx.x == 0) (void)xb_add(&bar[XB_XCNT(b.x)], 1u);
    return b;
}
__device__ __forceinline__ void xcd_barrier_complete(unsigned* bar, unsigned x, unsigned G, unsigned& nloc, unsigned& nx) {
    unsigned sum, cnt, mine, sp = 0u;
    for (;;) {
        sum = 0u; cnt = 0u; mine = 0u;
#pragma unroll
        for (unsigned j = 0; j < 16; ++j) { const unsigned c = xb_ld(&bar[XB_XCNT(j)]); sum += c; cnt += (c > 0u) ? 1u : 0u; mine = (j == x) ? c : mine; }
        if (sum == G) break;
        __builtin_amdgcn_s_sleep(1);
        if ((++sp & 255u) == 0u) { if (xb_ld(&bar[XB_TMO])) break; if (sp > XB_SPIN_CAP) { atomicAdd(&bar[XB_TMO], 1u); break; } }
    }
    nloc = mine > 0u ? mine : 1u; nx = cnt > 0u ? cnt : 1u;
}

__device__ __forceinline__ void xcd_barrier(const XcdBarrier& b) {
    asm volatile("s_waitcnt vmcnt(0)" ::: "memory");
    __syncthreads();
    if (threadIdx.x == 0) {
        unsigned* bar = b.bar;
        __builtin_amdgcn_s_waitcnt(0);
        unsigned nloc = b.st[0], nx = b.st[1];
        if (nloc == 0u) { xcd_barrier_complete(bar, b.x, b.total, nloc, nx); b.st[0] = nloc; b.st[1] = nx; }
        const unsigned old = xb_add(&bar[XB_XSUB(b.x)], 1u);
        const unsigned gen = old / nloc;
        if (old + 1u == (gen + 1u) * nloc) {
            __builtin_amdgcn_fence(__ATOMIC_RELEASE, "agent");
            asm volatile("s_waitcnt vmcnt(0)" ::: "memory");
            const unsigned og = xb_add(&bar[XB_TOP], 1u);
            const unsigned tg = og / nx;
            if (og + 1u == (tg + 1u) * nx) xb_add(&bar[XB_TOPGEN], 1u);
            else XB_SPIN(xb_ld(&bar[XB_TOPGEN]) == tg, bar);
            __builtin_amdgcn_fence(__ATOMIC_ACQUIRE, "agent");
            xb_add(&bar[XB_XGEN(b.x)], 1u);
            asm volatile("s_waitcnt vmcnt(0)" ::: "memory");
        } else {
            XB_SPIN(xb_ld(&bar[XB_XGEN(b.x)]) == gen, bar);
            __builtin_amdgcn_fence(__ATOMIC_ACQUIRE, "agent");
            asm volatile("s_waitcnt vmcnt(0)" ::: "memory");
        }
    }
    __syncthreads();
}


#define FILL_RSL(STP) do { pg8::Unit u0_; if (S.next(0, u0_)) { int tq_ = threadIdx.x; asm volatile("" : "+v"(tq_)); const int row_ = u0_.pm * 256 + (tq_ >> 1), hf_ = tq_ & 1; \
    typedef float f32x4_ __attribute__((ext_vector_type(4))); typedef float f32x2_ __attribute__((ext_vector_type(2))); \
    const f32x4_* sp_ = (const f32x4_*)((STP) + (size_t)row_ * 32 + hf_ * 16); const f32x4_ x0 = sp_[0], x1 = sp_[1], x2 = sp_[2], x3 = sp_[3]; \
    float sm_ = ((x0[0] + x0[2]) + (x1[0] + x1[2])) + ((x2[0] + x2[2]) + (x3[0] + x3[2])), sq_ = ((x0[1] + x0[3]) + (x1[1] + x1[3])) + ((x2[1] + x2[3]) + (x3[1] + x3[3])); \
    sm_ = xadd<1>(sm_); sq_ = xadd<1>(sq_); const float mu_ = sm_ * (1.f / 1024.f), rstd_ = rsqrtf(fmaxf(sq_ * (1.f / 1024.f) - mu_ * mu_, 0.f) + EPS); \
    if (hf_ == 0) *(LAS f32x2_*)(ldsl + RSL_OFF + 8 * (tq_ >> 1)) = (f32x2_){rstd_, -rstd_ * mu_}; } \
    __syncthreads(); } while (0)

enum { PH_PRO = 0, PH_IN = 1, PH_ATT = 2, PH_MIXB = 3, PH_OUT = 4, PH_GU = 5, PH_DN = 6, PH_FIN = 13, N_PHASES = 14 };
struct MArgs { const float* in[16]; float* out; unsigned char* ws; int ph_lo, ph_hi, li, pad; };

__global__ void __launch_bounds__(NWAVES * 64, 2) mk_fwd(MArgs a) {
    extern __shared__ __attribute__((aligned(128))) unsigned char lds[];
    LAS unsigned char* ldsl = (LAS unsigned char*)lds;
    volatile LAS unsigned* MISC = (volatile LAS unsigned*)(ldsl + MISC_OFF);
    const int tid = threadIdx.x;
    const int G = gridDim.x, bx = blockIdx.x, vcu = (G % 8 == 0) ? (bx % 8) * (G / 8) + bx / 8 : bx;
    unsigned char* ws = a.ws;
    for (int u = tid; u < (LDS_BYTES - LDSCTL_OFF) / 4; u += NWAVES * 64) ((LAS unsigned*)(ldsl + LDSCTL_OFF))[u] = 0u;
    __syncthreads();
    XcdBarrier bar; bar.bar = (unsigned*)(ws + WS_CTL) + CW_BAR + a.li * XCD_BAR_WORDS; bar.x = 0; bar.st = nullptr; bar.total = (unsigned)G;
    if (a.ph_hi - a.ph_lo > 1) bar = xcd_barrier_post((unsigned*)(ws + WS_CTL) + CW_BAR + a.li * XCD_BAR_WORDS, MISC + 8, (unsigned)G);
    const bool grp_ok = (G % 8 == 0) && (a.ph_hi - a.ph_lo > 1);
    XcdBarrier gbar = bar;
    if (grp_ok) gbar = xcd_barrier_post((unsigned*)(ws + WS_CTL) + CW_GBAR + (bx & 7) * GBAR_STRIDE, MISC + 10, (unsigned)(G / 8));
    const int G0 = G, bx0 = bx, vcu0 = vcu; unsigned char* const ws0 = ws;
    for (int ph = a.ph_lo; ph < a.ph_hi; ++ph) {
        int G = G0, bx = bx0, vcu = vcu0; unsigned zo = 0u; asm volatile("" : "+s"(G), "+s"(bx), "+s"(vcu), "+s"(zo)); unsigned char* ws = ws0 + zo;
        const int l = (ph >= 1 && ph <= 12) ? (ph - 1) / 6 : 0;
        const int kind = (ph == 0) ? PH_PRO : (ph == PH_FIN ? PH_FIN : 1 + (ph - 1) % 6);
        if (kind == PH_PRO) {
            { pro::Inputs pin{a.in[0], a.in[1], a.in[4], a.in[5], a.in[8], a.in[9], a.in[10], a.in[11], a.in[12], a.in[13], a.in[14], a.in[15]}; pro::prologue(ws, pin, ldsl + RING_OFF, vcu, G); }
        } else if (kind == PH_IN) {
            pg8::Gemm g{(const bf16_t*)(ws + WS_XB), (const bf16_t*)(ws + WS_WIN + l * SZ_WIN), T, NIN, D}; pg8::StaticOrder S; S.init(T, NIN, G, bx);
            if (l) FILL_RSL((const float*)(ws + WS_ST2));
            pg8::FEpiIn E{ws, a.in[6] + l * 256, l, (const LAS float*)(ldsl + RSL_OFF)};
            pg8::gemm_phase<pg8::FEpiIn, pg8::StaticOrder, true, true>(ldsl + RING_OFF, g, S, E);
        } else if (kind == PH_ATT) {
            for (int i = 0; i < 2; ++i) { const int idx = vcu * 2 + i; if (idx >= 512) break; const int bh = idx >> 4, qb = idx & 15;
                att::attn_unit(bh >> 2, bh & 3, qb, (const bf16_t*)(ws + WS_Q), (const bf16_t*)(ws + WS_K), (const bf16_t*)(ws + WS_V), (bf16_t*)(ws + WSB_OC + (size_t)(bh >> 2) * DLT_OC), a.in[2] + l * 256, a.in[3] + l * 128, l, (char*)lds + RING_OFF); }
            if (vcu * 2 + 1 < 512) {
                typedef unsigned u32x4_ __attribute__((ext_vector_type(4))); u32x4_ tva[4], tvb[4]; const int ia = vcu * 2, ib = ia + 1;
                fft::stage1_load(tva, ia >> 6, ia & 63, (const bf16_t*)(ws + WS_TAB)); fft::stage1_load(tvb, ib >> 6, ib & 63, (const bf16_t*)(ws + WS_TAB));
                fft::stage1_item(ia >> 6, ia & 63, tva, (bf16_t*)(ws + WS_XT), ldsl + RING_OFF); fft::stage1_item(ib >> 6, ib & 63, tvb, (bf16_t*)(ws + WS_XT), ldsl + RING_OFF); }
            if (vcu < 256) gla::gla_a_item(vcu >> 5, (vcu >> 3) & 3, vcu & 7, ws, ldsl + RING_OFF);
        } else if (kind == PH_MIXB) {
            if (vcu < 256) fft::stage2_item(vcu >> 5, vcu & 31, (const bf16_t*)(ws + WS_XT), (bf16_t*)(ws + WSB_OC + (size_t)(vcu >> 5) * DLT_OC), ldsl + RING_OFF);
            if (vcu < 256) gla::gla_b_item(vcu >> 5, (vcu >> 3) & 3, vcu & 7, ws, a.in[7] + l * 64, (bf16_t*)(ws + WSB_OC + (size_t)(vcu >> 5) * DLT_OC), ldsl + RING_OFF);
        } else if (kind == PH_OUT) {
            pg8::Gemm g{(const bf16_t*)(ws + WSB_OC + (size_t)(bx & 7) * DLT_OC), (const bf16_t*)(ws + WS_WOUT + l * SZ_WOUT), T, D, D}; pg8::StaticOrder S; S.init(T, D, G, bx);
            if (l) FILL_RSL((const float*)(ws + WS_ST2));
            pg8::FEpiRes E{l ? (const LAS float*)(ldsl + RSL_OFF) : (const LAS float*)nullptr, a.in[14] + (l ? l - 1 : 0) * 1024, a.in[15] + (l ? l - 1 : 0) * 1024, (bf16_t*)(ws + WS_XB), (float*)(ws + WS_ST1)};
            pg8::gemm_phase<pg8::FEpiRes, pg8::StaticOrder, true, true>(ldsl + RING_OFF, g, S, E);
        } else if (kind == PH_GU) {
            pg8::Gemm g{(const bf16_t*)(ws + WS_XB), (const bf16_t*)(ws + WS_WGU + l * SZ_WGU), T, NGU, D}; pg8::StaticOrder S; S.init(T, NGU, G, bx);
            FILL_RSL((const float*)(ws + WS_ST1));
            pg8::FEpiGU E{(const LAS float*)(ldsl + RSL_OFF), (const float*)(ws + V_C1GU) + l * NGU, (const float*)(ws + V_C2GU) + l * NGU, (bf16_t*)(ws + WS_ACT)};
            pg8::gemm_phase<pg8::FEpiGU, pg8::StaticOrder, true, true>(ldsl + RING_OFF, g, S, E);
        } else if (kind == PH_DN) {
            pg8::Gemm g{(const bf16_t*)(ws + WS_ACT), (const bf16_t*)(ws + WS_WDN + l * SZ_WDN), T, D, FF}; pg8::StaticOrder S; S.init(T, D, G, bx);
            FILL_RSL((const float*)(ws + WS_ST1));
            pg8::FEpiRes E{(const LAS float*)(ldsl + RSL_OFF), a.in[9] + l * 1024, a.in[10] + l * 1024, (bf16_t*)(ws + WS_XB), (float*)(ws + WS_ST2)};
            pg8::gemm_phase<pg8::FEpiRes, pg8::StaticOrder, true, true>(ldsl + RING_OFF, g, S, E);
        } else if (kind == PH_FIN) {
            const float* g2 = a.in[14] + 1024; const float* b2v = a.in[15] + 1024; const float* ST2 = (const float*)(ws + WS_ST2); const bf16_t* XB = (const bf16_t*)(ws + WS_XB); float* Y2 = a.out;
            int tid_f = threadIdx.x; asm volatile("" : "+v"(tid_f)); const int lane = tid_f & 63, wave = __builtin_amdgcn_readfirstlane(tid_f >> 6);
            typedef float f32x4 __attribute__((ext_vector_type(4))); typedef unsigned u32x2 __attribute__((ext_vector_type(2)));
            f32x4 gg[4], bq[4];
#pragma unroll
            for (int j = 0; j < 4; ++j) { gg[j] = *((const f32x4*)g2 + lane + 64 * j); bq[j] = *((const f32x4*)b2v + lane + 64 * j); }
            const bool grp_rows = (G % 8 == 0) && (S % ((G / 8) * NWAVES) == 0);
            const int r_first = grp_rows ? (bx & 7) * S + (bx >> 3) * NWAVES + wave : vcu * NWAVES + wave, r_step = grp_rows ? (G / 8) * NWAVES : G * NWAVES, r_end = grp_rows ? (bx & 7) * S + S : T;
            for (int row = r_first; row < r_end; row += r_step) { const RowStat rs = row_stat(ST2, row);
                const u32x2* xr = (const u32x2*)(XB + (size_t)row * 1024) + lane; f32x4* yr = (f32x4*)(Y2 + (size_t)row * 1024) + lane;
#pragma unroll
                for (int j = 0; j < 4; ++j) { const u32x2 w = xr[64 * j]; const f32x4 v = {__uint_as_float(w.x << 16), __uint_as_float(w.x & 0xffff0000u), __uint_as_float(w.y << 16), __uint_as_float(w.y & 0xffff0000u)};
                    yr[64 * j] = (v - rs.mu) * rs.rstd * gg[j] + bq[j]; } }
        }
        if (ph + 1 < a.ph_hi) { const bool local = grp_ok && kind != PH_PRO; if (local) xcd_barrier(gbar); else xcd_barrier(bar); }
    }
}

static void launch_frame(const MArgs& base, int lo, int hi, int grid, hipStream_t stream, int li = 0) {
    MArgs a = base; a.ph_lo = lo; a.ph_hi = hi; a.li = li;
    hipLaunchKernelGGL(mk_fwd, dim3(grid), dim3(NWAVES * 64), LDS_BYTES, stream, a);
}
extern "C" void kernel_launch(void* const* d_in, const int* in_sizes, int n_in, void* d_out, int out_size, void* d_ws, size_t ws_size, hipStream_t stream) {
    static int grid = 0;
    if (grid == 0) {
        if (n_in != 16 || in_sizes[0] != T * D || out_size != T * D || ws_size < WS_END) { fprintf(stderr, "kernel_launch: unexpected shapes (n_in %d, in0 %d, out %d, ws %zu)\n", n_in, n_in > 0 ? in_sizes[0] : -1, out_size, ws_size); grid = -1; return; }
        int dev = 0, cus = 0, per_cu = 0;
        if (hipGetDevice(&dev) != hipSuccess || hipDeviceGetAttribute(&cus, hipDeviceAttributeMultiprocessorCount, dev) != hipSuccess) { grid = -1; return; }
        if (hipFuncSetAttribute((const void*)mk_fwd, hipFuncAttributeMaxDynamicSharedMemorySize, LDS_BYTES) != hipSuccess) { fprintf(stderr, "kernel_launch: hipFuncSetAttribute failed\n"); grid = -1; return; }
        if (hipOccupancyMaxActiveBlocksPerMultiprocessor(&per_cu, (const void*)mk_fwd, NWAVES * 64, LDS_BYTES) != hipSuccess || per_cu < 1) { fprintf(stderr, "kernel_launch: occupancy query says %d workgroups per CU\n", per_cu); per_cu = 1; }
        (void)hipGetLastError();
        grid = cus;
        if (grid != 256) { fprintf(stderr, "kernel_launch: this kernel's work split is built for the 256 CUs of an MI355X, found %d; nothing launched\n", cus); grid = -1; return; }
    }
    if (grid < 0) return;
    const float* x = (const float*)d_in[0]; const float* w_in = (const float*)d_in[1]; const float* dlam = (const float*)d_in[2]; const float* dng = (const float*)d_in[3];
    const float* fw = (const float*)d_in[4]; const float* gw2 = (const float*)d_in[5]; const float* gb2 = (const float*)d_in[6]; const float* gng = (const float*)d_in[7];
    const float* w_out = (const float*)d_in[8]; const float* ln1g = (const float*)d_in[9]; const float* ln1b = (const float*)d_in[10];
    const float* wg = (const float*)d_in[11]; const float* wu = (const float*)d_in[12]; const float* wd = (const float*)d_in[13]; const float* ln2g = (const float*)d_in[14]; const float* ln2b = (const float*)d_in[15];
    char* ws = (char*)d_ws;
    float* ropec = (float*)(ws + V_ROPEC); float* ropes = (float*)(ws + V_ROPES); float* MF = (float*)(ws + V_MF);
    float* c1in = (float*)(ws + V_C1IN); float* c2in = (float*)(ws + V_C2IN); float* c1gu = (float*)(ws + V_C1GU); float* c2gu = (float*)(ws + V_C2GU);
    bf16_t* TAB = (bf16_t*)(ws + WS_TAB); bf16_t* XB = (bf16_t*)(ws + WS_XB);
    bf16_t* Q = (bf16_t*)(ws + WS_Q); bf16_t* K = (bf16_t*)(ws + WS_K); bf16_t* V = (bf16_t*)(ws + WS_V);
    bf16_t* GQK = (bf16_t*)(ws + WS_GQK); bf16_t* GV = (bf16_t*)(ws + WS_GV); bf16_t* GR = (bf16_t*)(ws + WS_GR); float* GL = (float*)(ws + WS_GL);
    bf16_t* OC = (bf16_t*)(ws + WS_OC); float* OF = (float*)(ws + WS_OF);
    (void)hipMemsetAsync(ws + WS_CTL, 0, CTL_ZERO_BYTES, stream);
    MArgs base{}; for (int i = 0; i < 16; ++i) base.in[i] = (const float*)d_in[i]; base.out = (float*)d_out; base.ws = (unsigned char*)d_ws;
    launch_frame(base, 0, N_PHASES, grid, stream, 0);
}
```

```cpp
#include <hip/hip_runtime.h>
#include <cstdint>
#include <cstdio>
#include <cmath>

typedef unsigned short bf16_t;
namespace cfg {
constexpr int B = 8, S = 2048, D = 1024, T = B * S, L = 2;
constexpr int INW = 2592, NIN = 3072, FF = 2816, NGU = 2 * FF;
constexpr float ALPHA = 1.41421356237309515f;
constexpr float EPS = 1e-5f;
constexpr float QSCALE = 0.125f * 1.4426950408889634f;
constexpr float GQSCALE = 0.17677669529663687f;
constexpr size_t MiB = 1u << 20;
constexpr size_t WS_CTL = 0;
constexpr size_t WS_VEC = 1 * MiB;
constexpr size_t V_ROPEC = WS_VEC, V_ROPES = WS_VEC + 256 * 1024, V_MF = WS_VEC + 512 * 1024;
constexpr size_t V_C1IN = WS_VEC + 768 * 1024, V_C2IN = V_C1IN + 24 * 1024, V_C1GU = V_C2IN + 24 * 1024, V_C2GU = V_C1GU + 44 * 1024;
constexpr size_t WS_WIN = 2 * MiB, WS_WOUT = 14 * MiB, WS_WGU = 18 * MiB, WS_WDN = 40 * MiB, WS_TAB = 51 * MiB;
constexpr size_t SZ_WIN = 6 * MiB, SZ_WOUT = 2 * MiB, SZ_WGU = 11 * MiB, SZ_WDN = 5632 * 1024;
constexpr size_t WS_XB = 67 * MiB;
constexpr size_t WS_Y1 = 99 * MiB, WS_Q = 99 * MiB, WS_K = 115 * MiB, WS_V = 131 * MiB, WS_XT = 147 * MiB;
constexpr size_t WS_ACT = 163 * MiB, WS_GQK = 163 * MiB, WS_GV = 171 * MiB, WS_GR = 179 * MiB, WS_GL = 187 * MiB, WS_OC = 203 * MiB, WS_OF = 235 * MiB;
constexpr size_t WSB_GQK = WS_ACT, WSB_GV = WS_ACT + 1 * MiB, WSB_GR = WS_ACT + 2 * MiB, WSB_GL = WS_ACT + 3 * MiB, WSB_OC = WS_ACT + 5 * MiB, WSB_OF = WS_ACT + 9 * MiB;
constexpr size_t DLT_GQK = 10 * MiB, DLT_GV = 10 * MiB, DLT_GR = 10 * MiB, DLT_GL = 9 * MiB, DLT_OC = 7 * MiB, DLT_OF = 9 * MiB;
constexpr size_t WS_ST1 = 251 * MiB, WS_ST2 = 253 * MiB, WS_DEC = 255 * MiB, WS_END = 256 * MiB;
}
using namespace cfg;

__device__ __forceinline__ float bf2f(bf16_t v) { return __uint_as_float((unsigned)v << 16); }
__device__ __forceinline__ bf16_t f2bf(float f) { unsigned u = __float_as_uint(f); return (bf16_t)((u + 0x7fffu + ((u >> 16) & 1u)) >> 16); }


template <int M> __device__ __forceinline__ float xadd(float v) {
    if constexpr (M == 32) { auto r = __builtin_amdgcn_permlane32_swap(__float_as_uint(v), __float_as_uint(v), false, false); return __uint_as_float(r[0]) + __uint_as_float(r[1]); }
    else return v + __int_as_float(__builtin_amdgcn_ds_swizzle(__float_as_int(v), (M << 10) | 0x1f));
}
struct RowStat { float mu, rstd; };
__device__ __forceinline__ RowStat row_stat(const float* ST, int row) {
    float s = 0.f, ss = 0.f;
    for (int i = 0; i < 8; ++i) { const float4 a = *(const float4*)(ST + (size_t)row * 32 + 4 * i); s += a.x + a.z; ss += a.y + a.w; }
    const float mu = s * (1.f / 1024.f); const float var = ss * (1.f / 1024.f) - mu * mu;
    RowStat r; r.mu = mu; r.rstd = rsqrtf(fmaxf(var, 0.f) + EPS); return r;
}
namespace pg8 {
#define PG8_LAS __attribute__((address_space(3)))
typedef unsigned short bf16_t;
typedef short bf16x8 __attribute__((ext_vector_type(8)));
typedef float f32x4 __attribute__((ext_vector_type(4)));
typedef unsigned u32x4 __attribute__((ext_vector_type(4)));
constexpr int BM = 256, BK = 64, HALF = 128, HTB = HALF * BK * 2  , STAGE_BYTES = 8 * HTB, NXCD = 8, WGM = 8;

__host__ __device__ __forceinline__ int lds_byte(int r, int c) { const int st = (r >> 4) * 2 + (c >> 5), rr = r & 15, cc = c & 31, ob = rr * 64 + cc * 2; return st * 1024 + (ob ^ (((ob >> 9) & 1) << 5)); }
__host__ __device__ __forceinline__ void stage_rc(int b, int& R, int& C) { const int st = b / 1024, sb = b % 1024, swz = sb ^ (((sb >> 9) & 1) << 5); R = (st >> 1) * 16 + swz / 64; C = (st & 1) * 32 + (swz % 64) / 2; }
__host__ __device__ __forceinline__ int perm32(int rho) { const int n = rho >> 4, i = rho & 15; return 8 * (i >> 2) + 4 * n + (i & 3); }

struct Unit { int pm, pn; };
struct Gemm { const bf16_t* A; const bf16_t* Bt; int M, N, K; };

struct StaticOrder {
    int nM, nN, nwg, G, c;
    __host__ __device__ void init(int M, int N, int G_, int c_) { nM = M / BM; nN = N / BM; nwg = nM * nN; G = G_; c = c_; }
    __host__ __device__ bool next(int i, Unit& u) const {
        const long L = (long)i * G + c; if (L >= nwg) return false;
        int wgid = (int)L; { const int q = nwg / NXCD, r = nwg % NXCD, xcd = wgid % NXCD, off = wgid / NXCD; wgid = (xcd < r ? xcd * (q + 1) : r * (q + 1) + (xcd - r) * q) + off; }
        const int nig = WGM * nN, gid = wgid / nig, fm = gid * WGM, gsz = (nM - fm) < WGM ? (nM - fm) : WGM;
        u.pm = fm + ((wgid % nig) % gsz); u.pn = (wgid % nig) / gsz; return true;
    }
    __device__ __forceinline__ void a_ready(const Unit&) const {}
    __device__ __forceinline__ void done(const Unit&) const {}
};
template <class Epi, class Sched, bool ALIGN_EPI = false, bool SP2 = false>
__device__ __forceinline__ void gemm_phase(PG8_LAS unsigned char* lds, const Gemm g, const Sched& S, const Epi& E) {
    int tid_o = threadIdx.x; asm volatile("" : "+v"(tid_o));
    const int tid = tid_o, wid = __builtin_amdgcn_readfirstlane(tid >> 6), lane = tid & 63, wr = wid >> 2, wc = wid & 3, fr = lane & 15, fq = lane >> 4;
    const int K = g.K, nt = K / BK;
    unsigned voffA[2], voffB[2];
#pragma unroll
    for (int i = 0; i < 2; ++i) { int R, C; stage_rc(tid * 16 + i * 8192, R, C); const int Rb = Epi::PERM ? ((R & ~31) + perm32(R & 31)) : R;
        voffA[i] = (unsigned)(R * K + C) * 2u; voffB[i] = (unsigned)(Rb * K + C) * 2u; }
    const size_t kstep = (size_t)(BK * 2);
    const size_t hstep = (size_t)HALF * K * 2;
    const size_t tstep = 2 * hstep;
    const unsigned ldsw = (unsigned)wid * 1024u;
    const int aoff = lds_byte(wr * 64 + fr, fq * 8), boff = lds_byte(wc * 32 + fr, fq * 8);
#define PG8_SA(b, h) (((b) * 2 + (h)) * HTB)
#define PG8_SB(b, h) ((4 + (b) * 2 + (h)) * HTB)
#define PG8_STAGE(bufoff, gbase, voff) do { _Pragma("unroll") for (int _i = 0; _i < 2; ++_i) \
        __builtin_amdgcn_global_load_lds((const unsigned*)((const char*)(gbase) + (voff)[_i]), (PG8_LAS unsigned*)(lds + (bufoff) + ldsw + _i * 8192), 16, 0, 0); } while (0)
#define PG8_LDA(dst, b, h) do { _Pragma("unroll") for (int m = 0; m < 4; ++m) _Pragma("unroll") for (int k = 0; k < 2; ++k) dst[m][k] = *(const PG8_LAS bf16x8*)(lds + PG8_SA(b, h) + aoff + m * 2048 + k * 1024); } while (0)
#define PG8_LDB(dst, b, h) do { _Pragma("unroll") for (int n = 0; n < 2; ++n) _Pragma("unroll") for (int k = 0; k < 2; ++k) dst[n][k] = *(const PG8_LAS bf16x8*)(lds + PG8_SB(b, h) + boff + n * 2048 + k * 1024); } while (0)
#define PG8_MMA(ai, bj, At, Bt) do { __builtin_amdgcn_s_setprio(1); _Pragma("unroll") for (int m = 0; m < 4; ++m) _Pragma("unroll") for (int n = 0; n < 2; ++n) _Pragma("unroll") for (int k = 0; k < 2; ++k) \
        acc[ai][bj][m][n] = __builtin_amdgcn_mfma_f32_16x16x32_bf16(Bt[n][k], At[m][k], acc[ai][bj][m][n], 0, 0, 0); __builtin_amdgcn_s_setprio(0); } while (0)
#define PG8_WAIT_V(n) asm volatile("s_waitcnt vmcnt(" #n ")" ::: "memory")
#define PG8_WAIT_L(n) asm volatile("s_waitcnt lgkmcnt(" #n ")" ::: "memory")
#define PG8_BAR __builtin_amdgcn_s_barrier()
#define PG8_SCHED __builtin_amdgcn_sched_barrier(0)
    Unit cur, nxt; int ui = 0;
    if (!S.next(0, cur)) return;
    f32x4 acc[2][2][4][2];
#pragma unroll
    for (int a = 0; a < 2; ++a)
#pragma unroll
        for (int b = 0; b < 2; ++b)
#pragma unroll
            for (int m = 0; m < 4; ++m)
#pragma unroll
                for (int n = 0; n < 2; ++n) acc[a][b][m][n] = (f32x4){0.f, 0.f, 0.f, 0.f};
    bf16x8 At[4][2], B0[2][2], B1[2][2];
    const char* cA = (const char*)g.A + (size_t)cur.pm * tstep; const char* cB = (const char*)g.Bt + (size_t)cur.pn * tstep;
    S.a_ready(cur);
    if constexpr (SP2) {
        PG8_STAGE(PG8_SB(0, 0), cB, voffB); PG8_STAGE(PG8_SB(0, 1), cB + hstep, voffB); PG8_STAGE(PG8_SA(0, 0), cA, voffA); PG8_STAGE(PG8_SA(0, 1), cA + hstep, voffA);
        if (wr == 1) PG8_BAR;
        PG8_WAIT_V(2); PG8_BAR;
        PG8_STAGE(PG8_SB(1, 0), cB + kstep, voffB); PG8_STAGE(PG8_SA(1, 0), cA + kstep, voffA); PG8_STAGE(PG8_SB(1, 1), cB + hstep + kstep, voffB);
        PG8_WAIT_V(6); PG8_BAR;
    } else {
        PG8_STAGE(PG8_SB(0, 0), cB, voffB); PG8_STAGE(PG8_SA(0, 0), cA, voffA); PG8_STAGE(PG8_SB(0, 1), cB + hstep, voffB); PG8_STAGE(PG8_SA(0, 1), cA + hstep, voffA);
        if (wr == 1) PG8_BAR;
        PG8_WAIT_V(4); PG8_BAR;
        PG8_STAGE(PG8_SB(1, 0), cB + kstep, voffB); PG8_STAGE(PG8_SA(1, 0), cA + kstep, voffA); PG8_STAGE(PG8_SB(1, 1), cB + hstep + kstep, voffB);
        PG8_WAIT_V(6); PG8_BAR;
    }
    for (;;) {
        const bool has_next = S.next(ui + 1, nxt);
        const char* nA = has_next ? (const char*)g.A + (size_t)nxt.pm * tstep : cA; const char* nB = has_next ? (const char*)g.Bt + (size_t)nxt.pn * tstep : cB;
        for (int t = 0; t < nt; t += 2) {
            const bool last = (t == nt - 2);
            const char* a1 = cA + (size_t)(t + 1) * kstep;
            const char* a2 = last ? nA : cA + (size_t)(t + 2) * kstep; const char* b2 = last ? nB : cB + (size_t)(t + 2) * kstep;
            const char* a3 = a2 + kstep; const char* b3 = b2 + kstep;
            if (last && has_next) S.a_ready(nxt);
            if constexpr (SP2) {
            PG8_LDB(B0, 0, 0); PG8_LDB(B1, 0, 1); PG8_SCHED; PG8_LDA(At, 0, 0); PG8_STAGE(PG8_SA(1, 1), a1 + hstep, voffA);
            PG8_WAIT_V(8); PG8_WAIT_L(0); PG8_BAR; PG8_MMA(0, 0, At, B0); PG8_MMA(0, 1, At, B1); PG8_BAR; PG8_SCHED;
            PG8_LDA(At, 0, 1); PG8_STAGE(PG8_SB(0, 0), b2, voffB); PG8_STAGE(PG8_SB(0, 1), b2 + hstep, voffB); PG8_STAGE(PG8_SA(0, 0), a2, voffA);
            PG8_WAIT_V(8); PG8_WAIT_L(0); PG8_BAR; PG8_MMA(1, 0, At, B0); PG8_MMA(1, 1, At, B1); PG8_BAR; PG8_SCHED;
            PG8_LDB(B0, 1, 0); PG8_LDB(B1, 1, 1); PG8_SCHED; PG8_LDA(At, 1, 0); PG8_STAGE(PG8_SA(0, 1), a2 + hstep, voffA);
            PG8_WAIT_V(8); PG8_WAIT_L(0); PG8_BAR; PG8_MMA(0, 0, At, B0); PG8_MMA(0, 1, At, B1); PG8_BAR; PG8_SCHED;
            PG8_LDA(At, 1, 1); PG8_STAGE(PG8_SB(1, 0), b3, voffB); PG8_STAGE(PG8_SB(1, 1), b3 + hstep, voffB); PG8_STAGE(PG8_SA(1, 0), a3, voffA);
            PG8_WAIT_V(8); PG8_WAIT_L(0); PG8_BAR; PG8_MMA(1, 0, At, B0); PG8_MMA(1, 1, At, B1); PG8_BAR; PG8_SCHED;
            } else {
            PG8_LDB(B0, 0, 0); PG8_SCHED; PG8_LDA(At, 0, 0); PG8_STAGE(PG8_SA(1, 1), a1 + hstep, voffA);
            PG8_WAIT_L(8); PG8_BAR; PG8_WAIT_L(0); PG8_MMA(0, 0, At, B0); PG8_BAR; PG8_SCHED;
            PG8_LDB(B1, 0, 1); PG8_STAGE(PG8_SB(0, 0), b2, voffB);
            PG8_BAR; PG8_WAIT_L(0); PG8_MMA(0, 1, At, B1); PG8_BAR;
            PG8_LDA(At, 0, 1); PG8_STAGE(PG8_SA(0, 0), a2, voffA);
            PG8_BAR; PG8_WAIT_L(0); PG8_MMA(1, 0, At, B0); PG8_BAR; PG8_SCHED;
            PG8_STAGE(PG8_SB(0, 1), b2 + hstep, voffB);
            PG8_WAIT_V(6); PG8_BAR; PG8_MMA(1, 1, At, B1); PG8_BAR;
            PG8_LDB(B0, 1, 0); PG8_SCHED; PG8_LDA(At, 1, 0); PG8_STAGE(PG8_SA(0, 1), a2 + hstep, voffA);
            PG8_WAIT_L(8); PG8_BAR; PG8_WAIT_L(0); PG8_MMA(0, 0, At, B0); PG8_BAR; PG8_SCHED;
            PG8_LDB(B1, 1, 1); PG8_STAGE(PG8_SB(1, 0), b3, voffB);
            PG8_BAR; PG8_WAIT_L(0); PG8_MMA(0, 1, At, B1); PG8_BAR;
            PG8_LDA(At, 1, 1); PG8_STAGE(PG8_SA(1, 0), a3, voffA);
            PG8_BAR; PG8_WAIT_L(0); PG8_MMA(1, 0, At, B0); PG8_BAR; PG8_SCHED;
            PG8_STAGE(PG8_SB(1, 1), b3 + hstep, voffB);
            PG8_WAIT_V(6); PG8_BAR; PG8_MMA(1, 1, At, B1); PG8_BAR;
            }
        }
        if constexpr (ALIGN_EPI) { if (wr == 0) PG8_BAR; }
        if constexpr (!Epi::AFTER_DRAIN) { E(acc, cur, wr, wc, fr, fq); S.done(cur); }
        if (!has_next) break;
#pragma unroll
        for (int a = 0; a < 2; ++a)
#pragma unroll
            for (int b = 0; b < 2; ++b)
#pragma unroll
                for (int m = 0; m < 4; ++m)
#pragma unroll
                    for (int n = 0; n < 2; ++n) acc[a][b][m][n] = (f32x4){0.f, 0.f, 0.f, 0.f};
        cur = nxt; cA = nA; cB = nB; ++ui;
        if constexpr (ALIGN_EPI) { if (wr == 1) PG8_BAR; }
    }
    PG8_WAIT_V(0);
    if constexpr (!ALIGN_EPI) { if (wr == 0) PG8_BAR; }
    PG8_BAR;
    if constexpr (Epi::AFTER_DRAIN) { E.fused(acc, cur, wr, wc, fr, fq, lds, wid, lane); S.done(cur); }
#undef PG8_SA
#undef PG8_SB
#undef PG8_STAGE
#undef PG8_LDA
#undef PG8_LDB
#undef PG8_MMA
#undef PG8_WAIT_V
#undef PG8_WAIT_L
#undef PG8_BAR
#undef PG8_SCHED
}
}
namespace pg8 {
__device__ __forceinline__ unsigned cvt_pk_bf16(float lo, float hi) { unsigned r; asm volatile("v_cvt_pk_bf16_f32 %0, %1, %2" : "=v"(r) : "v"(lo), "v"(hi)); return r; }
__device__ __forceinline__ void st8(bf16_t* p, const f32x4 a, const f32x4 b) { u32x4 w; w.x = cvt_pk_bf16(a[0], a[1]); w.y = cvt_pk_bf16(a[2], a[3]); w.z = cvt_pk_bf16(b[0], b[1]); w.w = cvt_pk_bf16(b[2], b[3]); *(u32x4*)p = w; }
__device__ __forceinline__ void st8nt(bf16_t* p, const f32x4 a, const f32x4 b) { u32x4 w; w.x = cvt_pk_bf16(a[0], a[1]); w.y = cvt_pk_bf16(a[2], a[3]); w.z = cvt_pk_bf16(b[0], b[1]); w.w = cvt_pk_bf16(b[2], b[3]); __builtin_nontemporal_store(w, (u32x4*)p); }
struct RS { float a, b; };
struct StatLd { f32x4 x, y; };
__device__ __forceinline__ StatLd stat_load(const float* ST, int row, int fq) { const f32x4* p = (const f32x4*)(ST + (size_t)row * 32 + fq * 8); StatLd r; r.x = p[0]; r.y = p[1]; return r; }
__device__ __forceinline__ RS stat_fin(const StatLd& t) {
    float s = (t.x[0] + t.x[2]) + (t.y[0] + t.y[2]), ss = (t.x[1] + t.x[3]) + (t.y[1] + t.y[3]);
    s = xadd<16>(s); ss = xadd<16>(ss); s = xadd<32>(s); ss = xadd<32>(ss);
    const float mu = s * (1.f / 1024.f), var = ss * (1.f / 1024.f) - mu * mu, rstd = rsqrtf(fmaxf(var, 0.f) + cfg::EPS);
    RS r; r.a = rstd; r.b = -rstd * mu; return r;
}
__device__ __forceinline__ RS row_stat16(const float* ST, int row, int fq) { return stat_fin(stat_load(ST, row, fq)); }
__device__ __forceinline__ float fsilu(float x) { return x * __builtin_amdgcn_rcpf(1.f + __expf(-x)); }
__device__ __forceinline__ float flogsig16(float x) { return (fminf(x, 0.f) - __logf(1.f + __expf(-fabsf(x)))) * (1.f / 16.f); }

struct FEpiIn {
    static constexpr bool PERM = true, AFTER_DRAIN = false;
    unsigned char* ws; const float* b2; int l; const PG8_LAS float* rsl;
    struct RowLd { f32x4 rc[2], rsn[2]; };
    template <int KIND> __device__ __forceinline__ RowLd load_row(int row, const float (&invf)[8]) const {
        RowLd r;
        if constexpr (KIND == 0) { const float pos = (float)(row & 2047);
#pragma unroll
            for (int e = 0; e < 8; ++e) { const float ang = pos * invf[e]; double rv = (double)ang * 0.15915494309189535; rv -= floor(rv); const float rev = (float)rv;
                r.rc[e >> 2][e & 3] = __builtin_amdgcn_cosf(rev); r.rsn[e >> 2][e & 3] = __builtin_amdgcn_sinf(rev); } }
        return r;
    }
    template <int KIND> __device__ __forceinline__ void rows(const f32x4 (&acc)[2][2][4][2], const Unit& u, int wr, int wc, int fr, int fq) const {
        const int pn = u.pn, cw = 32 * wc + 8 * fq, row0 = u.pm * BM + 64 * wr + fr;
        const bool st = l != 0;
        f32x4 k1[2][2], k2[2][2], bias[2][2];
        const float qs = __uint_as_float(__builtin_amdgcn_readfirstlane(__float_as_uint(pn < 2 ? cfg::QSCALE : 1.f)));
        float invf[8];
        if constexpr (KIND == 0) {
#pragma unroll
            for (int e = 0; e < 8; ++e) invf[e] = exp2f(-(float)(8 * fq + e) * (13.287712379549449f / 32.f)); }
        RowLd cur = load_row<KIND>(row0, invf), nxt;
        if (st) {
#pragma unroll
            for (int bj = 0; bj < 2; ++bj)
#pragma unroll
                for (int n = 0; n < 2; ++n) {
                    if constexpr (KIND == 2) {
                        const float* fp = (const float*)(ws + cfg::V_MF) + (size_t)(l * 8) * 512 + (pn - 6) * 256 + cw + 128 * bj + 4 * n;
                        k1[bj][n] = (*(const f32x4*)fp + *(const f32x4*)(fp + 1024)) + (*(const f32x4*)(fp + 2048) + *(const f32x4*)(fp + 3072));
                        k2[bj][n] = (*(const f32x4*)(fp + 512) + *(const f32x4*)(fp + 1536)) + (*(const f32x4*)(fp + 2560) + *(const f32x4*)(fp + 3584));
                    } else { const float* c1 = (const float*)(ws + cfg::V_C1IN) + l * cfg::NIN + pn * 256 + cw; const float* c2 = (const float*)(ws + cfg::V_C2IN) + l * cfg::NIN + pn * 256 + cw;
                        k1[bj][n] = *(const f32x4*)(c1 + 128 * bj + 4 * n); k2[bj][n] = *(const f32x4*)(c2 + 128 * bj + 4 * n); } } }
        if constexpr (KIND == 6) {
#pragma unroll
            for (int bj = 0; bj < 2; ++bj)
#pragma unroll
                for (int n = 0; n < 2; ++n) bias[bj][n] = *(const f32x4*)(b2 + 128 * bj + cw + 4 * n); }
#pragma unroll
        for (int i = 0; i < 8; ++i) {
            const int ai = i >> 2, m = i & 3, row = row0 + 128 * ai + 16 * m, pos = row & 2047;
            if (i < 7) nxt = load_row<KIND>(row0 + 128 * ((i + 1) >> 2) + 16 * ((i + 1) & 3), invf);
            f32x4 v[2][2];
            if (st) { typedef float f32x2 __attribute__((ext_vector_type(2))); const f32x2 t2 = *(const PG8_LAS f32x2*)(rsl + 2 * (128 * ai + 64 * wr + 16 * m + fr)); RS rs; rs.a = t2[0]; rs.b = t2[1];
#pragma unroll
                for (int bj = 0; bj < 2; ++bj)
#pragma unroll
                    for (int n = 0; n < 2; ++n) v[bj][n] = rs.a * acc[ai][bj][m][n] + (rs.b * k1[bj][n] + k2[bj][n]);
            } else {
#pragma unroll
                for (int bj = 0; bj < 2; ++bj)
#pragma unroll
                    for (int n = 0; n < 2; ++n) v[bj][n] = acc[ai][bj][m][n]; }
            if constexpr (KIND == 0) {
                f32x4 a0 = v[0][0] * cur.rc[0] - v[1][0] * cur.rsn[0], a1 = v[0][1] * cur.rc[1] - v[1][1] * cur.rsn[1];
                f32x4 b0 = v[1][0] * cur.rc[0] + v[0][0] * cur.rsn[0], b1 = v[1][1] * cur.rc[1] + v[0][1] * cur.rsn[1];
                a0 = a0 * qs; a1 = a1 * qs; b0 = b0 * qs; b1 = b1 * qs;
                bf16_t* dst = (bf16_t*)(ws + (pn < 2 ? cfg::WS_Q : cfg::WS_K)) + (size_t)row * 512 + (4 * (pn & 1) + wc) * 64 + 8 * fq;
                st8(dst, a0, a1); st8(dst + 32, b0, b1);
            } else if constexpr (KIND == 1) {
                bf16_t* dst = (bf16_t*)(ws + cfg::WS_V) + (size_t)row * 512 + (pn - 4) * 256 + cw; st8(dst, v[0][0], v[0][1]); st8(dst + 128, v[1][0], v[1][1]);
            } else if constexpr (KIND == 2) {
                bf16_t* dst = (bf16_t*)(ws + cfg::WS_TAB) + (size_t)row * 512 + (pn - 6) * 256 + cw; st8(dst, v[0][0], v[0][1]); st8(dst + 128, v[1][0], v[1][1]);
            } else if constexpr (KIND == 3) {
                bf16_t* dst = (bf16_t*)(ws + cfg::WSB_GQK + (size_t)(u.pm >> 3) * cfg::DLT_GQK) + (size_t)row * 256 + cw; st8(dst, v[0][0] * cfg::GQSCALE, v[0][1] * cfg::GQSCALE); st8(dst + 128, v[1][0], v[1][1]);
            } else if constexpr (KIND == 4) {
                bf16_t* dst = (bf16_t*)(ws + cfg::WSB_GV + (size_t)(u.pm >> 3) * cfg::DLT_GV) + (size_t)row * 256 + cw; st8(dst, v[0][0], v[0][1]); st8(dst + 128, v[1][0], v[1][1]);
            } else if constexpr (KIND == 5) {
                bf16_t* dst = (bf16_t*)(ws + cfg::WSB_GR + (size_t)(u.pm >> 3) * cfg::DLT_GR) + (size_t)row * 256 + cw;
#pragma unroll
                for (int bj = 0; bj < 2; ++bj) { f32x4 x0 = v[bj][0], x1 = v[bj][1];
#pragma unroll
                    for (int e = 0; e < 4; ++e) { x0[e] = fsilu(x0[e]); x1[e] = fsilu(x1[e]); } st8(dst + 128 * bj, x0, x1); }
            } else {
                float* dst = (float*)(ws + cfg::WSB_GL + (size_t)(u.pm >> 3) * cfg::DLT_GL) + (size_t)row * 256 + cw;
#pragma unroll
                for (int bj = 0; bj < 2; ++bj)
#pragma unroll
                    for (int n = 0; n < 2; ++n) { f32x4 x = v[bj][n] + bias[bj][n];
#pragma unroll
                        for (int e = 0; e < 4; ++e) x[e] = flogsig16(x[e]); *(f32x4*)(dst + 128 * bj + 4 * n) = x; }
            }
            if (i < 7) cur = nxt;
        }
    }
    __device__ __forceinline__ void operator()(const f32x4 (&acc)[2][2][4][2], const Unit& u, int wr, int wc, int fr, int fq) const {
        asm volatile("" : "+v"(fr), "+v"(fq));
        unsigned zo = 0u; asm volatile("" : "+s"(zo)); FEpiIn me = *this; me.ws = ws + zo;
        const int pn = u.pn;
        if (pn < 4) me.rows<0>(acc, u, wr, wc, fr, fq); else if (pn < 6) me.rows<1>(acc, u, wr, wc, fr, fq); else if (pn < 8) me.rows<2>(acc, u, wr, wc, fr, fq);
        else if (pn == 8) me.rows<3>(acc, u, wr, wc, fr, fq); else if (pn == 9) me.rows<4>(acc, u, wr, wc, fr, fq); else if (pn == 10) me.rows<5>(acc, u, wr, wc, fr, fq); else me.rows<6>(acc, u, wr, wc, fr, fq);
    }
};
struct FEpiRes {
    static constexpr bool PERM = true, AFTER_DRAIN = false;
    const PG8_LAS float* stprev;
    const float* g; const float* bb; bf16_t* XB; float* ST;
    struct RowLd { u32x4 xb[2]; };
    __device__ __forceinline__ RowLd load_row(int row, int col0, int fq) const {
        RowLd r; const size_t off = (size_t)row * 1024 + col0;
        r.xb[0] = *(const u32x4*)(XB + off); r.xb[1] = *(const u32x4*)(XB + off + 128);
        return r;
    }
    __device__ __forceinline__ void operator()(const f32x4 (&acc)[2][2][4][2], const Unit& u, int wr, int wc, int fr, int fq) const {
        asm volatile("" : "+v"(fr), "+v"(fq));
        const int col0 = u.pn * BM + 32 * wc + 8 * fq, row0 = u.pm * BM + 64 * wr + fr;
        f32x4 gv[2][2], bv[2][2];
        RowLd cur = load_row(row0, col0, fq), nxt;
        if (stprev) {
#pragma unroll
            for (int bj = 0; bj < 2; ++bj)
#pragma unroll
                for (int n = 0; n < 2; ++n) { gv[bj][n] = *(const f32x4*)(g + col0 + 128 * bj + 4 * n); bv[bj][n] = *(const f32x4*)(bb + col0 + 128 * bj + 4 * n); } }
#pragma unroll
        for (int i = 0; i < 8; ++i) { const int ai = i >> 2, m = i & 3, row = row0 + 128 * ai + 16 * m; const size_t off = (size_t)row * 1024 + col0;
            if (i < 7) nxt = load_row(row0 + 128 * ((i + 1) >> 2) + 16 * ((i + 1) & 3), col0, fq);
            RS rs; rs.a = 1.f; rs.b = 0.f; if (stprev) { typedef float f32x2 __attribute__((ext_vector_type(2))); const f32x2 t2 = *(const PG8_LAS f32x2*)(stprev + 2 * (128 * ai + 64 * wr + 16 * m + fr)); rs.a = t2[0]; rs.b = t2[1]; }
            float s = 0.f, ss = 0.f;
#pragma unroll
            for (int bj = 0; bj < 2; ++bj) { f32x4 y[2];
#pragma unroll
                for (int n = 0; n < 2; ++n) { const unsigned w0 = cur.xb[bj][2 * n], w1 = cur.xb[bj][2 * n + 1];
                    f32x4 x = (f32x4){__uint_as_float(w0 << 16), __uint_as_float(w0 & 0xffff0000u), __uint_as_float(w1 << 16), __uint_as_float(w1 & 0xffff0000u)};
                    if (stprev) x = (rs.a * x + rs.b) * gv[bj][n] + bv[bj][n];
                    y[n] = cfg::ALPHA * x + acc[ai][bj][m][n];
                    s += (y[n][0] + y[n][1]) + (y[n][2] + y[n][3]); ss += (y[n][0] * y[n][0] + y[n][1] * y[n][1]) + (y[n][2] * y[n][2] + y[n][3] * y[n][3]); }
                st8nt(XB + off + 128 * bj, y[0], y[1]); }
            s = xadd<16>(s); ss = xadd<16>(ss); s = xadd<32>(s); ss = xadd<32>(ss);
            if (fq == 0) { typedef float f32x2 __attribute__((ext_vector_type(2))); *(f32x2*)(ST + (size_t)row * 32 + (u.pn * 4 + wc) * 2) = (f32x2){s, ss}; }
            if (i < 7) cur = nxt; }
    }
};
struct FEpiGU {
    static constexpr bool PERM = true, AFTER_DRAIN = false;
    const PG8_LAS float* rsl;
    const float* c1; const float* c2; bf16_t* ACT;
    __device__ __forceinline__ void operator()(const f32x4 (&acc)[2][2][4][2], const Unit& u, int wr, int wc, int fr, int fq) const {
        asm volatile("" : "+v"(fr), "+v"(fq));
        const int cw = 32 * wc + 8 * fq, row0 = u.pm * BM + 64 * wr + fr; const float* c1p = c1 + u.pn * 256 + cw; const float* c2p = c2 + u.pn * 256 + cw;
        typedef float f32x2 __attribute__((ext_vector_type(2)));
        f32x4 k1[2][2], k2[2][2];
#pragma unroll
        for (int bj = 0; bj < 2; ++bj)
#pragma unroll
            for (int n = 0; n < 2; ++n) { k1[bj][n] = *(const f32x4*)(c1p + 128 * bj + 4 * n); k2[bj][n] = *(const f32x4*)(c2p + 128 * bj + 4 * n); }
#pragma unroll
        for (int i = 0; i < 8; ++i) { const int ai = i >> 2, m = i & 3; const f32x2 rs = *(const PG8_LAS f32x2*)(rsl + 2 * (128 * ai + 64 * wr + 16 * m + fr)); f32x4 a[2];
#pragma unroll
            for (int n = 0; n < 2; ++n) { const f32x4 hg = rs[0] * acc[ai][0][m][n] + (rs[1] * k1[0][n] + k2[0][n]), hu = rs[0] * acc[ai][1][m][n] + (rs[1] * k1[1][n] + k2[1][n]);
#pragma unroll
                for (int e = 0; e < 4; ++e) a[n][e] = fsilu(hg[e]) * hu[e]; }
            st8nt(ACT + (size_t)(row0 + 128 * ai + 16 * m) * cfg::FF + 128 * u.pn + cw, a[0], a[1]); }
    }
};
struct FEpiFour {
    static constexpr bool PERM = true, AFTER_DRAIN = false;
    bf16_t* OC;
    __device__ __forceinline__ void operator()(const f32x4 (&acc)[2][2][4][2], const Unit& u, int wr, int wc, int fr, int fq) const {
        asm volatile("" : "+v"(fr), "+v"(fq));
        const int cw = 32 * wc + 8 * fq;
#pragma unroll
        for (int ai = 0; ai < 2; ++ai)
#pragma unroll
            for (int m = 0; m < 4; ++m) { const int row = u.pm * BM + 128 * ai + 64 * wr + 16 * m + fr; bf16_t* dst = OC + (size_t)(u.pn * 2048 + row) * 1024 + 512 + cw;
                st8(dst, acc[ai][0][m][0], acc[ai][0][m][1]); st8(dst + 128, acc[ai][1][m][0], acc[ai][1][m][1]); }
    }
};
}
namespace att {
using bf16x8 = __attribute__((ext_vector_type(8))) short;
using s16x4  = __attribute__((ext_vector_type(4))) short;
using f32x16 = __attribute__((ext_vector_type(16))) float;
using u32x4  = __attribute__((ext_vector_type(4))) unsigned;
constexpr int NW = 8, QBLK = 32, KVBLK = 64, LD = 512, NT = cfg::S / KVBLK;
constexpr int SHM_V = KVBLK * 128 * 2, SHM_K = KVBLK * 128 * 2, SHM_X = 2 * SHM_V + 2 * SHM_K, SHM_ATTN = SHM_X + NW * 64 * 4;
constexpr float THRL = 6.0f;
#define ATT_KSWZ(row, colB) ((row) * 256 + ((colB) ^ (((row) & 7) << 4)))
#define ATT_SBAR() __builtin_amdgcn_sched_barrier(0)
__device__ __forceinline__ int crow(int r, int hi) { return (r & 3) + 8 * (r >> 2) + 4 * hi; }
__device__ __forceinline__ unsigned cvtpk(float lo, float hi) { unsigned r; asm volatile("v_cvt_pk_bf16_f32 %0, %1, %2" : "=v"(r) : "v"(lo), "v"(hi)); return r; }
__device__ __forceinline__ void softmaxP(f32x16& p0, f32x16& p1, float& m_reg, float& l_reg, f32x16& negm, float& alpha, bool first, bf16x8& pa0, bf16x8& pa1, bf16x8& pa2, bf16x8& pa3) {
#define ATT_M3(a, b, c) fmaxf(fmaxf(a, b), c)
  const float t0 = ATT_M3(p0[0], p0[1], p0[2]), t1 = ATT_M3(p0[3], p0[4], p0[5]), t2 = ATT_M3(p0[6], p0[7], p0[8]), t3 = ATT_M3(p0[9], p0[10], p0[11]), t4 = ATT_M3(p0[12], p0[13], p0[14]);
  const float t5 = ATT_M3(p0[15], p1[0], p1[1]), t6 = ATT_M3(p1[2], p1[3], p1[4]), t7 = ATT_M3(p1[5], p1[6], p1[7]), t8 = ATT_M3(p1[8], p1[9], p1[10]), t9 = ATT_M3(p1[11], p1[12], p1[13]);
  const float u0 = ATT_M3(t0, t1, t2), u1 = ATT_M3(t3, t4, t5), u2 = ATT_M3(t6, t7, t8), u3 = ATT_M3(t9, p1[14], p1[15]);
  float pmax = fmaxf(fmaxf(u0, u1), fmaxf(u2, u3));
#undef ATT_M3
  { auto rr = __builtin_amdgcn_permlane32_swap(__float_as_uint(pmax), __float_as_uint(pmax), false, false); pmax = fmaxf(__uint_as_float(rr[0]), __uint_as_float(rr[1])); }
  const float thr = first ? -3.0e38f : THRL;
  if (__builtin_expect(__all(pmax <= thr), 1)) { alpha = 1.f; }
  else { const float dl = first ? pmax : fmaxf(pmax, 0.f); alpha = first ? 0.f : __builtin_amdgcn_exp2f(-dl); m_reg += dl;
#pragma unroll
    for (int r = 0; r < 16; ++r) { p0[r] -= dl; p1[r] -= dl; negm[r] -= dl; } }
#pragma unroll
  for (int r = 0; r < 16; ++r) p0[r] = __builtin_amdgcn_exp2f(p0[r]);
#pragma unroll
  for (int r = 0; r < 16; ++r) p1[r] = __builtin_amdgcn_exp2f(p1[r]);
  { float q0 = p0[0] + p1[0], q1 = p0[1] + p1[1], q2 = p0[2] + p1[2], q3 = p0[3] + p1[3];
#pragma unroll
    for (int r = 4; r < 16; r += 4) { q0 += p0[r] + p1[r]; q1 += p0[r + 1] + p1[r + 1]; q2 += p0[r + 2] + p1[r + 2]; q3 += p0[r + 3] + p1[r + 3]; }
    float ps = (q0 + q1) + (q2 + q3);
    auto rr = __builtin_amdgcn_permlane32_swap(__float_as_uint(ps), __float_as_uint(ps), false, false); ps = __uint_as_float(rr[0]) + __uint_as_float(rr[1]);
    l_reg = l_reg * alpha + ps; }
#define ATT_PK4(P, BASE, OUT) do { u32x4 w = {cvtpk(P[BASE + 0], P[BASE + 1]), cvtpk(P[BASE + 2], P[BASE + 3]), cvtpk(P[BASE + 4], P[BASE + 5]), cvtpk(P[BASE + 6], P[BASE + 7])}; \
    OUT = *reinterpret_cast<bf16x8*>(&w); } while (0)
  ATT_PK4(p0, 0, pa0); ATT_PK4(p0, 8, pa1); ATT_PK4(p1, 0, pa2); ATT_PK4(p1, 8, pa3);
#undef ATT_PK4
}
template <int OFF> __device__ __forceinline__ bf16x8 k_read(int ka) { bf16x8 r; asm volatile("ds_read_b128 %0, %1 offset:%2" : "=&v"(r) : "v"(ka), "i"(OFF) : "memory"); return r; }
template <int KB> __device__ __forceinline__ void k_load2(bf16x8* kf, int ka0, int ka1) {
  kf[0] = k_read<KB * SHM_K>(ka0); kf[1] = k_read<KB * SHM_K + 8192>(ka0); kf[2] = k_read<KB * SHM_K>(ka1); kf[3] = k_read<KB * SHM_K + 8192>(ka1);
}
__device__ __forceinline__ void qk_mma2(f32x16& p0, f32x16& p1, const bf16x8* kf, bf16x8 q0, bf16x8 q1) {
  p0 = __builtin_amdgcn_mfma_f32_32x32x16_bf16(kf[0], q0, p0, 0, 0, 0); p1 = __builtin_amdgcn_mfma_f32_32x32x16_bf16(kf[1], q0, p1, 0, 0, 0);
  p0 = __builtin_amdgcn_mfma_f32_32x32x16_bf16(kf[2], q1, p0, 0, 0, 0); p1 = __builtin_amdgcn_mfma_f32_32x32x16_bf16(kf[3], q1, p1, 0, 0, 0);
}
__device__ __forceinline__ int v_st(int k, int c) { return ((k >> 3) * 4 + (c >> 5)) * 512 + ((k & 7) * 32 + (c & 31)) * 2; }
__device__ __forceinline__ int v_rd_base(int lane) { return ((lane & 3) << 3) | (((lane >> 2) & 3) << 6) | (((lane >> 4) & 1) << 5) | (((lane >> 5) & 1) << 8); }
constexpr int v_rd_off(int d0, int ks, int half) { return d0 * 512 + ks * 4096 + half * 2048; }
template <int OFF> __device__ __forceinline__ s16x4 tr_read(int vb) { s16x4 r; asm volatile("ds_read_b64_tr_b16 %0, %1 offset:%2" : "=&v"(r) : "v"(vb), "i"(OFF) : "memory"); return r; }
struct VF { s16x4 l[4], h[4]; };
template <int KS> __device__ __forceinline__ void vf_load(VF& f, int vb) {
  f.l[0] = tr_read<v_rd_off(0, KS, 0)>(vb); f.h[0] = tr_read<v_rd_off(0, KS, 1)>(vb); f.l[1] = tr_read<v_rd_off(1, KS, 0)>(vb); f.h[1] = tr_read<v_rd_off(1, KS, 1)>(vb);
  f.l[2] = tr_read<v_rd_off(2, KS, 0)>(vb); f.h[2] = tr_read<v_rd_off(2, KS, 1)>(vb); f.l[3] = tr_read<v_rd_off(3, KS, 0)>(vb); f.h[3] = tr_read<v_rd_off(3, KS, 1)>(vb);
}
__device__ __forceinline__ void pv_step(f32x16* o, bf16x8 pa, const VF& f) {
#define ATT_PK(L, H) (bf16x8){L[0], L[1], L[2], L[3], H[0], H[1], H[2], H[3]}
  o[0] = __builtin_amdgcn_mfma_f32_32x32x16_bf16(pa, ATT_PK(f.l[0], f.h[0]), o[0], 0, 0, 0);
  o[1] = __builtin_amdgcn_mfma_f32_32x32x16_bf16(pa, ATT_PK(f.l[1], f.h[1]), o[1], 0, 0, 0);
  o[2] = __builtin_amdgcn_mfma_f32_32x32x16_bf16(pa, ATT_PK(f.l[2], f.h[2]), o[2], 0, 0, 0);
  o[3] = __builtin_amdgcn_mfma_f32_32x32x16_bf16(pa, ATT_PK(f.l[3], f.h[3]), o[3], 0, 0, 0);
#undef ATT_PK
}
#define ATT_LWAIT(n) do { asm volatile("s_waitcnt lgkmcnt(" #n ")" ::: "memory"); ATT_SBAR(); } while (0)
template <int MP> __device__ __forceinline__ void att_give(const f32x16* o, float* Xw, int r32, int hi) {
  constexpr int RG = MP ? 0 : 8;
#pragma unroll
  for (int rr = 0; rr < 8; ++rr)
#pragma unroll
    for (int d0 = 0; d0 < 4; ++d0) Xw[(crow(RG + rr, hi) & 15) * 128 + d0 * 32 + r32] = o[d0][RG + rr];
}
template <int MP> __device__ __forceinline__ void att_fin(const f32x16* o, const float* Xr, float lam, const float (&gq)[4], bf16_t* OCw, int r32, int hi, int lane) {
  constexpr int RK = MP ? 8 : 0;
  unsigned pk[8][4];
#pragma unroll
  for (int rr = 0; rr < 8; ++rr) { const int lr = crow(RK + rr, hi) & 15;
    float df[4], ssq = 0.f;
#pragma unroll
    for (int d0 = 0; d0 < 4; ++d0) { const float x = Xr[lr * 128 + d0 * 32 + r32]; df[d0] = MP ? x - lam * o[d0][RK + rr] : o[d0][RK + rr] - lam * x; ssq += df[d0] * df[d0]; }
    ssq = xadd<1>(ssq); ssq = xadd<2>(ssq); ssq = xadd<4>(ssq); ssq = xadd<8>(ssq); ssq = xadd<16>(ssq);
    const float rn = rsqrtf(ssq * (1.f / 128.f) + cfg::EPS);
#pragma unroll
    for (int d0 = 0; d0 < 4; ++d0) pk[rr][d0] = cvtpk(df[d0] * rn * gq[d0], 0.f); }
  char* stg = (char*)Xr;
#pragma unroll
  for (int rr = 0; rr < 8; ++rr) { const int lr = crow(RK + rr, hi) & 15;
#pragma unroll
    for (int d0 = 0; d0 < 4; ++d0) *(unsigned short*)(stg + lr * 272 + (d0 * 32 + r32) * 2) = (unsigned short)pk[rr][d0]; }
#pragma unroll
  for (int i = 0; i < 4; ++i) { const int c = lane + 64 * i, row = c >> 4, cc = c & 15;
    const u32x4 v = *(const u32x4*)(stg + row * 272 + cc * 16); *(u32x4*)(OCw + (size_t)row * 1024 + cc * 8) = v; }
}
__device__ __forceinline__ void attn_unit(int b, int h, int qb, const bf16_t* __restrict__ Qg, const bf16_t* __restrict__ Kg, const bf16_t* __restrict__ Vg, bf16_t* __restrict__ OC,
                                          const float* __restrict__ lamp, const float* __restrict__ dgv, int layer, char* lds) {
  int tid_o = threadIdx.x; asm volatile("" : "+v"(tid_o));
  const int tid = tid_o, wid = __builtin_amdgcn_readfirstlane(tid >> 6), lane = tid & 63, r32 = lane & 31, hi = lane >> 5, mp = wid >> 2, wl = wid & 3, mofs = mp * 64;
  char* V_lds = lds; char* K_lds = lds + 2 * SHM_V;
  float* ws = (float*)(lds + SHM_X) + wid * 64; float* al_l = ws + 32;
  float m_reg = 0.f, l_reg = 0.f; f32x16 o[4] = {}, negm = {}; bf16x8 qr[4];
  const int q0 = qb * 128 + wl * QBLK;
  const bf16_t* Qw = Qg + (size_t)(b * cfg::S + q0 + r32) * LD + h * 128 + mofs + hi * 8;
#pragma unroll
  for (int d0 = 0; d0 < 4; ++d0) qr[d0] = *reinterpret_cast<const bf16x8*>(Qw + d0 * 16);
  const bf16_t* Kh = Kg + (size_t)b * cfg::S * LD + h * 128; const bf16_t* Vh = Vg + (size_t)b * cfg::S * LD + h * 128;
  const int vb0 = (int)(uintptr_t)V_lds + v_rd_base(lane);
  const int ka0 = (int)(uintptr_t)K_lds + ATT_KSWZ(r32, (mofs + hi * 8) * 2);
  const int gt = tid & 255, gr = gt >> 4, gc = (gt & 15) * 8;
  const bf16_t* gsrc = (mp ? Kh : Vh) + (size_t)gr * LD + gc;
  char* gdst = mp ? K_lds + ATT_KSWZ(gr, gc * 2) : V_lds + v_st(gr, gc);
  const int tofs = mp ? 2 : 0;
  bf16x8 st_[2][4];
#define ATT_GLOAD(i, t) do { const int t_ = (t) < NT ? (t) : NT - 1;     \
    _Pragma("unroll") for (int q_ = 0; q_ < 4; ++q_) st_[i][q_] = *reinterpret_cast<const bf16x8*>(gsrc + (size_t)(t_ * 64 + 16 * q_) * LD); } while (0)
#define ATT_GWRITE(i, t) do { asm volatile("s_waitcnt vmcnt(4)" ::: "memory"); if ((t) < NT) { \
    _Pragma("unroll") for (int q_ = 0; q_ < 4; ++q_) *(bf16x8*)(gdst + (i) * 16384 + q_ * 4096) = st_[i][q_]; } } while (0)
#define ATT_RESC(a) do { if (__any((a) < 1.f)) { if (hi == 0) al_l[r32] = (a); asm volatile("s_waitcnt lgkmcnt(0)" ::: "memory"); \
    _Pragma("unroll") for (int r = 0; r < 16; ++r) { const float a_ = al_l[crow(r, hi)]; _Pragma("unroll") for (int d = 0; d < 4; ++d) o[d][r] *= a_; } } } while (0)
  f32x16 s0, s1; float al; bf16x8 pa0, pa1, pa2, pa3, kf[8]; VF f0, f1;
#define ATT_VSEG(I, p) do { ATT_GWRITE(I, (p) + tofs); ATT_GLOAD(I, (p) + tofs + 2); ATT_SBAR(); \
    softmaxP(s0, s1, m_reg, l_reg, negm, al, (p) == 0, pa0, pa1, pa2, pa3); ATT_RESC(al); } while (0)
#define ATT_OL(pa) do { } while (0)
#define ATT_QK(KB) do { k_load2<KB>(kf, ka0, ka0 ^ 32); k_load2<KB>(kf + 4, ka0 ^ 64, ka0 ^ 96); ATT_LWAIT(4); s0 = negm; s1 = negm; qk_mma2(s0, s1, kf, qr[0], qr[1]); ATT_LWAIT(0); qk_mma2(s0, s1, kf + 4, qr[2], qr[3]); ATT_SBAR(); } while (0)
#define ATT_MSEG(VB, KB, QK) do { vf_load<0>(f0, vb0 + (VB) * SHM_V); vf_load<1>(f1, vb0 + (VB) * SHM_V); ATT_SBAR(); \
    ATT_LWAIT(8); pv_step(o, pa0, f0); ATT_OL(pa0); vf_load<2>(f0, vb0 + (VB) * SHM_V); \
    ATT_LWAIT(8); pv_step(o, pa1, f1); ATT_OL(pa1); vf_load<3>(f1, vb0 + (VB) * SHM_V); \
    if constexpr (QK) { k_load2<KB>(kf, ka0, ka0 ^ 32); ATT_LWAIT(12); } else ATT_LWAIT(8); \
    pv_step(o, pa2, f0); ATT_OL(pa2); \
    if constexpr (QK) ATT_LWAIT(4); else ATT_LWAIT(0); \
    pv_step(o, pa3, f1); ATT_OL(pa3); \
    if constexpr (QK) { k_load2<KB>(kf + 4, ka0 ^ 64, ka0 ^ 96); ATT_LWAIT(4); s0 = negm; s1 = negm; qk_mma2(s0, s1, kf, qr[0], qr[1]); ATT_LWAIT(0); qk_mma2(s0, s1, kf + 4, qr[2], qr[3]); } ATT_SBAR(); } while (0)
  { const int kr = tid >> 4, kc = (tid & 15) * 8;
    const bf16x8 k0 = *reinterpret_cast<const bf16x8*>(&Kh[(size_t)kr * LD + kc]), k1 = *reinterpret_cast<const bf16x8*>(&Kh[(size_t)(32 + kr) * LD + kc]);
    const bf16x8 k2 = *reinterpret_cast<const bf16x8*>(&Kh[(size_t)(64 + kr) * LD + kc]), k3 = *reinterpret_cast<const bf16x8*>(&Kh[(size_t)(96 + kr) * LD + kc]);
    ATT_GLOAD(0, tofs); ATT_GLOAD(1, tofs + 1);
    asm volatile("s_waitcnt vmcnt(8)" ::: "memory");
    *(bf16x8*)(K_lds + ATT_KSWZ(kr, kc * 2)) = k0; *(bf16x8*)(K_lds + ATT_KSWZ(32 + kr, kc * 2)) = k1;
    *(bf16x8*)(K_lds + SHM_K + ATT_KSWZ(kr, kc * 2)) = k2; *(bf16x8*)(K_lds + SHM_K + ATT_KSWZ(32 + kr, kc * 2)) = k3; }
  __syncthreads();
  if (mp) __syncthreads();
  ATT_QK(0); __syncthreads();
  for (int p = 0; p + 2 < NT; p += 2) {
    ATT_VSEG(0, p);           __syncthreads();
    ATT_MSEG(0, 1, true);     __syncthreads();
    ATT_VSEG(1, p + 1);       __syncthreads();
    ATT_MSEG(1, 0, true);     __syncthreads();
  }
  ATT_VSEG(0, NT - 2);   __syncthreads();
  ATT_MSEG(0, 1, true);   __syncthreads();
  ATT_VSEG(1, NT - 1);   __syncthreads();
  ATT_MSEG(1, 0, false);  __syncthreads();
  if (!mp) __syncthreads();
  const float lp0 = lamp[lane], lp1 = lamp[64 + lane], lp2 = lamp[128 + lane], lp3 = lamp[192 + lane];
  float gq[4];
#pragma unroll
  for (int d0 = 0; d0 < 4; ++d0) gq[d0] = dgv[d0 * 32 + r32];
  float* li_l = ws; if (hi == 0) li_l[r32] = l_reg; asm volatile("s_waitcnt lgkmcnt(0)" ::: "memory");
#pragma unroll
  for (int r = 0; r < 16; ++r) { const float rl = __builtin_amdgcn_rcpf(li_l[crow(r, hi)]);
#pragma unroll
    for (int d0 = 0; d0 < 4; ++d0) o[d0][r] *= rl; }
  __syncthreads();
  float* X = (float*)lds;
  const float* Xr = X + wid * 2048; float* Xw = X + (wid ^ 4) * 2048;
  int layer_o = __builtin_amdgcn_readfirstlane(layer); asm volatile("" : "+s"(layer_o)); const float lam_init = layer_o == 0 ? 0.2f : 0.35550906759f;
  if (mp == 0) att_give<0>(o, Xw, r32, hi); else att_give<1>(o, Xw, r32, hi);
  float lam; { float s1 = lp0 * lp1, s2 = lp2 * lp3;
    s1 = xadd<1>(s1); s2 = xadd<1>(s2); s1 = xadd<2>(s1); s2 = xadd<2>(s2); s1 = xadd<4>(s1); s2 = xadd<4>(s2); s1 = xadd<8>(s1); s2 = xadd<8>(s2); s1 = xadd<16>(s1); s2 = xadd<16>(s2); s1 = xadd<32>(s1); s2 = xadd<32>(s2);
    lam = __expf(s1) - __expf(s2) + lam_init; }
#pragma unroll
  for (int d0 = 0; d0 < 4; ++d0) gq[d0] *= (1.f - lam_init);
  __syncthreads();
  bf16_t* OCw = OC + (size_t)(b * cfg::S + q0 + 16 * mp) * 1024 + h * 128;
  if (mp == 0) att_fin<0>(o, Xr, lam, gq, OCw, r32, hi, lane); else att_fin<1>(o, Xr, lam, gq, OCw, r32, hi, lane);
  __syncthreads();
#undef ATT_GLOAD
#undef ATT_GWRITE
#undef ATT_VSEG
#undef ATT_MSEG
#undef ATT_RESC
#undef ATT_OL
#undef ATT_QK
}
#undef ATT_KSWZ
#undef ATT_SBAR
}
namespace gla {
using att::bf16x8; using att::s16x4; using att::f32x16; using att::u32x4; using att::crow; using att::cvtpk; using att::tr_read;
typedef float f32x4 __attribute__((ext_vector_type(4)));
typedef unsigned u32x2 __attribute__((ext_vector_type(2)));
#define GLAS __attribute__((address_space(3)))
constexpr int KT_STRIDE = 144;
constexpr int A_KT = 0, A_V = 36864, A_BEND = A_V + 32768;
constexpr int B_QT = 0, B_KT = 32768, B_V = 65536, B_SC = 98304;
__device__ __forceinline__ int v_st64(int k, int c) { const int kk = (k & ~0xC) | ((k & 4) << 1) | ((k & 8) >> 1); return ((kk >> 3) * 2 + (c >> 5)) * 512 + ((kk & 7) * 32 + (c & 31)) * 2; }
constexpr int v_off64(int d0, int ks, int half) { return d0 * 512 + ks * 2048 + half * 1024; }
__device__ __forceinline__ float bf2f_(unsigned short v) { return __uint_as_float((unsigned)v << 16); }
__device__ __forceinline__ void load_v_tile(const bf16_t* __restrict__ src, GLAS unsigned char* dst, int lane) {
    u32x4 tv[8];
#pragma unroll
    for (int i = 0; i < 8; ++i) { const int row = (lane >> 3) + 8 * i, ch = lane & 7; tv[i] = *(const u32x4*)(src + (size_t)row * 256 + ch * 8); }
#pragma unroll
    for (int i = 0; i < 8; ++i) { const int row = (lane >> 3) + 8 * i, ch = lane & 7; *(GLAS u32x4*)(dst + v_st64(row, ch * 8)) = tv[i]; }
}
#define GLA_PK(L, H) (bf16x8){L[0], L[1], L[2], L[3], H[0], H[1], H[2], H[3]}
#define GLA_MM4(o0, o1, vb, AF) do { \
    const s16x4 l00 = tr_read<v_off64(0, 0, 0)>(vb), h00 = tr_read<v_off64(0, 0, 1)>(vb), l01 = tr_read<v_off64(0, 1, 0)>(vb), h01 = tr_read<v_off64(0, 1, 1)>(vb); \
    const s16x4 l02 = tr_read<v_off64(0, 2, 0)>(vb), h02 = tr_read<v_off64(0, 2, 1)>(vb), l03 = tr_read<v_off64(0, 3, 0)>(vb), h03 = tr_read<v_off64(0, 3, 1)>(vb); \
    const s16x4 l10 = tr_read<v_off64(1, 0, 0)>(vb), h10 = tr_read<v_off64(1, 0, 1)>(vb), l11 = tr_read<v_off64(1, 1, 0)>(vb), h11 = tr_read<v_off64(1, 1, 1)>(vb); \
    const s16x4 l12 = tr_read<v_off64(1, 2, 0)>(vb), h12 = tr_read<v_off64(1, 2, 1)>(vb), l13 = tr_read<v_off64(1, 3, 0)>(vb), h13 = tr_read<v_off64(1, 3, 1)>(vb); \
    asm volatile("s_waitcnt lgkmcnt(0)" ::: "memory"); __builtin_amdgcn_sched_barrier(0); \
    o0 = __builtin_amdgcn_mfma_f32_32x32x16_bf16(AF(0), GLA_PK(l00, h00), o0, 0, 0, 0); o1 = __builtin_amdgcn_mfma_f32_32x32x16_bf16(AF(0), GLA_PK(l10, h10), o1, 0, 0, 0); \
    o0 = __builtin_amdgcn_mfma_f32_32x32x16_bf16(AF(1), GLA_PK(l01, h01), o0, 0, 0, 0); o1 = __builtin_amdgcn_mfma_f32_32x32x16_bf16(AF(1), GLA_PK(l11, h11), o1, 0, 0, 0); \
    o0 = __builtin_amdgcn_mfma_f32_32x32x16_bf16(AF(2), GLA_PK(l02, h02), o0, 0, 0, 0); o1 = __builtin_amdgcn_mfma_f32_32x32x16_bf16(AF(2), GLA_PK(l12, h12), o1, 0, 0, 0); \
    o0 = __builtin_amdgcn_mfma_f32_32x32x16_bf16(AF(3), GLA_PK(l03, h03), o0, 0, 0, 0); o1 = __builtin_amdgcn_mfma_f32_32x32x16_bf16(AF(3), GLA_PK(l13, h13), o1, 0, 0, 0); } while (0)
__device__ __forceinline__ bf16x8 afrag_tr(const GLAS unsigned char* row, int ks, int hi) { return *(const GLAS bf16x8*)(row + (16 * ks + 8 * hi) * 2); }

__device__ __forceinline__ void gla_a_item(int b, int h, int g, unsigned char* ws, GLAS unsigned char* lds) {
    int tid_o = threadIdx.x; asm volatile("" : "+v"(tid_o));
    const int tid = tid_o, wave = __builtin_amdgcn_readfirstlane(tid >> 6), lane = tid & 63, r32 = lane & 31, hi = lane >> 5;
    const float* GL = (const float*)(ws + cfg::WSB_GL + (size_t)b * cfg::DLT_GL); const bf16_t* GQK = (const bf16_t*)(ws + cfg::WSB_GQK + (size_t)b * cfg::DLT_GQK); const bf16_t* GV = (const bf16_t*)(ws + cfg::WSB_GV + (size_t)b * cfg::DLT_GV);
    float* KVC = (float*)(ws + cfg::WSB_OF + (size_t)b * cfg::DLT_OF); float* DEC = (float*)(ws + cfg::WS_DEC);
    const size_t tok0 = (size_t)b * 2048 + g * 256;
    GLAS float* bend_s = (GLAS float*)(lds + A_BEND);
    if (wave < 4) {
        const int c = wave, dir = lane >> 5, d = lane & 31;
        const float* gl = GL + (tok0 + c * 64) * 256 + dir * 128 + h * 32 + d; const bf16_t* kp = GQK + (tok0 + c * 64) * 256 + 128 + h * 32 + d;
        GLAS unsigned char* row = lds + A_KT + ((c * 2 + dir) * 32 + d) * KT_STRIDE; float bsum = 0.f; float gA[8], gB[8]; unsigned short kA[8], kB[8];
#define GLA_LOAD(G, K, blk) do { const int t0_ = dir ? 56 - 8 * (blk) : 8 * (blk); _Pragma("unroll") for (int i = 0; i < 8; ++i) { G[i] = gl[(size_t)(t0_ + i) * 256]; K[i] = kp[(size_t)(t0_ + i) * 256]; } } while (0)
#define GLA_PROC(G, K, blk) do { const int t0_ = dir ? 56 - 8 * (blk) : 8 * (blk); float kt[8]; \
            if (dir == 0) { _Pragma("unroll") for (int i = 0; i < 8; ++i) { bsum += G[i]; kt[i] = bf2f_(K[i]) * __expf(-bsum); } } \
            else { _Pragma("unroll") for (int i = 7; i >= 0; --i) { bsum += G[i]; kt[i] = bf2f_(K[i]) * __expf(-bsum); } } \
            u32x4 w; w.x = cvtpk(kt[0], kt[1]); w.y = cvtpk(kt[2], kt[3]); w.z = cvtpk(kt[4], kt[5]); w.w = cvtpk(kt[6], kt[7]); *(GLAS u32x4*)(row + t0_ * 2) = w; } while (0)
        GLA_LOAD(gA, kA, 0);
#pragma unroll
        for (int bp = 0; bp < 4; ++bp) { GLA_LOAD(gB, kB, 2 * bp + 1); GLA_PROC(gA, kA, 2 * bp); if (bp < 3) GLA_LOAD(gA, kA, 2 * bp + 2); GLA_PROC(gB, kB, 2 * bp + 1); }
#undef GLA_LOAD
#undef GLA_PROC
        bend_s[(c * 2 + dir) * 32 + d] = bsum;
        DEC[((size_t)((b * 4 + h) * 32 + g * 4 + c) * 2 + dir) * 32 + d] = __expf(bsum);
    } else { const int c = wave - 4; load_v_tile(GV + (tok0 + c * 64) * 256 + h * 64, lds + A_V + c * 8192, lane); }
    __syncthreads();
    {
        const int c = wave >> 1, dir = wave & 1; f32x16 o0 = {}, o1 = {};
        const int vb = (int)(unsigned)(uintptr_t)(lds + A_V + c * 8192) + att::v_rd_base(lane);
        const GLAS unsigned char* arow = lds + A_KT + ((c * 2 + dir) * 32 + r32) * KT_STRIDE;
#define GLA_AF(ks) afrag_tr(arow, ks, hi)
        GLA_MM4(o0, o1, vb, GLA_AF);
#undef GLA_AF
        float* dst = KVC + ((size_t)((b * 4 + h) * 32 + g * 4 + c) * 2 + dir) * 2048 + r32;
#pragma unroll
        for (int r = 0; r < 16; ++r) { const int d = crow(r, hi); const float sc = __expf(bend_s[(c * 2 + dir) * 32 + d]); dst[d * 64] = o0[r] * sc; dst[d * 64 + 32] = o1[r] * sc; }
    }
    __syncthreads();
}

__device__ __forceinline__ void gla_b_item(int b, int h, int g, unsigned char* ws, const float* __restrict__ gng, bf16_t* __restrict__ OC, GLAS unsigned char* lds) {
    int tid_o = threadIdx.x; asm volatile("" : "+v"(tid_o));
    const int tid = tid_o, wave = __builtin_amdgcn_readfirstlane(tid >> 6), lane = tid & 63, r32 = lane & 31, hi = lane >> 5;
    const float* GL = (const float*)(ws + cfg::WSB_GL + (size_t)b * cfg::DLT_GL); const bf16_t* GQK = (const bf16_t*)(ws + cfg::WSB_GQK + (size_t)b * cfg::DLT_GQK); const bf16_t* GV = (const bf16_t*)(ws + cfg::WSB_GV + (size_t)b * cfg::DLT_GV); const bf16_t* GR = (const bf16_t*)(ws + cfg::WSB_GR + (size_t)b * cfg::DLT_GR);
    const float* KVC = (const float*)(ws + cfg::WSB_OF + (size_t)b * cfg::DLT_OF) + (size_t)((b * 4 + h) * 32) * 2 * 2048; const float* DEC = (const float*)(ws + cfg::WS_DEC) + (size_t)((b * 4 + h) * 32) * 2 * 32;
    const size_t tok0 = (size_t)b * 2048 + g * 256;
    if (wave < 4) {
        const int c = wave, dir = lane >> 5, d = lane & 31;
        const float* gl = GL + (tok0 + c * 64) * 256 + dir * 128 + h * 32 + d; const bf16_t* qp = GQK + (tok0 + c * 64) * 256 + h * 32 + d;
        GLAS unsigned short* qt = (GLAS unsigned short*)(lds + B_QT + c * 8192) + dir * 32 + d;
        GLAS unsigned short* kt = (GLAS unsigned short*)(lds + B_KT + c * 8192 + dir * 4096) + d;
        float bsum = 0.f; float gA[8], gB[8]; unsigned short qA[8], kA[8], qB[8], kB[8];
#define GLB_LOAD(G, Q, K, blk) do { const int t0_ = dir ? 56 - 8 * (blk) : 8 * (blk); _Pragma("unroll") for (int i = 0; i < 8; ++i) { G[i] = gl[(size_t)(t0_ + i) * 256]; Q[i] = qp[(size_t)(t0_ + i) * 256]; K[i] = qp[(size_t)(t0_ + i) * 256 + 128]; } } while (0)
#define GLB_PROC(G, Q, K, blk) do { const int t0_ = dir ? 56 - 8 * (blk) : 8 * (blk); _Pragma("unroll") for (int ii = 0; ii < 8; ++ii) { \
            const float gi = dir ? G[7 - ii] : G[ii], qi = bf2f_(dir ? Q[7 - ii] : Q[ii]), ki = bf2f_(dir ? K[7 - ii] : K[ii]); const int tt = t0_ + (dir ? 7 - ii : ii); \
            bsum += gi; const float e = __expf(bsum), ei = __expf(-bsum); \
            qt[tt * 64] = (unsigned short)(cvtpk(qi * e, 0.f) & 0xffffu); kt[tt * 32] = (unsigned short)(cvtpk(ki * ei, 0.f) & 0xffffu); } } while (0)
        GLB_LOAD(gA, qA, kA, 0);
#pragma unroll
        for (int bp = 0; bp < 4; ++bp) { GLB_LOAD(gB, qB, kB, 2 * bp + 1); GLB_PROC(gA, qA, kA, 2 * bp); if (bp < 3) GLB_LOAD(gA, qA, kA, 2 * bp + 2); GLB_PROC(gB, qB, kB, 2 * bp + 1); }
#undef GLB_LOAD
#undef GLB_PROC
    } else {
        const int c = wave - 4;
        const int t2 = tid - 256, d = t2 >> 3, v8 = (t2 & 7) * 8;
        const float* kvp = KVC + d * 64 + v8; const float* dcp = DEC + d;
        const int F = 4 * g + 3;
        u32x4 tv[8];
#pragma unroll
        for (int i = 0; i < 8; ++i) { const int row = (lane >> 3) + 8 * i, ch = lane & 7; tv[i] = *(const u32x4*)(GV + (tok0 + c * 64) * 256 + h * 64 + (size_t)row * 256 + ch * 8); }
        f32x4 Sf0 = {0.f, 0.f, 0.f, 0.f}, Sf1 = Sf0, Sb0 = Sf0, Sb1 = Sf0;
        f32x4 a0A[8], a1A[8], a0B[8], a1B[8]; float dA[8], dB[8];
#define GLS_IDX(s_) (((s_) < F) ? (s_) * 2 : (31 - ((s_) - F)) * 2 + 1)
#define GLS_ISSUE(A0, A1, DD, s0) do { _Pragma("unroll") for (int j = 0; j < 8; ++j) { const int sc_ = (s0) + j < 34 ? (s0) + j : 33; const int ix_ = GLS_IDX(sc_); \
            A0[j] = *(const f32x4*)(kvp + (size_t)ix_ * 2048); A1[j] = *(const f32x4*)(kvp + (size_t)ix_ * 2048 + 4); DD[j] = dcp[ix_ * 32]; } } while (0)
#define GLS_WRITE(S0, S1, c4_, dofs_) do { u32x4 w; w.x = cvtpk(S0[0], S0[1]); w.y = cvtpk(S0[2], S0[3]); w.z = cvtpk(S1[0], S1[1]); w.w = cvtpk(S1[2], S1[3]); \
            *(GLAS u32x4*)(lds + B_SC + (c4_) * 8192 + v_st64((dofs_) + d, v8)) = w; } while (0)
#define GLS_PROC(A0, A1, DD, s0) do { _Pragma("unroll") for (int j = 0; j < 8; ++j) { const int s_ = (s0) + j; if (s_ < 34) { \
            if (s_ < F) { const int n_ = s_; if (n_ >= 4 * g) GLS_WRITE(Sf0, Sf1, n_ - 4 * g, 0); Sf0 = DD[j] * Sf0 + A0[j]; Sf1 = DD[j] * Sf1 + A1[j]; } \
            else { const int n_ = 31 - (s_ - F); if (n_ <= 4 * g + 3) GLS_WRITE(Sb0, Sb1, n_ - 4 * g, 32); Sb0 = DD[j] * Sb0 + A0[j]; Sb1 = DD[j] * Sb1 + A1[j]; } } } } while (0)
        GLS_ISSUE(a0A, a1A, dA, 0); GLS_ISSUE(a0B, a1B, dB, 8);
#pragma unroll
        for (int i = 0; i < 8; ++i) { const int row = (lane >> 3) + 8 * i, ch = lane & 7; *(GLAS u32x4*)(lds + B_V + c * 8192 + v_st64(row, ch * 8)) = tv[i]; }
        GLS_PROC(a0A, a1A, dA, 0);  GLS_ISSUE(a0A, a1A, dA, 16);
        GLS_PROC(a0B, a1B, dB, 8);  GLS_ISSUE(a0B, a1B, dB, 24);
        GLS_PROC(a0A, a1A, dA, 16); GLS_ISSUE(a0A, a1A, dA, 32);
        GLS_PROC(a0B, a1B, dB, 24);
        GLS_PROC(a0A, a1A, dA, 32);
        GLS_WRITE(Sf0, Sf1, 3, 0); GLS_WRITE(Sb0, Sb1, 0, 32);
#undef GLS_IDX
#undef GLS_ISSUE
#undef GLS_WRITE
#undef GLS_PROC
    }
    __syncthreads();
    {
        const int c = wave >> 1, th = wave & 1, t = 32 * th + r32;
        const GLAS unsigned char* qrow = lds + B_QT + c * 8192 + t * 128;
        f32x16 pf0 = {}, pf1 = {}, pb0 = {}, pb1 = {};
#pragma unroll
        for (int ks = 0; ks < 2; ++ks) {
            const bf16x8 qf = *(const GLAS bf16x8*)(qrow + (16 * ks + 8 * hi) * 2), qb = *(const GLAS bf16x8*)(qrow + (32 + 16 * ks + 8 * hi) * 2);
            const GLAS unsigned char* kf = lds + B_KT + c * 8192 + r32 * 64 + (16 * ks + 8 * hi) * 2; const GLAS unsigned char* kb = kf + 4096;
            pf0 = __builtin_amdgcn_mfma_f32_32x32x16_bf16(*(const GLAS bf16x8*)kf, qf, pf0, 0, 0, 0); pf1 = __builtin_amdgcn_mfma_f32_32x32x16_bf16(*(const GLAS bf16x8*)(kf + 2048), qf, pf1, 0, 0, 0);
            pb0 = __builtin_amdgcn_mfma_f32_32x32x16_bf16(*(const GLAS bf16x8*)kb, qb, pb0, 0, 0, 0); pb1 = __builtin_amdgcn_mfma_f32_32x32x16_bf16(*(const GLAS bf16x8*)(kb + 2048), qb, pb1, 0, 0, 0);
        }
#pragma unroll
        for (int r = 0; r < 16; ++r) { const int j0 = crow(r, hi), j1 = 32 + j0;
            pf0[r] = (j0 <= t ? pf0[r] : 0.f) + (j0 >= t ? pb0[r] : 0.f); pf1[r] = (j1 <= t ? pf1[r] : 0.f) + (j1 >= t ? pb1[r] : 0.f); }
        bf16x8 pa0, pa1, pa2, pa3;
#define GLA_PK4(P, BASE, OUT) do { unsigned a0 = cvtpk(P[BASE + 0], P[BASE + 1]), a1 = cvtpk(P[BASE + 2], P[BASE + 3]); unsigned b0 = cvtpk(P[BASE + 4], P[BASE + 5]), b1 = cvtpk(P[BASE + 6], P[BASE + 7]); \
    auto r0 = __builtin_amdgcn_permlane32_swap(a0, b0, false, false); auto r1 = __builtin_amdgcn_permlane32_swap(a1, b1, false, false); \
    u32x4 w = {r0[0], r1[0], r0[1], r1[1]}; OUT = *reinterpret_cast<bf16x8*>(&w); } while (0)
        GLA_PK4(pf0, 0, pa0); GLA_PK4(pf0, 8, pa1); GLA_PK4(pf1, 0, pa2); GLA_PK4(pf1, 8, pa3);
#undef GLA_PK4
        f32x16 o0 = {}, o1 = {};
        { const int vb = (int)(unsigned)(uintptr_t)(lds + B_V + c * 8192) + att::v_rd_base(lane);
#define GLA_AF(ks) ((ks) == 0 ? pa0 : (ks) == 1 ? pa1 : (ks) == 2 ? pa2 : pa3)
          GLA_MM4(o0, o1, vb, GLA_AF);
#undef GLA_AF
        }
        { const int vb = (int)(unsigned)(uintptr_t)(lds + B_SC + c * 8192) + att::v_rd_base(lane);
#define GLA_AF(ks) afrag_tr(qrow, ks, hi)
          GLA_MM4(o0, o1, vb, GLA_AF);
#undef GLA_AF
        }
        const float g0 = gng[r32], g1 = gng[32 + r32];
        const bf16_t* grb = GR + (tok0 + c * 64 + 32 * th) * 256 + h * 64 + r32; unsigned short gq0[16], gq1[16];
#pragma unroll
        for (int r = 0; r < 16; ++r) { gq0[r] = grb[(size_t)crow(r, hi) * 256]; gq1[r] = grb[(size_t)crow(r, hi) * 256 + 32]; }
#pragma unroll
        for (int r = 0; r < 16; ++r) {
            float ssq = o0[r] * o0[r] + o1[r] * o1[r];
            ssq = xadd<1>(ssq); ssq = xadd<2>(ssq); ssq = xadd<4>(ssq); ssq = xadd<8>(ssq); ssq = xadd<16>(ssq);
            const float rn = rsqrtf(ssq * (1.f / 64.f) + cfg::EPS);
            const size_t tok = tok0 + c * 64 + 32 * th + crow(r, hi);
            bf16_t* dst = OC + tok * 1024 + 768 + h * 64 + r32;
            dst[0] = (bf16_t)(cvtpk(o0[r] * rn * g0 * bf2f_(gq0[r]), 0.f) & 0xffffu); dst[32] = (bf16_t)(cvtpk(o1[r] * rn * g1 * bf2f_(gq1[r]), 0.f) & 0xffffu);
        }
    }
    __syncthreads();
}
#undef GLA_MM4
#undef GLA_PK
#undef GLAS
}
namespace fft {
using att::bf16x8; using att::s16x4; using att::f32x16; using att::u32x4; using att::crow; using att::cvtpk; using att::tr_read;
#define FLAS __attribute__((address_space(3)))
__device__ __forceinline__ int img_off(int k, int c) { const int kk = (k & ~0xC) | ((k & 4) << 1) | ((k & 8) >> 1); return ((kk >> 3) * 8 + (c >> 5)) * 512 + ((kk & 7) * 32 + (c & 31)) * 2; }
constexpr int rd_off(int ks, int half) { return ks * 8192 + half * 4096; }
#define FFT_PK(L, H) (bf16x8){L[0], L[1], L[2], L[3], H[0], H[1], H[2], H[3]}
typedef float f32x2_t __attribute__((ext_vector_type(2))); typedef __bf16 bf16x2_t __attribute__((ext_vector_type(2)));
__device__ __forceinline__ unsigned pk2f(float a, float b) { f32x2_t v = {a, b}; bf16x2_t r = __builtin_convertvector(v, bf16x2_t); return __builtin_bit_cast(unsigned, r); }

__device__ __forceinline__ void stage1_load(u32x4 (&tv)[4], int b, int s2, const bf16_t* __restrict__ FX) {
    int tid = threadIdx.x; asm volatile("" : "+v"(tid));
#pragma unroll
    for (int i = 0; i < 4; ++i) { const int p = tid + 512 * i, k = p >> 5, c8 = (p & 31) * 8; tv[i] = *(const u32x4*)(FX + (size_t)(b * 2048 + 64 * (k & 31) + s2) * 512 + (k >> 5) * 256 + c8); }
}
__device__ __forceinline__ void stage1_item(int b, int s2, const u32x4 (&tv)[4], bf16_t* __restrict__ I1, FLAS unsigned char* lds) {
    int tid_o = threadIdx.x; asm volatile("" : "+v"(tid_o));
    const int tid = tid_o, wave = __builtin_amdgcn_readfirstlane(tid >> 6), lane = tid & 63, r32 = lane & 31, hi = lane >> 5;
    bf16x8 F1[2][4];
#pragma unroll
    for (int ks = 0; ks < 4; ++ks) { float cr[8], ci[8];
#pragma unroll
        for (int j = 0; j < 8; ++j) { const int k = 16 * ks + 8 * hi + j, s1 = k & 31; const float rev = (float)((r32 * s1) & 31) * (1.f / 32.f); const float c = __builtin_amdgcn_cosf(rev), sn = __builtin_amdgcn_sinf(rev);
            const bool p1 = (k >> 5) != 0; cr[j] = p1 ? -sn : c; ci[j] = p1 ? -c : -sn; }
        u32x4 wr = {pk2f(cr[0], cr[1]), pk2f(cr[2], cr[3]), pk2f(cr[4], cr[5]), pk2f(cr[6], cr[7])}, wi = {pk2f(ci[0], ci[1]), pk2f(ci[2], ci[3]), pk2f(ci[4], ci[5]), pk2f(ci[6], ci[7])};
        F1[0][ks] = *reinterpret_cast<bf16x8*>(&wr); F1[1][ks] = *reinterpret_cast<bf16x8*>(&wi); }
    {
#pragma unroll
      for (int i = 0; i < 4; ++i) { const int p = tid + 512 * i, k = p >> 5, c8 = (p & 31) * 8; *(FLAS u32x4*)(lds + img_off(k, c8)) = tv[i]; } }
    __syncthreads();
    f32x16 re = {}, im = {};
    { const int vb = (int)(unsigned)(uintptr_t)lds + att::v_rd_base(lane) + wave * 512;
      const s16x4 l0 = tr_read<rd_off(0, 0)>(vb), h0 = tr_read<rd_off(0, 1)>(vb), l1 = tr_read<rd_off(1, 0)>(vb), h1 = tr_read<rd_off(1, 1)>(vb);
      const s16x4 l2 = tr_read<rd_off(2, 0)>(vb), h2 = tr_read<rd_off(2, 1)>(vb), l3 = tr_read<rd_off(3, 0)>(vb), h3 = tr_read<rd_off(3, 1)>(vb);
      asm volatile("s_waitcnt lgkmcnt(0)" ::: "memory"); __builtin_amdgcn_sched_barrier(0);
      re = __builtin_amdgcn_mfma_f32_32x32x16_bf16(F1[0][0], FFT_PK(l0, h0), re, 0, 0, 0); im = __builtin_amdgcn_mfma_f32_32x32x16_bf16(F1[1][0], FFT_PK(l0, h0), im, 0, 0, 0);
      re = __builtin_amdgcn_mfma_f32_32x32x16_bf16(F1[0][1], FFT_PK(l1, h1), re, 0, 0, 0); im = __builtin_amdgcn_mfma_f32_32x32x16_bf16(F1[1][1], FFT_PK(l1, h1), im, 0, 0, 0);
      re = __builtin_amdgcn_mfma_f32_32x32x16_bf16(F1[0][2], FFT_PK(l2, h2), re, 0, 0, 0); im = __builtin_amdgcn_mfma_f32_32x32x16_bf16(F1[1][2], FFT_PK(l2, h2), im, 0, 0, 0);
      re = __builtin_amdgcn_mfma_f32_32x32x16_bf16(F1[0][3], FFT_PK(l3, h3), re, 0, 0, 0); im = __builtin_amdgcn_mfma_f32_32x32x16_bf16(F1[1][3], FFT_PK(l3, h3), im, 0, 0, 0); }
    bf16_t* dst = I1 + (size_t)(b * 32) * 128 * 256 + (size_t)s2 * 256 + 32 * wave + r32;
#pragma unroll
    for (int r = 0; r < 16; ++r) { const int k1 = crow(r, hi); const float rev = (float)((k1 * s2) & 2047) * (1.f / 2048.f); const float ct = __builtin_amdgcn_cosf(rev), st = __builtin_amdgcn_sinf(rev);
        const float ar = re[r] * ct + im[r] * st, ai = im[r] * ct - re[r] * st; const unsigned w = pk2f(ar, ai);
        dst[(size_t)k1 * 128 * 256] = (bf16_t)(w & 0xffffu); dst[(size_t)k1 * 128 * 256 + 64 * 256] = (bf16_t)(w >> 16); }
    __syncthreads();
}

__device__ __forceinline__ void stage2_item(int b, int k1, const bf16_t* __restrict__ I1, bf16_t* __restrict__ OC, FLAS unsigned char* lds) {
    int tid_o = threadIdx.x; asm volatile("" : "+v"(tid_o));
    const int tid = tid_o, wave = __builtin_amdgcn_readfirstlane(tid >> 6), lane = tid & 63, r32 = lane & 31, hi = lane >> 5;
    const bf16_t* src = I1 + (size_t)(b * 32 + k1) * 128 * 256;
    { u32x4 tv[8];
#pragma unroll
      for (int i = 0; i < 8; ++i) { const int p = tid + 512 * i, k = p >> 5, c8 = (p & 31) * 8; tv[i] = *(const u32x4*)(src + (size_t)k * 256 + c8); }
#pragma unroll
      for (int i = 0; i < 8; ++i) { const int p = tid + 512 * i, k = p >> 5, c8 = (p & 31) * 8; *(FLAS u32x4*)(lds + img_off(k, c8)) = tv[i]; } }
    f32x16 y0 = {}, y1 = {};
    __syncthreads();
    const int vb = (int)(unsigned)(uintptr_t)lds + att::v_rd_base(lane) + wave * 512, vb2 = vb + 32768;
    bf16x8 F2[2][8];
#pragma unroll
    for (int ks = 0; ks < 8; ++ks) { float c0[8], c1[8];
#pragma unroll
        for (int j = 0; j < 8; ++j) { const int k = 16 * ks + 8 * hi + j, s2 = k & 63; const float r0 = (float)((r32 * s2) & 63) * (1.f / 64.f), r1 = (float)(((32 + r32) * s2) & 63) * (1.f / 64.f);
            c0[j] = (k >> 6) ? __builtin_amdgcn_sinf(r0) : __builtin_amdgcn_cosf(r0); c1[j] = (k >> 6) ? __builtin_amdgcn_sinf(r1) : __builtin_amdgcn_cosf(r1); }
        u32x4 w0 = {pk2f(c0[0], c0[1]), pk2f(c0[2], c0[3]), pk2f(c0[4], c0[5]), pk2f(c0[6], c0[7])}, w1 = {pk2f(c1[0], c1[1]), pk2f(c1[2], c1[3]), pk2f(c1[4], c1[5]), pk2f(c1[6], c1[7])};
        F2[0][ks] = *reinterpret_cast<bf16x8*>(&w0); F2[1][ks] = *reinterpret_cast<bf16x8*>(&w1); }
#define FFT_STEP(ks) do { \
      const s16x4 lo_ = tr_read<rd_off((ks) & 3, 0)>((ks) < 4 ? vb : vb2), hi_ = tr_read<rd_off((ks) & 3, 1)>((ks) < 4 ? vb : vb2); asm volatile("s_waitcnt lgkmcnt(0)" ::: "memory"); __builtin_amdgcn_sched_barrier(0); \
      y0 = __builtin_amdgcn_mfma_f32_32x32x16_bf16(F2[0][ks], FFT_PK(lo_, hi_), y0, 0, 0, 0); y1 = __builtin_amdgcn_mfma_f32_32x32x16_bf16(F2[1][ks], FFT_PK(lo_, hi_), y1, 0, 0, 0); } while (0)
    FFT_STEP(0); FFT_STEP(1); FFT_STEP(2); FFT_STEP(3); FFT_STEP(4); FFT_STEP(5); FFT_STEP(6); FFT_STEP(7);
#undef FFT_STEP
    bf16_t* dst = OC + (size_t)(b * 2048 + k1) * 1024 + 512 + 32 * wave + r32;
#pragma unroll
    for (int r = 0; r < 16; ++r) { const int k2 = crow(r, hi); const unsigned w = pk2f(y0[r], y1[r]);
        dst[(size_t)(32 * k2) * 1024] = (bf16_t)(w & 0xffffu); dst[(size_t)(32 * (32 + k2)) * 1024] = (bf16_t)(w >> 16); }
    __syncthreads();
}
#undef FFT_PK
#undef FLAS
}
namespace pro {
#define PLAS __attribute__((address_space(3)))
typedef float f32x4 __attribute__((ext_vector_type(4)));
typedef unsigned u32x4 __attribute__((ext_vector_type(4)));
__device__ __forceinline__ unsigned pk2(float lo, float hi) { unsigned r; asm volatile("v_cvt_pk_bf16_f32 %0, %1, %2" : "=v"(r) : "v"(lo), "v"(hi)); return r; }
__device__ __forceinline__ float lo_f(unsigned w) { return __uint_as_float(w << 16); }
__device__ __forceinline__ float hi_f(unsigned w) { return __uint_as_float(w & 0xffff0000u); }
template <bool SUMS, int STRIDE> __device__ __forceinline__ void tile_emit(int K, bf16_t* WT, const float* gain, const float* lnb, float (&a1)[4], float (&a2)[4], const PLAS float* scr, int lane) {
    const int c = lane & 7; float gk[8], bk[8];
#pragma unroll
    for (int q = 0; q < 8; ++q) { gk[q] = gain ? gain[8 * c + q] : 1.f; bk[q] = lnb ? lnb[8 * c + q] : 0.f; }
#pragma unroll
    for (int j = 0; j < 4; ++j) { const int n = (lane >> 3) + 8 * j; const PLAS float* s = scr + (8 * c) * STRIDE + n; float v[8];
#pragma unroll
        for (int q = 0; q < 8; ++q) v[q] = s[q * STRIDE];
        u32x4 o; o.x = pk2(v[0] * gk[0], v[1] * gk[1]); o.y = pk2(v[2] * gk[2], v[3] * gk[3]); o.z = pk2(v[4] * gk[4], v[5] * gk[5]); o.w = pk2(v[6] * gk[6], v[7] * gk[7]);
        *(u32x4*)(WT + (size_t)n * K + 8 * c) = o;
        if (SUMS) { float p1 = (lo_f(o.x) + hi_f(o.x)) + (lo_f(o.y) + hi_f(o.y)) + (lo_f(o.z) + hi_f(o.z)) + (lo_f(o.w) + hi_f(o.w)); float p2 = 0.f;
#pragma unroll
            for (int q = 0; q < 8; ++q) p2 += bk[q] * v[q];
            p1 = xadd<1>(p1); p2 = xadd<1>(p2); p1 = xadd<2>(p1); p2 = xadd<2>(p2); p1 = xadd<4>(p1); p2 = xadd<4>(p2);
            a1[j] += p1; a2[j] += p2; }
    }
    asm volatile("s_waitcnt lgkmcnt(0)" ::: "memory");
}
__device__ __forceinline__ void tile_dma(const float* W, int N, PLAS float* scr, int lane) {
    const float* src = W + (size_t)(lane >> 3) * N + (lane & 7) * 4;
#pragma unroll
    for (int i = 0; i < 8; ++i) __builtin_amdgcn_global_load_lds((const unsigned*)(src + (size_t)(8 * i) * N), (PLAS unsigned*)(scr + i * 256), 16, 0, 0);
}
template <bool SUMS, class Val> __device__ __forceinline__ void tile_item(const Val& val, int K, bf16_t* WT, const float* gain, const float* lnb, float (&a1)[4], float (&a2)[4], PLAS float* scr, int lane) {
#pragma unroll 2
    for (int i = 0; i < 32; ++i) { const int kk = 2 * i + (lane >> 5); scr[kk * 33 + (lane & 31)] = val(kk, lane & 31); }
    asm volatile("s_waitcnt lgkmcnt(0)" ::: "memory");
    tile_emit<SUMS, 33>(K, WT, gain, lnb, a1, a2, scr, lane);
}
struct ValPlain { static constexpr int BATCH = 32; const float* W; int N; __device__ __forceinline__ float operator()(int kk, int j) const { return W[(size_t)kk * N + j]; } };
struct ValGate { static constexpr int BATCH = 2; const float* W; const float* w2; __device__ __forceinline__ float operator()(int kk, int j) const {
    const float* wr = W + (size_t)kk * cfg::INW; float a = 0.f;
#pragma unroll
    for (int r = 0; r < 16; ++r) a += wr[r] * w2[r * 128 + j]; return a; } };

__device__ __forceinline__ void fold_item(int item, unsigned char* ws, const float* w_in, const float* fw, const float* lng, const float* lnb, PLAS unsigned char* lds, int tid) {
    const int l = item >> 5, g = (item >> 3) & 3, part = (item >> 2) & 1, kq = item & 3;
    PLAS float* M = (PLAS float*)lds;
    { const int c = tid >> 3, e0 = (tid & 7) * 8; float acc[8];
#pragma unroll
      for (int q = 0; q < 8; ++q) acc[q] = 0.f;
      const float* w = fw + (size_t)((l * 4 + g) * 64) * 64 + e0;
      for (int k2 = 0; k2 < 64; ++k2) { float rev = (float)((k2 * c) & 63) * (1.f / 64.f); asm volatile("" : "+v"(rev)); const float tr = part ? __builtin_amdgcn_sinf(rev) : __builtin_amdgcn_cosf(rev);
          const f32x4 w0 = *(const f32x4*)(w + k2 * 64), w1 = *(const f32x4*)(w + k2 * 64 + 4);
#pragma unroll
          for (int q = 0; q < 4; ++q) { acc[q] += tr * w0[q]; acc[4 + q] += tr * w1[q]; } }
      const float sc = 0.00276213586400995f;
#pragma unroll
      for (int q = 0; q < 8; ++q) M[c * 64 + e0 + q] = acc[q] * sc; }
    __syncthreads();
    PLAS float* Wl = (PLAS float*)(lds + 16384);
    { const float* wsrc = w_in + ((size_t)l * 1024 + kq * 256) * cfg::INW + 1536 + 64 * g; f32x4 tv[8];
#pragma unroll
      for (int i = 0; i < 8; ++i) tv[i] = *(const f32x4*)(wsrc + (size_t)((tid >> 4) + 32 * i) * cfg::INW + (tid & 15) * 4);
#pragma unroll
      for (int i = 0; i < 8; ++i) *(PLAS f32x4*)(Wl + ((tid >> 4) + 32 * i) * 64 + (tid & 15) * 4) = tv[i]; }
    __syncthreads();
    { const int e = tid & 63, kg = tid >> 6, k0 = kq * 256 + kg * 32, np = 1536 + part * 256 + g * 64 + e; float mc[64];
#pragma unroll
      for (int c = 0; c < 64; ++c) mc[c] = M[c * 64 + e];
      bf16_t* dst = (bf16_t*)(ws + cfg::WS_WIN + l * cfg::SZ_WIN) + (size_t)np * 1024 + k0; float s1 = 0.f, s2 = 0.f;
      for (int kb = 0; kb < 4; ++kb) { float o[8];
#pragma unroll
          for (int q = 0; q < 8; ++q) { const int k = k0 + kb * 8 + q; const PLAS f32x4* wr = (const PLAS f32x4*)(Wl + (kg * 32 + kb * 8 + q) * 64); float a = 0.f;
#pragma unroll
              for (int c4 = 0; c4 < 16; ++c4) { const f32x4 w4 = wr[c4]; a += w4[0] * mc[4 * c4] + w4[1] * mc[4 * c4 + 1] + w4[2] * mc[4 * c4 + 2] + w4[3] * mc[4 * c4 + 3]; }
              o[q] = a * (lng ? lng[k] : 1.f); s2 += lnb ? lnb[k] * a : 0.f; }
          u32x4 w; w.x = pk2(o[0], o[1]); w.y = pk2(o[2], o[3]); w.z = pk2(o[4], o[5]); w.w = pk2(o[6], o[7]); *(u32x4*)(dst + kb * 8) = w;
          s1 += (lo_f(w.x) + hi_f(w.x)) + (lo_f(w.y) + hi_f(w.y)) + (lo_f(w.z) + hi_f(w.z)) + (lo_f(w.w) + hi_f(w.w)); }
      __syncthreads();
      PLAS float* red = (PLAS float*)lds; red[(kg * 64 + e) * 2] = s1; red[(kg * 64 + e) * 2 + 1] = s2;
      __syncthreads();
      if (kg == 0) { float t1 = 0.f, t2 = 0.f;
#pragma unroll
          for (int w = 0; w < 8; ++w) { t1 += red[(w * 64 + e) * 2]; t2 += red[(w * 64 + e) * 2 + 1]; }
          float* fp = (float*)(ws + cfg::V_MF) + (size_t)((l * 4 + kq) * 2) * 512 + part * 256 + g * 64 + e; fp[0] = t1; fp[512] = t2; } }
    __syncthreads();
}

struct Inputs { const float *x, *w_in, *fw, *gw2, *w_out, *ln1g, *ln1b, *wg, *wu, *wd, *ln2g, *ln2b; };
__device__ __forceinline__ void prologue(unsigned char* ws, const Inputs& in, PLAS unsigned char* lds, int vcu, int G) {
    int tid_o = threadIdx.x; asm volatile("" : "+v"(tid_o));
    const int tid = tid_o, wave = __builtin_amdgcn_readfirstlane(tid >> 6), lane = tid & 63;
    const float* x = in.x; const float* w_in = in.w_in; const float* fw = in.fw; const float* gw2 = in.gw2; const float* w_out = in.w_out; const float* ln1g = in.ln1g; const float* ln1b = in.ln1b;
    const float* wg = in.wg; const float* wu = in.wu; const float* wd = in.wd; const float* ln2g = in.ln2g; const float* ln2b = in.ln2b;
    if (vcu < 64) { const int l = vcu >> 5; fold_item(vcu, ws, w_in, fw, l ? ln2g : (const float*)nullptr, l ? ln2b : (const float*)nullptr, lds, tid); }
    PLAS float* scr = (PLAS float*)(lds + wave * 16384); PLAS float* scr1 = scr + 2048; PLAS float* redw = (PLAS float*)(lds + 131072 + 1024 + wave * 256);
    const int gw = vcu * 8 + wave, NGW = G * 8;
    for (int it = vcu; it < 512; it += G) {
        const int l = it >> 8, r = it & 255; float a1[4] = {0.f, 0.f, 0.f, 0.f}, a2[4] = {0.f, 0.f, 0.f, 0.f}; float* c1o; float* c2o;
        const int k0 = wave * 64, k1 = k0 + 512;
        if (r < 80) { const int nb = r; const float* lngb = l ? ln2g : (const float*)nullptr; const float* lnbb = l ? ln2b : (const float*)nullptr;
            bf16_t* Wt = (bf16_t*)(ws + cfg::WS_WIN + l * cfg::SZ_WIN);
            if (nb < 72) { int np0, src;
                if (nb < 32) { const int pn = nb >> 3, p = (nb & 7) * 32, wc = (p >> 5) & 3, bj = p >> 7; np0 = pn * 256 + p; src = (pn >> 1) * 512 + (pn & 1) * 256 + 64 * wc + 32 * bj; }
                else if (nb < 48) { np0 = 1024 + (nb - 32) * 32; src = np0; }
                else { np0 = 2048 + (nb - 48) * 32; src = 1792 + (nb - 48) * 32; }
                tile_dma(w_in + ((size_t)l * 1024 + k0) * cfg::INW + src, cfg::INW, scr, lane); tile_dma(w_in + ((size_t)l * 1024 + k1) * cfg::INW + src, cfg::INW, scr1, lane);
                asm volatile("s_waitcnt vmcnt(0)" ::: "memory");
                tile_emit<true, 32>(1024, Wt + (size_t)np0 * 1024 + k0, lngb ? lngb + k0 : lngb, lnbb ? lnbb + k0 : lnbb, a1, a2, scr, lane);
                tile_emit<true, 32>(1024, Wt + (size_t)np0 * 1024 + k1, lngb ? lngb + k1 : lngb, lnbb ? lnbb + k1 : lnbb, a1, a2, scr1, lane);
                c1o = (float*)(ws + cfg::V_C1IN) + l * cfg::NIN + np0; c2o = (float*)(ws + cfg::V_C2IN) + l * cfg::NIN + np0;
            } else { const int p0 = (nb - 72) * 32, dir = p0 >> 7, kk0 = p0 & 127, np0 = 2816 + p0;
                for (int kb = wave; kb < 16; kb += 8) { const int kq = kb * 64; ValGate v{w_in + ((size_t)l * 1024 + kq) * cfg::INW + 2560 + 16 * dir, gw2 + (size_t)((l * 2 + dir) * 16) * 128 + kk0};
                    tile_item<true>(v, 1024, Wt + (size_t)np0 * 1024 + kq, lngb ? lngb + kq : lngb, lnbb ? lnbb + kq : lnbb, a1, a2, scr, lane); }
                c1o = (float*)(ws + cfg::V_C1IN) + l * cfg::NIN + np0; c2o = (float*)(ws + cfg::V_C2IN) + l * cfg::NIN + np0; }
        } else { const int nb = r - 80, np0 = nb * 32, pn = np0 >> 8, p = np0 & 255, bj = p >> 7, f0 = 128 * pn + (p & 127);
            const float* W = (bj ? wu : wg) + (size_t)l * 1024 * cfg::FF + f0; bf16_t* Wt = (bf16_t*)(ws + cfg::WS_WGU + l * cfg::SZ_WGU) + (size_t)np0 * 1024;
            tile_dma(W + (size_t)k0 * cfg::FF, cfg::FF, scr, lane); tile_dma(W + (size_t)k1 * cfg::FF, cfg::FF, scr1, lane);
            asm volatile("s_waitcnt vmcnt(0)" ::: "memory");
            tile_emit<true, 32>(1024, Wt + k0, ln1g + l * 1024 + k0, ln1b + l * 1024 + k0, a1, a2, scr, lane);
            tile_emit<true, 32>(1024, Wt + k1, ln1g + l * 1024 + k1, ln1b + l * 1024 + k1, a1, a2, scr1, lane);
            c1o = (float*)(ws + cfg::V_C1GU) + l * cfg::NGU + np0; c2o = (float*)(ws + cfg::V_C2GU) + l * cfg::NGU + np0; }
        if ((lane & 7) == 0) {
#pragma unroll
            for (int j = 0; j < 4; ++j) { const int n = (lane >> 3) + 8 * j; redw[n * 2] = a1[j]; redw[n * 2 + 1] = a2[j]; } }
        __syncthreads();
        if (wave == 0 && lane < 32) { float t1 = 0.f, t2 = 0.f;
#pragma unroll
            for (int w = 0; w < 8; ++w) { const PLAS float* rw = (const PLAS float*)(lds + 131072 + 1024 + w * 256); t1 += rw[lane * 2]; t2 += rw[lane * 2 + 1]; }
            c1o[lane] = t1; c2o[lane] = t2; }
        __syncthreads();
    }
    constexpr int I_OUT = 32 * 16, I_DN = 32 * 44, I_L = I_OUT + I_DN;
    for (int it = gw; it < 2 * I_L; it += 2 * NGW) {
        const float* Ws[2]; int Ns[2], Ks[2]; bf16_t* Wd[2]; float d1[4], d2[4];
#pragma unroll
        for (int q = 0; q < 2; ++q) { const int itq = it + q * NGW; const int ic = itq < 2 * I_L ? itq : it; const int l = ic / I_L; int r = ic - l * I_L;
            if (r < I_OUT) { const int nb = r >> 4, kb = r & 15, k0 = kb * 64, n0 = nb * 32; Ws[q] = w_out + ((size_t)l * 1024 + k0) * 1024 + n0; Ns[q] = 1024; Ks[q] = 1024;
                Wd[q] = (bf16_t*)(ws + cfg::WS_WOUT + l * cfg::SZ_WOUT) + (size_t)n0 * 1024 + k0; }
            else { r -= I_OUT; const int nb = r / 44, kb = r - nb * 44, k0 = kb * 64, n0 = nb * 32; Ws[q] = wd + ((size_t)l * cfg::FF + k0) * 1024 + n0; Ns[q] = 1024; Ks[q] = cfg::FF;
                Wd[q] = (bf16_t*)(ws + cfg::WS_WDN + l * cfg::SZ_WDN) + (size_t)n0 * cfg::FF + k0; } }
        tile_dma(Ws[0], Ns[0], scr, lane); tile_dma(Ws[1], Ns[1], scr1, lane);
        asm volatile("s_waitcnt vmcnt(0)" ::: "memory");
        tile_emit<false, 32>(Ks[0], Wd[0], (const float*)nullptr, (const float*)nullptr, d1, d2, scr, lane);
        if (it + NGW < 2 * I_L) tile_emit<false, 32>(Ks[1], Wd[1], (const float*)nullptr, (const float*)nullptr, d1, d2, scr1, lane);
    }
    const int xw = (vcu - 64) * 8 + wave, NXW = (G - 64) * 8;
    if (vcu >= 64 && G > 64)
    for (int m = xw; m < cfg::T; m += 4 * NXW) {
        f32x4 v[4][4];
#pragma unroll
        for (int q = 0; q < 4; ++q) { const int mr = (m + q * NXW) < cfg::T ? (m + q * NXW) : m; const f32x4* xr = (const f32x4*)(x + (size_t)mr * 1024) + lane;
#pragma unroll
            for (int j = 0; j < 4; ++j) v[q][j] = xr[64 * j]; }
#pragma unroll
        for (int q = 0; q < 4; ++q) { const int mr = (m + q * NXW) < cfg::T ? (m + q * NXW) : m; unsigned long long* o8 = (unsigned long long*)((bf16_t*)(ws + cfg::WS_XB) + (size_t)mr * 1024) + lane;
#pragma unroll
            for (int j = 0; j < 4; ++j) o8[64 * j] = (unsigned long long)pk2(v[q][j][0], v[q][j][1]) | ((unsigned long long)pk2(v[q][j][2], v[q][j][3]) << 32); } }
    for (int i = gw * 64 + lane; i < 2048 * 32; i += NGW * 64) { const int pos = i >> 5, f = i & 31; const float inv = exp2f(-(float)f * (13.287712379549449f / 32.f)); const float ang = (float)pos * inv;
        double rv = (double)ang * 0.15915494309189535; rv -= floor(rv); const float rev = (float)rv;
        ((float*)(ws + cfg::V_ROPEC))[i] = __builtin_amdgcn_cosf(rev); ((float*)(ws + cfg::V_ROPES))[i] = __builtin_amdgcn_sinf(rev); }
}
#undef PLAS
}
constexpr int NWAVES = 8;
constexpr int RING_OFF = 0, RING_BYTES = 131072;
constexpr int LDSCTL_OFF = RING_BYTES, MISC_OFF = LDSCTL_OFF + 320;
constexpr int RSL_OFF = 131072 + 4096;
constexpr int LDS_BYTES = 147456;
constexpr int CW_BAR = 4096;
constexpr int CW_GBAR = 8192, GBAR_STRIDE = 4096;
constexpr size_t CTL_ZERO_BYTES = 192 * 1024;
#define GAS __attribute__((address_space(1)))
#define LAS __attribute__((address_space(3)))
typedef GAS unsigned gu32;
#define RLX_AGENT __ATOMIC_RELAXED, __HIP_MEMORY_SCOPE_AGENT
#define XB_TMO      128
#define XB_XCNT(j)  (256  + 64 * (j))
#define XB_XSUB(j)  (1280 + 64 * (j))
#define XB_XGEN(j)  (2304 + 64 * (j))
#define XB_TOP      3328
#define XB_TOPGEN   3392
#define XCD_BAR_WORDS 3456
#define XB_SPIN_CAP (1u << 18)

__device__ __forceinline__ unsigned xb_ld(unsigned* p)              { return __hip_atomic_load(p, __ATOMIC_RELAXED, __HIP_MEMORY_SCOPE_AGENT); }
__device__ __forceinline__ unsigned xb_add(unsigned* p, unsigned v) { return __hip_atomic_fetch_add(p, v, __ATOMIC_RELAXED, __HIP_MEMORY_SCOPE_AGENT); }
__device__ __forceinline__ unsigned xb_xcc_id() { return (unsigned)__builtin_amdgcn_s_getreg((3 << 11) | 20) & 0xFu; }
#define XB_SPIN(cond, bar) do { unsigned _sp = 0; while (cond) { __builtin_amdgcn_s_sleep(1); \
    if ((++_sp & 255u) == 0u) { if (xb_ld(&(bar)[XB_TMO])) break; if (_sp > XB_SPIN_CAP) { atomicAdd(&(bar)[XB_TMO], 1u); break; } } } } while (0)

struct XcdBarrier {
    unsigned* bar; unsigned x; unsigned total;
    volatile LAS unsigned* st;
};

__device__ __forceinline__ XcdBarrier xcd_barrier_post(unsigned* bar, volatile LAS unsigned* st, unsigned total) {
    XcdBarrier b; b.bar = bar; b.x = xb_xcc_id(); b.st = st; b.total = total;
    if (threadIdx.x == 0) (void)xb_add(&bar[XB_XCNT(b.x)], 1u);
    return b;
}
__device__ __forceinline__ void xcd_barrier_complete(unsigned* bar, unsigned x, unsigned G, unsigned& nloc, unsigned& nx) {
    unsigned sum, cnt, mine, sp = 0u;
    for (;;) {
        sum = 0u; cnt = 0u; mine = 0u;
#pragma unroll
        for (unsigned j = 0; j < 16; ++j) { const unsigned c = xb_ld(&bar[XB_XCNT(j)]); sum += c; cnt += (c > 0u) ? 1u : 0u; mine = (j == x) ? c : mine; }
        if (sum == G) break;
        __builtin_amdgcn_s_sleep(1);
        if ((++sp & 255u) == 0u) { if (xb_ld(&bar[XB_TMO])) break; if (sp > XB_SPIN_CAP) { atomicAdd(&bar[XB_TMO], 1u); break; } }
    }
    nloc = mine > 0u ? mine : 1u; nx = cnt > 0u ? cnt : 1u;
}

__device__ __forceinline__ void xcd_barrier(const XcdBarrier& b) {
    asm volatile("s_waitcnt vmcnt(0)" ::: "memory");
    __syncthreads();
    if (threadIdx.x == 0) {
        unsigned* bar = b.bar;
        __builtin_amdgcn_s_waitcnt(0);
        unsigned nloc = b.st[0], nx = b.st[1];
        if (nloc == 0u) { xcd_barrier_complete(bar, b.x, b.total, nloc, nx); b.st[0] = nloc; b.st[1] = nx; }
        const unsigned old = xb_add(&bar[XB_XSUB(b.x)], 1u);
        const unsigned gen = old / nloc;
        if (old + 1u == (gen + 1u) * nloc) {
            __builtin_amdgcn_fence(__ATOMIC_RELEASE, "agent");
            asm volatile("s_waitcnt vmcnt(0)" ::: "memory");
            const unsigned og = xb_add(&bar[XB_TOP], 1u);
            const unsigned tg = og / nx;
            if (og + 1u == (tg + 1u) * nx) xb_add(&bar[XB_TOPGEN], 1u);
            else XB_SPIN(xb_ld(&bar[XB_TOPGEN]) == tg, bar);
            __builtin_amdgcn_fence(__ATOMIC_ACQUIRE, "agent");
            xb_add(&bar[XB_XGEN(b.x)], 1u);
            asm volatile("s_waitcnt vmcnt(0)" ::: "memory");
        } else {
            XB_SPIN(xb_ld(&bar[XB_XGEN(b.x)]) == gen, bar);
            __builtin_amdgcn_fence(__ATOMIC_ACQUIRE, "agent");
            asm volatile("s_waitcnt vmcnt(0)" ::: "memory");
        }
    }
    __syncthreads();
}


#define FILL_RSL(STP) do { pg8::Unit u0_; if (S.next(0, u0_)) { int tq_ = threadIdx.x; asm volatile("" : "+v"(tq_)); const int row_ = u0_.pm * 256 + (tq_ >> 1), hf_ = tq_ & 1; \
    typedef float f32x4_ __attribute__((ext_vector_type(4))); typedef float f32x2_ __attribute__((ext_vector_type(2))); \
    const f32x4_* sp_ = (const f32x4_*)((STP) + (size_t)row_ * 32 + hf_ * 16); const f32x4_ x0 = sp_[0], x1 = sp_[1], x2 = sp_[2], x3 = sp_[3]; \
    float sm_ = ((x0[0] + x0[2]) + (x1[0] + x1[2])) + ((x2[0] + x2[2]) + (x3[0] + x3[2])), sq_ = ((x0[1] + x0[3]) + (x1[1] + x1[3])) + ((x2[1] + x2[3]) + (x3[1] + x3[3])); \
    sm_ = xadd<1>(sm_); sq_ = xadd<1>(sq_); const float mu_ = sm_ * (1.f / 1024.f), rstd_ = rsqrtf(fmaxf(sq_ * (1.f / 1024.f) - mu_ * mu_, 0.f) + EPS); \
    if (hf_ == 0) *(LAS f32x2_*)(ldsl + RSL_OFF + 8 * (tq_ >> 1)) = (f32x2_){rstd_, -rstd_ * mu_}; } \
    __syncthreads(); } while (0)

enum { PH_PRO = 0, PH_IN = 1, PH_ATT = 2, PH_MIXB = 3, PH_OUT = 4, PH_GU = 5, PH_DN = 6, PH_FIN = 13, N_PHASES = 14 };
struct MArgs { const float* in[16]; float* out; unsigned char* ws; int ph_lo, ph_hi, li, pad; };

__global__ void __launch_bounds__(NWAVES * 64, 2) mk_fwd(MArgs a) {
    extern __shared__ __attribute__((aligned(128))) unsigned char lds[];
    LAS unsigned char* ldsl = (LAS unsigned char*)lds;
    volatile LAS unsigned* MISC = (volatile LAS unsigned*)(ldsl + MISC_OFF);
    const int tid = threadIdx.x;
    const int G = gridDim.x, bx = blockIdx.x, vcu = (G % 8 == 0) ? (bx % 8) * (G / 8) + bx / 8 : bx;
    unsigned char* ws = a.ws;
    for (int u = tid; u < (LDS_BYTES - LDSCTL_OFF) / 4; u += NWAVES * 64) ((LAS unsigned*)(ldsl + LDSCTL_OFF))[u] = 0u;
    __syncthreads();
    XcdBarrier bar; bar.bar = (unsigned*)(ws + WS_CTL) + CW_BAR + a.li * XCD_BAR_WORDS; bar.x = 0; bar.st = nullptr; bar.total = (unsigned)G;
    if (a.ph_hi - a.ph_lo > 1) bar = xcd_barrier_post((unsigned*)(ws + WS_CTL) + CW_BAR + a.li * XCD_BAR_WORDS, MISC + 8, (unsigned)G);
    const bool grp_ok = (G % 8 == 0) && (a.ph_hi - a.ph_lo > 1);
    XcdBarrier gbar = bar;
    if (grp_ok) gbar = xcd_barrier_post((unsigned*)(ws + WS_CTL) + CW_GBAR + (bx & 7) * GBAR_STRIDE, MISC + 10, (unsigned)(G / 8));
    const int G0 = G, bx0 = bx, vcu0 = vcu; unsigned char* const ws0 = ws;
    for (int ph = a.ph_lo; ph < a.ph_hi; ++ph) {
        int G = G0, bx = bx0, vcu = vcu0; unsigned zo = 0u; asm volatile("" : "+s"(G), "+s"(bx), "+s"(vcu), "+s"(zo)); unsigned char* ws = ws0 + zo;
        const int l = (ph >= 1 && ph <= 12) ? (ph - 1) / 6 : 0;
        const int kind = (ph == 0) ? PH_PRO : (ph == PH_FIN ? PH_FIN : 1 + (ph - 1) % 6);
        if (kind == PH_PRO) {
            { pro::Inputs pin{a.in[0], a.in[1], a.in[4], a.in[5], a.in[8], a.in[9], a.in[10], a.in[11], a.in[12], a.in[13], a.in[14], a.in[15]}; pro::prologue(ws, pin, ldsl + RING_OFF, vcu, G); }
        } else if (kind == PH_IN) {
            pg8::Gemm g{(const bf16_t*)(ws + WS_XB), (const bf16_t*)(ws + WS_WIN + l * SZ_WIN), T, NIN, D}; pg8::StaticOrder S; S.init(T, NIN, G, bx);
            if (l) FILL_RSL((const float*)(ws + WS_ST2));
            pg8::FEpiIn E{ws, a.in[6] + l * 256, l, (const LAS float*)(ldsl + RSL_OFF)};
            pg8::gemm_phase<pg8::FEpiIn, pg8::StaticOrder, true, true>(ldsl + RING_OFF, g, S, E);
        } else if (kind == PH_ATT) {
            for (int i = 0; i < 2; ++i) { const int idx = vcu * 2 + i; if (idx >= 512) break; const int bh = idx >> 4, qb = idx & 15;
                att::attn_unit(bh >> 2, bh & 3, qb, (const bf16_t*)(ws + WS_Q), (const bf16_t*)(ws + WS_K), (const bf16_t*)(ws + WS_V), (bf16_t*)(ws + WSB_OC + (size_t)(bh >> 2) * DLT_OC), a.in[2] + l * 256, a.in[3] + l * 128, l, (char*)lds + RING_OFF); }
            if (vcu * 2 + 1 < 512) {
                typedef unsigned u32x4_ __attribute__((ext_vector_type(4))); u32x4_ tva[4], tvb[4]; const int ia = vcu * 2, ib = ia + 1;
                fft::stage1_load(tva, ia >> 6, ia & 63, (const bf16_t*)(ws + WS_TAB)); fft::stage1_load(tvb, ib >> 6, ib & 63, (const bf16_t*)(ws + WS_TAB));
                fft::stage1_item(ia >> 6, ia & 63, tva, (bf16_t*)(ws + WS_XT), ldsl + RING_OFF); fft::stage1_item(ib >> 6, ib & 63, tvb, (bf16_t*)(ws + WS_XT), ldsl + RING_OFF); }
            if (vcu < 256) gla::gla_a_item(vcu >> 5, (vcu >> 3) & 3, vcu & 7, ws, ldsl + RING_OFF);
        } else if (kind == PH_MIXB) {
            if (vcu < 256) fft::stage2_item(vcu >> 5, vcu & 31, (const bf16_t*)(ws + WS_XT), (bf16_t*)(ws + WSB_OC + (size_t)(vcu >> 5) * DLT_OC), ldsl + RING_OFF);
            if (vcu < 256) gla::gla_b_item(vcu >> 5, (vcu >> 3) & 3, vcu & 7, ws, a.in[7] + l * 64, (bf16_t*)(ws + WSB_OC + (size_t)(vcu >> 5) * DLT_OC), ldsl + RING_OFF);
        } else if (kind == PH_OUT) {
            pg8::Gemm g{(const bf16_t*)(ws + WSB_OC + (size_t)(bx & 7) * DLT_OC), (const bf16_t*)(ws + WS_WOUT + l * SZ_WOUT), T, D, D}; pg8::StaticOrder S; S.init(T, D, G, bx);
            if (l) FILL_RSL((const float*)(ws + WS_ST2));
            pg8::FEpiRes E{l ? (const LAS float*)(ldsl + RSL_OFF) : (const LAS float*)nullptr, a.in[14] + (l ? l - 1 : 0) * 1024, a.in[15] + (l ? l - 1 : 0) * 1024, (bf16_t*)(ws + WS_XB), (float*)(ws + WS_ST1)};
            pg8::gemm_phase<pg8::FEpiRes, pg8::StaticOrder, true, true>(ldsl + RING_OFF, g, S, E);
        } else if (kind == PH_GU) {
            pg8::Gemm g{(const bf16_t*)(ws + WS_XB), (const bf16_t*)(ws + WS_WGU + l * SZ_WGU), T, NGU, D}; pg8::StaticOrder S; S.init(T, NGU, G, bx);
            FILL_RSL((const float*)(ws + WS_ST1));
            pg8::FEpiGU E{(const LAS float*)(ldsl + RSL_OFF), (const float*)(ws + V_C1GU) + l * NGU, (const float*)(ws + V_C2GU) + l * NGU, (bf16_t*)(ws + WS_ACT)};
            pg8::gemm_phase<pg8::FEpiGU, pg8::StaticOrder, true, true>(ldsl + RING_OFF, g, S, E);
        } else if (kind == PH_DN) {
            pg8::Gemm g{(const bf16_t*)(ws + WS_ACT), (const bf16_t*)(ws + WS_WDN + l * SZ_WDN), T, D, FF}; pg8::StaticOrder S; S.init(T, D, G, bx);
            FILL_RSL((const float*)(ws + WS_ST1));
            pg8::FEpiRes E{(const LAS float*)(ldsl + RSL_OFF), a.in[9] + l * 1024, a.in[10] + l * 1024, (bf16_t*)(ws + WS_XB), (float*)(ws + WS_ST2)};
            pg8::gemm_phase<pg8::FEpiRes, pg8::StaticOrder, true, true>(ldsl + RING_OFF, g, S, E);
        } else if (kind == PH_FIN) {
            const float* g2 = a.in[14] + 1024; const float* b2v = a.in[15] + 1024; const float* ST2 = (const float*)(ws + WS_ST2); const bf16_t* XB = (const bf16_t*)(ws + WS_XB); float* Y2 = a.out;
            int tid_f = threadIdx.x; asm volatile("" : "+v"(tid_f)); const int lane = tid_f & 63, wave = __builtin_amdgcn_readfirstlane(tid_f >> 6);
            typedef float f32x4 __attribute__((ext_vector_type(4))); typedef unsigned u32x2 __attribute__((ext_vector_type(2)));
            f32x4 gg[4], bq[4];
#pragma unroll
            for (int j = 0; j < 4; ++j) { gg[j] = *((const f32x4*)g2 + lane + 64 * j); bq[j] = *((const f32x4*)b2v + lane + 64 * j); }
            const bool grp_rows = (G % 8 == 0) && (S % ((G / 8) * NWAVES) == 0);
            const int r_first = grp_rows ? (bx & 7) * S + (bx >> 3) * NWAVES + wave : vcu * NWAVES + wave, r_step = grp_rows ? (G / 8) * NWAVES : G * NWAVES, r_end = grp_rows ? (bx & 7) * S + S : T;
            for (int row = r_first; row < r_end; row += r_step) { const RowStat rs = row_stat(ST2, row);
                const u32x2* xr = (const u32x2*)(XB + (size_t)row * 1024) + lane; f32x4* yr = (f32x4*)(Y2 + (size_t)row * 1024) + lane;
#pragma unroll
                for (int j = 0; j < 4; ++j) { const u32x2 w = xr[64 * j]; const f32x4 v = {__uint_as_float(w.x << 16), __uint_as_float(w.x & 0xffff0000u), __uint_as_float(w.y << 16), __uint_as_float(w.y & 0xffff0000u)};
                    yr[64 * j] = (v - rs.mu) * rs.rstd * gg[j] + bq[j]; } }
        }
        if (ph + 1 < a.ph_hi) { const bool local = grp_ok && kind != PH_PRO; if (local) xcd_barrier(gbar); else xcd_barrier(bar); }
    }
}

static void launch_frame(const MArgs& base, int lo, int hi, int grid, hipStream_t stream, int li = 0) {
    MArgs a = base; a.ph_lo = lo; a.ph_hi = hi; a.li = li;
    hipLaunchKernelGGL(mk_fwd, dim3(grid), dim3(NWAVES * 64), LDS_BYTES, stream, a);
}
extern "C" void kernel_launch(void* const* d_in, const int* in_sizes, int n_in, void* d_out, int out_size, void* d_ws, size_t ws_size, hipStream_t stream) {
    static int grid = 0;
    if (grid == 0) {
        if (n_in != 16 || in_sizes[0] != T * D || out_size != T * D || ws_size < WS_END) { fprintf(stderr, "kernel_launch: unexpected shapes (n_in %d, in0 %d, out %d, ws %zu)\n", n_in, n_in > 0 ? in_sizes[0] : -1, out_size, ws_size); grid = -1; return; }
        int dev = 0, cus = 0, per_cu = 0;
        if (hipGetDevice(&dev) != hipSuccess || hipDeviceGetAttribute(&cus, hipDeviceAttributeMultiprocessorCount, dev) != hipSuccess) { grid = -1; return; }
        if (hipFuncSetAttribute((const void*)mk_fwd, hipFuncAttributeMaxDynamicSharedMemorySize, LDS_BYTES) != hipSuccess) { fprintf(stderr, "kernel_launch: hipFuncSetAttribute failed\n"); grid = -1; return; }
        if (hipOccupancyMaxActiveBlocksPerMultiprocessor(&per_cu, (const void*)mk_fwd, NWAVES * 64, LDS_BYTES) != hipSuccess || per_cu < 1) { fprintf(stderr, "kernel_launch: occupancy query says %d workgroups per CU\n", per_cu); per_cu = 1; }
        (void)hipGetLastError();
        grid = cus;
        if (grid != 256) { fprintf(stderr, "kernel_launch: this kernel's work split is built for the 256 CUs of an MI355X, found %d; nothing launched\n", cus); grid = -1; return; }
    }
    if (grid < 0) return;
    const float* x = (const float*)d_in[0]; const float* w_in = (const float*)d_in[1]; const float* dlam = (const float*)d_in[2]; const float* dng = (const float*)d_in[3];
    const float* fw = (const float*)d_in[4]; const float* gw2 = (const float*)d_in[5]; const float* gb2 = (const float*)d_in[6]; const float* gng = (const float*)d_in[7];
    const float* w_out = (const float*)d_in[8]; const float* ln1g = (const float*)d_in[9]; const float* ln1b = (const float*)d_in[10];
    const float* wg = (const float*)d_in[11]; const float* wu = (const float*)d_in[12]; const float* wd = (const float*)d_in[13]; const float* ln2g = (const float*)d_in[14]; const float* ln2b = (const float*)d_in[15];
    char* ws = (char*)d_ws;
    float* ropec = (float*)(ws + V_ROPEC); float* ropes = (float*)(ws + V_ROPES); float* MF = (float*)(ws + V_MF);
    float* c1in = (float*)(ws + V_C1IN); float* c2in = (float*)(ws + V_C2IN); float* c1gu = (float*)(ws + V_C1GU); float* c2gu = (float*)(ws + V_C2GU);
    bf16_t* TAB = (bf16_t*)(ws + WS_TAB); bf16_t* XB = (bf16_t*)(ws + WS_XB);
    bf16_t* Q = (bf16_t*)(ws + WS_Q); bf16_t* K = (bf16_t*)(ws + WS_K); bf16_t* V = (bf16_t*)(ws + WS_V);
    bf16_t* GQK = (bf16_t*)(ws + WS_GQK); bf16_t* GV = (bf16_t*)(ws + WS_GV); bf16_t* GR = (bf16_t*)(ws + WS_GR); float* GL = (float*)(ws + WS_GL);
    bf16_t* OC = (bf16_t*)(ws + WS_OC); float* OF = (float*)(ws + WS_OF);
    (void)hipMemsetAsync(ws + WS_CTL, 0, CTL_ZERO_BYTES, stream);
    MArgs base{}; for (int i = 0; i < 16; ++i) base.in[i] = (const float*)d_in[i]; base.out = (float*)d_out; base.ws = (unsigned char*)d_ws;
    launch_frame(base, 0, N_PHASES, grid, stream, 0);
}
```

```cpp
#include <hip/hip_runtime.h>
#include <cstdint>
#include <cstdio>
#include <cmath>

typedef unsigned short bf16_t;
namespace cfg {
constexpr int B = 8, S = 2048, D = 1024, T = B * S, L = 2;
constexpr int INW = 2592, NIN = 3072, FF = 2816, NGU = 2 * FF;
constexpr float ALPHA = 1.41421356237309515f;
constexpr float EPS = 1e-5f;
constexpr float QSCALE = 0.125f * 1.4426950408889634f;
constexpr float GQSCALE = 0.17677669529663687f;
constexpr size_t MiB = 1u << 20;
constexpr size_t WS_CTL = 0;
constexpr size_t WS_VEC = 1 * MiB;
constexpr size_t V_ROPEC = WS_VEC, V_ROPES = WS_VEC + 256 * 1024, V_MF = WS_VEC + 512 * 1024;
constexpr size_t V_C1IN = WS_VEC + 768 * 1024, V_C2IN = V_C1IN + 24 * 1024, V_C1GU = V_C2IN + 24 * 1024, V_C2GU = V_C1GU + 44 * 1024;
constexpr size_t WS_WIN = 2 * MiB, WS_WOUT = 14 * MiB, WS_WGU = 18 * MiB, WS_WDN = 40 * MiB, WS_TAB = 51 * MiB;
constexpr size_t SZ_WIN = 6 * MiB, SZ_WOUT = 2 * MiB, SZ_WGU = 11 * MiB, SZ_WDN = 5632 * 1024;
constexpr size_t WS_XB = 67 * MiB;
constexpr size_t WS_Y1 = 99 * MiB, WS_Q = 99 * MiB, WS_K = 115 * MiB, WS_V = 131 * MiB, WS_XT = 147 * MiB;
constexpr size_t WS_ACT = 163 * MiB, WS_GQK = 163 * MiB, WS_GV = 171 * MiB, WS_GR = 179 * MiB, WS_GL = 187 * MiB, WS_OC = 203 * MiB, WS_OF = 235 * MiB;
constexpr size_t WSB_GQK = WS_ACT, WSB_GV = WS_ACT + 1 * MiB, WSB_GR = WS_ACT + 2 * MiB, WSB_GL = WS_ACT + 3 * MiB, WSB_OC = WS_ACT + 5 * MiB, WSB_OF = WS_ACT + 9 * MiB;
constexpr size_t DLT_GQK = 10 * MiB, DLT_GV = 10 * MiB, DLT_GR = 10 * MiB, DLT_GL = 9 * MiB, DLT_OC = 7 * MiB, DLT_OF = 9 * MiB;
constexpr size_t WS_ST1 = 251 * MiB, WS_ST2 = 253 * MiB, WS_DEC = 255 * MiB, WS_END = 256 * MiB;
}
using namespace cfg;

__device__ __forceinline__ float bf2f(bf16_t v) { return __uint_as_float((unsigned)v << 16); }
__device__ __forceinline__ bf16_t f2bf(float f) { unsigned u = __float_as_uint(f); return (bf16_t)((u + 0x7fffu + ((u >> 16) & 1u)) >> 16); }


template <int M> __device__ __forceinline__ float xadd(float v) {
    if constexpr (M == 32) { auto r = __builtin_amdgcn_permlane32_swap(__float_as_uint(v), __float_as_uint(v), false, false); return __uint_as_float(r[0]) + __uint_as_float(r[1]); }
    else return v + __int_as_float(__builtin_amdgcn_ds_swizzle(__float_as_int(v), (M << 10) | 0x1f));
}
struct RowStat { float mu, rstd; };
__device__ __forceinline__ RowStat row_stat(const float* ST, int row) {
    float s = 0.f, ss = 0.f;
    for (int i = 0; i < 8; ++i) { const float4 a = *(const float4*)(ST + (size_t)row * 32 + 4 * i); s += a.x + a.z; ss += a.y + a.w; }
    const float mu = s * (1.f / 1024.f); const float var = ss * (1.f / 1024.f) - mu * mu;
    RowStat r; r.mu = mu; r.rstd = rsqrtf(fmaxf(var, 0.f) + EPS); return r;
}
namespace pg8 {
#define PG8_LAS __attribute__((address_space(3)))
typedef unsigned short bf16_t;
typedef short bf16x8 __attribute__((ext_vector_type(8)));
typedef float f32x4 __attribute__((ext_vector_type(4)));
typedef unsigned u32x4 __attribute__((ext_vector_type(4)));
constexpr int BM = 256, BK = 64, HALF = 128, HTB = HALF * BK * 2  , STAGE_BYTES = 8 * HTB, NXCD = 8, WGM = 8;

__host__ __device__ __forceinline__ int lds_byte(int r, int c) { const int st = (r >> 4) * 2 + (c >> 5), rr = r & 15, cc = c & 31, ob = rr * 64 + cc * 2; return st * 1024 + (ob ^ (((ob >> 9) & 1) << 5)); }
__host__ __device__ __forceinline__ void stage_rc(int b, int& R, int& C) { const int st = b / 1024, sb = b % 1024, swz = sb ^ (((sb >> 9) & 1) << 5); R = (st >> 1) * 16 + swz / 64; C = (st & 1) * 32 + (swz % 64) / 2; }
__host__ __device__ __forceinline__ int perm32(int rho) { const int n = rho >> 4, i = rho & 15; return 8 * (i >> 2) + 4 * n + (i & 3); }

struct Unit { int pm, pn; };
struct Gemm { const bf16_t* A; const bf16_t* Bt; int M, N, K; };

struct StaticOrder {
    int nM, nN, nwg, G, c;
    __host__ __device__ void init(int M, int N, int G_, int c_) { nM = M / BM; nN = N / BM; nwg = nM * nN; G = G_; c = c_; }
    __host__ __device__ bool next(int i, Unit& u) const {
        const long L = (long)i * G + c; if (L >= nwg) return false;
        int wgid = (int)L; { const int q = nwg / NXCD, r = nwg % NXCD, xcd = wgid % NXCD, off = wgid / NXCD; wgid = (xcd < r ? xcd * (q + 1) : r * (q + 1) + (xcd - r) * q) + off; }
        const int nig = WGM * nN, gid = wgid / nig, fm = gid * WGM, gsz = (nM - fm) < WGM ? (nM - fm) : WGM;
        u.pm = fm + ((wgid % nig) % gsz); u.pn = (wgid % nig) / gsz; return true;
    }
    __device__ __forceinline__ void a_ready(const Unit&) const {}
    __device__ __forceinline__ void done(const Unit&) const {}
};
template <class Epi, class Sched, bool ALIGN_EPI = false, bool SP2 = false>
__device__ __forceinline__ void gemm_phase(PG8_LAS unsigned char* lds, const Gemm g, const Sched& S, const Epi& E) {
    int tid_o = threadIdx.x; asm volatile("" : "+v"(tid_o));
    const int tid = tid_o, wid = __builtin_amdgcn_readfirstlane(tid >> 6), lane = tid & 63, wr = wid >> 2, wc = wid & 3, fr = lane & 15, fq = lane >> 4;
    const int K = g.K, nt = K / BK;
    unsigned voffA[2], voffB[2];
#pragma unroll
    for (int i = 0; i < 2; ++i) { int R, C; stage_rc(tid * 16 + i * 8192, R, C); const int Rb = Epi::PERM ? ((R & ~31) + perm32(R & 31)) : R;
        voffA[i] = (unsigned)(R * K + C) * 2u; voffB[i] = (unsigned)(Rb * K + C) * 2u; }
    const size_t kstep = (size_t)(BK * 2);
    const size_t hstep = (size_t)HALF * K * 2;
    const size_t tstep = 2 * hstep;
    const unsigned ldsw = (unsigned)wid * 1024u;
    const int aoff = lds_byte(wr * 64 + fr, fq * 8), boff = lds_byte(wc * 32 + fr, fq * 8);
#define PG8_SA(b, h) (((b) * 2 + (h)) * HTB)
#define PG8_SB(b, h) ((4 + (b) * 2 + (h)) * HTB)
#define PG8_STAGE(bufoff, gbase, voff) do { _Pragma("unroll") for (int _i = 0; _i < 2; ++_i) \
        __builtin_amdgcn_global_load_lds((const unsigned*)((const char*)(gbase) + (voff)[_i]), (PG8_LAS unsigned*)(lds + (bufoff) + ldsw + _i * 8192), 16, 0, 0); } while (0)
#define PG8_LDA(dst, b, h) do { _Pragma("unroll") for (int m = 0; m < 4; ++m) _Pragma("unroll") for (int k = 0; k < 2; ++k) dst[m][k] = *(const PG8_LAS bf16x8*)(lds + PG8_SA(b, h) + aoff + m * 2048 + k * 1024); } while (0)
#define PG8_LDB(dst, b, h) do { _Pragma("unroll") for (int n = 0; n < 2; ++n) _Pragma("unroll") for (int k = 0; k < 2; ++k) dst[n][k] = *(const PG8_LAS bf16x8*)(lds + PG8_SB(b, h) + boff + n * 2048 + k * 1024); } while (0)
#define PG8_MMA(ai, bj, At, Bt) do { __builtin_amdgcn_s_setprio(1); _Pragma("unroll") for (int m = 0; m < 4; ++m) _Pragma("unroll") for (int n = 0; n < 2; ++n) _Pragma("unroll") for (int k = 0; k < 2; ++k) \
        acc[ai][bj][m][n] = __builtin_amdgcn_mfma_f32_16x16x32_bf16(Bt[n][k], At[m][k], acc[ai][bj][m][n], 0, 0, 0); __builtin_amdgcn_s_setprio(0); } while (0)
#define PG8_WAIT_V(n) asm volatile("s_waitcnt vmcnt(" #n ")" ::: "memory")
#define PG8_WAIT_L(n) asm volatile("s_waitcnt lgkmcnt(" #n ")" ::: "memory")
#define PG8_BAR __builtin_amdgcn_s_barrier()
#define PG8_SCHED __builtin_amdgcn_sched_barrier(0)
    Unit cur, nxt; int ui = 0;
    if (!S.next(0, cur)) return;
    f32x4 acc[2][2][4][2];
#pragma unroll
    for (int a = 0; a < 2; ++a)
#pragma unroll
        for (int b = 0; b < 2; ++b)
#pragma unroll
            for (int m = 0; m < 4; ++m)
#pragma unroll
                for (int n = 0; n < 2; ++n) acc[a][b][m][n] = (f32x4){0.f, 0.f, 0.f, 0.f};
    bf16x8 At[4][2], B0[2][2], B1[2][2];
    const char* cA = (const char*)g.A + (size_t)cur.pm * tstep; const char* cB = (const char*)g.Bt + (size_t)cur.pn * tstep;
    S.a_ready(cur);
    if constexpr (SP2) {
        PG8_STAGE(PG8_SB(0, 0), cB, voffB); PG8_STAGE(PG8_SB(0, 1), cB + hstep, voffB); PG8_STAGE(PG8_SA(0, 0), cA, voffA); PG8_STAGE(PG8_SA(0, 1), cA + hstep, voffA);
        if (wr == 1) PG8_BAR;
        PG8_WAIT_V(2); PG8_BAR;
        PG8_STAGE(PG8_SB(1, 0), cB + kstep, voffB); PG8_STAGE(PG8_SA(1, 0), cA + kstep, voffA); PG8_STAGE(PG8_SB(1, 1), cB + hstep + kstep, voffB);
        PG8_WAIT_V(6); PG8_BAR;
    } else {
        PG8_STAGE(PG8_SB(0, 0), cB, voffB); PG8_STAGE(PG8_SA(0, 0), cA, voffA); PG8_STAGE(PG8_SB(0, 1), cB + hstep, voffB); PG8_STAGE(PG8_SA(0, 1), cA + hstep, voffA);
        if (wr == 1) PG8_BAR;
        PG8_WAIT_V(4); PG8_BAR;
        PG8_STAGE(PG8_SB(1, 0), cB + kstep, voffB); PG8_STAGE(PG8_SA(1, 0), cA + kstep, voffA); PG8_STAGE(PG8_SB(1, 1), cB + hstep + kstep, voffB);
        PG8_WAIT_V(6); PG8_BAR;
    }
    for (;;) {
        const bool has_next = S.next(ui + 1, nxt);
        const char* nA = has_next ? (const char*)g.A + (size_t)nxt.pm * tstep : cA; const char* nB = has_next ? (const char*)g.Bt + (size_t)nxt.pn * tstep : cB;
        for (int t = 0; t < nt; t += 2) {
            const bool last = (t == nt - 2);
            const char* a1 = cA + (size_t)(t + 1) * kstep;
            const char* a2 = last ? nA : cA + (size_t)(t + 2) * kstep; const char* b2 = last ? nB : cB + (size_t)(t + 2) * kstep;
            const char* a3 = a2 + kstep; const char* b3 = b2 + kstep;
            if (last && has_next) S.a_ready(nxt);
            if constexpr (SP2) {
            PG8_LDB(B0, 0, 0); PG8_LDB(B1, 0, 1); PG8_SCHED; PG8_LDA(At, 0, 0); PG8_STAGE(PG8_SA(1, 1), a1 + hstep, voffA);
            PG8_WAIT_V(8); PG8_WAIT_L(0); PG8_BAR; PG8_MMA(0, 0, At, B0); PG8_MMA(0, 1, At, B1); PG8_BAR; PG8_SCHED;
            PG8_LDA(At, 0, 1); PG8_STAGE(PG8_SB(0, 0), b2, voffB); PG8_STAGE(PG8_SB(0, 1), b2 + hstep, voffB); PG8_STAGE(PG8_SA(0, 0), a2, voffA);
            PG8_WAIT_V(8); PG8_WAIT_L(0); PG8_BAR; PG8_MMA(1, 0, At, B0); PG8_MMA(1, 1, At, B1); PG8_BAR; PG8_SCHED;
            PG8_LDB(B0, 1, 0); PG8_LDB(B1, 1, 1); PG8_SCHED; PG8_LDA(At, 1, 0); PG8_STAGE(PG8_SA(0, 1), a2 + hstep, voffA);
            PG8_WAIT_V(8); PG8_WAIT_L(0); PG8_BAR; PG8_MMA(0, 0, At, B0); PG8_MMA(0, 1, At, B1); PG8_BAR; PG8_SCHED;
            PG8_LDA(At, 1, 1); PG8_STAGE(PG8_SB(1, 0), b3, voffB); PG8_STAGE(PG8_SB(1, 1), b3 + hstep, voffB); PG8_STAGE(PG8_SA(1, 0), a3, voffA);
            PG8_WAIT_V(8); PG8_WAIT_L(0); PG8_BAR; PG8_MMA(1, 0, At, B0); PG8_MMA(1, 1, At, B1); PG8_BAR; PG8_SCHED;
            } else {
            PG8_LDB(B0, 0, 0); PG8_SCHED; PG8_LDA(At, 0, 0); PG8_STAGE(PG8_SA(1, 1), a1 + hstep, voffA);
            PG8_WAIT_L(8); PG8_BAR; PG8_WAIT_L(0); PG8_MMA(0, 0, At, B0); PG8_BAR; PG8_SCHED;
            PG8_LDB(B1, 0, 1); PG8_STAGE(PG8_SB(0, 0), b2, voffB);
            PG8_BAR; PG8_WAIT_L(0); PG8_MMA(0, 1, At, B1); PG8_BAR;
            PG8_LDA(At, 0, 1); PG8_STAGE(PG8_SA(0, 0), a2, voffA);
            PG8_BAR; PG8_WAIT_L(0); PG8_MMA(1, 0, At, B0); PG8_BAR; PG8_SCHED;
            PG8_STAGE(PG8_SB(0, 1), b2 + hstep, voffB);
            PG8_WAIT_V(6); PG8_BAR; PG8_MMA(1, 1, At, B1); PG8_BAR;
            PG8_LDB(B0, 1, 0); PG8_SCHED; PG8_LDA(At, 1, 0); PG8_STAGE(PG8_SA(0, 1), a2 + hstep, voffA);
            PG8_WAIT_L(8); PG8_BAR; PG8_WAIT_L(0); PG8_MMA(0, 0, At, B0); PG8_BAR; PG8_SCHED;
            PG8_LDB(B1, 1, 1); PG8_STAGE(PG8_SB(1, 0), b3, voffB);
            PG8_BAR; PG8_WAIT_L(0); PG8_MMA(0, 1, At, B1); PG8_BAR;
            PG8_LDA(At, 1, 1); PG8_STAGE(PG8_SA(1, 0), a3, voffA);
            PG8_BAR; PG8_WAIT_L(0); PG8_MMA(1, 0, At, B0); PG8_BAR; PG8_SCHED;
            PG8_STAGE(PG8_SB(1, 1), b3 + hstep, voffB);
            PG8_WAIT_V(6); PG8_BAR; PG8_MMA(1, 1, At, B1); PG8_BAR;
            }
        }
        if constexpr (ALIGN_EPI) { if (wr == 0) PG8_BAR; }
        if constexpr (!Epi::AFTER_DRAIN) { E(acc, cur, wr, wc, fr, fq); S.done(cur); }
        if (!has_next) break;
#pragma unroll
        for (int a = 0; a < 2; ++a)
#pragma unroll
            for (int b = 0; b < 2; ++b)
#pragma unroll
                for (int m = 0; m < 4; ++m)
#pragma unroll
                    for (int n = 0; n < 2; ++n) acc[a][b][m][n] = (f32x4){0.f, 0.f, 0.f, 0.f};
        cur = nxt; cA = nA; cB = nB; ++ui;
        if constexpr (ALIGN_EPI) { if (wr == 1) PG8_BAR; }
    }
    PG8_WAIT_V(0);
    if constexpr (!ALIGN_EPI) { if (wr == 0) PG8_BAR; }
    PG8_BAR;
    if constexpr (Epi::AFTER_DRAIN) { E.fused(acc, cur, wr, wc, fr, fq, lds, wid, lane); S.done(cur); }
#undef PG8_SA
#undef PG8_SB
#undef PG8_STAGE
#undef PG8_LDA
#undef PG8_LDB
#undef PG8_MMA
#undef PG8_WAIT_V
#undef PG8_WAIT_L
#undef PG8_BAR
#undef PG8_SCHED
}
}
namespace pg8 {
__device__ __forceinline__ unsigned cvt_pk_bf16(float lo, float hi) { unsigned r; asm volatile("v_cvt_pk_bf16_f32 %0, %1, %2" : "=v"(r) : "v"(lo), "v"(hi)); return r; }
__device__ __forceinline__ void st8(bf16_t* p, const f32x4 a, const f32x4 b) { u32x4 w; w.x = cvt_pk_bf16(a[0], a[1]); w.y = cvt_pk_bf16(a[2], a[3]); w.z = cvt_pk_bf16(b[0], b[1]); w.w = cvt_pk_bf16(b[2], b[3]); *(u32x4*)p = w; }
__device__ __forceinline__ void st8nt(bf16_t* p, const f32x4 a, const f32x4 b) { u32x4 w; w.x = cvt_pk_bf16(a[0], a[1]); w.y = cvt_pk_bf16(a[2], a[3]); w.z = cvt_pk_bf16(b[0], b[1]); w.w = cvt_pk_bf16(b[2], b[3]); __builtin_nontemporal_store(w, (u32x4*)p); }
struct RS { float a, b; };
struct StatLd { f32x4 x, y; };
__device__ __forceinline__ StatLd stat_load(const float* ST, int row, int fq) { const f32x4* p = (const f32x4*)(ST + (size_t)row * 32 + fq * 8); StatLd r; r.x = p[0]; r.y = p[1]; return r; }
__device__ __forceinline__ RS stat_fin(const StatLd& t) {
    float s = (t.x[0] + t.x[2]) + (t.y[0] + t.y[2]), ss = (t.x[1] + t.x[3]) + (t.y[1] + t.y[3]);
    s = xadd<16>(s); ss = xadd<16>(ss); s = xadd<32>(s); ss = xadd<32>(ss);
    const float mu = s * (1.f / 1024.f), var = ss * (1.f / 1024.f) - mu * mu, rstd = rsqrtf(fmaxf(var, 0.f) + cfg::EPS);
    RS r; r.a = rstd; r.b = -rstd * mu; return r;
}
__device__ __forceinline__ RS row_stat16(const float* ST, int row, int fq) { return stat_fin(stat_load(ST, row, fq)); }
__device__ __forceinline__ float fsilu(float x) { return x * __builtin_amdgcn_rcpf(1.f + __expf(-x)); }
__device__ __forceinline__ float flogsig16(float x) { return (fminf(x, 0.f) - __logf(1.f + __expf(-fabsf(x)))) * (1.f / 16.f); }

struct FEpiIn {
    static constexpr bool PERM = true, AFTER_DRAIN = false;
    unsigned char* ws; const float* b2; int l; const PG8_LAS float* rsl;
    struct RowLd { f32x4 rc[2], rsn[2]; };
    template <int KIND> __device__ __forceinline__ RowLd load_row(int row, const float (&invf)[8]) const {
        RowLd r;
        if constexpr (KIND == 0) { const float pos = (float)(row & 2047);
#pragma unroll
            for (int e = 0; e < 8; ++e) { const float ang = pos * invf[e]; double rv = (double)ang * 0.15915494309189535; rv -= floor(rv); const float rev = (float)rv;
                r.rc[e >> 2][e & 3] = __builtin_amdgcn_cosf(rev); r.rsn[e >> 2][e & 3] = __builtin_amdgcn_sinf(rev); } }
        return r;
    }
    template <int KIND> __device__ __forceinline__ void rows(const f32x4 (&acc)[2][2][4][2], const Unit& u, int wr, int wc, int fr, int fq) const {
        const int pn = u.pn, cw = 32 * wc + 8 * fq, row0 = u.pm * BM + 64 * wr + fr;
        const bool st = l != 0;
        f32x4 k1[2][2], k2[2][2], bias[2][2];
        const float qs = __uint_as_float(__builtin_amdgcn_readfirstlane(__float_as_uint(pn < 2 ? cfg::QSCALE : 1.f)));
        float invf[8];
        if constexpr (KIND == 0) {
#pragma unroll
            for (int e = 0; e < 8; ++e) invf[e] = exp2f(-(float)(8 * fq + e) * (13.287712379549449f / 32.f)); }
        RowLd cur = load_row<KIND>(row0, invf), nxt;
        if (st) {
#pragma unroll
            for (int bj = 0; bj < 2; ++bj)
#pragma unroll
                for (int n = 0; n < 2; ++n) {
                    if constexpr (KIND == 2) {
                        const float* fp = (const float*)(ws + cfg::V_MF) + (size_t)(l * 8) * 512 + (pn - 6) * 256 + cw + 128 * bj + 4 * n;
                        k1[bj][n] = (*(const f32x4*)fp + *(const f32x4*)(fp + 1024)) + (*(const f32x4*)(fp + 2048) + *(const f32x4*)(fp + 3072));
                        k2[bj][n] = (*(const f32x4*)(fp + 512) + *(const f32x4*)(fp + 1536)) + (*(const f32x4*)(fp + 2560) + *(const f32x4*)(fp + 3584));
                    } else { const float* c1 = (const float*)(ws + cfg::V_C1IN) + l * cfg::NIN + pn * 256 + cw; const float* c2 = (const float*)(ws + cfg::V_C2IN) + l * cfg::NIN + pn * 256 + cw;
                        k1[bj][n] = *(const f32x4*)(c1 + 128 * bj + 4 * n); k2[bj][n] = *(const f32x4*)(c2 + 128 * bj + 4 * n); } } }
        if constexpr (KIND == 6) {
#pragma unroll
            for (int bj = 0; bj < 2; ++bj)
#pragma unroll
                for (int n = 0; n < 2; ++n) bias[bj][n] = *(const f32x4*)(b2 + 128 * bj + cw + 4 * n); }
#pragma unroll
        for (int i = 0; i < 8; ++i) {
            const int ai = i >> 2, m = i & 3, row = row0 + 128 * ai + 16 * m, pos = row & 2047;
            if (i < 7) nxt = load_row<KIND>(row0 + 128 * ((i + 1) >> 2) + 16 * ((i + 1) & 3), invf);
            f32x4 v[2][2];
            if (st) { typedef float f32x2 __attribute__((ext_vector_type(2))); const f32x2 t2 = *(const PG8_LAS f32x2*)(rsl + 2 * (128 * ai + 64 * wr + 16 * m + fr)); RS rs; rs.a = t2[0]; rs.b = t2[1];
#pragma unroll
                for (int bj = 0; bj < 2; ++bj)
#pragma unroll
                    for (int n = 0; n < 2; ++n) v[bj][n] = rs.a * acc[ai][bj][m][n] + (rs.b * k1[bj][n] + k2[bj][n]);
            } else {
#pragma unroll
                for (int bj = 0; bj < 2; ++bj)
#pragma unroll
                    for (int n = 0; n < 2; ++n) v[bj][n] = acc[ai][bj][m][n]; }
            if constexpr (KIND == 0) {
                f32x4 a0 = v[0][0] * cur.rc[0] - v[1][0] * cur.rsn[0], a1 = v[0][1] * cur.rc[1] - v[1][1] * cur.rsn[1];
                f32x4 b0 = v[1][0] * cur.rc[0] + v[0][0] * cur.rsn[0], b1 = v[1][1] * cur.rc[1] + v[0][1] * cur.rsn[1];
                a0 = a0 * qs; a1 = a1 * qs; b0 = b0 * qs; b1 = b1 * qs;
                bf16_t* dst = (bf16_t*)(ws + (pn < 2 ? cfg::WS_Q : cfg::WS_K)) + (size_t)row * 512 + (4 * (pn & 1) + wc) * 64 + 8 * fq;
                st8(dst, a0, a1); st8(dst + 32, b0, b1);
            } else if constexpr (KIND == 1) {
                bf16_t* dst = (bf16_t*)(ws + cfg::WS_V) + (size_t)row * 512 + (pn - 4) * 256 + cw; st8(dst, v[0][0], v[0][1]); st8(dst + 128, v[1][0], v[1][1]);
            } else if constexpr (KIND == 2) {
                bf16_t* dst = (bf16_t*)(ws + cfg::WS_TAB) + (size_t)row * 512 + (pn - 6) * 256 + cw; st8(dst, v[0][0], v[0][1]); st8(dst + 128, v[1][0], v[1][1]);
            } else if constexpr (KIND == 3) {
                bf16_t* dst = (bf16_t*)(ws + cfg::WSB_GQK + (size_t)(u.pm >> 3) * cfg::DLT_GQK) + (size_t)row * 256 + cw; st8(dst, v[0][0] * cfg::GQSCALE, v[0][1] * cfg::GQSCALE); st8(dst + 128, v[1][0], v[1][1]);
            } else if constexpr (KIND == 4) {
                bf16_t* dst = (bf16_t*)(ws + cfg::WSB_GV + (size_t)(u.pm >> 3) * cfg::DLT_GV) + (size_t)row * 256 + cw; st8(dst, v[0][0], v[0][1]); st8(dst + 128, v[1][0], v[1][1]);
            } else if constexpr (KIND == 5) {
                bf16_t* dst = (bf16_t*)(ws + cfg::WSB_GR + (size_t)(u.pm >> 3) * cfg::DLT_GR) + (size_t)row * 256 + cw;
#pragma unroll
                for (int bj = 0; bj < 2; ++bj) { f32x4 x0 = v[bj][0], x1 = v[bj][1];
#pragma unroll
                    for (int e = 0; e < 4; ++e) { x0[e] = fsilu(x0[e]); x1[e] = fsilu(x1[e]); } st8(dst + 128 * bj, x0, x1); }
            } else {
                float* dst = (float*)(ws + cfg::WSB_GL + (size_t)(u.pm >> 3) * cfg::DLT_GL) + (size_t)row * 256 + cw;
#pragma unroll
                for (int bj = 0; bj < 2; ++bj)
#pragma unroll
                    for (int n = 0; n < 2; ++n) { f32x4 x = v[bj][n] + bias[bj][n];
#pragma unroll
                        for (int e = 0; e < 4; ++e) x[e] = flogsig16(x[e]); *(f32x4*)(dst + 128 * bj + 4 * n) = x; }
            }
            if (i < 7) cur = nxt;
        }
    }
    __device__ __forceinline__ void operator()(const f32x4 (&acc)[2][2][4][2], const Unit& u, int wr, int wc, int fr, int fq) const {
        asm volatile("" : "+v"(fr), "+v"(fq));
        unsigned zo = 0u; asm volatile("" : "+s"(zo)); FEpiIn me = *this; me.ws = ws + zo;
        const int pn = u.pn;
        if (pn < 4) me.rows<0>(acc, u, wr, wc, fr, fq); else if (pn < 6) me.rows<1>(acc, u, wr, wc, fr, fq); else if (pn < 8) me.rows<2>(acc, u, wr, wc, fr, fq);
        else if (pn == 8) me.rows<3>(acc, u, wr, wc, fr, fq); else if (pn == 9) me.rows<4>(acc, u, wr, wc, fr, fq); else if (pn == 10) me.rows<5>(acc, u, wr, wc, fr, fq); else me.rows<6>(acc, u, wr, wc, fr, fq);
    }
};
struct FEpiRes {
    static constexpr bool PERM = true, AFTER_DRAIN = false;
    const PG8_LAS float* stprev;
    const float* g; const float* bb; bf16_t* XB; float* ST;
    struct RowLd { u32x4 xb[2]; };
    __device__ __forceinline__ RowLd load_row(int row, int col0, int fq) const {
        RowLd r; const size_t off = (size_t)row * 1024 + col0;
        r.xb[0] = *(const u32x4*)(XB + off); r.xb[1] = *(const u32x4*)(XB + off + 128);
        return r;
    }
    __device__ __forceinline__ void operator()(const f32x4 (&acc)[2][2][4][2], const Unit& u, int wr, int wc, int fr, int fq) const {
        asm volatile("" : "+v"(fr), "+v"(fq));
        const int col0 = u.pn * BM + 32 * wc + 8 * fq, row0 = u.pm * BM + 64 * wr + fr;
        f32x4 gv[2][2], bv[2][2];
        RowLd cur = load_row(row0, col0, fq), nxt;
        if (stprev) {
#pragma unroll
            for (int bj = 0; bj < 2; ++bj)
#pragma unroll
                for (int n = 0; n < 2; ++n) { gv[bj][n] = *(const f32x4*)(g + col0 + 128 * bj + 4 * n); bv[bj][n] = *(const f32x4*)(bb + col0 + 128 * bj + 4 * n); } }
#pragma unroll
        for (int i = 0; i < 8; ++i) { const int ai = i >> 2, m = i & 3, row = row0 + 128 * ai + 16 * m; const size_t off = (size_t)row * 1024 + col0;
            if (i < 7) nxt = load_row(row0 + 128 * ((i + 1) >> 2) + 16 * ((i + 1) & 3), col0, fq);
            RS rs; rs.a = 1.f; rs.b = 0.f; if (stprev) { typedef float f32x2 __attribute__((ext_vector_type(2))); const f32x2 t2 = *(const PG8_LAS f32x2*)(stprev + 2 * (128 * ai + 64 * wr + 16 * m + fr)); rs.a = t2[0]; rs.b = t2[1]; }
            float s = 0.f, ss = 0.f;
#pragma unroll
            for (int bj = 0; bj < 2; ++bj) { f32x4 y[2];
#pragma unroll
                for (int n = 0; n < 2; ++n) { const unsigned w0 = cur.xb[bj][2 * n], w1 = cur.xb[bj][2 * n + 1];
                    f32x4 x = (f32x4){__uint_as_float(w0 << 16), __uint_as_float(w0 & 0xffff0000u), __uint_as_float(w1 << 16), __uint_as_float(w1 & 0xffff0000u)};
                    if (stprev) x = (rs.a * x + rs.b) * gv[bj][n] + bv[bj][n];
                    y[n] = cfg::ALPHA * x + acc[ai][bj][m][n];
                    s += (y[n][0] + y[n][1]) + (y[n][2] + y[n][3]); ss += (y[n][0] * y[n][0] + y[n][1] * y[n][1]) + (y[n][2] * y[n][2] + y[n][3] * y[n][3]); }
                st8nt(XB + off + 128 * bj, y[0], y[1]); }
            s = xadd<16>(s); ss = xadd<16>(ss); s = xadd<32>(s); ss = xadd<32>(ss);
            if (fq == 0) { typedef float f32x2 __attribute__((ext_vector_type(2))); *(f32x2*)(ST + (size_t)row * 32 + (u.pn * 4 + wc) * 2) = (f32x2){s, ss}; }
            if (i < 7) cur = nxt; }
    }
};
struct FEpiGU {
    static constexpr bool PERM = true, AFTER_DRAIN = false;
    const PG8_LAS float* rsl;
    const float* c1; const float* c2; bf16_t* ACT;
    __device__ __forceinline__ void operator()(const f32x4 (&acc)[2][2][4][2], const Unit& u, int wr, int wc, int fr, int fq) const {
        asm volatile("" : "+v"(fr), "+v"(fq));
        const int cw = 32 * wc + 8 * fq, row0 = u.pm * BM + 64 * wr + fr; const float* c1p = c1 + u.pn * 256 + cw; const float* c2p = c2 + u.pn * 256 + cw;
        typedef float f32x2 __attribute__((ext_vector_type(2)));
        f32x4 k1[2][2], k2[2][2];
#pragma unroll
        for (int bj = 0; bj < 2; ++bj)
#pragma unroll
            for (int n = 0; n < 2; ++n) { k1[bj][n] = *(const f32x4*)(c1p + 128 * bj + 4 * n); k2[bj][n] = *(const f32x4*)(c2p + 128 * bj + 4 * n); }
#pragma unroll
        for (int i = 0; i < 8; ++i) { const int ai = i >> 2, m = i & 3; const f32x2 rs = *(const PG8_LAS f32x2*)(rsl + 2 * (128 * ai + 64 * wr + 16 * m + fr)); f32x4 a[2];
#pragma unroll
            for (int n = 0; n < 2; ++n) { const f32x4 hg = rs[0] * acc[ai][0][m][n] + (rs[1] * k1[0][n] + k2[0][n]), hu = rs[0] * acc[ai][1][m][n] + (rs[1] * k1[1][n] + k2[1][n]);
#pragma unroll
                for (int e = 0; e < 4; ++e) a[n][e] = fsilu(hg[e]) * hu[e]; }
            st8nt(ACT + (size_t)(row0 + 128 * ai + 16 * m) * cfg::FF + 128 * u.pn + cw, a[0], a[1]); }
    }
};
struct FEpiFour {
    static constexpr bool PERM = true, AFTER_DRAIN = false;
    bf16_t* OC;
    __device__ __forceinline__ void operator()(const f32x4 (&acc)[2][2][4][2], const Unit& u, int wr, int wc, int fr, int fq) const {
        asm volatile("" : "+v"(fr), "+v"(fq));
        const int cw = 32 * wc + 8 * fq;
#pragma unroll
        for (int ai = 0; ai < 2; ++ai)
#pragma unroll
            for (int m = 0; m < 4; ++m) { const int row = u.pm * BM + 128 * ai + 64 * wr + 16 * m + fr; bf16_t* dst = OC + (size_t)(u.pn * 2048 + row) * 1024 + 512 + cw;
                st8(dst, acc[ai][0][m][0], acc[ai][0][m][1]); st8(dst + 128, acc[ai][1][m][0], acc[ai][1][m][1]); }
    }
};
}
namespace att {
using bf16x8 = __attribute__((ext_vector_type(8))) short;
using s16x4  = __attribute__((ext_vector_type(4))) short;
using f32x16 = __attribute__((ext_vector_type(16))) float;
using u32x4  = __attribute__((ext_vector_type(4))) unsigned;
constexpr int NW = 8, QBLK = 32, KVBLK = 64, LD = 512, NT = cfg::S / KVBLK;
constexpr int SHM_V = KVBLK * 128 * 2, SHM_K = KVBLK * 128 * 2, SHM_X = 2 * SHM_V + 2 * SHM_K, SHM_ATTN = SHM_X + NW * 64 * 4;
constexpr float THRL = 6.0f;
#define ATT_KSWZ(row, colB) ((row) * 256 + ((colB) ^ (((row) & 7) << 4)))
#define ATT_SBAR() __builtin_amdgcn_sched_barrier(0)
__device__ __forceinline__ int crow(int r, int hi) { return (r & 3) + 8 * (r >> 2) + 4 * hi; }
__device__ __forceinline__ unsigned cvtpk(float lo, float hi) { unsigned r; asm volatile("v_cvt_pk_bf16_f32 %0, %1, %2" : "=v"(r) : "v"(lo), "v"(hi)); return r; }
__device__ __forceinline__ void softmaxP(f32x16& p0, f32x16& p1, float& m_reg, float& l_reg, f32x16& negm, float& alpha, bool first, bf16x8& pa0, bf16x8& pa1, bf16x8& pa2, bf16x8& pa3) {
#define ATT_M3(a, b, c) fmaxf(fmaxf(a, b), c)
  const float t0 = ATT_M3(p0[0], p0[1], p0[2]), t1 = ATT_M3(p0[3], p0[4], p0[5]), t2 = ATT_M3(p0[6], p0[7], p0[8]), t3 = ATT_M3(p0[9], p0[10], p0[11]), t4 = ATT_M3(p0[12], p0[13], p0[14]);
  const float t5 = ATT_M3(p0[15], p1[0], p1[1]), t6 = ATT_M3(p1[2], p1[3], p1[4]), t7 = ATT_M3(p1[5], p1[6], p1[7]), t8 = ATT_M3(p1[8], p1[9], p1[10]), t9 = ATT_M3(p1[11], p1[12], p1[13]);
  const float u0 = ATT_M3(t0, t1, t2), u1 = ATT_M3(t3, t4, t5), u2 = ATT_M3(t6, t7, t8), u3 = ATT_M3(t9, p1[14], p1[15]);
  float pmax = fmaxf(fmaxf(u0, u1), fmaxf(u2, u3));
#undef ATT_M3
  { auto rr = __builtin_amdgcn_permlane32_swap(__float_as_uint(pmax), __float_as_uint(pmax), false, false); pmax = fmaxf(__uint_as_float(rr[0]), __uint_as_float(rr[1])); }
  const float thr = first ? -3.0e38f : THRL;
  if (__builtin_expect(__all(pmax <= thr), 1)) { alpha = 1.f; }
  else { const float dl = first ? pmax : fmaxf(pmax, 0.f); alpha = first ? 0.f : __builtin_amdgcn_exp2f(-dl); m_reg += dl;
#pragma unroll
    for (int r = 0; r < 16; ++r) { p0[r] -= dl; p1[r] -= dl; negm[r] -= dl; } }
#pragma unroll
  for (int r = 0; r < 16; ++r) p0[r] = __builtin_amdgcn_exp2f(p0[r]);
#pragma unroll
  for (int r = 0; r < 16; ++r) p1[r] = __builtin_amdgcn_exp2f(p1[r]);
  { float q0 = p0[0] + p1[0], q1 = p0[1] + p1[1], q2 = p0[2] + p1[2], q3 = p0[3] + p1[3];
#pragma unroll
    for (int r = 4; r < 16; r += 4) { q0 += p0[r] + p1[r]; q1 += p0[r + 1] + p1[r + 1]; q2 += p0[r + 2] + p1[r + 2]; q3 += p0[r + 3] + p1[r + 3]; }
    float ps = (q0 + q1) + (q2 + q3);
    auto rr = __builtin_amdgcn_permlane32_swap(__float_as_uint(ps), __float_as_uint(ps), false, false); ps = __uint_as_float(rr[0]) + __uint_as_float(rr[1]);
    l_reg = l_reg * alpha + ps; }
#define ATT_PK4(P, BASE, OUT) do { u32x4 w = {cvtpk(P[BASE + 0], P[BASE + 1]), cvtpk(P[BASE + 2], P[BASE + 3]), cvtpk(P[BASE + 4], P[BASE + 5]), cvtpk(P[BASE + 6], P[BASE + 7])}; \
    OUT = *reinterpret_cast<bf16x8*>(&w); } while (0)
  ATT_PK4(p0, 0, pa0); ATT_PK4(p0, 8, pa1); ATT_PK4(p1, 0, pa2); ATT_PK4(p1, 8, pa3);
#undef ATT_PK4
}
template <int OFF> __device__ __forceinline__ bf16x8 k_read(int ka) { bf16x8 r; asm volatile("ds_read_b128 %0, %1 offset:%2" : "=&v"(r) : "v"(ka), "i"(OFF) : "memory"); return r; }
template <int KB> __device__ __forceinline__ void k_load2(bf16x8* kf, int ka0, int ka1) {
  kf[0] = k_read<KB * SHM_K>(ka0); kf[1] = k_read<KB * SHM_K + 8192>(ka0); kf[2] = k_read<KB * SHM_K>(ka1); kf[3] = k_read<KB * SHM_K + 8192>(ka1);
}
__device__ __forceinline__ void qk_mma2(f32x16& p0, f32x16& p1, const bf16x8* kf, bf16x8 q0, bf16x8 q1) {
  p0 = __builtin_amdgcn_mfma_f32_32x32x16_bf16(kf[0], q0, p0, 0, 0, 0); p1 = __builtin_amdgcn_mfma_f32_32x32x16_bf16(kf[1], q0, p1, 0, 0, 0);
  p0 = __builtin_amdgcn_mfma_f32_32x32x16_bf16(kf[2], q1, p0, 0, 0, 0); p1 = __builtin_amdgcn_mfma_f32_32x32x16_bf16(kf[3], q1, p1, 0, 0, 0);
}
__device__ __forceinline__ int v_st(int k, int c) { return ((k >> 3) * 4 + (c >> 5)) * 512 + ((k & 7) * 32 + (c & 31)) * 2; }
__device__ __forceinline__ int v_rd_base(int lane) { return ((lane & 3) << 3) | (((lane >> 2) & 3) << 6) | (((lane >> 4) & 1) << 5) | (((lane >> 5) & 1) << 8); }
constexpr int v_rd_off(int d0, int ks, int half) { return d0 * 512 + ks * 4096 + half * 2048; }
template <int OFF> __device__ __forceinline__ s16x4 tr_read(int vb) { s16x4 r; asm volatile("ds_read_b64_tr_b16 %0, %1 offset:%2" : "=&v"(r) : "v"(vb), "i"(OFF) : "memory"); return r; }
struct VF { s16x4 l[4], h[4]; };
template <int KS> __device__ __forceinline__ void vf_load(VF& f, int vb) {
  f.l[0] = tr_read<v_rd_off(0, KS, 0)>(vb); f.h[0] = tr_read<v_rd_off(0, KS, 1)>(vb); f.l[1] = tr_read<v_rd_off(1, KS, 0)>(vb); f.h[1] = tr_read<v_rd_off(1, KS, 1)>(vb);
  f.l[2] = tr_read<v_rd_off(2, KS, 0)>(vb); f.h[2] = tr_read<v_rd_off(2, KS, 1)>(vb); f.l[3] = tr_read<v_rd_off(3, KS, 0)>(vb); f.h[3] = tr_read<v_rd_off(3, KS, 1)>(vb);
}
__device__ __forceinline__ void pv_step(f32x16* o, bf16x8 pa, const VF& f) {
#define ATT_PK(L, H) (bf16x8){L[0], L[1], L[2], L[3], H[0], H[1], H[2], H[3]}
  o[0] = __builtin_amdgcn_mfma_f32_32x32x16_bf16(pa, ATT_PK(f.l[0], f.h[0]), o[0], 0, 0, 0);
  o[1] = __builtin_amdgcn_mfma_f32_32x32x16_bf16(pa, ATT_PK(f.l[1], f.h[1]), o[1], 0, 0, 0);
  o[2] = __builtin_amdgcn_mfma_f32_32x32x16_bf16(pa, ATT_PK(f.l[2], f.h[2]), o[2], 0, 0, 0);
  o[3] = __builtin_amdgcn_mfma_f32_32x32x16_bf16(pa, ATT_PK(f.l[3], f.h[3]), o[3], 0, 0, 0);
#undef ATT_PK
}
#define ATT_LWAIT(n) do { asm volatile("s_waitcnt lgkmcnt(" #n ")" ::: "memory"); ATT_SBAR(); } while (0)
template <int MP> __device__ __forceinline__ void att_give(const f32x16* o, float* Xw, int r32, int hi) {
  constexpr int RG = MP ? 0 : 8;
#pragma unroll
  for (int rr = 0; rr < 8; ++rr)
#pragma unroll
    for (int d0 = 0; d0 < 4; ++d0) Xw[(crow(RG + rr, hi) & 15) * 128 + d0 * 32 + r32] = o[d0][RG + rr];
}
template <int MP> __device__ __forceinline__ void att_fin(const f32x16* o, const float* Xr, float lam, const float (&gq)[4], bf16_t* OCw, int r32, int hi, int lane) {
  constexpr int RK = MP ? 8 : 0;
  unsigned pk[8][4];
#pragma unroll
  for (int rr = 0; rr < 8; ++rr) { const int lr = crow(RK + rr, hi) & 15;
    float df[4], ssq = 0.f;
#pragma unroll
    for (int d0 = 0; d0 < 4; ++d0) { const float x = Xr[lr * 128 + d0 * 32 + r32]; df[d0] = MP ? x - lam * o[d0][RK + rr] : o[d0][RK + rr] - lam * x; ssq += df[d0] * df[d0]; }
    ssq = xadd<1>(ssq); ssq = xadd<2>(ssq); ssq = xadd<4>(ssq); ssq = xadd<8>(ssq); ssq = xadd<16>(ssq);
    const float rn = rsqrtf(ssq * (1.f / 128.f) + cfg::EPS);
#pragma unroll
    for (int d0 = 0; d0 < 4; ++d0) pk[rr][d0] = cvtpk(df[d0] * rn * gq[d0], 0.f); }
  char* stg = (char*)Xr;
#pragma unroll
  for (int rr = 0; rr < 8; ++rr) { const int lr = crow(RK + rr, hi) & 15;
#pragma unroll
    for (int d0 = 0; d0 < 4; ++d0) *(unsigned short*)(stg + lr * 272 + (d0 * 32 + r32) * 2) = (unsigned short)pk[rr][d0]; }
#pragma unroll
  for (int i = 0; i < 4; ++i) { const int c = lane + 64 * i, row = c >> 4, cc = c & 15;
    const u32x4 v = *(const u32x4*)(stg + row * 272 + cc * 16); *(u32x4*)(OCw + (size_t)row * 1024 + cc * 8) = v; }
}
__device__ __forceinline__ void attn_unit(int b, int h, int qb, const bf16_t* __restrict__ Qg, const bf16_t* __restrict__ Kg, const bf16_t* __restrict__ Vg, bf16_t* __restrict__ OC,
                                          const float* __restrict__ lamp, const float* __restrict__ dgv, int layer, char* lds) {
  int tid_o = threadIdx.x; asm volatile("" : "+v"(tid_o));
  const int tid = tid_o, wid = __builtin_amdgcn_readfirstlane(tid >> 6), lane = tid & 63, r32 = lane & 31, hi = lane >> 5, mp = wid >> 2, wl = wid & 3, mofs = mp * 64;
  char* V_lds = lds; char* K_lds = lds + 2 * SHM_V;
  float* ws = (float*)(lds + SHM_X) + wid * 64; float* al_l = ws + 32;
  float m_reg = 0.f, l_reg = 0.f; f32x16 o[4] = {}, negm = {}; bf16x8 qr[4];
  const int q0 = qb * 128 + wl * QBLK;
  const bf16_t* Qw = Qg + (size_t)(b * cfg::S + q0 + r32) * LD + h * 128 + mofs + hi * 8;
#pragma unroll
  for (int d0 = 0; d0 < 4; ++d0) qr[d0] = *reinterpret_cast<const bf16x8*>(Qw + d0 * 16);
  const bf16_t* Kh = Kg + (size_t)b * cfg::S * LD + h * 128; const bf16_t* Vh = Vg + (size_t)b * cfg::S * LD + h * 128;
  const int vb0 = (int)(uintptr_t)V_lds + v_rd_base(lane);
  const int ka0 = (int)(uintptr_t)K_lds + ATT_KSWZ(r32, (mofs + hi * 8) * 2);
  const int gt = tid & 255, gr = gt >> 4, gc = (gt & 15) * 8;
  const bf16_t* gsrc = (mp ? Kh : Vh) + (size_t)gr * LD + gc;
  char* gdst = mp ? K_lds + ATT_KSWZ(gr, gc * 2) : V_lds + v_st(gr, gc);
  const int tofs = mp ? 2 : 0;
  bf16x8 st_[2][4];
#define ATT_GLOAD(i, t) do { const int t_ = (t) < NT ? (t) : NT - 1;     \
    _Pragma("unroll") for (int q_ = 0; q_ < 4; ++q_) st_[i][q_] = *reinterpret_cast<const bf16x8*>(gsrc + (size_t)(t_ * 64 + 16 * q_) * LD); } while (0)
#define ATT_GWRITE(i, t) do { asm volatile("s_waitcnt vmcnt(4)" ::: "memory"); if ((t) < NT) { \
    _Pragma("unroll") for (int q_ = 0; q_ < 4; ++q_) *(bf16x8*)(gdst + (i) * 16384 + q_ * 4096) = st_[i][q_]; } } while (0)
#define ATT_RESC(a) do { if (__any((a) < 1.f)) { if (hi == 0) al_l[r32] = (a); asm volatile("s_waitcnt lgkmcnt(0)" ::: "memory"); \
    _Pragma("unroll") for (int r = 0; r < 16; ++r) { const float a_ = al_l[crow(r, hi)]; _Pragma("unroll") for (int d = 0; d < 4; ++d) o[d][r] *= a_; } } } while (0)
  f32x16 s0, s1; float al; bf16x8 pa0, pa1, pa2, pa3, kf[8]; VF f0, f1;
#define ATT_VSEG(I, p) do { ATT_GWRITE(I, (p) + tofs); ATT_GLOAD(I, (p) + tofs + 2); ATT_SBAR(); \
    softmaxP(s0, s1, m_reg, l_reg, negm, al, (p) == 0, pa0, pa1, pa2, pa3); ATT_RESC(al); } while (0)
#define ATT_OL(pa) do { } while (0)
#define ATT_QK(KB) do { k_load2<KB>(kf, ka0, ka0 ^ 32); k_load2<KB>(kf + 4, ka0 ^ 64, ka0 ^ 96); ATT_LWAIT(4); s0 = negm; s1 = negm; qk_mma2(s0, s1, kf, qr[0], qr[1]); ATT_LWAIT(0); qk_mma2(s0, s1, kf + 4, qr[2], qr[3]); ATT_SBAR(); } while (0)
#define ATT_MSEG(VB, KB, QK) do { vf_load<0>(f0, vb0 + (VB) * SHM_V); vf_load<1>(f1, vb0 + (VB) * SHM_V); ATT_SBAR(); \
    ATT_LWAIT(8); pv_step(o, pa0, f0); ATT_OL(pa0); vf_load<2>(f0, vb0 + (VB) * SHM_V); \
    ATT_LWAIT(8); pv_step(o, pa1, f1); ATT_OL(pa1); vf_load<3>(f1, vb0 + (VB) * SHM_V); \
    if constexpr (QK) { k_load2<KB>(kf, ka0, ka0 ^ 32); ATT_LWAIT(12); } else ATT_LWAIT(8); \
    pv_step(o, pa2, f0); ATT_OL(pa2); \
    if constexpr (QK) ATT_LWAIT(4); else ATT_LWAIT(0); \
    pv_step(o, pa3, f1); ATT_OL(pa3); \
    if constexpr (QK) { k_load2<KB>(kf + 4, ka0 ^ 64, ka0 ^ 96); ATT_LWAIT(4); s0 = negm; s1 = negm; qk_mma2(s0, s1, kf, qr[0], qr[1]); ATT_LWAIT(0); qk_mma2(s0, s1, kf + 4, qr[2], qr[3]); } ATT_SBAR(); } while (0)
  { const int kr = tid >> 4, kc = (tid & 15) * 8;
    const bf16x8 k0 = *reinterpret_cast<const bf16x8*>(&Kh[(size_t)kr * LD + kc]), k1 = *reinterpret_cast<const bf16x8*>(&Kh[(size_t)(32 + kr) * LD + kc]);
    const bf16x8 k2 = *reinterpret_cast<const bf16x8*>(&Kh[(size_t)(64 + kr) * LD + kc]), k3 = *reinterpret_cast<const bf16x8*>(&Kh[(size_t)(96 + kr) * LD + kc]);
    ATT_GLOAD(0, tofs); ATT_GLOAD(1, tofs + 1);
    asm volatile("s_waitcnt vmcnt(8)" ::: "memory");
    *(bf16x8*)(K_lds + ATT_KSWZ(kr, kc * 2)) = k0; *(bf16x8*)(K_lds + ATT_KSWZ(32 + kr, kc * 2)) = k1;
    *(bf16x8*)(K_lds + SHM_K + ATT_KSWZ(kr, kc * 2)) = k2; *(bf16x8*)(K_lds + SHM_K + ATT_KSWZ(32 + kr, kc * 2)) = k3; }
  __syncthreads();
  if (mp) __syncthreads();
  ATT_QK(0); __syncthreads();
  for (int p = 0; p + 2 < NT; p += 2) {
    ATT_VSEG(0, p);           __syncthreads();
    ATT_MSEG(0, 1, true);     __syncthreads();
    ATT_VSEG(1, p + 1);       __syncthreads();
    ATT_MSEG(1, 0, true);     __syncthreads();
  }
  ATT_VSEG(0, NT - 2);   __syncthreads();
  ATT_MSEG(0, 1, true);   __syncthreads();
  ATT_VSEG(1, NT - 1);   __syncthreads();
  ATT_MSEG(1, 0, false);  __syncthreads();
  if (!mp) __syncthreads();
  const float lp0 = lamp[lane], lp1 = lamp[64 + lane], lp2 = lamp[128 + lane], lp3 = lamp[192 + lane];
  float gq[4];
#pragma unroll
  for (int d0 = 0; d0 < 4; ++d0) gq[d0] = dgv[d0 * 32 + r32];
  float* li_l = ws; if (hi == 0) li_l[r32] = l_reg; asm volatile("s_waitcnt lgkmcnt(0)" ::: "memory");
#pragma unroll
  for (int r = 0; r < 16; ++r) { const float rl = __builtin_amdgcn_rcpf(li_l[crow(r, hi)]);
#pragma unroll
    for (int d0 = 0; d0 < 4; ++d0) o[d0][r] *= rl; }
  __syncthreads();
  float* X = (float*)lds;
  const float* Xr = X + wid * 2048; float* Xw = X + (wid ^ 4) * 2048;
  int layer_o = __builtin_amdgcn_readfirstlane(layer); asm volatile("" : "+s"(layer_o)); const float lam_init = layer_o == 0 ? 0.2f : 0.35550906759f;
  if (mp == 0) att_give<0>(o, Xw, r32, hi); else att_give<1>(o, Xw, r32, hi);
  float lam; { float s1 = lp0 * lp1, s2 = lp2 * lp3;
    s1 = xadd<1>(s1); s2 = xadd<1>(s2); s1 = xadd<2>(s1); s2 = xadd<2>(s2); s1 = xadd<4>(s1); s2 = xadd<4>(s2); s1 = xadd<8>(s1); s2 = xadd<8>(s2); s1 = xadd<16>(s1); s2 = xadd<16>(s2); s1 = xadd<32>(s1); s2 = xadd<32>(s2);
    lam = __expf(s1) - __expf(s2) + lam_init; }
#pragma unroll
  for (int d0 = 0; d0 < 4; ++d0) gq[d0] *= (1.f - lam_init);
  __syncthreads();
  bf16_t* OCw = OC + (size_t)(b * cfg::S + q0 + 16 * mp) * 1024 + h * 128;
  if (mp == 0) att_fin<0>(o, Xr, lam, gq, OCw, r32, hi, lane); else att_fin<1>(o, Xr, lam, gq, OCw, r32, hi, lane);
  __syncthreads();
#undef ATT_GLOAD
#undef ATT_GWRITE
#undef ATT_VSEG
#undef ATT_MSEG
#undef ATT_RESC
#undef ATT_OL
#undef ATT_QK
}
#undef ATT_KSWZ
#undef ATT_SBAR
}
namespace gla {
using att::bf16x8; using att::s16x4; using att::f32x16; using att::u32x4; using att::crow; using att::cvtpk; using att::tr_read;
typedef float f32x4 __attribute__((ext_vector_type(4)));
typedef unsigned u32x2 __attribute__((ext_vector_type(2)));
#define GLAS __attribute__((address_space(3)))
constexpr int KT_STRIDE = 144;
constexpr int A_KT = 0, A_V = 36864, A_BEND = A_V + 32768;
constexpr int B_QT = 0, B_KT = 32768, B_V = 65536, B_SC = 98304;
__device__ __forceinline__ int v_st64(int k, int c) { const int kk = (k & ~0xC) | ((k & 4) << 1) | ((k & 8) >> 1); return ((kk >> 3) * 2 + (c >> 5)) * 512 + ((kk & 7) * 32 + (c & 31)) * 2; }
constexpr int v_off64(int d0, int ks, int half) { return d0 * 512 + ks * 2048 + half * 1024; }
__device__ __forceinline__ float bf2f_(unsigned short v) { return __uint_as_float((unsigned)v << 16); }
__device__ __forceinline__ void load_v_tile(const bf16_t* __restrict__ src, GLAS unsigned char* dst, int lane) {
    u32x4 tv[8];
#pragma unroll
    for (int i = 0; i < 8; ++i) { const int row = (lane >> 3) + 8 * i, ch = lane & 7; tv[i] = *(const u32x4*)(src + (size_t)row * 256 + ch * 8); }
#pragma unroll
    for (int i = 0; i < 8; ++i) { const int row = (lane >> 3) + 8 * i, ch = lane & 7; *(GLAS u32x4*)(dst + v_st64(row, ch * 8)) = tv[i]; }
}
#define GLA_PK(L, H) (bf16x8){L[0], L[1], L[2], L[3], H[0], H[1], H[2], H[3]}
#define GLA_MM4(o0, o1, vb, AF) do { \
    const s16x4 l00 = tr_read<v_off64(0, 0, 0)>(vb), h00 = tr_read<v_off64(0, 0, 1)>(vb), l01 = tr_read<v_off64(0, 1, 0)>(vb), h01 = tr_read<v_off64(0, 1, 1)>(vb); \
    const s16x4 l02 = tr_read<v_off64(0, 2, 0)>(vb), h02 = tr_read<v_off64(0, 2, 1)>(vb), l03 = tr_read<v_off64(0, 3, 0)>(vb), h03 = tr_read<v_off64(0, 3, 1)>(vb); \
    const s16x4 l10 = tr_read<v_off64(1, 0, 0)>(vb), h10 = tr_read<v_off64(1, 0, 1)>(vb), l11 = tr_read<v_off64(1, 1, 0)>(vb), h11 = tr_read<v_off64(1, 1, 1)>(vb); \
    const s16x4 l12 = tr_read<v_off64(1, 2, 0)>(vb), h12 = tr_read<v_off64(1, 2, 1)>(vb), l13 = tr_read<v_off64(1, 3, 0)>(vb), h13 = tr_read<v_off64(1, 3, 1)>(vb); \
    asm volatile("s_waitcnt lgkmcnt(0)" ::: "memory"); __builtin_amdgcn_sched_barrier(0); \
    o0 = __builtin_amdgcn_mfma_f32_32x32x16_bf16(AF(0), GLA_PK(l00, h00), o0, 0, 0, 0); o1 = __builtin_amdgcn_mfma_f32_32x32x16_bf16(AF(0), GLA_PK(l10, h10), o1, 0, 0, 0); \
    o0 = __builtin_amdgcn_mfma_f32_32x32x16_bf16(AF(1), GLA_PK(l01, h01), o0, 0, 0, 0); o1 = __builtin_amdgcn_mfma_f32_32x32x16_bf16(AF(1), GLA_PK(l11, h11), o1, 0, 0, 0); \
    o0 = __builtin_amdgcn_mfma_f32_32x32x16_bf16(AF(2), GLA_PK(l02, h02), o0, 0, 0, 0); o1 = __builtin_amdgcn_mfma_f32_32x32x16_bf16(AF(2), GLA_PK(l12, h12), o1, 0, 0, 0); \
    o0 = __builtin_amdgcn_mfma_f32_32x32x16_bf16(AF(3), GLA_PK(l03, h03), o0, 0, 0, 0); o1 = __builtin_amdgcn_mfma_f32_32x32x16_bf16(AF(3), GLA_PK(l13, h13), o1, 0, 0, 0); } while (0)
__device__ __forceinline__ bf16x8 afrag_tr(const GLAS unsigned char* row, int ks, int hi) { return *(const GLAS bf16x8*)(row + (16 * ks + 8 * hi) * 2); }

__device__ __forceinline__ void gla_a_item(int b, int h, int g, unsigned char* ws, GLAS unsigned char* lds) {
    int tid_o = threadIdx.x; asm volatile("" : "+v"(tid_o));
    const int tid = tid_o, wave = __builtin_amdgcn_readfirstlane(tid >> 6), lane = tid & 63, r32 = lane & 31, hi = lane >> 5;
    const float* GL = (const float*)(ws + cfg::WSB_GL + (size_t)b * cfg::DLT_GL); const bf16_t* GQK = (const bf16_t*)(ws + cfg::WSB_GQK + (size_t)b * cfg::DLT_GQK); const bf16_t* GV = (const bf16_t*)(ws + cfg::WSB_GV + (size_t)b * cfg::DLT_GV);
    float* KVC = (float*)(ws + cfg::WSB_OF + (size_t)b * cfg::DLT_OF); float* DEC = (float*)(ws + cfg::WS_DEC);
    const size_t tok0 = (size_t)b * 2048 + g * 256;
    GLAS float* bend_s = (GLAS float*)(lds + A_BEND);
    if (wave < 4) {
        const int c = wave, dir = lane >> 5, d = lane & 31;
        const float* gl = GL + (tok0 + c * 64) * 256 + dir * 128 + h * 32 + d; const bf16_t* kp = GQK + (tok0 + c * 64) * 256 + 128 + h * 32 + d;
        GLAS unsigned char* row = lds + A_KT + ((c * 2 + dir) * 32 + d) * KT_STRIDE; float bsum = 0.f; float gA[8], gB[8]; unsigned short kA[8], kB[8];
#define GLA_LOAD(G, K, blk) do { const int t0_ = dir ? 56 - 8 * (blk) : 8 * (blk); _Pragma("unroll") for (int i = 0; i < 8; ++i) { G[i] = gl[(size_t)(t0_ + i) * 256]; K[i] = kp[(size_t)(t0_ + i) * 256]; } } while (0)
#define GLA_PROC(G, K, blk) do { const int t0_ = dir ? 56 - 8 * (blk) : 8 * (blk); float kt[8]; \
            if (dir == 0) { _Pragma("unroll") for (int i = 0; i < 8; ++i) { bsum += G[i]; kt[i] = bf2f_(K[i]) * __expf(-bsum); } } \
            else { _Pragma("unroll") for (int i = 7; i >= 0; --i) { bsum += G[i]; kt[i] = bf2f_(K[i]) * __expf(-bsum); } } \
            u32x4 w; w.x = cvtpk(kt[0], kt[1]); w.y = cvtpk(kt[2], kt[3]); w.z = cvtpk(kt[4], kt[5]); w.w = cvtpk(kt[6], kt[7]); *(GLAS u32x4*)(row + t0_ * 2) = w; } while (0)
        GLA_LOAD(gA, kA, 0);
#pragma unroll
        for (int bp = 0; bp < 4; ++bp) { GLA_LOAD(gB, kB, 2 * bp + 1); GLA_PROC(gA, kA, 2 * bp); if (bp < 3) GLA_LOAD(gA, kA, 2 * bp + 2); GLA_PROC(gB, kB, 2 * bp + 1); }
#undef GLA_LOAD
#undef GLA_PROC
        bend_s[(c * 2 + dir) * 32 + d] = bsum;
        DEC[((size_t)((b * 4 + h) * 32 + g * 4 + c) * 2 + dir) * 32 + d] = __expf(bsum);
    } else { const int c = wave - 4; load_v_tile(GV + (tok0 + c * 64) * 256 + h * 64, lds + A_V + c * 8192, lane); }
    __syncthreads();
    {
        const int c = wave >> 1, dir = wave & 1; f32x16 o0 = {}, o1 = {};
        const int vb = (int)(unsigned)(uintptr_t)(lds + A_V + c * 8192) + att::v_rd_base(lane);
        const GLAS unsigned char* arow = lds + A_KT + ((c * 2 + dir) * 32 + r32) * KT_STRIDE;
#define GLA_AF(ks) afrag_tr(arow, ks, hi)
        GLA_MM4(o0, o1, vb, GLA_AF);
#undef GLA_AF
        float* dst = KVC + ((size_t)((b * 4 + h) * 32 + g * 4 + c) * 2 + dir) * 2048 + r32;
#pragma unroll
        for (int r = 0; r < 16; ++r) { const int d = crow(r, hi); const float sc = __expf(bend_s[(c * 2 + dir) * 32 + d]); dst[d * 64] = o0[r] * sc; dst[d * 64 + 32] = o1[r] * sc; }
    }
    __syncthreads();
}

__device__ __forceinline__ void gla_b_item(int b, int h, int g, unsigned char* ws, const float* __restrict__ gng, bf16_t* __restrict__ OC, GLAS unsigned char* lds) {
    int tid_o = threadIdx.x; asm volatile("" : "+v"(tid_o));
    const int tid = tid_o, wave = __builtin_amdgcn_readfirstlane(tid >> 6), lane = tid & 63, r32 = lane & 31, hi = lane >> 5;
    const float* GL = (const float*)(ws + cfg::WSB_GL + (size_t)b * cfg::DLT_GL); const bf16_t* GQK = (const bf16_t*)(ws + cfg::WSB_GQK + (size_t)b * cfg::DLT_GQK); const bf16_t* GV = (const bf16_t*)(ws + cfg::WSB_GV + (size_t)b * cfg::DLT_GV); const bf16_t* GR = (const bf16_t*)(ws + cfg::WSB_GR + (size_t)b * cfg::DLT_GR);
    const float* KVC = (const float*)(ws + cfg::WSB_OF + (size_t)b * cfg::DLT_OF) + (size_t)((b * 4 + h) * 32) * 2 * 2048; const float* DEC = (const float*)(ws + cfg::WS_DEC) + (size_t)((b * 4 + h) * 32) * 2 * 32;
    const size_t tok0 = (size_t)b * 2048 + g * 256;
    if (wave < 4) {
        const int c = wave, dir = lane >> 5, d = lane & 31;
        const float* gl = GL + (tok0 + c * 64) * 256 + dir * 128 + h * 32 + d; const bf16_t* qp = GQK + (tok0 + c * 64) * 256 + h * 32 + d;
        GLAS unsigned short* qt = (GLAS unsigned short*)(lds + B_QT + c * 8192) + dir * 32 + d;
        GLAS unsigned short* kt = (GLAS unsigned short*)(lds + B_KT + c * 8192 + dir * 4096) + d;
        float bsum = 0.f; float gA[8], gB[8]; unsigned short qA[8], kA[8], qB[8], kB[8];
#define GLB_LOAD(G, Q, K, blk) do { const int t0_ = dir ? 56 - 8 * (blk) : 8 * (blk); _Pragma("unroll") for (int i = 0; i < 8; ++i) { G[i] = gl[(size_t)(t0_ + i) * 256]; Q[i] = qp[(size_t)(t0_ + i) * 256]; K[i] = qp[(size_t)(t0_ + i) * 256 + 128]; } } while (0)
#define GLB_PROC(G, Q, K, blk) do { const int t0_ = dir ? 56 - 8 * (blk) : 8 * (blk); _Pragma("unroll") for (int ii = 0; ii < 8; ++ii) { \
            const float gi = dir ? G[7 - ii] : G[ii], qi = bf2f_(dir ? Q[7 - ii] : Q[ii]), ki = bf2f_(dir ? K[7 - ii] : K[ii]); const int tt = t0_ + (dir ? 7 - ii : ii); \
            bsum += gi; const float e = __expf(bsum), ei = __expf(-bsum); \
            qt[tt * 64] = (unsigned short)(cvtpk(qi * e, 0.f) & 0xffffu); kt[tt * 32] = (unsigned short)(cvtpk(ki * ei, 0.f) & 0xffffu); } } while (0)
        GLB_LOAD(gA, qA, kA, 0);
#pragma unroll
        for (int bp = 0; bp < 4; ++bp) { GLB_LOAD(gB, qB, kB, 2 * bp + 1); GLB_PROC(gA, qA, kA, 2 * bp); if (bp < 3) GLB_LOAD(gA, qA, kA, 2 * bp + 2); GLB_PROC(gB, qB, kB, 2 * bp + 1); }
#undef GLB_LOAD
#undef GLB_PROC
    } else {
        const int c = wave - 4;
        const int t2 = tid - 256, d = t2 >> 3, v8 = (t2 & 7) * 8;
        const float* kvp = KVC + d * 64 + v8; const float* dcp = DEC + d;
        const int F = 4 * g + 3;
        u32x4 tv[8];
#pragma unroll
        for (int i = 0; i < 8; ++i) { const int row = (lane >> 3) + 8 * i, ch = lane & 7; tv[i] = *(const u32x4*)(GV + (tok0 + c * 64) * 256 + h * 64 + (size_t)row * 256 + ch * 8); }
        f32x4 Sf0 = {0.f, 0.f, 0.f, 0.f}, Sf1 = Sf0, Sb0 = Sf0, Sb1 = Sf0;
        f32x4 a0A[8], a1A[8], a0B[8], a1B[8]; float dA[8], dB[8];
#define GLS_IDX(s_) (((s_) < F) ? (s_) * 2 : (31 - ((s_) - F)) * 2 + 1)
#define GLS_ISSUE(A0, A1, DD, s0) do { _Pragma("unroll") for (int j = 0; j < 8; ++j) { const int sc_ = (s0) + j < 34 ? (s0) + j : 33; const int ix_ = GLS_IDX(sc_); \
            A0[j] = *(const f32x4*)(kvp + (size_t)ix_ * 2048); A1[j] = *(const f32x4*)(kvp + (size_t)ix_ * 2048 + 4); DD[j] = dcp[ix_ * 32]; } } while (0)
#define GLS_WRITE(S0, S1, c4_, dofs_) do { u32x4 w; w.x = cvtpk(S0[0], S0[1]); w.y = cvtpk(S0[2], S0[3]); w.z = cvtpk(S1[0], S1[1]); w.w = cvtpk(S1[2], S1[3]); \
            *(GLAS u32x4*)(lds + B_SC + (c4_) * 8192 + v_st64((dofs_) + d, v8)) = w; } while (0)
#define GLS_PROC(A0, A1, DD, s0) do { _Pragma("unroll") for (int j = 0; j < 8; ++j) { const int s_ = (s0) + j; if (s_ < 34) { \
            if (s_ < F) { const int n_ = s_; if (n_ >= 4 * g) GLS_WRITE(Sf0, Sf1, n_ - 4 * g, 0); Sf0 = DD[j] * Sf0 + A0[j]; Sf1 = DD[j] * Sf1 + A1[j]; } \
            else { const int n_ = 31 - (s_ - F); if (n_ <= 4 * g + 3) GLS_WRITE(Sb0, Sb1, n_ - 4 * g, 32); Sb0 = DD[j] * Sb0 + A0[j]; Sb1 = DD[j] * Sb1 + A1[j]; } } } } while (0)
        GLS_ISSUE(a0A, a1A, dA, 0); GLS_ISSUE(a0B, a1B, dB, 8);
#pragma unroll
        for (int i = 0; i < 8; ++i) { const int row = (lane >> 3) + 8 * i, ch = lane & 7; *(GLAS u32x4*)(lds + B_V + c * 8192 + v_st64(row, ch * 8)) = tv[i]; }
        GLS_PROC(a0A, a1A, dA, 0);  GLS_ISSUE(a0A, a1A, dA, 16);
        GLS_PROC(a0B, a1B, dB, 8);  GLS_ISSUE(a0B, a1B, dB, 24);
        GLS_PROC(a0A, a1A, dA, 16); GLS_ISSUE(a0A, a1A, dA, 32);
        GLS_PROC(a0B, a1B, dB, 24);
        GLS_PROC(a0A, a1A, dA, 32);
        GLS_WRITE(Sf0, Sf1, 3, 0); GLS_WRITE(Sb0, Sb1, 0, 32);
#undef GLS_IDX
#undef GLS_ISSUE
#undef GLS_WRITE
#undef GLS_PROC
    }
    __syncthreads();
    {
        const int c = wave >> 1, th = wave & 1, t = 32 * th + r32;
        const GLAS unsigned char* qrow = lds + B_QT + c * 8192 + t * 128;
        f32x16 pf0 = {}, pf1 = {}, pb0 = {}, pb1 = {};
#pragma unroll
        for (int ks = 0; ks < 2; ++ks) {
            const bf16x8 qf = *(const GLAS bf16x8*)(qrow + (16 * ks + 8 * hi) * 2), qb = *(const GLAS bf16x8*)(qrow + (32 + 16 * ks + 8 * hi) * 2);
            const GLAS unsigned char* kf = lds + B_KT + c * 8192 + r32 * 64 + (16 * ks + 8 * hi) * 2; const GLAS unsigned char* kb = kf + 4096;
            pf0 = __builtin_amdgcn_mfma_f32_32x32x16_bf16(*(const GLAS bf16x8*)kf, qf, pf0, 0, 0, 0); pf1 = __builtin_amdgcn_mfma_f32_32x32x16_bf16(*(const GLAS bf16x8*)(kf + 2048), qf, pf1, 0, 0, 0);
            pb0 = __builtin_amdgcn_mfma_f32_32x32x16_bf16(*(const GLAS bf16x8*)kb, qb, pb0, 0, 0, 0); pb1 = __builtin_amdgcn_mfma_f32_32x32x16_bf16(*(const GLAS bf16x8*)(kb + 2048), qb, pb1, 0, 0, 0);
        }
#pragma unroll
        for (int r = 0; r < 16; ++r) { const int j0 = crow(r, hi), j1 = 32 + j0;
            pf0[r] = (j0 <= t ? pf0[r] : 0.f) + (j0 >= t ? pb0[r] : 0.f); pf1[r] = (j1 <= t ? pf1[r] : 0.f) + (j1 >= t ? pb1[r] : 0.f); }
        bf16x8 pa0, pa1, pa2, pa3;
#define GLA_PK4(P, BASE, OUT) do { unsigned a0 = cvtpk(P[BASE + 0], P[BASE + 1]), a1 = cvtpk(P[BASE + 2], P[BASE + 3]); unsigned b0 = cvtpk(P[BASE + 4], P[BASE + 5]), b1 = cvtpk(P[BASE + 6], P[BASE + 7]); \
    auto r0 = __builtin_amdgcn_permlane32_swap(a0, b0, false, false); auto r1 = __builtin_amdgcn_permlane32_swap(a1, b1, false, false); \
    u32x4 w = {r0[0], r1[0], r0[1], r1[1]}; OUT = *reinterpret_cast<bf16x8*>(&w); } while (0)
        GLA_PK4(pf0, 0, pa0); GLA_PK4(pf0, 8, pa1); GLA_PK4(pf1, 0, pa2); GLA_PK4(pf1, 8, pa3);
#undef GLA_PK4
        f32x16 o0 = {}, o1 = {};
        { const int vb = (int)(unsigned)(uintptr_t)(lds + B_V + c * 8192) + att::v_rd_base(lane);
#define GLA_AF(ks) ((ks) == 0 ? pa0 : (ks) == 1 ? pa1 : (ks) == 2 ? pa2 : pa3)
          GLA_MM4(o0, o1, vb, GLA_AF);
#undef GLA_AF
        }
        { const int vb = (int)(unsigned)(uintptr_t)(lds + B_SC + c * 8192) + att::v_rd_base(lane);
#define GLA_AF(ks) afrag_tr(qrow, ks, hi)
          GLA_MM4(o0, o1, vb, GLA_AF);
#undef GLA_AF
        }
        const float g0 = gng[r32], g1 = gng[32 + r32];
        const bf16_t* grb = GR + (tok0 + c * 64 + 32 * th) * 256 + h * 64 + r32; unsigned short gq0[16], gq1[16];
#pragma unroll
        for (int r = 0; r < 16; ++r) { gq0[r] = grb[(size_t)crow(r, hi) * 256]; gq1[r] = grb[(size_t)crow(r, hi) * 256 + 32]; }
#pragma unroll
        for (int r = 0; r < 16; ++r) {
            float ssq = o0[r] * o0[r] + o1[r] * o1[r];
            ssq = xadd<1>(ssq); ssq = xadd<2>(ssq); ssq = xadd<4>(ssq); ssq = xadd<8>(ssq); ssq = xadd<16>(ssq);
            const float rn = rsqrtf(ssq * (1.f / 64.f) + cfg::EPS);
            const size_t tok = tok0 + c * 64 + 32 * th + crow(r, hi);
            bf16_t* dst = OC + tok * 1024 + 768 + h * 64 + r32;
            dst[0] = (bf16_t)(cvtpk(o0[r] * rn * g0 * bf2f_(gq0[r]), 0.f) & 0xffffu); dst[32] = (bf16_t)(cvtpk(o1[r] * rn * g1 * bf2f_(gq1[r]), 0.f) & 0xffffu);
        }
    }
    __syncthreads();
}
#undef GLA_MM4
#undef GLA_PK
#undef GLAS
}
namespace fft {
using att::bf16x8; using att::s16x4; using att::f32x16; using att::u32x4; using att::crow; using att::cvtpk; using att::tr_read;
#define FLAS __attribute__((address_space(3)))
__device__ __forceinline__ int img_off(int k, int c) { const int kk = (k & ~0xC) | ((k & 4) << 1) | ((k & 8) >> 1); return ((kk >> 3) * 8 + (c >> 5)) * 512 + ((kk & 7) * 32 + (c & 31)) * 2; }
constexpr int rd_off(int ks, int half) { return ks * 8192 + half * 4096; }
#define FFT_PK(L, H) (bf16x8){L[0], L[1], L[2], L[3], H[0], H[1], H[2], H[3]}
typedef float f32x2_t __attribute__((ext_vector_type(2))); typedef __bf16 bf16x2_t __attribute__((ext_vector_type(2)));
__device__ __forceinline__ unsigned pk2f(float a, float b) { f32x2_t v = {a, b}; bf16x2_t r = __builtin_convertvector(v, bf16x2_t); return __builtin_bit_cast(unsigned, r); }

__device__ __forceinline__ void stage1_load(u32x4 (&tv)[4], int b, int s2, const bf16_t* __restrict__ FX) {
    int tid = threadIdx.x; asm volatile("" : "+v"(tid));
#pragma unroll
    for (int i = 0; i < 4; ++i) { const int p = tid + 512 * i, k = p >> 5, c8 = (p & 31) * 8; tv[i] = *(const u32x4*)(FX + (size_t)(b * 2048 + 64 * (k & 31) + s2) * 512 + (k >> 5) * 256 + c8); }
}
__device__ __forceinline__ void stage1_item(int b, int s2, const u32x4 (&tv)[4], bf16_t* __restrict__ I1, FLAS unsigned char* lds) {
    int tid_o = threadIdx.x; asm volatile("" : "+v"(tid_o));
    const int tid = tid_o, wave = __builtin_amdgcn_readfirstlane(tid >> 6), lane = tid & 63, r32 = lane & 31, hi = lane >> 5;
    bf16x8 F1[2][4];
#pragma unroll
    for (int ks = 0; ks < 4; ++ks) { float cr[8], ci[8];
#pragma unroll
        for (int j = 0; j < 8; ++j) { const int k = 16 * ks + 8 * hi + j, s1 = k & 31; const float rev = (float)((r32 * s1) & 31) * (1.f / 32.f); const float c = __builtin_amdgcn_cosf(rev), sn = __builtin_amdgcn_sinf(rev);
            const bool p1 = (k >> 5) != 0; cr[j] = p1 ? -sn : c; ci[j] = p1 ? -c : -sn; }
        u32x4 wr = {pk2f(cr[0], cr[1]), pk2f(cr[2], cr[3]), pk2f(cr[4], cr[5]), pk2f(cr[6], cr[7])}, wi = {pk2f(ci[0], ci[1]), pk2f(ci[2], ci[3]), pk2f(ci[4], ci[5]), pk2f(ci[6], ci[7])};
        F1[0][ks] = *reinterpret_cast<bf16x8*>(&wr); F1[1][ks] = *reinterpret_cast<bf16x8*>(&wi); }
    {
#pragma unroll
      for (int i = 0; i < 4; ++i) { const int p = tid + 512 * i, k = p >> 5, c8 = (p & 31) * 8; *(FLAS u32x4*)(lds + img_off(k, c8)) = tv[i]; } }
    __syncthreads();
    f32x16 re = {}, im = {};
    { const int vb = (int)(unsigned)(uintptr_t)lds + att::v_rd_base(lane) + wave * 512;
      const s16x4 l0 = tr_read<rd_off(0, 0)>(vb), h0 = tr_read<rd_off(0, 1)>(vb), l1 = tr_read<rd_off(1, 0)>(vb), h1 = tr_read<rd_off(1, 1)>(vb);
      const s16x4 l2 = tr_read<rd_off(2, 0)>(vb), h2 = tr_read<rd_off(2, 1)>(vb), l3 = tr_read<rd_off(3, 0)>(vb), h3 = tr_read<rd_off(3, 1)>(vb);
      asm volatile("s_waitcnt lgkmcnt(0)" ::: "memory"); __builtin_amdgcn_sched_barrier(0);
      re = __builtin_amdgcn_mfma_f32_32x32x16_bf16(F1[0][0], FFT_PK(l0, h0), re, 0, 0, 0); im = __builtin_amdgcn_mfma_f32_32x32x16_bf16(F1[1][0], FFT_PK(l0, h0), im, 0, 0, 0);
      re = __builtin_amdgcn_mfma_f32_32x32x16_bf16(F1[0][1], FFT_PK(l1, h1), re, 0, 0, 0); im = __builtin_amdgcn_mfma_f32_32x32x16_bf16(F1[1][1], FFT_PK(l1, h1), im, 0, 0, 0);
      re = __builtin_amdgcn_mfma_f32_32x32x16_bf16(F1[0][2], FFT_PK(l2, h2), re, 0, 0, 0); im = __builtin_amdgcn_mfma_f32_32x32x16_bf16(F1[1][2], FFT_PK(l2, h2), im, 0, 0, 0);
      re = __builtin_amdgcn_mfma_f32_32x32x16_bf16(F1[0][3], FFT_PK(l3, h3), re, 0, 0, 0); im = __builtin_amdgcn_mfma_f32_32x32x16_bf16(F1[1][3], FFT_PK(l3, h3), im, 0, 0, 0); }
    bf16_t* dst = I1 + (size_t)(b * 32) * 128 * 256 + (size_t)s2 * 256 + 32 * wave + r32;
#pragma unroll
    for (int r = 0; r < 16; ++r) { const int k1 = crow(r, hi); const float rev = (float)((k1 * s2) & 2047) * (1.f / 2048.f); const float ct = __builtin_amdgcn_cosf(rev), st = __builtin_amdgcn_sinf(rev);
        const float ar = re[r] * ct + im[r] * st, ai = im[r] * ct - re[r] * st; const unsigned w = pk2f(ar, ai);
        dst[(size_t)k1 * 128 * 256] = (bf16_t)(w & 0xffffu); dst[(size_t)k1 * 128 * 256 + 64 * 256] = (bf16_t)(w >> 16); }
    __syncthreads();
}

__device__ __forceinline__ void stage2_item(int b, int k1, const bf16_t* __restrict__ I1, bf16_t* __restrict__ OC, FLAS unsigned char* lds) {
    int tid_o = threadIdx.x; asm volatile("" : "+v"(tid_o));
    const int tid = tid_o, wave = __builtin_amdgcn_readfirstlane(tid >> 6), lane = tid & 63, r32 = lane & 31, hi = lane >> 5;
    const bf16_t* src = I1 + (size_t)(b * 32 + k1) * 128 * 256;
    { u32x4 tv[8];
#pragma unroll
      for (int i = 0; i < 8; ++i) { const int p = tid + 512 * i, k = p >> 5, c8 = (p & 31) * 8; tv[i] = *(const u32x4*)(src + (size_t)k * 256 + c8); }
#pragma unroll
      for (int i = 0; i < 8; ++i) { const int p = tid + 512 * i, k = p >> 5, c8 = (p & 31) * 8; *(FLAS u32x4*)(lds + img_off(k, c8)) = tv[i]; } }
    f32x16 y0 = {}, y1 = {};
    __syncthreads();
    const int vb = (int)(unsigned)(uintptr_t)lds + att::v_rd_base(lane) + wave * 512, vb2 = vb + 32768;
    bf16x8 F2[2][8];
#pragma unroll
    for (int ks = 0; ks < 8; ++ks) { float c0[8], c1[8];
#pragma unroll
        for (int j = 0; j < 8; ++j) { const int k = 16 * ks + 8 * hi + j, s2 = k & 63; const float r0 = (float)((r32 * s2) & 63) * (1.f / 64.f), r1 = (float)(((32 + r32) * s2) & 63) * (1.f / 64.f);
            c0[j] = (k >> 6) ? __builtin_amdgcn_sinf(r0) : __builtin_amdgcn_cosf(r0); c1[j] = (k >> 6) ? __builtin_amdgcn_sinf(r1) : __builtin_amdgcn_cosf(r1); }
        u32x4 w0 = {pk2f(c0[0], c0[1]), pk2f(c0[2], c0[3]), pk2f(c0[4], c0[5]), pk2f(c0[6], c0[7])}, w1 = {pk2f(c1[0], c1[1]), pk2f(c1[2], c1[3]), pk2f(c1[4], c1[5]), pk2f(c1[6], c1[7])};
        F2[0][ks] = *reinterpret_cast<bf16x8*>(&w0); F2[1][ks] = *reinterpret_cast<bf16x8*>(&w1); }
#define FFT_STEP(ks) do { \
      const s16x4 lo_ = tr_read<rd_off((ks) & 3, 0)>((ks) < 4 ? vb : vb2), hi_ = tr_read<rd_off((ks) & 3, 1)>((ks) < 4 ? vb : vb2); asm volatile("s_waitcnt lgkmcnt(0)" ::: "memory"); __builtin_amdgcn_sched_barrier(0); \
      y0 = __builtin_amdgcn_mfma_f32_32x32x16_bf16(F2[0][ks], FFT_PK(lo_, hi_), y0, 0, 0, 0); y1 = __builtin_amdgcn_mfma_f32_32x32x16_bf16(F2[1][ks], FFT_PK(lo_, hi_), y1, 0, 0, 0); } while (0)
    FFT_STEP(0); FFT_STEP(1); FFT_STEP(2); FFT_STEP(3); FFT_STEP(4); FFT_STEP(5); FFT_STEP(6); FFT_STEP(7);
#undef FFT_STEP
    bf16_t* dst = OC + (size_t)(b * 2048 + k1) * 1024 + 512 + 32 * wave + r32;
#pragma unroll
    for (int r = 0; r < 16; ++r) { const int k2 = crow(r, hi); const unsigned w = pk2f(y0[r], y1[r]);
        dst[(size_t)(32 * k2) * 1024] = (bf16_t)(w & 0xffffu); dst[(size_t)(32 * (32 + k2)) * 1024] = (bf16_t)(w >> 16); }
    __syncthreads();
}
#undef FFT_PK
#undef FLAS
}
namespace pro {
#define PLAS __attribute__((address_space(3)))
typedef float f32x4 __attribute__((ext_vector_type(4)));
typedef unsigned u32x4 __attribute__((ext_vector_type(4)));
__device__ __forceinline__ unsigned pk2(float lo, float hi) { unsigned r; asm volatile("v_cvt_pk_bf16_f32 %0, %1, %2" : "=v"(r) : "v"(lo), "v"(hi)); return r; }
__device__ __forceinline__ float lo_f(unsigned w) { return __uint_as_float(w << 16); }
__device__ __forceinline__ float hi_f(unsigned w) { return __uint_as_float(w & 0xffff0000u); }
template <bool SUMS, int STRIDE> __device__ __forceinline__ void tile_emit(int K, bf16_t* WT, const float* gain, const float* lnb, float (&a1)[4], float (&a2)[4], const PLAS float* scr, int lane) {
    const int c = lane & 7; float gk[8], bk[8];
#pragma unroll
    for (int q = 0; q < 8; ++q) { gk[q] = gain ? gain[8 * c + q] : 1.f; bk[q] = lnb ? lnb[8 * c + q] : 0.f; }
#pragma unroll
    for (int j = 0; j < 4; ++j) { const int n = (lane >> 3) + 8 * j; const PLAS float* s = scr + (8 * c) * STRIDE + n; float v[8];
#pragma unroll
        for (int q = 0; q < 8; ++q) v[q] = s[q * STRIDE];
        u32x4 o; o.x = pk2(v[0] * gk[0], v[1] * gk[1]); o.y = pk2(v[2] * gk[2], v[3] * gk[3]); o.z = pk2(v[4] * gk[4], v[5] * gk[5]); o.w = pk2(v[6] * gk[6], v[7] * gk[7]);
        *(u32x4*)(WT + (size_t)n * K + 8 * c) = o;
        if (SUMS) { float p1 = (lo_f(o.x) + hi_f(o.x)) + (lo_f(o.y) + hi_f(o.y)) + (lo_f(o.z) + hi_f(o.z)) + (lo_f(o.w) + hi_f(o.w)); float p2 = 0.f;
#pragma unroll
            for (int q = 0; q < 8; ++q) p2 += bk[q] * v[q];
            p1 = xadd<1>(p1); p2 = xadd<1>(p2); p1 = xadd<2>(p1); p2 = xadd<2>(p2); p1 = xadd<4>(p1); p2 = xadd<4>(p2);
            a1[j] += p1; a2[j] += p2; }
    }
    asm volatile("s_waitcnt lgkmcnt(0)" ::: "memory");
}
__device__ __forceinline__ void tile_dma(const float* W, int N, PLAS float* scr, int lane) {
    const float* src = W + (size_t)(lane >> 3) * N + (lane & 7) * 4;
#pragma unroll
    for (int i = 0; i < 8; ++i) __builtin_amdgcn_global_load_lds((const unsigned*)(src + (size_t)(8 * i) * N), (PLAS unsigned*)(scr + i * 256), 16, 0, 0);
}
template <bool SUMS, class Val> __device__ __forceinline__ void tile_item(const Val& val, int K, bf16_t* WT, const float* gain, const float* lnb, float (&a1)[4], float (&a2)[4], PLAS float* scr, int lane) {
#pragma unroll 2
    for (int i = 0; i < 32; ++i) { const int kk = 2 * i + (lane >> 5); scr[kk * 33 + (lane & 31)] = val(kk, lane & 31); }
    asm volatile("s_waitcnt lgkmcnt(0)" ::: "memory");
    tile_emit<SUMS, 33>(K, WT, gain, lnb, a1, a2, scr, lane);
}
struct ValPlain { static constexpr int BATCH = 32; const float* W; int N; __device__ __forceinline__ float operator()(int kk, int j) const { return W[(size_t)kk * N + j]; } };
struct ValGate { static constexpr int BATCH = 2; const float* W; const float* w2; __device__ __forceinline__ float operator()(int kk, int j) const {
    const float* wr = W + (size_t)kk * cfg::INW; float a = 0.f;
#pragma unroll
    for (int r = 0; r < 16; ++r) a += wr[r] * w2[r * 128 + j]; return a; } };

__device__ __forceinline__ void fold_item(int item, unsigned char* ws, const float* w_in, const float* fw, const float* lng, const float* lnb, PLAS unsigned char* lds, int tid) {
    const int l = item >> 5, g = (item >> 3) & 3, part = (item >> 2) & 1, kq = item & 3;
    PLAS float* M = (PLAS float*)lds;
    { const int c = tid >> 3, e0 = (tid & 7) * 8; float acc[8];
#pragma unroll
      for (int q = 0; q < 8; ++q) acc[q] = 0.f;
      const float* w = fw + (size_t)((l * 4 + g) * 64) * 64 + e0;
      for (int k2 = 0; k2 < 64; ++k2) { float rev = (float)((k2 * c) & 63) * (1.f / 64.f); asm volatile("" : "+v"(rev)); const float tr = part ? __builtin_amdgcn_sinf(rev) : __builtin_amdgcn_cosf(rev);
          const f32x4 w0 = *(const f32x4*)(w + k2 * 64), w1 = *(const f32x4*)(w + k2 * 64 + 4);
#pragma unroll
          for (int q = 0; q < 4; ++q) { acc[q] += tr * w0[q]; acc[4 + q] += tr * w1[q]; } }
      const float sc = 0.00276213586400995f;
#pragma unroll
      for (int q = 0; q < 8; ++q) M[c * 64 + e0 + q] = acc[q] * sc; }
    __syncthreads();
    PLAS float* Wl = (PLAS float*)(lds + 16384);
    { const float* wsrc = w_in + ((size_t)l * 1024 + kq * 256) * cfg::INW + 1536 + 64 * g; f32x4 tv[8];
#pragma unroll
      for (int i = 0; i < 8; ++i) tv[i] = *(const f32x4*)(wsrc + (size_t)((tid >> 4) + 32 * i) * cfg::INW + (tid & 15) * 4);
#pragma unroll
      for (int i = 0; i < 8; ++i) *(PLAS f32x4*)(Wl + ((tid >> 4) + 32 * i) * 64 + (tid & 15) * 4) = tv[i]; }
    __syncthreads();
    { const int e = tid & 63, kg = tid >> 6, k0 = kq * 256 + kg * 32, np = 1536 + part * 256 + g * 64 + e; float mc[64];
#pragma unroll
      for (int c = 0; c < 64; ++c) mc[c] = M[c * 64 + e];
      bf16_t* dst = (bf16_t*)(ws + cfg::WS_WIN + l * cfg::SZ_WIN) + (size_t)np * 1024 + k0; float s1 = 0.f, s2 = 0.f;
      for (int kb = 0; kb < 4; ++kb) { float o[8];
#pragma unroll
          for (int q = 0; q < 8; ++q) { const int k = k0 + kb * 8 + q; const PLAS f32x4* wr = (const PLAS f32x4*)(Wl + (kg * 32 + kb * 8 + q) * 64); float a = 0.f;
#pragma unroll
              for (int c4 = 0; c4 < 16; ++c4) { const f32x4 w4 = wr[c4]; a += w4[0] * mc[4 * c4] + w4[1] * mc[4 * c4 + 1] + w4[2] * mc[4 * c4 + 2] + w4[3] * mc[4 * c4 + 3]; }
              o[q] = a * (lng ? lng[k] : 1.f); s2 += lnb ? lnb[k] * a : 0.f; }
          u32x4 w; w.x = pk2(o[0], o[1]); w.y = pk2(o[2], o[3]); w.z = pk2(o[4], o[5]); w.w = pk2(o[6], o[7]); *(u32x4*)(dst + kb * 8) = w;
          s1 += (lo_f(w.x) + hi_f(w.x)) + (lo_f(w.y) + hi_f(w.y)) + (lo_f(w.z) + hi_f(w.z)) + (lo_f(w.w) + hi_f(w.w)); }
      __syncthreads();
      PLAS float* red = (PLAS float*)lds; red[(kg * 64 + e) * 2] = s1; red[(kg * 64 + e) * 2 + 1] = s2;
      __syncthreads();
      if (kg == 0) { float t1 = 0.f, t2 = 0.f;
#pragma unroll
          for (int w = 0; w < 8; ++w) { t1 += red[(w * 64 + e) * 2]; t2 += red[(w * 64 + e) * 2 + 1]; }
          float* fp = (float*)(ws + cfg::V_MF) + (size_t)((l * 4 + kq) * 2) * 512 + part * 256 + g * 64 + e; fp[0] = t1; fp[512] = t2; } }
    __syncthreads();
}

struct Inputs { const float *x, *w_in, *fw, *gw2, *w_out, *ln1g, *ln1b, *wg, *wu, *wd, *ln2g, *ln2b; };
__device__ __forceinline__ void prologue(unsigned char* ws, const Inputs& in, PLAS unsigned char* lds, int vcu, int G) {
    int tid_o = threadIdx.x; asm volatile("" : "+v"(tid_o));
    const int tid = tid_o, wave = __builtin_amdgcn_readfirstlane(tid >> 6), lane = tid & 63;
    const float* x = in.x; const float* w_in = in.w_in; const float* fw = in.fw; const float* gw2 = in.gw2; const float* w_out = in.w_out; const float* ln1g = in.ln1g; const float* ln1b = in.ln1b;
    const float* wg = in.wg; const float* wu = in.wu; const float* wd = in.wd; const float* ln2g = in.ln2g; const float* ln2b = in.ln2b;
    if (vcu < 64) { const int l = vcu >> 5; fold_item(vcu, ws, w_in, fw, l ? ln2g : (const float*)nullptr, l ? ln2b : (const float*)nullptr, lds, tid); }
    PLAS float* scr = (PLAS float*)(lds + wave * 16384); PLAS float* scr1 = scr + 2048; PLAS float* redw = (PLAS float*)(lds + 131072 + 1024 + wave * 256);
    const int gw = vcu * 8 + wave, NGW = G * 8;
    for (int it = vcu; it < 512; it += G) {
        const int l = it >> 8, r = it & 255; float a1[4] = {0.f, 0.f, 0.f, 0.f}, a2[4] = {0.f, 0.f, 0.f, 0.f}; float* c1o; float* c2o;
        const int k0 = wave * 64, k1 = k0 + 512;
        if (r < 80) { const int nb = r; const float* lngb = l ? ln2g : (const float*)nullptr; const float* lnbb = l ? ln2b : (const float*)nullptr;
            bf16_t* Wt = (bf16_t*)(ws + cfg::WS_WIN + l * cfg::SZ_WIN);
            if (nb < 72) { int np0, src;
                if (nb < 32) { const int pn = nb >> 3, p = (nb & 7) * 32, wc = (p >> 5) & 3, bj = p >> 7; np0 = pn * 256 + p; src = (pn >> 1) * 512 + (pn & 1) * 256 + 64 * wc + 32 * bj; }
                else if (nb < 48) { np0 = 1024 + (nb - 32) * 32; src = np0; }
                else { np0 = 2048 + (nb - 48) * 32; src = 1792 + (nb - 48) * 32; }
                tile_dma(w_in + ((size_t)l * 1024 + k0) * cfg::INW + src, cfg::INW, scr, lane); tile_dma(w_in + ((size_t)l * 1024 + k1) * cfg::INW + src, cfg::INW, scr1, lane);
                asm volatile("s_waitcnt vmcnt(0)" ::: "memory");
                tile_emit<true, 32>(1024, Wt + (size_t)np0 * 1024 + k0, lngb ? lngb + k0 : lngb, lnbb ? lnbb + k0 : lnbb, a1, a2, scr, lane);
                tile_emit<true, 32>(1024, Wt + (size_t)np0 * 1024 + k1, lngb ? lngb + k1 : lngb, lnbb ? lnbb + k1 : lnbb, a1, a2, scr1, lane);
                c1o = (float*)(ws + cfg::V_C1IN) + l * cfg::NIN + np0; c2o = (float*)(ws + cfg::V_C2IN) + l * cfg::NIN + np0;
            } else { const int p0 = (nb - 72) * 32, dir = p0 >> 7, kk0 = p0 & 127, np0 = 2816 + p0;
                for (int kb = wave; kb < 16; kb += 8) { const int kq = kb * 64; ValGate v{w_in + ((size_t)l * 1024 + kq) * cfg::INW + 2560 + 16 * dir, gw2 + (size_t)((l * 2 + dir) * 16) * 128 + kk0};
                    tile_item<true>(v, 1024, Wt + (size_t)np0 * 1024 + kq, lngb ? lngb + kq : lngb, lnbb ? lnbb + kq : lnbb, a1, a2, scr, lane); }
                c1o = (float*)(ws + cfg::V_C1IN) + l * cfg::NIN + np0; c2o = (float*)(ws + cfg::V_C2IN) + l * cfg::NIN + np0; }
        } else { const int nb = r - 80, np0 = nb * 32, pn = np0 >> 8, p = np0 & 255, bj = p >> 7, f0 = 128 * pn + (p & 127);
            const float* W = (bj ? wu : wg) + (size_t)l * 1024 * cfg::FF + f0; bf16_t* Wt = (bf16_t*)(ws + cfg::WS_WGU + l * cfg::SZ_WGU) + (size_t)np0 * 1024;
            tile_dma(W + (size_t)k0 * cfg::FF, cfg::FF, scr, lane); tile_dma(W + (size_t)k1 * cfg::FF, cfg::FF, scr1, lane);
            asm volatile("s_waitcnt vmcnt(0)" ::: "memory");
            tile_emit<true, 32>(1024, Wt + k0, ln1g + l * 1024 + k0, ln1b + l * 1024 + k0, a1, a2, scr, lane);
            tile_emit<true, 32>(1024, Wt + k1, ln1g + l * 1024 + k1, ln1b + l * 1024 + k1, a1, a2, scr1, lane);
            c1o = (float*)(ws + cfg::V_C1GU) + l * cfg::NGU + np0; c2o = (float*)(ws + cfg::V_C2GU) + l * cfg::NGU + np0; }
        if ((lane & 7) == 0) {
#pragma unroll
            for (int j = 0; j < 4; ++j) { const int n = (lane >> 3) + 8 * j; redw[n * 2] = a1[j]; redw[n * 2 + 1] = a2[j]; } }
        __syncthreads();
        if (wave == 0 && lane < 32) { float t1 = 0.f, t2 = 0.f;
#pragma unroll
            for (int w = 0; w < 8; ++w) { const PLAS float* rw = (const PLAS float*)(lds + 131072 + 1024 + w * 256); t1 += rw[lane * 2]; t2 += rw[lane * 2 + 1]; }
            c1o[lane] = t1; c2o[lane] = t2; }
        __syncthreads();
    }
    constexpr int I_OUT = 32 * 16, I_DN = 32 * 44, I_L = I_OUT + I_DN;
    for (int it = gw; it < 2 * I_L; it += 2 * NGW) {
        const float* Ws[2]; int Ns[2], Ks[2]; bf16_t* Wd[2]; float d1[4], d2[4];
#pragma unroll
        for (int q = 0; q < 2; ++q) { const int itq = it + q * NGW; const int ic = itq < 2 * I_L ? itq : it; const int l = ic / I_L; int r = ic - l * I_L;
            if (r < I_OUT) { const int nb = r >> 4, kb = r & 15, k0 = kb * 64, n0 = nb * 32; Ws[q] = w_out + ((size_t)l * 1024 + k0) * 1024 + n0; Ns[q] = 1024; Ks[q] = 1024;
                Wd[q] = (bf16_t*)(ws + cfg::WS_WOUT + l * cfg::SZ_WOUT) + (size_t)n0 * 1024 + k0; }
            else { r -= I_OUT; const int nb = r / 44, kb = r - nb * 44, k0 = kb * 64, n0 = nb * 32; Ws[q] = wd + ((size_t)l * cfg::FF + k0) * 1024 + n0; Ns[q] = 1024; Ks[q] = cfg::FF;
                Wd[q] = (bf16_t*)(ws + cfg::WS_WDN + l * cfg::SZ_WDN) + (size_t)n0 * cfg::FF + k0; } }
        tile_dma(Ws[0], Ns[0], scr, lane); tile_dma(Ws[1], Ns[1], scr1, lane);
        asm volatile("s_waitcnt vmcnt(0)" ::: "memory");
        tile_emit<false, 32>(Ks[0], Wd[0], (const float*)nullptr, (const float*)nullptr, d1, d2, scr, lane);
        if (it + NGW < 2 * I_L) tile_emit<false, 32>(Ks[1], Wd[1], (const float*)nullptr, (const float*)nullptr, d1, d2, scr1, lane);
    }
    const int xw = (vcu - 64) * 8 + wave, NXW = (G - 64) * 8;
    if (vcu >= 64 && G > 64)
    for (int m = xw; m < cfg::T; m += 4 * NXW) {
        f32x4 v[4][4];
#pragma unroll
        for (int q = 0; q < 4; ++q) { const int mr = (m + q * NXW) < cfg::T ? (m + q * NXW) : m; const f32x4* xr = (const f32x4*)(x + (size_t)mr * 1024) + lane;
#pragma unroll
            for (int j = 0; j < 4; ++j) v[q][j] = xr[64 * j]; }
#pragma unroll
        for (int q = 0; q < 4; ++q) { const int mr = (m + q * NXW) < cfg::T ? (m + q * NXW) : m; unsigned long long* o8 = (unsigned long long*)((bf16_t*)(ws + cfg::WS_XB) + (size_t)mr * 1024) + lane;
#pragma unroll
            for (int j = 0; j < 4; ++j) o8[64 * j] = (unsigned long long)pk2(v[q][j][0], v[q][j][1]) | ((unsigned long long)pk2(v[q][j][2], v[q][j][3]) << 32); } }
    for (int i = gw * 64 + lane; i < 2048 * 32; i += NGW * 64) { const int pos = i >> 5, f = i & 31; const float inv = exp2f(-(float)f * (13.287712379549449f / 32.f)); const float ang = (float)pos * inv;
        double rv = (double)ang * 0.15915494309189535; rv -= floor(rv); const float rev = (float)rv;
        ((float*)(ws + cfg::V_ROPEC))[i] = __builtin_amdgcn_cosf(rev); ((float*)(ws + cfg::V_ROPES))[i] = __builtin_amdgcn_sinf(rev); }
}
#undef PLAS
}
constexpr int NWAVES = 8;
constexpr int RING_OFF = 0, RING_BYTES = 131072;
constexpr int LDSCTL_OFF = RING_BYTES, MISC_OFF = LDSCTL_OFF + 320;
constexpr int RSL_OFF = 131072 + 4096;
constexpr int LDS_BYTES = 147456;
constexpr int CW_BAR = 4096;
constexpr int CODE_PREWARM_BYTES = 192 * 1024;
constexpr int CW_GBAR = 8192, GBAR_STRIDE = 4096;
constexpr size_t CTL_ZERO_BYTES = 192 * 1024;
#define GAS __attribute__((address_space(1)))
#define LAS __attribute__((address_space(3)))
typedef GAS unsigned gu32;
#define RLX_AGENT __ATOMIC_RELAXED, __HIP_MEMORY_SCOPE_AGENT
#define XB_TMO      128
#define XB_XCNT(j)  (256  + 64 * (j))
#define XB_XSUB(j)  (1280 + 64 * (j))
#define XB_XGEN(j)  (2304 + 64 * (j))
#define XB_TOP      3328
#define XB_TOPGEN   3392
#define XCD_BAR_WORDS 3456
#define XB_SPIN_CAP (1u << 18)

__device__ __forceinline__ unsigned xb_ld(unsigned* p)              { return __hip_atomic_load(p, __ATOMIC_RELAXED, __HIP_MEMORY_SCOPE_AGENT); }
__device__ __forceinline__ unsigned xb_add(unsigned* p, unsigned v) { return __hip_atomic_fetch_add(p, v, __ATOMIC_RELAXED, __HIP_MEMORY_SCOPE_AGENT); }
__device__ __forceinline__ unsigned xb_xcc_id() { return (unsigned)__builtin_amdgcn_s_getreg((3 << 11) | 20) & 0xFu; }
#define XB_SPIN(cond, bar) do { unsigned _sp = 0; while (cond) { __builtin_amdgcn_s_sleep(1); \
    if ((++_sp & 255u) == 0u) { if (xb_ld(&(bar)[XB_TMO])) break; if (_sp > XB_SPIN_CAP) { atomicAdd(&(bar)[XB_TMO], 1u); break; } } } } while (0)

struct XcdBarrier {
    unsigned* bar; unsigned x; unsigned total;
    volatile LAS unsigned* st;
};

__device__ __forceinline__ XcdBarrier xcd_barrier_post(unsigned* bar, volatile LAS unsigned* st, unsigned total) {
    XcdBarrier b; b.bar = bar; b.x = xb_xcc_id(); b.st = st; b.total = total;
    if (threadIdx.x == 0) (void)xb_add(&bar[XB_XCNT(b.x)], 1u);
    return b;
}
__device__ __forceinline__ void xcd_barrier_complete(unsigned* bar, unsigned x, unsigned G, unsigned& nloc, unsigned& nx) {
    unsigned sum, cnt, mine, sp = 0u;
    for (;;) {
        sum = 0u; cnt = 0u; mine = 0u;
#pragma unroll
        for (unsigned j = 0; j < 16; ++j) { const unsigned c = xb_ld(&bar[XB_XCNT(j)]); sum += c; cnt += (c > 0u) ? 1u : 0u; mine = (j == x) ? c : mine; }
        if (sum == G) break;
        __builtin_amdgcn_s_sleep(1);
        if ((++sp & 255u) == 0u) { if (xb_ld(&bar[XB_TMO])) break; if (sp > XB_SPIN_CAP) { atomicAdd(&bar[XB_TMO], 1u); break; } }
    }
    nloc = mine > 0u ? mine : 1u; nx = cnt > 0u ? cnt : 1u;
}

__device__ __forceinline__ void xcd_barrier(const XcdBarrier& b) {
    asm volatile("s_waitcnt vmcnt(0)" ::: "memory");
    __syncthreads();
    if (threadIdx.x == 0) {
        unsigned* bar = b.bar;
        __builtin_amdgcn_s_waitcnt(0);
        unsigned nloc = b.st[0], nx = b.st[1];
        if (nloc == 0u) { xcd_barrier_complete(bar, b.x, b.total, nloc, nx); b.st[0] = nloc; b.st[1] = nx; }
        const unsigned old = xb_add(&bar[XB_XSUB(b.x)], 1u);
        const unsigned gen = old / nloc;
        if (old + 1u == (gen + 1u) * nloc) {
            __builtin_amdgcn_fence(__ATOMIC_RELEASE, "agent");
            asm volatile("s_waitcnt vmcnt(0)" ::: "memory");
            const unsigned og = xb_add(&bar[XB_TOP], 1u);
            const unsigned tg = og / nx;
            if (og + 1u == (tg + 1u) * nx) xb_add(&bar[XB_TOPGEN], 1u);
            else XB_SPIN(xb_ld(&bar[XB_TOPGEN]) == tg, bar);
            __builtin_amdgcn_fence(__ATOMIC_ACQUIRE, "agent");
            xb_add(&bar[XB_XGEN(b.x)], 1u);
            asm volatile("s_waitcnt vmcnt(0)" ::: "memory");
        } else {
            XB_SPIN(xb_ld(&bar[XB_XGEN(b.x)]) == gen, bar);
            __builtin_amdgcn_fence(__ATOMIC_ACQUIRE, "agent");
            asm volatile("s_waitcnt vmcnt(0)" ::: "memory");
        }
    }
    __syncthreads();
}


#define FILL_RSL(STP) do { pg8::Unit u0_; if (S.next(0, u0_)) { int tq_ = threadIdx.x; asm volatile("" : "+v"(tq_)); const int row_ = u0_.pm * 256 + (tq_ >> 1), hf_ = tq_ & 1; \
    typedef float f32x4_ __attribute__((ext_vector_type(4))); typedef float f32x2_ __attribute__((ext_vector_type(2))); \
    const f32x4_* sp_ = (const f32x4_*)((STP) + (size_t)row_ * 32 + hf_ * 16); const f32x4_ x0 = sp_[0], x1 = sp_[1], x2 = sp_[2], x3 = sp_[3]; \
    float sm_ = ((x0[0] + x0[2]) + (x1[0] + x1[2])) + ((x2[0] + x2[2]) + (x3[0] + x3[2])), sq_ = ((x0[1] + x0[3]) + (x1[1] + x1[3])) + ((x2[1] + x2[3]) + (x3[1] + x3[3])); \
    sm_ = xadd<1>(sm_); sq_ = xadd<1>(sq_); const float mu_ = sm_ * (1.f / 1024.f), rstd_ = rsqrtf(fmaxf(sq_ * (1.f / 1024.f) - mu_ * mu_, 0.f) + EPS); \
    if (hf_ == 0) *(LAS f32x2_*)(ldsl + RSL_OFF + 8 * (tq_ >> 1)) = (f32x2_){rstd_, -rstd_ * mu_}; } \
    __syncthreads(); } while (0)

enum { PH_PRO = 0, PH_IN = 1, PH_ATT = 2, PH_MIXB = 3, PH_OUT = 4, PH_GU = 5, PH_DN = 6, PH_FIN = 13, N_PHASES = 14 };
struct MArgs { const float* in[16]; float* out; unsigned char* ws; int ph_lo, ph_hi, li, pad; };

__global__ void __launch_bounds__(NWAVES * 64, 2) mk_fwd(MArgs a) {
    extern __shared__ __attribute__((aligned(128))) unsigned char lds[];
    LAS unsigned char* ldsl = (LAS unsigned char*)lds;
    volatile LAS unsigned* MISC = (volatile LAS unsigned*)(ldsl + MISC_OFF);
    const int tid = threadIdx.x;
    const int G = gridDim.x, bx = blockIdx.x, vcu = (G % 8 == 0) ? (bx % 8) * (G / 8) + bx / 8 : bx;
    unsigned char* ws = a.ws;
    typedef unsigned pw_u32x4 __attribute__((ext_vector_type(4))); pw_u32x4 pw_v = {0u, 0u, 0u, 0u};
    { unsigned long long pc_; asm volatile("s_getpc_b64 %0" : "=s"(pc_)); const unsigned off_ = (unsigned)(((bx >> 3) * (NWAVES * 64) + tid) * 16);
      if (CODE_PREWARM_BYTES > 0 && off_ < (unsigned)CODE_PREWARM_BYTES) pw_v = *(const volatile pw_u32x4*)((const char*)(pc_ & ~63ull) + off_); }
    for (int u = tid; u < (LDS_BYTES - LDSCTL_OFF) / 4; u += NWAVES * 64) ((LAS unsigned*)(ldsl + LDSCTL_OFF))[u] = 0u;
    __syncthreads();
    XcdBarrier bar; bar.bar = (unsigned*)(ws + WS_CTL) + CW_BAR + a.li * XCD_BAR_WORDS; bar.x = 0; bar.st = nullptr; bar.total = (unsigned)G;
    if (a.ph_hi - a.ph_lo > 1) bar = xcd_barrier_post((unsigned*)(ws + WS_CTL) + CW_BAR + a.li * XCD_BAR_WORDS, MISC + 8, (unsigned)G);
    const bool grp_ok = (G % 8 == 0) && (a.ph_hi - a.ph_lo > 1);
    XcdBarrier gbar = bar;
    if (grp_ok) gbar = xcd_barrier_post((unsigned*)(ws + WS_CTL) + CW_GBAR + (bx & 7) * GBAR_STRIDE, MISC + 10, (unsigned)(G / 8));
    const int G0 = G, bx0 = bx, vcu0 = vcu; unsigned char* const ws0 = ws;
    for (int ph = a.ph_lo; ph < a.ph_hi; ++ph) {
        int G = G0, bx = bx0, vcu = vcu0; unsigned zo = 0u; asm volatile("" : "+s"(G), "+s"(bx), "+s"(vcu), "+s"(zo)); unsigned char* ws = ws0 + zo;
        const int l = (ph >= 1 && ph <= 12) ? (ph - 1) / 6 : 0;
        const int kind = (ph == 0) ? PH_PRO : (ph == PH_FIN ? PH_FIN : 1 + (ph - 1) % 6);
        if (kind == PH_PRO) {
            { pro::Inputs pin{a.in[0], a.in[1], a.in[4], a.in[5], a.in[8], a.in[9], a.in[10], a.in[11], a.in[12], a.in[13], a.in[14], a.in[15]}; pro::prologue(ws, pin, ldsl + RING_OFF, vcu, G); }
            asm volatile("" :: "v"(pw_v));
        } else if (kind == PH_IN) {
            pg8::Gemm g{(const bf16_t*)(ws + WS_XB), (const bf16_t*)(ws + WS_WIN + l * SZ_WIN), T, NIN, D}; pg8::StaticOrder S; S.init(T, NIN, G, bx);
            if (l) FILL_RSL((const float*)(ws + WS_ST2));
            pg8::FEpiIn E{ws, a.in[6] + l * 256, l, (const LAS float*)(ldsl + RSL_OFF)};
            pg8::gemm_phase<pg8::FEpiIn, pg8::StaticOrder, true, true>(ldsl + RING_OFF, g, S, E);
        } else if (kind == PH_ATT) {
            for (int i = 0; i < 2; ++i) { const int idx = vcu * 2 + i; if (idx >= 512) break; const int bh = idx >> 4, qb = idx & 15;
                att::attn_unit(bh >> 2, bh & 3, qb, (const bf16_t*)(ws + WS_Q), (const bf16_t*)(ws + WS_K), (const bf16_t*)(ws + WS_V), (bf16_t*)(ws + WSB_OC + (size_t)(bh >> 2) * DLT_OC), a.in[2] + l * 256, a.in[3] + l * 128, l, (char*)lds + RING_OFF); }
            if (vcu * 2 + 1 < 512) {
                typedef unsigned u32x4_ __attribute__((ext_vector_type(4))); u32x4_ tva[4], tvb[4]; const int ia = vcu * 2, ib = ia + 1;
                fft::stage1_load(tva, ia >> 6, ia & 63, (const bf16_t*)(ws + WS_TAB)); fft::stage1_load(tvb, ib >> 6, ib & 63, (const bf16_t*)(ws + WS_TAB));
                fft::stage1_item(ia >> 6, ia & 63, tva, (bf16_t*)(ws + WS_XT), ldsl + RING_OFF); fft::stage1_item(ib >> 6, ib & 63, tvb, (bf16_t*)(ws + WS_XT), ldsl + RING_OFF); }
            if (vcu < 256) gla::gla_a_item(vcu >> 5, (vcu >> 3) & 3, vcu & 7, ws, ldsl + RING_OFF);
        } else if (kind == PH_MIXB) {
            if (vcu < 256) fft::stage2_item(vcu >> 5, vcu & 31, (const bf16_t*)(ws + WS_XT), (bf16_t*)(ws + WSB_OC + (size_t)(vcu >> 5) * DLT_OC), ldsl + RING_OFF);
            if (vcu < 256) gla::gla_b_item(vcu >> 5, (vcu >> 3) & 3, vcu & 7, ws, a.in[7] + l * 64, (bf16_t*)(ws + WSB_OC + (size_t)(vcu >> 5) * DLT_OC), ldsl + RING_OFF);
        } else if (kind == PH_OUT) {
            pg8::Gemm g{(const bf16_t*)(ws + WSB_OC + (size_t)(bx & 7) * DLT_OC), (const bf16_t*)(ws + WS_WOUT + l * SZ_WOUT), T, D, D}; pg8::StaticOrder S; S.init(T, D, G, bx);
            if (l) FILL_RSL((const float*)(ws + WS_ST2));
            pg8::FEpiRes E{l ? (const LAS float*)(ldsl + RSL_OFF) : (const LAS float*)nullptr, a.in[14] + (l ? l - 1 : 0) * 1024, a.in[15] + (l ? l - 1 : 0) * 1024, (bf16_t*)(ws + WS_XB), (float*)(ws + WS_ST1)};
            pg8::gemm_phase<pg8::FEpiRes, pg8::StaticOrder, true, true>(ldsl + RING_OFF, g, S, E);
        } else if (kind == PH_GU) {
            pg8::Gemm g{(const bf16_t*)(ws + WS_XB), (const bf16_t*)(ws + WS_WGU + l * SZ_WGU), T, NGU, D}; pg8::StaticOrder S; S.init(T, NGU, G, bx);
            FILL_RSL((const float*)(ws + WS_ST1));
            pg8::FEpiGU E{(const LAS float*)(ldsl + RSL_OFF), (const float*)(ws + V_C1GU) + l * NGU, (const float*)(ws + V_C2GU) + l * NGU, (bf16_t*)(ws + WS_ACT)};
            pg8::gemm_phase<pg8::FEpiGU, pg8::StaticOrder, true, true>(ldsl + RING_OFF, g, S, E);
        } else if (kind == PH_DN) {
            pg8::Gemm g{(const bf16_t*)(ws + WS_ACT), (const bf16_t*)(ws + WS_WDN + l * SZ_WDN), T, D, FF}; pg8::StaticOrder S; S.init(T, D, G, bx);
            FILL_RSL((const float*)(ws + WS_ST1));
            pg8::FEpiRes E{(const LAS float*)(ldsl + RSL_OFF), a.in[9] + l * 1024, a.in[10] + l * 1024, (bf16_t*)(ws + WS_XB), (float*)(ws + WS_ST2)};
            pg8::gemm_phase<pg8::FEpiRes, pg8::StaticOrder, true, true>(ldsl + RING_OFF, g, S, E);
        } else if (kind == PH_FIN) {
            const float* g2 = a.in[14] + 1024; const float* b2v = a.in[15] + 1024; const float* ST2 = (const float*)(ws + WS_ST2); const bf16_t* XB = (const bf16_t*)(ws + WS_XB); float* Y2 = a.out;
            int tid_f = threadIdx.x; asm volatile("" : "+v"(tid_f)); const int lane = tid_f & 63, wave = __builtin_amdgcn_readfirstlane(tid_f >> 6);
            typedef float f32x4 __attribute__((ext_vector_type(4))); typedef unsigned u32x2 __attribute__((ext_vector_type(2)));
            f32x4 gg[4], bq[4];
#pragma unroll
            for (int j = 0; j < 4; ++j) { gg[j] = *((const f32x4*)g2 + lane + 64 * j); bq[j] = *((const f32x4*)b2v + lane + 64 * j); }
            const bool grp_rows = (G % 8 == 0) && (S % ((G / 8) * NWAVES) == 0);
            const int r_first = grp_rows ? (bx & 7) * S + (bx >> 3) * NWAVES + wave : vcu * NWAVES + wave, r_step = grp_rows ? (G / 8) * NWAVES : G * NWAVES, r_end = grp_rows ? (bx & 7) * S + S : T;
            for (int row = r_first; row < r_end; row += r_step) { const RowStat rs = row_stat(ST2, row);
                const u32x2* xr = (const u32x2*)(XB + (size_t)row * 1024) + lane; f32x4* yr = (f32x4*)(Y2 + (size_t)row * 1024) + lane;
#pragma unroll
                for (int j = 0; j < 4; ++j) { const u32x2 w = xr[64 * j]; const f32x4 v = {__uint_as_float(w.x << 16), __uint_as_float(w.x & 0xffff0000u), __uint_as_float(w.y << 16), __uint_as_float(w.y & 0xffff0000u)};
                    yr[64 * j] = (v - rs.mu) * rs.rstd * gg[j] + bq[j]; } }
        }
        if (ph + 1 < a.ph_hi) { const bool local = grp_ok && kind != PH_PRO; if (local) xcd_barrier(gbar); else xcd_barrier(bar); }
    }
}

static void launch_frame(const MArgs& base, int lo, int hi, int grid, hipStream_t stream, int li = 0) {
    MArgs a = base; a.ph_lo = lo; a.ph_hi = hi; a.li = li;
    hipLaunchKernelGGL(mk_fwd, dim3(grid), dim3(NWAVES * 64), LDS_BYTES, stream, a);
}
extern "C" void kernel_launch(void* const* d_in, const int* in_sizes, int n_in, void* d_out, int out_size, void* d_ws, size_t ws_size, hipStream_t stream) {
    static int grid = 0;
    if (grid == 0) {
        if (n_in != 16 || in_sizes[0] != T * D || out_size != T * D || ws_size < WS_END) { fprintf(stderr, "kernel_launch: unexpected shapes (n_in %d, in0 %d, out %d, ws %zu)\n", n_in, n_in > 0 ? in_sizes[0] : -1, out_size, ws_size); grid = -1; return; }
        int dev = 0, cus = 0, per_cu = 0;
        if (hipGetDevice(&dev) != hipSuccess || hipDeviceGetAttribute(&cus, hipDeviceAttributeMultiprocessorCount, dev) != hipSuccess) { grid = -1; return; }
        if (hipFuncSetAttribute((const void*)mk_fwd, hipFuncAttributeMaxDynamicSharedMemorySize, LDS_BYTES) != hipSuccess) { fprintf(stderr, "kernel_launch: hipFuncSetAttribute failed\n"); grid = -1; return; }
        if (hipOccupancyMaxActiveBlocksPerMultiprocessor(&per_cu, (const void*)mk_fwd, NWAVES * 64, LDS_BYTES) != hipSuccess || per_cu < 1) { fprintf(stderr, "kernel_launch: occupancy query says %d workgroups per CU\n", per_cu); per_cu = 1; }
        (void)hipGetLastError();
        grid = cus;
        if (grid != 256) { fprintf(stderr, "kernel_launch: this kernel's work split is built for the 256 CUs of an MI355X, found %d; nothing launched\n", cus); grid = -1; return; }
    }
    if (grid < 0) return;
    const float* x = (const float*)d_in[0]; const float* w_in = (const float*)d_in[1]; const float* dlam = (const float*)d_in[2]; const float* dng = (const float*)d_in[3];
    const float* fw = (const float*)d_in[4]; const float* gw2 = (const float*)d_in[5]; const float* gb2 = (const float*)d_in[6]; const float* gng = (const float*)d_in[7];
    const float* w_out = (const float*)d_in[8]; const float* ln1g = (const float*)d_in[9]; const float* ln1b = (const float*)d_in[10];
    const float* wg = (const float*)d_in[11]; const float* wu = (const float*)d_in[12]; const float* wd = (const float*)d_in[13]; const float* ln2g = (const float*)d_in[14]; const float* ln2b = (const float*)d_in[15];
    char* ws = (char*)d_ws;
    float* ropec = (float*)(ws + V_ROPEC); float* ropes = (float*)(ws + V_ROPES); float* MF = (float*)(ws + V_MF);
    float* c1in = (float*)(ws + V_C1IN); float* c2in = (float*)(ws + V_C2IN); float* c1gu = (float*)(ws + V_C1GU); float* c2gu = (float*)(ws + V_C2GU);
    bf16_t* TAB = (bf16_t*)(ws + WS_TAB); bf16_t* XB = (bf16_t*)(ws + WS_XB);
    bf16_t* Q = (bf16_t*)(ws + WS_Q); bf16_t* K = (bf16_t*)(ws + WS_K); bf16_t* V = (bf16_t*)(ws + WS_V);
    bf16_t* GQK = (bf16_t*)(ws + WS_GQK); bf16_t* GV = (bf16_t*)(ws + WS_GV); bf16_t* GR = (bf16_t*)(ws + WS_GR); float* GL = (float*)(ws + WS_GL);
    bf16_t* OC = (bf16_t*)(ws + WS_OC); float* OF = (float*)(ws + WS_OF);
    (void)hipMemsetAsync(ws + WS_CTL, 0, CTL_ZERO_BYTES, stream);
    MArgs base{}; for (int i = 0; i < 16; ++i) base.in[i] = (const float*)d_in[i]; base.out = (float*)d_out; base.ws = (unsigned char*)d_ws;
    launch_frame(base, 0, N_PHASES, grid, stream, 0);
}
```

```cpp
#include <hip/hip_runtime.h>
#include <cstdint>
#include <cstdio>
#include <cmath>

typedef unsigned short bf16_t;
namespace cfg {
constexpr int B = 8, S = 2048, D = 1024, T = B * S, L = 2;
constexpr int INW = 2592, NIN = 3072, FF = 2816, NGU = 2 * FF;
constexpr float ALPHA = 1.41421356237309515f;
constexpr float EPS = 1e-5f;
constexpr float QSCALE = 0.125f * 1.4426950408889634f;
constexpr float GQSCALE = 0.17677669529663687f;
constexpr size_t MiB = 1u << 20;
constexpr size_t WS_CTL = 0;
constexpr size_t WS_VEC = 1 * MiB;
constexpr size_t V_ROPEC = WS_VEC, V_ROPES = WS_VEC + 256 * 1024, V_MF = WS_VEC + 512 * 1024;
constexpr size_t V_C1IN = WS_VEC + 768 * 1024, V_C2IN = V_C1IN + 24 * 1024, V_C1GU = V_C2IN + 24 * 1024, V_C2GU = V_C1GU + 44 * 1024;
constexpr size_t WS_WIN = 2 * MiB, WS_WOUT = 14 * MiB, WS_WGU = 18 * MiB, WS_WDN = 40 * MiB, WS_TAB = 51 * MiB;
constexpr size_t SZ_WIN = 6 * MiB, SZ_WOUT = 2 * MiB, SZ_WGU = 11 * MiB, SZ_WDN = 5632 * 1024;
constexpr size_t WS_XB = 67 * MiB;
constexpr size_t WS_Y1 = 99 * MiB, WS_Q = 99 * MiB, WS_K = 115 * MiB, WS_V = 131 * MiB, WS_XT = 147 * MiB;
constexpr size_t WS_ACT = 163 * MiB, WS_GQK = 163 * MiB, WS_GV = 171 * MiB, WS_GR = 179 * MiB, WS_GL = 187 * MiB, WS_OC = 203 * MiB, WS_OF = 235 * MiB;
constexpr size_t WSB_GQK = WS_ACT, WSB_GV = WS_ACT + 1 * MiB, WSB_GR = WS_ACT + 2 * MiB, WSB_GL = WS_ACT + 3 * MiB, WSB_OC = WS_ACT + 5 * MiB, WSB_OF = WS_ACT + 9 * MiB;
constexpr size_t DLT_GQK = 10 * MiB, DLT_GV = 10 * MiB, DLT_GR = 10 * MiB, DLT_GL = 9 * MiB, DLT_OC = 7 * MiB, DLT_OF = 9 * MiB;
constexpr size_t WS_ST1 = 251 * MiB, WS_ST2 = 253 * MiB, WS_DEC = 255 * MiB, WS_END = 256 * MiB;
}
using namespace cfg;

__device__ __forceinline__ float bf2f(bf16_t v) { return __uint_as_float((unsigned)v << 16); }
__device__ __forceinline__ bf16_t f2bf(float f) { unsigned u = __float_as_uint(f); return (bf16_t)((u + 0x7fffu + ((u >> 16) & 1u)) >> 16); }


template <int M> __device__ __forceinline__ float xadd(float v) {
    if constexpr (M == 32) { auto r = __builtin_amdgcn_permlane32_swap(__float_as_uint(v), __float_as_uint(v), false, false); return __uint_as_float(r[0]) + __uint_as_float(r[1]); }
    else return v + __int_as_float(__builtin_amdgcn_ds_swizzle(__float_as_int(v), (M << 10) | 0x1f));
}
struct RowStat { float mu, rstd; };
__device__ __forceinline__ RowStat row_stat(const float* ST, int row) {
    float s = 0.f, ss = 0.f;
    for (int i = 0; i < 8; ++i) { const float4 a = *(const float4*)(ST + (size_t)row * 32 + 4 * i); s += a.x + a.z; ss += a.y + a.w; }
    const float mu = s * (1.f / 1024.f); const float var = ss * (1.f / 1024.f) - mu * mu;
    RowStat r; r.mu = mu; r.rstd = rsqrtf(fmaxf(var, 0.f) + EPS); return r;
}
namespace pg8 {
#define PG8_LAS __attribute__((address_space(3)))
typedef unsigned short bf16_t;
typedef short bf16x8 __attribute__((ext_vector_type(8)));
typedef float f32x4 __attribute__((ext_vector_type(4)));
typedef unsigned u32x4 __attribute__((ext_vector_type(4)));
constexpr int BM = 256, BK = 64, HALF = 128, HTB = HALF * BK * 2  , STAGE_BYTES = 8 * HTB, NXCD = 8, WGM = 8;

__host__ __device__ __forceinline__ int lds_byte(int r, int c) { const int st = (r >> 4) * 2 + (c >> 5), rr = r & 15, cc = c & 31, ob = rr * 64 + cc * 2; return st * 1024 + (ob ^ (((ob >> 9) & 1) << 5)); }
__host__ __device__ __forceinline__ void stage_rc(int b, int& R, int& C) { const int st = b / 1024, sb = b % 1024, swz = sb ^ (((sb >> 9) & 1) << 5); R = (st >> 1) * 16 + swz / 64; C = (st & 1) * 32 + (swz % 64) / 2; }
__host__ __device__ __forceinline__ int perm32(int rho) { const int n = rho >> 4, i = rho & 15; return 8 * (i >> 2) + 4 * n + (i & 3); }

struct Unit { int pm, pn; };
struct Gemm { const bf16_t* A; const bf16_t* Bt; int M, N, K; };

struct StaticOrder {
    int nM, nN, nwg, G, c;
    __host__ __device__ void init(int M, int N, int G_, int c_) { nM = M / BM; nN = N / BM; nwg = nM * nN; G = G_; c = c_; }
    __host__ __device__ bool next(int i, Unit& u) const {
        const long L = (long)i * G + c; if (L >= nwg) return false;
        int wgid = (int)L; { const int q = nwg / NXCD, r = nwg % NXCD, xcd = wgid % NXCD, off = wgid / NXCD; wgid = (xcd < r ? xcd * (q + 1) : r * (q + 1) + (xcd - r) * q) + off; }
        const int nig = WGM * nN, gid = wgid / nig, fm = gid * WGM, gsz = (nM - fm) < WGM ? (nM - fm) : WGM;
        u.pm = fm + ((wgid % nig) % gsz); u.pn = (wgid % nig) / gsz; return true;
    }
    __device__ __forceinline__ void a_ready(const Unit&) const {}
    __device__ __forceinline__ void done(const Unit&) const {}
};
template <class Epi, class Sched, bool ALIGN_EPI = false, bool SP2 = false>
__device__ __forceinline__ void gemm_phase(PG8_LAS unsigned char* lds, const Gemm g, const Sched& S, const Epi& E) {
    int tid_o = threadIdx.x; asm volatile("" : "+v"(tid_o));
    const int tid = tid_o, wid = __builtin_amdgcn_readfirstlane(tid >> 6), lane = tid & 63, wr = wid >> 2, wc = wid & 3, fr = lane & 15, fq = lane >> 4;
    const int K = g.K, nt = K / BK;
    unsigned voffA[2], voffB[2];
#pragma unroll
    for (int i = 0; i < 2; ++i) { int R, C; stage_rc(tid * 16 + i * 8192, R, C); const int Rb = Epi::PERM ? ((R & ~31) + perm32(R & 31)) : R;
        voffA[i] = (unsigned)(R * K + C) * 2u; voffB[i] = (unsigned)(Rb * K + C) * 2u; }
    const size_t kstep = (size_t)(BK * 2);
    const size_t hstep = (size_t)HALF * K * 2;
    const size_t tstep = 2 * hstep;
    const unsigned ldsw = (unsigned)wid * 1024u;
    const int aoff = lds_byte(wr * 64 + fr, fq * 8), boff = lds_byte(wc * 32 + fr, fq * 8);
#define PG8_SA(b, h) (((b) * 2 + (h)) * HTB)
#define PG8_SB(b, h) ((4 + (b) * 2 + (h)) * HTB)
#define PG8_STAGE(bufoff, gbase, voff) do { _Pragma("unroll") for (int _i = 0; _i < 2; ++_i) \
        __builtin_amdgcn_global_load_lds((const unsigned*)((const char*)(gbase) + (voff)[_i]), (PG8_LAS unsigned*)(lds + (bufoff) + ldsw + _i * 8192), 16, 0, 0); } while (0)
#define PG8_LDA(dst, b, h) do { _Pragma("unroll") for (int m = 0; m < 4; ++m) _Pragma("unroll") for (int k = 0; k < 2; ++k) dst[m][k] = *(const PG8_LAS bf16x8*)(lds + PG8_SA(b, h) + aoff + m * 2048 + k * 1024); } while (0)
#define PG8_LDB(dst, b, h) do { _Pragma("unroll") for (int n = 0; n < 2; ++n) _Pragma("unroll") for (int k = 0; k < 2; ++k) dst[n][k] = *(const PG8_LAS bf16x8*)(lds + PG8_SB(b, h) + boff + n * 2048 + k * 1024); } while (0)
#define PG8_MMA(ai, bj, At, Bt) do { __builtin_amdgcn_s_setprio(1); _Pragma("unroll") for (int m = 0; m < 4; ++m) _Pragma("unroll") for (int n = 0; n < 2; ++n) _Pragma("unroll") for (int k = 0; k < 2; ++k) \
        acc[ai][bj][m][n] = __builtin_amdgcn_mfma_f32_16x16x32_bf16(Bt[n][k], At[m][k], acc[ai][bj][m][n], 0, 0, 0); __builtin_amdgcn_s_setprio(0); } while (0)
#define PG8_WAIT_V(n) asm volatile("s_waitcnt vmcnt(" #n ")" ::: "memory")
#define PG8_WAIT_L(n) asm volatile("s_waitcnt lgkmcnt(" #n ")" ::: "memory")
#define PG8_BAR __builtin_amdgcn_s_barrier()
#define PG8_SCHED __builtin_amdgcn_sched_barrier(0)
    Unit cur, nxt; int ui = 0;
    if (!S.next(0, cur)) return;
    f32x4 acc[2][2][4][2];
#pragma unroll
    for (int a = 0; a < 2; ++a)
#pragma unroll
        for (int b = 0; b < 2; ++b)
#pragma unroll
            for (int m = 0; m < 4; ++m)
#pragma unroll
                for (int n = 0; n < 2; ++n) acc[a][b][m][n] = (f32x4){0.f, 0.f, 0.f, 0.f};
    bf16x8 At[4][2], B0[2][2], B1[2][2];
    const char* cA = (const char*)g.A + (size_t)cur.pm * tstep; const char* cB = (const char*)g.Bt + (size_t)cur.pn * tstep;
    S.a_ready(cur);
    if constexpr (SP2) {
        PG8_STAGE(PG8_SB(0, 0), cB, voffB); PG8_STAGE(PG8_SB(0, 1), cB + hstep, voffB); PG8_STAGE(PG8_SA(0, 0), cA, voffA); PG8_STAGE(PG8_SA(0, 1), cA + hstep, voffA);
        if (wr == 1) PG8_BAR;
        PG8_WAIT_V(2); PG8_BAR;
        PG8_STAGE(PG8_SB(1, 0), cB + kstep, voffB); PG8_STAGE(PG8_SA(1, 0), cA + kstep, voffA); PG8_STAGE(PG8_SB(1, 1), cB + hstep + kstep, voffB);
        PG8_WAIT_V(6); PG8_BAR;
    } else {
        PG8_STAGE(PG8_SB(0, 0), cB, voffB); PG8_STAGE(PG8_SA(0, 0), cA, voffA); PG8_STAGE(PG8_SB(0, 1), cB + hstep, voffB); PG8_STAGE(PG8_SA(0, 1), cA + hstep, voffA);
        if (wr == 1) PG8_BAR;
        PG8_WAIT_V(4); PG8_BAR;
        PG8_STAGE(PG8_SB(1, 0), cB + kstep, voffB); PG8_STAGE(PG8_SA(1, 0), cA + kstep, voffA); PG8_STAGE(PG8_SB(1, 1), cB + hstep + kstep, voffB);
        PG8_WAIT_V(6); PG8_BAR;
    }
    for (;;) {
        const bool has_next = S.next(ui + 1, nxt);
        const char* nA = has_next ? (const char*)g.A + (size_t)nxt.pm * tstep : cA; const char* nB = has_next ? (const char*)g.Bt + (size_t)nxt.pn * tstep : cB;
        for (int t = 0; t < nt; t += 2) {
            const bool last = (t == nt - 2);
            const char* a1 = cA + (size_t)(t + 1) * kstep;
            const char* a2 = last ? nA : cA + (size_t)(t + 2) * kstep; const char* b2 = last ? nB : cB + (size_t)(t + 2) * kstep;
            const char* a3 = a2 + kstep; const char* b3 = b2 + kstep;
            if (last && has_next) S.a_ready(nxt);
            if constexpr (SP2) {
            PG8_LDB(B0, 0, 0); PG8_LDB(B1, 0, 1); PG8_SCHED; PG8_LDA(At, 0, 0); PG8_STAGE(PG8_SA(1, 1), a1 + hstep, voffA);
            PG8_WAIT_V(8); PG8_WAIT_L(0); PG8_BAR; PG8_MMA(0, 0, At, B0); PG8_MMA(0, 1, At, B1); PG8_BAR; PG8_SCHED;
            PG8_LDA(At, 0, 1); PG8_STAGE(PG8_SB(0, 0), b2, voffB); PG8_STAGE(PG8_SB(0, 1), b2 + hstep, voffB); PG8_STAGE(PG8_SA(0, 0), a2, voffA);
            PG8_WAIT_V(8); PG8_WAIT_L(0); PG8_BAR; PG8_MMA(1, 0, At, B0); PG8_MMA(1, 1, At, B1); PG8_BAR; PG8_SCHED;
            PG8_LDB(B0, 1, 0); PG8_LDB(B1, 1, 1); PG8_SCHED; PG8_LDA(At, 1, 0); PG8_STAGE(PG8_SA(0, 1), a2 + hstep, voffA);
            PG8_WAIT_V(8); PG8_WAIT_L(0); PG8_BAR; PG8_MMA(0, 0, At, B0); PG8_MMA(0, 1, At, B1); PG8_BAR; PG8_SCHED;
            PG8_LDA(At, 1, 1); PG8_STAGE(PG8_SB(1, 0), b3, voffB); PG8_STAGE(PG8_SB(1, 1), b3 + hstep, voffB); PG8_STAGE(PG8_SA(1, 0), a3, voffA);
            PG8_WAIT_V(8); PG8_WAIT_L(0); PG8_BAR; PG8_MMA(1, 0, At, B0); PG8_MMA(1, 1, At, B1); PG8_BAR; PG8_SCHED;
            } else {
            PG8_LDB(B0, 0, 0); PG8_SCHED; PG8_LDA(At, 0, 0); PG8_STAGE(PG8_SA(1, 1), a1 + hstep, voffA);
            PG8_WAIT_L(8); PG8_BAR; PG8_WAIT_L(0); PG8_MMA(0, 0, At, B0); PG8_BAR; PG8_SCHED;
            PG8_LDB(B1, 0, 1); PG8_STAGE(PG8_SB(0, 0), b2, voffB);
            PG8_BAR; PG8_WAIT_L(0); PG8_MMA(0, 1, At, B1); PG8_BAR;
            PG8_LDA(At, 0, 1); PG8_STAGE(PG8_SA(0, 0), a2, voffA);
            PG8_BAR; PG8_WAIT_L(0); PG8_MMA(1, 0, At, B0); PG8_BAR; PG8_SCHED;
            PG8_STAGE(PG8_SB(0, 1), b2 + hstep, voffB);
            PG8_WAIT_V(6); PG8_BAR; PG8_MMA(1, 1, At, B1); PG8_BAR;
            PG8_LDB(B0, 1, 0); PG8_SCHED; PG8_LDA(At, 1, 0); PG8_STAGE(PG8_SA(0, 1), a2 + hstep, voffA);
            PG8_WAIT_L(8); PG8_BAR; PG8_WAIT_L(0); PG8_MMA(0, 0, At, B0); PG8_BAR; PG8_SCHED;
            PG8_LDB(B1, 1, 1); PG8_STAGE(PG8_SB(1, 0), b3, voffB);
            PG8_BAR; PG8_WAIT_L(0); PG8_MMA(0, 1, At, B1); PG8_BAR;
            PG8_LDA(At, 1, 1); PG8_STAGE(PG8_SA(1, 0), a3, voffA);
            PG8_BAR; PG8_WAIT_L(0); PG8_MMA(1, 0, At, B0); PG8_BAR; PG8_SCHED;
            PG8_STAGE(PG8_SB(1, 1), b3 + hstep, voffB);
            PG8_WAIT_V(6); PG8_BAR; PG8_MMA(1, 1, At, B1); PG8_BAR;
            }
        }
        if constexpr (ALIGN_EPI) { if (wr == 0) PG8_BAR; }
        if constexpr (!Epi::AFTER_DRAIN) { E(acc, cur, wr, wc, fr, fq); S.done(cur); }
        if (!has_next) break;
#pragma unroll
        for (int a = 0; a < 2; ++a)
#pragma unroll
            for (int b = 0; b < 2; ++b)
#pragma unroll
                for (int m = 0; m < 4; ++m)
#pragma unroll
                    for (int n = 0; n < 2; ++n) acc[a][b][m][n] = (f32x4){0.f, 0.f, 0.f, 0.f};
        cur = nxt; cA = nA; cB = nB; ++ui;
        if constexpr (ALIGN_EPI) { if (wr == 1) PG8_BAR; }
    }
    PG8_WAIT_V(0);
    if constexpr (!ALIGN_EPI) { if (wr == 0) PG8_BAR; }
    PG8_BAR;
    if constexpr (Epi::AFTER_DRAIN) { E.fused(acc, cur, wr, wc, fr, fq, lds, wid, lane); S.done(cur); }
#undef PG8_SA
#undef PG8_SB
#undef PG8_STAGE
#undef PG8_LDA
#undef PG8_LDB
#undef PG8_MMA
#undef PG8_WAIT_V
#undef PG8_WAIT_L
#undef PG8_BAR
#undef PG8_SCHED
}
}
namespace pg8 {
__device__ __forceinline__ unsigned cvt_pk_bf16(float lo, float hi) { unsigned r; asm volatile("v_cvt_pk_bf16_f32 %0, %1, %2" : "=v"(r) : "v"(lo), "v"(hi)); return r; }
__device__ __forceinline__ void st8(bf16_t* p, const f32x4 a, const f32x4 b) { u32x4 w; w.x = cvt_pk_bf16(a[0], a[1]); w.y = cvt_pk_bf16(a[2], a[3]); w.z = cvt_pk_bf16(b[0], b[1]); w.w = cvt_pk_bf16(b[2], b[3]); *(u32x4*)p = w; }
__device__ __forceinline__ void st8nt(bf16_t* p, const f32x4 a, const f32x4 b) { u32x4 w; w.x = cvt_pk_bf16(a[0], a[1]); w.y = cvt_pk_bf16(a[2], a[3]); w.z = cvt_pk_bf16(b[0], b[1]); w.w = cvt_pk_bf16(b[2], b[3]); __builtin_nontemporal_store(w, (u32x4*)p); }
struct RS { float a, b; };
struct StatLd { f32x4 x, y; };
__device__ __forceinline__ StatLd stat_load(const float* ST, int row, int fq) { const f32x4* p = (const f32x4*)(ST + (size_t)row * 32 + fq * 8); StatLd r; r.x = p[0]; r.y = p[1]; return r; }
__device__ __forceinline__ RS stat_fin(const StatLd& t) {
    float s = (t.x[0] + t.x[2]) + (t.y[0] + t.y[2]), ss = (t.x[1] + t.x[3]) + (t.y[1] + t.y[3]);
    s = xadd<16>(s); ss = xadd<16>(ss); s = xadd<32>(s); ss = xadd<32>(ss);
    const float mu = s * (1.f / 1024.f), var = ss * (1.f / 1024.f) - mu * mu, rstd = rsqrtf(fmaxf(var, 0.f) + cfg::EPS);
    RS r; r.a = rstd; r.b = -rstd * mu; return r;
}
__device__ __forceinline__ RS row_stat16(const float* ST, int row, int fq) { return stat_fin(stat_load(ST, row, fq)); }
__device__ __forceinline__ float fsilu(float x) { return x * __builtin_amdgcn_rcpf(1.f + __expf(-x)); }
__device__ __forceinline__ float flogsig16(float x) { return (fminf(x, 0.f) - __logf(1.f + __expf(-fabsf(x)))) * (1.f / 16.f); }

struct FEpiIn {
    static constexpr bool PERM = true, AFTER_DRAIN = false;
    unsigned char* ws; const float* b2; int l; const PG8_LAS float* rsl;
    struct RowLd { f32x4 rc[2], rsn[2]; };
    template <int KIND> __device__ __forceinline__ RowLd load_row(int row, const float (&invf)[8]) const {
        RowLd r;
        if constexpr (KIND == 0) { const float pos = (float)(row & 2047);
#pragma unroll
            for (int e = 0; e < 8; ++e) { const float ang = pos * invf[e]; double rv = (double)ang * 0.15915494309189535; rv -= floor(rv); const float rev = (float)rv;
                r.rc[e >> 2][e & 3] = __builtin_amdgcn_cosf(rev); r.rsn[e >> 2][e & 3] = __builtin_amdgcn_sinf(rev); } }
        return r;
    }
    template <int KIND> __device__ __forceinline__ void rows(const f32x4 (&acc)[2][2][4][2], const Unit& u, int wr, int wc, int fr, int fq) const {
        const int pn = u.pn, cw = 32 * wc + 8 * fq, row0 = u.pm * BM + 64 * wr + fr;
        const bool st = l != 0;
        f32x4 k1[2][2], k2[2][2], bias[2][2];
        const float qs = __uint_as_float(__builtin_amdgcn_readfirstlane(__float_as_uint(pn < 2 ? cfg::QSCALE : 1.f)));
        float invf[8];
        if constexpr (KIND == 0) {
#pragma unroll
            for (int e = 0; e < 8; ++e) invf[e] = exp2f(-(float)(8 * fq + e) * (13.287712379549449f / 32.f)); }
        RowLd cur = load_row<KIND>(row0, invf), nxt;
        if (st) {
#pragma unroll
            for (int bj = 0; bj < 2; ++bj)
#pragma unroll
                for (int n = 0; n < 2; ++n) {
                    if constexpr (KIND == 2) {
                        const float* fp = (const float*)(ws + cfg::V_MF) + (size_t)(l * 8) * 512 + (pn - 6) * 256 + cw + 128 * bj + 4 * n;
                        k1[bj][n] = (*(const f32x4*)fp + *(const f32x4*)(fp + 1024)) + (*(const f32x4*)(fp + 2048) + *(const f32x4*)(fp + 3072));
                        k2[bj][n] = (*(const f32x4*)(fp + 512) + *(const f32x4*)(fp + 1536)) + (*(const f32x4*)(fp + 2560) + *(const f32x4*)(fp + 3584));
                    } else { const float* c1 = (const float*)(ws + cfg::V_C1IN) + l * cfg::NIN + pn * 256 + cw; const float* c2 = (const float*)(ws + cfg::V_C2IN) + l * cfg::NIN + pn * 256 + cw;
                        k1[bj][n] = *(const f32x4*)(c1 + 128 * bj + 4 * n); k2[bj][n] = *(const f32x4*)(c2 + 128 * bj + 4 * n); } } }
        if constexpr (KIND == 6) {
#pragma unroll
            for (int bj = 0; bj < 2; ++bj)
#pragma unroll
                for (int n = 0; n < 2; ++n) bias[bj][n] = *(const f32x4*)(b2 + 128 * bj + cw + 4 * n); }
#pragma unroll
        for (int i = 0; i < 8; ++i) {
            const int ai = i >> 2, m = i & 3, row = row0 + 128 * ai + 16 * m, pos = row & 2047;
            if (i < 7) nxt = load_row<KIND>(row0 + 128 * ((i + 1) >> 2) + 16 * ((i + 1) & 3), invf);
            f32x4 v[2][2];
            if (st) { typedef float f32x2 __attribute__((ext_vector_type(2))); const f32x2 t2 = *(const PG8_LAS f32x2*)(rsl + 2 * (128 * ai + 64 * wr + 16 * m + fr)); RS rs; rs.a = t2[0]; rs.b = t2[1];
#pragma unroll
                for (int bj = 0; bj < 2; ++bj)
#pragma unroll
                    for (int n = 0; n < 2; ++n) v[bj][n] = rs.a * acc[ai][bj][m][n] + (rs.b * k1[bj][n] + k2[bj][n]);
            } else {
#pragma unroll
                for (int bj = 0; bj < 2; ++bj)
#pragma unroll
                    for (int n = 0; n < 2; ++n) v[bj][n] = acc[ai][bj][m][n]; }
            if constexpr (KIND == 0) {
                f32x4 a0 = v[0][0] * cur.rc[0] - v[1][0] * cur.rsn[0], a1 = v[0][1] * cur.rc[1] - v[1][1] * cur.rsn[1];
                f32x4 b0 = v[1][0] * cur.rc[0] + v[0][0] * cur.rsn[0], b1 = v[1][1] * cur.rc[1] + v[0][1] * cur.rsn[1];
                a0 = a0 * qs; a1 = a1 * qs; b0 = b0 * qs; b1 = b1 * qs;
                bf16_t* dst = (bf16_t*)(ws + (pn < 2 ? cfg::WS_Q : cfg::WS_K)) + (size_t)row * 512 + (4 * (pn & 1) + wc) * 64 + 8 * fq;
                st8(dst, a0, a1); st8(dst + 32, b0, b1);
            } else if constexpr (KIND == 1) {
                bf16_t* dst = (bf16_t*)(ws + cfg::WS_V) + (size_t)row * 512 + (pn - 4) * 256 + cw; st8(dst, v[0][0], v[0][1]); st8(dst + 128, v[1][0], v[1][1]);
            } else if constexpr (KIND == 2) {
                bf16_t* dst = (bf16_t*)(ws + cfg::WS_TAB) + (size_t)row * 512 + (pn - 6) * 256 + cw; st8(dst, v[0][0], v[0][1]); st8(dst + 128, v[1][0], v[1][1]);
            } else if constexpr (KIND == 3) {
                bf16_t* dst = (bf16_t*)(ws + cfg::WSB_GQK + (size_t)(u.pm >> 3) * cfg::DLT_GQK) + (size_t)row * 256 + cw; st8(dst, v[0][0] * cfg::GQSCALE, v[0][1] * cfg::GQSCALE); st8(dst + 128, v[1][0], v[1][1]);
            } else if constexpr (KIND == 4) {
                bf16_t* dst = (bf16_t*)(ws + cfg::WSB_GV + (size_t)(u.pm >> 3) * cfg::DLT_GV) + (size_t)row * 256 + cw; st8(dst, v[0][0], v[0][1]); st8(dst + 128, v[1][0], v[1][1]);
            } else if constexpr (KIND == 5) {
                bf16_t* dst = (bf16_t*)(ws + cfg::WSB_GR + (size_t)(u.pm >> 3) * cfg::DLT_GR) + (size_t)row * 256 + cw;
#pragma unroll
                for (int bj = 0; bj < 2; ++bj) { f32x4 x0 = v[bj][0], x1 = v[bj][1];
#pragma unroll
                    for (int e = 0; e < 4; ++e) { x0[e] = fsilu(x0[e]); x1[e] = fsilu(x1[e]); } st8(dst + 128 * bj, x0, x1); }
            } else {
                float* dst = (float*)(ws + cfg::WSB_GL + (size_t)(u.pm >> 3) * cfg::DLT_GL) + (size_t)row * 256 + cw;
#pragma unroll
                for (int bj = 0; bj < 2; ++bj)
#pragma unroll
                    for (int n = 0; n < 2; ++n) { f32x4 x = v[bj][n] + bias[bj][n];
#pragma unroll
                        for (int e = 0; e < 4; ++e) x[e] = flogsig16(x[e]); *(f32x4*)(dst + 128 * bj + 4 * n) = x; }
            }
            if (i < 7) cur = nxt;
        }
    }
    __device__ __forceinline__ void operator()(const f32x4 (&acc)[2][2][4][2], const Unit& u, int wr, int wc, int fr, int fq) const {
        asm volatile("" : "+v"(fr), "+v"(fq));
        unsigned zo = 0u; asm volatile("" : "+s"(zo)); FEpiIn me = *this; me.ws = ws + zo;
        const int pn = u.pn;
        if (pn < 4) me.rows<0>(acc, u, wr, wc, fr, fq); else if (pn < 6) me.rows<1>(acc, u, wr, wc, fr, fq); else if (pn < 8) me.rows<2>(acc, u, wr, wc, fr, fq);
        else if (pn == 8) me.rows<3>(acc, u, wr, wc, fr, fq); else if (pn == 9) me.rows<4>(acc, u, wr, wc, fr, fq); else if (pn == 10) me.rows<5>(acc, u, wr, wc, fr, fq); else me.rows<6>(acc, u, wr, wc, fr, fq);
    }
};
struct FEpiRes {
    static constexpr bool PERM = true, AFTER_DRAIN = false;
    const PG8_LAS float* stprev;
    const float* g; const float* bb; bf16_t* XB; float* ST;
    struct RowLd { u32x4 xb[2]; };
    __device__ __forceinline__ RowLd load_row(int row, int col0, int fq) const {
        RowLd r; const size_t off = (size_t)row * 1024 + col0;
        r.xb[0] = *(const u32x4*)(XB + off); r.xb[1] = *(const u32x4*)(XB + off + 128);
        return r;
    }
    __device__ __forceinline__ void operator()(const f32x4 (&acc)[2][2][4][2], const Unit& u, int wr, int wc, int fr, int fq) const {
        asm volatile("" : "+v"(fr), "+v"(fq));
        const int col0 = u.pn * BM + 32 * wc + 8 * fq, row0 = u.pm * BM + 64 * wr + fr;
        f32x4 gv[2][2], bv[2][2];
        RowLd cur = load_row(row0, col0, fq), nxt;
        if (stprev) {
#pragma unroll
            for (int bj = 0; bj < 2; ++bj)
#pragma unroll
                for (int n = 0; n < 2; ++n) { gv[bj][n] = *(const f32x4*)(g + col0 + 128 * bj + 4 * n); bv[bj][n] = *(const f32x4*)(bb + col0 + 128 * bj + 4 * n); } }
#pragma unroll
        for (int i = 0; i < 8; ++i) { const int ai = i >> 2, m = i & 3, row = row0 + 128 * ai + 16 * m; const size_t off = (size_t)row * 1024 + col0;
            if (i < 7) nxt = load_row(row0 + 128 * ((i + 1) >> 2) + 16 * ((i + 1) & 3), col0, fq);
            RS rs; rs.a = 1.f; rs.b = 0.f; if (stprev) { typedef float f32x2 __attribute__((ext_vector_type(2))); const f32x2 t2 = *(const PG8_LAS f32x2*)(stprev + 2 * (128 * ai + 64 * wr + 16 * m + fr)); rs.a = t2[0]; rs.b = t2[1]; }
            float s = 0.f, ss = 0.f;
#pragma unroll
            for (int bj = 0; bj < 2; ++bj) { f32x4 y[2];
#pragma unroll
                for (int n = 0; n < 2; ++n) { const unsigned w0 = cur.xb[bj][2 * n], w1 = cur.xb[bj][2 * n + 1];
                    f32x4 x = (f32x4){__uint_as_float(w0 << 16), __uint_as_float(w0 & 0xffff0000u), __uint_as_float(w1 << 16), __uint_as_float(w1 & 0xffff0000u)};
                    if (stprev) x = (rs.a * x + rs.b) * gv[bj][n] + bv[bj][n];
                    y[n] = cfg::ALPHA * x + acc[ai][bj][m][n];
                    s += (y[n][0] + y[n][1]) + (y[n][2] + y[n][3]); ss += (y[n][0] * y[n][0] + y[n][1] * y[n][1]) + (y[n][2] * y[n][2] + y[n][3] * y[n][3]); }
                st8nt(XB + off + 128 * bj, y[0], y[1]); }
            s = xadd<16>(s); ss = xadd<16>(ss); s = xadd<32>(s); ss = xadd<32>(ss);
            if (fq == 0) { typedef float f32x2 __attribute__((ext_vector_type(2))); *(f32x2*)(ST + (size_t)row * 32 + (u.pn * 4 + wc) * 2) = (f32x2){s, ss}; }
            if (i < 7) cur = nxt; }
    }
};
struct FEpiGU {
    static constexpr bool PERM = true, AFTER_DRAIN = false;
    const PG8_LAS float* rsl;
    const float* c1; const float* c2; bf16_t* ACT;
    __device__ __forceinline__ void operator()(const f32x4 (&acc)[2][2][4][2], const Unit& u, int wr, int wc, int fr, int fq) const {
        asm volatile("" : "+v"(fr), "+v"(fq));
        const int cw = 32 * wc + 8 * fq, row0 = u.pm * BM + 64 * wr + fr; const float* c1p = c1 + u.pn * 256 + cw; const float* c2p = c2 + u.pn * 256 + cw;
        typedef float f32x2 __attribute__((ext_vector_type(2)));
        f32x4 k1[2][2], k2[2][2];
#pragma unroll
        for (int bj = 0; bj < 2; ++bj)
#pragma unroll
            for (int n = 0; n < 2; ++n) { k1[bj][n] = *(const f32x4*)(c1p + 128 * bj + 4 * n); k2[bj][n] = *(const f32x4*)(c2p + 128 * bj + 4 * n); }
#pragma unroll
        for (int i = 0; i < 8; ++i) { const int ai = i >> 2, m = i & 3; const f32x2 rs = *(const PG8_LAS f32x2*)(rsl + 2 * (128 * ai + 64 * wr + 16 * m + fr)); f32x4 a[2];
#pragma unroll
            for (int n = 0; n < 2; ++n) { const f32x4 hg = rs[0] * acc[ai][0][m][n] + (rs[1] * k1[0][n] + k2[0][n]), hu = rs[0] * acc[ai][1][m][n] + (rs[1] * k1[1][n] + k2[1][n]);
#pragma unroll
                for (int e = 0; e < 4; ++e) a[n][e] = fsilu(hg[e]) * hu[e]; }
            st8nt(ACT + (size_t)(row0 + 128 * ai + 16 * m) * cfg::FF + 128 * u.pn + cw, a[0], a[1]); }
    }
};
struct FEpiFour {
    static constexpr bool PERM = true, AFTER_DRAIN = false;
    bf16_t* OC;
    __device__ __forceinline__ void operator()(const f32x4 (&acc)[2][2][4][2], const Unit& u, int wr, int wc, int fr, int fq) const {
        asm volatile("" : "+v"(fr), "+v"(fq));
        const int cw = 32 * wc + 8 * fq;
#pragma unroll
        for (int ai = 0; ai < 2; ++ai)
#pragma unroll
            for (int m = 0; m < 4; ++m) { const int row = u.pm * BM + 128 * ai + 64 * wr + 16 * m + fr; bf16_t* dst = OC + (size_t)(u.pn * 2048 + row) * 1024 + 512 + cw;
                st8(dst, acc[ai][0][m][0], acc[ai][0][m][1]); st8(dst + 128, acc[ai][1][m][0], acc[ai][1][m][1]); }
    }
};
}
namespace att {
using bf16x8 = __attribute__((ext_vector_type(8))) short;
using s16x4  = __attribute__((ext_vector_type(4))) short;
using f32x16 = __attribute__((ext_vector_type(16))) float;
using u32x4  = __attribute__((ext_vector_type(4))) unsigned;
constexpr int NW = 8, QBLK = 32, KVBLK = 64, LD = 512, NT = cfg::S / KVBLK;
constexpr int SHM_V = KVBLK * 128 * 2, SHM_K = KVBLK * 128 * 2, SHM_X = 2 * SHM_V + 2 * SHM_K, SHM_ATTN = SHM_X + NW * 64 * 4;
constexpr float THRL = 6.0f;
#define ATT_KSWZ(row, colB) ((row) * 256 + ((colB) ^ (((row) & 7) << 4)))
#define ATT_SBAR() __builtin_amdgcn_sched_barrier(0)
__device__ __forceinline__ int crow(int r, int hi) { return (r & 3) + 8 * (r >> 2) + 4 * hi; }
__device__ __forceinline__ unsigned cvtpk(float lo, float hi) { unsigned r; asm volatile("v_cvt_pk_bf16_f32 %0, %1, %2" : "=v"(r) : "v"(lo), "v"(hi)); return r; }
__device__ __forceinline__ void softmaxP(f32x16& p0, f32x16& p1, float& m_reg, float& l_reg, f32x16& negm, float& alpha, bool first, bf16x8& pa0, bf16x8& pa1, bf16x8& pa2, bf16x8& pa3) {
#define ATT_M3(a, b, c) fmaxf(fmaxf(a, b), c)
  const float t0 = ATT_M3(p0[0], p0[1], p0[2]), t1 = ATT_M3(p0[3], p0[4], p0[5]), t2 = ATT_M3(p0[6], p0[7], p0[8]), t3 = ATT_M3(p0[9], p0[10], p0[11]), t4 = ATT_M3(p0[12], p0[13], p0[14]);
  const float t5 = ATT_M3(p0[15], p1[0], p1[1]), t6 = ATT_M3(p1[2], p1[3], p1[4]), t7 = ATT_M3(p1[5], p1[6], p1[7]), t8 = ATT_M3(p1[8], p1[9], p1[10]), t9 = ATT_M3(p1[11], p1[12], p1[13]);
  const float u0 = ATT_M3(t0, t1, t2), u1 = ATT_M3(t3, t4, t5), u2 = ATT_M3(t6, t7, t8), u3 = ATT_M3(t9, p1[14], p1[15]);
  float pmax = fmaxf(fmaxf(u0, u1), fmaxf(u2, u3));
#undef ATT_M3
  { auto rr = __builtin_amdgcn_permlane32_swap(__float_as_uint(pmax), __float_as_uint(pmax), false, false); pmax = fmaxf(__uint_as_float(rr[0]), __uint_as_float(rr[1])); }
  const float thr = first ? -3.0e38f : THRL;
  if (__builtin_expect(__all(pmax <= thr), 1)) { alpha = 1.f; }
  else { const float dl = first ? pmax : fmaxf(pmax, 0.f); alpha = first ? 0.f : __builtin_amdgcn_exp2f(-dl); m_reg += dl;
#pragma unroll
    for (int r = 0; r < 16; ++r) { p0[r] -= dl; p1[r] -= dl; negm[r] -= dl; } }
#pragma unroll
  for (int r = 0; r < 16; ++r) p0[r] = __builtin_amdgcn_exp2f(p0[r]);
#pragma unroll
  for (int r = 0; r < 16; ++r) p1[r] = __builtin_amdgcn_exp2f(p1[r]);
  { float q0 = p0[0] + p1[0], q1 = p0[1] + p1[1], q2 = p0[2] + p1[2], q3 = p0[3] + p1[3];
#pragma unroll
    for (int r = 4; r < 16; r += 4) { q0 += p0[r] + p1[r]; q1 += p0[r + 1] + p1[r + 1]; q2 += p0[r + 2] + p1[r + 2]; q3 += p0[r + 3] + p1[r + 3]; }
    float ps = (q0 + q1) + (q2 + q3);
    auto rr = __builtin_amdgcn_permlane32_swap(__float_as_uint(ps), __float_as_uint(ps), false, false); ps = __uint_as_float(rr[0]) + __uint_as_float(rr[1]);
    l_reg = l_reg * alpha + ps; }
#define ATT_PK4(P, BASE, OUT) do { u32x4 w = {cvtpk(P[BASE + 0], P[BASE + 1]), cvtpk(P[BASE + 2], P[BASE + 3]), cvtpk(P[BASE + 4], P[BASE + 5]), cvtpk(P[BASE + 6], P[BASE + 7])}; \
    OUT = *reinterpret_cast<bf16x8*>(&w); } while (0)
  ATT_PK4(p0, 0, pa0); ATT_PK4(p0, 8, pa1); ATT_PK4(p1, 0, pa2); ATT_PK4(p1, 8, pa3);
#undef ATT_PK4
}
template <int OFF> __device__ __forceinline__ bf16x8 k_read(int ka) { bf16x8 r; asm volatile("ds_read_b128 %0, %1 offset:%2" : "=&v"(r) : "v"(ka), "i"(OFF) : "memory"); return r; }
template <int KB> __device__ __forceinline__ void k_load2(bf16x8* kf, int ka0, int ka1) {
  kf[0] = k_read<KB * SHM_K>(ka0); kf[1] = k_read<KB * SHM_K + 8192>(ka0); kf[2] = k_read<KB * SHM_K>(ka1); kf[3] = k_read<KB * SHM_K + 8192>(ka1);
}
__device__ __forceinline__ void qk_mma2(f32x16& p0, f32x16& p1, const bf16x8* kf, bf16x8 q0, bf16x8 q1) {
  p0 = __builtin_amdgcn_mfma_f32_32x32x16_bf16(kf[0], q0, p0, 0, 0, 0); p1 = __builtin_amdgcn_mfma_f32_32x32x16_bf16(kf[1], q0, p1, 0, 0, 0);
  p0 = __builtin_amdgcn_mfma_f32_32x32x16_bf16(kf[2], q1, p0, 0, 0, 0); p1 = __builtin_amdgcn_mfma_f32_32x32x16_bf16(kf[3], q1, p1, 0, 0, 0);
}
__device__ __forceinline__ int v_st(int k, int c) { return ((k >> 3) * 4 + (c >> 5)) * 512 + ((k & 7) * 32 + (c & 31)) * 2; }
__device__ __forceinline__ int v_rd_base(int lane) { return ((lane & 3) << 3) | (((lane >> 2) & 3) << 6) | (((lane >> 4) & 1) << 5) | (((lane >> 5) & 1) << 8); }
constexpr int v_rd_off(int d0, int ks, int half) { return d0 * 512 + ks * 4096 + half * 2048; }
template <int OFF> __device__ __forceinline__ s16x4 tr_read(int vb) { s16x4 r; asm volatile("ds_read_b64_tr_b16 %0, %1 offset:%2" : "=&v"(r) : "v"(vb), "i"(OFF) : "memory"); return r; }
struct VF { s16x4 l[4], h[4]; };
template <int KS> __device__ __forceinline__ void vf_load(VF& f, int vb) {
  f.l[0] = tr_read<v_rd_off(0, KS, 0)>(vb); f.h[0] = tr_read<v_rd_off(0, KS, 1)>(vb); f.l[1] = tr_read<v_rd_off(1, KS, 0)>(vb); f.h[1] = tr_read<v_rd_off(1, KS, 1)>(vb);
  f.l[2] = tr_read<v_rd_off(2, KS, 0)>(vb); f.h[2] = tr_read<v_rd_off(2, KS, 1)>(vb); f.l[3] = tr_read<v_rd_off(3, KS, 0)>(vb); f.h[3] = tr_read<v_rd_off(3, KS, 1)>(vb);
}
__device__ __forceinline__ void pv_step(f32x16* o, bf16x8 pa, const VF& f) {
#define ATT_PK(L, H) (bf16x8){L[0], L[1], L[2], L[3], H[0], H[1], H[2], H[3]}
  o[0] = __builtin_amdgcn_mfma_f32_32x32x16_bf16(pa, ATT_PK(f.l[0], f.h[0]), o[0], 0, 0, 0);
  o[1] = __builtin_amdgcn_mfma_f32_32x32x16_bf16(pa, ATT_PK(f.l[1], f.h[1]), o[1], 0, 0, 0);
  o[2] = __builtin_amdgcn_mfma_f32_32x32x16_bf16(pa, ATT_PK(f.l[2], f.h[2]), o[2], 0, 0, 0);
  o[3] = __builtin_amdgcn_mfma_f32_32x32x16_bf16(pa, ATT_PK(f.l[3], f.h[3]), o[3], 0, 0, 0);
#undef ATT_PK
}
#define ATT_LWAIT(n) do { asm volatile("s_waitcnt lgkmcnt(" #n ")" ::: "memory"); ATT_SBAR(); } while (0)
template <int MP> __device__ __forceinline__ void att_give(const f32x16* o, float* Xw, int r32, int hi) {
  constexpr int RG = MP ? 0 : 8;
#pragma unroll
  for (int rr = 0; rr < 8; ++rr)
#pragma unroll
    for (int d0 = 0; d0 < 4; ++d0) Xw[(crow(RG + rr, hi) & 15) * 128 + d0 * 32 + r32] = o[d0][RG + rr];
}
template <int MP> __device__ __forceinline__ void att_fin(const f32x16* o, const float* Xr, float lam, const float (&gq)[4], bf16_t* OCw, int r32, int hi, int lane) {
  constexpr int RK = MP ? 8 : 0;
  unsigned pk[8][4];
#pragma unroll
  for (int rr = 0; rr < 8; ++rr) { const int lr = crow(RK + rr, hi) & 15;
    float df[4], ssq = 0.f;
#pragma unroll
    for (int d0 = 0; d0 < 4; ++d0) { const float x = Xr[lr * 128 + d0 * 32 + r32]; df[d0] = MP ? x - lam * o[d0][RK + rr] : o[d0][RK + rr] - lam * x; ssq += df[d0] * df[d0]; }
    ssq = xadd<1>(ssq); ssq = xadd<2>(ssq); ssq = xadd<4>(ssq); ssq = xadd<8>(ssq); ssq = xadd<16>(ssq);
    const float rn = rsqrtf(ssq * (1.f / 128.f) + cfg::EPS);
#pragma unroll
    for (int d0 = 0; d0 < 4; ++d0) pk[rr][d0] = cvtpk(df[d0] * rn * gq[d0], 0.f); }
  char* stg = (char*)Xr;
#pragma unroll
  for (int rr = 0; rr < 8; ++rr) { const int lr = crow(RK + rr, hi) & 15;
#pragma unroll
    for (int d0 = 0; d0 < 4; ++d0) *(unsigned short*)(stg + lr * 272 + (d0 * 32 + r32) * 2) = (unsigned short)pk[rr][d0]; }
#pragma unroll
  for (int i = 0; i < 4; ++i) { const int c = lane + 64 * i, row = c >> 4, cc = c & 15;
    const u32x4 v = *(const u32x4*)(stg + row * 272 + cc * 16); *(u32x4*)(OCw + (size_t)row * 1024 + cc * 8) = v; }
}
__device__ __forceinline__ void attn_unit(int b, int h, int qb, const bf16_t* __restrict__ Qg, const bf16_t* __restrict__ Kg, const bf16_t* __restrict__ Vg, bf16_t* __restrict__ OC,
                                          const float* __restrict__ lamp, const float* __restrict__ dgv, int layer, char* lds) {
  int tid_o = threadIdx.x; asm volatile("" : "+v"(tid_o));
  const int tid = tid_o, wid = __builtin_amdgcn_readfirstlane(tid >> 6), lane = tid & 63, r32 = lane & 31, hi = lane >> 5, mp = wid >> 2, wl = wid & 3, mofs = mp * 64;
  char* V_lds = lds; char* K_lds = lds + 2 * SHM_V;
  float* ws = (float*)(lds + SHM_X) + wid * 64; float* al_l = ws + 32;
  float m_reg = 0.f, l_reg = 0.f; f32x16 o[4] = {}, negm = {}; bf16x8 qr[4];
  const int q0 = qb * 128 + wl * QBLK;
  const bf16_t* Qw = Qg + (size_t)(b * cfg::S + q0 + r32) * LD + h * 128 + mofs + hi * 8;
#pragma unroll
  for (int d0 = 0; d0 < 4; ++d0) qr[d0] = *reinterpret_cast<const bf16x8*>(Qw + d0 * 16);
  const bf16_t* Kh = Kg + (size_t)b * cfg::S * LD + h * 128; const bf16_t* Vh = Vg + (size_t)b * cfg::S * LD + h * 128;
  const int vb0 = (int)(uintptr_t)V_lds + v_rd_base(lane);
  const int ka0 = (int)(uintptr_t)K_lds + ATT_KSWZ(r32, (mofs + hi * 8) * 2);
  const int gt = tid & 255, gr = gt >> 4, gc = (gt & 15) * 8;
  const bf16_t* gsrc = (mp ? Kh : Vh) + (size_t)gr * LD + gc;
  char* gdst = mp ? K_lds + ATT_KSWZ(gr, gc * 2) : V_lds + v_st(gr, gc);
  const int tofs = mp ? 2 : 0;
  bf16x8 st_[2][4];
#define ATT_GLOAD(i, t) do { const int t_ = (t) < NT ? (t) : NT - 1;     \
    _Pragma("unroll") for (int q_ = 0; q_ < 4; ++q_) st_[i][q_] = *reinterpret_cast<const bf16x8*>(gsrc + (size_t)(t_ * 64 + 16 * q_) * LD); } while (0)
#define ATT_GWRITE(i, t) do { asm volatile("s_waitcnt vmcnt(4)" ::: "memory"); if ((t) < NT) { \
    _Pragma("unroll") for (int q_ = 0; q_ < 4; ++q_) *(bf16x8*)(gdst + (i) * 16384 + q_ * 4096) = st_[i][q_]; } } while (0)
#define ATT_RESC(a) do { if (__any((a) < 1.f)) { if (hi == 0) al_l[r32] = (a); asm volatile("s_waitcnt lgkmcnt(0)" ::: "memory"); \
    _Pragma("unroll") for (int r = 0; r < 16; ++r) { const float a_ = al_l[crow(r, hi)]; _Pragma("unroll") for (int d = 0; d < 4; ++d) o[d][r] *= a_; } } } while (0)
  f32x16 s0, s1; float al; bf16x8 pa0, pa1, pa2, pa3, kf[8]; VF f0, f1;
#define ATT_VSEG(I, p) do { ATT_GWRITE(I, (p) + tofs); ATT_GLOAD(I, (p) + tofs + 2); ATT_SBAR(); \
    softmaxP(s0, s1, m_reg, l_reg, negm, al, (p) == 0, pa0, pa1, pa2, pa3); ATT_RESC(al); } while (0)
#define ATT_OL(pa) do { } while (0)
#define ATT_QK(KB) do { k_load2<KB>(kf, ka0, ka0 ^ 32); k_load2<KB>(kf + 4, ka0 ^ 64, ka0 ^ 96); ATT_LWAIT(4); s0 = negm; s1 = negm; qk_mma2(s0, s1, kf, qr[0], qr[1]); ATT_LWAIT(0); qk_mma2(s0, s1, kf + 4, qr[2], qr[3]); ATT_SBAR(); } while (0)
#define ATT_MSEG(VB, KB, QK) do { vf_load<0>(f0, vb0 + (VB) * SHM_V); vf_load<1>(f1, vb0 + (VB) * SHM_V); ATT_SBAR(); \
    ATT_LWAIT(8); pv_step(o, pa0, f0); ATT_OL(pa0); vf_load<2>(f0, vb0 + (VB) * SHM_V); \
    ATT_LWAIT(8); pv_step(o, pa1, f1); ATT_OL(pa1); vf_load<3>(f1, vb0 + (VB) * SHM_V); \
    if constexpr (QK) { k_load2<KB>(kf, ka0, ka0 ^ 32); ATT_LWAIT(12); } else ATT_LWAIT(8); \
    pv_step(o, pa2, f0); ATT_OL(pa2); \
    if constexpr (QK) ATT_LWAIT(4); else ATT_LWAIT(0); \
    pv_step(o, pa3, f1); ATT_OL(pa3); \
    if constexpr (QK) { k_load2<KB>(kf + 4, ka0 ^ 64, ka0 ^ 96); ATT_LWAIT(4); s0 = negm; s1 = negm; qk_mma2(s0, s1, kf, qr[0], qr[1]); ATT_LWAIT(0); qk_mma2(s0, s1, kf + 4, qr[2], qr[3]); } ATT_SBAR(); } while (0)
  { const int kr = tid >> 4, kc = (tid & 15) * 8;
    const bf16x8 k0 = *reinterpret_cast<const bf16x8*>(&Kh[(size_t)kr * LD + kc]), k1 = *reinterpret_cast<const bf16x8*>(&Kh[(size_t)(32 + kr) * LD + kc]);
    const bf16x8 k2 = *reinterpret_cast<const bf16x8*>(&Kh[(size_t)(64 + kr) * LD + kc]), k3 = *reinterpret_cast<const bf16x8*>(&Kh[(size_t)(96 + kr) * LD + kc]);
    ATT_GLOAD(0, tofs); ATT_GLOAD(1, tofs + 1);
    asm volatile("s_waitcnt vmcnt(8)" ::: "memory");
    *(bf16x8*)(K_lds + ATT_KSWZ(kr, kc * 2)) = k0; *(bf16x8*)(K_lds + ATT_KSWZ(32 + kr, kc * 2)) = k1;
    *(bf16x8*)(K_lds + SHM_K + ATT_KSWZ(kr, kc * 2)) = k2; *(bf16x8*)(K_lds + SHM_K + ATT_KSWZ(32 + kr, kc * 2)) = k3; }
  __syncthreads();
  if (mp) __syncthreads();
  ATT_QK(0); __syncthreads();
  for (int p = 0; p + 2 < NT; p += 2) {
    ATT_VSEG(0, p);           __syncthreads();
    ATT_MSEG(0, 1, true);     __syncthreads();
    ATT_VSEG(1, p + 1);       __syncthreads();
    ATT_MSEG(1, 0, true);     __syncthreads();
  }
  ATT_VSEG(0, NT - 2);   __syncthreads();
  ATT_MSEG(0, 1, true);   __syncthreads();
  ATT_VSEG(1, NT - 1);   __syncthreads();
  ATT_MSEG(1, 0, false);  __syncthreads();
  if (!mp) __syncthreads();
  const float lp0 = lamp[lane], lp1 = lamp[64 + lane], lp2 = lamp[128 + lane], lp3 = lamp[192 + lane];
  float gq[4];
#pragma unroll
  for (int d0 = 0; d0 < 4; ++d0) gq[d0] = dgv[d0 * 32 + r32];
  float* li_l = ws; if (hi == 0) li_l[r32] = l_reg; asm volatile("s_waitcnt lgkmcnt(0)" ::: "memory");
#pragma unroll
  for (int r = 0; r < 16; ++r) { const float rl = __builtin_amdgcn_rcpf(li_l[crow(r, hi)]);
#pragma unroll
    for (int d0 = 0; d0 < 4; ++d0) o[d0][r] *= rl; }
  __syncthreads();
  float* X = (float*)lds;
  const float* Xr = X + wid * 2048; float* Xw = X + (wid ^ 4) * 2048;
  int layer_o = __builtin_amdgcn_readfirstlane(layer); asm volatile("" : "+s"(layer_o)); const float lam_init = layer_o == 0 ? 0.2f : 0.35550906759f;
  if (mp == 0) att_give<0>(o, Xw, r32, hi); else att_give<1>(o, Xw, r32, hi);
  float lam; { float s1 = lp0 * lp1, s2 = lp2 * lp3;
    s1 = xadd<1>(s1); s2 = xadd<1>(s2); s1 = xadd<2>(s1); s2 = xadd<2>(s2); s1 = xadd<4>(s1); s2 = xadd<4>(s2); s1 = xadd<8>(s1); s2 = xadd<8>(s2); s1 = xadd<16>(s1); s2 = xadd<16>(s2); s1 = xadd<32>(s1); s2 = xadd<32>(s2);
    lam = __expf(s1) - __expf(s2) + lam_init; }
#pragma unroll
  for (int d0 = 0; d0 < 4; ++d0) gq[d0] *= (1.f - lam_init);
  __syncthreads();
  bf16_t* OCw = OC + (size_t)(b * cfg::S + q0 + 16 * mp) * 1024 + h * 128;
  if (mp == 0) att_fin<0>(o, Xr, lam, gq, OCw, r32, hi, lane); else att_fin<1>(o, Xr, lam, gq, OCw, r32, hi, lane);
  __syncthreads();
#undef ATT_GLOAD
#undef ATT_GWRITE
#undef ATT_VSEG
#undef ATT_MSEG
#undef ATT_RESC
#undef ATT_OL
#undef ATT_QK
}
#undef ATT_KSWZ
#undef ATT_SBAR
}
namespace gla {
using att::bf16x8; using att::s16x4; using att::f32x16; using att::u32x4; using att::crow; using att::cvtpk; using att::tr_read;
typedef float f32x4 __attribute__((ext_vector_type(4)));
typedef unsigned u32x2 __attribute__((ext_vector_type(2)));
#define GLAS __attribute__((address_space(3)))
constexpr int KT_STRIDE = 144;
constexpr int A_KT = 0, A_V = 36864, A_BEND = A_V + 32768;
constexpr int B_QT = 0, B_KT = 32768, B_V = 65536, B_SC = 98304;
__device__ __forceinline__ int v_st64(int k, int c) { const int kk = (k & ~0xC) | ((k & 4) << 1) | ((k & 8) >> 1); return ((kk >> 3) * 2 + (c >> 5)) * 512 + ((kk & 7) * 32 + (c & 31)) * 2; }
constexpr int v_off64(int d0, int ks, int half) { return d0 * 512 + ks * 2048 + half * 1024; }
__device__ __forceinline__ float bf2f_(unsigned short v) { return __uint_as_float((unsigned)v << 16); }
__device__ __forceinline__ void load_v_tile(const bf16_t* __restrict__ src, GLAS unsigned char* dst, int lane) {
    u32x4 tv[8];
#pragma unroll
    for (int i = 0; i < 8; ++i) { const int row = (lane >> 3) + 8 * i, ch = lane & 7; tv[i] = *(const u32x4*)(src + (size_t)row * 256 + ch * 8); }
#pragma unroll
    for (int i = 0; i < 8; ++i) { const int row = (lane >> 3) + 8 * i, ch = lane & 7; *(GLAS u32x4*)(dst + v_st64(row, ch * 8)) = tv[i]; }
}
#define GLA_PK(L, H) (bf16x8){L[0], L[1], L[2], L[3], H[0], H[1], H[2], H[3]}
#define GLA_MM4(o0, o1, vb, AF) do { \
    const s16x4 l00 = tr_read<v_off64(0, 0, 0)>(vb), h00 = tr_read<v_off64(0, 0, 1)>(vb), l01 = tr_read<v_off64(0, 1, 0)>(vb), h01 = tr_read<v_off64(0, 1, 1)>(vb); \
    const s16x4 l02 = tr_read<v_off64(0, 2, 0)>(vb), h02 = tr_read<v_off64(0, 2, 1)>(vb), l03 = tr_read<v_off64(0, 3, 0)>(vb), h03 = tr_read<v_off64(0, 3, 1)>(vb); \
    const s16x4 l10 = tr_read<v_off64(1, 0, 0)>(vb), h10 = tr_read<v_off64(1, 0, 1)>(vb), l11 = tr_read<v_off64(1, 1, 0)>(vb), h11 = tr_read<v_off64(1, 1, 1)>(vb); \
    const s16x4 l12 = tr_read<v_off64(1, 2, 0)>(vb), h12 = tr_read<v_off64(1, 2, 1)>(vb), l13 = tr_read<v_off64(1, 3, 0)>(vb), h13 = tr_read<v_off64(1, 3, 1)>(vb); \
    asm volatile("s_waitcnt lgkmcnt(0)" ::: "memory"); __builtin_amdgcn_sched_barrier(0); \
    o0 = __builtin_amdgcn_mfma_f32_32x32x16_bf16(AF(0), GLA_PK(l00, h00), o0, 0, 0, 0); o1 = __builtin_amdgcn_mfma_f32_32x32x16_bf16(AF(0), GLA_PK(l10, h10), o1, 0, 0, 0); \
    o0 = __builtin_amdgcn_mfma_f32_32x32x16_bf16(AF(1), GLA_PK(l01, h01), o0, 0, 0, 0); o1 = __builtin_amdgcn_mfma_f32_32x32x16_bf16(AF(1), GLA_PK(l11, h11), o1, 0, 0, 0); \
    o0 = __builtin_amdgcn_mfma_f32_32x32x16_bf16(AF(2), GLA_PK(l02, h02), o0, 0, 0, 0); o1 = __builtin_amdgcn_mfma_f32_32x32x16_bf16(AF(2), GLA_PK(l12, h12), o1, 0, 0, 0); \
    o0 = __builtin_amdgcn_mfma_f32_32x32x16_bf16(AF(3), GLA_PK(l03, h03), o0, 0, 0, 0); o1 = __builtin_amdgcn_mfma_f32_32x32x16_bf16(AF(3), GLA_PK(l13, h13), o1, 0, 0, 0); } while (0)
__device__ __forceinline__ bf16x8 afrag_tr(const GLAS unsigned char* row, int ks, int hi) { return *(const GLAS bf16x8*)(row + (16 * ks + 8 * hi) * 2); }

__device__ __forceinline__ void gla_a_item(int b, int h, int g, unsigned char* ws, GLAS unsigned char* lds) {
    int tid_o = threadIdx.x; asm volatile("" : "+v"(tid_o));
    const int tid = tid_o, wave = __builtin_amdgcn_readfirstlane(tid >> 6), lane = tid & 63, r32 = lane & 31, hi = lane >> 5;
    const float* GL = (const float*)(ws + cfg::WSB_GL + (size_t)b * cfg::DLT_GL); const bf16_t* GQK = (const bf16_t*)(ws + cfg::WSB_GQK + (size_t)b * cfg::DLT_GQK); const bf16_t* GV = (const bf16_t*)(ws + cfg::WSB_GV + (size_t)b * cfg::DLT_GV);
    float* KVC = (float*)(ws + cfg::WSB_OF + (size_t)b * cfg::DLT_OF); float* DEC = (float*)(ws + cfg::WS_DEC);
    const size_t tok0 = (size_t)b * 2048 + g * 256;
    GLAS float* bend_s = (GLAS float*)(lds + A_BEND);
    if (wave < 4) {
        const int c = wave, dir = lane >> 5, d = lane & 31;
        const float* gl = GL + (tok0 + c * 64) * 256 + dir * 128 + h * 32 + d; const bf16_t* kp = GQK + (tok0 + c * 64) * 256 + 128 + h * 32 + d;
        GLAS unsigned char* row = lds + A_KT + ((c * 2 + dir) * 32 + d) * KT_STRIDE; float bsum = 0.f; float gA[8], gB[8]; unsigned short kA[8], kB[8];
#define GLA_LOAD(G, K, blk) do { const int t0_ = dir ? 56 - 8 * (blk) : 8 * (blk); _Pragma("unroll") for (int i = 0; i < 8; ++i) { G[i] = gl[(size_t)(t0_ + i) * 256]; K[i] = kp[(size_t)(t0_ + i) * 256]; } } while (0)
#define GLA_PROC(G, K, blk) do { const int t0_ = dir ? 56 - 8 * (blk) : 8 * (blk); float kt[8]; \
            if (dir == 0) { _Pragma("unroll") for (int i = 0; i < 8; ++i) { bsum += G[i]; kt[i] = bf2f_(K[i]) * __expf(-bsum); } } \
            else { _Pragma("unroll") for (int i = 7; i >= 0; --i) { bsum += G[i]; kt[i] = bf2f_(K[i]) * __expf(-bsum); } } \
            u32x4 w; w.x = cvtpk(kt[0], kt[1]); w.y = cvtpk(kt[2], kt[3]); w.z = cvtpk(kt[4], kt[5]); w.w = cvtpk(kt[6], kt[7]); *(GLAS u32x4*)(row + t0_ * 2) = w; } while (0)
        GLA_LOAD(gA, kA, 0);
#pragma unroll
        for (int bp = 0; bp < 4; ++bp) { GLA_LOAD(gB, kB, 2 * bp + 1); GLA_PROC(gA, kA, 2 * bp); if (bp < 3) GLA_LOAD(gA, kA, 2 * bp + 2); GLA_PROC(gB, kB, 2 * bp + 1); }
#undef GLA_LOAD
#undef GLA_PROC
        bend_s[(c * 2 + dir) * 32 + d] = bsum;
        DEC[((size_t)((b * 4 + h) * 32 + g * 4 + c) * 2 + dir) * 32 + d] = __expf(bsum);
    } else { const int c = wave - 4; load_v_tile(GV + (tok0 + c * 64) * 256 + h * 64, lds + A_V + c * 8192, lane); }
    __syncthreads();
    {
        const int c = wave >> 1, dir = wave & 1; f32x16 o0 = {}, o1 = {};
        const int vb = (int)(unsigned)(uintptr_t)(lds + A_V + c * 8192) + att::v_rd_base(lane);
        const GLAS unsigned char* arow = lds + A_KT + ((c * 2 + dir) * 32 + r32) * KT_STRIDE;
#define GLA_AF(ks) afrag_tr(arow, ks, hi)
        GLA_MM4(o0, o1, vb, GLA_AF);
#undef GLA_AF
        float* dst = KVC + ((size_t)((b * 4 + h) * 32 + g * 4 + c) * 2 + dir) * 2048 + r32;
#pragma unroll
        for (int r = 0; r < 16; ++r) { const int d = crow(r, hi); const float sc = __expf(bend_s[(c * 2 + dir) * 32 + d]); dst[d * 64] = o0[r] * sc; dst[d * 64 + 32] = o1[r] * sc; }
    }
    __syncthreads();
}

__device__ __forceinline__ void gla_b_item(int b, int h, int g, unsigned char* ws, const float* __restrict__ gng, bf16_t* __restrict__ OC, GLAS unsigned char* lds) {
    int tid_o = threadIdx.x; asm volatile("" : "+v"(tid_o));
    const int tid = tid_o, wave = __builtin_amdgcn_readfirstlane(tid >> 6), lane = tid & 63, r32 = lane & 31, hi = lane >> 5;
    const float* GL = (const float*)(ws + cfg::WSB_GL + (size_t)b * cfg::DLT_GL); const bf16_t* GQK = (const bf16_t*)(ws + cfg::WSB_GQK + (size_t)b * cfg::DLT_GQK); const bf16_t* GV = (const bf16_t*)(ws + cfg::WSB_GV + (size_t)b * cfg::DLT_GV); const bf16_t* GR = (const bf16_t*)(ws + cfg::WSB_GR + (size_t)b * cfg::DLT_GR);
    const float* KVC = (const float*)(ws + cfg::WSB_OF + (size_t)b * cfg::DLT_OF) + (size_t)((b * 4 + h) * 32) * 2 * 2048; const float* DEC = (const float*)(ws + cfg::WS_DEC) + (size_t)((b * 4 + h) * 32) * 2 * 32;
    const size_t tok0 = (size_t)b * 2048 + g * 256;
    if (wave < 4) {
        const int c = wave, dir = lane >> 5, d = lane & 31;
        const float* gl = GL + (tok0 + c * 64) * 256 + dir * 128 + h * 32 + d; const bf16_t* qp = GQK + (tok0 + c * 64) * 256 + h * 32 + d;
        GLAS unsigned short* qt = (GLAS unsigned short*)(lds + B_QT + c * 8192) + dir * 32 + d;
        GLAS unsigned short* kt = (GLAS unsigned short*)(lds + B_KT + c * 8192 + dir * 4096) + d;
        float bsum = 0.f; float gA[8], gB[8]; unsigned short qA[8], kA[8], qB[8], kB[8];
#define GLB_LOAD(G, Q, K, blk) do { const int t0_ = dir ? 56 - 8 * (blk) : 8 * (blk); _Pragma("unroll") for (int i = 0; i < 8; ++i) { G[i] = gl[(size_t)(t0_ + i) * 256]; Q[i] = qp[(size_t)(t0_ + i) * 256]; K[i] = qp[(size_t)(t0_ + i) * 256 + 128]; } } while (0)
#define GLB_PROC(G, Q, K, blk) do { const int t0_ = dir ? 56 - 8 * (blk) : 8 * (blk); _Pragma("unroll") for (int ii = 0; ii < 8; ++ii) { \
            const float gi = dir ? G[7 - ii] : G[ii], qi = bf2f_(dir ? Q[7 - ii] : Q[ii]), ki = bf2f_(dir ? K[7 - ii] : K[ii]); const int tt = t0_ + (dir ? 7 - ii : ii); \
            bsum += gi; const float e = __expf(bsum), ei = __expf(-bsum); \
            qt[tt * 64] = (unsigned short)(cvtpk(qi * e, 0.f) & 0xffffu); kt[tt * 32] = (unsigned short)(cvtpk(ki * ei, 0.f) & 0xffffu); } } while (0)
        GLB_LOAD(gA, qA, kA, 0);
#pragma unroll
        for (int bp = 0; bp < 4; ++bp) { GLB_LOAD(gB, qB, kB, 2 * bp + 1); GLB_PROC(gA, qA, kA, 2 * bp); if (bp < 3) GLB_LOAD(gA, qA, kA, 2 * bp + 2); GLB_PROC(gB, qB, kB, 2 * bp + 1); }
#undef GLB_LOAD
#undef GLB_PROC
    } else {
        const int c = wave - 4;
        const int t2 = tid - 256, d = t2 >> 3, v8 = (t2 & 7) * 8;
        const float* kvp = KVC + d * 64 + v8; const float* dcp = DEC + d;
        const int F = 4 * g + 3;
        u32x4 tv[8];
#pragma unroll
        for (int i = 0; i < 8; ++i) { const int row = (lane >> 3) + 8 * i, ch = lane & 7; tv[i] = *(const u32x4*)(GV + (tok0 + c * 64) * 256 + h * 64 + (size_t)row * 256 + ch * 8); }
        f32x4 Sf0 = {0.f, 0.f, 0.f, 0.f}, Sf1 = Sf0, Sb0 = Sf0, Sb1 = Sf0;
        f32x4 a0A[8], a1A[8], a0B[8], a1B[8]; float dA[8], dB[8];
#define GLS_IDX(s_) (((s_) < F) ? (s_) * 2 : (31 - ((s_) - F)) * 2 + 1)
#define GLS_ISSUE(A0, A1, DD, s0) do { _Pragma("unroll") for (int j = 0; j < 8; ++j) { const int sc_ = (s0) + j < 34 ? (s0) + j : 33; const int ix_ = GLS_IDX(sc_); \
            A0[j] = *(const f32x4*)(kvp + (size_t)ix_ * 2048); A1[j] = *(const f32x4*)(kvp + (size_t)ix_ * 2048 + 4); DD[j] = dcp[ix_ * 32]; } } while (0)
#define GLS_WRITE(S0, S1, c4_, dofs_) do { u32x4 w; w.x = cvtpk(S0[0], S0[1]); w.y = cvtpk(S0[2], S0[3]); w.z = cvtpk(S1[0], S1[1]); w.w = cvtpk(S1[2], S1[3]); \
            *(GLAS u32x4*)(lds + B_SC + (c4_) * 8192 + v_st64((dofs_) + d, v8)) = w; } while (0)
#define GLS_PROC(A0, A1, DD, s0) do { _Pragma("unroll") for (int j = 0; j < 8; ++j) { const int s_ = (s0) + j; if (s_ < 34) { \
            if (s_ < F) { const int n_ = s_; if (n_ >= 4 * g) GLS_WRITE(Sf0, Sf1, n_ - 4 * g, 0); Sf0 = DD[j] * Sf0 + A0[j]; Sf1 = DD[j] * Sf1 + A1[j]; } \
            else { const int n_ = 31 - (s_ - F); if (n_ <= 4 * g + 3) GLS_WRITE(Sb0, Sb1, n_ - 4 * g, 32); Sb0 = DD[j] * Sb0 + A0[j]; Sb1 = DD[j] * Sb1 + A1[j]; } } } } while (0)
        GLS_ISSUE(a0A, a1A, dA, 0); GLS_ISSUE(a0B, a1B, dB, 8);
#pragma unroll
        for (int i = 0; i < 8; ++i) { const int row = (lane >> 3) + 8 * i, ch = lane & 7; *(GLAS u32x4*)(lds + B_V + c * 8192 + v_st64(row, ch * 8)) = tv[i]; }
        GLS_PROC(a0A, a1A, dA, 0);  GLS_ISSUE(a0A, a1A, dA, 16);
        GLS_PROC(a0B, a1B, dB, 8);  GLS_ISSUE(a0B, a1B, dB, 24);
        GLS_PROC(a0A, a1A, dA, 16); GLS_ISSUE(a0A, a1A, dA, 32);
        GLS_PROC(a0B, a1B, dB, 24);
        GLS_PROC(a0A, a1A, dA, 32);
        GLS_WRITE(Sf0, Sf1, 3, 0); GLS_WRITE(Sb0, Sb1, 0, 32);
#undef GLS_IDX
#undef GLS_ISSUE
#undef GLS_WRITE
#undef GLS_PROC
    }
    __syncthreads();
    {
        const int c = wave >> 1, th = wave & 1, t = 32 * th + r32;
        const GLAS unsigned char* qrow = lds + B_QT + c * 8192 + t * 128;
        f32x16 pf0 = {}, pf1 = {}, pb0 = {}, pb1 = {};
#pragma unroll
        for (int ks = 0; ks < 2; ++ks) {
            const bf16x8 qf = *(const GLAS bf16x8*)(qrow + (16 * ks + 8 * hi) * 2), qb = *(const GLAS bf16x8*)(qrow + (32 + 16 * ks + 8 * hi) * 2);
            const GLAS unsigned char* kf = lds + B_KT + c * 8192 + r32 * 64 + (16 * ks + 8 * hi) * 2; const GLAS unsigned char* kb = kf + 4096;
            pf0 = __builtin_amdgcn_mfma_f32_32x32x16_bf16(*(const GLAS bf16x8*)kf, qf, pf0, 0, 0, 0); pf1 = __builtin_amdgcn_mfma_f32_32x32x16_bf16(*(const GLAS bf16x8*)(kf + 2048), qf, pf1, 0, 0, 0);
            pb0 = __builtin_amdgcn_mfma_f32_32x32x16_bf16(*(const GLAS bf16x8*)kb, qb, pb0, 0, 0, 0); pb1 = __builtin_amdgcn_mfma_f32_32x32x16_bf16(*(const GLAS bf16x8*)(kb + 2048), qb, pb1, 0, 0, 0);
        }
#pragma unroll
        for (int r = 0; r < 16; ++r) { const int j0 = crow(r, hi), j1 = 32 + j0;
            pf0[r] = (j0 <= t ? pf0[r] : 0.f) + (j0 >= t ? pb0[r] : 0.f); pf1[r] = (j1 <= t ? pf1[r] : 0.f) + (j1 >= t ? pb1[r] : 0.f); }
        bf16x8 pa0, pa1, pa2, pa3;
#define GLA_PK4(P, BASE, OUT) do { unsigned a0 = cvtpk(P[BASE + 0], P[BASE + 1]), a1 = cvtpk(P[BASE + 2], P[BASE + 3]); unsigned b0 = cvtpk(P[BASE + 4], P[BASE + 5]), b1 = cvtpk(P[BASE + 6], P[BASE + 7]); \
    auto r0 = __builtin_amdgcn_permlane32_swap(a0, b0, false, false); auto r1 = __builtin_amdgcn_permlane32_swap(a1, b1, false, false); \
    u32x4 w = {r0[0], r1[0], r0[1], r1[1]}; OUT = *reinterpret_cast<bf16x8*>(&w); } while (0)
        GLA_PK4(pf0, 0, pa0); GLA_PK4(pf0, 8, pa1); GLA_PK4(pf1, 0, pa2); GLA_PK4(pf1, 8, pa3);
#undef GLA_PK4
        f32x16 o0 = {}, o1 = {};
        { const int vb = (int)(unsigned)(uintptr_t)(lds + B_V + c * 8192) + att::v_rd_base(lane);
#define GLA_AF(ks) ((ks) == 0 ? pa0 : (ks) == 1 ? pa1 : (ks) == 2 ? pa2 : pa3)
          GLA_MM4(o0, o1, vb, GLA_AF);
#undef GLA_AF
        }
        { const int vb = (int)(unsigned)(uintptr_t)(lds + B_SC + c * 8192) + att::v_rd_base(lane);
#define GLA_AF(ks) afrag_tr(qrow, ks, hi)
          GLA_MM4(o0, o1, vb, GLA_AF);
#undef GLA_AF
        }
        const float g0 = gng[r32], g1 = gng[32 + r32];
        const bf16_t* grb = GR + (tok0 + c * 64 + 32 * th) * 256 + h * 64 + r32; unsigned short gq0[16], gq1[16];
#pragma unroll
        for (int r = 0; r < 16; ++r) { gq0[r] = grb[(size_t)crow(r, hi) * 256]; gq1[r] = grb[(size_t)crow(r, hi) * 256 + 32]; }
#pragma unroll
        for (int r = 0; r < 16; ++r) {
            float ssq = o0[r] * o0[r] + o1[r] * o1[r];
            ssq = xadd<1>(ssq); ssq = xadd<2>(ssq); ssq = xadd<4>(ssq); ssq = xadd<8>(ssq); ssq = xadd<16>(ssq);
            const float rn = rsqrtf(ssq * (1.f / 64.f) + cfg::EPS);
            const size_t tok = tok0 + c * 64 + 32 * th + crow(r, hi);
            bf16_t* dst = OC + tok * 1024 + 768 + h * 64 + r32;
            dst[0] = (bf16_t)(cvtpk(o0[r] * rn * g0 * bf2f_(gq0[r]), 0.f) & 0xffffu); dst[32] = (bf16_t)(cvtpk(o1[r] * rn * g1 * bf2f_(gq1[r]), 0.f) & 0xffffu);
        }
    }
    __syncthreads();
}
#undef GLA_MM4
#undef GLA_PK
#undef GLAS
}
namespace fft {
using att::bf16x8; using att::s16x4; using att::f32x16; using att::u32x4; using att::crow; using att::cvtpk; using att::tr_read;
#define FLAS __attribute__((address_space(3)))
__device__ __forceinline__ int img_off(int k, int c) { const int kk = (k & ~0xC) | ((k & 4) << 1) | ((k & 8) >> 1); return ((kk >> 3) * 8 + (c >> 5)) * 512 + ((kk & 7) * 32 + (c & 31)) * 2; }
constexpr int rd_off(int ks, int half) { return ks * 8192 + half * 4096; }
#define FFT_PK(L, H) (bf16x8){L[0], L[1], L[2], L[3], H[0], H[1], H[2], H[3]}
typedef float f32x2_t __attribute__((ext_vector_type(2))); typedef __bf16 bf16x2_t __attribute__((ext_vector_type(2)));
__device__ __forceinline__ unsigned pk2f(float a, float b) { f32x2_t v = {a, b}; bf16x2_t r = __builtin_convertvector(v, bf16x2_t); return __builtin_bit_cast(unsigned, r); }

__device__ __forceinline__ void stage1_load(u32x4 (&tv)[4], int b, int s2, const bf16_t* __restrict__ FX) {
    int tid = threadIdx.x; asm volatile("" : "+v"(tid));
#pragma unroll
    for (int i = 0; i < 4; ++i) { const int p = tid + 512 * i, k = p >> 5, c8 = (p & 31) * 8; tv[i] = *(const u32x4*)(FX + (size_t)(b * 2048 + 64 * (k & 31) + s2) * 512 + (k >> 5) * 256 + c8); }
}
__device__ __forceinline__ void stage1_item(int b, int s2, const u32x4 (&tv)[4], bf16_t* __restrict__ I1, FLAS unsigned char* lds) {
    int tid_o = threadIdx.x; asm volatile("" : "+v"(tid_o));
    const int tid = tid_o, wave = __builtin_amdgcn_readfirstlane(tid >> 6), lane = tid & 63, r32 = lane & 31, hi = lane >> 5;
    bf16x8 F1[2][4];
#pragma unroll
    for (int ks = 0; ks < 4; ++ks) { float cr[8], ci[8];
#pragma unroll
        for (int j = 0; j < 8; ++j) { const int k = 16 * ks + 8 * hi + j, s1 = k & 31; const float rev = (float)((r32 * s1) & 31) * (1.f / 32.f); const float c = __builtin_amdgcn_cosf(rev), sn = __builtin_amdgcn_sinf(rev);
            const bool p1 = (k >> 5) != 0; cr[j] = p1 ? -sn : c; ci[j] = p1 ? -c : -sn; }
        u32x4 wr = {pk2f(cr[0], cr[1]), pk2f(cr[2], cr[3]), pk2f(cr[4], cr[5]), pk2f(cr[6], cr[7])}, wi = {pk2f(ci[0], ci[1]), pk2f(ci[2], ci[3]), pk2f(ci[4], ci[5]), pk2f(ci[6], ci[7])};
        F1[0][ks] = *reinterpret_cast<bf16x8*>(&wr); F1[1][ks] = *reinterpret_cast<bf16x8*>(&wi); }
    {
#pragma unroll
      for (int i = 0; i < 4; ++i) { const int p = tid + 512 * i, k = p >> 5, c8 = (p & 31) * 8; *(FLAS u32x4*)(lds + img_off(k, c8)) = tv[i]; } }
    __syncthreads();
    f32x16 re = {}, im = {};
    { const int vb = (int)(unsigned)(uintptr_t)lds + att::v_rd_base(lane) + wave * 512;
      const s16x4 l0 = tr_read<rd_off(0, 0)>(vb), h0 = tr_read<rd_off(0, 1)>(vb), l1 = tr_read<rd_off(1, 0)>(vb), h1 = tr_read<rd_off(1, 1)>(vb);
      const s16x4 l2 = tr_read<rd_off(2, 0)>(vb), h2 = tr_read<rd_off(2, 1)>(vb), l3 = tr_read<rd_off(3, 0)>(vb), h3 = tr_read<rd_off(3, 1)>(vb);
      asm volatile("s_waitcnt lgkmcnt(0)" ::: "memory"); __builtin_amdgcn_sched_barrier(0);
      re = __builtin_amdgcn_mfma_f32_32x32x16_bf16(F1[0][0], FFT_PK(l0, h0), re, 0, 0, 0); im = __builtin_amdgcn_mfma_f32_32x32x16_bf16(F1[1][0], FFT_PK(l0, h0), im, 0, 0, 0);
      re = __builtin_amdgcn_mfma_f32_32x32x16_bf16(F1[0][1], FFT_PK(l1, h1), re, 0, 0, 0); im = __builtin_amdgcn_mfma_f32_32x32x16_bf16(F1[1][1], FFT_PK(l1, h1), im, 0, 0, 0);
      re = __builtin_amdgcn_mfma_f32_32x32x16_bf16(F1[0][2], FFT_PK(l2, h2), re, 0, 0, 0); im = __builtin_amdgcn_mfma_f32_32x32x16_bf16(F1[1][2], FFT_PK(l2, h2), im, 0, 0, 0);
      re = __builtin_amdgcn_mfma_f32_32x32x16_bf16(F1[0][3], FFT_PK(l3, h3), re, 0, 0, 0); im = __builtin_amdgcn_mfma_f32_32x32x16_bf16(F1[1][3], FFT_PK(l3, h3), im, 0, 0, 0); }
    bf16_t* dst = I1 + (size_t)(b * 32) * 128 * 256 + (size_t)s2 * 256 + 32 * wave + r32;
#pragma unroll
    for (int r = 0; r < 16; ++r) { const int k1 = crow(r, hi); const float rev = (float)((k1 * s2) & 2047) * (1.f / 2048.f); const float ct = __builtin_amdgcn_cosf(rev), st = __builtin_amdgcn_sinf(rev);
        const float ar = re[r] * ct + im[r] * st, ai = im[r] * ct - re[r] * st; const unsigned w = pk2f(ar, ai);
        dst[(size_t)k1 * 128 * 256] = (bf16_t)(w & 0xffffu); dst[(size_t)k1 * 128 * 256 + 64 * 256] = (bf16_t)(w >> 16); }
    __syncthreads();
}

__device__ __forceinline__ void stage2_item(int b, int k1, const bf16_t* __restrict__ I1, bf16_t* __restrict__ OC, FLAS unsigned char* lds) {
    int tid_o = threadIdx.x; asm volatile("" : "+v"(tid_o));
    const int tid = tid_o, wave = __builtin_amdgcn_readfirstlane(tid >> 6), lane = tid & 63, r32 = lane & 31, hi = lane >> 5;
    const bf16_t* src = I1 + (size_t)(b * 32 + k1) * 128 * 256;
    { u32x4 tv[8];
#pragma unroll
      for (int i = 0; i < 8; ++i) { const int p = tid + 512 * i, k = p >> 5, c8 = (p & 31) * 8; tv[i] = *(const u32x4*)(src + (size_t)k * 256 + c8); }
#pragma unroll
      for (int i = 0; i < 8; ++i) { const int p = tid + 512 * i, k = p >> 5, c8 = (p & 31) * 8; *(FLAS u32x4*)(lds + img_off(k, c8)) = tv[i]; } }
    f32x16 y0 = {}, y1 = {};
    __syncthreads();
    const int vb = (int)(unsigned)(uintptr_t)lds + att::v_rd_base(lane) + wave * 512, vb2 = vb + 32768;
    bf16x8 F2[2][8];
#pragma unroll
    for (int ks = 0; ks < 8; ++ks) { float c0[8], c1[8];
#pragma unroll
        for (int j = 0; j < 8; ++j) { const int k = 16 * ks + 8 * hi + j, s2 = k & 63; const float r0 = (float)((r32 * s2) & 63) * (1.f / 64.f), r1 = (float)(((32 + r32) * s2) & 63) * (1.f / 64.f);
            c0[j] = (k >> 6) ? __builtin_amdgcn_sinf(r0) : __builtin_amdgcn_cosf(r0); c1[j] = (k >> 6) ? __builtin_amdgcn_sinf(r1) : __builtin_amdgcn_cosf(r1); }
        u32x4 w0 = {pk2f(c0[0], c0[1]), pk2f(c0[2], c0[3]), pk2f(c0[4], c0[5]), pk2f(c0[6], c0[7])}, w1 = {pk2f(c1[0], c1[1]), pk2f(c1[2], c1[3]), pk2f(c1[4], c1[5]), pk2f(c1[6], c1[7])};
        F2[0][ks] = *reinterpret_cast<bf16x8*>(&w0); F2[1][ks] = *reinterpret_cast<bf16x8*>(&w1); }
#define FFT_STEP(ks) do { \
      const s16x4 lo_ = tr_read<rd_off((ks) & 3, 0)>((ks) < 4 ? vb : vb2), hi_ = tr_read<rd_off((ks) & 3, 1)>((ks) < 4 ? vb : vb2); asm volatile("s_waitcnt lgkmcnt(0)" ::: "memory"); __builtin_amdgcn_sched_barrier(0); \
      y0 = __builtin_amdgcn_mfma_f32_32x32x16_bf16(F2[0][ks], FFT_PK(lo_, hi_), y0, 0, 0, 0); y1 = __builtin_amdgcn_mfma_f32_32x32x16_bf16(F2[1][ks], FFT_PK(lo_, hi_), y1, 0, 0, 0); } while (0)
    FFT_STEP(0); FFT_STEP(1); FFT_STEP(2); FFT_STEP(3); FFT_STEP(4); FFT_STEP(5); FFT_STEP(6); FFT_STEP(7);
#undef FFT_STEP
    bf16_t* dst = OC + (size_t)(b * 2048 + k1) * 1024 + 512 + 32 * wave + r32;
#pragma unroll
    for (int r = 0; r < 16; ++r) { const int k2 = crow(r, hi); const unsigned w = pk2f(y0[r], y1[r]);
        dst[(size_t)(32 * k2) * 1024] = (bf16_t)(w & 0xffffu); dst[(size_t)(32 * (32 + k2)) * 1024] = (bf16_t)(w >> 16); }
    __syncthreads();
}
#undef FFT_PK
#undef FLAS
}
namespace pro {
#define PLAS __attribute__((address_space(3)))
typedef float f32x4 __attribute__((ext_vector_type(4)));
typedef unsigned u32x4 __attribute__((ext_vector_type(4)));
__device__ __forceinline__ unsigned pk2(float lo, float hi) { unsigned r; asm volatile("v_cvt_pk_bf16_f32 %0, %1, %2" : "=v"(r) : "v"(lo), "v"(hi)); return r; }
__device__ __forceinline__ float lo_f(unsigned w) { return __uint_as_float(w << 16); }
__device__ __forceinline__ float hi_f(unsigned w) { return __uint_as_float(w & 0xffff0000u); }
template <bool SUMS, int STRIDE> __device__ __forceinline__ void tile_emit(int K, bf16_t* WT, const float* gain, const float* lnb, float (&a1)[4], float (&a2)[4], const PLAS float* scr, int lane) {
    const int c = lane & 7; float gk[8], bk[8];
#pragma unroll
    for (int q = 0; q < 8; ++q) { gk[q] = gain ? gain[8 * c + q] : 1.f; bk[q] = lnb ? lnb[8 * c + q] : 0.f; }
#pragma unroll
    for (int j = 0; j < 4; ++j) { const int n = (lane >> 3) + 8 * j; const PLAS float* s = scr + (8 * c) * STRIDE + n; float v[8];
#pragma unroll
        for (int q = 0; q < 8; ++q) v[q] = s[q * STRIDE];
        u32x4 o; o.x = pk2(v[0] * gk[0], v[1] * gk[1]); o.y = pk2(v[2] * gk[2], v[3] * gk[3]); o.z = pk2(v[4] * gk[4], v[5] * gk[5]); o.w = pk2(v[6] * gk[6], v[7] * gk[7]);
        *(u32x4*)(WT + (size_t)n * K + 8 * c) = o;
        if (SUMS) { float p1 = (lo_f(o.x) + hi_f(o.x)) + (lo_f(o.y) + hi_f(o.y)) + (lo_f(o.z) + hi_f(o.z)) + (lo_f(o.w) + hi_f(o.w)); float p2 = 0.f;
#pragma unroll
            for (int q = 0; q < 8; ++q) p2 += bk[q] * v[q];
            p1 = xadd<1>(p1); p2 = xadd<1>(p2); p1 = xadd<2>(p1); p2 = xadd<2>(p2); p1 = xadd<4>(p1); p2 = xadd<4>(p2);
            a1[j] += p1; a2[j] += p2; }
    }
    asm volatile("s_waitcnt lgkmcnt(0)" ::: "memory");
}
__device__ __forceinline__ void tile_dma(const float* W, int N, PLAS float* scr, int lane) {
    const float* src = W + (size_t)(lane >> 3) * N + (lane & 7) * 4;
#pragma unroll
    for (int i = 0; i < 8; ++i) __builtin_amdgcn_global_load_lds((const unsigned*)(src + (size_t)(8 * i) * N), (PLAS unsigned*)(scr + i * 256), 16, 0, 0);
}
template <bool SUMS, class Val> __device__ __forceinline__ void tile_item(const Val& val, int K, bf16_t* WT, const float* gain, const float* lnb, float (&a1)[4], float (&a2)[4], PLAS float* scr, int lane) {
#pragma unroll 2
    for (int i = 0; i < 32; ++i) { const int kk = 2 * i + (lane >> 5); scr[kk * 33 + (lane & 31)] = val(kk, lane & 31); }
    asm volatile("s_waitcnt lgkmcnt(0)" ::: "memory");
    tile_emit<SUMS, 33>(K, WT, gain, lnb, a1, a2, scr, lane);
}
struct ValPlain { static constexpr int BATCH = 32; const float* W; int N; __device__ __forceinline__ float operator()(int kk, int j) const { return W[(size_t)kk * N + j]; } };
struct ValGate { static constexpr int BATCH = 2; const float* W; const float* w2; __device__ __forceinline__ float operator()(int kk, int j) const {
    const float* wr = W + (size_t)kk * cfg::INW; float a = 0.f;
#pragma unroll
    for (int r = 0; r < 16; ++r) a += wr[r] * w2[r * 128 + j]; return a; } };

__device__ __forceinline__ void fold_item(int item, unsigned char* ws, const float* w_in, const float* fw, const float* lng, const float* lnb, PLAS unsigned char* lds, int tid) {
    const int l = item >> 5, g = (item >> 3) & 3, part = (item >> 2) & 1, kq = item & 3;
    PLAS float* M = (PLAS float*)lds;
    { const int c = tid >> 3, e0 = (tid & 7) * 8; float acc[8];
#pragma unroll
      for (int q = 0; q < 8; ++q) acc[q] = 0.f;
      const float* w = fw + (size_t)((l * 4 + g) * 64) * 64 + e0;
      for (int k2 = 0; k2 < 64; ++k2) { float rev = (float)((k2 * c) & 63) * (1.f / 64.f); asm volatile("" : "+v"(rev)); const float tr = part ? __builtin_amdgcn_sinf(rev) : __builtin_amdgcn_cosf(rev);
          const f32x4 w0 = *(const f32x4*)(w + k2 * 64), w1 = *(const f32x4*)(w + k2 * 64 + 4);
#pragma unroll
          for (int q = 0; q < 4; ++q) { acc[q] += tr * w0[q]; acc[4 + q] += tr * w1[q]; } }
      const float sc = 0.00276213586400995f;
#pragma unroll
      for (int q = 0; q < 8; ++q) M[c * 64 + e0 + q] = acc[q] * sc; }
    __syncthreads();
    PLAS float* Wl = (PLAS float*)(lds + 16384);
    { const float* wsrc = w_in + ((size_t)l * 1024 + kq * 256) * cfg::INW + 1536 + 64 * g; f32x4 tv[8];
#pragma unroll
      for (int i = 0; i < 8; ++i) tv[i] = *(const f32x4*)(wsrc + (size_t)((tid >> 4) + 32 * i) * cfg::INW + (tid & 15) * 4);
#pragma unroll
      for (int i = 0; i < 8; ++i) *(PLAS f32x4*)(Wl + ((tid >> 4) + 32 * i) * 64 + (tid & 15) * 4) = tv[i]; }
    __syncthreads();
    { const int e = tid & 63, kg = tid >> 6, k0 = kq * 256 + kg * 32, np = 1536 + part * 256 + g * 64 + e; float mc[64];
#pragma unroll
      for (int c = 0; c < 64; ++c) mc[c] = M[c * 64 + e];
      bf16_t* dst = (bf16_t*)(ws + cfg::WS_WIN + l * cfg::SZ_WIN) + (size_t)np * 1024 + k0; float s1 = 0.f, s2 = 0.f;
      for (int kb = 0; kb < 4; ++kb) { float o[8];
#pragma unroll
          for (int q = 0; q < 8; ++q) { const int k = k0 + kb * 8 + q; const PLAS f32x4* wr = (const PLAS f32x4*)(Wl + (kg * 32 + kb * 8 + q) * 64); float a = 0.f;
#pragma unroll
              for (int c4 = 0; c4 < 16; ++c4) { const f32x4 w4 = wr[c4]; a += w4[0] * mc[4 * c4] + w4[1] * mc[4 * c4 + 1] + w4[2] * mc[4 * c4 + 2] + w4[3] * mc[4 * c4 + 3]; }
              o[q] = a * (lng ? lng[k] : 1.f); s2 += lnb ? lnb[k] * a : 0.f; }
          u32x4 w; w.x = pk2(o[0], o[1]); w.y = pk2(o[2], o[3]); w.z = pk2(o[4], o[5]); w.w = pk2(o[6], o[7]); *(u32x4*)(dst + kb * 8) = w;
          s1 += (lo_f(w.x) + hi_f(w.x)) + (lo_f(w.y) + hi_f(w.y)) + (lo_f(w.z) + hi_f(w.z)) + (lo_f(w.w) + hi_f(w.w)); }
      __syncthreads();
      PLAS float* red = (PLAS float*)lds; red[(kg * 64 + e) * 2] = s1; red[(kg * 64 + e) * 2 + 1] = s2;
      __syncthreads();
      if (kg == 0) { float t1 = 0.f, t2 = 0.f;
#pragma unroll
          for (int w = 0; w < 8; ++w) { t1 += red[(w * 64 + e) * 2]; t2 += red[(w * 64 + e) * 2 + 1]; }
          float* fp = (float*)(ws + cfg::V_MF) + (size_t)((l * 4 + kq) * 2) * 512 + part * 256 + g * 64 + e; fp[0] = t1; fp[512] = t2; } }
    __syncthreads();
}

struct Inputs { const float *x, *w_in, *fw, *gw2, *w_out, *ln1g, *ln1b, *wg, *wu, *wd, *ln2g, *ln2b; };
__device__ __forceinline__ void prologue(unsigned char* ws, const Inputs& in, PLAS unsigned char* lds, int vcu, int G) {
    int tid_o = threadIdx.x; asm volatile("" : "+v"(tid_o));
    const int tid = tid_o, wave = __builtin_amdgcn_readfirstlane(tid >> 6), lane = tid & 63;
    const float* x = in.x; const float* w_in = in.w_in; const float* fw = in.fw; const float* gw2 = in.gw2; const float* w_out = in.w_out; const float* ln1g = in.ln1g; const float* ln1b = in.ln1b;
    const float* wg = in.wg; const float* wu = in.wu; const float* wd = in.wd; const float* ln2g = in.ln2g; const float* ln2b = in.ln2b;
    if (vcu < 64) { const int l = vcu >> 5; fold_item(vcu, ws, w_in, fw, l ? ln2g : (const float*)nullptr, l ? ln2b : (const float*)nullptr, lds, tid); }
    PLAS float* scr = (PLAS float*)(lds + wave * 16384); PLAS float* scr1 = scr + 2048; PLAS float* redw = (PLAS float*)(lds + 131072 + 1024 + wave * 256);
    const int gw = vcu * 8 + wave, NGW = G * 8;
    for (int it = vcu; it < 512; it += G) {
        const int l = it >> 8, r = it & 255; float a1[4] = {0.f, 0.f, 0.f, 0.f}, a2[4] = {0.f, 0.f, 0.f, 0.f}; float* c1o; float* c2o;
        const int k0 = wave * 64, k1 = k0 + 512;
        if (r < 80) { const int nb = r; const float* lngb = l ? ln2g : (const float*)nullptr; const float* lnbb = l ? ln2b : (const float*)nullptr;
            bf16_t* Wt = (bf16_t*)(ws + cfg::WS_WIN + l * cfg::SZ_WIN);
            if (nb < 72) { int np0, src;
                if (nb < 32) { const int pn = nb >> 3, p = (nb & 7) * 32, wc = (p >> 5) & 3, bj = p >> 7; np0 = pn * 256 + p; src = (pn >> 1) * 512 + (pn & 1) * 256 + 64 * wc + 32 * bj; }
                else if (nb < 48) { np0 = 1024 + (nb - 32) * 32; src = np0; }
                else { np0 = 2048 + (nb - 48) * 32; src = 1792 + (nb - 48) * 32; }
                tile_dma(w_in + ((size_t)l * 1024 + k0) * cfg::INW + src, cfg::INW, scr, lane); tile_dma(w_in + ((size_t)l * 1024 + k1) * cfg::INW + src, cfg::INW, scr1, lane);
                asm volatile("s_waitcnt vmcnt(0)" ::: "memory");
                tile_emit<true, 32>(1024, Wt + (size_t)np0 * 1024 + k0, lngb ? lngb + k0 : lngb, lnbb ? lnbb + k0 : lnbb, a1, a2, scr, lane);
                tile_emit<true, 32>(1024, Wt + (size_t)np0 * 1024 + k1, lngb ? lngb + k1 : lngb, lnbb ? lnbb + k1 : lnbb, a1, a2, scr1, lane);
                c1o = (float*)(ws + cfg::V_C1IN) + l * cfg::NIN + np0; c2o = (float*)(ws + cfg::V_C2IN) + l * cfg::NIN + np0;
            } else { const int p0 = (nb - 72) * 32, dir = p0 >> 7, kk0 = p0 & 127, np0 = 2816 + p0;
                for (int kb = wave; kb < 16; kb += 8) { const int kq = kb * 64; ValGate v{w_in + ((size_t)l * 1024 + kq) * cfg::INW + 2560 + 16 * dir, gw2 + (size_t)((l * 2 + dir) * 16) * 128 + kk0};
                    tile_item<true>(v, 1024, Wt + (size_t)np0 * 1024 + kq, lngb ? lngb + kq : lngb, lnbb ? lnbb + kq : lnbb, a1, a2, scr, lane); }
                c1o = (float*)(ws + cfg::V_C1IN) + l * cfg::NIN + np0; c2o = (float*)(ws + cfg::V_C2IN) + l * cfg::NIN + np0; }
        } else { const int nb = r - 80, np0 = nb * 32, pn = np0 >> 8, p = np0 & 255, bj = p >> 7, f0 = 128 * pn + (p & 127);
            const float* W = (bj ? wu : wg) + (size_t)l * 1024 * cfg::FF + f0; bf16_t* Wt = (bf16_t*)(ws + cfg::WS_WGU + l * cfg::SZ_WGU) + (size_t)np0 * 1024;
            tile_dma(W + (size_t)k0 * cfg::FF, cfg::FF, scr, lane); tile_dma(W + (size_t)k1 * cfg::FF, cfg::FF, scr1, lane);
            asm volatile("s_waitcnt vmcnt(0)" ::: "memory");
            tile_emit<true, 32>(1024, Wt + k0, ln1g + l * 1024 + k0, ln1b + l * 1024 + k0, a1, a2, scr, lane);
            tile_emit<true, 32>(1024, Wt + k1, ln1g + l * 1024 + k1, ln1b + l * 1024 + k1, a1, a2, scr1, lane);
            c1o = (float*)(ws + cfg::V_C1GU) + l * cfg::NGU + np0; c2o = (float*)(ws + cfg::V_C2GU) + l * cfg::NGU + np0; }
        if ((lane & 7) == 0) {
#pragma unroll
            for (int j = 0; j < 4; ++j) { const int n = (lane >> 3) + 8 * j; redw[n * 2] = a1[j]; redw[n * 2 + 1] = a2[j]; } }
        __syncthreads();
        if (wave == 0 && lane < 32) { float t1 = 0.f, t2 = 0.f;
#pragma unroll
            for (int w = 0; w < 8; ++w) { const PLAS float* rw = (const PLAS float*)(lds + 131072 + 1024 + w * 256); t1 += rw[lane * 2]; t2 += rw[lane * 2 + 1]; }
            c1o[lane] = t1; c2o[lane] = t2; }
        __syncthreads();
    }
    constexpr int I_OUT = 32 * 16, I_DN = 32 * 44, I_L = I_OUT + I_DN;
    for (int it = gw; it < 2 * I_L; it += 2 * NGW) {
        const float* Ws[2]; int Ns[2], Ks[2]; bf16_t* Wd[2]; float d1[4], d2[4];
#pragma unroll
        for (int q = 0; q < 2; ++q) { const int itq = it + q * NGW; const int ic = itq < 2 * I_L ? itq : it; const int l = ic / I_L; int r = ic - l * I_L;
            if (r < I_OUT) { const int nb = r >> 4, kb = r & 15, k0 = kb * 64, n0 = nb * 32; Ws[q] = w_out + ((size_t)l * 1024 + k0) * 1024 + n0; Ns[q] = 1024; Ks[q] = 1024;
                Wd[q] = (bf16_t*)(ws + cfg::WS_WOUT + l * cfg::SZ_WOUT) + (size_t)n0 * 1024 + k0; }
            else { r -= I_OUT; const int nb = r / 44, kb = r - nb * 44, k0 = kb * 64, n0 = nb * 32; Ws[q] = wd + ((size_t)l * cfg::FF + k0) * 1024 + n0; Ns[q] = 1024; Ks[q] = cfg::FF;
                Wd[q] = (bf16_t*)(ws + cfg::WS_WDN + l * cfg::SZ_WDN) + (size_t)n0 * cfg::FF + k0; } }
        tile_dma(Ws[0], Ns[0], scr, lane); tile_dma(Ws[1], Ns[1], scr1, lane);
        asm volatile("s_waitcnt vmcnt(0)" ::: "memory");
        tile_emit<false, 32>(Ks[0], Wd[0], (const float*)nullptr, (const float*)nullptr, d1, d2, scr, lane);
        if (it + NGW < 2 * I_L) tile_emit<false, 32>(Ks[1], Wd[1], (const float*)nullptr, (const float*)nullptr, d1, d2, scr1, lane);
    }
    const int xw = (vcu - 64) * 8 + wave, NXW = (G - 64) * 8;
    if (vcu >= 64 && G > 64)
    for (int m = xw; m < cfg::T; m += 4 * NXW) {
        f32x4 v[4][4];
#pragma unroll
        for (int q = 0; q < 4; ++q) { const int mr = (m + q * NXW) < cfg::T ? (m + q * NXW) : m; const f32x4* xr = (const f32x4*)(x + (size_t)mr * 1024) + lane;
#pragma unroll
            for (int j = 0; j < 4; ++j) v[q][j] = xr[64 * j]; }
#pragma unroll
        for (int q = 0; q < 4; ++q) { const int mr = (m + q * NXW) < cfg::T ? (m + q * NXW) : m; unsigned long long* o8 = (unsigned long long*)((bf16_t*)(ws + cfg::WS_XB) + (size_t)mr * 1024) + lane;
#pragma unroll
            for (int j = 0; j < 4; ++j) o8[64 * j] = (unsigned long long)pk2(v[q][j][0], v[q][j][1]) | ((unsigned long long)pk2(v[q][j][2], v[q][j][3]) << 32); } }
    for (int i = gw * 64 + lane; i < 2048 * 32; i += NGW * 64) { const int pos = i >> 5, f = i & 31; const float inv = exp2f(-(float)f * (13.287712379549449f / 32.f)); const float ang = (float)pos * inv;
        double rv = (double)ang * 0.15915494309189535; rv -= floor(rv); const float rev = (float)rv;
        ((float*)(ws + cfg::V_ROPEC))[i] = __builtin_amdgcn_cosf(rev); ((float*)(ws + cfg::V_ROPES))[i] = __builtin_amdgcn_sinf(rev); }
}
#undef PLAS
}
constexpr int NWAVES = 8;
constexpr int RING_OFF = 0, RING_BYTES = 131072;
constexpr int LDSCTL_OFF = RING_BYTES, MISC_OFF = LDSCTL_OFF + 320;
constexpr int RSL_OFF = 131072 + 4096;
constexpr int LDS_BYTES = 147456;
constexpr int CW_BAR = 4096;
constexpr int CODE_PREWARM_BYTES = 192 * 1024;
constexpr int CW_GBAR = 8192, GBAR_STRIDE = 4096;
constexpr size_t CTL_ZERO_BYTES = 192 * 1024;
#define GAS __attribute__((address_space(1)))
#define LAS __attribute__((address_space(3)))
typedef GAS unsigned gu32;
#define RLX_AGENT __ATOMIC_RELAXED, __HIP_MEMORY_SCOPE_AGENT
#define XB_TMO      128
#define XB_XCNT(j)  (256  + 64 * (j))
#define XB_XSUB(j)  (1280 + 64 * (j))
#define XB_XGEN(j)  (2304 + 64 * (j))
#define XB_TOP      3328
#define XB_TOPGEN   3392
#define XCD_BAR_WORDS 3456
#define XB_SPIN_CAP (1u << 18)

__device__ __forceinline__ unsigned xb_ld(unsigned* p)              { return __hip_atomic_load(p, __ATOMIC_RELAXED, __HIP_MEMORY_SCOPE_AGENT); }
__device__ __forceinline__ unsigned xb_add(unsigned* p, unsigned v) { return __hip_atomic_fetch_add(p, v, __ATOMIC_RELAXED, __HIP_MEMORY_SCOPE_AGENT); }
__device__ __forceinline__ unsigned xb_xcc_id() { return (unsigned)__builtin_amdgcn_s_getreg((3 << 11) | 20) & 0xFu; }
#define XB_SPIN(cond, bar) do { unsigned _sp = 0; while (cond) { __builtin_amdgcn_s_sleep(1); \
    if ((++_sp & 255u) == 0u) { if (xb_ld(&(bar)[XB_TMO])) break; if (_sp > XB_SPIN_CAP) { atomicAdd(&(bar)[XB_TMO], 1u); break; } } } } while (0)

struct XcdBarrier {
    unsigned* bar; unsigned x; unsigned total; unsigned same_l2_ok;
    volatile LAS unsigned* st;
};

__device__ __forceinline__ XcdBarrier xcd_barrier_post(unsigned* bar, volatile LAS unsigned* st, unsigned total) {
    XcdBarrier b; b.bar = bar; b.x = xb_xcc_id(); b.st = st; b.total = total; b.same_l2_ok = 0u;
    if (threadIdx.x == 0) (void)xb_add(&bar[XB_XCNT(b.x)], 1u);
    return b;
}
__device__ __forceinline__ void xcd_barrier_complete(unsigned* bar, unsigned x, unsigned G, unsigned& nloc, unsigned& nx) {
    unsigned sum, cnt, mine, sp = 0u;
    for (;;) {
        sum = 0u; cnt = 0u; mine = 0u;
#pragma unroll
        for (unsigned j = 0; j < 16; ++j) { const unsigned c = xb_ld(&bar[XB_XCNT(j)]); sum += c; cnt += (c > 0u) ? 1u : 0u; mine = (j == x) ? c : mine; }
        if (sum == G) break;
        __builtin_amdgcn_s_sleep(1);
        if ((++sp & 255u) == 0u) { if (xb_ld(&bar[XB_TMO])) break; if (sp > XB_SPIN_CAP) { atomicAdd(&bar[XB_TMO], 1u); break; } }
    }
    nloc = mine > 0u ? mine : 1u; nx = cnt > 0u ? cnt : 1u;
}

__device__ __forceinline__ void xcd_barrier(const XcdBarrier& b) {
    asm volatile("s_waitcnt vmcnt(0)" ::: "memory");
    __syncthreads();
    if (threadIdx.x == 0) {
        unsigned* bar = b.bar;
        __builtin_amdgcn_s_waitcnt(0);
        unsigned nloc = b.st[0], nx = b.st[1];
        if (nloc == 0u) { xcd_barrier_complete(bar, b.x, b.total, nloc, nx); b.st[0] = nloc; b.st[1] = nx; }
        const unsigned old = xb_add(&bar[XB_XSUB(b.x)], 1u);
        const unsigned gen = old / nloc;
        if (old + 1u == (gen + 1u) * nloc) {
            if (!(b.same_l2_ok && nx == 1u)) {
            __builtin_amdgcn_fence(__ATOMIC_RELEASE, "agent");
            asm volatile("s_waitcnt vmcnt(0)" ::: "memory");
            const unsigned og = xb_add(&bar[XB_TOP], 1u);
            const unsigned tg = og / nx;
            if (og + 1u == (tg + 1u) * nx) xb_add(&bar[XB_TOPGEN], 1u);
            else XB_SPIN(xb_ld(&bar[XB_TOPGEN]) == tg, bar);
            }
            __builtin_amdgcn_fence(__ATOMIC_ACQUIRE, "agent");
            xb_add(&bar[XB_XGEN(b.x)], 1u);
            asm volatile("s_waitcnt vmcnt(0)" ::: "memory");
        } else {
            XB_SPIN(xb_ld(&bar[XB_XGEN(b.x)]) == gen, bar);
            __builtin_amdgcn_fence(__ATOMIC_ACQUIRE, "agent");
            asm volatile("s_waitcnt vmcnt(0)" ::: "memory");
        }
    }
    __syncthreads();
}


#define FILL_RSL(STP) do { pg8::Unit u0_; if (S.next(0, u0_)) { int tq_ = threadIdx.x; asm volatile("" : "+v"(tq_)); const int row_ = u0_.pm * 256 + (tq_ >> 1), hf_ = tq_ & 1; \
    typedef float f32x4_ __attribute__((ext_vector_type(4))); typedef float f32x2_ __attribute__((ext_vector_type(2))); \
    const f32x4_* sp_ = (const f32x4_*)((STP) + (size_t)row_ * 32 + hf_ * 16); const f32x4_ x0 = sp_[0], x1 = sp_[1], x2 = sp_[2], x3 = sp_[3]; \
    float sm_ = ((x0[0] + x0[2]) + (x1[0] + x1[2])) + ((x2[0] + x2[2]) + (x3[0] + x3[2])), sq_ = ((x0[1] + x0[3]) + (x1[1] + x1[3])) + ((x2[1] + x2[3]) + (x3[1] + x3[3])); \
    sm_ = xadd<1>(sm_); sq_ = xadd<1>(sq_); const float mu_ = sm_ * (1.f / 1024.f), rstd_ = rsqrtf(fmaxf(sq_ * (1.f / 1024.f) - mu_ * mu_, 0.f) + EPS); \
    if (hf_ == 0) *(LAS f32x2_*)(ldsl + RSL_OFF + 8 * (tq_ >> 1)) = (f32x2_){rstd_, -rstd_ * mu_}; } \
    __syncthreads(); } while (0)

enum { PH_PRO = 0, PH_IN = 1, PH_ATT = 2, PH_MIXB = 3, PH_OUT = 4, PH_GU = 5, PH_DN = 6, PH_FIN = 13, N_PHASES = 14 };
struct MArgs { const float* in[16]; float* out; unsigned char* ws; int ph_lo, ph_hi, li, pad; };

__global__ void __launch_bounds__(NWAVES * 64, 2) mk_fwd(MArgs a) {
    extern __shared__ __attribute__((aligned(128))) unsigned char lds[];
    LAS unsigned char* ldsl = (LAS unsigned char*)lds;
    volatile LAS unsigned* MISC = (volatile LAS unsigned*)(ldsl + MISC_OFF);
    const int tid = threadIdx.x;
    const int G = gridDim.x, bx = blockIdx.x, vcu = (G % 8 == 0) ? (bx % 8) * (G / 8) + bx / 8 : bx;
    unsigned char* ws = a.ws;
    typedef unsigned pw_u32x4 __attribute__((ext_vector_type(4))); pw_u32x4 pw_v = {0u, 0u, 0u, 0u};
    { unsigned long long pc_; asm volatile("s_getpc_b64 %0" : "=s"(pc_)); const unsigned off_ = (unsigned)(((bx >> 3) * (NWAVES * 64) + tid) * 16);
      if (CODE_PREWARM_BYTES > 0 && off_ < (unsigned)CODE_PREWARM_BYTES) pw_v = *(const volatile pw_u32x4*)((const char*)(pc_ & ~63ull) + off_); }
    for (int u = tid; u < (LDS_BYTES - LDSCTL_OFF) / 4; u += NWAVES * 64) ((LAS unsigned*)(ldsl + LDSCTL_OFF))[u] = 0u;
    __syncthreads();
    XcdBarrier bar; bar.bar = (unsigned*)(ws + WS_CTL) + CW_BAR + a.li * XCD_BAR_WORDS; bar.x = 0; bar.st = nullptr; bar.total = (unsigned)G; bar.same_l2_ok = 0u;
    if (a.ph_hi - a.ph_lo > 1) bar = xcd_barrier_post((unsigned*)(ws + WS_CTL) + CW_BAR + a.li * XCD_BAR_WORDS, MISC + 8, (unsigned)G);
    const bool grp_ok = (G % 8 == 0) && (a.ph_hi - a.ph_lo > 1);
    XcdBarrier gbar = bar;
    if (grp_ok) { gbar = xcd_barrier_post((unsigned*)(ws + WS_CTL) + CW_GBAR + (bx & 7) * GBAR_STRIDE, MISC + 10, (unsigned)(G / 8)); gbar.same_l2_ok = 1u; }
    const int G0 = G, bx0 = bx, vcu0 = vcu; unsigned char* const ws0 = ws;
    for (int ph = a.ph_lo; ph < a.ph_hi; ++ph) {
        int G = G0, bx = bx0, vcu = vcu0; unsigned zo = 0u; asm volatile("" : "+s"(G), "+s"(bx), "+s"(vcu), "+s"(zo)); unsigned char* ws = ws0 + zo;
        const int l = (ph >= 1 && ph <= 12) ? (ph - 1) / 6 : 0;
        const int kind = (ph == 0) ? PH_PRO : (ph == PH_FIN ? PH_FIN : 1 + (ph - 1) % 6);
        if (kind == PH_PRO) {
            { pro::Inputs pin{a.in[0], a.in[1], a.in[4], a.in[5], a.in[8], a.in[9], a.in[10], a.in[11], a.in[12], a.in[13], a.in[14], a.in[15]}; pro::prologue(ws, pin, ldsl + RING_OFF, vcu, G); }
            asm volatile("" :: "v"(pw_v));
        } else if (kind == PH_IN) {
            pg8::Gemm g{(const bf16_t*)(ws + WS_XB), (const bf16_t*)(ws + WS_WIN + l * SZ_WIN), T, NIN, D}; pg8::StaticOrder S; S.init(T, NIN, G, bx);
            if (l) FILL_RSL((const float*)(ws + WS_ST2));
            pg8::FEpiIn E{ws, a.in[6] + l * 256, l, (const LAS float*)(ldsl + RSL_OFF)};
            pg8::gemm_phase<pg8::FEpiIn, pg8::StaticOrder, true, true>(ldsl + RING_OFF, g, S, E);
        } else if (kind == PH_ATT) {
            for (int i = 0; i < 2; ++i) { const int idx = vcu * 2 + i; if (idx >= 512) break; const int bh = idx >> 4, qb = idx & 15;
                att::attn_unit(bh >> 2, bh & 3, qb, (const bf16_t*)(ws + WS_Q), (const bf16_t*)(ws + WS_K), (const bf16_t*)(ws + WS_V), (bf16_t*)(ws + WSB_OC + (size_t)(bh >> 2) * DLT_OC), a.in[2] + l * 256, a.in[3] + l * 128, l, (char*)lds + RING_OFF); }
            if (vcu * 2 + 1 < 512) {
                typedef unsigned u32x4_ __attribute__((ext_vector_type(4))); u32x4_ tva[4], tvb[4]; const int ia = vcu * 2, ib = ia + 1;
                fft::stage1_load(tva, ia >> 6, ia & 63, (const bf16_t*)(ws + WS_TAB)); fft::stage1_load(tvb, ib >> 6, ib & 63, (const bf16_t*)(ws + WS_TAB));
                fft::stage1_item(ia >> 6, ia & 63, tva, (bf16_t*)(ws + WS_XT), ldsl + RING_OFF); fft::stage1_item(ib >> 6, ib & 63, tvb, (bf16_t*)(ws + WS_XT), ldsl + RING_OFF); }
            if (vcu < 256) gla::gla_a_item(vcu >> 5, (vcu >> 3) & 3, vcu & 7, ws, ldsl + RING_OFF);
        } else if (kind == PH_MIXB) {
            if (vcu < 256) fft::stage2_item(vcu >> 5, vcu & 31, (const bf16_t*)(ws + WS_XT), (bf16_t*)(ws + WSB_OC + (size_t)(vcu >> 5) * DLT_OC), ldsl + RING_OFF);
            if (vcu < 256) gla::gla_b_item(vcu >> 5, (vcu >> 3) & 3, vcu & 7, ws, a.in[7] + l * 64, (bf16_t*)(ws + WSB_OC + (size_t)(vcu >> 5) * DLT_OC), ldsl + RING_OFF);
        } else if (kind == PH_OUT) {
            pg8::Gemm g{(const bf16_t*)(ws + WSB_OC + (size_t)(bx & 7) * DLT_OC), (const bf16_t*)(ws + WS_WOUT + l * SZ_WOUT), T, D, D}; pg8::StaticOrder S; S.init(T, D, G, bx);
            if (l) FILL_RSL((const float*)(ws + WS_ST2));
            pg8::FEpiRes E{l ? (const LAS float*)(ldsl + RSL_OFF) : (const LAS float*)nullptr, a.in[14] + (l ? l - 1 : 0) * 1024, a.in[15] + (l ? l - 1 : 0) * 1024, (bf16_t*)(ws + WS_XB), (float*)(ws + WS_ST1)};
            pg8::gemm_phase<pg8::FEpiRes, pg8::StaticOrder, true, true>(ldsl + RING_OFF, g, S, E);
        } else if (kind == PH_GU) {
            pg8::Gemm g{(const bf16_t*)(ws + WS_XB), (const bf16_t*)(ws + WS_WGU + l * SZ_WGU), T, NGU, D}; pg8::StaticOrder S; S.init(T, NGU, G, bx);
            FILL_RSL((const float*)(ws + WS_ST1));
            pg8::FEpiGU E{(const LAS float*)(ldsl + RSL_OFF), (const float*)(ws + V_C1GU) + l * NGU, (const float*)(ws + V_C2GU) + l * NGU, (bf16_t*)(ws + WS_ACT)};
            pg8::gemm_phase<pg8::FEpiGU, pg8::StaticOrder, true, true>(ldsl + RING_OFF, g, S, E);
        } else if (kind == PH_DN) {
            pg8::Gemm g{(const bf16_t*)(ws + WS_ACT), (const bf16_t*)(ws + WS_WDN + l * SZ_WDN), T, D, FF}; pg8::StaticOrder S; S.init(T, D, G, bx);
            FILL_RSL((const float*)(ws + WS_ST1));
            pg8::FEpiRes E{(const LAS float*)(ldsl + RSL_OFF), a.in[9] + l * 1024, a.in[10] + l * 1024, (bf16_t*)(ws + WS_XB), (float*)(ws + WS_ST2)};
            pg8::gemm_phase<pg8::FEpiRes, pg8::StaticOrder, true, true>(ldsl + RING_OFF, g, S, E);
        } else if (kind == PH_FIN) {
            const float* g2 = a.in[14] + 1024; const float* b2v = a.in[15] + 1024; const float* ST2 = (const float*)(ws + WS_ST2); const bf16_t* XB = (const bf16_t*)(ws + WS_XB); float* Y2 = a.out;
            int tid_f = threadIdx.x; asm volatile("" : "+v"(tid_f)); const int lane = tid_f & 63, wave = __builtin_amdgcn_readfirstlane(tid_f >> 6);
            typedef float f32x4 __attribute__((ext_vector_type(4))); typedef unsigned u32x2 __attribute__((ext_vector_type(2)));
            f32x4 gg[4], bq[4];
#pragma unroll
            for (int j = 0; j < 4; ++j) { gg[j] = *((const f32x4*)g2 + lane + 64 * j); bq[j] = *((const f32x4*)b2v + lane + 64 * j); }
            const bool grp_rows = (G % 8 == 0) && (S % ((G / 8) * NWAVES) == 0);
            const int r_first = grp_rows ? (bx & 7) * S + (bx >> 3) * NWAVES + wave : vcu * NWAVES + wave, r_step = grp_rows ? (G / 8) * NWAVES : G * NWAVES, r_end = grp_rows ? (bx & 7) * S + S : T;
            for (int row = r_first; row < r_end; row += r_step) { const RowStat rs = row_stat(ST2, row);
                const u32x2* xr = (const u32x2*)(XB + (size_t)row * 1024) + lane; f32x4* yr = (f32x4*)(Y2 + (size_t)row * 1024) + lane;
#pragma unroll
                for (int j = 0; j < 4; ++j) { const u32x2 w = xr[64 * j]; const f32x4 v = {__uint_as_float(w.x << 16), __uint_as_float(w.x & 0xffff0000u), __uint_as_float(w.y << 16), __uint_as_float(w.y & 0xffff0000u)};
                    yr[64 * j] = (v - rs.mu) * rs.rstd * gg[j] + bq[j]; } }
        }
        if (ph + 1 < a.ph_hi) { const bool local = grp_ok && kind != PH_PRO; if (local) xcd_barrier(gbar); else xcd_barrier(bar); }
    }
}

static void launch_frame(const MArgs& base, int lo, int hi, int grid, hipStream_t stream, int li = 0) {
    MArgs a = base; a.ph_lo = lo; a.ph_hi = hi; a.li = li;
    hipLaunchKernelGGL(mk_fwd, dim3(grid), dim3(NWAVES * 64), LDS_BYTES, stream, a);
}
extern "C" void kernel_launch(void* const* d_in, const int* in_sizes, int n_in, void* d_out, int out_size, void* d_ws, size_t ws_size, hipStream_t stream) {
    static int grid = 0;
    if (grid == 0) {
        if (n_in != 16 || in_sizes[0] != T * D || out_size != T * D || ws_size < WS_END) { fprintf(stderr, "kernel_launch: unexpected shapes (n_in %d, in0 %d, out %d, ws %zu)\n", n_in, n_in > 0 ? in_sizes[0] : -1, out_size, ws_size); grid = -1; return; }
        int dev = 0, cus = 0, per_cu = 0;
        if (hipGetDevice(&dev) != hipSuccess || hipDeviceGetAttribute(&cus, hipDeviceAttributeMultiprocessorCount, dev) != hipSuccess) { grid = -1; return; }
        if (hipFuncSetAttribute((const void*)mk_fwd, hipFuncAttributeMaxDynamicSharedMemorySize, LDS_BYTES) != hipSuccess) { fprintf(stderr, "kernel_launch: hipFuncSetAttribute failed\n"); grid = -1; return; }
        if (hipOccupancyMaxActiveBlocksPerMultiprocessor(&per_cu, (const void*)mk_fwd, NWAVES * 64, LDS_BYTES) != hipSuccess || per_cu < 1) { fprintf(stderr, "kernel_launch: occupancy query says %d workgroups per CU\n", per_cu); per_cu = 1; }
        (void)hipGetLastError();
        grid = cus;
        if (grid != 256) { fprintf(stderr, "kernel_launch: this kernel's work split is built for the 256 CUs of an MI355X, found %d; nothing launched\n", cus); grid = -1; return; }
    }
    if (grid < 0) return;
    const float* x = (const float*)d_in[0]; const float* w_in = (const float*)d_in[1]; const float* dlam = (const float*)d_in[2]; const float* dng = (const float*)d_in[3];
    const float* fw = (const float*)d_in[4]; const float* gw2 = (const float*)d_in[5]; const float* gb2 = (const float*)d_in[6]; const float* gng = (const float*)d_in[7];
    const float* w_out = (const float*)d_in[8]; const float* ln1g = (const float*)d_in[9]; const float* ln1b = (const float*)d_in[10];
    const float* wg = (const float*)d_in[11]; const float* wu = (const float*)d_in[12]; const float* wd = (const float*)d_in[13]; const float* ln2g = (const float*)d_in[14]; const float* ln2b = (const float*)d_in[15];
    char* ws = (char*)d_ws;
    float* ropec = (float*)(ws + V_ROPEC); float* ropes = (float*)(ws + V_ROPES); float* MF = (float*)(ws + V_MF);
    float* c1in = (float*)(ws + V_C1IN); float* c2in = (float*)(ws + V_C2IN); float* c1gu = (float*)(ws + V_C1GU); float* c2gu = (float*)(ws + V_C2GU);
    bf16_t* TAB = (bf16_t*)(ws + WS_TAB); bf16_t* XB = (bf16_t*)(ws + WS_XB);
    bf16_t* Q = (bf16_t*)(ws + WS_Q); bf16_t* K = (bf16_t*)(ws + WS_K); bf16_t* V = (bf16_t*)(ws + WS_V);
    bf16_t* GQK = (bf16_t*)(ws + WS_GQK); bf16_t* GV = (bf16_t*)(ws + WS_GV); bf16_t* GR = (bf16_t*)(ws + WS_GR); float* GL = (float*)(ws + WS_GL);
    bf16_t* OC = (bf16_t*)(ws + WS_OC); float* OF = (float*)(ws + WS_OF);
    (void)hipMemsetAsync(ws + WS_CTL, 0, CTL_ZERO_BYTES, stream);
    MArgs base{}; for (int i = 0; i < 16; ++i) base.in[i] = (const float*)d_in[i]; base.out = (float*)d_out; base.ws = (unsigned char*)d_ws;
    launch_frame(base, 0, N_PHASES, grid, stream, 0);
}
```

```cpp
#include <hip/hip_runtime.h>
#include <cstdint>
#include <cstdio>
#include <cmath>

typedef unsigned short bf16_t;
namespace cfg {
constexpr int B = 8, S = 2048, D = 1024, T = B * S, L = 2;
constexpr int INW = 2592, NIN = 3072, FF = 2816, NGU = 2 * FF;
constexpr float ALPHA = 1.41421356237309515f;
constexpr float EPS = 1e-5f;
constexpr float QSCALE = 0.125f * 1.4426950408889634f;
constexpr float GQSCALE = 0.17677669529663687f;
constexpr size_t MiB = 1u << 20;
constexpr size_t WS_CTL = 0;
constexpr size_t WS_VEC = 1 * MiB;
constexpr size_t V_ROPEC = WS_VEC, V_ROPES = WS_VEC + 256 * 1024, V_MF = WS_VEC + 512 * 1024;
constexpr size_t V_C1IN = WS_VEC + 768 * 1024, V_C2IN = V_C1IN + 24 * 1024, V_C1GU = V_C2IN + 24 * 1024, V_C2GU = V_C1GU + 44 * 1024;
constexpr size_t WS_WIN = 2 * MiB, WS_WOUT = 14 * MiB, WS_WGU = 18 * MiB, WS_WDN = 40 * MiB, WS_TAB = 51 * MiB;
constexpr size_t SZ_WIN = 6 * MiB, SZ_WOUT = 2 * MiB, SZ_WGU = 11 * MiB, SZ_WDN = 5632 * 1024;
constexpr size_t WS_XB = 67 * MiB;
constexpr size_t WS_Y1 = 99 * MiB, WS_Q = 99 * MiB, WS_K = 115 * MiB, WS_V = 131 * MiB, WS_XT = 147 * MiB;
constexpr size_t WS_ACT = 163 * MiB, WS_GQK = 163 * MiB, WS_GV = 171 * MiB, WS_GR = 179 * MiB, WS_GL = 187 * MiB, WS_OC = 203 * MiB, WS_OF = 235 * MiB;
constexpr size_t WSB_GQK = WS_ACT, WSB_GV = WS_ACT + 1 * MiB, WSB_GR = WS_ACT + 2 * MiB, WSB_GL = WS_ACT + 3 * MiB, WSB_OC = WS_ACT + 5 * MiB, WSB_OF = WS_ACT + 9 * MiB;
constexpr size_t DLT_GQK = 10 * MiB, DLT_GV = 10 * MiB, DLT_GR = 10 * MiB, DLT_GL = 9 * MiB, DLT_OC = 7 * MiB, DLT_OF = 9 * MiB;
constexpr size_t WS_ST1 = 251 * MiB, WS_ST2 = 253 * MiB, WS_DEC = 255 * MiB, WS_END = 256 * MiB;
}
using namespace cfg;

__device__ __forceinline__ float bf2f(bf16_t v) { return __uint_as_float((unsigned)v << 16); }
__device__ __forceinline__ bf16_t f2bf(float f) { unsigned u = __float_as_uint(f); return (bf16_t)((u + 0x7fffu + ((u >> 16) & 1u)) >> 16); }


template <int M> __device__ __forceinline__ float xadd(float v) {
    if constexpr (M == 32) { auto r = __builtin_amdgcn_permlane32_swap(__float_as_uint(v), __float_as_uint(v), false, false); return __uint_as_float(r[0]) + __uint_as_float(r[1]); }
    else return v + __int_as_float(__builtin_amdgcn_ds_swizzle(__float_as_int(v), (M << 10) | 0x1f));
}
struct RowStat { float mu, rstd; };
__device__ __forceinline__ RowStat row_stat(const float* ST, int row) {
    float s = 0.f, ss = 0.f;
    for (int i = 0; i < 8; ++i) { const float4 a = *(const float4*)(ST + (size_t)row * 32 + 4 * i); s += a.x + a.z; ss += a.y + a.w; }
    const float mu = s * (1.f / 1024.f); const float var = ss * (1.f / 1024.f) - mu * mu;
    RowStat r; r.mu = mu; r.rstd = rsqrtf(fmaxf(var, 0.f) + EPS); return r;
}
namespace pg8 {
#define PG8_LAS __attribute__((address_space(3)))
typedef unsigned short bf16_t;
typedef short bf16x8 __attribute__((ext_vector_type(8)));
typedef float f32x4 __attribute__((ext_vector_type(4)));
typedef unsigned u32x4 __attribute__((ext_vector_type(4)));
constexpr int BM = 256, BK = 64, HALF = 128, HTB = HALF * BK * 2  , STAGE_BYTES = 8 * HTB, NXCD = 8, WGM = 8;

__host__ __device__ __forceinline__ int lds_byte(int r, int c) { const int st = (r >> 4) * 2 + (c >> 5), rr = r & 15, cc = c & 31, ob = rr * 64 + cc * 2; return st * 1024 + (ob ^ (((ob >> 9) & 1) << 5)); }
__host__ __device__ __forceinline__ void stage_rc(int b, int& R, int& C) { const int st = b / 1024, sb = b % 1024, swz = sb ^ (((sb >> 9) & 1) << 5); R = (st >> 1) * 16 + swz / 64; C = (st & 1) * 32 + (swz % 64) / 2; }
__host__ __device__ __forceinline__ int perm32(int rho) { const int n = rho >> 4, i = rho & 15; return 8 * (i >> 2) + 4 * n + (i & 3); }

struct Unit { int pm, pn; };
struct Gemm { const bf16_t* A; const bf16_t* Bt; int M, N, K; };

struct StaticOrder {
    int nM, nN, nwg, G, c;
    __host__ __device__ void init(int M, int N, int G_, int c_) { nM = M / BM; nN = N / BM; nwg = nM * nN; G = G_; c = c_; }
    __host__ __device__ bool next(int i, Unit& u) const {
        const long L = (long)i * G + c; if (L >= nwg) return false;
        int wgid = (int)L; { const int q = nwg / NXCD, r = nwg % NXCD, xcd = wgid % NXCD, off = wgid / NXCD; wgid = (xcd < r ? xcd * (q + 1) : r * (q + 1) + (xcd - r) * q) + off; }
        const int nig = WGM * nN, gid = wgid / nig, fm = gid * WGM, gsz = (nM - fm) < WGM ? (nM - fm) : WGM;
        u.pm = fm + ((wgid % nig) % gsz); u.pn = (wgid % nig) / gsz; return true;
    }
    __device__ __forceinline__ void a_ready(const Unit&) const {}
    __device__ __forceinline__ void done(const Unit&) const {}
};
template <class Epi, class Sched, bool ALIGN_EPI = false, bool SP2 = false>
__device__ __forceinline__ void gemm_phase(PG8_LAS unsigned char* lds, const Gemm g, const Sched& S, const Epi& E) {
    int tid_o = threadIdx.x; asm volatile("" : "+v"(tid_o));
    const int tid = tid_o, wid = __builtin_amdgcn_readfirstlane(tid >> 6), lane = tid & 63, wr = wid >> 2, wc = wid & 3, fr = lane & 15, fq = lane >> 4;
    const int K = g.K, nt = K / BK;
    unsigned voffA[2], voffB[2];
#pragma unroll
    for (int i = 0; i < 2; ++i) { int R, C; stage_rc(tid * 16 + i * 8192, R, C); const int Rb = Epi::PERM ? ((R & ~31) + perm32(R & 31)) : R;
        voffA[i] = (unsigned)(R * K + C) * 2u; voffB[i] = (unsigned)(Rb * K + C) * 2u; }
    const size_t kstep = (size_t)(BK * 2);
    const size_t hstep = (size_t)HALF * K * 2;
    const size_t tstep = 2 * hstep;
    const unsigned ldsw = (unsigned)wid * 1024u;
    const int aoff = lds_byte(wr * 64 + fr, fq * 8), boff = lds_byte(wc * 32 + fr, fq * 8);
#define PG8_SA(b, h) (((b) * 2 + (h)) * HTB)
#define PG8_SB(b, h) ((4 + (b) * 2 + (h)) * HTB)
#define PG8_STAGE(bufoff, gbase, voff) do { _Pragma("unroll") for (int _i = 0; _i < 2; ++_i) \
        __builtin_amdgcn_global_load_lds((const unsigned*)((const char*)(gbase) + (voff)[_i]), (PG8_LAS unsigned*)(lds + (bufoff) + ldsw + _i * 8192), 16, 0, 0); } while (0)
#define PG8_LDA(dst, b, h) do { _Pragma("unroll") for (int m = 0; m < 4; ++m) _Pragma("unroll") for (int k = 0; k < 2; ++k) dst[m][k] = *(const PG8_LAS bf16x8*)(lds + PG8_SA(b, h) + aoff + m * 2048 + k * 1024); } while (0)
#define PG8_LDB(dst, b, h) do { _Pragma("unroll") for (int n = 0; n < 2; ++n) _Pragma("unroll") for (int k = 0; k < 2; ++k) dst[n][k] = *(const PG8_LAS bf16x8*)(lds + PG8_SB(b, h) + boff + n * 2048 + k * 1024); } while (0)
#define PG8_MMA(ai, bj, At, Bt) do { __builtin_amdgcn_s_setprio(1); _Pragma("unroll") for (int m = 0; m < 4; ++m) _Pragma("unroll") for (int n = 0; n < 2; ++n) _Pragma("unroll") for (int k = 0; k < 2; ++k) \
        acc[ai][bj][m][n] = __builtin_amdgcn_mfma_f32_16x16x32_bf16(Bt[n][k], At[m][k], acc[ai][bj][m][n], 0, 0, 0); __builtin_amdgcn_s_setprio(0); } while (0)
#define PG8_WAIT_V(n) asm volatile("s_waitcnt vmcnt(" #n ")" ::: "memory")
#define PG8_WAIT_L(n) asm volatile("s_waitcnt lgkmcnt(" #n ")" ::: "memory")
#define PG8_BAR __builtin_amdgcn_s_barrier()
#define PG8_SCHED __builtin_amdgcn_sched_barrier(0)
    Unit cur, nxt; int ui = 0;
    if (!S.next(0, cur)) return;
    f32x4 acc[2][2][4][2];
#pragma unroll
    for (int a = 0; a < 2; ++a)
#pragma unroll
        for (int b = 0; b < 2; ++b)
#pragma unroll
            for (int m = 0; m < 4; ++m)
#pragma unroll
                for (int n = 0; n < 2; ++n) acc[a][b][m][n] = (f32x4){0.f, 0.f, 0.f, 0.f};
    bf16x8 At[4][2], B0[2][2], B1[2][2];
    const char* cA = (const char*)g.A + (size_t)cur.pm * tstep; const char* cB = (const char*)g.Bt + (size_t)cur.pn * tstep;
    S.a_ready(cur);
    if constexpr (SP2) {
        PG8_STAGE(PG8_SB(0, 0), cB, voffB); PG8_STAGE(PG8_SB(0, 1), cB + hstep, voffB); PG8_STAGE(PG8_SA(0, 0), cA, voffA); PG8_STAGE(PG8_SA(0, 1), cA + hstep, voffA);
        if (wr == 1) PG8_BAR;
        PG8_WAIT_V(2); PG8_BAR;
        PG8_STAGE(PG8_SB(1, 0), cB + kstep, voffB); PG8_STAGE(PG8_SA(1, 0), cA + kstep, voffA); PG8_STAGE(PG8_SB(1, 1), cB + hstep + kstep, voffB);
        PG8_WAIT_V(6); PG8_BAR;
    } else {
        PG8_STAGE(PG8_SB(0, 0), cB, voffB); PG8_STAGE(PG8_SA(0, 0), cA, voffA); PG8_STAGE(PG8_SB(0, 1), cB + hstep, voffB); PG8_STAGE(PG8_SA(0, 1), cA + hstep, voffA);
        if (wr == 1) PG8_BAR;
        PG8_WAIT_V(4); PG8_BAR;
        PG8_STAGE(PG8_SB(1, 0), cB + kstep, voffB); PG8_STAGE(PG8_SA(1, 0), cA + kstep, voffA); PG8_STAGE(PG8_SB(1, 1), cB + hstep + kstep, voffB);
        PG8_WAIT_V(6); PG8_BAR;
    }
    for (;;) {
        const bool has_next = S.next(ui + 1, nxt);
        const char* nA = has_next ? (const char*)g.A + (size_t)nxt.pm * tstep : cA; const char* nB = has_next ? (const char*)g.Bt + (size_t)nxt.pn * tstep : cB;
        for (int t = 0; t < nt; t += 2) {
            const bool last = (t == nt - 2);
            const char* a1 = cA + (size_t)(t + 1) * kstep;
            const char* a2 = last ? nA : cA + (size_t)(t + 2) * kstep; const char* b2 = last ? nB : cB + (size_t)(t + 2) * kstep;
            const char* a3 = a2 + kstep; const char* b3 = b2 + kstep;
            if (last && has_next) S.a_ready(nxt);
            if constexpr (SP2) {
            PG8_LDB(B0, 0, 0); PG8_LDB(B1, 0, 1); PG8_SCHED; PG8_LDA(At, 0, 0); PG8_STAGE(PG8_SA(1, 1), a1 + hstep, voffA);
            PG8_WAIT_V(8); PG8_WAIT_L(0); PG8_BAR; PG8_MMA(0, 0, At, B0); PG8_MMA(0, 1, At, B1); PG8_BAR; PG8_SCHED;
            PG8_LDA(At, 0, 1); PG8_STAGE(PG8_SB(0, 0), b2, voffB); PG8_STAGE(PG8_SB(0, 1), b2 + hstep, voffB); PG8_STAGE(PG8_SA(0, 0), a2, voffA);
            PG8_WAIT_V(8); PG8_WAIT_L(0); PG8_BAR; PG8_MMA(1, 0, At, B0); PG8_MMA(1, 1, At, B1); PG8_BAR; PG8_SCHED;
            PG8_LDB(B0, 1, 0); PG8_LDB(B1, 1, 1); PG8_SCHED; PG8_LDA(At, 1, 0); PG8_STAGE(PG8_SA(0, 1), a2 + hstep, voffA);
            PG8_WAIT_V(8); PG8_WAIT_L(0); PG8_BAR; PG8_MMA(0, 0, At, B0); PG8_MMA(0, 1, At, B1); PG8_BAR; PG8_SCHED;
            PG8_LDA(At, 1, 1); PG8_STAGE(PG8_SB(1, 0), b3, voffB); PG8_STAGE(PG8_SB(1, 1), b3 + hstep, voffB); PG8_STAGE(PG8_SA(1, 0), a3, voffA);
            PG8_WAIT_V(8); PG8_WAIT_L(0); PG8_BAR; PG8_MMA(1, 0, At, B0); PG8_MMA(1, 1, At, B1); PG8_BAR; PG8_SCHED;
            } else {
            PG8_LDB(B0, 0, 0); PG8_SCHED; PG8_LDA(At, 0, 0); PG8_STAGE(PG8_SA(1, 1), a1 + hstep, voffA);
            PG8_WAIT_L(8); PG8_BAR; PG8_WAIT_L(0); PG8_MMA(0, 0, At, B0); PG8_BAR; PG8_SCHED;
            PG8_LDB(B1, 0, 1); PG8_STAGE(PG8_SB(0, 0), b2, voffB);
            PG8_BAR; PG8_WAIT_L(0); PG8_MMA(0, 1, At, B1); PG8_BAR;
            PG8_LDA(At, 0, 1); PG8_STAGE(PG8_SA(0, 0), a2, voffA);
            PG8_BAR; PG8_WAIT_L(0); PG8_MMA(1, 0, At, B0); PG8_BAR; PG8_SCHED;
            PG8_STAGE(PG8_SB(0, 1), b2 + hstep, voffB);
            PG8_WAIT_V(6); PG8_BAR; PG8_MMA(1, 1, At, B1); PG8_BAR;
            PG8_LDB(B0, 1, 0); PG8_SCHED; PG8_LDA(At, 1, 0); PG8_STAGE(PG8_SA(0, 1), a2 + hstep, voffA);
            PG8_WAIT_L(8); PG8_BAR; PG8_WAIT_L(0); PG8_MMA(0, 0, At, B0); PG8_BAR; PG8_SCHED;
            PG8_LDB(B1, 1, 1); PG8_STAGE(PG8_SB(1, 0), b3, voffB);
            PG8_BAR; PG8_WAIT_L(0); PG8_MMA(0, 1, At, B1); PG8_BAR;
            PG8_LDA(At, 1, 1); PG8_STAGE(PG8_SA(1, 0), a3, voffA);
            PG8_BAR; PG8_WAIT_L(0); PG8_MMA(1, 0, At, B0); PG8_BAR; PG8_SCHED;
            PG8_STAGE(PG8_SB(1, 1), b3 + hstep, voffB);
            PG8_WAIT_V(6); PG8_BAR; PG8_MMA(1, 1, At, B1); PG8_BAR;
            }
        }
        if constexpr (ALIGN_EPI) { if (wr == 0) PG8_BAR; }
        if constexpr (!Epi::AFTER_DRAIN) { E(acc, cur, wr, wc, fr, fq); S.done(cur); }
        if (!has_next) break;
#pragma unroll
        for (int a = 0; a < 2; ++a)
#pragma unroll
            for (int b = 0; b < 2; ++b)
#pragma unroll
                for (int m = 0; m < 4; ++m)
#pragma unroll
                    for (int n = 0; n < 2; ++n) acc[a][b][m][n] = (f32x4){0.f, 0.f, 0.f, 0.f};
        cur = nxt; cA = nA; cB = nB; ++ui;
        if constexpr (ALIGN_EPI) { if (wr == 1) PG8_BAR; }
    }
    PG8_WAIT_V(0);
    if constexpr (!ALIGN_EPI) { if (wr == 0) PG8_BAR; }
    PG8_BAR;
    if constexpr (Epi::AFTER_DRAIN) { E.fused(acc, cur, wr, wc, fr, fq, lds, wid, lane); S.done(cur); }
#undef PG8_SA
#undef PG8_SB
#undef PG8_STAGE
#undef PG8_LDA
#undef PG8_LDB
#undef PG8_MMA
#undef PG8_WAIT_V
#undef PG8_WAIT_L
#undef PG8_BAR
#undef PG8_SCHED
}
}
namespace pg8 {
__device__ __forceinline__ unsigned cvt_pk_bf16(float lo, float hi) { unsigned r; asm volatile("v_cvt_pk_bf16_f32 %0, %1, %2" : "=v"(r) : "v"(lo), "v"(hi)); return r; }
__device__ __forceinline__ void st8(bf16_t* p, const f32x4 a, const f32x4 b) { u32x4 w; w.x = cvt_pk_bf16(a[0], a[1]); w.y = cvt_pk_bf16(a[2], a[3]); w.z = cvt_pk_bf16(b[0], b[1]); w.w = cvt_pk_bf16(b[2], b[3]); *(u32x4*)p = w; }
__device__ __forceinline__ void st8nt(bf16_t* p, const f32x4 a, const f32x4 b) { u32x4 w; w.x = cvt_pk_bf16(a[0], a[1]); w.y = cvt_pk_bf16(a[2], a[3]); w.z = cvt_pk_bf16(b[0], b[1]); w.w = cvt_pk_bf16(b[2], b[3]); __builtin_nontemporal_store(w, (u32x4*)p); }
struct RS { float a, b; };
struct StatLd { f32x4 x, y; };
__device__ __forceinline__ StatLd stat_load(const float* ST, int row, int fq) { const f32x4* p = (const f32x4*)(ST + (size_t)row * 32 + fq * 8); StatLd r; r.x = p[0]; r.y = p[1]; return r; }
__device__ __forceinline__ RS stat_fin(const StatLd& t) {
    float s = (t.x[0] + t.x[2]) + (t.y[0] + t.y[2]), ss = (t.x[1] + t.x[3]) + (t.y[1] + t.y[3]);
    s = xadd<16>(s); ss = xadd<16>(ss); s = xadd<32>(s); ss = xadd<32>(ss);
    const float mu = s * (1.f / 1024.f), var = ss * (1.f / 1024.f) - mu * mu, rstd = rsqrtf(fmaxf(var, 0.f) + cfg::EPS);
    RS r; r.a = rstd; r.b = -rstd * mu; return r;
}
__device__ __forceinline__ RS row_stat16(const float* ST, int row, int fq) { return stat_fin(stat_load(ST, row, fq)); }
__device__ __forceinline__ float fsilu(float x) { return x * __builtin_amdgcn_rcpf(1.f + __expf(-x)); }
__device__ __forceinline__ float flogsig16(float x) { return (fminf(x, 0.f) - __logf(1.f + __expf(-fabsf(x)))) * (1.f / 16.f); }

struct FEpiIn {
    static constexpr bool PERM = true, AFTER_DRAIN = false;
    unsigned char* ws; const float* b2; int l; const PG8_LAS float* rsl;
    struct RowLd { f32x4 rc[2], rsn[2]; };
    template <int KIND> __device__ __forceinline__ RowLd load_row(int row, const float (&invf)[8]) const {
        RowLd r;
        if constexpr (KIND == 0) { const float pos = (float)(row & 2047);
#pragma unroll
            for (int e = 0; e < 8; ++e) { const float ang = pos * invf[e]; double rv = (double)ang * 0.15915494309189535; rv -= floor(rv); const float rev = (float)rv;
                r.rc[e >> 2][e & 3] = __builtin_amdgcn_cosf(rev); r.rsn[e >> 2][e & 3] = __builtin_amdgcn_sinf(rev); } }
        return r;
    }
    template <int KIND> __device__ __forceinline__ void rows(const f32x4 (&acc)[2][2][4][2], const Unit& u, int wr, int wc, int fr, int fq) const {
        const int pn = u.pn, cw = 32 * wc + 8 * fq, row0 = u.pm * BM + 64 * wr + fr;
        const bool st = l != 0;
        f32x4 k1[2][2], k2[2][2], bias[2][2];
        const float qs = __uint_as_float(__builtin_amdgcn_readfirstlane(__float_as_uint(pn < 2 ? cfg::QSCALE : 1.f)));
        float invf[8];
        if constexpr (KIND == 0) {
#pragma unroll
            for (int e = 0; e < 8; ++e) invf[e] = exp2f(-(float)(8 * fq + e) * (13.287712379549449f / 32.f)); }
        RowLd cur = load_row<KIND>(row0, invf), nxt;
        if (st) {
#pragma unroll
            for (int bj = 0; bj < 2; ++bj)
#pragma unroll
                for (int n = 0; n < 2; ++n) {
                    if constexpr (KIND == 2) {
                        const float* fp = (const float*)(ws + cfg::V_MF) + (size_t)(l * 8) * 512 + (pn - 6) * 256 + cw + 128 * bj + 4 * n;
                        k1[bj][n] = (*(const f32x4*)fp + *(const f32x4*)(fp + 1024)) + (*(const f32x4*)(fp + 2048) + *(const f32x4*)(fp + 3072));
                        k2[bj][n] = (*(const f32x4*)(fp + 512) + *(const f32x4*)(fp + 1536)) + (*(const f32x4*)(fp + 2560) + *(const f32x4*)(fp + 3584));
                    } else { const float* c1 = (const float*)(ws + cfg::V_C1IN) + l * cfg::NIN + pn * 256 + cw; const float* c2 = (const float*)(ws + cfg::V_C2IN) + l * cfg::NIN + pn * 256 + cw;
                        k1[bj][n] = *(const f32x4*)(c1 + 128 * bj + 4 * n); k2[bj][n] = *(const f32x4*)(c2 + 128 * bj + 4 * n); } } }
        if constexpr (KIND == 6) {
#pragma unroll
            for (int bj = 0; bj < 2; ++bj)
#pragma unroll
                for (int n = 0; n < 2; ++n) bias[bj][n] = *(const f32x4*)(b2 + 128 * bj + cw + 4 * n); }
#pragma unroll
        for (int i = 0; i < 8; ++i) {
            const int ai = i >> 2, m = i & 3, row = row0 + 128 * ai + 16 * m, pos = row & 2047;
            if (i < 7) nxt = load_row<KIND>(row0 + 128 * ((i + 1) >> 2) + 16 * ((i + 1) & 3), invf);
            f32x4 v[2][2];
            if (st) { typedef float f32x2 __attribute__((ext_vector_type(2))); const f32x2 t2 = *(const PG8_LAS f32x2*)(rsl + 2 * (128 * ai + 64 * wr + 16 * m + fr)); RS rs; rs.a = t2[0]; rs.b = t2[1];
#pragma unroll
                for (int bj = 0; bj < 2; ++bj)
#pragma unroll
                    for (int n = 0; n < 2; ++n) v[bj][n] = rs.a * acc[ai][bj][m][n] + (rs.b * k1[bj][n] + k2[bj][n]);
            } else {
#pragma unroll
                for (int bj = 0; bj < 2; ++bj)
#pragma unroll
                    for (int n = 0; n < 2; ++n) v[bj][n] = acc[ai][bj][m][n]; }
            if constexpr (KIND == 0) {
                f32x4 a0 = v[0][0] * cur.rc[0] - v[1][0] * cur.rsn[0], a1 = v[0][1] * cur.rc[1] - v[1][1] * cur.rsn[1];
                f32x4 b0 = v[1][0] * cur.rc[0] + v[0][0] * cur.rsn[0], b1 = v[1][1] * cur.rc[1] + v[0][1] * cur.rsn[1];
                a0 = a0 * qs; a1 = a1 * qs; b0 = b0 * qs; b1 = b1 * qs;
                bf16_t* dst = (bf16_t*)(ws + (pn < 2 ? cfg::WS_Q : cfg::WS_K)) + (size_t)row * 512 + (4 * (pn & 1) + wc) * 64 + 8 * fq;
                st8(dst, a0, a1); st8(dst + 32, b0, b1);
            } else if constexpr (KIND == 1) {
                bf16_t* dst = (bf16_t*)(ws + cfg::WS_V) + (size_t)row * 512 + (pn - 4) * 256 + cw; st8(dst, v[0][0], v[0][1]); st8(dst + 128, v[1][0], v[1][1]);
            } else if constexpr (KIND == 2) {
                bf16_t* dst = (bf16_t*)(ws + cfg::WS_TAB) + (size_t)row * 512 + (pn - 6) * 256 + cw; st8(dst, v[0][0], v[0][1]); st8(dst + 128, v[1][0], v[1][1]);
            } else if constexpr (KIND == 3) {
                bf16_t* dst = (bf16_t*)(ws + cfg::WSB_GQK + (size_t)(u.pm >> 3) * cfg::DLT_GQK) + (size_t)row * 256 + cw; st8(dst, v[0][0] * cfg::GQSCALE, v[0][1] * cfg::GQSCALE); st8(dst + 128, v[1][0], v[1][1]);
            } else if constexpr (KIND == 4) {
                bf16_t* dst = (bf16_t*)(ws + cfg::WSB_GV + (size_t)(u.pm >> 3) * cfg::DLT_GV) + (size_t)row * 256 + cw; st8(dst, v[0][0], v[0][1]); st8(dst + 128, v[1][0], v[1][1]);
            } else if constexpr (KIND == 5) {
                bf16_t* dst = (bf16_t*)(ws + cfg::WSB_GR + (size_t)(u.pm >> 3) * cfg::DLT_GR) + (size_t)row * 256 + cw;
#pragma unroll
                for (int bj = 0; bj < 2; ++bj) { f32x4 x0 = v[bj][0], x1 = v[bj][1];
#pragma unroll
                    for (int e = 0; e < 4; ++e) { x0[e] = fsilu(x0[e]); x1[e] = fsilu(x1[e]); } st8(dst + 128 * bj, x0, x1); }
            } else {
                float* dst = (float*)(ws + cfg::WSB_GL + (size_t)(u.pm >> 3) * cfg::DLT_GL) + (size_t)row * 256 + cw;
#pragma unroll
                for (int bj = 0; bj < 2; ++bj)
#pragma unroll
                    for (int n = 0; n < 2; ++n) { f32x4 x = v[bj][n] + bias[bj][n];
#pragma unroll
                        for (int e = 0; e < 4; ++e) x[e] = flogsig16(x[e]); *(f32x4*)(dst + 128 * bj + 4 * n) = x; }
            }
            if (i < 7) cur = nxt;
        }
    }
    __device__ __forceinline__ void operator()(const f32x4 (&acc)[2][2][4][2], const Unit& u, int wr, int wc, int fr, int fq) const {
        asm volatile("" : "+v"(fr), "+v"(fq));
        unsigned zo = 0u; asm volatile("" : "+s"(zo)); FEpiIn me = *this; me.ws = ws + zo;
        const int pn = u.pn;
        if (pn < 4) me.rows<0>(acc, u, wr, wc, fr, fq); else if (pn < 6) me.rows<1>(acc, u, wr, wc, fr, fq); else if (pn < 8) me.rows<2>(acc, u, wr, wc, fr, fq);
        else if (pn == 8) me.rows<3>(acc, u, wr, wc, fr, fq); else if (pn == 9) me.rows<4>(acc, u, wr, wc, fr, fq); else if (pn == 10) me.rows<5>(acc, u, wr, wc, fr, fq); else me.rows<6>(acc, u, wr, wc, fr, fq);
    }
};
struct FEpiRes {
    static constexpr bool PERM = true, AFTER_DRAIN = false;
    const PG8_LAS float* stprev;
    const float* g; const float* bb; bf16_t* XB; float* ST;
    struct RowLd { u32x4 xb[2]; };
    __device__ __forceinline__ RowLd load_row(int row, int col0, int fq) const {
        RowLd r; const size_t off = (size_t)row * 1024 + col0;
        r.xb[0] = *(const u32x4*)(XB + off); r.xb[1] = *(const u32x4*)(XB + off + 128);
        return r;
    }
    __device__ __forceinline__ void operator()(const f32x4 (&acc)[2][2][4][2], const Unit& u, int wr, int wc, int fr, int fq) const {
        asm volatile("" : "+v"(fr), "+v"(fq));
        const int col0 = u.pn * BM + 32 * wc + 8 * fq, row0 = u.pm * BM + 64 * wr + fr;
        f32x4 gv[2][2], bv[2][2];
        RowLd cur = load_row(row0, col0, fq), nxt;
        if (stprev) {
#pragma unroll
            for (int bj = 0; bj < 2; ++bj)
#pragma unroll
                for (int n = 0; n < 2; ++n) { gv[bj][n] = *(const f32x4*)(g + col0 + 128 * bj + 4 * n); bv[bj][n] = *(const f32x4*)(bb + col0 + 128 * bj + 4 * n); } }
#pragma unroll
        for (int i = 0; i < 8; ++i) { const int ai = i >> 2, m = i & 3, row = row0 + 128 * ai + 16 * m; const size_t off = (size_t)row * 1024 + col0;
            if (i < 7) nxt = load_row(row0 + 128 * ((i + 1) >> 2) + 16 * ((i + 1) & 3), col0, fq);
            RS rs; rs.a = 1.f; rs.b = 0.f; if (stprev) { typedef float f32x2 __attribute__((ext_vector_type(2))); const f32x2 t2 = *(const PG8_LAS f32x2*)(stprev + 2 * (128 * ai + 64 * wr + 16 * m + fr)); rs.a = t2[0]; rs.b = t2[1]; }
            float s = 0.f, ss = 0.f;
#pragma unroll
            for (int bj = 0; bj < 2; ++bj) { f32x4 y[2];
#pragma unroll
                for (int n = 0; n < 2; ++n) { const unsigned w0 = cur.xb[bj][2 * n], w1 = cur.xb[bj][2 * n + 1];
                    f32x4 x = (f32x4){__uint_as_float(w0 << 16), __uint_as_float(w0 & 0xffff0000u), __uint_as_float(w1 << 16), __uint_as_float(w1 & 0xffff0000u)};
                    if (stprev) x = (rs.a * x + rs.b) * gv[bj][n] + bv[bj][n];
                    y[n] = cfg::ALPHA * x + acc[ai][bj][m][n];
                    s += (y[n][0] + y[n][1]) + (y[n][2] + y[n][3]); ss += (y[n][0] * y[n][0] + y[n][1] * y[n][1]) + (y[n][2] * y[n][2] + y[n][3] * y[n][3]); }
                st8nt(XB + off + 128 * bj, y[0], y[1]); }
            s = xadd<16>(s); ss = xadd<16>(ss); s = xadd<32>(s); ss = xadd<32>(ss);
            if (fq == 0) { typedef float f32x2 __attribute__((ext_vector_type(2))); *(f32x2*)(ST + (size_t)row * 32 + (u.pn * 4 + wc) * 2) = (f32x2){s, ss}; }
            if (i < 7) cur = nxt; }
    }
};
struct FEpiGU {
    static constexpr bool PERM = true, AFTER_DRAIN = false;
    const PG8_LAS float* rsl;
    const float* c1; const float* c2; bf16_t* ACT;
    __device__ __forceinline__ void operator()(const f32x4 (&acc)[2][2][4][2], const Unit& u, int wr, int wc, int fr, int fq) const {
        asm volatile("" : "+v"(fr), "+v"(fq));
        const int cw = 32 * wc + 8 * fq, row0 = u.pm * BM + 64 * wr + fr; const float* c1p = c1 + u.pn * 256 + cw; const float* c2p = c2 + u.pn * 256 + cw;
        typedef float f32x2 __attribute__((ext_vector_type(2)));
        const __amdgpu_buffer_rsrc_t act_rsrc = __builtin_amdgcn_make_buffer_rsrc(ACT, 0, cfg::T * cfg::FF * 2, 0x00020000);
        f32x4 k1[2][2], k2[2][2];
#pragma unroll
        for (int bj = 0; bj < 2; ++bj)
#pragma unroll
            for (int n = 0; n < 2; ++n) { k1[bj][n] = *(const f32x4*)(c1p + 128 * bj + 4 * n); k2[bj][n] = *(const f32x4*)(c2p + 128 * bj + 4 * n); }
#pragma unroll
        for (int i = 0; i < 8; ++i) { const int ai = i >> 2, m = i & 3; const f32x2 rs = *(const PG8_LAS f32x2*)(rsl + 2 * (128 * ai + 64 * wr + 16 * m + fr)); f32x4 a[2];
#pragma unroll
            for (int n = 0; n < 2; ++n) { const f32x4 hg = rs[0] * acc[ai][0][m][n] + (rs[1] * k1[0][n] + k2[0][n]), hu = rs[0] * acc[ai][1][m][n] + (rs[1] * k1[1][n] + k2[1][n]);
#pragma unroll
                for (int e = 0; e < 4; ++e) a[n][e] = fsilu(hg[e]) * hu[e]; }
            { u32x4 w; w.x = cvt_pk_bf16(a[0][0], a[0][1]); w.y = cvt_pk_bf16(a[0][2], a[0][3]); w.z = cvt_pk_bf16(a[1][0], a[1][1]); w.w = cvt_pk_bf16(a[1][2], a[1][3]);
              __builtin_amdgcn_raw_buffer_store_b128(w, act_rsrc, (unsigned)(((size_t)(row0 + 128 * ai + 16 * m) * cfg::FF + 128 * u.pn + cw) * 2), 0, 16); } }
    }
};
struct FEpiFour {
    static constexpr bool PERM = true, AFTER_DRAIN = false;
    bf16_t* OC;
    __device__ __forceinline__ void operator()(const f32x4 (&acc)[2][2][4][2], const Unit& u, int wr, int wc, int fr, int fq) const {
        asm volatile("" : "+v"(fr), "+v"(fq));
        const int cw = 32 * wc + 8 * fq;
#pragma unroll
        for (int ai = 0; ai < 2; ++ai)
#pragma unroll
            for (int m = 0; m < 4; ++m) { const int row = u.pm * BM + 128 * ai + 64 * wr + 16 * m + fr; bf16_t* dst = OC + (size_t)(u.pn * 2048 + row) * 1024 + 512 + cw;
                st8(dst, acc[ai][0][m][0], acc[ai][0][m][1]); st8(dst + 128, acc[ai][1][m][0], acc[ai][1][m][1]); }
    }
};
}
namespace att {
using bf16x8 = __attribute__((ext_vector_type(8))) short;
using s16x4  = __attribute__((ext_vector_type(4))) short;
using f32x16 = __attribute__((ext_vector_type(16))) float;
using u32x4  = __attribute__((ext_vector_type(4))) unsigned;
constexpr int NW = 8, QBLK = 32, KVBLK = 64, LD = 512, NT = cfg::S / KVBLK;
constexpr int SHM_V = KVBLK * 128 * 2, SHM_K = KVBLK * 128 * 2, SHM_X = 2 * SHM_V + 2 * SHM_K, SHM_ATTN = SHM_X + NW * 64 * 4;
constexpr float THRL = 6.0f;
#define ATT_KSWZ(row, colB) ((row) * 256 + ((colB) ^ (((row) & 7) << 4)))
#define ATT_SBAR() __builtin_amdgcn_sched_barrier(0)
__device__ __forceinline__ int crow(int r, int hi) { return (r & 3) + 8 * (r >> 2) + 4 * hi; }
__device__ __forceinline__ unsigned cvtpk(float lo, float hi) { unsigned r; asm volatile("v_cvt_pk_bf16_f32 %0, %1, %2" : "=v"(r) : "v"(lo), "v"(hi)); return r; }
__device__ __forceinline__ void softmaxP(f32x16& p0, f32x16& p1, float& m_reg, float& l_reg, f32x16& negm, float& alpha, bool first, bf16x8& pa0, bf16x8& pa1, bf16x8& pa2, bf16x8& pa3) {
#define ATT_M3(a, b, c) fmaxf(fmaxf(a, b), c)
  const float t0 = ATT_M3(p0[0], p0[1], p0[2]), t1 = ATT_M3(p0[3], p0[4], p0[5]), t2 = ATT_M3(p0[6], p0[7], p0[8]), t3 = ATT_M3(p0[9], p0[10], p0[11]), t4 = ATT_M3(p0[12], p0[13], p0[14]);
  const float t5 = ATT_M3(p0[15], p1[0], p1[1]), t6 = ATT_M3(p1[2], p1[3], p1[4]), t7 = ATT_M3(p1[5], p1[6], p1[7]), t8 = ATT_M3(p1[8], p1[9], p1[10]), t9 = ATT_M3(p1[11], p1[12], p1[13]);
  const float u0 = ATT_M3(t0, t1, t2), u1 = ATT_M3(t3, t4, t5), u2 = ATT_M3(t6, t7, t8), u3 = ATT_M3(t9, p1[14], p1[15]);
  float pmax = fmaxf(fmaxf(u0, u1), fmaxf(u2, u3));
#undef ATT_M3
  { auto rr = __builtin_amdgcn_permlane32_swap(__float_as_uint(pmax), __float_as_uint(pmax), false, false); pmax = fmaxf(__uint_as_float(rr[0]), __uint_as_float(rr[1])); }
  const float thr = first ? -3.0e38f : THRL;
  if (__builtin_expect(__all(pmax <= thr), 1)) { alpha = 1.f; }
  else { const float dl = first ? pmax : fmaxf(pmax, 0.f); alpha = first ? 0.f : __builtin_amdgcn_exp2f(-dl); m_reg += dl;
#pragma unroll
    for (int r = 0; r < 16; ++r) { p0[r] -= dl; p1[r] -= dl; negm[r] -= dl; } }
#pragma unroll
  for (int r = 0; r < 16; ++r) p0[r] = __builtin_amdgcn_exp2f(p0[r]);
#pragma unroll
  for (int r = 0; r < 16; ++r) p1[r] = __builtin_amdgcn_exp2f(p1[r]);
  { float q0 = p0[0] + p1[0], q1 = p0[1] + p1[1], q2 = p0[2] + p1[2], q3 = p0[3] + p1[3];
#pragma unroll
    for (int r = 4; r < 16; r += 4) { q0 += p0[r] + p1[r]; q1 += p0[r + 1] + p1[r + 1]; q2 += p0[r + 2] + p1[r + 2]; q3 += p0[r + 3] + p1[r + 3]; }
    float ps = (q0 + q1) + (q2 + q3);
    auto rr = __builtin_amdgcn_permlane32_swap(__float_as_uint(ps), __float_as_uint(ps), false, false); ps = __uint_as_float(rr[0]) + __uint_as_float(rr[1]);
    l_reg = l_reg * alpha + ps; }
#define ATT_PK4(P, BASE, OUT) do { u32x4 w = {cvtpk(P[BASE + 0], P[BASE + 1]), cvtpk(P[BASE + 2], P[BASE + 3]), cvtpk(P[BASE + 4], P[BASE + 5]), cvtpk(P[BASE + 6], P[BASE + 7])}; \
    OUT = *reinterpret_cast<bf16x8*>(&w); } while (0)
  ATT_PK4(p0, 0, pa0); ATT_PK4(p0, 8, pa1); ATT_PK4(p1, 0, pa2); ATT_PK4(p1, 8, pa3);
#undef ATT_PK4
}
template <int OFF> __device__ __forceinline__ bf16x8 k_read(int ka) { bf16x8 r; asm volatile("ds_read_b128 %0, %1 offset:%2" : "=&v"(r) : "v"(ka), "i"(OFF) : "memory"); return r; }
template <int KB> __device__ __forceinline__ void k_load2(bf16x8* kf, int ka0, int ka1) {
  kf[0] = k_read<KB * SHM_K>(ka0); kf[1] = k_read<KB * SHM_K + 8192>(ka0); kf[2] = k_read<KB * SHM_K>(ka1); kf[3] = k_read<KB * SHM_K + 8192>(ka1);
}
__device__ __forceinline__ void qk_mma2(f32x16& p0, f32x16& p1, const bf16x8* kf, bf16x8 q0, bf16x8 q1) {
  p0 = __builtin_amdgcn_mfma_f32_32x32x16_bf16(kf[0], q0, p0, 0, 0, 0); p1 = __builtin_amdgcn_mfma_f32_32x32x16_bf16(kf[1], q0, p1, 0, 0, 0);
  p0 = __builtin_amdgcn_mfma_f32_32x32x16_bf16(kf[2], q1, p0, 0, 0, 0); p1 = __builtin_amdgcn_mfma_f32_32x32x16_bf16(kf[3], q1, p1, 0, 0, 0);
}
__device__ __forceinline__ int v_st(int k, int c) { return ((k >> 3) * 4 + (c >> 5)) * 512 + ((k & 7) * 32 + (c & 31)) * 2; }
__device__ __forceinline__ int v_rd_base(int lane) { return ((lane & 3) << 3) | (((lane >> 2) & 3) << 6) | (((lane >> 4) & 1) << 5) | (((lane >> 5) & 1) << 8); }
constexpr int v_rd_off(int d0, int ks, int half) { return d0 * 512 + ks * 4096 + half * 2048; }
template <int OFF> __device__ __forceinline__ s16x4 tr_read(int vb) { s16x4 r; asm volatile("ds_read_b64_tr_b16 %0, %1 offset:%2" : "=&v"(r) : "v"(vb), "i"(OFF) : "memory"); return r; }
struct VF { s16x4 l[4], h[4]; };
template <int KS> __device__ __forceinline__ void vf_load(VF& f, int vb) {
  f.l[0] = tr_read<v_rd_off(0, KS, 0)>(vb); f.h[0] = tr_read<v_rd_off(0, KS, 1)>(vb); f.l[1] = tr_read<v_rd_off(1, KS, 0)>(vb); f.h[1] = tr_read<v_rd_off(1, KS, 1)>(vb);
  f.l[2] = tr_read<v_rd_off(2, KS, 0)>(vb); f.h[2] = tr_read<v_rd_off(2, KS, 1)>(vb); f.l[3] = tr_read<v_rd_off(3, KS, 0)>(vb); f.h[3] = tr_read<v_rd_off(3, KS, 1)>(vb);
}
__device__ __forceinline__ void pv_step(f32x16* o, bf16x8 pa, const VF& f) {
#define ATT_PK(L, H) (bf16x8){L[0], L[1], L[2], L[3], H[0], H[1], H[2], H[3]}
  o[0] = __builtin_amdgcn_mfma_f32_32x32x16_bf16(pa, ATT_PK(f.l[0], f.h[0]), o[0], 0, 0, 0);
  o[1] = __builtin_amdgcn_mfma_f32_32x32x16_bf16(pa, ATT_PK(f.l[1], f.h[1]), o[1], 0, 0, 0);
  o[2] = __builtin_amdgcn_mfma_f32_32x32x16_bf16(pa, ATT_PK(f.l[2], f.h[2]), o[2], 0, 0, 0);
  o[3] = __builtin_amdgcn_mfma_f32_32x32x16_bf16(pa, ATT_PK(f.l[3], f.h[3]), o[3], 0, 0, 0);
#undef ATT_PK
}
#define ATT_LWAIT(n) do { asm volatile("s_waitcnt lgkmcnt(" #n ")" ::: "memory"); ATT_SBAR(); } while (0)
template <int MP> __device__ __forceinline__ void att_give(const f32x16* o, float* Xw, int r32, int hi) {
  constexpr int RG = MP ? 0 : 8;
#pragma unroll
  for (int rr = 0; rr < 8; ++rr)
#pragma unroll
    for (int d0 = 0; d0 < 4; ++d0) Xw[(crow(RG + rr, hi) & 15) * 128 + d0 * 32 + r32] = o[d0][RG + rr];
}
template <int MP> __device__ __forceinline__ void att_fin(const f32x16* o, const float* Xr, float lam, const float (&gq)[4], bf16_t* OCw, int r32, int hi, int lane) {
  constexpr int RK = MP ? 8 : 0;
  unsigned pk[8][4];
#pragma unroll
  for (int rr = 0; rr < 8; ++rr) { const int lr = crow(RK + rr, hi) & 15;
    float df[4], ssq = 0.f;
#pragma unroll
    for (int d0 = 0; d0 < 4; ++d0) { const float x = Xr[lr * 128 + d0 * 32 + r32]; df[d0] = MP ? x - lam * o[d0][RK + rr] : o[d0][RK + rr] - lam * x; ssq += df[d0] * df[d0]; }
    ssq = xadd<1>(ssq); ssq = xadd<2>(ssq); ssq = xadd<4>(ssq); ssq = xadd<8>(ssq); ssq = xadd<16>(ssq);
    const float rn = rsqrtf(ssq * (1.f / 128.f) + cfg::EPS);
#pragma unroll
    for (int d0 = 0; d0 < 4; ++d0) pk[rr][d0] = cvtpk(df[d0] * rn * gq[d0], 0.f); }
  char* stg = (char*)Xr;
#pragma unroll
  for (int rr = 0; rr < 8; ++rr) { const int lr = crow(RK + rr, hi) & 15;
#pragma unroll
    for (int d0 = 0; d0 < 4; ++d0) *(unsigned short*)(stg + lr * 272 + (d0 * 32 + r32) * 2) = (unsigned short)pk[rr][d0]; }
#pragma unroll
  for (int i = 0; i < 4; ++i) { const int c = lane + 64 * i, row = c >> 4, cc = c & 15;
    const u32x4 v = *(const u32x4*)(stg + row * 272 + cc * 16); *(u32x4*)(OCw + (size_t)row * 1024 + cc * 8) = v; }
}
__device__ __forceinline__ void attn_unit(int b, int h, int qb, const bf16_t* __restrict__ Qg, const bf16_t* __restrict__ Kg, const bf16_t* __restrict__ Vg, bf16_t* __restrict__ OC,
                                          const float* __restrict__ lamp, const float* __restrict__ dgv, int layer, char* lds) {
  int tid_o = threadIdx.x; asm volatile("" : "+v"(tid_o));
  const int tid = tid_o, wid = __builtin_amdgcn_readfirstlane(tid >> 6), lane = tid & 63, r32 = lane & 31, hi = lane >> 5, mp = wid >> 2, wl = wid & 3, mofs = mp * 64;
  char* V_lds = lds; char* K_lds = lds + 2 * SHM_V;
  float* ws = (float*)(lds + SHM_X) + wid * 64; float* al_l = ws + 32;
  float m_reg = 0.f, l_reg = 0.f; f32x16 o[4] = {}, negm = {}; bf16x8 qr[4];
  const int q0 = qb * 128 + wl * QBLK;
  const bf16_t* Qw = Qg + (size_t)(b * cfg::S + q0 + r32) * LD + h * 128 + mofs + hi * 8;
#pragma unroll
  for (int d0 = 0; d0 < 4; ++d0) qr[d0] = *reinterpret_cast<const bf16x8*>(Qw + d0 * 16);
  const bf16_t* Kh = Kg + (size_t)b * cfg::S * LD + h * 128; const bf16_t* Vh = Vg + (size_t)b * cfg::S * LD + h * 128;
  const int vb0 = (int)(uintptr_t)V_lds + v_rd_base(lane);
  const int ka0 = (int)(uintptr_t)K_lds + ATT_KSWZ(r32, (mofs + hi * 8) * 2);
  const int gt = tid & 255, gr = gt >> 4, gc = (gt & 15) * 8;
  const bf16_t* gsrc = (mp ? Kh : Vh) + (size_t)gr * LD + gc;
  char* gdst = mp ? K_lds + ATT_KSWZ(gr, gc * 2) : V_lds + v_st(gr, gc);
  const int tofs = mp ? 2 : 0;
  bf16x8 st_[2][4];
#define ATT_GLOAD(i, t) do { const int t_ = (t) < NT ? (t) : NT - 1;     \
    _Pragma("unroll") for (int q_ = 0; q_ < 4; ++q_) st_[i][q_] = *reinterpret_cast<const bf16x8*>(gsrc + (size_t)(t_ * 64 + 16 * q_) * LD); } while (0)
#define ATT_GWRITE(i, t) do { asm volatile("s_waitcnt vmcnt(4)" ::: "memory"); if ((t) < NT) { \
    _Pragma("unroll") for (int q_ = 0; q_ < 4; ++q_) *(bf16x8*)(gdst + (i) * 16384 + q_ * 4096) = st_[i][q_]; } } while (0)
#define ATT_RESC(a) do { if (__any((a) < 1.f)) { if (hi == 0) al_l[r32] = (a); asm volatile("s_waitcnt lgkmcnt(0)" ::: "memory"); \
    _Pragma("unroll") for (int r = 0; r < 16; ++r) { const float a_ = al_l[crow(r, hi)]; _Pragma("unroll") for (int d = 0; d < 4; ++d) o[d][r] *= a_; } } } while (0)
  f32x16 s0, s1; float al; bf16x8 pa0, pa1, pa2, pa3, kf[8]; VF f0, f1;
#define ATT_VSEG(I, p) do { ATT_GWRITE(I, (p) + tofs); ATT_GLOAD(I, (p) + tofs + 2); ATT_SBAR(); \
    softmaxP(s0, s1, m_reg, l_reg, negm, al, (p) == 0, pa0, pa1, pa2, pa3); ATT_RESC(al); } while (0)
#define ATT_OL(pa) do { } while (0)
#define ATT_QK(KB) do { k_load2<KB>(kf, ka0, ka0 ^ 32); k_load2<KB>(kf + 4, ka0 ^ 64, ka0 ^ 96); ATT_LWAIT(4); s0 = negm; s1 = negm; qk_mma2(s0, s1, kf, qr[0], qr[1]); ATT_LWAIT(0); qk_mma2(s0, s1, kf + 4, qr[2], qr[3]); ATT_SBAR(); } while (0)
#define ATT_MSEG(VB, KB, QK) do { vf_load<0>(f0, vb0 + (VB) * SHM_V); vf_load<1>(f1, vb0 + (VB) * SHM_V); ATT_SBAR(); \
    ATT_LWAIT(8); pv_step(o, pa0, f0); ATT_OL(pa0); vf_load<2>(f0, vb0 + (VB) * SHM_V); \
    ATT_LWAIT(8); pv_step(o, pa1, f1); ATT_OL(pa1); vf_load<3>(f1, vb0 + (VB) * SHM_V); \
    if constexpr (QK) { k_load2<KB>(kf, ka0, ka0 ^ 32); ATT_LWAIT(12); } else ATT_LWAIT(8); \
    pv_step(o, pa2, f0); ATT_OL(pa2); \
    if constexpr (QK) ATT_LWAIT(4); else ATT_LWAIT(0); \
    pv_step(o, pa3, f1); ATT_OL(pa3); \
    if constexpr (QK) { k_load2<KB>(kf + 4, ka0 ^ 64, ka0 ^ 96); ATT_LWAIT(4); s0 = negm; s1 = negm; qk_mma2(s0, s1, kf, qr[0], qr[1]); ATT_LWAIT(0); qk_mma2(s0, s1, kf + 4, qr[2], qr[3]); } ATT_SBAR(); } while (0)
  { const int kr = tid >> 4, kc = (tid & 15) * 8;
    const bf16x8 k0 = *reinterpret_cast<const bf16x8*>(&Kh[(size_t)kr * LD + kc]), k1 = *reinterpret_cast<const bf16x8*>(&Kh[(size_t)(32 + kr) * LD + kc]);
    const bf16x8 k2 = *reinterpret_cast<const bf16x8*>(&Kh[(size_t)(64 + kr) * LD + kc]), k3 = *reinterpret_cast<const bf16x8*>(&Kh[(size_t)(96 + kr) * LD + kc]);
    ATT_GLOAD(0, tofs); ATT_GLOAD(1, tofs + 1);
    asm volatile("s_waitcnt vmcnt(8)" ::: "memory");
    *(bf16x8*)(K_lds + ATT_KSWZ(kr, kc * 2)) = k0; *(bf16x8*)(K_lds + ATT_KSWZ(32 + kr, kc * 2)) = k1;
    *(bf16x8*)(K_lds + SHM_K + ATT_KSWZ(kr, kc * 2)) = k2; *(bf16x8*)(K_lds + SHM_K + ATT_KSWZ(32 + kr, kc * 2)) = k3; }
  __syncthreads();
#define ATT_BAR_M() do { if (mp) __syncthreads(); } while (0)
#define ATT_BAR_V() do { if (!mp) __syncthreads(); } while (0)
  ATT_QK(0); ATT_BAR_M();
  for (int p = 0; p + 2 < NT; p += 2) {
    ATT_VSEG(0, p);           ATT_BAR_V();
    ATT_MSEG(0, 1, true);     ATT_BAR_M();
    ATT_VSEG(1, p + 1);       ATT_BAR_V();
    ATT_MSEG(1, 0, true);     ATT_BAR_M();
  }
  ATT_VSEG(0, NT - 2);   ATT_BAR_V();
  ATT_MSEG(0, 1, true);   ATT_BAR_M();
  ATT_VSEG(1, NT - 1);   ATT_BAR_V();
  ATT_MSEG(1, 0, false);
#undef ATT_BAR_M
#undef ATT_BAR_V
  const float lp0 = lamp[lane], lp1 = lamp[64 + lane], lp2 = lamp[128 + lane], lp3 = lamp[192 + lane];
  float gq[4];
#pragma unroll
  for (int d0 = 0; d0 < 4; ++d0) gq[d0] = dgv[d0 * 32 + r32];
  float* li_l = ws; if (hi == 0) li_l[r32] = l_reg; asm volatile("s_waitcnt lgkmcnt(0)" ::: "memory");
#pragma unroll
  for (int r = 0; r < 16; ++r) { const float rl = __builtin_amdgcn_rcpf(li_l[crow(r, hi)]);
#pragma unroll
    for (int d0 = 0; d0 < 4; ++d0) o[d0][r] *= rl; }
  __syncthreads();
  float* X = (float*)lds;
  const float* Xr = X + wid * 2048; float* Xw = X + (wid ^ 4) * 2048;
  int layer_o = __builtin_amdgcn_readfirstlane(layer); asm volatile("" : "+s"(layer_o)); const float lam_init = layer_o == 0 ? 0.2f : 0.35550906759f;
  if (mp == 0) att_give<0>(o, Xw, r32, hi); else att_give<1>(o, Xw, r32, hi);
  float lam; { float s1 = lp0 * lp1, s2 = lp2 * lp3;
    s1 = xadd<1>(s1); s2 = xadd<1>(s2); s1 = xadd<2>(s1); s2 = xadd<2>(s2); s1 = xadd<4>(s1); s2 = xadd<4>(s2); s1 = xadd<8>(s1); s2 = xadd<8>(s2); s1 = xadd<16>(s1); s2 = xadd<16>(s2); s1 = xadd<32>(s1); s2 = xadd<32>(s2);
    lam = __expf(s1) - __expf(s2) + lam_init; }
#pragma unroll
  for (int d0 = 0; d0 < 4; ++d0) gq[d0] *= (1.f - lam_init);
  __syncthreads();
  bf16_t* OCw = OC + (size_t)(b * cfg::S + q0 + 16 * mp) * 1024 + h * 128;
  if (mp == 0) att_fin<0>(o, Xr, lam, gq, OCw, r32, hi, lane); else att_fin<1>(o, Xr, lam, gq, OCw, r32, hi, lane);
  __syncthreads();
#undef ATT_GLOAD
#undef ATT_GWRITE
#undef ATT_VSEG
#undef ATT_MSEG
#undef ATT_RESC
#undef ATT_OL
#undef ATT_QK
}
#undef ATT_KSWZ
#undef ATT_SBAR
}
namespace gla {
using att::bf16x8; using att::s16x4; using att::f32x16; using att::u32x4; using att::crow; using att::cvtpk; using att::tr_read;
typedef float f32x4 __attribute__((ext_vector_type(4)));
typedef unsigned u32x2 __attribute__((ext_vector_type(2)));
#define GLAS __attribute__((address_space(3)))
constexpr int KT_STRIDE = 144;
constexpr int A_KT = 0, A_V = 36864, A_BEND = A_V + 32768;
constexpr int B_QT = 0, B_KT = 32768, B_V = 65536, B_SC = 98304;
__device__ __forceinline__ int v_st64(int k, int c) { const int kk = (k & ~0xC) | ((k & 4) << 1) | ((k & 8) >> 1); return ((kk >> 3) * 2 + (c >> 5)) * 512 + ((kk & 7) * 32 + (c & 31)) * 2; }
constexpr int v_off64(int d0, int ks, int half) { return d0 * 512 + ks * 2048 + half * 1024; }
__device__ __forceinline__ float bf2f_(unsigned short v) { return __uint_as_float((unsigned)v << 16); }
__device__ __forceinline__ void load_v_tile(const bf16_t* __restrict__ src, GLAS unsigned char* dst, int lane) {
    u32x4 tv[8];
#pragma unroll
    for (int i = 0; i < 8; ++i) { const int row = (lane >> 3) + 8 * i, ch = lane & 7; tv[i] = *(const u32x4*)(src + (size_t)row * 256 + ch * 8); }
#pragma unroll
    for (int i = 0; i < 8; ++i) { const int row = (lane >> 3) + 8 * i, ch = lane & 7; *(GLAS u32x4*)(dst + v_st64(row, ch * 8)) = tv[i]; }
}
#define GLA_PK(L, H) (bf16x8){L[0], L[1], L[2], L[3], H[0], H[1], H[2], H[3]}
#define GLA_MM4(o0, o1, vb, AF) do { \
    const s16x4 l00 = tr_read<v_off64(0, 0, 0)>(vb), h00 = tr_read<v_off64(0, 0, 1)>(vb), l01 = tr_read<v_off64(0, 1, 0)>(vb), h01 = tr_read<v_off64(0, 1, 1)>(vb); \
    const s16x4 l02 = tr_read<v_off64(0, 2, 0)>(vb), h02 = tr_read<v_off64(0, 2, 1)>(vb), l03 = tr_read<v_off64(0, 3, 0)>(vb), h03 = tr_read<v_off64(0, 3, 1)>(vb); \
    const s16x4 l10 = tr_read<v_off64(1, 0, 0)>(vb), h10 = tr_read<v_off64(1, 0, 1)>(vb), l11 = tr_read<v_off64(1, 1, 0)>(vb), h11 = tr_read<v_off64(1, 1, 1)>(vb); \
    const s16x4 l12 = tr_read<v_off64(1, 2, 0)>(vb), h12 = tr_read<v_off64(1, 2, 1)>(vb), l13 = tr_read<v_off64(1, 3, 0)>(vb), h13 = tr_read<v_off64(1, 3, 1)>(vb); \
    asm volatile("s_waitcnt lgkmcnt(0)" ::: "memory"); __builtin_amdgcn_sched_barrier(0); \
    o0 = __builtin_amdgcn_mfma_f32_32x32x16_bf16(AF(0), GLA_PK(l00, h00), o0, 0, 0, 0); o1 = __builtin_amdgcn_mfma_f32_32x32x16_bf16(AF(0), GLA_PK(l10, h10), o1, 0, 0, 0); \
    o0 = __builtin_amdgcn_mfma_f32_32x32x16_bf16(AF(1), GLA_PK(l01, h01), o0, 0, 0, 0); o1 = __builtin_amdgcn_mfma_f32_32x32x16_bf16(AF(1), GLA_PK(l11, h11), o1, 0, 0, 0); \
    o0 = __builtin_amdgcn_mfma_f32_32x32x16_bf16(AF(2), GLA_PK(l02, h02), o0, 0, 0, 0); o1 = __builtin_amdgcn_mfma_f32_32x32x16_bf16(AF(2), GLA_PK(l12, h12), o1, 0, 0, 0); \
    o0 = __builtin_amdgcn_mfma_f32_32x32x16_bf16(AF(3), GLA_PK(l03, h03), o0, 0, 0, 0); o1 = __builtin_amdgcn_mfma_f32_32x32x16_bf16(AF(3), GLA_PK(l13, h13), o1, 0, 0, 0); } while (0)
__device__ __forceinline__ bf16x8 afrag_tr(const GLAS unsigned char* row, int ks, int hi) { return *(const GLAS bf16x8*)(row + (16 * ks + 8 * hi) * 2); }

__device__ __forceinline__ void gla_a_item(int b, int h, int g, unsigned char* ws, GLAS unsigned char* lds) {
    int tid_o = threadIdx.x; asm volatile("" : "+v"(tid_o));
    const int tid = tid_o, wave = __builtin_amdgcn_readfirstlane(tid >> 6), lane = tid & 63, r32 = lane & 31, hi = lane >> 5;
    const float* GL = (const float*)(ws + cfg::WSB_GL + (size_t)b * cfg::DLT_GL); const bf16_t* GQK = (const bf16_t*)(ws + cfg::WSB_GQK + (size_t)b * cfg::DLT_GQK); const bf16_t* GV = (const bf16_t*)(ws + cfg::WSB_GV + (size_t)b * cfg::DLT_GV);
    float* KVC = (float*)(ws + cfg::WSB_OF + (size_t)b * cfg::DLT_OF); float* DEC = (float*)(ws + cfg::WS_DEC);
    const size_t tok0 = (size_t)b * 2048 + g * 256;
    GLAS float* bend_s = (GLAS float*)(lds + A_BEND);
    if (wave < 4) {
        const int c = wave, dir = lane >> 5, d = lane & 31;
        const float* gl = GL + (tok0 + c * 64) * 256 + dir * 128 + h * 32 + d; const bf16_t* kp = GQK + (tok0 + c * 64) * 256 + 128 + h * 32 + d;
        GLAS unsigned char* row = lds + A_KT + ((c * 2 + dir) * 32 + d) * KT_STRIDE; float bsum = 0.f; float gA[8], gB[8]; unsigned short kA[8], kB[8];
#define GLA_LOAD(G, K, blk) do { const int t0_ = dir ? 56 - 8 * (blk) : 8 * (blk); _Pragma("unroll") for (int i = 0; i < 8; ++i) { G[i] = gl[(size_t)(t0_ + i) * 256]; K[i] = kp[(size_t)(t0_ + i) * 256]; } } while (0)
#define GLA_PROC(G, K, blk) do { const int t0_ = dir ? 56 - 8 * (blk) : 8 * (blk); float kt[8]; \
            if (dir == 0) { _Pragma("unroll") for (int i = 0; i < 8; ++i) { bsum += G[i]; kt[i] = bf2f_(K[i]) * __expf(-bsum); } } \
            else { _Pragma("unroll") for (int i = 7; i >= 0; --i) { bsum += G[i]; kt[i] = bf2f_(K[i]) * __expf(-bsum); } } \
            u32x4 w; w.x = cvtpk(kt[0], kt[1]); w.y = cvtpk(kt[2], kt[3]); w.z = cvtpk(kt[4], kt[5]); w.w = cvtpk(kt[6], kt[7]); *(GLAS u32x4*)(row + t0_ * 2) = w; } while (0)
        GLA_LOAD(gA, kA, 0);
#pragma unroll
        for (int bp = 0; bp < 4; ++bp) { GLA_LOAD(gB, kB, 2 * bp + 1); GLA_PROC(gA, kA, 2 * bp); if (bp < 3) GLA_LOAD(gA, kA, 2 * bp + 2); GLA_PROC(gB, kB, 2 * bp + 1); }
#undef GLA_LOAD
#undef GLA_PROC
        bend_s[(c * 2 + dir) * 32 + d] = bsum;
        DEC[((size_t)((b * 4 + h) * 32 + g * 4 + c) * 2 + dir) * 32 + d] = __expf(bsum);
    } else { const int c = wave - 4; load_v_tile(GV + (tok0 + c * 64) * 256 + h * 64, lds + A_V + c * 8192, lane); }
    __syncthreads();
    {
        const int c = wave >> 1, dir = wave & 1; f32x16 o0 = {}, o1 = {};
        const int vb = (int)(unsigned)(uintptr_t)(lds + A_V + c * 8192) + att::v_rd_base(lane);
        const GLAS unsigned char* arow = lds + A_KT + ((c * 2 + dir) * 32 + r32) * KT_STRIDE;
#define GLA_AF(ks) afrag_tr(arow, ks, hi)
        GLA_MM4(o0, o1, vb, GLA_AF);
#undef GLA_AF
        float* dst = KVC + ((size_t)((b * 4 + h) * 32 + g * 4 + c) * 2 + dir) * 2048 + r32;
#pragma unroll
        for (int r = 0; r < 16; ++r) { const int d = crow(r, hi); const float sc = __expf(bend_s[(c * 2 + dir) * 32 + d]); dst[d * 64] = o0[r] * sc; dst[d * 64 + 32] = o1[r] * sc; }
    }
    __syncthreads();
}

__device__ __forceinline__ void gla_b_item(int b, int h, int g, unsigned char* ws, const float* __restrict__ gng, bf16_t* __restrict__ OC, GLAS unsigned char* lds) {
    int tid_o = threadIdx.x; asm volatile("" : "+v"(tid_o));
    const int tid = tid_o, wave = __builtin_amdgcn_readfirstlane(tid >> 6), lane = tid & 63, r32 = lane & 31, hi = lane >> 5;
    const float* GL = (const float*)(ws + cfg::WSB_GL + (size_t)b * cfg::DLT_GL); const bf16_t* GQK = (const bf16_t*)(ws + cfg::WSB_GQK + (size_t)b * cfg::DLT_GQK); const bf16_t* GV = (const bf16_t*)(ws + cfg::WSB_GV + (size_t)b * cfg::DLT_GV); const bf16_t* GR = (const bf16_t*)(ws + cfg::WSB_GR + (size_t)b * cfg::DLT_GR);
    const float* KVC = (const float*)(ws + cfg::WSB_OF + (size_t)b * cfg::DLT_OF) + (size_t)((b * 4 + h) * 32) * 2 * 2048; const float* DEC = (const float*)(ws + cfg::WS_DEC) + (size_t)((b * 4 + h) * 32) * 2 * 32;
    const size_t tok0 = (size_t)b * 2048 + g * 256;
    if (wave < 4) {
        const int c = wave, dir = lane >> 5, d = lane & 31;
        const float* gl = GL + (tok0 + c * 64) * 256 + dir * 128 + h * 32 + d; const bf16_t* qp = GQK + (tok0 + c * 64) * 256 + h * 32 + d;
        GLAS unsigned short* qt = (GLAS unsigned short*)(lds + B_QT + c * 8192) + dir * 32 + d;
        GLAS unsigned short* kt = (GLAS unsigned short*)(lds + B_KT + c * 8192 + dir * 4096) + d;
        float bsum = 0.f; float gA[8], gB[8]; unsigned short qA[8], kA[8], qB[8], kB[8];
#define GLB_LOAD(G, Q, K, blk) do { const int t0_ = dir ? 56 - 8 * (blk) : 8 * (blk); _Pragma("unroll") for (int i = 0; i < 8; ++i) { G[i] = gl[(size_t)(t0_ + i) * 256]; Q[i] = qp[(size_t)(t0_ + i) * 256]; K[i] = qp[(size_t)(t0_ + i) * 256 + 128]; } } while (0)
#define GLB_PROC(G, Q, K, blk) do { const int t0_ = dir ? 56 - 8 * (blk) : 8 * (blk); _Pragma("unroll") for (int ii = 0; ii < 8; ++ii) { \
            const float gi = dir ? G[7 - ii] : G[ii], qi = bf2f_(dir ? Q[7 - ii] : Q[ii]), ki = bf2f_(dir ? K[7 - ii] : K[ii]); const int tt = t0_ + (dir ? 7 - ii : ii); \
            bsum += gi; const float e = __expf(bsum), ei = __expf(-bsum); \
            qt[tt * 64] = (unsigned short)(cvtpk(qi * e, 0.f) & 0xffffu); kt[tt * 32] = (unsigned short)(cvtpk(ki * ei, 0.f) & 0xffffu); } } while (0)
        GLB_LOAD(gA, qA, kA, 0);
#pragma unroll
        for (int bp = 0; bp < 4; ++bp) { GLB_LOAD(gB, qB, kB, 2 * bp + 1); GLB_PROC(gA, qA, kA, 2 * bp); if (bp < 3) GLB_LOAD(gA, qA, kA, 2 * bp + 2); GLB_PROC(gB, qB, kB, 2 * bp + 1); }
#undef GLB_LOAD
#undef GLB_PROC
    } else {
        const int c = wave - 4;
        const int t2 = tid - 256, d = t2 >> 3, v8 = (t2 & 7) * 8;
        const float* kvp = KVC + d * 64 + v8; const float* dcp = DEC + d;
        const int F = 4 * g + 3;
        u32x4 tv[8];
#pragma unroll
        for (int i = 0; i < 8; ++i) { const int row = (lane >> 3) + 8 * i, ch = lane & 7; tv[i] = *(const u32x4*)(GV + (tok0 + c * 64) * 256 + h * 64 + (size_t)row * 256 + ch * 8); }
        f32x4 Sf0 = {0.f, 0.f, 0.f, 0.f}, Sf1 = Sf0, Sb0 = Sf0, Sb1 = Sf0;
        f32x4 a0A[8], a1A[8], a0B[8], a1B[8]; float dA[8], dB[8];
#define GLS_IDX(s_) (((s_) < F) ? (s_) * 2 : (31 - ((s_) - F)) * 2 + 1)
#define GLS_ISSUE(A0, A1, DD, s0) do { _Pragma("unroll") for (int j = 0; j < 8; ++j) { const int sc_ = (s0) + j < 34 ? (s0) + j : 33; const int ix_ = GLS_IDX(sc_); \
            A0[j] = *(const f32x4*)(kvp + (size_t)ix_ * 2048); A1[j] = *(const f32x4*)(kvp + (size_t)ix_ * 2048 + 4); DD[j] = dcp[ix_ * 32]; } } while (0)
#define GLS_WRITE(S0, S1, c4_, dofs_) do { u32x4 w; w.x = cvtpk(S0[0], S0[1]); w.y = cvtpk(S0[2], S0[3]); w.z = cvtpk(S1[0], S1[1]); w.w = cvtpk(S1[2], S1[3]); \
            *(GLAS u32x4*)(lds + B_SC + (c4_) * 8192 + v_st64((dofs_) + d, v8)) = w; } while (0)
#define GLS_PROC(A0, A1, DD, s0) do { _Pragma("unroll") for (int j = 0; j < 8; ++j) { const int s_ = (s0) + j; if (s_ < 34) { \
            if (s_ < F) { const int n_ = s_; if (n_ >= 4 * g) GLS_WRITE(Sf0, Sf1, n_ - 4 * g, 0); Sf0 = DD[j] * Sf0 + A0[j]; Sf1 = DD[j] * Sf1 + A1[j]; } \
            else { const int n_ = 31 - (s_ - F); if (n_ <= 4 * g + 3) GLS_WRITE(Sb0, Sb1, n_ - 4 * g, 32); Sb0 = DD[j] * Sb0 + A0[j]; Sb1 = DD[j] * Sb1 + A1[j]; } } } } while (0)
        GLS_ISSUE(a0A, a1A, dA, 0); GLS_ISSUE(a0B, a1B, dB, 8);
#pragma unroll
        for (int i = 0; i < 8; ++i) { const int row = (lane >> 3) + 8 * i, ch = lane & 7; *(GLAS u32x4*)(lds + B_V + c * 8192 + v_st64(row, ch * 8)) = tv[i]; }
        GLS_PROC(a0A, a1A, dA, 0);  GLS_ISSUE(a0A, a1A, dA, 16);
        GLS_PROC(a0B, a1B, dB, 8);  GLS_ISSUE(a0B, a1B, dB, 24);
        GLS_PROC(a0A, a1A, dA, 16); GLS_ISSUE(a0A, a1A, dA, 32);
        GLS_PROC(a0B, a1B, dB, 24);
        GLS_PROC(a0A, a1A, dA, 32);
        GLS_WRITE(Sf0, Sf1, 3, 0); GLS_WRITE(Sb0, Sb1, 0, 32);
#undef GLS_IDX
#undef GLS_ISSUE
#undef GLS_WRITE
#undef GLS_PROC
    }
    __syncthreads();
    {
        const int c = wave >> 1, th = wave & 1, t = 32 * th + r32;
        const GLAS unsigned char* qrow = lds + B_QT + c * 8192 + t * 128;
        f32x16 pf0 = {}, pf1 = {}, pb0 = {}, pb1 = {};
#pragma unroll
        for (int ks = 0; ks < 2; ++ks) {
            const bf16x8 qf = *(const GLAS bf16x8*)(qrow + (16 * ks + 8 * hi) * 2), qb = *(const GLAS bf16x8*)(qrow + (32 + 16 * ks + 8 * hi) * 2);
            const GLAS unsigned char* kf = lds + B_KT + c * 8192 + r32 * 64 + (16 * ks + 8 * hi) * 2; const GLAS unsigned char* kb = kf + 4096;
            pf0 = __builtin_amdgcn_mfma_f32_32x32x16_bf16(*(const GLAS bf16x8*)kf, qf, pf0, 0, 0, 0); pf1 = __builtin_amdgcn_mfma_f32_32x32x16_bf16(*(const GLAS bf16x8*)(kf + 2048), qf, pf1, 0, 0, 0);
            pb0 = __builtin_amdgcn_mfma_f32_32x32x16_bf16(*(const GLAS bf16x8*)kb, qb, pb0, 0, 0, 0); pb1 = __builtin_amdgcn_mfma_f32_32x32x16_bf16(*(const GLAS bf16x8*)(kb + 2048), qb, pb1, 0, 0, 0);
        }
#pragma unroll
        for (int r = 0; r < 16; ++r) { const int j0 = crow(r, hi), j1 = 32 + j0;
            pf0[r] = (j0 <= t ? pf0[r] : 0.f) + (j0 >= t ? pb0[r] : 0.f); pf1[r] = (j1 <= t ? pf1[r] : 0.f) + (j1 >= t ? pb1[r] : 0.f); }
        bf16x8 pa0, pa1, pa2, pa3;
#define GLA_PK4(P, BASE, OUT) do { unsigned a0 = cvtpk(P[BASE + 0], P[BASE + 1]), a1 = cvtpk(P[BASE + 2], P[BASE + 3]); unsigned b0 = cvtpk(P[BASE + 4], P[BASE + 5]), b1 = cvtpk(P[BASE + 6], P[BASE + 7]); \
    auto r0 = __builtin_amdgcn_permlane32_swap(a0, b0, false, false); auto r1 = __builtin_amdgcn_permlane32_swap(a1, b1, false, false); \
    u32x4 w = {r0[0], r1[0], r0[1], r1[1]}; OUT = *reinterpret_cast<bf16x8*>(&w); } while (0)
        GLA_PK4(pf0, 0, pa0); GLA_PK4(pf0, 8, pa1); GLA_PK4(pf1, 0, pa2); GLA_PK4(pf1, 8, pa3);
#undef GLA_PK4
        f32x16 o0 = {}, o1 = {};
        { const int vb = (int)(unsigned)(uintptr_t)(lds + B_V + c * 8192) + att::v_rd_base(lane);
#define GLA_AF(ks) ((ks) == 0 ? pa0 : (ks) == 1 ? pa1 : (ks) == 2 ? pa2 : pa3)
          GLA_MM4(o0, o1, vb, GLA_AF);
#undef GLA_AF
        }
        { const int vb = (int)(unsigned)(uintptr_t)(lds + B_SC + c * 8192) + att::v_rd_base(lane);
#define GLA_AF(ks) afrag_tr(qrow, ks, hi)
          GLA_MM4(o0, o1, vb, GLA_AF);
#undef GLA_AF
        }
        const float g0 = gng[r32], g1 = gng[32 + r32];
        const bf16_t* grb = GR + (tok0 + c * 64 + 32 * th) * 256 + h * 64 + r32; unsigned short gq0[16], gq1[16];
#pragma unroll
        for (int r = 0; r < 16; ++r) { gq0[r] = grb[(size_t)crow(r, hi) * 256]; gq1[r] = grb[(size_t)crow(r, hi) * 256 + 32]; }
#pragma unroll
        for (int r = 0; r < 16; ++r) {
            float ssq = o0[r] * o0[r] + o1[r] * o1[r];
            ssq = xadd<1>(ssq); ssq = xadd<2>(ssq); ssq = xadd<4>(ssq); ssq = xadd<8>(ssq); ssq = xadd<16>(ssq);
            const float rn = rsqrtf(ssq * (1.f / 64.f) + cfg::EPS);
            const size_t tok = tok0 + c * 64 + 32 * th + crow(r, hi);
            bf16_t* dst = OC + tok * 1024 + 768 + h * 64 + r32;
            dst[0] = (bf16_t)(cvtpk(o0[r] * rn * g0 * bf2f_(gq0[r]), 0.f) & 0xffffu); dst[32] = (bf16_t)(cvtpk(o1[r] * rn * g1 * bf2f_(gq1[r]), 0.f) & 0xffffu);
        }
    }
    __syncthreads();
}
#undef GLA_MM4
#undef GLA_PK
#undef GLAS
}
namespace fft {
using att::bf16x8; using att::s16x4; using att::f32x16; using att::u32x4; using att::crow; using att::cvtpk; using att::tr_read;
#define FLAS __attribute__((address_space(3)))
__device__ __forceinline__ int img_off(int k, int c) { const int kk = (k & ~0xC) | ((k & 4) << 1) | ((k & 8) >> 1); return ((kk >> 3) * 8 + (c >> 5)) * 512 + ((kk & 7) * 32 + (c & 31)) * 2; }
constexpr int rd_off(int ks, int half) { return ks * 8192 + half * 4096; }
#define FFT_PK(L, H) (bf16x8){L[0], L[1], L[2], L[3], H[0], H[1], H[2], H[3]}
typedef float f32x2_t __attribute__((ext_vector_type(2))); typedef __bf16 bf16x2_t __attribute__((ext_vector_type(2)));
__device__ __forceinline__ unsigned pk2f(float a, float b) { f32x2_t v = {a, b}; bf16x2_t r = __builtin_convertvector(v, bf16x2_t); return __builtin_bit_cast(unsigned, r); }

__device__ __forceinline__ void stage1_load(u32x4 (&tv)[4], int b, int s2, const bf16_t* __restrict__ FX) {
    int tid = threadIdx.x; asm volatile("" : "+v"(tid));
#pragma unroll
    for (int i = 0; i < 4; ++i) { const int p = tid + 512 * i, k = p >> 5, c8 = (p & 31) * 8; tv[i] = *(const u32x4*)(FX + (size_t)(b * 2048 + 64 * (k & 31) + s2) * 512 + (k >> 5) * 256 + c8); }
}
__device__ __forceinline__ void stage1_item(int b, int s2, const u32x4 (&tv)[4], bf16_t* __restrict__ I1, FLAS unsigned char* lds) {
    int tid_o = threadIdx.x; asm volatile("" : "+v"(tid_o));
    const int tid = tid_o, wave = __builtin_amdgcn_readfirstlane(tid >> 6), lane = tid & 63, r32 = lane & 31, hi = lane >> 5;
    bf16x8 F1[2][4];
#pragma unroll
    for (int ks = 0; ks < 4; ++ks) { float cr[8], ci[8];
#pragma unroll
        for (int j = 0; j < 8; ++j) { const int k = 16 * ks + 8 * hi + j, s1 = k & 31; const float rev = (float)((r32 * s1) & 31) * (1.f / 32.f); const float c = __builtin_amdgcn_cosf(rev), sn = __builtin_amdgcn_sinf(rev);
            const bool p1 = (k >> 5) != 0; cr[j] = p1 ? -sn : c; ci[j] = p1 ? -c : -sn; }
        u32x4 wr = {pk2f(cr[0], cr[1]), pk2f(cr[2], cr[3]), pk2f(cr[4], cr[5]), pk2f(cr[6], cr[7])}, wi = {pk2f(ci[0], ci[1]), pk2f(ci[2], ci[3]), pk2f(ci[4], ci[5]), pk2f(ci[6], ci[7])};
        F1[0][ks] = *reinterpret_cast<bf16x8*>(&wr); F1[1][ks] = *reinterpret_cast<bf16x8*>(&wi); }
    {
#pragma unroll
      for (int i = 0; i < 4; ++i) { const int p = tid + 512 * i, k = p >> 5, c8 = (p & 31) * 8; *(FLAS u32x4*)(lds + img_off(k, c8)) = tv[i]; } }
    __syncthreads();
    f32x16 re = {}, im = {};
    { const int vb = (int)(unsigned)(uintptr_t)lds + att::v_rd_base(lane) + wave * 512;
      const s16x4 l0 = tr_read<rd_off(0, 0)>(vb), h0 = tr_read<rd_off(0, 1)>(vb), l1 = tr_read<rd_off(1, 0)>(vb), h1 = tr_read<rd_off(1, 1)>(vb);
      const s16x4 l2 = tr_read<rd_off(2, 0)>(vb), h2 = tr_read<rd_off(2, 1)>(vb), l3 = tr_read<rd_off(3, 0)>(vb), h3 = tr_read<rd_off(3, 1)>(vb);
      asm volatile("s_waitcnt lgkmcnt(0)" ::: "memory"); __builtin_amdgcn_sched_barrier(0);
      re = __builtin_amdgcn_mfma_f32_32x32x16_bf16(F1[0][0], FFT_PK(l0, h0), re, 0, 0, 0); im = __builtin_amdgcn_mfma_f32_32x32x16_bf16(F1[1][0], FFT_PK(l0, h0), im, 0, 0, 0);
      re = __builtin_amdgcn_mfma_f32_32x32x16_bf16(F1[0][1], FFT_PK(l1, h1), re, 0, 0, 0); im = __builtin_amdgcn_mfma_f32_32x32x16_bf16(F1[1][1], FFT_PK(l1, h1), im, 0, 0, 0);
      re = __builtin_amdgcn_mfma_f32_32x32x16_bf16(F1[0][2], FFT_PK(l2, h2), re, 0, 0, 0); im = __builtin_amdgcn_mfma_f32_32x32x16_bf16(F1[1][2], FFT_PK(l2, h2), im, 0, 0, 0);
      re = __builtin_amdgcn_mfma_f32_32x32x16_bf16(F1[0][3], FFT_PK(l3, h3), re, 0, 0, 0); im = __builtin_amdgcn_mfma_f32_32x32x16_bf16(F1[1][3], FFT_PK(l3, h3), im, 0, 0, 0); }
    bf16_t* dst = I1 + (size_t)(b * 32) * 128 * 256 + (size_t)s2 * 256 + 32 * wave + r32;
#pragma unroll
    for (int r = 0; r < 16; ++r) { const int k1 = crow(r, hi); const float rev = (float)((k1 * s2) & 2047) * (1.f / 2048.f); const float ct = __builtin_amdgcn_cosf(rev), st = __builtin_amdgcn_sinf(rev);
        const float ar = re[r] * ct + im[r] * st, ai = im[r] * ct - re[r] * st; const unsigned w = pk2f(ar, ai);
        dst[(size_t)k1 * 128 * 256] = (bf16_t)(w & 0xffffu); dst[(size_t)k1 * 128 * 256 + 64 * 256] = (bf16_t)(w >> 16); }
    __syncthreads();
}

__device__ __forceinline__ void stage2_item(int b, int k1, const bf16_t* __restrict__ I1, bf16_t* __restrict__ OC, FLAS unsigned char* lds) {
    int tid_o = threadIdx.x; asm volatile("" : "+v"(tid_o));
    const int tid = tid_o, wave = __builtin_amdgcn_readfirstlane(tid >> 6), lane = tid & 63, r32 = lane & 31, hi = lane >> 5;
    const bf16_t* src = I1 + (size_t)(b * 32 + k1) * 128 * 256;
    { u32x4 tv[8];
#pragma unroll
      for (int i = 0; i < 8; ++i) { const int p = tid + 512 * i, k = p >> 5, c8 = (p & 31) * 8; tv[i] = *(const u32x4*)(src + (size_t)k * 256 + c8); }
#pragma unroll
      for (int i = 0; i < 8; ++i) { const int p = tid + 512 * i, k = p >> 5, c8 = (p & 31) * 8; *(FLAS u32x4*)(lds + img_off(k, c8)) = tv[i]; } }
    f32x16 y0 = {}, y1 = {};
    __syncthreads();
    const int vb = (int)(unsigned)(uintptr_t)lds + att::v_rd_base(lane) + wave * 512, vb2 = vb + 32768;
    bf16x8 F2[2][8];
#pragma unroll
    for (int ks = 0; ks < 8; ++ks) { float c0[8], c1[8];
#pragma unroll
        for (int j = 0; j < 8; ++j) { const int k = 16 * ks + 8 * hi + j, s2 = k & 63; const float r0 = (float)((r32 * s2) & 63) * (1.f / 64.f), r1 = (float)(((32 + r32) * s2) & 63) * (1.f / 64.f);
            c0[j] = (k >> 6) ? __builtin_amdgcn_sinf(r0) : __builtin_amdgcn_cosf(r0); c1[j] = (k >> 6) ? __builtin_amdgcn_sinf(r1) : __builtin_amdgcn_cosf(r1); }
        u32x4 w0 = {pk2f(c0[0], c0[1]), pk2f(c0[2], c0[3]), pk2f(c0[4], c0[5]), pk2f(c0[6], c0[7])}, w1 = {pk2f(c1[0], c1[1]), pk2f(c1[2], c1[3]), pk2f(c1[4], c1[5]), pk2f(c1[6], c1[7])};
        F2[0][ks] = *reinterpret_cast<bf16x8*>(&w0); F2[1][ks] = *reinterpret_cast<bf16x8*>(&w1); }
#define FFT_STEP(ks) do { \
      const s16x4 lo_ = tr_read<rd_off((ks) & 3, 0)>((ks) < 4 ? vb : vb2), hi_ = tr_read<rd_off((ks) & 3, 1)>((ks) < 4 ? vb : vb2); asm volatile("s_waitcnt lgkmcnt(0)" ::: "memory"); __builtin_amdgcn_sched_barrier(0); \
      y0 = __builtin_amdgcn_mfma_f32_32x32x16_bf16(F2[0][ks], FFT_PK(lo_, hi_), y0, 0, 0, 0); y1 = __builtin_amdgcn_mfma_f32_32x32x16_bf16(F2[1][ks], FFT_PK(lo_, hi_), y1, 0, 0, 0); } while (0)
    FFT_STEP(0); FFT_STEP(1); FFT_STEP(2); FFT_STEP(3); FFT_STEP(4); FFT_STEP(5); FFT_STEP(6); FFT_STEP(7);
#undef FFT_STEP
    bf16_t* dst = OC + (size_t)(b * 2048 + k1) * 1024 + 512 + 32 * wave + r32;
#pragma unroll
    for (int r = 0; r < 16; ++r) { const int k2 = crow(r, hi); const unsigned w = pk2f(y0[r], y1[r]);
        dst[(size_t)(32 * k2) * 1024] = (bf16_t)(w & 0xffffu); dst[(size_t)(32 * (32 + k2)) * 1024] = (bf16_t)(w >> 16); }
    __syncthreads();
}
#undef FFT_PK
#undef FLAS
}
namespace pro {
#define PLAS __attribute__((address_space(3)))
typedef float f32x4 __attribute__((ext_vector_type(4)));
typedef unsigned u32x4 __attribute__((ext_vector_type(4)));
__device__ __forceinline__ unsigned pk2(float lo, float hi) { unsigned r; asm volatile("v_cvt_pk_bf16_f32 %0, %1, %2" : "=v"(r) : "v"(lo), "v"(hi)); return r; }
__device__ __forceinline__ float lo_f(unsigned w) { return __uint_as_float(w << 16); }
__device__ __forceinline__ float hi_f(unsigned w) { return __uint_as_float(w & 0xffff0000u); }
template <bool SUMS, int STRIDE> __device__ __forceinline__ void tile_emit(int K, bf16_t* WT, const float* gain, const float* lnb, float (&a1)[4], float (&a2)[4], const PLAS float* scr, int lane) {
    const int c = lane & 7; float gk[8], bk[8];
    const __amdgpu_buffer_rsrc_t wt_rsrc = __builtin_amdgcn_make_buffer_rsrc(WT, 0, 0x7ffffff0, 0x00020000);
#pragma unroll
    for (int q = 0; q < 8; ++q) { gk[q] = gain ? gain[8 * c + q] : 1.f; bk[q] = lnb ? lnb[8 * c + q] : 0.f; }
#pragma unroll
    for (int j = 0; j < 4; ++j) { const int n = (lane >> 3) + 8 * j; const PLAS float* s = scr + (8 * c) * STRIDE + (STRIDE == 32 ? 4 * (((n >> 2) - c) & 7) + (n & 3) : n); float v[8];
#pragma unroll
        for (int q = 0; q < 8; ++q) v[q] = s[q * STRIDE];
        u32x4 o; o.x = pk2(v[0] * gk[0], v[1] * gk[1]); o.y = pk2(v[2] * gk[2], v[3] * gk[3]); o.z = pk2(v[4] * gk[4], v[5] * gk[5]); o.w = pk2(v[6] * gk[6], v[7] * gk[7]);
        __builtin_amdgcn_raw_buffer_store_b128(o, wt_rsrc, (unsigned)(((size_t)n * K + 8 * c) * 2), 0, 16);
        if (SUMS) { float p1 = (lo_f(o.x) + hi_f(o.x)) + (lo_f(o.y) + hi_f(o.y)) + (lo_f(o.z) + hi_f(o.z)) + (lo_f(o.w) + hi_f(o.w)); float p2 = 0.f;
#pragma unroll
            for (int q = 0; q < 8; ++q) p2 += bk[q] * v[q];
            p1 = xadd<1>(p1); p2 = xadd<1>(p2); p1 = xadd<2>(p1); p2 = xadd<2>(p2); p1 = xadd<4>(p1); p2 = xadd<4>(p2);
            a1[j] += p1; a2[j] += p2; }
    }
    asm volatile("s_waitcnt lgkmcnt(0)" ::: "memory");
}
__device__ __forceinline__ void tile_dma(const float* W, int N, PLAS float* scr, int lane) {
    const float* src = W + (size_t)(lane >> 3) * N;
#pragma unroll
    for (int i = 0; i < 8; ++i) __builtin_amdgcn_global_load_lds((const unsigned*)(src + (size_t)(8 * i) * N + (((lane & 7) + i) & 7) * 4), (PLAS unsigned*)(scr + i * 256), 16, 0, 0);
}
template <bool SUMS, class Val> __device__ __forceinline__ void tile_item(const Val& val, int K, bf16_t* WT, const float* gain, const float* lnb, float (&a1)[4], float (&a2)[4], PLAS float* scr, int lane) {
#pragma unroll 2
    for (int i = 0; i < 32; ++i) { const int kk = 2 * i + (lane >> 5); scr[kk * 33 + (lane & 31)] = val(kk, lane & 31); }
    asm volatile("s_waitcnt lgkmcnt(0)" ::: "memory");
    tile_emit<SUMS, 33>(K, WT, gain, lnb, a1, a2, scr, lane);
}
struct ValPlain { static constexpr int BATCH = 32; const float* W; int N; __device__ __forceinline__ float operator()(int kk, int j) const { return W[(size_t)kk * N + j]; } };
struct ValGate { static constexpr int BATCH = 2; const float* W; const float* w2; __device__ __forceinline__ float operator()(int kk, int j) const {
    const float* wr = W + (size_t)kk * cfg::INW; float a = 0.f;
#pragma unroll
    for (int r = 0; r < 16; ++r) a += wr[r] * w2[r * 128 + j]; return a; } };

__device__ __forceinline__ void fold_item(int item, unsigned char* ws, const float* w_in, const float* fw, const float* lng, const float* lnb, PLAS unsigned char* lds, int tid) {
    const int l = item >> 5, g = (item >> 3) & 3, part = (item >> 2) & 1, kq = item & 3;
    PLAS float* M = (PLAS float*)lds;
    { const int c = tid >> 3, e0 = (tid & 7) * 8; float acc[8];
#pragma unroll
      for (int q = 0; q < 8; ++q) acc[q] = 0.f;
      const float* w = fw + (size_t)((l * 4 + g) * 64) * 64 + e0;
      for (int k2 = 0; k2 < 64; ++k2) { float rev = (float)((k2 * c) & 63) * (1.f / 64.f); asm volatile("" : "+v"(rev)); const float tr = part ? __builtin_amdgcn_sinf(rev) : __builtin_amdgcn_cosf(rev);
          const f32x4 w0 = *(const f32x4*)(w + k2 * 64), w1 = *(const f32x4*)(w + k2 * 64 + 4);
#pragma unroll
          for (int q = 0; q < 4; ++q) { acc[q] += tr * w0[q]; acc[4 + q] += tr * w1[q]; } }
      const float sc = 0.00276213586400995f;
#pragma unroll
      for (int q = 0; q < 8; ++q) M[c * 64 + e0 + q] = acc[q] * sc; }
    __syncthreads();
    PLAS float* Wl = (PLAS float*)(lds + 16384);
    { const float* wsrc = w_in + ((size_t)l * 1024 + kq * 256) * cfg::INW + 1536 + 64 * g; f32x4 tv[8];
#pragma unroll
      for (int i = 0; i < 8; ++i) tv[i] = *(const f32x4*)(wsrc + (size_t)((tid >> 4) + 32 * i) * cfg::INW + (tid & 15) * 4);
#pragma unroll
      for (int i = 0; i < 8; ++i) *(PLAS f32x4*)(Wl + ((tid >> 4) + 32 * i) * 64 + (tid & 15) * 4) = tv[i]; }
    __syncthreads();
    { const int e = tid & 63, kg = tid >> 6, k0 = kq * 256 + kg * 32, np = 1536 + part * 256 + g * 64 + e; float mc[64];
#pragma unroll
      for (int c = 0; c < 64; ++c) mc[c] = M[c * 64 + e];
      bf16_t* dst = (bf16_t*)(ws + cfg::WS_WIN + l * cfg::SZ_WIN) + (size_t)np * 1024 + k0; float s1 = 0.f, s2 = 0.f;
      for (int kb = 0; kb < 4; ++kb) { float o[8];
#pragma unroll
          for (int q = 0; q < 8; ++q) { const int k = k0 + kb * 8 + q; const PLAS f32x4* wr = (const PLAS f32x4*)(Wl + (kg * 32 + kb * 8 + q) * 64); float a = 0.f;
#pragma unroll
              for (int c4 = 0; c4 < 16; ++c4) { const f32x4 w4 = wr[c4]; a += w4[0] * mc[4 * c4] + w4[1] * mc[4 * c4 + 1] + w4[2] * mc[4 * c4 + 2] + w4[3] * mc[4 * c4 + 3]; }
              o[q] = a * (lng ? lng[k] : 1.f); s2 += lnb ? lnb[k] * a : 0.f; }
          u32x4 w; w.x = pk2(o[0], o[1]); w.y = pk2(o[2], o[3]); w.z = pk2(o[4], o[5]); w.w = pk2(o[6], o[7]); *(u32x4*)(dst + kb * 8) = w;
          s1 += (lo_f(w.x) + hi_f(w.x)) + (lo_f(w.y) + hi_f(w.y)) + (lo_f(w.z) + hi_f(w.z)) + (lo_f(w.w) + hi_f(w.w)); }
      __syncthreads();
      PLAS float* red = (PLAS float*)lds; red[(kg * 64 + e) * 2] = s1; red[(kg * 64 + e) * 2 + 1] = s2;
      __syncthreads();
      if (kg == 0) { float t1 = 0.f, t2 = 0.f;
#pragma unroll
          for (int w = 0; w < 8; ++w) { t1 += red[(w * 64 + e) * 2]; t2 += red[(w * 64 + e) * 2 + 1]; }
          float* fp = (float*)(ws + cfg::V_MF) + (size_t)((l * 4 + kq) * 2) * 512 + part * 256 + g * 64 + e; fp[0] = t1; fp[512] = t2; } }
    __syncthreads();
}

struct Inputs { const float *x, *w_in, *fw, *gw2, *w_out, *ln1g, *ln1b, *wg, *wu, *wd, *ln2g, *ln2b; };
__device__ __forceinline__ void prologue(unsigned char* ws, const Inputs& in, PLAS unsigned char* lds, int vcu, int G) {
    int tid_o = threadIdx.x; asm volatile("" : "+v"(tid_o));
    const int tid = tid_o, wave = __builtin_amdgcn_readfirstlane(tid >> 6), lane = tid & 63;
    const float* x = in.x; const float* w_in = in.w_in; const float* fw = in.fw; const float* gw2 = in.gw2; const float* w_out = in.w_out; const float* ln1g = in.ln1g; const float* ln1b = in.ln1b;
    const float* wg = in.wg; const float* wu = in.wu; const float* wd = in.wd; const float* ln2g = in.ln2g; const float* ln2b = in.ln2b;
    if (vcu < 64) { const int l = vcu >> 5; fold_item(vcu, ws, w_in, fw, l ? ln2g : (const float*)nullptr, l ? ln2b : (const float*)nullptr, lds, tid); }
    PLAS float* scr = (PLAS float*)(lds + wave * 16384); PLAS float* scr1 = scr + 2048; PLAS float* redw = (PLAS float*)(lds + 131072 + 1024 + wave * 256);
    const bool gate_wg3 = (G == 256) && (((vcu + 64) & 127) >= 36) && (((vcu + 64) & 127) < 40);
    const int gw = (G == 256) ? (gate_wg3 ? 0x40000000 : (vcu - (vcu > 103 ? 4 : 0) - (vcu > 231 ? 4 : 0)) * 8 + wave) : vcu * 8 + wave, NGW = (G == 256) ? (G - 8) * 8 : G * 8;
    if (G == 256) {
        const int l = vcu >> 7, P = (vcu + 64) & 127; float a1[2][4], a2[2][4];     PLAS float* redp = (PLAS float*)(lds + 131072 + 1024 + wave * 512);
#pragma unroll
        for (int q = 0; q < 2; ++q)
#pragma unroll
            for (int j = 0; j < 4; ++j) { a1[q][j] = 0.f; a2[q][j] = 0.f; }
        int np0A, np0B; float* c1b; float* c2b;
        if (P < 40) { const float* lngb = l ? ln2g : (const float*)nullptr; const float* lnbb = l ? ln2b : (const float*)nullptr;
            bf16_t* Wt = (bf16_t*)(ws + cfg::WS_WIN + l * cfg::SZ_WIN); c1b = (float*)(ws + cfg::V_C1IN) + l * cfg::NIN; c2b = (float*)(ws + cfg::V_C2IN) + l * cfg::NIN;
            if (P < 36) { int srcA;
                if (P < 16) { const int pn = P >> 2, wc = P & 3; np0A = pn * 256 + 32 * wc; np0B = np0A + 128; srcA = (pn >> 1) * 512 + (pn & 1) * 256 + 64 * wc; }
                else if (P < 24) { np0A = 1024 + (P - 16) * 64; np0B = np0A + 32; srcA = np0A; }
                else { np0A = 2048 + (P - 24) * 64; np0B = np0A + 32; srcA = 1792 + (P - 24) * 64; }
                const float* Wsrc = w_in + (size_t)l * 1024 * cfg::INW + srcA;
                for (int kh = 0; kh < 2; ++kh) { const int k0 = (wave + 8 * kh) * 64;
                    tile_dma(Wsrc + (size_t)k0 * cfg::INW, cfg::INW, scr, lane); tile_dma(Wsrc + (size_t)k0 * cfg::INW + 32, cfg::INW, scr1, lane);
                    asm volatile("s_waitcnt vmcnt(0)" ::: "memory");
                    tile_emit<true, 32>(1024, Wt + (size_t)np0A * 1024 + k0, lngb ? lngb + k0 : lngb, lnbb ? lnbb + k0 : lnbb, a1[0], a2[0], scr, lane);
                    tile_emit<true, 32>(1024, Wt + (size_t)np0B * 1024 + k0, lngb ? lngb + k0 : lngb, lnbb ? lnbb + k0 : lnbb, a1[1], a2[1], scr1, lane); }
            } else { const int p0A = (P - 36) * 64; np0A = 2816 + p0A; np0B = np0A + 32;
#pragma unroll
                for (int q = 0; q < 2; ++q) { const int p0 = p0A + 32 * q, dir = p0 >> 7, kk0 = p0 & 127, np0 = 2816 + p0;
                    for (int kb = wave; kb < 16; kb += 8) { const int kq = kb * 64; ValGate v{w_in + ((size_t)l * 1024 + kq) * cfg::INW + 2560 + 16 * dir, gw2 + (size_t)((l * 2 + dir) * 16) * 128 + kk0};
                        tile_item<true>(v, 1024, Wt + (size_t)np0 * 1024 + kq, lngb ? lngb + kq : lngb, lnbb ? lnbb + kq : lnbb, a1[q], a2[q], scr, lane); } } }
        } else { const int nbA = 2 * (P - 40); np0A = nbA * 32; np0B = np0A + 32; const int pn = np0A >> 8, p = np0A & 255, bj = p >> 7, f0 = 128 * pn + (p & 127);
            const float* Wsrc = (bj ? wu : wg) + (size_t)l * 1024 * cfg::FF + f0; bf16_t* Wt = (bf16_t*)(ws + cfg::WS_WGU + l * cfg::SZ_WGU);
            c1b = (float*)(ws + cfg::V_C1GU) + l * cfg::NGU; c2b = (float*)(ws + cfg::V_C2GU) + l * cfg::NGU;
            for (int kh = 0; kh < 2; ++kh) { const int k0 = (wave + 8 * kh) * 64;
                tile_dma(Wsrc + (size_t)k0 * cfg::FF, cfg::FF, scr, lane); tile_dma(Wsrc + (size_t)k0 * cfg::FF + 32, cfg::FF, scr1, lane);
                asm volatile("s_waitcnt vmcnt(0)" ::: "memory");
                tile_emit<true, 32>(1024, Wt + (size_t)np0A * 1024 + k0, ln1g + l * 1024 + k0, ln1b + l * 1024 + k0, a1[0], a2[0], scr, lane);
                tile_emit<true, 32>(1024, Wt + (size_t)np0B * 1024 + k0, ln1g + l * 1024 + k0, ln1b + l * 1024 + k0, a1[1], a2[1], scr1, lane); } }
        if ((lane & 7) == 0) {
#pragma unroll
            for (int q = 0; q < 2; ++q)
#pragma unroll
                for (int j = 0; j < 4; ++j) { const int n = (lane >> 3) + 8 * j; redp[(q * 32 + n) * 2] = a1[q][j]; redp[(q * 32 + n) * 2 + 1] = a2[q][j]; } }
        __syncthreads();
        if (wave == 0) { float t1 = 0.f, t2 = 0.f;
#pragma unroll
            for (int w = 0; w < 8; ++w) { const PLAS float* rw = (const PLAS float*)(lds + 131072 + 1024 + w * 512); t1 += rw[lane * 2]; t2 += rw[lane * 2 + 1]; }
            const int col = (lane < 32 ? np0A : np0B) + (lane & 31); c1b[col] = t1; c2b[col] = t2; }
        __syncthreads();
    }
    constexpr int I_OUT = 32 * 16, I_DN = 32 * 44, I_L = I_OUT + I_DN;
    for (int it = gw; it < 2 * I_L; it += 2 * NGW) {
        const float* Ws[2]; int Ns[2], Ks[2]; bf16_t* Wd[2]; float d1[4], d2[4];
#pragma unroll
        for (int q = 0; q < 2; ++q) { const int itq = it + q * NGW; const int ic = itq < 2 * I_L ? itq : it; const int l = ic / I_L; int r = ic - l * I_L;
            if (r < I_OUT) { const int nb = r >> 4, kb = r & 15, k0 = kb * 64, n0 = nb * 32; Ws[q] = w_out + ((size_t)l * 1024 + k0) * 1024 + n0; Ns[q] = 1024; Ks[q] = 1024;
                Wd[q] = (bf16_t*)(ws + cfg::WS_WOUT + l * cfg::SZ_WOUT) + (size_t)n0 * 1024 + k0; }
            else { r -= I_OUT; const int nb = r / 44, kb = r - nb * 44, k0 = kb * 64, n0 = nb * 32; Ws[q] = wd + ((size_t)l * cfg::FF + k0) * 1024 + n0; Ns[q] = 1024; Ks[q] = cfg::FF;
                Wd[q] = (bf16_t*)(ws + cfg::WS_WDN + l * cfg::SZ_WDN) + (size_t)n0 * cfg::FF + k0; } }
        tile_dma(Ws[0], Ns[0], scr, lane); tile_dma(Ws[1], Ns[1], scr1, lane);
        asm volatile("s_waitcnt vmcnt(0)" ::: "memory");
        tile_emit<false, 32>(Ks[0], Wd[0], (const float*)nullptr, (const float*)nullptr, d1, d2, scr, lane);
        if (it + NGW < 2 * I_L) tile_emit<false, 32>(Ks[1], Wd[1], (const float*)nullptr, (const float*)nullptr, d1, d2, scr1, lane);
    }
    const int pq_ = (vcu + 64) & 127; const bool gate_wg = pq_ >= 36 && pq_ < 40;
    const int xw = (vcu - 64 - (vcu > 103 ? 4 : 0) - (vcu > 231 ? 4 : 0)) * 8 + wave, NXW = (G - 72) * 8;
    if (vcu >= 64 && !gate_wg && G == 256)
    for (int m = xw; m < cfg::T; m += 4 * NXW) {
        f32x4 v[4][4];
#pragma unroll
        for (int q = 0; q < 4; ++q) { const int mr = (m + q * NXW) < cfg::T ? (m + q * NXW) : m; const f32x4* xr = (const f32x4*)(x + (size_t)mr * 1024) + 2 * lane;
#pragma unroll
            for (int j = 0; j < 2; ++j) { v[q][2 * j] = xr[128 * j]; v[q][2 * j + 1] = xr[128 * j + 1]; } }
        const __amdgpu_buffer_rsrc_t xb_rsrc = __builtin_amdgcn_make_buffer_rsrc(ws + cfg::WS_XB, 0, cfg::T * 1024 * 2, 0x00020000);
#pragma unroll
        for (int q = 0; q < 4; ++q) { const int mr = (m + q * NXW) < cfg::T ? (m + q * NXW) : m;
#pragma unroll
            for (int j = 0; j < 2; ++j) { u32x4 o; o.x = pk2(v[q][2 * j][0], v[q][2 * j][1]); o.y = pk2(v[q][2 * j][2], v[q][2 * j][3]); o.z = pk2(v[q][2 * j + 1][0], v[q][2 * j + 1][1]); o.w = pk2(v[q][2 * j + 1][2], v[q][2 * j + 1][3]);
                __builtin_amdgcn_raw_buffer_store_b128(o, xb_rsrc, (unsigned)((mr * 1024 + 8 * (lane + 64 * j)) * 2), 0, 16); } } }
}
#undef PLAS
}
constexpr int NWAVES = 8;
constexpr int RING_OFF = 0, RING_BYTES = 131072;
constexpr int LDSCTL_OFF = RING_BYTES, MISC_OFF = LDSCTL_OFF + 320;
constexpr int RSL_OFF = 131072 + 4096;
constexpr int LDS_BYTES = 147456;
constexpr int CW_BAR = 4096;
constexpr int CODE_PREWARM_BYTES = 202 * 1024;
constexpr int CW_GBAR = 8192, GBAR_STRIDE = 4096;
constexpr size_t CTL_ZERO_BYTES = 192 * 1024;
#define GAS __attribute__((address_space(1)))
#define LAS __attribute__((address_space(3)))
typedef GAS unsigned gu32;
#define RLX_AGENT __ATOMIC_RELAXED, __HIP_MEMORY_SCOPE_AGENT
#define XB_TMO      128
#define XB_XCNT(j)  (256  + 64 * (j))
#define XB_XSUB(j)  (1280 + 64 * (j))
#define XB_XGEN(j)  (2304 + 64 * (j))
#define XB_TOP      3328
#define XB_TOPGEN   3392
#define XCD_BAR_WORDS 3456
#define XB_SPIN_CAP (1u << 18)

__device__ __forceinline__ unsigned xb_ld(unsigned* p)              { return __hip_atomic_load(p, __ATOMIC_RELAXED, __HIP_MEMORY_SCOPE_AGENT); }
__device__ __forceinline__ unsigned xb_add(unsigned* p, unsigned v) { return __hip_atomic_fetch_add(p, v, __ATOMIC_RELAXED, __HIP_MEMORY_SCOPE_AGENT); }
__device__ __forceinline__ unsigned xb_xcc_id() { return (unsigned)__builtin_amdgcn_s_getreg((3 << 11) | 20) & 0xFu; }
#define XB_SPIN(cond, bar) do { unsigned _sp = 0; while (cond) { __builtin_amdgcn_s_sleep(1); \
    if ((++_sp & 255u) == 0u) { if (xb_ld(&(bar)[XB_TMO])) break; if (_sp > XB_SPIN_CAP) { atomicAdd(&(bar)[XB_TMO], 1u); break; } } } } while (0)

struct XcdBarrier {
    unsigned* bar; unsigned x; unsigned total; unsigned same_l2_ok;
    volatile LAS unsigned* st;
};

__device__ __forceinline__ XcdBarrier xcd_barrier_post(unsigned* bar, volatile LAS unsigned* st, unsigned total) {
    XcdBarrier b; b.bar = bar; b.x = xb_xcc_id(); b.st = st; b.total = total; b.same_l2_ok = 0u;
    if (threadIdx.x == 0) (void)xb_add(&bar[XB_XCNT(b.x)], 1u);
    return b;
}
__device__ __forceinline__ void xcd_barrier_complete(unsigned* bar, unsigned x, unsigned G, unsigned& nloc, unsigned& nx) {
    unsigned sum, cnt, mine, sp = 0u;
    for (;;) {
        sum = 0u; cnt = 0u; mine = 0u;
#pragma unroll
        for (unsigned j = 0; j < 16; ++j) { const unsigned c = xb_ld(&bar[XB_XCNT(j)]); sum += c; cnt += (c > 0u) ? 1u : 0u; mine = (j == x) ? c : mine; }
        if (sum == G) break;
        __builtin_amdgcn_s_sleep(1);
        if ((++sp & 255u) == 0u) { if (xb_ld(&bar[XB_TMO])) break; if (sp > XB_SPIN_CAP) { atomicAdd(&bar[XB_TMO], 1u); break; } }
    }
    nloc = mine > 0u ? mine : 1u; nx = cnt > 0u ? cnt : 1u;
}

struct NoMid { __device__ __forceinline__ void operator()() const {} };
template <class Mid = NoMid>
__device__ __forceinline__ void xcd_barrier(const XcdBarrier& b, const Mid& mid = Mid()) {
    asm volatile("s_waitcnt vmcnt(0)" ::: "memory");
    __syncthreads();
    mid();
    if (threadIdx.x == 0) {
        unsigned* bar = b.bar;
        __builtin_amdgcn_s_waitcnt(0);
        unsigned nloc = b.st[0], nx = b.st[1];
        if (nloc == 0u) { xcd_barrier_complete(bar, b.x, b.total, nloc, nx); b.st[0] = nloc; b.st[1] = nx; }
        const bool fast = b.same_l2_ok && nx == 1u;
        unsigned old;
        if (fast) { unsigned* ap_ = &bar[XB_XSUB(b.x)]; const unsigned one_ = 1u;
            asm volatile("global_atomic_add %0, %1, %2, off sc0\n\tbuffer_inv sc1\n\ts_waitcnt vmcnt(1)" : "=&v"(old) : "v"(ap_), "v"(one_) : "memory"); }
        else old = xb_add(&bar[XB_XSUB(b.x)], 1u);
        const unsigned gen = old / nloc;
        if (old + 1u == (gen + 1u) * nloc) {
            if (!fast) {
            __builtin_amdgcn_fence(__ATOMIC_RELEASE, "agent");
            asm volatile("s_waitcnt vmcnt(0)" ::: "memory");
            const unsigned og = xb_add(&bar[XB_TOP], 1u);
            const unsigned tg = og / nx;
            if (og + 1u == (tg + 1u) * nx) xb_add(&bar[XB_TOPGEN], 1u);
            else XB_SPIN(xb_ld(&bar[XB_TOPGEN]) == tg, bar);
            }
            if (!fast) __builtin_amdgcn_fence(__ATOMIC_ACQUIRE, "agent");
            xb_add(&bar[XB_XGEN(b.x)], 1u);
            asm volatile("s_waitcnt vmcnt(0)" ::: "memory");
        } else {
            XB_SPIN(xb_ld(&bar[XB_XGEN(b.x)]) == gen, bar);
            if (!fast) __builtin_amdgcn_fence(__ATOMIC_ACQUIRE, "agent");
            asm volatile("s_waitcnt vmcnt(0)" ::: "memory");
        }
    }
    __syncthreads();
}
#define XB_SPLIT 3520
__device__ __forceinline__ void xcd_split_arrive(const XcdBarrier& b) {
    asm volatile("s_waitcnt vmcnt(0)" ::: "memory");
    __syncthreads();
    if (threadIdx.x == 0) {
        const bool fast = b.same_l2_ok && b.st[0] != 0u && b.st[1] == 1u;
        if (!fast) { __builtin_amdgcn_fence(__ATOMIC_RELEASE, "agent"); asm volatile("s_waitcnt vmcnt(0)" ::: "memory"); }
        (void)xb_add(&b.bar[XB_SPLIT], 1u);
        if (fast) asm volatile("buffer_inv sc1" ::: "memory");
    }
}
template <class Mid = NoMid>
__device__ __forceinline__ void xcd_split_wait(const XcdBarrier& b, unsigned target, const Mid& mid = Mid()) {
    mid();
    if (threadIdx.x == 0) {
        unsigned* bar = b.bar;
        XB_SPIN(xb_ld(&bar[XB_SPLIT]) < target, bar);
        const bool fast = b.same_l2_ok && b.st[0] != 0u && b.st[1] == 1u;
        if (!fast) __builtin_amdgcn_fence(__ATOMIC_ACQUIRE, "agent");
        asm volatile("s_waitcnt vmcnt(0)" ::: "memory");
    }
    __syncthreads();
}


#define FILL_RSL(STP) do { pg8::Unit u0_; if (S.next(0, u0_)) { int tq_ = threadIdx.x; asm volatile("" : "+v"(tq_)); const int row_ = u0_.pm * 256 + (tq_ >> 1), hf_ = tq_ & 1; \
    typedef float f32x4_ __attribute__((ext_vector_type(4))); typedef float f32x2_ __attribute__((ext_vector_type(2))); \
    const f32x4_* sp_ = (const f32x4_*)((STP) + (size_t)row_ * 32 + hf_ * 16); const f32x4_ x0 = sp_[0], x1 = sp_[1], x2 = sp_[2], x3 = sp_[3]; \
    float sm_ = ((x0[0] + x0[2]) + (x1[0] + x1[2])) + ((x2[0] + x2[2]) + (x3[0] + x3[2])), sq_ = ((x0[1] + x0[3]) + (x1[1] + x1[3])) + ((x2[1] + x2[3]) + (x3[1] + x3[3])); \
    sm_ = xadd<1>(sm_); sq_ = xadd<1>(sq_); const float mu_ = sm_ * (1.f / 1024.f), rstd_ = rsqrtf(fmaxf(sq_ * (1.f / 1024.f) - mu_ * mu_, 0.f) + EPS); \
    if (hf_ == 0) *(LAS f32x2_*)(ldsl + RSL_OFF + 8 * (tq_ >> 1)) = (f32x2_){rstd_, -rstd_ * mu_}; } \
    __syncthreads(); } while (0)

enum { PH_PRO = 0, PH_IN = 1, PH_ATT = 2, PH_MIXB = 3, PH_OUT = 4, PH_GU = 5, PH_DN = 6, PH_FIN = 13, N_PHASES = 14 };
struct MArgs { const float* in[16]; float* out; unsigned char* ws; int ph_lo, ph_hi, li, pad; };

__global__ void __launch_bounds__(NWAVES * 64, 2) mk_fwd(MArgs a) {
    extern __shared__ __attribute__((aligned(128))) unsigned char lds[];
    LAS unsigned char* ldsl = (LAS unsigned char*)lds;
    volatile LAS unsigned* MISC = (volatile LAS unsigned*)(ldsl + MISC_OFF);
    const int tid = threadIdx.x;
    const int G = gridDim.x, bx = blockIdx.x, vcu = (G % 8 == 0) ? (bx % 8) * (G / 8) + bx / 8 : bx;
    unsigned char* ws = a.ws;
    typedef unsigned pw_u32x4 __attribute__((ext_vector_type(4))); pw_u32x4 pw_v = {0u, 0u, 0u, 0u};
    unsigned long long pc_; asm volatile("s_getpc_b64 %0" : "=s"(pc_)); const char* const code0 = (const char*)(pc_ & ~63ull);
    { const unsigned off_ = (unsigned)(((bx >> 3) * (NWAVES * 64) + tid) * 16);
      if (CODE_PREWARM_BYTES > 0 && off_ < (unsigned)CODE_PREWARM_BYTES) pw_v = *(const volatile pw_u32x4*)(code0 + off_); }
    for (int u = tid; u < (LDS_BYTES - LDSCTL_OFF) / 4; u += NWAVES * 64) ((LAS unsigned*)(ldsl + LDSCTL_OFF))[u] = 0u;
    __syncthreads();
    XcdBarrier bar; bar.bar = (unsigned*)(ws + WS_CTL) + CW_BAR + a.li * XCD_BAR_WORDS; bar.x = 0; bar.st = nullptr; bar.total = (unsigned)G; bar.same_l2_ok = 0u;
    if (a.ph_hi - a.ph_lo > 1) bar = xcd_barrier_post((unsigned*)(ws + WS_CTL) + CW_BAR + a.li * XCD_BAR_WORDS, MISC + 8, (unsigned)G);
    const bool grp_ok = (G % 8 == 0) && (a.ph_hi - a.ph_lo > 1);
    XcdBarrier gbar = bar;
    if (grp_ok) { gbar = xcd_barrier_post((unsigned*)(ws + WS_CTL) + CW_GBAR + (bx & 7) * GBAR_STRIDE, MISC + 10, (unsigned)(G / 8)); gbar.same_l2_ok = 1u; }
    const int G0 = G, bx0 = bx, vcu0 = vcu; unsigned char* const ws0 = ws;
    for (int ph = a.ph_lo; ph < a.ph_hi; ++ph) {
        int G = G0, bx = bx0, vcu = vcu0; unsigned zo = 0u; asm volatile("" : "+s"(G), "+s"(bx), "+s"(vcu), "+s"(zo)); unsigned char* ws = ws0 + zo;
        const int l = (ph >= 1 && ph <= 12) ? (ph - 1) / 6 : 0;
        const int kind = (ph == 0) ? PH_PRO : (ph == PH_FIN ? PH_FIN : 1 + (ph - 1) % 6);
        if (kind == PH_PRO) {
            { pro::Inputs pin{a.in[0], a.in[1], a.in[4], a.in[5], a.in[8], a.in[9], a.in[10], a.in[11], a.in[12], a.in[13], a.in[14], a.in[15]}; pro::prologue(ws, pin, ldsl + RING_OFF, vcu, G); }
            asm volatile("" :: "v"(pw_v));
        } else if (kind == PH_IN) {
            pg8::Gemm g{(const bf16_t*)(ws + WS_XB), (const bf16_t*)(ws + WS_WIN + l * SZ_WIN), T, NIN, D}; pg8::StaticOrder S; S.init(T, NIN, G, bx);
            if (l) FILL_RSL((const float*)(ws + WS_ST2));
            pg8::FEpiIn E{ws, a.in[6] + l * 256, l, (const LAS float*)(ldsl + RSL_OFF)};
            pg8::gemm_phase<pg8::FEpiIn, pg8::StaticOrder, true, true>(ldsl + RING_OFF, g, S, E);
        } else if (kind == PH_ATT) {
            if (vcu * 2 + 1 < 512) {
                typedef unsigned u32x4_ __attribute__((ext_vector_type(4))); u32x4_ tva[4], tvb[4]; const int ia = vcu * 2, ib = ia + 1;
                fft::stage1_load(tva, ia >> 6, ia & 63, (const bf16_t*)(ws + WS_TAB)); fft::stage1_load(tvb, ib >> 6, ib & 63, (const bf16_t*)(ws + WS_TAB));
                fft::stage1_item(ia >> 6, ia & 63, tva, (bf16_t*)(ws + WS_XT), ldsl + RING_OFF); fft::stage1_item(ib >> 6, ib & 63, tvb, (bf16_t*)(ws + WS_XT), ldsl + RING_OFF); }
            if (vcu < 256) gla::gla_a_item(vcu >> 5, (vcu >> 3) & 3, vcu & 7, ws, ldsl + RING_OFF);
            if (grp_ok) xcd_split_arrive(gbar);
            for (int i = 0; i < 2; ++i) { const int idx = vcu * 2 + i; if (idx >= 512) break; const int bh = idx >> 4, qb = idx & 15;
                att::attn_unit(bh >> 2, bh & 3, qb, (const bf16_t*)(ws + WS_Q), (const bf16_t*)(ws + WS_K), (const bf16_t*)(ws + WS_V), (bf16_t*)(ws + WSB_OC + (size_t)(bh >> 2) * DLT_OC), a.in[2] + l * 256, a.in[3] + l * 128, l, (char*)lds + RING_OFF); }
        } else if (kind == PH_MIXB) {
            if (vcu < 256) fft::stage2_item(vcu >> 5, vcu & 31, (const bf16_t*)(ws + WS_XT), (bf16_t*)(ws + WSB_OC + (size_t)(vcu >> 5) * DLT_OC), ldsl + RING_OFF);
            if (vcu < 256) gla::gla_b_item(vcu >> 5, (vcu >> 3) & 3, vcu & 7, ws, a.in[7] + l * 64, (bf16_t*)(ws + WSB_OC + (size_t)(vcu >> 5) * DLT_OC), ldsl + RING_OFF);
        } else if (kind == PH_OUT) {
            pg8::Gemm g{(const bf16_t*)(ws + WSB_OC + (size_t)(bx & 7) * DLT_OC), (const bf16_t*)(ws + WS_WOUT + l * SZ_WOUT), T, D, D}; pg8::StaticOrder S; S.init(T, D, G, bx);
            if (l) FILL_RSL((const float*)(ws + WS_ST2));
            pg8::FEpiRes E{l ? (const LAS float*)(ldsl + RSL_OFF) : (const LAS float*)nullptr, a.in[14] + (l ? l - 1 : 0) * 1024, a.in[15] + (l ? l - 1 : 0) * 1024, (bf16_t*)(ws + WS_XB), (float*)(ws + WS_ST1)};
            pg8::gemm_phase<pg8::FEpiRes, pg8::StaticOrder, true, true>(ldsl + RING_OFF, g, S, E);
        } else if (kind == PH_GU) {
            pg8::Gemm g{(const bf16_t*)(ws + WS_XB), (const bf16_t*)(ws + WS_WGU + l * SZ_WGU), T, NGU, D}; pg8::StaticOrder S; S.init(T, NGU, G, bx);
            FILL_RSL((const float*)(ws + WS_ST1));
            pg8::FEpiGU E{(const LAS float*)(ldsl + RSL_OFF), (const float*)(ws + V_C1GU) + l * NGU, (const float*)(ws + V_C2GU) + l * NGU, (bf16_t*)(ws + WS_ACT)};
            pg8::gemm_phase<pg8::FEpiGU, pg8::StaticOrder, true, true>(ldsl + RING_OFF, g, S, E);
        } else if (kind == PH_DN) {
            pg8::Gemm g{(const bf16_t*)(ws + WS_ACT), (const bf16_t*)(ws + WS_WDN + l * SZ_WDN), T, D, FF}; pg8::StaticOrder S; S.init(T, D, G, bx);
            FILL_RSL((const float*)(ws + WS_ST1));
            pg8::FEpiRes E{(const LAS float*)(ldsl + RSL_OFF), a.in[9] + l * 1024, a.in[10] + l * 1024, (bf16_t*)(ws + WS_XB), (float*)(ws + WS_ST2)};
            pg8::gemm_phase<pg8::FEpiRes, pg8::StaticOrder, true, true>(ldsl + RING_OFF, g, S, E);
        } else if (kind == PH_FIN) {
            const float* g2 = a.in[14] + 1024; const float* b2v = a.in[15] + 1024; const float* ST2 = (const float*)(ws + WS_ST2); const bf16_t* XB = (const bf16_t*)(ws + WS_XB); float* Y2 = a.out;
            int tid_f = threadIdx.x; asm volatile("" : "+v"(tid_f)); const int lane = tid_f & 63, wave = __builtin_amdgcn_readfirstlane(tid_f >> 6);
            typedef float f32x4 __attribute__((ext_vector_type(4))); typedef unsigned u32x2 __attribute__((ext_vector_type(2)));
            f32x4 gg[4], bq[4];
#pragma unroll
            for (int j = 0; j < 4; ++j) { gg[j] = *((const f32x4*)g2 + lane + 64 * j); bq[j] = *((const f32x4*)b2v + lane + 64 * j); }
            const bool grp_rows = (G % 8 == 0) && (S % ((G / 8) * NWAVES) == 0);
            const int r_first = grp_rows ? (bx & 7) * S + (bx >> 3) * NWAVES + wave : vcu * NWAVES + wave, r_step = grp_rows ? (G / 8) * NWAVES : G * NWAVES, r_end = grp_rows ? (bx & 7) * S + S : T;
            for (int row = r_first; row < r_end; row += 4 * r_step) { float sv[4]; u32x2 w[4][4];
#pragma unroll
                for (int q = 0; q < 4; ++q) { const int rq = (row + q * r_step < r_end) ? row + q * r_step : row;
                    sv[q] = ST2[(size_t)rq * 32 + (lane & 31)];
                    const u32x2* xr = (const u32x2*)(XB + (size_t)rq * 1024) + lane;
#pragma unroll
                    for (int j = 0; j < 4; ++j) w[q][j] = xr[64 * j]; }
#pragma unroll
                for (int q = 0; q < 4; ++q) { if (row + q * r_step < r_end) {
                    float t = sv[q]; t = xadd<2>(t); t = xadd<4>(t); t = xadd<8>(t); t = xadd<16>(t);
                    const float o = __int_as_float(__builtin_amdgcn_ds_swizzle(__float_as_int(t), (1 << 10) | 0x1f));
                    const float s_ = (lane & 1) ? o : t, ss_ = (lane & 1) ? t : o;
                    const float mu = s_ * (1.f / 1024.f), var = ss_ * (1.f / 1024.f) - mu * mu, rstd = rsqrtf(fmaxf(var, 0.f) + EPS);
                    f32x4* yr = (f32x4*)(Y2 + (size_t)(row + q * r_step) * 1024) + lane;
#pragma unroll
                    for (int j = 0; j < 4; ++j) { const u32x2 ww = w[q][j]; const f32x4 v = {__uint_as_float(ww.x << 16), __uint_as_float(ww.x & 0xffff0000u), __uint_as_float(ww.y << 16), __uint_as_float(ww.y & 0xffff0000u)};
                        yr[64 * j] = (v - mu) * rstd * gg[j] + bq[j]; } } } }
        }
        typedef unsigned rt_u32x4 __attribute__((ext_vector_type(4))); rt_u32x4 rt0 = {0u, 0u, 0u, 0u}, rt1 = rt0;
        auto mid = [&]() { if (threadIdx.x >= 256) { const unsigned o_ = (unsigned)(((bx >> 3) * 256 + (threadIdx.x - 256)) * 16);
                if (o_ < (unsigned)CODE_PREWARM_BYTES) rt0 = *(const volatile rt_u32x4*)(code0 + o_);
                if (o_ + 131072u < (unsigned)CODE_PREWARM_BYTES) rt1 = *(const volatile rt_u32x4*)(code0 + o_ + 131072u); } };
        if (ph + 1 < a.ph_hi) { const bool local = grp_ok && kind != PH_PRO; if (local && kind == PH_ATT) xcd_split_wait(gbar, (unsigned)(G / 8) * (unsigned)(l + 1), mid); else if (local) xcd_barrier(gbar, mid); else xcd_barrier(bar); }
        asm volatile("" :: "v"(rt0), "v"(rt1));
    }
}

static void launch_frame(const MArgs& base, int lo, int hi, int grid, hipStream_t stream, int li = 0) {
    MArgs a = base; a.ph_lo = lo; a.ph_hi = hi; a.li = li;
    hipLaunchKernelGGL(mk_fwd, dim3(grid), dim3(NWAVES * 64), LDS_BYTES, stream, a);
}
extern "C" void kernel_launch(void* const* d_in, const int* in_sizes, int n_in, void* d_out, int out_size, void* d_ws, size_t ws_size, hipStream_t stream) {
    static int grid = 0;
    if (grid == 0) {
        if (n_in != 16 || in_sizes[0] != T * D || out_size != T * D || ws_size < WS_END) { fprintf(stderr, "kernel_launch: unexpected shapes (n_in %d, in0 %d, out %d, ws %zu)\n", n_in, n_in > 0 ? in_sizes[0] : -1, out_size, ws_size); grid = -1; return; }
        int dev = 0, cus = 0, per_cu = 0;
        if (hipGetDevice(&dev) != hipSuccess || hipDeviceGetAttribute(&cus, hipDeviceAttributeMultiprocessorCount, dev) != hipSuccess) { grid = -1; return; }
        if (hipFuncSetAttribute((const void*)mk_fwd, hipFuncAttributeMaxDynamicSharedMemorySize, LDS_BYTES) != hipSuccess) { fprintf(stderr, "kernel_launch: hipFuncSetAttribute failed\n"); grid = -1; return; }
        if (hipOccupancyMaxActiveBlocksPerMultiprocessor(&per_cu, (const void*)mk_fwd, NWAVES * 64, LDS_BYTES) != hipSuccess || per_cu < 1) { fprintf(stderr, "kernel_launch: occupancy query says %d workgroups per CU\n", per_cu); per_cu = 1; }
        (void)hipGetLastError();
        grid = cus;
        if (grid != 256) { fprintf(stderr, "kernel_launch: this kernel's work split is built for the 256 CUs of an MI355X, found %d; nothing launched\n", cus); grid = -1; return; }
    }
    if (grid < 0) return;
    const float* x = (const float*)d_in[0]; const float* w_in = (const float*)d_in[1]; const float* dlam = (const float*)d_in[2]; const float* dng = (const float*)d_in[3];
    const float* fw = (const float*)d_in[4]; const float* gw2 = (const float*)d_in[5]; const float* gb2 = (const float*)d_in[6]; const float* gng = (const float*)d_in[7];
    const float* w_out = (const float*)d_in[8]; const float* ln1g = (const float*)d_in[9]; const float* ln1b = (const float*)d_in[10];
    const float* wg = (const float*)d_in[11]; const float* wu = (const float*)d_in[12]; const float* wd = (const float*)d_in[13]; const float* ln2g = (const float*)d_in[14]; const float* ln2b = (const float*)d_in[15];
    char* ws = (char*)d_ws;
    float* ropec = (float*)(ws + V_ROPEC); float* ropes = (float*)(ws + V_ROPES); float* MF = (float*)(ws + V_MF);
    float* c1in = (float*)(ws + V_C1IN); float* c2in = (float*)(ws + V_C2IN); float* c1gu = (float*)(ws + V_C1GU); float* c2gu = (float*)(ws + V_C2GU);
    bf16_t* TAB = (bf16_t*)(ws + WS_TAB); bf16_t* XB = (bf16_t*)(ws + WS_XB);
    bf16_t* Q = (bf16_t*)(ws + WS_Q); bf16_t* K = (bf16_t*)(ws + WS_K); bf16_t* V = (bf16_t*)(ws + WS_V);
    bf16_t* GQK = (bf16_t*)(ws + WS_GQK); bf16_t* GV = (bf16_t*)(ws + WS_GV); bf16_t* GR = (bf16_t*)(ws + WS_GR); float* GL = (float*)(ws + WS_GL);
    bf16_t* OC = (bf16_t*)(ws + WS_OC); float* OF = (float*)(ws + WS_OF);
    (void)hipMemsetAsync(ws + WS_CTL, 0, CTL_ZERO_BYTES, stream);
    MArgs base{}; for (int i = 0; i < 16; ++i) base.in[i] = (const float*)d_in[i]; base.out = (float*)d_out; base.ws = (unsigned char*)d_ws;
    launch_frame(base, 0, N_PHASES, grid, stream, 0);
}
```
